# Optimizing an MI355X kernel written in HIP

```python
import math
import jax, jax.numpy as jnp
from jax import lax
import numpy as np

D_MODEL = 1024
BATCH = 4
SEQ = 4096
DEPTH = 2

D_INNER = 2 * D_MODEL
GROUP_WIDTH = D_INNER // 4
GRID_W = 64

ATTN_HEADS = 8
ATTN_KV_HEADS = 2
ATTN_HEAD_DIM = GROUP_WIDTH // ATTN_HEADS
Q_BLOCK = 128
ROPE_THETA = 10000.0

HGRN_HEADS = 4
HGRN_WIDTH = GROUP_WIDTH
HGRN_HEAD_V = HGRN_WIDTH // HGRN_HEADS
HGRN_EXPAND = 128
HGRN_KEY_WIDTH = HGRN_HEADS * HGRN_EXPAND

SSD_HEADS = 8
SSD_HEAD_DIM = GROUP_WIDTH // SSD_HEADS
SSD_WIDTH = SSD_HEADS * SSD_HEAD_DIM
SSD_GROUPS = 2
SSD_STATE = 128
SSD_CONV_WIDTH = 5
SSD_CONV_CH = SSD_WIDTH + 2 * SSD_GROUPS * SSD_STATE
SSD_CHUNK = 128

GLA_HEADS = 4
GLA_WIDTH = GROUP_WIDTH
GLA_KEY_WIDTH = GLA_WIDTH // 2
GLA_HEAD_K = GLA_KEY_WIDTH // GLA_HEADS
GLA_HEAD_V = GLA_WIDTH // GLA_HEADS
GLA_GATE_RANK = 16
GLA_GATE_NORMALIZER = 16.0

LIN_CHUNK = 64

DEEPNORM_ALPHA = (2 * DEPTH) ** 0.25
DEEPNORM_BETA = (8 * DEPTH) ** -0.25

IN_SPLITS = (
    ATTN_HEADS * ATTN_HEAD_DIM, ATTN_KV_HEADS * ATTN_HEAD_DIM, ATTN_KV_HEADS * ATTN_HEAD_DIM, GROUP_WIDTH,
    HGRN_KEY_WIDTH, HGRN_KEY_WIDTH, HGRN_KEY_WIDTH, HGRN_WIDTH, HGRN_WIDTH,
    SSD_CONV_CH, SSD_HEADS, SSD_HEADS, SSD_WIDTH,
    GLA_KEY_WIDTH, GLA_KEY_WIDTH, GLA_WIDTH, GLA_GATE_RANK, GLA_GATE_RANK, GLA_WIDTH,
)
N_IN = sum(IN_SPLITS)

kernel_name = 'hybrid_parallel_bidir_encoder'


def rms_norm(x, gain, eps=1e-6):
    xf = x.astype(jnp.float32)
    y = xf * lax.rsqrt(jnp.mean(xf * xf, axis=-1, keepdims=True) + eps)
    return (y * gain.astype(jnp.float32)).astype(x.dtype)


def layer_norm(x, gain, bias, eps=1e-5):
    xf = x.astype(jnp.float32)
    mu = jnp.mean(xf, axis=-1, keepdims=True)
    xc = xf - mu
    var = jnp.mean(xc * xc, axis=-1, keepdims=True)
    return (xc * lax.rsqrt(var + eps) * gain.astype(jnp.float32) + bias.astype(jnp.float32)).astype(x.dtype)


def split_columns(h, sizes):
    cuts = []
    acc = 0
    for w in sizes[:-1]:
        acc += w
        cuts.append(acc)
    return jnp.split(h, cuts, axis=-1)


def flip_seq(t):
    return jnp.flip(t, axis=1)


def axial_rope_tables(n_tokens):
    rows = n_tokens // GRID_W
    row_pos = jnp.repeat(jnp.arange(rows, dtype=jnp.float32), GRID_W)
    col_pos = jnp.tile(jnp.arange(GRID_W, dtype=jnp.float32), rows)
    axis_dim = ATTN_HEAD_DIM // 2
    inv_freq = jnp.power(ROPE_THETA, -jnp.arange(0, axis_dim, 2, dtype=jnp.float32) / axis_dim)
    ang_r = row_pos[:, None] * inv_freq
    ang_c = col_pos[:, None] * inv_freq
    return (jnp.cos(ang_r), jnp.sin(ang_r), jnp.cos(ang_c), jnp.sin(ang_c))


def _rotate(x, cos, sin):
    x1, x2 = jnp.split(x, 2, axis=-1)
    cos = cos[None, :, None, :].astype(x.dtype)
    sin = sin[None, :, None, :].astype(x.dtype)
    return jnp.concatenate([x1 * cos - x2 * sin, x2 * cos + x1 * sin], axis=-1)


def apply_axial_rope(x, rope):
    cos_r, sin_r, cos_c, sin_c = rope
    x_row, x_col = jnp.split(x, 2, axis=-1)
    return jnp.concatenate([_rotate(x_row, cos_r, sin_r), _rotate(x_col, cos_c, sin_c)], axis=-1)


def attention_branch(q_raw, k_raw, v_raw, z, q_gain, k_gain, rope):
    Bsz, L, _ = q_raw.shape
    group = ATTN_HEADS // ATTN_KV_HEADS
    q = rms_norm(q_raw.reshape(Bsz, L, ATTN_HEADS, ATTN_HEAD_DIM), q_gain)
    k = rms_norm(k_raw.reshape(Bsz, L, ATTN_KV_HEADS, ATTN_HEAD_DIM), k_gain)
    v = v_raw.reshape(Bsz, L, ATTN_KV_HEADS, ATTN_HEAD_DIM)
    q = apply_axial_rope(q, rope)
    k = apply_axial_rope(k, rope)
    q = q.reshape(Bsz, L // Q_BLOCK, Q_BLOCK, ATTN_KV_HEADS, group, ATTN_HEAD_DIM).transpose(1, 0, 2, 3, 4, 5)
    scale = ATTN_HEAD_DIM ** -0.5

    def attend(q_blk):
        s = jnp.einsum('bqkgd,bskd->bkgqs', q_blk, k).astype(jnp.float32) * scale
        p = jax.nn.softmax(s, axis=-1).astype(v.dtype)
        return jnp.einsum('bkgqs,bskd->bqkgd', p, v)

    o = lax.map(attend, q)
    o = o.transpose(1, 0, 2, 3, 4, 5).reshape(Bsz, L, ATTN_HEADS * ATTN_HEAD_DIM)
    return o * jax.nn.silu(z)


def chunked_gated_scan(q, k, v, log_g):
    Bsz, L, H, K = q.shape
    V = v.shape[-1]
    n_chunks = L // LIN_CHUNK
    f32 = jnp.float32

    def to_chunks(t):
        return t.astype(f32).reshape(Bsz, n_chunks, LIN_CHUNK, H, t.shape[-1]).transpose(1, 0, 3, 2, 4)

    qc, kc, vc, gc = to_chunks(q), to_chunks(k), to_chunks(v), to_chunks(log_g)
    lower = jnp.tril(jnp.ones((LIN_CHUNK, LIN_CHUNK), bool))[:, :, None]

    def step(state, blk):
        qi, ki, vi, gi = blk
        b = jnp.cumsum(gi, axis=2)
        rel = jnp.where(lower, b[:, :, :, None, :] - b[:, :, None, :, :], -jnp.inf)
        scores = jnp.einsum('bhtk,bhsk,bhtsk->bhts', qi, ki, jnp.exp(rel))
        out = (jnp.einsum('bhts,bhsv->bhtv', scores, vi)
               + jnp.einsum('bhtk,bhkv->bhtv', qi * jnp.exp(b), state))
        b_end = b[:, :, -1:, :]
        state = (jnp.exp(b_end[:, :, 0, :])[..., None] * state
                 + jnp.einsum('bhsk,bhsv->bhkv', ki * jnp.exp(b_end - b), vi))
        return state, out

    state0 = jnp.zeros((Bsz, H, K, V), f32)
    _, out = lax.scan(step, state0, (qc, kc, vc, gc))
    return out.transpose(1, 0, 3, 2, 4).reshape(Bsz, L, H, V).astype(v.dtype)


def bidirectional_gated_scan(q, k_fwd, log_g_fwd, k_bwd, log_g_bwd, v):
    o_f = chunked_gated_scan(q, k_fwd, v, log_g_fwd)
    o_b = flip_seq(chunked_gated_scan(flip_seq(q), flip_seq(k_bwd), flip_seq(v), flip_seq(log_g_bwd)))
    return o_f + o_b


def hgrn2_branch(q_raw, f_fwd_raw, f_bwd_raw, i_raw, z, lower_bound, norm_gain):
    Bsz, L, _ = q_raw.shape
    key_shape = (Bsz, L, HGRN_HEADS, HGRN_EXPAND)
    q = jax.nn.silu(q_raw).reshape(key_shape) * (HGRN_EXPAND ** -0.5)
    v = i_raw.reshape(Bsz, L, HGRN_HEADS, HGRN_HEAD_V)
    lb = jnp.maximum(lower_bound.astype(jnp.float32), 0.0).reshape(HGRN_HEADS, HGRN_EXPAND)
    log_lb = jnp.log(lb)
    log_1m_lb = jnp.log1p(-lb)

    def forget(f_raw):
        f = f_raw.astype(jnp.float32).reshape(key_shape)
        log_f = jnp.logaddexp(log_lb, log_1m_lb + jax.nn.log_sigmoid(f))
        one_minus_f = jnp.exp(log_1m_lb + jax.nn.log_sigmoid(-f))
        return one_minus_f, log_f

    k_f, g_f = forget(f_fwd_raw)
    k_b, g_b = forget(f_bwd_raw)
    o = bidirectional_gated_scan(q, k_f, g_f, k_b, g_b, v).reshape(Bsz, L, HGRN_WIDTH)
    return rms_norm(o, norm_gain) * jax.nn.silu(z)


def segsum(a):
    T = a.shape[-1]
    ae = jnp.broadcast_to(a[..., None], a.shape + (T,))
    cs = jnp.cumsum(jnp.where(jnp.tril(jnp.ones((T, T), bool), -1), ae, 0.0), axis=-2)
    return jnp.where(jnp.tril(jnp.ones((T, T), bool)), cs, -jnp.inf)


def ssd_scan(x, dt, a_coef, b_in, c_in):
    Bsz, L, H, P = x.shape
    G, N = b_in.shape[-2], b_in.shape[-1]
    R = H // G
    C = SSD_CHUNK
    nc = L // C
    f32 = jnp.float32
    xdt = (x.astype(f32) * dt[..., None]).reshape(Bsz, nc, C, G, R, P)
    a = (dt * a_coef).reshape(Bsz, nc, C, H).transpose(0, 1, 3, 2)
    a_cs = jnp.cumsum(a, axis=-1)
    bc = b_in.astype(f32).reshape(Bsz, nc, C, G, N)
    cc = c_in.astype(f32).reshape(Bsz, nc, C, G, N)
    decay_in = jnp.exp(segsum(a)).reshape(Bsz, nc, G, R, C, C)
    cb = jnp.einsum('bclgn,bcsgn->bcgls', cc, bc)
    y_diag = jnp.einsum('bcgls,bcgrls,bcsgrp->bclgrp', cb, decay_in, xdt)
    decay_to_end = jnp.exp(a_cs[..., -1:] - a_cs).reshape(Bsz, nc, G, R, C)
    states = jnp.einsum('bclgn,bcgrl,bclgrp->bcgrpn', bc, decay_to_end, xdt)
    states = jnp.concatenate([jnp.zeros_like(states[:, :1]), states], axis=1)
    chunk_a = jnp.pad(a_cs[..., -1].transpose(0, 2, 1), ((0, 0), (0, 0), (1, 0)))
    decay_chunk = jnp.exp(segsum(chunk_a)).reshape(Bsz, G, R, nc + 1, nc + 1)
    states = jnp.einsum('bgrzc,bcgrpn->bzgrpn', decay_chunk, states)[:, :-1]
    y_off = jnp.einsum('bclgn,bcgrpn,bcgrl->bclgrp', cc, states, jnp.exp(a_cs).reshape(Bsz, nc, G, R, C))
    return (y_diag + y_off).reshape(Bsz, L, H, P)


def centred_depthwise_conv(u, w, b):
    width, ch = w.shape
    y = lax.conv_general_dilated(u, w[:, None, :].astype(u.dtype), window_strides=(1,),
                                 padding=[((width - 1) // 2, width // 2)],
                                 dimension_numbers=('NWC', 'WIO', 'NWC'),
                                 feature_group_count=ch)
    return y + b.astype(u.dtype)


def ssd_branch(xbc, dt_fwd_raw, dt_bwd_raw, z, conv_w, conv_b, dt_bias, a_log, d_skip, norm_gain):
    Bsz, L, _ = xbc.shape
    f32 = jnp.float32
    u = jax.nn.silu(centred_depthwise_conv(xbc, conv_w, conv_b))
    xs, b_in, c_in = jnp.split(u, [SSD_WIDTH, SSD_WIDTH + SSD_GROUPS * SSD_STATE], axis=-1)
    xs = xs.reshape(Bsz, L, SSD_HEADS, SSD_HEAD_DIM)
    b_in = b_in.reshape(Bsz, L, SSD_GROUPS, SSD_STATE)
    c_in = c_in.reshape(Bsz, L, SSD_GROUPS, SSD_STATE)
    dt_f = jax.nn.softplus(dt_fwd_raw.astype(f32) + dt_bias[0].astype(f32))
    dt_b = jax.nn.softplus(dt_bwd_raw.astype(f32) + dt_bias[1].astype(f32))
    a_f = -jnp.exp(a_log[0].astype(f32))
    a_b = -jnp.exp(a_log[1].astype(f32))
    y_f = ssd_scan(xs, dt_f, a_f, b_in, c_in)
    y_b = flip_seq(ssd_scan(flip_seq(xs), flip_seq(dt_b), a_b, flip_seq(b_in), flip_seq(c_in)))
    y = y_f + y_b + d_skip.astype(f32)[:, None] * xs.astype(f32)
    y = y.reshape(Bsz, L, SSD_WIDTH).astype(z.dtype)
    return rms_norm(y * jax.nn.silu(z), norm_gain)


def gla_branch(q_raw, k_raw, v_raw, gk_fwd_low, gk_bwd_low, z, gk_w2, gk_b, norm_gain):
    Bsz, L, _ = q_raw.shape
    key_shape = (Bsz, L, GLA_HEADS, GLA_HEAD_K)
    q = q_raw.reshape(key_shape) * (GLA_HEAD_K ** -0.5)
    k = k_raw.reshape(key_shape)
    v = v_raw.reshape(Bsz, L, GLA_HEADS, GLA_HEAD_V)

    def log_gate(low, w2, b2):
        gk = jnp.einsum('bsr,rk->bsk', low, w2) + b2
        return (jax.nn.log_sigmoid(gk.astype(jnp.float32)) / GLA_GATE_NORMALIZER).reshape(key_shape)

    g_f = log_gate(gk_fwd_low, gk_w2[0], gk_b[0])
    g_b = log_gate(gk_bwd_low, gk_w2[1], gk_b[1])
    o = bidirectional_gated_scan(q, k, g_f, k, g_b, v)
    o = rms_norm(o, norm_gain).reshape(Bsz, L, GLA_WIDTH)
    return o * jax.nn.silu(z)


def setup_inputs(seed: int = 0) -> dict:
    key = jax.random.key(seed)
    ks = jax.random.split(key, 20)
    f32 = jnp.float32

    def nrm(k, shape, scale):
        return jax.random.normal(k, shape, f32) * scale

    x = nrm(ks[0], (BATCH, SEQ, D_MODEL), 1.0)
    w_in = nrm(ks[1], (DEPTH, D_MODEL, N_IN), D_MODEL ** -0.5)
    attn_q_norm = 1.0 + nrm(ks[2], (DEPTH, ATTN_HEAD_DIM), 0.02)
    attn_k_norm = 1.0 + nrm(ks[3], (DEPTH, ATTN_HEAD_DIM), 0.02)
    hgrn_lb_logits = nrm(ks[4], (DEPTH, HGRN_KEY_WIDTH), 0.1)
    hgrn_norm = 1.0 + nrm(ks[5], (DEPTH, HGRN_WIDTH), 0.02)
    ssd_conv_w = nrm(ks[6], (DEPTH, SSD_CONV_WIDTH, SSD_CONV_CH), SSD_CONV_WIDTH ** -0.5)
    ssd_conv_b = nrm(ks[7], (DEPTH, SSD_CONV_CH), 0.02)
    dt0 = jnp.exp(jax.random.uniform(ks[8], (DEPTH, 2, SSD_HEADS), f32,
                                     minval=math.log(1e-3), maxval=math.log(1e-1)))
    ssd_dt_bias = dt0 + jnp.log(-jnp.expm1(-dt0))
    ssd_a_log = jnp.log(jax.random.uniform(ks[9], (DEPTH, 2, SSD_HEADS), f32, minval=1.0, maxval=16.0))
    ssd_d = 1.0 + nrm(ks[10], (DEPTH, SSD_HEADS), 0.02)
    ssd_norm = 1.0 + nrm(ks[11], (DEPTH, SSD_WIDTH), 0.02)
    gla_gk_w2 = nrm(ks[12], (DEPTH, 2, GLA_GATE_RANK, GLA_KEY_WIDTH), GLA_GATE_RANK ** -0.5)
    gla_gk_b = nrm(ks[13], (DEPTH, 2, GLA_KEY_WIDTH), 0.02)
    gla_norm = 1.0 + nrm(ks[14], (DEPTH, GLA_HEAD_V), 0.02)
    w_out = nrm(ks[15], (DEPTH, D_INNER, D_MODEL), (D_INNER ** -0.5) * DEEPNORM_BETA)
    ln_g = 1.0 + nrm(ks[16], (DEPTH, D_MODEL), 0.02)
    ln_b = nrm(ks[17], (DEPTH, D_MODEL), 0.02)
    return {'x': x, 'w_in': w_in, 'attn_q_norm': attn_q_norm, 'attn_k_norm': attn_k_norm,
            'hgrn_lb_logits': hgrn_lb_logits, 'hgrn_norm': hgrn_norm,
            'ssd_conv_w': ssd_conv_w, 'ssd_conv_b': ssd_conv_b, 'ssd_dt_bias': ssd_dt_bias,
            'ssd_a_log': ssd_a_log, 'ssd_d': ssd_d, 'ssd_norm': ssd_norm,
            'gla_gk_w2': gla_gk_w2, 'gla_gk_b': gla_gk_b, 'gla_norm': gla_norm,
            'w_out': w_out, 'ln_g': ln_g, 'ln_b': ln_b}


def reference(x, w_in, attn_q_norm, attn_k_norm, hgrn_lb_logits, hgrn_norm,
              ssd_conv_w, ssd_conv_b, ssd_dt_bias, ssd_a_log, ssd_d, ssd_norm,
              gla_gk_w2, gla_gk_b, gla_norm, w_out, ln_g, ln_b):
    L = x.shape[1]
    rope = axial_rope_tables(L)
    lower_bounds = jnp.cumsum(jax.nn.softmax(hgrn_lb_logits.astype(jnp.float32), axis=0), axis=0)
    lower_bounds = lower_bounds - lower_bounds[0]
    for i in range(DEPTH):
        h = jnp.einsum('bsd,dn->bsn', x, w_in[i])
        (a_q, a_k, a_v, a_z,
         h_q, h_ff, h_fb, h_i, h_z,
         s_xbc, s_dtf, s_dtb, s_z,
         g_q, g_k, g_v, g_lf, g_lb, g_z) = split_columns(h, IN_SPLITS)
        y_a = attention_branch(a_q, a_k, a_v, a_z, attn_q_norm[i], attn_k_norm[i], rope)
        y_h = hgrn2_branch(h_q, h_ff, h_fb, h_i, h_z, lower_bounds[i], hgrn_norm[i])
        y_s = ssd_branch(s_xbc, s_dtf, s_dtb, s_z, ssd_conv_w[i], ssd_conv_b[i],
                         ssd_dt_bias[i], ssd_a_log[i], ssd_d[i], ssd_norm[i])
        y_g = gla_branch(g_q, g_k, g_v, g_lf, g_lb, g_z, gla_gk_w2[i], gla_gk_b[i], gla_norm[i])
        mixed = jnp.concatenate([y_a.astype(x.dtype), y_h.astype(x.dtype),
                                 y_s.astype(x.dtype), y_g.astype(x.dtype)], axis=-1)
        out = jnp.einsum('bsn,nd->bsd', mixed, w_out[i])
        x = layer_norm(DEEPNORM_ALPHA * x + out, ln_g[i], ln_b[i])
    return x
```

```cpp
#include <hip/hip_runtime.h>
#include <hip/hip_cooperative_groups.h>
#include <stdint.h>
#include <stdio.h>
namespace cg = cooperative_groups;

#ifndef ONE_LAUNCH
#define ONE_LAUNCH 0
#endif

#ifndef PH_MASK
#define PH_MASK 0xFFF
#endif
#define DEV __device__ __forceinline__
typedef unsigned short bf16_t;
typedef short bf16x8 __attribute__((ext_vector_type(8)));
typedef float f32x16 __attribute__((ext_vector_type(16)));
typedef unsigned u32x4 __attribute__((ext_vector_type(4)));

constexpr int NT = 512;
constexpr int T_ALL = 16384, TH = 8192, SEQ = 4096, DM = 1024, NPAD = 7168, DI = 2048, NIN = 6960;
constexpr int A_Q = 0, A_K = 512, A_V = 640, A_Z = 768, H_Q = 1280, H_FF = 1792, H_FB = 2304, H_I = 2816, H_Z = 3328,
              S_X = 3840, S_Z = 4864, G_Q = 5376, G_K = 5632, G_V = 5888, G_Z = 6400, SM0 = 6912;
constexpr size_t OFF_CTRL = 0, OFF_TAB = 65536, OFF_XB = 131072;
constexpr size_t OFF_WIN = OFF_XB + (size_t)T_ALL * DM * 2;
constexpr size_t OFF_WOUT = OFF_WIN + (size_t)NPAD * DM * 2;
constexpr size_t OFF_H = OFF_WOUT + (size_t)DM * DI * 2;
constexpr size_t OFF_SMALL = OFF_H + (size_t)TH * NPAD * 2;
constexpr size_t OFF_MIXED = OFF_SMALL + (size_t)TH * 48 * 4;
constexpr size_t OFF_OBUF = OFF_MIXED + (size_t)TH * DI * 2;
constexpr size_t OFF_VT = OFF_OBUF + (size_t)6 * TH * 512 * 2;
constexpr size_t WS_END = OFF_VT + (size_t)2 * 2 * 64 * SEQ * 2;
constexpr size_t CTRL_BYTES = 65536;
constexpr int CTR_WORD0 = 4096;
constexpr int LDS_BYTES = 148480;
constexpr float LOG2E = 1.4426950408889634f;
constexpr float QSCALE = 0.125f * LOG2E;
constexpr float DN_ALPHA = 1.4142135623730951f;
constexpr int NPHASE = 21;

struct Params {
  const float* x; const float* w_in; const float* q_gain; const float* k_gain; const float* lb_logits; const float* hgrn_norm;
  const float* conv_w; const float* conv_b; const float* dt_bias; const float* a_log; const float* ssd_d; const float* ssd_norm;
  const float* gk_w2; const float* gk_b; const float* gla_norm; const float* w_out; const float* ln_g; const float* ln_b;
  float* out; unsigned char* ws;
  int phase_begin, phase_end;
};

DEV int launder(int v) { asm volatile("" : "+v"(v)); return v; }
DEV float bf2f(bf16_t v) { return __uint_as_float(((unsigned)v) << 16); }
DEV bf16_t f2bf(float f) { unsigned u = __float_as_uint(f); u += 0x7fffu + ((u >> 16) & 1u); return (bf16_t)(u >> 16); }
DEV unsigned pk2(float lo, float hi) { return (unsigned)f2bf(lo) | ((unsigned)f2bf(hi) << 16); }
DEV float fsigmoid(float x) { return 1.f / (1.f + __expf(-x)); }
DEV float fsilu(float x) { return x / (1.f + __expf(-x)); }
DEV int rowoff(int reg, int h) { return (reg & 3) + 8 * (reg >> 2) + 4 * h; }
DEV f32x16 zero16() { f32x16 z;
#pragma unroll
  for (int i = 0; i < 16; ++i) z[i] = 0.f; return z; }

template <int KD>
DEV void mma32(f32x16& acc, const bf16_t* a, int lda, const bf16_t* b, int ldb, int lane) {
  const int r = lane & 31, h = lane >> 5;
  const bf16_t* ap = a + r * lda + 8 * h;
  const bf16_t* bp = b + r * ldb + 8 * h;
#pragma unroll
  for (int k = 0; k < KD; k += 16) {
    bf16x8 av = *(const bf16x8*)(ap + k);
    bf16x8 bv = *(const bf16x8*)(bp + k);
    acc = __builtin_amdgcn_mfma_f32_32x32x16_bf16(av, bv, acc, 0, 0, 0);
  }
}

DEV int orig_col(int n) {
  if (n < 4864) return n;
  if (n < 6400) return n + 16;
  if (n < 6912) return n + 48;
  if (n < 6928) return n - 2048;
  if (n < 6960) return n - 512;
  return -1;
}

DEV void convert_weights(const Params& p, int l, unsigned char* smem) {
  float* s = (float*)smem;
  const int tid = launder(threadIdx.x);
  const float* win = p.w_in + (size_t)l * DM * NIN;
  const float* wout = p.w_out + (size_t)l * DI * DM;
  bf16_t* wint = (bf16_t*)(p.ws + OFF_WIN);
  bf16_t* woutt = (bf16_t*)(p.ws + OFF_WOUT);
  const int n_in_tiles = (NPAD / 64) * (DM / 64);
  const int n_out_tiles = (DM / 64) * (DI / 64);
  for (int it = blockIdx.x; it < n_in_tiles + n_out_tiles; it += gridDim.x) {
    __syncthreads();
    if (it < n_in_tiles) {
      const int n0 = (it / 16) * 64, k0 = (it % 16) * 64;
#pragma unroll
      for (int e = 0; e < 8; ++e) {
        const int idx = e * NT + tid, kk = idx >> 6, nn = idx & 63;
        const int oc = orig_col(n0 + nn);
        s[kk * 65 + nn] = (oc >= 0) ? win[(size_t)(k0 + kk) * NIN + oc] : 0.f;
      }
      __syncthreads();
      const int n = tid >> 3, kc = (tid & 7) * 8;
      uint4 o;
      o.x = pk2(s[(kc + 0) * 65 + n], s[(kc + 1) * 65 + n]); o.y = pk2(s[(kc + 2) * 65 + n], s[(kc + 3) * 65 + n]);
      o.z = pk2(s[(kc + 4) * 65 + n], s[(kc + 5) * 65 + n]); o.w = pk2(s[(kc + 6) * 65 + n], s[(kc + 7) * 65 + n]);
      *(uint4*)(wint + (size_t)(n0 + n) * DM + k0 + kc) = o;
    } else {
      const int j = it - n_in_tiles;
      const int n0 = (j / 32) * 64, k0 = (j % 32) * 64;
#pragma unroll
      for (int e = 0; e < 8; ++e) {
        const int idx = e * NT + tid, kk = idx >> 6, nn = idx & 63;
        s[kk * 65 + nn] = wout[(size_t)(k0 + kk) * DM + n0 + nn];
      }
      __syncthreads();
      const int n = tid >> 3, kc = (tid & 7) * 8;
      uint4 o;
      o.x = pk2(s[(kc + 0) * 65 + n], s[(kc + 1) * 65 + n]); o.y = pk2(s[(kc + 2) * 65 + n], s[(kc + 3) * 65 + n]);
      o.z = pk2(s[(kc + 4) * 65 + n], s[(kc + 5) * 65 + n]); o.w = pk2(s[(kc + 6) * 65 + n], s[(kc + 7) * 65 + n]);
      *(uint4*)(woutt + (size_t)(n0 + n) * DI + k0 + kc) = o;
    }
  }
  __syncthreads();
}

DEV void dsincos(double x, double& s, double& c) {
  const double k = rint(x * 0.63661977236758134308);
  double r = fma(-k, 1.57079632679489655800e+00, x);
  r = fma(-k, 6.12323399573676603587e-17, r);
  const double r2 = r * r;
  const double t3 = r2 * r, t5 = t3 * r2, t7 = t5 * r2, t9 = t7 * r2, t11 = t9 * r2, t13 = t11 * r2, t15 = t13 * r2;
  const double sinr = r - t3 / 6.0 + t5 / 120.0 - t7 / 5040.0 + t9 / 362880.0 - t11 / 39916800.0 + t13 / 6227020800.0 - t15 / 1307674368000.0;
  const double u2 = r2, u4 = u2 * u2, u6 = u4 * u2, u8 = u6 * u2, u10 = u8 * u2, u12 = u10 * u2, u14 = u12 * u2, u16 = u14 * u2;
  const double cosr = 1.0 - u2 / 2.0 + u4 / 24.0 - u6 / 720.0 + u8 / 40320.0 - u10 / 3628800.0 + u12 / 479001600.0 - u14 / 87178291200.0 + u16 / 20922789888000.0;
  const int q = ((int)k) & 3;
  if (q == 0) { s = sinr; c = cosr; }
  else if (q == 1) { s = cosr; c = -sinr; }
  else if (q == 2) { s = -sinr; c = -cosr; }
  else { s = -cosr; c = sinr; }
}

DEV void phase_pro(const Params& p, unsigned char* smem) {
  const int tid = launder(threadIdx.x);
  const size_t gtid = (size_t)blockIdx.x * NT + tid, gsz = (size_t)gridDim.x * NT;
  const float4* x4 = (const float4*)p.x;
  uint4* xb4 = (uint4*)(p.ws + OFF_XB);
  for (size_t i = gtid; i < (size_t)T_ALL * DM / 8; i += gsz) {
    const float4 a = x4[2 * i], b = x4[2 * i + 1];
    uint4 o; o.x = pk2(a.x, a.y); o.y = pk2(a.z, a.w); o.z = pk2(b.x, b.y); o.w = pk2(b.z, b.w);
    xb4[i] = o;
  }
  if (blockIdx.x == 0) {
    float2* tab = (float2*)(p.ws + OFF_TAB);
    for (int i = tid; i < 64 * 16; i += NT) {
      const int pos = i >> 4, fi = i & 15;
      const float invf = (float)exp(-(double)fi * (9.210340371976184 / 16.0));
      const float ang = (float)pos * invf;
      double s, c; dsincos((double)ang, s, c);
      tab[i] = make_float2((float)c, (float)s);
    }
  }
  convert_weights(p, 0, smem);
}

DEV void gemm_block(const bf16_t* __restrict__ A, int lda, const bf16_t* __restrict__ Bt, int ldb, int nk, unsigned char* smem, f32x16 (&acc)[2][2]) {
  const int tid = launder(threadIdx.x), lane = tid & 63, w = tid >> 6, wr = w >> 2, wc = w & 3, r = lane & 31, h = lane >> 5;
  const int ar = tid >> 2, ac = (tid & 3) * 16;
  const int br = tid >> 1, bc = (tid & 1) * 32;
  const bf16_t* ag = A + (size_t)ar * lda + ac;
  const bf16_t* bg = Bt + (size_t)br * ldb + bc;
  uint4 ra0, ra1, rb0, rb1, rb2, rb3;
#pragma unroll
  for (int i = 0; i < 2; ++i)
#pragma unroll
    for (int j = 0; j < 2; ++j) acc[i][j] = zero16();
  {
    const uint4* pa = (const uint4*)ag; ra0 = pa[0]; ra1 = pa[1];
    const uint4* pb = (const uint4*)bg; rb0 = pb[0]; rb1 = pb[1]; rb2 = pb[2]; rb3 = pb[3];
    uint4* sa = (uint4*)(smem + ar * 144 + ac * 2); sa[0] = ra0; sa[1] = ra1;
    uint4* sb = (uint4*)(smem + 18432 + br * 144 + bc * 2); sb[0] = rb0; sb[1] = rb1; sb[2] = rb2; sb[3] = rb3;
  }
  __syncthreads();
  for (int kt = 0; kt < nk; ++kt) {
    if (kt + 1 < nk) {
      const uint4* pa = (const uint4*)(ag + (kt + 1) * 64); ra0 = pa[0]; ra1 = pa[1];
      const uint4* pb = (const uint4*)(bg + (kt + 1) * 64); rb0 = pb[0]; rb1 = pb[1]; rb2 = pb[2]; rb3 = pb[3];
    }
    const bf16_t* sa = (const bf16_t*)(smem + (kt & 1) * 55296);
    const bf16_t* sb = (const bf16_t*)(smem + (kt & 1) * 55296 + 18432);
#pragma unroll
    for (int ks = 0; ks < 4; ++ks) {
      const bf16x8 a0 = *(const bf16x8*)(sa + (wr * 64 + r) * 72 + ks * 16 + 8 * h);
      const bf16x8 a1 = *(const bf16x8*)(sa + (wr * 64 + 32 + r) * 72 + ks * 16 + 8 * h);
      const bf16x8 b0 = *(const bf16x8*)(sb + (wc * 64 + r) * 72 + ks * 16 + 8 * h);
      const bf16x8 b1 = *(const bf16x8*)(sb + (wc * 64 + 32 + r) * 72 + ks * 16 + 8 * h);
      acc[0][0] = __builtin_amdgcn_mfma_f32_32x32x16_bf16(a0, b0, acc[0][0], 0, 0, 0);
      acc[0][1] = __builtin_amdgcn_mfma_f32_32x32x16_bf16(a0, b1, acc[0][1], 0, 0, 0);
      acc[1][0] = __builtin_amdgcn_mfma_f32_32x32x16_bf16(a1, b0, acc[1][0], 0, 0, 0);
      acc[1][1] = __builtin_amdgcn_mfma_f32_32x32x16_bf16(a1, b1, acc[1][1], 0, 0, 0);
    }
    if (kt + 1 < nk) {
      unsigned char* base = smem + ((kt + 1) & 1) * 55296;
      uint4* sa2 = (uint4*)(base + ar * 144 + ac * 2); sa2[0] = ra0; sa2[1] = ra1;
      uint4* sb2 = (uint4*)(base + 18432 + br * 144 + bc * 2); sb2[0] = rb0; sb2[1] = rb1; sb2[2] = rb2; sb2[3] = rb3;
    }
    __syncthreads();
  }
}

DEV void phase_inproj(const Params& p, int l, int hf, unsigned char* smem) {
  const int tid = launder(threadIdx.x), lane = tid & 63, w = tid >> 6, wr = w >> 2, wc = w & 3, c = lane & 31, h = lane >> 5;
  const bf16_t* A = (const bf16_t*)(p.ws + OFF_XB) + (size_t)hf * TH * DM;
  const bf16_t* Bt = (const bf16_t*)(p.ws + OFF_WIN);
  bf16_t* Hh = (bf16_t*)(p.ws + OFF_H);
  float* SMALL = (float*)(p.ws + OFF_SMALL);
  bf16_t* VT = (bf16_t*)(p.ws + OFF_VT);
  const float2* tab = (const float2*)(p.ws + OFF_TAB);
  const int n_items = (TH / 128) * (NPAD / 256);
  for (int it = blockIdx.x; it < n_items; it += gridDim.x) {
    const int pn = it % 28, pm = it / 28;
    f32x16 acc[2][2];
    gemm_block(A + (size_t)pm * 128 * DM, DM, Bt + (size_t)pn * 256 * DM, DM, DM / 64, smem, acc);
    const int colbase = pn * 256 + wc * 64;
    const int rowb = pm * 128 + wr * 64;
    if (colbase == SM0) {
#pragma unroll
      for (int mi = 0; mi < 2; ++mi)
#pragma unroll
        for (int reg = 0; reg < 16; ++reg) {
          const int row = rowb + mi * 32 + rowoff(reg, h);
          SMALL[(size_t)row * 48 + c] = acc[mi][0][reg];
          if (c < 16) SMALL[(size_t)row * 48 + 32 + c] = acc[mi][1][reg];
        }
    } else if (colbase < SM0) {
      if (colbase < A_V) {
        const bool isq = colbase < A_K;
        const float* gain = (isq ? p.q_gain : p.k_gain) + l * 64;
        const float g0 = gain[c], g1 = gain[32 + c];
        const float osc = isq ? QSCALE : 1.f;
#pragma unroll
        for (int mi = 0; mi < 2; ++mi)
#pragma unroll
          for (int reg = 0; reg < 16; ++reg) {
            float ss = acc[mi][0][reg] * acc[mi][0][reg] + acc[mi][1][reg] * acc[mi][1][reg];
            ss += __shfl_xor(ss, 1); ss += __shfl_xor(ss, 2); ss += __shfl_xor(ss, 4); ss += __shfl_xor(ss, 8); ss += __shfl_xor(ss, 16);
            const float rstd = rsqrtf(ss * (1.f / 64.f) + 1e-6f);
            const int row = rowb + mi * 32 + rowoff(reg, h);
            const int t = row & (SEQ - 1);
            const float2 cs0 = tab[(t >> 6) * 16 + (c & 15)], cs1 = tab[(t & 63) * 16 + (c & 15)];
            const float v0 = acc[mi][0][reg] * rstd * g0, v1 = acc[mi][1][reg] * rstd * g1;
            const float p0 = __shfl_xor(v0, 16), p1 = __shfl_xor(v1, 16);
            const float o0 = (c & 16) ? (v0 * cs0.x + p0 * cs0.y) : (v0 * cs0.x - p0 * cs0.y);
            const float o1 = (c & 16) ? (v1 * cs1.x + p1 * cs1.y) : (v1 * cs1.x - p1 * cs1.y);
            acc[mi][0][reg] = o0 * osc; acc[mi][1][reg] = o1 * osc;
          }
      }
      if (colbase >= A_V && colbase < A_Z) {
        const int kvh = (colbase - A_V) >> 6;
#pragma unroll
        for (int mi = 0; mi < 2; ++mi)
#pragma unroll
          for (int ni = 0; ni < 2; ++ni)
#pragma unroll
            for (int g = 0; g < 4; ++g) {
              const int row = rowb + mi * 32 + 8 * g + 4 * h;
              const int bl = row >> 12, t = row & (SEQ - 1);
              const int d = ni * 32 + c;
              uint2 o; o.x = pk2(acc[mi][ni][4 * g + 0], acc[mi][ni][4 * g + 1]); o.y = pk2(acc[mi][ni][4 * g + 2], acc[mi][ni][4 * g + 3]);
              *(uint2*)(VT + ((size_t)((bl * 2 + kvh) * 64 + d)) * SEQ + t) = o;
            }
      } else {
        bf16_t* so = (bf16_t*)(smem + w * 9216);
#pragma unroll
        for (int mi = 0; mi < 2; ++mi)
#pragma unroll
          for (int ni = 0; ni < 2; ++ni)
#pragma unroll
            for (int reg = 0; reg < 16; ++reg)
              so[(mi * 32 + rowoff(reg, h)) * 72 + ni * 32 + c] = f2bf(acc[mi][ni][reg]);
        __builtin_amdgcn_s_waitcnt(0xc07f);
        __builtin_amdgcn_wave_barrier();
#pragma unroll
        for (int i = 0; i < 8; ++i) {
          const int rr = i * 8 + (lane >> 3), ch = lane & 7;
          const uint4 v = *(const uint4*)(so + rr * 72 + ch * 8);
          *(uint4*)(Hh + (size_t)(rowb + rr) * NPAD + colbase + ch * 8) = v;
        }
      }
    }
    __syncthreads();
  }
}

DEV void phase_outproj(const Params& p, int l, int hf, unsigned char* smem) {
  const int tid = launder(threadIdx.x), lane = tid & 63, w = tid >> 6, wr = w >> 2, wc = w & 3, c = lane & 31, h = lane >> 5;
  const bf16_t* A = (const bf16_t*)(p.ws + OFF_MIXED);
  const bf16_t* Bt = (const bf16_t*)(p.ws + OFF_WOUT);
  const float* xin = (l == 0) ? p.x : p.out;
  const int n_items = (TH / 128) * (DM / 256);
  for (int it = blockIdx.x; it < n_items; it += gridDim.x) {
    const int pn = it & 3, pm = it >> 2;
    f32x16 acc[2][2];
    gemm_block(A + (size_t)pm * 128 * DI, DI, Bt + (size_t)pn * 256 * DI, DI, DI / 64, smem, acc);
#pragma unroll
    for (int mi = 0; mi < 2; ++mi)
#pragma unroll
      for (int ni = 0; ni < 2; ++ni)
#pragma unroll
        for (int reg = 0; reg < 16; ++reg) {
          const int row = hf * TH + pm * 128 + wr * 64 + mi * 32 + rowoff(reg, h);
          const int col = pn * 256 + wc * 64 + ni * 32 + c;
          const size_t idx = (size_t)row * DM + col;
          p.out[idx] = DN_ALPHA * xin[idx] + acc[mi][ni][reg];
        }
    __syncthreads();
  }
}

DEV void phase_ln(const Params& p, int l, int hf) {
  const int tid = launder(threadIdx.x), lane = tid & 63, w = tid >> 6;
  const float* g = p.ln_g + l * DM; const float* b = p.ln_b + l * DM;
  bf16_t* xb = (bf16_t*)(p.ws + OFF_XB);
  for (int r = blockIdx.x * 8 + w; r < TH; r += gridDim.x * 8) {
    const int row = hf * TH + r;
    float4* rp = (float4*)(p.out + (size_t)row * DM);
    float4 v[4];
    float s = 0.f;
#pragma unroll
    for (int j = 0; j < 4; ++j) { v[j] = rp[j * 64 + lane]; s += (v[j].x + v[j].y) + (v[j].z + v[j].w); }
#pragma unroll
    for (int o = 32; o >= 1; o >>= 1) s += __shfl_xor(s, o);
    const float mu = s * (1.f / DM);
    float q = 0.f;
#pragma unroll
    for (int j = 0; j < 4; ++j) { const float a = v[j].x - mu, bb = v[j].y - mu, cc = v[j].z - mu, d = v[j].w - mu; q += (a * a + bb * bb) + (cc * cc + d * d); }
#pragma unroll
    for (int o = 32; o >= 1; o >>= 1) q += __shfl_xor(q, o);
    const float rstd = rsqrtf(q * (1.f / DM) + 1e-5f);
#pragma unroll
    for (int j = 0; j < 4; ++j) {
      const int col = (j * 64 + lane) * 4;
      const float4 gg = *(const float4*)(g + col), bb = *(const float4*)(b + col);
      float4 o;
      o.x = (v[j].x - mu) * rstd * gg.x + bb.x; o.y = (v[j].y - mu) * rstd * gg.y + bb.y;
      o.z = (v[j].z - mu) * rstd * gg.z + bb.z; o.w = (v[j].w - mu) * rstd * gg.w + bb.w;
      rp[j * 64 + lane] = o;
      if (l == 0) { uint2 pk; pk.x = pk2(o.x, o.y); pk.y = pk2(o.z, o.w); *(uint2*)(xb + (size_t)row * DM + col) = pk; }
    }
  }
}

DEV void attn_item(const Params& p, int l, int item, unsigned char* smem) {
  const int tid = launder(threadIdx.x), lane = tid & 63, w = tid >> 6, r = lane & 31, h = lane >> 5;
  const int qt = item & 15, head = (item >> 4) & 7, bl = item >> 7;
  const int kvh = head >> 2;
  const bf16_t* Hh = (const bf16_t*)(p.ws + OFF_H);
  const bf16_t* VT = (const bf16_t*)(p.ws + OFF_VT);
  bf16_t* MX = (bf16_t*)(p.ws + OFF_MIXED);
  const size_t rowbase = (size_t)bl * SEQ;
  float mq = fabsf(p.q_gain[l * 64 + lane]), mk = fabsf(p.k_gain[l * 64 + lane]);
#pragma unroll
  for (int o = 32; o >= 1; o >>= 1) { mq = fmaxf(mq, __shfl_xor(mq, o)); mk = fmaxf(mk, __shfl_xor(mk, o)); }
  const float M2 = 8.f * mq * mk * LOG2E * 1.01f;
  const int qrow = qt * 256 + w * 32 + r;
  const bf16_t* qp = Hh + (rowbase + qrow) * NPAD + A_Q + head * 64 + 8 * h;
  bf16x8 qf[4];
#pragma unroll
  for (int ks = 0; ks < 4; ++ks) qf[ks] = *(const bf16x8*)(qp + ks * 16);
  f32x16 o0 = zero16(), o1 = zero16();
  float lsum = 0.f;
  const int srow = tid >> 3, sch = (tid & 7) * 8;
  const bf16_t* kp = Hh + (rowbase + srow) * NPAD + A_K + kvh * 64 + sch;
  const bf16_t* vp = VT + ((size_t)((bl * 2 + kvh) * 64 + srow)) * SEQ + sch;
  uint4 rk = *(const uint4*)kp, rv = *(const uint4*)vp;
  *(uint4*)(smem + srow * 144 + sch * 2) = rk;
  *(uint4*)(smem + 9216 + srow * 144 + sch * 2) = rv;
  __syncthreads();
  for (int kt = 0; kt < SEQ / 64; ++kt) {
    if (kt + 1 < SEQ / 64) { rk = *(const uint4*)(kp + (size_t)(kt + 1) * 64 * NPAD); rv = *(const uint4*)(vp + (kt + 1) * 64); }
    const bf16_t* sK = (const bf16_t*)(smem + (kt & 1) * 18432);
    const bf16_t* sV = (const bf16_t*)(smem + (kt & 1) * 18432 + 9216);
    f32x16 s0 = zero16(), s1 = zero16();
#pragma unroll
    for (int ks = 0; ks < 4; ++ks) {
      const bf16x8 a0 = *(const bf16x8*)(sK + r * 72 + ks * 16 + 8 * h);
      const bf16x8 a1 = *(const bf16x8*)(sK + (32 + r) * 72 + ks * 16 + 8 * h);
      s0 = __builtin_amdgcn_mfma_f32_32x32x16_bf16(a0, qf[ks], s0, 0, 0, 0);
      s1 = __builtin_amdgcn_mfma_f32_32x32x16_bf16(a1, qf[ks], s1, 0, 0, 0);
    }
#pragma unroll
    for (int i = 0; i < 16; ++i) { s0[i] = __builtin_amdgcn_exp2f(s0[i] - M2); s1[i] = __builtin_amdgcn_exp2f(s1[i] - M2); lsum += s0[i] + s1[i]; }
    union { bf16x8 v; unsigned u[4]; } pb[2][2];
#pragma unroll
    for (int s = 0; s < 2; ++s)
#pragma unroll
      for (int j = 0; j < 4; ++j) {
        pb[0][s].u[j] = pk2(s0[8 * s + 2 * j], s0[8 * s + 2 * j + 1]);
        pb[1][s].u[j] = pk2(s1[8 * s + 2 * j], s1[8 * s + 2 * j + 1]);
      }
#pragma unroll
    for (int kt2 = 0; kt2 < 2; ++kt2)
#pragma unroll
      for (int s = 0; s < 2; ++s) {
        const int kb = kt2 * 32 + 16 * s + 4 * h;
        union { bf16x8 v; uint2 u[2]; } a0, a1;
        a0.u[0] = *(const uint2*)(sV + r * 72 + kb); a0.u[1] = *(const uint2*)(sV + r * 72 + kb + 8);
        a1.u[0] = *(const uint2*)(sV + (32 + r) * 72 + kb); a1.u[1] = *(const uint2*)(sV + (32 + r) * 72 + kb + 8);
        o0 = __builtin_amdgcn_mfma_f32_32x32x16_bf16(a0.v, pb[kt2][s].v, o0, 0, 0, 0);
        o1 = __builtin_amdgcn_mfma_f32_32x32x16_bf16(a1.v, pb[kt2][s].v, o1, 0, 0, 0);
      }
    if (kt + 1 < SEQ / 64) {
      unsigned char* base = smem + ((kt + 1) & 1) * 18432;
      *(uint4*)(base + srow * 144 + sch * 2) = rk;
      *(uint4*)(base + 9216 + srow * 144 + sch * 2) = rv;
    }
    __syncthreads();
  }
  lsum += __shfl_xor(lsum, 32);
  const float inv = 1.f / lsum;
  const bf16_t* zp = Hh + (rowbase + qrow) * NPAD + A_Z + head * 64;
  bf16_t* op = MX + (rowbase + qrow) * DI + head * 64;
#pragma unroll
  for (int dt = 0; dt < 2; ++dt)
#pragma unroll
    for (int g = 0; g < 4; ++g) {
      const int d0 = dt * 32 + 8 * g + 4 * h;
      const uint2 zz = *(const uint2*)(zp + d0);
      const float z0 = bf2f((bf16_t)(zz.x & 0xffff)), z1 = bf2f((bf16_t)(zz.x >> 16)), z2 = bf2f((bf16_t)(zz.y & 0xffff)), z3 = bf2f((bf16_t)(zz.y >> 16));
      const f32x16& oo = dt ? o1 : o0;
      uint2 ov;
      ov.x = pk2(oo[4 * g + 0] * inv * fsilu(z0), oo[4 * g + 1] * inv * fsilu(z1));
      ov.y = pk2(oo[4 * g + 2] * inv * fsilu(z2), oo[4 * g + 3] * inv * fsilu(z3));
      *(uint2*)(op + d0) = ov;
    }
  __syncthreads();
}

constexpr int L_QT = 0, L_KT = 17408, L_QC = 34816, L_KHT = 52224, L_VT = 70656, L_P = 89088, L_ST = 98304, L_RAW = 89088,
              L_D = 138240, L_TOT = 138752, L_ACS = 142848, L_DT = 143104, L_LOW = 143360;

template <int K, int V> struct ScanGeom {
  static constexpr int KP = K + 8;
  static constexpr int NS = (K / 32) * (V / 32) / 8;
};

template <int K, int V>
DEV void scan_write_state(unsigned char* smem, const f32x16* S, int w, int lane) {
  constexpr int KP = K + 8, NS = ScanGeom<K, V>::NS, NVT = V / 32;
  bf16_t* sST = (bf16_t*)(smem + L_ST);
  const int c = lane & 31, h = lane >> 5;
#pragma unroll
  for (int i = 0; i < NS; ++i) {
    const int tile = w * NS + i, kt = tile / NVT, nt = tile % NVT;
#pragma unroll
    for (int g = 0; g < 4; ++g) {
      uint2 o; o.x = pk2(S[i][4 * g + 0], S[i][4 * g + 1]); o.y = pk2(S[i][4 * g + 2], S[i][4 * g + 3]);
      *(uint2*)(sST + (nt * 32 + c) * KP + kt * 32 + 8 * g + 4 * h) = o;
    }
  }
}

template <int K, int V, bool SSDM>
DEV void scan_core(unsigned char* smem, f32x16* S, bf16_t* orow0, int dir, int w, int lane) {
  constexpr int KP = K + 8, NS = ScanGeom<K, V>::NS, NVT = V / 32, NOT = 2 * NVT;
  const bf16_t* sQt = (const bf16_t*)(smem + L_QT); const bf16_t* sKt = (const bf16_t*)(smem + L_KT);
  const bf16_t* sQc = (const bf16_t*)(smem + L_QC); const bf16_t* sKhT = (const bf16_t*)(smem + L_KHT);
  const bf16_t* sVT = (const bf16_t*)(smem + L_VT); bf16_t* sP = (bf16_t*)(smem + L_P);
  const bf16_t* sST = (const bf16_t*)(smem + L_ST); const float* sD = (const float*)(smem + L_D);
  const float* sAcs = (const float*)(smem + L_ACS);
  const int c = lane & 31, h = lane >> 5;
  scan_write_state<K, V>(smem, S, w, lane);
  if (w < 4) {
    const int tt = w >> 1, st = w & 1;
    f32x16 acc = zero16();
    if (st <= tt) mma32<K>(acc, sQt + tt * 32 * KP, KP, sKt + st * 32 * KP, KP, lane);
#pragma unroll
    for (int reg = 0; reg < 16; ++reg) {
      const int tau = tt * 32 + rowoff(reg, h), sig = st * 32 + c;
      float v = 0.f;
      if (sig <= tau) { v = acc[reg]; if (SSDM) v *= __expf(sAcs[tau] - sAcs[sig]); }
      sP[tau * 72 + sig] = f2bf(v);
    }
  }
  __syncthreads();
  if (w < NOT) {
    const int tt = w / NVT, nt = w % NVT;
    f32x16 acc = zero16();
    mma32<64>(acc, sP + tt * 32 * 72, 72, sVT + nt * 32 * 72, 72, lane);
    mma32<K>(acc, sQc + tt * 32 * KP, KP, sST + nt * 32 * KP, KP, lane);
#pragma unroll
    for (int reg = 0; reg < 16; ++reg) {
      const int tau = tt * 32 + rowoff(reg, h);
      const int tok = dir ? (63 - tau) : tau;
      orow0[(size_t)tok * 512 + nt * 32 + c] = f2bf(acc[reg]);
    }
  }
#pragma unroll
  for (int i = 0; i < NS; ++i) {
    const int tile = w * NS + i, kt = tile / NVT, nt = tile % NVT;
#pragma unroll
    for (int reg = 0; reg < 16; ++reg) S[i][reg] *= sD[kt * 32 + rowoff(reg, h)];
    mma32<64>(S[i], sKhT + kt * 32 * 72, 72, sVT + nt * 32 * 72, 72, lane);
  }
  __syncthreads();
}

DEV void store16(bf16_t* dst, const float* v) {
  uint4 a, b;
  a.x = pk2(v[0], v[1]); a.y = pk2(v[2], v[3]); a.z = pk2(v[4], v[5]); a.w = pk2(v[6], v[7]);
  b.x = pk2(v[8], v[9]); b.y = pk2(v[10], v[11]); b.z = pk2(v[12], v[13]); b.w = pk2(v[14], v[15]);
  ((uint4*)dst)[0] = a; ((uint4*)dst)[1] = b;
}
DEV void gather16(bf16_t* dst, const bf16_t* src, int stride) {
  unsigned u[8];
#pragma unroll
  for (int i = 0; i < 8; ++i) u[i] = (unsigned)src[(2 * i) * stride] | ((unsigned)src[(2 * i + 1) * stride] << 16);
  ((uint4*)dst)[0] = make_uint4(u[0], u[1], u[2], u[3]); ((uint4*)dst)[1] = make_uint4(u[4], u[5], u[6], u[7]);
}

DEV void hgrn_item(const Params& p, int l, int bl, int head, int dir, unsigned char* smem) {
  constexpr int K = 128, V = 128, KP = 136;
  const int tid = launder(threadIdx.x), lane = tid & 63, w = tid >> 6;
  const int ch = tid & 127, qd = tid >> 7;
  const bf16_t* Hh = (const bf16_t*)(p.ws + OFF_H);
  bf16_t* OB = (bf16_t*)(p.ws + OFF_OBUF) + (size_t)(0 * 2 + dir) * TH * 512;
  const size_t rowbase = (size_t)bl * SEQ;
  float lbv = 0.f;
  if (l > 0) lbv = fsigmoid(p.lb_logits[512 + head * 128 + ch] - p.lb_logits[head * 128 + ch]);
  const int fbase = dir ? H_FB : H_FF;
  bf16_t* sQt = (bf16_t*)(smem + L_QT); bf16_t* sKt = (bf16_t*)(smem + L_KT); bf16_t* sQc = (bf16_t*)(smem + L_QC);
  bf16_t* sKhT = (bf16_t*)(smem + L_KHT); bf16_t* sVT = (bf16_t*)(smem + L_VT);
  float* sD = (float*)(smem + L_D); float* sTot = (float*)(smem + L_TOT);
  const bf16_t* rawQ = (const bf16_t*)(smem + L_RAW); const bf16_t* rawF = rawQ + 8192; const bf16_t* rawV = rawQ + 16384;
  f32x16 S[2]; S[0] = zero16(); S[1] = zero16();
  u32x4 pre[6];
  const int prow0 = tid >> 4, pc16 = (tid & 15) * 8;
  auto gload = [&](int cidx) __attribute__((always_inline)) {
    const int chunk = dir ? (63 - cidx) : cidx;
#pragma unroll
    for (int j = 0; j < 2; ++j) {
      const int row = prow0 + 32 * j;
      const int tok = chunk * 64 + (dir ? (63 - row) : row);
      const bf16_t* rp = Hh + (rowbase + tok) * NPAD + head * 128 + pc16;
      pre[j] = *(const u32x4*)(rp + H_Q); pre[2 + j] = *(const u32x4*)(rp + fbase); pre[4 + j] = *(const u32x4*)(rp + H_I);
    }
  };
  gload(0);
  for (int cidx = 0; cidx < 64; ++cidx) {
    const int chunk = dir ? (63 - cidx) : cidx;
#pragma unroll
    for (int j = 0; j < 2; ++j) {
      unsigned char* d = smem + L_RAW + (prow0 + 32 * j) * 256 + pc16 * 2;
      *(u32x4*)d = pre[j]; *(u32x4*)(d + 16384) = pre[2 + j]; *(u32x4*)(d + 32768) = pre[4 + j];
    }
    __syncthreads();
    if (cidx + 1 < 64) gload(cidx + 1);
    float run = 0.f;
#pragma unroll 1
    for (int i0 = 0; i0 < 16; i0 += 4) {
#pragma unroll
      for (int ii = 0; ii < 4; ++ii) {
        const float f = bf2f(rawF[(16 * qd + i0 + ii) * 128 + ch]);
        const float sg = 1.f / (1.f + __expf(-f));
        run += __logf(lbv + (1.f - lbv) * sg);
      }
    }
    sTot[qd * 128 + ch] = run;
    __syncthreads();
    const float t0 = sTot[ch], t1 = sTot[128 + ch], t2 = sTot[256 + ch], t3 = sTot[384 + ch];
    const float off = (qd > 0 ? t0 : 0.f) + (qd > 1 ? t1 : 0.f) + (qd > 2 ? t2 : 0.f);
    const float ref = t0 + t1, bend = (t0 + t1) + (t2 + t3);
    float b = off;
#pragma unroll 1
    for (int i0 = 0; i0 < 16; i0 += 4) {
      float kh4[4]; unsigned vb[4];
#pragma unroll
      for (int ii = 0; ii < 4; ++ii) {
        const int tau = 16 * qd + i0 + ii;
        const float f = bf2f(rawF[tau * 128 + ch]);
        const float sg = 1.f / (1.f + __expf(-f));
        b += __logf(lbv + (1.f - lbv) * sg);
        const float kx = (1.f - lbv) / (1.f + __expf(f));
        const float qr = bf2f(rawQ[tau * 128 + ch]);
        const float qx = qr * (1.f / (1.f + __expf(-qr))) * 0.08838834764831845f;
        sQt[tau * KP + ch] = f2bf(qx * __expf(b - ref));
        sKt[tau * KP + ch] = f2bf(kx * __expf(ref - b));
        sQc[tau * KP + ch] = f2bf(qx * __expf(b));
        kh4[ii] = kx * __expf(bend - b);
        vb[ii] = rawV[tau * 128 + ch];
      }
      uint2 o; o.x = pk2(kh4[0], kh4[1]); o.y = pk2(kh4[2], kh4[3]);
      *(uint2*)(sKhT + ch * 72 + 16 * qd + i0) = o;
      uint2 ov; ov.x = vb[0] | (vb[1] << 16); ov.y = vb[2] | (vb[3] << 16);
      *(uint2*)(sVT + ch * 72 + 16 * qd + i0) = ov;
    }
    if (qd == 0) sD[ch] = __expf(bend);
    __syncthreads();
    scan_core<K, V, false>(smem, S, OB + (rowbase + (size_t)chunk * 64) * 512 + head * 128, dir, w, lane);
  }
}

DEV void gla_item(const Params& p, int l, int bl, int head, int dir, unsigned char* smem) {
  constexpr int K = 64, V = 128, KP = 72;
  const int tid = launder(threadIdx.x), lane = tid & 63, w = tid >> 6;
  const int ch = tid & 63, oc = tid >> 6;
  const int vn = tid & 127, vq = tid >> 7;
  const bf16_t* Hh = (const bf16_t*)(p.ws + OFF_H);
  const float* SMALL = (const float*)(p.ws + OFF_SMALL);
  bf16_t* OB = (bf16_t*)(p.ws + OFF_OBUF) + (size_t)(2 * 2 + dir) * TH * 512;
  const size_t rowbase = (size_t)bl * SEQ;
  bf16_t* sQt = (bf16_t*)(smem + L_QT); bf16_t* sKt = (bf16_t*)(smem + L_KT); bf16_t* sQc = (bf16_t*)(smem + L_QC);
  bf16_t* sKhT = (bf16_t*)(smem + L_KHT); bf16_t* sVT = (bf16_t*)(smem + L_VT);
  float* sD = (float*)(smem + L_D); float* sTot = (float*)(smem + L_TOT); float* sLow = (float*)(smem + L_LOW);
  const bf16_t* rawQ = (const bf16_t*)(smem + L_RAW); const bf16_t* rawK = rawQ + 4096; const bf16_t* rawV = rawQ + 8192;
  float w2c[16];
#pragma unroll
  for (int r = 0; r < 16; ++r) w2c[r] = p.gk_w2[((size_t)(l * 2 + dir) * 16 + r) * 256 + head * 64 + ch];
  const float gb = p.gk_b[(l * 2 + dir) * 256 + head * 64 + ch];
  f32x16 S[1]; S[0] = zero16();
  u32x4 pre[4];
  float plow0, plow1;
  const int qrow = tid >> 3, qc8 = (tid & 7) * 8, vrow0 = tid >> 4, vc16 = (tid & 15) * 8;
  auto gload = [&](int cidx) __attribute__((always_inline)) {
    const int chunk = dir ? (63 - cidx) : cidx;
    {
      const int tok = chunk * 64 + (dir ? (63 - qrow) : qrow);
      const bf16_t* rp = Hh + (rowbase + tok) * NPAD + head * 64 + qc8;
      pre[0] = *(const u32x4*)(rp + G_Q); pre[1] = *(const u32x4*)(rp + G_K);
      { const float* lp = SMALL + (rowbase + tok) * 48 + 16 + dir * 16 + (tid & 7) * 2; plow0 = lp[0]; plow1 = lp[1]; }
    }
#pragma unroll
    for (int j = 0; j < 2; ++j) {
      const int row = vrow0 + 32 * j;
      const int tok = chunk * 64 + (dir ? (63 - row) : row);
      pre[2 + j] = *(const u32x4*)(Hh + (rowbase + tok) * NPAD + G_V + head * 128 + vc16);
    }
  };
  gload(0);
  for (int cidx = 0; cidx < 64; ++cidx) {
    const int chunk = dir ? (63 - cidx) : cidx;
    {
      unsigned char* d = smem + L_RAW + qrow * 128 + qc8 * 2;
      *(u32x4*)d = pre[0]; *(u32x4*)(d + 8192) = pre[1];
      sLow[qrow * 16 + (tid & 7) * 2] = plow0; sLow[qrow * 16 + (tid & 7) * 2 + 1] = plow1;
#pragma unroll
      for (int j = 0; j < 2; ++j) *(u32x4*)(smem + L_RAW + 16384 + (vrow0 + 32 * j) * 256 + vc16 * 2) = pre[2 + j];
    }
    __syncthreads();
    if (cidx + 1 < 64) gload(cidx + 1);
    float run = 0.f;
#pragma unroll 1
    for (int i = 0; i < 8; ++i) {
      const int tau = 8 * oc + i;
      float gk = gb;
#pragma unroll
      for (int r = 0; r < 16; ++r) gk += sLow[tau * 16 + r] * w2c[r];
      run += (fminf(gk, 0.f) - __logf(1.f + __expf(-fabsf(gk)))) * (1.f / 16.f);
    }
    sTot[oc * 64 + ch] = run;
    __syncthreads();
    float off = 0.f, ref = 0.f, bend = 0.f;
#pragma unroll
    for (int j = 0; j < 8; ++j) { const float t = sTot[j * 64 + ch]; if (j < oc) off += t; if (j < 4) ref += t; bend += t; }
    float b = off;
#pragma unroll 1
    for (int i0 = 0; i0 < 8; i0 += 4) {
      float kh4[4];
#pragma unroll
      for (int ii = 0; ii < 4; ++ii) {
        const int tau = 8 * oc + i0 + ii;
        float gk = gb;
#pragma unroll
        for (int r = 0; r < 16; ++r) gk += sLow[tau * 16 + r] * w2c[r];
        b += (fminf(gk, 0.f) - __logf(1.f + __expf(-fabsf(gk)))) * (1.f / 16.f);
        const float qx = bf2f(rawQ[tau * 64 + ch]) * 0.125f, kx = bf2f(rawK[tau * 64 + ch]);
        sQt[tau * KP + ch] = f2bf(qx * __expf(b - ref));
        sKt[tau * KP + ch] = f2bf(kx * __expf(ref - b));
        sQc[tau * KP + ch] = f2bf(qx * __expf(b));
        kh4[ii] = kx * __expf(bend - b);
      }
      uint2 o; o.x = pk2(kh4[0], kh4[1]); o.y = pk2(kh4[2], kh4[3]);
      *(uint2*)(sKhT + ch * 72 + 8 * oc + i0) = o;
    }
#pragma unroll 1
    for (int i0 = 0; i0 < 16; i0 += 4) {
      unsigned vb[4];
#pragma unroll
      for (int ii = 0; ii < 4; ++ii) vb[ii] = rawV[(16 * vq + i0 + ii) * 128 + vn];
      uint2 ov; ov.x = vb[0] | (vb[1] << 16); ov.y = vb[2] | (vb[3] << 16);
      *(uint2*)(sVT + vn * 72 + 16 * vq + i0) = ov;
    }
    if (oc == 0) sD[ch] = __expf(bend);
    __syncthreads();
    scan_core<K, V, false>(smem, S, OB + (rowbase + (size_t)chunk * 64) * 512 + head * 128, dir, w, lane);
  }
}

DEV void ssd_item(const Params& p, int l, int bl, int head, int dir, unsigned char* smem) {
  constexpr int K = 128, V = 64, KP = 136;
  const int tid = launder(threadIdx.x), lane = tid & 63, w = tid >> 6;
  const int n = tid & 127, qd = tid >> 7;
  const int pp = tid & 63, oc = tid >> 6;
  const int grp = head >> 2;
  const bf16_t* Hh = (const bf16_t*)(p.ws + OFF_H);
  const float* SMALL = (const float*)(p.ws + OFF_SMALL);
  bf16_t* OB = (bf16_t*)(p.ws + OFF_OBUF) + (size_t)(1 * 2 + dir) * TH * 512;
  const size_t rowbase = (size_t)bl * SEQ;
  bf16_t* sQt = (bf16_t*)(smem + L_QT); bf16_t* sKt = (bf16_t*)(smem + L_KT); bf16_t* sQc = (bf16_t*)(smem + L_QC);
  bf16_t* sKhT = (bf16_t*)(smem + L_KHT); bf16_t* sVT = (bf16_t*)(smem + L_VT);
  float* sD = (float*)(smem + L_D); float* sAcs = (float*)(smem + L_ACS); float* sDt = (float*)(smem + L_DT);
  const bf16_t* rawB = (const bf16_t*)(smem + L_RAW); const bf16_t* rawC = rawB + 68 * 128; const bf16_t* rawX = rawB + 2 * 68 * 128;
  const int chB = 512 + grp * 128 + n, chC = 768 + grp * 128 + n, chX = head * 64 + pp;
  const float* cw = p.conv_w + (size_t)l * 5 * 1024; const float* cb = p.conv_b + (size_t)l * 1024;
  float wB[5], wC[5], wX[5];
#pragma unroll
  for (int j = 0; j < 5; ++j) { wB[j] = cw[j * 1024 + chB]; wC[j] = cw[j * 1024 + chC]; wX[j] = cw[j * 1024 + chX]; }
  const float bB = cb[chB], bC = cb[chC], bX = cb[chX];
  const float dtb = p.dt_bias[(l * 2 + dir) * 8 + head];
  const float Acoef = -__expf(p.a_log[(l * 2 + dir) * 8 + head]);
  f32x16 S[1]; S[0] = zero16();
  u32x4 pre[6];
  float rdt = 0.f;
  auto decode = [&](int id, int& row, int& gcol, int& loff) __attribute__((always_inline)) {
    if (id < 1088) { row = id >> 4; gcol = S_X + 512 + grp * 128 + (id & 15) * 8; loff = row * 256 + (id & 15) * 16; }
    else if (id < 2176) { const int i2 = id - 1088; row = i2 >> 4; gcol = S_X + 768 + grp * 128 + (i2 & 15) * 8; loff = 17408 + row * 256 + (i2 & 15) * 16; }
    else { const int i2 = id - 2176; row = i2 >> 3; gcol = S_X + head * 64 + (i2 & 7) * 8; loff = 34816 + row * 128 + (i2 & 7) * 16; }
  };
  auto gload = [&](int cidx) __attribute__((always_inline)) {
    const int chunk = dir ? (63 - cidx) : cidx;
#pragma unroll
    for (int j = 0; j < 6; ++j) {
      const int id = tid + 512 * j;
      pre[j] = (u32x4){0u, 0u, 0u, 0u};
      if (id < 2720) {
        int row, gcol, loff; decode(id, row, gcol, loff);
        const int s = chunk * 64 + row - 2;
        if (s >= 0 && s < SEQ) pre[j] = *(const u32x4*)(Hh + (rowbase + s) * NPAD + gcol);
      }
    }
    if (w == 0) {
      const int tok = chunk * 64 + (dir ? (63 - lane) : lane);
      rdt = SMALL[(rowbase + tok) * 48 + dir * 8 + head];
    }
  };
  gload(0);
  for (int cidx = 0; cidx < 64; ++cidx) {
    const int chunk = dir ? (63 - cidx) : cidx;
#pragma unroll
    for (int j = 0; j < 6; ++j) {
      const int id = tid + 512 * j;
      if (id < 2720) { int row, gcol, loff; decode(id, row, gcol, loff); *(u32x4*)(smem + L_RAW + loff) = pre[j]; }
    }
    if (w == 0) {
      const float xx = rdt + dtb;
      const float dt = (xx > 20.f) ? xx : log1pf(__expf(xx));
      float a = dt * Acoef;
#pragma unroll
      for (int o = 1; o < 64; o <<= 1) { const float t = __shfl_up(a, o); if (lane >= o) a += t; }
      sAcs[lane] = a; sDt[lane] = dt;
    }
    __syncthreads();
    if (cidx + 1 < 64) gload(cidx + 1);
    const float aend = sAcs[63];
#pragma unroll 1
    for (int i0 = 0; i0 < 16; i0 += 4) {
      float kh4[4];
#pragma unroll
      for (int ii = 0; ii < 4; ++ii) {
        const int tau = 16 * qd + i0 + ii;
        const int tl = dir ? (63 - tau) : tau;
        float uB = bB, uC = bC;
#pragma unroll
        for (int j = 0; j < 5; ++j) { uB += wB[j] * bf2f(rawB[(tl + j) * 128 + n]); uC += wC[j] * bf2f(rawC[(tl + j) * 128 + n]); }
        uB = fsilu(uB); uC = fsilu(uC);
        const float ac = sAcs[tau];
        sQt[tau * KP + n] = f2bf(uC);
        sKt[tau * KP + n] = f2bf(uB);
        sQc[tau * KP + n] = f2bf(uC * __expf(ac));
        kh4[ii] = uB * __expf(aend - ac);
      }
      uint2 o; o.x = pk2(kh4[0], kh4[1]); o.y = pk2(kh4[2], kh4[3]);
      *(uint2*)(sKhT + n * 72 + 16 * qd + i0) = o;
    }
#pragma unroll 1
    for (int i0 = 0; i0 < 8; i0 += 4) {
      float xv[4];
#pragma unroll
      for (int ii = 0; ii < 4; ++ii) {
        const int tau = 8 * oc + i0 + ii;
        const int tl = dir ? (63 - tau) : tau;
        float u = bX;
#pragma unroll
        for (int j = 0; j < 5; ++j) u += wX[j] * bf2f(rawX[(tl + j) * 64 + pp]);
        xv[ii] = fsilu(u) * sDt[tau];
      }
      uint2 o; o.x = pk2(xv[0], xv[1]); o.y = pk2(xv[2], xv[3]);
      *(uint2*)(sVT + pp * 72 + 8 * oc + i0) = o;
    }
    if (qd == 0) sD[n] = __expf(aend);
    __syncthreads();
    scan_core<K, V, true>(smem, S, OB + (rowbase + (size_t)chunk * 64) * 512 + head * 64, dir, w, lane);
  }
}

DEV void phase_mix(const Params& p, int l, int hf, int phase, unsigned char* smem) {
  unsigned* ctr = (unsigned*)(p.ws + OFF_CTRL) + CTR_WORD0 + phase * 16;
  volatile int* sItem = (volatile int*)(smem + LDS_BYTES - 16);
  const int n_items = 64 + 256;
  for (;;) {
    __syncthreads();
    if (threadIdx.x == 0) *sItem = (int)atomicAdd(ctr, 1u);
    __syncthreads();
    const int it = *sItem;
    if (it >= n_items) break;
    if (it < 16) { if (PH_MASK & 0x100) hgrn_item(p, l, it >> 3, (it >> 1) & 3, it & 1, smem); }
    else if (it < 32) { const int j = it - 16; if (PH_MASK & 0x200) gla_item(p, l, j >> 3, (j >> 1) & 3, j & 1, smem); }
    else if (it < 64) { const int j = it - 32; if (PH_MASK & 0x400) ssd_item(p, l, j >> 4, (j >> 1) & 7, j & 1, smem); }
    else { if (PH_MASK & 0x800) attn_item(p, l, it - 64, smem); }
  }
}

DEV void phase_fin(const Params& p, int l, int hf) {
  const int tid = launder(threadIdx.x), lane = tid & 63, w = tid >> 6;
  const bf16_t* Hh = (const bf16_t*)(p.ws + OFF_H);
  const bf16_t* OB = (const bf16_t*)(p.ws + OFF_OBUF);
  bf16_t* MX = (bf16_t*)(p.ws + OFF_MIXED);
  const int c0 = lane * 8;
  const float* cw = p.conv_w + (size_t)l * 5 * 1024; const float* cb = p.conv_b + (size_t)l * 1024;
  for (int r = blockIdx.x * 8 + w; r < TH; r += gridDim.x * 8) {
    const bf16_t* hrow = Hh + (size_t)r * NPAD;
    {
      const uint4 a = *(const uint4*)(OB + ((size_t)0 * TH + r) * 512 + c0), b = *(const uint4*)(OB + ((size_t)1 * TH + r) * 512 + c0);
      const uint4 z = *(const uint4*)(hrow + H_Z + c0);
      const unsigned au[4] = {a.x, a.y, a.z, a.w}, bu[4] = {b.x, b.y, b.z, b.w}, zu[4] = {z.x, z.y, z.z, z.w};
      float o[8]; float ss = 0.f;
#pragma unroll
      for (int j = 0; j < 4; ++j) {
        o[2 * j] = bf2f((bf16_t)(au[j] & 0xffff)) + bf2f((bf16_t)(bu[j] & 0xffff));
        o[2 * j + 1] = bf2f((bf16_t)(au[j] >> 16)) + bf2f((bf16_t)(bu[j] >> 16));
        ss += o[2 * j] * o[2 * j] + o[2 * j + 1] * o[2 * j + 1];
      }
#pragma unroll
      for (int of = 32; of >= 1; of >>= 1) ss += __shfl_xor(ss, of);
      const float rstd = rsqrtf(ss * (1.f / 512.f) + 1e-6f);
      float y[8];
#pragma unroll
      for (int j = 0; j < 8; ++j) {
        const float zz = bf2f((bf16_t)((j & 1) ? (zu[j >> 1] >> 16) : (zu[j >> 1] & 0xffff)));
        y[j] = o[j] * rstd * p.hgrn_norm[l * 512 + c0 + j] * fsilu(zz);
      }
      uint4 ov; ov.x = pk2(y[0], y[1]); ov.y = pk2(y[2], y[3]); ov.z = pk2(y[4], y[5]); ov.w = pk2(y[6], y[7]);
      *(uint4*)(MX + (size_t)r * DI + 512 + c0) = ov;
    }
    {
      const uint4 a = *(const uint4*)(OB + ((size_t)4 * TH + r) * 512 + c0), b = *(const uint4*)(OB + ((size_t)5 * TH + r) * 512 + c0);
      const uint4 z = *(const uint4*)(hrow + G_Z + c0);
      const unsigned au[4] = {a.x, a.y, a.z, a.w}, bu[4] = {b.x, b.y, b.z, b.w}, zu[4] = {z.x, z.y, z.z, z.w};
      float o[8]; float ss = 0.f;
#pragma unroll
      for (int j = 0; j < 4; ++j) {
        o[2 * j] = bf2f((bf16_t)(au[j] & 0xffff)) + bf2f((bf16_t)(bu[j] & 0xffff));
        o[2 * j + 1] = bf2f((bf16_t)(au[j] >> 16)) + bf2f((bf16_t)(bu[j] >> 16));
        ss += o[2 * j] * o[2 * j] + o[2 * j + 1] * o[2 * j + 1];
      }
#pragma unroll
      for (int of = 8; of >= 1; of >>= 1) ss += __shfl_xor(ss, of);
      const float rstd = rsqrtf(ss * (1.f / 128.f) + 1e-6f);
      float y[8];
#pragma unroll
      for (int j = 0; j < 8; ++j) {
        const float zz = bf2f((bf16_t)((j & 1) ? (zu[j >> 1] >> 16) : (zu[j >> 1] & 0xffff)));
        y[j] = o[j] * rstd * p.gla_norm[l * 128 + ((c0 + j) & 127)] * fsilu(zz);
      }
      uint4 ov; ov.x = pk2(y[0], y[1]); ov.y = pk2(y[2], y[3]); ov.z = pk2(y[4], y[5]); ov.w = pk2(y[6], y[7]);
      *(uint4*)(MX + (size_t)r * DI + 1536 + c0) = ov;
    }
    {
      const uint4 a = *(const uint4*)(OB + ((size_t)2 * TH + r) * 512 + c0), b = *(const uint4*)(OB + ((size_t)3 * TH + r) * 512 + c0);
      const uint4 z = *(const uint4*)(hrow + S_Z + c0);
      const unsigned au[4] = {a.x, a.y, a.z, a.w}, bu[4] = {b.x, b.y, b.z, b.w}, zu[4] = {z.x, z.y, z.z, z.w};
      float u[8];
#pragma unroll
      for (int j = 0; j < 8; ++j) u[j] = cb[c0 + j];
      const int t = r & (SEQ - 1);
#pragma unroll
      for (int jj = 0; jj < 5; ++jj) {
        const int s = t + jj - 2;
        if (s >= 0 && s < SEQ) {
          const uint4 xr = *(const uint4*)(Hh + (size_t)(r + jj - 2) * NPAD + S_X + c0);
          const unsigned xu[4] = {xr.x, xr.y, xr.z, xr.w};
#pragma unroll
          for (int j = 0; j < 8; ++j) {
            const float xv = bf2f((bf16_t)((j & 1) ? (xu[j >> 1] >> 16) : (xu[j >> 1] & 0xffff)));
            u[j] += cw[jj * 1024 + c0 + j] * xv;
          }
        }
      }
      const float dsk = p.ssd_d[l * 8 + (c0 >> 6)];
      float y[8]; float ss = 0.f;
#pragma unroll
      for (int j = 0; j < 8; ++j) {
        const float of = bf2f((bf16_t)((j & 1) ? (au[j >> 1] >> 16) : (au[j >> 1] & 0xffff)));
        const float ob = bf2f((bf16_t)((j & 1) ? (bu[j >> 1] >> 16) : (bu[j >> 1] & 0xffff)));
        const float zz = bf2f((bf16_t)((j & 1) ? (zu[j >> 1] >> 16) : (zu[j >> 1] & 0xffff)));
        y[j] = (of + ob + dsk * fsilu(u[j])) * fsilu(zz);
        ss += y[j] * y[j];
      }
#pragma unroll
      for (int of = 32; of >= 1; of >>= 1) ss += __shfl_xor(ss, of);
      const float rstd = rsqrtf(ss * (1.f / 512.f) + 1e-6f);
#pragma unroll
      for (int j = 0; j < 8; ++j) y[j] = y[j] * rstd * p.ssd_norm[l * 512 + c0 + j];
      uint4 ov; ov.x = pk2(y[0], y[1]); ov.y = pk2(y[2], y[3]); ov.z = pk2(y[4], y[5]); ov.w = pk2(y[6], y[7]);
      *(uint4*)(MX + (size_t)r * DI + 1024 + c0) = ov;
    }
  }
}

__global__ void __launch_bounds__(NT) mega(Params p) {
  extern __shared__ __attribute__((aligned(16))) unsigned char smem[];
  for (int ph = p.phase_begin; ph < p.phase_end; ++ph) {
    if (ph == 0) { if (PH_MASK & 1) phase_pro(p, smem); }
    else {
      const int q = ph - 1, l = q / 10, hf = (q / 5) & 1, st = q % 5;
      if (st == 0) { if (PH_MASK & 2) phase_inproj(p, l, hf, smem); }
      else if (st == 1) { if (PH_MASK & 0xF00) phase_mix(p, l, hf, ph, smem); }
      else if (st == 2) { if (PH_MASK & 8) phase_fin(p, l, hf); }
      else if (st == 3) { if (PH_MASK & 16) phase_outproj(p, l, hf, smem); }
      else {
        if (PH_MASK & 32) phase_ln(p, l, hf);
        if ((PH_MASK & 1) && l == 0 && hf == 1) convert_weights(p, 1, smem);
      }
    }
#if ONE_LAUNCH
    if (ph + 1 < p.phase_end) cg::this_grid().sync();
#endif
  }
}

extern "C" void kernel_launch(void* const* d_in, const int* in_sizes, int n_in, void* d_out, int out_size, void* d_ws, size_t ws_size,
                              hipStream_t stream) {
  static int grid_blocks = 0;
  if (!grid_blocks) {
    int dev = 0, cus = 0, per_cu = 0;
    hipGetDevice(&dev);
    hipDeviceGetAttribute(&cus, hipDeviceAttributeMultiprocessorCount, dev);
    hipFuncSetAttribute((const void*)mega, hipFuncAttributeMaxDynamicSharedMemorySize, LDS_BYTES);
    hipOccupancyMaxActiveBlocksPerMultiprocessor(&per_cu, mega, NT, LDS_BYTES);
    if (per_cu < 1) per_cu = 1;
    grid_blocks = cus;
  }
  Params p{};
  p.x = (const float*)d_in[0]; p.w_in = (const float*)d_in[1]; p.q_gain = (const float*)d_in[2]; p.k_gain = (const float*)d_in[3];
  p.lb_logits = (const float*)d_in[4]; p.hgrn_norm = (const float*)d_in[5]; p.conv_w = (const float*)d_in[6]; p.conv_b = (const float*)d_in[7];
  p.dt_bias = (const float*)d_in[8]; p.a_log = (const float*)d_in[9]; p.ssd_d = (const float*)d_in[10]; p.ssd_norm = (const float*)d_in[11];
  p.gk_w2 = (const float*)d_in[12]; p.gk_b = (const float*)d_in[13]; p.gla_norm = (const float*)d_in[14]; p.w_out = (const float*)d_in[15];
  p.ln_g = (const float*)d_in[16]; p.ln_b = (const float*)d_in[17];
  p.out = (float*)d_out; p.ws = (unsigned char*)d_ws;
  hipMemsetAsync(d_ws, 0, CTRL_BYTES, stream);
#if ONE_LAUNCH
  p.phase_begin = 0; p.phase_end = NPHASE;
  void* args[] = {&p};
  hipError_t e = hipLaunchCooperativeKernel((const void*)mega, dim3(grid_blocks), dim3(NT), args, LDS_BYTES, stream);
  if (e != hipSuccess) fprintf(stderr, "cooperative launch failed: %s (grid %d)\n", hipGetErrorString(e), grid_blocks);
#else
  for (int ph = 0; ph < NPHASE; ++ph) {
    p.phase_begin = ph; p.phase_end = ph + 1;
    hipLaunchKernelGGL(mega, dim3(grid_blocks), dim3(NT), LDS_BYTES, stream, p);
  }
#endif
}
```

```cpp
#include <hip/hip_runtime.h>
#include <hip/hip_cooperative_groups.h>
#include <stdint.h>
#include <stdio.h>
namespace cg = cooperative_groups;

#ifndef ONE_LAUNCH
#define ONE_LAUNCH 1
#endif

#ifndef PH_MASK
#define PH_MASK 0xFFF
#endif
#define DEV __device__ __forceinline__
typedef unsigned short bf16_t;
typedef short bf16x8 __attribute__((ext_vector_type(8)));
typedef float f32x16 __attribute__((ext_vector_type(16)));
typedef unsigned u32x4 __attribute__((ext_vector_type(4)));

constexpr int NT = 512;
constexpr int T_ALL = 16384, TH = 8192, SEQ = 4096, DM = 1024, NPAD = 7168, DI = 2048, NIN = 6960;
constexpr int A_Q = 0, A_K = 512, A_V = 640, A_Z = 768, H_Q = 1280, H_FF = 1792, H_FB = 2304, H_I = 2816, H_Z = 3328,
              S_X = 3840, S_Z = 4864, G_Q = 5376, G_K = 5632, G_V = 5888, G_Z = 6400, SM0 = 6912;
constexpr size_t OFF_CTRL = 0, OFF_TAB = 65536, OFF_XB = 131072;
constexpr size_t OFF_WIN = OFF_XB + (size_t)T_ALL * DM * 2;
constexpr size_t OFF_WOUT = OFF_WIN + (size_t)NPAD * DM * 2;
constexpr size_t OFF_H = OFF_WOUT + (size_t)DM * DI * 2;
constexpr size_t OFF_SMALL = OFF_H + (size_t)TH * NPAD * 2;
constexpr size_t OFF_MIXED = OFF_SMALL + (size_t)TH * 48 * 4;
constexpr size_t OFF_OBUF = OFF_MIXED + (size_t)TH * DI * 2;
constexpr size_t OFF_VT = OFF_OBUF + (size_t)6 * TH * 512 * 2;
constexpr size_t WS_END = OFF_VT + (size_t)2 * 2 * 64 * SEQ * 2;
constexpr size_t CTRL_BYTES = 65536;
constexpr int CTR_WORD0 = 4096;
constexpr int LDS_BYTES = 148480;
constexpr float LOG2E = 1.4426950408889634f;
constexpr float QSCALE = 0.125f * LOG2E;
constexpr float DN_ALPHA = 1.4142135623730951f;
constexpr int NPHASE = 21;

struct Params {
  const float* x; const float* w_in; const float* q_gain; const float* k_gain; const float* lb_logits; const float* hgrn_norm;
  const float* conv_w; const float* conv_b; const float* dt_bias; const float* a_log; const float* ssd_d; const float* ssd_norm;
  const float* gk_w2; const float* gk_b; const float* gla_norm; const float* w_out; const float* ln_g; const float* ln_b;
  float* out; unsigned char* ws;
  int phase_begin, phase_end;
};

DEV int launder(int v) { asm volatile("" : "+v"(v)); return v; }
DEV float bf2f(bf16_t v) { return __uint_as_float(((unsigned)v) << 16); }
DEV bf16_t f2bf(float f) { unsigned u = __float_as_uint(f); u += 0x7fffu + ((u >> 16) & 1u); return (bf16_t)(u >> 16); }
DEV unsigned pk2(float lo, float hi) { return (unsigned)f2bf(lo) | ((unsigned)f2bf(hi) << 16); }
DEV float fsigmoid(float x) { return 1.f / (1.f + __expf(-x)); }
DEV float fsilu(float x) { return x / (1.f + __expf(-x)); }
DEV int rowoff(int reg, int h) { return (reg & 3) + 8 * (reg >> 2) + 4 * h; }
DEV f32x16 zero16() { f32x16 z;
#pragma unroll
  for (int i = 0; i < 16; ++i) z[i] = 0.f; return z; }

template <int KD>
DEV void mma32(f32x16& acc, const bf16_t* a, int lda, const bf16_t* b, int ldb, int lane) {
  const int r = lane & 31, h = lane >> 5;
  const bf16_t* ap = a + r * lda + 8 * h;
  const bf16_t* bp = b + r * ldb + 8 * h;
#pragma unroll
  for (int k = 0; k < KD; k += 16) {
    bf16x8 av = *(const bf16x8*)(ap + k);
    bf16x8 bv = *(const bf16x8*)(bp + k);
    acc = __builtin_amdgcn_mfma_f32_32x32x16_bf16(av, bv, acc, 0, 0, 0);
  }
}

DEV int orig_col(int n) {
  if (n < 4864) return n;
  if (n < 6400) return n + 16;
  if (n < 6912) return n + 48;
  if (n < 6928) return n - 2048;
  if (n < 6960) return n - 512;
  return -1;
}

DEV void convert_weights(const Params& p, int l, unsigned char* smem) {
  float* s = (float*)smem;
  const int tid = launder(threadIdx.x);
  const float* win = p.w_in + (size_t)l * DM * NIN;
  const float* wout = p.w_out + (size_t)l * DI * DM;
  bf16_t* wint = (bf16_t*)(p.ws + OFF_WIN);
  bf16_t* woutt = (bf16_t*)(p.ws + OFF_WOUT);
  const int n_in_tiles = (NPAD / 64) * (DM / 64);
  const int n_out_tiles = (DM / 64) * (DI / 64);
  for (int it = blockIdx.x; it < n_in_tiles + n_out_tiles; it += gridDim.x) {
    __syncthreads();
    if (it < n_in_tiles) {
      const int n0 = (it / 16) * 64, k0 = (it % 16) * 64;
#pragma unroll
      for (int e = 0; e < 8; ++e) {
        const int idx = e * NT + tid, kk = idx >> 6, nn = idx & 63;
        const int oc = orig_col(n0 + nn);
        s[kk * 65 + nn] = (oc >= 0) ? win[(size_t)(k0 + kk) * NIN + oc] : 0.f;
      }
      __syncthreads();
      const int n = tid >> 3, kc = (tid & 7) * 8;
      uint4 o;
      o.x = pk2(s[(kc + 0) * 65 + n], s[(kc + 1) * 65 + n]); o.y = pk2(s[(kc + 2) * 65 + n], s[(kc + 3) * 65 + n]);
      o.z = pk2(s[(kc + 4) * 65 + n], s[(kc + 5) * 65 + n]); o.w = pk2(s[(kc + 6) * 65 + n], s[(kc + 7) * 65 + n]);
      *(uint4*)(wint + (size_t)(n0 + n) * DM + k0 + kc) = o;
    } else {
      const int j = it - n_in_tiles;
      const int n0 = (j / 32) * 64, k0 = (j % 32) * 64;
#pragma unroll
      for (int e = 0; e < 8; ++e) {
        const int idx = e * NT + tid, kk = idx >> 6, nn = idx & 63;
        s[kk * 65 + nn] = wout[(size_t)(k0 + kk) * DM + n0 + nn];
      }
      __syncthreads();
      const int n = tid >> 3, kc = (tid & 7) * 8;
      uint4 o;
      o.x = pk2(s[(kc + 0) * 65 + n], s[(kc + 1) * 65 + n]); o.y = pk2(s[(kc + 2) * 65 + n], s[(kc + 3) * 65 + n]);
      o.z = pk2(s[(kc + 4) * 65 + n], s[(kc + 5) * 65 + n]); o.w = pk2(s[(kc + 6) * 65 + n], s[(kc + 7) * 65 + n]);
      *(uint4*)(woutt + (size_t)(n0 + n) * DI + k0 + kc) = o;
    }
  }
  __syncthreads();
}

DEV void dsincos(double x, double& s, double& c) {
  const double k = rint(x * 0.63661977236758134308);
  double r = fma(-k, 1.57079632679489655800e+00, x);
  r = fma(-k, 6.12323399573676603587e-17, r);
  const double r2 = r * r;
  const double t3 = r2 * r, t5 = t3 * r2, t7 = t5 * r2, t9 = t7 * r2, t11 = t9 * r2, t13 = t11 * r2, t15 = t13 * r2;
  const double sinr = r - t3 / 6.0 + t5 / 120.0 - t7 / 5040.0 + t9 / 362880.0 - t11 / 39916800.0 + t13 / 6227020800.0 - t15 / 1307674368000.0;
  const double u2 = r2, u4 = u2 * u2, u6 = u4 * u2, u8 = u6 * u2, u10 = u8 * u2, u12 = u10 * u2, u14 = u12 * u2, u16 = u14 * u2;
  const double cosr = 1.0 - u2 / 2.0 + u4 / 24.0 - u6 / 720.0 + u8 / 40320.0 - u10 / 3628800.0 + u12 / 479001600.0 - u14 / 87178291200.0 + u16 / 20922789888000.0;
  const int q = ((int)k) & 3;
  if (q == 0) { s = sinr; c = cosr; }
  else if (q == 1) { s = cosr; c = -sinr; }
  else if (q == 2) { s = -sinr; c = -cosr; }
  else { s = -cosr; c = sinr; }
}

DEV void phase_pro(const Params& p, unsigned char* smem) {
  const int tid = launder(threadIdx.x);
  const size_t gtid = (size_t)blockIdx.x * NT + tid, gsz = (size_t)gridDim.x * NT;
  const float4* x4 = (const float4*)p.x;
  uint4* xb4 = (uint4*)(p.ws + OFF_XB);
  for (size_t i = gtid; i < (size_t)T_ALL * DM / 8; i += gsz) {
    const float4 a = x4[2 * i], b = x4[2 * i + 1];
    uint4 o; o.x = pk2(a.x, a.y); o.y = pk2(a.z, a.w); o.z = pk2(b.x, b.y); o.w = pk2(b.z, b.w);
    xb4[i] = o;
  }
  if (blockIdx.x == 0) {
    float2* tab = (float2*)(p.ws + OFF_TAB);
    for (int i = tid; i < 64 * 16; i += NT) {
      const int pos = i >> 4, fi = i & 15;
      const float invf = (float)exp(-(double)fi * (9.210340371976184 / 16.0));
      const float ang = (float)pos * invf;
      double s, c; dsincos((double)ang, s, c);
      tab[i] = make_float2((float)c, (float)s);
    }
  }
  convert_weights(p, 0, smem);
}

DEV void gemm_block(const bf16_t* __restrict__ A, int lda, const bf16_t* __restrict__ Bt, int ldb, int nk, unsigned char* smem, f32x16 (&acc)[2][2]) {
  const int tid = launder(threadIdx.x), lane = tid & 63, w = tid >> 6, wr = w >> 2, wc = w & 3, r = lane & 31, h = lane >> 5;
  const int ar = tid >> 2, ac = (tid & 3) * 16;
  const int br = tid >> 1, bc = (tid & 1) * 32;
  const bf16_t* ag = A + (size_t)ar * lda + ac;
  const bf16_t* bg = Bt + (size_t)br * ldb + bc;
  uint4 ra0, ra1, rb0, rb1, rb2, rb3;
#pragma unroll
  for (int i = 0; i < 2; ++i)
#pragma unroll
    for (int j = 0; j < 2; ++j) acc[i][j] = zero16();
  {
    const uint4* pa = (const uint4*)ag; ra0 = pa[0]; ra1 = pa[1];
    const uint4* pb = (const uint4*)bg; rb0 = pb[0]; rb1 = pb[1]; rb2 = pb[2]; rb3 = pb[3];
    uint4* sa = (uint4*)(smem + ar * 144 + ac * 2); sa[0] = ra0; sa[1] = ra1;
    uint4* sb = (uint4*)(smem + 18432 + br * 144 + bc * 2); sb[0] = rb0; sb[1] = rb1; sb[2] = rb2; sb[3] = rb3;
  }
  __syncthreads();
  for (int kt = 0; kt < nk; ++kt) {
    if (kt + 1 < nk) {
      const uint4* pa = (const uint4*)(ag + (kt + 1) * 64); ra0 = pa[0]; ra1 = pa[1];
      const uint4* pb = (const uint4*)(bg + (kt + 1) * 64); rb0 = pb[0]; rb1 = pb[1]; rb2 = pb[2]; rb3 = pb[3];
    }
    const bf16_t* sa = (const bf16_t*)(smem + (kt & 1) * 55296);
    const bf16_t* sb = (const bf16_t*)(smem + (kt & 1) * 55296 + 18432);
#pragma unroll
    for (int ks = 0; ks < 4; ++ks) {
      const bf16x8 a0 = *(const bf16x8*)(sa + (wr * 64 + r) * 72 + ks * 16 + 8 * h);
      const bf16x8 a1 = *(const bf16x8*)(sa + (wr * 64 + 32 + r) * 72 + ks * 16 + 8 * h);
      const bf16x8 b0 = *(const bf16x8*)(sb + (wc * 64 + r) * 72 + ks * 16 + 8 * h);
      const bf16x8 b1 = *(const bf16x8*)(sb + (wc * 64 + 32 + r) * 72 + ks * 16 + 8 * h);
      acc[0][0] = __builtin_amdgcn_mfma_f32_32x32x16_bf16(a0, b0, acc[0][0], 0, 0, 0);
      acc[0][1] = __builtin_amdgcn_mfma_f32_32x32x16_bf16(a0, b1, acc[0][1], 0, 0, 0);
      acc[1][0] = __builtin_amdgcn_mfma_f32_32x32x16_bf16(a1, b0, acc[1][0], 0, 0, 0);
      acc[1][1] = __builtin_amdgcn_mfma_f32_32x32x16_bf16(a1, b1, acc[1][1], 0, 0, 0);
    }
    if (kt + 1 < nk) {
      unsigned char* base = smem + ((kt + 1) & 1) * 55296;
      uint4* sa2 = (uint4*)(base + ar * 144 + ac * 2); sa2[0] = ra0; sa2[1] = ra1;
      uint4* sb2 = (uint4*)(base + 18432 + br * 144 + bc * 2); sb2[0] = rb0; sb2[1] = rb1; sb2[2] = rb2; sb2[3] = rb3;
    }
    __syncthreads();
  }
}

DEV void phase_inproj(const Params& p, int l, int hf, unsigned char* smem) {
  const int tid = launder(threadIdx.x), lane = tid & 63, w = tid >> 6, wr = w >> 2, wc = w & 3, c = lane & 31, h = lane >> 5;
  const bf16_t* A = (const bf16_t*)(p.ws + OFF_XB) + (size_t)hf * TH * DM;
  const bf16_t* Bt = (const bf16_t*)(p.ws + OFF_WIN);
  bf16_t* Hh = (bf16_t*)(p.ws + OFF_H);
  float* SMALL = (float*)(p.ws + OFF_SMALL);
  bf16_t* VT = (bf16_t*)(p.ws + OFF_VT);
  const float2* tab = (const float2*)(p.ws + OFF_TAB);
  const int n_items = (TH / 128) * (NPAD / 256);
  for (int it = blockIdx.x; it < n_items; it += gridDim.x) {
    const int pn = it % 28, pm = it / 28;
    f32x16 acc[2][2];
    gemm_block(A + (size_t)pm * 128 * DM, DM, Bt + (size_t)pn * 256 * DM, DM, DM / 64, smem, acc);
    const int colbase = pn * 256 + wc * 64;
    const int rowb = pm * 128 + wr * 64;
    if (colbase == SM0) {
#pragma unroll
      for (int mi = 0; mi < 2; ++mi)
#pragma unroll
        for (int reg = 0; reg < 16; ++reg) {
          const int row = rowb + mi * 32 + rowoff(reg, h);
          SMALL[(size_t)row * 48 + c] = acc[mi][0][reg];
          if (c < 16) SMALL[(size_t)row * 48 + 32 + c] = acc[mi][1][reg];
        }
    } else if (colbase < SM0) {
      if (colbase < A_V) {
        const bool isq = colbase < A_K;
        const float* gain = (isq ? p.q_gain : p.k_gain) + l * 64;
        const float g0 = gain[c], g1 = gain[32 + c];
        const float osc = isq ? QSCALE : 1.f;
#pragma unroll
        for (int mi = 0; mi < 2; ++mi)
#pragma unroll
          for (int reg = 0; reg < 16; ++reg) {
            float ss = acc[mi][0][reg] * acc[mi][0][reg] + acc[mi][1][reg] * acc[mi][1][reg];
            ss += __shfl_xor(ss, 1); ss += __shfl_xor(ss, 2); ss += __shfl_xor(ss, 4); ss += __shfl_xor(ss, 8); ss += __shfl_xor(ss, 16);
            const float rstd = rsqrtf(ss * (1.f / 64.f) + 1e-6f);
            const int row = rowb + mi * 32 + rowoff(reg, h);
            const int t = row & (SEQ - 1);
            const float2 cs0 = tab[(t >> 6) * 16 + (c & 15)], cs1 = tab[(t & 63) * 16 + (c & 15)];
            const float v0 = acc[mi][0][reg] * rstd * g0, v1 = acc[mi][1][reg] * rstd * g1;
            const float p0 = __shfl_xor(v0, 16), p1 = __shfl_xor(v1, 16);
            const float o0 = (c & 16) ? (v0 * cs0.x + p0 * cs0.y) : (v0 * cs0.x - p0 * cs0.y);
            const float o1 = (c & 16) ? (v1 * cs1.x + p1 * cs1.y) : (v1 * cs1.x - p1 * cs1.y);
            acc[mi][0][reg] = o0 * osc; acc[mi][1][reg] = o1 * osc;
          }
      }
      if (colbase >= A_V && colbase < A_Z) {
        const int kvh = (colbase - A_V) >> 6;
#pragma unroll
        for (int mi = 0; mi < 2; ++mi)
#pragma unroll
          for (int ni = 0; ni < 2; ++ni)
#pragma unroll
            for (int g = 0; g < 4; ++g) {
              const int row = rowb + mi * 32 + 8 * g + 4 * h;
              const int bl = row >> 12, t = row & (SEQ - 1);
              const int d = ni * 32 + c;
              uint2 o; o.x = pk2(acc[mi][ni][4 * g + 0], acc[mi][ni][4 * g + 1]); o.y = pk2(acc[mi][ni][4 * g + 2], acc[mi][ni][4 * g + 3]);
              *(uint2*)(VT + ((size_t)((bl * 2 + kvh) * 64 + d)) * SEQ + t) = o;
            }
      } else {
        bf16_t* so = (bf16_t*)(smem + w * 9216);
#pragma unroll
        for (int mi = 0; mi < 2; ++mi)
#pragma unroll
          for (int ni = 0; ni < 2; ++ni)
#pragma unroll
            for (int reg = 0; reg < 16; ++reg)
              so[(mi * 32 + rowoff(reg, h)) * 72 + ni * 32 + c] = f2bf(acc[mi][ni][reg]);
        __builtin_amdgcn_s_waitcnt(0xc07f);
        __builtin_amdgcn_wave_barrier();
#pragma unroll
        for (int i = 0; i < 8; ++i) {
          const int rr = i * 8 + (lane >> 3), ch = lane & 7;
          const uint4 v = *(const uint4*)(so + rr * 72 + ch * 8);
          *(uint4*)(Hh + (size_t)(rowb + rr) * NPAD + colbase + ch * 8) = v;
        }
      }
    }
    __syncthreads();
  }
}

DEV void phase_outproj(const Params& p, int l, int hf, unsigned char* smem) {
  const int tid = launder(threadIdx.x), lane = tid & 63, w = tid >> 6, wr = w >> 2, wc = w & 3, c = lane & 31, h = lane >> 5;
  const bf16_t* A = (const bf16_t*)(p.ws + OFF_MIXED);
  const bf16_t* Bt = (const bf16_t*)(p.ws + OFF_WOUT);
  const float* xin = (l == 0) ? p.x : p.out;
  const int n_items = (TH / 128) * (DM / 256);
  for (int it = blockIdx.x; it < n_items; it += gridDim.x) {
    const int pn = it & 3, pm = it >> 2;
    f32x16 acc[2][2];
    gemm_block(A + (size_t)pm * 128 * DI, DI, Bt + (size_t)pn * 256 * DI, DI, DI / 64, smem, acc);
#pragma unroll
    for (int mi = 0; mi < 2; ++mi)
#pragma unroll
      for (int ni = 0; ni < 2; ++ni)
#pragma unroll
        for (int reg = 0; reg < 16; ++reg) {
          const int row = hf * TH + pm * 128 + wr * 64 + mi * 32 + rowoff(reg, h);
          const int col = pn * 256 + wc * 64 + ni * 32 + c;
          const size_t idx = (size_t)row * DM + col;
          p.out[idx] = DN_ALPHA * xin[idx] + acc[mi][ni][reg];
        }
    __syncthreads();
  }
}

DEV void phase_ln(const Params& p, int l, int hf) {
  const int tid = launder(threadIdx.x), lane = tid & 63, w = tid >> 6;
  const float* g = p.ln_g + l * DM; const float* b = p.ln_b + l * DM;
  bf16_t* xb = (bf16_t*)(p.ws + OFF_XB);
  for (int r = blockIdx.x * 8 + w; r < TH; r += gridDim.x * 8) {
    const int row = hf * TH + r;
    float4* rp = (float4*)(p.out + (size_t)row * DM);
    float4 v[4];
    float s = 0.f;
#pragma unroll
    for (int j = 0; j < 4; ++j) { v[j] = rp[j * 64 + lane]; s += (v[j].x + v[j].y) + (v[j].z + v[j].w); }
#pragma unroll
    for (int o = 32; o >= 1; o >>= 1) s += __shfl_xor(s, o);
    const float mu = s * (1.f / DM);
    float q = 0.f;
#pragma unroll
    for (int j = 0; j < 4; ++j) { const float a = v[j].x - mu, bb = v[j].y - mu, cc = v[j].z - mu, d = v[j].w - mu; q += (a * a + bb * bb) + (cc * cc + d * d); }
#pragma unroll
    for (int o = 32; o >= 1; o >>= 1) q += __shfl_xor(q, o);
    const float rstd = rsqrtf(q * (1.f / DM) + 1e-5f);
#pragma unroll
    for (int j = 0; j < 4; ++j) {
      const int col = (j * 64 + lane) * 4;
      const float4 gg = *(const float4*)(g + col), bb = *(const float4*)(b + col);
      float4 o;
      o.x = (v[j].x - mu) * rstd * gg.x + bb.x; o.y = (v[j].y - mu) * rstd * gg.y + bb.y;
      o.z = (v[j].z - mu) * rstd * gg.z + bb.z; o.w = (v[j].w - mu) * rstd * gg.w + bb.w;
      rp[j * 64 + lane] = o;
      if (l == 0) { uint2 pk; pk.x = pk2(o.x, o.y); pk.y = pk2(o.z, o.w); *(uint2*)(xb + (size_t)row * DM + col) = pk; }
    }
  }
}

DEV void attn_item(const Params& p, int l, int item, unsigned char* smem) {
  const int tid = launder(threadIdx.x), lane = tid & 63, w = tid >> 6, r = lane & 31, h = lane >> 5;
  const int qt = item & 15, head = (item >> 4) & 7, bl = item >> 7;
  const int kvh = head >> 2;
  const bf16_t* Hh = (const bf16_t*)(p.ws + OFF_H);
  const bf16_t* VT = (const bf16_t*)(p.ws + OFF_VT);
  bf16_t* MX = (bf16_t*)(p.ws + OFF_MIXED);
  const size_t rowbase = (size_t)bl * SEQ;
  float mq = fabsf(p.q_gain[l * 64 + lane]), mk = fabsf(p.k_gain[l * 64 + lane]);
#pragma unroll
  for (int o = 32; o >= 1; o >>= 1) { mq = fmaxf(mq, __shfl_xor(mq, o)); mk = fmaxf(mk, __shfl_xor(mk, o)); }
  const float M2 = 8.f * mq * mk * LOG2E * 1.01f;
  const int qrow = qt * 256 + w * 32 + r;
  const bf16_t* qp = Hh + (rowbase + qrow) * NPAD + A_Q + head * 64 + 8 * h;
  bf16x8 qf[4];
#pragma unroll
  for (int ks = 0; ks < 4; ++ks) qf[ks] = *(const bf16x8*)(qp + ks * 16);
  f32x16 o0 = zero16(), o1 = zero16();
  float lsum = 0.f;
  const int srow = tid >> 3, sch = (tid & 7) * 8;
  const bf16_t* kp = Hh + (rowbase + srow) * NPAD + A_K + kvh * 64 + sch;
  const bf16_t* vp = VT + ((size_t)((bl * 2 + kvh) * 64 + srow)) * SEQ + sch;
  uint4 rk = *(const uint4*)kp, rv = *(const uint4*)vp;
  *(uint4*)(smem + srow * 144 + sch * 2) = rk;
  *(uint4*)(smem + 9216 + srow * 144 + sch * 2) = rv;
  __syncthreads();
  for (int kt = 0; kt < SEQ / 64; ++kt) {
    if (kt + 1 < SEQ / 64) { rk = *(const uint4*)(kp + (size_t)(kt + 1) * 64 * NPAD); rv = *(const uint4*)(vp + (kt + 1) * 64); }
    const bf16_t* sK = (const bf16_t*)(smem + (kt & 1) * 18432);
    const bf16_t* sV = (const bf16_t*)(smem + (kt & 1) * 18432 + 9216);
    f32x16 s0 = zero16(), s1 = zero16();
#pragma unroll
    for (int ks = 0; ks < 4; ++ks) {
      const bf16x8 a0 = *(const bf16x8*)(sK + r * 72 + ks * 16 + 8 * h);
      const bf16x8 a1 = *(const bf16x8*)(sK + (32 + r) * 72 + ks * 16 + 8 * h);
      s0 = __builtin_amdgcn_mfma_f32_32x32x16_bf16(a0, qf[ks], s0, 0, 0, 0);
      s1 = __builtin_amdgcn_mfma_f32_32x32x16_bf16(a1, qf[ks], s1, 0, 0, 0);
    }
#pragma unroll
    for (int i = 0; i < 16; ++i) { s0[i] = __builtin_amdgcn_exp2f(s0[i] - M2); s1[i] = __builtin_amdgcn_exp2f(s1[i] - M2); lsum += s0[i] + s1[i]; }
    union { bf16x8 v; unsigned u[4]; } pb[2][2];
#pragma unroll
    for (int s = 0; s < 2; ++s)
#pragma unroll
      for (int j = 0; j < 4; ++j) {
        pb[0][s].u[j] = pk2(s0[8 * s + 2 * j], s0[8 * s + 2 * j + 1]);
        pb[1][s].u[j] = pk2(s1[8 * s + 2 * j], s1[8 * s + 2 * j + 1]);
      }
#pragma unroll
    for (int kt2 = 0; kt2 < 2; ++kt2)
#pragma unroll
      for (int s = 0; s < 2; ++s) {
        const int kb = kt2 * 32 + 16 * s + 4 * h;
        union { bf16x8 v; uint2 u[2]; } a0, a1;
        a0.u[0] = *(const uint2*)(sV + r * 72 + kb); a0.u[1] = *(const uint2*)(sV + r * 72 + kb + 8);
        a1.u[0] = *(const uint2*)(sV + (32 + r) * 72 + kb); a1.u[1] = *(const uint2*)(sV + (32 + r) * 72 + kb + 8);
        o0 = __builtin_amdgcn_mfma_f32_32x32x16_bf16(a0.v, pb[kt2][s].v, o0, 0, 0, 0);
        o1 = __builtin_amdgcn_mfma_f32_32x32x16_bf16(a1.v, pb[kt2][s].v, o1, 0, 0, 0);
      }
    if (kt + 1 < SEQ / 64) {
      unsigned char* base = smem + ((kt + 1) & 1) * 18432;
      *(uint4*)(base + srow * 144 + sch * 2) = rk;
      *(uint4*)(base + 9216 + srow * 144 + sch * 2) = rv;
    }
    __syncthreads();
  }
  lsum += __shfl_xor(lsum, 32);
  const float inv = 1.f / lsum;
  const bf16_t* zp = Hh + (rowbase + qrow) * NPAD + A_Z + head * 64;
  bf16_t* op = MX + (rowbase + qrow) * DI + head * 64;
#pragma unroll
  for (int dt = 0; dt < 2; ++dt)
#pragma unroll
    for (int g = 0; g < 4; ++g) {
      const int d0 = dt * 32 + 8 * g + 4 * h;
      const uint2 zz = *(const uint2*)(zp + d0);
      const float z0 = bf2f((bf16_t)(zz.x & 0xffff)), z1 = bf2f((bf16_t)(zz.x >> 16)), z2 = bf2f((bf16_t)(zz.y & 0xffff)), z3 = bf2f((bf16_t)(zz.y >> 16));
      const f32x16& oo = dt ? o1 : o0;
      uint2 ov;
      ov.x = pk2(oo[4 * g + 0] * inv * fsilu(z0), oo[4 * g + 1] * inv * fsilu(z1));
      ov.y = pk2(oo[4 * g + 2] * inv * fsilu(z2), oo[4 * g + 3] * inv * fsilu(z3));
      *(uint2*)(op + d0) = ov;
    }
  __syncthreads();
}

constexpr int L_QT = 0, L_KT = 17408, L_QC = 34816, L_KHT = 52224, L_VT = 70656, L_P = 89088, L_ST = 98304, L_RAW = 89088,
              L_D = 138240, L_TOT = 138752, L_ACS = 142848, L_DT = 143104, L_LOW = 143360;

template <int K, int V> struct ScanGeom {
  static constexpr int KP = K + 8;
  static constexpr int NS = (K / 32) * (V / 32) / 8;
};

template <int K, int V>
DEV void scan_write_state(unsigned char* smem, const f32x16* S, int w, int lane) {
  constexpr int KP = K + 8, NS = ScanGeom<K, V>::NS, NVT = V / 32;
  bf16_t* sST = (bf16_t*)(smem + L_ST);
  const int c = lane & 31, h = lane >> 5;
#pragma unroll
  for (int i = 0; i < NS; ++i) {
    const int tile = w * NS + i, kt = tile / NVT, nt = tile % NVT;
#pragma unroll
    for (int g = 0; g < 4; ++g) {
      uint2 o; o.x = pk2(S[i][4 * g + 0], S[i][4 * g + 1]); o.y = pk2(S[i][4 * g + 2], S[i][4 * g + 3]);
      *(uint2*)(sST + (nt * 32 + c) * KP + kt * 32 + 8 * g + 4 * h) = o;
    }
  }
}

template <int K, int V, bool SSDM>
DEV void scan_core(unsigned char* smem, f32x16* S, bf16_t* orow0, int dir, int w, int lane) {
  constexpr int KP = K + 8, NS = ScanGeom<K, V>::NS, NVT = V / 32, NOT = 2 * NVT;
  const bf16_t* sQt = (const bf16_t*)(smem + L_QT); const bf16_t* sKt = (const bf16_t*)(smem + L_KT);
  const bf16_t* sQc = (const bf16_t*)(smem + L_QC); const bf16_t* sKhT = (const bf16_t*)(smem + L_KHT);
  const bf16_t* sVT = (const bf16_t*)(smem + L_VT); bf16_t* sP = (bf16_t*)(smem + L_P);
  const bf16_t* sST = (const bf16_t*)(smem + L_ST); const float* sD = (const float*)(smem + L_D);
  const float* sAcs = (const float*)(smem + L_ACS);
  const int c = lane & 31, h = lane >> 5;
  scan_write_state<K, V>(smem, S, w, lane);
  if (w < 4) {
    const int tt = w >> 1, st = w & 1;
    f32x16 acc = zero16();
    if (st <= tt) mma32<K>(acc, sQt + tt * 32 * KP, KP, sKt + st * 32 * KP, KP, lane);
#pragma unroll
    for (int reg = 0; reg < 16; ++reg) {
      const int tau = tt * 32 + rowoff(reg, h), sig = st * 32 + c;
      float v = 0.f;
      if (sig <= tau) { v = acc[reg]; if (SSDM) v *= __expf(sAcs[tau] - sAcs[sig]); }
      sP[tau * 72 + sig] = f2bf(v);
    }
  }
  __syncthreads();
  if (w < NOT) {
    const int tt = w / NVT, nt = w % NVT;
    f32x16 acc = zero16();
    mma32<64>(acc, sP + tt * 32 * 72, 72, sVT + nt * 32 * 72, 72, lane);
    mma32<K>(acc, sQc + tt * 32 * KP, KP, sST + nt * 32 * KP, KP, lane);
#pragma unroll
    for (int reg = 0; reg < 16; ++reg) {
      const int tau = tt * 32 + rowoff(reg, h);
      const int tok = dir ? (63 - tau) : tau;
      orow0[(size_t)tok * 512 + nt * 32 + c] = f2bf(acc[reg]);
    }
  }
#pragma unroll
  for (int i = 0; i < NS; ++i) {
    const int tile = w * NS + i, kt = tile / NVT, nt = tile % NVT;
#pragma unroll
    for (int reg = 0; reg < 16; ++reg) S[i][reg] *= sD[kt * 32 + rowoff(reg, h)];
    mma32<64>(S[i], sKhT + kt * 32 * 72, 72, sVT + nt * 32 * 72, 72, lane);
  }
  __syncthreads();
}

DEV void store16(bf16_t* dst, const float* v) {
  uint4 a, b;
  a.x = pk2(v[0], v[1]); a.y = pk2(v[2], v[3]); a.z = pk2(v[4], v[5]); a.w = pk2(v[6], v[7]);
  b.x = pk2(v[8], v[9]); b.y = pk2(v[10], v[11]); b.z = pk2(v[12], v[13]); b.w = pk2(v[14], v[15]);
  ((uint4*)dst)[0] = a; ((uint4*)dst)[1] = b;
}
DEV void gather16(bf16_t* dst, const bf16_t* src, int stride) {
  unsigned u[8];
#pragma unroll
  for (int i = 0; i < 8; ++i) u[i] = (unsigned)src[(2 * i) * stride] | ((unsigned)src[(2 * i + 1) * stride] << 16);
  ((uint4*)dst)[0] = make_uint4(u[0], u[1], u[2], u[3]); ((uint4*)dst)[1] = make_uint4(u[4], u[5], u[6], u[7]);
}

DEV void hgrn_item(const Params& p, int l, int bl, int head, int dir, unsigned char* smem) {
  constexpr int K = 128, V = 128, KP = 136;
  const int tid = launder(threadIdx.x), lane = tid & 63, w = tid >> 6;
  const int ch = tid & 127, qd = tid >> 7;
  const bf16_t* Hh = (const bf16_t*)(p.ws + OFF_H);
  bf16_t* OB = (bf16_t*)(p.ws + OFF_OBUF) + (size_t)(0 * 2 + dir) * TH * 512;
  const size_t rowbase = (size_t)bl * SEQ;
  float lbv = 0.f;
  if (l > 0) lbv = fsigmoid(p.lb_logits[512 + head * 128 + ch] - p.lb_logits[head * 128 + ch]);
  const int fbase = dir ? H_FB : H_FF;
  bf16_t* sQt = (bf16_t*)(smem + L_QT); bf16_t* sKt = (bf16_t*)(smem + L_KT); bf16_t* sQc = (bf16_t*)(smem + L_QC);
  bf16_t* sKhT = (bf16_t*)(smem + L_KHT); bf16_t* sVT = (bf16_t*)(smem + L_VT);
  float* sD = (float*)(smem + L_D); float* sTot = (float*)(smem + L_TOT);
  const bf16_t* rawQ = (const bf16_t*)(smem + L_RAW); const bf16_t* rawF = rawQ + 8192; const bf16_t* rawV = rawQ + 16384;
  f32x16 S[2]; S[0] = zero16(); S[1] = zero16();
  u32x4 pre[6];
  const int prow0 = tid >> 4, pc16 = (tid & 15) * 8;
  auto gload = [&](int cidx) __attribute__((always_inline)) {
    const int chunk = dir ? (63 - cidx) : cidx;
#pragma unroll
    for (int j = 0; j < 2; ++j) {
      const int row = prow0 + 32 * j;
      const int tok = chunk * 64 + (dir ? (63 - row) : row);
      const bf16_t* rp = Hh + (rowbase + tok) * NPAD + head * 128 + pc16;
      pre[j] = *(const u32x4*)(rp + H_Q); pre[2 + j] = *(const u32x4*)(rp + fbase); pre[4 + j] = *(const u32x4*)(rp + H_I);
    }
  };
  gload(0);
  for (int cidx = 0; cidx < 64; ++cidx) {
    const int chunk = dir ? (63 - cidx) : cidx;
#pragma unroll
    for (int j = 0; j < 2; ++j) {
      unsigned char* d = smem + L_RAW + (prow0 + 32 * j) * 256 + pc16 * 2;
      *(u32x4*)d = pre[j]; *(u32x4*)(d + 16384) = pre[2 + j]; *(u32x4*)(d + 32768) = pre[4 + j];
    }
    __syncthreads();
    if (cidx + 1 < 64) gload(cidx + 1);
    float run = 0.f;
#pragma unroll 1
    for (int i0 = 0; i0 < 16; i0 += 4) {
#pragma unroll
      for (int ii = 0; ii < 4; ++ii) {
        const float f = bf2f(rawF[(16 * qd + i0 + ii) * 128 + ch]);
        const float sg = 1.f / (1.f + __expf(-f));
        run += __logf(lbv + (1.f - lbv) * sg);
      }
    }
    sTot[qd * 128 + ch] = run;
    __syncthreads();
    const float t0 = sTot[ch], t1 = sTot[128 + ch], t2 = sTot[256 + ch], t3 = sTot[384 + ch];
    const float off = (qd > 0 ? t0 : 0.f) + (qd > 1 ? t1 : 0.f) + (qd > 2 ? t2 : 0.f);
    const float ref = t0 + t1, bend = (t0 + t1) + (t2 + t3);
    float b = off;
#pragma unroll 1
    for (int i0 = 0; i0 < 16; i0 += 4) {
      float kh4[4]; unsigned vb[4];
#pragma unroll
      for (int ii = 0; ii < 4; ++ii) {
        const int tau = 16 * qd + i0 + ii;
        const float f = bf2f(rawF[tau * 128 + ch]);
        const float sg = 1.f / (1.f + __expf(-f));
        b += __logf(lbv + (1.f - lbv) * sg);
        const float kx = (1.f - lbv) / (1.f + __expf(f));
        const float qr = bf2f(rawQ[tau * 128 + ch]);
        const float qx = qr * (1.f / (1.f + __expf(-qr))) * 0.08838834764831845f;
        sQt[tau * KP + ch] = f2bf(qx * __expf(b - ref));
        sKt[tau * KP + ch] = f2bf(kx * __expf(ref - b));
        sQc[tau * KP + ch] = f2bf(qx * __expf(b));
        kh4[ii] = kx * __expf(bend - b);
        vb[ii] = rawV[tau * 128 + ch];
      }
      uint2 o; o.x = pk2(kh4[0], kh4[1]); o.y = pk2(kh4[2], kh4[3]);
      *(uint2*)(sKhT + ch * 72 + 16 * qd + i0) = o;
      uint2 ov; ov.x = vb[0] | (vb[1] << 16); ov.y = vb[2] | (vb[3] << 16);
      *(uint2*)(sVT + ch * 72 + 16 * qd + i0) = ov;
    }
    if (qd == 0) sD[ch] = __expf(bend);
    __syncthreads();
    scan_core<K, V, false>(smem, S, OB + (rowbase + (size_t)chunk * 64) * 512 + head * 128, dir, w, lane);
  }
}

DEV void gla_item(const Params& p, int l, int bl, int head, int dir, unsigned char* smem) {
  constexpr int K = 64, V = 128, KP = 72;
  const int tid = launder(threadIdx.x), lane = tid & 63, w = tid >> 6;
  const int ch = tid & 63, oc = tid >> 6;
  const int vn = tid & 127, vq = tid >> 7;
  const bf16_t* Hh = (const bf16_t*)(p.ws + OFF_H);
  const float* SMALL = (const float*)(p.ws + OFF_SMALL);
  bf16_t* OB = (bf16_t*)(p.ws + OFF_OBUF) + (size_t)(2 * 2 + dir) * TH * 512;
  const size_t rowbase = (size_t)bl * SEQ;
  bf16_t* sQt = (bf16_t*)(smem + L_QT); bf16_t* sKt = (bf16_t*)(smem + L_KT); bf16_t* sQc = (bf16_t*)(smem + L_QC);
  bf16_t* sKhT = (bf16_t*)(smem + L_KHT); bf16_t* sVT = (bf16_t*)(smem + L_VT);
  float* sD = (float*)(smem + L_D); float* sTot = (float*)(smem + L_TOT); float* sLow = (float*)(smem + L_LOW);
  const bf16_t* rawQ = (const bf16_t*)(smem + L_RAW); const bf16_t* rawK = rawQ + 4096; const bf16_t* rawV = rawQ + 8192;
  float w2c[16];
#pragma unroll
  for (int r = 0; r < 16; ++r) w2c[r] = p.gk_w2[((size_t)(l * 2 + dir) * 16 + r) * 256 + head * 64 + ch];
  const float gb = p.gk_b[(l * 2 + dir) * 256 + head * 64 + ch];
  f32x16 S[1]; S[0] = zero16();
  u32x4 pre[4];
  float plow0, plow1;
  const int qrow = tid >> 3, qc8 = (tid & 7) * 8, vrow0 = tid >> 4, vc16 = (tid & 15) * 8;
  auto gload = [&](int cidx) __attribute__((always_inline)) {
    const int chunk = dir ? (63 - cidx) : cidx;
    {
      const int tok = chunk * 64 + (dir ? (63 - qrow) : qrow);
      const bf16_t* rp = Hh + (rowbase + tok) * NPAD + head * 64 + qc8;
      pre[0] = *(const u32x4*)(rp + G_Q); pre[1] = *(const u32x4*)(rp + G_K);
      { const float* lp = SMALL + (rowbase + tok) * 48 + 16 + dir * 16 + (tid & 7) * 2; plow0 = lp[0]; plow1 = lp[1]; }
    }
#pragma unroll
    for (int j = 0; j < 2; ++j) {
      const int row = vrow0 + 32 * j;
      const int tok = chunk * 64 + (dir ? (63 - row) : row);
      pre[2 + j] = *(const u32x4*)(Hh + (rowbase + tok) * NPAD + G_V + head * 128 + vc16);
    }
  };
  gload(0);
  for (int cidx = 0; cidx < 64; ++cidx) {
    const int chunk = dir ? (63 - cidx) : cidx;
    {
      unsigned char* d = smem + L_RAW + qrow * 128 + qc8 * 2;
      *(u32x4*)d = pre[0]; *(u32x4*)(d + 8192) = pre[1];
      sLow[qrow * 16 + (tid & 7) * 2] = plow0; sLow[qrow * 16 + (tid & 7) * 2 + 1] = plow1;
#pragma unroll
      for (int j = 0; j < 2; ++j) *(u32x4*)(smem + L_RAW + 16384 + (vrow0 + 32 * j) * 256 + vc16 * 2) = pre[2 + j];
    }
    __syncthreads();
    if (cidx + 1 < 64) gload(cidx + 1);
    float run = 0.f;
#pragma unroll 1
    for (int i = 0; i < 8; ++i) {
      const int tau = 8 * oc + i;
      float gk = gb;
#pragma unroll
      for (int r = 0; r < 16; ++r) gk += sLow[tau * 16 + r] * w2c[r];
      run += (fminf(gk, 0.f) - __logf(1.f + __expf(-fabsf(gk)))) * (1.f / 16.f);
    }
    sTot[oc * 64 + ch] = run;
    __syncthreads();
    float off = 0.f, ref = 0.f, bend = 0.f;
#pragma unroll
    for (int j = 0; j < 8; ++j) { const float t = sTot[j * 64 + ch]; if (j < oc) off += t; if (j < 4) ref += t; bend += t; }
    float b = off;
#pragma unroll 1
    for (int i0 = 0; i0 < 8; i0 += 4) {
      float kh4[4];
#pragma unroll
      for (int ii = 0; ii < 4; ++ii) {
        const int tau = 8 * oc + i0 + ii;
        float gk = gb;
#pragma unroll
        for (int r = 0; r < 16; ++r) gk += sLow[tau * 16 + r] * w2c[r];
        b += (fminf(gk, 0.f) - __logf(1.f + __expf(-fabsf(gk)))) * (1.f / 16.f);
        const float qx = bf2f(rawQ[tau * 64 + ch]) * 0.125f, kx = bf2f(rawK[tau * 64 + ch]);
        sQt[tau * KP + ch] = f2bf(qx * __expf(b - ref));
        sKt[tau * KP + ch] = f2bf(kx * __expf(ref - b));
        sQc[tau * KP + ch] = f2bf(qx * __expf(b));
        kh4[ii] = kx * __expf(bend - b);
      }
      uint2 o; o.x = pk2(kh4[0], kh4[1]); o.y = pk2(kh4[2], kh4[3]);
      *(uint2*)(sKhT + ch * 72 + 8 * oc + i0) = o;
    }
#pragma unroll 1
    for (int i0 = 0; i0 < 16; i0 += 4) {
      unsigned vb[4];
#pragma unroll
      for (int ii = 0; ii < 4; ++ii) vb[ii] = rawV[(16 * vq + i0 + ii) * 128 + vn];
      uint2 ov; ov.x = vb[0] | (vb[1] << 16); ov.y = vb[2] | (vb[3] << 16);
      *(uint2*)(sVT + vn * 72 + 16 * vq + i0) = ov;
    }
    if (oc == 0) sD[ch] = __expf(bend);
    __syncthreads();
    scan_core<K, V, false>(smem, S, OB + (rowbase + (size_t)chunk * 64) * 512 + head * 128, dir, w, lane);
  }
}

DEV void ssd_item(const Params& p, int l, int bl, int head, int dir, unsigned char* smem) {
  constexpr int K = 128, V = 64, KP = 136;
  const int tid = launder(threadIdx.x), lane = tid & 63, w = tid >> 6;
  const int n = tid & 127, qd = tid >> 7;
  const int pp = tid & 63, oc = tid >> 6;
  const int grp = head >> 2;
  const bf16_t* Hh = (const bf16_t*)(p.ws + OFF_H);
  const float* SMALL = (const float*)(p.ws + OFF_SMALL);
  bf16_t* OB = (bf16_t*)(p.ws + OFF_OBUF) + (size_t)(1 * 2 + dir) * TH * 512;
  const size_t rowbase = (size_t)bl * SEQ;
  bf16_t* sQt = (bf16_t*)(smem + L_QT); bf16_t* sKt = (bf16_t*)(smem + L_KT); bf16_t* sQc = (bf16_t*)(smem + L_QC);
  bf16_t* sKhT = (bf16_t*)(smem + L_KHT); bf16_t* sVT = (bf16_t*)(smem + L_VT);
  float* sD = (float*)(smem + L_D); float* sAcs = (float*)(smem + L_ACS); float* sDt = (float*)(smem + L_DT);
  const bf16_t* rawB = (const bf16_t*)(smem + L_RAW); const bf16_t* rawC = rawB + 68 * 128; const bf16_t* rawX = rawB + 2 * 68 * 128;
  const int chB = 512 + grp * 128 + n, chC = 768 + grp * 128 + n, chX = head * 64 + pp;
  const float* cw = p.conv_w + (size_t)l * 5 * 1024; const float* cb = p.conv_b + (size_t)l * 1024;
  float wB[5], wC[5], wX[5];
#pragma unroll
  for (int j = 0; j < 5; ++j) { wB[j] = cw[j * 1024 + chB]; wC[j] = cw[j * 1024 + chC]; wX[j] = cw[j * 1024 + chX]; }
  const float bB = cb[chB], bC = cb[chC], bX = cb[chX];
  const float dtb = p.dt_bias[(l * 2 + dir) * 8 + head];
  const float Acoef = -__expf(p.a_log[(l * 2 + dir) * 8 + head]);
  f32x16 S[1]; S[0] = zero16();
  u32x4 pre[6];
  float rdt = 0.f;
  auto decode = [&](int id, int& row, int& gcol, int& loff) __attribute__((always_inline)) {
    if (id < 1088) { row = id >> 4; gcol = S_X + 512 + grp * 128 + (id & 15) * 8; loff = row * 256 + (id & 15) * 16; }
    else if (id < 2176) { const int i2 = id - 1088; row = i2 >> 4; gcol = S_X + 768 + grp * 128 + (i2 & 15) * 8; loff = 17408 + row * 256 + (i2 & 15) * 16; }
    else { const int i2 = id - 2176; row = i2 >> 3; gcol = S_X + head * 64 + (i2 & 7) * 8; loff = 34816 + row * 128 + (i2 & 7) * 16; }
  };
  auto gload = [&](int cidx) __attribute__((always_inline)) {
    const int chunk = dir ? (63 - cidx) : cidx;
#pragma unroll
    for (int j = 0; j < 6; ++j) {
      const int id = tid + 512 * j;
      pre[j] = (u32x4){0u, 0u, 0u, 0u};
      if (id < 2720) {
        int row, gcol, loff; decode(id, row, gcol, loff);
        const int s = chunk * 64 + row - 2;
        if (s >= 0 && s < SEQ) pre[j] = *(const u32x4*)(Hh + (rowbase + s) * NPAD + gcol);
      }
    }
    if (w == 0) {
      const int tok = chunk * 64 + (dir ? (63 - lane) : lane);
      rdt = SMALL[(rowbase + tok) * 48 + dir * 8 + head];
    }
  };
  gload(0);
  for (int cidx = 0; cidx < 64; ++cidx) {
    const int chunk = dir ? (63 - cidx) : cidx;
#pragma unroll
    for (int j = 0; j < 6; ++j) {
      const int id = tid + 512 * j;
      if (id < 2720) { int row, gcol, loff; decode(id, row, gcol, loff); *(u32x4*)(smem + L_RAW + loff) = pre[j]; }
    }
    if (w == 0) {
      const float xx = rdt + dtb;
      const float dt = (xx > 20.f) ? xx : log1pf(__expf(xx));
      float a = dt * Acoef;
#pragma unroll
      for (int o = 1; o < 64; o <<= 1) { const float t = __shfl_up(a, o); if (lane >= o) a += t; }
      sAcs[lane] = a; sDt[lane] = dt;
    }
    __syncthreads();
    if (cidx + 1 < 64) gload(cidx + 1);
    const float aend = sAcs[63];
#pragma unroll 1
    for (int i0 = 0; i0 < 16; i0 += 4) {
      float kh4[4];
#pragma unroll
      for (int ii = 0; ii < 4; ++ii) {
        const int tau = 16 * qd + i0 + ii;
        const int tl = dir ? (63 - tau) : tau;
        float uB = bB, uC = bC;
#pragma unroll
        for (int j = 0; j < 5; ++j) { uB += wB[j] * bf2f(rawB[(tl + j) * 128 + n]); uC += wC[j] * bf2f(rawC[(tl + j) * 128 + n]); }
        uB = fsilu(uB); uC = fsilu(uC);
        const float ac = sAcs[tau];
        sQt[tau * KP + n] = f2bf(uC);
        sKt[tau * KP + n] = f2bf(uB);
        sQc[tau * KP + n] = f2bf(uC * __expf(ac));
        kh4[ii] = uB * __expf(aend - ac);
      }
      uint2 o; o.x = pk2(kh4[0], kh4[1]); o.y = pk2(kh4[2], kh4[3]);
      *(uint2*)(sKhT + n * 72 + 16 * qd + i0) = o;
    }
#pragma unroll 1
    for (int i0 = 0; i0 < 8; i0 += 4) {
      float xv[4];
#pragma unroll
      for (int ii = 0; ii < 4; ++ii) {
        const int tau = 8 * oc + i0 + ii;
        const int tl = dir ? (63 - tau) : tau;
        float u = bX;
#pragma unroll
        for (int j = 0; j < 5; ++j) u += wX[j] * bf2f(rawX[(tl + j) * 64 + pp]);
        xv[ii] = fsilu(u) * sDt[tau];
      }
      uint2 o; o.x = pk2(xv[0], xv[1]); o.y = pk2(xv[2], xv[3]);
      *(uint2*)(sVT + pp * 72 + 8 * oc + i0) = o;
    }
    if (qd == 0) sD[n] = __expf(aend);
    __syncthreads();
    scan_core<K, V, true>(smem, S, OB + (rowbase + (size_t)chunk * 64) * 512 + head * 64, dir, w, lane);
  }
}

DEV void phase_mix(const Params& p, int l, int hf, int phase, unsigned char* smem) {
  unsigned* ctr = (unsigned*)(p.ws + OFF_CTRL) + CTR_WORD0 + phase * 16;
  volatile int* sItem = (volatile int*)(smem + LDS_BYTES - 16);
  const int n_items = 64 + 256;
  for (;;) {
    __syncthreads();
    if (threadIdx.x == 0) *sItem = (int)atomicAdd(ctr, 1u);
    __syncthreads();
    const int it = *sItem;
    if (it >= n_items) break;
    if (it < 16) { if (PH_MASK & 0x100) hgrn_item(p, l, it >> 3, (it >> 1) & 3, it & 1, smem); }
    else if (it < 32) { const int j = it - 16; if (PH_MASK & 0x200) gla_item(p, l, j >> 3, (j >> 1) & 3, j & 1, smem); }
    else if (it < 64) { const int j = it - 32; if (PH_MASK & 0x400) ssd_item(p, l, j >> 4, (j >> 1) & 7, j & 1, smem); }
    else { if (PH_MASK & 0x800) attn_item(p, l, it - 64, smem); }
  }
}

DEV void phase_fin(const Params& p, int l, int hf) {
  const int tid = launder(threadIdx.x), lane = tid & 63, w = tid >> 6;
  const bf16_t* Hh = (const bf16_t*)(p.ws + OFF_H);
  const bf16_t* OB = (const bf16_t*)(p.ws + OFF_OBUF);
  bf16_t* MX = (bf16_t*)(p.ws + OFF_MIXED);
  const int c0 = lane * 8;
  const float* cw = p.conv_w + (size_t)l * 5 * 1024; const float* cb = p.conv_b + (size_t)l * 1024;
  for (int r = blockIdx.x * 8 + w; r < TH; r += gridDim.x * 8) {
    const bf16_t* hrow = Hh + (size_t)r * NPAD;
    {
      const uint4 a = *(const uint4*)(OB + ((size_t)0 * TH + r) * 512 + c0), b = *(const uint4*)(OB + ((size_t)1 * TH + r) * 512 + c0);
      const uint4 z = *(const uint4*)(hrow + H_Z + c0);
      const unsigned au[4] = {a.x, a.y, a.z, a.w}, bu[4] = {b.x, b.y, b.z, b.w}, zu[4] = {z.x, z.y, z.z, z.w};
      float o[8]; float ss = 0.f;
#pragma unroll
      for (int j = 0; j < 4; ++j) {
        o[2 * j] = bf2f((bf16_t)(au[j] & 0xffff)) + bf2f((bf16_t)(bu[j] & 0xffff));
        o[2 * j + 1] = bf2f((bf16_t)(au[j] >> 16)) + bf2f((bf16_t)(bu[j] >> 16));
        ss += o[2 * j] * o[2 * j] + o[2 * j + 1] * o[2 * j + 1];
      }
#pragma unroll
      for (int of = 32; of >= 1; of >>= 1) ss += __shfl_xor(ss, of);
      const float rstd = rsqrtf(ss * (1.f / 512.f) + 1e-6f);
      float y[8];
#pragma unroll
      for (int j = 0; j < 8; ++j) {
        const float zz = bf2f((bf16_t)((j & 1) ? (zu[j >> 1] >> 16) : (zu[j >> 1] & 0xffff)));
        y[j] = o[j] * rstd * p.hgrn_norm[l * 512 + c0 + j] * fsilu(zz);
      }
      uint4 ov; ov.x = pk2(y[0], y[1]); ov.y = pk2(y[2], y[3]); ov.z = pk2(y[4], y[5]); ov.w = pk2(y[6], y[7]);
      *(uint4*)(MX + (size_t)r * DI + 512 + c0) = ov;
    }
    {
      const uint4 a = *(const uint4*)(OB + ((size_t)4 * TH + r) * 512 + c0), b = *(const uint4*)(OB + ((size_t)5 * TH + r) * 512 + c0);
      const uint4 z = *(const uint4*)(hrow + G_Z + c0);
      const unsigned au[4] = {a.x, a.y, a.z, a.w}, bu[4] = {b.x, b.y, b.z, b.w}, zu[4] = {z.x, z.y, z.z, z.w};
      float o[8]; float ss = 0.f;
#pragma unroll
      for (int j = 0; j < 4; ++j) {
        o[2 * j] = bf2f((bf16_t)(au[j] & 0xffff)) + bf2f((bf16_t)(bu[j] & 0xffff));
        o[2 * j + 1] = bf2f((bf16_t)(au[j] >> 16)) + bf2f((bf16_t)(bu[j] >> 16));
        ss += o[2 * j] * o[2 * j] + o[2 * j + 1] * o[2 * j + 1];
      }
#pragma unroll
      for (int of = 8; of >= 1; of >>= 1) ss += __shfl_xor(ss, of);
      const float rstd = rsqrtf(ss * (1.f / 128.f) + 1e-6f);
      float y[8];
#pragma unroll
      for (int j = 0; j < 8; ++j) {
        const float zz = bf2f((bf16_t)((j & 1) ? (zu[j >> 1] >> 16) : (zu[j >> 1] & 0xffff)));
        y[j] = o[j] * rstd * p.gla_norm[l * 128 + ((c0 + j) & 127)] * fsilu(zz);
      }
      uint4 ov; ov.x = pk2(y[0], y[1]); ov.y = pk2(y[2], y[3]); ov.z = pk2(y[4], y[5]); ov.w = pk2(y[6], y[7]);
      *(uint4*)(MX + (size_t)r * DI + 1536 + c0) = ov;
    }
    {
      const uint4 a = *(const uint4*)(OB + ((size_t)2 * TH + r) * 512 + c0), b = *(const uint4*)(OB + ((size_t)3 * TH + r) * 512 + c0);
      const uint4 z = *(const uint4*)(hrow + S_Z + c0);
      const unsigned au[4] = {a.x, a.y, a.z, a.w}, bu[4] = {b.x, b.y, b.z, b.w}, zu[4] = {z.x, z.y, z.z, z.w};
      float u[8];
#pragma unroll
      for (int j = 0; j < 8; ++j) u[j] = cb[c0 + j];
      const int t = r & (SEQ - 1);
#pragma unroll
      for (int jj = 0; jj < 5; ++jj) {
        const int s = t + jj - 2;
        if (s >= 0 && s < SEQ) {
          const uint4 xr = *(const uint4*)(Hh + (size_t)(r + jj - 2) * NPAD + S_X + c0);
          const unsigned xu[4] = {xr.x, xr.y, xr.z, xr.w};
#pragma unroll
          for (int j = 0; j < 8; ++j) {
            const float xv = bf2f((bf16_t)((j & 1) ? (xu[j >> 1] >> 16) : (xu[j >> 1] & 0xffff)));
            u[j] += cw[jj * 1024 + c0 + j] * xv;
          }
        }
      }
      const float dsk = p.ssd_d[l * 8 + (c0 >> 6)];
      float y[8]; float ss = 0.f;
#pragma unroll
      for (int j = 0; j < 8; ++j) {
        const float of = bf2f((bf16_t)((j & 1) ? (au[j >> 1] >> 16) : (au[j >> 1] & 0xffff)));
        const float ob = bf2f((bf16_t)((j & 1) ? (bu[j >> 1] >> 16) : (bu[j >> 1] & 0xffff)));
        const float zz = bf2f((bf16_t)((j & 1) ? (zu[j >> 1] >> 16) : (zu[j >> 1] & 0xffff)));
        y[j] = (of + ob + dsk * fsilu(u[j])) * fsilu(zz);
        ss += y[j] * y[j];
      }
#pragma unroll
      for (int of = 32; of >= 1; of >>= 1) ss += __shfl_xor(ss, of);
      const float rstd = rsqrtf(ss * (1.f / 512.f) + 1e-6f);
#pragma unroll
      for (int j = 0; j < 8; ++j) y[j] = y[j] * rstd * p.ssd_norm[l * 512 + c0 + j];
      uint4 ov; ov.x = pk2(y[0], y[1]); ov.y = pk2(y[2], y[3]); ov.z = pk2(y[4], y[5]); ov.w = pk2(y[6], y[7]);
      *(uint4*)(MX + (size_t)r * DI + 1024 + c0) = ov;
    }
  }
}

__global__ void __launch_bounds__(NT) mega(Params p) {
  extern __shared__ __attribute__((aligned(16))) unsigned char smem[];
  for (int ph = p.phase_begin; ph < p.phase_end; ++ph) {
    if (ph == 0) { if (PH_MASK & 1) phase_pro(p, smem); }
    else {
      const int q = ph - 1, l = q / 10, hf = (q / 5) & 1, st = q % 5;
      if (st == 0) { if (PH_MASK & 2) phase_inproj(p, l, hf, smem); }
      else if (st == 1) { if (PH_MASK & 0xF00) phase_mix(p, l, hf, ph, smem); }
      else if (st == 2) { if (PH_MASK & 8) phase_fin(p, l, hf); }
      else if (st == 3) { if (PH_MASK & 16) phase_outproj(p, l, hf, smem); }
      else {
        if (PH_MASK & 32) phase_ln(p, l, hf);
        if ((PH_MASK & 1) && l == 0 && hf == 1) convert_weights(p, 1, smem);
      }
    }
#if ONE_LAUNCH
    if (ph + 1 < p.phase_end) cg::this_grid().sync();
#endif
  }
}

extern "C" void kernel_launch(void* const* d_in, const int* in_sizes, int n_in, void* d_out, int out_size, void* d_ws, size_t ws_size,
                              hipStream_t stream) {
  static int grid_blocks = 0;
  if (!grid_blocks) {
    int dev = 0, cus = 0, per_cu = 0;
    hipGetDevice(&dev);
    hipDeviceGetAttribute(&cus, hipDeviceAttributeMultiprocessorCount, dev);
    hipFuncSetAttribute((const void*)mega, hipFuncAttributeMaxDynamicSharedMemorySize, LDS_BYTES);
    hipOccupancyMaxActiveBlocksPerMultiprocessor(&per_cu, mega, NT, LDS_BYTES);
    if (per_cu < 1) per_cu = 1;
    grid_blocks = cus;
  }
  Params p{};
  p.x = (const float*)d_in[0]; p.w_in = (const float*)d_in[1]; p.q_gain = (const float*)d_in[2]; p.k_gain = (const float*)d_in[3];
  p.lb_logits = (const float*)d_in[4]; p.hgrn_norm = (const float*)d_in[5]; p.conv_w = (const float*)d_in[6]; p.conv_b = (const float*)d_in[7];
  p.dt_bias = (const float*)d_in[8]; p.a_log = (const float*)d_in[9]; p.ssd_d = (const float*)d_in[10]; p.ssd_norm = (const float*)d_in[11];
  p.gk_w2 = (const float*)d_in[12]; p.gk_b = (const float*)d_in[13]; p.gla_norm = (const float*)d_in[14]; p.w_out = (const float*)d_in[15];
  p.ln_g = (const float*)d_in[16]; p.ln_b = (const float*)d_in[17];
  p.out = (float*)d_out; p.ws = (unsigned char*)d_ws;
  hipMemsetAsync(d_ws, 0, CTRL_BYTES, stream);
#if ONE_LAUNCH
  p.phase_begin = 0; p.phase_end = NPHASE;
  void* args[] = {&p};
  hipError_t e = hipLaunchCooperativeKernel((const void*)mega, dim3(grid_blocks), dim3(NT), args, LDS_BYTES, stream);
  if (e != hipSuccess) fprintf(stderr, "cooperative launch failed: %s (grid %d)\n", hipGetErrorString(e), grid_blocks);
#else
  for (int ph = 0; ph < NPHASE; ++ph) {
    p.phase_begin = ph; p.phase_end = ph + 1;
    hipLaunchKernelGGL(mega, dim3(grid_blocks), dim3(NT), LDS_BYTES, stream, p);
  }
#endif
}
```

```cpp
#include <hip/hip_runtime.h>
#include <hip/hip_cooperative_groups.h>
#include <stdint.h>
#include <stdio.h>
namespace cg = cooperative_groups;

#ifndef ONE_LAUNCH
#define ONE_LAUNCH 1
#endif

#ifndef PH_MASK
#define PH_MASK 0xFFF
#endif
#define DEV __device__ __forceinline__
typedef unsigned short bf16_t;
typedef short bf16x8 __attribute__((ext_vector_type(8)));
typedef float f32x16 __attribute__((ext_vector_type(16)));
typedef unsigned u32x4 __attribute__((ext_vector_type(4)));

constexpr int NT = 512;
constexpr int T_ALL = 16384, TH = 8192, SEQ = 4096, DM = 1024, NPAD = 7168, DI = 2048, NIN = 6960;
constexpr int A_Q = 0, A_K = 512, A_V = 640, A_Z = 768, H_Q = 1280, H_FF = 1792, H_FB = 2304, H_I = 2816, H_Z = 3328,
              S_X = 3840, S_Z = 4864, G_Q = 5376, G_K = 5632, G_V = 5888, G_Z = 6400, SM0 = 6912;
constexpr size_t OFF_CTRL = 0, OFF_TAB = 65536, OFF_XB = 131072;
constexpr size_t OFF_WIN = OFF_XB + (size_t)T_ALL * DM * 2;
constexpr size_t OFF_WOUT = OFF_WIN + (size_t)NPAD * DM * 2;
constexpr size_t OFF_H = OFF_WOUT + (size_t)DM * DI * 2;
constexpr size_t OFF_SMALL = OFF_H + (size_t)TH * NPAD * 2;
constexpr size_t OFF_MIXED = OFF_SMALL + (size_t)TH * 48 * 4;
constexpr size_t OFF_OBUF = OFF_MIXED + (size_t)TH * DI * 2;
constexpr size_t OFF_VT = OFF_OBUF + (size_t)6 * TH * 512 * 2;
constexpr size_t WS_END = OFF_VT + (size_t)2 * 2 * 64 * SEQ * 2;
constexpr size_t CTRL_BYTES = 65536;
constexpr int CTR_WORD0 = 4096;
constexpr int LDS_BYTES = 148480;
constexpr float LOG2E = 1.4426950408889634f;
constexpr float QSCALE = 0.125f * LOG2E;
constexpr float DN_ALPHA = 1.4142135623730951f;
constexpr int NPHASE = 21;

struct Params {
  const float* x; const float* w_in; const float* q_gain; const float* k_gain; const float* lb_logits; const float* hgrn_norm;
  const float* conv_w; const float* conv_b; const float* dt_bias; const float* a_log; const float* ssd_d; const float* ssd_norm;
  const float* gk_w2; const float* gk_b; const float* gla_norm; const float* w_out; const float* ln_g; const float* ln_b;
  float* out; unsigned char* ws;
  int phase_begin, phase_end;
};

DEV int launder(int v) { asm volatile("" : "+v"(v)); return v; }
DEV float bf2f(bf16_t v) { return __uint_as_float(((unsigned)v) << 16); }
DEV bf16_t f2bf(float f) { unsigned u = __float_as_uint(f); u += 0x7fffu + ((u >> 16) & 1u); return (bf16_t)(u >> 16); }
DEV unsigned pk2(float lo, float hi) { return (unsigned)f2bf(lo) | ((unsigned)f2bf(hi) << 16); }
DEV float fsigmoid(float x) { return 1.f / (1.f + __expf(-x)); }
DEV float fsilu(float x) { return x / (1.f + __expf(-x)); }
DEV int rowoff(int reg, int h) { return (reg & 3) + 8 * (reg >> 2) + 4 * h; }
DEV f32x16 zero16() { f32x16 z;
#pragma unroll
  for (int i = 0; i < 16; ++i) z[i] = 0.f; return z; }

template <int KD>
DEV void mma32(f32x16& acc, const bf16_t* a, int lda, const bf16_t* b, int ldb, int lane) {
  const int r = lane & 31, h = lane >> 5;
  const bf16_t* ap = a + r * lda + 8 * h;
  const bf16_t* bp = b + r * ldb + 8 * h;
#pragma unroll
  for (int k = 0; k < KD; k += 16) {
    bf16x8 av = *(const bf16x8*)(ap + k);
    bf16x8 bv = *(const bf16x8*)(bp + k);
    acc = __builtin_amdgcn_mfma_f32_32x32x16_bf16(av, bv, acc, 0, 0, 0);
  }
}

DEV int orig_col(int n) {
  if (n < 4864) return n;
  if (n < 6400) return n + 16;
  if (n < 6912) return n + 48;
  if (n < 6928) return n - 2048;
  if (n < 6960) return n - 512;
  return -1;
}

DEV void convert_weights(const Params& p, int l, unsigned char* smem) {
  float* s = (float*)smem;
  const int tid = launder(threadIdx.x);
  const float* win = p.w_in + (size_t)l * DM * NIN;
  const float* wout = p.w_out + (size_t)l * DI * DM;
  bf16_t* wint = (bf16_t*)(p.ws + OFF_WIN);
  bf16_t* woutt = (bf16_t*)(p.ws + OFF_WOUT);
  const int n_in_tiles = (NPAD / 64) * (DM / 64);
  const int n_out_tiles = (DM / 64) * (DI / 64);
  for (int it = blockIdx.x; it < n_in_tiles + n_out_tiles; it += gridDim.x) {
    __syncthreads();
    if (it < n_in_tiles) {
      const int n0 = (it / 16) * 64, k0 = (it % 16) * 64;
#pragma unroll
      for (int e = 0; e < 8; ++e) {
        const int idx = e * NT + tid, kk = idx >> 6, nn = idx & 63;
        const int oc = orig_col(n0 + nn);
        s[kk * 65 + nn] = (oc >= 0) ? win[(size_t)(k0 + kk) * NIN + oc] : 0.f;
      }
      __syncthreads();
      const int n = tid >> 3, kc = (tid & 7) * 8;
      uint4 o;
      o.x = pk2(s[(kc + 0) * 65 + n], s[(kc + 1) * 65 + n]); o.y = pk2(s[(kc + 2) * 65 + n], s[(kc + 3) * 65 + n]);
      o.z = pk2(s[(kc + 4) * 65 + n], s[(kc + 5) * 65 + n]); o.w = pk2(s[(kc + 6) * 65 + n], s[(kc + 7) * 65 + n]);
      *(uint4*)(wint + (size_t)(n0 + n) * DM + k0 + kc) = o;
    } else {
      const int j = it - n_in_tiles;
      const int n0 = (j / 32) * 64, k0 = (j % 32) * 64;
#pragma unroll
      for (int e = 0; e < 8; ++e) {
        const int idx = e * NT + tid, kk = idx >> 6, nn = idx & 63;
        s[kk * 65 + nn] = wout[(size_t)(k0 + kk) * DM + n0 + nn];
      }
      __syncthreads();
      const int n = tid >> 3, kc = (tid & 7) * 8;
      uint4 o;
      o.x = pk2(s[(kc + 0) * 65 + n], s[(kc + 1) * 65 + n]); o.y = pk2(s[(kc + 2) * 65 + n], s[(kc + 3) * 65 + n]);
      o.z = pk2(s[(kc + 4) * 65 + n], s[(kc + 5) * 65 + n]); o.w = pk2(s[(kc + 6) * 65 + n], s[(kc + 7) * 65 + n]);
      *(uint4*)(woutt + (size_t)(n0 + n) * DI + k0 + kc) = o;
    }
  }
  __syncthreads();
}

DEV void dsincos(double x, double& s, double& c) {
  const double k = rint(x * 0.63661977236758134308);
  double r = fma(-k, 1.57079632679489655800e+00, x);
  r = fma(-k, 6.12323399573676603587e-17, r);
  const double r2 = r * r;
  const double t3 = r2 * r, t5 = t3 * r2, t7 = t5 * r2, t9 = t7 * r2, t11 = t9 * r2, t13 = t11 * r2, t15 = t13 * r2;
  const double sinr = r - t3 / 6.0 + t5 / 120.0 - t7 / 5040.0 + t9 / 362880.0 - t11 / 39916800.0 + t13 / 6227020800.0 - t15 / 1307674368000.0;
  const double u2 = r2, u4 = u2 * u2, u6 = u4 * u2, u8 = u6 * u2, u10 = u8 * u2, u12 = u10 * u2, u14 = u12 * u2, u16 = u14 * u2;
  const double cosr = 1.0 - u2 / 2.0 + u4 / 24.0 - u6 / 720.0 + u8 / 40320.0 - u10 / 3628800.0 + u12 / 479001600.0 - u14 / 87178291200.0 + u16 / 20922789888000.0;
  const int q = ((int)k) & 3;
  if (q == 0) { s = sinr; c = cosr; }
  else if (q == 1) { s = cosr; c = -sinr; }
  else if (q == 2) { s = -sinr; c = -cosr; }
  else { s = -cosr; c = sinr; }
}

DEV void phase_pro(const Params& p, unsigned char* smem) {
  const int tid = launder(threadIdx.x);
  const size_t gtid = (size_t)blockIdx.x * NT + tid, gsz = (size_t)gridDim.x * NT;
  const float4* x4 = (const float4*)p.x;
  uint4* xb4 = (uint4*)(p.ws + OFF_XB);
  for (size_t i = gtid; i < (size_t)T_ALL * DM / 8; i += gsz) {
    const float4 a = x4[2 * i], b = x4[2 * i + 1];
    uint4 o; o.x = pk2(a.x, a.y); o.y = pk2(a.z, a.w); o.z = pk2(b.x, b.y); o.w = pk2(b.z, b.w);
    xb4[i] = o;
  }
  if (blockIdx.x == 0) {
    float2* tab = (float2*)(p.ws + OFF_TAB);
    for (int i = tid; i < 64 * 16; i += NT) {
      const int pos = i >> 4, fi = i & 15;
      const float invf = (float)exp(-(double)fi * (9.210340371976184 / 16.0));
      const float ang = (float)pos * invf;
      double s, c; dsincos((double)ang, s, c);
      tab[i] = make_float2((float)c, (float)s);
    }
  }
  convert_weights(p, 0, smem);
}

DEV void gemm_block(const bf16_t* __restrict__ A, int lda, const bf16_t* __restrict__ Bt, int ldb, int nk, unsigned char* smem, f32x16 (&acc)[2][2]) {
  const int tid = launder(threadIdx.x), lane = tid & 63, w = tid >> 6, wr = w >> 2, wc = w & 3, r = lane & 31, h = lane >> 5;
  const int ar = tid >> 2, ac = (tid & 3) * 16;
  const int br = tid >> 1, bc = (tid & 1) * 32;
  const bf16_t* ag = A + (size_t)ar * lda + ac;
  const bf16_t* bg = Bt + (size_t)br * ldb + bc;
  uint4 ra0, ra1, rb0, rb1, rb2, rb3;
#pragma unroll
  for (int i = 0; i < 2; ++i)
#pragma unroll
    for (int j = 0; j < 2; ++j) acc[i][j] = zero16();
  {
    const uint4* pa = (const uint4*)ag; ra0 = pa[0]; ra1 = pa[1];
    const uint4* pb = (const uint4*)bg; rb0 = pb[0]; rb1 = pb[1]; rb2 = pb[2]; rb3 = pb[3];
    uint4* sa = (uint4*)(smem + ar * 144 + ac * 2); sa[0] = ra0; sa[1] = ra1;
    uint4* sb = (uint4*)(smem + 18432 + br * 144 + bc * 2); sb[0] = rb0; sb[1] = rb1; sb[2] = rb2; sb[3] = rb3;
  }
  __syncthreads();
  for (int kt = 0; kt < nk; ++kt) {
    if (kt + 1 < nk) {
      const uint4* pa = (const uint4*)(ag + (kt + 1) * 64); ra0 = pa[0]; ra1 = pa[1];
      const uint4* pb = (const uint4*)(bg + (kt + 1) * 64); rb0 = pb[0]; rb1 = pb[1]; rb2 = pb[2]; rb3 = pb[3];
    }
    const bf16_t* sa = (const bf16_t*)(smem + (kt & 1) * 55296);
    const bf16_t* sb = (const bf16_t*)(smem + (kt & 1) * 55296 + 18432);
#pragma unroll
    for (int ks = 0; ks < 4; ++ks) {
      const bf16x8 a0 = *(const bf16x8*)(sa + (wr * 64 + r) * 72 + ks * 16 + 8 * h);
      const bf16x8 a1 = *(const bf16x8*)(sa + (wr * 64 + 32 + r) * 72 + ks * 16 + 8 * h);
      const bf16x8 b0 = *(const bf16x8*)(sb + (wc * 64 + r) * 72 + ks * 16 + 8 * h);
      const bf16x8 b1 = *(const bf16x8*)(sb + (wc * 64 + 32 + r) * 72 + ks * 16 + 8 * h);
      acc[0][0] = __builtin_amdgcn_mfma_f32_32x32x16_bf16(a0, b0, acc[0][0], 0, 0, 0);
      acc[0][1] = __builtin_amdgcn_mfma_f32_32x32x16_bf16(a0, b1, acc[0][1], 0, 0, 0);
      acc[1][0] = __builtin_amdgcn_mfma_f32_32x32x16_bf16(a1, b0, acc[1][0], 0, 0, 0);
      acc[1][1] = __builtin_amdgcn_mfma_f32_32x32x16_bf16(a1, b1, acc[1][1], 0, 0, 0);
    }
    if (kt + 1 < nk) {
      unsigned char* base = smem + ((kt + 1) & 1) * 55296;
      uint4* sa2 = (uint4*)(base + ar * 144 + ac * 2); sa2[0] = ra0; sa2[1] = ra1;
      uint4* sb2 = (uint4*)(base + 18432 + br * 144 + bc * 2); sb2[0] = rb0; sb2[1] = rb1; sb2[2] = rb2; sb2[3] = rb3;
    }
    __syncthreads();
  }
}

DEV void phase_inproj(const Params& p, int l, int hf, unsigned char* smem) {
  const int tid = launder(threadIdx.x), lane = tid & 63, w = tid >> 6, wr = w >> 2, wc = w & 3, c = lane & 31, h = lane >> 5;
  const bf16_t* A = (const bf16_t*)(p.ws + OFF_XB) + (size_t)hf * TH * DM;
  const bf16_t* Bt = (const bf16_t*)(p.ws + OFF_WIN);
  bf16_t* Hh = (bf16_t*)(p.ws + OFF_H);
  float* SMALL = (float*)(p.ws + OFF_SMALL);
  bf16_t* VT = (bf16_t*)(p.ws + OFF_VT);
  const float2* tab = (const float2*)(p.ws + OFF_TAB);
  const int n_items = (TH / 128) * (NPAD / 256);
  for (int it = blockIdx.x; it < n_items; it += gridDim.x) {
    const int pn = it % 28, pm = it / 28;
    f32x16 acc[2][2];
    gemm_block(A + (size_t)pm * 128 * DM, DM, Bt + (size_t)pn * 256 * DM, DM, DM / 64, smem, acc);
    const int colbase = pn * 256 + wc * 64;
    const int rowb = pm * 128 + wr * 64;
    if (colbase == SM0) {
#pragma unroll
      for (int mi = 0; mi < 2; ++mi)
#pragma unroll
        for (int reg = 0; reg < 16; ++reg) {
          const int row = rowb + mi * 32 + rowoff(reg, h);
          SMALL[(size_t)row * 48 + c] = acc[mi][0][reg];
          if (c < 16) SMALL[(size_t)row * 48 + 32 + c] = acc[mi][1][reg];
        }
    } else if (colbase < SM0) {
      if (colbase < A_V) {
        const bool isq = colbase < A_K;
        const float* gain = (isq ? p.q_gain : p.k_gain) + l * 64;
        const float g0 = gain[c], g1 = gain[32 + c];
        const float osc = isq ? QSCALE : 1.f;
#pragma unroll
        for (int mi = 0; mi < 2; ++mi)
#pragma unroll
          for (int reg = 0; reg < 16; ++reg) {
            float ss = acc[mi][0][reg] * acc[mi][0][reg] + acc[mi][1][reg] * acc[mi][1][reg];
            ss += __shfl_xor(ss, 1); ss += __shfl_xor(ss, 2); ss += __shfl_xor(ss, 4); ss += __shfl_xor(ss, 8); ss += __shfl_xor(ss, 16);
            const float rstd = rsqrtf(ss * (1.f / 64.f) + 1e-6f);
            const int row = rowb + mi * 32 + rowoff(reg, h);
            const int t = row & (SEQ - 1);
            const float2 cs0 = tab[(t >> 6) * 16 + (c & 15)], cs1 = tab[(t & 63) * 16 + (c & 15)];
            const float v0 = acc[mi][0][reg] * rstd * g0, v1 = acc[mi][1][reg] * rstd * g1;
            const float p0 = __shfl_xor(v0, 16), p1 = __shfl_xor(v1, 16);
            const float o0 = (c & 16) ? (v0 * cs0.x + p0 * cs0.y) : (v0 * cs0.x - p0 * cs0.y);
            const float o1 = (c & 16) ? (v1 * cs1.x + p1 * cs1.y) : (v1 * cs1.x - p1 * cs1.y);
            acc[mi][0][reg] = o0 * osc; acc[mi][1][reg] = o1 * osc;
          }
      }
      if (colbase >= A_V && colbase < A_Z) {
        const int kvh = (colbase - A_V) >> 6;
#pragma unroll
        for (int mi = 0; mi < 2; ++mi)
#pragma unroll
          for (int ni = 0; ni < 2; ++ni)
#pragma unroll
            for (int g = 0; g < 4; ++g) {
              const int row = rowb + mi * 32 + 8 * g + 4 * h;
              const int bl = row >> 12, t = row & (SEQ - 1);
              const int d = ni * 32 + c;
              uint2 o; o.x = pk2(acc[mi][ni][4 * g + 0], acc[mi][ni][4 * g + 1]); o.y = pk2(acc[mi][ni][4 * g + 2], acc[mi][ni][4 * g + 3]);
              *(uint2*)(VT + ((size_t)((bl * 2 + kvh) * 64 + d)) * SEQ + t) = o;
            }
      } else {
        bf16_t* so = (bf16_t*)(smem + w * 9216);
#pragma unroll
        for (int mi = 0; mi < 2; ++mi)
#pragma unroll
          for (int ni = 0; ni < 2; ++ni)
#pragma unroll
            for (int reg = 0; reg < 16; ++reg)
              so[(mi * 32 + rowoff(reg, h)) * 72 + ni * 32 + c] = f2bf(acc[mi][ni][reg]);
        __builtin_amdgcn_s_waitcnt(0xc07f);
        __builtin_amdgcn_wave_barrier();
#pragma unroll
        for (int i = 0; i < 8; ++i) {
          const int rr = i * 8 + (lane >> 3), ch = lane & 7;
          const uint4 v = *(const uint4*)(so + rr * 72 + ch * 8);
          *(uint4*)(Hh + (size_t)(rowb + rr) * NPAD + colbase + ch * 8) = v;
        }
      }
    }
    __syncthreads();
  }
}

DEV void phase_outproj(const Params& p, int l, int hf, unsigned char* smem) {
  const int tid = launder(threadIdx.x), lane = tid & 63, w = tid >> 6, wr = w >> 2, wc = w & 3, c = lane & 31, h = lane >> 5;
  const bf16_t* A = (const bf16_t*)(p.ws + OFF_MIXED);
  const bf16_t* Bt = (const bf16_t*)(p.ws + OFF_WOUT);
  const float* xin = (l == 0) ? p.x : p.out;
  const int n_items = (TH / 128) * (DM / 256);
  for (int it = blockIdx.x; it < n_items; it += gridDim.x) {
    const int pn = it & 3, pm = it >> 2;
    f32x16 acc[2][2];
    gemm_block(A + (size_t)pm * 128 * DI, DI, Bt + (size_t)pn * 256 * DI, DI, DI / 64, smem, acc);
#pragma unroll
    for (int mi = 0; mi < 2; ++mi)
#pragma unroll
      for (int ni = 0; ni < 2; ++ni)
#pragma unroll
        for (int reg = 0; reg < 16; ++reg) {
          const int row = hf * TH + pm * 128 + wr * 64 + mi * 32 + rowoff(reg, h);
          const int col = pn * 256 + wc * 64 + ni * 32 + c;
          const size_t idx = (size_t)row * DM + col;
          p.out[idx] = DN_ALPHA * xin[idx] + acc[mi][ni][reg];
        }
    __syncthreads();
  }
}

DEV void phase_ln(const Params& p, int l, int hf) {
  const int tid = launder(threadIdx.x), lane = tid & 63, w = tid >> 6;
  const float* g = p.ln_g + l * DM; const float* b = p.ln_b + l * DM;
  bf16_t* xb = (bf16_t*)(p.ws + OFF_XB);
  for (int r = blockIdx.x * 8 + w; r < TH; r += gridDim.x * 8) {
    const int row = hf * TH + r;
    float4* rp = (float4*)(p.out + (size_t)row * DM);
    float4 v[4];
    float s = 0.f;
#pragma unroll
    for (int j = 0; j < 4; ++j) { v[j] = rp[j * 64 + lane]; s += (v[j].x + v[j].y) + (v[j].z + v[j].w); }
#pragma unroll
    for (int o = 32; o >= 1; o >>= 1) s += __shfl_xor(s, o);
    const float mu = s * (1.f / DM);
    float q = 0.f;
#pragma unroll
    for (int j = 0; j < 4; ++j) { const float a = v[j].x - mu, bb = v[j].y - mu, cc = v[j].z - mu, d = v[j].w - mu; q += (a * a + bb * bb) + (cc * cc + d * d); }
#pragma unroll
    for (int o = 32; o >= 1; o >>= 1) q += __shfl_xor(q, o);
    const float rstd = rsqrtf(q * (1.f / DM) + 1e-5f);
#pragma unroll
    for (int j = 0; j < 4; ++j) {
      const int col = (j * 64 + lane) * 4;
      const float4 gg = *(const float4*)(g + col), bb = *(const float4*)(b + col);
      float4 o;
      o.x = (v[j].x - mu) * rstd * gg.x + bb.x; o.y = (v[j].y - mu) * rstd * gg.y + bb.y;
      o.z = (v[j].z - mu) * rstd * gg.z + bb.z; o.w = (v[j].w - mu) * rstd * gg.w + bb.w;
      rp[j * 64 + lane] = o;
      if (l == 0) { uint2 pk; pk.x = pk2(o.x, o.y); pk.y = pk2(o.z, o.w); *(uint2*)(xb + (size_t)row * DM + col) = pk; }
    }
  }
}

DEV void attn_item(const Params& p, int l, int item, unsigned char* smem) {
  const int tid = launder(threadIdx.x), lane = tid & 63, w = tid >> 6, r = lane & 31, h = lane >> 5;
  const int qt = item & 15, head = (item >> 4) & 7, bl = item >> 7;
  const int kvh = head >> 2;
  const bf16_t* Hh = (const bf16_t*)(p.ws + OFF_H);
  const bf16_t* VT = (const bf16_t*)(p.ws + OFF_VT);
  bf16_t* MX = (bf16_t*)(p.ws + OFF_MIXED);
  const size_t rowbase = (size_t)bl * SEQ;
  float mq = fabsf(p.q_gain[l * 64 + lane]), mk = fabsf(p.k_gain[l * 64 + lane]);
#pragma unroll
  for (int o = 32; o >= 1; o >>= 1) { mq = fmaxf(mq, __shfl_xor(mq, o)); mk = fmaxf(mk, __shfl_xor(mk, o)); }
  const float M2 = 8.f * mq * mk * LOG2E * 1.01f;
  const int qrow = qt * 256 + w * 32 + r;
  const bf16_t* qp = Hh + (rowbase + qrow) * NPAD + A_Q + head * 64 + 8 * h;
  bf16x8 qf[4];
#pragma unroll
  for (int ks = 0; ks < 4; ++ks) qf[ks] = *(const bf16x8*)(qp + ks * 16);
  f32x16 o0 = zero16(), o1 = zero16();
  float lsum = 0.f;
  const int srow = tid >> 3, sch = (tid & 7) * 8;
  const bf16_t* kp = Hh + (rowbase + srow) * NPAD + A_K + kvh * 64 + sch;
  const bf16_t* vp = VT + ((size_t)((bl * 2 + kvh) * 64 + srow)) * SEQ + sch;
  uint4 rk = *(const uint4*)kp, rv = *(const uint4*)vp;
  *(uint4*)(smem + srow * 144 + sch * 2) = rk;
  *(uint4*)(smem + 9216 + srow * 144 + sch * 2) = rv;
  __syncthreads();
  for (int kt = 0; kt < SEQ / 64; ++kt) {
    if (kt + 1 < SEQ / 64) { rk = *(const uint4*)(kp + (size_t)(kt + 1) * 64 * NPAD); rv = *(const uint4*)(vp + (kt + 1) * 64); }
    const bf16_t* sK = (const bf16_t*)(smem + (kt & 1) * 18432);
    const bf16_t* sV = (const bf16_t*)(smem + (kt & 1) * 18432 + 9216);
    f32x16 s0 = zero16(), s1 = zero16();
#pragma unroll
    for (int ks = 0; ks < 4; ++ks) {
      const bf16x8 a0 = *(const bf16x8*)(sK + r * 72 + ks * 16 + 8 * h);
      const bf16x8 a1 = *(const bf16x8*)(sK + (32 + r) * 72 + ks * 16 + 8 * h);
      s0 = __builtin_amdgcn_mfma_f32_32x32x16_bf16(a0, qf[ks], s0, 0, 0, 0);
      s1 = __builtin_amdgcn_mfma_f32_32x32x16_bf16(a1, qf[ks], s1, 0, 0, 0);
    }
#pragma unroll
    for (int i = 0; i < 16; ++i) { s0[i] = __builtin_amdgcn_exp2f(s0[i] - M2); s1[i] = __builtin_amdgcn_exp2f(s1[i] - M2); lsum += s0[i] + s1[i]; }
    union { bf16x8 v; unsigned u[4]; } pb[2][2];
#pragma unroll
    for (int s = 0; s < 2; ++s)
#pragma unroll
      for (int j = 0; j < 4; ++j) {
        pb[0][s].u[j] = pk2(s0[8 * s + 2 * j], s0[8 * s + 2 * j + 1]);
        pb[1][s].u[j] = pk2(s1[8 * s + 2 * j], s1[8 * s + 2 * j + 1]);
      }
#pragma unroll
    for (int kt2 = 0; kt2 < 2; ++kt2)
#pragma unroll
      for (int s = 0; s < 2; ++s) {
        const int kb = kt2 * 32 + 16 * s + 4 * h;
        union { bf16x8 v; uint2 u[2]; } a0, a1;
        a0.u[0] = *(const uint2*)(sV + r * 72 + kb); a0.u[1] = *(const uint2*)(sV + r * 72 + kb + 8);
        a1.u[0] = *(const uint2*)(sV + (32 + r) * 72 + kb); a1.u[1] = *(const uint2*)(sV + (32 + r) * 72 + kb + 8);
        o0 = __builtin_amdgcn_mfma_f32_32x32x16_bf16(a0.v, pb[kt2][s].v, o0, 0, 0, 0);
        o1 = __builtin_amdgcn_mfma_f32_32x32x16_bf16(a1.v, pb[kt2][s].v, o1, 0, 0, 0);
      }
    if (kt + 1 < SEQ / 64) {
      unsigned char* base = smem + ((kt + 1) & 1) * 18432;
      *(uint4*)(base + srow * 144 + sch * 2) = rk;
      *(uint4*)(base + 9216 + srow * 144 + sch * 2) = rv;
    }
    __syncthreads();
  }
  lsum += __shfl_xor(lsum, 32);
  const float inv = 1.f / lsum;
  const bf16_t* zp = Hh + (rowbase + qrow) * NPAD + A_Z + head * 64;
  bf16_t* op = MX + (rowbase + qrow) * DI + head * 64;
#pragma unroll
  for (int dt = 0; dt < 2; ++dt)
#pragma unroll
    for (int g = 0; g < 4; ++g) {
      const int d0 = dt * 32 + 8 * g + 4 * h;
      const uint2 zz = *(const uint2*)(zp + d0);
      const float z0 = bf2f((bf16_t)(zz.x & 0xffff)), z1 = bf2f((bf16_t)(zz.x >> 16)), z2 = bf2f((bf16_t)(zz.y & 0xffff)), z3 = bf2f((bf16_t)(zz.y >> 16));
      const f32x16& oo = dt ? o1 : o0;
      uint2 ov;
      ov.x = pk2(oo[4 * g + 0] * inv * fsilu(z0), oo[4 * g + 1] * inv * fsilu(z1));
      ov.y = pk2(oo[4 * g + 2] * inv * fsilu(z2), oo[4 * g + 3] * inv * fsilu(z3));
      *(uint2*)(op + d0) = ov;
    }
  __syncthreads();
}

constexpr int L_QT = 0, L_KT = 17408, L_QC = 34816, L_KHT = 52224, L_VT = 70656, L_P = 89088, L_ST = 98304, L_RAW = 89088,
              L_D = 138240, L_TOT = 138752, L_ACS = 142848, L_DT = 143104, L_LOW = 143360;

template <int K, int V> struct ScanGeom {
  static constexpr int KP = K + 8;
  static constexpr int NS = (K / 32) * (V / 32) / 8;
};

template <int K, int V>
DEV void scan_write_state(unsigned char* smem, const f32x16* S, int w, int lane) {
  constexpr int KP = K + 8, NS = ScanGeom<K, V>::NS, NVT = V / 32;
  bf16_t* sST = (bf16_t*)(smem + L_ST);
  const int c = lane & 31, h = lane >> 5;
#pragma unroll
  for (int i = 0; i < NS; ++i) {
    const int tile = w * NS + i, kt = tile / NVT, nt = tile % NVT;
#pragma unroll
    for (int g = 0; g < 4; ++g) {
      uint2 o; o.x = pk2(S[i][4 * g + 0], S[i][4 * g + 1]); o.y = pk2(S[i][4 * g + 2], S[i][4 * g + 3]);
      *(uint2*)(sST + (nt * 32 + c) * KP + kt * 32 + 8 * g + 4 * h) = o;
    }
  }
}

template <int K, int V, bool SSDM>
DEV void scan_core(unsigned char* smem, f32x16* S, bf16_t* orow0, int dir, int w, int lane) {
  constexpr int KP = K + 8, NS = ScanGeom<K, V>::NS, NVT = V / 32, NOT = 2 * NVT;
  const bf16_t* sQt = (const bf16_t*)(smem + L_QT); const bf16_t* sKt = (const bf16_t*)(smem + L_KT);
  const bf16_t* sQc = (const bf16_t*)(smem + L_QC); const bf16_t* sKhT = (const bf16_t*)(smem + L_KHT);
  const bf16_t* sVT = (const bf16_t*)(smem + L_VT); bf16_t* sP = (bf16_t*)(smem + L_P);
  const bf16_t* sST = (const bf16_t*)(smem + L_ST); const float* sD = (const float*)(smem + L_D);
  const float* sAcs = (const float*)(smem + L_ACS);
  const int c = lane & 31, h = lane >> 5;
  scan_write_state<K, V>(smem, S, w, lane);
  if (w < 4) {
    const int tt = w >> 1, st = w & 1;
    f32x16 acc = zero16();
    if (st <= tt) mma32<K>(acc, sQt + tt * 32 * KP, KP, sKt + st * 32 * KP, KP, lane);
#pragma unroll
    for (int reg = 0; reg < 16; ++reg) {
      const int tau = tt * 32 + rowoff(reg, h), sig = st * 32 + c;
      float v = 0.f;
      if (sig <= tau) { v = acc[reg]; if (SSDM) v *= __expf(sAcs[tau] - sAcs[sig]); }
      sP[tau * 72 + sig] = f2bf(v);
    }
  }
  __syncthreads();
  if (w < NOT) {
    const int tt = w / NVT, nt = w % NVT;
    f32x16 acc = zero16();
    mma32<64>(acc, sP + tt * 32 * 72, 72, sVT + nt * 32 * 72, 72, lane);
    mma32<K>(acc, sQc + tt * 32 * KP, KP, sST + nt * 32 * KP, KP, lane);
#pragma unroll
    for (int reg = 0; reg < 16; ++reg) {
      const int tau = tt * 32 + rowoff(reg, h);
      const int tok = dir ? (63 - tau) : tau;
      orow0[(size_t)tok * 512 + nt * 32 + c] = f2bf(acc[reg]);
    }
  }
#pragma unroll
  for (int i = 0; i < NS; ++i) {
    const int tile = w * NS + i, kt = tile / NVT, nt = tile % NVT;
#pragma unroll
    for (int reg = 0; reg < 16; ++reg) S[i][reg] *= sD[kt * 32 + rowoff(reg, h)];
    mma32<64>(S[i], sKhT + kt * 32 * 72, 72, sVT + nt * 32 * 72, 72, lane);
  }
  __syncthreads();
}

DEV void store16(bf16_t* dst, const float* v) {
  uint4 a, b;
  a.x = pk2(v[0], v[1]); a.y = pk2(v[2], v[3]); a.z = pk2(v[4], v[5]); a.w = pk2(v[6], v[7]);
  b.x = pk2(v[8], v[9]); b.y = pk2(v[10], v[11]); b.z = pk2(v[12], v[13]); b.w = pk2(v[14], v[15]);
  ((uint4*)dst)[0] = a; ((uint4*)dst)[1] = b;
}
DEV void gather16(bf16_t* dst, const bf16_t* src, int stride) {
  unsigned u[8];
#pragma unroll
  for (int i = 0; i < 8; ++i) u[i] = (unsigned)src[(2 * i) * stride] | ((unsigned)src[(2 * i + 1) * stride] << 16);
  ((uint4*)dst)[0] = make_uint4(u[0], u[1], u[2], u[3]); ((uint4*)dst)[1] = make_uint4(u[4], u[5], u[6], u[7]);
}

DEV void hgrn_item(const Params& p, int l, int bl, int head, int dir, unsigned char* smem) {
  constexpr int K = 128, V = 128, KP = 136;
  const int tid = launder(threadIdx.x), lane = tid & 63, w = tid >> 6;
  const int ch = tid & 127, qd = tid >> 7;
  const bf16_t* Hh = (const bf16_t*)(p.ws + OFF_H);
  bf16_t* OB = (bf16_t*)(p.ws + OFF_OBUF) + (size_t)(0 * 2 + dir) * TH * 512;
  const size_t rowbase = (size_t)bl * SEQ;
  float lbv = 0.f;
  if (l > 0) lbv = fsigmoid(p.lb_logits[512 + head * 128 + ch] - p.lb_logits[head * 128 + ch]);
  const int fbase = dir ? H_FB : H_FF;
  bf16_t* sQt = (bf16_t*)(smem + L_QT); bf16_t* sKt = (bf16_t*)(smem + L_KT); bf16_t* sQc = (bf16_t*)(smem + L_QC);
  bf16_t* sKhT = (bf16_t*)(smem + L_KHT); bf16_t* sVT = (bf16_t*)(smem + L_VT);
  float* sD = (float*)(smem + L_D); float* sTot = (float*)(smem + L_TOT);
  const bf16_t* rawQ = (const bf16_t*)(smem + L_RAW); const bf16_t* rawF = rawQ + 8192; const bf16_t* rawV = rawQ + 16384;
  f32x16 S[2]; S[0] = zero16(); S[1] = zero16();
  u32x4 pre[6];
  const int prow0 = tid >> 4, pc16 = (tid & 15) * 8;
  auto gload = [&](int cidx) __attribute__((always_inline)) {
    const int chunk = dir ? (63 - cidx) : cidx;
#pragma unroll
    for (int j = 0; j < 2; ++j) {
      const int row = prow0 + 32 * j;
      const int tok = chunk * 64 + (dir ? (63 - row) : row);
      const bf16_t* rp = Hh + (rowbase + tok) * NPAD + head * 128 + pc16;
      pre[j] = *(const u32x4*)(rp + H_Q); pre[2 + j] = *(const u32x4*)(rp + fbase); pre[4 + j] = *(const u32x4*)(rp + H_I);
    }
  };
  gload(0);
  for (int cidx = 0; cidx < 64; ++cidx) {
    const int chunk = dir ? (63 - cidx) : cidx;
#pragma unroll
    for (int j = 0; j < 2; ++j) {
      unsigned char* d = smem + L_RAW + (prow0 + 32 * j) * 256 + pc16 * 2;
      *(u32x4*)d = pre[j]; *(u32x4*)(d + 16384) = pre[2 + j]; *(u32x4*)(d + 32768) = pre[4 + j];
    }
    __syncthreads();
    if (cidx + 1 < 64) gload(cidx + 1);
    float run = 0.f;
#pragma unroll 1
    for (int i0 = 0; i0 < 16; i0 += 4) {
#pragma unroll
      for (int ii = 0; ii < 4; ++ii) {
        const float f = bf2f(rawF[(16 * qd + i0 + ii) * 128 + ch]);
        const float sg = 1.f / (1.f + __expf(-f));
        run += __logf(lbv + (1.f - lbv) * sg);
      }
    }
    sTot[qd * 128 + ch] = run;
    __syncthreads();
    const float t0 = sTot[ch], t1 = sTot[128 + ch], t2 = sTot[256 + ch], t3 = sTot[384 + ch];
    const float off = (qd > 0 ? t0 : 0.f) + (qd > 1 ? t1 : 0.f) + (qd > 2 ? t2 : 0.f);
    const float ref = t0 + t1, bend = (t0 + t1) + (t2 + t3);
    float b = off;
#pragma unroll 1
    for (int i0 = 0; i0 < 16; i0 += 4) {
      float kh4[4]; unsigned vb[4];
#pragma unroll
      for (int ii = 0; ii < 4; ++ii) {
        const int tau = 16 * qd + i0 + ii;
        const float f = bf2f(rawF[tau * 128 + ch]);
        const float sg = 1.f / (1.f + __expf(-f));
        b += __logf(lbv + (1.f - lbv) * sg);
        const float kx = (1.f - lbv) / (1.f + __expf(f));
        const float qr = bf2f(rawQ[tau * 128 + ch]);
        const float qx = qr * (1.f / (1.f + __expf(-qr))) * 0.08838834764831845f;
        sQt[tau * KP + ch] = f2bf(qx * __expf(b - ref));
        sKt[tau * KP + ch] = f2bf(kx * __expf(ref - b));
        sQc[tau * KP + ch] = f2bf(qx * __expf(b));
        kh4[ii] = kx * __expf(bend - b);
        vb[ii] = rawV[tau * 128 + ch];
      }
      uint2 o; o.x = pk2(kh4[0], kh4[1]); o.y = pk2(kh4[2], kh4[3]);
      *(uint2*)(sKhT + ch * 72 + 16 * qd + i0) = o;
      uint2 ov; ov.x = vb[0] | (vb[1] << 16); ov.y = vb[2] | (vb[3] << 16);
      *(uint2*)(sVT + ch * 72 + 16 * qd + i0) = ov;
    }
    if (qd == 0) sD[ch] = __expf(bend);
    __syncthreads();
    scan_core<K, V, false>(smem, S, OB + (rowbase + (size_t)chunk * 64) * 512 + head * 128, dir, w, lane);
  }
}

DEV void gla_item(const Params& p, int l, int bl, int head, int dir, unsigned char* smem) {
  constexpr int K = 64, V = 128, KP = 72;
  const int tid = launder(threadIdx.x), lane = tid & 63, w = tid >> 6;
  const int ch = tid & 63, oc = tid >> 6;
  const int vn = tid & 127, vq = tid >> 7;
  const bf16_t* Hh = (const bf16_t*)(p.ws + OFF_H);
  const float* SMALL = (const float*)(p.ws + OFF_SMALL);
  bf16_t* OB = (bf16_t*)(p.ws + OFF_OBUF) + (size_t)(2 * 2 + dir) * TH * 512;
  const size_t rowbase = (size_t)bl * SEQ;
  bf16_t* sQt = (bf16_t*)(smem + L_QT); bf16_t* sKt = (bf16_t*)(smem + L_KT); bf16_t* sQc = (bf16_t*)(smem + L_QC);
  bf16_t* sKhT = (bf16_t*)(smem + L_KHT); bf16_t* sVT = (bf16_t*)(smem + L_VT);
  float* sD = (float*)(smem + L_D); float* sTot = (float*)(smem + L_TOT); float* sLow = (float*)(smem + L_LOW);
  const bf16_t* rawQ = (const bf16_t*)(smem + L_RAW); const bf16_t* rawK = rawQ + 4096; const bf16_t* rawV = rawQ + 8192;
  float w2c[16];
#pragma unroll
  for (int r = 0; r < 16; ++r) w2c[r] = p.gk_w2[((size_t)(l * 2 + dir) * 16 + r) * 256 + head * 64 + ch];
  const float gb = p.gk_b[(l * 2 + dir) * 256 + head * 64 + ch];
  f32x16 S[1]; S[0] = zero16();
  u32x4 pre[4];
  float plow0, plow1;
  const int qrow = tid >> 3, qc8 = (tid & 7) * 8, vrow0 = tid >> 4, vc16 = (tid & 15) * 8;
  auto gload = [&](int cidx) __attribute__((always_inline)) {
    const int chunk = dir ? (63 - cidx) : cidx;
    {
      const int tok = chunk * 64 + (dir ? (63 - qrow) : qrow);
      const bf16_t* rp = Hh + (rowbase + tok) * NPAD + head * 64 + qc8;
      pre[0] = *(const u32x4*)(rp + G_Q); pre[1] = *(const u32x4*)(rp + G_K);
      { const float* lp = SMALL + (rowbase + tok) * 48 + 16 + dir * 16 + (tid & 7) * 2; plow0 = lp[0]; plow1 = lp[1]; }
    }
#pragma unroll
    for (int j = 0; j < 2; ++j) {
      const int row = vrow0 + 32 * j;
      const int tok = chunk * 64 + (dir ? (63 - row) : row);
      pre[2 + j] = *(const u32x4*)(Hh + (rowbase + tok) * NPAD + G_V + head * 128 + vc16);
    }
  };
  gload(0);
  for (int cidx = 0; cidx < 64; ++cidx) {
    const int chunk = dir ? (63 - cidx) : cidx;
    {
      unsigned char* d = smem + L_RAW + qrow * 128 + qc8 * 2;
      *(u32x4*)d = pre[0]; *(u32x4*)(d + 8192) = pre[1];
      sLow[qrow * 16 + (tid & 7) * 2] = plow0; sLow[qrow * 16 + (tid & 7) * 2 + 1] = plow1;
#pragma unroll
      for (int j = 0; j < 2; ++j) *(u32x4*)(smem + L_RAW + 16384 + (vrow0 + 32 * j) * 256 + vc16 * 2) = pre[2 + j];
    }
    __syncthreads();
    if (cidx + 1 < 64) gload(cidx + 1);
    float run = 0.f;
#pragma unroll 1
    for (int i = 0; i < 8; ++i) {
      const int tau = 8 * oc + i;
      float gk = gb;
#pragma unroll
      for (int r = 0; r < 16; ++r) gk += sLow[tau * 16 + r] * w2c[r];
      run += (fminf(gk, 0.f) - __logf(1.f + __expf(-fabsf(gk)))) * (1.f / 16.f);
    }
    sTot[oc * 64 + ch] = run;
    __syncthreads();
    float off = 0.f, ref = 0.f, bend = 0.f;
#pragma unroll
    for (int j = 0; j < 8; ++j) { const float t = sTot[j * 64 + ch]; if (j < oc) off += t; if (j < 4) ref += t; bend += t; }
    float b = off;
#pragma unroll 1
    for (int i0 = 0; i0 < 8; i0 += 4) {
      float kh4[4];
#pragma unroll
      for (int ii = 0; ii < 4; ++ii) {
        const int tau = 8 * oc + i0 + ii;
        float gk = gb;
#pragma unroll
        for (int r = 0; r < 16; ++r) gk += sLow[tau * 16 + r] * w2c[r];
        b += (fminf(gk, 0.f) - __logf(1.f + __expf(-fabsf(gk)))) * (1.f / 16.f);
        const float qx = bf2f(rawQ[tau * 64 + ch]) * 0.125f, kx = bf2f(rawK[tau * 64 + ch]);
        sQt[tau * KP + ch] = f2bf(qx * __expf(b - ref));
        sKt[tau * KP + ch] = f2bf(kx * __expf(ref - b));
        sQc[tau * KP + ch] = f2bf(qx * __expf(b));
        kh4[ii] = kx * __expf(bend - b);
      }
      uint2 o; o.x = pk2(kh4[0], kh4[1]); o.y = pk2(kh4[2], kh4[3]);
      *(uint2*)(sKhT + ch * 72 + 8 * oc + i0) = o;
    }
#pragma unroll 1
    for (int i0 = 0; i0 < 16; i0 += 4) {
      unsigned vb[4];
#pragma unroll
      for (int ii = 0; ii < 4; ++ii) vb[ii] = rawV[(16 * vq + i0 + ii) * 128 + vn];
      uint2 ov; ov.x = vb[0] | (vb[1] << 16); ov.y = vb[2] | (vb[3] << 16);
      *(uint2*)(sVT + vn * 72 + 16 * vq + i0) = ov;
    }
    if (oc == 0) sD[ch] = __expf(bend);
    __syncthreads();
    scan_core<K, V, false>(smem, S, OB + (rowbase + (size_t)chunk * 64) * 512 + head * 128, dir, w, lane);
  }
}

DEV void ssd_item(const Params& p, int l, int bl, int head, int dir, unsigned char* smem) {
  constexpr int K = 128, V = 64, KP = 136;
  const int tid = launder(threadIdx.x), lane = tid & 63, w = tid >> 6;
  const int n = tid & 127, qd = tid >> 7;
  const int pp = tid & 63, oc = tid >> 6;
  const int grp = head >> 2;
  const bf16_t* Hh = (const bf16_t*)(p.ws + OFF_H);
  const float* SMALL = (const float*)(p.ws + OFF_SMALL);
  bf16_t* OB = (bf16_t*)(p.ws + OFF_OBUF) + (size_t)(1 * 2 + dir) * TH * 512;
  const size_t rowbase = (size_t)bl * SEQ;
  bf16_t* sQt = (bf16_t*)(smem + L_QT); bf16_t* sKt = (bf16_t*)(smem + L_KT); bf16_t* sQc = (bf16_t*)(smem + L_QC);
  bf16_t* sKhT = (bf16_t*)(smem + L_KHT); bf16_t* sVT = (bf16_t*)(smem + L_VT);
  float* sD = (float*)(smem + L_D); float* sAcs = (float*)(smem + L_ACS); float* sDt = (float*)(smem + L_DT);
  const bf16_t* rawB = (const bf16_t*)(smem + L_RAW); const bf16_t* rawC = rawB + 68 * 128; const bf16_t* rawX = rawB + 2 * 68 * 128;
  const int chB = 512 + grp * 128 + n, chC = 768 + grp * 128 + n, chX = head * 64 + pp;
  const float* cw = p.conv_w + (size_t)l * 5 * 1024; const float* cb = p.conv_b + (size_t)l * 1024;
  float wB[5], wC[5], wX[5];
#pragma unroll
  for (int j = 0; j < 5; ++j) { wB[j] = cw[j * 1024 + chB]; wC[j] = cw[j * 1024 + chC]; wX[j] = cw[j * 1024 + chX]; }
  const float bB = cb[chB], bC = cb[chC], bX = cb[chX];
  const float dtb = p.dt_bias[(l * 2 + dir) * 8 + head];
  const float Acoef = -__expf(p.a_log[(l * 2 + dir) * 8 + head]);
  f32x16 S[1]; S[0] = zero16();
  u32x4 pre[6];
  float rdt = 0.f;
  auto decode = [&](int id, int& row, int& gcol, int& loff) __attribute__((always_inline)) {
    if (id < 1088) { row = id >> 4; gcol = S_X + 512 + grp * 128 + (id & 15) * 8; loff = row * 256 + (id & 15) * 16; }
    else if (id < 2176) { const int i2 = id - 1088; row = i2 >> 4; gcol = S_X + 768 + grp * 128 + (i2 & 15) * 8; loff = 17408 + row * 256 + (i2 & 15) * 16; }
    else { const int i2 = id - 2176; row = i2 >> 3; gcol = S_X + head * 64 + (i2 & 7) * 8; loff = 34816 + row * 128 + (i2 & 7) * 16; }
  };
  auto gload = [&](int cidx) __attribute__((always_inline)) {
    const int chunk = dir ? (63 - cidx) : cidx;
#pragma unroll
    for (int j = 0; j < 6; ++j) {
      const int id = tid + 512 * j;
      pre[j] = (u32x4){0u, 0u, 0u, 0u};
      if (id < 2720) {
        int row, gcol, loff; decode(id, row, gcol, loff);
        const int s = chunk * 64 + row - 2;
        if (s >= 0 && s < SEQ) pre[j] = *(const u32x4*)(Hh + (rowbase + s) * NPAD + gcol);
      }
    }
    if (w == 0) {
      const int tok = chunk * 64 + (dir ? (63 - lane) : lane);
      rdt = SMALL[(rowbase + tok) * 48 + dir * 8 + head];
    }
  };
  gload(0);
  for (int cidx = 0; cidx < 64; ++cidx) {
    const int chunk = dir ? (63 - cidx) : cidx;
#pragma unroll
    for (int j = 0; j < 6; ++j) {
      const int id = tid + 512 * j;
      if (id < 2720) { int row, gcol, loff; decode(id, row, gcol, loff); *(u32x4*)(smem + L_RAW + loff) = pre[j]; }
    }
    if (w == 0) {
      const float xx = rdt + dtb;
      const float dt = (xx > 20.f) ? xx : log1pf(__expf(xx));
      float a = dt * Acoef;
#pragma unroll
      for (int o = 1; o < 64; o <<= 1) { const float t = __shfl_up(a, o); if (lane >= o) a += t; }
      sAcs[lane] = a; sDt[lane] = dt;
    }
    __syncthreads();
    if (cidx + 1 < 64) gload(cidx + 1);
    const float aend = sAcs[63];
#pragma unroll 1
    for (int i0 = 0; i0 < 16; i0 += 4) {
      float kh4[4];
#pragma unroll
      for (int ii = 0; ii < 4; ++ii) {
        const int tau = 16 * qd + i0 + ii;
        const int tl = dir ? (63 - tau) : tau;
        float uB = bB, uC = bC;
#pragma unroll
        for (int j = 0; j < 5; ++j) { uB += wB[j] * bf2f(rawB[(tl + j) * 128 + n]); uC += wC[j] * bf2f(rawC[(tl + j) * 128 + n]); }
        uB = fsilu(uB); uC = fsilu(uC);
        const float ac = sAcs[tau];
        sQt[tau * KP + n] = f2bf(uC);
        sKt[tau * KP + n] = f2bf(uB);
        sQc[tau * KP + n] = f2bf(uC * __expf(ac));
        kh4[ii] = uB * __expf(aend - ac);
      }
      uint2 o; o.x = pk2(kh4[0], kh4[1]); o.y = pk2(kh4[2], kh4[3]);
      *(uint2*)(sKhT + n * 72 + 16 * qd + i0) = o;
    }
#pragma unroll 1
    for (int i0 = 0; i0 < 8; i0 += 4) {
      float xv[4];
#pragma unroll
      for (int ii = 0; ii < 4; ++ii) {
        const int tau = 8 * oc + i0 + ii;
        const int tl = dir ? (63 - tau) : tau;
        float u = bX;
#pragma unroll
        for (int j = 0; j < 5; ++j) u += wX[j] * bf2f(rawX[(tl + j) * 64 + pp]);
        xv[ii] = fsilu(u) * sDt[tau];
      }
      uint2 o; o.x = pk2(xv[0], xv[1]); o.y = pk2(xv[2], xv[3]);
      *(uint2*)(sVT + pp * 72 + 8 * oc + i0) = o;
    }
    if (qd == 0) sD[n] = __expf(aend);
    __syncthreads();
    scan_core<K, V, true>(smem, S, OB + (rowbase + (size_t)chunk * 64) * 512 + head * 64, dir, w, lane);
  }
}

DEV void phase_mix(const Params& p, int l, int hf, int slot, int item_lo, int item_hi, unsigned char* smem) {
  unsigned* ctr = (unsigned*)(p.ws + OFF_CTRL) + CTR_WORD0 + slot * 16;
  volatile int* sItem = (volatile int*)(smem + LDS_BYTES - 16);
  for (;;) {
    __syncthreads();
    if (threadIdx.x == 0) *sItem = item_lo + (int)atomicAdd(ctr, 1u);
    __syncthreads();
    const int it = *sItem;
    if (it >= item_hi) break;
    if (it < 16) { if (PH_MASK & 0x100) hgrn_item(p, l, it >> 3, (it >> 1) & 3, it & 1, smem); }
    else if (it < 32) { const int j = it - 16; if (PH_MASK & 0x200) gla_item(p, l, j >> 3, (j >> 1) & 3, j & 1, smem); }
    else if (it < 64) { const int j = it - 32; if (PH_MASK & 0x400) ssd_item(p, l, j >> 4, (j >> 1) & 7, j & 1, smem); }
    else { if (PH_MASK & 0x800) attn_item(p, l, it - 64, smem); }
  }
}

DEV void phase_fin(const Params& p, int l, int hf) {
  const int tid = launder(threadIdx.x), lane = tid & 63, w = tid >> 6;
  const bf16_t* Hh = (const bf16_t*)(p.ws + OFF_H);
  const bf16_t* OB = (const bf16_t*)(p.ws + OFF_OBUF);
  bf16_t* MX = (bf16_t*)(p.ws + OFF_MIXED);
  const int c0 = lane * 8;
  const float* cw = p.conv_w + (size_t)l * 5 * 1024; const float* cb = p.conv_b + (size_t)l * 1024;
  for (int r = blockIdx.x * 8 + w; r < TH; r += gridDim.x * 8) {
    const bf16_t* hrow = Hh + (size_t)r * NPAD;
    {
      const uint4 a = *(const uint4*)(OB + ((size_t)0 * TH + r) * 512 + c0), b = *(const uint4*)(OB + ((size_t)1 * TH + r) * 512 + c0);
      const uint4 z = *(const uint4*)(hrow + H_Z + c0);
      const unsigned au[4] = {a.x, a.y, a.z, a.w}, bu[4] = {b.x, b.y, b.z, b.w}, zu[4] = {z.x, z.y, z.z, z.w};
      float o[8]; float ss = 0.f;
#pragma unroll
      for (int j = 0; j < 4; ++j) {
        o[2 * j] = bf2f((bf16_t)(au[j] & 0xffff)) + bf2f((bf16_t)(bu[j] & 0xffff));
        o[2 * j + 1] = bf2f((bf16_t)(au[j] >> 16)) + bf2f((bf16_t)(bu[j] >> 16));
        ss += o[2 * j] * o[2 * j] + o[2 * j + 1] * o[2 * j + 1];
      }
#pragma unroll
      for (int of = 32; of >= 1; of >>= 1) ss += __shfl_xor(ss, of);
      const float rstd = rsqrtf(ss * (1.f / 512.f) + 1e-6f);
      float y[8];
#pragma unroll
      for (int j = 0; j < 8; ++j) {
        const float zz = bf2f((bf16_t)((j & 1) ? (zu[j >> 1] >> 16) : (zu[j >> 1] & 0xffff)));
        y[j] = o[j] * rstd * p.hgrn_norm[l * 512 + c0 + j] * fsilu(zz);
      }
      uint4 ov; ov.x = pk2(y[0], y[1]); ov.y = pk2(y[2], y[3]); ov.z = pk2(y[4], y[5]); ov.w = pk2(y[6], y[7]);
      *(uint4*)(MX + (size_t)r * DI + 512 + c0) = ov;
    }
    {
      const uint4 a = *(const uint4*)(OB + ((size_t)4 * TH + r) * 512 + c0), b = *(const uint4*)(OB + ((size_t)5 * TH + r) * 512 + c0);
      const uint4 z = *(const uint4*)(hrow + G_Z + c0);
      const unsigned au[4] = {a.x, a.y, a.z, a.w}, bu[4] = {b.x, b.y, b.z, b.w}, zu[4] = {z.x, z.y, z.z, z.w};
      float o[8]; float ss = 0.f;
#pragma unroll
      for (int j = 0; j < 4; ++j) {
        o[2 * j] = bf2f((bf16_t)(au[j] & 0xffff)) + bf2f((bf16_t)(bu[j] & 0xffff));
        o[2 * j + 1] = bf2f((bf16_t)(au[j] >> 16)) + bf2f((bf16_t)(bu[j] >> 16));
        ss += o[2 * j] * o[2 * j] + o[2 * j + 1] * o[2 * j + 1];
      }
#pragma unroll
      for (int of = 8; of >= 1; of >>= 1) ss += __shfl_xor(ss, of);
      const float rstd = rsqrtf(ss * (1.f / 128.f) + 1e-6f);
      float y[8];
#pragma unroll
      for (int j = 0; j < 8; ++j) {
        const float zz = bf2f((bf16_t)((j & 1) ? (zu[j >> 1] >> 16) : (zu[j >> 1] & 0xffff)));
        y[j] = o[j] * rstd * p.gla_norm[l * 128 + ((c0 + j) & 127)] * fsilu(zz);
      }
      uint4 ov; ov.x = pk2(y[0], y[1]); ov.y = pk2(y[2], y[3]); ov.z = pk2(y[4], y[5]); ov.w = pk2(y[6], y[7]);
      *(uint4*)(MX + (size_t)r * DI + 1536 + c0) = ov;
    }
    {
      const uint4 a = *(const uint4*)(OB + ((size_t)2 * TH + r) * 512 + c0), b = *(const uint4*)(OB + ((size_t)3 * TH + r) * 512 + c0);
      const uint4 z = *(const uint4*)(hrow + S_Z + c0);
      const unsigned au[4] = {a.x, a.y, a.z, a.w}, bu[4] = {b.x, b.y, b.z, b.w}, zu[4] = {z.x, z.y, z.z, z.w};
      float u[8];
#pragma unroll
      for (int j = 0; j < 8; ++j) u[j] = cb[c0 + j];
      const int t = r & (SEQ - 1);
#pragma unroll
      for (int jj = 0; jj < 5; ++jj) {
        const int s = t + jj - 2;
        if (s >= 0 && s < SEQ) {
          const uint4 xr = *(const uint4*)(Hh + (size_t)(r + jj - 2) * NPAD + S_X + c0);
          const unsigned xu[4] = {xr.x, xr.y, xr.z, xr.w};
#pragma unroll
          for (int j = 0; j < 8; ++j) {
            const float xv = bf2f((bf16_t)((j & 1) ? (xu[j >> 1] >> 16) : (xu[j >> 1] & 0xffff)));
            u[j] += cw[jj * 1024 + c0 + j] * xv;
          }
        }
      }
      const float dsk = p.ssd_d[l * 8 + (c0 >> 6)];
      float y[8]; float ss = 0.f;
#pragma unroll
      for (int j = 0; j < 8; ++j) {
        const float of = bf2f((bf16_t)((j & 1) ? (au[j >> 1] >> 16) : (au[j >> 1] & 0xffff)));
        const float ob = bf2f((bf16_t)((j & 1) ? (bu[j >> 1] >> 16) : (bu[j >> 1] & 0xffff)));
        const float zz = bf2f((bf16_t)((j & 1) ? (zu[j >> 1] >> 16) : (zu[j >> 1] & 0xffff)));
        y[j] = (of + ob + dsk * fsilu(u[j])) * fsilu(zz);
        ss += y[j] * y[j];
      }
#pragma unroll
      for (int of = 32; of >= 1; of >>= 1) ss += __shfl_xor(ss, of);
      const float rstd = rsqrtf(ss * (1.f / 512.f) + 1e-6f);
#pragma unroll
      for (int j = 0; j < 8; ++j) y[j] = y[j] * rstd * p.ssd_norm[l * 512 + c0 + j];
      uint4 ov; ov.x = pk2(y[0], y[1]); ov.y = pk2(y[2], y[3]); ov.z = pk2(y[4], y[5]); ov.w = pk2(y[6], y[7]);
      *(uint4*)(MX + (size_t)r * DI + 1024 + c0) = ov;
    }
  }
}


#define XB_TMO      128
#define XB_XCNT(j)  (256  + 64 * (j))
#define XB_XSUB(j)  (1280 + 64 * (j))
#define XB_XGEN(j)  (2304 + 64 * (j))
#define XB_TOP      3328
#define XB_TOPGEN   3392
#define XB_SPIN_CAP (1u << 22)
#define LAS __attribute__((address_space(3)))
DEV unsigned xb_ld(unsigned* p) { return __hip_atomic_load(p, __ATOMIC_RELAXED, __HIP_MEMORY_SCOPE_AGENT); }
DEV unsigned xb_add(unsigned* p, unsigned v) { return __hip_atomic_fetch_add(p, v, __ATOMIC_RELAXED, __HIP_MEMORY_SCOPE_AGENT); }
DEV unsigned xb_xcc_id() { return (unsigned)__builtin_amdgcn_s_getreg((3 << 11) | 20) & 0xFu; }
#define XB_SPIN(cond, bar) do { unsigned _sp = 0; while (cond) { __builtin_amdgcn_s_sleep(1); \
    if ((++_sp & 255u) == 0u) { if (xb_ld(&(bar)[XB_TMO])) break; if (_sp > XB_SPIN_CAP) { atomicAdd(&(bar)[XB_TMO], 1u); break; } } } } while (0)
struct XcdBarrier { unsigned* bar; unsigned x; volatile LAS unsigned* st; };
DEV XcdBarrier xcd_barrier_post(unsigned* bar, volatile LAS unsigned* st) {
  XcdBarrier b; b.bar = bar; b.x = xb_xcc_id(); b.st = st;
  if (threadIdx.x == 0) (void)xb_add(&bar[XB_XCNT(b.x)], 1u);
  return b;
}
DEV void xcd_barrier_complete(unsigned* bar, unsigned x, unsigned& nloc, unsigned& nx) {
  const unsigned G = gridDim.x * gridDim.y * gridDim.z;
  unsigned sum, cnt, mine, sp = 0u;
  for (;;) {
    sum = 0u; cnt = 0u; mine = 0u;
#pragma unroll
    for (unsigned j = 0; j < 16; ++j) { const unsigned c = xb_ld(&bar[XB_XCNT(j)]); sum += c; cnt += (c > 0u) ? 1u : 0u; mine = (j == x) ? c : mine; }
    if (sum == G) break;
    __builtin_amdgcn_s_sleep(1);
    if ((++sp & 255u) == 0u) { if (xb_ld(&bar[XB_TMO])) break; if (sp > XB_SPIN_CAP) { atomicAdd(&bar[XB_TMO], 1u); break; } }
  }
  nloc = mine > 0u ? mine : 1u; nx = cnt > 0u ? cnt : 1u;
}
DEV void xcd_barrier(const XcdBarrier& b) {
  asm volatile("s_waitcnt vmcnt(0)" ::: "memory");
  __syncthreads();
  if (threadIdx.x == 0) {
    unsigned* bar = b.bar;
    __builtin_amdgcn_s_waitcnt(0);
    unsigned nloc = b.st[0], nx = b.st[1];
    if (nloc == 0u) { xcd_barrier_complete(bar, b.x, nloc, nx); b.st[0] = nloc; b.st[1] = nx; }
    const unsigned old = xb_add(&bar[XB_XSUB(b.x)], 1u);
    const unsigned gen = old / nloc;
    if (old + 1u == (gen + 1u) * nloc) {
      __builtin_amdgcn_fence(__ATOMIC_RELEASE, "agent");
      asm volatile("s_waitcnt vmcnt(0)" ::: "memory");
      const unsigned og = xb_add(&bar[XB_TOP], 1u);
      const unsigned tg = og / nx;
      if (og + 1u == (tg + 1u) * nx) xb_add(&bar[XB_TOPGEN], 1u);
      else XB_SPIN(xb_ld(&bar[XB_TOPGEN]) == tg, bar);
      __builtin_amdgcn_fence(__ATOMIC_ACQUIRE, "agent");
      xb_add(&bar[XB_XGEN(b.x)], 1u);
      asm volatile("s_waitcnt vmcnt(0)" ::: "memory");
    } else {
      XB_SPIN(xb_ld(&bar[XB_XGEN(b.x)]) == gen, bar);
      __builtin_amdgcn_fence(__ATOMIC_ACQUIRE, "agent");
      asm volatile("s_waitcnt vmcnt(0)" ::: "memory");
    }
  }
  __syncthreads();
}

#ifndef PROBE_ST
#define PROBE_ST -1
#endif
#ifndef PROBE_REP
#define PROBE_REP 0
#endif
#ifndef PROBE_LO
#define PROBE_LO 0
#endif
#ifndef PROBE_HI
#define PROBE_HI 320
#endif
DEV void run_phase(const Params& p, int ph, int rep, unsigned char* smem) {
  if (ph == 0) { if (PH_MASK & 1) phase_pro(p, smem); }
  else {
    const int q = ph - 1, l = q / 10, hf = (q / 5) & 1, st = q % 5;
    if (st == 0) { if (PH_MASK & 2) phase_inproj(p, l, hf, smem); }
    else if (st == 1) { if (PH_MASK & 0xF00) phase_mix(p, l, hf, ph + 32 * rep, rep ? PROBE_LO : 0, rep ? PROBE_HI : 320, smem); }
    else if (st == 2) { if (PH_MASK & 8) phase_fin(p, l, hf); }
    else if (st == 3) { if (PH_MASK & 16) phase_outproj(p, l, hf, smem); }
    else {
      if (PH_MASK & 32) phase_ln(p, l, hf);
      if ((PH_MASK & 1) && l == 0 && hf == 1) convert_weights(p, 1, smem);
    }
  }
}
__global__ void __launch_bounds__(NT) mega(Params p) {
  extern __shared__ __attribute__((aligned(16))) unsigned char smem[];
#if ONE_LAUNCH
  volatile LAS unsigned* xst = (volatile LAS unsigned*)(smem + LDS_BYTES - 32);
  if (threadIdx.x == 0) { xst[0] = 0u; xst[1] = 0u; }
  __syncthreads();
  XcdBarrier xb = xcd_barrier_post((unsigned*)(p.ws + OFF_CTRL), xst);
#endif
  for (int ph = p.phase_begin; ph < p.phase_end; ++ph) {
    run_phase(p, ph, 0, smem);
#if PROBE_REP > 0
    {
      const int q = ph - 1, l = q / 10, st = q % 5;
      const bool idem = (ph == 0) ? (PROBE_ST == 9) : (st == PROBE_ST && (st != 3 || l == 0));
      if (idem) for (int r = 1; r <= PROBE_REP; ++r) {
#if ONE_LAUNCH
        xcd_barrier(xb);
#endif
        run_phase(p, ph, r, smem);
      }
    }
#endif
#if ONE_LAUNCH
    if (ph + 1 < p.phase_end) xcd_barrier(xb);
#endif
  }
}

extern "C" void kernel_launch(void* const* d_in, const int* in_sizes, int n_in, void* d_out, int out_size, void* d_ws, size_t ws_size,
                              hipStream_t stream) {
  static int grid_blocks = 0;
  if (!grid_blocks) {
    int dev = 0, cus = 0, per_cu = 0;
    hipGetDevice(&dev);
    hipDeviceGetAttribute(&cus, hipDeviceAttributeMultiprocessorCount, dev);
    hipFuncSetAttribute((const void*)mega, hipFuncAttributeMaxDynamicSharedMemorySize, LDS_BYTES);
    hipOccupancyMaxActiveBlocksPerMultiprocessor(&per_cu, mega, NT, LDS_BYTES);
    if (per_cu < 1) per_cu = 1;
    grid_blocks = cus;
  }
  Params p{};
  p.x = (const float*)d_in[0]; p.w_in = (const float*)d_in[1]; p.q_gain = (const float*)d_in[2]; p.k_gain = (const float*)d_in[3];
  p.lb_logits = (const float*)d_in[4]; p.hgrn_norm = (const float*)d_in[5]; p.conv_w = (const float*)d_in[6]; p.conv_b = (const float*)d_in[7];
  p.dt_bias = (const float*)d_in[8]; p.a_log = (const float*)d_in[9]; p.ssd_d = (const float*)d_in[10]; p.ssd_norm = (const float*)d_in[11];
  p.gk_w2 = (const float*)d_in[12]; p.gk_b = (const float*)d_in[13]; p.gla_norm = (const float*)d_in[14]; p.w_out = (const float*)d_in[15];
  p.ln_g = (const float*)d_in[16]; p.ln_b = (const float*)d_in[17];
  p.out = (float*)d_out; p.ws = (unsigned char*)d_ws;
  hipMemsetAsync(d_ws, 0, CTRL_BYTES, stream);
#if ONE_LAUNCH
  p.phase_begin = 0; p.phase_end = NPHASE;
  void* args[] = {&p};
  (void)args;
  hipLaunchKernelGGL(mega, dim3(grid_blocks), dim3(NT), LDS_BYTES, stream, p);
#else
  for (int ph = 0; ph < NPHASE; ++ph) {
    p.phase_begin = ph; p.phase_end = ph + 1;
    hipLaunchKernelGGL(mega, dim3(grid_blocks), dim3(NT), LDS_BYTES, stream, p);
  }
#endif
}
```

```cpp
#include <hip/hip_runtime.h>
#include <hip/hip_cooperative_groups.h>
#include <stdint.h>
#include <stdio.h>
namespace cg = cooperative_groups;

#ifndef ONE_LAUNCH
#define ONE_LAUNCH 1
#endif

#ifndef PH_MASK
#define PH_MASK 0xFFF
#endif
#define DEV __device__ __forceinline__
typedef unsigned short bf16_t;
typedef short bf16x8 __attribute__((ext_vector_type(8)));
typedef float f32x16 __attribute__((ext_vector_type(16)));
typedef unsigned u32x4 __attribute__((ext_vector_type(4)));

constexpr int NT = 512;
constexpr int T_ALL = 16384, TH = 8192, SEQ = 4096, DM = 1024, NPAD = 7168, DI = 2048, NIN = 6960;
constexpr int A_Q = 0, A_K = 512, A_V = 640, A_Z = 768, H_Q = 1280, H_FF = 1792, H_FB = 2304, H_I = 2816, H_Z = 3328,
              S_X = 3840, S_Z = 4864, G_Q = 5376, G_K = 5632, G_V = 5888, G_Z = 6400, SM0 = 6912;
constexpr size_t OFF_CTRL = 0, OFF_TAB = 65536, OFF_XB = 131072;
constexpr size_t OFF_WIN = OFF_XB + (size_t)T_ALL * DM * 2;
constexpr size_t OFF_WOUT = OFF_WIN + (size_t)NPAD * DM * 2;
constexpr size_t OFF_H = OFF_WOUT + (size_t)DM * DI * 2;
constexpr size_t OFF_SMALL = OFF_H + (size_t)TH * NPAD * 2;
constexpr size_t OFF_MIXED = OFF_SMALL + (size_t)TH * 48 * 4;
constexpr size_t OFF_OBUF = OFF_MIXED + (size_t)TH * DI * 2;
constexpr size_t OFF_VT = OFF_OBUF + (size_t)6 * TH * 512 * 2;
constexpr size_t OFF_DB = OFF_VT + (size_t)2 * 2 * 64 * SEQ * 2;
constexpr int NSEG = 8, SLEN = 64 / NSEG;
constexpr size_t WS_END = OFF_DB + (size_t)64 * NSEG * 128 * 4;
constexpr size_t OFF_SB0 = OFF_MIXED, OFF_SB1 = OFF_SB0 + (size_t)16 * NSEG * 16384 * 4, OFF_SB2 = OFF_SB1 + (size_t)16 * NSEG * 8192 * 4;
static_assert(OFF_SB2 + (size_t)32 * NSEG * 8192 * 4 <= OFF_OBUF, "state buffers must fit in MIXED");
static_assert(WS_END <= 268435456, "workspace");
constexpr size_t CTRL_BYTES = 65536;
constexpr int CTR_WORD0 = 4096;
constexpr int LDS_BYTES = 148480;
constexpr float LOG2E = 1.4426950408889634f;
constexpr float QSCALE = 0.125f * LOG2E;
constexpr float DN_ALPHA = 1.4142135623730951f;
constexpr int NPHASE = 29;
constexpr int ATT_SPLIT = 144;

struct Params {
  const float* x; const float* w_in; const float* q_gain; const float* k_gain; const float* lb_logits; const float* hgrn_norm;
  const float* conv_w; const float* conv_b; const float* dt_bias; const float* a_log; const float* ssd_d; const float* ssd_norm;
  const float* gk_w2; const float* gk_b; const float* gla_norm; const float* w_out; const float* ln_g; const float* ln_b;
  float* out; unsigned char* ws;
  int phase_begin, phase_end;
};

DEV int launder(int v) { asm volatile("" : "+v"(v)); return v; }
DEV float bf2f(bf16_t v) { return __uint_as_float(((unsigned)v) << 16); }
DEV bf16_t f2bf(float f) { unsigned u = __float_as_uint(f); u += 0x7fffu + ((u >> 16) & 1u); return (bf16_t)(u >> 16); }
DEV unsigned pk2(float lo, float hi) { return (unsigned)f2bf(lo) | ((unsigned)f2bf(hi) << 16); }
DEV float fsigmoid(float x) { return 1.f / (1.f + __expf(-x)); }
DEV float fsilu(float x) { return x / (1.f + __expf(-x)); }
DEV int rowoff(int reg, int h) { return (reg & 3) + 8 * (reg >> 2) + 4 * h; }
DEV f32x16 zero16() { f32x16 z;
#pragma unroll
  for (int i = 0; i < 16; ++i) z[i] = 0.f; return z; }

template <int KD>
DEV void mma32(f32x16& acc, const bf16_t* a, int lda, const bf16_t* b, int ldb, int lane) {
  const int r = lane & 31, h = lane >> 5;
  const bf16_t* ap = a + r * lda + 8 * h;
  const bf16_t* bp = b + r * ldb + 8 * h;
#pragma unroll 4
  for (int k = 0; k < KD; k += 16) {
    bf16x8 av = *(const bf16x8*)(ap + k);
    bf16x8 bv = *(const bf16x8*)(bp + k);
    acc = __builtin_amdgcn_mfma_f32_32x32x16_bf16(av, bv, acc, 0, 0, 0);
  }
}

DEV int orig_col(int n) {
  if (n < 4864) return n;
  if (n < 6400) return n + 16;
  if (n < 6912) return n + 48;
  if (n < 6928) return n - 2048;
  if (n < 6960) return n - 512;
  return -1;
}

DEV void convert_weights(const Params& p, int l, unsigned char* smem) {
  float* s = (float*)smem;
  const int tid = launder(threadIdx.x);
  const float* win = p.w_in + (size_t)l * DM * NIN;
  const float* wout = p.w_out + (size_t)l * DI * DM;
  bf16_t* wint = (bf16_t*)(p.ws + OFF_WIN);
  bf16_t* woutt = (bf16_t*)(p.ws + OFF_WOUT);
  const int n_in_tiles = (NPAD / 64) * (DM / 64);
  const int n_out_tiles = (DM / 64) * (DI / 64);
  for (int it = blockIdx.x; it < n_in_tiles + n_out_tiles; it += gridDim.x) {
    __syncthreads();
    if (it < n_in_tiles) {
      const int n0 = (it / 16) * 64, k0 = (it % 16) * 64;
#pragma unroll
      for (int e = 0; e < 8; ++e) {
        const int idx = e * NT + tid, kk = idx >> 6, nn = idx & 63;
        const int oc = orig_col(n0 + nn);
        s[kk * 65 + nn] = (oc >= 0) ? win[(size_t)(k0 + kk) * NIN + oc] : 0.f;
      }
      __syncthreads();
      const int n = tid >> 3, kc = (tid & 7) * 8;
      uint4 o;
      o.x = pk2(s[(kc + 0) * 65 + n], s[(kc + 1) * 65 + n]); o.y = pk2(s[(kc + 2) * 65 + n], s[(kc + 3) * 65 + n]);
      o.z = pk2(s[(kc + 4) * 65 + n], s[(kc + 5) * 65 + n]); o.w = pk2(s[(kc + 6) * 65 + n], s[(kc + 7) * 65 + n]);
      *(uint4*)(wint + (size_t)(n0 + n) * DM + k0 + kc) = o;
    } else {
      const int j = it - n_in_tiles;
      const int n0 = (j / 32) * 64, k0 = (j % 32) * 64;
#pragma unroll
      for (int e = 0; e < 8; ++e) {
        const int idx = e * NT + tid, kk = idx >> 6, nn = idx & 63;
        s[kk * 65 + nn] = wout[(size_t)(k0 + kk) * DM + n0 + nn];
      }
      __syncthreads();
      const int n = tid >> 3, kc = (tid & 7) * 8;
      uint4 o;
      o.x = pk2(s[(kc + 0) * 65 + n], s[(kc + 1) * 65 + n]); o.y = pk2(s[(kc + 2) * 65 + n], s[(kc + 3) * 65 + n]);
      o.z = pk2(s[(kc + 4) * 65 + n], s[(kc + 5) * 65 + n]); o.w = pk2(s[(kc + 6) * 65 + n], s[(kc + 7) * 65 + n]);
      *(uint4*)(woutt + (size_t)(n0 + n) * DI + k0 + kc) = o;
    }
  }
  __syncthreads();
}

DEV void dsincos(double x, double& s, double& c) {
  const double k = rint(x * 0.63661977236758134308);
  double r = fma(-k, 1.57079632679489655800e+00, x);
  r = fma(-k, 6.12323399573676603587e-17, r);
  const double r2 = r * r;
  const double t3 = r2 * r, t5 = t3 * r2, t7 = t5 * r2, t9 = t7 * r2, t11 = t9 * r2, t13 = t11 * r2, t15 = t13 * r2;
  const double sinr = r - t3 / 6.0 + t5 / 120.0 - t7 / 5040.0 + t9 / 362880.0 - t11 / 39916800.0 + t13 / 6227020800.0 - t15 / 1307674368000.0;
  const double u2 = r2, u4 = u2 * u2, u6 = u4 * u2, u8 = u6 * u2, u10 = u8 * u2, u12 = u10 * u2, u14 = u12 * u2, u16 = u14 * u2;
  const double cosr = 1.0 - u2 / 2.0 + u4 / 24.0 - u6 / 720.0 + u8 / 40320.0 - u10 / 3628800.0 + u12 / 479001600.0 - u14 / 87178291200.0 + u16 / 20922789888000.0;
  const int q = ((int)k) & 3;
  if (q == 0) { s = sinr; c = cosr; }
  else if (q == 1) { s = cosr; c = -sinr; }
  else if (q == 2) { s = -sinr; c = -cosr; }
  else { s = -cosr; c = sinr; }
}

DEV void phase_pro(const Params& p, unsigned char* smem) {
  const int tid = launder(threadIdx.x);
  const size_t gtid = (size_t)blockIdx.x * NT + tid, gsz = (size_t)gridDim.x * NT;
  const float4* x4 = (const float4*)p.x;
  uint4* xb4 = (uint4*)(p.ws + OFF_XB);
  for (size_t i = gtid; i < (size_t)T_ALL * DM / 8; i += gsz) {
    const float4 a = x4[2 * i], b = x4[2 * i + 1];
    uint4 o; o.x = pk2(a.x, a.y); o.y = pk2(a.z, a.w); o.z = pk2(b.x, b.y); o.w = pk2(b.z, b.w);
    xb4[i] = o;
  }
  if (blockIdx.x == 0) {
    float2* tab = (float2*)(p.ws + OFF_TAB);
    for (int i = tid; i < 64 * 16; i += NT) {
      const int pos = i >> 4, fi = i & 15;
      const float invf = (float)exp(-(double)fi * (9.210340371976184 / 16.0));
      const float ang = (float)pos * invf;
      double s, c; dsincos((double)ang, s, c);
      tab[i] = make_float2((float)c, (float)s);
    }
  }
  convert_weights(p, 0, smem);
}

DEV void gemm_block(const bf16_t* __restrict__ A, int lda, const bf16_t* __restrict__ A2, int lda2, int ksplit, const bf16_t* __restrict__ Bt, int ldb, int nk, unsigned char* smem, f32x16 (&acc)[2][2]) {
  const int tid = launder(threadIdx.x), lane = tid & 63, w = tid >> 6, wr = w >> 2, wc = w & 3, r = lane & 31, h = lane >> 5;
  const int ar = tid >> 2, ac = (tid & 3) * 16;
  const int br = tid >> 1, bc = (tid & 1) * 32;
  const bf16_t* ag = A + (size_t)ar * lda + ac;
  const bf16_t* ag2 = A2 + (size_t)ar * lda2 + ac;
  const bf16_t* bg = Bt + (size_t)br * ldb + bc;
  uint4 ra0, ra1, rb0, rb1, rb2, rb3;
#pragma unroll
  for (int i = 0; i < 2; ++i)
#pragma unroll
    for (int j = 0; j < 2; ++j) acc[i][j] = zero16();
  {
    const uint4* pa = (const uint4*)((0 < ksplit) ? ag : ag2); ra0 = pa[0]; ra1 = pa[1];
    const uint4* pb = (const uint4*)bg; rb0 = pb[0]; rb1 = pb[1]; rb2 = pb[2]; rb3 = pb[3];
    uint4* sa = (uint4*)(smem + ar * 144 + ac * 2); sa[0] = ra0; sa[1] = ra1;
    uint4* sb = (uint4*)(smem + 18432 + br * 144 + bc * 2); sb[0] = rb0; sb[1] = rb1; sb[2] = rb2; sb[3] = rb3;
  }
  __syncthreads();
  for (int kt = 0; kt < nk; ++kt) {
    if (kt + 1 < nk) {
      const uint4* pa = (const uint4*)((kt + 1 < ksplit) ? (ag + (kt + 1) * 64) : (ag2 + (kt + 1 - ksplit) * 64)); ra0 = pa[0]; ra1 = pa[1];
      const uint4* pb = (const uint4*)(bg + (kt + 1) * 64); rb0 = pb[0]; rb1 = pb[1]; rb2 = pb[2]; rb3 = pb[3];
    }
    const bf16_t* sa = (const bf16_t*)(smem + (kt & 1) * 55296);
    const bf16_t* sb = (const bf16_t*)(smem + (kt & 1) * 55296 + 18432);
#pragma unroll
    for (int ks = 0; ks < 4; ++ks) {
      const bf16x8 a0 = *(const bf16x8*)(sa + (wr * 64 + r) * 72 + ks * 16 + 8 * h);
      const bf16x8 a1 = *(const bf16x8*)(sa + (wr * 64 + 32 + r) * 72 + ks * 16 + 8 * h);
      const bf16x8 b0 = *(const bf16x8*)(sb + (wc * 64 + r) * 72 + ks * 16 + 8 * h);
      const bf16x8 b1 = *(const bf16x8*)(sb + (wc * 64 + 32 + r) * 72 + ks * 16 + 8 * h);
      acc[0][0] = __builtin_amdgcn_mfma_f32_32x32x16_bf16(a0, b0, acc[0][0], 0, 0, 0);
      acc[0][1] = __builtin_amdgcn_mfma_f32_32x32x16_bf16(a0, b1, acc[0][1], 0, 0, 0);
      acc[1][0] = __builtin_amdgcn_mfma_f32_32x32x16_bf16(a1, b0, acc[1][0], 0, 0, 0);
      acc[1][1] = __builtin_amdgcn_mfma_f32_32x32x16_bf16(a1, b1, acc[1][1], 0, 0, 0);
    }
    if (kt + 1 < nk) {
      unsigned char* base = smem + ((kt + 1) & 1) * 55296;
      uint4* sa2 = (uint4*)(base + ar * 144 + ac * 2); sa2[0] = ra0; sa2[1] = ra1;
      uint4* sb2 = (uint4*)(base + 18432 + br * 144 + bc * 2); sb2[0] = rb0; sb2[1] = rb1; sb2[2] = rb2; sb2[3] = rb3;
    }
    __syncthreads();
  }
}

DEV void phase_inproj(const Params& p, int l, int hf, unsigned char* smem) {
  const int tid = launder(threadIdx.x), lane = tid & 63, w = tid >> 6, wr = w >> 2, wc = w & 3, c = lane & 31, h = lane >> 5;
  const bf16_t* A = (const bf16_t*)(p.ws + OFF_XB) + (size_t)hf * TH * DM;
  const bf16_t* Bt = (const bf16_t*)(p.ws + OFF_WIN);
  bf16_t* Hh = (bf16_t*)(p.ws + OFF_H);
  float* SMALL = (float*)(p.ws + OFF_SMALL);
  bf16_t* VT = (bf16_t*)(p.ws + OFF_VT);
  const float2* tab = (const float2*)(p.ws + OFF_TAB);
  const int n_items = (TH / 128) * (NPAD / 256);
  for (int it = blockIdx.x; it < n_items; it += gridDim.x) {
    const int pn = it % 28, pm = it / 28;
    f32x16 acc[2][2];
    gemm_block(A + (size_t)pm * 128 * DM, DM, A, DM, DM / 64, Bt + (size_t)pn * 256 * DM, DM, DM / 64, smem, acc);
    const int colbase = pn * 256 + wc * 64;
    const int rowb = pm * 128 + wr * 64;
    if (colbase == SM0) {
#pragma unroll
      for (int mi = 0; mi < 2; ++mi)
#pragma unroll
        for (int reg = 0; reg < 16; ++reg) {
          const int row = rowb + mi * 32 + rowoff(reg, h);
          SMALL[(size_t)row * 48 + c] = acc[mi][0][reg];
          if (c < 16) SMALL[(size_t)row * 48 + 32 + c] = acc[mi][1][reg];
        }
    } else if (colbase < SM0) {
      if (colbase < A_V) {
        const bool isq = colbase < A_K;
        const float* gain = (isq ? p.q_gain : p.k_gain) + l * 64;
        const float g0 = gain[c], g1 = gain[32 + c];
        const float osc = isq ? QSCALE : 1.f;
#pragma unroll
        for (int mi = 0; mi < 2; ++mi)
#pragma unroll
          for (int reg = 0; reg < 16; ++reg) {
            float ss = acc[mi][0][reg] * acc[mi][0][reg] + acc[mi][1][reg] * acc[mi][1][reg];
            ss += __shfl_xor(ss, 1); ss += __shfl_xor(ss, 2); ss += __shfl_xor(ss, 4); ss += __shfl_xor(ss, 8); ss += __shfl_xor(ss, 16);
            const float rstd = rsqrtf(ss * (1.f / 64.f) + 1e-6f);
            const int row = rowb + mi * 32 + rowoff(reg, h);
            const int t = row & (SEQ - 1);
            const float2 cs0 = tab[(t >> 6) * 16 + (c & 15)], cs1 = tab[(t & 63) * 16 + (c & 15)];
            const float v0 = acc[mi][0][reg] * rstd * g0, v1 = acc[mi][1][reg] * rstd * g1;
            const float p0 = __shfl_xor(v0, 16), p1 = __shfl_xor(v1, 16);
            const float o0 = (c & 16) ? (v0 * cs0.x + p0 * cs0.y) : (v0 * cs0.x - p0 * cs0.y);
            const float o1 = (c & 16) ? (v1 * cs1.x + p1 * cs1.y) : (v1 * cs1.x - p1 * cs1.y);
            acc[mi][0][reg] = o0 * osc; acc[mi][1][reg] = o1 * osc;
          }
      }
      if (colbase >= A_V && colbase < A_Z) {
        const int kvh = (colbase - A_V) >> 6;
#pragma unroll
        for (int mi = 0; mi < 2; ++mi)
#pragma unroll
          for (int ni = 0; ni < 2; ++ni)
#pragma unroll
            for (int g = 0; g < 4; ++g) {
              const int row = rowb + mi * 32 + 8 * g + 4 * h;
              const int bl = row >> 12, t = row & (SEQ - 1);
              const int d = ni * 32 + c;
              uint2 o; o.x = pk2(acc[mi][ni][4 * g + 0], acc[mi][ni][4 * g + 1]); o.y = pk2(acc[mi][ni][4 * g + 2], acc[mi][ni][4 * g + 3]);
              *(uint2*)(VT + ((size_t)((bl * 2 + kvh) * 64 + d)) * SEQ + t) = o;
            }
      } else {
        bf16_t* so = (bf16_t*)(smem + w * 9216);
#pragma unroll
        for (int mi = 0; mi < 2; ++mi)
#pragma unroll
          for (int ni = 0; ni < 2; ++ni)
#pragma unroll
            for (int reg = 0; reg < 16; ++reg)
              so[(mi * 32 + rowoff(reg, h)) * 72 + ni * 32 + c] = f2bf(acc[mi][ni][reg]);
        __builtin_amdgcn_s_waitcnt(0xc07f);
        __builtin_amdgcn_wave_barrier();
#pragma unroll
        for (int i = 0; i < 8; ++i) {
          const int rr = i * 8 + (lane >> 3), ch = lane & 7;
          const uint4 v = *(const uint4*)(so + rr * 72 + ch * 8);
          *(uint4*)(Hh + (size_t)(rowb + rr) * NPAD + colbase + ch * 8) = v;
        }
      }
    }
    __syncthreads();
  }
}

DEV void phase_outproj(const Params& p, int l, int hf, unsigned char* smem) {
  const int tid = launder(threadIdx.x), lane = tid & 63, w = tid >> 6, wr = w >> 2, wc = w & 3, c = lane & 31, h = lane >> 5;
  const bf16_t* A = (const bf16_t*)(p.ws + OFF_MIXED);
  const bf16_t* Hat = (const bf16_t*)(p.ws + OFF_H) + A_Q;
  const bf16_t* Bt = (const bf16_t*)(p.ws + OFF_WOUT);
  const float* xin = (l == 0) ? p.x : p.out;
  const int n_items = (TH / 128) * (DM / 256);
  for (int it = blockIdx.x; it < n_items; it += gridDim.x) {
    const int pn = it & 3, pm = it >> 2;
    f32x16 acc[2][2];
    gemm_block(Hat + (size_t)pm * 128 * NPAD, NPAD, A + (size_t)pm * 128 * DI + 512, DI, 8, Bt + (size_t)pn * 256 * DI, DI, DI / 64, smem, acc);
#pragma unroll
    for (int mi = 0; mi < 2; ++mi)
#pragma unroll
      for (int ni = 0; ni < 2; ++ni)
#pragma unroll
        for (int reg = 0; reg < 16; ++reg) {
          const int row = hf * TH + pm * 128 + wr * 64 + mi * 32 + rowoff(reg, h);
          const int col = pn * 256 + wc * 64 + ni * 32 + c;
          const size_t idx = (size_t)row * DM + col;
          p.out[idx] = DN_ALPHA * xin[idx] + acc[mi][ni][reg];
        }
    __syncthreads();
  }
}

DEV void phase_ln(const Params& p, int l, int hf) {
  const int tid = launder(threadIdx.x), lane = tid & 63, w = tid >> 6;
  const float* g = p.ln_g + l * DM; const float* b = p.ln_b + l * DM;
  bf16_t* xb = (bf16_t*)(p.ws + OFF_XB);
  for (int r = blockIdx.x * 8 + w; r < TH; r += gridDim.x * 8) {
    const int row = hf * TH + r;
    float4* rp = (float4*)(p.out + (size_t)row * DM);
    float4 v[4];
    float s = 0.f;
#pragma unroll
    for (int j = 0; j < 4; ++j) { v[j] = rp[j * 64 + lane]; s += (v[j].x + v[j].y) + (v[j].z + v[j].w); }
#pragma unroll
    for (int o = 32; o >= 1; o >>= 1) s += __shfl_xor(s, o);
    const float mu = s * (1.f / DM);
    float q = 0.f;
#pragma unroll
    for (int j = 0; j < 4; ++j) { const float a = v[j].x - mu, bb = v[j].y - mu, cc = v[j].z - mu, d = v[j].w - mu; q += (a * a + bb * bb) + (cc * cc + d * d); }
#pragma unroll
    for (int o = 32; o >= 1; o >>= 1) q += __shfl_xor(q, o);
    const float rstd = rsqrtf(q * (1.f / DM) + 1e-5f);
#pragma unroll
    for (int j = 0; j < 4; ++j) {
      const int col = (j * 64 + lane) * 4;
      const float4 gg = *(const float4*)(g + col), bb = *(const float4*)(b + col);
      float4 o;
      o.x = (v[j].x - mu) * rstd * gg.x + bb.x; o.y = (v[j].y - mu) * rstd * gg.y + bb.y;
      o.z = (v[j].z - mu) * rstd * gg.z + bb.z; o.w = (v[j].w - mu) * rstd * gg.w + bb.w;
      rp[j * 64 + lane] = o;
      if (l == 0) { uint2 pk; pk.x = pk2(o.x, o.y); pk.y = pk2(o.z, o.w); *(uint2*)(xb + (size_t)row * DM + col) = pk; }
    }
  }
}

DEV void attn_item(const Params& p, int l, int item, unsigned char* smem) {
  const int tid = launder(threadIdx.x), lane = tid & 63, w = tid >> 6, r = lane & 31, h = lane >> 5;
  const int qt = item & 15, head = (item >> 4) & 7, bl = item >> 7;
  const int kvh = head >> 2;
  bf16_t* Hh = (bf16_t*)(p.ws + OFF_H);
  const bf16_t* VT = (const bf16_t*)(p.ws + OFF_VT);
  const size_t rowbase = (size_t)bl * SEQ;
  float mq = fabsf(p.q_gain[l * 64 + lane]), mk = fabsf(p.k_gain[l * 64 + lane]);
#pragma unroll
  for (int o = 32; o >= 1; o >>= 1) { mq = fmaxf(mq, __shfl_xor(mq, o)); mk = fmaxf(mk, __shfl_xor(mk, o)); }
  const float M2 = 8.f * mq * mk * LOG2E * 1.01f;
  const int qrow = qt * 256 + w * 32 + r;
  const bf16_t* qp = Hh + (rowbase + qrow) * NPAD + A_Q + head * 64 + 8 * h;
  bf16x8 qf[4];
#pragma unroll
  for (int ks = 0; ks < 4; ++ks) qf[ks] = *(const bf16x8*)(qp + ks * 16);
  f32x16 o0 = zero16(), o1 = zero16();
  float lsum = 0.f;
  const int srow = tid >> 3, sch = (tid & 7) * 8;
  const bf16_t* kp = Hh + (rowbase + srow) * NPAD + A_K + kvh * 64 + sch;
  const bf16_t* vp = VT + ((size_t)((bl * 2 + kvh) * 64 + srow)) * SEQ + sch;
  uint4 rk = *(const uint4*)kp, rv = *(const uint4*)vp;
  *(uint4*)(smem + srow * 144 + sch * 2) = rk;
  *(uint4*)(smem + 9216 + srow * 144 + sch * 2) = rv;
  __syncthreads();
  for (int kt = 0; kt < SEQ / 64; ++kt) {
    if (kt + 1 < SEQ / 64) { rk = *(const uint4*)(kp + (size_t)(kt + 1) * 64 * NPAD); rv = *(const uint4*)(vp + (kt + 1) * 64); }
    const bf16_t* sK = (const bf16_t*)(smem + (kt & 1) * 18432);
    const bf16_t* sV = (const bf16_t*)(smem + (kt & 1) * 18432 + 9216);
    f32x16 s0 = zero16(), s1 = zero16();
#pragma unroll
    for (int ks = 0; ks < 4; ++ks) {
      const bf16x8 a0 = *(const bf16x8*)(sK + r * 72 + ks * 16 + 8 * h);
      const bf16x8 a1 = *(const bf16x8*)(sK + (32 + r) * 72 + ks * 16 + 8 * h);
      s0 = __builtin_amdgcn_mfma_f32_32x32x16_bf16(a0, qf[ks], s0, 0, 0, 0);
      s1 = __builtin_amdgcn_mfma_f32_32x32x16_bf16(a1, qf[ks], s1, 0, 0, 0);
    }
#pragma unroll
    for (int i = 0; i < 16; ++i) { s0[i] = __builtin_amdgcn_exp2f(s0[i] - M2); s1[i] = __builtin_amdgcn_exp2f(s1[i] - M2); lsum += s0[i] + s1[i]; }
    union { bf16x8 v; unsigned u[4]; } pb[2][2];
#pragma unroll
    for (int s = 0; s < 2; ++s)
#pragma unroll
      for (int j = 0; j < 4; ++j) {
        pb[0][s].u[j] = pk2(s0[8 * s + 2 * j], s0[8 * s + 2 * j + 1]);
        pb[1][s].u[j] = pk2(s1[8 * s + 2 * j], s1[8 * s + 2 * j + 1]);
      }
#pragma unroll
    for (int kt2 = 0; kt2 < 2; ++kt2)
#pragma unroll
      for (int s = 0; s < 2; ++s) {
        const int kb = kt2 * 32 + 16 * s + 4 * h;
        union { bf16x8 v; uint2 u[2]; } a0, a1;
        a0.u[0] = *(const uint2*)(sV + r * 72 + kb); a0.u[1] = *(const uint2*)(sV + r * 72 + kb + 8);
        a1.u[0] = *(const uint2*)(sV + (32 + r) * 72 + kb); a1.u[1] = *(const uint2*)(sV + (32 + r) * 72 + kb + 8);
        o0 = __builtin_amdgcn_mfma_f32_32x32x16_bf16(a0.v, pb[kt2][s].v, o0, 0, 0, 0);
        o1 = __builtin_amdgcn_mfma_f32_32x32x16_bf16(a1.v, pb[kt2][s].v, o1, 0, 0, 0);
      }
    if (kt + 1 < SEQ / 64) {
      unsigned char* base = smem + ((kt + 1) & 1) * 18432;
      *(uint4*)(base + srow * 144 + sch * 2) = rk;
      *(uint4*)(base + 9216 + srow * 144 + sch * 2) = rv;
    }
    __syncthreads();
  }
  lsum += __shfl_xor(lsum, 32);
  const float inv = 1.f / lsum;
  const bf16_t* zp = Hh + (rowbase + qrow) * NPAD + A_Z + head * 64;
  bf16_t* op = Hh + (rowbase + qrow) * NPAD + A_Q + head * 64;
#pragma unroll
  for (int dt = 0; dt < 2; ++dt)
#pragma unroll
    for (int g = 0; g < 4; ++g) {
      const int d0 = dt * 32 + 8 * g + 4 * h;
      const uint2 zz = *(const uint2*)(zp + d0);
      const float z0 = bf2f((bf16_t)(zz.x & 0xffff)), z1 = bf2f((bf16_t)(zz.x >> 16)), z2 = bf2f((bf16_t)(zz.y & 0xffff)), z3 = bf2f((bf16_t)(zz.y >> 16));
      const f32x16& oo = dt ? o1 : o0;
      uint2 ov;
      ov.x = pk2(oo[4 * g + 0] * inv * fsilu(z0), oo[4 * g + 1] * inv * fsilu(z1));
      ov.y = pk2(oo[4 * g + 2] * inv * fsilu(z2), oo[4 * g + 3] * inv * fsilu(z3));
      *(uint2*)(op + d0) = ov;
    }
  __syncthreads();
}

constexpr int L_QT = 0, L_KT = 17408, L_QC = 34816, L_KHT = 52224, L_VT = 70656, L_P = 89088, L_ST = 98304, L_RAW = 89088,
              L_D = 138240, L_TOT = 138752, L_ACS = 142848, L_DT = 143104, L_LOW = 143360;

template <int K, int V> struct ScanGeom {
  static constexpr int KP = K + 8;
  static constexpr int NS = (K / 32) * (V / 32) / 8;
};

template <int K, int V>
DEV void scan_write_state(unsigned char* smem, const f32x16* S, int w, int lane) {
  constexpr int KP = K + 8, NS = ScanGeom<K, V>::NS, NVT = V / 32;
  bf16_t* sST = (bf16_t*)(smem + L_ST);
  const int c = lane & 31, h = lane >> 5;
#pragma unroll
  for (int i = 0; i < NS; ++i) {
    const int tile = w * NS + i, kt = tile / NVT, nt = tile % NVT;
#pragma unroll
    for (int g = 0; g < 4; ++g) {
      uint2 o; o.x = pk2(S[i][4 * g + 0], S[i][4 * g + 1]); o.y = pk2(S[i][4 * g + 2], S[i][4 * g + 3]);
      *(uint2*)(sST + (nt * 32 + c) * KP + kt * 32 + 8 * g + 4 * h) = o;
    }
  }
}

template <int K, int V, bool SSDM>
DEV void scan_core(unsigned char* smem, f32x16* S, bf16_t* orow0, int dir, int w, int lane, bool do_out) {
  constexpr int KP = K + 8, NS = ScanGeom<K, V>::NS, NVT = V / 32, NOT = 2 * NVT;
  const bf16_t* sQt = (const bf16_t*)(smem + L_QT); const bf16_t* sKt = (const bf16_t*)(smem + L_KT);
  const bf16_t* sQc = (const bf16_t*)(smem + L_QC); const bf16_t* sKhT = (const bf16_t*)(smem + L_KHT);
  const bf16_t* sVT = (const bf16_t*)(smem + L_VT); bf16_t* sP = (bf16_t*)(smem + L_P);
  const bf16_t* sST = (const bf16_t*)(smem + L_ST); const float* sD = (const float*)(smem + L_D);
  const float* sAcs = (const float*)(smem + L_ACS);
  const int c = lane & 31, h = lane >> 5;
  if (do_out) scan_write_state<K, V>(smem, S, w, lane);
  if (do_out && w < 4) {
    const int tt = w >> 1, st = w & 1;
    f32x16 acc = zero16();
    if (st <= tt) mma32<K>(acc, sQt + tt * 32 * KP, KP, sKt + st * 32 * KP, KP, lane);
#pragma unroll
    for (int reg = 0; reg < 16; ++reg) {
      const int tau = tt * 32 + rowoff(reg, h), sig = st * 32 + c;
      float v = 0.f;
      if (sig <= tau) { v = acc[reg]; if (SSDM) v *= __expf(sAcs[tau] - sAcs[sig]); }
      sP[tau * 72 + sig] = f2bf(v);
    }
  }
  __syncthreads();
  if (do_out && w < NOT) {
    const int tt = w / NVT, nt = w % NVT;
    f32x16 acc = zero16();
    mma32<64>(acc, sP + tt * 32 * 72, 72, sVT + nt * 32 * 72, 72, lane);
    mma32<K>(acc, sQc + tt * 32 * KP, KP, sST + nt * 32 * KP, KP, lane);
#pragma unroll
    for (int reg = 0; reg < 16; ++reg) {
      const int tau = tt * 32 + rowoff(reg, h);
      const int tok = dir ? (63 - tau) : tau;
      orow0[(size_t)tok * 512 + nt * 32 + c] = f2bf(acc[reg]);
    }
  }
#pragma unroll
  for (int i = 0; i < NS; ++i) {
    const int tile = w * NS + i, kt = tile / NVT, nt = tile % NVT;
#pragma unroll
    for (int reg = 0; reg < 16; ++reg) S[i][reg] *= sD[kt * 32 + rowoff(reg, h)];
    mma32<64>(S[i], sKhT + kt * 32 * 72, 72, sVT + nt * 32 * 72, 72, lane);
  }
  __syncthreads();
}

template <int K, int V>
DEV void state_store(float* buf, const f32x16* S, int w, int lane) {
  constexpr int NS = ScanGeom<K, V>::NS, NVT = V / 32;
  const int c = lane & 31, h = lane >> 5;
#pragma unroll
  for (int i = 0; i < NS; ++i) {
    const int tile = w * NS + i, kt = tile / NVT, nt = tile % NVT;
#pragma unroll
    for (int reg = 0; reg < 16; ++reg) buf[(kt * 32 + rowoff(reg, h)) * V + nt * 32 + c] = S[i][reg];
  }
}
template <int K, int V>
DEV void state_load(const float* buf, f32x16* S, int w, int lane) {
  constexpr int NS = ScanGeom<K, V>::NS, NVT = V / 32;
  const int c = lane & 31, h = lane >> 5;
#pragma unroll
  for (int i = 0; i < NS; ++i) {
    const int tile = w * NS + i, kt = tile / NVT, nt = tile % NVT;
#pragma unroll
    for (int reg = 0; reg < 16; ++reg) S[i][reg] = buf[(kt * 32 + rowoff(reg, h)) * V + nt * 32 + c];
  }
}

DEV void store16(bf16_t* dst, const float* v) {
  uint4 a, b;
  a.x = pk2(v[0], v[1]); a.y = pk2(v[2], v[3]); a.z = pk2(v[4], v[5]); a.w = pk2(v[6], v[7]);
  b.x = pk2(v[8], v[9]); b.y = pk2(v[10], v[11]); b.z = pk2(v[12], v[13]); b.w = pk2(v[14], v[15]);
  ((uint4*)dst)[0] = a; ((uint4*)dst)[1] = b;
}
DEV void gather16(bf16_t* dst, const bf16_t* src, int stride) {
  unsigned u[8];
#pragma unroll
  for (int i = 0; i < 8; ++i) u[i] = (unsigned)src[(2 * i) * stride] | ((unsigned)src[(2 * i + 1) * stride] << 16);
  ((uint4*)dst)[0] = make_uint4(u[0], u[1], u[2], u[3]); ((uint4*)dst)[1] = make_uint4(u[4], u[5], u[6], u[7]);
}

DEV void hgrn_item(const Params& p, int l, int it, int seg, int mode, unsigned char* smem) {
  const int bl = it >> 3, head = (it >> 1) & 3, dir = it & 1;
  const bool do_out = (mode == 3);
  constexpr int K = 128, V = 128, KP = 136;
  const int tid = launder(threadIdx.x), lane = tid & 63, w = tid >> 6;
  const int ch = tid & 127, qd = tid >> 7;
  const bf16_t* Hh = (const bf16_t*)(p.ws + OFF_H);
  bf16_t* OB = (bf16_t*)(p.ws + OFF_OBUF) + (size_t)(0 * 2 + dir) * TH * 512;
  const size_t rowbase = (size_t)bl * SEQ;
  float lbv = 0.f;
  if (l > 0) lbv = fsigmoid(p.lb_logits[512 + head * 128 + ch] - p.lb_logits[head * 128 + ch]);
  const int fbase = dir ? H_FB : H_FF;
  bf16_t* sQt = (bf16_t*)(smem + L_QT); bf16_t* sKt = (bf16_t*)(smem + L_KT); bf16_t* sQc = (bf16_t*)(smem + L_QC);
  bf16_t* sKhT = (bf16_t*)(smem + L_KHT); bf16_t* sVT = (bf16_t*)(smem + L_VT);
  float* sD = (float*)(smem + L_D); float* sTot = (float*)(smem + L_TOT);
  const bf16_t* rawQ = (const bf16_t*)(smem + L_RAW); const bf16_t* rawF = rawQ + 8192; const bf16_t* rawV = rawQ + 16384;
  f32x16 S[2]; S[0] = zero16(); S[1] = zero16();
  float* sbuf = (float*)(p.ws + OFF_SB0) + ((size_t)it * NSEG + seg) * 16384;
  if (do_out) state_load<K, V>(sbuf, S, w, lane);
  float dlog = 0.f;
  u32x4 pre[6];
  const int prow0 = tid >> 4, pc16 = (tid & 15) * 8;
  auto gload = [&](int cidx) __attribute__((always_inline)) {
    const int chunk = dir ? (63 - cidx) : cidx;
#pragma unroll
    for (int j = 0; j < 2; ++j) {
      const int row = prow0 + 32 * j;
      const int tok = chunk * 64 + (dir ? (63 - row) : row);
      const bf16_t* rp = Hh + (rowbase + tok) * NPAD + head * 128 + pc16;
      pre[j] = *(const u32x4*)(rp + H_Q); pre[2 + j] = *(const u32x4*)(rp + fbase); pre[4 + j] = *(const u32x4*)(rp + H_I);
    }
  };
  gload(seg * SLEN);
  for (int ci = 0; ci < SLEN; ++ci) {
    const int cidx = seg * SLEN + ci;
    const int chunk = dir ? (63 - cidx) : cidx;
#pragma unroll
    for (int j = 0; j < 2; ++j) {
      unsigned char* d = smem + L_RAW + (prow0 + 32 * j) * 256 + pc16 * 2;
      *(u32x4*)d = pre[j]; *(u32x4*)(d + 16384) = pre[2 + j]; *(u32x4*)(d + 32768) = pre[4 + j];
    }
    __syncthreads();
    if (ci + 1 < SLEN) gload(cidx + 1);
    float run = 0.f;
#pragma unroll 1
    for (int i0 = 0; i0 < 16; i0 += 4) {
#pragma unroll
      for (int ii = 0; ii < 4; ++ii) {
        const float f = bf2f(rawF[(16 * qd + i0 + ii) * 128 + ch]);
        const float sg = 1.f / (1.f + __expf(-f));
        run += __logf(lbv + (1.f - lbv) * sg);
      }
    }
    sTot[qd * 128 + ch] = run;
    __syncthreads();
    const float t0 = sTot[ch], t1 = sTot[128 + ch], t2 = sTot[256 + ch], t3 = sTot[384 + ch];
    const float off = (qd > 0 ? t0 : 0.f) + (qd > 1 ? t1 : 0.f) + (qd > 2 ? t2 : 0.f);
    const float ref = t0 + t1, bend = (t0 + t1) + (t2 + t3);
    dlog += bend;
    float b = off;
#pragma unroll 1
    for (int i0 = 0; i0 < 16; i0 += 4) {
      float kh4[4]; unsigned vb[4];
#pragma unroll
      for (int ii = 0; ii < 4; ++ii) {
        const int tau = 16 * qd + i0 + ii;
        const float f = bf2f(rawF[tau * 128 + ch]);
        const float sg = 1.f / (1.f + __expf(-f));
        b += __logf(lbv + (1.f - lbv) * sg);
        const float kx = (1.f - lbv) / (1.f + __expf(f));
        if (do_out) {
          const float qr = bf2f(rawQ[tau * 128 + ch]);
          const float qx = qr * (1.f / (1.f + __expf(-qr))) * 0.08838834764831845f;
          sQt[tau * KP + ch] = f2bf(qx * __expf(b - ref));
          sKt[tau * KP + ch] = f2bf(kx * __expf(ref - b));
          sQc[tau * KP + ch] = f2bf(qx * __expf(b));
        }
        kh4[ii] = kx * __expf(bend - b);
        vb[ii] = rawV[tau * 128 + ch];
      }
      uint2 o; o.x = pk2(kh4[0], kh4[1]); o.y = pk2(kh4[2], kh4[3]);
      *(uint2*)(sKhT + ch * 72 + 16 * qd + i0) = o;
      uint2 ov; ov.x = vb[0] | (vb[1] << 16); ov.y = vb[2] | (vb[3] << 16);
      *(uint2*)(sVT + ch * 72 + 16 * qd + i0) = ov;
    }
    if (qd == 0) sD[ch] = __expf(bend);
    __syncthreads();
    scan_core<K, V, false>(smem, S, OB + (rowbase + (size_t)chunk * 64) * 512 + head * 128, dir, w, lane, do_out);
  }
  if (!do_out) {
    state_store<K, V>(sbuf, S, w, lane);
    if (qd == 0) ((float*)(p.ws + OFF_DB))[((size_t)it * NSEG + seg) * 128 + ch] = __expf(dlog);
  }
}

DEV void gla_item(const Params& p, int l, int it, int seg, int mode, unsigned char* smem) {
  const int j16 = it - 16, bl = j16 >> 3, head = (j16 >> 1) & 3, dir = j16 & 1;
  const bool do_out = (mode == 3);
  constexpr int K = 64, V = 128, KP = 72;
  const int tid = launder(threadIdx.x), lane = tid & 63, w = tid >> 6;
  const int ch = tid & 63, oc = tid >> 6;
  const int vn = tid & 127, vq = tid >> 7;
  const bf16_t* Hh = (const bf16_t*)(p.ws + OFF_H);
  const float* SMALL = (const float*)(p.ws + OFF_SMALL);
  bf16_t* OB = (bf16_t*)(p.ws + OFF_OBUF) + (size_t)(2 * 2 + dir) * TH * 512;
  const size_t rowbase = (size_t)bl * SEQ;
  bf16_t* sQt = (bf16_t*)(smem + L_QT); bf16_t* sKt = (bf16_t*)(smem + L_KT); bf16_t* sQc = (bf16_t*)(smem + L_QC);
  bf16_t* sKhT = (bf16_t*)(smem + L_KHT); bf16_t* sVT = (bf16_t*)(smem + L_VT);
  float* sD = (float*)(smem + L_D); float* sTot = (float*)(smem + L_TOT); float* sLow = (float*)(smem + L_LOW);
  const bf16_t* rawQ = (const bf16_t*)(smem + L_RAW); const bf16_t* rawK = rawQ + 4096; const bf16_t* rawV = rawQ + 8192;
  float w2c[16];
#pragma unroll
  for (int r = 0; r < 16; ++r) w2c[r] = p.gk_w2[((size_t)(l * 2 + dir) * 16 + r) * 256 + head * 64 + ch];
  const float gb = p.gk_b[(l * 2 + dir) * 256 + head * 64 + ch];
  f32x16 S[1]; S[0] = zero16();
  float* sbuf = (float*)(p.ws + OFF_SB1) + ((size_t)j16 * NSEG + seg) * 8192;
  if (do_out) state_load<K, V>(sbuf, S, w, lane);
  float dlog = 0.f;
  u32x4 pre[4];
  float plow0, plow1;
  const int qrow = tid >> 3, qc8 = (tid & 7) * 8, vrow0 = tid >> 4, vc16 = (tid & 15) * 8;
  auto gload = [&](int cidx) __attribute__((always_inline)) {
    const int chunk = dir ? (63 - cidx) : cidx;
    {
      const int tok = chunk * 64 + (dir ? (63 - qrow) : qrow);
      const bf16_t* rp = Hh + (rowbase + tok) * NPAD + head * 64 + qc8;
      pre[0] = *(const u32x4*)(rp + G_Q); pre[1] = *(const u32x4*)(rp + G_K);
      { const float* lp = SMALL + (rowbase + tok) * 48 + 16 + dir * 16 + (tid & 7) * 2; plow0 = lp[0]; plow1 = lp[1]; }
    }
#pragma unroll
    for (int j = 0; j < 2; ++j) {
      const int row = vrow0 + 32 * j;
      const int tok = chunk * 64 + (dir ? (63 - row) : row);
      pre[2 + j] = *(const u32x4*)(Hh + (rowbase + tok) * NPAD + G_V + head * 128 + vc16);
    }
  };
  gload(seg * SLEN);
  for (int ci = 0; ci < SLEN; ++ci) {
    const int cidx = seg * SLEN + ci;
    const int chunk = dir ? (63 - cidx) : cidx;
    {
      unsigned char* d = smem + L_RAW + qrow * 128 + qc8 * 2;
      *(u32x4*)d = pre[0]; *(u32x4*)(d + 8192) = pre[1];
      sLow[qrow * 16 + (tid & 7) * 2] = plow0; sLow[qrow * 16 + (tid & 7) * 2 + 1] = plow1;
#pragma unroll
      for (int j = 0; j < 2; ++j) *(u32x4*)(smem + L_RAW + 16384 + (vrow0 + 32 * j) * 256 + vc16 * 2) = pre[2 + j];
    }
    __syncthreads();
    if (ci + 1 < SLEN) gload(cidx + 1);
    float run = 0.f;
#pragma unroll 1
    for (int i = 0; i < 8; ++i) {
      const int tau = 8 * oc + i;
      float gk = gb;
#pragma unroll
      for (int r = 0; r < 16; ++r) gk += sLow[tau * 16 + r] * w2c[r];
      run += (fminf(gk, 0.f) - __logf(1.f + __expf(-fabsf(gk)))) * (1.f / 16.f);
    }
    sTot[oc * 64 + ch] = run;
    __syncthreads();
    float off = 0.f, ref = 0.f, bend = 0.f;
#pragma unroll
    for (int j = 0; j < 8; ++j) { const float t = sTot[j * 64 + ch]; if (j < oc) off += t; if (j < 4) ref += t; bend += t; }
    dlog += bend;
    float b = off;
#pragma unroll 1
    for (int i0 = 0; i0 < 8; i0 += 4) {
      float kh4[4];
#pragma unroll
      for (int ii = 0; ii < 4; ++ii) {
        const int tau = 8 * oc + i0 + ii;
        float gk = gb;
#pragma unroll
        for (int r = 0; r < 16; ++r) gk += sLow[tau * 16 + r] * w2c[r];
        b += (fminf(gk, 0.f) - __logf(1.f + __expf(-fabsf(gk)))) * (1.f / 16.f);
        const float qx = bf2f(rawQ[tau * 64 + ch]) * 0.125f, kx = bf2f(rawK[tau * 64 + ch]);
        if (do_out) {
          sQt[tau * KP + ch] = f2bf(qx * __expf(b - ref));
          sKt[tau * KP + ch] = f2bf(kx * __expf(ref - b));
          sQc[tau * KP + ch] = f2bf(qx * __expf(b));
        }
        kh4[ii] = kx * __expf(bend - b);
      }
      uint2 o; o.x = pk2(kh4[0], kh4[1]); o.y = pk2(kh4[2], kh4[3]);
      *(uint2*)(sKhT + ch * 72 + 8 * oc + i0) = o;
    }
#pragma unroll 1
    for (int i0 = 0; i0 < 16; i0 += 4) {
      unsigned vb[4];
#pragma unroll
      for (int ii = 0; ii < 4; ++ii) vb[ii] = rawV[(16 * vq + i0 + ii) * 128 + vn];
      uint2 ov; ov.x = vb[0] | (vb[1] << 16); ov.y = vb[2] | (vb[3] << 16);
      *(uint2*)(sVT + vn * 72 + 16 * vq + i0) = ov;
    }
    if (oc == 0) sD[ch] = __expf(bend);
    __syncthreads();
    scan_core<K, V, false>(smem, S, OB + (rowbase + (size_t)chunk * 64) * 512 + head * 128, dir, w, lane, do_out);
  }
  if (!do_out) {
    state_store<K, V>(sbuf, S, w, lane);
    if (oc == 0) ((float*)(p.ws + OFF_DB))[((size_t)it * NSEG + seg) * 128 + ch] = __expf(dlog);
  }
}

DEV void ssd_item(const Params& p, int l, int it, int seg, int mode, unsigned char* smem) {
  const int j32 = it - 32, bl = j32 >> 4, head = (j32 >> 1) & 7, dir = j32 & 1;
  const bool do_out = (mode == 3);
  constexpr int K = 128, V = 64, KP = 136;
  const int tid = launder(threadIdx.x), lane = tid & 63, w = tid >> 6;
  const int n = tid & 127, qd = tid >> 7;
  const int pp = tid & 63, oc = tid >> 6;
  const int grp = head >> 2;
  const bf16_t* Hh = (const bf16_t*)(p.ws + OFF_H);
  const float* SMALL = (const float*)(p.ws + OFF_SMALL);
  bf16_t* OB = (bf16_t*)(p.ws + OFF_OBUF) + (size_t)(1 * 2 + dir) * TH * 512;
  const size_t rowbase = (size_t)bl * SEQ;
  bf16_t* sQt = (bf16_t*)(smem + L_QT); bf16_t* sKt = (bf16_t*)(smem + L_KT); bf16_t* sQc = (bf16_t*)(smem + L_QC);
  bf16_t* sKhT = (bf16_t*)(smem + L_KHT); bf16_t* sVT = (bf16_t*)(smem + L_VT);
  float* sD = (float*)(smem + L_D); float* sAcs = (float*)(smem + L_ACS); float* sDt = (float*)(smem + L_DT);
  const bf16_t* rawB = (const bf16_t*)(smem + L_RAW); const bf16_t* rawC = rawB + 68 * 128; const bf16_t* rawX = rawB + 2 * 68 * 128;
  const int chB = 512 + grp * 128 + n, chC = 768 + grp * 128 + n, chX = head * 64 + pp;
  const float* cw = p.conv_w + (size_t)l * 5 * 1024; const float* cb = p.conv_b + (size_t)l * 1024;
  float wB[5], wC[5], wX[5];
#pragma unroll
  for (int j = 0; j < 5; ++j) { wB[j] = cw[j * 1024 + chB]; wC[j] = cw[j * 1024 + chC]; wX[j] = cw[j * 1024 + chX]; }
  const float bB = cb[chB], bC = cb[chC], bX = cb[chX];
  const float dtb = p.dt_bias[(l * 2 + dir) * 8 + head];
  const float Acoef = -__expf(p.a_log[(l * 2 + dir) * 8 + head]);
  f32x16 S[1]; S[0] = zero16();
  float* sbuf = (float*)(p.ws + OFF_SB2) + ((size_t)j32 * NSEG + seg) * 8192;
  if (do_out) state_load<K, V>(sbuf, S, w, lane);
  float dlog = 0.f;
  u32x4 pre[6];
  float rdt = 0.f;
  auto decode = [&](int id, int& row, int& gcol, int& loff) __attribute__((always_inline)) {
    if (id < 1088) { row = id >> 4; gcol = S_X + 512 + grp * 128 + (id & 15) * 8; loff = row * 256 + (id & 15) * 16; }
    else if (id < 2176) { const int i2 = id - 1088; row = i2 >> 4; gcol = S_X + 768 + grp * 128 + (i2 & 15) * 8; loff = 17408 + row * 256 + (i2 & 15) * 16; }
    else { const int i2 = id - 2176; row = i2 >> 3; gcol = S_X + head * 64 + (i2 & 7) * 8; loff = 34816 + row * 128 + (i2 & 7) * 16; }
  };
  auto gload = [&](int cidx) __attribute__((always_inline)) {
    const int chunk = dir ? (63 - cidx) : cidx;
#pragma unroll
    for (int j = 0; j < 6; ++j) {
      const int id = tid + 512 * j;
      pre[j] = (u32x4){0u, 0u, 0u, 0u};
      if (id < 2720) {
        int row, gcol, loff; decode(id, row, gcol, loff);
        const int s = chunk * 64 + row - 2;
        if (s >= 0 && s < SEQ) pre[j] = *(const u32x4*)(Hh + (rowbase + s) * NPAD + gcol);
      }
    }
    if (w == 0) {
      const int tok = chunk * 64 + (dir ? (63 - lane) : lane);
      rdt = SMALL[(rowbase + tok) * 48 + dir * 8 + head];
    }
  };
  gload(seg * SLEN);
  for (int ci = 0; ci < SLEN; ++ci) {
    const int cidx = seg * SLEN + ci;
    const int chunk = dir ? (63 - cidx) : cidx;
#pragma unroll
    for (int j = 0; j < 6; ++j) {
      const int id = tid + 512 * j;
      if (id < 2720) { int row, gcol, loff; decode(id, row, gcol, loff); *(u32x4*)(smem + L_RAW + loff) = pre[j]; }
    }
    if (w == 0) {
      const float xx = rdt + dtb;
      const float dt = (xx > 20.f) ? xx : log1pf(__expf(xx));
      float a = dt * Acoef;
#pragma unroll
      for (int o = 1; o < 64; o <<= 1) { const float t = __shfl_up(a, o); if (lane >= o) a += t; }
      sAcs[lane] = a; sDt[lane] = dt;
    }
    __syncthreads();
    if (ci + 1 < SLEN) gload(cidx + 1);
    const float aend = sAcs[63];
    dlog += aend;
#pragma unroll 1
    for (int i0 = 0; i0 < 16; i0 += 2) {
      float kh2[2];
#pragma unroll
      for (int ii = 0; ii < 2; ++ii) {
        const int tau = 16 * qd + i0 + ii;
        const int tl = dir ? (63 - tau) : tau;
        float uB = bB, uC = bC;
#pragma unroll
        for (int j = 0; j < 5; ++j) { uB += wB[j] * bf2f(rawB[(tl + j) * 128 + n]); uC += wC[j] * bf2f(rawC[(tl + j) * 128 + n]); }
        uB = fsilu(uB); uC = fsilu(uC);
        const float ac = sAcs[tau];
        if (do_out) {
          sQt[tau * KP + n] = f2bf(uC);
          sKt[tau * KP + n] = f2bf(uB);
          sQc[tau * KP + n] = f2bf(uC * __expf(ac));
        }
        kh2[ii] = uB * __expf(aend - ac);
      }
      *(unsigned*)(sKhT + n * 72 + 16 * qd + i0) = pk2(kh2[0], kh2[1]);
    }
#pragma unroll 1
    for (int i0 = 0; i0 < 8; i0 += 2) {
      float xv[2];
#pragma unroll
      for (int ii = 0; ii < 2; ++ii) {
        const int tau = 8 * oc + i0 + ii;
        const int tl = dir ? (63 - tau) : tau;
        float u = bX;
#pragma unroll
        for (int j = 0; j < 5; ++j) u += wX[j] * bf2f(rawX[(tl + j) * 64 + pp]);
        xv[ii] = fsilu(u) * sDt[tau];
      }
      *(unsigned*)(sVT + pp * 72 + 8 * oc + i0) = pk2(xv[0], xv[1]);
    }
    if (qd == 0) sD[n] = __expf(aend);
    __syncthreads();
    scan_core<K, V, true>(smem, S, OB + (rowbase + (size_t)chunk * 64) * 512 + head * 64, dir, w, lane, do_out);
  }
  if (!do_out) {
    state_store<K, V>(sbuf, S, w, lane);
    if (qd == 0) ((float*)(p.ws + OFF_DB))[((size_t)it * NSEG + seg) * 128 + n] = __expf(dlog);
  }
}


DEV void phase_mix(const Params& p, int l, int hf, int slot, int mode, int att_lo, int att_hi, int vid_lo, int vid_hi, unsigned char* smem) {
  unsigned* ctr = (unsigned*)(p.ws + OFF_CTRL) + CTR_WORD0 + slot * 16;
  volatile int* sItem = (volatile int*)(smem + LDS_BYTES - 16);
  const int n_scan = 64 * NSEG;
  int hi = n_scan + (att_hi - att_lo); if (vid_hi < hi) hi = vid_hi;
  for (;;) {
    __syncthreads();
    if (threadIdx.x == 0) *sItem = vid_lo + (int)atomicAdd(ctr, 1u);
    __syncthreads();
    const int vid = *sItem;
    if (vid >= hi) break;
    if (vid < n_scan) {
      const int seg = vid >> 6, it = vid & 63;
      if (it < 16) { if (PH_MASK & 0x100) hgrn_item(p, l, it, seg, mode, smem); }
      else if (it < 32) { if (PH_MASK & 0x200) gla_item(p, l, it, seg, mode, smem); }
      else { if (PH_MASK & 0x400) ssd_item(p, l, it, seg, mode, smem); }
    } else { if (PH_MASK & 0x800) attn_item(p, l, att_lo + (vid - n_scan), smem); }
  }
}

DEV void phase_scan2(const Params& p) {
  const size_t gtid = (size_t)blockIdx.x * NT + threadIdx.x, gsz = (size_t)gridDim.x * NT;
  const float* DB = (const float*)(p.ws + OFF_DB);
  for (size_t e = gtid; e < 655360; e += gsz) {
    float* buf; const float* dp; int stride;
    if (e < 262144) { const int it = (int)(e >> 14), idx = (int)(e & 16383); buf = (float*)(p.ws + OFF_SB0) + (size_t)it * NSEG * 16384 + idx; stride = 16384; dp = DB + (size_t)it * NSEG * 128 + (idx >> 7); }
    else if (e < 393216) { const int e2 = (int)(e - 262144), j = e2 >> 13, idx = e2 & 8191; buf = (float*)(p.ws + OFF_SB1) + (size_t)j * NSEG * 8192 + idx; stride = 8192; dp = DB + (size_t)(16 + j) * NSEG * 128 + (idx >> 7); }
    else { const int e3 = (int)(e - 393216), j = e3 >> 13, idx = e3 & 8191; buf = (float*)(p.ws + OFF_SB2) + (size_t)j * NSEG * 8192 + idx; stride = 8192; dp = DB + (size_t)(32 + j) * NSEG * 128 + (idx >> 6); }
    float u[NSEG], d[NSEG];
#pragma unroll
    for (int sg = 0; sg < NSEG; ++sg) { u[sg] = buf[(size_t)sg * stride]; d[sg] = dp[sg * 128]; }
    float st = 0.f;
#pragma unroll
    for (int sg = 0; sg < NSEG; ++sg) { buf[(size_t)sg * stride] = st; st = d[sg] * st + u[sg]; }
  }
}

DEV void phase_fin(const Params& p, int l, int hf) {
  const int tid = launder(threadIdx.x), lane = tid & 63, w = tid >> 6;
  const bf16_t* Hh = (const bf16_t*)(p.ws + OFF_H);
  const bf16_t* OB = (const bf16_t*)(p.ws + OFF_OBUF);
  bf16_t* MX = (bf16_t*)(p.ws + OFF_MIXED);
  const int c0 = lane * 8;
  const float* cw = p.conv_w + (size_t)l * 5 * 1024; const float* cb = p.conv_b + (size_t)l * 1024;
  for (int r = blockIdx.x * 8 + w; r < TH; r += gridDim.x * 8) {
    const bf16_t* hrow = Hh + (size_t)r * NPAD;
    {
      const uint4 a = *(const uint4*)(OB + ((size_t)0 * TH + r) * 512 + c0), b = *(const uint4*)(OB + ((size_t)1 * TH + r) * 512 + c0);
      const uint4 z = *(const uint4*)(hrow + H_Z + c0);
      const unsigned au[4] = {a.x, a.y, a.z, a.w}, bu[4] = {b.x, b.y, b.z, b.w}, zu[4] = {z.x, z.y, z.z, z.w};
      float o[8]; float ss = 0.f;
#pragma unroll
      for (int j = 0; j < 4; ++j) {
        o[2 * j] = bf2f((bf16_t)(au[j] & 0xffff)) + bf2f((bf16_t)(bu[j] & 0xffff));
        o[2 * j + 1] = bf2f((bf16_t)(au[j] >> 16)) + bf2f((bf16_t)(bu[j] >> 16));
        ss += o[2 * j] * o[2 * j] + o[2 * j + 1] * o[2 * j + 1];
      }
#pragma unroll
      for (int of = 32; of >= 1; of >>= 1) ss += __shfl_xor(ss, of);
      const float rstd = rsqrtf(ss * (1.f / 512.f) + 1e-6f);
      float y[8];
#pragma unroll
      for (int j = 0; j < 8; ++j) {
        const float zz = bf2f((bf16_t)((j & 1) ? (zu[j >> 1] >> 16) : (zu[j >> 1] & 0xffff)));
        y[j] = o[j] * rstd * p.hgrn_norm[l * 512 + c0 + j] * fsilu(zz);
      }
      uint4 ov; ov.x = pk2(y[0], y[1]); ov.y = pk2(y[2], y[3]); ov.z = pk2(y[4], y[5]); ov.w = pk2(y[6], y[7]);
      *(uint4*)(MX + (size_t)r * DI + 512 + c0) = ov;
    }
    {
      const uint4 a = *(const uint4*)(OB + ((size_t)4 * TH + r) * 512 + c0), b = *(const uint4*)(OB + ((size_t)5 * TH + r) * 512 + c0);
      const uint4 z = *(const uint4*)(hrow + G_Z + c0);
      const unsigned au[4] = {a.x, a.y, a.z, a.w}, bu[4] = {b.x, b.y, b.z, b.w}, zu[4] = {z.x, z.y, z.z, z.w};
      float o[8]; float ss = 0.f;
#pragma unroll
      for (int j = 0; j < 4; ++j) {
        o[2 * j] = bf2f((bf16_t)(au[j] & 0xffff)) + bf2f((bf16_t)(bu[j] & 0xffff));
        o[2 * j + 1] = bf2f((bf16_t)(au[j] >> 16)) + bf2f((bf16_t)(bu[j] >> 16));
        ss += o[2 * j] * o[2 * j] + o[2 * j + 1] * o[2 * j + 1];
      }
#pragma unroll
      for (int of = 8; of >= 1; of >>= 1) ss += __shfl_xor(ss, of);
      const float rstd = rsqrtf(ss * (1.f / 128.f) + 1e-6f);
      float y[8];
#pragma unroll
      for (int j = 0; j < 8; ++j) {
        const float zz = bf2f((bf16_t)((j & 1) ? (zu[j >> 1] >> 16) : (zu[j >> 1] & 0xffff)));
        y[j] = o[j] * rstd * p.gla_norm[l * 128 + ((c0 + j) & 127)] * fsilu(zz);
      }
      uint4 ov; ov.x = pk2(y[0], y[1]); ov.y = pk2(y[2], y[3]); ov.z = pk2(y[4], y[5]); ov.w = pk2(y[6], y[7]);
      *(uint4*)(MX + (size_t)r * DI + 1536 + c0) = ov;
    }
    {
      const uint4 a = *(const uint4*)(OB + ((size_t)2 * TH + r) * 512 + c0), b = *(const uint4*)(OB + ((size_t)3 * TH + r) * 512 + c0);
      const uint4 z = *(const uint4*)(hrow + S_Z + c0);
      const unsigned au[4] = {a.x, a.y, a.z, a.w}, bu[4] = {b.x, b.y, b.z, b.w}, zu[4] = {z.x, z.y, z.z, z.w};
      float u[8];
#pragma unroll
      for (int j = 0; j < 8; ++j) u[j] = cb[c0 + j];
      const int t = r & (SEQ - 1);
#pragma unroll
      for (int jj = 0; jj < 5; ++jj) {
        const int s = t + jj - 2;
        if (s >= 0 && s < SEQ) {
          const uint4 xr = *(const uint4*)(Hh + (size_t)(r + jj - 2) * NPAD + S_X + c0);
          const unsigned xu[4] = {xr.x, xr.y, xr.z, xr.w};
#pragma unroll
          for (int j = 0; j < 8; ++j) {
            const float xv = bf2f((bf16_t)((j & 1) ? (xu[j >> 1] >> 16) : (xu[j >> 1] & 0xffff)));
            u[j] += cw[jj * 1024 + c0 + j] * xv;
          }
        }
      }
      const float dsk = p.ssd_d[l * 8 + (c0 >> 6)];
      float y[8]; float ss = 0.f;
#pragma unroll
      for (int j = 0; j < 8; ++j) {
        const float of = bf2f((bf16_t)((j & 1) ? (au[j >> 1] >> 16) : (au[j >> 1] & 0xffff)));
        const float ob = bf2f((bf16_t)((j & 1) ? (bu[j >> 1] >> 16) : (bu[j >> 1] & 0xffff)));
        const float zz = bf2f((bf16_t)((j & 1) ? (zu[j >> 1] >> 16) : (zu[j >> 1] & 0xffff)));
        y[j] = (of + ob + dsk * fsilu(u[j])) * fsilu(zz);
        ss += y[j] * y[j];
      }
#pragma unroll
      for (int of = 32; of >= 1; of >>= 1) ss += __shfl_xor(ss, of);
      const float rstd = rsqrtf(ss * (1.f / 512.f) + 1e-6f);
#pragma unroll
      for (int j = 0; j < 8; ++j) y[j] = y[j] * rstd * p.ssd_norm[l * 512 + c0 + j];
      uint4 ov; ov.x = pk2(y[0], y[1]); ov.y = pk2(y[2], y[3]); ov.z = pk2(y[4], y[5]); ov.w = pk2(y[6], y[7]);
      *(uint4*)(MX + (size_t)r * DI + 1024 + c0) = ov;
    }
  }
}


#define XB_TMO      128
#define XB_XCNT(j)  (256  + 64 * (j))
#define XB_XSUB(j)  (1280 + 64 * (j))
#define XB_XGEN(j)  (2304 + 64 * (j))
#define XB_TOP      3328
#define XB_TOPGEN   3392
#define XB_SPIN_CAP (1u << 22)
#define LAS __attribute__((address_space(3)))
DEV unsigned xb_ld(unsigned* p) { return __hip_atomic_load(p, __ATOMIC_RELAXED, __HIP_MEMORY_SCOPE_AGENT); }
DEV unsigned xb_add(unsigned* p, unsigned v) { return __hip_atomic_fetch_add(p, v, __ATOMIC_RELAXED, __HIP_MEMORY_SCOPE_AGENT); }
DEV unsigned xb_xcc_id() { return (unsigned)__builtin_amdgcn_s_getreg((3 << 11) | 20) & 0xFu; }
#define XB_SPIN(cond, bar) do { unsigned _sp = 0; while (cond) { __builtin_amdgcn_s_sleep(1); \
    if ((++_sp & 255u) == 0u) { if (xb_ld(&(bar)[XB_TMO])) break; if (_sp > XB_SPIN_CAP) { atomicAdd(&(bar)[XB_TMO], 1u); break; } } } } while (0)
struct XcdBarrier { unsigned* bar; unsigned x; volatile LAS unsigned* st; };
DEV XcdBarrier xcd_barrier_post(unsigned* bar, volatile LAS unsigned* st) {
  XcdBarrier b; b.bar = bar; b.x = xb_xcc_id(); b.st = st;
  if (threadIdx.x == 0) (void)xb_add(&bar[XB_XCNT(b.x)], 1u);
  return b;
}
DEV void xcd_barrier_complete(unsigned* bar, unsigned x, unsigned& nloc, unsigned& nx) {
  const unsigned G = gridDim.x * gridDim.y * gridDim.z;
  unsigned sum, cnt, mine, sp = 0u;
  for (;;) {
    sum = 0u; cnt = 0u; mine = 0u;
#pragma unroll
    for (unsigned j = 0; j < 16; ++j) { const unsigned c = xb_ld(&bar[XB_XCNT(j)]); sum += c; cnt += (c > 0u) ? 1u : 0u; mine = (j == x) ? c : mine; }
    if (sum == G) break;
    __builtin_amdgcn_s_sleep(1);
    if ((++sp & 255u) == 0u) { if (xb_ld(&bar[XB_TMO])) break; if (sp > XB_SPIN_CAP) { atomicAdd(&bar[XB_TMO], 1u); break; } }
  }
  nloc = mine > 0u ? mine : 1u; nx = cnt > 0u ? cnt : 1u;
}
DEV void xcd_barrier(const XcdBarrier& b) {
  asm volatile("s_waitcnt vmcnt(0)" ::: "memory");
  __syncthreads();
  if (threadIdx.x == 0) {
    unsigned* bar = b.bar;
    __builtin_amdgcn_s_waitcnt(0);
    unsigned nloc = b.st[0], nx = b.st[1];
    if (nloc == 0u) { xcd_barrier_complete(bar, b.x, nloc, nx); b.st[0] = nloc; b.st[1] = nx; }
    const unsigned old = xb_add(&bar[XB_XSUB(b.x)], 1u);
    const unsigned gen = old / nloc;
    if (old + 1u == (gen + 1u) * nloc) {
      __builtin_amdgcn_fence(__ATOMIC_RELEASE, "agent");
      asm volatile("s_waitcnt vmcnt(0)" ::: "memory");
      const unsigned og = xb_add(&bar[XB_TOP], 1u);
      const unsigned tg = og / nx;
      if (og + 1u == (tg + 1u) * nx) xb_add(&bar[XB_TOPGEN], 1u);
      else XB_SPIN(xb_ld(&bar[XB_TOPGEN]) == tg, bar);
      __builtin_amdgcn_fence(__ATOMIC_ACQUIRE, "agent");
      xb_add(&bar[XB_XGEN(b.x)], 1u);
      asm volatile("s_waitcnt vmcnt(0)" ::: "memory");
    } else {
      XB_SPIN(xb_ld(&bar[XB_XGEN(b.x)]) == gen, bar);
      __builtin_amdgcn_fence(__ATOMIC_ACQUIRE, "agent");
      asm volatile("s_waitcnt vmcnt(0)" ::: "memory");
    }
  }
  __syncthreads();
}

#ifndef PROBE_ST
#define PROBE_ST -1
#endif
#ifndef PROBE_REP
#define PROBE_REP 0
#endif
#ifndef PROBE_LO
#define PROBE_LO 0
#endif
#ifndef PROBE_HI
#define PROBE_HI 100000
#endif
DEV void run_phase(const Params& p, int ph, int rep, unsigned char* smem) {
  if (ph == 0) { if (PH_MASK & 1) phase_pro(p, smem); }
  else {
    const int q = ph - 1, l = q / 14, hf = (q / 7) & 1, st = q % 7;
    if (st == 0) { if (PH_MASK & 2) phase_inproj(p, l, hf, smem); }
    else if (st == 1) { if (PH_MASK & 0xF00) phase_mix(p, l, hf, ph + 32 * rep, 1, 0, ATT_SPLIT, rep ? PROBE_LO : 0, rep ? PROBE_HI : 100000, smem); }
    else if (st == 2) { if (PH_MASK & 0x700) phase_scan2(p); }
    else if (st == 3) { if (PH_MASK & 0xF00) phase_mix(p, l, hf, ph + 32 * rep, 3, ATT_SPLIT, 256, rep ? PROBE_LO : 0, rep ? PROBE_HI : 100000, smem); }
    else if (st == 4) { if (PH_MASK & 8) phase_fin(p, l, hf); }
    else if (st == 5) { if (PH_MASK & 16) phase_outproj(p, l, hf, smem); }
    else {
      if (PH_MASK & 32) phase_ln(p, l, hf);
      if ((PH_MASK & 1) && l == 0 && hf == 1) convert_weights(p, 1, smem);
    }
  }
}
__global__ void __launch_bounds__(NT) mega(Params p) {
  extern __shared__ __attribute__((aligned(16))) unsigned char smem[];
#if ONE_LAUNCH
  volatile LAS unsigned* xst = (volatile LAS unsigned*)(smem + LDS_BYTES - 32);
  if (threadIdx.x == 0) { xst[0] = 0u; xst[1] = 0u; }
  __syncthreads();
  XcdBarrier xb = xcd_barrier_post((unsigned*)(p.ws + OFF_CTRL), xst);
#endif
  for (int ph = p.phase_begin; ph < p.phase_end; ++ph) {
    int nrep = 0;
#if PROBE_REP > 0
    {
      const int q = ph - 1, l = q / 14, st = q % 7;
      const bool idem = (ph == 0) ? (PROBE_ST == 9) : (st == PROBE_ST && (st != 5 || l == 0));
      if (idem) nrep = PROBE_REP;
    }
#endif
    for (int r = 0; r <= nrep; ++r) {
      run_phase(p, ph, r, smem);
#if ONE_LAUNCH
      if (r < nrep || ph + 1 < p.phase_end) xcd_barrier(xb);
#endif
    }
  }
}

extern "C" void kernel_launch(void* const* d_in, const int* in_sizes, int n_in, void* d_out, int out_size, void* d_ws, size_t ws_size,
                              hipStream_t stream) {
  static int grid_blocks = 0;
  if (!grid_blocks) {
    int dev = 0, cus = 0, per_cu = 0;
    hipGetDevice(&dev);
    hipDeviceGetAttribute(&cus, hipDeviceAttributeMultiprocessorCount, dev);
    hipFuncSetAttribute((const void*)mega, hipFuncAttributeMaxDynamicSharedMemorySize, LDS_BYTES);
    hipOccupancyMaxActiveBlocksPerMultiprocessor(&per_cu, mega, NT, LDS_BYTES);
    if (per_cu < 1) per_cu = 1;
    grid_blocks = cus;
  }
  Params p{};
  p.x = (const float*)d_in[0]; p.w_in = (const float*)d_in[1]; p.q_gain = (const float*)d_in[2]; p.k_gain = (const float*)d_in[3];
  p.lb_logits = (const float*)d_in[4]; p.hgrn_norm = (const float*)d_in[5]; p.conv_w = (const float*)d_in[6]; p.conv_b = (const float*)d_in[7];
  p.dt_bias = (const float*)d_in[8]; p.a_log = (const float*)d_in[9]; p.ssd_d = (const float*)d_in[10]; p.ssd_norm = (const float*)d_in[11];
  p.gk_w2 = (const float*)d_in[12]; p.gk_b = (const float*)d_in[13]; p.gla_norm = (const float*)d_in[14]; p.w_out = (const float*)d_in[15];
  p.ln_g = (const float*)d_in[16]; p.ln_b = (const float*)d_in[17];
  p.out = (float*)d_out; p.ws = (unsigned char*)d_ws;
  hipMemsetAsync(d_ws, 0, CTRL_BYTES, stream);
#if ONE_LAUNCH
  p.phase_begin = 0; p.phase_end = NPHASE;
  void* args[] = {&p};
  (void)args;
  hipLaunchKernelGGL(mega, dim3(grid_blocks), dim3(NT), LDS_BYTES, stream, p);
#else
  for (int ph = 0; ph < NPHASE; ++ph) {
    p.phase_begin = ph; p.phase_end = ph + 1;
    hipLaunchKernelGGL(mega, dim3(grid_blocks), dim3(NT), LDS_BYTES, stream, p);
  }
#endif
}
```

```cpp
#include <hip/hip_runtime.h>
#include <hip/hip_cooperative_groups.h>
#include <stdint.h>
#include <stdio.h>
namespace cg = cooperative_groups;

#ifndef ONE_LAUNCH
#define ONE_LAUNCH 1
#endif

#ifndef PH_MASK
#define PH_MASK 0xFFF
#endif
#define DEV __device__ __forceinline__
typedef unsigned short bf16_t;
typedef short bf16x8 __attribute__((ext_vector_type(8)));
typedef float f32x16 __attribute__((ext_vector_type(16)));
typedef unsigned u32x4 __attribute__((ext_vector_type(4)));

constexpr int NT = 512;
constexpr int T_ALL = 16384, TH = 8192, SEQ = 4096, DM = 1024, NPAD = 7168, DI = 2048, NIN = 6960;
constexpr int A_Q = 0, A_K = 512, A_V = 640, A_Z = 768, H_Q = 1280, H_FF = 1792, H_FB = 2304, H_I = 2816, H_Z = 3328,
              S_X = 3840, S_Z = 4864, G_Q = 5376, G_K = 5632, G_V = 5888, G_Z = 6400, SM0 = 6912;
constexpr size_t OFF_CTRL = 0, OFF_TAB = 65536, OFF_XB = 131072;
constexpr size_t OFF_WIN = OFF_XB + (size_t)T_ALL * DM * 2;
constexpr size_t OFF_WOUT = OFF_WIN + (size_t)NPAD * DM * 2;
constexpr size_t OFF_H = OFF_WOUT + (size_t)DM * DI * 2;
constexpr size_t OFF_SMALL = OFF_H + (size_t)TH * NPAD * 2;
constexpr size_t OFF_MIXED = OFF_SMALL + (size_t)TH * 48 * 4;
constexpr size_t OFF_OBUF = OFF_MIXED + (size_t)TH * DI * 2;
constexpr size_t OFF_VT = OFF_OBUF + (size_t)6 * TH * 512 * 2;
constexpr size_t OFF_DB = OFF_VT + (size_t)2 * 2 * 64 * SEQ * 2;
constexpr int NSEG = 8, SLEN = 64 / NSEG;
constexpr size_t WS_END = OFF_DB + (size_t)64 * NSEG * 128 * 4;
constexpr size_t OFF_SB0 = OFF_MIXED, OFF_SB1 = OFF_SB0 + (size_t)16 * NSEG * 16384 * 4, OFF_SB2 = OFF_SB1 + (size_t)16 * NSEG * 8192 * 4;
static_assert(OFF_SB2 + (size_t)32 * NSEG * 8192 * 4 <= OFF_OBUF, "state buffers must fit in MIXED");
static_assert(WS_END <= 268435456, "workspace");
constexpr size_t CTRL_BYTES = 65536;
constexpr int CTR_WORD0 = 4096;
constexpr int LDS_BYTES = 148480;
constexpr float LOG2E = 1.4426950408889634f;
constexpr float QSCALE = 0.125f * LOG2E;
constexpr float DN_ALPHA = 1.4142135623730951f;
constexpr int NPHASE = 29;
constexpr int ATT_SPLIT = 144;

struct Params {
  const float* x; const float* w_in; const float* q_gain; const float* k_gain; const float* lb_logits; const float* hgrn_norm;
  const float* conv_w; const float* conv_b; const float* dt_bias; const float* a_log; const float* ssd_d; const float* ssd_norm;
  const float* gk_w2; const float* gk_b; const float* gla_norm; const float* w_out; const float* ln_g; const float* ln_b;
  float* out; unsigned char* ws;
  int phase_begin, phase_end;
};

DEV int launder(int v) { asm volatile("" : "+v"(v)); return v; }
DEV float bf2f(bf16_t v) { return __uint_as_float(((unsigned)v) << 16); }
DEV bf16_t f2bf(float f) { unsigned u = __float_as_uint(f); u += 0x7fffu + ((u >> 16) & 1u); return (bf16_t)(u >> 16); }
DEV unsigned pk2(float lo, float hi) { return (unsigned)f2bf(lo) | ((unsigned)f2bf(hi) << 16); }
DEV float fsigmoid(float x) { return 1.f / (1.f + __expf(-x)); }
DEV float fsilu(float x) { return x / (1.f + __expf(-x)); }
DEV int rowoff(int reg, int h) { return (reg & 3) + 8 * (reg >> 2) + 4 * h; }
DEV f32x16 zero16() { f32x16 z;
#pragma unroll
  for (int i = 0; i < 16; ++i) z[i] = 0.f; return z; }

template <int KD>
DEV void mma32(f32x16& acc, const bf16_t* a, int lda, const bf16_t* b, int ldb, int lane) {
  const int r = lane & 31, h = lane >> 5;
  const bf16_t* ap = a + r * lda + 8 * h;
  const bf16_t* bp = b + r * ldb + 8 * h;
#pragma unroll 4
  for (int k = 0; k < KD; k += 16) {
    bf16x8 av = *(const bf16x8*)(ap + k);
    bf16x8 bv = *(const bf16x8*)(bp + k);
    acc = __builtin_amdgcn_mfma_f32_32x32x16_bf16(av, bv, acc, 0, 0, 0);
  }
}

DEV int orig_col(int n) {
  if (n < 4864) return n;
  if (n < 6400) return n + 16;
  if (n < 6912) return n + 48;
  if (n < 6928) return n - 2048;
  if (n < 6960) return n - 512;
  return -1;
}

DEV void convert_weights(const Params& p, int l, unsigned char* smem) {
  float* s = (float*)smem;
  const int tid = launder(threadIdx.x);
  const float* win = p.w_in + (size_t)l * DM * NIN;
  const float* wout = p.w_out + (size_t)l * DI * DM;
  bf16_t* wint = (bf16_t*)(p.ws + OFF_WIN);
  bf16_t* woutt = (bf16_t*)(p.ws + OFF_WOUT);
  const int n_in_tiles = (NPAD / 64) * (DM / 64);
  const int n_out_tiles = (DM / 64) * (DI / 64);
  for (int it = blockIdx.x; it < n_in_tiles + n_out_tiles; it += gridDim.x) {
    __syncthreads();
    if (it < n_in_tiles) {
      const int n0 = (it / 16) * 64, k0 = (it % 16) * 64;
#pragma unroll
      for (int e = 0; e < 8; ++e) {
        const int idx = e * NT + tid, kk = idx >> 6, nn = idx & 63;
        const int oc = orig_col(n0 + nn);
        s[kk * 65 + nn] = (oc >= 0) ? win[(size_t)(k0 + kk) * NIN + oc] : 0.f;
      }
      __syncthreads();
      const int n = tid >> 3, kc = (tid & 7) * 8;
      uint4 o;
      o.x = pk2(s[(kc + 0) * 65 + n], s[(kc + 1) * 65 + n]); o.y = pk2(s[(kc + 2) * 65 + n], s[(kc + 3) * 65 + n]);
      o.z = pk2(s[(kc + 4) * 65 + n], s[(kc + 5) * 65 + n]); o.w = pk2(s[(kc + 6) * 65 + n], s[(kc + 7) * 65 + n]);
      *(uint4*)(wint + (size_t)(n0 + n) * DM + k0 + kc) = o;
    } else {
      const int j = it - n_in_tiles;
      const int n0 = (j / 32) * 64, k0 = (j % 32) * 64;
#pragma unroll
      for (int e = 0; e < 8; ++e) {
        const int idx = e * NT + tid, kk = idx >> 6, nn = idx & 63;
        s[kk * 65 + nn] = wout[(size_t)(k0 + kk) * DM + n0 + nn];
      }
      __syncthreads();
      const int n = tid >> 3, kc = (tid & 7) * 8;
      uint4 o;
      o.x = pk2(s[(kc + 0) * 65 + n], s[(kc + 1) * 65 + n]); o.y = pk2(s[(kc + 2) * 65 + n], s[(kc + 3) * 65 + n]);
      o.z = pk2(s[(kc + 4) * 65 + n], s[(kc + 5) * 65 + n]); o.w = pk2(s[(kc + 6) * 65 + n], s[(kc + 7) * 65 + n]);
      *(uint4*)(woutt + (size_t)(n0 + n) * DI + k0 + kc) = o;
    }
  }
  __syncthreads();
}

DEV void dsincos(double x, double& s, double& c) {
  const double k = rint(x * 0.63661977236758134308);
  double r = fma(-k, 1.57079632679489655800e+00, x);
  r = fma(-k, 6.12323399573676603587e-17, r);
  const double r2 = r * r;
  const double t3 = r2 * r, t5 = t3 * r2, t7 = t5 * r2, t9 = t7 * r2, t11 = t9 * r2, t13 = t11 * r2, t15 = t13 * r2;
  const double sinr = r - t3 / 6.0 + t5 / 120.0 - t7 / 5040.0 + t9 / 362880.0 - t11 / 39916800.0 + t13 / 6227020800.0 - t15 / 1307674368000.0;
  const double u2 = r2, u4 = u2 * u2, u6 = u4 * u2, u8 = u6 * u2, u10 = u8 * u2, u12 = u10 * u2, u14 = u12 * u2, u16 = u14 * u2;
  const double cosr = 1.0 - u2 / 2.0 + u4 / 24.0 - u6 / 720.0 + u8 / 40320.0 - u10 / 3628800.0 + u12 / 479001600.0 - u14 / 87178291200.0 + u16 / 20922789888000.0;
  const int q = ((int)k) & 3;
  if (q == 0) { s = sinr; c = cosr; }
  else if (q == 1) { s = cosr; c = -sinr; }
  else if (q == 2) { s = -sinr; c = -cosr; }
  else { s = -cosr; c = sinr; }
}

DEV void phase_pro(const Params& p, unsigned char* smem) {
  const int tid = launder(threadIdx.x);
  const size_t gtid = (size_t)blockIdx.x * NT + tid, gsz = (size_t)gridDim.x * NT;
  const float4* x4 = (const float4*)p.x;
  uint4* xb4 = (uint4*)(p.ws + OFF_XB);
  for (size_t i = gtid; i < (size_t)T_ALL * DM / 8; i += gsz) {
    const float4 a = x4[2 * i], b = x4[2 * i + 1];
    uint4 o; o.x = pk2(a.x, a.y); o.y = pk2(a.z, a.w); o.z = pk2(b.x, b.y); o.w = pk2(b.z, b.w);
    xb4[i] = o;
  }
  if (blockIdx.x == 0) {
    float2* tab = (float2*)(p.ws + OFF_TAB);
    for (int i = tid; i < 64 * 16; i += NT) {
      const int pos = i >> 4, fi = i & 15;
      const float invf = (float)exp(-(double)fi * (9.210340371976184 / 16.0));
      const float ang = (float)pos * invf;
      double s, c; dsincos((double)ang, s, c);
      tab[i] = make_float2((float)c, (float)s);
    }
  }
  convert_weights(p, 0, smem);
}

struct GStage { u32x4 a0, a1, b0, b1, b2, b3; };
DEV void gemm_block(const bf16_t* __restrict__ A, int lda, const bf16_t* __restrict__ A2, int lda2, int ksplit, const bf16_t* __restrict__ Bt, int ldb, int nk, unsigned char* smem, f32x16 (&acc)[2][2]) {
  const int tid = launder(threadIdx.x), lane = tid & 63, w = tid >> 6, wr = w >> 2, wc = w & 3, r = lane & 31, h = lane >> 5;
  const int ar = tid >> 2, ac = (tid & 3) * 16;
  const int br = tid >> 1, bc = (tid & 1) * 32;
  const bf16_t* ag = A + (size_t)ar * lda + ac;
  const bf16_t* ag2 = A2 + (size_t)ar * lda2 + ac;
  const bf16_t* bg = Bt + (size_t)br * ldb + bc;
#pragma unroll
  for (int i = 0; i < 2; ++i)
#pragma unroll
    for (int j = 0; j < 2; ++j) acc[i][j] = zero16();
  auto gload = [&](GStage& g, int kt) __attribute__((always_inline)) {
    const u32x4* pa = (const u32x4*)((kt < ksplit) ? (ag + kt * 64) : (ag2 + (kt - ksplit) * 64)); g.a0 = pa[0]; g.a1 = pa[1];
    const u32x4* pb = (const u32x4*)(bg + kt * 64); g.b0 = pb[0]; g.b1 = pb[1]; g.b2 = pb[2]; g.b3 = pb[3];
  };
  auto sstore = [&](const GStage& g, int st) __attribute__((always_inline)) {
    unsigned char* base = smem + st * 55296;
    u32x4* sa = (u32x4*)(base + ar * 144 + ac * 2); sa[0] = g.a0; sa[1] = g.a1;
    u32x4* sb = (u32x4*)(base + 18432 + br * 144 + bc * 2); sb[0] = g.b0; sb[1] = g.b1; sb[2] = g.b2; sb[3] = g.b3;
  };
  auto compute = [&](int st) __attribute__((always_inline)) {
    const bf16_t* sa = (const bf16_t*)(smem + st * 55296);
    const bf16_t* sb = (const bf16_t*)(smem + st * 55296 + 18432);
#pragma unroll
    for (int ks = 0; ks < 4; ++ks) {
      const bf16x8 a0 = *(const bf16x8*)(sa + (wr * 64 + r) * 72 + ks * 16 + 8 * h);
      const bf16x8 a1 = *(const bf16x8*)(sa + (wr * 64 + 32 + r) * 72 + ks * 16 + 8 * h);
      const bf16x8 b0 = *(const bf16x8*)(sb + (wc * 64 + r) * 72 + ks * 16 + 8 * h);
      const bf16x8 b1 = *(const bf16x8*)(sb + (wc * 64 + 32 + r) * 72 + ks * 16 + 8 * h);
      acc[0][0] = __builtin_amdgcn_mfma_f32_32x32x16_bf16(a0, b0, acc[0][0], 0, 0, 0);
      acc[0][1] = __builtin_amdgcn_mfma_f32_32x32x16_bf16(a0, b1, acc[0][1], 0, 0, 0);
      acc[1][0] = __builtin_amdgcn_mfma_f32_32x32x16_bf16(a1, b0, acc[1][0], 0, 0, 0);
      acc[1][1] = __builtin_amdgcn_mfma_f32_32x32x16_bf16(a1, b1, acc[1][1], 0, 0, 0);
    }
  };
  GStage G0, G1;
  gload(G0, 0); gload(G1, 1);
  sstore(G0, 0); gload(G0, 2);
  __syncthreads();
  for (int kt = 0; kt < nk; kt += 2) {
    sstore(G1, 1);
    if (kt + 3 < nk) gload(G1, kt + 3);
    compute(0);
    __syncthreads();
    if (kt + 2 < nk) { sstore(G0, 0); if (kt + 4 < nk) gload(G0, kt + 4); }
    compute(1);
    __syncthreads();
  }
}

DEV void phase_inproj(const Params& p, int l, int hf, unsigned char* smem) {
  const int tid = launder(threadIdx.x), lane = tid & 63, w = tid >> 6, wr = w >> 2, wc = w & 3, c = lane & 31, h = lane >> 5;
  const bf16_t* A = (const bf16_t*)(p.ws + OFF_XB) + (size_t)hf * TH * DM;
  const bf16_t* Bt = (const bf16_t*)(p.ws + OFF_WIN);
  bf16_t* Hh = (bf16_t*)(p.ws + OFF_H);
  float* SMALL = (float*)(p.ws + OFF_SMALL);
  bf16_t* VT = (bf16_t*)(p.ws + OFF_VT);
  const float2* tab = (const float2*)(p.ws + OFF_TAB);
  const int n_items = (TH / 128) * (NPAD / 256);
  for (int it = blockIdx.x; it < n_items; it += gridDim.x) {
    const int pn = it % 28, pm = it / 28;
    f32x16 acc[2][2];
    gemm_block(A + (size_t)pm * 128 * DM, DM, A, DM, DM / 64, Bt + (size_t)pn * 256 * DM, DM, DM / 64, smem, acc);
    const int colbase = pn * 256 + wc * 64;
    const int rowb = pm * 128 + wr * 64;
    if (colbase == SM0) {
#pragma unroll
      for (int mi = 0; mi < 2; ++mi)
#pragma unroll
        for (int reg = 0; reg < 16; ++reg) {
          const int row = rowb + mi * 32 + rowoff(reg, h);
          SMALL[(size_t)row * 48 + c] = acc[mi][0][reg];
          if (c < 16) SMALL[(size_t)row * 48 + 32 + c] = acc[mi][1][reg];
        }
    } else if (colbase < SM0) {
      if (colbase < A_V) {
        const bool isq = colbase < A_K;
        const float* gain = (isq ? p.q_gain : p.k_gain) + l * 64;
        const float g0 = gain[c], g1 = gain[32 + c];
        const float osc = isq ? QSCALE : 1.f;
#pragma unroll
        for (int mi = 0; mi < 2; ++mi)
#pragma unroll
          for (int reg = 0; reg < 16; ++reg) {
            float ss = acc[mi][0][reg] * acc[mi][0][reg] + acc[mi][1][reg] * acc[mi][1][reg];
            ss += __shfl_xor(ss, 1); ss += __shfl_xor(ss, 2); ss += __shfl_xor(ss, 4); ss += __shfl_xor(ss, 8); ss += __shfl_xor(ss, 16);
            const float rstd = rsqrtf(ss * (1.f / 64.f) + 1e-6f);
            const int row = rowb + mi * 32 + rowoff(reg, h);
            const int t = row & (SEQ - 1);
            const float2 cs0 = tab[(t >> 6) * 16 + (c & 15)], cs1 = tab[(t & 63) * 16 + (c & 15)];
            const float v0 = acc[mi][0][reg] * rstd * g0, v1 = acc[mi][1][reg] * rstd * g1;
            const float p0 = __shfl_xor(v0, 16), p1 = __shfl_xor(v1, 16);
            const float o0 = (c & 16) ? (v0 * cs0.x + p0 * cs0.y) : (v0 * cs0.x - p0 * cs0.y);
            const float o1 = (c & 16) ? (v1 * cs1.x + p1 * cs1.y) : (v1 * cs1.x - p1 * cs1.y);
            acc[mi][0][reg] = o0 * osc; acc[mi][1][reg] = o1 * osc;
          }
      }
      if (colbase >= A_V && colbase < A_Z) {
        const int kvh = (colbase - A_V) >> 6;
#pragma unroll
        for (int mi = 0; mi < 2; ++mi)
#pragma unroll
          for (int ni = 0; ni < 2; ++ni)
#pragma unroll
            for (int g = 0; g < 4; ++g) {
              const int row = rowb + mi * 32 + 8 * g + 4 * h;
              const int bl = row >> 12, t = row & (SEQ - 1);
              const int d = ni * 32 + c;
              uint2 o; o.x = pk2(acc[mi][ni][4 * g + 0], acc[mi][ni][4 * g + 1]); o.y = pk2(acc[mi][ni][4 * g + 2], acc[mi][ni][4 * g + 3]);
              *(uint2*)(VT + ((size_t)((bl * 2 + kvh) * 64 + d)) * SEQ + t) = o;
            }
      } else {
        bf16_t* so = (bf16_t*)(smem + w * 9216);
#pragma unroll
        for (int mi = 0; mi < 2; ++mi)
#pragma unroll
          for (int ni = 0; ni < 2; ++ni)
#pragma unroll
            for (int reg = 0; reg < 16; ++reg)
              so[(mi * 32 + rowoff(reg, h)) * 72 + ni * 32 + c] = f2bf(acc[mi][ni][reg]);
        __builtin_amdgcn_s_waitcnt(0xc07f);
        __builtin_amdgcn_wave_barrier();
#pragma unroll
        for (int i = 0; i < 8; ++i) {
          const int rr = i * 8 + (lane >> 3), ch = lane & 7;
          const uint4 v = *(const uint4*)(so + rr * 72 + ch * 8);
          *(uint4*)(Hh + (size_t)(rowb + rr) * NPAD + colbase + ch * 8) = v;
        }
      }
    }
    __syncthreads();
  }
}

DEV void phase_outproj(const Params& p, int l, int hf, unsigned char* smem) {
  const int tid = launder(threadIdx.x), lane = tid & 63, w = tid >> 6, wr = w >> 2, wc = w & 3, c = lane & 31, h = lane >> 5;
  const bf16_t* A = (const bf16_t*)(p.ws + OFF_MIXED);
  const bf16_t* Hat = (const bf16_t*)(p.ws + OFF_H) + A_Q;
  const bf16_t* Bt = (const bf16_t*)(p.ws + OFF_WOUT);
  const float* xin = (l == 0) ? p.x : p.out;
  const int n_items = (TH / 128) * (DM / 256);
  for (int it = blockIdx.x; it < n_items; it += gridDim.x) {
    const int pn = it & 3, pm = it >> 2;
    f32x16 acc[2][2];
    gemm_block(Hat + (size_t)pm * 128 * NPAD, NPAD, A + (size_t)pm * 128 * DI + 512, DI, 8, Bt + (size_t)pn * 256 * DI, DI, DI / 64, smem, acc);
#pragma unroll
    for (int mi = 0; mi < 2; ++mi)
#pragma unroll
      for (int ni = 0; ni < 2; ++ni)
#pragma unroll
        for (int reg = 0; reg < 16; ++reg) {
          const int row = hf * TH + pm * 128 + wr * 64 + mi * 32 + rowoff(reg, h);
          const int col = pn * 256 + wc * 64 + ni * 32 + c;
          const size_t idx = (size_t)row * DM + col;
          p.out[idx] = DN_ALPHA * xin[idx] + acc[mi][ni][reg];
        }
    __syncthreads();
  }
}

DEV void phase_ln(const Params& p, int l, int hf) {
  const int tid = launder(threadIdx.x), lane = tid & 63, w = tid >> 6;
  const float* g = p.ln_g + l * DM; const float* b = p.ln_b + l * DM;
  bf16_t* xb = (bf16_t*)(p.ws + OFF_XB);
  for (int r = blockIdx.x * 8 + w; r < TH; r += gridDim.x * 8) {
    const int row = hf * TH + r;
    float4* rp = (float4*)(p.out + (size_t)row * DM);
    float4 v[4];
    float s = 0.f;
#pragma unroll
    for (int j = 0; j < 4; ++j) { v[j] = rp[j * 64 + lane]; s += (v[j].x + v[j].y) + (v[j].z + v[j].w); }
#pragma unroll
    for (int o = 32; o >= 1; o >>= 1) s += __shfl_xor(s, o);
    const float mu = s * (1.f / DM);
    float q = 0.f;
#pragma unroll
    for (int j = 0; j < 4; ++j) { const float a = v[j].x - mu, bb = v[j].y - mu, cc = v[j].z - mu, d = v[j].w - mu; q += (a * a + bb * bb) + (cc * cc + d * d); }
#pragma unroll
    for (int o = 32; o >= 1; o >>= 1) q += __shfl_xor(q, o);
    const float rstd = rsqrtf(q * (1.f / DM) + 1e-5f);
#pragma unroll
    for (int j = 0; j < 4; ++j) {
      const int col = (j * 64 + lane) * 4;
      const float4 gg = *(const float4*)(g + col), bb = *(const float4*)(b + col);
      float4 o;
      o.x = (v[j].x - mu) * rstd * gg.x + bb.x; o.y = (v[j].y - mu) * rstd * gg.y + bb.y;
      o.z = (v[j].z - mu) * rstd * gg.z + bb.z; o.w = (v[j].w - mu) * rstd * gg.w + bb.w;
      rp[j * 64 + lane] = o;
      if (l == 0) { uint2 pk; pk.x = pk2(o.x, o.y); pk.y = pk2(o.z, o.w); *(uint2*)(xb + (size_t)row * DM + col) = pk; }
    }
  }
}

DEV void attn_item(const Params& p, int l, int item, unsigned char* smem) {
  const int tid = launder(threadIdx.x), lane = tid & 63, w = tid >> 6, r = lane & 31, h = lane >> 5;
  const int qt = item & 15, head = (item >> 4) & 7, bl = item >> 7;
  const int kvh = head >> 2;
  bf16_t* Hh = (bf16_t*)(p.ws + OFF_H);
  const bf16_t* VT = (const bf16_t*)(p.ws + OFF_VT);
  const size_t rowbase = (size_t)bl * SEQ;
  float mq = fabsf(p.q_gain[l * 64 + lane]), mk = fabsf(p.k_gain[l * 64 + lane]);
#pragma unroll
  for (int o = 32; o >= 1; o >>= 1) { mq = fmaxf(mq, __shfl_xor(mq, o)); mk = fmaxf(mk, __shfl_xor(mk, o)); }
  const float M2 = 8.f * mq * mk * LOG2E * 1.01f;
  const int qrow = qt * 256 + w * 32 + r;
  const bf16_t* qp = Hh + (rowbase + qrow) * NPAD + A_Q + head * 64 + 8 * h;
  bf16x8 qf[4];
#pragma unroll
  for (int ks = 0; ks < 4; ++ks) qf[ks] = *(const bf16x8*)(qp + ks * 16);
  f32x16 o0 = zero16(), o1 = zero16();
  float lsum = 0.f;
  const int srow = tid >> 3, sch = (tid & 7) * 8;
  const bf16_t* kp = Hh + (rowbase + srow) * NPAD + A_K + kvh * 64 + sch;
  const bf16_t* vp = VT + ((size_t)((bl * 2 + kvh) * 64 + srow)) * SEQ + sch;
  auto compute = [&](int st) __attribute__((always_inline)) {
    const bf16_t* sK = (const bf16_t*)(smem + st * 18432);
    const bf16_t* sV = (const bf16_t*)(smem + st * 18432 + 9216);
    f32x16 s0 = zero16(), s1 = zero16();
#pragma unroll
    for (int ks = 0; ks < 4; ++ks) {
      const bf16x8 a0 = *(const bf16x8*)(sK + r * 72 + ks * 16 + 8 * h);
      const bf16x8 a1 = *(const bf16x8*)(sK + (32 + r) * 72 + ks * 16 + 8 * h);
      s0 = __builtin_amdgcn_mfma_f32_32x32x16_bf16(a0, qf[ks], s0, 0, 0, 0);
      s1 = __builtin_amdgcn_mfma_f32_32x32x16_bf16(a1, qf[ks], s1, 0, 0, 0);
    }
#pragma unroll
    for (int i = 0; i < 16; ++i) { s0[i] = __builtin_amdgcn_exp2f(s0[i] - M2); s1[i] = __builtin_amdgcn_exp2f(s1[i] - M2); lsum += s0[i] + s1[i]; }
    union { bf16x8 v; unsigned u[4]; } pb[2][2];
#pragma unroll
    for (int s = 0; s < 2; ++s)
#pragma unroll
      for (int j = 0; j < 4; ++j) {
        pb[0][s].u[j] = pk2(s0[8 * s + 2 * j], s0[8 * s + 2 * j + 1]);
        pb[1][s].u[j] = pk2(s1[8 * s + 2 * j], s1[8 * s + 2 * j + 1]);
      }
#pragma unroll
    for (int kt2 = 0; kt2 < 2; ++kt2)
#pragma unroll
      for (int s = 0; s < 2; ++s) {
        const int kb = kt2 * 32 + 16 * s + 4 * h;
        union { bf16x8 v; uint2 u[2]; } a0, a1;
        a0.u[0] = *(const uint2*)(sV + r * 72 + kb); a0.u[1] = *(const uint2*)(sV + r * 72 + kb + 8);
        a1.u[0] = *(const uint2*)(sV + (32 + r) * 72 + kb); a1.u[1] = *(const uint2*)(sV + (32 + r) * 72 + kb + 8);
        o0 = __builtin_amdgcn_mfma_f32_32x32x16_bf16(a0.v, pb[kt2][s].v, o0, 0, 0, 0);
        o1 = __builtin_amdgcn_mfma_f32_32x32x16_bf16(a1.v, pb[kt2][s].v, o1, 0, 0, 0);
      }
  };
  constexpr int NKT = SEQ / 64;
  u32x4 k0 = *(const u32x4*)kp, v0 = *(const u32x4*)vp;
  u32x4 k1 = *(const u32x4*)(kp + (size_t)64 * NPAD), v1 = *(const u32x4*)(vp + 64);
  *(u32x4*)(smem + srow * 144 + sch * 2) = k0;
  *(u32x4*)(smem + 9216 + srow * 144 + sch * 2) = v0;
  k0 = *(const u32x4*)(kp + (size_t)2 * 64 * NPAD); v0 = *(const u32x4*)(vp + 2 * 64);
  __syncthreads();
  for (int kt = 0; kt < NKT; kt += 2) {
    *(u32x4*)(smem + 18432 + srow * 144 + sch * 2) = k1;
    *(u32x4*)(smem + 18432 + 9216 + srow * 144 + sch * 2) = v1;
    if (kt + 3 < NKT) { k1 = *(const u32x4*)(kp + (size_t)(kt + 3) * 64 * NPAD); v1 = *(const u32x4*)(vp + (kt + 3) * 64); }
    compute(0);
    __syncthreads();
    if (kt + 2 < NKT) {
      *(u32x4*)(smem + srow * 144 + sch * 2) = k0;
      *(u32x4*)(smem + 9216 + srow * 144 + sch * 2) = v0;
      if (kt + 4 < NKT) { k0 = *(const u32x4*)(kp + (size_t)(kt + 4) * 64 * NPAD); v0 = *(const u32x4*)(vp + (kt + 4) * 64); }
    }
    compute(1);
    __syncthreads();
  }
  lsum += __shfl_xor(lsum, 32);
  const float inv = 1.f / lsum;
  const bf16_t* zp = Hh + (rowbase + qrow) * NPAD + A_Z + head * 64;
  bf16_t* op = Hh + (rowbase + qrow) * NPAD + A_Q + head * 64;
#pragma unroll
  for (int dt = 0; dt < 2; ++dt)
#pragma unroll
    for (int g = 0; g < 4; ++g) {
      const int d0 = dt * 32 + 8 * g + 4 * h;
      const uint2 zz = *(const uint2*)(zp + d0);
      const float z0 = bf2f((bf16_t)(zz.x & 0xffff)), z1 = bf2f((bf16_t)(zz.x >> 16)), z2 = bf2f((bf16_t)(zz.y & 0xffff)), z3 = bf2f((bf16_t)(zz.y >> 16));
      const f32x16& oo = dt ? o1 : o0;
      uint2 ov;
      ov.x = pk2(oo[4 * g + 0] * inv * fsilu(z0), oo[4 * g + 1] * inv * fsilu(z1));
      ov.y = pk2(oo[4 * g + 2] * inv * fsilu(z2), oo[4 * g + 3] * inv * fsilu(z3));
      *(uint2*)(op + d0) = ov;
    }
  __syncthreads();
}

constexpr int L_QT = 0, L_KT = 17408, L_QC = 34816, L_KHT = 52224, L_VT = 70656, L_P = 89088, L_ST = 98304, L_RAW = 89088,
              L_D = 138240, L_TOT = 138752, L_ACS = 142848, L_DT = 143104, L_LOW = 143360;

template <int K, int V> struct ScanGeom {
  static constexpr int KP = K + 8;
  static constexpr int NS = (K / 32) * (V / 32) / 8;
};

template <int K, int V>
DEV void scan_write_state(unsigned char* smem, const f32x16* S, int w, int lane) {
  constexpr int KP = K + 8, NS = ScanGeom<K, V>::NS, NVT = V / 32;
  bf16_t* sST = (bf16_t*)(smem + L_ST);
  const int c = lane & 31, h = lane >> 5;
#pragma unroll
  for (int i = 0; i < NS; ++i) {
    const int tile = w * NS + i, kt = tile / NVT, nt = tile % NVT;
#pragma unroll
    for (int g = 0; g < 4; ++g) {
      uint2 o; o.x = pk2(S[i][4 * g + 0], S[i][4 * g + 1]); o.y = pk2(S[i][4 * g + 2], S[i][4 * g + 3]);
      *(uint2*)(sST + (nt * 32 + c) * KP + kt * 32 + 8 * g + 4 * h) = o;
    }
  }
}

template <int K, int V, bool SSDM>
DEV void scan_core(unsigned char* smem, f32x16* S, bf16_t* orow0, int dir, int w, int lane, bool do_out) {
  constexpr int KP = K + 8, NS = ScanGeom<K, V>::NS, NVT = V / 32, NOT = 2 * NVT;
  const bf16_t* sQt = (const bf16_t*)(smem + L_QT); const bf16_t* sKt = (const bf16_t*)(smem + L_KT);
  const bf16_t* sQc = (const bf16_t*)(smem + L_QC); const bf16_t* sKhT = (const bf16_t*)(smem + L_KHT);
  const bf16_t* sVT = (const bf16_t*)(smem + L_VT); bf16_t* sP = (bf16_t*)(smem + L_P);
  const bf16_t* sST = (const bf16_t*)(smem + L_ST); const float* sD = (const float*)(smem + L_D);
  const float* sAcs = (const float*)(smem + L_ACS);
  const int c = lane & 31, h = lane >> 5;
  if (do_out) scan_write_state<K, V>(smem, S, w, lane);
  if (do_out && w < 4) {
    const int tt = w >> 1, st = w & 1;
    f32x16 acc = zero16();
    if (st <= tt) mma32<K>(acc, sQt + tt * 32 * KP, KP, sKt + st * 32 * KP, KP, lane);
#pragma unroll
    for (int reg = 0; reg < 16; ++reg) {
      const int tau = tt * 32 + rowoff(reg, h), sig = st * 32 + c;
      float v = 0.f;
      if (sig <= tau) { v = acc[reg]; if (SSDM) v *= __expf(sAcs[tau] - sAcs[sig]); }
      sP[tau * 72 + sig] = f2bf(v);
    }
  }
  __syncthreads();
  if (do_out && w < NOT) {
    const int tt = w / NVT, nt = w % NVT;
    f32x16 acc = zero16();
    mma32<64>(acc, sP + tt * 32 * 72, 72, sVT + nt * 32 * 72, 72, lane);
    mma32<K>(acc, sQc + tt * 32 * KP, KP, sST + nt * 32 * KP, KP, lane);
#pragma unroll
    for (int reg = 0; reg < 16; ++reg) {
      const int tau = tt * 32 + rowoff(reg, h);
      const int tok = dir ? (63 - tau) : tau;
      orow0[(size_t)tok * 512 + nt * 32 + c] = f2bf(acc[reg]);
    }
  }
#pragma unroll
  for (int i = 0; i < NS; ++i) {
    const int tile = w * NS + i, kt = tile / NVT, nt = tile % NVT;
#pragma unroll
    for (int reg = 0; reg < 16; ++reg) S[i][reg] *= sD[kt * 32 + rowoff(reg, h)];
    mma32<64>(S[i], sKhT + kt * 32 * 72, 72, sVT + nt * 32 * 72, 72, lane);
  }
  __syncthreads();
}

template <int K, int V>
DEV void state_store(float* buf, const f32x16* S, int w, int lane) {
  constexpr int NS = ScanGeom<K, V>::NS, NVT = V / 32;
  const int c = lane & 31, h = lane >> 5;
#pragma unroll
  for (int i = 0; i < NS; ++i) {
    const int tile = w * NS + i, kt = tile / NVT, nt = tile % NVT;
#pragma unroll
    for (int reg = 0; reg < 16; ++reg) buf[(kt * 32 + rowoff(reg, h)) * V + nt * 32 + c] = S[i][reg];
  }
}
template <int K, int V>
DEV void state_load(const float* buf, f32x16* S, int w, int lane) {
  constexpr int NS = ScanGeom<K, V>::NS, NVT = V / 32;
  const int c = lane & 31, h = lane >> 5;
#pragma unroll
  for (int i = 0; i < NS; ++i) {
    const int tile = w * NS + i, kt = tile / NVT, nt = tile % NVT;
#pragma unroll
    for (int reg = 0; reg < 16; ++reg) S[i][reg] = buf[(kt * 32 + rowoff(reg, h)) * V + nt * 32 + c];
  }
}

DEV void store16(bf16_t* dst, const float* v) {
  uint4 a, b;
  a.x = pk2(v[0], v[1]); a.y = pk2(v[2], v[3]); a.z = pk2(v[4], v[5]); a.w = pk2(v[6], v[7]);
  b.x = pk2(v[8], v[9]); b.y = pk2(v[10], v[11]); b.z = pk2(v[12], v[13]); b.w = pk2(v[14], v[15]);
  ((uint4*)dst)[0] = a; ((uint4*)dst)[1] = b;
}
DEV void gather16(bf16_t* dst, const bf16_t* src, int stride) {
  unsigned u[8];
#pragma unroll
  for (int i = 0; i < 8; ++i) u[i] = (unsigned)src[(2 * i) * stride] | ((unsigned)src[(2 * i + 1) * stride] << 16);
  ((uint4*)dst)[0] = make_uint4(u[0], u[1], u[2], u[3]); ((uint4*)dst)[1] = make_uint4(u[4], u[5], u[6], u[7]);
}

DEV void hgrn_item(const Params& p, int l, int it, int seg, int mode, unsigned char* smem) {
  const int bl = it >> 3, head = (it >> 1) & 3, dir = it & 1;
  const bool do_out = (mode == 3);
  constexpr int K = 128, V = 128, KP = 136;
  const int tid = launder(threadIdx.x), lane = tid & 63, w = tid >> 6;
  const int ch = tid & 127, qd = tid >> 7;
  const bf16_t* Hh = (const bf16_t*)(p.ws + OFF_H);
  bf16_t* OB = (bf16_t*)(p.ws + OFF_OBUF) + (size_t)(0 * 2 + dir) * TH * 512;
  const size_t rowbase = (size_t)bl * SEQ;
  float lbv = 0.f;
  if (l > 0) lbv = fsigmoid(p.lb_logits[512 + head * 128 + ch] - p.lb_logits[head * 128 + ch]);
  const int fbase = dir ? H_FB : H_FF;
  bf16_t* sQt = (bf16_t*)(smem + L_QT); bf16_t* sKt = (bf16_t*)(smem + L_KT); bf16_t* sQc = (bf16_t*)(smem + L_QC);
  bf16_t* sKhT = (bf16_t*)(smem + L_KHT); bf16_t* sVT = (bf16_t*)(smem + L_VT);
  float* sD = (float*)(smem + L_D); float* sTot = (float*)(smem + L_TOT);
  const bf16_t* rawQ = (const bf16_t*)(smem + L_RAW); const bf16_t* rawF = rawQ + 8192; const bf16_t* rawV = rawQ + 16384;
  f32x16 S[2]; S[0] = zero16(); S[1] = zero16();
  float* sbuf = (float*)(p.ws + OFF_SB0) + ((size_t)it * NSEG + seg) * 16384;
  if (do_out) state_load<K, V>(sbuf, S, w, lane);
  float dlog = 0.f;
  u32x4 pre[6];
  const int prow0 = tid >> 4, pc16 = (tid & 15) * 8;
  auto gload = [&](int cidx) __attribute__((always_inline)) {
    const int chunk = dir ? (63 - cidx) : cidx;
#pragma unroll
    for (int j = 0; j < 2; ++j) {
      const int row = prow0 + 32 * j;
      const int tok = chunk * 64 + (dir ? (63 - row) : row);
      const bf16_t* rp = Hh + (rowbase + tok) * NPAD + head * 128 + pc16;
      pre[j] = *(const u32x4*)(rp + H_Q); pre[2 + j] = *(const u32x4*)(rp + fbase); pre[4 + j] = *(const u32x4*)(rp + H_I);
    }
  };
  gload(seg * SLEN);
  for (int ci = 0; ci < SLEN; ++ci) {
    const int cidx = seg * SLEN + ci;
    const int chunk = dir ? (63 - cidx) : cidx;
#pragma unroll
    for (int j = 0; j < 2; ++j) {
      unsigned char* d = smem + L_RAW + (prow0 + 32 * j) * 256 + pc16 * 2;
      *(u32x4*)d = pre[j]; *(u32x4*)(d + 16384) = pre[2 + j]; *(u32x4*)(d + 32768) = pre[4 + j];
    }
    __syncthreads();
    if (ci + 1 < SLEN) gload(cidx + 1);
    float run = 0.f;
#pragma unroll 1
    for (int i0 = 0; i0 < 16; i0 += 4) {
#pragma unroll
      for (int ii = 0; ii < 4; ++ii) {
        const float f = bf2f(rawF[(16 * qd + i0 + ii) * 128 + ch]);
        const float sg = 1.f / (1.f + __expf(-f));
        run += __logf(lbv + (1.f - lbv) * sg);
      }
    }
    sTot[qd * 128 + ch] = run;
    __syncthreads();
    const float t0 = sTot[ch], t1 = sTot[128 + ch], t2 = sTot[256 + ch], t3 = sTot[384 + ch];
    const float off = (qd > 0 ? t0 : 0.f) + (qd > 1 ? t1 : 0.f) + (qd > 2 ? t2 : 0.f);
    const float ref = t0 + t1, bend = (t0 + t1) + (t2 + t3);
    dlog += bend;
    float b = off;
#pragma unroll 1
    for (int i0 = 0; i0 < 16; i0 += 4) {
      float kh4[4]; unsigned vb[4];
#pragma unroll
      for (int ii = 0; ii < 4; ++ii) {
        const int tau = 16 * qd + i0 + ii;
        const float f = bf2f(rawF[tau * 128 + ch]);
        const float sg = 1.f / (1.f + __expf(-f));
        b += __logf(lbv + (1.f - lbv) * sg);
        const float kx = (1.f - lbv) / (1.f + __expf(f));
        if (do_out) {
          const float qr = bf2f(rawQ[tau * 128 + ch]);
          const float qx = qr * (1.f / (1.f + __expf(-qr))) * 0.08838834764831845f;
          sQt[tau * KP + ch] = f2bf(qx * __expf(b - ref));
          sKt[tau * KP + ch] = f2bf(kx * __expf(ref - b));
          sQc[tau * KP + ch] = f2bf(qx * __expf(b));
        }
        kh4[ii] = kx * __expf(bend - b);
        vb[ii] = rawV[tau * 128 + ch];
      }
      uint2 o; o.x = pk2(kh4[0], kh4[1]); o.y = pk2(kh4[2], kh4[3]);
      *(uint2*)(sKhT + ch * 72 + 16 * qd + i0) = o;
      uint2 ov; ov.x = vb[0] | (vb[1] << 16); ov.y = vb[2] | (vb[3] << 16);
      *(uint2*)(sVT + ch * 72 + 16 * qd + i0) = ov;
    }
    if (qd == 0) sD[ch] = __expf(bend);
    __syncthreads();
    scan_core<K, V, false>(smem, S, OB + (rowbase + (size_t)chunk * 64) * 512 + head * 128, dir, w, lane, do_out);
  }
  if (!do_out) {
    state_store<K, V>(sbuf, S, w, lane);
    if (qd == 0) ((float*)(p.ws + OFF_DB))[((size_t)it * NSEG + seg) * 128 + ch] = __expf(dlog);
  }
}

DEV void gla_item(const Params& p, int l, int it, int seg, int mode, unsigned char* smem) {
  const int j16 = it - 16, bl = j16 >> 3, head = (j16 >> 1) & 3, dir = j16 & 1;
  const bool do_out = (mode == 3);
  constexpr int K = 64, V = 128, KP = 72;
  const int tid = launder(threadIdx.x), lane = tid & 63, w = tid >> 6;
  const int ch = tid & 63, oc = tid >> 6;
  const int vn = tid & 127, vq = tid >> 7;
  const bf16_t* Hh = (const bf16_t*)(p.ws + OFF_H);
  const float* SMALL = (const float*)(p.ws + OFF_SMALL);
  bf16_t* OB = (bf16_t*)(p.ws + OFF_OBUF) + (size_t)(2 * 2 + dir) * TH * 512;
  const size_t rowbase = (size_t)bl * SEQ;
  bf16_t* sQt = (bf16_t*)(smem + L_QT); bf16_t* sKt = (bf16_t*)(smem + L_KT); bf16_t* sQc = (bf16_t*)(smem + L_QC);
  bf16_t* sKhT = (bf16_t*)(smem + L_KHT); bf16_t* sVT = (bf16_t*)(smem + L_VT);
  float* sD = (float*)(smem + L_D); float* sTot = (float*)(smem + L_TOT); float* sLow = (float*)(smem + L_LOW);
  const bf16_t* rawQ = (const bf16_t*)(smem + L_RAW); const bf16_t* rawK = rawQ + 4096; const bf16_t* rawV = rawQ + 8192;
  float w2c[16];
#pragma unroll
  for (int r = 0; r < 16; ++r) w2c[r] = p.gk_w2[((size_t)(l * 2 + dir) * 16 + r) * 256 + head * 64 + ch];
  const float gb = p.gk_b[(l * 2 + dir) * 256 + head * 64 + ch];
  f32x16 S[1]; S[0] = zero16();
  float* sbuf = (float*)(p.ws + OFF_SB1) + ((size_t)j16 * NSEG + seg) * 8192;
  if (do_out) state_load<K, V>(sbuf, S, w, lane);
  float dlog = 0.f;
  u32x4 pre[4];
  float plow0, plow1;
  const int qrow = tid >> 3, qc8 = (tid & 7) * 8, vrow0 = tid >> 4, vc16 = (tid & 15) * 8;
  auto gload = [&](int cidx) __attribute__((always_inline)) {
    const int chunk = dir ? (63 - cidx) : cidx;
    {
      const int tok = chunk * 64 + (dir ? (63 - qrow) : qrow);
      const bf16_t* rp = Hh + (rowbase + tok) * NPAD + head * 64 + qc8;
      pre[0] = *(const u32x4*)(rp + G_Q); pre[1] = *(const u32x4*)(rp + G_K);
      { const float* lp = SMALL + (rowbase + tok) * 48 + 16 + dir * 16 + (tid & 7) * 2; plow0 = lp[0]; plow1 = lp[1]; }
    }
#pragma unroll
    for (int j = 0; j < 2; ++j) {
      const int row = vrow0 + 32 * j;
      const int tok = chunk * 64 + (dir ? (63 - row) : row);
      pre[2 + j] = *(const u32x4*)(Hh + (rowbase + tok) * NPAD + G_V + head * 128 + vc16);
    }
  };
  gload(seg * SLEN);
  for (int ci = 0; ci < SLEN; ++ci) {
    const int cidx = seg * SLEN + ci;
    const int chunk = dir ? (63 - cidx) : cidx;
    {
      unsigned char* d = smem + L_RAW + qrow * 128 + qc8 * 2;
      *(u32x4*)d = pre[0]; *(u32x4*)(d + 8192) = pre[1];
      sLow[qrow * 16 + (tid & 7) * 2] = plow0; sLow[qrow * 16 + (tid & 7) * 2 + 1] = plow1;
#pragma unroll
      for (int j = 0; j < 2; ++j) *(u32x4*)(smem + L_RAW + 16384 + (vrow0 + 32 * j) * 256 + vc16 * 2) = pre[2 + j];
    }
    __syncthreads();
    if (ci + 1 < SLEN) gload(cidx + 1);
    float run = 0.f;
#pragma unroll 1
    for (int i = 0; i < 8; ++i) {
      const int tau = 8 * oc + i;
      float gk = gb;
#pragma unroll
      for (int r = 0; r < 16; ++r) gk += sLow[tau * 16 + r] * w2c[r];
      run += (fminf(gk, 0.f) - __logf(1.f + __expf(-fabsf(gk)))) * (1.f / 16.f);
    }
    sTot[oc * 64 + ch] = run;
    __syncthreads();
    float off = 0.f, ref = 0.f, bend = 0.f;
#pragma unroll
    for (int j = 0; j < 8; ++j) { const float t = sTot[j * 64 + ch]; if (j < oc) off += t; if (j < 4) ref += t; bend += t; }
    dlog += bend;
    float b = off;
#pragma unroll 1
    for (int i0 = 0; i0 < 8; i0 += 4) {
      float kh4[4];
#pragma unroll
      for (int ii = 0; ii < 4; ++ii) {
        const int tau = 8 * oc + i0 + ii;
        float gk = gb;
#pragma unroll
        for (int r = 0; r < 16; ++r) gk += sLow[tau * 16 + r] * w2c[r];
        b += (fminf(gk, 0.f) - __logf(1.f + __expf(-fabsf(gk)))) * (1.f / 16.f);
        const float qx = bf2f(rawQ[tau * 64 + ch]) * 0.125f, kx = bf2f(rawK[tau * 64 + ch]);
        if (do_out) {
          sQt[tau * KP + ch] = f2bf(qx * __expf(b - ref));
          sKt[tau * KP + ch] = f2bf(kx * __expf(ref - b));
          sQc[tau * KP + ch] = f2bf(qx * __expf(b));
        }
        kh4[ii] = kx * __expf(bend - b);
      }
      uint2 o; o.x = pk2(kh4[0], kh4[1]); o.y = pk2(kh4[2], kh4[3]);
      *(uint2*)(sKhT + ch * 72 + 8 * oc + i0) = o;
    }
#pragma unroll 1
    for (int i0 = 0; i0 < 16; i0 += 4) {
      unsigned vb[4];
#pragma unroll
      for (int ii = 0; ii < 4; ++ii) vb[ii] = rawV[(16 * vq + i0 + ii) * 128 + vn];
      uint2 ov; ov.x = vb[0] | (vb[1] << 16); ov.y = vb[2] | (vb[3] << 16);
      *(uint2*)(sVT + vn * 72 + 16 * vq + i0) = ov;
    }
    if (oc == 0) sD[ch] = __expf(bend);
    __syncthreads();
    scan_core<K, V, false>(smem, S, OB + (rowbase + (size_t)chunk * 64) * 512 + head * 128, dir, w, lane, do_out);
  }
  if (!do_out) {
    state_store<K, V>(sbuf, S, w, lane);
    if (oc == 0) ((float*)(p.ws + OFF_DB))[((size_t)it * NSEG + seg) * 128 + ch] = __expf(dlog);
  }
}

DEV void ssd_item(const Params& p, int l, int it, int seg, int mode, unsigned char* smem) {
  const int j32 = it - 32, bl = j32 >> 4, head = (j32 >> 1) & 7, dir = j32 & 1;
  const bool do_out = (mode == 3);
  constexpr int K = 128, V = 64, KP = 136;
  const int tid = launder(threadIdx.x), lane = tid & 63, w = tid >> 6;
  const int n = tid & 127, qd = tid >> 7;
  const int pp = tid & 63, oc = tid >> 6;
  const int grp = head >> 2;
  const bf16_t* Hh = (const bf16_t*)(p.ws + OFF_H);
  const float* SMALL = (const float*)(p.ws + OFF_SMALL);
  bf16_t* OB = (bf16_t*)(p.ws + OFF_OBUF) + (size_t)(1 * 2 + dir) * TH * 512;
  const size_t rowbase = (size_t)bl * SEQ;
  bf16_t* sQt = (bf16_t*)(smem + L_QT); bf16_t* sKt = (bf16_t*)(smem + L_KT); bf16_t* sQc = (bf16_t*)(smem + L_QC);
  bf16_t* sKhT = (bf16_t*)(smem + L_KHT); bf16_t* sVT = (bf16_t*)(smem + L_VT);
  float* sD = (float*)(smem + L_D); float* sAcs = (float*)(smem + L_ACS); float* sDt = (float*)(smem + L_DT);
  const bf16_t* rawB = (const bf16_t*)(smem + L_RAW); const bf16_t* rawC = rawB + 68 * 128; const bf16_t* rawX = rawB + 2 * 68 * 128;
  const int chB = 512 + grp * 128 + n, chC = 768 + grp * 128 + n, chX = head * 64 + pp;
  const float* cw = p.conv_w + (size_t)l * 5 * 1024; const float* cb = p.conv_b + (size_t)l * 1024;
  float wB[5], wC[5], wX[5];
#pragma unroll
  for (int j = 0; j < 5; ++j) { wB[j] = cw[j * 1024 + chB]; wC[j] = cw[j * 1024 + chC]; wX[j] = cw[j * 1024 + chX]; }
  const float bB = cb[chB], bC = cb[chC], bX = cb[chX];
  const float dtb = p.dt_bias[(l * 2 + dir) * 8 + head];
  const float Acoef = -__expf(p.a_log[(l * 2 + dir) * 8 + head]);
  f32x16 S[1]; S[0] = zero16();
  float* sbuf = (float*)(p.ws + OFF_SB2) + ((size_t)j32 * NSEG + seg) * 8192;
  if (do_out) state_load<K, V>(sbuf, S, w, lane);
  float dlog = 0.f;
  u32x4 pre[6];
  float rdt = 0.f;
  auto decode = [&](int id, int& row, int& gcol, int& loff) __attribute__((always_inline)) {
    if (id < 1088) { row = id >> 4; gcol = S_X + 512 + grp * 128 + (id & 15) * 8; loff = row * 256 + (id & 15) * 16; }
    else if (id < 2176) { const int i2 = id - 1088; row = i2 >> 4; gcol = S_X + 768 + grp * 128 + (i2 & 15) * 8; loff = 17408 + row * 256 + (i2 & 15) * 16; }
    else { const int i2 = id - 2176; row = i2 >> 3; gcol = S_X + head * 64 + (i2 & 7) * 8; loff = 34816 + row * 128 + (i2 & 7) * 16; }
  };
  auto gload = [&](int cidx) __attribute__((always_inline)) {
    const int chunk = dir ? (63 - cidx) : cidx;
#pragma unroll
    for (int j = 0; j < 6; ++j) {
      const int id = tid + 512 * j;
      pre[j] = (u32x4){0u, 0u, 0u, 0u};
      if (id < 2720) {
        int row, gcol, loff; decode(id, row, gcol, loff);
        const int s = chunk * 64 + row - 2;
        if (s >= 0 && s < SEQ) pre[j] = *(const u32x4*)(Hh + (rowbase + s) * NPAD + gcol);
      }
    }
    if (w == 0) {
      const int tok = chunk * 64 + (dir ? (63 - lane) : lane);
      rdt = SMALL[(rowbase + tok) * 48 + dir * 8 + head];
    }
  };
  gload(seg * SLEN);
  for (int ci = 0; ci < SLEN; ++ci) {
    const int cidx = seg * SLEN + ci;
    const int chunk = dir ? (63 - cidx) : cidx;
#pragma unroll
    for (int j = 0; j < 6; ++j) {
      const int id = tid + 512 * j;
      if (id < 2720) { int row, gcol, loff; decode(id, row, gcol, loff); *(u32x4*)(smem + L_RAW + loff) = pre[j]; }
    }
    if (w == 0) {
      const float xx = rdt + dtb;
      const float dt = (xx > 20.f) ? xx : log1pf(__expf(xx));
      float a = dt * Acoef;
#pragma unroll
      for (int o = 1; o < 64; o <<= 1) { const float t = __shfl_up(a, o); if (lane >= o) a += t; }
      sAcs[lane] = a; sDt[lane] = dt;
    }
    __syncthreads();
    if (ci + 1 < SLEN) gload(cidx + 1);
    const float aend = sAcs[63];
    dlog += aend;
#pragma unroll 1
    for (int i0 = 0; i0 < 16; i0 += 2) {
      float kh2[2];
#pragma unroll
      for (int ii = 0; ii < 2; ++ii) {
        const int tau = 16 * qd + i0 + ii;
        const int tl = dir ? (63 - tau) : tau;
        float uB = bB, uC = bC;
#pragma unroll
        for (int j = 0; j < 5; ++j) { uB += wB[j] * bf2f(rawB[(tl + j) * 128 + n]); uC += wC[j] * bf2f(rawC[(tl + j) * 128 + n]); }
        uB = fsilu(uB); uC = fsilu(uC);
        const float ac = sAcs[tau];
        if (do_out) {
          sQt[tau * KP + n] = f2bf(uC);
          sKt[tau * KP + n] = f2bf(uB);
          sQc[tau * KP + n] = f2bf(uC * __expf(ac));
        }
        kh2[ii] = uB * __expf(aend - ac);
      }
      *(unsigned*)(sKhT + n * 72 + 16 * qd + i0) = pk2(kh2[0], kh2[1]);
    }
#pragma unroll 1
    for (int i0 = 0; i0 < 8; i0 += 2) {
      float xv[2];
#pragma unroll
      for (int ii = 0; ii < 2; ++ii) {
        const int tau = 8 * oc + i0 + ii;
        const int tl = dir ? (63 - tau) : tau;
        float u = bX;
#pragma unroll
        for (int j = 0; j < 5; ++j) u += wX[j] * bf2f(rawX[(tl + j) * 64 + pp]);
        xv[ii] = fsilu(u) * sDt[tau];
      }
      *(unsigned*)(sVT + pp * 72 + 8 * oc + i0) = pk2(xv[0], xv[1]);
    }
    if (qd == 0) sD[n] = __expf(aend);
    __syncthreads();
    scan_core<K, V, true>(smem, S, OB + (rowbase + (size_t)chunk * 64) * 512 + head * 64, dir, w, lane, do_out);
  }
  if (!do_out) {
    state_store<K, V>(sbuf, S, w, lane);
    if (qd == 0) ((float*)(p.ws + OFF_DB))[((size_t)it * NSEG + seg) * 128 + n] = __expf(dlog);
  }
}


DEV void phase_mix(const Params& p, int l, int hf, int slot, int mode, int att_lo, int att_hi, int vid_lo, int vid_hi, unsigned char* smem) {
  unsigned* ctr = (unsigned*)(p.ws + OFF_CTRL) + CTR_WORD0 + slot * 16;
  volatile int* sItem = (volatile int*)(smem + LDS_BYTES - 16);
  const int n_scan = 64 * NSEG;
  int hi = n_scan + (att_hi - att_lo); if (vid_hi < hi) hi = vid_hi;
  for (;;) {
    __syncthreads();
    if (threadIdx.x == 0) *sItem = vid_lo + (int)atomicAdd(ctr, 1u);
    __syncthreads();
    const int vid = *sItem;
    if (vid >= hi) break;
    if (vid < n_scan) {
      const int seg = vid >> 6, it = vid & 63;
      if (it < 16) { if (PH_MASK & 0x100) hgrn_item(p, l, it, seg, mode, smem); }
      else if (it < 32) { if (PH_MASK & 0x200) gla_item(p, l, it, seg, mode, smem); }
      else { if (PH_MASK & 0x400) ssd_item(p, l, it, seg, mode, smem); }
    } else { if (PH_MASK & 0x800) attn_item(p, l, att_lo + (vid - n_scan), smem); }
  }
}

DEV void phase_scan2(const Params& p) {
  const size_t gtid = (size_t)blockIdx.x * NT + threadIdx.x, gsz = (size_t)gridDim.x * NT;
  const float* DB = (const float*)(p.ws + OFF_DB);
  for (size_t e = gtid; e < 655360; e += gsz) {
    float* buf; const float* dp; int stride;
    if (e < 262144) { const int it = (int)(e >> 14), idx = (int)(e & 16383); buf = (float*)(p.ws + OFF_SB0) + (size_t)it * NSEG * 16384 + idx; stride = 16384; dp = DB + (size_t)it * NSEG * 128 + (idx >> 7); }
    else if (e < 393216) { const int e2 = (int)(e - 262144), j = e2 >> 13, idx = e2 & 8191; buf = (float*)(p.ws + OFF_SB1) + (size_t)j * NSEG * 8192 + idx; stride = 8192; dp = DB + (size_t)(16 + j) * NSEG * 128 + (idx >> 7); }
    else { const int e3 = (int)(e - 393216), j = e3 >> 13, idx = e3 & 8191; buf = (float*)(p.ws + OFF_SB2) + (size_t)j * NSEG * 8192 + idx; stride = 8192; dp = DB + (size_t)(32 + j) * NSEG * 128 + (idx >> 6); }
    float u[NSEG], d[NSEG];
#pragma unroll
    for (int sg = 0; sg < NSEG; ++sg) { u[sg] = buf[(size_t)sg * stride]; d[sg] = dp[sg * 128]; }
    float st = 0.f;
#pragma unroll
    for (int sg = 0; sg < NSEG; ++sg) { buf[(size_t)sg * stride] = st; st = d[sg] * st + u[sg]; }
  }
}

DEV void phase_fin(const Params& p, int l, int hf) {
  const int tid = launder(threadIdx.x), lane = tid & 63, w = tid >> 6;
  const bf16_t* Hh = (const bf16_t*)(p.ws + OFF_H);
  const bf16_t* OB = (const bf16_t*)(p.ws + OFF_OBUF);
  bf16_t* MX = (bf16_t*)(p.ws + OFF_MIXED);
  const int c0 = lane * 8;
  const float* cw = p.conv_w + (size_t)l * 5 * 1024; const float* cb = p.conv_b + (size_t)l * 1024;
  for (int r = blockIdx.x * 8 + w; r < TH; r += gridDim.x * 8) {
    const bf16_t* hrow = Hh + (size_t)r * NPAD;
    {
      const uint4 a = *(const uint4*)(OB + ((size_t)0 * TH + r) * 512 + c0), b = *(const uint4*)(OB + ((size_t)1 * TH + r) * 512 + c0);
      const uint4 z = *(const uint4*)(hrow + H_Z + c0);
      const unsigned au[4] = {a.x, a.y, a.z, a.w}, bu[4] = {b.x, b.y, b.z, b.w}, zu[4] = {z.x, z.y, z.z, z.w};
      float o[8]; float ss = 0.f;
#pragma unroll
      for (int j = 0; j < 4; ++j) {
        o[2 * j] = bf2f((bf16_t)(au[j] & 0xffff)) + bf2f((bf16_t)(bu[j] & 0xffff));
        o[2 * j + 1] = bf2f((bf16_t)(au[j] >> 16)) + bf2f((bf16_t)(bu[j] >> 16));
        ss += o[2 * j] * o[2 * j] + o[2 * j + 1] * o[2 * j + 1];
      }
#pragma unroll
      for (int of = 32; of >= 1; of >>= 1) ss += __shfl_xor(ss, of);
      const float rstd = rsqrtf(ss * (1.f / 512.f) + 1e-6f);
      float y[8];
#pragma unroll
      for (int j = 0; j < 8; ++j) {
        const float zz = bf2f((bf16_t)((j & 1) ? (zu[j >> 1] >> 16) : (zu[j >> 1] & 0xffff)));
        y[j] = o[j] * rstd * p.hgrn_norm[l * 512 + c0 + j] * fsilu(zz);
      }
      uint4 ov; ov.x = pk2(y[0], y[1]); ov.y = pk2(y[2], y[3]); ov.z = pk2(y[4], y[5]); ov.w = pk2(y[6], y[7]);
      *(uint4*)(MX + (size_t)r * DI + 512 + c0) = ov;
    }
    {
      const uint4 a = *(const uint4*)(OB + ((size_t)4 * TH + r) * 512 + c0), b = *(const uint4*)(OB + ((size_t)5 * TH + r) * 512 + c0);
      const uint4 z = *(const uint4*)(hrow + G_Z + c0);
      const unsigned au[4] = {a.x, a.y, a.z, a.w}, bu[4] = {b.x, b.y, b.z, b.w}, zu[4] = {z.x, z.y, z.z, z.w};
      float o[8]; float ss = 0.f;
#pragma unroll
      for (int j = 0; j < 4; ++j) {
        o[2 * j] = bf2f((bf16_t)(au[j] & 0xffff)) + bf2f((bf16_t)(bu[j] & 0xffff));
        o[2 * j + 1] = bf2f((bf16_t)(au[j] >> 16)) + bf2f((bf16_t)(bu[j] >> 16));
        ss += o[2 * j] * o[2 * j] + o[2 * j + 1] * o[2 * j + 1];
      }
#pragma unroll
      for (int of = 8; of >= 1; of >>= 1) ss += __shfl_xor(ss, of);
      const float rstd = rsqrtf(ss * (1.f / 128.f) + 1e-6f);
      float y[8];
#pragma unroll
      for (int j = 0; j < 8; ++j) {
        const float zz = bf2f((bf16_t)((j & 1) ? (zu[j >> 1] >> 16) : (zu[j >> 1] & 0xffff)));
        y[j] = o[j] * rstd * p.gla_norm[l * 128 + ((c0 + j) & 127)] * fsilu(zz);
      }
      uint4 ov; ov.x = pk2(y[0], y[1]); ov.y = pk2(y[2], y[3]); ov.z = pk2(y[4], y[5]); ov.w = pk2(y[6], y[7]);
      *(uint4*)(MX + (size_t)r * DI + 1536 + c0) = ov;
    }
    {
      const uint4 a = *(const uint4*)(OB + ((size_t)2 * TH + r) * 512 + c0), b = *(const uint4*)(OB + ((size_t)3 * TH + r) * 512 + c0);
      const uint4 z = *(const uint4*)(hrow + S_Z + c0);
      const unsigned au[4] = {a.x, a.y, a.z, a.w}, bu[4] = {b.x, b.y, b.z, b.w}, zu[4] = {z.x, z.y, z.z, z.w};
      float u[8];
#pragma unroll
      for (int j = 0; j < 8; ++j) u[j] = cb[c0 + j];
      const int t = r & (SEQ - 1);
#pragma unroll
      for (int jj = 0; jj < 5; ++jj) {
        const int s = t + jj - 2;
        if (s >= 0 && s < SEQ) {
          const uint4 xr = *(const uint4*)(Hh + (size_t)(r + jj - 2) * NPAD + S_X + c0);
          const unsigned xu[4] = {xr.x, xr.y, xr.z, xr.w};
#pragma unroll
          for (int j = 0; j < 8; ++j) {
            const float xv = bf2f((bf16_t)((j & 1) ? (xu[j >> 1] >> 16) : (xu[j >> 1] & 0xffff)));
            u[j] += cw[jj * 1024 + c0 + j] * xv;
          }
        }
      }
      const float dsk = p.ssd_d[l * 8 + (c0 >> 6)];
      float y[8]; float ss = 0.f;
#pragma unroll
      for (int j = 0; j < 8; ++j) {
        const float of = bf2f((bf16_t)((j & 1) ? (au[j >> 1] >> 16) : (au[j >> 1] & 0xffff)));
        const float ob = bf2f((bf16_t)((j & 1) ? (bu[j >> 1] >> 16) : (bu[j >> 1] & 0xffff)));
        const float zz = bf2f((bf16_t)((j & 1) ? (zu[j >> 1] >> 16) : (zu[j >> 1] & 0xffff)));
        y[j] = (of + ob + dsk * fsilu(u[j])) * fsilu(zz);
        ss += y[j] * y[j];
      }
#pragma unroll
      for (int of = 32; of >= 1; of >>= 1) ss += __shfl_xor(ss, of);
      const float rstd = rsqrtf(ss * (1.f / 512.f) + 1e-6f);
#pragma unroll
      for (int j = 0; j < 8; ++j) y[j] = y[j] * rstd * p.ssd_norm[l * 512 + c0 + j];
      uint4 ov; ov.x = pk2(y[0], y[1]); ov.y = pk2(y[2], y[3]); ov.z = pk2(y[4], y[5]); ov.w = pk2(y[6], y[7]);
      *(uint4*)(MX + (size_t)r * DI + 1024 + c0) = ov;
    }
  }
}


#define XB_TMO      128
#define XB_XCNT(j)  (256  + 64 * (j))
#define XB_XSUB(j)  (1280 + 64 * (j))
#define XB_XGEN(j)  (2304 + 64 * (j))
#define XB_TOP      3328
#define XB_TOPGEN   3392
#define XB_SPIN_CAP (1u << 22)
#define LAS __attribute__((address_space(3)))
DEV unsigned xb_ld(unsigned* p) { return __hip_atomic_load(p, __ATOMIC_RELAXED, __HIP_MEMORY_SCOPE_AGENT); }
DEV unsigned xb_add(unsigned* p, unsigned v) { return __hip_atomic_fetch_add(p, v, __ATOMIC_RELAXED, __HIP_MEMORY_SCOPE_AGENT); }
DEV unsigned xb_xcc_id() { return (unsigned)__builtin_amdgcn_s_getreg((3 << 11) | 20) & 0xFu; }
#define XB_SPIN(cond, bar) do { unsigned _sp = 0; while (cond) { __builtin_amdgcn_s_sleep(1); \
    if ((++_sp & 255u) == 0u) { if (xb_ld(&(bar)[XB_TMO])) break; if (_sp > XB_SPIN_CAP) { atomicAdd(&(bar)[XB_TMO], 1u); break; } } } } while (0)
struct XcdBarrier { unsigned* bar; unsigned x; volatile LAS unsigned* st; };
DEV XcdBarrier xcd_barrier_post(unsigned* bar, volatile LAS unsigned* st) {
  XcdBarrier b; b.bar = bar; b.x = xb_xcc_id(); b.st = st;
  if (threadIdx.x == 0) (void)xb_add(&bar[XB_XCNT(b.x)], 1u);
  return b;
}
DEV void xcd_barrier_complete(unsigned* bar, unsigned x, unsigned& nloc, unsigned& nx) {
  const unsigned G = gridDim.x * gridDim.y * gridDim.z;
  unsigned sum, cnt, mine, sp = 0u;
  for (;;) {
    sum = 0u; cnt = 0u; mine = 0u;
#pragma unroll
    for (unsigned j = 0; j < 16; ++j) { const unsigned c = xb_ld(&bar[XB_XCNT(j)]); sum += c; cnt += (c > 0u) ? 1u : 0u; mine = (j == x) ? c : mine; }
    if (sum == G) break;
    __builtin_amdgcn_s_sleep(1);
    if ((++sp & 255u) == 0u) { if (xb_ld(&bar[XB_TMO])) break; if (sp > XB_SPIN_CAP) { atomicAdd(&bar[XB_TMO], 1u); break; } }
  }
  nloc = mine > 0u ? mine : 1u; nx = cnt > 0u ? cnt : 1u;
}
DEV void xcd_barrier(const XcdBarrier& b) {
  asm volatile("s_waitcnt vmcnt(0)" ::: "memory");
  __syncthreads();
  if (threadIdx.x == 0) {
    unsigned* bar = b.bar;
    __builtin_amdgcn_s_waitcnt(0);
    unsigned nloc = b.st[0], nx = b.st[1];
    if (nloc == 0u) { xcd_barrier_complete(bar, b.x, nloc, nx); b.st[0] = nloc; b.st[1] = nx; }
    const unsigned old = xb_add(&bar[XB_XSUB(b.x)], 1u);
    const unsigned gen = old / nloc;
    if (old + 1u == (gen + 1u) * nloc) {
      __builtin_amdgcn_fence(__ATOMIC_RELEASE, "agent");
      asm volatile("s_waitcnt vmcnt(0)" ::: "memory");
      const unsigned og = xb_add(&bar[XB_TOP], 1u);
      const unsigned tg = og / nx;
      if (og + 1u == (tg + 1u) * nx) xb_add(&bar[XB_TOPGEN], 1u);
      else XB_SPIN(xb_ld(&bar[XB_TOPGEN]) == tg, bar);
      __builtin_amdgcn_fence(__ATOMIC_ACQUIRE, "agent");
      xb_add(&bar[XB_XGEN(b.x)], 1u);
      asm volatile("s_waitcnt vmcnt(0)" ::: "memory");
    } else {
      XB_SPIN(xb_ld(&bar[XB_XGEN(b.x)]) == gen, bar);
      __builtin_amdgcn_fence(__ATOMIC_ACQUIRE, "agent");
      asm volatile("s_waitcnt vmcnt(0)" ::: "memory");
    }
  }
  __syncthreads();
}

#ifndef PROBE_ST
#define PROBE_ST -1
#endif
#ifndef PROBE_REP
#define PROBE_REP 0
#endif
#ifndef PROBE_LO
#define PROBE_LO 0
#endif
#ifndef PROBE_HI
#define PROBE_HI 100000
#endif
DEV void run_phase(const Params& p, int ph, int rep, unsigned char* smem) {
  if (ph == 0) { if (PH_MASK & 1) phase_pro(p, smem); }
  else {
    const int q = ph - 1, l = q / 14, hf = (q / 7) & 1, st = q % 7;
    if (st == 0) { if (PH_MASK & 2) phase_inproj(p, l, hf, smem); }
    else if (st == 1) { if (PH_MASK & 0xF00) phase_mix(p, l, hf, ph + 32 * rep, 1, 0, ATT_SPLIT, rep ? PROBE_LO : 0, rep ? PROBE_HI : 100000, smem); }
    else if (st == 2) { if (PH_MASK & 0x700) phase_scan2(p); }
    else if (st == 3) { if (PH_MASK & 0xF00) phase_mix(p, l, hf, ph + 32 * rep, 3, ATT_SPLIT, 256, rep ? PROBE_LO : 0, rep ? PROBE_HI : 100000, smem); }
    else if (st == 4) { if (PH_MASK & 8) phase_fin(p, l, hf); }
    else if (st == 5) { if (PH_MASK & 16) phase_outproj(p, l, hf, smem); }
    else {
      if (PH_MASK & 32) phase_ln(p, l, hf);
      if ((PH_MASK & 1) && l == 0 && hf == 1) convert_weights(p, 1, smem);
    }
  }
}
__global__ void __launch_bounds__(NT) mega(Params p) {
  extern __shared__ __attribute__((aligned(16))) unsigned char smem[];
#if ONE_LAUNCH
  volatile LAS unsigned* xst = (volatile LAS unsigned*)(smem + LDS_BYTES - 32);
  if (threadIdx.x == 0) { xst[0] = 0u; xst[1] = 0u; }
  __syncthreads();
  XcdBarrier xb = xcd_barrier_post((unsigned*)(p.ws + OFF_CTRL), xst);
#endif
  for (int ph = p.phase_begin; ph < p.phase_end; ++ph) {
    int nrep = 0;
#if PROBE_REP > 0
    {
      const int q = ph - 1, l = q / 14, st = q % 7;
      const bool idem = (ph == 0) ? (PROBE_ST == 9) : (st == PROBE_ST && (st != 5 || l == 0));
      if (idem) nrep = PROBE_REP;
    }
#endif
    for (int r = 0; r <= nrep; ++r) {
      run_phase(p, ph, r, smem);
#if ONE_LAUNCH
      if (r < nrep || ph + 1 < p.phase_end) xcd_barrier(xb);
#endif
    }
  }
}

extern "C" void kernel_launch(void* const* d_in, const int* in_sizes, int n_in, void* d_out, int out_size, void* d_ws, size_t ws_size,
                              hipStream_t stream) {
  static int grid_blocks = 0;
  if (!grid_blocks) {
    int dev = 0, cus = 0, per_cu = 0;
    hipGetDevice(&dev);
    hipDeviceGetAttribute(&cus, hipDeviceAttributeMultiprocessorCount, dev);
    hipFuncSetAttribute((const void*)mega, hipFuncAttributeMaxDynamicSharedMemorySize, LDS_BYTES);
    hipOccupancyMaxActiveBlocksPerMultiprocessor(&per_cu, mega, NT, LDS_BYTES);
    if (per_cu < 1) per_cu = 1;
    grid_blocks = cus;
  }
  Params p{};
  p.x = (const float*)d_in[0]; p.w_in = (const float*)d_in[1]; p.q_gain = (const float*)d_in[2]; p.k_gain = (const float*)d_in[3];
  p.lb_logits = (const float*)d_in[4]; p.hgrn_norm = (const float*)d_in[5]; p.conv_w = (const float*)d_in[6]; p.conv_b = (const float*)d_in[7];
  p.dt_bias = (const float*)d_in[8]; p.a_log = (const float*)d_in[9]; p.ssd_d = (const float*)d_in[10]; p.ssd_norm = (const float*)d_in[11];
  p.gk_w2 = (const float*)d_in[12]; p.gk_b = (const float*)d_in[13]; p.gla_norm = (const float*)d_in[14]; p.w_out = (const float*)d_in[15];
  p.ln_g = (const float*)d_in[16]; p.ln_b = (const float*)d_in[17];
  p.out = (float*)d_out; p.ws = (unsigned char*)d_ws;
  hipMemsetAsync(d_ws, 0, CTRL_BYTES, stream);
#if ONE_LAUNCH
  p.phase_begin = 0; p.phase_end = NPHASE;
  void* args[] = {&p};
  (void)args;
  hipLaunchKernelGGL(mega, dim3(grid_blocks), dim3(NT), LDS_BYTES, stream, p);
#else
  for (int ph = 0; ph < NPHASE; ++ph) {
    p.phase_begin = ph; p.phase_end = ph + 1;
    hipLaunchKernelGGL(mega, dim3(grid_blocks), dim3(NT), LDS_BYTES, stream, p);
  }
#endif
}
```

```cpp
#include <hip/hip_runtime.h>
#include <hip/hip_cooperative_groups.h>
#include <stdint.h>
#include <stdio.h>
namespace cg = cooperative_groups;

#ifndef ONE_LAUNCH
#define ONE_LAUNCH 1
#endif

#ifndef PH_MASK
#define PH_MASK 0xFFF
#endif
#define DEV __device__ __forceinline__
typedef unsigned short bf16_t;
typedef short bf16x8 __attribute__((ext_vector_type(8)));
typedef float f32x16 __attribute__((ext_vector_type(16)));
typedef unsigned u32x4 __attribute__((ext_vector_type(4)));

constexpr int NT = 512;
constexpr int T_ALL = 16384, TH = 8192, SEQ = 4096, DM = 1024, NPAD = 7168, DI = 2048, NIN = 6960;
constexpr int A_Q = 0, A_K = 512, A_V = 640, A_Z = 768, H_Q = 1280, H_FF = 1792, H_FB = 2304, H_I = 2816, H_Z = 3328,
              S_X = 3840, S_Z = 4864, G_Q = 5376, G_K = 5632, G_V = 5888, G_Z = 6400, SM0 = 6912;
constexpr size_t OFF_CTRL = 0, OFF_TAB = 65536, OFF_XB = 131072;
constexpr size_t OFF_WIN = OFF_XB + (size_t)T_ALL * DM * 2;
constexpr size_t OFF_WOUT = OFF_WIN + (size_t)NPAD * DM * 2;
constexpr size_t OFF_H = OFF_WOUT + (size_t)DM * DI * 2;
constexpr size_t OFF_SMALL = OFF_H + (size_t)TH * NPAD * 2;
constexpr size_t OFF_OBUF = OFF_SMALL + (size_t)TH * 48 * 4;
constexpr size_t OFF_VT = OFF_OBUF + (size_t)6 * TH * 512 * 2;
constexpr size_t OFF_DB = OFF_VT + (size_t)2 * 2 * 64 * SEQ * 2;
constexpr int NSEG = 8, SLEN = 64 / NSEG;
constexpr size_t OFF_MIXED = OFF_DB + (size_t)64 * NSEG * 128 * 4;
constexpr size_t OFF_SB0 = OFF_MIXED, OFF_SB1 = OFF_SB0 + (size_t)16 * NSEG * 16384 * 4, OFF_SB2 = OFF_SB1 + (size_t)16 * NSEG * 8192 * 4;
constexpr size_t OFF_U = OFF_SB2 + (size_t)32 * NSEG * 8192 * 4;
constexpr size_t WS_END = OFF_U + (size_t)TH * 1024 * 2;
static_assert(OFF_MIXED + (size_t)TH * DI * 2 <= WS_END, "MIXED must fit");
static_assert(WS_END <= 268435456, "workspace");
constexpr size_t CTRL_BYTES = 65536;
constexpr int CTR_WORD0 = 4096;
constexpr int LDS_BYTES = 148480;
constexpr float LOG2E = 1.4426950408889634f;
constexpr float QSCALE = 0.125f * LOG2E;
constexpr float DN_ALPHA = 1.4142135623730951f;
constexpr int NPHASE = 33;
constexpr int ATT_SPLIT = 144;

struct Params {
  const float* x; const float* w_in; const float* q_gain; const float* k_gain; const float* lb_logits; const float* hgrn_norm;
  const float* conv_w; const float* conv_b; const float* dt_bias; const float* a_log; const float* ssd_d; const float* ssd_norm;
  const float* gk_w2; const float* gk_b; const float* gla_norm; const float* w_out; const float* ln_g; const float* ln_b;
  float* out; unsigned char* ws;
  int phase_begin, phase_end;
};

DEV int launder(int v) { asm volatile("" : "+v"(v)); return v; }
DEV float bf2f(bf16_t v) { return __uint_as_float(((unsigned)v) << 16); }
DEV bf16_t f2bf(float f) { unsigned u = __float_as_uint(f); u += 0x7fffu + ((u >> 16) & 1u); return (bf16_t)(u >> 16); }
DEV unsigned pk2(float lo, float hi) { return (unsigned)f2bf(lo) | ((unsigned)f2bf(hi) << 16); }
DEV float fsigmoid(float x) { return 1.f / (1.f + __expf(-x)); }
DEV float fsilu(float x) { return x / (1.f + __expf(-x)); }
DEV unsigned cvtpk(float lo, float hi) { unsigned r; asm("v_cvt_pk_bf16_f32 %0, %1, %2" : "=v"(r) : "v"(lo), "v"(hi)); return r; }
DEV float ex2(float x) { return __builtin_amdgcn_exp2f(x); }
DEV float lg2(float x) { return __builtin_amdgcn_logf(x); }
DEV float frcp(float x) { return __builtin_amdgcn_rcpf(x); }
DEV float lo16(unsigned u) { return __uint_as_float(u << 16); }
DEV float hi16(unsigned u) { return __uint_as_float(u & 0xffff0000u); }
DEV int rowoff(int reg, int h) { return (reg & 3) + 8 * (reg >> 2) + 4 * h; }
DEV f32x16 zero16() { f32x16 z;
#pragma unroll
  for (int i = 0; i < 16; ++i) z[i] = 0.f; return z; }

template <int KD>
DEV void mma32(f32x16& acc, const bf16_t* a, int lda, const bf16_t* b, int ldb, int lane) {
  const int r = lane & 31, h = lane >> 5;
  const bf16_t* ap = a + r * lda + 8 * h;
  const bf16_t* bp = b + r * ldb + 8 * h;
#pragma unroll 4
  for (int k = 0; k < KD; k += 16) {
    bf16x8 av = *(const bf16x8*)(ap + k);
    bf16x8 bv = *(const bf16x8*)(bp + k);
    acc = __builtin_amdgcn_mfma_f32_32x32x16_bf16(av, bv, acc, 0, 0, 0);
  }
}

DEV int orig_col(int n) {
  if (n < 4864) return n;
  if (n < 6400) return n + 16;
  if (n < 6912) return n + 48;
  if (n < 6928) return n - 2048;
  if (n < 6960) return n - 512;
  return -1;
}

DEV void convert_weights(const Params& p, int l, unsigned char* smem) {
  float* s = (float*)smem;
  const int tid = launder(threadIdx.x);
  const float* win = p.w_in + (size_t)l * DM * NIN;
  const float* wout = p.w_out + (size_t)l * DI * DM;
  bf16_t* wint = (bf16_t*)(p.ws + OFF_WIN);
  bf16_t* woutt = (bf16_t*)(p.ws + OFF_WOUT);
  const int n_in_tiles = (NPAD / 64) * (DM / 64);
  const int n_out_tiles = (DM / 64) * (DI / 64);
  for (int it = blockIdx.x; it < n_in_tiles + n_out_tiles; it += gridDim.x) {
    __syncthreads();
    if (it < n_in_tiles) {
      const int n0 = (it / 16) * 64, k0 = (it % 16) * 64;
#pragma unroll
      for (int e = 0; e < 8; ++e) {
        const int idx = e * NT + tid, kk = idx >> 6, nn = idx & 63;
        const int oc = orig_col(n0 + nn);
        s[kk * 65 + nn] = (oc >= 0) ? win[(size_t)(k0 + kk) * NIN + oc] : 0.f;
      }
      __syncthreads();
      const int n = tid >> 3, kc = (tid & 7) * 8;
      uint4 o;
      o.x = pk2(s[(kc + 0) * 65 + n], s[(kc + 1) * 65 + n]); o.y = pk2(s[(kc + 2) * 65 + n], s[(kc + 3) * 65 + n]);
      o.z = pk2(s[(kc + 4) * 65 + n], s[(kc + 5) * 65 + n]); o.w = pk2(s[(kc + 6) * 65 + n], s[(kc + 7) * 65 + n]);
      *(uint4*)(wint + (size_t)(n0 + n) * DM + k0 + kc) = o;
    } else {
      const int j = it - n_in_tiles;
      const int n0 = (j / 32) * 64, k0 = (j % 32) * 64;
#pragma unroll
      for (int e = 0; e < 8; ++e) {
        const int idx = e * NT + tid, kk = idx >> 6, nn = idx & 63;
        s[kk * 65 + nn] = wout[(size_t)(k0 + kk) * DM + n0 + nn];
      }
      __syncthreads();
      const int n = tid >> 3, kc = (tid & 7) * 8;
      uint4 o;
      o.x = pk2(s[(kc + 0) * 65 + n], s[(kc + 1) * 65 + n]); o.y = pk2(s[(kc + 2) * 65 + n], s[(kc + 3) * 65 + n]);
      o.z = pk2(s[(kc + 4) * 65 + n], s[(kc + 5) * 65 + n]); o.w = pk2(s[(kc + 6) * 65 + n], s[(kc + 7) * 65 + n]);
      *(uint4*)(woutt + (size_t)(n0 + n) * DI + k0 + kc) = o;
    }
  }
  __syncthreads();
}

DEV void dsincos(double x, double& s, double& c) {
  const double k = rint(x * 0.63661977236758134308);
  double r = fma(-k, 1.57079632679489655800e+00, x);
  r = fma(-k, 6.12323399573676603587e-17, r);
  const double r2 = r * r;
  const double t3 = r2 * r, t5 = t3 * r2, t7 = t5 * r2, t9 = t7 * r2, t11 = t9 * r2, t13 = t11 * r2, t15 = t13 * r2;
  const double sinr = r - t3 / 6.0 + t5 / 120.0 - t7 / 5040.0 + t9 / 362880.0 - t11 / 39916800.0 + t13 / 6227020800.0 - t15 / 1307674368000.0;
  const double u2 = r2, u4 = u2 * u2, u6 = u4 * u2, u8 = u6 * u2, u10 = u8 * u2, u12 = u10 * u2, u14 = u12 * u2, u16 = u14 * u2;
  const double cosr = 1.0 - u2 / 2.0 + u4 / 24.0 - u6 / 720.0 + u8 / 40320.0 - u10 / 3628800.0 + u12 / 479001600.0 - u14 / 87178291200.0 + u16 / 20922789888000.0;
  const int q = ((int)k) & 3;
  if (q == 0) { s = sinr; c = cosr; }
  else if (q == 1) { s = cosr; c = -sinr; }
  else if (q == 2) { s = -sinr; c = -cosr; }
  else { s = -cosr; c = sinr; }
}

DEV void phase_pro(const Params& p, unsigned char* smem) {
  const int tid = launder(threadIdx.x);
  const size_t gtid = (size_t)blockIdx.x * NT + tid, gsz = (size_t)gridDim.x * NT;
  const float4* x4 = (const float4*)p.x;
  uint4* xb4 = (uint4*)(p.ws + OFF_XB);
  for (size_t i = gtid; i < (size_t)T_ALL * DM / 8; i += gsz) {
    const float4 a = x4[2 * i], b = x4[2 * i + 1];
    uint4 o; o.x = pk2(a.x, a.y); o.y = pk2(a.z, a.w); o.z = pk2(b.x, b.y); o.w = pk2(b.z, b.w);
    xb4[i] = o;
  }
  if (blockIdx.x == 0) {
    float2* tab = (float2*)(p.ws + OFF_TAB);
    for (int i = tid; i < 64 * 16; i += NT) {
      const int pos = i >> 4, fi = i & 15;
      const float invf = (float)exp(-(double)fi * (9.210340371976184 / 16.0));
      const float ang = (float)pos * invf;
      double s, c; dsincos((double)ang, s, c);
      tab[i] = make_float2((float)c, (float)s);
    }
  }
  convert_weights(p, 0, smem);
}

struct GStage { u32x4 a0, a1, b0, b1, b2, b3; };
DEV void gemm_block(const bf16_t* __restrict__ A, int lda, const bf16_t* __restrict__ A2, int lda2, int ksplit, const bf16_t* __restrict__ Bt, int ldb, int nk, unsigned char* smem, f32x16 (&acc)[2][2]) {
  const int tid = launder(threadIdx.x), lane = tid & 63, w = tid >> 6, wr = w >> 2, wc = w & 3, r = lane & 31, h = lane >> 5;
  const int ar = tid >> 2, ac = (tid & 3) * 16;
  const int br = tid >> 1, bc = (tid & 1) * 32;
  const bf16_t* ag = A + (size_t)ar * lda + ac;
  const bf16_t* ag2 = A2 + (size_t)ar * lda2 + ac;
  const bf16_t* bg = Bt + (size_t)br * ldb + bc;
#pragma unroll
  for (int i = 0; i < 2; ++i)
#pragma unroll
    for (int j = 0; j < 2; ++j) acc[i][j] = zero16();
  auto gload = [&](GStage& g, int kt) __attribute__((always_inline)) {
    const u32x4* pa = (const u32x4*)((kt < ksplit) ? (ag + kt * 64) : (ag2 + (kt - ksplit) * 64)); g.a0 = pa[0]; g.a1 = pa[1];
    const u32x4* pb = (const u32x4*)(bg + kt * 64); g.b0 = pb[0]; g.b1 = pb[1]; g.b2 = pb[2]; g.b3 = pb[3];
  };
  auto sstore = [&](const GStage& g, int st) __attribute__((always_inline)) {
    unsigned char* base = smem + st * 55296;
    u32x4* sa = (u32x4*)(base + ar * 144 + ac * 2); sa[0] = g.a0; sa[1] = g.a1;
    u32x4* sb = (u32x4*)(base + 18432 + br * 144 + bc * 2); sb[0] = g.b0; sb[1] = g.b1; sb[2] = g.b2; sb[3] = g.b3;
  };
  auto compute = [&](int st) __attribute__((always_inline)) {
    const bf16_t* sa = (const bf16_t*)(smem + st * 55296);
    const bf16_t* sb = (const bf16_t*)(smem + st * 55296 + 18432);
#pragma unroll
    for (int ks = 0; ks < 4; ++ks) {
      const bf16x8 a0 = *(const bf16x8*)(sa + (wr * 64 + r) * 72 + ks * 16 + 8 * h);
      const bf16x8 a1 = *(const bf16x8*)(sa + (wr * 64 + 32 + r) * 72 + ks * 16 + 8 * h);
      const bf16x8 b0 = *(const bf16x8*)(sb + (wc * 64 + r) * 72 + ks * 16 + 8 * h);
      const bf16x8 b1 = *(const bf16x8*)(sb + (wc * 64 + 32 + r) * 72 + ks * 16 + 8 * h);
      acc[0][0] = __builtin_amdgcn_mfma_f32_32x32x16_bf16(a0, b0, acc[0][0], 0, 0, 0);
      acc[0][1] = __builtin_amdgcn_mfma_f32_32x32x16_bf16(a0, b1, acc[0][1], 0, 0, 0);
      acc[1][0] = __builtin_amdgcn_mfma_f32_32x32x16_bf16(a1, b0, acc[1][0], 0, 0, 0);
      acc[1][1] = __builtin_amdgcn_mfma_f32_32x32x16_bf16(a1, b1, acc[1][1], 0, 0, 0);
    }
  };
  GStage G0, G1;
  gload(G0, 0); gload(G1, 1);
  sstore(G0, 0); gload(G0, 2);
  __syncthreads();
  for (int kt = 0; kt < nk; kt += 2) {
    sstore(G1, 1);
    if (kt + 3 < nk) gload(G1, kt + 3);
    compute(0);
    __syncthreads();
    if (kt + 2 < nk) { sstore(G0, 0); if (kt + 4 < nk) gload(G0, kt + 4); }
    compute(1);
    __syncthreads();
  }
}

DEV void phase_inproj(const Params& p, int l, int hf, unsigned char* smem) {
  const int tid = launder(threadIdx.x), lane = tid & 63, w = tid >> 6, wr = w >> 2, wc = w & 3, c = lane & 31, h = lane >> 5;
  const bf16_t* A = (const bf16_t*)(p.ws + OFF_XB) + (size_t)hf * TH * DM;
  const bf16_t* Bt = (const bf16_t*)(p.ws + OFF_WIN);
  bf16_t* Hh = (bf16_t*)(p.ws + OFF_H);
  float* SMALL = (float*)(p.ws + OFF_SMALL);
  bf16_t* VT = (bf16_t*)(p.ws + OFF_VT);
  const float2* tab = (const float2*)(p.ws + OFF_TAB);
  const int n_items = (TH / 128) * (NPAD / 256);
  for (int it = blockIdx.x; it < n_items; it += gridDim.x) {
    const int pn = it % 28, pm = it / 28;
    f32x16 acc[2][2];
    gemm_block(A + (size_t)pm * 128 * DM, DM, A, DM, DM / 64, Bt + (size_t)pn * 256 * DM, DM, DM / 64, smem, acc);
    const int colbase = pn * 256 + wc * 64;
    const int rowb = pm * 128 + wr * 64;
    if (colbase == SM0) {
#pragma unroll
      for (int mi = 0; mi < 2; ++mi)
#pragma unroll
        for (int reg = 0; reg < 16; ++reg) {
          const int row = rowb + mi * 32 + rowoff(reg, h);
          SMALL[(size_t)row * 48 + c] = acc[mi][0][reg];
          if (c < 16) SMALL[(size_t)row * 48 + 32 + c] = acc[mi][1][reg];
        }
    } else if (colbase < SM0) {
      if (colbase < A_V) {
        const bool isq = colbase < A_K;
        const float* gain = (isq ? p.q_gain : p.k_gain) + l * 64;
        const float g0 = gain[c], g1 = gain[32 + c];
        const float osc = isq ? QSCALE : 1.f;
#pragma unroll
        for (int mi = 0; mi < 2; ++mi)
#pragma unroll
          for (int reg = 0; reg < 16; ++reg) {
            float ss = acc[mi][0][reg] * acc[mi][0][reg] + acc[mi][1][reg] * acc[mi][1][reg];
            ss += __shfl_xor(ss, 1); ss += __shfl_xor(ss, 2); ss += __shfl_xor(ss, 4); ss += __shfl_xor(ss, 8); ss += __shfl_xor(ss, 16);
            const float rstd = rsqrtf(ss * (1.f / 64.f) + 1e-6f);
            const int row = rowb + mi * 32 + rowoff(reg, h);
            const int t = row & (SEQ - 1);
            const float2 cs0 = tab[(t >> 6) * 16 + (c & 15)], cs1 = tab[(t & 63) * 16 + (c & 15)];
            const float v0 = acc[mi][0][reg] * rstd * g0, v1 = acc[mi][1][reg] * rstd * g1;
            const float p0 = __shfl_xor(v0, 16), p1 = __shfl_xor(v1, 16);
            const float o0 = (c & 16) ? (v0 * cs0.x + p0 * cs0.y) : (v0 * cs0.x - p0 * cs0.y);
            const float o1 = (c & 16) ? (v1 * cs1.x + p1 * cs1.y) : (v1 * cs1.x - p1 * cs1.y);
            acc[mi][0][reg] = o0 * osc; acc[mi][1][reg] = o1 * osc;
          }
      }
      if (colbase >= A_V && colbase < A_Z) {
        const int kvh = (colbase - A_V) >> 6;
#pragma unroll
        for (int mi = 0; mi < 2; ++mi)
#pragma unroll
          for (int ni = 0; ni < 2; ++ni)
#pragma unroll
            for (int g = 0; g < 4; ++g) {
              const int row = rowb + mi * 32 + 8 * g + 4 * h;
              const int bl = row >> 12, t = row & (SEQ - 1);
              const int d = ni * 32 + c;
              uint2 o; o.x = pk2(acc[mi][ni][4 * g + 0], acc[mi][ni][4 * g + 1]); o.y = pk2(acc[mi][ni][4 * g + 2], acc[mi][ni][4 * g + 3]);
              *(uint2*)(VT + ((size_t)((bl * 2 + kvh) * 64 + d)) * SEQ + t) = o;
            }
      } else {
        bf16_t* so = (bf16_t*)(smem + w * 9216);
#pragma unroll
        for (int mi = 0; mi < 2; ++mi)
#pragma unroll
          for (int ni = 0; ni < 2; ++ni)
#pragma unroll
            for (int reg = 0; reg < 16; ++reg)
              so[(mi * 32 + rowoff(reg, h)) * 72 + ni * 32 + c] = f2bf(acc[mi][ni][reg]);
        __builtin_amdgcn_s_waitcnt(0xc07f);
        __builtin_amdgcn_wave_barrier();
#pragma unroll
        for (int i = 0; i < 8; ++i) {
          const int rr = i * 8 + (lane >> 3), ch = lane & 7;
          const uint4 v = *(const uint4*)(so + rr * 72 + ch * 8);
          *(uint4*)(Hh + (size_t)(rowb + rr) * NPAD + colbase + ch * 8) = v;
        }
      }
    }
    __syncthreads();
  }
}

DEV void phase_outproj(const Params& p, int l, int hf, unsigned char* smem) {
  const int tid = launder(threadIdx.x), lane = tid & 63, w = tid >> 6, wr = w >> 2, wc = w & 3, c = lane & 31, h = lane >> 5;
  const bf16_t* A = (const bf16_t*)(p.ws + OFF_MIXED);
  const bf16_t* Hat = (const bf16_t*)(p.ws + OFF_H) + A_Q;
  const bf16_t* Bt = (const bf16_t*)(p.ws + OFF_WOUT);
  const float* xin = (l == 0) ? p.x : p.out;
  const int n_items = (TH / 128) * (DM / 256);
  for (int it = blockIdx.x; it < n_items; it += gridDim.x) {
    const int pn = it & 3, pm = it >> 2;
    f32x16 acc[2][2];
    gemm_block(Hat + (size_t)pm * 128 * NPAD, NPAD, A + (size_t)pm * 128 * DI + 512, DI, 8, Bt + (size_t)pn * 256 * DI, DI, DI / 64, smem, acc);
#pragma unroll
    for (int mi = 0; mi < 2; ++mi)
#pragma unroll
      for (int ni = 0; ni < 2; ++ni)
#pragma unroll
        for (int reg = 0; reg < 16; ++reg) {
          const int row = hf * TH + pm * 128 + wr * 64 + mi * 32 + rowoff(reg, h);
          const int col = pn * 256 + wc * 64 + ni * 32 + c;
          const size_t idx = (size_t)row * DM + col;
          p.out[idx] = DN_ALPHA * xin[idx] + acc[mi][ni][reg];
        }
    __syncthreads();
  }
}

DEV void phase_ln(const Params& p, int l, int hf) {
  const int tid = launder(threadIdx.x), lane = tid & 63, w = tid >> 6;
  const float* g = p.ln_g + l * DM; const float* b = p.ln_b + l * DM;
  bf16_t* xb = (bf16_t*)(p.ws + OFF_XB);
  for (int r = blockIdx.x * 8 + w; r < TH; r += gridDim.x * 8) {
    const int row = hf * TH + r;
    float4* rp = (float4*)(p.out + (size_t)row * DM);
    float4 v[4];
    float s = 0.f;
#pragma unroll
    for (int j = 0; j < 4; ++j) { v[j] = rp[j * 64 + lane]; s += (v[j].x + v[j].y) + (v[j].z + v[j].w); }
#pragma unroll
    for (int o = 32; o >= 1; o >>= 1) s += __shfl_xor(s, o);
    const float mu = s * (1.f / DM);
    float q = 0.f;
#pragma unroll
    for (int j = 0; j < 4; ++j) { const float a = v[j].x - mu, bb = v[j].y - mu, cc = v[j].z - mu, d = v[j].w - mu; q += (a * a + bb * bb) + (cc * cc + d * d); }
#pragma unroll
    for (int o = 32; o >= 1; o >>= 1) q += __shfl_xor(q, o);
    const float rstd = rsqrtf(q * (1.f / DM) + 1e-5f);
#pragma unroll
    for (int j = 0; j < 4; ++j) {
      const int col = (j * 64 + lane) * 4;
      const float4 gg = *(const float4*)(g + col), bb = *(const float4*)(b + col);
      float4 o;
      o.x = (v[j].x - mu) * rstd * gg.x + bb.x; o.y = (v[j].y - mu) * rstd * gg.y + bb.y;
      o.z = (v[j].z - mu) * rstd * gg.z + bb.z; o.w = (v[j].w - mu) * rstd * gg.w + bb.w;
      rp[j * 64 + lane] = o;
      if (l == 0) { uint2 pk; pk.x = pk2(o.x, o.y); pk.y = pk2(o.z, o.w); *(uint2*)(xb + (size_t)row * DM + col) = pk; }
    }
  }
}

DEV void attn_item(const Params& p, int l, int item, unsigned char* smem) {
  const int tid = launder(threadIdx.x), lane = tid & 63, w = tid >> 6, r = lane & 31, h = lane >> 5;
  const int qt = item & 15, head = (item >> 4) & 7, bl = item >> 7;
  const int kvh = head >> 2;
  bf16_t* Hh = (bf16_t*)(p.ws + OFF_H);
  const bf16_t* VT = (const bf16_t*)(p.ws + OFF_VT);
  const size_t rowbase = (size_t)bl * SEQ;
  float mq = fabsf(p.q_gain[l * 64 + lane]), mk = fabsf(p.k_gain[l * 64 + lane]);
#pragma unroll
  for (int o = 32; o >= 1; o >>= 1) { mq = fmaxf(mq, __shfl_xor(mq, o)); mk = fmaxf(mk, __shfl_xor(mk, o)); }
  const float M2 = 8.f * mq * mk * LOG2E * 1.01f;
  const int qrow = qt * 256 + w * 32 + r;
  const bf16_t* qp = Hh + (rowbase + qrow) * NPAD + A_Q + head * 64 + 8 * h;
  bf16x8 qf[4];
#pragma unroll
  for (int ks = 0; ks < 4; ++ks) qf[ks] = *(const bf16x8*)(qp + ks * 16);
  f32x16 o0 = zero16(), o1 = zero16();
  float lsum = 0.f;
  const int srow = tid >> 3, sch = (tid & 7) * 8;
  const bf16_t* kp = Hh + (rowbase + srow) * NPAD + A_K + kvh * 64 + sch;
  const bf16_t* vp = VT + ((size_t)((bl * 2 + kvh) * 64 + srow)) * SEQ + sch;
  auto compute = [&](int st) __attribute__((always_inline)) {
    const bf16_t* sK = (const bf16_t*)(smem + st * 18432);
    const bf16_t* sV = (const bf16_t*)(smem + st * 18432 + 9216);
    f32x16 s0 = zero16(), s1 = zero16();
#pragma unroll
    for (int ks = 0; ks < 4; ++ks) {
      const bf16x8 a0 = *(const bf16x8*)(sK + r * 72 + ks * 16 + 8 * h);
      const bf16x8 a1 = *(const bf16x8*)(sK + (32 + r) * 72 + ks * 16 + 8 * h);
      s0 = __builtin_amdgcn_mfma_f32_32x32x16_bf16(a0, qf[ks], s0, 0, 0, 0);
      s1 = __builtin_amdgcn_mfma_f32_32x32x16_bf16(a1, qf[ks], s1, 0, 0, 0);
    }
#pragma unroll
    for (int i = 0; i < 16; ++i) { s0[i] = __builtin_amdgcn_exp2f(s0[i] - M2); s1[i] = __builtin_amdgcn_exp2f(s1[i] - M2); lsum += s0[i] + s1[i]; }
    union { bf16x8 v; unsigned u[4]; } pb[2][2];
#pragma unroll
    for (int s = 0; s < 2; ++s)
#pragma unroll
      for (int j = 0; j < 4; ++j) {
        pb[0][s].u[j] = pk2(s0[8 * s + 2 * j], s0[8 * s + 2 * j + 1]);
        pb[1][s].u[j] = pk2(s1[8 * s + 2 * j], s1[8 * s + 2 * j + 1]);
      }
#pragma unroll
    for (int kt2 = 0; kt2 < 2; ++kt2)
#pragma unroll
      for (int s = 0; s < 2; ++s) {
        const int kb = kt2 * 32 + 16 * s + 4 * h;
        union { bf16x8 v; uint2 u[2]; } a0, a1;
        a0.u[0] = *(const uint2*)(sV + r * 72 + kb); a0.u[1] = *(const uint2*)(sV + r * 72 + kb + 8);
        a1.u[0] = *(const uint2*)(sV + (32 + r) * 72 + kb); a1.u[1] = *(const uint2*)(sV + (32 + r) * 72 + kb + 8);
        o0 = __builtin_amdgcn_mfma_f32_32x32x16_bf16(a0.v, pb[kt2][s].v, o0, 0, 0, 0);
        o1 = __builtin_amdgcn_mfma_f32_32x32x16_bf16(a1.v, pb[kt2][s].v, o1, 0, 0, 0);
      }
  };
  constexpr int NKT = SEQ / 64;
  u32x4 k0 = *(const u32x4*)kp, v0 = *(const u32x4*)vp;
  u32x4 k1 = *(const u32x4*)(kp + (size_t)64 * NPAD), v1 = *(const u32x4*)(vp + 64);
  *(u32x4*)(smem + srow * 144 + sch * 2) = k0;
  *(u32x4*)(smem + 9216 + srow * 144 + sch * 2) = v0;
  k0 = *(const u32x4*)(kp + (size_t)2 * 64 * NPAD); v0 = *(const u32x4*)(vp + 2 * 64);
  __syncthreads();
  for (int kt = 0; kt < NKT; kt += 2) {
    *(u32x4*)(smem + 18432 + srow * 144 + sch * 2) = k1;
    *(u32x4*)(smem + 18432 + 9216 + srow * 144 + sch * 2) = v1;
    if (kt + 3 < NKT) { k1 = *(const u32x4*)(kp + (size_t)(kt + 3) * 64 * NPAD); v1 = *(const u32x4*)(vp + (kt + 3) * 64); }
    compute(0);
    __syncthreads();
    if (kt + 2 < NKT) {
      *(u32x4*)(smem + srow * 144 + sch * 2) = k0;
      *(u32x4*)(smem + 9216 + srow * 144 + sch * 2) = v0;
      if (kt + 4 < NKT) { k0 = *(const u32x4*)(kp + (size_t)(kt + 4) * 64 * NPAD); v0 = *(const u32x4*)(vp + (kt + 4) * 64); }
    }
    compute(1);
    __syncthreads();
  }
  lsum += __shfl_xor(lsum, 32);
  const float inv = 1.f / lsum;
  const bf16_t* zp = Hh + (rowbase + qrow) * NPAD + A_Z + head * 64;
  bf16_t* op = Hh + (rowbase + qrow) * NPAD + A_Q + head * 64;
#pragma unroll
  for (int dt = 0; dt < 2; ++dt)
#pragma unroll
    for (int g = 0; g < 4; ++g) {
      const int d0 = dt * 32 + 8 * g + 4 * h;
      const uint2 zz = *(const uint2*)(zp + d0);
      const float z0 = bf2f((bf16_t)(zz.x & 0xffff)), z1 = bf2f((bf16_t)(zz.x >> 16)), z2 = bf2f((bf16_t)(zz.y & 0xffff)), z3 = bf2f((bf16_t)(zz.y >> 16));
      const f32x16& oo = dt ? o1 : o0;
      uint2 ov;
      ov.x = pk2(oo[4 * g + 0] * inv * fsilu(z0), oo[4 * g + 1] * inv * fsilu(z1));
      ov.y = pk2(oo[4 * g + 2] * inv * fsilu(z2), oo[4 * g + 3] * inv * fsilu(z3));
      *(uint2*)(op + d0) = ov;
    }
  __syncthreads();
}

constexpr int L_QT = 0, L_KT = 17408, L_QC = 34816, L_KHT = 52224, L_VT = 70656, L_P = 89088, L_ST = 98304, L_RAW = 89088,
              L_D = 138240, L_TOT = 138752, L_ACS = 142848, L_DT = 143104, L_LOW = 143360;

template <int K, int V> struct ScanGeom {
  static constexpr int KP = K + 8;
  static constexpr int NS = (K / 32) * (V / 32) / 8;
};

template <int K, int V>
DEV void scan_write_state(unsigned char* smem, const f32x16* S, int w, int lane) {
  constexpr int KP = K + 8, NS = ScanGeom<K, V>::NS, NVT = V / 32;
  bf16_t* sST = (bf16_t*)(smem + L_ST);
  const int c = lane & 31, h = lane >> 5;
#pragma unroll
  for (int i = 0; i < NS; ++i) {
    const int tile = w * NS + i, kt = tile / NVT, nt = tile % NVT;
#pragma unroll
    for (int g = 0; g < 4; ++g) {
      uint2 o; o.x = pk2(S[i][4 * g + 0], S[i][4 * g + 1]); o.y = pk2(S[i][4 * g + 2], S[i][4 * g + 3]);
      *(uint2*)(sST + (nt * 32 + c) * KP + kt * 32 + 8 * g + 4 * h) = o;
    }
  }
}

template <int K, int V, bool SSDM>
DEV void scan_core(unsigned char* smem, f32x16* S, bf16_t* orow0, int dir, int w, int lane, bool do_out) {
  constexpr int KP = K + 8, NS = ScanGeom<K, V>::NS, NVT = V / 32, NOT = 2 * NVT;
  const bf16_t* sQt = (const bf16_t*)(smem + L_QT); const bf16_t* sKt = (const bf16_t*)(smem + L_KT);
  const bf16_t* sQc = (const bf16_t*)(smem + L_QC); const bf16_t* sKhT = (const bf16_t*)(smem + L_KHT);
  const bf16_t* sVT = (const bf16_t*)(smem + L_VT); bf16_t* sP = (bf16_t*)(smem + L_P);
  const bf16_t* sST = (const bf16_t*)(smem + L_ST); const float* sD = (const float*)(smem + L_D);
  const float* sAcs = (const float*)(smem + L_ACS);
  const int c = lane & 31, h = lane >> 5;
  if (do_out) scan_write_state<K, V>(smem, S, w, lane);
  if (do_out && w < 4) {
    const int tt = w >> 1, st = w & 1;
    f32x16 acc = zero16();
    if (st <= tt) mma32<K>(acc, sQt + tt * 32 * KP, KP, sKt + st * 32 * KP, KP, lane);
#pragma unroll
    for (int reg = 0; reg < 16; ++reg) {
      const int tau = tt * 32 + rowoff(reg, h), sig = st * 32 + c;
      float v = 0.f;
      if (sig <= tau) { v = acc[reg]; if (SSDM) v *= ex2(sAcs[tau] - sAcs[sig]); }
      sP[tau * 72 + sig] = f2bf(v);
    }
  }
  __syncthreads();
  if (do_out && w < NOT) {
    const int tt = w / NVT, nt = w % NVT;
    f32x16 acc = zero16();
    mma32<64>(acc, sP + tt * 32 * 72, 72, sVT + nt * 32 * 72, 72, lane);
    mma32<K>(acc, sQc + tt * 32 * KP, KP, sST + nt * 32 * KP, KP, lane);
#pragma unroll
    for (int reg = 0; reg < 16; ++reg) {
      const int tau = tt * 32 + rowoff(reg, h);
      const int tok = dir ? (63 - tau) : tau;
      orow0[(size_t)tok * 512 + nt * 32 + c] = f2bf(acc[reg]);
    }
  }
#pragma unroll
  for (int i = 0; i < NS; ++i) {
    const int tile = w * NS + i, kt = tile / NVT, nt = tile % NVT;
#pragma unroll
    for (int reg = 0; reg < 16; ++reg) S[i][reg] *= sD[kt * 32 + rowoff(reg, h)];
    mma32<64>(S[i], sKhT + kt * 32 * 72, 72, sVT + nt * 32 * 72, 72, lane);
  }
  __syncthreads();
}

template <int K, int V>
DEV void state_store(float* buf, const f32x16* S, int w, int lane) {
  constexpr int NS = ScanGeom<K, V>::NS, NVT = V / 32;
  const int c = lane & 31, h = lane >> 5;
#pragma unroll
  for (int i = 0; i < NS; ++i) {
    const int tile = w * NS + i, kt = tile / NVT, nt = tile % NVT;
#pragma unroll
    for (int reg = 0; reg < 16; ++reg) buf[(kt * 32 + rowoff(reg, h)) * V + nt * 32 + c] = S[i][reg];
  }
}
template <int K, int V>
DEV void state_load(const float* buf, f32x16* S, int w, int lane) {
  constexpr int NS = ScanGeom<K, V>::NS, NVT = V / 32;
  const int c = lane & 31, h = lane >> 5;
#pragma unroll
  for (int i = 0; i < NS; ++i) {
    const int tile = w * NS + i, kt = tile / NVT, nt = tile % NVT;
#pragma unroll
    for (int reg = 0; reg < 16; ++reg) S[i][reg] = buf[(kt * 32 + rowoff(reg, h)) * V + nt * 32 + c];
  }
}

DEV void store16(bf16_t* dst, const float* v) {
  uint4 a, b;
  a.x = pk2(v[0], v[1]); a.y = pk2(v[2], v[3]); a.z = pk2(v[4], v[5]); a.w = pk2(v[6], v[7]);
  b.x = pk2(v[8], v[9]); b.y = pk2(v[10], v[11]); b.z = pk2(v[12], v[13]); b.w = pk2(v[14], v[15]);
  ((uint4*)dst)[0] = a; ((uint4*)dst)[1] = b;
}
DEV void gather16(bf16_t* dst, const bf16_t* src, int stride) {
  unsigned u[8];
#pragma unroll
  for (int i = 0; i < 8; ++i) u[i] = (unsigned)src[(2 * i) * stride] | ((unsigned)src[(2 * i + 1) * stride] << 16);
  ((uint4*)dst)[0] = make_uint4(u[0], u[1], u[2], u[3]); ((uint4*)dst)[1] = make_uint4(u[4], u[5], u[6], u[7]);
}

DEV void hgrn_item(const Params& p, int l, int it, int seg, int mode, unsigned char* smem) {
  const int bl = it >> 3, head = (it >> 1) & 3, dir = it & 1;
  const bool do_out = (mode == 3);
  constexpr int K = 128, V = 128, KP = 136, KPW = 68;
  const int tid = launder(threadIdx.x), lane = tid & 63, w = tid >> 6;
  const int cp = tid & 63, tg = tid >> 6, ch0 = 2 * cp;
  const bf16_t* Hh = (const bf16_t*)(p.ws + OFF_H);
  bf16_t* OB = (bf16_t*)(p.ws + OFF_OBUF) + (size_t)(0 * 2 + dir) * TH * 512;
  const size_t rowbase = (size_t)bl * SEQ;
  float lb0 = 0.f, lb1 = 0.f;
  if (l > 0) {
    lb0 = fsigmoid(p.lb_logits[512 + head * 128 + ch0] - p.lb_logits[head * 128 + ch0]);
    lb1 = fsigmoid(p.lb_logits[512 + head * 128 + ch0 + 1] - p.lb_logits[head * 128 + ch0 + 1]);
  }
  const float om0 = 1.f - lb0, om1 = 1.f - lb1;
  const int fbase = dir ? H_FB : H_FF;
  unsigned* sQt = (unsigned*)(smem + L_QT); unsigned* sKt = (unsigned*)(smem + L_KT); unsigned* sQc = (unsigned*)(smem + L_QC);
  bf16_t* sKhT = (bf16_t*)(smem + L_KHT); bf16_t* sVT = (bf16_t*)(smem + L_VT);
  float* sD = (float*)(smem + L_D); float* sTot = (float*)(smem + L_TOT);
  const unsigned* rawQ = (const unsigned*)(smem + L_RAW); const unsigned* rawF = rawQ + 4096; const unsigned* rawV = rawQ + 8192;
  f32x16 S[2]; S[0] = zero16(); S[1] = zero16();
  float* sbuf = (float*)(p.ws + OFF_SB0) + ((size_t)it * NSEG + seg) * 16384;
  if (do_out) state_load<K, V>(sbuf, S, w, lane);
  float dlog0 = 0.f, dlog1 = 0.f;
  u32x4 pre[6];
  const int prow0 = tid >> 4, pc16 = (tid & 15) * 8;
  auto gload = [&](int cidx) __attribute__((always_inline)) {
    const int chunk = dir ? (63 - cidx) : cidx;
#pragma unroll
    for (int j = 0; j < 2; ++j) {
      const int row = prow0 + 32 * j;
      const int tok = chunk * 64 + (dir ? (63 - row) : row);
      const bf16_t* rp = Hh + (rowbase + tok) * NPAD + head * 128 + pc16;
      if (do_out) pre[j] = *(const u32x4*)(rp + H_Q);
      pre[2 + j] = *(const u32x4*)(rp + fbase); pre[4 + j] = *(const u32x4*)(rp + H_I);
    }
  };
  gload(seg * SLEN);
  for (int ci = 0; ci < SLEN; ++ci) {
    const int cidx = seg * SLEN + ci;
    const int chunk = dir ? (63 - cidx) : cidx;
#pragma unroll
    for (int j = 0; j < 2; ++j) {
      unsigned char* d = smem + L_RAW + (prow0 + 32 * j) * 256 + pc16 * 2;
      if (do_out) *(u32x4*)d = pre[j];
      *(u32x4*)(d + 16384) = pre[2 + j]; *(u32x4*)(d + 32768) = pre[4 + j];
    }
    __syncthreads();
    if (ci + 1 < SLEN) gload(cidx + 1);
    float r0 = 0.f, r1 = 0.f;
#pragma unroll
    for (int i = 0; i < 8; ++i) {
      const unsigned u = rawF[(8 * tg + i) * 64 + cp];
      const float e0 = ex2(fminf(-lo16(u) * LOG2E, 80.f)), e1 = ex2(fminf(-hi16(u) * LOG2E, 80.f));
      r0 += lg2(lb0 + om0 * frcp(1.f + e0)); r1 += lg2(lb1 + om1 * frcp(1.f + e1));
    }
    *(float2*)(sTot + tg * 128 + ch0) = make_float2(r0, r1);
    __syncthreads();
    float off0 = 0.f, off1 = 0.f, ref0 = 0.f, ref1 = 0.f, be0 = 0.f, be1 = 0.f;
#pragma unroll
    for (int j = 0; j < 8; ++j) {
      const float2 t = *(const float2*)(sTot + j * 128 + ch0);
      if (j < tg) { off0 += t.x; off1 += t.y; }
      if (j < 4) { ref0 += t.x; ref1 += t.y; }
      be0 += t.x; be1 += t.y;
    }
    dlog0 += be0; dlog1 += be1;
    const float eref0 = ex2(ref0), eref1 = ex2(ref1), ebr0 = ex2(be0 - ref0), ebr1 = ex2(be1 - ref1);
    float b0 = off0, b1 = off1;
    float kh0[8], kh1[8]; unsigned vv[8];
#pragma unroll
    for (int i = 0; i < 8; ++i) {
      const int tau = 8 * tg + i;
      const unsigned u = rawF[tau * 64 + cp];
      const float e0 = ex2(fminf(-lo16(u) * LOG2E, 80.f)), e1 = ex2(fminf(-hi16(u) * LOG2E, 80.f));
      const float s0 = frcp(1.f + e0), s1 = frcp(1.f + e1);
      b0 += lg2(lb0 + om0 * s0); b1 += lg2(lb1 + om1 * s1);
      const float kx0 = om0 * e0 * s0, kx1 = om1 * e1 * s1;
      const float E0 = ex2(b0 - ref0), E1 = ex2(b1 - ref1);
      const float kt0 = kx0 * frcp(E0), kt1 = kx1 * frcp(E1);
      if (do_out) {
        const unsigned uq = rawQ[tau * 64 + cp];
        const float q0 = lo16(uq), q1 = hi16(uq);
        const float qx0 = q0 * frcp(1.f + ex2(fminf(-q0 * LOG2E, 80.f))) * 0.08838834764831845f;
        const float qx1 = q1 * frcp(1.f + ex2(fminf(-q1 * LOG2E, 80.f))) * 0.08838834764831845f;
        const float qt0 = qx0 * E0, qt1 = qx1 * E1;
        sQt[tau * KPW + cp] = cvtpk(qt0, qt1);
        sKt[tau * KPW + cp] = cvtpk(kt0, kt1);
        sQc[tau * KPW + cp] = cvtpk(qt0 * eref0, qt1 * eref1);
      }
      kh0[i] = kt0 * ebr0; kh1[i] = kt1 * ebr1;
      vv[i] = rawV[tau * 64 + cp];
    }
    *(u32x4*)(sKhT + ch0 * 72 + 8 * tg) = (u32x4){cvtpk(kh0[0], kh0[1]), cvtpk(kh0[2], kh0[3]), cvtpk(kh0[4], kh0[5]), cvtpk(kh0[6], kh0[7])};
    *(u32x4*)(sKhT + (ch0 + 1) * 72 + 8 * tg) = (u32x4){cvtpk(kh1[0], kh1[1]), cvtpk(kh1[2], kh1[3]), cvtpk(kh1[4], kh1[5]), cvtpk(kh1[6], kh1[7])};
    *(u32x4*)(sVT + ch0 * 72 + 8 * tg) = (u32x4){(vv[0] & 0xffffu) | (vv[1] << 16), (vv[2] & 0xffffu) | (vv[3] << 16), (vv[4] & 0xffffu) | (vv[5] << 16), (vv[6] & 0xffffu) | (vv[7] << 16)};
    *(u32x4*)(sVT + (ch0 + 1) * 72 + 8 * tg) = (u32x4){(vv[0] >> 16) | (vv[1] & 0xffff0000u), (vv[2] >> 16) | (vv[3] & 0xffff0000u), (vv[4] >> 16) | (vv[5] & 0xffff0000u), (vv[6] >> 16) | (vv[7] & 0xffff0000u)};
    if (tg == 0) *(float2*)(sD + ch0) = make_float2(ex2(be0), ex2(be1));
    __syncthreads();
    scan_core<K, V, false>(smem, S, OB + (rowbase + (size_t)chunk * 64) * 512 + head * 128, dir, w, lane, do_out);
  }
  if (!do_out) {
    state_store<K, V>(sbuf, S, w, lane);
    if (tg == 0) *(float2*)((float*)(p.ws + OFF_DB) + ((size_t)it * NSEG + seg) * 128 + ch0) = make_float2(ex2(dlog0), ex2(dlog1));
  }
}

DEV void gla_item(const Params& p, int l, int it, int seg, int mode, unsigned char* smem) {
  const int j16 = it - 16, bl = j16 >> 3, head = (j16 >> 1) & 3, dir = j16 & 1;
  const bool do_out = (mode == 3);
  constexpr int K = 64, V = 128, KP = 72, KPW = 36;
  const int tid = launder(threadIdx.x), lane = tid & 63, w = tid >> 6;
  const int cp = tid & 31, tg = tid >> 5, ch0 = 2 * cp;
  const int vp2 = tid & 63, vg = tid >> 6;
  const bf16_t* Hh = (const bf16_t*)(p.ws + OFF_H);
  const float* SMALL = (const float*)(p.ws + OFF_SMALL);
  bf16_t* OB = (bf16_t*)(p.ws + OFF_OBUF) + (size_t)(2 * 2 + dir) * TH * 512;
  const size_t rowbase = (size_t)bl * SEQ;
  unsigned* sQt = (unsigned*)(smem + L_QT); unsigned* sKt = (unsigned*)(smem + L_KT); unsigned* sQc = (unsigned*)(smem + L_QC);
  bf16_t* sKhT = (bf16_t*)(smem + L_KHT); bf16_t* sVT = (bf16_t*)(smem + L_VT);
  float* sD = (float*)(smem + L_D); float* sTot = (float*)(smem + L_TOT); float* sLow = (float*)(smem + L_LOW);
  const unsigned* rawQ = (const unsigned*)(smem + L_RAW); const unsigned* rawK = rawQ + 2048; const unsigned* rawV = rawQ + 4096;
  float* sG = (float*)(smem + L_RAW + 32768);
  float w2a[16], w2b[16];
#pragma unroll
  for (int r = 0; r < 16; ++r) {
    const float* wp = p.gk_w2 + ((size_t)(l * 2 + dir) * 16 + r) * 256 + head * 64 + ch0;
    w2a[r] = wp[0]; w2b[r] = wp[1];
  }
  const float gb0 = p.gk_b[(l * 2 + dir) * 256 + head * 64 + ch0], gb1 = p.gk_b[(l * 2 + dir) * 256 + head * 64 + ch0 + 1];
  f32x16 S[1]; S[0] = zero16();
  float* sbuf = (float*)(p.ws + OFF_SB1) + ((size_t)j16 * NSEG + seg) * 8192;
  if (do_out) state_load<K, V>(sbuf, S, w, lane);
  float dlog0 = 0.f, dlog1 = 0.f;
  u32x4 pre[4];
  float plow0, plow1;
  const int qrow = tid >> 3, qc8 = (tid & 7) * 8, vrow0 = tid >> 4, vc16 = (tid & 15) * 8;
  auto gload = [&](int cidx) __attribute__((always_inline)) {
    const int chunk = dir ? (63 - cidx) : cidx;
    {
      const int tok = chunk * 64 + (dir ? (63 - qrow) : qrow);
      const bf16_t* rp = Hh + (rowbase + tok) * NPAD + head * 64 + qc8;
      if (do_out) pre[0] = *(const u32x4*)(rp + G_Q);
      pre[1] = *(const u32x4*)(rp + G_K);
      const float* lp = SMALL + (rowbase + tok) * 48 + 16 + dir * 16 + (tid & 7) * 2; plow0 = lp[0]; plow1 = lp[1];
    }
#pragma unroll
    for (int j = 0; j < 2; ++j) {
      const int row = vrow0 + 32 * j;
      const int tok = chunk * 64 + (dir ? (63 - row) : row);
      pre[2 + j] = *(const u32x4*)(Hh + (rowbase + tok) * NPAD + G_V + head * 128 + vc16);
    }
  };
  gload(seg * SLEN);
  for (int ci = 0; ci < SLEN; ++ci) {
    const int cidx = seg * SLEN + ci;
    const int chunk = dir ? (63 - cidx) : cidx;
    {
      unsigned char* d = smem + L_RAW + qrow * 128 + qc8 * 2;
      if (do_out) *(u32x4*)d = pre[0];
      *(u32x4*)(d + 8192) = pre[1];
      sLow[qrow * 16 + (tid & 7) * 2] = plow0; sLow[qrow * 16 + (tid & 7) * 2 + 1] = plow1;
#pragma unroll
      for (int j = 0; j < 2; ++j) *(u32x4*)(smem + L_RAW + 16384 + (vrow0 + 32 * j) * 256 + vc16 * 2) = pre[2 + j];
    }
    __syncthreads();
    if (ci + 1 < SLEN) gload(cidx + 1);
    float r0 = 0.f, r1 = 0.f;
#pragma unroll
    for (int i = 0; i < 4; ++i) {
      const int tau = 4 * tg + i;
      float g0 = gb0, g1 = gb1;
#pragma unroll
      for (int r4 = 0; r4 < 4; ++r4) {
        const float4 lw = *(const float4*)(sLow + tau * 16 + 4 * r4);
        g0 += lw.x * w2a[4 * r4] + lw.y * w2a[4 * r4 + 1] + lw.z * w2a[4 * r4 + 2] + lw.w * w2a[4 * r4 + 3];
        g1 += lw.x * w2b[4 * r4] + lw.y * w2b[4 * r4 + 1] + lw.z * w2b[4 * r4 + 2] + lw.w * w2b[4 * r4 + 3];
      }
      const float l0 = (fminf(g0, 0.f) * LOG2E - lg2(1.f + ex2(-fabsf(g0) * LOG2E))) * (1.f / 16.f);
      const float l1 = (fminf(g1, 0.f) * LOG2E - lg2(1.f + ex2(-fabsf(g1) * LOG2E))) * (1.f / 16.f);
      *(float2*)(sG + tau * 64 + ch0) = make_float2(l0, l1);
      r0 += l0; r1 += l1;
    }
    *(float2*)(sTot + tg * 64 + ch0) = make_float2(r0, r1);
    __syncthreads();
    float off0 = 0.f, off1 = 0.f, ref0 = 0.f, ref1 = 0.f, be0 = 0.f, be1 = 0.f;
#pragma unroll
    for (int j = 0; j < 16; ++j) {
      const float2 t = *(const float2*)(sTot + j * 64 + ch0);
      if (j < tg) { off0 += t.x; off1 += t.y; }
      if (j < 8) { ref0 += t.x; ref1 += t.y; }
      be0 += t.x; be1 += t.y;
    }
    dlog0 += be0; dlog1 += be1;
    const float eref0 = ex2(ref0), eref1 = ex2(ref1), ebr0 = ex2(be0 - ref0), ebr1 = ex2(be1 - ref1);
    float b0 = off0, b1 = off1;
    float kh0[4], kh1[4];
#pragma unroll
    for (int i = 0; i < 4; ++i) {
      const int tau = 4 * tg + i;
      const float2 gg = *(const float2*)(sG + tau * 64 + ch0);
      b0 += gg.x; b1 += gg.y;
      const float E0 = ex2(b0 - ref0), E1 = ex2(b1 - ref1);
      const unsigned uk = rawK[tau * 32 + cp];
      const float kt0 = lo16(uk) * frcp(E0), kt1 = hi16(uk) * frcp(E1);
      if (do_out) {
        const unsigned uq = rawQ[tau * 32 + cp];
        const float qt0 = lo16(uq) * 0.125f * E0, qt1 = hi16(uq) * 0.125f * E1;
        sQt[tau * KPW + cp] = cvtpk(qt0, qt1);
        sKt[tau * KPW + cp] = cvtpk(kt0, kt1);
        sQc[tau * KPW + cp] = cvtpk(qt0 * eref0, qt1 * eref1);
      }
      kh0[i] = kt0 * ebr0; kh1[i] = kt1 * ebr1;
    }
    *(uint2*)(sKhT + ch0 * 72 + 4 * tg) = make_uint2(cvtpk(kh0[0], kh0[1]), cvtpk(kh0[2], kh0[3]));
    *(uint2*)(sKhT + (ch0 + 1) * 72 + 4 * tg) = make_uint2(cvtpk(kh1[0], kh1[1]), cvtpk(kh1[2], kh1[3]));
    {
      unsigned vv[8];
#pragma unroll
      for (int i = 0; i < 8; ++i) vv[i] = rawV[(8 * vg + i) * 64 + vp2];
      *(u32x4*)(sVT + (2 * vp2) * 72 + 8 * vg) = (u32x4){(vv[0] & 0xffffu) | (vv[1] << 16), (vv[2] & 0xffffu) | (vv[3] << 16), (vv[4] & 0xffffu) | (vv[5] << 16), (vv[6] & 0xffffu) | (vv[7] << 16)};
      *(u32x4*)(sVT + (2 * vp2 + 1) * 72 + 8 * vg) = (u32x4){(vv[0] >> 16) | (vv[1] & 0xffff0000u), (vv[2] >> 16) | (vv[3] & 0xffff0000u), (vv[4] >> 16) | (vv[5] & 0xffff0000u), (vv[6] >> 16) | (vv[7] & 0xffff0000u)};
    }
    if (tg == 0) *(float2*)(sD + ch0) = make_float2(ex2(be0), ex2(be1));
    __syncthreads();
    scan_core<K, V, false>(smem, S, OB + (rowbase + (size_t)chunk * 64) * 512 + head * 128, dir, w, lane, do_out);
  }
  if (!do_out) {
    state_store<K, V>(sbuf, S, w, lane);
    if (tg == 0) *(float2*)((float*)(p.ws + OFF_DB) + ((size_t)it * NSEG + seg) * 128 + ch0) = make_float2(ex2(dlog0), ex2(dlog1));
  }
}

DEV void ssd_item(const Params& p, int l, int it, int seg, int mode, unsigned char* smem) {
  const int j32 = it - 32, bl = j32 >> 4, head = (j32 >> 1) & 7, dir = j32 & 1;
  const bool do_out = (mode == 3);
  constexpr int K = 128, V = 64, KP = 136, KPW = 68;
  const int tid = launder(threadIdx.x), lane = tid & 63, w = tid >> 6;
  const int cp = tid & 63, tg = tid >> 6, n0 = 2 * cp;
  const int pp = tid & 63;
  const int grp = head >> 2;
  const bf16_t* U = (const bf16_t*)(p.ws + OFF_U);
  const float* SMALL = (const float*)(p.ws + OFF_SMALL);
  bf16_t* OB = (bf16_t*)(p.ws + OFF_OBUF) + (size_t)(1 * 2 + dir) * TH * 512;
  const size_t rowbase = (size_t)bl * SEQ;
  const unsigned* sQt = (const unsigned*)(smem + L_QT); const unsigned* sKt = (const unsigned*)(smem + L_KT); unsigned* sQc = (unsigned*)(smem + L_QC);
  bf16_t* sKhT = (bf16_t*)(smem + L_KHT); bf16_t* sVT = (bf16_t*)(smem + L_VT);
  float* sD = (float*)(smem + L_D); float* sAcs = (float*)(smem + L_ACS); float* sDt = (float*)(smem + L_DT);
  const bf16_t* rawX = (const bf16_t*)(smem + L_RAW);
  const float dtb = p.dt_bias[(l * 2 + dir) * 8 + head];
  const float Acoef = -__expf(p.a_log[(l * 2 + dir) * 8 + head]) * LOG2E;
  f32x16 S[1]; S[0] = zero16();
  float* sbuf = (float*)(p.ws + OFF_SB2) + ((size_t)j32 * NSEG + seg) * 8192;
  if (do_out) state_load<K, V>(sbuf, S, w, lane);
  float dlog = 0.f;
  u32x4 pre[5];
  float rdt = 0.f;
  const int prow0 = tid >> 4, pc16 = (tid & 15) * 8, xrow = tid >> 3, xc8 = (tid & 7) * 8;
  auto gload = [&](int cidx) __attribute__((always_inline)) {
    const int chunk = dir ? (63 - cidx) : cidx;
#pragma unroll
    for (int j = 0; j < 2; ++j) {
      const int row = prow0 + 32 * j;
      const int tok = chunk * 64 + (dir ? (63 - row) : row);
      const bf16_t* rp = U + (rowbase + tok) * 1024 + grp * 128 + pc16;
      pre[j] = *(const u32x4*)(rp + 512);
      if (do_out) pre[2 + j] = *(const u32x4*)(rp + 768);
    }
    {
      const int tok = chunk * 64 + (dir ? (63 - xrow) : xrow);
      pre[4] = *(const u32x4*)(U + (rowbase + tok) * 1024 + head * 64 + xc8);
    }
    if (w == 0) {
      const int tok = chunk * 64 + (dir ? (63 - lane) : lane);
      rdt = SMALL[(rowbase + tok) * 48 + dir * 8 + head];
    }
  };
  gload(seg * SLEN);
  for (int ci = 0; ci < SLEN; ++ci) {
    const int cidx = seg * SLEN + ci;
    const int chunk = dir ? (63 - cidx) : cidx;
#pragma unroll
    for (int j = 0; j < 2; ++j) {
      const int row = prow0 + 32 * j;
      *(u32x4*)(smem + L_KT + row * (KP * 2) + pc16 * 2) = pre[j];
      if (do_out) *(u32x4*)(smem + L_QT + row * (KP * 2) + pc16 * 2) = pre[2 + j];
    }
    *(u32x4*)(smem + L_RAW + xrow * 128 + xc8 * 2) = pre[4];
    if (w == 0) {
      const float xx = rdt + dtb;
      const float dt = (xx > 20.f) ? xx : log1pf(__expf(xx));
      float a = dt * Acoef;
#pragma unroll
      for (int o = 1; o < 64; o <<= 1) { const float t = __shfl_up(a, o); if (lane >= o) a += t; }
      sAcs[lane] = a; sDt[lane] = dt;
    }
    __syncthreads();
    if (ci + 1 < SLEN) gload(cidx + 1);
    const float aend = sAcs[63];
    dlog += aend;
    {
      float kh0[8], kh1[8];
#pragma unroll
      for (int i = 0; i < 8; ++i) {
        const int tau = 8 * tg + i;
        const float ac = sAcs[tau];
        const unsigned ub = sKt[tau * KPW + cp];
        const float eb = ex2(aend - ac);
        kh0[i] = lo16(ub) * eb; kh1[i] = hi16(ub) * eb;
        if (do_out) {
          const unsigned uc = sQt[tau * KPW + cp];
          const float ea = ex2(ac);
          sQc[tau * KPW + cp] = cvtpk(lo16(uc) * ea, hi16(uc) * ea);
        }
      }
      *(u32x4*)(sKhT + n0 * 72 + 8 * tg) = (u32x4){cvtpk(kh0[0], kh0[1]), cvtpk(kh0[2], kh0[3]), cvtpk(kh0[4], kh0[5]), cvtpk(kh0[6], kh0[7])};
      *(u32x4*)(sKhT + (n0 + 1) * 72 + 8 * tg) = (u32x4){cvtpk(kh1[0], kh1[1]), cvtpk(kh1[2], kh1[3]), cvtpk(kh1[4], kh1[5]), cvtpk(kh1[6], kh1[7])};
      float xv[8];
#pragma unroll
      for (int i = 0; i < 8; ++i) { const int tau = 8 * tg + i; xv[i] = bf2f(rawX[tau * 64 + pp]) * sDt[tau]; }
      *(u32x4*)(sVT + pp * 72 + 8 * tg) = (u32x4){cvtpk(xv[0], xv[1]), cvtpk(xv[2], xv[3]), cvtpk(xv[4], xv[5]), cvtpk(xv[6], xv[7])};
      if (tg == 0) *(float2*)(sD + n0) = make_float2(ex2(aend), ex2(aend));
    }
    __syncthreads();
    scan_core<K, V, true>(smem, S, OB + (rowbase + (size_t)chunk * 64) * 512 + head * 64, dir, w, lane, do_out);
  }
  if (!do_out) {
    state_store<K, V>(sbuf, S, w, lane);
    if (tg == 0) *(float2*)((float*)(p.ws + OFF_DB) + ((size_t)it * NSEG + seg) * 128 + n0) = make_float2(ex2(dlog), ex2(dlog));
  }
}

DEV void phase_prep(const Params& p, int l, int hf) {
  const int tid = launder(threadIdx.x);
  const int cg8 = (tid & 127) * 8, rsub = tid >> 7;
  const bf16_t* Hh = (const bf16_t*)(p.ws + OFF_H);
  bf16_t* U = (bf16_t*)(p.ws + OFF_U);
  const float* cw = p.conv_w + (size_t)l * 5 * 1024; const float* cb = p.conv_b + (size_t)l * 1024;
  float wv[5][8], bv[8];
#pragma unroll
  for (int j = 0; j < 5; ++j)
#pragma unroll
    for (int e = 0; e < 8; ++e) wv[j][e] = cw[j * 1024 + cg8 + e];
#pragma unroll
  for (int e = 0; e < 8; ++e) bv[e] = cb[cg8 + e];
  for (int r = blockIdx.x * 4 + rsub; r < TH; r += gridDim.x * 4) {
    const int t = r & (SEQ - 1);
    float u[8];
#pragma unroll
    for (int e = 0; e < 8; ++e) u[e] = bv[e];
#pragma unroll
    for (int j = 0; j < 5; ++j) {
      const int s = t + j - 2;
      if (s >= 0 && s < SEQ) {
        const u32x4 x = *(const u32x4*)(Hh + (size_t)(r + j - 2) * NPAD + S_X + cg8);
#pragma unroll
        for (int e = 0; e < 4; ++e) { u[2 * e] += wv[j][2 * e] * lo16(x[e]); u[2 * e + 1] += wv[j][2 * e + 1] * hi16(x[e]); }
      }
    }
    u32x4 o;
#pragma unroll
    for (int e = 0; e < 4; ++e) {
      const float a = u[2 * e] * frcp(1.f + ex2(fminf(-u[2 * e] * LOG2E, 80.f)));
      const float b = u[2 * e + 1] * frcp(1.f + ex2(fminf(-u[2 * e + 1] * LOG2E, 80.f)));
      o[e] = cvtpk(a, b);
    }
    *(u32x4*)(U + (size_t)r * 1024 + cg8) = o;
  }
}

DEV void phase_mix(const Params& p, int l, int hf, int slot, int mode, int att_lo, int att_hi, int vid_lo, int vid_hi, unsigned char* smem) {
  unsigned* ctr = (unsigned*)(p.ws + OFF_CTRL) + CTR_WORD0 + slot * 16;
  volatile int* sItem = (volatile int*)(smem + LDS_BYTES - 16);
  const int n_scan = 64 * NSEG;
  int hi = n_scan + (att_hi - att_lo); if (vid_hi < hi) hi = vid_hi;
  for (;;) {
    __syncthreads();
    if (threadIdx.x == 0) *sItem = vid_lo + (int)atomicAdd(ctr, 1u);
    __syncthreads();
    const int vid = *sItem;
    if (vid >= hi) break;
    if (vid < n_scan) {
      const int seg = vid >> 6, it = vid & 63;
      if (it < 16) { if (PH_MASK & 0x100) hgrn_item(p, l, it, seg, mode, smem); }
      else if (it < 32) { if (PH_MASK & 0x200) gla_item(p, l, it, seg, mode, smem); }
      else { if (PH_MASK & 0x400) ssd_item(p, l, it, seg, mode, smem); }
    } else { if (PH_MASK & 0x800) attn_item(p, l, att_lo + (vid - n_scan), smem); }
  }
}

DEV void phase_scan2(const Params& p) {
  const size_t gtid = (size_t)blockIdx.x * NT + threadIdx.x, gsz = (size_t)gridDim.x * NT;
  const float* DB = (const float*)(p.ws + OFF_DB);
  for (size_t e = gtid; e < 655360; e += gsz) {
    float* buf; const float* dp; int stride;
    if (e < 262144) { const int it = (int)(e >> 14), idx = (int)(e & 16383); buf = (float*)(p.ws + OFF_SB0) + (size_t)it * NSEG * 16384 + idx; stride = 16384; dp = DB + (size_t)it * NSEG * 128 + (idx >> 7); }
    else if (e < 393216) { const int e2 = (int)(e - 262144), j = e2 >> 13, idx = e2 & 8191; buf = (float*)(p.ws + OFF_SB1) + (size_t)j * NSEG * 8192 + idx; stride = 8192; dp = DB + (size_t)(16 + j) * NSEG * 128 + (idx >> 7); }
    else { const int e3 = (int)(e - 393216), j = e3 >> 13, idx = e3 & 8191; buf = (float*)(p.ws + OFF_SB2) + (size_t)j * NSEG * 8192 + idx; stride = 8192; dp = DB + (size_t)(32 + j) * NSEG * 128 + (idx >> 6); }
    float u[NSEG], d[NSEG];
#pragma unroll
    for (int sg = 0; sg < NSEG; ++sg) { u[sg] = buf[(size_t)sg * stride]; d[sg] = dp[sg * 128]; }
    float st = 0.f;
#pragma unroll
    for (int sg = 0; sg < NSEG; ++sg) { buf[(size_t)sg * stride] = st; st = d[sg] * st + u[sg]; }
  }
}

DEV void phase_fin(const Params& p, int l, int hf) {
  const int tid = launder(threadIdx.x), lane = tid & 63, w = tid >> 6;
  const bf16_t* Hh = (const bf16_t*)(p.ws + OFF_H);
  const bf16_t* OB = (const bf16_t*)(p.ws + OFF_OBUF);
  bf16_t* MX = (bf16_t*)(p.ws + OFF_MIXED);
  const int c0 = lane * 8;
  const float* cw = p.conv_w + (size_t)l * 5 * 1024; const float* cb = p.conv_b + (size_t)l * 1024;
  for (int r = blockIdx.x * 8 + w; r < TH; r += gridDim.x * 8) {
    const bf16_t* hrow = Hh + (size_t)r * NPAD;
    {
      const uint4 a = *(const uint4*)(OB + ((size_t)0 * TH + r) * 512 + c0), b = *(const uint4*)(OB + ((size_t)1 * TH + r) * 512 + c0);
      const uint4 z = *(const uint4*)(hrow + H_Z + c0);
      const unsigned au[4] = {a.x, a.y, a.z, a.w}, bu[4] = {b.x, b.y, b.z, b.w}, zu[4] = {z.x, z.y, z.z, z.w};
      float o[8]; float ss = 0.f;
#pragma unroll
      for (int j = 0; j < 4; ++j) {
        o[2 * j] = bf2f((bf16_t)(au[j] & 0xffff)) + bf2f((bf16_t)(bu[j] & 0xffff));
        o[2 * j + 1] = bf2f((bf16_t)(au[j] >> 16)) + bf2f((bf16_t)(bu[j] >> 16));
        ss += o[2 * j] * o[2 * j] + o[2 * j + 1] * o[2 * j + 1];
      }
#pragma unroll
      for (int of = 32; of >= 1; of >>= 1) ss += __shfl_xor(ss, of);
      const float rstd = rsqrtf(ss * (1.f / 512.f) + 1e-6f);
      float y[8];
#pragma unroll
      for (int j = 0; j < 8; ++j) {
        const float zz = bf2f((bf16_t)((j & 1) ? (zu[j >> 1] >> 16) : (zu[j >> 1] & 0xffff)));
        y[j] = o[j] * rstd * p.hgrn_norm[l * 512 + c0 + j] * fsilu(zz);
      }
      uint4 ov; ov.x = pk2(y[0], y[1]); ov.y = pk2(y[2], y[3]); ov.z = pk2(y[4], y[5]); ov.w = pk2(y[6], y[7]);
      *(uint4*)(MX + (size_t)r * DI + 512 + c0) = ov;
    }
    {
      const uint4 a = *(const uint4*)(OB + ((size_t)4 * TH + r) * 512 + c0), b = *(const uint4*)(OB + ((size_t)5 * TH + r) * 512 + c0);
      const uint4 z = *(const uint4*)(hrow + G_Z + c0);
      const unsigned au[4] = {a.x, a.y, a.z, a.w}, bu[4] = {b.x, b.y, b.z, b.w}, zu[4] = {z.x, z.y, z.z, z.w};
      float o[8]; float ss = 0.f;
#pragma unroll
      for (int j = 0; j < 4; ++j) {
        o[2 * j] = bf2f((bf16_t)(au[j] & 0xffff)) + bf2f((bf16_t)(bu[j] & 0xffff));
        o[2 * j + 1] = bf2f((bf16_t)(au[j] >> 16)) + bf2f((bf16_t)(bu[j] >> 16));
        ss += o[2 * j] * o[2 * j] + o[2 * j + 1] * o[2 * j + 1];
      }
#pragma unroll
      for (int of = 8; of >= 1; of >>= 1) ss += __shfl_xor(ss, of);
      const float rstd = rsqrtf(ss * (1.f / 128.f) + 1e-6f);
      float y[8];
#pragma unroll
      for (int j = 0; j < 8; ++j) {
        const float zz = bf2f((bf16_t)((j & 1) ? (zu[j >> 1] >> 16) : (zu[j >> 1] & 0xffff)));
        y[j] = o[j] * rstd * p.gla_norm[l * 128 + ((c0 + j) & 127)] * fsilu(zz);
      }
      uint4 ov; ov.x = pk2(y[0], y[1]); ov.y = pk2(y[2], y[3]); ov.z = pk2(y[4], y[5]); ov.w = pk2(y[6], y[7]);
      *(uint4*)(MX + (size_t)r * DI + 1536 + c0) = ov;
    }
    {
      const uint4 a = *(const uint4*)(OB + ((size_t)2 * TH + r) * 512 + c0), b = *(const uint4*)(OB + ((size_t)3 * TH + r) * 512 + c0);
      const uint4 z = *(const uint4*)(hrow + S_Z + c0);
      const unsigned au[4] = {a.x, a.y, a.z, a.w}, bu[4] = {b.x, b.y, b.z, b.w}, zu[4] = {z.x, z.y, z.z, z.w};
      float u[8];
#pragma unroll
      for (int j = 0; j < 8; ++j) u[j] = cb[c0 + j];
      const int t = r & (SEQ - 1);
#pragma unroll
      for (int jj = 0; jj < 5; ++jj) {
        const int s = t + jj - 2;
        if (s >= 0 && s < SEQ) {
          const uint4 xr = *(const uint4*)(Hh + (size_t)(r + jj - 2) * NPAD + S_X + c0);
          const unsigned xu[4] = {xr.x, xr.y, xr.z, xr.w};
#pragma unroll
          for (int j = 0; j < 8; ++j) {
            const float xv = bf2f((bf16_t)((j & 1) ? (xu[j >> 1] >> 16) : (xu[j >> 1] & 0xffff)));
            u[j] += cw[jj * 1024 + c0 + j] * xv;
          }
        }
      }
      const float dsk = p.ssd_d[l * 8 + (c0 >> 6)];
      float y[8]; float ss = 0.f;
#pragma unroll
      for (int j = 0; j < 8; ++j) {
        const float of = bf2f((bf16_t)((j & 1) ? (au[j >> 1] >> 16) : (au[j >> 1] & 0xffff)));
        const float ob = bf2f((bf16_t)((j & 1) ? (bu[j >> 1] >> 16) : (bu[j >> 1] & 0xffff)));
        const float zz = bf2f((bf16_t)((j & 1) ? (zu[j >> 1] >> 16) : (zu[j >> 1] & 0xffff)));
        y[j] = (of + ob + dsk * fsilu(u[j])) * fsilu(zz);
        ss += y[j] * y[j];
      }
#pragma unroll
      for (int of = 32; of >= 1; of >>= 1) ss += __shfl_xor(ss, of);
      const float rstd = rsqrtf(ss * (1.f / 512.f) + 1e-6f);
#pragma unroll
      for (int j = 0; j < 8; ++j) y[j] = y[j] * rstd * p.ssd_norm[l * 512 + c0 + j];
      uint4 ov; ov.x = pk2(y[0], y[1]); ov.y = pk2(y[2], y[3]); ov.z = pk2(y[4], y[5]); ov.w = pk2(y[6], y[7]);
      *(uint4*)(MX + (size_t)r * DI + 1024 + c0) = ov;
    }
  }
}


#define XB_TMO      128
#define XB_XCNT(j)  (256  + 64 * (j))
#define XB_XSUB(j)  (1280 + 64 * (j))
#define XB_XGEN(j)  (2304 + 64 * (j))
#define XB_TOP      3328
#define XB_TOPGEN   3392
#define XB_SPIN_CAP (1u << 22)
#define LAS __attribute__((address_space(3)))
DEV unsigned xb_ld(unsigned* p) { return __hip_atomic_load(p, __ATOMIC_RELAXED, __HIP_MEMORY_SCOPE_AGENT); }
DEV unsigned xb_add(unsigned* p, unsigned v) { return __hip_atomic_fetch_add(p, v, __ATOMIC_RELAXED, __HIP_MEMORY_SCOPE_AGENT); }
DEV unsigned xb_xcc_id() { return (unsigned)__builtin_amdgcn_s_getreg((3 << 11) | 20) & 0xFu; }
#define XB_SPIN(cond, bar) do { unsigned _sp = 0; while (cond) { __builtin_amdgcn_s_sleep(1); \
    if ((++_sp & 255u) == 0u) { if (xb_ld(&(bar)[XB_TMO])) break; if (_sp > XB_SPIN_CAP) { atomicAdd(&(bar)[XB_TMO], 1u); break; } } } } while (0)
struct XcdBarrier { unsigned* bar; unsigned x; volatile LAS unsigned* st; };
DEV XcdBarrier xcd_barrier_post(unsigned* bar, volatile LAS unsigned* st) {
  XcdBarrier b; b.bar = bar; b.x = xb_xcc_id(); b.st = st;
  if (threadIdx.x == 0) (void)xb_add(&bar[XB_XCNT(b.x)], 1u);
  return b;
}
DEV void xcd_barrier_complete(unsigned* bar, unsigned x, unsigned& nloc, unsigned& nx) {
  const unsigned G = gridDim.x * gridDim.y * gridDim.z;
  unsigned sum, cnt, mine, sp = 0u;
  for (;;) {
    sum = 0u; cnt = 0u; mine = 0u;
#pragma unroll
    for (unsigned j = 0; j < 16; ++j) { const unsigned c = xb_ld(&bar[XB_XCNT(j)]); sum += c; cnt += (c > 0u) ? 1u : 0u; mine = (j == x) ? c : mine; }
    if (sum == G) break;
    __builtin_amdgcn_s_sleep(1);
    if ((++sp & 255u) == 0u) { if (xb_ld(&bar[XB_TMO])) break; if (sp > XB_SPIN_CAP) { atomicAdd(&bar[XB_TMO], 1u); break; } }
  }
  nloc = mine > 0u ? mine : 1u; nx = cnt > 0u ? cnt : 1u;
}
DEV void xcd_barrier(const XcdBarrier& b) {
  asm volatile("s_waitcnt vmcnt(0)" ::: "memory");
  __syncthreads();
  if (threadIdx.x == 0) {
    unsigned* bar = b.bar;
    __builtin_amdgcn_s_waitcnt(0);
    unsigned nloc = b.st[0], nx = b.st[1];
    if (nloc == 0u) { xcd_barrier_complete(bar, b.x, nloc, nx); b.st[0] = nloc; b.st[1] = nx; }
    const unsigned old = xb_add(&bar[XB_XSUB(b.x)], 1u);
    const unsigned gen = old / nloc;
    if (old + 1u == (gen + 1u) * nloc) {
      __builtin_amdgcn_fence(__ATOMIC_RELEASE, "agent");
      asm volatile("s_waitcnt vmcnt(0)" ::: "memory");
      const unsigned og = xb_add(&bar[XB_TOP], 1u);
      const unsigned tg = og / nx;
      if (og + 1u == (tg + 1u) * nx) xb_add(&bar[XB_TOPGEN], 1u);
      else XB_SPIN(xb_ld(&bar[XB_TOPGEN]) == tg, bar);
      __builtin_amdgcn_fence(__ATOMIC_ACQUIRE, "agent");
      xb_add(&bar[XB_XGEN(b.x)], 1u);
      asm volatile("s_waitcnt vmcnt(0)" ::: "memory");
    } else {
      XB_SPIN(xb_ld(&bar[XB_XGEN(b.x)]) == gen, bar);
      __builtin_amdgcn_fence(__ATOMIC_ACQUIRE, "agent");
      asm volatile("s_waitcnt vmcnt(0)" ::: "memory");
    }
  }
  __syncthreads();
}

#ifndef PROBE_ST
#define PROBE_ST -1
#endif
#ifndef PROBE_REP
#define PROBE_REP 0
#endif
#ifndef PROBE_LO
#define PROBE_LO 0
#endif
#ifndef PROBE_HI
#define PROBE_HI 100000
#endif
DEV void run_phase(const Params& p, int ph, int rep, unsigned char* smem) {
  if (ph == 0) { if (PH_MASK & 1) phase_pro(p, smem); }
  else {
    const int q = ph - 1, l = q / 16, hf = (q / 8) & 1, st = q % 8;
    if (st == 0) { if (PH_MASK & 2) phase_inproj(p, l, hf, smem); }
    else if (st == 1) { if (PH_MASK & 4) phase_prep(p, l, hf); }
    else if (st == 2) { if (PH_MASK & 0xF00) phase_mix(p, l, hf, ph + 40 * rep, 1, 0, ATT_SPLIT, rep ? PROBE_LO : 0, rep ? PROBE_HI : 100000, smem); }
    else if (st == 3) { if (PH_MASK & 0x700) phase_scan2(p); }
    else if (st == 4) { if (PH_MASK & 0xF00) phase_mix(p, l, hf, ph + 40 * rep, 3, ATT_SPLIT, 256, rep ? PROBE_LO : 0, rep ? PROBE_HI : 100000, smem); }
    else if (st == 5) { if (PH_MASK & 8) phase_fin(p, l, hf); }
    else if (st == 6) { if (PH_MASK & 16) phase_outproj(p, l, hf, smem); }
    else {
      if (PH_MASK & 32) phase_ln(p, l, hf);
      if ((PH_MASK & 1) && l == 0 && hf == 1) convert_weights(p, 1, smem);
    }
  }
}
__global__ void __launch_bounds__(NT) mega(Params p) {
  extern __shared__ __attribute__((aligned(16))) unsigned char smem[];
#if ONE_LAUNCH
  volatile LAS unsigned* xst = (volatile LAS unsigned*)(smem + LDS_BYTES - 32);
  if (threadIdx.x == 0) { xst[0] = 0u; xst[1] = 0u; }
  __syncthreads();
  XcdBarrier xb = xcd_barrier_post((unsigned*)(p.ws + OFF_CTRL), xst);
#endif
  for (int ph = p.phase_begin; ph < p.phase_end; ++ph) {
    int nrep = 0;
#if PROBE_REP > 0
    {
      const int q = ph - 1, l = q / 16, st = q % 8;
      const bool idem = (ph == 0) ? (PROBE_ST == 9) : (st == PROBE_ST && (st != 6 || l == 0));
      if (idem) nrep = PROBE_REP;
    }
#endif
    for (int r = 0; r <= nrep; ++r) {
      run_phase(p, ph, r, smem);
#if ONE_LAUNCH
      if (r < nrep || ph + 1 < p.phase_end) xcd_barrier(xb);
#endif
    }
  }
}

extern "C" void kernel_launch(void* const* d_in, const int* in_sizes, int n_in, void* d_out, int out_size, void* d_ws, size_t ws_size,
                              hipStream_t stream) {
  static int grid_blocks = 0;
  if (!grid_blocks) {
    int dev = 0, cus = 0, per_cu = 0;
    hipGetDevice(&dev);
    hipDeviceGetAttribute(&cus, hipDeviceAttributeMultiprocessorCount, dev);
    hipFuncSetAttribute((const void*)mega, hipFuncAttributeMaxDynamicSharedMemorySize, LDS_BYTES);
    hipOccupancyMaxActiveBlocksPerMultiprocessor(&per_cu, mega, NT, LDS_BYTES);
    if (per_cu < 1) per_cu = 1;
    grid_blocks = cus;
  }
  Params p{};
  p.x = (const float*)d_in[0]; p.w_in = (const float*)d_in[1]; p.q_gain = (const float*)d_in[2]; p.k_gain = (const float*)d_in[3];
  p.lb_logits = (const float*)d_in[4]; p.hgrn_norm = (const float*)d_in[5]; p.conv_w = (const float*)d_in[6]; p.conv_b = (const float*)d_in[7];
  p.dt_bias = (const float*)d_in[8]; p.a_log = (const float*)d_in[9]; p.ssd_d = (const float*)d_in[10]; p.ssd_norm = (const float*)d_in[11];
  p.gk_w2 = (const float*)d_in[12]; p.gk_b = (const float*)d_in[13]; p.gla_norm = (const float*)d_in[14]; p.w_out = (const float*)d_in[15];
  p.ln_g = (const float*)d_in[16]; p.ln_b = (const float*)d_in[17];
  p.out = (float*)d_out; p.ws = (unsigned char*)d_ws;
  hipMemsetAsync(d_ws, 0, CTRL_BYTES, stream);
#if ONE_LAUNCH
  p.phase_begin = 0; p.phase_end = NPHASE;
  void* args[] = {&p};
  (void)args;
  hipLaunchKernelGGL(mega, dim3(grid_blocks), dim3(NT), LDS_BYTES, stream, p);
#else
  for (int ph = 0; ph < NPHASE; ++ph) {
    p.phase_begin = ph; p.phase_end = ph + 1;
    hipLaunchKernelGGL(mega, dim3(grid_blocks), dim3(NT), LDS_BYTES, stream, p);
  }
#endif
}
```

```cpp
#include <hip/hip_runtime.h>
#include <hip/hip_cooperative_groups.h>
#include <stdint.h>
#include <stdio.h>
namespace cg = cooperative_groups;

#ifndef ONE_LAUNCH
#define ONE_LAUNCH 1
#endif

#ifndef PH_MASK
#define PH_MASK 0xFFF
#endif
#define DEV __device__ __forceinline__
typedef unsigned short bf16_t;
typedef short bf16x8 __attribute__((ext_vector_type(8)));
typedef float f32x16 __attribute__((ext_vector_type(16)));
typedef unsigned u32x4 __attribute__((ext_vector_type(4)));

constexpr int NT = 512;
constexpr int T_ALL = 16384, TH = 8192, SEQ = 4096, DM = 1024, NPAD = 7168, DI = 2048, NIN = 6960;
constexpr int A_Q = 0, A_K = 512, A_V = 640, A_Z = 768, H_Q = 1280, H_FF = 1792, H_FB = 2304, H_I = 2816, H_Z = 3328,
              S_X = 3840, S_Z = 4864, G_Q = 5376, G_K = 5632, G_V = 5888, G_Z = 6400, SM0 = 6912;
constexpr size_t OFF_CTRL = 0, OFF_TAB = 65536, OFF_XB = 131072;
constexpr size_t OFF_WIN = OFF_XB + (size_t)T_ALL * DM * 2;
constexpr size_t OFF_WOUT = OFF_WIN + (size_t)NPAD * DM * 2;
constexpr size_t OFF_H = OFF_WOUT + (size_t)DM * DI * 2;
constexpr size_t OFF_SMALL = OFF_H + (size_t)TH * NPAD * 2;
constexpr size_t OFF_OBUF = OFF_SMALL + (size_t)TH * 48 * 4;
constexpr size_t OFF_VT = OFF_OBUF + (size_t)6 * TH * 512 * 2;
constexpr size_t OFF_DB = OFF_VT + (size_t)2 * 2 * 64 * SEQ * 2;
constexpr int NSEG = 8, SLEN = 64 / NSEG;
constexpr size_t OFF_MIXED = OFF_DB + (size_t)64 * NSEG * 128 * 4;
constexpr size_t OFF_SB0 = OFF_MIXED, OFF_SB1 = OFF_SB0 + (size_t)16 * NSEG * 16384 * 4, OFF_SB2 = OFF_SB1 + (size_t)16 * NSEG * 8192 * 4;
constexpr size_t OFF_U = OFF_SB2 + (size_t)32 * NSEG * 8192 * 4;
constexpr size_t WS_END = OFF_U + (size_t)TH * 1024 * 2;
static_assert(OFF_MIXED + (size_t)TH * DI * 2 <= WS_END, "MIXED must fit");
static_assert(WS_END <= 268435456, "workspace");
constexpr size_t CTRL_BYTES = 65536;
constexpr int CTR_WORD0 = 4096;
constexpr int LDS_BYTES = 148480;
constexpr float LOG2E = 1.4426950408889634f;
constexpr float QSCALE = 0.125f * LOG2E;
constexpr float DN_ALPHA = 1.4142135623730951f;
constexpr int NPHASE = 33;
constexpr int ATT_SPLIT = 144;

struct Params {
  const float* x; const float* w_in; const float* q_gain; const float* k_gain; const float* lb_logits; const float* hgrn_norm;
  const float* conv_w; const float* conv_b; const float* dt_bias; const float* a_log; const float* ssd_d; const float* ssd_norm;
  const float* gk_w2; const float* gk_b; const float* gla_norm; const float* w_out; const float* ln_g; const float* ln_b;
  float* out; unsigned char* ws;
  int phase_begin, phase_end;
};

DEV int launder(int v) { asm volatile("" : "+v"(v)); return v; }
DEV float bf2f(bf16_t v) { return __uint_as_float(((unsigned)v) << 16); }
DEV bf16_t f2bf(float f) { unsigned u = __float_as_uint(f); u += 0x7fffu + ((u >> 16) & 1u); return (bf16_t)(u >> 16); }
DEV unsigned pk2(float lo, float hi) { return (unsigned)f2bf(lo) | ((unsigned)f2bf(hi) << 16); }
DEV float fsigmoid(float x) { return 1.f / (1.f + __expf(-x)); }
DEV float fsilu(float x) { return x / (1.f + __expf(-x)); }
DEV unsigned cvtpk(float lo, float hi) { unsigned r; asm("v_cvt_pk_bf16_f32 %0, %1, %2" : "=v"(r) : "v"(lo), "v"(hi)); return r; }
DEV float ex2(float x) { return __builtin_amdgcn_exp2f(x); }
DEV float lg2(float x) { return __builtin_amdgcn_logf(x); }
DEV float frcp(float x) { return __builtin_amdgcn_rcpf(x); }
DEV float lo16(unsigned u) { return __uint_as_float(u << 16); }
DEV float hi16(unsigned u) { return __uint_as_float(u & 0xffff0000u); }
DEV int rowoff(int reg, int h) { return (reg & 3) + 8 * (reg >> 2) + 4 * h; }
DEV f32x16 zero16() { f32x16 z;
#pragma unroll
  for (int i = 0; i < 16; ++i) z[i] = 0.f; return z; }

template <int KD>
DEV void mma32(f32x16& acc, const bf16_t* a, int lda, const bf16_t* b, int ldb, int lane) {
  const int r = lane & 31, h = lane >> 5;
  const bf16_t* ap = a + r * lda + 8 * h;
  const bf16_t* bp = b + r * ldb + 8 * h;
#pragma unroll 4
  for (int k = 0; k < KD; k += 16) {
    bf16x8 av = *(const bf16x8*)(ap + k);
    bf16x8 bv = *(const bf16x8*)(bp + k);
    acc = __builtin_amdgcn_mfma_f32_32x32x16_bf16(av, bv, acc, 0, 0, 0);
  }
}

DEV int orig_col(int n) {
  if (n < 4864) return n;
  if (n < 6400) return n + 16;
  if (n < 6912) return n + 48;
  if (n < 6928) return n - 2048;
  if (n < 6960) return n - 512;
  return -1;
}

DEV void convert_weights(const Params& p, int l, unsigned char* smem) {
  float* s = (float*)smem;
  const int tid = launder(threadIdx.x);
  const float* win = p.w_in + (size_t)l * DM * NIN;
  const float* wout = p.w_out + (size_t)l * DI * DM;
  bf16_t* wint = (bf16_t*)(p.ws + OFF_WIN);
  bf16_t* woutt = (bf16_t*)(p.ws + OFF_WOUT);
  const int n_in_tiles = (NPAD / 64) * (DM / 64);
  const int n_out_tiles = (DM / 64) * (DI / 64);
  for (int it = blockIdx.x; it < n_in_tiles + n_out_tiles; it += gridDim.x) {
    __syncthreads();
    if (it < n_in_tiles) {
      const int n0 = (it / 16) * 64, k0 = (it % 16) * 64;
#pragma unroll
      for (int e = 0; e < 8; ++e) {
        const int idx = e * NT + tid, kk = idx >> 6, nn = idx & 63;
        const int oc = orig_col(n0 + nn);
        s[kk * 65 + nn] = (oc >= 0) ? win[(size_t)(k0 + kk) * NIN + oc] : 0.f;
      }
      __syncthreads();
      const int n = tid >> 3, kc = (tid & 7) * 8;
      uint4 o;
      o.x = pk2(s[(kc + 0) * 65 + n], s[(kc + 1) * 65 + n]); o.y = pk2(s[(kc + 2) * 65 + n], s[(kc + 3) * 65 + n]);
      o.z = pk2(s[(kc + 4) * 65 + n], s[(kc + 5) * 65 + n]); o.w = pk2(s[(kc + 6) * 65 + n], s[(kc + 7) * 65 + n]);
      *(uint4*)(wint + (size_t)(n0 + n) * DM + k0 + kc) = o;
    } else {
      const int j = it - n_in_tiles;
      const int n0 = (j / 32) * 64, k0 = (j % 32) * 64;
#pragma unroll
      for (int e = 0; e < 8; ++e) {
        const int idx = e * NT + tid, kk = idx >> 6, nn = idx & 63;
        s[kk * 65 + nn] = wout[(size_t)(k0 + kk) * DM + n0 + nn];
      }
      __syncthreads();
      const int n = tid >> 3, kc = (tid & 7) * 8;
      uint4 o;
      o.x = pk2(s[(kc + 0) * 65 + n], s[(kc + 1) * 65 + n]); o.y = pk2(s[(kc + 2) * 65 + n], s[(kc + 3) * 65 + n]);
      o.z = pk2(s[(kc + 4) * 65 + n], s[(kc + 5) * 65 + n]); o.w = pk2(s[(kc + 6) * 65 + n], s[(kc + 7) * 65 + n]);
      *(uint4*)(woutt + (size_t)(n0 + n) * DI + k0 + kc) = o;
    }
  }
  __syncthreads();
}

DEV void fsincos(float x, float& s, float& c) {
  const float k = rintf(x * 0.63661977236758134308f);
  float r = fmaf(-k, 1.5707855225e+00f, x);
  r = fmaf(-k, 1.0804273188e-05f, r);
  r = fmaf(-k, 6.0770999344e-11f, r);
  const float r2 = r * r;
  float ps = fmaf(r2, 2.7557319224e-06f, -1.9841269841e-04f);
  ps = fmaf(ps, r2, 8.3333333333e-03f); ps = fmaf(ps, r2, -1.6666666667e-01f);
  const float sinr = fmaf(ps * r2, r, r);
  float pc = fmaf(r2, -2.7557319224e-07f, 2.4801587302e-05f);
  pc = fmaf(pc, r2, -1.3888888889e-03f); pc = fmaf(pc, r2, 4.1666666667e-02f); pc = fmaf(pc, r2, -0.5f);
  const float cosr = fmaf(pc, r2, 1.0f);
  const int q = ((int)k) & 3;
  if (q == 0) { s = sinr; c = cosr; }
  else if (q == 1) { s = cosr; c = -sinr; }
  else if (q == 2) { s = -sinr; c = -cosr; }
  else { s = -cosr; c = sinr; }
}

DEV void phase_pro(const Params& p, unsigned char* smem) {
  const int tid = launder(threadIdx.x);
  const size_t gtid = (size_t)blockIdx.x * NT + tid, gsz = (size_t)gridDim.x * NT;
  const float4* x4 = (const float4*)p.x;
  uint4* xb4 = (uint4*)(p.ws + OFF_XB);
  for (size_t i = gtid; i < (size_t)T_ALL * DM / 8; i += gsz) {
    const float4 a = x4[2 * i], b = x4[2 * i + 1];
    uint4 o; o.x = pk2(a.x, a.y); o.y = pk2(a.z, a.w); o.z = pk2(b.x, b.y); o.w = pk2(b.z, b.w);
    xb4[i] = o;
  }
  if (blockIdx.x == 0) {
    float2* tab = (float2*)(p.ws + OFF_TAB);
    for (int i = tid; i < 64 * 16; i += NT) {
      const int pos = i >> 4, fi = i & 15;
      const float invf = exp2f(-(float)fi * (13.287712379549449f / 16.0f));
      const float ang = (float)pos * invf;
      float sn, cs; fsincos(ang, sn, cs);
      tab[i] = make_float2(cs, sn);
    }
  }
}

namespace pg8 {
#define PG8_LAS __attribute__((address_space(3)))
typedef unsigned short bf16_t;
typedef short bf16x8 __attribute__((ext_vector_type(8)));
typedef float f32x4 __attribute__((ext_vector_type(4)));
typedef unsigned u32x4 __attribute__((ext_vector_type(4)));
constexpr int BM = 256, BK = 64, HALF = 128, HTB = HALF * BK * 2  , STAGE_BYTES = 8 * HTB, NXCD = 8, WGM = 8;

__host__ __device__ __forceinline__ int lds_byte(int r, int c) { const int st = (r >> 4) * 2 + (c >> 5), rr = r & 15, cc = c & 31, ob = rr * 64 + cc * 2; return st * 1024 + (ob ^ (((ob >> 9) & 1) << 5)); }
__host__ __device__ __forceinline__ void stage_rc(int b, int& R, int& C) { const int st = b / 1024, sb = b % 1024, swz = sb ^ (((sb >> 9) & 1) << 5); R = (st >> 1) * 16 + swz / 64; C = (st & 1) * 32 + (swz % 64) / 2; }
__host__ __device__ __forceinline__ int perm32(int rho) { const int n = rho >> 4, i = rho & 15; return 8 * (i >> 2) + 4 * n + (i & 3); }

struct Unit { int pm, pn; };
struct Gemm { const bf16_t* A; const bf16_t* Bt; int M, N, K; };

__device__ __forceinline__ unsigned cvt_pk_bf16(float lo, float hi) { unsigned r; asm volatile("v_cvt_pk_bf16_f32 %0, %1, %2" : "=v"(r) : "v"(lo), "v"(hi)); return r; }

struct XcdOrder {
    int rpx, nN, x, c, ncu;
    __device__ void init(int M, int N) { rpx = (M / BM) / NXCD; nN = N / BM; x = blockIdx.x & 7; c = blockIdx.x >> 3; ncu = gridDim.x >> 3; }
    __device__ bool next(int i, Unit& u) const { const int j = c + i * ncu; if (j >= rpx * nN) return false; u.pm = rpx * x + (j % rpx); u.pn = j / rpx; return true; }
    __device__ __forceinline__ void a_ready(const Unit&) const {}
    __device__ __forceinline__ void done(const Unit&) const {}
};
struct EpiIn {
    static constexpr bool PERM = true, AFTER_DRAIN = false;
    bf16_t* O; int ldc; float* small; int small_pn;
    __device__ __forceinline__ void operator()(const f32x4 (&acc)[2][2][4][2], const Unit& u, int wr, int wc, int fr, int fq) const {
        const int row0 = u.pm * BM + wr * 64 + fr, col0 = u.pn * BM + wc * 32 + 8 * fq;
        if (u.pn == small_pn) {
            const int c = wc * 32 + 8 * fq;
            if (c < 48) {
#pragma unroll
                for (int ai = 0; ai < 2; ++ai)
#pragma unroll
                    for (int m = 0; m < 4; ++m) { float* rp = small + (size_t)(row0 + ai * HALF + m * 16) * 48 + c; *(f32x4*)rp = acc[ai][0][m][0]; *(f32x4*)(rp + 4) = acc[ai][0][m][1]; }
            }
            return;
        }
#pragma unroll
        for (int ai = 0; ai < 2; ++ai)
#pragma unroll
            for (int m = 0; m < 4; ++m) { bf16_t* rowp = O + (size_t)(row0 + ai * HALF + m * 16) * ldc + col0;
#pragma unroll
                for (int bj = 0; bj < 2; ++bj) { const f32x4 v0 = acc[ai][bj][m][0], v1 = acc[ai][bj][m][1];
                    u32x4 w; w.x = cvt_pk_bf16(v0[0], v0[1]); w.y = cvt_pk_bf16(v0[2], v0[3]); w.z = cvt_pk_bf16(v1[0], v1[1]); w.w = cvt_pk_bf16(v1[2], v1[3]);
                    *(u32x4*)(rowp + bj * HALF) = w; } }
    }
};
struct EpiOut {
    static constexpr bool PERM = true, AFTER_DRAIN = false;
    const float* X; float* Y; int ldc; float alpha;
    __device__ __forceinline__ void operator()(const f32x4 (&acc)[2][2][4][2], const Unit& u, int wr, int wc, int fr, int fq) const {
        const int row0 = u.pm * BM + wr * 64 + fr, col0 = u.pn * BM + wc * 32 + 8 * fq;
#pragma unroll
        for (int ai = 0; ai < 2; ++ai)
#pragma unroll
            for (int m = 0; m < 4; ++m) { const size_t off = (size_t)(row0 + ai * HALF + m * 16) * ldc + col0;
#pragma unroll
                for (int bj = 0; bj < 2; ++bj) { const f32x4 x0 = *(const f32x4*)(X + off + bj * HALF), x1 = *(const f32x4*)(X + off + bj * HALF + 4);
                    *(f32x4*)(Y + off + bj * HALF) = x0 * alpha + acc[ai][bj][m][0]; *(f32x4*)(Y + off + bj * HALF + 4) = x1 * alpha + acc[ai][bj][m][1]; } }
    }
};

template <class Epi, class Sched, bool ALIGN_EPI = false, bool SP2 = false>
__device__ __forceinline__ void gemm_phase(PG8_LAS unsigned char* lds, const Gemm g, const Sched& S, const Epi& E) {
    const int tid = launder((int)threadIdx.x), wid = __builtin_amdgcn_readfirstlane(tid >> 6), lane = tid & 63, wr = wid >> 2, wc = wid & 3, fr = lane & 15, fq = lane >> 4;
    const int K = g.K, nt = K / BK;
    unsigned voffA[2], voffB[2];
#pragma unroll
    for (int i = 0; i < 2; ++i) { int R, C; stage_rc(tid * 16 + i * 8192, R, C); const int Rb = Epi::PERM ? ((R & ~31) + perm32(R & 31)) : R;
        voffA[i] = (unsigned)(R * K + C) * 2u; voffB[i] = (unsigned)(Rb * K + C) * 2u; }
    const size_t kstep = (size_t)(BK * 2);
    const size_t hstep = (size_t)HALF * K * 2;
    const size_t tstep = 2 * hstep;
    const unsigned ldsw = (unsigned)wid * 1024u;
    const int aoff = lds_byte(wr * 64 + fr, fq * 8), boff = lds_byte(wc * 32 + fr, fq * 8);
#define PG8_SA(b, h) (((b) * 2 + (h)) * HTB)
#define PG8_SB(b, h) ((4 + (b) * 2 + (h)) * HTB)
#define PG8_STAGE(bufoff, gbase, voff) do { _Pragma("unroll") for (int _i = 0; _i < 2; ++_i) \
        __builtin_amdgcn_global_load_lds((const unsigned*)((const char*)(gbase) + (voff)[_i]), (PG8_LAS unsigned*)(lds + (bufoff) + ldsw + _i * 8192), 16, 0, 0); } while (0)
#define PG8_LDA(dst, b, h) do { _Pragma("unroll") for (int m = 0; m < 4; ++m) _Pragma("unroll") for (int k = 0; k < 2; ++k) dst[m][k] = *(const PG8_LAS bf16x8*)(lds + PG8_SA(b, h) + aoff + m * 2048 + k * 1024); } while (0)
#define PG8_LDB(dst, b, h) do { _Pragma("unroll") for (int n = 0; n < 2; ++n) _Pragma("unroll") for (int k = 0; k < 2; ++k) dst[n][k] = *(const PG8_LAS bf16x8*)(lds + PG8_SB(b, h) + boff + n * 2048 + k * 1024); } while (0)
#define PG8_MMA(ai, bj, At, Bt) do { __builtin_amdgcn_s_setprio(1); _Pragma("unroll") for (int m = 0; m < 4; ++m) _Pragma("unroll") for (int n = 0; n < 2; ++n) _Pragma("unroll") for (int k = 0; k < 2; ++k) \
        acc[ai][bj][m][n] = __builtin_amdgcn_mfma_f32_16x16x32_bf16(Bt[n][k], At[m][k], acc[ai][bj][m][n], 0, 0, 0); __builtin_amdgcn_s_setprio(0); } while (0)
#define PG8_WAIT_V(n) asm volatile("s_waitcnt vmcnt(" #n ")" ::: "memory")
#define PG8_WAIT_L(n) asm volatile("s_waitcnt lgkmcnt(" #n ")" ::: "memory")
#define PG8_BAR __builtin_amdgcn_s_barrier()
#define PG8_SCHED __builtin_amdgcn_sched_barrier(0)
    Unit cur, nxt; int ui = 0;
    if (!S.next(0, cur)) return;
    f32x4 acc[2][2][4][2];
#pragma unroll
    for (int a = 0; a < 2; ++a)
#pragma unroll
        for (int b = 0; b < 2; ++b)
#pragma unroll
            for (int m = 0; m < 4; ++m)
#pragma unroll
                for (int n = 0; n < 2; ++n) acc[a][b][m][n] = (f32x4){0.f, 0.f, 0.f, 0.f};
    bf16x8 At[4][2], B0[2][2], B1[2][2];
    const char* cA = (const char*)g.A + (size_t)cur.pm * tstep; const char* cB = (const char*)g.Bt + (size_t)cur.pn * tstep;
    S.a_ready(cur);
    if constexpr (SP2) {
        PG8_STAGE(PG8_SB(0, 0), cB, voffB); PG8_STAGE(PG8_SB(0, 1), cB + hstep, voffB); PG8_STAGE(PG8_SA(0, 0), cA, voffA); PG8_STAGE(PG8_SA(0, 1), cA + hstep, voffA);
        if (wr == 1) PG8_BAR;
        PG8_WAIT_V(2); PG8_BAR;
        PG8_STAGE(PG8_SB(1, 0), cB + kstep, voffB); PG8_STAGE(PG8_SA(1, 0), cA + kstep, voffA); PG8_STAGE(PG8_SB(1, 1), cB + hstep + kstep, voffB);
        PG8_WAIT_V(6); PG8_BAR;
    } else {
        PG8_STAGE(PG8_SB(0, 0), cB, voffB); PG8_STAGE(PG8_SA(0, 0), cA, voffA); PG8_STAGE(PG8_SB(0, 1), cB + hstep, voffB); PG8_STAGE(PG8_SA(0, 1), cA + hstep, voffA);
        if (wr == 1) PG8_BAR;
        PG8_WAIT_V(4); PG8_BAR;
        PG8_STAGE(PG8_SB(1, 0), cB + kstep, voffB); PG8_STAGE(PG8_SA(1, 0), cA + kstep, voffA); PG8_STAGE(PG8_SB(1, 1), cB + hstep + kstep, voffB);
        PG8_WAIT_V(6); PG8_BAR;
    }
    for (;;) {
        const bool has_next = S.next(ui + 1, nxt);
        const char* nA = has_next ? (const char*)g.A + (size_t)nxt.pm * tstep : cA; const char* nB = has_next ? (const char*)g.Bt + (size_t)nxt.pn * tstep : cB;
        for (int t = 0; t < nt; t += 2) {
            const bool last = (t == nt - 2);
            const char* a1 = cA + (size_t)(t + 1) * kstep;
            const char* a2 = last ? nA : cA + (size_t)(t + 2) * kstep; const char* b2 = last ? nB : cB + (size_t)(t + 2) * kstep;
            const char* a3 = a2 + kstep; const char* b3 = b2 + kstep;
            if (last && has_next) S.a_ready(nxt);
            if constexpr (SP2) {
            PG8_LDB(B0, 0, 0); PG8_LDB(B1, 0, 1); PG8_SCHED; PG8_LDA(At, 0, 0); PG8_STAGE(PG8_SA(1, 1), a1 + hstep, voffA);
            PG8_WAIT_V(8); PG8_WAIT_L(0); PG8_BAR; PG8_MMA(0, 0, At, B0); PG8_MMA(0, 1, At, B1); PG8_BAR; PG8_SCHED;
            PG8_LDA(At, 0, 1); PG8_STAGE(PG8_SB(0, 0), b2, voffB); PG8_STAGE(PG8_SB(0, 1), b2 + hstep, voffB); PG8_STAGE(PG8_SA(0, 0), a2, voffA);
            PG8_WAIT_V(8); PG8_WAIT_L(0); PG8_BAR; PG8_MMA(1, 0, At, B0); PG8_MMA(1, 1, At, B1); PG8_BAR; PG8_SCHED;
            PG8_LDB(B0, 1, 0); PG8_LDB(B1, 1, 1); PG8_SCHED; PG8_LDA(At, 1, 0); PG8_STAGE(PG8_SA(0, 1), a2 + hstep, voffA);
            PG8_WAIT_V(8); PG8_WAIT_L(0); PG8_BAR; PG8_MMA(0, 0, At, B0); PG8_MMA(0, 1, At, B1); PG8_BAR; PG8_SCHED;
            PG8_LDA(At, 1, 1); PG8_STAGE(PG8_SB(1, 0), b3, voffB); PG8_STAGE(PG8_SB(1, 1), b3 + hstep, voffB); PG8_STAGE(PG8_SA(1, 0), a3, voffA);
            PG8_WAIT_V(8); PG8_WAIT_L(0); PG8_BAR; PG8_MMA(1, 0, At, B0); PG8_MMA(1, 1, At, B1); PG8_BAR; PG8_SCHED;
            } else {
            PG8_LDB(B0, 0, 0); PG8_SCHED; PG8_LDA(At, 0, 0); PG8_STAGE(PG8_SA(1, 1), a1 + hstep, voffA);
            PG8_WAIT_L(8); PG8_BAR; PG8_WAIT_L(0); PG8_MMA(0, 0, At, B0); PG8_BAR; PG8_SCHED;
            PG8_LDB(B1, 0, 1); PG8_STAGE(PG8_SB(0, 0), b2, voffB);
            PG8_BAR; PG8_WAIT_L(0); PG8_MMA(0, 1, At, B1); PG8_BAR;
            PG8_LDA(At, 0, 1); PG8_STAGE(PG8_SA(0, 0), a2, voffA);
            PG8_BAR; PG8_WAIT_L(0); PG8_MMA(1, 0, At, B0); PG8_BAR; PG8_SCHED;
            PG8_STAGE(PG8_SB(0, 1), b2 + hstep, voffB);
            PG8_WAIT_V(6); PG8_BAR; PG8_MMA(1, 1, At, B1); PG8_BAR;
            PG8_LDB(B0, 1, 0); PG8_SCHED; PG8_LDA(At, 1, 0); PG8_STAGE(PG8_SA(0, 1), a2 + hstep, voffA);
            PG8_WAIT_L(8); PG8_BAR; PG8_WAIT_L(0); PG8_MMA(0, 0, At, B0); PG8_BAR; PG8_SCHED;
            PG8_LDB(B1, 1, 1); PG8_STAGE(PG8_SB(1, 0), b3, voffB);
            PG8_BAR; PG8_WAIT_L(0); PG8_MMA(0, 1, At, B1); PG8_BAR;
            PG8_LDA(At, 1, 1); PG8_STAGE(PG8_SA(1, 0), a3, voffA);
            PG8_BAR; PG8_WAIT_L(0); PG8_MMA(1, 0, At, B0); PG8_BAR; PG8_SCHED;
            PG8_STAGE(PG8_SB(1, 1), b3 + hstep, voffB);
            PG8_WAIT_V(6); PG8_BAR; PG8_MMA(1, 1, At, B1); PG8_BAR;
            }
        }
        if constexpr (ALIGN_EPI) { if (wr == 0) PG8_BAR; }
        if constexpr (!Epi::AFTER_DRAIN) { E(acc, cur, wr, wc, fr, fq); S.done(cur); }
        if (!has_next) break;
#pragma unroll
        for (int a = 0; a < 2; ++a)
#pragma unroll
            for (int b = 0; b < 2; ++b)
#pragma unroll
                for (int m = 0; m < 4; ++m)
#pragma unroll
                    for (int n = 0; n < 2; ++n) acc[a][b][m][n] = (f32x4){0.f, 0.f, 0.f, 0.f};
        cur = nxt; cA = nA; cB = nB; ++ui;
        if constexpr (ALIGN_EPI) { if (wr == 1) PG8_BAR; }
    }
    PG8_WAIT_V(0);
    if constexpr (!ALIGN_EPI) { if (wr == 0) PG8_BAR; }
    PG8_BAR;
    if constexpr (Epi::AFTER_DRAIN) { E.fused(acc, cur, wr, wc, fr, fq, lds, wid, lane); S.done(cur); }
#undef PG8_SA
#undef PG8_SB
#undef PG8_STAGE
#undef PG8_LDA
#undef PG8_LDB
#undef PG8_MMA
#undef PG8_WAIT_V
#undef PG8_WAIT_L
#undef PG8_BAR
#undef PG8_SCHED
}
}

DEV void phase_inproj(const Params& p, int l, int hf, unsigned char* smem) {
  pg8::Gemm g{(const bf16_t*)(p.ws + OFF_XB) + (size_t)hf * TH * DM, (const bf16_t*)(p.ws + OFF_WIN), TH, NPAD, DM};
  pg8::XcdOrder S; S.init(TH, NPAD);
  pg8::EpiIn E{(bf16_t*)(p.ws + OFF_H), NPAD, (float*)(p.ws + OFF_SMALL), SM0 / 256};
  pg8::gemm_phase<pg8::EpiIn, pg8::XcdOrder, true, true>((PG8_LAS unsigned char*)smem, g, S, E);
}

DEV void phase_outproj(const Params& p, int l, int hf, unsigned char* smem) {
  pg8::Gemm g{(const bf16_t*)(p.ws + OFF_MIXED), (const bf16_t*)(p.ws + OFF_WOUT), TH, DM, DI};
  pg8::XcdOrder S; S.init(TH, DM);
  const float* xin = ((l == 0) ? p.x : p.out) + (size_t)hf * TH * DM;
  pg8::EpiOut E{xin, p.out + (size_t)hf * TH * DM, DM, DN_ALPHA};
  pg8::gemm_phase<pg8::EpiOut, pg8::XcdOrder, true, true>((PG8_LAS unsigned char*)smem, g, S, E);
}

DEV void phase_ln(const Params& p, int l, int hf) {
  const int tid = launder(threadIdx.x), lane = tid & 63, w = tid >> 6;
  const float* g = p.ln_g + l * DM; const float* b = p.ln_b + l * DM;
  bf16_t* xb = (bf16_t*)(p.ws + OFF_XB);
  for (int r = blockIdx.x * 8 + w; r < TH; r += gridDim.x * 8) {
    const int row = hf * TH + r;
    float4* rp = (float4*)(p.out + (size_t)row * DM);
    float4 v[4];
    float s = 0.f;
#pragma unroll
    for (int j = 0; j < 4; ++j) { v[j] = rp[j * 64 + lane]; s += (v[j].x + v[j].y) + (v[j].z + v[j].w); }
#pragma unroll
    for (int o = 32; o >= 1; o >>= 1) s += __shfl_xor(s, o);
    const float mu = s * (1.f / DM);
    float q = 0.f;
#pragma unroll
    for (int j = 0; j < 4; ++j) { const float a = v[j].x - mu, bb = v[j].y - mu, cc = v[j].z - mu, d = v[j].w - mu; q += (a * a + bb * bb) + (cc * cc + d * d); }
#pragma unroll
    for (int o = 32; o >= 1; o >>= 1) q += __shfl_xor(q, o);
    const float rstd = rsqrtf(q * (1.f / DM) + 1e-5f);
#pragma unroll
    for (int j = 0; j < 4; ++j) {
      const int col = (j * 64 + lane) * 4;
      const float4 gg = *(const float4*)(g + col), bb = *(const float4*)(b + col);
      float4 o;
      o.x = (v[j].x - mu) * rstd * gg.x + bb.x; o.y = (v[j].y - mu) * rstd * gg.y + bb.y;
      o.z = (v[j].z - mu) * rstd * gg.z + bb.z; o.w = (v[j].w - mu) * rstd * gg.w + bb.w;
      rp[j * 64 + lane] = o;
      if (l == 0) { uint2 pk; pk.x = pk2(o.x, o.y); pk.y = pk2(o.z, o.w); *(uint2*)(xb + (size_t)row * DM + col) = pk; }
    }
  }
}

DEV void attn_item(const Params& p, int l, int item, unsigned char* smem) {
  const int tid = launder(threadIdx.x), lane = tid & 63, w = tid >> 6, r = lane & 31, h = lane >> 5;
  const int qt = item & 15, head = (item >> 4) & 7, bl = item >> 7;
  const int kvh = head >> 2;
  bf16_t* Hh = (bf16_t*)(p.ws + OFF_H);
  const bf16_t* VT = (const bf16_t*)(p.ws + OFF_VT);
  const size_t rowbase = (size_t)bl * SEQ;
  float mq = fabsf(p.q_gain[l * 64 + lane]), mk = fabsf(p.k_gain[l * 64 + lane]);
#pragma unroll
  for (int o = 32; o >= 1; o >>= 1) { mq = fmaxf(mq, __shfl_xor(mq, o)); mk = fmaxf(mk, __shfl_xor(mk, o)); }
  const float M2 = 8.f * mq * mk * LOG2E * 1.01f;
  const int qrow = qt * 256 + w * 32 + r;
  const bf16_t* qp = Hh + (rowbase + qrow) * NPAD + A_Q + head * 64 + 8 * h;
  bf16x8 qf[4];
#pragma unroll
  for (int ks = 0; ks < 4; ++ks) qf[ks] = *(const bf16x8*)(qp + ks * 16);
  f32x16 o0 = zero16(), o1 = zero16();
  float lsum = 0.f;
  const int srow = tid >> 3, sch = (tid & 7) * 8;
  const bf16_t* kp = Hh + (rowbase + srow) * NPAD + A_K + kvh * 64 + sch;
  const bf16_t* vp = VT + ((size_t)((bl * 2 + kvh) * 64 + srow)) * SEQ + sch;
  auto compute = [&](int st) __attribute__((always_inline)) {
    const bf16_t* sK = (const bf16_t*)(smem + st * 18432);
    const bf16_t* sV = (const bf16_t*)(smem + st * 18432 + 9216);
    f32x16 s0 = zero16(), s1 = zero16();
#pragma unroll
    for (int ks = 0; ks < 4; ++ks) {
      const bf16x8 a0 = *(const bf16x8*)(sK + r * 72 + ks * 16 + 8 * h);
      const bf16x8 a1 = *(const bf16x8*)(sK + (32 + r) * 72 + ks * 16 + 8 * h);
      s0 = __builtin_amdgcn_mfma_f32_32x32x16_bf16(a0, qf[ks], s0, 0, 0, 0);
      s1 = __builtin_amdgcn_mfma_f32_32x32x16_bf16(a1, qf[ks], s1, 0, 0, 0);
    }
#pragma unroll
    for (int i = 0; i < 16; ++i) { s0[i] = __builtin_amdgcn_exp2f(s0[i] - M2); s1[i] = __builtin_amdgcn_exp2f(s1[i] - M2); lsum += s0[i] + s1[i]; }
    union { bf16x8 v; unsigned u[4]; } pb[2][2];
#pragma unroll
    for (int s = 0; s < 2; ++s)
#pragma unroll
      for (int j = 0; j < 4; ++j) {
        pb[0][s].u[j] = pk2(s0[8 * s + 2 * j], s0[8 * s + 2 * j + 1]);
        pb[1][s].u[j] = pk2(s1[8 * s + 2 * j], s1[8 * s + 2 * j + 1]);
      }
#pragma unroll
    for (int kt2 = 0; kt2 < 2; ++kt2)
#pragma unroll
      for (int s = 0; s < 2; ++s) {
        const int kb = kt2 * 32 + 16 * s + 4 * h;
        union { bf16x8 v; uint2 u[2]; } a0, a1;
        a0.u[0] = *(const uint2*)(sV + r * 72 + kb); a0.u[1] = *(const uint2*)(sV + r * 72 + kb + 8);
        a1.u[0] = *(const uint2*)(sV + (32 + r) * 72 + kb); a1.u[1] = *(const uint2*)(sV + (32 + r) * 72 + kb + 8);
        o0 = __builtin_amdgcn_mfma_f32_32x32x16_bf16(a0.v, pb[kt2][s].v, o0, 0, 0, 0);
        o1 = __builtin_amdgcn_mfma_f32_32x32x16_bf16(a1.v, pb[kt2][s].v, o1, 0, 0, 0);
      }
  };
  constexpr int NKT = SEQ / 64;
  u32x4 k0 = *(const u32x4*)kp, v0 = *(const u32x4*)vp;
  u32x4 k1 = *(const u32x4*)(kp + (size_t)64 * NPAD), v1 = *(const u32x4*)(vp + 64);
  *(u32x4*)(smem + srow * 144 + sch * 2) = k0;
  *(u32x4*)(smem + 9216 + srow * 144 + sch * 2) = v0;
  k0 = *(const u32x4*)(kp + (size_t)2 * 64 * NPAD); v0 = *(const u32x4*)(vp + 2 * 64);
  __syncthreads();
  for (int kt = 0; kt < NKT; kt += 2) {
    *(u32x4*)(smem + 18432 + srow * 144 + sch * 2) = k1;
    *(u32x4*)(smem + 18432 + 9216 + srow * 144 + sch * 2) = v1;
    if (kt + 3 < NKT) { k1 = *(const u32x4*)(kp + (size_t)(kt + 3) * 64 * NPAD); v1 = *(const u32x4*)(vp + (kt + 3) * 64); }
    compute(0);
    __syncthreads();
    if (kt + 2 < NKT) {
      *(u32x4*)(smem + srow * 144 + sch * 2) = k0;
      *(u32x4*)(smem + 9216 + srow * 144 + sch * 2) = v0;
      if (kt + 4 < NKT) { k0 = *(const u32x4*)(kp + (size_t)(kt + 4) * 64 * NPAD); v0 = *(const u32x4*)(vp + (kt + 4) * 64); }
    }
    compute(1);
    __syncthreads();
  }
  lsum += __shfl_xor(lsum, 32);
  const float inv = 1.f / lsum;
  const bf16_t* zp = Hh + (rowbase + qrow) * NPAD + A_Z + head * 64;
  bf16_t* op = Hh + (rowbase + qrow) * NPAD + A_Q + head * 64;
#pragma unroll
  for (int dt = 0; dt < 2; ++dt)
#pragma unroll
    for (int g = 0; g < 4; ++g) {
      const int d0 = dt * 32 + 8 * g + 4 * h;
      const uint2 zz = *(const uint2*)(zp + d0);
      const float z0 = bf2f((bf16_t)(zz.x & 0xffff)), z1 = bf2f((bf16_t)(zz.x >> 16)), z2 = bf2f((bf16_t)(zz.y & 0xffff)), z3 = bf2f((bf16_t)(zz.y >> 16));
      const f32x16& oo = dt ? o1 : o0;
      uint2 ov;
      ov.x = pk2(oo[4 * g + 0] * inv * fsilu(z0), oo[4 * g + 1] * inv * fsilu(z1));
      ov.y = pk2(oo[4 * g + 2] * inv * fsilu(z2), oo[4 * g + 3] * inv * fsilu(z3));
      *(uint2*)(op + d0) = ov;
    }
  __syncthreads();
}

constexpr int L_QT = 0, L_KT = 17408, L_QC = 34816, L_KHT = 52224, L_VT = 70656, L_P = 89088, L_ST = 98304, L_RAW = 89088,
              L_D = 138240, L_TOT = 138752, L_ACS = 142848, L_DT = 143104, L_LOW = 143360;

template <int K, int V> struct ScanGeom {
  static constexpr int KP = K + 8;
  static constexpr int NS = (K / 32) * (V / 32) / 8;
};

template <int K, int V>
DEV void scan_write_state(unsigned char* smem, const f32x16* S, int w, int lane) {
  constexpr int KP = K + 8, NS = ScanGeom<K, V>::NS, NVT = V / 32;
  bf16_t* sST = (bf16_t*)(smem + L_ST);
  const int c = lane & 31, h = lane >> 5;
#pragma unroll
  for (int i = 0; i < NS; ++i) {
    const int tile = w * NS + i, kt = tile / NVT, nt = tile % NVT;
#pragma unroll
    for (int g = 0; g < 4; ++g) {
      uint2 o; o.x = pk2(S[i][4 * g + 0], S[i][4 * g + 1]); o.y = pk2(S[i][4 * g + 2], S[i][4 * g + 3]);
      *(uint2*)(sST + (nt * 32 + c) * KP + kt * 32 + 8 * g + 4 * h) = o;
    }
  }
}

template <int K, int V, bool SSDM>
DEV void scan_core(unsigned char* smem, f32x16* S, bf16_t* orow0, int dir, int w, int lane, bool do_out) {
  constexpr int KP = K + 8, NS = ScanGeom<K, V>::NS, NVT = V / 32, NOT = 2 * NVT;
  const bf16_t* sQt = (const bf16_t*)(smem + L_QT); const bf16_t* sKt = (const bf16_t*)(smem + L_KT);
  const bf16_t* sQc = (const bf16_t*)(smem + L_QC); const bf16_t* sKhT = (const bf16_t*)(smem + L_KHT);
  const bf16_t* sVT = (const bf16_t*)(smem + L_VT); bf16_t* sP = (bf16_t*)(smem + L_P);
  const bf16_t* sST = (const bf16_t*)(smem + L_ST); const float* sD = (const float*)(smem + L_D);
  const float* sAcs = (const float*)(smem + L_ACS);
  const int c = lane & 31, h = lane >> 5;
  if (do_out) scan_write_state<K, V>(smem, S, w, lane);
  if (do_out && w < 4) {
    const int tt = w >> 1, st = w & 1;
    f32x16 acc = zero16();
    if (st <= tt) mma32<K>(acc, sQt + tt * 32 * KP, KP, sKt + st * 32 * KP, KP, lane);
#pragma unroll
    for (int reg = 0; reg < 16; ++reg) {
      const int tau = tt * 32 + rowoff(reg, h), sig = st * 32 + c;
      float v = 0.f;
      if (sig <= tau) { v = acc[reg]; if (SSDM) v *= ex2(sAcs[tau] - sAcs[sig]); }
      sP[tau * 72 + sig] = f2bf(v);
    }
  }
  __syncthreads();
  if (do_out && w < NOT) {
    const int tt = w / NVT, nt = w % NVT;
    f32x16 acc = zero16();
    mma32<64>(acc, sP + tt * 32 * 72, 72, sVT + nt * 32 * 72, 72, lane);
    mma32<K>(acc, sQc + tt * 32 * KP, KP, sST + nt * 32 * KP, KP, lane);
#pragma unroll
    for (int reg = 0; reg < 16; ++reg) {
      const int tau = tt * 32 + rowoff(reg, h);
      const int tok = dir ? (63 - tau) : tau;
      orow0[(size_t)tok * 512 + nt * 32 + c] = f2bf(acc[reg]);
    }
  }
#pragma unroll
  for (int i = 0; i < NS; ++i) {
    const int tile = w * NS + i, kt = tile / NVT, nt = tile % NVT;
#pragma unroll
    for (int reg = 0; reg < 16; ++reg) S[i][reg] *= sD[kt * 32 + rowoff(reg, h)];
    mma32<64>(S[i], sKhT + kt * 32 * 72, 72, sVT + nt * 32 * 72, 72, lane);
  }
  __syncthreads();
}

template <int K, int V>
DEV void state_store(float* buf, const f32x16* S, int w, int lane) {
  constexpr int NS = ScanGeom<K, V>::NS, NVT = V / 32;
  const int c = lane & 31, h = lane >> 5;
#pragma unroll
  for (int i = 0; i < NS; ++i) {
    const int tile = w * NS + i, kt = tile / NVT, nt = tile % NVT;
#pragma unroll
    for (int reg = 0; reg < 16; ++reg) buf[(kt * 32 + rowoff(reg, h)) * V + nt * 32 + c] = S[i][reg];
  }
}
template <int K, int V>
DEV void state_load(const float* buf, f32x16* S, int w, int lane) {
  constexpr int NS = ScanGeom<K, V>::NS, NVT = V / 32;
  const int c = lane & 31, h = lane >> 5;
#pragma unroll
  for (int i = 0; i < NS; ++i) {
    const int tile = w * NS + i, kt = tile / NVT, nt = tile % NVT;
#pragma unroll
    for (int reg = 0; reg < 16; ++reg) S[i][reg] = buf[(kt * 32 + rowoff(reg, h)) * V + nt * 32 + c];
  }
}

DEV void store16(bf16_t* dst, const float* v) {
  uint4 a, b;
  a.x = pk2(v[0], v[1]); a.y = pk2(v[2], v[3]); a.z = pk2(v[4], v[5]); a.w = pk2(v[6], v[7]);
  b.x = pk2(v[8], v[9]); b.y = pk2(v[10], v[11]); b.z = pk2(v[12], v[13]); b.w = pk2(v[14], v[15]);
  ((uint4*)dst)[0] = a; ((uint4*)dst)[1] = b;
}
DEV void gather16(bf16_t* dst, const bf16_t* src, int stride) {
  unsigned u[8];
#pragma unroll
  for (int i = 0; i < 8; ++i) u[i] = (unsigned)src[(2 * i) * stride] | ((unsigned)src[(2 * i + 1) * stride] << 16);
  ((uint4*)dst)[0] = make_uint4(u[0], u[1], u[2], u[3]); ((uint4*)dst)[1] = make_uint4(u[4], u[5], u[6], u[7]);
}

DEV void hgrn_item(const Params& p, int l, int it, int seg, int mode, unsigned char* smem) {
  const int bl = it >> 3, head = (it >> 1) & 3, dir = it & 1;
  const bool do_out = (mode == 3);
  constexpr int K = 128, V = 128, KP = 136, KPW = 68;
  const int tid = launder(threadIdx.x), lane = tid & 63, w = tid >> 6;
  const int cp = tid & 63, tg = tid >> 6, ch0 = 2 * cp;
  const bf16_t* Hh = (const bf16_t*)(p.ws + OFF_H);
  bf16_t* OB = (bf16_t*)(p.ws + OFF_OBUF) + (size_t)(0 * 2 + dir) * TH * 512;
  const size_t rowbase = (size_t)bl * SEQ;
  float lb0 = 0.f, lb1 = 0.f;
  if (l > 0) {
    lb0 = fsigmoid(p.lb_logits[512 + head * 128 + ch0] - p.lb_logits[head * 128 + ch0]);
    lb1 = fsigmoid(p.lb_logits[512 + head * 128 + ch0 + 1] - p.lb_logits[head * 128 + ch0 + 1]);
  }
  const float om0 = 1.f - lb0, om1 = 1.f - lb1;
  const int fbase = dir ? H_FB : H_FF;
  unsigned* sQt = (unsigned*)(smem + L_QT); unsigned* sKt = (unsigned*)(smem + L_KT); unsigned* sQc = (unsigned*)(smem + L_QC);
  bf16_t* sKhT = (bf16_t*)(smem + L_KHT); bf16_t* sVT = (bf16_t*)(smem + L_VT);
  float* sD = (float*)(smem + L_D); float* sTot = (float*)(smem + L_TOT);
  const unsigned* rawQ = (const unsigned*)(smem + L_RAW); const unsigned* rawF = rawQ + 4096; const unsigned* rawV = rawQ + 8192;
  f32x16 S[2]; S[0] = zero16(); S[1] = zero16();
  float* sbuf = (float*)(p.ws + OFF_SB0) + ((size_t)it * NSEG + seg) * 16384;
  if (do_out) state_load<K, V>(sbuf, S, w, lane);
  float dlog0 = 0.f, dlog1 = 0.f;
  u32x4 pre[6];
  const int prow0 = tid >> 4, pc16 = (tid & 15) * 8;
  auto gload = [&](int cidx) __attribute__((always_inline)) {
    const int chunk = dir ? (63 - cidx) : cidx;
#pragma unroll
    for (int j = 0; j < 2; ++j) {
      const int row = prow0 + 32 * j;
      const int tok = chunk * 64 + (dir ? (63 - row) : row);
      const bf16_t* rp = Hh + (rowbase + tok) * NPAD + head * 128 + pc16;
      if (do_out) pre[j] = *(const u32x4*)(rp + H_Q);
      pre[2 + j] = *(const u32x4*)(rp + fbase); pre[4 + j] = *(const u32x4*)(rp + H_I);
    }
  };
  gload(seg * SLEN);
  for (int ci = 0; ci < SLEN; ++ci) {
    const int cidx = seg * SLEN + ci;
    const int chunk = dir ? (63 - cidx) : cidx;
#pragma unroll
    for (int j = 0; j < 2; ++j) {
      unsigned char* d = smem + L_RAW + (prow0 + 32 * j) * 256 + pc16 * 2;
      if (do_out) *(u32x4*)d = pre[j];
      *(u32x4*)(d + 16384) = pre[2 + j]; *(u32x4*)(d + 32768) = pre[4 + j];
    }
    __syncthreads();
    if (ci + 1 < SLEN) gload(cidx + 1);
    float r0 = 0.f, r1 = 0.f;
#pragma unroll
    for (int i = 0; i < 8; ++i) {
      const unsigned u = rawF[(8 * tg + i) * 64 + cp];
      const float e0 = ex2(fminf(-lo16(u) * LOG2E, 80.f)), e1 = ex2(fminf(-hi16(u) * LOG2E, 80.f));
      r0 += lg2(lb0 + om0 * frcp(1.f + e0)); r1 += lg2(lb1 + om1 * frcp(1.f + e1));
    }
    *(float2*)(sTot + tg * 128 + ch0) = make_float2(r0, r1);
    __syncthreads();
    float off0 = 0.f, off1 = 0.f, ref0 = 0.f, ref1 = 0.f, be0 = 0.f, be1 = 0.f;
#pragma unroll
    for (int j = 0; j < 8; ++j) {
      const float2 t = *(const float2*)(sTot + j * 128 + ch0);
      if (j < tg) { off0 += t.x; off1 += t.y; }
      if (j < 4) { ref0 += t.x; ref1 += t.y; }
      be0 += t.x; be1 += t.y;
    }
    dlog0 += be0; dlog1 += be1;
    const float eref0 = ex2(ref0), eref1 = ex2(ref1), ebr0 = ex2(be0 - ref0), ebr1 = ex2(be1 - ref1);
    float b0 = off0, b1 = off1;
    float kh0[8], kh1[8]; unsigned vv[8];
#pragma unroll
    for (int i = 0; i < 8; ++i) {
      const int tau = 8 * tg + i;
      const unsigned u = rawF[tau * 64 + cp];
      const float e0 = ex2(fminf(-lo16(u) * LOG2E, 80.f)), e1 = ex2(fminf(-hi16(u) * LOG2E, 80.f));
      const float s0 = frcp(1.f + e0), s1 = frcp(1.f + e1);
      b0 += lg2(lb0 + om0 * s0); b1 += lg2(lb1 + om1 * s1);
      const float kx0 = om0 * e0 * s0, kx1 = om1 * e1 * s1;
      const float E0 = ex2(b0 - ref0), E1 = ex2(b1 - ref1);
      const float kt0 = kx0 * frcp(E0), kt1 = kx1 * frcp(E1);
      if (do_out) {
        const unsigned uq = rawQ[tau * 64 + cp];
        const float q0 = lo16(uq), q1 = hi16(uq);
        const float qx0 = q0 * frcp(1.f + ex2(fminf(-q0 * LOG2E, 80.f))) * 0.08838834764831845f;
        const float qx1 = q1 * frcp(1.f + ex2(fminf(-q1 * LOG2E, 80.f))) * 0.08838834764831845f;
        const float qt0 = qx0 * E0, qt1 = qx1 * E1;
        sQt[tau * KPW + cp] = cvtpk(qt0, qt1);
        sKt[tau * KPW + cp] = cvtpk(kt0, kt1);
        sQc[tau * KPW + cp] = cvtpk(qt0 * eref0, qt1 * eref1);
      }
      kh0[i] = kt0 * ebr0; kh1[i] = kt1 * ebr1;
      vv[i] = rawV[tau * 64 + cp];
    }
    *(u32x4*)(sKhT + ch0 * 72 + 8 * tg) = (u32x4){cvtpk(kh0[0], kh0[1]), cvtpk(kh0[2], kh0[3]), cvtpk(kh0[4], kh0[5]), cvtpk(kh0[6], kh0[7])};
    *(u32x4*)(sKhT + (ch0 + 1) * 72 + 8 * tg) = (u32x4){cvtpk(kh1[0], kh1[1]), cvtpk(kh1[2], kh1[3]), cvtpk(kh1[4], kh1[5]), cvtpk(kh1[6], kh1[7])};
    *(u32x4*)(sVT + ch0 * 72 + 8 * tg) = (u32x4){(vv[0] & 0xffffu) | (vv[1] << 16), (vv[2] & 0xffffu) | (vv[3] << 16), (vv[4] & 0xffffu) | (vv[5] << 16), (vv[6] & 0xffffu) | (vv[7] << 16)};
    *(u32x4*)(sVT + (ch0 + 1) * 72 + 8 * tg) = (u32x4){(vv[0] >> 16) | (vv[1] & 0xffff0000u), (vv[2] >> 16) | (vv[3] & 0xffff0000u), (vv[4] >> 16) | (vv[5] & 0xffff0000u), (vv[6] >> 16) | (vv[7] & 0xffff0000u)};
    if (tg == 0) *(float2*)(sD + ch0) = make_float2(ex2(be0), ex2(be1));
    __syncthreads();
    scan_core<K, V, false>(smem, S, OB + (rowbase + (size_t)chunk * 64) * 512 + head * 128, dir, w, lane, do_out);
  }
  if (!do_out) {
    state_store<K, V>(sbuf, S, w, lane);
    if (tg == 0) *(float2*)((float*)(p.ws + OFF_DB) + ((size_t)it * NSEG + seg) * 128 + ch0) = make_float2(ex2(dlog0), ex2(dlog1));
  }
}

DEV void gla_item(const Params& p, int l, int it, int seg, int mode, unsigned char* smem) {
  const int j16 = it - 16, bl = j16 >> 3, head = (j16 >> 1) & 3, dir = j16 & 1;
  const bool do_out = (mode == 3);
  constexpr int K = 64, V = 128, KP = 72, KPW = 36;
  const int tid = launder(threadIdx.x), lane = tid & 63, w = tid >> 6;
  const int cp = tid & 31, tg = tid >> 5, ch0 = 2 * cp;
  const int vp2 = tid & 63, vg = tid >> 6;
  const bf16_t* Hh = (const bf16_t*)(p.ws + OFF_H);
  const float* SMALL = (const float*)(p.ws + OFF_SMALL);
  bf16_t* OB = (bf16_t*)(p.ws + OFF_OBUF) + (size_t)(2 * 2 + dir) * TH * 512;
  const size_t rowbase = (size_t)bl * SEQ;
  unsigned* sQt = (unsigned*)(smem + L_QT); unsigned* sKt = (unsigned*)(smem + L_KT); unsigned* sQc = (unsigned*)(smem + L_QC);
  bf16_t* sKhT = (bf16_t*)(smem + L_KHT); bf16_t* sVT = (bf16_t*)(smem + L_VT);
  float* sD = (float*)(smem + L_D); float* sTot = (float*)(smem + L_TOT); float* sLow = (float*)(smem + L_LOW);
  const unsigned* rawQ = (const unsigned*)(smem + L_RAW); const unsigned* rawK = rawQ + 2048; const unsigned* rawV = rawQ + 4096;
  float* sG = (float*)(smem + L_RAW + 32768);
  float w2a[16], w2b[16];
#pragma unroll
  for (int r = 0; r < 16; ++r) {
    const float* wp = p.gk_w2 + ((size_t)(l * 2 + dir) * 16 + r) * 256 + head * 64 + ch0;
    w2a[r] = wp[0]; w2b[r] = wp[1];
  }
  const float gb0 = p.gk_b[(l * 2 + dir) * 256 + head * 64 + ch0], gb1 = p.gk_b[(l * 2 + dir) * 256 + head * 64 + ch0 + 1];
  f32x16 S[1]; S[0] = zero16();
  float* sbuf = (float*)(p.ws + OFF_SB1) + ((size_t)j16 * NSEG + seg) * 8192;
  if (do_out) state_load<K, V>(sbuf, S, w, lane);
  float dlog0 = 0.f, dlog1 = 0.f;
  u32x4 pre[4];
  float plow0, plow1;
  const int qrow = tid >> 3, qc8 = (tid & 7) * 8, vrow0 = tid >> 4, vc16 = (tid & 15) * 8;
  auto gload = [&](int cidx) __attribute__((always_inline)) {
    const int chunk = dir ? (63 - cidx) : cidx;
    {
      const int tok = chunk * 64 + (dir ? (63 - qrow) : qrow);
      const bf16_t* rp = Hh + (rowbase + tok) * NPAD + head * 64 + qc8;
      if (do_out) pre[0] = *(const u32x4*)(rp + G_Q);
      pre[1] = *(const u32x4*)(rp + G_K);
      const float* lp = SMALL + (rowbase + tok) * 48 + 16 + dir * 16 + (tid & 7) * 2; plow0 = lp[0]; plow1 = lp[1];
    }
#pragma unroll
    for (int j = 0; j < 2; ++j) {
      const int row = vrow0 + 32 * j;
      const int tok = chunk * 64 + (dir ? (63 - row) : row);
      pre[2 + j] = *(const u32x4*)(Hh + (rowbase + tok) * NPAD + G_V + head * 128 + vc16);
    }
  };
  gload(seg * SLEN);
  for (int ci = 0; ci < SLEN; ++ci) {
    const int cidx = seg * SLEN + ci;
    const int chunk = dir ? (63 - cidx) : cidx;
    {
      unsigned char* d = smem + L_RAW + qrow * 128 + qc8 * 2;
      if (do_out) *(u32x4*)d = pre[0];
      *(u32x4*)(d + 8192) = pre[1];
      sLow[qrow * 16 + (tid & 7) * 2] = plow0; sLow[qrow * 16 + (tid & 7) * 2 + 1] = plow1;
#pragma unroll
      for (int j = 0; j < 2; ++j) *(u32x4*)(smem + L_RAW + 16384 + (vrow0 + 32 * j) * 256 + vc16 * 2) = pre[2 + j];
    }
    __syncthreads();
    if (ci + 1 < SLEN) gload(cidx + 1);
    float r0 = 0.f, r1 = 0.f;
#pragma unroll
    for (int i = 0; i < 4; ++i) {
      const int tau = 4 * tg + i;
      float g0 = gb0, g1 = gb1;
#pragma unroll
      for (int r4 = 0; r4 < 4; ++r4) {
        const float4 lw = *(const float4*)(sLow + tau * 16 + 4 * r4);
        g0 += lw.x * w2a[4 * r4] + lw.y * w2a[4 * r4 + 1] + lw.z * w2a[4 * r4 + 2] + lw.w * w2a[4 * r4 + 3];
        g1 += lw.x * w2b[4 * r4] + lw.y * w2b[4 * r4 + 1] + lw.z * w2b[4 * r4 + 2] + lw.w * w2b[4 * r4 + 3];
      }
      const float l0 = (fminf(g0, 0.f) * LOG2E - lg2(1.f + ex2(-fabsf(g0) * LOG2E))) * (1.f / 16.f);
      const float l1 = (fminf(g1, 0.f) * LOG2E - lg2(1.f + ex2(-fabsf(g1) * LOG2E))) * (1.f / 16.f);
      *(float2*)(sG + tau * 64 + ch0) = make_float2(l0, l1);
      r0 += l0; r1 += l1;
    }
    *(float2*)(sTot + tg * 64 + ch0) = make_float2(r0, r1);
    __syncthreads();
    float off0 = 0.f, off1 = 0.f, ref0 = 0.f, ref1 = 0.f, be0 = 0.f, be1 = 0.f;
#pragma unroll
    for (int j = 0; j < 16; ++j) {
      const float2 t = *(const float2*)(sTot + j * 64 + ch0);
      if (j < tg) { off0 += t.x; off1 += t.y; }
      if (j < 8) { ref0 += t.x; ref1 += t.y; }
      be0 += t.x; be1 += t.y;
    }
    dlog0 += be0; dlog1 += be1;
    const float eref0 = ex2(ref0), eref1 = ex2(ref1), ebr0 = ex2(be0 - ref0), ebr1 = ex2(be1 - ref1);
    float b0 = off0, b1 = off1;
    float kh0[4], kh1[4];
#pragma unroll
    for (int i = 0; i < 4; ++i) {
      const int tau = 4 * tg + i;
      const float2 gg = *(const float2*)(sG + tau * 64 + ch0);
      b0 += gg.x; b1 += gg.y;
      const float E0 = ex2(b0 - ref0), E1 = ex2(b1 - ref1);
      const unsigned uk = rawK[tau * 32 + cp];
      const float kt0 = lo16(uk) * frcp(E0), kt1 = hi16(uk) * frcp(E1);
      if (do_out) {
        const unsigned uq = rawQ[tau * 32 + cp];
        const float qt0 = lo16(uq) * 0.125f * E0, qt1 = hi16(uq) * 0.125f * E1;
        sQt[tau * KPW + cp] = cvtpk(qt0, qt1);
        sKt[tau * KPW + cp] = cvtpk(kt0, kt1);
        sQc[tau * KPW + cp] = cvtpk(qt0 * eref0, qt1 * eref1);
      }
      kh0[i] = kt0 * ebr0; kh1[i] = kt1 * ebr1;
    }
    *(uint2*)(sKhT + ch0 * 72 + 4 * tg) = make_uint2(cvtpk(kh0[0], kh0[1]), cvtpk(kh0[2], kh0[3]));
    *(uint2*)(sKhT + (ch0 + 1) * 72 + 4 * tg) = make_uint2(cvtpk(kh1[0], kh1[1]), cvtpk(kh1[2], kh1[3]));
    {
      unsigned vv[8];
#pragma unroll
      for (int i = 0; i < 8; ++i) vv[i] = rawV[(8 * vg + i) * 64 + vp2];
      *(u32x4*)(sVT + (2 * vp2) * 72 + 8 * vg) = (u32x4){(vv[0] & 0xffffu) | (vv[1] << 16), (vv[2] & 0xffffu) | (vv[3] << 16), (vv[4] & 0xffffu) | (vv[5] << 16), (vv[6] & 0xffffu) | (vv[7] << 16)};
      *(u32x4*)(sVT + (2 * vp2 + 1) * 72 + 8 * vg) = (u32x4){(vv[0] >> 16) | (vv[1] & 0xffff0000u), (vv[2] >> 16) | (vv[3] & 0xffff0000u), (vv[4] >> 16) | (vv[5] & 0xffff0000u), (vv[6] >> 16) | (vv[7] & 0xffff0000u)};
    }
    if (tg == 0) *(float2*)(sD + ch0) = make_float2(ex2(be0), ex2(be1));
    __syncthreads();
    scan_core<K, V, false>(smem, S, OB + (rowbase + (size_t)chunk * 64) * 512 + head * 128, dir, w, lane, do_out);
  }
  if (!do_out) {
    state_store<K, V>(sbuf, S, w, lane);
    if (tg == 0) *(float2*)((float*)(p.ws + OFF_DB) + ((size_t)it * NSEG + seg) * 128 + ch0) = make_float2(ex2(dlog0), ex2(dlog1));
  }
}

DEV void ssd_item(const Params& p, int l, int it, int seg, int mode, unsigned char* smem) {
  const int j32 = it - 32, bl = j32 >> 4, head = (j32 >> 1) & 7, dir = j32 & 1;
  const bool do_out = (mode == 3);
  constexpr int K = 128, V = 64, KP = 136, KPW = 68;
  const int tid = launder(threadIdx.x), lane = tid & 63, w = tid >> 6;
  const int cp = tid & 63, tg = tid >> 6, n0 = 2 * cp;
  const int pp = tid & 63;
  const int grp = head >> 2;
  const bf16_t* U = (const bf16_t*)(p.ws + OFF_U);
  const float* SMALL = (const float*)(p.ws + OFF_SMALL);
  bf16_t* OB = (bf16_t*)(p.ws + OFF_OBUF) + (size_t)(1 * 2 + dir) * TH * 512;
  const size_t rowbase = (size_t)bl * SEQ;
  const unsigned* sQt = (const unsigned*)(smem + L_QT); const unsigned* sKt = (const unsigned*)(smem + L_KT); unsigned* sQc = (unsigned*)(smem + L_QC);
  bf16_t* sKhT = (bf16_t*)(smem + L_KHT); bf16_t* sVT = (bf16_t*)(smem + L_VT);
  float* sD = (float*)(smem + L_D); float* sAcs = (float*)(smem + L_ACS); float* sDt = (float*)(smem + L_DT);
  const bf16_t* rawX = (const bf16_t*)(smem + L_RAW);
  const float dtb = p.dt_bias[(l * 2 + dir) * 8 + head];
  const float Acoef = -__expf(p.a_log[(l * 2 + dir) * 8 + head]) * LOG2E;
  f32x16 S[1]; S[0] = zero16();
  float* sbuf = (float*)(p.ws + OFF_SB2) + ((size_t)j32 * NSEG + seg) * 8192;
  if (do_out) state_load<K, V>(sbuf, S, w, lane);
  float dlog = 0.f;
  u32x4 pre[5];
  float rdt = 0.f;
  const int prow0 = tid >> 4, pc16 = (tid & 15) * 8, xrow = tid >> 3, xc8 = (tid & 7) * 8;
  auto gload = [&](int cidx) __attribute__((always_inline)) {
    const int chunk = dir ? (63 - cidx) : cidx;
#pragma unroll
    for (int j = 0; j < 2; ++j) {
      const int row = prow0 + 32 * j;
      const int tok = chunk * 64 + (dir ? (63 - row) : row);
      const bf16_t* rp = U + (rowbase + tok) * 1024 + grp * 128 + pc16;
      pre[j] = *(const u32x4*)(rp + 512);
      if (do_out) pre[2 + j] = *(const u32x4*)(rp + 768);
    }
    {
      const int tok = chunk * 64 + (dir ? (63 - xrow) : xrow);
      pre[4] = *(const u32x4*)(U + (rowbase + tok) * 1024 + head * 64 + xc8);
    }
    if (w == 0) {
      const int tok = chunk * 64 + (dir ? (63 - lane) : lane);
      rdt = SMALL[(rowbase + tok) * 48 + dir * 8 + head];
    }
  };
  gload(seg * SLEN);
  for (int ci = 0; ci < SLEN; ++ci) {
    const int cidx = seg * SLEN + ci;
    const int chunk = dir ? (63 - cidx) : cidx;
#pragma unroll
    for (int j = 0; j < 2; ++j) {
      const int row = prow0 + 32 * j;
      *(u32x4*)(smem + L_KT + row * (KP * 2) + pc16 * 2) = pre[j];
      if (do_out) *(u32x4*)(smem + L_QT + row * (KP * 2) + pc16 * 2) = pre[2 + j];
    }
    *(u32x4*)(smem + L_RAW + xrow * 128 + xc8 * 2) = pre[4];
    if (w == 0) {
      const float xx = rdt + dtb;
      const float dt = (xx > 20.f) ? xx : log1pf(__expf(xx));
      float a = dt * Acoef;
#pragma unroll
      for (int o = 1; o < 64; o <<= 1) { const float t = __shfl_up(a, o); if (lane >= o) a += t; }
      sAcs[lane] = a; sDt[lane] = dt;
    }
    __syncthreads();
    if (ci + 1 < SLEN) gload(cidx + 1);
    const float aend = sAcs[63];
    dlog += aend;
    {
      float kh0[8], kh1[8];
#pragma unroll
      for (int i = 0; i < 8; ++i) {
        const int tau = 8 * tg + i;
        const float ac = sAcs[tau];
        const unsigned ub = sKt[tau * KPW + cp];
        const float eb = ex2(aend - ac);
        kh0[i] = lo16(ub) * eb; kh1[i] = hi16(ub) * eb;
        if (do_out) {
          const unsigned uc = sQt[tau * KPW + cp];
          const float ea = ex2(ac);
          sQc[tau * KPW + cp] = cvtpk(lo16(uc) * ea, hi16(uc) * ea);
        }
      }
      *(u32x4*)(sKhT + n0 * 72 + 8 * tg) = (u32x4){cvtpk(kh0[0], kh0[1]), cvtpk(kh0[2], kh0[3]), cvtpk(kh0[4], kh0[5]), cvtpk(kh0[6], kh0[7])};
      *(u32x4*)(sKhT + (n0 + 1) * 72 + 8 * tg) = (u32x4){cvtpk(kh1[0], kh1[1]), cvtpk(kh1[2], kh1[3]), cvtpk(kh1[4], kh1[5]), cvtpk(kh1[6], kh1[7])};
      float xv[8];
#pragma unroll
      for (int i = 0; i < 8; ++i) { const int tau = 8 * tg + i; xv[i] = bf2f(rawX[tau * 64 + pp]) * sDt[tau]; }
      *(u32x4*)(sVT + pp * 72 + 8 * tg) = (u32x4){cvtpk(xv[0], xv[1]), cvtpk(xv[2], xv[3]), cvtpk(xv[4], xv[5]), cvtpk(xv[6], xv[7])};
      if (tg == 0) *(float2*)(sD + n0) = make_float2(ex2(aend), ex2(aend));
    }
    __syncthreads();
    scan_core<K, V, true>(smem, S, OB + (rowbase + (size_t)chunk * 64) * 512 + head * 64, dir, w, lane, do_out);
  }
  if (!do_out) {
    state_store<K, V>(sbuf, S, w, lane);
    if (tg == 0) *(float2*)((float*)(p.ws + OFF_DB) + ((size_t)it * NSEG + seg) * 128 + n0) = make_float2(ex2(dlog), ex2(dlog));
  }
}

DEV void phase_prep(const Params& p, int l, int hf, unsigned char* smem) {
  const int tid = launder(threadIdx.x), lane = tid & 63, w = tid >> 6;
  bf16_t* Hh = (bf16_t*)(p.ws + OFF_H);
  {
    const int cg8 = (tid & 127) * 8, rsub = tid >> 7;
    bf16_t* U = (bf16_t*)(p.ws + OFF_U);
    const float* cw = p.conv_w + (size_t)l * 5 * 1024; const float* cb = p.conv_b + (size_t)l * 1024;
    float wv[5][8], bv[8];
#pragma unroll
    for (int j = 0; j < 5; ++j)
#pragma unroll
      for (int e = 0; e < 8; ++e) wv[j][e] = cw[j * 1024 + cg8 + e];
#pragma unroll
    for (int e = 0; e < 8; ++e) bv[e] = cb[cg8 + e];
    for (int r = blockIdx.x * 4 + rsub; r < TH; r += gridDim.x * 4) {
      const int t = r & (SEQ - 1);
      float u[8];
#pragma unroll
      for (int e = 0; e < 8; ++e) u[e] = bv[e];
#pragma unroll
      for (int j = 0; j < 5; ++j) {
        const int s = t + j - 2;
        if (s >= 0 && s < SEQ) {
          const u32x4 x = *(const u32x4*)(Hh + (size_t)(r + j - 2) * NPAD + S_X + cg8);
#pragma unroll
          for (int e = 0; e < 4; ++e) { u[2 * e] += wv[j][2 * e] * lo16(x[e]); u[2 * e + 1] += wv[j][2 * e + 1] * hi16(x[e]); }
        }
      }
      u32x4 o;
#pragma unroll
      for (int e = 0; e < 4; ++e) {
        const float a = u[2 * e] * frcp(1.f + ex2(fminf(-u[2 * e] * LOG2E, 80.f)));
        const float b = u[2 * e + 1] * frcp(1.f + ex2(fminf(-u[2 * e + 1] * LOG2E, 80.f)));
        o[e] = cvtpk(a, b);
      }
      *(u32x4*)(U + (size_t)r * 1024 + cg8) = o;
    }
  }
  {
    const float2* tab = (const float2*)(p.ws + OFF_TAB);
    const int i16 = lane & 15, grp = lane >> 4;
    for (int pq = blockIdx.x * 8 + w; pq < TH * 10 / 4; pq += gridDim.x * 8) {
      const int pi = pq * 4 + grp, row = pi / 10, hd = pi - row * 10;
      const bool isq = hd < 8;
      bf16_t* ptr = Hh + (size_t)row * NPAD + (isq ? (A_Q + hd * 64) : (A_K + (hd - 8) * 64)) + 4 * i16;
      const float* gain = (isq ? p.q_gain : p.k_gain) + l * 64 + 4 * i16;
      const uint2 xr = *(const uint2*)ptr;
      float x[4] = {lo16(xr.x), hi16(xr.x), lo16(xr.y), hi16(xr.y)};
      float ss = x[0] * x[0] + x[1] * x[1] + x[2] * x[2] + x[3] * x[3];
      ss += __shfl_xor(ss, 1); ss += __shfl_xor(ss, 2); ss += __shfl_xor(ss, 4); ss += __shfl_xor(ss, 8);
      const float rstd = rsqrtf(ss * (1.f / 64.f) + 1e-6f);
      const int t = row & (SEQ - 1);
      const int pos = (i16 < 8) ? (t >> 6) : (t & 63);
      const float osc = isq ? QSCALE : 1.f;
      float o[4];
#pragma unroll
      for (int e = 0; e < 4; ++e) {
        const float v = x[e] * rstd * gain[e];
        const float pv = __shfl_xor(v, 4);
        const float2 cs = tab[pos * 16 + 4 * (i16 & 3) + e];
        o[e] = ((i16 & 4) ? (v * cs.x + pv * cs.y) : (v * cs.x - pv * cs.y)) * osc;
      }
      *(uint2*)ptr = make_uint2(cvtpk(o[0], o[1]), cvtpk(o[2], o[3]));
    }
  }
  {
    bf16_t* VT = (bf16_t*)(p.ws + OFF_VT);
    bf16_t* sT = (bf16_t*)smem;
    for (int tile = blockIdx.x; tile < TH / 64; tile += gridDim.x) {
      __syncthreads();
#pragma unroll
      for (int j = 0; j < 2; ++j) {
        const int id = tid + 512 * j, rr = id >> 4, c8 = (id & 15) * 8;
        *(u32x4*)(sT + rr * 136 + c8) = *(const u32x4*)(Hh + (size_t)(tile * 64 + rr) * NPAD + A_V + c8);
      }
      __syncthreads();
      const int c = tid >> 2, tq = (tid & 3) * 16;
      unsigned v[16];
#pragma unroll
      for (int i = 0; i < 16; ++i) v[i] = sT[(tq + i) * 136 + c];
      const int row0 = tile * 64, bl = row0 >> 12, t0 = (row0 & (SEQ - 1)) + tq;
      bf16_t* dst = VT + ((size_t)((bl * 2 + (c >> 6)) * 64 + (c & 63))) * SEQ + t0;
      *(u32x4*)dst = (u32x4){v[0] | (v[1] << 16), v[2] | (v[3] << 16), v[4] | (v[5] << 16), v[6] | (v[7] << 16)};
      *(u32x4*)(dst + 8) = (u32x4){v[8] | (v[9] << 16), v[10] | (v[11] << 16), v[12] | (v[13] << 16), v[14] | (v[15] << 16)};
    }
    __syncthreads();
  }
}

DEV void phase_mix(const Params& p, int l, int hf, int slot, int mode, int att_lo, int att_hi, int vid_lo, int vid_hi, unsigned char* smem) {
  unsigned* ctr = (unsigned*)(p.ws + OFF_CTRL) + CTR_WORD0 + slot * 16;
  volatile int* sItem = (volatile int*)(smem + LDS_BYTES - 16);
  const int n_scan = 64 * NSEG;
  int hi = n_scan + (att_hi - att_lo); if (vid_hi < hi) hi = vid_hi;
  for (;;) {
    __syncthreads();
    if (threadIdx.x == 0) *sItem = vid_lo + (int)atomicAdd(ctr, 1u);
    __syncthreads();
    const int vid = *sItem;
    if (vid >= hi) break;
    if (vid < n_scan) {
      const int seg = vid >> 6, it = vid & 63;
      if (it < 16) { if (PH_MASK & 0x100) hgrn_item(p, l, it, seg, mode, smem); }
      else if (it < 32) { if (PH_MASK & 0x200) gla_item(p, l, it, seg, mode, smem); }
      else { if (PH_MASK & 0x400) ssd_item(p, l, it, seg, mode, smem); }
    } else { if (PH_MASK & 0x800) attn_item(p, l, att_lo + (vid - n_scan), smem); }
  }
}

DEV void phase_scan2(const Params& p) {
  const size_t gtid = (size_t)blockIdx.x * NT + threadIdx.x, gsz = (size_t)gridDim.x * NT;
  const float* DB = (const float*)(p.ws + OFF_DB);
  for (size_t e = gtid; e < 655360; e += gsz) {
    float* buf; const float* dp; int stride;
    if (e < 262144) { const int it = (int)(e >> 14), idx = (int)(e & 16383); buf = (float*)(p.ws + OFF_SB0) + (size_t)it * NSEG * 16384 + idx; stride = 16384; dp = DB + (size_t)it * NSEG * 128 + (idx >> 7); }
    else if (e < 393216) { const int e2 = (int)(e - 262144), j = e2 >> 13, idx = e2 & 8191; buf = (float*)(p.ws + OFF_SB1) + (size_t)j * NSEG * 8192 + idx; stride = 8192; dp = DB + (size_t)(16 + j) * NSEG * 128 + (idx >> 7); }
    else { const int e3 = (int)(e - 393216), j = e3 >> 13, idx = e3 & 8191; buf = (float*)(p.ws + OFF_SB2) + (size_t)j * NSEG * 8192 + idx; stride = 8192; dp = DB + (size_t)(32 + j) * NSEG * 128 + (idx >> 6); }
    float u[NSEG], d[NSEG];
#pragma unroll
    for (int sg = 0; sg < NSEG; ++sg) { u[sg] = buf[(size_t)sg * stride]; d[sg] = dp[sg * 128]; }
    float st = 0.f;
#pragma unroll
    for (int sg = 0; sg < NSEG; ++sg) { buf[(size_t)sg * stride] = st; st = d[sg] * st + u[sg]; }
  }
}

DEV void phase_fin(const Params& p, int l, int hf) {
  const int tid = launder(threadIdx.x), lane = tid & 63, w = tid >> 6;
  const bf16_t* Hh = (const bf16_t*)(p.ws + OFF_H);
  const bf16_t* OB = (const bf16_t*)(p.ws + OFF_OBUF);
  bf16_t* MX = (bf16_t*)(p.ws + OFF_MIXED);
  const int c0 = lane * 8;
  const float* cw = p.conv_w + (size_t)l * 5 * 1024; const float* cb = p.conv_b + (size_t)l * 1024;
  for (int r = blockIdx.x * 8 + w; r < TH; r += gridDim.x * 8) {
    const bf16_t* hrow = Hh + (size_t)r * NPAD;
    *(u32x4*)(MX + (size_t)r * DI + c0) = *(const u32x4*)(hrow + A_Q + c0);
    {
      const uint4 a = *(const uint4*)(OB + ((size_t)0 * TH + r) * 512 + c0), b = *(const uint4*)(OB + ((size_t)1 * TH + r) * 512 + c0);
      const uint4 z = *(const uint4*)(hrow + H_Z + c0);
      const unsigned au[4] = {a.x, a.y, a.z, a.w}, bu[4] = {b.x, b.y, b.z, b.w}, zu[4] = {z.x, z.y, z.z, z.w};
      float o[8]; float ss = 0.f;
#pragma unroll
      for (int j = 0; j < 4; ++j) {
        o[2 * j] = bf2f((bf16_t)(au[j] & 0xffff)) + bf2f((bf16_t)(bu[j] & 0xffff));
        o[2 * j + 1] = bf2f((bf16_t)(au[j] >> 16)) + bf2f((bf16_t)(bu[j] >> 16));
        ss += o[2 * j] * o[2 * j] + o[2 * j + 1] * o[2 * j + 1];
      }
#pragma unroll
      for (int of = 32; of >= 1; of >>= 1) ss += __shfl_xor(ss, of);
      const float rstd = rsqrtf(ss * (1.f / 512.f) + 1e-6f);
      float y[8];
#pragma unroll
      for (int j = 0; j < 8; ++j) {
        const float zz = bf2f((bf16_t)((j & 1) ? (zu[j >> 1] >> 16) : (zu[j >> 1] & 0xffff)));
        y[j] = o[j] * rstd * p.hgrn_norm[l * 512 + c0 + j] * fsilu(zz);
      }
      uint4 ov; ov.x = pk2(y[0], y[1]); ov.y = pk2(y[2], y[3]); ov.z = pk2(y[4], y[5]); ov.w = pk2(y[6], y[7]);
      *(uint4*)(MX + (size_t)r * DI + 512 + c0) = ov;
    }
    {
      const uint4 a = *(const uint4*)(OB + ((size_t)4 * TH + r) * 512 + c0), b = *(const uint4*)(OB + ((size_t)5 * TH + r) * 512 + c0);
      const uint4 z = *(const uint4*)(hrow + G_Z + c0);
      const unsigned au[4] = {a.x, a.y, a.z, a.w}, bu[4] = {b.x, b.y, b.z, b.w}, zu[4] = {z.x, z.y, z.z, z.w};
      float o[8]; float ss = 0.f;
#pragma unroll
      for (int j = 0; j < 4; ++j) {
        o[2 * j] = bf2f((bf16_t)(au[j] & 0xffff)) + bf2f((bf16_t)(bu[j] & 0xffff));
        o[2 * j + 1] = bf2f((bf16_t)(au[j] >> 16)) + bf2f((bf16_t)(bu[j] >> 16));
        ss += o[2 * j] * o[2 * j] + o[2 * j + 1] * o[2 * j + 1];
      }
#pragma unroll
      for (int of = 8; of >= 1; of >>= 1) ss += __shfl_xor(ss, of);
      const float rstd = rsqrtf(ss * (1.f / 128.f) + 1e-6f);
      float y[8];
#pragma unroll
      for (int j = 0; j < 8; ++j) {
        const float zz = bf2f((bf16_t)((j & 1) ? (zu[j >> 1] >> 16) : (zu[j >> 1] & 0xffff)));
        y[j] = o[j] * rstd * p.gla_norm[l * 128 + ((c0 + j) & 127)] * fsilu(zz);
      }
      uint4 ov; ov.x = pk2(y[0], y[1]); ov.y = pk2(y[2], y[3]); ov.z = pk2(y[4], y[5]); ov.w = pk2(y[6], y[7]);
      *(uint4*)(MX + (size_t)r * DI + 1536 + c0) = ov;
    }
    {
      const uint4 a = *(const uint4*)(OB + ((size_t)2 * TH + r) * 512 + c0), b = *(const uint4*)(OB + ((size_t)3 * TH + r) * 512 + c0);
      const uint4 z = *(const uint4*)(hrow + S_Z + c0);
      const unsigned au[4] = {a.x, a.y, a.z, a.w}, bu[4] = {b.x, b.y, b.z, b.w}, zu[4] = {z.x, z.y, z.z, z.w};
      float u[8];
#pragma unroll
      for (int j = 0; j < 8; ++j) u[j] = cb[c0 + j];
      const int t = r & (SEQ - 1);
#pragma unroll
      for (int jj = 0; jj < 5; ++jj) {
        const int s = t + jj - 2;
        if (s >= 0 && s < SEQ) {
          const uint4 xr = *(const uint4*)(Hh + (size_t)(r + jj - 2) * NPAD + S_X + c0);
          const unsigned xu[4] = {xr.x, xr.y, xr.z, xr.w};
#pragma unroll
          for (int j = 0; j < 8; ++j) {
            const float xv = bf2f((bf16_t)((j & 1) ? (xu[j >> 1] >> 16) : (xu[j >> 1] & 0xffff)));
            u[j] += cw[jj * 1024 + c0 + j] * xv;
          }
        }
      }
      const float dsk = p.ssd_d[l * 8 + (c0 >> 6)];
      float y[8]; float ss = 0.f;
#pragma unroll
      for (int j = 0; j < 8; ++j) {
        const float of = bf2f((bf16_t)((j & 1) ? (au[j >> 1] >> 16) : (au[j >> 1] & 0xffff)));
        const float ob = bf2f((bf16_t)((j & 1) ? (bu[j >> 1] >> 16) : (bu[j >> 1] & 0xffff)));
        const float zz = bf2f((bf16_t)((j & 1) ? (zu[j >> 1] >> 16) : (zu[j >> 1] & 0xffff)));
        y[j] = (of + ob + dsk * fsilu(u[j])) * fsilu(zz);
        ss += y[j] * y[j];
      }
#pragma unroll
      for (int of = 32; of >= 1; of >>= 1) ss += __shfl_xor(ss, of);
      const float rstd = rsqrtf(ss * (1.f / 512.f) + 1e-6f);
#pragma unroll
      for (int j = 0; j < 8; ++j) y[j] = y[j] * rstd * p.ssd_norm[l * 512 + c0 + j];
      uint4 ov; ov.x = pk2(y[0], y[1]); ov.y = pk2(y[2], y[3]); ov.z = pk2(y[4], y[5]); ov.w = pk2(y[6], y[7]);
      *(uint4*)(MX + (size_t)r * DI + 1024 + c0) = ov;
    }
  }
}


#define XB_TMO      128
#define XB_XCNT(j)  (256  + 64 * (j))
#define XB_XSUB(j)  (1280 + 64 * (j))
#define XB_XGEN(j)  (2304 + 64 * (j))
#define XB_TOP      3328
#define XB_TOPGEN   3392
#define XB_SPIN_CAP (1u << 22)
#define LAS __attribute__((address_space(3)))
DEV unsigned xb_ld(unsigned* p) { return __hip_atomic_load(p, __ATOMIC_RELAXED, __HIP_MEMORY_SCOPE_AGENT); }
DEV unsigned xb_add(unsigned* p, unsigned v) { return __hip_atomic_fetch_add(p, v, __ATOMIC_RELAXED, __HIP_MEMORY_SCOPE_AGENT); }
DEV unsigned xb_xcc_id() { return (unsigned)__builtin_amdgcn_s_getreg((3 << 11) | 20) & 0xFu; }
#define XB_SPIN(cond, bar) do { unsigned _sp = 0; while (cond) { __builtin_amdgcn_s_sleep(1); \
    if ((++_sp & 255u) == 0u) { if (xb_ld(&(bar)[XB_TMO])) break; if (_sp > XB_SPIN_CAP) { atomicAdd(&(bar)[XB_TMO], 1u); break; } } } } while (0)
struct XcdBarrier { unsigned* bar; unsigned x; volatile LAS unsigned* st; };
DEV XcdBarrier xcd_barrier_post(unsigned* bar, volatile LAS unsigned* st) {
  XcdBarrier b; b.bar = bar; b.x = xb_xcc_id(); b.st = st;
  if (threadIdx.x == 0) (void)xb_add(&bar[XB_XCNT(b.x)], 1u);
  return b;
}
DEV void xcd_barrier_complete(unsigned* bar, unsigned x, unsigned& nloc, unsigned& nx) {
  const unsigned G = gridDim.x * gridDim.y * gridDim.z;
  unsigned sum, cnt, mine, sp = 0u;
  for (;;) {
    sum = 0u; cnt = 0u; mine = 0u;
#pragma unroll
    for (unsigned j = 0; j < 16; ++j) { const unsigned c = xb_ld(&bar[XB_XCNT(j)]); sum += c; cnt += (c > 0u) ? 1u : 0u; mine = (j == x) ? c : mine; }
    if (sum == G) break;
    __builtin_amdgcn_s_sleep(1);
    if ((++sp & 255u) == 0u) { if (xb_ld(&bar[XB_TMO])) break; if (sp > XB_SPIN_CAP) { atomicAdd(&bar[XB_TMO], 1u); break; } }
  }
  nloc = mine > 0u ? mine : 1u; nx = cnt > 0u ? cnt : 1u;
}
DEV void xcd_barrier(const XcdBarrier& b) {
  asm volatile("s_waitcnt vmcnt(0)" ::: "memory");
  __syncthreads();
  if (threadIdx.x == 0) {
    unsigned* bar = b.bar;
    __builtin_amdgcn_s_waitcnt(0);
    unsigned nloc = b.st[0], nx = b.st[1];
    if (nloc == 0u) { xcd_barrier_complete(bar, b.x, nloc, nx); b.st[0] = nloc; b.st[1] = nx; }
    const unsigned old = xb_add(&bar[XB_XSUB(b.x)], 1u);
    const unsigned gen = old / nloc;
    if (old + 1u == (gen + 1u) * nloc) {
      __builtin_amdgcn_fence(__ATOMIC_RELEASE, "agent");
      asm volatile("s_waitcnt vmcnt(0)" ::: "memory");
      const unsigned og = xb_add(&bar[XB_TOP], 1u);
      const unsigned tg = og / nx;
      if (og + 1u == (tg + 1u) * nx) xb_add(&bar[XB_TOPGEN], 1u);
      else XB_SPIN(xb_ld(&bar[XB_TOPGEN]) == tg, bar);
      __builtin_amdgcn_fence(__ATOMIC_ACQUIRE, "agent");
      xb_add(&bar[XB_XGEN(b.x)], 1u);
      asm volatile("s_waitcnt vmcnt(0)" ::: "memory");
    } else {
      XB_SPIN(xb_ld(&bar[XB_XGEN(b.x)]) == gen, bar);
      __builtin_amdgcn_fence(__ATOMIC_ACQUIRE, "agent");
      asm volatile("s_waitcnt vmcnt(0)" ::: "memory");
    }
  }
  __syncthreads();
}

#ifndef PROBE_ST
#define PROBE_ST -1
#endif
#ifndef PROBE_REP
#define PROBE_REP 0
#endif
#ifndef PROBE_LO
#define PROBE_LO 0
#endif
#ifndef PROBE_HI
#define PROBE_HI 100000
#endif
DEV void run_phase(const Params& p, int ph, int rep, unsigned char* smem) {
  if (ph == 0) { if (PH_MASK & 1) phase_pro(p, smem); }
  if ((PH_MASK & 1) && (ph == 0 || ph == 16)) convert_weights(p, ph == 0 ? 0 : 1, smem);
  if (ph != 0) {
    const int q = ph - 1, l = q / 16, hf = (q / 8) & 1, st = q % 8;
    if (st == 0) { if (PH_MASK & 2) phase_inproj(p, l, hf, smem); }
    else if (st == 1) { if (PH_MASK & 4) phase_prep(p, l, hf, smem); }
    else if (st == 2) { if (PH_MASK & 0xF00) phase_mix(p, l, hf, ph + 40 * rep, 1, 0, ATT_SPLIT, rep ? PROBE_LO : 0, rep ? PROBE_HI : 100000, smem); }
    else if (st == 3) { if (PH_MASK & 0x700) phase_scan2(p); }
    else if (st == 4) { if (PH_MASK & 0xF00) phase_mix(p, l, hf, ph + 40 * rep, 3, ATT_SPLIT, 256, rep ? PROBE_LO : 0, rep ? PROBE_HI : 100000, smem); }
    else if (st == 5) { if (PH_MASK & 8) phase_fin(p, l, hf); }
    else if (st == 6) { if (PH_MASK & 16) phase_outproj(p, l, hf, smem); }
    else {
      if (PH_MASK & 32) phase_ln(p, l, hf);
    }
  }
}
__global__ void __launch_bounds__(NT) mega(Params p) {
  extern __shared__ __attribute__((aligned(16))) unsigned char smem[];
#if ONE_LAUNCH
  volatile LAS unsigned* xst = (volatile LAS unsigned*)(smem + LDS_BYTES - 32);
  if (threadIdx.x == 0) { xst[0] = 0u; xst[1] = 0u; }
  __syncthreads();
  XcdBarrier xb = xcd_barrier_post((unsigned*)(p.ws + OFF_CTRL), xst);
#endif
  Params* lp = (Params*)(smem + 147456);
  if (threadIdx.x == 0) *lp = p;
  __syncthreads();
  const int ph_begin = p.phase_begin, ph_end = p.phase_end;
  for (int ph = ph_begin; ph < ph_end; ++ph) {
    int nrep = 0;
#if PROBE_REP > 0
    {
      const int q = ph - 1, l = q / 16, st = q % 8;
      const bool idem = (ph == 0) ? (PROBE_ST == 9) : (st == PROBE_ST && (st != 6 || l == 0));
      if (idem) nrep = PROBE_REP;
    }
#endif
    for (int r = 0; r <= nrep; ++r) {
      run_phase(*lp, ph, r, smem);
#if ONE_LAUNCH
      if (r < nrep || ph + 1 < ph_end) xcd_barrier(xb);
#endif
    }
  }
}

extern "C" void kernel_launch(void* const* d_in, const int* in_sizes, int n_in, void* d_out, int out_size, void* d_ws, size_t ws_size,
                              hipStream_t stream) {
  static int grid_blocks = 0;
  if (!grid_blocks) {
    int dev = 0, cus = 0, per_cu = 0;
    hipGetDevice(&dev);
    hipDeviceGetAttribute(&cus, hipDeviceAttributeMultiprocessorCount, dev);
    hipFuncSetAttribute((const void*)mega, hipFuncAttributeMaxDynamicSharedMemorySize, LDS_BYTES);
    hipOccupancyMaxActiveBlocksPerMultiprocessor(&per_cu, mega, NT, LDS_BYTES);
    if (per_cu < 1) per_cu = 1;
    grid_blocks = cus;
  }
  Params p{};
  p.x = (const float*)d_in[0]; p.w_in = (const float*)d_in[1]; p.q_gain = (const float*)d_in[2]; p.k_gain = (const float*)d_in[3];
  p.lb_logits = (const float*)d_in[4]; p.hgrn_norm = (const float*)d_in[5]; p.conv_w = (const float*)d_in[6]; p.conv_b = (const float*)d_in[7];
  p.dt_bias = (const float*)d_in[8]; p.a_log = (const float*)d_in[9]; p.ssd_d = (const float*)d_in[10]; p.ssd_norm = (const float*)d_in[11];
  p.gk_w2 = (const float*)d_in[12]; p.gk_b = (const float*)d_in[13]; p.gla_norm = (const float*)d_in[14]; p.w_out = (const float*)d_in[15];
  p.ln_g = (const float*)d_in[16]; p.ln_b = (const float*)d_in[17];
  p.out = (float*)d_out; p.ws = (unsigned char*)d_ws;
  hipMemsetAsync(d_ws, 0, CTRL_BYTES, stream);
#if ONE_LAUNCH
  p.phase_begin = 0; p.phase_end = NPHASE;
  void* args[] = {&p};
  (void)args;
  hipLaunchKernelGGL(mega, dim3(grid_blocks), dim3(NT), LDS_BYTES, stream, p);
#else
  for (int ph = 0; ph < NPHASE; ++ph) {
    p.phase_begin = ph; p.phase_end = ph + 1;
    hipLaunchKernelGGL(mega, dim3(grid_blocks), dim3(NT), LDS_BYTES, stream, p);
  }
#endif
}
```

```cpp
#include <hip/hip_runtime.h>
#include <hip/hip_cooperative_groups.h>
#include <stdint.h>
#include <stdio.h>
namespace cg = cooperative_groups;

#ifndef ONE_LAUNCH
#define ONE_LAUNCH 1
#endif

#ifndef PH_MASK
#define PH_MASK 0xFFF
#endif
#define DEV __device__ __forceinline__
typedef unsigned short bf16_t;
typedef short bf16x8 __attribute__((ext_vector_type(8)));
typedef float f32x16 __attribute__((ext_vector_type(16)));
typedef unsigned u32x4 __attribute__((ext_vector_type(4)));

constexpr int NT = 512;
constexpr int T_ALL = 16384, TH = 8192, SEQ = 4096, DM = 1024, NPAD = 7168, DI = 2048, NIN = 6960;
constexpr int A_Q = 0, A_K = 512, A_V = 640, A_Z = 768, H_Q = 1280, H_FF = 1792, H_FB = 2304, H_I = 2816, H_Z = 3328,
              S_X = 3840, S_Z = 4864, G_Q = 5376, G_K = 5632, G_V = 5888, G_Z = 6400, SM0 = 6912;
constexpr size_t OFF_CTRL = 0, OFF_TAB = 65536, OFF_XB = 131072;
constexpr size_t OFF_WIN = OFF_XB + (size_t)T_ALL * DM * 2;
constexpr size_t OFF_WOUT = OFF_WIN + (size_t)NPAD * DM * 2;
constexpr size_t OFF_H = OFF_WOUT + (size_t)DM * DI * 2;
constexpr size_t OFF_SMALL = OFF_H + (size_t)TH * NPAD * 2;
constexpr size_t OFF_OBUF = OFF_SMALL + (size_t)TH * 48 * 4;
constexpr size_t OFF_VT = OFF_OBUF + (size_t)6 * TH * 512 * 2;
constexpr size_t OFF_DB = OFF_VT + (size_t)2 * 2 * 64 * SEQ * 2;
constexpr int NSEG = 8, SLEN = 64 / NSEG;
constexpr size_t OFF_MIXED = OFF_DB + (size_t)64 * NSEG * 128 * 4;
constexpr size_t OFF_SB0 = OFF_MIXED, OFF_SB1 = OFF_SB0 + (size_t)16 * NSEG * 16384 * 4, OFF_SB2 = OFF_SB1 + (size_t)16 * NSEG * 8192 * 4;
constexpr size_t OFF_U = OFF_SB2 + (size_t)32 * NSEG * 8192 * 4;
constexpr size_t WS_END = OFF_U + (size_t)TH * 1024 * 2;
static_assert(OFF_MIXED + (size_t)TH * DI * 2 <= WS_END, "MIXED must fit");
static_assert(WS_END <= 268435456, "workspace");
constexpr size_t CTRL_BYTES = 65536;
constexpr int CTR_WORD0 = 4096;
constexpr int LDS_BYTES = 148480;
constexpr float LOG2E = 1.4426950408889634f;
constexpr float QSCALE = 0.125f * LOG2E;
constexpr float DN_ALPHA = 1.4142135623730951f;
constexpr int NPHASE = 33;
constexpr int ATT_SPLIT = 144;

struct Params {
  const float* x; const float* w_in; const float* q_gain; const float* k_gain; const float* lb_logits; const float* hgrn_norm;
  const float* conv_w; const float* conv_b; const float* dt_bias; const float* a_log; const float* ssd_d; const float* ssd_norm;
  const float* gk_w2; const float* gk_b; const float* gla_norm; const float* w_out; const float* ln_g; const float* ln_b;
  float* out; unsigned char* ws;
  int phase_begin, phase_end;
};

DEV int launder(int v) { asm volatile("" : "+v"(v)); return v; }
DEV float bf2f(bf16_t v) { return __uint_as_float(((unsigned)v) << 16); }
DEV bf16_t f2bf(float f) { unsigned u = __float_as_uint(f); u += 0x7fffu + ((u >> 16) & 1u); return (bf16_t)(u >> 16); }
DEV unsigned pk2(float lo, float hi) { unsigned r; asm("v_cvt_pk_bf16_f32 %0, %1, %2" : "=v"(r) : "v"(lo), "v"(hi)); return r; }
DEV float fsigmoid(float x) { return 1.f / (1.f + __expf(-x)); }
DEV float fsilu(float x) { return x / (1.f + __expf(-x)); }
DEV unsigned cvtpk(float lo, float hi) { unsigned r; asm("v_cvt_pk_bf16_f32 %0, %1, %2" : "=v"(r) : "v"(lo), "v"(hi)); return r; }
DEV float ex2(float x) { return __builtin_amdgcn_exp2f(x); }
DEV float lg2(float x) { return __builtin_amdgcn_logf(x); }
DEV float frcp(float x) { return __builtin_amdgcn_rcpf(x); }
DEV float lo16(unsigned u) { return __uint_as_float(u << 16); }
DEV float hi16(unsigned u) { return __uint_as_float(u & 0xffff0000u); }
DEV int rowoff(int reg, int h) { return (reg & 3) + 8 * (reg >> 2) + 4 * h; }
DEV f32x16 zero16() { f32x16 z;
#pragma unroll
  for (int i = 0; i < 16; ++i) z[i] = 0.f; return z; }

template <int KD>
DEV void mma32(f32x16& acc, const bf16_t* a, int lda, const bf16_t* b, int ldb, int lane) {
  const int r = lane & 31, h = lane >> 5;
  const bf16_t* ap = a + r * lda + 8 * h;
  const bf16_t* bp = b + r * ldb + 8 * h;
#pragma unroll 4
  for (int k = 0; k < KD; k += 16) {
    bf16x8 av = *(const bf16x8*)(ap + k);
    bf16x8 bv = *(const bf16x8*)(bp + k);
    acc = __builtin_amdgcn_mfma_f32_32x32x16_bf16(av, bv, acc, 0, 0, 0);
  }
}

DEV int orig_col(int n) {
  if (n < 4864) return n;
  if (n < 6400) return n + 16;
  if (n < 6912) return n + 48;
  if (n < 6928) return n - 2048;
  if (n < 6960) return n - 512;
  return -1;
}

DEV void convert_weights(const Params& p, int l, unsigned char* smem) {
  float* s = (float*)smem;
  const int tid = launder(threadIdx.x);
  const float* win = p.w_in + (size_t)l * DM * NIN;
  const float* wout = p.w_out + (size_t)l * DI * DM;
  bf16_t* wint = (bf16_t*)(p.ws + OFF_WIN);
  bf16_t* woutt = (bf16_t*)(p.ws + OFF_WOUT);
  const int n_in_tiles = (NPAD / 64) * (DM / 64);
  const int n_out_tiles = (DM / 64) * (DI / 64);
  for (int it = blockIdx.x; it < n_in_tiles + n_out_tiles; it += gridDim.x) {
    __syncthreads();
    if (it < n_in_tiles) {
      const int n0 = (it / 16) * 64, k0 = (it % 16) * 64;
#pragma unroll
      for (int e = 0; e < 8; ++e) {
        const int idx = e * NT + tid, kk = idx >> 6, nn = idx & 63;
        const int oc = orig_col(n0 + nn);
        s[kk * 65 + nn] = (oc >= 0) ? win[(size_t)(k0 + kk) * NIN + oc] : 0.f;
      }
      __syncthreads();
      const int n = tid >> 3, kc = (tid & 7) * 8;
      uint4 o;
      o.x = pk2(s[(kc + 0) * 65 + n], s[(kc + 1) * 65 + n]); o.y = pk2(s[(kc + 2) * 65 + n], s[(kc + 3) * 65 + n]);
      o.z = pk2(s[(kc + 4) * 65 + n], s[(kc + 5) * 65 + n]); o.w = pk2(s[(kc + 6) * 65 + n], s[(kc + 7) * 65 + n]);
      *(uint4*)(wint + (size_t)(n0 + n) * DM + k0 + kc) = o;
    } else {
      const int j = it - n_in_tiles;
      const int n0 = (j / 32) * 64, k0 = (j % 32) * 64;
#pragma unroll
      for (int e = 0; e < 8; ++e) {
        const int idx = e * NT + tid, kk = idx >> 6, nn = idx & 63;
        s[kk * 65 + nn] = wout[(size_t)(k0 + kk) * DM + n0 + nn];
      }
      __syncthreads();
      const int n = tid >> 3, kc = (tid & 7) * 8;
      uint4 o;
      o.x = pk2(s[(kc + 0) * 65 + n], s[(kc + 1) * 65 + n]); o.y = pk2(s[(kc + 2) * 65 + n], s[(kc + 3) * 65 + n]);
      o.z = pk2(s[(kc + 4) * 65 + n], s[(kc + 5) * 65 + n]); o.w = pk2(s[(kc + 6) * 65 + n], s[(kc + 7) * 65 + n]);
      *(uint4*)(woutt + (size_t)(n0 + n) * DI + k0 + kc) = o;
    }
  }
  __syncthreads();
}

DEV void fsincos(float x, float& s, float& c) {
  const float k = rintf(x * 0.63661977236758134308f);
  float r = fmaf(-k, 1.5707855225e+00f, x);
  r = fmaf(-k, 1.0804273188e-05f, r);
  r = fmaf(-k, 6.0770999344e-11f, r);
  const float r2 = r * r;
  float ps = fmaf(r2, 2.7557319224e-06f, -1.9841269841e-04f);
  ps = fmaf(ps, r2, 8.3333333333e-03f); ps = fmaf(ps, r2, -1.6666666667e-01f);
  const float sinr = fmaf(ps * r2, r, r);
  float pc = fmaf(r2, -2.7557319224e-07f, 2.4801587302e-05f);
  pc = fmaf(pc, r2, -1.3888888889e-03f); pc = fmaf(pc, r2, 4.1666666667e-02f); pc = fmaf(pc, r2, -0.5f);
  const float cosr = fmaf(pc, r2, 1.0f);
  const int q = ((int)k) & 3;
  if (q == 0) { s = sinr; c = cosr; }
  else if (q == 1) { s = cosr; c = -sinr; }
  else if (q == 2) { s = -sinr; c = -cosr; }
  else { s = -cosr; c = sinr; }
}

DEV void phase_pro(const Params& p, unsigned char* smem) {
  const int tid = launder(threadIdx.x);
  const size_t gtid = (size_t)blockIdx.x * NT + tid, gsz = (size_t)gridDim.x * NT;
  const float4* x4 = (const float4*)p.x;
  uint4* xb4 = (uint4*)(p.ws + OFF_XB);
  for (size_t i = gtid; i < (size_t)T_ALL * DM / 8; i += gsz) {
    const float4 a = x4[2 * i], b = x4[2 * i + 1];
    uint4 o; o.x = pk2(a.x, a.y); o.y = pk2(a.z, a.w); o.z = pk2(b.x, b.y); o.w = pk2(b.z, b.w);
    xb4[i] = o;
  }
  if (blockIdx.x == 0) {
    float2* tab = (float2*)(p.ws + OFF_TAB);
    for (int i = tid; i < 64 * 16; i += NT) {
      const int pos = i >> 4, fi = i & 15;
      const float invf = exp2f(-(float)fi * (13.287712379549449f / 16.0f));
      const float ang = (float)pos * invf;
      float sn, cs; fsincos(ang, sn, cs);
      tab[i] = make_float2(cs, sn);
    }
  }
}

namespace pg8 {
#define PG8_LAS __attribute__((address_space(3)))
typedef unsigned short bf16_t;
typedef short bf16x8 __attribute__((ext_vector_type(8)));
typedef float f32x4 __attribute__((ext_vector_type(4)));
typedef unsigned u32x4 __attribute__((ext_vector_type(4)));
constexpr int BM = 256, BK = 64, HALF = 128, HTB = HALF * BK * 2  , STAGE_BYTES = 8 * HTB, NXCD = 8, WGM = 8;

__host__ __device__ __forceinline__ int lds_byte(int r, int c) { const int st = (r >> 4) * 2 + (c >> 5), rr = r & 15, cc = c & 31, ob = rr * 64 + cc * 2; return st * 1024 + (ob ^ (((ob >> 9) & 1) << 5)); }
__host__ __device__ __forceinline__ void stage_rc(int b, int& R, int& C) { const int st = b / 1024, sb = b % 1024, swz = sb ^ (((sb >> 9) & 1) << 5); R = (st >> 1) * 16 + swz / 64; C = (st & 1) * 32 + (swz % 64) / 2; }
__host__ __device__ __forceinline__ int perm32(int rho) { const int n = rho >> 4, i = rho & 15; return 8 * (i >> 2) + 4 * n + (i & 3); }

struct Unit { int pm, pn; };
struct Gemm { const bf16_t* A; const bf16_t* Bt; int M, N, K; };

__device__ __forceinline__ unsigned cvt_pk_bf16(float lo, float hi) { unsigned r; asm volatile("v_cvt_pk_bf16_f32 %0, %1, %2" : "=v"(r) : "v"(lo), "v"(hi)); return r; }

struct XcdOrder {
    int rpx, nN, x, c, ncu;
    __device__ void init(int M, int N) { rpx = (M / BM) / NXCD; nN = N / BM; x = blockIdx.x & 7; c = blockIdx.x >> 3; ncu = gridDim.x >> 3; }
    __device__ bool next(int i, Unit& u) const { const int j = c + i * ncu; if (j >= rpx * nN) return false; u.pm = rpx * x + (j % rpx); u.pn = j / rpx; return true; }
    __device__ __forceinline__ void a_ready(const Unit&) const {}
    __device__ __forceinline__ void done(const Unit&) const {}
};
struct EpiIn {
    static constexpr bool PERM = true, AFTER_DRAIN = false;
    bf16_t* O; int ldc; float* small; int small_pn;
    __device__ __forceinline__ void operator()(const f32x4 (&acc)[2][2][4][2], const Unit& u, int wr, int wc, int fr, int fq) const {
        const int row0 = u.pm * BM + wr * 64 + fr, col0 = u.pn * BM + wc * 32 + 8 * fq;
        if (u.pn == small_pn) {
            const int c = wc * 32 + 8 * fq;
            if (c < 48) {
#pragma unroll
                for (int ai = 0; ai < 2; ++ai)
#pragma unroll
                    for (int m = 0; m < 4; ++m) { float* rp = small + (size_t)(row0 + ai * HALF + m * 16) * 48 + c; *(f32x4*)rp = acc[ai][0][m][0]; *(f32x4*)(rp + 4) = acc[ai][0][m][1]; }
            }
            return;
        }
#pragma unroll
        for (int ai = 0; ai < 2; ++ai)
#pragma unroll
            for (int m = 0; m < 4; ++m) { bf16_t* rowp = O + (size_t)(row0 + ai * HALF + m * 16) * ldc + col0;
#pragma unroll
                for (int bj = 0; bj < 2; ++bj) { const f32x4 v0 = acc[ai][bj][m][0], v1 = acc[ai][bj][m][1];
                    u32x4 w; w.x = cvt_pk_bf16(v0[0], v0[1]); w.y = cvt_pk_bf16(v0[2], v0[3]); w.z = cvt_pk_bf16(v1[0], v1[1]); w.w = cvt_pk_bf16(v1[2], v1[3]);
                    *(u32x4*)(rowp + bj * HALF) = w; } }
    }
};
struct EpiOut {
    static constexpr bool PERM = true, AFTER_DRAIN = false;
    const float* X; float* Y; int ldc; float alpha;
    __device__ __forceinline__ void operator()(const f32x4 (&acc)[2][2][4][2], const Unit& u, int wr, int wc, int fr, int fq) const {
        const int row0 = u.pm * BM + wr * 64 + fr, col0 = u.pn * BM + wc * 32 + 8 * fq;
#pragma unroll
        for (int ai = 0; ai < 2; ++ai)
#pragma unroll
            for (int m = 0; m < 4; ++m) { const size_t off = (size_t)(row0 + ai * HALF + m * 16) * ldc + col0;
#pragma unroll
                for (int bj = 0; bj < 2; ++bj) { const f32x4 x0 = *(const f32x4*)(X + off + bj * HALF), x1 = *(const f32x4*)(X + off + bj * HALF + 4);
                    *(f32x4*)(Y + off + bj * HALF) = x0 * alpha + acc[ai][bj][m][0]; *(f32x4*)(Y + off + bj * HALF + 4) = x1 * alpha + acc[ai][bj][m][1]; } }
    }
};

template <class Epi, class Sched, bool ALIGN_EPI = false, bool SP2 = false>
__device__ __forceinline__ void gemm_phase(PG8_LAS unsigned char* lds, const Gemm g, const Sched& S, const Epi& E) {
    const int tid = launder((int)threadIdx.x), wid = __builtin_amdgcn_readfirstlane(tid >> 6), lane = tid & 63, wr = wid >> 2, wc = wid & 3, fr = lane & 15, fq = lane >> 4;
    const int K = g.K, nt = K / BK;
    unsigned voffA[2], voffB[2];
#pragma unroll
    for (int i = 0; i < 2; ++i) { int R, C; stage_rc(tid * 16 + i * 8192, R, C); const int Rb = Epi::PERM ? ((R & ~31) + perm32(R & 31)) : R;
        voffA[i] = (unsigned)(R * K + C) * 2u; voffB[i] = (unsigned)(Rb * K + C) * 2u; }
    const size_t kstep = (size_t)(BK * 2);
    const size_t hstep = (size_t)HALF * K * 2;
    const size_t tstep = 2 * hstep;
    const unsigned ldsw = (unsigned)wid * 1024u;
    const int aoff = lds_byte(wr * 64 + fr, fq * 8), boff = lds_byte(wc * 32 + fr, fq * 8);
#define PG8_SA(b, h) (((b) * 2 + (h)) * HTB)
#define PG8_SB(b, h) ((4 + (b) * 2 + (h)) * HTB)
#define PG8_STAGE(bufoff, gbase, voff) do { _Pragma("unroll") for (int _i = 0; _i < 2; ++_i) \
        __builtin_amdgcn_global_load_lds((const unsigned*)((const char*)(gbase) + (voff)[_i]), (PG8_LAS unsigned*)(lds + (bufoff) + ldsw + _i * 8192), 16, 0, 0); } while (0)
#define PG8_LDA(dst, b, h) do { _Pragma("unroll") for (int m = 0; m < 4; ++m) _Pragma("unroll") for (int k = 0; k < 2; ++k) dst[m][k] = *(const PG8_LAS bf16x8*)(lds + PG8_SA(b, h) + aoff + m * 2048 + k * 1024); } while (0)
#define PG8_LDB(dst, b, h) do { _Pragma("unroll") for (int n = 0; n < 2; ++n) _Pragma("unroll") for (int k = 0; k < 2; ++k) dst[n][k] = *(const PG8_LAS bf16x8*)(lds + PG8_SB(b, h) + boff + n * 2048 + k * 1024); } while (0)
#define PG8_MMA(ai, bj, At, Bt) do { __builtin_amdgcn_s_setprio(1); _Pragma("unroll") for (int m = 0; m < 4; ++m) _Pragma("unroll") for (int n = 0; n < 2; ++n) _Pragma("unroll") for (int k = 0; k < 2; ++k) \
        acc[ai][bj][m][n] = __builtin_amdgcn_mfma_f32_16x16x32_bf16(Bt[n][k], At[m][k], acc[ai][bj][m][n], 0, 0, 0); __builtin_amdgcn_s_setprio(0); } while (0)
#define PG8_WAIT_V(n) asm volatile("s_waitcnt vmcnt(" #n ")" ::: "memory")
#define PG8_WAIT_L(n) asm volatile("s_waitcnt lgkmcnt(" #n ")" ::: "memory")
#define PG8_BAR __builtin_amdgcn_s_barrier()
#define PG8_SCHED __builtin_amdgcn_sched_barrier(0)
    Unit cur, nxt; int ui = 0;
    if (!S.next(0, cur)) return;
    f32x4 acc[2][2][4][2];
#pragma unroll
    for (int a = 0; a < 2; ++a)
#pragma unroll
        for (int b = 0; b < 2; ++b)
#pragma unroll
            for (int m = 0; m < 4; ++m)
#pragma unroll
                for (int n = 0; n < 2; ++n) acc[a][b][m][n] = (f32x4){0.f, 0.f, 0.f, 0.f};
    bf16x8 At[4][2], B0[2][2], B1[2][2];
    const char* cA = (const char*)g.A + (size_t)cur.pm * tstep; const char* cB = (const char*)g.Bt + (size_t)cur.pn * tstep;
    S.a_ready(cur);
    if constexpr (SP2) {
        PG8_STAGE(PG8_SB(0, 0), cB, voffB); PG8_STAGE(PG8_SB(0, 1), cB + hstep, voffB); PG8_STAGE(PG8_SA(0, 0), cA, voffA); PG8_STAGE(PG8_SA(0, 1), cA + hstep, voffA);
        if (wr == 1) PG8_BAR;
        PG8_WAIT_V(2); PG8_BAR;
        PG8_STAGE(PG8_SB(1, 0), cB + kstep, voffB); PG8_STAGE(PG8_SA(1, 0), cA + kstep, voffA); PG8_STAGE(PG8_SB(1, 1), cB + hstep + kstep, voffB);
        PG8_WAIT_V(6); PG8_BAR;
    } else {
        PG8_STAGE(PG8_SB(0, 0), cB, voffB); PG8_STAGE(PG8_SA(0, 0), cA, voffA); PG8_STAGE(PG8_SB(0, 1), cB + hstep, voffB); PG8_STAGE(PG8_SA(0, 1), cA + hstep, voffA);
        if (wr == 1) PG8_BAR;
        PG8_WAIT_V(4); PG8_BAR;
        PG8_STAGE(PG8_SB(1, 0), cB + kstep, voffB); PG8_STAGE(PG8_SA(1, 0), cA + kstep, voffA); PG8_STAGE(PG8_SB(1, 1), cB + hstep + kstep, voffB);
        PG8_WAIT_V(6); PG8_BAR;
    }
    for (;;) {
        const bool has_next = S.next(ui + 1, nxt);
        const char* nA = has_next ? (const char*)g.A + (size_t)nxt.pm * tstep : cA; const char* nB = has_next ? (const char*)g.Bt + (size_t)nxt.pn * tstep : cB;
        for (int t = 0; t < nt; t += 2) {
            const bool last = (t == nt - 2);
            const char* a1 = cA + (size_t)(t + 1) * kstep;
            const char* a2 = last ? nA : cA + (size_t)(t + 2) * kstep; const char* b2 = last ? nB : cB + (size_t)(t + 2) * kstep;
            const char* a3 = a2 + kstep; const char* b3 = b2 + kstep;
            if (last && has_next) S.a_ready(nxt);
            if constexpr (SP2) {
            PG8_LDB(B0, 0, 0); PG8_LDB(B1, 0, 1); PG8_SCHED; PG8_LDA(At, 0, 0); PG8_STAGE(PG8_SA(1, 1), a1 + hstep, voffA);
            PG8_WAIT_V(8); PG8_WAIT_L(0); PG8_BAR; PG8_MMA(0, 0, At, B0); PG8_MMA(0, 1, At, B1); PG8_BAR; PG8_SCHED;
            PG8_LDA(At, 0, 1); PG8_STAGE(PG8_SB(0, 0), b2, voffB); PG8_STAGE(PG8_SB(0, 1), b2 + hstep, voffB); PG8_STAGE(PG8_SA(0, 0), a2, voffA);
            PG8_WAIT_V(8); PG8_WAIT_L(0); PG8_BAR; PG8_MMA(1, 0, At, B0); PG8_MMA(1, 1, At, B1); PG8_BAR; PG8_SCHED;
            PG8_LDB(B0, 1, 0); PG8_LDB(B1, 1, 1); PG8_SCHED; PG8_LDA(At, 1, 0); PG8_STAGE(PG8_SA(0, 1), a2 + hstep, voffA);
            PG8_WAIT_V(8); PG8_WAIT_L(0); PG8_BAR; PG8_MMA(0, 0, At, B0); PG8_MMA(0, 1, At, B1); PG8_BAR; PG8_SCHED;
            PG8_LDA(At, 1, 1); PG8_STAGE(PG8_SB(1, 0), b3, voffB); PG8_STAGE(PG8_SB(1, 1), b3 + hstep, voffB); PG8_STAGE(PG8_SA(1, 0), a3, voffA);
            PG8_WAIT_V(8); PG8_WAIT_L(0); PG8_BAR; PG8_MMA(1, 0, At, B0); PG8_MMA(1, 1, At, B1); PG8_BAR; PG8_SCHED;
            } else {
            PG8_LDB(B0, 0, 0); PG8_SCHED; PG8_LDA(At, 0, 0); PG8_STAGE(PG8_SA(1, 1), a1 + hstep, voffA);
            PG8_WAIT_L(8); PG8_BAR; PG8_WAIT_L(0); PG8_MMA(0, 0, At, B0); PG8_BAR; PG8_SCHED;
            PG8_LDB(B1, 0, 1); PG8_STAGE(PG8_SB(0, 0), b2, voffB);
            PG8_BAR; PG8_WAIT_L(0); PG8_MMA(0, 1, At, B1); PG8_BAR;
            PG8_LDA(At, 0, 1); PG8_STAGE(PG8_SA(0, 0), a2, voffA);
            PG8_BAR; PG8_WAIT_L(0); PG8_MMA(1, 0, At, B0); PG8_BAR; PG8_SCHED;
            PG8_STAGE(PG8_SB(0, 1), b2 + hstep, voffB);
            PG8_WAIT_V(6); PG8_BAR; PG8_MMA(1, 1, At, B1); PG8_BAR;
            PG8_LDB(B0, 1, 0); PG8_SCHED; PG8_LDA(At, 1, 0); PG8_STAGE(PG8_SA(0, 1), a2 + hstep, voffA);
            PG8_WAIT_L(8); PG8_BAR; PG8_WAIT_L(0); PG8_MMA(0, 0, At, B0); PG8_BAR; PG8_SCHED;
            PG8_LDB(B1, 1, 1); PG8_STAGE(PG8_SB(1, 0), b3, voffB);
            PG8_BAR; PG8_WAIT_L(0); PG8_MMA(0, 1, At, B1); PG8_BAR;
            PG8_LDA(At, 1, 1); PG8_STAGE(PG8_SA(1, 0), a3, voffA);
            PG8_BAR; PG8_WAIT_L(0); PG8_MMA(1, 0, At, B0); PG8_BAR; PG8_SCHED;
            PG8_STAGE(PG8_SB(1, 1), b3 + hstep, voffB);
            PG8_WAIT_V(6); PG8_BAR; PG8_MMA(1, 1, At, B1); PG8_BAR;
            }
        }
        if constexpr (ALIGN_EPI) { if (wr == 0) PG8_BAR; }
        if constexpr (!Epi::AFTER_DRAIN) { E(acc, cur, wr, wc, fr, fq); S.done(cur); }
        if (!has_next) break;
#pragma unroll
        for (int a = 0; a < 2; ++a)
#pragma unroll
            for (int b = 0; b < 2; ++b)
#pragma unroll
                for (int m = 0; m < 4; ++m)
#pragma unroll
                    for (int n = 0; n < 2; ++n) acc[a][b][m][n] = (f32x4){0.f, 0.f, 0.f, 0.f};
        cur = nxt; cA = nA; cB = nB; ++ui;
        if constexpr (ALIGN_EPI) { if (wr == 1) PG8_BAR; }
    }
    PG8_WAIT_V(0);
    if constexpr (!ALIGN_EPI) { if (wr == 0) PG8_BAR; }
    PG8_BAR;
    if constexpr (Epi::AFTER_DRAIN) { E.fused(acc, cur, wr, wc, fr, fq, lds, wid, lane); S.done(cur); }
#undef PG8_SA
#undef PG8_SB
#undef PG8_STAGE
#undef PG8_LDA
#undef PG8_LDB
#undef PG8_MMA
#undef PG8_WAIT_V
#undef PG8_WAIT_L
#undef PG8_BAR
#undef PG8_SCHED
}
}

DEV void phase_inproj(const Params& p, int l, int hf, unsigned char* smem) {
  pg8::Gemm g{(const bf16_t*)(p.ws + OFF_XB) + (size_t)hf * TH * DM, (const bf16_t*)(p.ws + OFF_WIN), TH, NPAD, DM};
  pg8::XcdOrder S; S.init(TH, NPAD);
  pg8::EpiIn E{(bf16_t*)(p.ws + OFF_H), NPAD, (float*)(p.ws + OFF_SMALL), SM0 / 256};
  pg8::gemm_phase<pg8::EpiIn, pg8::XcdOrder, true, true>((PG8_LAS unsigned char*)smem, g, S, E);
}

DEV void phase_outproj(const Params& p, int l, int hf, unsigned char* smem) {
  pg8::Gemm g{(const bf16_t*)(p.ws + OFF_MIXED), (const bf16_t*)(p.ws + OFF_WOUT), TH, DM, DI};
  pg8::XcdOrder S; S.init(TH, DM);
  const float* xin = ((l == 0) ? p.x : p.out) + (size_t)hf * TH * DM;
  pg8::EpiOut E{xin, p.out + (size_t)hf * TH * DM, DM, DN_ALPHA};
  pg8::gemm_phase<pg8::EpiOut, pg8::XcdOrder, true, true>((PG8_LAS unsigned char*)smem, g, S, E);
}

DEV void phase_ln(const Params& p, int l, int hf) {
  const int tid = launder(threadIdx.x), lane = tid & 63, w = tid >> 6;
  const float* g = p.ln_g + l * DM; const float* b = p.ln_b + l * DM;
  bf16_t* xb = (bf16_t*)(p.ws + OFF_XB);
  for (int r = blockIdx.x * 8 + w; r < TH; r += gridDim.x * 8) {
    const int row = hf * TH + r;
    float4* rp = (float4*)(p.out + (size_t)row * DM);
    float4 v[4];
    float s = 0.f;
#pragma unroll
    for (int j = 0; j < 4; ++j) { v[j] = rp[j * 64 + lane]; s += (v[j].x + v[j].y) + (v[j].z + v[j].w); }
#pragma unroll
    for (int o = 32; o >= 1; o >>= 1) s += __shfl_xor(s, o);
    const float mu = s * (1.f / DM);
    float q = 0.f;
#pragma unroll
    for (int j = 0; j < 4; ++j) { const float a = v[j].x - mu, bb = v[j].y - mu, cc = v[j].z - mu, d = v[j].w - mu; q += (a * a + bb * bb) + (cc * cc + d * d); }
#pragma unroll
    for (int o = 32; o >= 1; o >>= 1) q += __shfl_xor(q, o);
    const float rstd = rsqrtf(q * (1.f / DM) + 1e-5f);
#pragma unroll
    for (int j = 0; j < 4; ++j) {
      const int col = (j * 64 + lane) * 4;
      const float4 gg = *(const float4*)(g + col), bb = *(const float4*)(b + col);
      float4 o;
      o.x = (v[j].x - mu) * rstd * gg.x + bb.x; o.y = (v[j].y - mu) * rstd * gg.y + bb.y;
      o.z = (v[j].z - mu) * rstd * gg.z + bb.z; o.w = (v[j].w - mu) * rstd * gg.w + bb.w;
      rp[j * 64 + lane] = o;
      if (l == 0) { uint2 pk; pk.x = pk2(o.x, o.y); pk.y = pk2(o.z, o.w); *(uint2*)(xb + (size_t)row * DM + col) = pk; }
    }
  }
}

DEV void attn_item(const Params& p, int l, int item, unsigned char* smem) {
  const int tid = launder(threadIdx.x), lane = tid & 63, w = tid >> 6, r = lane & 31, h = lane >> 5;
  const int qt = item & 15, head = (item >> 4) & 7, bl = item >> 7;
  const int kvh = head >> 2;
  bf16_t* Hh = (bf16_t*)(p.ws + OFF_H);
  const bf16_t* VT = (const bf16_t*)(p.ws + OFF_VT);
  const size_t rowbase = (size_t)bl * SEQ;
  float mq = fabsf(p.q_gain[l * 64 + lane]), mk = fabsf(p.k_gain[l * 64 + lane]);
#pragma unroll
  for (int o = 32; o >= 1; o >>= 1) { mq = fmaxf(mq, __shfl_xor(mq, o)); mk = fmaxf(mk, __shfl_xor(mk, o)); }
  const float M2 = 8.f * mq * mk * LOG2E * 1.01f;
  const int qrow = qt * 256 + w * 32 + r;
  const bf16_t* qp = Hh + (rowbase + qrow) * NPAD + A_Q + head * 64 + 8 * h;
  bf16x8 qf[4];
#pragma unroll
  for (int ks = 0; ks < 4; ++ks) qf[ks] = *(const bf16x8*)(qp + ks * 16);
  f32x16 o0 = zero16(), o1 = zero16();
  float lsum = 0.f;
  const int srow = tid >> 3, sch = (tid & 7) * 8;
  const bf16_t* kp = Hh + (rowbase + srow) * NPAD + A_K + kvh * 64 + sch;
  const bf16_t* vp = VT + ((size_t)((bl * 2 + kvh) * 64 + srow)) * SEQ + sch;
  auto compute = [&](int st) __attribute__((always_inline)) {
    const bf16_t* sK = (const bf16_t*)(smem + st * 18432);
    const bf16_t* sV = (const bf16_t*)(smem + st * 18432 + 9216);
    f32x16 s0, s1;
#pragma unroll
    for (int i = 0; i < 16; ++i) { s0[i] = -M2; s1[i] = -M2; }
#pragma unroll
    for (int ks = 0; ks < 4; ++ks) {
      const bf16x8 a0 = *(const bf16x8*)(sK + r * 72 + ks * 16 + 8 * h);
      const bf16x8 a1 = *(const bf16x8*)(sK + (32 + r) * 72 + ks * 16 + 8 * h);
      s0 = __builtin_amdgcn_mfma_f32_32x32x16_bf16(a0, qf[ks], s0, 0, 0, 0);
      s1 = __builtin_amdgcn_mfma_f32_32x32x16_bf16(a1, qf[ks], s1, 0, 0, 0);
    }
#pragma unroll
    for (int i = 0; i < 16; ++i) { s0[i] = __builtin_amdgcn_exp2f(s0[i]); s1[i] = __builtin_amdgcn_exp2f(s1[i]); lsum += s0[i] + s1[i]; }
    union { bf16x8 v; unsigned u[4]; } pb[2][2];
#pragma unroll
    for (int s = 0; s < 2; ++s)
#pragma unroll
      for (int j = 0; j < 4; ++j) {
        pb[0][s].u[j] = pk2(s0[8 * s + 2 * j], s0[8 * s + 2 * j + 1]);
        pb[1][s].u[j] = pk2(s1[8 * s + 2 * j], s1[8 * s + 2 * j + 1]);
      }
#pragma unroll
    for (int kt2 = 0; kt2 < 2; ++kt2)
#pragma unroll
      for (int s = 0; s < 2; ++s) {
        const int kb = kt2 * 32 + 16 * s + 4 * h;
        union { bf16x8 v; uint2 u[2]; } a0, a1;
        a0.u[0] = *(const uint2*)(sV + r * 72 + kb); a0.u[1] = *(const uint2*)(sV + r * 72 + kb + 8);
        a1.u[0] = *(const uint2*)(sV + (32 + r) * 72 + kb); a1.u[1] = *(const uint2*)(sV + (32 + r) * 72 + kb + 8);
        o0 = __builtin_amdgcn_mfma_f32_32x32x16_bf16(a0.v, pb[kt2][s].v, o0, 0, 0, 0);
        o1 = __builtin_amdgcn_mfma_f32_32x32x16_bf16(a1.v, pb[kt2][s].v, o1, 0, 0, 0);
      }
  };
  constexpr int NKT = SEQ / 64;
  u32x4 k0 = *(const u32x4*)kp, v0 = *(const u32x4*)vp;
  u32x4 k1 = *(const u32x4*)(kp + (size_t)64 * NPAD), v1 = *(const u32x4*)(vp + 64);
  *(u32x4*)(smem + srow * 144 + sch * 2) = k0;
  *(u32x4*)(smem + 9216 + srow * 144 + sch * 2) = v0;
  k0 = *(const u32x4*)(kp + (size_t)2 * 64 * NPAD); v0 = *(const u32x4*)(vp + 2 * 64);
  __syncthreads();
  for (int kt = 0; kt < NKT; kt += 2) {
    *(u32x4*)(smem + 18432 + srow * 144 + sch * 2) = k1;
    *(u32x4*)(smem + 18432 + 9216 + srow * 144 + sch * 2) = v1;
    if (kt + 3 < NKT) { k1 = *(const u32x4*)(kp + (size_t)(kt + 3) * 64 * NPAD); v1 = *(const u32x4*)(vp + (kt + 3) * 64); }
    compute(0);
    __syncthreads();
    if (kt + 2 < NKT) {
      *(u32x4*)(smem + srow * 144 + sch * 2) = k0;
      *(u32x4*)(smem + 9216 + srow * 144 + sch * 2) = v0;
      if (kt + 4 < NKT) { k0 = *(const u32x4*)(kp + (size_t)(kt + 4) * 64 * NPAD); v0 = *(const u32x4*)(vp + (kt + 4) * 64); }
    }
    compute(1);
    __syncthreads();
  }
  lsum += __shfl_xor(lsum, 32);
  const float inv = 1.f / lsum;
  const bf16_t* zp = Hh + (rowbase + qrow) * NPAD + A_Z + head * 64;
  bf16_t* op = Hh + (rowbase + qrow) * NPAD + A_Q + head * 64;
#pragma unroll
  for (int dt = 0; dt < 2; ++dt)
#pragma unroll
    for (int g = 0; g < 4; ++g) {
      const int d0 = dt * 32 + 8 * g + 4 * h;
      const uint2 zz = *(const uint2*)(zp + d0);
      const float z0 = bf2f((bf16_t)(zz.x & 0xffff)), z1 = bf2f((bf16_t)(zz.x >> 16)), z2 = bf2f((bf16_t)(zz.y & 0xffff)), z3 = bf2f((bf16_t)(zz.y >> 16));
      const f32x16& oo = dt ? o1 : o0;
      uint2 ov;
      ov.x = pk2(oo[4 * g + 0] * inv * fsilu(z0), oo[4 * g + 1] * inv * fsilu(z1));
      ov.y = pk2(oo[4 * g + 2] * inv * fsilu(z2), oo[4 * g + 3] * inv * fsilu(z3));
      *(uint2*)(op + d0) = ov;
    }
  __syncthreads();
}

constexpr int L_QT = 0, L_KT = 17408, L_QC = 34816, L_KHT = 52224, L_VT = 70656, L_P = 89088, L_ST = 98304, L_RAW = 89088,
              L_D = 138240, L_TOT = 138752, L_ACS = 142848, L_DT = 143104, L_LOW = 143360;

template <int K, int V> struct ScanGeom {
  static constexpr int KP = K + 8;
  static constexpr int NS = (K / 32) * (V / 32) / 8;
};

template <int K, int V>
DEV void scan_write_state(unsigned char* smem, const f32x16* S, int w, int lane) {
  constexpr int KP = K + 8, NS = ScanGeom<K, V>::NS, NVT = V / 32;
  bf16_t* sST = (bf16_t*)(smem + L_ST);
  const int c = lane & 31, h = lane >> 5;
#pragma unroll
  for (int i = 0; i < NS; ++i) {
    const int tile = w * NS + i, kt = tile / NVT, nt = tile % NVT;
#pragma unroll
    for (int g = 0; g < 4; ++g) {
      uint2 o; o.x = pk2(S[i][4 * g + 0], S[i][4 * g + 1]); o.y = pk2(S[i][4 * g + 2], S[i][4 * g + 3]);
      *(uint2*)(sST + (nt * 32 + c) * KP + kt * 32 + 8 * g + 4 * h) = o;
    }
  }
}

template <int K, int V, bool SSDM>
DEV void scan_core(unsigned char* smem, f32x16* S, bf16_t* orow0, int dir, int w, int lane, bool do_out) {
  constexpr int KP = K + 8, NS = ScanGeom<K, V>::NS, NVT = V / 32, NOT = 2 * NVT;
  const bf16_t* sQt = (const bf16_t*)(smem + L_QT); const bf16_t* sKt = (const bf16_t*)(smem + L_KT);
  const bf16_t* sQc = (const bf16_t*)(smem + L_QC); const bf16_t* sKhT = (const bf16_t*)(smem + L_KHT);
  const bf16_t* sVT = (const bf16_t*)(smem + L_VT); bf16_t* sP = (bf16_t*)(smem + L_P);
  const bf16_t* sST = (const bf16_t*)(smem + L_ST); const float* sD = (const float*)(smem + L_D);
  const float* sAcs = (const float*)(smem + L_ACS);
  const int c = lane & 31, h = lane >> 5;
  if (do_out) scan_write_state<K, V>(smem, S, w, lane);
  if (do_out && w < 4) {
    const int tt = w >> 1, st = w & 1;
    f32x16 acc = zero16();
    if (st <= tt) mma32<K>(acc, sQt + tt * 32 * KP, KP, sKt + st * 32 * KP, KP, lane);
#pragma unroll
    for (int reg = 0; reg < 16; ++reg) {
      const int tau = tt * 32 + rowoff(reg, h), sig = st * 32 + c;
      float v = 0.f;
      if (sig <= tau) { v = acc[reg]; if (SSDM) v *= ex2(sAcs[tau] - sAcs[sig]); }
      sP[tau * 72 + sig] = f2bf(v);
    }
  }
  __syncthreads();
  if (do_out && w < NOT) {
    const int tt = w / NVT, nt = w % NVT;
    f32x16 acc = zero16();
    mma32<64>(acc, sP + tt * 32 * 72, 72, sVT + nt * 32 * 72, 72, lane);
    mma32<K>(acc, sQc + tt * 32 * KP, KP, sST + nt * 32 * KP, KP, lane);
#pragma unroll
    for (int reg = 0; reg < 16; ++reg) {
      const int tau = tt * 32 + rowoff(reg, h);
      const int tok = dir ? (63 - tau) : tau;
      orow0[(size_t)tok * 512 + nt * 32 + c] = f2bf(acc[reg]);
    }
  }
#pragma unroll
  for (int i = 0; i < NS; ++i) {
    const int tile = w * NS + i, kt = tile / NVT, nt = tile % NVT;
#pragma unroll
    for (int reg = 0; reg < 16; ++reg) S[i][reg] *= sD[kt * 32 + rowoff(reg, h)];
    mma32<64>(S[i], sKhT + kt * 32 * 72, 72, sVT + nt * 32 * 72, 72, lane);
  }
  __syncthreads();
}

template <int K, int V>
DEV void state_store(float* buf, const f32x16* S, int w, int lane) {
  constexpr int NS = ScanGeom<K, V>::NS, NVT = V / 32;
  const int c = lane & 31, h = lane >> 5;
#pragma unroll
  for (int i = 0; i < NS; ++i) {
    const int tile = w * NS + i, kt = tile / NVT, nt = tile % NVT;
#pragma unroll
    for (int reg = 0; reg < 16; ++reg) buf[(kt * 32 + rowoff(reg, h)) * V + nt * 32 + c] = S[i][reg];
  }
}
template <int K, int V>
DEV void state_load(const float* buf, f32x16* S, int w, int lane) {
  constexpr int NS = ScanGeom<K, V>::NS, NVT = V / 32;
  const int c = lane & 31, h = lane >> 5;
#pragma unroll
  for (int i = 0; i < NS; ++i) {
    const int tile = w * NS + i, kt = tile / NVT, nt = tile % NVT;
#pragma unroll
    for (int reg = 0; reg < 16; ++reg) S[i][reg] = buf[(kt * 32 + rowoff(reg, h)) * V + nt * 32 + c];
  }
}

DEV void store16(bf16_t* dst, const float* v) {
  uint4 a, b;
  a.x = pk2(v[0], v[1]); a.y = pk2(v[2], v[3]); a.z = pk2(v[4], v[5]); a.w = pk2(v[6], v[7]);
  b.x = pk2(v[8], v[9]); b.y = pk2(v[10], v[11]); b.z = pk2(v[12], v[13]); b.w = pk2(v[14], v[15]);
  ((uint4*)dst)[0] = a; ((uint4*)dst)[1] = b;
}
DEV void gather16(bf16_t* dst, const bf16_t* src, int stride) {
  unsigned u[8];
#pragma unroll
  for (int i = 0; i < 8; ++i) u[i] = (unsigned)src[(2 * i) * stride] | ((unsigned)src[(2 * i + 1) * stride] << 16);
  ((uint4*)dst)[0] = make_uint4(u[0], u[1], u[2], u[3]); ((uint4*)dst)[1] = make_uint4(u[4], u[5], u[6], u[7]);
}

DEV void hgrn_item(const Params& p, int l, int it, int seg, int mode, unsigned char* smem) {
  const int bl = it >> 3, head = (it >> 1) & 3, dir = it & 1;
  const bool do_out = (mode == 3);
  constexpr int K = 128, V = 128, KP = 136, KPW = 68;
  const int tid = launder(threadIdx.x), lane = tid & 63, w = tid >> 6;
  const int cp = tid & 63, tg = tid >> 6, ch0 = 2 * cp;
  const bf16_t* Hh = (const bf16_t*)(p.ws + OFF_H);
  bf16_t* OB = (bf16_t*)(p.ws + OFF_OBUF) + (size_t)(0 * 2 + dir) * TH * 512;
  const size_t rowbase = (size_t)bl * SEQ;
  float lb0 = 0.f, lb1 = 0.f;
  if (l > 0) {
    lb0 = fsigmoid(p.lb_logits[512 + head * 128 + ch0] - p.lb_logits[head * 128 + ch0]);
    lb1 = fsigmoid(p.lb_logits[512 + head * 128 + ch0 + 1] - p.lb_logits[head * 128 + ch0 + 1]);
  }
  const float om0 = 1.f - lb0, om1 = 1.f - lb1;
  const int fbase = dir ? H_FB : H_FF;
  unsigned* sQt = (unsigned*)(smem + L_QT); unsigned* sKt = (unsigned*)(smem + L_KT); unsigned* sQc = (unsigned*)(smem + L_QC);
  bf16_t* sKhT = (bf16_t*)(smem + L_KHT); bf16_t* sVT = (bf16_t*)(smem + L_VT);
  float* sD = (float*)(smem + L_D); float* sTot = (float*)(smem + L_TOT);
  const unsigned* rawQ = (const unsigned*)(smem + L_RAW); const unsigned* rawF = rawQ + 4096; const unsigned* rawV = rawQ + 8192;
  f32x16 S[2]; S[0] = zero16(); S[1] = zero16();
  float* sbuf = (float*)(p.ws + OFF_SB0) + ((size_t)it * NSEG + seg) * 16384;
  if (do_out) state_load<K, V>(sbuf, S, w, lane);
  float dlog0 = 0.f, dlog1 = 0.f;
  u32x4 pre[6];
  const int prow0 = tid >> 4, pc16 = (tid & 15) * 8;
  auto gload = [&](int cidx) __attribute__((always_inline)) {
    const int chunk = dir ? (63 - cidx) : cidx;
#pragma unroll
    for (int j = 0; j < 2; ++j) {
      const int row = prow0 + 32 * j;
      const int tok = chunk * 64 + (dir ? (63 - row) : row);
      const bf16_t* rp = Hh + (rowbase + tok) * NPAD + head * 128 + pc16;
      if (do_out) pre[j] = *(const u32x4*)(rp + H_Q);
      pre[2 + j] = *(const u32x4*)(rp + fbase); pre[4 + j] = *(const u32x4*)(rp + H_I);
    }
  };
  gload(seg * SLEN);
  for (int ci = 0; ci < SLEN; ++ci) {
    const int cidx = seg * SLEN + ci;
    const int chunk = dir ? (63 - cidx) : cidx;
#pragma unroll
    for (int j = 0; j < 2; ++j) {
      unsigned char* d = smem + L_RAW + (prow0 + 32 * j) * 256 + pc16 * 2;
      if (do_out) *(u32x4*)d = pre[j];
      *(u32x4*)(d + 16384) = pre[2 + j]; *(u32x4*)(d + 32768) = pre[4 + j];
    }
    __syncthreads();
    if (ci + 1 < SLEN) gload(cidx + 1);
    float r0 = 0.f, r1 = 0.f;
#pragma unroll
    for (int i = 0; i < 8; ++i) {
      const unsigned u = rawF[(8 * tg + i) * 64 + cp];
      const float e0 = ex2(fminf(-lo16(u) * LOG2E, 80.f)), e1 = ex2(fminf(-hi16(u) * LOG2E, 80.f));
      r0 += lg2(lb0 + om0 * frcp(1.f + e0)); r1 += lg2(lb1 + om1 * frcp(1.f + e1));
    }
    *(float2*)(sTot + tg * 128 + ch0) = make_float2(r0, r1);
    __syncthreads();
    float off0 = 0.f, off1 = 0.f, ref0 = 0.f, ref1 = 0.f, be0 = 0.f, be1 = 0.f;
#pragma unroll
    for (int j = 0; j < 8; ++j) {
      const float2 t = *(const float2*)(sTot + j * 128 + ch0);
      if (j < tg) { off0 += t.x; off1 += t.y; }
      if (j < 4) { ref0 += t.x; ref1 += t.y; }
      be0 += t.x; be1 += t.y;
    }
    dlog0 += be0; dlog1 += be1;
    const float eref0 = ex2(ref0), eref1 = ex2(ref1), ebr0 = ex2(be0 - ref0), ebr1 = ex2(be1 - ref1);
    float b0 = off0, b1 = off1;
    float kh0[8], kh1[8]; unsigned vv[8];
#pragma unroll
    for (int i = 0; i < 8; ++i) {
      const int tau = 8 * tg + i;
      const unsigned u = rawF[tau * 64 + cp];
      const float e0 = ex2(fminf(-lo16(u) * LOG2E, 80.f)), e1 = ex2(fminf(-hi16(u) * LOG2E, 80.f));
      const float s0 = frcp(1.f + e0), s1 = frcp(1.f + e1);
      b0 += lg2(lb0 + om0 * s0); b1 += lg2(lb1 + om1 * s1);
      const float kx0 = om0 * e0 * s0, kx1 = om1 * e1 * s1;
      const float E0 = ex2(b0 - ref0), E1 = ex2(b1 - ref1);
      const float kt0 = kx0 * frcp(E0), kt1 = kx1 * frcp(E1);
      if (do_out) {
        const unsigned uq = rawQ[tau * 64 + cp];
        const float q0 = lo16(uq), q1 = hi16(uq);
        const float qx0 = q0 * frcp(1.f + ex2(fminf(-q0 * LOG2E, 80.f))) * 0.08838834764831845f;
        const float qx1 = q1 * frcp(1.f + ex2(fminf(-q1 * LOG2E, 80.f))) * 0.08838834764831845f;
        const float qt0 = qx0 * E0, qt1 = qx1 * E1;
        sQt[tau * KPW + cp] = cvtpk(qt0, qt1);
        sKt[tau * KPW + cp] = cvtpk(kt0, kt1);
        sQc[tau * KPW + cp] = cvtpk(qt0 * eref0, qt1 * eref1);
      }
      kh0[i] = kt0 * ebr0; kh1[i] = kt1 * ebr1;
      vv[i] = rawV[tau * 64 + cp];
    }
    *(u32x4*)(sKhT + ch0 * 72 + 8 * tg) = (u32x4){cvtpk(kh0[0], kh0[1]), cvtpk(kh0[2], kh0[3]), cvtpk(kh0[4], kh0[5]), cvtpk(kh0[6], kh0[7])};
    *(u32x4*)(sKhT + (ch0 + 1) * 72 + 8 * tg) = (u32x4){cvtpk(kh1[0], kh1[1]), cvtpk(kh1[2], kh1[3]), cvtpk(kh1[4], kh1[5]), cvtpk(kh1[6], kh1[7])};
    *(u32x4*)(sVT + ch0 * 72 + 8 * tg) = (u32x4){(vv[0] & 0xffffu) | (vv[1] << 16), (vv[2] & 0xffffu) | (vv[3] << 16), (vv[4] & 0xffffu) | (vv[5] << 16), (vv[6] & 0xffffu) | (vv[7] << 16)};
    *(u32x4*)(sVT + (ch0 + 1) * 72 + 8 * tg) = (u32x4){(vv[0] >> 16) | (vv[1] & 0xffff0000u), (vv[2] >> 16) | (vv[3] & 0xffff0000u), (vv[4] >> 16) | (vv[5] & 0xffff0000u), (vv[6] >> 16) | (vv[7] & 0xffff0000u)};
    if (tg == 0) *(float2*)(sD + ch0) = make_float2(ex2(be0), ex2(be1));
    __syncthreads();
    scan_core<K, V, false>(smem, S, OB + (rowbase + (size_t)chunk * 64) * 512 + head * 128, dir, w, lane, do_out);
  }
  if (!do_out) {
    state_store<K, V>(sbuf, S, w, lane);
    if (tg == 0) *(float2*)((float*)(p.ws + OFF_DB) + ((size_t)it * NSEG + seg) * 128 + ch0) = make_float2(ex2(dlog0), ex2(dlog1));
  }
}

DEV void gla_item(const Params& p, int l, int it, int seg, int mode, unsigned char* smem) {
  const int j16 = it - 16, bl = j16 >> 3, head = (j16 >> 1) & 3, dir = j16 & 1;
  const bool do_out = (mode == 3);
  constexpr int K = 64, V = 128, KP = 72, KPW = 36;
  const int tid = launder(threadIdx.x), lane = tid & 63, w = tid >> 6;
  const int cp = tid & 31, tg = tid >> 5, ch0 = 2 * cp;
  const int vp2 = tid & 63, vg = tid >> 6;
  const bf16_t* Hh = (const bf16_t*)(p.ws + OFF_H);
  const float* SMALL = (const float*)(p.ws + OFF_SMALL);
  bf16_t* OB = (bf16_t*)(p.ws + OFF_OBUF) + (size_t)(2 * 2 + dir) * TH * 512;
  const size_t rowbase = (size_t)bl * SEQ;
  unsigned* sQt = (unsigned*)(smem + L_QT); unsigned* sKt = (unsigned*)(smem + L_KT); unsigned* sQc = (unsigned*)(smem + L_QC);
  bf16_t* sKhT = (bf16_t*)(smem + L_KHT); bf16_t* sVT = (bf16_t*)(smem + L_VT);
  float* sD = (float*)(smem + L_D); float* sTot = (float*)(smem + L_TOT); float* sLow = (float*)(smem + L_LOW);
  const unsigned* rawQ = (const unsigned*)(smem + L_RAW); const unsigned* rawK = rawQ + 2048; const unsigned* rawV = rawQ + 4096;
  float* sG = (float*)(smem + L_RAW + 32768);
  float w2a[16], w2b[16];
#pragma unroll
  for (int r = 0; r < 16; ++r) {
    const float* wp = p.gk_w2 + ((size_t)(l * 2 + dir) * 16 + r) * 256 + head * 64 + ch0;
    w2a[r] = wp[0]; w2b[r] = wp[1];
  }
  const float gb0 = p.gk_b[(l * 2 + dir) * 256 + head * 64 + ch0], gb1 = p.gk_b[(l * 2 + dir) * 256 + head * 64 + ch0 + 1];
  f32x16 S[1]; S[0] = zero16();
  float* sbuf = (float*)(p.ws + OFF_SB1) + ((size_t)j16 * NSEG + seg) * 8192;
  if (do_out) state_load<K, V>(sbuf, S, w, lane);
  float dlog0 = 0.f, dlog1 = 0.f;
  u32x4 pre[4];
  float plow0, plow1;
  const int qrow = tid >> 3, qc8 = (tid & 7) * 8, vrow0 = tid >> 4, vc16 = (tid & 15) * 8;
  auto gload = [&](int cidx) __attribute__((always_inline)) {
    const int chunk = dir ? (63 - cidx) : cidx;
    {
      const int tok = chunk * 64 + (dir ? (63 - qrow) : qrow);
      const bf16_t* rp = Hh + (rowbase + tok) * NPAD + head * 64 + qc8;
      if (do_out) pre[0] = *(const u32x4*)(rp + G_Q);
      pre[1] = *(const u32x4*)(rp + G_K);
      const float* lp = SMALL + (rowbase + tok) * 48 + 16 + dir * 16 + (tid & 7) * 2; plow0 = lp[0]; plow1 = lp[1];
    }
#pragma unroll
    for (int j = 0; j < 2; ++j) {
      const int row = vrow0 + 32 * j;
      const int tok = chunk * 64 + (dir ? (63 - row) : row);
      pre[2 + j] = *(const u32x4*)(Hh + (rowbase + tok) * NPAD + G_V + head * 128 + vc16);
    }
  };
  gload(seg * SLEN);
  for (int ci = 0; ci < SLEN; ++ci) {
    const int cidx = seg * SLEN + ci;
    const int chunk = dir ? (63 - cidx) : cidx;
    {
      unsigned char* d = smem + L_RAW + qrow * 128 + qc8 * 2;
      if (do_out) *(u32x4*)d = pre[0];
      *(u32x4*)(d + 8192) = pre[1];
      sLow[qrow * 16 + (tid & 7) * 2] = plow0; sLow[qrow * 16 + (tid & 7) * 2 + 1] = plow1;
#pragma unroll
      for (int j = 0; j < 2; ++j) *(u32x4*)(smem + L_RAW + 16384 + (vrow0 + 32 * j) * 256 + vc16 * 2) = pre[2 + j];
    }
    __syncthreads();
    if (ci + 1 < SLEN) gload(cidx + 1);
    float r0 = 0.f, r1 = 0.f;
#pragma unroll
    for (int i = 0; i < 4; ++i) {
      const int tau = 4 * tg + i;
      float g0 = gb0, g1 = gb1;
#pragma unroll
      for (int r4 = 0; r4 < 4; ++r4) {
        const float4 lw = *(const float4*)(sLow + tau * 16 + 4 * r4);
        g0 += lw.x * w2a[4 * r4] + lw.y * w2a[4 * r4 + 1] + lw.z * w2a[4 * r4 + 2] + lw.w * w2a[4 * r4 + 3];
        g1 += lw.x * w2b[4 * r4] + lw.y * w2b[4 * r4 + 1] + lw.z * w2b[4 * r4 + 2] + lw.w * w2b[4 * r4 + 3];
      }
      const float l0 = (fminf(g0, 0.f) * LOG2E - lg2(1.f + ex2(-fabsf(g0) * LOG2E))) * (1.f / 16.f);
      const float l1 = (fminf(g1, 0.f) * LOG2E - lg2(1.f + ex2(-fabsf(g1) * LOG2E))) * (1.f / 16.f);
      *(float2*)(sG + tau * 64 + ch0) = make_float2(l0, l1);
      r0 += l0; r1 += l1;
    }
    *(float2*)(sTot + tg * 64 + ch0) = make_float2(r0, r1);
    __syncthreads();
    float off0 = 0.f, off1 = 0.f, ref0 = 0.f, ref1 = 0.f, be0 = 0.f, be1 = 0.f;
#pragma unroll
    for (int j = 0; j < 16; ++j) {
      const float2 t = *(const float2*)(sTot + j * 64 + ch0);
      if (j < tg) { off0 += t.x; off1 += t.y; }
      if (j < 8) { ref0 += t.x; ref1 += t.y; }
      be0 += t.x; be1 += t.y;
    }
    dlog0 += be0; dlog1 += be1;
    const float eref0 = ex2(ref0), eref1 = ex2(ref1), ebr0 = ex2(be0 - ref0), ebr1 = ex2(be1 - ref1);
    float b0 = off0, b1 = off1;
    float kh0[4], kh1[4];
#pragma unroll
    for (int i = 0; i < 4; ++i) {
      const int tau = 4 * tg + i;
      const float2 gg = *(const float2*)(sG + tau * 64 + ch0);
      b0 += gg.x; b1 += gg.y;
      const float E0 = ex2(b0 - ref0), E1 = ex2(b1 - ref1);
      const unsigned uk = rawK[tau * 32 + cp];
      const float kt0 = lo16(uk) * frcp(E0), kt1 = hi16(uk) * frcp(E1);
      if (do_out) {
        const unsigned uq = rawQ[tau * 32 + cp];
        const float qt0 = lo16(uq) * 0.125f * E0, qt1 = hi16(uq) * 0.125f * E1;
        sQt[tau * KPW + cp] = cvtpk(qt0, qt1);
        sKt[tau * KPW + cp] = cvtpk(kt0, kt1);
        sQc[tau * KPW + cp] = cvtpk(qt0 * eref0, qt1 * eref1);
      }
      kh0[i] = kt0 * ebr0; kh1[i] = kt1 * ebr1;
    }
    *(uint2*)(sKhT + ch0 * 72 + 4 * tg) = make_uint2(cvtpk(kh0[0], kh0[1]), cvtpk(kh0[2], kh0[3]));
    *(uint2*)(sKhT + (ch0 + 1) * 72 + 4 * tg) = make_uint2(cvtpk(kh1[0], kh1[1]), cvtpk(kh1[2], kh1[3]));
    {
      unsigned vv[8];
#pragma unroll
      for (int i = 0; i < 8; ++i) vv[i] = rawV[(8 * vg + i) * 64 + vp2];
      *(u32x4*)(sVT + (2 * vp2) * 72 + 8 * vg) = (u32x4){(vv[0] & 0xffffu) | (vv[1] << 16), (vv[2] & 0xffffu) | (vv[3] << 16), (vv[4] & 0xffffu) | (vv[5] << 16), (vv[6] & 0xffffu) | (vv[7] << 16)};
      *(u32x4*)(sVT + (2 * vp2 + 1) * 72 + 8 * vg) = (u32x4){(vv[0] >> 16) | (vv[1] & 0xffff0000u), (vv[2] >> 16) | (vv[3] & 0xffff0000u), (vv[4] >> 16) | (vv[5] & 0xffff0000u), (vv[6] >> 16) | (vv[7] & 0xffff0000u)};
    }
    if (tg == 0) *(float2*)(sD + ch0) = make_float2(ex2(be0), ex2(be1));
    __syncthreads();
    scan_core<K, V, false>(smem, S, OB + (rowbase + (size_t)chunk * 64) * 512 + head * 128, dir, w, lane, do_out);
  }
  if (!do_out) {
    state_store<K, V>(sbuf, S, w, lane);
    if (tg == 0) *(float2*)((float*)(p.ws + OFF_DB) + ((size_t)it * NSEG + seg) * 128 + ch0) = make_float2(ex2(dlog0), ex2(dlog1));
  }
}

DEV void ssd_item(const Params& p, int l, int it, int seg, int mode, unsigned char* smem) {
  const int j32 = it - 32, bl = j32 >> 4, head = (j32 >> 1) & 7, dir = j32 & 1;
  const bool do_out = (mode == 3);
  constexpr int K = 128, V = 64, KP = 136, KPW = 68;
  const int tid = launder(threadIdx.x), lane = tid & 63, w = tid >> 6;
  const int cp = tid & 63, tg = tid >> 6, n0 = 2 * cp;
  const int pp = tid & 63;
  const int grp = head >> 2;
  const bf16_t* U = (const bf16_t*)(p.ws + OFF_U);
  const float* SMALL = (const float*)(p.ws + OFF_SMALL);
  bf16_t* OB = (bf16_t*)(p.ws + OFF_OBUF) + (size_t)(1 * 2 + dir) * TH * 512;
  const size_t rowbase = (size_t)bl * SEQ;
  const unsigned* sQt = (const unsigned*)(smem + L_QT); const unsigned* sKt = (const unsigned*)(smem + L_KT); unsigned* sQc = (unsigned*)(smem + L_QC);
  bf16_t* sKhT = (bf16_t*)(smem + L_KHT); bf16_t* sVT = (bf16_t*)(smem + L_VT);
  float* sD = (float*)(smem + L_D); float* sAcs = (float*)(smem + L_ACS); float* sDt = (float*)(smem + L_DT);
  const bf16_t* rawX = (const bf16_t*)(smem + L_RAW);
  const float dtb = p.dt_bias[(l * 2 + dir) * 8 + head];
  const float Acoef = -__expf(p.a_log[(l * 2 + dir) * 8 + head]) * LOG2E;
  f32x16 S[1]; S[0] = zero16();
  float* sbuf = (float*)(p.ws + OFF_SB2) + ((size_t)j32 * NSEG + seg) * 8192;
  if (do_out) state_load<K, V>(sbuf, S, w, lane);
  float dlog = 0.f;
  u32x4 pre[5];
  float rdt = 0.f;
  const int prow0 = tid >> 4, pc16 = (tid & 15) * 8, xrow = tid >> 3, xc8 = (tid & 7) * 8;
  auto gload = [&](int cidx) __attribute__((always_inline)) {
    const int chunk = dir ? (63 - cidx) : cidx;
#pragma unroll
    for (int j = 0; j < 2; ++j) {
      const int row = prow0 + 32 * j;
      const int tok = chunk * 64 + (dir ? (63 - row) : row);
      const bf16_t* rp = U + (rowbase + tok) * 1024 + grp * 128 + pc16;
      pre[j] = *(const u32x4*)(rp + 512);
      if (do_out) pre[2 + j] = *(const u32x4*)(rp + 768);
    }
    {
      const int tok = chunk * 64 + (dir ? (63 - xrow) : xrow);
      pre[4] = *(const u32x4*)(U + (rowbase + tok) * 1024 + head * 64 + xc8);
    }
    if (w == 0) {
      const int tok = chunk * 64 + (dir ? (63 - lane) : lane);
      rdt = SMALL[(rowbase + tok) * 48 + dir * 8 + head];
    }
  };
  gload(seg * SLEN);
  for (int ci = 0; ci < SLEN; ++ci) {
    const int cidx = seg * SLEN + ci;
    const int chunk = dir ? (63 - cidx) : cidx;
#pragma unroll
    for (int j = 0; j < 2; ++j) {
      const int row = prow0 + 32 * j;
      *(u32x4*)(smem + L_KT + row * (KP * 2) + pc16 * 2) = pre[j];
      if (do_out) *(u32x4*)(smem + L_QT + row * (KP * 2) + pc16 * 2) = pre[2 + j];
    }
    *(u32x4*)(smem + L_RAW + xrow * 128 + xc8 * 2) = pre[4];
    if (w == 0) {
      const float xx = rdt + dtb;
      const float dt = (xx > 20.f) ? xx : log1pf(__expf(xx));
      float a = dt * Acoef;
#pragma unroll
      for (int o = 1; o < 64; o <<= 1) { const float t = __shfl_up(a, o); if (lane >= o) a += t; }
      sAcs[lane] = a; sDt[lane] = dt;
    }
    __syncthreads();
    if (ci + 1 < SLEN) gload(cidx + 1);
    const float aend = sAcs[63];
    dlog += aend;
    {
      float kh0[8], kh1[8];
#pragma unroll
      for (int i = 0; i < 8; ++i) {
        const int tau = 8 * tg + i;
        const float ac = sAcs[tau];
        const unsigned ub = sKt[tau * KPW + cp];
        const float eb = ex2(aend - ac);
        kh0[i] = lo16(ub) * eb; kh1[i] = hi16(ub) * eb;
        if (do_out) {
          const unsigned uc = sQt[tau * KPW + cp];
          const float ea = ex2(ac);
          sQc[tau * KPW + cp] = cvtpk(lo16(uc) * ea, hi16(uc) * ea);
        }
      }
      *(u32x4*)(sKhT + n0 * 72 + 8 * tg) = (u32x4){cvtpk(kh0[0], kh0[1]), cvtpk(kh0[2], kh0[3]), cvtpk(kh0[4], kh0[5]), cvtpk(kh0[6], kh0[7])};
      *(u32x4*)(sKhT + (n0 + 1) * 72 + 8 * tg) = (u32x4){cvtpk(kh1[0], kh1[1]), cvtpk(kh1[2], kh1[3]), cvtpk(kh1[4], kh1[5]), cvtpk(kh1[6], kh1[7])};
      float xv[8];
#pragma unroll
      for (int i = 0; i < 8; ++i) { const int tau = 8 * tg + i; xv[i] = bf2f(rawX[tau * 64 + pp]) * sDt[tau]; }
      *(u32x4*)(sVT + pp * 72 + 8 * tg) = (u32x4){cvtpk(xv[0], xv[1]), cvtpk(xv[2], xv[3]), cvtpk(xv[4], xv[5]), cvtpk(xv[6], xv[7])};
      if (tg == 0) *(float2*)(sD + n0) = make_float2(ex2(aend), ex2(aend));
    }
    __syncthreads();
    scan_core<K, V, true>(smem, S, OB + (rowbase + (size_t)chunk * 64) * 512 + head * 64, dir, w, lane, do_out);
  }
  if (!do_out) {
    state_store<K, V>(sbuf, S, w, lane);
    if (tg == 0) *(float2*)((float*)(p.ws + OFF_DB) + ((size_t)it * NSEG + seg) * 128 + n0) = make_float2(ex2(dlog), ex2(dlog));
  }
}

DEV void phase_prep(const Params& p, int l, int hf, unsigned char* smem) {
  const int tid = launder(threadIdx.x), lane = tid & 63, w = tid >> 6;
  bf16_t* Hh = (bf16_t*)(p.ws + OFF_H);
  {
    const int cg8 = (tid & 127) * 8, rsub = tid >> 7;
    bf16_t* U = (bf16_t*)(p.ws + OFF_U);
    const float* cw = p.conv_w + (size_t)l * 5 * 1024; const float* cb = p.conv_b + (size_t)l * 1024;
    float wv[5][8], bv[8];
#pragma unroll
    for (int j = 0; j < 5; ++j)
#pragma unroll
      for (int e = 0; e < 8; ++e) wv[j][e] = cw[j * 1024 + cg8 + e];
#pragma unroll
    for (int e = 0; e < 8; ++e) bv[e] = cb[cg8 + e];
    for (int r = blockIdx.x * 4 + rsub; r < TH; r += gridDim.x * 4) {
      const int t = r & (SEQ - 1);
      float u[8];
#pragma unroll
      for (int e = 0; e < 8; ++e) u[e] = bv[e];
#pragma unroll
      for (int j = 0; j < 5; ++j) {
        const int s = t + j - 2;
        if (s >= 0 && s < SEQ) {
          const u32x4 x = *(const u32x4*)(Hh + (size_t)(r + j - 2) * NPAD + S_X + cg8);
#pragma unroll
          for (int e = 0; e < 4; ++e) { u[2 * e] += wv[j][2 * e] * lo16(x[e]); u[2 * e + 1] += wv[j][2 * e + 1] * hi16(x[e]); }
        }
      }
      u32x4 o;
#pragma unroll
      for (int e = 0; e < 4; ++e) {
        const float a = u[2 * e] * frcp(1.f + ex2(fminf(-u[2 * e] * LOG2E, 80.f)));
        const float b = u[2 * e + 1] * frcp(1.f + ex2(fminf(-u[2 * e + 1] * LOG2E, 80.f)));
        o[e] = cvtpk(a, b);
      }
      *(u32x4*)(U + (size_t)r * 1024 + cg8) = o;
    }
  }
  {
    const float2* tabg = (const float2*)(p.ws + OFF_TAB);
    float2* stab = (float2*)smem;
    __syncthreads();
    for (int i = tid; i < 1024; i += NT) stab[i] = tabg[i];
    __syncthreads();
    const int i16 = lane & 15, grp = lane >> 4;
    const float* gq = p.q_gain + l * 64 + 4 * i16; const float* gk = p.k_gain + l * 64 + 4 * i16;
    const float gqv[4] = {gq[0], gq[1], gq[2], gq[3]}, gkv[4] = {gk[0], gk[1], gk[2], gk[3]};
    constexpr int NQ = TH * 10 / 4, UNR = 5;
    const int nw = gridDim.x * 8;
    for (int pq0 = blockIdx.x * 8 + w; pq0 < NQ; pq0 += nw * UNR) {
      uint2 xr[UNR]; bf16_t* ptr[UNR]; int rowv[UNR]; bool isqv[UNR]; bool ok[UNR];
#pragma unroll
      for (int u = 0; u < UNR; ++u) {
        const int pq = pq0 + u * nw;
        ok[u] = pq < NQ;
        const int pi = (ok[u] ? pq : 0) * 4 + grp, row = pi / 10, hd = pi - row * 10;
        rowv[u] = row; isqv[u] = hd < 8;
        ptr[u] = Hh + (size_t)row * NPAD + (isqv[u] ? (A_Q + hd * 64) : (A_K + (hd - 8) * 64)) + 4 * i16;
        xr[u] = *(const uint2*)ptr[u];
      }
#pragma unroll
      for (int u = 0; u < UNR; ++u) {
        const float x[4] = {lo16(xr[u].x), hi16(xr[u].x), lo16(xr[u].y), hi16(xr[u].y)};
        float ss = x[0] * x[0] + x[1] * x[1] + x[2] * x[2] + x[3] * x[3];
        ss += __shfl_xor(ss, 1); ss += __shfl_xor(ss, 2); ss += __shfl_xor(ss, 4); ss += __shfl_xor(ss, 8);
        const float rstd = rsqrtf(ss * (1.f / 64.f) + 1e-6f);
        const int t = rowv[u] & (SEQ - 1);
        const int pos = (i16 < 8) ? (t >> 6) : (t & 63);
        const float osc = isqv[u] ? QSCALE : 1.f;
        float o[4];
#pragma unroll
        for (int e = 0; e < 4; ++e) {
          const float v = x[e] * rstd * (isqv[u] ? gqv[e] : gkv[e]);
          const float pv = __shfl_xor(v, 4);
          const float2 cs = stab[pos * 16 + 4 * (i16 & 3) + e];
          o[e] = ((i16 & 4) ? (v * cs.x + pv * cs.y) : (v * cs.x - pv * cs.y)) * osc;
        }
        if (ok[u]) *(uint2*)ptr[u] = make_uint2(cvtpk(o[0], o[1]), cvtpk(o[2], o[3]));
      }
    }
  }
  {
    bf16_t* VT = (bf16_t*)(p.ws + OFF_VT);
    bf16_t* sT = (bf16_t*)smem;
    for (int tile = blockIdx.x; tile < TH / 64; tile += gridDim.x) {
      __syncthreads();
#pragma unroll
      for (int j = 0; j < 2; ++j) {
        const int id = tid + 512 * j, rr = id >> 4, c8 = (id & 15) * 8;
        *(u32x4*)(sT + rr * 136 + c8) = *(const u32x4*)(Hh + (size_t)(tile * 64 + rr) * NPAD + A_V + c8);
      }
      __syncthreads();
      const int c = tid >> 2, tq = (tid & 3) * 16;
      unsigned v[16];
#pragma unroll
      for (int i = 0; i < 16; ++i) v[i] = sT[(tq + i) * 136 + c];
      const int row0 = tile * 64, bl = row0 >> 12, t0 = (row0 & (SEQ - 1)) + tq;
      bf16_t* dst = VT + ((size_t)((bl * 2 + (c >> 6)) * 64 + (c & 63))) * SEQ + t0;
      *(u32x4*)dst = (u32x4){v[0] | (v[1] << 16), v[2] | (v[3] << 16), v[4] | (v[5] << 16), v[6] | (v[7] << 16)};
      *(u32x4*)(dst + 8) = (u32x4){v[8] | (v[9] << 16), v[10] | (v[11] << 16), v[12] | (v[13] << 16), v[14] | (v[15] << 16)};
    }
    __syncthreads();
  }
}

DEV void phase_mix(const Params& p, int l, int hf, int slot, int mode, int att_lo, int att_hi, int vid_lo, int vid_hi, unsigned char* smem) {
  unsigned* ctr = (unsigned*)(p.ws + OFF_CTRL) + CTR_WORD0 + slot * 16;
  volatile int* sItem = (volatile int*)(smem + LDS_BYTES - 16);
  const int n_scan = 64 * NSEG;
  int hi = n_scan + (att_hi - att_lo); if (vid_hi < hi) hi = vid_hi;
  for (;;) {
    __syncthreads();
    if (threadIdx.x == 0) *sItem = vid_lo + (int)atomicAdd(ctr, 1u);
    __syncthreads();
    const int vid = *sItem;
    if (vid >= hi) break;
    if (vid < n_scan) {
      const int seg = vid >> 6, it = vid & 63;
      if (it < 16) { if (PH_MASK & 0x100) hgrn_item(p, l, it, seg, mode, smem); }
      else if (it < 32) { if (PH_MASK & 0x200) gla_item(p, l, it, seg, mode, smem); }
      else { if (PH_MASK & 0x400) ssd_item(p, l, it, seg, mode, smem); }
    } else { if (PH_MASK & 0x800) attn_item(p, l, att_lo + (vid - n_scan), smem); }
  }
}

DEV void phase_scan2(const Params& p) {
  const size_t gtid = (size_t)blockIdx.x * NT + threadIdx.x, gsz = (size_t)gridDim.x * NT;
  const float* DB = (const float*)(p.ws + OFF_DB);
  for (size_t e = gtid; e < 655360; e += gsz) {
    float* buf; const float* dp; int stride;
    if (e < 262144) { const int it = (int)(e >> 14), idx = (int)(e & 16383); buf = (float*)(p.ws + OFF_SB0) + (size_t)it * NSEG * 16384 + idx; stride = 16384; dp = DB + (size_t)it * NSEG * 128 + (idx >> 7); }
    else if (e < 393216) { const int e2 = (int)(e - 262144), j = e2 >> 13, idx = e2 & 8191; buf = (float*)(p.ws + OFF_SB1) + (size_t)j * NSEG * 8192 + idx; stride = 8192; dp = DB + (size_t)(16 + j) * NSEG * 128 + (idx >> 7); }
    else { const int e3 = (int)(e - 393216), j = e3 >> 13, idx = e3 & 8191; buf = (float*)(p.ws + OFF_SB2) + (size_t)j * NSEG * 8192 + idx; stride = 8192; dp = DB + (size_t)(32 + j) * NSEG * 128 + (idx >> 6); }
    float u[NSEG], d[NSEG];
#pragma unroll
    for (int sg = 0; sg < NSEG; ++sg) { u[sg] = buf[(size_t)sg * stride]; d[sg] = dp[sg * 128]; }
    float st = 0.f;
#pragma unroll
    for (int sg = 0; sg < NSEG; ++sg) { buf[(size_t)sg * stride] = st; st = d[sg] * st + u[sg]; }
  }
}

DEV void phase_fin(const Params& p, int l, int hf) {
  const int tid = launder(threadIdx.x), lane = tid & 63, w = tid >> 6;
  const bf16_t* Hh = (const bf16_t*)(p.ws + OFF_H);
  const bf16_t* OB = (const bf16_t*)(p.ws + OFF_OBUF);
  bf16_t* MX = (bf16_t*)(p.ws + OFF_MIXED);
  const int c0 = lane * 8;
  const float* cw = p.conv_w + (size_t)l * 5 * 1024; const float* cb = p.conv_b + (size_t)l * 1024;
  for (int r = blockIdx.x * 8 + w; r < TH; r += gridDim.x * 8) {
    const bf16_t* hrow = Hh + (size_t)r * NPAD;
    *(u32x4*)(MX + (size_t)r * DI + c0) = *(const u32x4*)(hrow + A_Q + c0);
    {
      const uint4 a = *(const uint4*)(OB + ((size_t)0 * TH + r) * 512 + c0), b = *(const uint4*)(OB + ((size_t)1 * TH + r) * 512 + c0);
      const uint4 z = *(const uint4*)(hrow + H_Z + c0);
      const unsigned au[4] = {a.x, a.y, a.z, a.w}, bu[4] = {b.x, b.y, b.z, b.w}, zu[4] = {z.x, z.y, z.z, z.w};
      float o[8]; float ss = 0.f;
#pragma unroll
      for (int j = 0; j < 4; ++j) {
        o[2 * j] = bf2f((bf16_t)(au[j] & 0xffff)) + bf2f((bf16_t)(bu[j] & 0xffff));
        o[2 * j + 1] = bf2f((bf16_t)(au[j] >> 16)) + bf2f((bf16_t)(bu[j] >> 16));
        ss += o[2 * j] * o[2 * j] + o[2 * j + 1] * o[2 * j + 1];
      }
#pragma unroll
      for (int of = 32; of >= 1; of >>= 1) ss += __shfl_xor(ss, of);
      const float rstd = rsqrtf(ss * (1.f / 512.f) + 1e-6f);
      float y[8];
#pragma unroll
      for (int j = 0; j < 8; ++j) {
        const float zz = bf2f((bf16_t)((j & 1) ? (zu[j >> 1] >> 16) : (zu[j >> 1] & 0xffff)));
        y[j] = o[j] * rstd * p.hgrn_norm[l * 512 + c0 + j] * fsilu(zz);
      }
      uint4 ov; ov.x = pk2(y[0], y[1]); ov.y = pk2(y[2], y[3]); ov.z = pk2(y[4], y[5]); ov.w = pk2(y[6], y[7]);
      *(uint4*)(MX + (size_t)r * DI + 512 + c0) = ov;
    }
    {
      const uint4 a = *(const uint4*)(OB + ((size_t)4 * TH + r) * 512 + c0), b = *(const uint4*)(OB + ((size_t)5 * TH + r) * 512 + c0);
      const uint4 z = *(const uint4*)(hrow + G_Z + c0);
      const unsigned au[4] = {a.x, a.y, a.z, a.w}, bu[4] = {b.x, b.y, b.z, b.w}, zu[4] = {z.x, z.y, z.z, z.w};
      float o[8]; float ss = 0.f;
#pragma unroll
      for (int j = 0; j < 4; ++j) {
        o[2 * j] = bf2f((bf16_t)(au[j] & 0xffff)) + bf2f((bf16_t)(bu[j] & 0xffff));
        o[2 * j + 1] = bf2f((bf16_t)(au[j] >> 16)) + bf2f((bf16_t)(bu[j] >> 16));
        ss += o[2 * j] * o[2 * j] + o[2 * j + 1] * o[2 * j + 1];
      }
#pragma unroll
      for (int of = 8; of >= 1; of >>= 1) ss += __shfl_xor(ss, of);
      const float rstd = rsqrtf(ss * (1.f / 128.f) + 1e-6f);
      float y[8];
#pragma unroll
      for (int j = 0; j < 8; ++j) {
        const float zz = bf2f((bf16_t)((j & 1) ? (zu[j >> 1] >> 16) : (zu[j >> 1] & 0xffff)));
        y[j] = o[j] * rstd * p.gla_norm[l * 128 + ((c0 + j) & 127)] * fsilu(zz);
      }
      uint4 ov; ov.x = pk2(y[0], y[1]); ov.y = pk2(y[2], y[3]); ov.z = pk2(y[4], y[5]); ov.w = pk2(y[6], y[7]);
      *(uint4*)(MX + (size_t)r * DI + 1536 + c0) = ov;
    }
    {
      const uint4 a = *(const uint4*)(OB + ((size_t)2 * TH + r) * 512 + c0), b = *(const uint4*)(OB + ((size_t)3 * TH + r) * 512 + c0);
      const uint4 z = *(const uint4*)(hrow + S_Z + c0);
      const unsigned au[4] = {a.x, a.y, a.z, a.w}, bu[4] = {b.x, b.y, b.z, b.w}, zu[4] = {z.x, z.y, z.z, z.w};
      float u[8];
#pragma unroll
      for (int j = 0; j < 8; ++j) u[j] = cb[c0 + j];
      const int t = r & (SEQ - 1);
#pragma unroll
      for (int jj = 0; jj < 5; ++jj) {
        const int s = t + jj - 2;
        if (s >= 0 && s < SEQ) {
          const uint4 xr = *(const uint4*)(Hh + (size_t)(r + jj - 2) * NPAD + S_X + c0);
          const unsigned xu[4] = {xr.x, xr.y, xr.z, xr.w};
#pragma unroll
          for (int j = 0; j < 8; ++j) {
            const float xv = bf2f((bf16_t)((j & 1) ? (xu[j >> 1] >> 16) : (xu[j >> 1] & 0xffff)));
            u[j] += cw[jj * 1024 + c0 + j] * xv;
          }
        }
      }
      const float dsk = p.ssd_d[l * 8 + (c0 >> 6)];
      float y[8]; float ss = 0.f;
#pragma unroll
      for (int j = 0; j < 8; ++j) {
        const float of = bf2f((bf16_t)((j & 1) ? (au[j >> 1] >> 16) : (au[j >> 1] & 0xffff)));
        const float ob = bf2f((bf16_t)((j & 1) ? (bu[j >> 1] >> 16) : (bu[j >> 1] & 0xffff)));
        const float zz = bf2f((bf16_t)((j & 1) ? (zu[j >> 1] >> 16) : (zu[j >> 1] & 0xffff)));
        y[j] = (of + ob + dsk * fsilu(u[j])) * fsilu(zz);
        ss += y[j] * y[j];
      }
#pragma unroll
      for (int of = 32; of >= 1; of >>= 1) ss += __shfl_xor(ss, of);
      const float rstd = rsqrtf(ss * (1.f / 512.f) + 1e-6f);
#pragma unroll
      for (int j = 0; j < 8; ++j) y[j] = y[j] * rstd * p.ssd_norm[l * 512 + c0 + j];
      uint4 ov; ov.x = pk2(y[0], y[1]); ov.y = pk2(y[2], y[3]); ov.z = pk2(y[4], y[5]); ov.w = pk2(y[6], y[7]);
      *(uint4*)(MX + (size_t)r * DI + 1024 + c0) = ov;
    }
  }
}


#define XB_TMO      128
#define XB_XCNT(j)  (256  + 64 * (j))
#define XB_XSUB(j)  (1280 + 64 * (j))
#define XB_XGEN(j)  (2304 + 64 * (j))
#define XB_TOP      3328
#define XB_TOPGEN   3392
#define XB_SPIN_CAP (1u << 22)
#define LAS __attribute__((address_space(3)))
DEV unsigned xb_ld(unsigned* p) { return __hip_atomic_load(p, __ATOMIC_RELAXED, __HIP_MEMORY_SCOPE_AGENT); }
DEV unsigned xb_add(unsigned* p, unsigned v) { return __hip_atomic_fetch_add(p, v, __ATOMIC_RELAXED, __HIP_MEMORY_SCOPE_AGENT); }
DEV unsigned xb_xcc_id() { return (unsigned)__builtin_amdgcn_s_getreg((3 << 11) | 20) & 0xFu; }
#define XB_SPIN(cond, bar) do { unsigned _sp = 0; while (cond) { __builtin_amdgcn_s_sleep(1); \
    if ((++_sp & 255u) == 0u) { if (xb_ld(&(bar)[XB_TMO])) break; if (_sp > XB_SPIN_CAP) { atomicAdd(&(bar)[XB_TMO], 1u); break; } } } } while (0)
struct XcdBarrier { unsigned* bar; unsigned x; volatile LAS unsigned* st; };
DEV XcdBarrier xcd_barrier_post(unsigned* bar, volatile LAS unsigned* st) {
  XcdBarrier b; b.bar = bar; b.x = xb_xcc_id(); b.st = st;
  if (threadIdx.x == 0) (void)xb_add(&bar[XB_XCNT(b.x)], 1u);
  return b;
}
DEV void xcd_barrier_complete(unsigned* bar, unsigned x, unsigned& nloc, unsigned& nx) {
  const unsigned G = gridDim.x * gridDim.y * gridDim.z;
  unsigned sum, cnt, mine, sp = 0u;
  for (;;) {
    sum = 0u; cnt = 0u; mine = 0u;
#pragma unroll
    for (unsigned j = 0; j < 16; ++j) { const unsigned c = xb_ld(&bar[XB_XCNT(j)]); sum += c; cnt += (c > 0u) ? 1u : 0u; mine = (j == x) ? c : mine; }
    if (sum == G) break;
    __builtin_amdgcn_s_sleep(1);
    if ((++sp & 255u) == 0u) { if (xb_ld(&bar[XB_TMO])) break; if (sp > XB_SPIN_CAP) { atomicAdd(&bar[XB_TMO], 1u); break; } }
  }
  nloc = mine > 0u ? mine : 1u; nx = cnt > 0u ? cnt : 1u;
}
DEV void xcd_barrier(const XcdBarrier& b) {
  asm volatile("s_waitcnt vmcnt(0)" ::: "memory");
  __syncthreads();
  if (threadIdx.x == 0) {
    unsigned* bar = b.bar;
    __builtin_amdgcn_s_waitcnt(0);
    unsigned nloc = b.st[0], nx = b.st[1];
    if (nloc == 0u) { xcd_barrier_complete(bar, b.x, nloc, nx); b.st[0] = nloc; b.st[1] = nx; }
    const unsigned old = xb_add(&bar[XB_XSUB(b.x)], 1u);
    const unsigned gen = old / nloc;
    if (old + 1u == (gen + 1u) * nloc) {
      __builtin_amdgcn_fence(__ATOMIC_RELEASE, "agent");
      asm volatile("s_waitcnt vmcnt(0)" ::: "memory");
      const unsigned og = xb_add(&bar[XB_TOP], 1u);
      const unsigned tg = og / nx;
      if (og + 1u == (tg + 1u) * nx) xb_add(&bar[XB_TOPGEN], 1u);
      else XB_SPIN(xb_ld(&bar[XB_TOPGEN]) == tg, bar);
      __builtin_amdgcn_fence(__ATOMIC_ACQUIRE, "agent");
      xb_add(&bar[XB_XGEN(b.x)], 1u);
      asm volatile("s_waitcnt vmcnt(0)" ::: "memory");
    } else {
      XB_SPIN(xb_ld(&bar[XB_XGEN(b.x)]) == gen, bar);
      __builtin_amdgcn_fence(__ATOMIC_ACQUIRE, "agent");
      asm volatile("s_waitcnt vmcnt(0)" ::: "memory");
    }
  }
  __syncthreads();
}

#ifndef PROBE_ST
#define PROBE_ST -1
#endif
#ifndef PROBE_REP
#define PROBE_REP 0
#endif
#ifndef PROBE_LO
#define PROBE_LO 0
#endif
#ifndef PROBE_HI
#define PROBE_HI 100000
#endif
DEV void run_phase(const Params& p, int ph, int rep, unsigned char* smem) {
  if (ph == 0) { if (PH_MASK & 1) phase_pro(p, smem); }
  if ((PH_MASK & 1) && (ph == 0 || ph == 16)) convert_weights(p, ph == 0 ? 0 : 1, smem);
  if (ph != 0) {
    const int q = ph - 1, l = q / 16, hf = (q / 8) & 1, st = q % 8;
    if (st == 0) { if (PH_MASK & 2) phase_inproj(p, l, hf, smem); }
    else if (st == 1) { if (PH_MASK & 4) phase_prep(p, l, hf, smem); }
    else if (st == 2) { if (PH_MASK & 0xF00) phase_mix(p, l, hf, ph + 40 * rep, 1, 0, ATT_SPLIT, rep ? PROBE_LO : 0, rep ? PROBE_HI : 100000, smem); }
    else if (st == 3) { if (PH_MASK & 0x700) phase_scan2(p); }
    else if (st == 4) { if (PH_MASK & 0xF00) phase_mix(p, l, hf, ph + 40 * rep, 3, ATT_SPLIT, 256, rep ? PROBE_LO : 0, rep ? PROBE_HI : 100000, smem); }
    else if (st == 5) { if (PH_MASK & 8) phase_fin(p, l, hf); }
    else if (st == 6) { if (PH_MASK & 16) phase_outproj(p, l, hf, smem); }
    else {
      if (PH_MASK & 32) phase_ln(p, l, hf);
    }
  }
}
__global__ void __launch_bounds__(NT) mega(Params p) {
  extern __shared__ __attribute__((aligned(16))) unsigned char smem[];
#if ONE_LAUNCH
  volatile LAS unsigned* xst = (volatile LAS unsigned*)(smem + LDS_BYTES - 32);
  if (threadIdx.x == 0) { xst[0] = 0u; xst[1] = 0u; }
  __syncthreads();
  XcdBarrier xb = xcd_barrier_post((unsigned*)(p.ws + OFF_CTRL), xst);
#endif
  Params* lp = (Params*)(smem + 147456);
  if (threadIdx.x == 0) *lp = p;
  __syncthreads();
  const int ph_begin = p.phase_begin, ph_end = p.phase_end;
  for (int ph = ph_begin; ph < ph_end; ++ph) {
    int nrep = 0;
#if PROBE_REP > 0
    {
      const int q = ph - 1, l = q / 16, st = q % 8;
      const bool idem = (ph == 0) ? (PROBE_ST == 9) : (st == PROBE_ST && (st != 6 || l == 0));
      if (idem) nrep = PROBE_REP;
    }
#endif
    for (int r = 0; r <= nrep; ++r) {
      run_phase(*lp, ph, r, smem);
#if ONE_LAUNCH
      if (r < nrep || ph + 1 < ph_end) xcd_barrier(xb);
#endif
    }
  }
}

extern "C" void kernel_launch(void* const* d_in, const int* in_sizes, int n_in, void* d_out, int out_size, void* d_ws, size_t ws_size,
                              hipStream_t stream) {
  static int grid_blocks = 0;
  if (!grid_blocks) {
    int dev = 0, cus = 0, per_cu = 0;
    hipGetDevice(&dev);
    hipDeviceGetAttribute(&cus, hipDeviceAttributeMultiprocessorCount, dev);
    hipFuncSetAttribute((const void*)mega, hipFuncAttributeMaxDynamicSharedMemorySize, LDS_BYTES);
    hipOccupancyMaxActiveBlocksPerMultiprocessor(&per_cu, mega, NT, LDS_BYTES);
    if (per_cu < 1) per_cu = 1;
    grid_blocks = cus;
  }
  Params p{};
  p.x = (const float*)d_in[0]; p.w_in = (const float*)d_in[1]; p.q_gain = (const float*)d_in[2]; p.k_gain = (const float*)d_in[3];
  p.lb_logits = (const float*)d_in[4]; p.hgrn_norm = (const float*)d_in[5]; p.conv_w = (const float*)d_in[6]; p.conv_b = (const float*)d_in[7];
  p.dt_bias = (const float*)d_in[8]; p.a_log = (const float*)d_in[9]; p.ssd_d = (const float*)d_in[10]; p.ssd_norm = (const float*)d_in[11];
  p.gk_w2 = (const float*)d_in[12]; p.gk_b = (const float*)d_in[13]; p.gla_norm = (const float*)d_in[14]; p.w_out = (const float*)d_in[15];
  p.ln_g = (const float*)d_in[16]; p.ln_b = (const float*)d_in[17];
  p.out = (float*)d_out; p.ws = (unsigned char*)d_ws;
  hipMemsetAsync(d_ws, 0, CTRL_BYTES, stream);
#if ONE_LAUNCH
  p.phase_begin = 0; p.phase_end = NPHASE;
  void* args[] = {&p};
  (void)args;
  hipLaunchKernelGGL(mega, dim3(grid_blocks), dim3(NT), LDS_BYTES, stream, p);
#else
  for (int ph = 0; ph < NPHASE; ++ph) {
    p.phase_begin = ph; p.phase_end = ph + 1;
    hipLaunchKernelGGL(mega, dim3(grid_blocks), dim3(NT), LDS_BYTES, stream, p);
  }
#endif
}
```

```cpp
#include <hip/hip_runtime.h>
#include <hip/hip_cooperative_groups.h>
#include <stdint.h>
#include <stdio.h>
namespace cg = cooperative_groups;

#ifndef ONE_LAUNCH
#define ONE_LAUNCH 1
#endif

#ifndef PH_MASK
#define PH_MASK 0xFFF
#endif
#ifndef PROBE_ST
#define PROBE_ST -1
#endif
#ifndef PROBE_REP
#define PROBE_REP 0
#endif
#ifndef PROBE_TYPE
#define PROBE_TYPE -1
#endif
#ifndef PROBE_LO
#define PROBE_LO 0
#endif
#ifndef PROBE_HI
#define PROBE_HI 100000
#endif
#define DEV __device__ __forceinline__
typedef unsigned short bf16_t;
typedef short bf16x8 __attribute__((ext_vector_type(8)));
typedef float f32x16 __attribute__((ext_vector_type(16)));
typedef unsigned u32x4 __attribute__((ext_vector_type(4)));

constexpr int NT = 512;
constexpr int T_ALL = 16384, TH = 8192, SEQ = 4096, DM = 1024, NPAD = 7168, DI = 2048, NIN = 6960;
constexpr int A_Q = 0, A_K = 512, A_V = 640, A_Z = 768, H_Q = 1280, H_FF = 1792, H_FB = 2304, H_I = 2816, H_Z = 3328,
              S_X = 3840, S_Z = 4864, G_Q = 5376, G_K = 5632, G_V = 5888, G_Z = 6400, SM0 = 6912;
constexpr size_t OFF_CTRL = 0, OFF_TAB = 65536, OFF_XB = 131072;
constexpr size_t OFF_WIN = OFF_XB + (size_t)T_ALL * DM * 2;
constexpr size_t OFF_WOUT = OFF_WIN + (size_t)NPAD * DM * 2;
constexpr size_t OFF_H = OFF_WOUT + (size_t)DM * DI * 2;
constexpr size_t OFF_SMALL = OFF_H + (size_t)TH * NPAD * 2;
constexpr size_t OFF_OBUF = OFF_SMALL + (size_t)TH * 48 * 4;
constexpr size_t OFF_VT = OFF_OBUF + (size_t)6 * TH * 512 * 2;
constexpr size_t OFF_DB = OFF_VT + (size_t)2 * 2 * 64 * SEQ * 2;
constexpr int NSEG = 4, SLEN = 64 / NSEG;
constexpr size_t OFF_MIXED = OFF_DB + (size_t)64 * NSEG * 128 * 4;
constexpr size_t OFF_SB0 = OFF_MIXED, OFF_SB1 = OFF_SB0 + (size_t)16 * NSEG * 16384 * 4, OFF_SB2 = OFF_SB1 + (size_t)16 * NSEG * 8192 * 4;
constexpr size_t OFF_U = OFF_SB2 + (size_t)32 * NSEG * 8192 * 4;
constexpr size_t WS_END = (OFF_U + (size_t)TH * 1024 * 2 > OFF_MIXED + (size_t)TH * DI * 2) ? (OFF_U + (size_t)TH * 1024 * 2) : (OFF_MIXED + (size_t)TH * DI * 2);
static_assert(OFF_MIXED + (size_t)TH * DI * 2 <= WS_END, "MIXED must fit");
static_assert(WS_END <= 268435456, "workspace");
constexpr size_t CTRL_BYTES = 65536;
constexpr int CTR_WORD0 = 4096;
constexpr int LDS_BYTES = 148480;
constexpr float LOG2E = 1.4426950408889634f;
constexpr float QSCALE = 0.125f * LOG2E;
constexpr float DN_ALPHA = 1.4142135623730951f;
constexpr int NPHASE = 33;
constexpr int ATT_SPLIT = 144;

struct Params {
  const float* x; const float* w_in; const float* q_gain; const float* k_gain; const float* lb_logits; const float* hgrn_norm;
  const float* conv_w; const float* conv_b; const float* dt_bias; const float* a_log; const float* ssd_d; const float* ssd_norm;
  const float* gk_w2; const float* gk_b; const float* gla_norm; const float* w_out; const float* ln_g; const float* ln_b;
  float* out; unsigned char* ws;
  int phase_begin, phase_end;
};

DEV void lds_barrier() { asm volatile("s_waitcnt lgkmcnt(0)" ::: "memory"); __builtin_amdgcn_s_barrier(); asm volatile("" ::: "memory"); }
DEV int launder(int v) { asm volatile("" : "+v"(v)); return v; }
DEV float bf2f(bf16_t v) { return __uint_as_float(((unsigned)v) << 16); }
DEV bf16_t f2bf(float f) { unsigned u = __float_as_uint(f); u += 0x7fffu + ((u >> 16) & 1u); return (bf16_t)(u >> 16); }
DEV unsigned pk2(float lo, float hi) { unsigned r; asm("v_cvt_pk_bf16_f32 %0, %1, %2" : "=v"(r) : "v"(lo), "v"(hi)); return r; }
DEV float fsigmoid(float x) { return 1.f / (1.f + __expf(-x)); }
DEV float fsilu(float x) { return x / (1.f + __expf(-x)); }
DEV unsigned cvtpk(float lo, float hi) { unsigned r; asm("v_cvt_pk_bf16_f32 %0, %1, %2" : "=v"(r) : "v"(lo), "v"(hi)); return r; }
DEV float ex2(float x) { return __builtin_amdgcn_exp2f(x); }
DEV float lg2(float x) { return __builtin_amdgcn_logf(x); }
DEV float frcp(float x) { return __builtin_amdgcn_rcpf(x); }
DEV float lo16(unsigned u) { return __uint_as_float(u << 16); }
DEV float hi16(unsigned u) { return __uint_as_float(u & 0xffff0000u); }
DEV int rowoff(int reg, int h) { return (reg & 3) + 8 * (reg >> 2) + 4 * h; }
DEV f32x16 zero16() { f32x16 z;
#pragma unroll
  for (int i = 0; i < 16; ++i) z[i] = 0.f; return z; }

template <int KD>
DEV void mma32(f32x16& acc, const bf16_t* a, int lda, const bf16_t* b, int ldb, int lane) {
  const int r = lane & 31, h = lane >> 5;
  const bf16_t* ap = a + r * lda + 8 * h;
  const bf16_t* bp = b + r * ldb + 8 * h;
#pragma unroll 4
  for (int k = 0; k < KD; k += 16) {
    bf16x8 av = *(const bf16x8*)(ap + k);
    bf16x8 bv = *(const bf16x8*)(bp + k);
    acc = __builtin_amdgcn_mfma_f32_32x32x16_bf16(av, bv, acc, 0, 0, 0);
  }
}

DEV int orig_col(int n) {
  if (n < 4864) return n;
  if (n < 6400) return n + 16;
  if (n < 6912) return n + 48;
  if (n < 6928) return n - 2048;
  if (n < 6960) return n - 512;
  return -1;
}

DEV void convert_weights(const Params& p, int l, unsigned char* smem) {
  float* s = (float*)smem;
  const int tid = launder(threadIdx.x);
  const float* win = p.w_in + (size_t)l * DM * NIN;
  const float* wout = p.w_out + (size_t)l * DI * DM;
  bf16_t* wint = (bf16_t*)(p.ws + OFF_WIN);
  bf16_t* woutt = (bf16_t*)(p.ws + OFF_WOUT);
  const int n_in_tiles = (NPAD / 64) * (DM / 64);
  const int n_out_tiles = (DM / 64) * (DI / 64);
  for (int it = blockIdx.x; it < n_in_tiles + n_out_tiles; it += gridDim.x) {
    lds_barrier();
    if (it < n_in_tiles) {
      const int n0 = (it / 16) * 64, k0 = (it % 16) * 64;
#pragma unroll
      for (int e = 0; e < 8; ++e) {
        const int idx = e * NT + tid, kk = idx >> 6, nn = idx & 63;
        const int oc = orig_col(n0 + nn);
        s[kk * 65 + nn] = (oc >= 0) ? win[(size_t)(k0 + kk) * NIN + oc] : 0.f;
      }
      lds_barrier();
      const int n = tid >> 3, kc = (tid & 7) * 8;
      uint4 o;
      o.x = pk2(s[(kc + 0) * 65 + n], s[(kc + 1) * 65 + n]); o.y = pk2(s[(kc + 2) * 65 + n], s[(kc + 3) * 65 + n]);
      o.z = pk2(s[(kc + 4) * 65 + n], s[(kc + 5) * 65 + n]); o.w = pk2(s[(kc + 6) * 65 + n], s[(kc + 7) * 65 + n]);
      *(uint4*)(wint + (size_t)(n0 + n) * DM + k0 + kc) = o;
    } else {
      const int j = it - n_in_tiles;
      const int n0 = (j / 32) * 64, k0 = (j % 32) * 64;
#pragma unroll
      for (int e = 0; e < 8; ++e) {
        const int idx = e * NT + tid, kk = idx >> 6, nn = idx & 63;
        s[kk * 65 + nn] = wout[(size_t)(k0 + kk) * DM + n0 + nn];
      }
      lds_barrier();
      const int n = tid >> 3, kc = (tid & 7) * 8;
      uint4 o;
      o.x = pk2(s[(kc + 0) * 65 + n], s[(kc + 1) * 65 + n]); o.y = pk2(s[(kc + 2) * 65 + n], s[(kc + 3) * 65 + n]);
      o.z = pk2(s[(kc + 4) * 65 + n], s[(kc + 5) * 65 + n]); o.w = pk2(s[(kc + 6) * 65 + n], s[(kc + 7) * 65 + n]);
      *(uint4*)(woutt + (size_t)(n0 + n) * DI + k0 + kc) = o;
    }
  }
  lds_barrier();
}

DEV void fsincos(float x, float& s, float& c) {
  const float k = rintf(x * 0.63661977236758134308f);
  float r = fmaf(-k, 1.5707855225e+00f, x);
  r = fmaf(-k, 1.0804273188e-05f, r);
  r = fmaf(-k, 6.0770999344e-11f, r);
  const float r2 = r * r;
  float ps = fmaf(r2, 2.7557319224e-06f, -1.9841269841e-04f);
  ps = fmaf(ps, r2, 8.3333333333e-03f); ps = fmaf(ps, r2, -1.6666666667e-01f);
  const float sinr = fmaf(ps * r2, r, r);
  float pc = fmaf(r2, -2.7557319224e-07f, 2.4801587302e-05f);
  pc = fmaf(pc, r2, -1.3888888889e-03f); pc = fmaf(pc, r2, 4.1666666667e-02f); pc = fmaf(pc, r2, -0.5f);
  const float cosr = fmaf(pc, r2, 1.0f);
  const int q = ((int)k) & 3;
  if (q == 0) { s = sinr; c = cosr; }
  else if (q == 1) { s = cosr; c = -sinr; }
  else if (q == 2) { s = -sinr; c = -cosr; }
  else { s = -cosr; c = sinr; }
}

DEV void phase_pro(const Params& p, unsigned char* smem) {
  const int tid = launder(threadIdx.x);
  const size_t gtid = (size_t)blockIdx.x * NT + tid, gsz = (size_t)gridDim.x * NT;
  const float4* x4 = (const float4*)p.x;
  uint4* xb4 = (uint4*)(p.ws + OFF_XB);
  for (size_t i = gtid; i < (size_t)T_ALL * DM / 8; i += gsz) {
    const float4 a = x4[2 * i], b = x4[2 * i + 1];
    uint4 o; o.x = pk2(a.x, a.y); o.y = pk2(a.z, a.w); o.z = pk2(b.x, b.y); o.w = pk2(b.z, b.w);
    xb4[i] = o;
  }
  if (blockIdx.x == 0) {
    float2* tab = (float2*)(p.ws + OFF_TAB);
    for (int i = tid; i < 64 * 16; i += NT) {
      const int pos = i >> 4, fi = i & 15;
      const float invf = exp2f(-(float)fi * (13.287712379549449f / 16.0f));
      const float ang = (float)pos * invf;
      float sn, cs; fsincos(ang, sn, cs);
      tab[i] = make_float2(cs, sn);
    }
  }
}

namespace pg8 {
#define PG8_LAS __attribute__((address_space(3)))
typedef unsigned short bf16_t;
typedef short bf16x8 __attribute__((ext_vector_type(8)));
typedef float f32x4 __attribute__((ext_vector_type(4)));
typedef unsigned u32x4 __attribute__((ext_vector_type(4)));
constexpr int BM = 256, BK = 64, HALF = 128, HTB = HALF * BK * 2  , STAGE_BYTES = 8 * HTB, NXCD = 8, WGM = 8;

__host__ __device__ __forceinline__ int lds_byte(int r, int c) { const int st = (r >> 4) * 2 + (c >> 5), rr = r & 15, cc = c & 31, ob = rr * 64 + cc * 2; return st * 1024 + (ob ^ (((ob >> 9) & 1) << 5)); }
__host__ __device__ __forceinline__ void stage_rc(int b, int& R, int& C) { const int st = b / 1024, sb = b % 1024, swz = sb ^ (((sb >> 9) & 1) << 5); R = (st >> 1) * 16 + swz / 64; C = (st & 1) * 32 + (swz % 64) / 2; }
__host__ __device__ __forceinline__ int perm32(int rho) { const int n = rho >> 4, i = rho & 15; return 8 * (i >> 2) + 4 * n + (i & 3); }

struct Unit { int pm, pn; };
struct Gemm { const bf16_t* A; const bf16_t* Bt; int M, N, K; };

__device__ __forceinline__ unsigned cvt_pk_bf16(float lo, float hi) { unsigned r; asm volatile("v_cvt_pk_bf16_f32 %0, %1, %2" : "=v"(r) : "v"(lo), "v"(hi)); return r; }

struct XcdOrder {
    int rpx, nN, x, c, ncu;
    __device__ void init(int M, int N) { rpx = (M / BM) / NXCD; nN = N / BM; x = blockIdx.x & 7; c = blockIdx.x >> 3; ncu = gridDim.x >> 3; }
    __device__ bool next(int i, Unit& u) const { const int j = c + i * ncu; if (j >= rpx * nN) return false; u.pm = rpx * x + (j % rpx); u.pn = j / rpx; return true; }
    __device__ __forceinline__ void a_ready(const Unit&) const {}
    __device__ __forceinline__ void done(const Unit&) const {}
};
struct EpiIn {
    static constexpr bool PERM = true, AFTER_DRAIN = false;
    bf16_t* O; int ldc; float* small; int small_pn;
    __device__ __forceinline__ void operator()(const f32x4 (&acc)[2][2][4][2], const Unit& u, int wr, int wc, int fr, int fq) const {
        const int row0 = u.pm * BM + wr * 64 + fr, col0 = u.pn * BM + wc * 32 + 8 * fq;
        if (u.pn == small_pn) {
            const int c = wc * 32 + 8 * fq;
            if (c < 48) {
#pragma unroll
                for (int ai = 0; ai < 2; ++ai)
#pragma unroll
                    for (int m = 0; m < 4; ++m) { float* rp = small + (size_t)(row0 + ai * HALF + m * 16) * 48 + c; *(f32x4*)rp = acc[ai][0][m][0]; *(f32x4*)(rp + 4) = acc[ai][0][m][1]; }
            }
            return;
        }
#pragma unroll
        for (int ai = 0; ai < 2; ++ai)
#pragma unroll
            for (int m = 0; m < 4; ++m) { bf16_t* rowp = O + (size_t)(row0 + ai * HALF + m * 16) * ldc + col0;
#pragma unroll
                for (int bj = 0; bj < 2; ++bj) { const f32x4 v0 = acc[ai][bj][m][0], v1 = acc[ai][bj][m][1];
                    u32x4 w; w.x = cvt_pk_bf16(v0[0], v0[1]); w.y = cvt_pk_bf16(v0[2], v0[3]); w.z = cvt_pk_bf16(v1[0], v1[1]); w.w = cvt_pk_bf16(v1[2], v1[3]);
                    *(u32x4*)(rowp + bj * HALF) = w; } }
    }
};
struct EpiOut {
    static constexpr bool PERM = true, AFTER_DRAIN = false;
    const float* X; float* Y; int ldc; float alpha;
    __device__ __forceinline__ void operator()(const f32x4 (&acc)[2][2][4][2], const Unit& u, int wr, int wc, int fr, int fq) const {
        const int row0 = u.pm * BM + wr * 64 + fr, col0 = u.pn * BM + wc * 32 + 8 * fq;
#pragma unroll
        for (int ai = 0; ai < 2; ++ai)
#pragma unroll
            for (int m = 0; m < 4; ++m) { const size_t off = (size_t)(row0 + ai * HALF + m * 16) * ldc + col0;
#pragma unroll
                for (int bj = 0; bj < 2; ++bj) { const f32x4 x0 = *(const f32x4*)(X + off + bj * HALF), x1 = *(const f32x4*)(X + off + bj * HALF + 4);
                    *(f32x4*)(Y + off + bj * HALF) = x0 * alpha + acc[ai][bj][m][0]; *(f32x4*)(Y + off + bj * HALF + 4) = x1 * alpha + acc[ai][bj][m][1]; } }
    }
};

template <class Epi, class Sched, bool ALIGN_EPI = false, bool SP2 = false>
__device__ __forceinline__ void gemm_phase(PG8_LAS unsigned char* lds, const Gemm g, const Sched& S, const Epi& E) {
    const int tid = launder((int)threadIdx.x), wid = __builtin_amdgcn_readfirstlane(tid >> 6), lane = tid & 63, wr = wid >> 2, wc = wid & 3, fr = lane & 15, fq = lane >> 4;
    const int K = g.K, nt = K / BK;
    unsigned voffA[2], voffB[2];
#pragma unroll
    for (int i = 0; i < 2; ++i) { int R, C; stage_rc(tid * 16 + i * 8192, R, C); const int Rb = Epi::PERM ? ((R & ~31) + perm32(R & 31)) : R;
        voffA[i] = (unsigned)(R * K + C) * 2u; voffB[i] = (unsigned)(Rb * K + C) * 2u; }
    const size_t kstep = (size_t)(BK * 2);
    const size_t hstep = (size_t)HALF * K * 2;
    const size_t tstep = 2 * hstep;
    const unsigned ldsw = (unsigned)wid * 1024u;
    const int aoff = lds_byte(wr * 64 + fr, fq * 8), boff = lds_byte(wc * 32 + fr, fq * 8);
#define PG8_SA(b, h) (((b) * 2 + (h)) * HTB)
#define PG8_SB(b, h) ((4 + (b) * 2 + (h)) * HTB)
#define PG8_STAGE(bufoff, gbase, voff) do { _Pragma("unroll") for (int _i = 0; _i < 2; ++_i) \
        __builtin_amdgcn_global_load_lds((const unsigned*)((const char*)(gbase) + (voff)[_i]), (PG8_LAS unsigned*)(lds + (bufoff) + ldsw + _i * 8192), 16, 0, 0); } while (0)
#define PG8_LDA(dst, b, h) do { _Pragma("unroll") for (int m = 0; m < 4; ++m) _Pragma("unroll") for (int k = 0; k < 2; ++k) dst[m][k] = *(const PG8_LAS bf16x8*)(lds + PG8_SA(b, h) + aoff + m * 2048 + k * 1024); } while (0)
#define PG8_LDB(dst, b, h) do { _Pragma("unroll") for (int n = 0; n < 2; ++n) _Pragma("unroll") for (int k = 0; k < 2; ++k) dst[n][k] = *(const PG8_LAS bf16x8*)(lds + PG8_SB(b, h) + boff + n * 2048 + k * 1024); } while (0)
#define PG8_MMA(ai, bj, At, Bt) do { __builtin_amdgcn_s_setprio(1); _Pragma("unroll") for (int m = 0; m < 4; ++m) _Pragma("unroll") for (int n = 0; n < 2; ++n) _Pragma("unroll") for (int k = 0; k < 2; ++k) \
        acc[ai][bj][m][n] = __builtin_amdgcn_mfma_f32_16x16x32_bf16(Bt[n][k], At[m][k], acc[ai][bj][m][n], 0, 0, 0); __builtin_amdgcn_s_setprio(0); } while (0)
#define PG8_WAIT_V(n) asm volatile("s_waitcnt vmcnt(" #n ")" ::: "memory")
#define PG8_WAIT_L(n) asm volatile("s_waitcnt lgkmcnt(" #n ")" ::: "memory")
#define PG8_BAR __builtin_amdgcn_s_barrier()
#define PG8_SCHED __builtin_amdgcn_sched_barrier(0)
    Unit cur, nxt; int ui = 0;
    if (!S.next(0, cur)) return;
    f32x4 acc[2][2][4][2];
#pragma unroll
    for (int a = 0; a < 2; ++a)
#pragma unroll
        for (int b = 0; b < 2; ++b)
#pragma unroll
            for (int m = 0; m < 4; ++m)
#pragma unroll
                for (int n = 0; n < 2; ++n) acc[a][b][m][n] = (f32x4){0.f, 0.f, 0.f, 0.f};
    bf16x8 At[4][2], B0[2][2], B1[2][2];
    const char* cA = (const char*)g.A + (size_t)cur.pm * tstep; const char* cB = (const char*)g.Bt + (size_t)cur.pn * tstep;
    S.a_ready(cur);
    if constexpr (SP2) {
        PG8_STAGE(PG8_SB(0, 0), cB, voffB); PG8_STAGE(PG8_SB(0, 1), cB + hstep, voffB); PG8_STAGE(PG8_SA(0, 0), cA, voffA); PG8_STAGE(PG8_SA(0, 1), cA + hstep, voffA);
        if (wr == 1) PG8_BAR;
        PG8_WAIT_V(2); PG8_BAR;
        PG8_STAGE(PG8_SB(1, 0), cB + kstep, voffB); PG8_STAGE(PG8_SA(1, 0), cA + kstep, voffA); PG8_STAGE(PG8_SB(1, 1), cB + hstep + kstep, voffB);
        PG8_WAIT_V(6); PG8_BAR;
    } else {
        PG8_STAGE(PG8_SB(0, 0), cB, voffB); PG8_STAGE(PG8_SA(0, 0), cA, voffA); PG8_STAGE(PG8_SB(0, 1), cB + hstep, voffB); PG8_STAGE(PG8_SA(0, 1), cA + hstep, voffA);
        if (wr == 1) PG8_BAR;
        PG8_WAIT_V(4); PG8_BAR;
        PG8_STAGE(PG8_SB(1, 0), cB + kstep, voffB); PG8_STAGE(PG8_SA(1, 0), cA + kstep, voffA); PG8_STAGE(PG8_SB(1, 1), cB + hstep + kstep, voffB);
        PG8_WAIT_V(6); PG8_BAR;
    }
    for (;;) {
        const bool has_next = S.next(ui + 1, nxt);
        const char* nA = has_next ? (const char*)g.A + (size_t)nxt.pm * tstep : cA; const char* nB = has_next ? (const char*)g.Bt + (size_t)nxt.pn * tstep : cB;
        for (int t = 0; t < nt; t += 2) {
            const bool last = (t == nt - 2);
            const char* a1 = cA + (size_t)(t + 1) * kstep;
            const char* a2 = last ? nA : cA + (size_t)(t + 2) * kstep; const char* b2 = last ? nB : cB + (size_t)(t + 2) * kstep;
            const char* a3 = a2 + kstep; const char* b3 = b2 + kstep;
            if (last && has_next) S.a_ready(nxt);
            if constexpr (SP2) {
            PG8_LDB(B0, 0, 0); PG8_LDB(B1, 0, 1); PG8_SCHED; PG8_LDA(At, 0, 0); PG8_STAGE(PG8_SA(1, 1), a1 + hstep, voffA);
            PG8_WAIT_V(8); PG8_WAIT_L(0); PG8_BAR; PG8_MMA(0, 0, At, B0); PG8_MMA(0, 1, At, B1); PG8_BAR; PG8_SCHED;
            PG8_LDA(At, 0, 1); PG8_STAGE(PG8_SB(0, 0), b2, voffB); PG8_STAGE(PG8_SB(0, 1), b2 + hstep, voffB); PG8_STAGE(PG8_SA(0, 0), a2, voffA);
            PG8_WAIT_V(8); PG8_WAIT_L(0); PG8_BAR; PG8_MMA(1, 0, At, B0); PG8_MMA(1, 1, At, B1); PG8_BAR; PG8_SCHED;
            PG8_LDB(B0, 1, 0); PG8_LDB(B1, 1, 1); PG8_SCHED; PG8_LDA(At, 1, 0); PG8_STAGE(PG8_SA(0, 1), a2 + hstep, voffA);
            PG8_WAIT_V(8); PG8_WAIT_L(0); PG8_BAR; PG8_MMA(0, 0, At, B0); PG8_MMA(0, 1, At, B1); PG8_BAR; PG8_SCHED;
            PG8_LDA(At, 1, 1); PG8_STAGE(PG8_SB(1, 0), b3, voffB); PG8_STAGE(PG8_SB(1, 1), b3 + hstep, voffB); PG8_STAGE(PG8_SA(1, 0), a3, voffA);
            PG8_WAIT_V(8); PG8_WAIT_L(0); PG8_BAR; PG8_MMA(1, 0, At, B0); PG8_MMA(1, 1, At, B1); PG8_BAR; PG8_SCHED;
            } else {
            PG8_LDB(B0, 0, 0); PG8_SCHED; PG8_LDA(At, 0, 0); PG8_STAGE(PG8_SA(1, 1), a1 + hstep, voffA);
            PG8_WAIT_L(8); PG8_BAR; PG8_WAIT_L(0); PG8_MMA(0, 0, At, B0); PG8_BAR; PG8_SCHED;
            PG8_LDB(B1, 0, 1); PG8_STAGE(PG8_SB(0, 0), b2, voffB);
            PG8_BAR; PG8_WAIT_L(0); PG8_MMA(0, 1, At, B1); PG8_BAR;
            PG8_LDA(At, 0, 1); PG8_STAGE(PG8_SA(0, 0), a2, voffA);
            PG8_BAR; PG8_WAIT_L(0); PG8_MMA(1, 0, At, B0); PG8_BAR; PG8_SCHED;
            PG8_STAGE(PG8_SB(0, 1), b2 + hstep, voffB);
            PG8_WAIT_V(6); PG8_BAR; PG8_MMA(1, 1, At, B1); PG8_BAR;
            PG8_LDB(B0, 1, 0); PG8_SCHED; PG8_LDA(At, 1, 0); PG8_STAGE(PG8_SA(0, 1), a2 + hstep, voffA);
            PG8_WAIT_L(8); PG8_BAR; PG8_WAIT_L(0); PG8_MMA(0, 0, At, B0); PG8_BAR; PG8_SCHED;
            PG8_LDB(B1, 1, 1); PG8_STAGE(PG8_SB(1, 0), b3, voffB);
            PG8_BAR; PG8_WAIT_L(0); PG8_MMA(0, 1, At, B1); PG8_BAR;
            PG8_LDA(At, 1, 1); PG8_STAGE(PG8_SA(1, 0), a3, voffA);
            PG8_BAR; PG8_WAIT_L(0); PG8_MMA(1, 0, At, B0); PG8_BAR; PG8_SCHED;
            PG8_STAGE(PG8_SB(1, 1), b3 + hstep, voffB);
            PG8_WAIT_V(6); PG8_BAR; PG8_MMA(1, 1, At, B1); PG8_BAR;
            }
        }
        if constexpr (ALIGN_EPI) { if (wr == 0) PG8_BAR; }
        if constexpr (!Epi::AFTER_DRAIN) { E(acc, cur, wr, wc, fr, fq); S.done(cur); }
        if (!has_next) break;
#pragma unroll
        for (int a = 0; a < 2; ++a)
#pragma unroll
            for (int b = 0; b < 2; ++b)
#pragma unroll
                for (int m = 0; m < 4; ++m)
#pragma unroll
                    for (int n = 0; n < 2; ++n) acc[a][b][m][n] = (f32x4){0.f, 0.f, 0.f, 0.f};
        cur = nxt; cA = nA; cB = nB; ++ui;
        if constexpr (ALIGN_EPI) { if (wr == 1) PG8_BAR; }
    }
    PG8_WAIT_V(0);
    if constexpr (!ALIGN_EPI) { if (wr == 0) PG8_BAR; }
    PG8_BAR;
    if constexpr (Epi::AFTER_DRAIN) { E.fused(acc, cur, wr, wc, fr, fq, lds, wid, lane); S.done(cur); }
#undef PG8_SA
#undef PG8_SB
#undef PG8_STAGE
#undef PG8_LDA
#undef PG8_LDB
#undef PG8_MMA
#undef PG8_WAIT_V
#undef PG8_WAIT_L
#undef PG8_BAR
#undef PG8_SCHED
}
}

DEV void phase_inproj(const Params& p, int l, int hf, unsigned char* smem) {
  pg8::Gemm g{(const bf16_t*)(p.ws + OFF_XB) + (size_t)hf * TH * DM, (const bf16_t*)(p.ws + OFF_WIN), TH, NPAD, DM};
  pg8::XcdOrder S; S.init(TH, NPAD);
  pg8::EpiIn E{(bf16_t*)(p.ws + OFF_H), NPAD, (float*)(p.ws + OFF_SMALL), SM0 / 256};
  pg8::gemm_phase<pg8::EpiIn, pg8::XcdOrder, true, true>((PG8_LAS unsigned char*)smem, g, S, E);
}

DEV void phase_outproj(const Params& p, int l, int hf, unsigned char* smem) {
  pg8::Gemm g{(const bf16_t*)(p.ws + OFF_MIXED), (const bf16_t*)(p.ws + OFF_WOUT), TH, DM, DI};
  pg8::XcdOrder S; S.init(TH, DM);
  const float* xin = ((l == 0) ? p.x : p.out) + (size_t)hf * TH * DM;
  pg8::EpiOut E{xin, p.out + (size_t)hf * TH * DM, DM, DN_ALPHA};
  pg8::gemm_phase<pg8::EpiOut, pg8::XcdOrder, true, true>((PG8_LAS unsigned char*)smem, g, S, E);
}

DEV void phase_ln(const Params& p, int l, int hf) {
  const int tid = launder(threadIdx.x), lane = tid & 63, w = tid >> 6;
  const float* g = p.ln_g + l * DM; const float* b = p.ln_b + l * DM;
  bf16_t* xb = (bf16_t*)(p.ws + OFF_XB);
  for (int r = blockIdx.x * 8 + w; r < TH; r += gridDim.x * 8) {
    const int row = hf * TH + r;
    float4* rp = (float4*)(p.out + (size_t)row * DM);
    float4 v[4];
    float s = 0.f;
#pragma unroll
    for (int j = 0; j < 4; ++j) { v[j] = rp[j * 64 + lane]; s += (v[j].x + v[j].y) + (v[j].z + v[j].w); }
#pragma unroll
    for (int o = 32; o >= 1; o >>= 1) s += __shfl_xor(s, o);
    const float mu = s * (1.f / DM);
    float q = 0.f;
#pragma unroll
    for (int j = 0; j < 4; ++j) { const float a = v[j].x - mu, bb = v[j].y - mu, cc = v[j].z - mu, d = v[j].w - mu; q += (a * a + bb * bb) + (cc * cc + d * d); }
#pragma unroll
    for (int o = 32; o >= 1; o >>= 1) q += __shfl_xor(q, o);
    const float rstd = rsqrtf(q * (1.f / DM) + 1e-5f);
#pragma unroll
    for (int j = 0; j < 4; ++j) {
      const int col = (j * 64 + lane) * 4;
      const float4 gg = *(const float4*)(g + col), bb = *(const float4*)(b + col);
      float4 o;
      o.x = (v[j].x - mu) * rstd * gg.x + bb.x; o.y = (v[j].y - mu) * rstd * gg.y + bb.y;
      o.z = (v[j].z - mu) * rstd * gg.z + bb.z; o.w = (v[j].w - mu) * rstd * gg.w + bb.w;
      rp[j * 64 + lane] = o;
      if (l == 0) { uint2 pk; pk.x = pk2(o.x, o.y); pk.y = pk2(o.z, o.w); *(uint2*)(xb + (size_t)row * DM + col) = pk; }
    }
  }
}

DEV void attn_item(const Params& p, int l, int item, unsigned char* smem) {
  const int tid = launder(threadIdx.x), lane = tid & 63, w = tid >> 6, r = lane & 31, h = lane >> 5;
  const int qt = item & 15, head = (item >> 4) & 7, bl = item >> 7;
  const int kvh = head >> 2;
  bf16_t* Hh = (bf16_t*)(p.ws + OFF_H);
  const bf16_t* VT = (const bf16_t*)(p.ws + OFF_VT);
  const size_t rowbase = (size_t)bl * SEQ;
  float mq = fabsf(p.q_gain[l * 64 + lane]), mk = fabsf(p.k_gain[l * 64 + lane]);
#pragma unroll
  for (int o = 32; o >= 1; o >>= 1) { mq = fmaxf(mq, __shfl_xor(mq, o)); mk = fmaxf(mk, __shfl_xor(mk, o)); }
  const float M2 = 8.f * mq * mk * LOG2E * 1.01f;
  const int qrow = qt * 256 + w * 32 + r;
  const bf16_t* qp = Hh + (rowbase + qrow) * NPAD + A_Q + head * 64 + 8 * h;
  bf16x8 qf[4];
#pragma unroll
  for (int ks = 0; ks < 4; ++ks) qf[ks] = *(const bf16x8*)(qp + ks * 16);
  f32x16 o0 = zero16(), o1 = zero16();
  float lsum = 0.f;
  const int srow = tid >> 3, sch = (tid & 7) * 8;
  const bf16_t* kp = Hh + (rowbase + srow) * NPAD + A_K + kvh * 64 + sch;
  const bf16_t* vp = VT + ((size_t)((bl * 2 + kvh) * 64 + srow)) * SEQ + sch;
  auto compute = [&](int st) __attribute__((always_inline)) {
    const bf16_t* sK = (const bf16_t*)(smem + st * 18432);
    const bf16_t* sV = (const bf16_t*)(smem + st * 18432 + 9216);
    f32x16 s0, s1;
#pragma unroll
    for (int i = 0; i < 16; ++i) { s0[i] = -M2; s1[i] = -M2; }
#pragma unroll
    for (int ks = 0; ks < 4; ++ks) {
      const bf16x8 a0 = *(const bf16x8*)(sK + r * 72 + ks * 16 + 8 * h);
      const bf16x8 a1 = *(const bf16x8*)(sK + (32 + r) * 72 + ks * 16 + 8 * h);
      s0 = __builtin_amdgcn_mfma_f32_32x32x16_bf16(a0, qf[ks], s0, 0, 0, 0);
      s1 = __builtin_amdgcn_mfma_f32_32x32x16_bf16(a1, qf[ks], s1, 0, 0, 0);
    }
#pragma unroll
    for (int i = 0; i < 16; ++i) { s0[i] = __builtin_amdgcn_exp2f(s0[i]); s1[i] = __builtin_amdgcn_exp2f(s1[i]); lsum += s0[i] + s1[i]; }
    union { bf16x8 v; unsigned u[4]; } pb[2][2];
#pragma unroll
    for (int s = 0; s < 2; ++s)
#pragma unroll
      for (int j = 0; j < 4; ++j) {
        pb[0][s].u[j] = pk2(s0[8 * s + 2 * j], s0[8 * s + 2 * j + 1]);
        pb[1][s].u[j] = pk2(s1[8 * s + 2 * j], s1[8 * s + 2 * j + 1]);
      }
#pragma unroll
    for (int kt2 = 0; kt2 < 2; ++kt2)
#pragma unroll
      for (int s = 0; s < 2; ++s) {
        const int kb = kt2 * 32 + 16 * s + 4 * h;
        union { bf16x8 v; uint2 u[2]; } a0, a1;
        a0.u[0] = *(const uint2*)(sV + r * 72 + kb); a0.u[1] = *(const uint2*)(sV + r * 72 + kb + 8);
        a1.u[0] = *(const uint2*)(sV + (32 + r) * 72 + kb); a1.u[1] = *(const uint2*)(sV + (32 + r) * 72 + kb + 8);
        o0 = __builtin_amdgcn_mfma_f32_32x32x16_bf16(a0.v, pb[kt2][s].v, o0, 0, 0, 0);
        o1 = __builtin_amdgcn_mfma_f32_32x32x16_bf16(a1.v, pb[kt2][s].v, o1, 0, 0, 0);
      }
  };
  constexpr int NKT = SEQ / 64;
  u32x4 k0 = *(const u32x4*)kp, v0 = *(const u32x4*)vp;
  u32x4 k1 = *(const u32x4*)(kp + (size_t)64 * NPAD), v1 = *(const u32x4*)(vp + 64);
  *(u32x4*)(smem + srow * 144 + sch * 2) = k0;
  *(u32x4*)(smem + 9216 + srow * 144 + sch * 2) = v0;
  k0 = *(const u32x4*)(kp + (size_t)2 * 64 * NPAD); v0 = *(const u32x4*)(vp + 2 * 64);
  lds_barrier();
  for (int kt = 0; kt < NKT; kt += 2) {
    *(u32x4*)(smem + 18432 + srow * 144 + sch * 2) = k1;
    *(u32x4*)(smem + 18432 + 9216 + srow * 144 + sch * 2) = v1;
    if (kt + 3 < NKT) { k1 = *(const u32x4*)(kp + (size_t)(kt + 3) * 64 * NPAD); v1 = *(const u32x4*)(vp + (kt + 3) * 64); }
    compute(0);
    lds_barrier();
    if (kt + 2 < NKT) {
      *(u32x4*)(smem + srow * 144 + sch * 2) = k0;
      *(u32x4*)(smem + 9216 + srow * 144 + sch * 2) = v0;
      if (kt + 4 < NKT) { k0 = *(const u32x4*)(kp + (size_t)(kt + 4) * 64 * NPAD); v0 = *(const u32x4*)(vp + (kt + 4) * 64); }
    }
    compute(1);
    lds_barrier();
  }
  lsum += __shfl_xor(lsum, 32);
  const float inv = 1.f / lsum;
  const bf16_t* zp = Hh + (rowbase + qrow) * NPAD + A_Z + head * 64;
  bf16_t* op = Hh + (rowbase + qrow) * NPAD + A_Q + head * 64;
#pragma unroll
  for (int dt = 0; dt < 2; ++dt)
#pragma unroll
    for (int g = 0; g < 4; ++g) {
      const int d0 = dt * 32 + 8 * g + 4 * h;
      const uint2 zz = *(const uint2*)(zp + d0);
      const float z0 = bf2f((bf16_t)(zz.x & 0xffff)), z1 = bf2f((bf16_t)(zz.x >> 16)), z2 = bf2f((bf16_t)(zz.y & 0xffff)), z3 = bf2f((bf16_t)(zz.y >> 16));
      const f32x16& oo = dt ? o1 : o0;
      uint2 ov;
      ov.x = pk2(oo[4 * g + 0] * inv * fsilu(z0), oo[4 * g + 1] * inv * fsilu(z1));
      ov.y = pk2(oo[4 * g + 2] * inv * fsilu(z2), oo[4 * g + 3] * inv * fsilu(z3));
      *(uint2*)(op + d0) = ov;
    }
  lds_barrier();
}

constexpr int L_QT = 0, L_KT = 17408, L_QC = 34816, L_KHT = 52224, L_VT = 70656, L_P = 89088, L_ST = 98304, L_RAW = 89088,
              L_D = 138240, L_TOT = 138752, L_ACS = 142848, L_DT = 143104, L_LOW = 143360;

template <int K, int V> struct ScanGeom {
  static constexpr int KP = K + 8;
  static constexpr int NS = (K / 32) * (V / 32) / 8;
};

template <int K, int V>
DEV void scan_write_state(unsigned char* smem, const f32x16* S, int w, int lane) {
  constexpr int KP = K + 8, NS = ScanGeom<K, V>::NS, NVT = V / 32;
  bf16_t* sST = (bf16_t*)(smem + L_ST);
  const int c = lane & 31, h = lane >> 5;
#pragma unroll
  for (int i = 0; i < NS; ++i) {
    const int tile = w * NS + i, kt = tile / NVT, nt = tile % NVT;
#pragma unroll
    for (int g = 0; g < 4; ++g) {
      uint2 o; o.x = pk2(S[i][4 * g + 0], S[i][4 * g + 1]); o.y = pk2(S[i][4 * g + 2], S[i][4 * g + 3]);
      *(uint2*)(sST + (nt * 32 + c) * KP + kt * 32 + 8 * g + 4 * h) = o;
    }
  }
}

template <int K, int V, bool SSDM>
DEV void scan_core(unsigned char* smem, f32x16* S, bf16_t* orow0, int dir, int w, int lane, bool do_out) {
  constexpr int KP = K + 8, NS = ScanGeom<K, V>::NS, NVT = V / 32, NOT = 2 * NVT;
  const bf16_t* sQt = (const bf16_t*)(smem + L_QT); const bf16_t* sKt = (const bf16_t*)(smem + L_KT);
  const bf16_t* sQc = (const bf16_t*)(smem + L_QC); const bf16_t* sKhT = (const bf16_t*)(smem + L_KHT);
  const bf16_t* sVT = (const bf16_t*)(smem + L_VT); bf16_t* sP = (bf16_t*)(smem + L_P);
  const bf16_t* sST = (const bf16_t*)(smem + L_ST); const float* sD = (const float*)(smem + L_D);
  const float* sAcs = (const float*)(smem + L_ACS);
  const int c = lane & 31, h = lane >> 5;
  if (do_out) scan_write_state<K, V>(smem, S, w, lane);
  if (do_out && w < 4) {
    const int tt = w >> 1, st = w & 1;
    f32x16 acc = zero16();
    if (st <= tt) mma32<K>(acc, sQt + tt * 32 * KP, KP, sKt + st * 32 * KP, KP, lane);
#pragma unroll
    for (int reg = 0; reg < 16; ++reg) {
      const int tau = tt * 32 + rowoff(reg, h), sig = st * 32 + c;
      float v = 0.f;
      if (sig <= tau) { v = acc[reg]; if (SSDM) v *= ex2(sAcs[tau] - sAcs[sig]); }
      sP[tau * 72 + sig] = f2bf(v);
    }
  }
  lds_barrier();
  if (do_out && w < NOT) {
    const int tt = w / NVT, nt = w % NVT;
    f32x16 acc = zero16();
    mma32<64>(acc, sP + tt * 32 * 72, 72, sVT + nt * 32 * 72, 72, lane);
    mma32<K>(acc, sQc + tt * 32 * KP, KP, sST + nt * 32 * KP, KP, lane);
#pragma unroll
    for (int reg = 0; reg < 16; ++reg) {
      const int tau = tt * 32 + rowoff(reg, h);
      const int tok = dir ? (63 - tau) : tau;
      orow0[(size_t)tok * 512 + nt * 32 + c] = f2bf(acc[reg]);
    }
  }
#pragma unroll
  for (int i = 0; i < NS; ++i) {
    const int tile = w * NS + i, kt = tile / NVT, nt = tile % NVT;
#pragma unroll
    for (int reg = 0; reg < 16; ++reg) S[i][reg] *= sD[kt * 32 + rowoff(reg, h)];
    mma32<64>(S[i], sKhT + kt * 32 * 72, 72, sVT + nt * 32 * 72, 72, lane);
  }
  lds_barrier();
}

template <int K, int V>
DEV void state_store(float* buf, const f32x16* S, int w, int lane) {
  constexpr int NS = ScanGeom<K, V>::NS, NVT = V / 32;
  const int c = lane & 31, h = lane >> 5;
#pragma unroll
  for (int i = 0; i < NS; ++i) {
    const int tile = w * NS + i, kt = tile / NVT, nt = tile % NVT;
#pragma unroll
    for (int reg = 0; reg < 16; ++reg) buf[(kt * 32 + rowoff(reg, h)) * V + nt * 32 + c] = S[i][reg];
  }
}
template <int K, int V>
DEV void state_load(const float* buf, f32x16* S, int w, int lane) {
  constexpr int NS = ScanGeom<K, V>::NS, NVT = V / 32;
  const int c = lane & 31, h = lane >> 5;
#pragma unroll
  for (int i = 0; i < NS; ++i) {
    const int tile = w * NS + i, kt = tile / NVT, nt = tile % NVT;
#pragma unroll
    for (int reg = 0; reg < 16; ++reg) S[i][reg] = buf[(kt * 32 + rowoff(reg, h)) * V + nt * 32 + c];
  }
}

DEV void store16(bf16_t* dst, const float* v) {
  uint4 a, b;
  a.x = pk2(v[0], v[1]); a.y = pk2(v[2], v[3]); a.z = pk2(v[4], v[5]); a.w = pk2(v[6], v[7]);
  b.x = pk2(v[8], v[9]); b.y = pk2(v[10], v[11]); b.z = pk2(v[12], v[13]); b.w = pk2(v[14], v[15]);
  ((uint4*)dst)[0] = a; ((uint4*)dst)[1] = b;
}
DEV void gather16(bf16_t* dst, const bf16_t* src, int stride) {
  unsigned u[8];
#pragma unroll
  for (int i = 0; i < 8; ++i) u[i] = (unsigned)src[(2 * i) * stride] | ((unsigned)src[(2 * i + 1) * stride] << 16);
  ((uint4*)dst)[0] = make_uint4(u[0], u[1], u[2], u[3]); ((uint4*)dst)[1] = make_uint4(u[4], u[5], u[6], u[7]);
}

DEV void hgrn_item(const Params& p, int l, int it, int seg, int mode, unsigned char* smem) {
  const int bl = it >> 3, head = (it >> 1) & 3, dir = it & 1;
  const bool do_out = (mode == 3);
  constexpr int K = 128, V = 128, KP = 136, KPW = 68;
  const int tid = launder(threadIdx.x), lane = tid & 63, w = tid >> 6;
  const int cp = tid & 63, tg = tid >> 6, ch0 = 2 * cp;
  const bf16_t* Hh = (const bf16_t*)(p.ws + OFF_H);
  bf16_t* OB = (bf16_t*)(p.ws + OFF_OBUF) + (size_t)(0 * 2 + dir) * TH * 512;
  const size_t rowbase = (size_t)bl * SEQ;
  float lb0 = 0.f, lb1 = 0.f;
  if (l > 0) {
    lb0 = fsigmoid(p.lb_logits[512 + head * 128 + ch0] - p.lb_logits[head * 128 + ch0]);
    lb1 = fsigmoid(p.lb_logits[512 + head * 128 + ch0 + 1] - p.lb_logits[head * 128 + ch0 + 1]);
  }
  const float om0 = 1.f - lb0, om1 = 1.f - lb1;
  const int fbase = dir ? H_FB : H_FF;
  unsigned* sQt = (unsigned*)(smem + L_QT); unsigned* sKt = (unsigned*)(smem + L_KT); unsigned* sQc = (unsigned*)(smem + L_QC);
  bf16_t* sKhT = (bf16_t*)(smem + L_KHT); bf16_t* sVT = (bf16_t*)(smem + L_VT);
  float* sD = (float*)(smem + L_D); float* sTot = (float*)(smem + L_TOT);
  f32x16 S[2]; S[0] = zero16(); S[1] = zero16();
  float* sbuf = (float*)(p.ws + OFF_SB0) + ((size_t)it * NSEG + seg) * 16384;
  if (do_out) state_load<K, V>(sbuf, S, w, lane);
  float dlog0 = 0.f, dlog1 = 0.f;
  unsigned pf[8], pq[8], pv[8];
  auto gload = [&](int cidx) __attribute__((always_inline)) {
    const int chunk = dir ? (63 - cidx) : cidx;
#pragma unroll
    for (int i = 0; i < 8; ++i) {
      const int tau = 8 * tg + i;
      const int tok = chunk * 64 + (dir ? (63 - tau) : tau);
      const unsigned* rp = (const unsigned*)(Hh + (rowbase + tok) * NPAD + head * 128) + cp;
      pf[i] = rp[fbase / 2]; pv[i] = rp[H_I / 2];
      pq[i] = do_out ? rp[H_Q / 2] : 0u;
    }
  };
  gload(seg * SLEN);
  for (int ci = 0; ci < SLEN; ++ci) {
    const int cidx = seg * SLEN + ci;
    const int chunk = dir ? (63 - cidx) : cidx;
    float g0[8], g1[8], kx0[8], kx1[8];
    float r0 = 0.f, r1 = 0.f;
#pragma unroll
    for (int i = 0; i < 8; ++i) {
      const float e0 = ex2(fminf(-lo16(pf[i]) * LOG2E, 80.f)), e1 = ex2(fminf(-hi16(pf[i]) * LOG2E, 80.f));
      const float s0 = frcp(1.f + e0), s1 = frcp(1.f + e1);
      r0 += lg2(lb0 + om0 * s0); r1 += lg2(lb1 + om1 * s1);
      g0[i] = r0; g1[i] = r1;
      kx0[i] = om0 * e0 * s0; kx1[i] = om1 * e1 * s1;
    }
    *(float2*)(sTot + tg * 128 + ch0) = make_float2(r0, r1);
    unsigned vv[8], qq[8];
#pragma unroll
    for (int i = 0; i < 8; ++i) { vv[i] = pv[i]; qq[i] = pq[i]; }
    lds_barrier();
    if (ci + 1 < SLEN) gload(cidx + 1);
    float off0 = 0.f, off1 = 0.f, ref0 = 0.f, ref1 = 0.f, be0 = 0.f, be1 = 0.f;
#pragma unroll
    for (int j = 0; j < 8; ++j) {
      const float2 t = *(const float2*)(sTot + j * 128 + ch0);
      if (j < tg) { off0 += t.x; off1 += t.y; }
      if (j < 4) { ref0 += t.x; ref1 += t.y; }
      be0 += t.x; be1 += t.y;
    }
    dlog0 += be0; dlog1 += be1;
    const float eref0 = ex2(ref0), eref1 = ex2(ref1), ebr0 = ex2(be0 - ref0), ebr1 = ex2(be1 - ref1);
    const float d0 = off0 - ref0, d1 = off1 - ref1;
    float kh0[8], kh1[8];
#pragma unroll
    for (int i = 0; i < 8; ++i) {
      const int tau = 8 * tg + i;
      const float E0 = ex2(g0[i] + d0), E1 = ex2(g1[i] + d1);
      const float kt0 = kx0[i] * frcp(E0), kt1 = kx1[i] * frcp(E1);
      if (do_out) {
        const float qt0 = lo16(qq[i]) * E0, qt1 = hi16(qq[i]) * E1;
        sQt[tau * KPW + cp] = cvtpk(qt0, qt1);
        sKt[tau * KPW + cp] = cvtpk(kt0, kt1);
        sQc[tau * KPW + cp] = cvtpk(qt0 * eref0, qt1 * eref1);
      }
      kh0[i] = kt0 * ebr0; kh1[i] = kt1 * ebr1;
    }
    *(u32x4*)(sKhT + ch0 * 72 + 8 * tg) = (u32x4){cvtpk(kh0[0], kh0[1]), cvtpk(kh0[2], kh0[3]), cvtpk(kh0[4], kh0[5]), cvtpk(kh0[6], kh0[7])};
    *(u32x4*)(sKhT + (ch0 + 1) * 72 + 8 * tg) = (u32x4){cvtpk(kh1[0], kh1[1]), cvtpk(kh1[2], kh1[3]), cvtpk(kh1[4], kh1[5]), cvtpk(kh1[6], kh1[7])};
    *(u32x4*)(sVT + ch0 * 72 + 8 * tg) = (u32x4){(vv[0] & 0xffffu) | (vv[1] << 16), (vv[2] & 0xffffu) | (vv[3] << 16), (vv[4] & 0xffffu) | (vv[5] << 16), (vv[6] & 0xffffu) | (vv[7] << 16)};
    *(u32x4*)(sVT + (ch0 + 1) * 72 + 8 * tg) = (u32x4){(vv[0] >> 16) | (vv[1] & 0xffff0000u), (vv[2] >> 16) | (vv[3] & 0xffff0000u), (vv[4] >> 16) | (vv[5] & 0xffff0000u), (vv[6] >> 16) | (vv[7] & 0xffff0000u)};
    if (tg == 0) *(float2*)(sD + ch0) = make_float2(ex2(be0), ex2(be1));
    lds_barrier();
    scan_core<K, V, false>(smem, S, OB + (rowbase + (size_t)chunk * 64) * 512 + head * 128, dir, w, lane, do_out);
  }
  if (!do_out) {
    state_store<K, V>(sbuf, S, w, lane);
    if (tg == 0) *(float2*)((float*)(p.ws + OFF_DB) + ((size_t)it * NSEG + seg) * 128 + ch0) = make_float2(ex2(dlog0), ex2(dlog1));
  }
}

DEV void gla_item(const Params& p, int l, int it, int seg, int mode, unsigned char* smem) {
  const int j16 = it - 16, bl = j16 >> 3, head = (j16 >> 1) & 3, dir = j16 & 1;
  const bool do_out = (mode == 3);
  constexpr int K = 64, V = 128, KP = 72, KPW = 36;
  const int tid = launder(threadIdx.x), lane = tid & 63, w = tid >> 6;
  const int cp = tid & 31, tg = tid >> 5, ch0 = 2 * cp;
  const int vp2 = tid & 63, vg = tid >> 6;
  const bf16_t* Hh = (const bf16_t*)(p.ws + OFF_H);
  const float* SMALL = (const float*)(p.ws + OFF_SMALL);
  bf16_t* OB = (bf16_t*)(p.ws + OFF_OBUF) + (size_t)(2 * 2 + dir) * TH * 512;
  const size_t rowbase = (size_t)bl * SEQ;
  unsigned* sQt = (unsigned*)(smem + L_QT); unsigned* sKt = (unsigned*)(smem + L_KT); unsigned* sQc = (unsigned*)(smem + L_QC);
  bf16_t* sKhT = (bf16_t*)(smem + L_KHT); bf16_t* sVT = (bf16_t*)(smem + L_VT);
  float* sD = (float*)(smem + L_D); float* sTot = (float*)(smem + L_TOT); float* sLow = (float*)(smem + L_LOW);
  const unsigned* rawQ = (const unsigned*)(smem + L_RAW); const unsigned* rawK = rawQ + 2048; const unsigned* rawV = rawQ + 4096;
  float* sG = (float*)(smem + L_RAW + 32768);
  float w2a[16], w2b[16];
#pragma unroll
  for (int r = 0; r < 16; ++r) {
    const float* wp = p.gk_w2 + ((size_t)(l * 2 + dir) * 16 + r) * 256 + head * 64 + ch0;
    w2a[r] = wp[0]; w2b[r] = wp[1];
  }
  const float gb0 = p.gk_b[(l * 2 + dir) * 256 + head * 64 + ch0], gb1 = p.gk_b[(l * 2 + dir) * 256 + head * 64 + ch0 + 1];
  f32x16 S[1]; S[0] = zero16();
  float* sbuf = (float*)(p.ws + OFF_SB1) + ((size_t)j16 * NSEG + seg) * 8192;
  if (do_out) state_load<K, V>(sbuf, S, w, lane);
  float dlog0 = 0.f, dlog1 = 0.f;
  u32x4 pre[4];
  float plow0, plow1;
  const int qrow = tid >> 3, qc8 = (tid & 7) * 8, vrow0 = tid >> 4, vc16 = (tid & 15) * 8;
  auto gload = [&](int cidx) __attribute__((always_inline)) {
    const int chunk = dir ? (63 - cidx) : cidx;
    {
      const int tok = chunk * 64 + (dir ? (63 - qrow) : qrow);
      const bf16_t* rp = Hh + (rowbase + tok) * NPAD + head * 64 + qc8;
      if (do_out) pre[0] = *(const u32x4*)(rp + G_Q);
      pre[1] = *(const u32x4*)(rp + G_K);
      const float* lp = SMALL + (rowbase + tok) * 48 + 16 + dir * 16 + (tid & 7) * 2; plow0 = lp[0]; plow1 = lp[1];
    }
#pragma unroll
    for (int j = 0; j < 2; ++j) {
      const int row = vrow0 + 32 * j;
      const int tok = chunk * 64 + (dir ? (63 - row) : row);
      pre[2 + j] = *(const u32x4*)(Hh + (rowbase + tok) * NPAD + G_V + head * 128 + vc16);
    }
  };
  gload(seg * SLEN);
  for (int ci = 0; ci < SLEN; ++ci) {
    const int cidx = seg * SLEN + ci;
    const int chunk = dir ? (63 - cidx) : cidx;
    {
      unsigned char* d = smem + L_RAW + qrow * 128 + qc8 * 2;
      if (do_out) *(u32x4*)d = pre[0];
      *(u32x4*)(d + 8192) = pre[1];
      sLow[qrow * 16 + (tid & 7) * 2] = plow0; sLow[qrow * 16 + (tid & 7) * 2 + 1] = plow1;
#pragma unroll
      for (int j = 0; j < 2; ++j) *(u32x4*)(smem + L_RAW + 16384 + (vrow0 + 32 * j) * 256 + vc16 * 2) = pre[2 + j];
    }
    lds_barrier();
    if (ci + 1 < SLEN) gload(cidx + 1);
    float r0 = 0.f, r1 = 0.f;
#pragma unroll
    for (int i = 0; i < 4; ++i) {
      const int tau = 4 * tg + i;
      float g0 = gb0, g1 = gb1;
#pragma unroll
      for (int r4 = 0; r4 < 4; ++r4) {
        const float4 lw = *(const float4*)(sLow + tau * 16 + 4 * r4);
        g0 += lw.x * w2a[4 * r4] + lw.y * w2a[4 * r4 + 1] + lw.z * w2a[4 * r4 + 2] + lw.w * w2a[4 * r4 + 3];
        g1 += lw.x * w2b[4 * r4] + lw.y * w2b[4 * r4 + 1] + lw.z * w2b[4 * r4 + 2] + lw.w * w2b[4 * r4 + 3];
      }
      const float l0 = (fminf(g0, 0.f) * LOG2E - lg2(1.f + ex2(-fabsf(g0) * LOG2E))) * (1.f / 16.f);
      const float l1 = (fminf(g1, 0.f) * LOG2E - lg2(1.f + ex2(-fabsf(g1) * LOG2E))) * (1.f / 16.f);
      *(float2*)(sG + tau * 64 + ch0) = make_float2(l0, l1);
      r0 += l0; r1 += l1;
    }
    *(float2*)(sTot + tg * 64 + ch0) = make_float2(r0, r1);
    lds_barrier();
    float off0 = 0.f, off1 = 0.f, ref0 = 0.f, ref1 = 0.f, be0 = 0.f, be1 = 0.f;
#pragma unroll
    for (int j = 0; j < 16; ++j) {
      const float2 t = *(const float2*)(sTot + j * 64 + ch0);
      if (j < tg) { off0 += t.x; off1 += t.y; }
      if (j < 8) { ref0 += t.x; ref1 += t.y; }
      be0 += t.x; be1 += t.y;
    }
    dlog0 += be0; dlog1 += be1;
    const float eref0 = ex2(ref0), eref1 = ex2(ref1), ebr0 = ex2(be0 - ref0), ebr1 = ex2(be1 - ref1);
    float b0 = off0, b1 = off1;
    float kh0[4], kh1[4];
#pragma unroll
    for (int i = 0; i < 4; ++i) {
      const int tau = 4 * tg + i;
      const float2 gg = *(const float2*)(sG + tau * 64 + ch0);
      b0 += gg.x; b1 += gg.y;
      const float E0 = ex2(b0 - ref0), E1 = ex2(b1 - ref1);
      const unsigned uk = rawK[tau * 32 + cp];
      const float kt0 = lo16(uk) * frcp(E0), kt1 = hi16(uk) * frcp(E1);
      if (do_out) {
        const unsigned uq = rawQ[tau * 32 + cp];
        const float qt0 = lo16(uq) * E0, qt1 = hi16(uq) * E1;
        sQt[tau * KPW + cp] = cvtpk(qt0, qt1);
        sKt[tau * KPW + cp] = cvtpk(kt0, kt1);
        sQc[tau * KPW + cp] = cvtpk(qt0 * eref0, qt1 * eref1);
      }
      kh0[i] = kt0 * ebr0; kh1[i] = kt1 * ebr1;
    }
    *(uint2*)(sKhT + ch0 * 72 + 4 * tg) = make_uint2(cvtpk(kh0[0], kh0[1]), cvtpk(kh0[2], kh0[3]));
    *(uint2*)(sKhT + (ch0 + 1) * 72 + 4 * tg) = make_uint2(cvtpk(kh1[0], kh1[1]), cvtpk(kh1[2], kh1[3]));
    {
      unsigned vv[8];
#pragma unroll
      for (int i = 0; i < 8; ++i) vv[i] = rawV[(8 * vg + i) * 64 + vp2];
      *(u32x4*)(sVT + (2 * vp2) * 72 + 8 * vg) = (u32x4){(vv[0] & 0xffffu) | (vv[1] << 16), (vv[2] & 0xffffu) | (vv[3] << 16), (vv[4] & 0xffffu) | (vv[5] << 16), (vv[6] & 0xffffu) | (vv[7] << 16)};
      *(u32x4*)(sVT + (2 * vp2 + 1) * 72 + 8 * vg) = (u32x4){(vv[0] >> 16) | (vv[1] & 0xffff0000u), (vv[2] >> 16) | (vv[3] & 0xffff0000u), (vv[4] >> 16) | (vv[5] & 0xffff0000u), (vv[6] >> 16) | (vv[7] & 0xffff0000u)};
    }
    if (tg == 0) *(float2*)(sD + ch0) = make_float2(ex2(be0), ex2(be1));
    lds_barrier();
    scan_core<K, V, false>(smem, S, OB + (rowbase + (size_t)chunk * 64) * 512 + head * 128, dir, w, lane, do_out);
  }
  if (!do_out) {
    state_store<K, V>(sbuf, S, w, lane);
    if (tg == 0) *(float2*)((float*)(p.ws + OFF_DB) + ((size_t)it * NSEG + seg) * 128 + ch0) = make_float2(ex2(dlog0), ex2(dlog1));
  }
}

DEV void ssd_item(const Params& p, int l, int it, int seg, int mode, unsigned char* smem) {
  const int j32 = it - 32, bl = j32 >> 4, head = (j32 >> 1) & 7, dir = j32 & 1;
  const bool do_out = (mode == 3);
  constexpr int K = 128, V = 64, KP = 136, KPW = 68;
  const int tid = launder(threadIdx.x), lane = tid & 63, w = tid >> 6;
  const int cp = tid & 63, tg = tid >> 6, n0 = 2 * cp;
  const int pp = tid & 63;
  const int grp = head >> 2;
  const bf16_t* U = (const bf16_t*)(p.ws + OFF_U);
  const float* SMALL = (const float*)(p.ws + OFF_SMALL);
  bf16_t* OB = (bf16_t*)(p.ws + OFF_OBUF) + (size_t)(1 * 2 + dir) * TH * 512;
  const size_t rowbase = (size_t)bl * SEQ;
  const unsigned* sQt = (const unsigned*)(smem + L_QT); const unsigned* sKt = (const unsigned*)(smem + L_KT); unsigned* sQc = (unsigned*)(smem + L_QC);
  bf16_t* sKhT = (bf16_t*)(smem + L_KHT); bf16_t* sVT = (bf16_t*)(smem + L_VT);
  float* sD = (float*)(smem + L_D); float* sAcs = (float*)(smem + L_ACS); float* sDt = (float*)(smem + L_DT);
  const bf16_t* rawX = (const bf16_t*)(smem + L_RAW);
  const float dtb = p.dt_bias[(l * 2 + dir) * 8 + head];
  const float Acoef = -__expf(p.a_log[(l * 2 + dir) * 8 + head]) * LOG2E;
  f32x16 S[1]; S[0] = zero16();
  float* sbuf = (float*)(p.ws + OFF_SB2) + ((size_t)j32 * NSEG + seg) * 8192;
  if (do_out) state_load<K, V>(sbuf, S, w, lane);
  float dlog = 0.f;
  u32x4 pre[5];
  float rdt = 0.f;
  const int prow0 = tid >> 4, pc16 = (tid & 15) * 8, xrow = tid >> 3, xc8 = (tid & 7) * 8;
  auto gload = [&](int cidx) __attribute__((always_inline)) {
    const int chunk = dir ? (63 - cidx) : cidx;
#pragma unroll
    for (int j = 0; j < 2; ++j) {
      const int row = prow0 + 32 * j;
      const int tok = chunk * 64 + (dir ? (63 - row) : row);
      const bf16_t* rp = U + (rowbase + tok) * 1024 + grp * 128 + pc16;
      pre[j] = *(const u32x4*)(rp + 512);
      if (do_out) pre[2 + j] = *(const u32x4*)(rp + 768);
    }
    {
      const int tok = chunk * 64 + (dir ? (63 - xrow) : xrow);
      pre[4] = *(const u32x4*)(U + (rowbase + tok) * 1024 + head * 64 + xc8);
    }
    if (w == 0) {
      const int tok = chunk * 64 + (dir ? (63 - lane) : lane);
      rdt = SMALL[(rowbase + tok) * 48 + dir * 8 + head];
    }
  };
  gload(seg * SLEN);
  for (int ci = 0; ci < SLEN; ++ci) {
    const int cidx = seg * SLEN + ci;
    const int chunk = dir ? (63 - cidx) : cidx;
#pragma unroll
    for (int j = 0; j < 2; ++j) {
      const int row = prow0 + 32 * j;
      *(u32x4*)(smem + L_KT + row * (KP * 2) + pc16 * 2) = pre[j];
      if (do_out) *(u32x4*)(smem + L_QT + row * (KP * 2) + pc16 * 2) = pre[2 + j];
    }
    *(u32x4*)(smem + L_RAW + xrow * 128 + xc8 * 2) = pre[4];
    if (w == 0) {
      const float xx = rdt + dtb;
      const float dt = (xx > 20.f) ? xx : log1pf(__expf(xx));
      float a = dt * Acoef;
#pragma unroll
      for (int o = 1; o < 64; o <<= 1) { const float t = __shfl_up(a, o); if (lane >= o) a += t; }
      sAcs[lane] = a; sDt[lane] = dt;
    }
    lds_barrier();
    if (ci + 1 < SLEN) gload(cidx + 1);
    const float aend = sAcs[63];
    dlog += aend;
    {
      float kh0[8], kh1[8];
#pragma unroll
      for (int i = 0; i < 8; ++i) {
        const int tau = 8 * tg + i;
        const float ac = sAcs[tau];
        const unsigned ub = sKt[tau * KPW + cp];
        const float eb = ex2(aend - ac);
        kh0[i] = lo16(ub) * eb; kh1[i] = hi16(ub) * eb;
        if (do_out) {
          const unsigned uc = sQt[tau * KPW + cp];
          const float ea = ex2(ac);
          sQc[tau * KPW + cp] = cvtpk(lo16(uc) * ea, hi16(uc) * ea);
        }
      }
      *(u32x4*)(sKhT + n0 * 72 + 8 * tg) = (u32x4){cvtpk(kh0[0], kh0[1]), cvtpk(kh0[2], kh0[3]), cvtpk(kh0[4], kh0[5]), cvtpk(kh0[6], kh0[7])};
      *(u32x4*)(sKhT + (n0 + 1) * 72 + 8 * tg) = (u32x4){cvtpk(kh1[0], kh1[1]), cvtpk(kh1[2], kh1[3]), cvtpk(kh1[4], kh1[5]), cvtpk(kh1[6], kh1[7])};
      float xv[8];
#pragma unroll
      for (int i = 0; i < 8; ++i) { const int tau = 8 * tg + i; xv[i] = bf2f(rawX[tau * 64 + pp]) * sDt[tau]; }
      *(u32x4*)(sVT + pp * 72 + 8 * tg) = (u32x4){cvtpk(xv[0], xv[1]), cvtpk(xv[2], xv[3]), cvtpk(xv[4], xv[5]), cvtpk(xv[6], xv[7])};
      if (tg == 0) *(float2*)(sD + n0) = make_float2(ex2(aend), ex2(aend));
    }
    lds_barrier();
    scan_core<K, V, true>(smem, S, OB + (rowbase + (size_t)chunk * 64) * 512 + head * 64, dir, w, lane, do_out);
  }
  if (!do_out) {
    state_store<K, V>(sbuf, S, w, lane);
    if (tg == 0) *(float2*)((float*)(p.ws + OFF_DB) + ((size_t)it * NSEG + seg) * 128 + n0) = make_float2(ex2(dlog), ex2(dlog));
  }
}

DEV void phase_prep(const Params& p, int l, int hf, unsigned char* smem) {
  const int tid = launder(threadIdx.x), lane = tid & 63, w = tid >> 6;
  bf16_t* Hh = (bf16_t*)(p.ws + OFF_H);
  {
    const int cg8 = (tid & 127) * 8, rsub = tid >> 7;
    bf16_t* U = (bf16_t*)(p.ws + OFF_U);
    const float* cw = p.conv_w + (size_t)l * 5 * 1024; const float* cb = p.conv_b + (size_t)l * 1024;
    float wv[5][8], bv[8];
#pragma unroll
    for (int j = 0; j < 5; ++j)
#pragma unroll
      for (int e = 0; e < 8; ++e) wv[j][e] = cw[j * 1024 + cg8 + e];
#pragma unroll
    for (int e = 0; e < 8; ++e) bv[e] = cb[cg8 + e];
    for (int r = blockIdx.x * 4 + rsub; r < TH; r += gridDim.x * 4) {
      const int t = r & (SEQ - 1);
      float u[8];
#pragma unroll
      for (int e = 0; e < 8; ++e) u[e] = bv[e];
#pragma unroll
      for (int j = 0; j < 5; ++j) {
        const int s = t + j - 2;
        if (s >= 0 && s < SEQ) {
          const u32x4 x = *(const u32x4*)(Hh + (size_t)(r + j - 2) * NPAD + S_X + cg8);
#pragma unroll
          for (int e = 0; e < 4; ++e) { u[2 * e] += wv[j][2 * e] * lo16(x[e]); u[2 * e + 1] += wv[j][2 * e + 1] * hi16(x[e]); }
        }
      }
      u32x4 o;
#pragma unroll
      for (int e = 0; e < 4; ++e) {
        const float a = u[2 * e] * frcp(1.f + ex2(fminf(-u[2 * e] * LOG2E, 80.f)));
        const float b = u[2 * e + 1] * frcp(1.f + ex2(fminf(-u[2 * e + 1] * LOG2E, 80.f)));
        o[e] = cvtpk(a, b);
      }
      *(u32x4*)(U + (size_t)r * 1024 + cg8) = o;
    }
  }
  {
    const float2* tabg = (const float2*)(p.ws + OFF_TAB);
    float2* stab = (float2*)smem;
    lds_barrier();
    for (int i = tid; i < 1024; i += NT) stab[i] = tabg[i];
    lds_barrier();
    const int i16 = lane & 15, grp = lane >> 4;
    const float* gq = p.q_gain + l * 64 + 4 * i16; const float* gk = p.k_gain + l * 64 + 4 * i16;
    const float gqv[4] = {gq[0], gq[1], gq[2], gq[3]}, gkv[4] = {gk[0], gk[1], gk[2], gk[3]};
    constexpr int NQ = TH * 10 / 4, UNR = 5;
    const int nw = gridDim.x * 8;
    for (int pq0 = blockIdx.x * 8 + w; pq0 < NQ; pq0 += nw * UNR) {
      uint2 xr[UNR]; bf16_t* ptr[UNR]; int rowv[UNR]; bool isqv[UNR]; bool ok[UNR];
#pragma unroll
      for (int u = 0; u < UNR; ++u) {
        const int pq = pq0 + u * nw;
        ok[u] = pq < NQ;
        const int pi = (ok[u] ? pq : 0) * 4 + grp, row = pi / 10, hd = pi - row * 10;
        rowv[u] = row; isqv[u] = hd < 8;
        ptr[u] = Hh + (size_t)row * NPAD + (isqv[u] ? (A_Q + hd * 64) : (A_K + (hd - 8) * 64)) + 4 * i16;
        xr[u] = *(const uint2*)ptr[u];
      }
#pragma unroll
      for (int u = 0; u < UNR; ++u) {
        const float x[4] = {lo16(xr[u].x), hi16(xr[u].x), lo16(xr[u].y), hi16(xr[u].y)};
        float ss = x[0] * x[0] + x[1] * x[1] + x[2] * x[2] + x[3] * x[3];
        ss += __shfl_xor(ss, 1); ss += __shfl_xor(ss, 2); ss += __shfl_xor(ss, 4); ss += __shfl_xor(ss, 8);
        const float rstd = rsqrtf(ss * (1.f / 64.f) + 1e-6f);
        const int t = rowv[u] & (SEQ - 1);
        const int pos = (i16 < 8) ? (t >> 6) : (t & 63);
        const float osc = isqv[u] ? QSCALE : 1.f;
        float o[4];
#pragma unroll
        for (int e = 0; e < 4; ++e) {
          const float v = x[e] * rstd * (isqv[u] ? gqv[e] : gkv[e]);
          const float pv = __shfl_xor(v, 4);
          const float2 cs = stab[pos * 16 + 4 * (i16 & 3) + e];
          o[e] = ((i16 & 4) ? (v * cs.x + pv * cs.y) : (v * cs.x - pv * cs.y)) * osc;
        }
        if (ok[u]) *(uint2*)ptr[u] = make_uint2(cvtpk(o[0], o[1]), cvtpk(o[2], o[3]));
      }
    }
  }
  {
    const int c8 = (tid & 63) * 8, rs = tid >> 6;
    for (int r = blockIdx.x * 8 + rs; r < TH; r += gridDim.x * 8) {
      bf16_t* hp = Hh + (size_t)r * NPAD + H_Q + c8;
      u32x4 x = *(const u32x4*)hp;
#pragma unroll
      for (int e = 0; e < 4; ++e) {
        const float a = lo16(x[e]), b = hi16(x[e]);
        x[e] = cvtpk(a * frcp(1.f + ex2(fminf(-a * LOG2E, 80.f))) * 0.08838834764831845f, b * frcp(1.f + ex2(fminf(-b * LOG2E, 80.f))) * 0.08838834764831845f);
      }
      *(u32x4*)hp = x;
      if (c8 < 256) {
        bf16_t* gp = Hh + (size_t)r * NPAD + G_Q + c8;
        u32x4 y = *(const u32x4*)gp;
#pragma unroll
        for (int e = 0; e < 4; ++e) y[e] = cvtpk(lo16(y[e]) * 0.125f, hi16(y[e]) * 0.125f);
        *(u32x4*)gp = y;
      }
    }
  }
  {
    bf16_t* VT = (bf16_t*)(p.ws + OFF_VT);
    bf16_t* sT = (bf16_t*)smem;
    for (int tile = blockIdx.x; tile < TH / 64; tile += gridDim.x) {
      lds_barrier();
#pragma unroll
      for (int j = 0; j < 2; ++j) {
        const int id = tid + 512 * j, rr = id >> 4, c8 = (id & 15) * 8;
        *(u32x4*)(sT + rr * 136 + c8) = *(const u32x4*)(Hh + (size_t)(tile * 64 + rr) * NPAD + A_V + c8);
      }
      lds_barrier();
      const int c = tid >> 2, tq = (tid & 3) * 16;
      unsigned v[16];
#pragma unroll
      for (int i = 0; i < 16; ++i) v[i] = sT[(tq + i) * 136 + c];
      const int row0 = tile * 64, bl = row0 >> 12, t0 = (row0 & (SEQ - 1)) + tq;
      bf16_t* dst = VT + ((size_t)((bl * 2 + (c >> 6)) * 64 + (c & 63))) * SEQ + t0;
      *(u32x4*)dst = (u32x4){v[0] | (v[1] << 16), v[2] | (v[3] << 16), v[4] | (v[5] << 16), v[6] | (v[7] << 16)};
      *(u32x4*)(dst + 8) = (u32x4){v[8] | (v[9] << 16), v[10] | (v[11] << 16), v[12] | (v[13] << 16), v[14] | (v[15] << 16)};
    }
    lds_barrier();
  }
}

DEV void phase_mix(const Params& p, int l, int hf, int slot, int mode, int att_lo, int att_hi, int vid_lo, int vid_hi, unsigned char* smem) {
  unsigned* ctr = (unsigned*)(p.ws + OFF_CTRL) + CTR_WORD0 + slot * 16;
  volatile int* sItem = (volatile int*)(smem + LDS_BYTES - 16);
  const int n_scan = 64 * NSEG;
  int hi = n_scan + (att_hi - att_lo); if (vid_hi < hi) hi = vid_hi;
  for (;;) {
    lds_barrier();
    if (threadIdx.x == 0) *sItem = vid_lo + (int)atomicAdd(ctr, 1u);
    lds_barrier();
    const int vid = *sItem;
    if (vid >= hi) break;
    if (vid < n_scan) {
      const int seg = vid >> 6, it = vid & 63;
      if (mode == 1 && seg == NSEG - 1) continue;
#if PROBE_REP > 0
      if (slot >= 40 && PROBE_TYPE >= 0 && ((it < 16) ? 0 : (it < 32) ? 1 : 2) != PROBE_TYPE) continue;
#endif
      if (it < 16) { if (PH_MASK & 0x100) hgrn_item(p, l, it, seg, mode, smem); }
      else if (it < 32) { if (PH_MASK & 0x200) gla_item(p, l, it, seg, mode, smem); }
      else { if (PH_MASK & 0x400) ssd_item(p, l, it, seg, mode, smem); }
    } else { if (PH_MASK & 0x800) attn_item(p, l, att_lo + (vid - n_scan), smem); }
  }
}

DEV void phase_scan2(const Params& p) {
  const size_t gtid = (size_t)blockIdx.x * NT + threadIdx.x, gsz = (size_t)gridDim.x * NT;
  const float* DB = (const float*)(p.ws + OFF_DB);
  for (size_t e = gtid; e < 655360; e += gsz) {
    float* buf; const float* dp; int stride;
    if (e < 262144) { const int it = (int)(e >> 14), idx = (int)(e & 16383); buf = (float*)(p.ws + OFF_SB0) + (size_t)it * NSEG * 16384 + idx; stride = 16384; dp = DB + (size_t)it * NSEG * 128 + (idx >> 7); }
    else if (e < 393216) { const int e2 = (int)(e - 262144), j = e2 >> 13, idx = e2 & 8191; buf = (float*)(p.ws + OFF_SB1) + (size_t)j * NSEG * 8192 + idx; stride = 8192; dp = DB + (size_t)(16 + j) * NSEG * 128 + (idx >> 7); }
    else { const int e3 = (int)(e - 393216), j = e3 >> 13, idx = e3 & 8191; buf = (float*)(p.ws + OFF_SB2) + (size_t)j * NSEG * 8192 + idx; stride = 8192; dp = DB + (size_t)(32 + j) * NSEG * 128 + (idx >> 6); }
    float u[NSEG - 1], d[NSEG - 1];
#pragma unroll
    for (int sg = 0; sg < NSEG - 1; ++sg) { u[sg] = buf[(size_t)sg * stride]; d[sg] = dp[sg * 128]; }
    float st = 0.f;
#pragma unroll
    for (int sg = 0; sg < NSEG; ++sg) { buf[(size_t)sg * stride] = st; if (sg < NSEG - 1) st = d[sg] * st + u[sg]; }
  }
}

DEV void phase_fin(const Params& p, int l, int hf) {
  const int tid = launder(threadIdx.x), lane = tid & 63, w = tid >> 6;
  const bf16_t* Hh = (const bf16_t*)(p.ws + OFF_H);
  const bf16_t* OB = (const bf16_t*)(p.ws + OFF_OBUF);
  bf16_t* MX = (bf16_t*)(p.ws + OFF_MIXED);
  const int c0 = lane * 8;
  const float* cw = p.conv_w + (size_t)l * 5 * 1024; const float* cb = p.conv_b + (size_t)l * 1024;
  for (int r = blockIdx.x * 8 + w; r < TH; r += gridDim.x * 8) {
    const bf16_t* hrow = Hh + (size_t)r * NPAD;
    *(u32x4*)(MX + (size_t)r * DI + c0) = *(const u32x4*)(hrow + A_Q + c0);
    {
      const uint4 a = *(const uint4*)(OB + ((size_t)0 * TH + r) * 512 + c0), b = *(const uint4*)(OB + ((size_t)1 * TH + r) * 512 + c0);
      const uint4 z = *(const uint4*)(hrow + H_Z + c0);
      const unsigned au[4] = {a.x, a.y, a.z, a.w}, bu[4] = {b.x, b.y, b.z, b.w}, zu[4] = {z.x, z.y, z.z, z.w};
      float o[8]; float ss = 0.f;
#pragma unroll
      for (int j = 0; j < 4; ++j) {
        o[2 * j] = bf2f((bf16_t)(au[j] & 0xffff)) + bf2f((bf16_t)(bu[j] & 0xffff));
        o[2 * j + 1] = bf2f((bf16_t)(au[j] >> 16)) + bf2f((bf16_t)(bu[j] >> 16));
        ss += o[2 * j] * o[2 * j] + o[2 * j + 1] * o[2 * j + 1];
      }
#pragma unroll
      for (int of = 32; of >= 1; of >>= 1) ss += __shfl_xor(ss, of);
      const float rstd = rsqrtf(ss * (1.f / 512.f) + 1e-6f);
      float y[8];
#pragma unroll
      for (int j = 0; j < 8; ++j) {
        const float zz = bf2f((bf16_t)((j & 1) ? (zu[j >> 1] >> 16) : (zu[j >> 1] & 0xffff)));
        y[j] = o[j] * rstd * p.hgrn_norm[l * 512 + c0 + j] * fsilu(zz);
      }
      uint4 ov; ov.x = pk2(y[0], y[1]); ov.y = pk2(y[2], y[3]); ov.z = pk2(y[4], y[5]); ov.w = pk2(y[6], y[7]);
      *(uint4*)(MX + (size_t)r * DI + 512 + c0) = ov;
    }
    {
      const uint4 a = *(const uint4*)(OB + ((size_t)4 * TH + r) * 512 + c0), b = *(const uint4*)(OB + ((size_t)5 * TH + r) * 512 + c0);
      const uint4 z = *(const uint4*)(hrow + G_Z + c0);
      const unsigned au[4] = {a.x, a.y, a.z, a.w}, bu[4] = {b.x, b.y, b.z, b.w}, zu[4] = {z.x, z.y, z.z, z.w};
      float o[8]; float ss = 0.f;
#pragma unroll
      for (int j = 0; j < 4; ++j) {
        o[2 * j] = bf2f((bf16_t)(au[j] & 0xffff)) + bf2f((bf16_t)(bu[j] & 0xffff));
        o[2 * j + 1] = bf2f((bf16_t)(au[j] >> 16)) + bf2f((bf16_t)(bu[j] >> 16));
        ss += o[2 * j] * o[2 * j] + o[2 * j + 1] * o[2 * j + 1];
      }
#pragma unroll
      for (int of = 8; of >= 1; of >>= 1) ss += __shfl_xor(ss, of);
      const float rstd = rsqrtf(ss * (1.f / 128.f) + 1e-6f);
      float y[8];
#pragma unroll
      for (int j = 0; j < 8; ++j) {
        const float zz = bf2f((bf16_t)((j & 1) ? (zu[j >> 1] >> 16) : (zu[j >> 1] & 0xffff)));
        y[j] = o[j] * rstd * p.gla_norm[l * 128 + ((c0 + j) & 127)] * fsilu(zz);
      }
      uint4 ov; ov.x = pk2(y[0], y[1]); ov.y = pk2(y[2], y[3]); ov.z = pk2(y[4], y[5]); ov.w = pk2(y[6], y[7]);
      *(uint4*)(MX + (size_t)r * DI + 1536 + c0) = ov;
    }
    {
      const uint4 a = *(const uint4*)(OB + ((size_t)2 * TH + r) * 512 + c0), b = *(const uint4*)(OB + ((size_t)3 * TH + r) * 512 + c0);
      const uint4 z = *(const uint4*)(hrow + S_Z + c0);
      const unsigned au[4] = {a.x, a.y, a.z, a.w}, bu[4] = {b.x, b.y, b.z, b.w}, zu[4] = {z.x, z.y, z.z, z.w};
      float u[8];
#pragma unroll
      for (int j = 0; j < 8; ++j) u[j] = cb[c0 + j];
      const int t = r & (SEQ - 1);
#pragma unroll
      for (int jj = 0; jj < 5; ++jj) {
        const int s = t + jj - 2;
        if (s >= 0 && s < SEQ) {
          const uint4 xr = *(const uint4*)(Hh + (size_t)(r + jj - 2) * NPAD + S_X + c0);
          const unsigned xu[4] = {xr.x, xr.y, xr.z, xr.w};
#pragma unroll
          for (int j = 0; j < 8; ++j) {
            const float xv = bf2f((bf16_t)((j & 1) ? (xu[j >> 1] >> 16) : (xu[j >> 1] & 0xffff)));
            u[j] += cw[jj * 1024 + c0 + j] * xv;
          }
        }
      }
      const float dsk = p.ssd_d[l * 8 + (c0 >> 6)];
      float y[8]; float ss = 0.f;
#pragma unroll
      for (int j = 0; j < 8; ++j) {
        const float of = bf2f((bf16_t)((j & 1) ? (au[j >> 1] >> 16) : (au[j >> 1] & 0xffff)));
        const float ob = bf2f((bf16_t)((j & 1) ? (bu[j >> 1] >> 16) : (bu[j >> 1] & 0xffff)));
        const float zz = bf2f((bf16_t)((j & 1) ? (zu[j >> 1] >> 16) : (zu[j >> 1] & 0xffff)));
        y[j] = (of + ob + dsk * fsilu(u[j])) * fsilu(zz);
        ss += y[j] * y[j];
      }
#pragma unroll
      for (int of = 32; of >= 1; of >>= 1) ss += __shfl_xor(ss, of);
      const float rstd = rsqrtf(ss * (1.f / 512.f) + 1e-6f);
#pragma unroll
      for (int j = 0; j < 8; ++j) y[j] = y[j] * rstd * p.ssd_norm[l * 512 + c0 + j];
      uint4 ov; ov.x = pk2(y[0], y[1]); ov.y = pk2(y[2], y[3]); ov.z = pk2(y[4], y[5]); ov.w = pk2(y[6], y[7]);
      *(uint4*)(MX + (size_t)r * DI + 1024 + c0) = ov;
    }
  }
}


#define XB_TMO      128
#define XB_XCNT(j)  (256  + 64 * (j))
#define XB_XSUB(j)  (1280 + 64 * (j))
#define XB_XGEN(j)  (2304 + 64 * (j))
#define XB_TOP      3328
#define XB_TOPGEN   3392
#define XB_SPIN_CAP (1u << 22)
#define LAS __attribute__((address_space(3)))
DEV unsigned xb_ld(unsigned* p) { return __hip_atomic_load(p, __ATOMIC_RELAXED, __HIP_MEMORY_SCOPE_AGENT); }
DEV unsigned xb_add(unsigned* p, unsigned v) { return __hip_atomic_fetch_add(p, v, __ATOMIC_RELAXED, __HIP_MEMORY_SCOPE_AGENT); }
DEV unsigned xb_xcc_id() { return (unsigned)__builtin_amdgcn_s_getreg((3 << 11) | 20) & 0xFu; }
#define XB_SPIN(cond, bar) do { unsigned _sp = 0; while (cond) { __builtin_amdgcn_s_sleep(1); \
    if ((++_sp & 255u) == 0u) { if (xb_ld(&(bar)[XB_TMO])) break; if (_sp > XB_SPIN_CAP) { atomicAdd(&(bar)[XB_TMO], 1u); break; } } } } while (0)
struct XcdBarrier { unsigned* bar; unsigned x; volatile LAS unsigned* st; };
DEV XcdBarrier xcd_barrier_post(unsigned* bar, volatile LAS unsigned* st) {
  XcdBarrier b; b.bar = bar; b.x = xb_xcc_id(); b.st = st;
  if (threadIdx.x == 0) (void)xb_add(&bar[XB_XCNT(b.x)], 1u);
  return b;
}
DEV void xcd_barrier_complete(unsigned* bar, unsigned x, unsigned& nloc, unsigned& nx) {
  const unsigned G = gridDim.x * gridDim.y * gridDim.z;
  unsigned sum, cnt, mine, sp = 0u;
  for (;;) {
    sum = 0u; cnt = 0u; mine = 0u;
#pragma unroll
    for (unsigned j = 0; j < 16; ++j) { const unsigned c = xb_ld(&bar[XB_XCNT(j)]); sum += c; cnt += (c > 0u) ? 1u : 0u; mine = (j == x) ? c : mine; }
    if (sum == G) break;
    __builtin_amdgcn_s_sleep(1);
    if ((++sp & 255u) == 0u) { if (xb_ld(&bar[XB_TMO])) break; if (sp > XB_SPIN_CAP) { atomicAdd(&bar[XB_TMO], 1u); break; } }
  }
  nloc = mine > 0u ? mine : 1u; nx = cnt > 0u ? cnt : 1u;
}
DEV void xcd_barrier(const XcdBarrier& b) {
  asm volatile("s_waitcnt vmcnt(0)" ::: "memory");
  __syncthreads();
  if (threadIdx.x == 0) {
    unsigned* bar = b.bar;
    __builtin_amdgcn_s_waitcnt(0);
    unsigned nloc = b.st[0], nx = b.st[1];
    if (nloc == 0u) { xcd_barrier_complete(bar, b.x, nloc, nx); b.st[0] = nloc; b.st[1] = nx; }
    const unsigned old = xb_add(&bar[XB_XSUB(b.x)], 1u);
    const unsigned gen = old / nloc;
    if (old + 1u == (gen + 1u) * nloc) {
      __builtin_amdgcn_fence(__ATOMIC_RELEASE, "agent");
      asm volatile("s_waitcnt vmcnt(0)" ::: "memory");
      const unsigned og = xb_add(&bar[XB_TOP], 1u);
      const unsigned tg = og / nx;
      if (og + 1u == (tg + 1u) * nx) xb_add(&bar[XB_TOPGEN], 1u);
      else XB_SPIN(xb_ld(&bar[XB_TOPGEN]) == tg, bar);
      __builtin_amdgcn_fence(__ATOMIC_ACQUIRE, "agent");
      xb_add(&bar[XB_XGEN(b.x)], 1u);
      asm volatile("s_waitcnt vmcnt(0)" ::: "memory");
    } else {
      XB_SPIN(xb_ld(&bar[XB_XGEN(b.x)]) == gen, bar);
      __builtin_amdgcn_fence(__ATOMIC_ACQUIRE, "agent");
      asm volatile("s_waitcnt vmcnt(0)" ::: "memory");
    }
  }
  __syncthreads();
}

DEV void run_phase(const Params& p, int ph, int rep, unsigned char* smem) {
  if (ph == 0) { if (PH_MASK & 1) phase_pro(p, smem); }
  if ((PH_MASK & 1) && (ph == 0 || ph == 16)) convert_weights(p, ph == 0 ? 0 : 1, smem);
  if (ph != 0) {
    const int q = ph - 1, l = q / 16, hf = (q / 8) & 1, st = q % 8;
    if (st == 0) { if (PH_MASK & 2) phase_inproj(p, l, hf, smem); }
    else if (st == 1) { if (PH_MASK & 4) phase_prep(p, l, hf, smem); }
    else if (st == 2) { if (PH_MASK & 0xF00) phase_mix(p, l, hf, ph + 40 * rep, 1, 0, ATT_SPLIT, rep ? PROBE_LO : 0, rep ? PROBE_HI : 100000, smem); }
    else if (st == 3) { if (PH_MASK & 0x700) phase_scan2(p); }
    else if (st == 4) { if (PH_MASK & 0xF00) phase_mix(p, l, hf, ph + 40 * rep, 3, ATT_SPLIT, 256, rep ? PROBE_LO : 0, rep ? PROBE_HI : 100000, smem); }
    else if (st == 5) { if (PH_MASK & 8) phase_fin(p, l, hf); }
    else if (st == 6) { if (PH_MASK & 16) phase_outproj(p, l, hf, smem); }
    else {
      if (PH_MASK & 32) phase_ln(p, l, hf);
    }
  }
}
__global__ void __launch_bounds__(NT) mega(Params p) {
  extern __shared__ __attribute__((aligned(16))) unsigned char smem[];
#if ONE_LAUNCH
  volatile LAS unsigned* xst = (volatile LAS unsigned*)(smem + LDS_BYTES - 32);
  if (threadIdx.x == 0) { xst[0] = 0u; xst[1] = 0u; }
  __syncthreads();
  XcdBarrier xb = xcd_barrier_post((unsigned*)(p.ws + OFF_CTRL), xst);
#endif
  Params* lp = (Params*)(smem + 147456);
  if (threadIdx.x == 0) *lp = p;
  __syncthreads();
  const int ph_begin = p.phase_begin, ph_end = p.phase_end;
  for (int ph = ph_begin; ph < ph_end; ++ph) {
    int nrep = 0;
#if PROBE_REP > 0
    {
      const int q = ph - 1, l = q / 16, st = q % 8;
      const bool idem = (ph == 0) ? (PROBE_ST == 9) : (st == PROBE_ST && (st != 6 || l == 0));
      if (idem) nrep = PROBE_REP;
    }
#endif
    for (int r = 0; r <= nrep; ++r) {
      run_phase(*lp, ph, r, smem);
#if ONE_LAUNCH
      if (r < nrep || ph + 1 < ph_end) xcd_barrier(xb);
#endif
    }
  }
}

extern "C" void kernel_launch(void* const* d_in, const int* in_sizes, int n_in, void* d_out, int out_size, void* d_ws, size_t ws_size,
                              hipStream_t stream) {
  static int grid_blocks = 0;
  if (!grid_blocks) {
    int dev = 0, cus = 0, per_cu = 0;
    hipGetDevice(&dev);
    hipDeviceGetAttribute(&cus, hipDeviceAttributeMultiprocessorCount, dev);
    hipFuncSetAttribute((const void*)mega, hipFuncAttributeMaxDynamicSharedMemorySize, LDS_BYTES);
    hipOccupancyMaxActiveBlocksPerMultiprocessor(&per_cu, mega, NT, LDS_BYTES);
    if (per_cu < 1) per_cu = 1;
    grid_blocks = cus;
  }
  Params p{};
  p.x = (const float*)d_in[0]; p.w_in = (const float*)d_in[1]; p.q_gain = (const float*)d_in[2]; p.k_gain = (const float*)d_in[3];
  p.lb_logits = (const float*)d_in[4]; p.hgrn_norm = (const float*)d_in[5]; p.conv_w = (const float*)d_in[6]; p.conv_b = (const float*)d_in[7];
  p.dt_bias = (const float*)d_in[8]; p.a_log = (const float*)d_in[9]; p.ssd_d = (const float*)d_in[10]; p.ssd_norm = (const float*)d_in[11];
  p.gk_w2 = (const float*)d_in[12]; p.gk_b = (const float*)d_in[13]; p.gla_norm = (const float*)d_in[14]; p.w_out = (const float*)d_in[15];
  p.ln_g = (const float*)d_in[16]; p.ln_b = (const float*)d_in[17];
  p.out = (float*)d_out; p.ws = (unsigned char*)d_ws;
  hipMemsetAsync(d_ws, 0, CTRL_BYTES, stream);
#if ONE_LAUNCH
  p.phase_begin = 0; p.phase_end = NPHASE;
  void* args[] = {&p};
  (void)args;
  hipLaunchKernelGGL(mega, dim3(grid_blocks), dim3(NT), LDS_BYTES, stream, p);
#else
  for (int ph = 0; ph < NPHASE; ++ph) {
    p.phase_begin = ph; p.phase_end = ph + 1;
    hipLaunchKernelGGL(mega, dim3(grid_blocks), dim3(NT), LDS_BYTES, stream, p);
  }
#endif
}
```

```cpp
#include <hip/hip_runtime.h>
#include <hip/hip_cooperative_groups.h>
#include <stdint.h>
#include <stdio.h>
namespace cg = cooperative_groups;

#ifndef ONE_LAUNCH
#define ONE_LAUNCH 1
#endif

#ifndef PH_MASK
#define PH_MASK 0xFFF
#endif
#ifndef PROBE_ST
#define PROBE_ST -1
#endif
#ifndef PROBE_REP
#define PROBE_REP 0
#endif
#ifndef PROBE_TYPE
#define PROBE_TYPE -1
#endif
#ifndef PROBE_LO
#define PROBE_LO 0
#endif
#ifndef PROBE_HI
#define PROBE_HI 100000
#endif
#define DEV __device__ __forceinline__
typedef unsigned short bf16_t;
typedef short bf16x8 __attribute__((ext_vector_type(8)));
typedef float f32x16 __attribute__((ext_vector_type(16)));
typedef unsigned u32x4 __attribute__((ext_vector_type(4)));

constexpr int NT = 512;
constexpr int T_ALL = 16384, TH = 8192, SEQ = 4096, DM = 1024, NPAD = 7168, DI = 2048, NIN = 6960;
constexpr int A_Q = 0, A_K = 512, A_V = 640, A_Z = 768, H_Q = 1280, H_FF = 1792, H_FB = 2304, H_I = 2816, H_Z = 3328,
              S_X = 3840, S_Z = 4864, G_Q = 5376, G_K = 5632, G_V = 5888, G_Z = 6400, SM0 = 6912;
constexpr size_t OFF_CTRL = 0, OFF_TAB = 65536, OFF_XB = 131072;
constexpr size_t OFF_WIN = OFF_XB + (size_t)T_ALL * DM * 2;
constexpr size_t OFF_WOUT = OFF_WIN + (size_t)NPAD * DM * 2;
constexpr size_t OFF_H = OFF_WOUT + (size_t)DM * DI * 2;
constexpr size_t OFF_SMALL = OFF_H + (size_t)TH * NPAD * 2;
constexpr size_t OFF_OBUF = OFF_SMALL + (size_t)TH * 48 * 4;
constexpr size_t OFF_VT = OFF_OBUF + (size_t)6 * TH * 512 * 2;
constexpr size_t OFF_DB = OFF_VT + (size_t)2 * 2 * 64 * SEQ * 2;
constexpr int NSEG = 4, SLEN = 64 / NSEG;
constexpr size_t OFF_MIXED = OFF_DB + (size_t)64 * NSEG * 128 * 4;
constexpr size_t OFF_SB0 = OFF_MIXED, OFF_SB1 = OFF_SB0 + (size_t)16 * NSEG * 16384 * 4, OFF_SB2 = OFF_SB1 + (size_t)16 * NSEG * 8192 * 4;
constexpr size_t OFF_U = OFF_SB2 + (size_t)32 * NSEG * 8192 * 4;
constexpr size_t WS_END = (OFF_U + (size_t)TH * 1024 * 2 > OFF_MIXED + (size_t)TH * DI * 2) ? (OFF_U + (size_t)TH * 1024 * 2) : (OFF_MIXED + (size_t)TH * DI * 2);
static_assert(OFF_MIXED + (size_t)TH * DI * 2 <= WS_END, "MIXED must fit");
static_assert(WS_END <= 268435456, "workspace");
constexpr size_t CTRL_BYTES = 65536;
constexpr int CTR_WORD0 = 4096;
constexpr int LDS_BYTES = 148480;
constexpr float LOG2E = 1.4426950408889634f;
constexpr float QSCALE = 0.125f * LOG2E;
constexpr float DN_ALPHA = 1.4142135623730951f;
constexpr int NPHASE = 33;
constexpr int ATT_SPLIT = 144;

struct Params {
  const float* x; const float* w_in; const float* q_gain; const float* k_gain; const float* lb_logits; const float* hgrn_norm;
  const float* conv_w; const float* conv_b; const float* dt_bias; const float* a_log; const float* ssd_d; const float* ssd_norm;
  const float* gk_w2; const float* gk_b; const float* gla_norm; const float* w_out; const float* ln_g; const float* ln_b;
  float* out; unsigned char* ws;
  int phase_begin, phase_end;
};

DEV void lds_barrier() { asm volatile("s_waitcnt lgkmcnt(0)" ::: "memory"); __builtin_amdgcn_s_barrier(); asm volatile("" ::: "memory"); }
DEV int launder(int v) { asm volatile("" : "+v"(v)); return v; }
DEV float bf2f(bf16_t v) { return __uint_as_float(((unsigned)v) << 16); }
DEV bf16_t f2bf(float f) { unsigned u = __float_as_uint(f); u += 0x7fffu + ((u >> 16) & 1u); return (bf16_t)(u >> 16); }
typedef __bf16 bf16x2_t __attribute__((ext_vector_type(2)));
typedef float f32x2_t __attribute__((ext_vector_type(2)));
DEV unsigned pk2(float lo, float hi) { const f32x2_t f = {lo, hi}; const bf16x2_t b = __builtin_convertvector(f, bf16x2_t); return __builtin_bit_cast(unsigned, b); }
DEV float fsigmoid(float x) { return 1.f / (1.f + __expf(-x)); }
DEV float fsilu(float x) { return x / (1.f + __expf(-x)); }
DEV unsigned cvtpk(float lo, float hi) { return pk2(lo, hi); }
DEV float ex2(float x) { return __builtin_amdgcn_exp2f(x); }
DEV float lg2(float x) { return __builtin_amdgcn_logf(x); }
DEV float frcp(float x) { return __builtin_amdgcn_rcpf(x); }
DEV float lo16(unsigned u) { return __uint_as_float(u << 16); }
DEV float hi16(unsigned u) { return __uint_as_float(u & 0xffff0000u); }
DEV int rowoff(int reg, int h) { return (reg & 3) + 8 * (reg >> 2) + 4 * h; }
DEV f32x16 zero16() { f32x16 z;
#pragma unroll
  for (int i = 0; i < 16; ++i) z[i] = 0.f; return z; }

template <int KD>
DEV void mma32(f32x16& acc, const bf16_t* a, int lda, const bf16_t* b, int ldb, int lane) {
  const int r = lane & 31, h = lane >> 5;
  const bf16_t* ap = a + r * lda + 8 * h;
  const bf16_t* bp = b + r * ldb + 8 * h;
#pragma unroll 4
  for (int k = 0; k < KD; k += 16) {
    bf16x8 av = *(const bf16x8*)(ap + k);
    bf16x8 bv = *(const bf16x8*)(bp + k);
    acc = __builtin_amdgcn_mfma_f32_32x32x16_bf16(av, bv, acc, 0, 0, 0);
  }
}

DEV int orig_col(int n) {
  if (n < 4864) return n;
  if (n < 6400) return n + 16;
  if (n < 6912) return n + 48;
  if (n < 6928) return n - 2048;
  if (n < 6960) return n - 512;
  return -1;
}

DEV void convert_weights(const Params& p, int l, unsigned char* smem) {
  float* s = (float*)smem;
  const int tid = launder(threadIdx.x);
  const float* win = p.w_in + (size_t)l * DM * NIN;
  const float* wout = p.w_out + (size_t)l * DI * DM;
  bf16_t* wint = (bf16_t*)(p.ws + OFF_WIN);
  bf16_t* woutt = (bf16_t*)(p.ws + OFF_WOUT);
  const int n_in_tiles = (NPAD / 64) * (DM / 64);
  const int n_out_tiles = (DM / 64) * (DI / 64);
  for (int it = blockIdx.x; it < n_in_tiles + n_out_tiles; it += gridDim.x) {
    lds_barrier();
    if (it < n_in_tiles) {
      const int n0 = (it / 16) * 64, k0 = (it % 16) * 64;
#pragma unroll
      for (int e = 0; e < 8; ++e) {
        const int idx = e * NT + tid, kk = idx >> 6, nn = idx & 63;
        const int oc = orig_col(n0 + nn);
        s[kk * 65 + nn] = (oc >= 0) ? win[(size_t)(k0 + kk) * NIN + oc] : 0.f;
      }
      lds_barrier();
      const int n = tid >> 3, kc = (tid & 7) * 8;
      uint4 o;
      o.x = pk2(s[(kc + 0) * 65 + n], s[(kc + 1) * 65 + n]); o.y = pk2(s[(kc + 2) * 65 + n], s[(kc + 3) * 65 + n]);
      o.z = pk2(s[(kc + 4) * 65 + n], s[(kc + 5) * 65 + n]); o.w = pk2(s[(kc + 6) * 65 + n], s[(kc + 7) * 65 + n]);
      *(uint4*)(wint + (size_t)(n0 + n) * DM + k0 + kc) = o;
    } else {
      const int j = it - n_in_tiles;
      const int n0 = (j / 32) * 64, k0 = (j % 32) * 64;
#pragma unroll
      for (int e = 0; e < 8; ++e) {
        const int idx = e * NT + tid, kk = idx >> 6, nn = idx & 63;
        s[kk * 65 + nn] = wout[(size_t)(k0 + kk) * DM + n0 + nn];
      }
      lds_barrier();
      const int n = tid >> 3, kc = (tid & 7) * 8;
      uint4 o;
      o.x = pk2(s[(kc + 0) * 65 + n], s[(kc + 1) * 65 + n]); o.y = pk2(s[(kc + 2) * 65 + n], s[(kc + 3) * 65 + n]);
      o.z = pk2(s[(kc + 4) * 65 + n], s[(kc + 5) * 65 + n]); o.w = pk2(s[(kc + 6) * 65 + n], s[(kc + 7) * 65 + n]);
      *(uint4*)(woutt + (size_t)(n0 + n) * DI + k0 + kc) = o;
    }
  }
  lds_barrier();
}

DEV void fsincos(float x, float& s, float& c) {
  const float k = rintf(x * 0.63661977236758134308f);
  float r = fmaf(-k, 1.5707855225e+00f, x);
  r = fmaf(-k, 1.0804273188e-05f, r);
  r = fmaf(-k, 6.0770999344e-11f, r);
  const float r2 = r * r;
  float ps = fmaf(r2, 2.7557319224e-06f, -1.9841269841e-04f);
  ps = fmaf(ps, r2, 8.3333333333e-03f); ps = fmaf(ps, r2, -1.6666666667e-01f);
  const float sinr = fmaf(ps * r2, r, r);
  float pc = fmaf(r2, -2.7557319224e-07f, 2.4801587302e-05f);
  pc = fmaf(pc, r2, -1.3888888889e-03f); pc = fmaf(pc, r2, 4.1666666667e-02f); pc = fmaf(pc, r2, -0.5f);
  const float cosr = fmaf(pc, r2, 1.0f);
  const int q = ((int)k) & 3;
  if (q == 0) { s = sinr; c = cosr; }
  else if (q == 1) { s = cosr; c = -sinr; }
  else if (q == 2) { s = -sinr; c = -cosr; }
  else { s = -cosr; c = sinr; }
}

DEV void phase_pro(const Params& p, unsigned char* smem) {
  const int tid = launder(threadIdx.x);
  const size_t gtid = (size_t)blockIdx.x * NT + tid, gsz = (size_t)gridDim.x * NT;
  const float4* x4 = (const float4*)p.x;
  uint4* xb4 = (uint4*)(p.ws + OFF_XB);
  for (size_t i = gtid; i < (size_t)T_ALL * DM / 8; i += gsz) {
    const float4 a = x4[2 * i], b = x4[2 * i + 1];
    uint4 o; o.x = pk2(a.x, a.y); o.y = pk2(a.z, a.w); o.z = pk2(b.x, b.y); o.w = pk2(b.z, b.w);
    xb4[i] = o;
  }
  if (blockIdx.x == 0) {
    float2* tab = (float2*)(p.ws + OFF_TAB);
    for (int i = tid; i < 64 * 16; i += NT) {
      const int pos = i >> 4, fi = i & 15;
      const float invf = exp2f(-(float)fi * (13.287712379549449f / 16.0f));
      const float ang = (float)pos * invf;
      float sn, cs; fsincos(ang, sn, cs);
      tab[i] = make_float2(cs, sn);
    }
  }
}

namespace pg8 {
#define PG8_LAS __attribute__((address_space(3)))
typedef unsigned short bf16_t;
typedef short bf16x8 __attribute__((ext_vector_type(8)));
typedef float f32x4 __attribute__((ext_vector_type(4)));
typedef unsigned u32x4 __attribute__((ext_vector_type(4)));
constexpr int BM = 256, BK = 64, HALF = 128, HTB = HALF * BK * 2  , STAGE_BYTES = 8 * HTB, NXCD = 8, WGM = 8;

__host__ __device__ __forceinline__ int lds_byte(int r, int c) { const int st = (r >> 4) * 2 + (c >> 5), rr = r & 15, cc = c & 31, ob = rr * 64 + cc * 2; return st * 1024 + (ob ^ (((ob >> 9) & 1) << 5)); }
__host__ __device__ __forceinline__ void stage_rc(int b, int& R, int& C) { const int st = b / 1024, sb = b % 1024, swz = sb ^ (((sb >> 9) & 1) << 5); R = (st >> 1) * 16 + swz / 64; C = (st & 1) * 32 + (swz % 64) / 2; }
__host__ __device__ __forceinline__ int perm32(int rho) { const int n = rho >> 4, i = rho & 15; return 8 * (i >> 2) + 4 * n + (i & 3); }

struct Unit { int pm, pn; };
struct Gemm { const bf16_t* A; const bf16_t* Bt; int M, N, K; };

__device__ __forceinline__ unsigned cvt_pk_bf16(float lo, float hi) { unsigned r; asm volatile("v_cvt_pk_bf16_f32 %0, %1, %2" : "=v"(r) : "v"(lo), "v"(hi)); return r; }

struct XcdOrder {
    int rpx, nN, x, c, ncu;
    __device__ void init(int M, int N) { rpx = (M / BM) / NXCD; nN = N / BM; x = blockIdx.x & 7; c = blockIdx.x >> 3; ncu = gridDim.x >> 3; }
    __device__ bool next(int i, Unit& u) const { const int j = c + i * ncu; if (j >= rpx * nN) return false; u.pm = rpx * x + (j % rpx); u.pn = j / rpx; return true; }
    __device__ __forceinline__ void a_ready(const Unit&) const {}
    __device__ __forceinline__ void done(const Unit&) const {}
};
struct EpiIn {
    static constexpr bool PERM = true, AFTER_DRAIN = false;
    bf16_t* O; int ldc; float* small; int small_pn;
    __device__ __forceinline__ void operator()(const f32x4 (&acc)[2][2][4][2], const Unit& u, int wr, int wc, int fr, int fq) const {
        const int row0 = u.pm * BM + wr * 64 + fr, col0 = u.pn * BM + wc * 32 + 8 * fq;
        if (u.pn == small_pn) {
            const int c = wc * 32 + 8 * fq;
            if (c < 48) {
#pragma unroll
                for (int ai = 0; ai < 2; ++ai)
#pragma unroll
                    for (int m = 0; m < 4; ++m) { float* rp = small + (size_t)(row0 + ai * HALF + m * 16) * 48 + c; *(f32x4*)rp = acc[ai][0][m][0]; *(f32x4*)(rp + 4) = acc[ai][0][m][1]; }
            }
            return;
        }
#pragma unroll
        for (int ai = 0; ai < 2; ++ai)
#pragma unroll
            for (int m = 0; m < 4; ++m) { bf16_t* rowp = O + (size_t)(row0 + ai * HALF + m * 16) * ldc + col0;
#pragma unroll
                for (int bj = 0; bj < 2; ++bj) { const f32x4 v0 = acc[ai][bj][m][0], v1 = acc[ai][bj][m][1];
                    u32x4 w; w.x = cvt_pk_bf16(v0[0], v0[1]); w.y = cvt_pk_bf16(v0[2], v0[3]); w.z = cvt_pk_bf16(v1[0], v1[1]); w.w = cvt_pk_bf16(v1[2], v1[3]);
                    *(u32x4*)(rowp + bj * HALF) = w; } }
    }
};
struct EpiOut {
    static constexpr bool PERM = true, AFTER_DRAIN = false;
    const float* X; float* Y; int ldc; float alpha;
    __device__ __forceinline__ void operator()(const f32x4 (&acc)[2][2][4][2], const Unit& u, int wr, int wc, int fr, int fq) const {
        const int row0 = u.pm * BM + wr * 64 + fr, col0 = u.pn * BM + wc * 32 + 8 * fq;
#pragma unroll
        for (int ai = 0; ai < 2; ++ai)
#pragma unroll
            for (int m = 0; m < 4; ++m) { const size_t off = (size_t)(row0 + ai * HALF + m * 16) * ldc + col0;
#pragma unroll
                for (int bj = 0; bj < 2; ++bj) { const f32x4 x0 = *(const f32x4*)(X + off + bj * HALF), x1 = *(const f32x4*)(X + off + bj * HALF + 4);
                    *(f32x4*)(Y + off + bj * HALF) = x0 * alpha + acc[ai][bj][m][0]; *(f32x4*)(Y + off + bj * HALF + 4) = x1 * alpha + acc[ai][bj][m][1]; } }
    }
};

template <class Epi, class Sched, bool ALIGN_EPI = false, bool SP2 = false>
__device__ __forceinline__ void gemm_phase(PG8_LAS unsigned char* lds, const Gemm g, const Sched& S, const Epi& E) {
    const int tid = launder((int)threadIdx.x), wid = __builtin_amdgcn_readfirstlane(tid >> 6), lane = tid & 63, wr = wid >> 2, wc = wid & 3, fr = lane & 15, fq = lane >> 4;
    const int K = g.K, nt = K / BK;
    unsigned voffA[2], voffB[2];
#pragma unroll
    for (int i = 0; i < 2; ++i) { int R, C; stage_rc(tid * 16 + i * 8192, R, C); const int Rb = Epi::PERM ? ((R & ~31) + perm32(R & 31)) : R;
        voffA[i] = (unsigned)(R * K + C) * 2u; voffB[i] = (unsigned)(Rb * K + C) * 2u; }
    const size_t kstep = (size_t)(BK * 2);
    const size_t hstep = (size_t)HALF * K * 2;
    const size_t tstep = 2 * hstep;
    const unsigned ldsw = (unsigned)wid * 1024u;
    const int aoff = lds_byte(wr * 64 + fr, fq * 8), boff = lds_byte(wc * 32 + fr, fq * 8);
#define PG8_SA(b, h) (((b) * 2 + (h)) * HTB)
#define PG8_SB(b, h) ((4 + (b) * 2 + (h)) * HTB)
#define PG8_STAGE(bufoff, gbase, voff) do { _Pragma("unroll") for (int _i = 0; _i < 2; ++_i) \
        __builtin_amdgcn_global_load_lds((const unsigned*)((const char*)(gbase) + (voff)[_i]), (PG8_LAS unsigned*)(lds + (bufoff) + ldsw + _i * 8192), 16, 0, 0); } while (0)
#define PG8_LDA(dst, b, h) do { _Pragma("unroll") for (int m = 0; m < 4; ++m) _Pragma("unroll") for (int k = 0; k < 2; ++k) dst[m][k] = *(const PG8_LAS bf16x8*)(lds + PG8_SA(b, h) + aoff + m * 2048 + k * 1024); } while (0)
#define PG8_LDB(dst, b, h) do { _Pragma("unroll") for (int n = 0; n < 2; ++n) _Pragma("unroll") for (int k = 0; k < 2; ++k) dst[n][k] = *(const PG8_LAS bf16x8*)(lds + PG8_SB(b, h) + boff + n * 2048 + k * 1024); } while (0)
#define PG8_MMA(ai, bj, At, Bt) do { __builtin_amdgcn_s_setprio(1); _Pragma("unroll") for (int m = 0; m < 4; ++m) _Pragma("unroll") for (int n = 0; n < 2; ++n) _Pragma("unroll") for (int k = 0; k < 2; ++k) \
        acc[ai][bj][m][n] = __builtin_amdgcn_mfma_f32_16x16x32_bf16(Bt[n][k], At[m][k], acc[ai][bj][m][n], 0, 0, 0); __builtin_amdgcn_s_setprio(0); } while (0)
#define PG8_WAIT_V(n) asm volatile("s_waitcnt vmcnt(" #n ")" ::: "memory")
#define PG8_WAIT_L(n) asm volatile("s_waitcnt lgkmcnt(" #n ")" ::: "memory")
#define PG8_BAR __builtin_amdgcn_s_barrier()
#define PG8_SCHED __builtin_amdgcn_sched_barrier(0)
    Unit cur, nxt; int ui = 0;
    if (!S.next(0, cur)) return;
    f32x4 acc[2][2][4][2];
#pragma unroll
    for (int a = 0; a < 2; ++a)
#pragma unroll
        for (int b = 0; b < 2; ++b)
#pragma unroll
            for (int m = 0; m < 4; ++m)
#pragma unroll
                for (int n = 0; n < 2; ++n) acc[a][b][m][n] = (f32x4){0.f, 0.f, 0.f, 0.f};
    bf16x8 At[4][2], B0[2][2], B1[2][2];
    const char* cA = (const char*)g.A + (size_t)cur.pm * tstep; const char* cB = (const char*)g.Bt + (size_t)cur.pn * tstep;
    S.a_ready(cur);
    if constexpr (SP2) {
        PG8_STAGE(PG8_SB(0, 0), cB, voffB); PG8_STAGE(PG8_SB(0, 1), cB + hstep, voffB); PG8_STAGE(PG8_SA(0, 0), cA, voffA); PG8_STAGE(PG8_SA(0, 1), cA + hstep, voffA);
        if (wr == 1) PG8_BAR;
        PG8_WAIT_V(2); PG8_BAR;
        PG8_STAGE(PG8_SB(1, 0), cB + kstep, voffB); PG8_STAGE(PG8_SA(1, 0), cA + kstep, voffA); PG8_STAGE(PG8_SB(1, 1), cB + hstep + kstep, voffB);
        PG8_WAIT_V(6); PG8_BAR;
    } else {
        PG8_STAGE(PG8_SB(0, 0), cB, voffB); PG8_STAGE(PG8_SA(0, 0), cA, voffA); PG8_STAGE(PG8_SB(0, 1), cB + hstep, voffB); PG8_STAGE(PG8_SA(0, 1), cA + hstep, voffA);
        if (wr == 1) PG8_BAR;
        PG8_WAIT_V(4); PG8_BAR;
        PG8_STAGE(PG8_SB(1, 0), cB + kstep, voffB); PG8_STAGE(PG8_SA(1, 0), cA + kstep, voffA); PG8_STAGE(PG8_SB(1, 1), cB + hstep + kstep, voffB);
        PG8_WAIT_V(6); PG8_BAR;
    }
    for (;;) {
        const bool has_next = S.next(ui + 1, nxt);
        const char* nA = has_next ? (const char*)g.A + (size_t)nxt.pm * tstep : cA; const char* nB = has_next ? (const char*)g.Bt + (size_t)nxt.pn * tstep : cB;
        for (int t = 0; t < nt; t += 2) {
            const bool last = (t == nt - 2);
            const char* a1 = cA + (size_t)(t + 1) * kstep;
            const char* a2 = last ? nA : cA + (size_t)(t + 2) * kstep; const char* b2 = last ? nB : cB + (size_t)(t + 2) * kstep;
            const char* a3 = a2 + kstep; const char* b3 = b2 + kstep;
            if (last && has_next) S.a_ready(nxt);
            if constexpr (SP2) {
            PG8_LDB(B0, 0, 0); PG8_LDB(B1, 0, 1); PG8_SCHED; PG8_LDA(At, 0, 0); PG8_STAGE(PG8_SA(1, 1), a1 + hstep, voffA);
            PG8_WAIT_V(8); PG8_WAIT_L(0); PG8_BAR; PG8_MMA(0, 0, At, B0); PG8_MMA(0, 1, At, B1); PG8_BAR; PG8_SCHED;
            PG8_LDA(At, 0, 1); PG8_STAGE(PG8_SB(0, 0), b2, voffB); PG8_STAGE(PG8_SB(0, 1), b2 + hstep, voffB); PG8_STAGE(PG8_SA(0, 0), a2, voffA);
            PG8_WAIT_V(8); PG8_WAIT_L(0); PG8_BAR; PG8_MMA(1, 0, At, B0); PG8_MMA(1, 1, At, B1); PG8_BAR; PG8_SCHED;
            PG8_LDB(B0, 1, 0); PG8_LDB(B1, 1, 1); PG8_SCHED; PG8_LDA(At, 1, 0); PG8_STAGE(PG8_SA(0, 1), a2 + hstep, voffA);
            PG8_WAIT_V(8); PG8_WAIT_L(0); PG8_BAR; PG8_MMA(0, 0, At, B0); PG8_MMA(0, 1, At, B1); PG8_BAR; PG8_SCHED;
            PG8_LDA(At, 1, 1); PG8_STAGE(PG8_SB(1, 0), b3, voffB); PG8_STAGE(PG8_SB(1, 1), b3 + hstep, voffB); PG8_STAGE(PG8_SA(1, 0), a3, voffA);
            PG8_WAIT_V(8); PG8_WAIT_L(0); PG8_BAR; PG8_MMA(1, 0, At, B0); PG8_MMA(1, 1, At, B1); PG8_BAR; PG8_SCHED;
            } else {
            PG8_LDB(B0, 0, 0); PG8_SCHED; PG8_LDA(At, 0, 0); PG8_STAGE(PG8_SA(1, 1), a1 + hstep, voffA);
            PG8_WAIT_L(8); PG8_BAR; PG8_WAIT_L(0); PG8_MMA(0, 0, At, B0); PG8_BAR; PG8_SCHED;
            PG8_LDB(B1, 0, 1); PG8_STAGE(PG8_SB(0, 0), b2, voffB);
            PG8_BAR; PG8_WAIT_L(0); PG8_MMA(0, 1, At, B1); PG8_BAR;
            PG8_LDA(At, 0, 1); PG8_STAGE(PG8_SA(0, 0), a2, voffA);
            PG8_BAR; PG8_WAIT_L(0); PG8_MMA(1, 0, At, B0); PG8_BAR; PG8_SCHED;
            PG8_STAGE(PG8_SB(0, 1), b2 + hstep, voffB);
            PG8_WAIT_V(6); PG8_BAR; PG8_MMA(1, 1, At, B1); PG8_BAR;
            PG8_LDB(B0, 1, 0); PG8_SCHED; PG8_LDA(At, 1, 0); PG8_STAGE(PG8_SA(0, 1), a2 + hstep, voffA);
            PG8_WAIT_L(8); PG8_BAR; PG8_WAIT_L(0); PG8_MMA(0, 0, At, B0); PG8_BAR; PG8_SCHED;
            PG8_LDB(B1, 1, 1); PG8_STAGE(PG8_SB(1, 0), b3, voffB);
            PG8_BAR; PG8_WAIT_L(0); PG8_MMA(0, 1, At, B1); PG8_BAR;
            PG8_LDA(At, 1, 1); PG8_STAGE(PG8_SA(1, 0), a3, voffA);
            PG8_BAR; PG8_WAIT_L(0); PG8_MMA(1, 0, At, B0); PG8_BAR; PG8_SCHED;
            PG8_STAGE(PG8_SB(1, 1), b3 + hstep, voffB);
            PG8_WAIT_V(6); PG8_BAR; PG8_MMA(1, 1, At, B1); PG8_BAR;
            }
        }
        if constexpr (ALIGN_EPI) { if (wr == 0) PG8_BAR; }
        if constexpr (!Epi::AFTER_DRAIN) { E(acc, cur, wr, wc, fr, fq); S.done(cur); }
        if (!has_next) break;
#pragma unroll
        for (int a = 0; a < 2; ++a)
#pragma unroll
            for (int b = 0; b < 2; ++b)
#pragma unroll
                for (int m = 0; m < 4; ++m)
#pragma unroll
                    for (int n = 0; n < 2; ++n) acc[a][b][m][n] = (f32x4){0.f, 0.f, 0.f, 0.f};
        cur = nxt; cA = nA; cB = nB; ++ui;
        if constexpr (ALIGN_EPI) { if (wr == 1) PG8_BAR; }
    }
    PG8_WAIT_V(0);
    if constexpr (!ALIGN_EPI) { if (wr == 0) PG8_BAR; }
    PG8_BAR;
    if constexpr (Epi::AFTER_DRAIN) { E.fused(acc, cur, wr, wc, fr, fq, lds, wid, lane); S.done(cur); }
#undef PG8_SA
#undef PG8_SB
#undef PG8_STAGE
#undef PG8_LDA
#undef PG8_LDB
#undef PG8_MMA
#undef PG8_WAIT_V
#undef PG8_WAIT_L
#undef PG8_BAR
#undef PG8_SCHED
}
}

DEV void phase_inproj(const Params& p, int l, int hf, unsigned char* smem) {
  pg8::Gemm g{(const bf16_t*)(p.ws + OFF_XB) + (size_t)hf * TH * DM, (const bf16_t*)(p.ws + OFF_WIN), TH, NPAD, DM};
  pg8::XcdOrder S; S.init(TH, NPAD);
  pg8::EpiIn E{(bf16_t*)(p.ws + OFF_H), NPAD, (float*)(p.ws + OFF_SMALL), SM0 / 256};
  pg8::gemm_phase<pg8::EpiIn, pg8::XcdOrder, true, true>((PG8_LAS unsigned char*)smem, g, S, E);
}

DEV void phase_outproj(const Params& p, int l, int hf, unsigned char* smem) {
  pg8::Gemm g{(const bf16_t*)(p.ws + OFF_MIXED), (const bf16_t*)(p.ws + OFF_WOUT), TH, DM, DI};
  pg8::XcdOrder S; S.init(TH, DM);
  const float* xin = ((l == 0) ? p.x : p.out) + (size_t)hf * TH * DM;
  pg8::EpiOut E{xin, p.out + (size_t)hf * TH * DM, DM, DN_ALPHA};
  pg8::gemm_phase<pg8::EpiOut, pg8::XcdOrder, true, true>((PG8_LAS unsigned char*)smem, g, S, E);
}

DEV void phase_ln(const Params& p, int l, int hf) {
  const int tid = launder(threadIdx.x), lane = tid & 63, w = tid >> 6;
  const float* g = p.ln_g + l * DM; const float* b = p.ln_b + l * DM;
  bf16_t* xb = (bf16_t*)(p.ws + OFF_XB);
  for (int r = blockIdx.x * 8 + w; r < TH; r += gridDim.x * 8) {
    const int row = hf * TH + r;
    float4* rp = (float4*)(p.out + (size_t)row * DM);
    float4 v[4];
    float s = 0.f;
#pragma unroll
    for (int j = 0; j < 4; ++j) { v[j] = rp[j * 64 + lane]; s += (v[j].x + v[j].y) + (v[j].z + v[j].w); }
#pragma unroll
    for (int o = 32; o >= 1; o >>= 1) s += __shfl_xor(s, o);
    const float mu = s * (1.f / DM);
    float q = 0.f;
#pragma unroll
    for (int j = 0; j < 4; ++j) { const float a = v[j].x - mu, bb = v[j].y - mu, cc = v[j].z - mu, d = v[j].w - mu; q += (a * a + bb * bb) + (cc * cc + d * d); }
#pragma unroll
    for (int o = 32; o >= 1; o >>= 1) q += __shfl_xor(q, o);
    const float rstd = rsqrtf(q * (1.f / DM) + 1e-5f);
#pragma unroll
    for (int j = 0; j < 4; ++j) {
      const int col = (j * 64 + lane) * 4;
      const float4 gg = *(const float4*)(g + col), bb = *(const float4*)(b + col);
      float4 o;
      o.x = (v[j].x - mu) * rstd * gg.x + bb.x; o.y = (v[j].y - mu) * rstd * gg.y + bb.y;
      o.z = (v[j].z - mu) * rstd * gg.z + bb.z; o.w = (v[j].w - mu) * rstd * gg.w + bb.w;
      rp[j * 64 + lane] = o;
      if (l == 0) { uint2 pk; pk.x = pk2(o.x, o.y); pk.y = pk2(o.z, o.w); *(uint2*)(xb + (size_t)row * DM + col) = pk; }
    }
  }
}

DEV void attn_item(const Params& p, int l, int item, unsigned char* smem) {
  const int tid = launder(threadIdx.x), lane = tid & 63, w = tid >> 6, r = lane & 31, h = lane >> 5;
  const int qt = item & 15, head = (item >> 4) & 7, bl = item >> 7;
  const int kvh = head >> 2;
  bf16_t* Hh = (bf16_t*)(p.ws + OFF_H);
  const bf16_t* VT = (const bf16_t*)(p.ws + OFF_VT);
  const size_t rowbase = (size_t)bl * SEQ;
  float mq = fabsf(p.q_gain[l * 64 + lane]), mk = fabsf(p.k_gain[l * 64 + lane]);
#pragma unroll
  for (int o = 32; o >= 1; o >>= 1) { mq = fmaxf(mq, __shfl_xor(mq, o)); mk = fmaxf(mk, __shfl_xor(mk, o)); }
  const float M2 = 8.f * mq * mk * LOG2E * 1.01f;
  const int qrow = qt * 256 + w * 32 + r;
  const bf16_t* qp = Hh + (rowbase + qrow) * NPAD + A_Q + head * 64 + 8 * h;
  bf16x8 qf[4];
#pragma unroll
  for (int ks = 0; ks < 4; ++ks) qf[ks] = *(const bf16x8*)(qp + ks * 16);
  f32x16 o0 = zero16(), o1 = zero16();
  float lsum = 0.f;
  const int srow = tid >> 3, sch = (tid & 7) * 8;
  const bf16_t* kp = Hh + (rowbase + srow) * NPAD + A_K + kvh * 64 + sch;
  const bf16_t* vp = VT + ((size_t)((bl * 2 + kvh) * 64 + srow)) * SEQ + sch;
  union PB { bf16x8 v; unsigned u[4]; };
  auto qk = [&](int st, f32x16& s0, f32x16& s1) __attribute__((always_inline)) {
    const bf16_t* sK = (const bf16_t*)(smem + st * 18432);
#pragma unroll
    for (int i = 0; i < 16; ++i) { s0[i] = -M2; s1[i] = -M2; }
#pragma unroll
    for (int ks = 0; ks < 4; ++ks) {
      const bf16x8 a0 = *(const bf16x8*)(sK + r * 72 + ks * 16 + 8 * h);
      const bf16x8 a1 = *(const bf16x8*)(sK + (32 + r) * 72 + ks * 16 + 8 * h);
      s0 = __builtin_amdgcn_mfma_f32_32x32x16_bf16(a0, qf[ks], s0, 0, 0, 0);
      s1 = __builtin_amdgcn_mfma_f32_32x32x16_bf16(a1, qf[ks], s1, 0, 0, 0);
    }
  };
  auto soft = [&](f32x16& s0, f32x16& s1, PB (&pb)[2][2]) __attribute__((always_inline)) {
#pragma unroll
    for (int i = 0; i < 16; ++i) { s0[i] = __builtin_amdgcn_exp2f(s0[i]); s1[i] = __builtin_amdgcn_exp2f(s1[i]); lsum += s0[i] + s1[i]; }
#pragma unroll
    for (int s = 0; s < 2; ++s)
#pragma unroll
      for (int j = 0; j < 4; ++j) {
        pb[0][s].u[j] = pk2(s0[8 * s + 2 * j], s0[8 * s + 2 * j + 1]);
        pb[1][s].u[j] = pk2(s1[8 * s + 2 * j], s1[8 * s + 2 * j + 1]);
      }
  };
  auto pv = [&](int st, const PB (&pb)[2][2]) __attribute__((always_inline)) {
    const bf16_t* sV = (const bf16_t*)(smem + st * 18432 + 9216);
#pragma unroll
    for (int kt2 = 0; kt2 < 2; ++kt2)
#pragma unroll
      for (int s = 0; s < 2; ++s) {
        const int kb = kt2 * 32 + 16 * s + 4 * h;
        union { bf16x8 v; uint2 u[2]; } a0, a1;
        a0.u[0] = *(const uint2*)(sV + r * 72 + kb); a0.u[1] = *(const uint2*)(sV + r * 72 + kb + 8);
        a1.u[0] = *(const uint2*)(sV + (32 + r) * 72 + kb); a1.u[1] = *(const uint2*)(sV + (32 + r) * 72 + kb + 8);
        o0 = __builtin_amdgcn_mfma_f32_32x32x16_bf16(a0.v, pb[kt2][s].v, o0, 0, 0, 0);
        o1 = __builtin_amdgcn_mfma_f32_32x32x16_bf16(a1.v, pb[kt2][s].v, o1, 0, 0, 0);
      }
  };
  auto compute2 = [&](int sta, int stb) __attribute__((always_inline)) {
    f32x16 sa0, sa1, sb0, sb1; PB pa[2][2], pbb[2][2];
    qk(sta, sa0, sa1); qk(stb, sb0, sb1);
    soft(sa0, sa1, pa); pv(sta, pa);
    soft(sb0, sb1, pbb); pv(stb, pbb);
  };
  constexpr int NKT = SEQ / 64;
  auto sstore = [&](int st, const u32x4& kk, const u32x4& vv) __attribute__((always_inline)) {
    *(u32x4*)(smem + st * 18432 + srow * 144 + sch * 2) = kk;
    *(u32x4*)(smem + st * 18432 + 9216 + srow * 144 + sch * 2) = vv;
  };
  u32x4 k0 = *(const u32x4*)kp, v0 = *(const u32x4*)vp;
  u32x4 k1 = *(const u32x4*)(kp + (size_t)64 * NPAD), v1 = *(const u32x4*)(vp + 64);
  sstore(0, k0, v0); sstore(1, k1, v1);
  k0 = *(const u32x4*)(kp + (size_t)2 * 64 * NPAD); v0 = *(const u32x4*)(vp + 2 * 64);
  k1 = *(const u32x4*)(kp + (size_t)3 * 64 * NPAD); v1 = *(const u32x4*)(vp + 3 * 64);
  lds_barrier();
  for (int kt = 0; kt < NKT; kt += 4) {
    sstore(2, k0, v0); sstore(3, k1, v1);
    if (kt + 4 < NKT) {
      k0 = *(const u32x4*)(kp + (size_t)(kt + 4) * 64 * NPAD); v0 = *(const u32x4*)(vp + (kt + 4) * 64);
      k1 = *(const u32x4*)(kp + (size_t)(kt + 5) * 64 * NPAD); v1 = *(const u32x4*)(vp + (kt + 5) * 64);
    }
    compute2(0, 1);
    lds_barrier();
    if (kt + 4 < NKT) {
      sstore(0, k0, v0); sstore(1, k1, v1);
      if (kt + 6 < NKT) {
        k0 = *(const u32x4*)(kp + (size_t)(kt + 6) * 64 * NPAD); v0 = *(const u32x4*)(vp + (kt + 6) * 64);
        k1 = *(const u32x4*)(kp + (size_t)(kt + 7) * 64 * NPAD); v1 = *(const u32x4*)(vp + (kt + 7) * 64);
      }
    }
    compute2(2, 3);
    lds_barrier();
  }
  lsum += __shfl_xor(lsum, 32);
  const float inv = 1.f / lsum;
  const bf16_t* zp = Hh + (rowbase + qrow) * NPAD + A_Z + head * 64;
  bf16_t* op = Hh + (rowbase + qrow) * NPAD + A_Q + head * 64;
#pragma unroll
  for (int dt = 0; dt < 2; ++dt)
#pragma unroll
    for (int g = 0; g < 4; ++g) {
      const int d0 = dt * 32 + 8 * g + 4 * h;
      const uint2 zz = *(const uint2*)(zp + d0);
      const float z0 = bf2f((bf16_t)(zz.x & 0xffff)), z1 = bf2f((bf16_t)(zz.x >> 16)), z2 = bf2f((bf16_t)(zz.y & 0xffff)), z3 = bf2f((bf16_t)(zz.y >> 16));
      const f32x16& oo = dt ? o1 : o0;
      uint2 ov;
      ov.x = pk2(oo[4 * g + 0] * inv * fsilu(z0), oo[4 * g + 1] * inv * fsilu(z1));
      ov.y = pk2(oo[4 * g + 2] * inv * fsilu(z2), oo[4 * g + 3] * inv * fsilu(z3));
      *(uint2*)(op + d0) = ov;
    }
  lds_barrier();
}

constexpr int L_QT = 0, L_KT = 17408, L_QC = 34816, L_KHT = 52224, L_VT = 70656, L_P = 89088, L_ST = 98304, L_RAW = 89088,
              L_D = 138240, L_TOT = 138752, L_ACS = 142848, L_DT = 143104, L_LOW = 143360;

template <int K, int V> struct ScanGeom {
  static constexpr int KP = K + 8;
  static constexpr int NS = (K / 32) * (V / 32) / 8;
};

template <int K, int V>
DEV void scan_write_state(unsigned char* smem, const f32x16* S, int w, int lane) {
  constexpr int KP = K + 8, NS = ScanGeom<K, V>::NS, NVT = V / 32;
  bf16_t* sST = (bf16_t*)(smem + L_ST);
  const int c = lane & 31, h = lane >> 5;
#pragma unroll
  for (int i = 0; i < NS; ++i) {
    const int tile = w * NS + i, kt = tile / NVT, nt = tile % NVT;
#pragma unroll
    for (int g = 0; g < 4; ++g) {
      uint2 o; o.x = pk2(S[i][4 * g + 0], S[i][4 * g + 1]); o.y = pk2(S[i][4 * g + 2], S[i][4 * g + 3]);
      *(uint2*)(sST + (nt * 32 + c) * KP + kt * 32 + 8 * g + 4 * h) = o;
    }
  }
}

template <int K, int V, bool SSDM>
DEV void scan_core(unsigned char* smem, f32x16* S, bf16_t* orow0, int dir, int w, int lane, bool do_out) {
  constexpr int KP = K + 8, NS = ScanGeom<K, V>::NS, NVT = V / 32, NOT = 2 * NVT;
  const bf16_t* sQt = (const bf16_t*)(smem + L_QT); const bf16_t* sKt = (const bf16_t*)(smem + L_KT);
  const bf16_t* sQc = (const bf16_t*)(smem + L_QC); const bf16_t* sKhT = (const bf16_t*)(smem + L_KHT);
  const bf16_t* sVT = (const bf16_t*)(smem + L_VT); bf16_t* sP = (bf16_t*)(smem + L_P);
  const bf16_t* sST = (const bf16_t*)(smem + L_ST); const float* sD = (const float*)(smem + L_D);
  const float* sAcs = (const float*)(smem + L_ACS);
  const int c = lane & 31, h = lane >> 5;
  if (do_out) scan_write_state<K, V>(smem, S, w, lane);
  if (do_out && w < 4) {
    const int tt = w >> 1, st = w & 1;
    f32x16 acc = zero16();
    if (st <= tt) mma32<K>(acc, sQt + tt * 32 * KP, KP, sKt + st * 32 * KP, KP, lane);
#pragma unroll
    for (int reg = 0; reg < 16; ++reg) {
      const int tau = tt * 32 + rowoff(reg, h), sig = st * 32 + c;
      float v = 0.f;
      if (sig <= tau) { v = acc[reg]; if (SSDM) v *= ex2(sAcs[tau] - sAcs[sig]); }
      sP[tau * 72 + sig] = f2bf(v);
    }
  }
  lds_barrier();
  if (do_out && w < NOT) {
    const int tt = w / NVT, nt = w % NVT;
    f32x16 acc = zero16();
    mma32<64>(acc, sP + tt * 32 * 72, 72, sVT + nt * 32 * 72, 72, lane);
    mma32<K>(acc, sQc + tt * 32 * KP, KP, sST + nt * 32 * KP, KP, lane);
#pragma unroll
    for (int reg = 0; reg < 16; ++reg) {
      const int tau = tt * 32 + rowoff(reg, h);
      const int tok = dir ? (63 - tau) : tau;
      orow0[(size_t)tok * 512 + nt * 32 + c] = f2bf(acc[reg]);
    }
  }
#pragma unroll
  for (int i = 0; i < NS; ++i) {
    const int tile = w * NS + i, kt = tile / NVT, nt = tile % NVT;
#pragma unroll
    for (int reg = 0; reg < 16; ++reg) S[i][reg] *= sD[kt * 32 + rowoff(reg, h)];
    mma32<64>(S[i], sKhT + kt * 32 * 72, 72, sVT + nt * 32 * 72, 72, lane);
  }
  lds_barrier();
}

template <int K, int V>
DEV void state_store(float* buf, const f32x16* S, int w, int lane) {
  constexpr int NS = ScanGeom<K, V>::NS, NVT = V / 32;
  const int c = lane & 31, h = lane >> 5;
#pragma unroll
  for (int i = 0; i < NS; ++i) {
    const int tile = w * NS + i, kt = tile / NVT, nt = tile % NVT;
#pragma unroll
    for (int reg = 0; reg < 16; ++reg) buf[(kt * 32 + rowoff(reg, h)) * V + nt * 32 + c] = S[i][reg];
  }
}
template <int K, int V>
DEV void state_load(const float* buf, f32x16* S, int w, int lane) {
  constexpr int NS = ScanGeom<K, V>::NS, NVT = V / 32;
  const int c = lane & 31, h = lane >> 5;
#pragma unroll
  for (int i = 0; i < NS; ++i) {
    const int tile = w * NS + i, kt = tile / NVT, nt = tile % NVT;
#pragma unroll
    for (int reg = 0; reg < 16; ++reg) S[i][reg] = buf[(kt * 32 + rowoff(reg, h)) * V + nt * 32 + c];
  }
}

DEV void store16(bf16_t* dst, const float* v) {
  uint4 a, b;
  a.x = pk2(v[0], v[1]); a.y = pk2(v[2], v[3]); a.z = pk2(v[4], v[5]); a.w = pk2(v[6], v[7]);
  b.x = pk2(v[8], v[9]); b.y = pk2(v[10], v[11]); b.z = pk2(v[12], v[13]); b.w = pk2(v[14], v[15]);
  ((uint4*)dst)[0] = a; ((uint4*)dst)[1] = b;
}
DEV void gather16(bf16_t* dst, const bf16_t* src, int stride) {
  unsigned u[8];
#pragma unroll
  for (int i = 0; i < 8; ++i) u[i] = (unsigned)src[(2 * i) * stride] | ((unsigned)src[(2 * i + 1) * stride] << 16);
  ((uint4*)dst)[0] = make_uint4(u[0], u[1], u[2], u[3]); ((uint4*)dst)[1] = make_uint4(u[4], u[5], u[6], u[7]);
}

DEV void hgrn_item(const Params& p, int l, int it, int seg, int mode, unsigned char* smem) {
  const int bl = it >> 3, head = (it >> 1) & 3, dir = it & 1;
  const bool do_out = (mode == 3);
  constexpr int K = 128, V = 128, KP = 136, KPW = 68;
  const int tid = launder(threadIdx.x), lane = tid & 63, w = tid >> 6;
  const int cp = tid & 63, tg = tid >> 6, ch0 = 2 * cp;
  const bf16_t* Hh = (const bf16_t*)(p.ws + OFF_H);
  bf16_t* OB = (bf16_t*)(p.ws + OFF_OBUF) + (size_t)(0 * 2 + dir) * TH * 512;
  const size_t rowbase = (size_t)bl * SEQ;
  float lb0 = 0.f, lb1 = 0.f;
  if (l > 0) {
    lb0 = fsigmoid(p.lb_logits[512 + head * 128 + ch0] - p.lb_logits[head * 128 + ch0]);
    lb1 = fsigmoid(p.lb_logits[512 + head * 128 + ch0 + 1] - p.lb_logits[head * 128 + ch0 + 1]);
  }
  const float om0 = 1.f - lb0, om1 = 1.f - lb1;
  const int fbase = dir ? H_FB : H_FF;
  unsigned* sQt = (unsigned*)(smem + L_QT); unsigned* sKt = (unsigned*)(smem + L_KT); unsigned* sQc = (unsigned*)(smem + L_QC);
  bf16_t* sKhT = (bf16_t*)(smem + L_KHT); bf16_t* sVT = (bf16_t*)(smem + L_VT);
  float* sD = (float*)(smem + L_D); float* sTot = (float*)(smem + L_TOT);
  f32x16 S[2]; S[0] = zero16(); S[1] = zero16();
  float* sbuf = (float*)(p.ws + OFF_SB0) + ((size_t)it * NSEG + seg) * 16384;
  if (do_out) state_load<K, V>(sbuf, S, w, lane);
  float dlog0 = 0.f, dlog1 = 0.f;
  unsigned pf[8], pq[8], pv[8];
  auto gload = [&](int cidx) __attribute__((always_inline)) {
    const int chunk = dir ? (63 - cidx) : cidx;
#pragma unroll
    for (int i = 0; i < 8; ++i) {
      const int tau = 8 * tg + i;
      const int tok = chunk * 64 + (dir ? (63 - tau) : tau);
      const unsigned* rp = (const unsigned*)(Hh + (rowbase + tok) * NPAD + head * 128) + cp;
      pf[i] = rp[fbase / 2]; pv[i] = rp[H_I / 2];
      pq[i] = do_out ? rp[H_Q / 2] : 0u;
    }
  };
  gload(seg * SLEN);
  for (int ci = 0; ci < SLEN; ++ci) {
    const int cidx = seg * SLEN + ci;
    const int chunk = dir ? (63 - cidx) : cidx;
    float g0[8], g1[8], kx0[8], kx1[8];
    float r0 = 0.f, r1 = 0.f;
#pragma unroll
    for (int i = 0; i < 8; ++i) {
      const float e0 = ex2(fminf(-lo16(pf[i]) * LOG2E, 80.f)), e1 = ex2(fminf(-hi16(pf[i]) * LOG2E, 80.f));
      const float s0 = frcp(1.f + e0), s1 = frcp(1.f + e1);
      r0 += lg2(lb0 + om0 * s0); r1 += lg2(lb1 + om1 * s1);
      g0[i] = r0; g1[i] = r1;
      kx0[i] = om0 * e0 * s0; kx1[i] = om1 * e1 * s1;
    }
    *(float2*)(sTot + tg * 128 + ch0) = make_float2(r0, r1);
    unsigned vv[8], qq[8];
#pragma unroll
    for (int i = 0; i < 8; ++i) { vv[i] = pv[i]; qq[i] = pq[i]; }
    lds_barrier();
    if (ci + 1 < SLEN) gload(cidx + 1);
    float off0 = 0.f, off1 = 0.f, ref0 = 0.f, ref1 = 0.f, be0 = 0.f, be1 = 0.f;
#pragma unroll
    for (int j = 0; j < 8; ++j) {
      const float2 t = *(const float2*)(sTot + j * 128 + ch0);
      if (j < tg) { off0 += t.x; off1 += t.y; }
      if (j < 4) { ref0 += t.x; ref1 += t.y; }
      be0 += t.x; be1 += t.y;
    }
    dlog0 += be0; dlog1 += be1;
    const float eref0 = ex2(ref0), eref1 = ex2(ref1), ebr0 = ex2(be0 - ref0), ebr1 = ex2(be1 - ref1);
    const float d0 = off0 - ref0, d1 = off1 - ref1;
    float kh0[8], kh1[8];
#pragma unroll
    for (int i = 0; i < 8; ++i) {
      const int tau = 8 * tg + i;
      const float E0 = ex2(g0[i] + d0), E1 = ex2(g1[i] + d1);
      const float kt0 = kx0[i] * frcp(E0), kt1 = kx1[i] * frcp(E1);
      if (do_out) {
        const float qt0 = lo16(qq[i]) * E0, qt1 = hi16(qq[i]) * E1;
        sQt[tau * KPW + cp] = cvtpk(qt0, qt1);
        sKt[tau * KPW + cp] = cvtpk(kt0, kt1);
        sQc[tau * KPW + cp] = cvtpk(qt0 * eref0, qt1 * eref1);
      }
      kh0[i] = kt0 * ebr0; kh1[i] = kt1 * ebr1;
    }
    *(u32x4*)(sKhT + ch0 * 72 + 8 * tg) = (u32x4){cvtpk(kh0[0], kh0[1]), cvtpk(kh0[2], kh0[3]), cvtpk(kh0[4], kh0[5]), cvtpk(kh0[6], kh0[7])};
    *(u32x4*)(sKhT + (ch0 + 1) * 72 + 8 * tg) = (u32x4){cvtpk(kh1[0], kh1[1]), cvtpk(kh1[2], kh1[3]), cvtpk(kh1[4], kh1[5]), cvtpk(kh1[6], kh1[7])};
    *(u32x4*)(sVT + ch0 * 72 + 8 * tg) = (u32x4){(vv[0] & 0xffffu) | (vv[1] << 16), (vv[2] & 0xffffu) | (vv[3] << 16), (vv[4] & 0xffffu) | (vv[5] << 16), (vv[6] & 0xffffu) | (vv[7] << 16)};
    *(u32x4*)(sVT + (ch0 + 1) * 72 + 8 * tg) = (u32x4){(vv[0] >> 16) | (vv[1] & 0xffff0000u), (vv[2] >> 16) | (vv[3] & 0xffff0000u), (vv[4] >> 16) | (vv[5] & 0xffff0000u), (vv[6] >> 16) | (vv[7] & 0xffff0000u)};
    if (tg == 0) *(float2*)(sD + ch0) = make_float2(ex2(be0), ex2(be1));
    lds_barrier();
    scan_core<K, V, false>(smem, S, OB + (rowbase + (size_t)chunk * 64) * 512 + head * 128, dir, w, lane, do_out);
  }
  if (!do_out) {
    state_store<K, V>(sbuf, S, w, lane);
    if (tg == 0) *(float2*)((float*)(p.ws + OFF_DB) + ((size_t)it * NSEG + seg) * 128 + ch0) = make_float2(ex2(dlog0), ex2(dlog1));
  }
}

DEV void gla_item(const Params& p, int l, int it, int seg, int mode, unsigned char* smem) {
  const int j16 = it - 16, bl = j16 >> 3, head = (j16 >> 1) & 3, dir = j16 & 1;
  const bool do_out = (mode == 3);
  constexpr int K = 64, V = 128, KP = 72, KPW = 36;
  const int tid = launder(threadIdx.x), lane = tid & 63, w = tid >> 6;
  const int cp = tid & 31, tg = tid >> 5, ch0 = 2 * cp;
  const int vp2 = tid & 63, vg = tid >> 6;
  const bf16_t* Hh = (const bf16_t*)(p.ws + OFF_H);
  const float* SMALL = (const float*)(p.ws + OFF_SMALL);
  bf16_t* OB = (bf16_t*)(p.ws + OFF_OBUF) + (size_t)(2 * 2 + dir) * TH * 512;
  const size_t rowbase = (size_t)bl * SEQ;
  unsigned* sQt = (unsigned*)(smem + L_QT); unsigned* sKt = (unsigned*)(smem + L_KT); unsigned* sQc = (unsigned*)(smem + L_QC);
  bf16_t* sKhT = (bf16_t*)(smem + L_KHT); bf16_t* sVT = (bf16_t*)(smem + L_VT);
  float* sD = (float*)(smem + L_D); float* sTot = (float*)(smem + L_TOT); float* sLow = (float*)(smem + L_LOW);
  const unsigned* rawQ = (const unsigned*)(smem + L_RAW); const unsigned* rawK = rawQ + 2048; const unsigned* rawV = rawQ + 4096;
  float* sG = (float*)(smem + L_RAW + 32768);
  float w2a[16], w2b[16];
#pragma unroll
  for (int r = 0; r < 16; ++r) {
    const float* wp = p.gk_w2 + ((size_t)(l * 2 + dir) * 16 + r) * 256 + head * 64 + ch0;
    w2a[r] = wp[0]; w2b[r] = wp[1];
  }
  const float gb0 = p.gk_b[(l * 2 + dir) * 256 + head * 64 + ch0], gb1 = p.gk_b[(l * 2 + dir) * 256 + head * 64 + ch0 + 1];
  f32x16 S[1]; S[0] = zero16();
  float* sbuf = (float*)(p.ws + OFF_SB1) + ((size_t)j16 * NSEG + seg) * 8192;
  if (do_out) state_load<K, V>(sbuf, S, w, lane);
  float dlog0 = 0.f, dlog1 = 0.f;
  u32x4 pre[4];
  float plow0, plow1;
  const int qrow = tid >> 3, qc8 = (tid & 7) * 8, vrow0 = tid >> 4, vc16 = (tid & 15) * 8;
  auto gload = [&](int cidx) __attribute__((always_inline)) {
    const int chunk = dir ? (63 - cidx) : cidx;
    {
      const int tok = chunk * 64 + (dir ? (63 - qrow) : qrow);
      const bf16_t* rp = Hh + (rowbase + tok) * NPAD + head * 64 + qc8;
      if (do_out) pre[0] = *(const u32x4*)(rp + G_Q);
      pre[1] = *(const u32x4*)(rp + G_K);
      const float* lp = SMALL + (rowbase + tok) * 48 + 16 + dir * 16 + (tid & 7) * 2; plow0 = lp[0]; plow1 = lp[1];
    }
#pragma unroll
    for (int j = 0; j < 2; ++j) {
      const int row = vrow0 + 32 * j;
      const int tok = chunk * 64 + (dir ? (63 - row) : row);
      pre[2 + j] = *(const u32x4*)(Hh + (rowbase + tok) * NPAD + G_V + head * 128 + vc16);
    }
  };
  gload(seg * SLEN);
  for (int ci = 0; ci < SLEN; ++ci) {
    const int cidx = seg * SLEN + ci;
    const int chunk = dir ? (63 - cidx) : cidx;
    {
      unsigned char* d = smem + L_RAW + qrow * 128 + qc8 * 2;
      if (do_out) *(u32x4*)d = pre[0];
      *(u32x4*)(d + 8192) = pre[1];
      sLow[qrow * 16 + (tid & 7) * 2] = plow0; sLow[qrow * 16 + (tid & 7) * 2 + 1] = plow1;
#pragma unroll
      for (int j = 0; j < 2; ++j) *(u32x4*)(smem + L_RAW + 16384 + (vrow0 + 32 * j) * 256 + vc16 * 2) = pre[2 + j];
    }
    lds_barrier();
    if (ci + 1 < SLEN) gload(cidx + 1);
    float r0 = 0.f, r1 = 0.f;
#pragma unroll
    for (int i = 0; i < 4; ++i) {
      const int tau = 4 * tg + i;
      float g0 = gb0, g1 = gb1;
#pragma unroll
      for (int r4 = 0; r4 < 4; ++r4) {
        const float4 lw = *(const float4*)(sLow + tau * 16 + 4 * r4);
        g0 += lw.x * w2a[4 * r4] + lw.y * w2a[4 * r4 + 1] + lw.z * w2a[4 * r4 + 2] + lw.w * w2a[4 * r4 + 3];
        g1 += lw.x * w2b[4 * r4] + lw.y * w2b[4 * r4 + 1] + lw.z * w2b[4 * r4 + 2] + lw.w * w2b[4 * r4 + 3];
      }
      const float l0 = (fminf(g0, 0.f) * LOG2E - lg2(1.f + ex2(-fabsf(g0) * LOG2E))) * (1.f / 16.f);
      const float l1 = (fminf(g1, 0.f) * LOG2E - lg2(1.f + ex2(-fabsf(g1) * LOG2E))) * (1.f / 16.f);
      *(float2*)(sG + tau * 64 + ch0) = make_float2(l0, l1);
      r0 += l0; r1 += l1;
    }
    *(float2*)(sTot + tg * 64 + ch0) = make_float2(r0, r1);
    lds_barrier();
    float off0 = 0.f, off1 = 0.f, ref0 = 0.f, ref1 = 0.f, be0 = 0.f, be1 = 0.f;
#pragma unroll
    for (int j = 0; j < 16; ++j) {
      const float2 t = *(const float2*)(sTot + j * 64 + ch0);
      if (j < tg) { off0 += t.x; off1 += t.y; }
      if (j < 8) { ref0 += t.x; ref1 += t.y; }
      be0 += t.x; be1 += t.y;
    }
    dlog0 += be0; dlog1 += be1;
    const float eref0 = ex2(ref0), eref1 = ex2(ref1), ebr0 = ex2(be0 - ref0), ebr1 = ex2(be1 - ref1);
    float b0 = off0, b1 = off1;
    float kh0[4], kh1[4];
#pragma unroll
    for (int i = 0; i < 4; ++i) {
      const int tau = 4 * tg + i;
      const float2 gg = *(const float2*)(sG + tau * 64 + ch0);
      b0 += gg.x; b1 += gg.y;
      const float E0 = ex2(b0 - ref0), E1 = ex2(b1 - ref1);
      const unsigned uk = rawK[tau * 32 + cp];
      const float kt0 = lo16(uk) * frcp(E0), kt1 = hi16(uk) * frcp(E1);
      if (do_out) {
        const unsigned uq = rawQ[tau * 32 + cp];
        const float qt0 = lo16(uq) * E0, qt1 = hi16(uq) * E1;
        sQt[tau * KPW + cp] = cvtpk(qt0, qt1);
        sKt[tau * KPW + cp] = cvtpk(kt0, kt1);
        sQc[tau * KPW + cp] = cvtpk(qt0 * eref0, qt1 * eref1);
      }
      kh0[i] = kt0 * ebr0; kh1[i] = kt1 * ebr1;
    }
    *(uint2*)(sKhT + ch0 * 72 + 4 * tg) = make_uint2(cvtpk(kh0[0], kh0[1]), cvtpk(kh0[2], kh0[3]));
    *(uint2*)(sKhT + (ch0 + 1) * 72 + 4 * tg) = make_uint2(cvtpk(kh1[0], kh1[1]), cvtpk(kh1[2], kh1[3]));
    {
      unsigned vv[8];
#pragma unroll
      for (int i = 0; i < 8; ++i) vv[i] = rawV[(8 * vg + i) * 64 + vp2];
      *(u32x4*)(sVT + (2 * vp2) * 72 + 8 * vg) = (u32x4){(vv[0] & 0xffffu) | (vv[1] << 16), (vv[2] & 0xffffu) | (vv[3] << 16), (vv[4] & 0xffffu) | (vv[5] << 16), (vv[6] & 0xffffu) | (vv[7] << 16)};
      *(u32x4*)(sVT + (2 * vp2 + 1) * 72 + 8 * vg) = (u32x4){(vv[0] >> 16) | (vv[1] & 0xffff0000u), (vv[2] >> 16) | (vv[3] & 0xffff0000u), (vv[4] >> 16) | (vv[5] & 0xffff0000u), (vv[6] >> 16) | (vv[7] & 0xffff0000u)};
    }
    if (tg == 0) *(float2*)(sD + ch0) = make_float2(ex2(be0), ex2(be1));
    lds_barrier();
    scan_core<K, V, false>(smem, S, OB + (rowbase + (size_t)chunk * 64) * 512 + head * 128, dir, w, lane, do_out);
  }
  if (!do_out) {
    state_store<K, V>(sbuf, S, w, lane);
    if (tg == 0) *(float2*)((float*)(p.ws + OFF_DB) + ((size_t)it * NSEG + seg) * 128 + ch0) = make_float2(ex2(dlog0), ex2(dlog1));
  }
}

DEV void ssd_item(const Params& p, int l, int it, int seg, int mode, unsigned char* smem) {
  const int j32 = it - 32, bl = j32 >> 4, head = (j32 >> 1) & 7, dir = j32 & 1;
  const bool do_out = (mode == 3);
  constexpr int K = 128, V = 64, KP = 136, KPW = 68;
  const int tid = launder(threadIdx.x), lane = tid & 63, w = tid >> 6;
  const int cp = tid & 63, tg = tid >> 6, n0 = 2 * cp;
  const int pp = tid & 63;
  const int grp = head >> 2;
  const bf16_t* U = (const bf16_t*)(p.ws + OFF_U);
  const float* SMALL = (const float*)(p.ws + OFF_SMALL);
  bf16_t* OB = (bf16_t*)(p.ws + OFF_OBUF) + (size_t)(1 * 2 + dir) * TH * 512;
  const size_t rowbase = (size_t)bl * SEQ;
  const unsigned* sQt = (const unsigned*)(smem + L_QT); const unsigned* sKt = (const unsigned*)(smem + L_KT); unsigned* sQc = (unsigned*)(smem + L_QC);
  bf16_t* sKhT = (bf16_t*)(smem + L_KHT); bf16_t* sVT = (bf16_t*)(smem + L_VT);
  float* sD = (float*)(smem + L_D); float* sAcs = (float*)(smem + L_ACS); float* sDt = (float*)(smem + L_DT);
  const bf16_t* rawX = (const bf16_t*)(smem + L_RAW);
  const float dtb = p.dt_bias[(l * 2 + dir) * 8 + head];
  const float Acoef = -__expf(p.a_log[(l * 2 + dir) * 8 + head]) * LOG2E;
  f32x16 S[1]; S[0] = zero16();
  float* sbuf = (float*)(p.ws + OFF_SB2) + ((size_t)j32 * NSEG + seg) * 8192;
  if (do_out) state_load<K, V>(sbuf, S, w, lane);
  float dlog = 0.f;
  u32x4 pre[5];
  float rdt = 0.f;
  const int prow0 = tid >> 4, pc16 = (tid & 15) * 8, xrow = tid >> 3, xc8 = (tid & 7) * 8;
  auto gload = [&](int cidx) __attribute__((always_inline)) {
    const int chunk = dir ? (63 - cidx) : cidx;
#pragma unroll
    for (int j = 0; j < 2; ++j) {
      const int row = prow0 + 32 * j;
      const int tok = chunk * 64 + (dir ? (63 - row) : row);
      const bf16_t* rp = U + (rowbase + tok) * 1024 + grp * 128 + pc16;
      pre[j] = *(const u32x4*)(rp + 512);
      if (do_out) pre[2 + j] = *(const u32x4*)(rp + 768);
    }
    {
      const int tok = chunk * 64 + (dir ? (63 - xrow) : xrow);
      pre[4] = *(const u32x4*)(U + (rowbase + tok) * 1024 + head * 64 + xc8);
    }
    if (w == 0) {
      const int tok = chunk * 64 + (dir ? (63 - lane) : lane);
      rdt = SMALL[(rowbase + tok) * 48 + dir * 8 + head];
    }
  };
  gload(seg * SLEN);
  for (int ci = 0; ci < SLEN; ++ci) {
    const int cidx = seg * SLEN + ci;
    const int chunk = dir ? (63 - cidx) : cidx;
#pragma unroll
    for (int j = 0; j < 2; ++j) {
      const int row = prow0 + 32 * j;
      *(u32x4*)(smem + L_KT + row * (KP * 2) + pc16 * 2) = pre[j];
      if (do_out) *(u32x4*)(smem + L_QT + row * (KP * 2) + pc16 * 2) = pre[2 + j];
    }
    *(u32x4*)(smem + L_RAW + xrow * 128 + xc8 * 2) = pre[4];
    if (w == 0) {
      const float xx = rdt + dtb;
      const float dt = (xx > 20.f) ? xx : log1pf(__expf(xx));
      float a = dt * Acoef;
#pragma unroll
      for (int o = 1; o < 64; o <<= 1) { const float t = __shfl_up(a, o); if (lane >= o) a += t; }
      sAcs[lane] = a; sDt[lane] = dt;
    }
    lds_barrier();
    if (ci + 1 < SLEN) gload(cidx + 1);
    const float aend = sAcs[63];
    dlog += aend;
    {
      float kh0[8], kh1[8];
#pragma unroll
      for (int i = 0; i < 8; ++i) {
        const int tau = 8 * tg + i;
        const float ac = sAcs[tau];
        const unsigned ub = sKt[tau * KPW + cp];
        const float eb = ex2(aend - ac);
        kh0[i] = lo16(ub) * eb; kh1[i] = hi16(ub) * eb;
        if (do_out) {
          const unsigned uc = sQt[tau * KPW + cp];
          const float ea = ex2(ac);
          sQc[tau * KPW + cp] = cvtpk(lo16(uc) * ea, hi16(uc) * ea);
        }
      }
      *(u32x4*)(sKhT + n0 * 72 + 8 * tg) = (u32x4){cvtpk(kh0[0], kh0[1]), cvtpk(kh0[2], kh0[3]), cvtpk(kh0[4], kh0[5]), cvtpk(kh0[6], kh0[7])};
      *(u32x4*)(sKhT + (n0 + 1) * 72 + 8 * tg) = (u32x4){cvtpk(kh1[0], kh1[1]), cvtpk(kh1[2], kh1[3]), cvtpk(kh1[4], kh1[5]), cvtpk(kh1[6], kh1[7])};
      float xv[8];
#pragma unroll
      for (int i = 0; i < 8; ++i) { const int tau = 8 * tg + i; xv[i] = bf2f(rawX[tau * 64 + pp]) * sDt[tau]; }
      *(u32x4*)(sVT + pp * 72 + 8 * tg) = (u32x4){cvtpk(xv[0], xv[1]), cvtpk(xv[2], xv[3]), cvtpk(xv[4], xv[5]), cvtpk(xv[6], xv[7])};
      if (tg == 0) *(float2*)(sD + n0) = make_float2(ex2(aend), ex2(aend));
    }
    lds_barrier();
    scan_core<K, V, true>(smem, S, OB + (rowbase + (size_t)chunk * 64) * 512 + head * 64, dir, w, lane, do_out);
  }
  if (!do_out) {
    state_store<K, V>(sbuf, S, w, lane);
    if (tg == 0) *(float2*)((float*)(p.ws + OFF_DB) + ((size_t)it * NSEG + seg) * 128 + n0) = make_float2(ex2(dlog), ex2(dlog));
  }
}

DEV void phase_prep(const Params& p, int l, int hf, unsigned char* smem) {
  const int tid = launder(threadIdx.x), lane = tid & 63, w = tid >> 6;
  bf16_t* Hh = (bf16_t*)(p.ws + OFF_H);
  {
    const int cg8 = (tid & 127) * 8, rsub = tid >> 7;
    bf16_t* U = (bf16_t*)(p.ws + OFF_U);
    const float* cw = p.conv_w + (size_t)l * 5 * 1024; const float* cb = p.conv_b + (size_t)l * 1024;
    float wv[5][8], bv[8];
#pragma unroll
    for (int j = 0; j < 5; ++j)
#pragma unroll
      for (int e = 0; e < 8; ++e) wv[j][e] = cw[j * 1024 + cg8 + e];
#pragma unroll
    for (int e = 0; e < 8; ++e) bv[e] = cb[cg8 + e];
    for (int r = blockIdx.x * 4 + rsub; r < TH; r += gridDim.x * 4) {
      const int t = r & (SEQ - 1);
      float u[8];
#pragma unroll
      for (int e = 0; e < 8; ++e) u[e] = bv[e];
#pragma unroll
      for (int j = 0; j < 5; ++j) {
        const int s = t + j - 2;
        if (s >= 0 && s < SEQ) {
          const u32x4 x = *(const u32x4*)(Hh + (size_t)(r + j - 2) * NPAD + S_X + cg8);
#pragma unroll
          for (int e = 0; e < 4; ++e) { u[2 * e] += wv[j][2 * e] * lo16(x[e]); u[2 * e + 1] += wv[j][2 * e + 1] * hi16(x[e]); }
        }
      }
      u32x4 o;
#pragma unroll
      for (int e = 0; e < 4; ++e) {
        const float a = u[2 * e] * frcp(1.f + ex2(fminf(-u[2 * e] * LOG2E, 80.f)));
        const float b = u[2 * e + 1] * frcp(1.f + ex2(fminf(-u[2 * e + 1] * LOG2E, 80.f)));
        o[e] = cvtpk(a, b);
      }
      *(u32x4*)(U + (size_t)r * 1024 + cg8) = o;
    }
  }
  {
    const float2* tabg = (const float2*)(p.ws + OFF_TAB);
    float2* stab = (float2*)smem;
    lds_barrier();
    for (int i = tid; i < 1024; i += NT) stab[i] = tabg[i];
    lds_barrier();
    const int i16 = lane & 15, grp = lane >> 4;
    const float* gq = p.q_gain + l * 64 + 4 * i16; const float* gk = p.k_gain + l * 64 + 4 * i16;
    const float gqv[4] = {gq[0], gq[1], gq[2], gq[3]}, gkv[4] = {gk[0], gk[1], gk[2], gk[3]};
    constexpr int NQ = TH * 10 / 4, UNR = 5;
    const int nw = gridDim.x * 8;
    for (int pq0 = blockIdx.x * 8 + w; pq0 < NQ; pq0 += nw * UNR) {
      uint2 xr[UNR]; bf16_t* ptr[UNR]; int rowv[UNR]; bool isqv[UNR]; bool ok[UNR];
#pragma unroll
      for (int u = 0; u < UNR; ++u) {
        const int pq = pq0 + u * nw;
        ok[u] = pq < NQ;
        const int pi = (ok[u] ? pq : 0) * 4 + grp, row = pi / 10, hd = pi - row * 10;
        rowv[u] = row; isqv[u] = hd < 8;
        ptr[u] = Hh + (size_t)row * NPAD + (isqv[u] ? (A_Q + hd * 64) : (A_K + (hd - 8) * 64)) + 4 * i16;
        xr[u] = *(const uint2*)ptr[u];
      }
#pragma unroll
      for (int u = 0; u < UNR; ++u) {
        const float x[4] = {lo16(xr[u].x), hi16(xr[u].x), lo16(xr[u].y), hi16(xr[u].y)};
        float ss = x[0] * x[0] + x[1] * x[1] + x[2] * x[2] + x[3] * x[3];
        ss += __shfl_xor(ss, 1); ss += __shfl_xor(ss, 2); ss += __shfl_xor(ss, 4); ss += __shfl_xor(ss, 8);
        const float rstd = rsqrtf(ss * (1.f / 64.f) + 1e-6f);
        const int t = rowv[u] & (SEQ - 1);
        const int pos = (i16 < 8) ? (t >> 6) : (t & 63);
        const float osc = isqv[u] ? QSCALE : 1.f;
        float o[4];
#pragma unroll
        for (int e = 0; e < 4; ++e) {
          const float v = x[e] * rstd * (isqv[u] ? gqv[e] : gkv[e]);
          const float pv = __shfl_xor(v, 4);
          const float2 cs = stab[pos * 16 + 4 * (i16 & 3) + e];
          o[e] = ((i16 & 4) ? (v * cs.x + pv * cs.y) : (v * cs.x - pv * cs.y)) * osc;
        }
        if (ok[u]) *(uint2*)ptr[u] = make_uint2(cvtpk(o[0], o[1]), cvtpk(o[2], o[3]));
      }
    }
  }
  {
    const int c8 = (tid & 63) * 8, rs = tid >> 6;
    for (int r = blockIdx.x * 8 + rs; r < TH; r += gridDim.x * 8) {
      bf16_t* hp = Hh + (size_t)r * NPAD + H_Q + c8;
      u32x4 x = *(const u32x4*)hp;
#pragma unroll
      for (int e = 0; e < 4; ++e) {
        const float a = lo16(x[e]), b = hi16(x[e]);
        x[e] = cvtpk(a * frcp(1.f + ex2(fminf(-a * LOG2E, 80.f))) * 0.08838834764831845f, b * frcp(1.f + ex2(fminf(-b * LOG2E, 80.f))) * 0.08838834764831845f);
      }
      *(u32x4*)hp = x;
      if (c8 < 256) {
        bf16_t* gp = Hh + (size_t)r * NPAD + G_Q + c8;
        u32x4 y = *(const u32x4*)gp;
#pragma unroll
        for (int e = 0; e < 4; ++e) y[e] = cvtpk(lo16(y[e]) * 0.125f, hi16(y[e]) * 0.125f);
        *(u32x4*)gp = y;
      }
    }
  }
  {
    bf16_t* VT = (bf16_t*)(p.ws + OFF_VT);
    bf16_t* sT = (bf16_t*)smem;
    for (int tile = blockIdx.x; tile < TH / 64; tile += gridDim.x) {
      lds_barrier();
#pragma unroll
      for (int j = 0; j < 2; ++j) {
        const int id = tid + 512 * j, rr = id >> 4, c8 = (id & 15) * 8;
        *(u32x4*)(sT + rr * 136 + c8) = *(const u32x4*)(Hh + (size_t)(tile * 64 + rr) * NPAD + A_V + c8);
      }
      lds_barrier();
      const int c = tid >> 2, tq = (tid & 3) * 16;
      unsigned v[16];
#pragma unroll
      for (int i = 0; i < 16; ++i) v[i] = sT[(tq + i) * 136 + c];
      const int row0 = tile * 64, bl = row0 >> 12, t0 = (row0 & (SEQ - 1)) + tq;
      bf16_t* dst = VT + ((size_t)((bl * 2 + (c >> 6)) * 64 + (c & 63))) * SEQ + t0;
      *(u32x4*)dst = (u32x4){v[0] | (v[1] << 16), v[2] | (v[3] << 16), v[4] | (v[5] << 16), v[6] | (v[7] << 16)};
      *(u32x4*)(dst + 8) = (u32x4){v[8] | (v[9] << 16), v[10] | (v[11] << 16), v[12] | (v[13] << 16), v[14] | (v[15] << 16)};
    }
    lds_barrier();
  }
}

DEV void phase_mix(const Params& p, int l, int hf, int slot, int mode, int att_lo, int att_hi, int vid_lo, int vid_hi, unsigned char* smem) {
  unsigned* ctr = (unsigned*)(p.ws + OFF_CTRL) + CTR_WORD0 + slot * 16;
  volatile int* sItem = (volatile int*)(smem + LDS_BYTES - 16);
  const int n_scan = 64 * NSEG;
  int hi = n_scan + (att_hi - att_lo); if (vid_hi < hi) hi = vid_hi;
  for (;;) {
    lds_barrier();
    if (threadIdx.x == 0) *sItem = vid_lo + (int)atomicAdd(ctr, 1u);
    lds_barrier();
    const int vid = *sItem;
    if (vid >= hi) break;
    if (vid < n_scan) {
      const int seg = vid >> 6, it = vid & 63;
      if (mode == 1 && seg == NSEG - 1) continue;
#if PROBE_REP > 0
      if (slot >= 40 && PROBE_TYPE >= 0 && ((it < 16) ? 0 : (it < 32) ? 1 : 2) != PROBE_TYPE) continue;
#endif
      if (it < 16) { if (PH_MASK & 0x100) hgrn_item(p, l, it, seg, mode, smem); }
      else if (it < 32) { if (PH_MASK & 0x200) gla_item(p, l, it, seg, mode, smem); }
      else { if (PH_MASK & 0x400) ssd_item(p, l, it, seg, mode, smem); }
    } else { if (PH_MASK & 0x800) attn_item(p, l, att_lo + (vid - n_scan), smem); }
  }
}

DEV void phase_scan2(const Params& p) {
  const size_t gtid = (size_t)blockIdx.x * NT + threadIdx.x, gsz = (size_t)gridDim.x * NT;
  const float* DB = (const float*)(p.ws + OFF_DB);
  for (size_t e = gtid; e < 655360; e += gsz) {
    float* buf; const float* dp; int stride;
    if (e < 262144) { const int it = (int)(e >> 14), idx = (int)(e & 16383); buf = (float*)(p.ws + OFF_SB0) + (size_t)it * NSEG * 16384 + idx; stride = 16384; dp = DB + (size_t)it * NSEG * 128 + (idx >> 7); }
    else if (e < 393216) { const int e2 = (int)(e - 262144), j = e2 >> 13, idx = e2 & 8191; buf = (float*)(p.ws + OFF_SB1) + (size_t)j * NSEG * 8192 + idx; stride = 8192; dp = DB + (size_t)(16 + j) * NSEG * 128 + (idx >> 7); }
    else { const int e3 = (int)(e - 393216), j = e3 >> 13, idx = e3 & 8191; buf = (float*)(p.ws + OFF_SB2) + (size_t)j * NSEG * 8192 + idx; stride = 8192; dp = DB + (size_t)(32 + j) * NSEG * 128 + (idx >> 6); }
    float u[NSEG - 1], d[NSEG - 1];
#pragma unroll
    for (int sg = 0; sg < NSEG - 1; ++sg) { u[sg] = buf[(size_t)sg * stride]; d[sg] = dp[sg * 128]; }
    float st = 0.f;
#pragma unroll
    for (int sg = 0; sg < NSEG; ++sg) { buf[(size_t)sg * stride] = st; if (sg < NSEG - 1) st = d[sg] * st + u[sg]; }
  }
}

DEV void phase_fin(const Params& p, int l, int hf) {
  const int tid = launder(threadIdx.x), lane = tid & 63, w = tid >> 6;
  const bf16_t* Hh = (const bf16_t*)(p.ws + OFF_H);
  const bf16_t* OB = (const bf16_t*)(p.ws + OFF_OBUF);
  bf16_t* MX = (bf16_t*)(p.ws + OFF_MIXED);
  const int c0 = lane * 8;
  const float* cw = p.conv_w + (size_t)l * 5 * 1024; const float* cb = p.conv_b + (size_t)l * 1024;
  for (int r = blockIdx.x * 8 + w; r < TH; r += gridDim.x * 8) {
    const bf16_t* hrow = Hh + (size_t)r * NPAD;
    *(u32x4*)(MX + (size_t)r * DI + c0) = *(const u32x4*)(hrow + A_Q + c0);
    {
      const uint4 a = *(const uint4*)(OB + ((size_t)0 * TH + r) * 512 + c0), b = *(const uint4*)(OB + ((size_t)1 * TH + r) * 512 + c0);
      const uint4 z = *(const uint4*)(hrow + H_Z + c0);
      const unsigned au[4] = {a.x, a.y, a.z, a.w}, bu[4] = {b.x, b.y, b.z, b.w}, zu[4] = {z.x, z.y, z.z, z.w};
      float o[8]; float ss = 0.f;
#pragma unroll
      for (int j = 0; j < 4; ++j) {
        o[2 * j] = bf2f((bf16_t)(au[j] & 0xffff)) + bf2f((bf16_t)(bu[j] & 0xffff));
        o[2 * j + 1] = bf2f((bf16_t)(au[j] >> 16)) + bf2f((bf16_t)(bu[j] >> 16));
        ss += o[2 * j] * o[2 * j] + o[2 * j + 1] * o[2 * j + 1];
      }
#pragma unroll
      for (int of = 32; of >= 1; of >>= 1) ss += __shfl_xor(ss, of);
      const float rstd = rsqrtf(ss * (1.f / 512.f) + 1e-6f);
      float y[8];
#pragma unroll
      for (int j = 0; j < 8; ++j) {
        const float zz = bf2f((bf16_t)((j & 1) ? (zu[j >> 1] >> 16) : (zu[j >> 1] & 0xffff)));
        y[j] = o[j] * rstd * p.hgrn_norm[l * 512 + c0 + j] * fsilu(zz);
      }
      uint4 ov; ov.x = pk2(y[0], y[1]); ov.y = pk2(y[2], y[3]); ov.z = pk2(y[4], y[5]); ov.w = pk2(y[6], y[7]);
      *(uint4*)(MX + (size_t)r * DI + 512 + c0) = ov;
    }
    {
      const uint4 a = *(const uint4*)(OB + ((size_t)4 * TH + r) * 512 + c0), b = *(const uint4*)(OB + ((size_t)5 * TH + r) * 512 + c0);
      const uint4 z = *(const uint4*)(hrow + G_Z + c0);
      const unsigned au[4] = {a.x, a.y, a.z, a.w}, bu[4] = {b.x, b.y, b.z, b.w}, zu[4] = {z.x, z.y, z.z, z.w};
      float o[8]; float ss = 0.f;
#pragma unroll
      for (int j = 0; j < 4; ++j) {
        o[2 * j] = bf2f((bf16_t)(au[j] & 0xffff)) + bf2f((bf16_t)(bu[j] & 0xffff));
        o[2 * j + 1] = bf2f((bf16_t)(au[j] >> 16)) + bf2f((bf16_t)(bu[j] >> 16));
        ss += o[2 * j] * o[2 * j] + o[2 * j + 1] * o[2 * j + 1];
      }
#pragma unroll
      for (int of = 8; of >= 1; of >>= 1) ss += __shfl_xor(ss, of);
      const float rstd = rsqrtf(ss * (1.f / 128.f) + 1e-6f);
      float y[8];
#pragma unroll
      for (int j = 0; j < 8; ++j) {
        const float zz = bf2f((bf16_t)((j & 1) ? (zu[j >> 1] >> 16) : (zu[j >> 1] & 0xffff)));
        y[j] = o[j] * rstd * p.gla_norm[l * 128 + ((c0 + j) & 127)] * fsilu(zz);
      }
      uint4 ov; ov.x = pk2(y[0], y[1]); ov.y = pk2(y[2], y[3]); ov.z = pk2(y[4], y[5]); ov.w = pk2(y[6], y[7]);
      *(uint4*)(MX + (size_t)r * DI + 1536 + c0) = ov;
    }
    {
      const uint4 a = *(const uint4*)(OB + ((size_t)2 * TH + r) * 512 + c0), b = *(const uint4*)(OB + ((size_t)3 * TH + r) * 512 + c0);
      const uint4 z = *(const uint4*)(hrow + S_Z + c0);
      const unsigned au[4] = {a.x, a.y, a.z, a.w}, bu[4] = {b.x, b.y, b.z, b.w}, zu[4] = {z.x, z.y, z.z, z.w};
      float u[8];
#pragma unroll
      for (int j = 0; j < 8; ++j) u[j] = cb[c0 + j];
      const int t = r & (SEQ - 1);
#pragma unroll
      for (int jj = 0; jj < 5; ++jj) {
        const int s = t + jj - 2;
        if (s >= 0 && s < SEQ) {
          const uint4 xr = *(const uint4*)(Hh + (size_t)(r + jj - 2) * NPAD + S_X + c0);
          const unsigned xu[4] = {xr.x, xr.y, xr.z, xr.w};
#pragma unroll
          for (int j = 0; j < 8; ++j) {
            const float xv = bf2f((bf16_t)((j & 1) ? (xu[j >> 1] >> 16) : (xu[j >> 1] & 0xffff)));
            u[j] += cw[jj * 1024 + c0 + j] * xv;
          }
        }
      }
      const float dsk = p.ssd_d[l * 8 + (c0 >> 6)];
      float y[8]; float ss = 0.f;
#pragma unroll
      for (int j = 0; j < 8; ++j) {
        const float of = bf2f((bf16_t)((j & 1) ? (au[j >> 1] >> 16) : (au[j >> 1] & 0xffff)));
        const float ob = bf2f((bf16_t)((j & 1) ? (bu[j >> 1] >> 16) : (bu[j >> 1] & 0xffff)));
        const float zz = bf2f((bf16_t)((j & 1) ? (zu[j >> 1] >> 16) : (zu[j >> 1] & 0xffff)));
        y[j] = (of + ob + dsk * fsilu(u[j])) * fsilu(zz);
        ss += y[j] * y[j];
      }
#pragma unroll
      for (int of = 32; of >= 1; of >>= 1) ss += __shfl_xor(ss, of);
      const float rstd = rsqrtf(ss * (1.f / 512.f) + 1e-6f);
#pragma unroll
      for (int j = 0; j < 8; ++j) y[j] = y[j] * rstd * p.ssd_norm[l * 512 + c0 + j];
      uint4 ov; ov.x = pk2(y[0], y[1]); ov.y = pk2(y[2], y[3]); ov.z = pk2(y[4], y[5]); ov.w = pk2(y[6], y[7]);
      *(uint4*)(MX + (size_t)r * DI + 1024 + c0) = ov;
    }
  }
}


#define XB_TMO      128
#define XB_XCNT(j)  (256  + 64 * (j))
#define XB_XSUB(j)  (1280 + 64 * (j))
#define XB_XGEN(j)  (2304 + 64 * (j))
#define XB_TOP      3328
#define XB_TOPGEN   3392
#define XB_SPIN_CAP (1u << 22)
#define LAS __attribute__((address_space(3)))
DEV unsigned xb_ld(unsigned* p) { return __hip_atomic_load(p, __ATOMIC_RELAXED, __HIP_MEMORY_SCOPE_AGENT); }
DEV unsigned xb_add(unsigned* p, unsigned v) { return __hip_atomic_fetch_add(p, v, __ATOMIC_RELAXED, __HIP_MEMORY_SCOPE_AGENT); }
DEV unsigned xb_xcc_id() { return (unsigned)__builtin_amdgcn_s_getreg((3 << 11) | 20) & 0xFu; }
#define XB_SPIN(cond, bar) do { unsigned _sp = 0; while (cond) { __builtin_amdgcn_s_sleep(1); \
    if ((++_sp & 255u) == 0u) { if (xb_ld(&(bar)[XB_TMO])) break; if (_sp > XB_SPIN_CAP) { atomicAdd(&(bar)[XB_TMO], 1u); break; } } } } while (0)
struct XcdBarrier { unsigned* bar; unsigned x; volatile LAS unsigned* st; };
DEV XcdBarrier xcd_barrier_post(unsigned* bar, volatile LAS unsigned* st) {
  XcdBarrier b; b.bar = bar; b.x = xb_xcc_id(); b.st = st;
  if (threadIdx.x == 0) (void)xb_add(&bar[XB_XCNT(b.x)], 1u);
  return b;
}
DEV void xcd_barrier_complete(unsigned* bar, unsigned x, unsigned& nloc, unsigned& nx) {
  const unsigned G = gridDim.x * gridDim.y * gridDim.z;
  unsigned sum, cnt, mine, sp = 0u;
  for (;;) {
    sum = 0u; cnt = 0u; mine = 0u;
#pragma unroll
    for (unsigned j = 0; j < 16; ++j) { const unsigned c = xb_ld(&bar[XB_XCNT(j)]); sum += c; cnt += (c > 0u) ? 1u : 0u; mine = (j == x) ? c : mine; }
    if (sum == G) break;
    __builtin_amdgcn_s_sleep(1);
    if ((++sp & 255u) == 0u) { if (xb_ld(&bar[XB_TMO])) break; if (sp > XB_SPIN_CAP) { atomicAdd(&bar[XB_TMO], 1u); break; } }
  }
  nloc = mine > 0u ? mine : 1u; nx = cnt > 0u ? cnt : 1u;
}
DEV void xcd_barrier(const XcdBarrier& b) {
  asm volatile("s_waitcnt vmcnt(0)" ::: "memory");
  __syncthreads();
  if (threadIdx.x == 0) {
    unsigned* bar = b.bar;
    __builtin_amdgcn_s_waitcnt(0);
    unsigned nloc = b.st[0], nx = b.st[1];
    if (nloc == 0u) { xcd_barrier_complete(bar, b.x, nloc, nx); b.st[0] = nloc; b.st[1] = nx; }
    const unsigned old = xb_add(&bar[XB_XSUB(b.x)], 1u);
    const unsigned gen = old / nloc;
    if (old + 1u == (gen + 1u) * nloc) {
      __builtin_amdgcn_fence(__ATOMIC_RELEASE, "agent");
      asm volatile("s_waitcnt vmcnt(0)" ::: "memory");
      const unsigned og = xb_add(&bar[XB_TOP], 1u);
      const unsigned tg = og / nx;
      if (og + 1u == (tg + 1u) * nx) xb_add(&bar[XB_TOPGEN], 1u);
      else XB_SPIN(xb_ld(&bar[XB_TOPGEN]) == tg, bar);
      __builtin_amdgcn_fence(__ATOMIC_ACQUIRE, "agent");
      xb_add(&bar[XB_XGEN(b.x)], 1u);
      asm volatile("s_waitcnt vmcnt(0)" ::: "memory");
    } else {
      XB_SPIN(xb_ld(&bar[XB_XGEN(b.x)]) == gen, bar);
      __builtin_amdgcn_fence(__ATOMIC_ACQUIRE, "agent");
      asm volatile("s_waitcnt vmcnt(0)" ::: "memory");
    }
  }
  __syncthreads();
}

DEV void run_phase(const Params& p, int ph, int rep, unsigned char* smem) {
  if (ph == 0) { if (PH_MASK & 1) phase_pro(p, smem); }
  if ((PH_MASK & 1) && (ph == 0 || ph == 16)) convert_weights(p, ph == 0 ? 0 : 1, smem);
  if (ph != 0) {
    const int q = ph - 1, l = q / 16, hf = (q / 8) & 1, st = q % 8;
    if (st == 0) { if (PH_MASK & 2) phase_inproj(p, l, hf, smem); }
    else if (st == 1) { if (PH_MASK & 4) phase_prep(p, l, hf, smem); }
    else if (st == 2) { if (PH_MASK & 0xF00) phase_mix(p, l, hf, ph + 40 * rep, 1, 0, ATT_SPLIT, rep ? PROBE_LO : 0, rep ? PROBE_HI : 100000, smem); }
    else if (st == 3) { if (PH_MASK & 0x700) phase_scan2(p); }
    else if (st == 4) { if (PH_MASK & 0xF00) phase_mix(p, l, hf, ph + 40 * rep, 3, ATT_SPLIT, 256, rep ? PROBE_LO : 0, rep ? PROBE_HI : 100000, smem); }
    else if (st == 5) { if (PH_MASK & 8) phase_fin(p, l, hf); }
    else if (st == 6) { if (PH_MASK & 16) phase_outproj(p, l, hf, smem); }
    else {
      if (PH_MASK & 32) phase_ln(p, l, hf);
    }
  }
}
__global__ void __launch_bounds__(NT) mega(Params p) {
  extern __shared__ __attribute__((aligned(16))) unsigned char smem[];
#if ONE_LAUNCH
  volatile LAS unsigned* xst = (volatile LAS unsigned*)(smem + LDS_BYTES - 32);
  if (threadIdx.x == 0) { xst[0] = 0u; xst[1] = 0u; }
  __syncthreads();
  XcdBarrier xb = xcd_barrier_post((unsigned*)(p.ws + OFF_CTRL), xst);
#endif
  Params* lp = (Params*)(smem + 147456);
  if (threadIdx.x == 0) *lp = p;
  __syncthreads();
  const int ph_begin = p.phase_begin, ph_end = p.phase_end;
  for (int ph = ph_begin; ph < ph_end; ++ph) {
    int nrep = 0;
#if PROBE_REP > 0
    {
      const int q = ph - 1, l = q / 16, st = q % 8;
      const bool idem = (ph == 0) ? (PROBE_ST == 9) : (st == PROBE_ST && (st != 6 || l == 0));
      if (idem) nrep = PROBE_REP;
    }
#endif
    for (int r = 0; r <= nrep; ++r) {
      run_phase(*lp, ph, r, smem);
#if ONE_LAUNCH
      if (r < nrep || ph + 1 < ph_end) xcd_barrier(xb);
#endif
    }
  }
}

extern "C" void kernel_launch(void* const* d_in, const int* in_sizes, int n_in, void* d_out, int out_size, void* d_ws, size_t ws_size,
                              hipStream_t stream) {
  static int grid_blocks = 0;
  if (!grid_blocks) {
    int dev = 0, cus = 0, per_cu = 0;
    hipGetDevice(&dev);
    hipDeviceGetAttribute(&cus, hipDeviceAttributeMultiprocessorCount, dev);
    hipFuncSetAttribute((const void*)mega, hipFuncAttributeMaxDynamicSharedMemorySize, LDS_BYTES);
    hipOccupancyMaxActiveBlocksPerMultiprocessor(&per_cu, mega, NT, LDS_BYTES);
    if (per_cu < 1) per_cu = 1;
    grid_blocks = cus;
  }
  Params p{};
  p.x = (const float*)d_in[0]; p.w_in = (const float*)d_in[1]; p.q_gain = (const float*)d_in[2]; p.k_gain = (const float*)d_in[3];
  p.lb_logits = (const float*)d_in[4]; p.hgrn_norm = (const float*)d_in[5]; p.conv_w = (const float*)d_in[6]; p.conv_b = (const float*)d_in[7];
  p.dt_bias = (const float*)d_in[8]; p.a_log = (const float*)d_in[9]; p.ssd_d = (const float*)d_in[10]; p.ssd_norm = (const float*)d_in[11];
  p.gk_w2 = (const float*)d_in[12]; p.gk_b = (const float*)d_in[13]; p.gla_norm = (const float*)d_in[14]; p.w_out = (const float*)d_in[15];
  p.ln_g = (const float*)d_in[16]; p.ln_b = (const float*)d_in[17];
  p.out = (float*)d_out; p.ws = (unsigned char*)d_ws;
  hipMemsetAsync(d_ws, 0, CTRL_BYTES, stream);
#if ONE_LAUNCH
  p.phase_begin = 0; p.phase_end = NPHASE;
  void* args[] = {&p};
  (void)args;
  hipLaunchKernelGGL(mega, dim3(grid_blocks), dim3(NT), LDS_BYTES, stream, p);
#else
  for (int ph = 0; ph < NPHASE; ++ph) {
    p.phase_begin = ph; p.phase_end = ph + 1;
    hipLaunchKernelGGL(mega, dim3(grid_blocks), dim3(NT), LDS_BYTES, stream, p);
  }
#endif
}
```

```cpp
#include <hip/hip_runtime.h>
#include <hip/hip_cooperative_groups.h>
#include <stdint.h>
#include <stdio.h>
namespace cg = cooperative_groups;

#ifndef ONE_LAUNCH
#define ONE_LAUNCH 1
#endif

#ifndef PH_MASK
#define PH_MASK 0xFFF
#endif
#ifndef PROBE_ST
#define PROBE_ST -1
#endif
#ifndef PROBE_REP
#define PROBE_REP 0
#endif
#ifndef PROBE_TYPE
#define PROBE_TYPE -1
#endif
#ifndef PROBE_LO
#define PROBE_LO 0
#endif
#ifndef PROBE_HI
#define PROBE_HI 100000
#endif
#define DEV __device__ __forceinline__
typedef unsigned short bf16_t;
typedef short bf16x8 __attribute__((ext_vector_type(8)));
typedef float f32x16 __attribute__((ext_vector_type(16)));
typedef unsigned u32x4 __attribute__((ext_vector_type(4)));

constexpr int NT = 512;
constexpr int T_ALL = 16384, TH = 8192, SEQ = 4096, DM = 1024, NPAD = 7168, DI = 2048, NIN = 6960;
constexpr int A_Q = 0, A_K = 512, A_V = 640, A_Z = 768, H_Q = 1280, H_FF = 1792, H_FB = 2304, H_I = 2816, H_Z = 3328,
              S_X = 3840, S_Z = 4864, G_Q = 5376, G_K = 5632, G_V = 5888, G_Z = 6400, SM0 = 6912;
constexpr size_t OFF_CTRL = 0, OFF_TAB = 65536, OFF_XB = 131072;
constexpr size_t OFF_WIN = OFF_XB + (size_t)T_ALL * DM * 2;
constexpr size_t OFF_WOUT = OFF_WIN + (size_t)NPAD * DM * 2;
constexpr size_t OFF_H = OFF_WOUT + (size_t)DM * DI * 2;
constexpr size_t OFF_SMALL = OFF_H + (size_t)TH * NPAD * 2;
constexpr size_t OFF_OBUF = OFF_SMALL + (size_t)TH * 48 * 4;
constexpr size_t OFF_VT = OFF_OBUF + (size_t)6 * TH * 512 * 2;
constexpr size_t OFF_DB = OFF_VT + (size_t)2 * 2 * 64 * SEQ * 2;
constexpr int NSEG = 4, SLEN = 64 / NSEG;
constexpr size_t OFF_MIXED = OFF_DB + (size_t)64 * NSEG * 128 * 4;
constexpr size_t OFF_SB0 = OFF_MIXED, OFF_SB1 = OFF_SB0 + (size_t)16 * NSEG * 16384 * 4, OFF_SB2 = OFF_SB1 + (size_t)16 * NSEG * 8192 * 4;
constexpr size_t OFF_U = OFF_SB2 + (size_t)32 * NSEG * 8192 * 4;
constexpr size_t WS_END = (OFF_U + (size_t)TH * 1024 * 2 > OFF_MIXED + (size_t)TH * DI * 2) ? (OFF_U + (size_t)TH * 1024 * 2) : (OFF_MIXED + (size_t)TH * DI * 2);
static_assert(OFF_MIXED + (size_t)TH * DI * 2 <= WS_END, "MIXED must fit");
static_assert(WS_END <= 268435456, "workspace");
constexpr size_t CTRL_BYTES = 65536;
constexpr int CTR_WORD0 = 4096;
constexpr int LDS_BYTES = 148480;
constexpr float LOG2E = 1.4426950408889634f;
constexpr float QSCALE = 0.125f * LOG2E;
constexpr float DN_ALPHA = 1.4142135623730951f;
constexpr int NPHASE = 27;
constexpr int ATT_SPLIT = 144;

struct Params {
  const float* x; const float* w_in; const float* q_gain; const float* k_gain; const float* lb_logits; const float* hgrn_norm;
  const float* conv_w; const float* conv_b; const float* dt_bias; const float* a_log; const float* ssd_d; const float* ssd_norm;
  const float* gk_w2; const float* gk_b; const float* gla_norm; const float* w_out; const float* ln_g; const float* ln_b;
  float* out; unsigned char* ws;
  int phase_begin, phase_end;
};

DEV void lds_barrier() { asm volatile("s_waitcnt lgkmcnt(0)" ::: "memory"); __builtin_amdgcn_s_barrier(); asm volatile("" ::: "memory"); }
DEV int launder(int v) { asm volatile("" : "+v"(v)); return v; }
DEV float bf2f(bf16_t v) { return __uint_as_float(((unsigned)v) << 16); }
DEV bf16_t f2bf(float f) { unsigned u = __float_as_uint(f); u += 0x7fffu + ((u >> 16) & 1u); return (bf16_t)(u >> 16); }
typedef __bf16 bf16x2_t __attribute__((ext_vector_type(2)));
typedef float f32x2_t __attribute__((ext_vector_type(2)));
DEV unsigned pk2(float lo, float hi) { const f32x2_t f = {lo, hi}; const bf16x2_t b = __builtin_convertvector(f, bf16x2_t); return __builtin_bit_cast(unsigned, b); }
DEV float fsigmoid(float x) { return 1.f / (1.f + __expf(-x)); }
DEV float fsilu(float x) { return x / (1.f + __expf(-x)); }
DEV unsigned cvtpk(float lo, float hi) { return pk2(lo, hi); }
DEV float ex2(float x) { return __builtin_amdgcn_exp2f(x); }
DEV float lg2(float x) { return __builtin_amdgcn_logf(x); }
DEV float frcp(float x) { return __builtin_amdgcn_rcpf(x); }
DEV float lo16(unsigned u) { return __uint_as_float(u << 16); }
DEV float hi16(unsigned u) { return __uint_as_float(u & 0xffff0000u); }
DEV int rowoff(int reg, int h) { return (reg & 3) + 8 * (reg >> 2) + 4 * h; }
DEV f32x16 zero16() { f32x16 z;
#pragma unroll
  for (int i = 0; i < 16; ++i) z[i] = 0.f; return z; }

template <int KD>
DEV void mma32(f32x16& acc, const bf16_t* a, int lda, const bf16_t* b, int ldb, int lane) {
  const int r = lane & 31, h = lane >> 5;
  const bf16_t* ap = a + r * lda + 8 * h;
  const bf16_t* bp = b + r * ldb + 8 * h;
#pragma unroll 4
  for (int k = 0; k < KD; k += 16) {
    bf16x8 av = *(const bf16x8*)(ap + k);
    bf16x8 bv = *(const bf16x8*)(bp + k);
    acc = __builtin_amdgcn_mfma_f32_32x32x16_bf16(av, bv, acc, 0, 0, 0);
  }
}

DEV int orig_col(int n) {
  if (n < 4864) return n;
  if (n < 6400) return n + 16;
  if (n < 6912) return n + 48;
  if (n < 6928) return n - 2048;
  if (n < 6960) return n - 512;
  return -1;
}

DEV void convert_weights(const Params& p, int l, int which, unsigned char* smem) {
  float* s = (float*)smem;
  const int tid = launder(threadIdx.x);
  const float* win = p.w_in + (size_t)l * DM * NIN;
  const float* wout = p.w_out + (size_t)l * DI * DM;
  bf16_t* wint = (bf16_t*)(p.ws + OFF_WIN);
  bf16_t* woutt = (bf16_t*)(p.ws + OFF_WOUT);
  const int n_in_tiles = (NPAD / 64) * (DM / 64);
  const int n_out_tiles = (DM / 64) * (DI / 64);
  const int it_lo = (which & 1) ? 0 : n_in_tiles, it_hi = (which & 2) ? (n_in_tiles + n_out_tiles) : n_in_tiles;
  for (int it = it_lo + blockIdx.x; it < it_hi; it += gridDim.x) {
    lds_barrier();
    if (it < n_in_tiles) {
      const int n0 = (it / 16) * 64, k0 = (it % 16) * 64;
#pragma unroll
      for (int e = 0; e < 8; ++e) {
        const int idx = e * NT + tid, kk = idx >> 6, nn = idx & 63;
        const int oc = orig_col(n0 + nn);
        s[kk * 65 + nn] = (oc >= 0) ? win[(size_t)(k0 + kk) * NIN + oc] : 0.f;
      }
      lds_barrier();
      const int n = tid >> 3, kc = (tid & 7) * 8;
      uint4 o;
      o.x = pk2(s[(kc + 0) * 65 + n], s[(kc + 1) * 65 + n]); o.y = pk2(s[(kc + 2) * 65 + n], s[(kc + 3) * 65 + n]);
      o.z = pk2(s[(kc + 4) * 65 + n], s[(kc + 5) * 65 + n]); o.w = pk2(s[(kc + 6) * 65 + n], s[(kc + 7) * 65 + n]);
      *(uint4*)(wint + (size_t)(n0 + n) * DM + k0 + kc) = o;
    } else {
      const int j = it - n_in_tiles;
      const int n0 = (j / 32) * 64, k0 = (j % 32) * 64;
#pragma unroll
      for (int e = 0; e < 8; ++e) {
        const int idx = e * NT + tid, kk = idx >> 6, nn = idx & 63;
        s[kk * 65 + nn] = wout[(size_t)(k0 + kk) * DM + n0 + nn];
      }
      lds_barrier();
      const int n = tid >> 3, kc = (tid & 7) * 8;
      uint4 o;
      o.x = pk2(s[(kc + 0) * 65 + n], s[(kc + 1) * 65 + n]); o.y = pk2(s[(kc + 2) * 65 + n], s[(kc + 3) * 65 + n]);
      o.z = pk2(s[(kc + 4) * 65 + n], s[(kc + 5) * 65 + n]); o.w = pk2(s[(kc + 6) * 65 + n], s[(kc + 7) * 65 + n]);
      *(uint4*)(woutt + (size_t)(n0 + n) * DI + k0 + kc) = o;
    }
  }
  lds_barrier();
}

DEV void fsincos(float x, float& s, float& c) {
  const float k = rintf(x * 0.63661977236758134308f);
  float r = fmaf(-k, 1.5707855225e+00f, x);
  r = fmaf(-k, 1.0804273188e-05f, r);
  r = fmaf(-k, 6.0770999344e-11f, r);
  const float r2 = r * r;
  float ps = fmaf(r2, 2.7557319224e-06f, -1.9841269841e-04f);
  ps = fmaf(ps, r2, 8.3333333333e-03f); ps = fmaf(ps, r2, -1.6666666667e-01f);
  const float sinr = fmaf(ps * r2, r, r);
  float pc = fmaf(r2, -2.7557319224e-07f, 2.4801587302e-05f);
  pc = fmaf(pc, r2, -1.3888888889e-03f); pc = fmaf(pc, r2, 4.1666666667e-02f); pc = fmaf(pc, r2, -0.5f);
  const float cosr = fmaf(pc, r2, 1.0f);
  const int q = ((int)k) & 3;
  if (q == 0) { s = sinr; c = cosr; }
  else if (q == 1) { s = cosr; c = -sinr; }
  else if (q == 2) { s = -sinr; c = -cosr; }
  else { s = -cosr; c = sinr; }
}

DEV void phase_pro(const Params& p, unsigned char* smem) {
  const int tid = launder(threadIdx.x);
  const size_t gtid = (size_t)blockIdx.x * NT + tid, gsz = (size_t)gridDim.x * NT;
  const float4* x4 = (const float4*)p.x;
  uint4* xb4 = (uint4*)(p.ws + OFF_XB);
  for (size_t i = gtid; i < (size_t)T_ALL * DM / 8; i += gsz) {
    const float4 a = x4[2 * i], b = x4[2 * i + 1];
    uint4 o; o.x = pk2(a.x, a.y); o.y = pk2(a.z, a.w); o.z = pk2(b.x, b.y); o.w = pk2(b.z, b.w);
    xb4[i] = o;
  }
  if (blockIdx.x == 0) {
    float2* tab = (float2*)(p.ws + OFF_TAB);
    for (int i = tid; i < 64 * 16; i += NT) {
      const int pos = i >> 4, fi = i & 15;
      const float invf = exp2f(-(float)fi * (13.287712379549449f / 16.0f));
      const float ang = (float)pos * invf;
      float sn, cs; fsincos(ang, sn, cs);
      tab[i] = make_float2(cs, sn);
    }
  }
}

namespace pg8 {
#define PG8_LAS __attribute__((address_space(3)))
typedef unsigned short bf16_t;
typedef short bf16x8 __attribute__((ext_vector_type(8)));
typedef float f32x4 __attribute__((ext_vector_type(4)));
typedef unsigned u32x4 __attribute__((ext_vector_type(4)));
constexpr int BM = 256, BK = 64, HALF = 128, HTB = HALF * BK * 2  , STAGE_BYTES = 8 * HTB, NXCD = 8, WGM = 8;

__host__ __device__ __forceinline__ int lds_byte(int r, int c) { const int st = (r >> 4) * 2 + (c >> 5), rr = r & 15, cc = c & 31, ob = rr * 64 + cc * 2; return st * 1024 + (ob ^ (((ob >> 9) & 1) << 5)); }
__host__ __device__ __forceinline__ void stage_rc(int b, int& R, int& C) { const int st = b / 1024, sb = b % 1024, swz = sb ^ (((sb >> 9) & 1) << 5); R = (st >> 1) * 16 + swz / 64; C = (st & 1) * 32 + (swz % 64) / 2; }
__host__ __device__ __forceinline__ int perm32(int rho) { const int n = rho >> 4, i = rho & 15; return 8 * (i >> 2) + 4 * n + (i & 3); }

struct Unit { int pm, pn; };
struct Gemm { const bf16_t* A; const bf16_t* Bt; int M, N, K; };

__device__ __forceinline__ unsigned cvt_pk_bf16(float lo, float hi) { unsigned r; asm volatile("v_cvt_pk_bf16_f32 %0, %1, %2" : "=v"(r) : "v"(lo), "v"(hi)); return r; }

struct XcdOrder {
    int rpx, nN, x, c, ncu, skew;
    __device__ void init(int M, int N, int skew_ = 0) { rpx = (M / BM) / NXCD; nN = N / BM; x = blockIdx.x & 7; c = blockIdx.x >> 3; ncu = gridDim.x >> 3; skew = skew_; }
    __device__ bool next(int i, Unit& u) const {
        const int total = rpx * nN, full = (total / ncu) * ncu;
        int j = c + i * ncu;
        if (skew > 0 && j >= full) { const int cc = c - skew; j = (cc >= 0 && i == total / ncu) ? full + cc : total; }
        if (j >= total) return false; u.pm = rpx * x + (j % rpx); u.pn = j / rpx; return true; }
    __device__ __forceinline__ void a_ready(const Unit&) const {}
    __device__ __forceinline__ void done(const Unit&) const {}
};
struct EpiIn {
    static constexpr bool PERM = true, AFTER_DRAIN = false;
    bf16_t* O; int ldc; float* small; int small_pn;
    __device__ __forceinline__ void operator()(const f32x4 (&acc)[2][2][4][2], const Unit& u, int wr, int wc, int fr, int fq) const {
        const int row0 = u.pm * BM + wr * 64 + fr, col0 = u.pn * BM + wc * 32 + 8 * fq;
        if (u.pn == small_pn) {
            const int c = wc * 32 + 8 * fq;
            if (c < 48) {
#pragma unroll
                for (int ai = 0; ai < 2; ++ai)
#pragma unroll
                    for (int m = 0; m < 4; ++m) { float* rp = small + (size_t)(row0 + ai * HALF + m * 16) * 48 + c; *(f32x4*)rp = acc[ai][0][m][0]; *(f32x4*)(rp + 4) = acc[ai][0][m][1]; }
            }
            return;
        }
#pragma unroll
        for (int ai = 0; ai < 2; ++ai)
#pragma unroll
            for (int m = 0; m < 4; ++m) { bf16_t* rowp = O + (size_t)(row0 + ai * HALF + m * 16) * ldc + col0;
#pragma unroll
                for (int bj = 0; bj < 2; ++bj) { const f32x4 v0 = acc[ai][bj][m][0], v1 = acc[ai][bj][m][1];
                    u32x4 w; w.x = cvt_pk_bf16(v0[0], v0[1]); w.y = cvt_pk_bf16(v0[2], v0[3]); w.z = cvt_pk_bf16(v1[0], v1[1]); w.w = cvt_pk_bf16(v1[2], v1[3]);
                    *(u32x4*)(rowp + bj * HALF) = w; } }
    }
};
struct EpiOut {
    static constexpr bool PERM = true, AFTER_DRAIN = false;
    const float* X; float* Y; int ldc; float alpha;
    __device__ __forceinline__ void operator()(const f32x4 (&acc)[2][2][4][2], const Unit& u, int wr, int wc, int fr, int fq) const {
        const int row0 = u.pm * BM + wr * 64 + fr, col0 = u.pn * BM + wc * 32 + 8 * fq;
#pragma unroll
        for (int ai = 0; ai < 2; ++ai)
#pragma unroll
            for (int m = 0; m < 4; ++m) { const size_t off = (size_t)(row0 + ai * HALF + m * 16) * ldc + col0;
#pragma unroll
                for (int bj = 0; bj < 2; ++bj) { const f32x4 x0 = *(const f32x4*)(X + off + bj * HALF), x1 = *(const f32x4*)(X + off + bj * HALF + 4);
                    *(f32x4*)(Y + off + bj * HALF) = x0 * alpha + acc[ai][bj][m][0]; *(f32x4*)(Y + off + bj * HALF + 4) = x1 * alpha + acc[ai][bj][m][1]; } }
    }
};

template <class Epi, class Sched, bool ALIGN_EPI = false, bool SP2 = false>
__device__ __forceinline__ void gemm_phase(PG8_LAS unsigned char* lds, const Gemm g, const Sched& S, const Epi& E) {
    const int tid = launder((int)threadIdx.x), wid = __builtin_amdgcn_readfirstlane(tid >> 6), lane = tid & 63, wr = wid >> 2, wc = wid & 3, fr = lane & 15, fq = lane >> 4;
    const int K = g.K, nt = K / BK;
    unsigned voffA[2], voffB[2];
#pragma unroll
    for (int i = 0; i < 2; ++i) { int R, C; stage_rc(tid * 16 + i * 8192, R, C); const int Rb = Epi::PERM ? ((R & ~31) + perm32(R & 31)) : R;
        voffA[i] = (unsigned)(R * K + C) * 2u; voffB[i] = (unsigned)(Rb * K + C) * 2u; }
    const size_t kstep = (size_t)(BK * 2);
    const size_t hstep = (size_t)HALF * K * 2;
    const size_t tstep = 2 * hstep;
    const unsigned ldsw = (unsigned)wid * 1024u;
    const int aoff = lds_byte(wr * 64 + fr, fq * 8), boff = lds_byte(wc * 32 + fr, fq * 8);
#define PG8_SA(b, h) (((b) * 2 + (h)) * HTB)
#define PG8_SB(b, h) ((4 + (b) * 2 + (h)) * HTB)
#define PG8_STAGE(bufoff, gbase, voff) do { _Pragma("unroll") for (int _i = 0; _i < 2; ++_i) \
        __builtin_amdgcn_global_load_lds((const unsigned*)((const char*)(gbase) + (voff)[_i]), (PG8_LAS unsigned*)(lds + (bufoff) + ldsw + _i * 8192), 16, 0, 0); } while (0)
#define PG8_LDA(dst, b, h) do { _Pragma("unroll") for (int m = 0; m < 4; ++m) _Pragma("unroll") for (int k = 0; k < 2; ++k) dst[m][k] = *(const PG8_LAS bf16x8*)(lds + PG8_SA(b, h) + aoff + m * 2048 + k * 1024); } while (0)
#define PG8_LDB(dst, b, h) do { _Pragma("unroll") for (int n = 0; n < 2; ++n) _Pragma("unroll") for (int k = 0; k < 2; ++k) dst[n][k] = *(const PG8_LAS bf16x8*)(lds + PG8_SB(b, h) + boff + n * 2048 + k * 1024); } while (0)
#define PG8_MMA(ai, bj, At, Bt) do { __builtin_amdgcn_s_setprio(1); _Pragma("unroll") for (int m = 0; m < 4; ++m) _Pragma("unroll") for (int n = 0; n < 2; ++n) _Pragma("unroll") for (int k = 0; k < 2; ++k) \
        acc[ai][bj][m][n] = __builtin_amdgcn_mfma_f32_16x16x32_bf16(Bt[n][k], At[m][k], acc[ai][bj][m][n], 0, 0, 0); __builtin_amdgcn_s_setprio(0); } while (0)
#define PG8_WAIT_V(n) asm volatile("s_waitcnt vmcnt(" #n ")" ::: "memory")
#define PG8_WAIT_L(n) asm volatile("s_waitcnt lgkmcnt(" #n ")" ::: "memory")
#define PG8_BAR __builtin_amdgcn_s_barrier()
#define PG8_SCHED __builtin_amdgcn_sched_barrier(0)
    Unit cur, nxt; int ui = 0;
    if (!S.next(0, cur)) return;
    f32x4 acc[2][2][4][2];
#pragma unroll
    for (int a = 0; a < 2; ++a)
#pragma unroll
        for (int b = 0; b < 2; ++b)
#pragma unroll
            for (int m = 0; m < 4; ++m)
#pragma unroll
                for (int n = 0; n < 2; ++n) acc[a][b][m][n] = (f32x4){0.f, 0.f, 0.f, 0.f};
    bf16x8 At[4][2], B0[2][2], B1[2][2];
    const char* cA = (const char*)g.A + (size_t)cur.pm * tstep; const char* cB = (const char*)g.Bt + (size_t)cur.pn * tstep;
    S.a_ready(cur);
    if constexpr (SP2) {
        PG8_STAGE(PG8_SB(0, 0), cB, voffB); PG8_STAGE(PG8_SB(0, 1), cB + hstep, voffB); PG8_STAGE(PG8_SA(0, 0), cA, voffA); PG8_STAGE(PG8_SA(0, 1), cA + hstep, voffA);
        if (wr == 1) PG8_BAR;
        PG8_WAIT_V(2); PG8_BAR;
        PG8_STAGE(PG8_SB(1, 0), cB + kstep, voffB); PG8_STAGE(PG8_SA(1, 0), cA + kstep, voffA); PG8_STAGE(PG8_SB(1, 1), cB + hstep + kstep, voffB);
        PG8_WAIT_V(6); PG8_BAR;
    } else {
        PG8_STAGE(PG8_SB(0, 0), cB, voffB); PG8_STAGE(PG8_SA(0, 0), cA, voffA); PG8_STAGE(PG8_SB(0, 1), cB + hstep, voffB); PG8_STAGE(PG8_SA(0, 1), cA + hstep, voffA);
        if (wr == 1) PG8_BAR;
        PG8_WAIT_V(4); PG8_BAR;
        PG8_STAGE(PG8_SB(1, 0), cB + kstep, voffB); PG8_STAGE(PG8_SA(1, 0), cA + kstep, voffA); PG8_STAGE(PG8_SB(1, 1), cB + hstep + kstep, voffB);
        PG8_WAIT_V(6); PG8_BAR;
    }
    for (;;) {
        const bool has_next = S.next(ui + 1, nxt);
        const char* nA = has_next ? (const char*)g.A + (size_t)nxt.pm * tstep : cA; const char* nB = has_next ? (const char*)g.Bt + (size_t)nxt.pn * tstep : cB;
        for (int t = 0; t < nt; t += 2) {
            const bool last = (t == nt - 2);
            const char* a1 = cA + (size_t)(t + 1) * kstep;
            const char* a2 = last ? nA : cA + (size_t)(t + 2) * kstep; const char* b2 = last ? nB : cB + (size_t)(t + 2) * kstep;
            const char* a3 = a2 + kstep; const char* b3 = b2 + kstep;
            if (last && has_next) S.a_ready(nxt);
            if constexpr (SP2) {
            PG8_LDB(B0, 0, 0); PG8_LDB(B1, 0, 1); PG8_SCHED; PG8_LDA(At, 0, 0); PG8_STAGE(PG8_SA(1, 1), a1 + hstep, voffA);
            PG8_WAIT_V(8); PG8_WAIT_L(0); PG8_BAR; PG8_MMA(0, 0, At, B0); PG8_MMA(0, 1, At, B1); PG8_BAR; PG8_SCHED;
            PG8_LDA(At, 0, 1); PG8_STAGE(PG8_SB(0, 0), b2, voffB); PG8_STAGE(PG8_SB(0, 1), b2 + hstep, voffB); PG8_STAGE(PG8_SA(0, 0), a2, voffA);
            PG8_WAIT_V(8); PG8_WAIT_L(0); PG8_BAR; PG8_MMA(1, 0, At, B0); PG8_MMA(1, 1, At, B1); PG8_BAR; PG8_SCHED;
            PG8_LDB(B0, 1, 0); PG8_LDB(B1, 1, 1); PG8_SCHED; PG8_LDA(At, 1, 0); PG8_STAGE(PG8_SA(0, 1), a2 + hstep, voffA);
            PG8_WAIT_V(8); PG8_WAIT_L(0); PG8_BAR; PG8_MMA(0, 0, At, B0); PG8_MMA(0, 1, At, B1); PG8_BAR; PG8_SCHED;
            PG8_LDA(At, 1, 1); PG8_STAGE(PG8_SB(1, 0), b3, voffB); PG8_STAGE(PG8_SB(1, 1), b3 + hstep, voffB); PG8_STAGE(PG8_SA(1, 0), a3, voffA);
            PG8_WAIT_V(8); PG8_WAIT_L(0); PG8_BAR; PG8_MMA(1, 0, At, B0); PG8_MMA(1, 1, At, B1); PG8_BAR; PG8_SCHED;
            } else {
            PG8_LDB(B0, 0, 0); PG8_SCHED; PG8_LDA(At, 0, 0); PG8_STAGE(PG8_SA(1, 1), a1 + hstep, voffA);
            PG8_WAIT_L(8); PG8_BAR; PG8_WAIT_L(0); PG8_MMA(0, 0, At, B0); PG8_BAR; PG8_SCHED;
            PG8_LDB(B1, 0, 1); PG8_STAGE(PG8_SB(0, 0), b2, voffB);
            PG8_BAR; PG8_WAIT_L(0); PG8_MMA(0, 1, At, B1); PG8_BAR;
            PG8_LDA(At, 0, 1); PG8_STAGE(PG8_SA(0, 0), a2, voffA);
            PG8_BAR; PG8_WAIT_L(0); PG8_MMA(1, 0, At, B0); PG8_BAR; PG8_SCHED;
            PG8_STAGE(PG8_SB(0, 1), b2 + hstep, voffB);
            PG8_WAIT_V(6); PG8_BAR; PG8_MMA(1, 1, At, B1); PG8_BAR;
            PG8_LDB(B0, 1, 0); PG8_SCHED; PG8_LDA(At, 1, 0); PG8_STAGE(PG8_SA(0, 1), a2 + hstep, voffA);
            PG8_WAIT_L(8); PG8_BAR; PG8_WAIT_L(0); PG8_MMA(0, 0, At, B0); PG8_BAR; PG8_SCHED;
            PG8_LDB(B1, 1, 1); PG8_STAGE(PG8_SB(1, 0), b3, voffB);
            PG8_BAR; PG8_WAIT_L(0); PG8_MMA(0, 1, At, B1); PG8_BAR;
            PG8_LDA(At, 1, 1); PG8_STAGE(PG8_SA(1, 0), a3, voffA);
            PG8_BAR; PG8_WAIT_L(0); PG8_MMA(1, 0, At, B0); PG8_BAR; PG8_SCHED;
            PG8_STAGE(PG8_SB(1, 1), b3 + hstep, voffB);
            PG8_WAIT_V(6); PG8_BAR; PG8_MMA(1, 1, At, B1); PG8_BAR;
            }
        }
        if constexpr (ALIGN_EPI) { if (wr == 0) PG8_BAR; }
        if constexpr (!Epi::AFTER_DRAIN) { E(acc, cur, wr, wc, fr, fq); S.done(cur); }
        if (!has_next) break;
#pragma unroll
        for (int a = 0; a < 2; ++a)
#pragma unroll
            for (int b = 0; b < 2; ++b)
#pragma unroll
                for (int m = 0; m < 4; ++m)
#pragma unroll
                    for (int n = 0; n < 2; ++n) acc[a][b][m][n] = (f32x4){0.f, 0.f, 0.f, 0.f};
        cur = nxt; cA = nA; cB = nB; ++ui;
        if constexpr (ALIGN_EPI) { if (wr == 1) PG8_BAR; }
    }
    PG8_WAIT_V(0);
    if constexpr (!ALIGN_EPI) { if (wr == 0) PG8_BAR; }
    PG8_BAR;
    if constexpr (Epi::AFTER_DRAIN) { E.fused(acc, cur, wr, wc, fr, fq, lds, wid, lane); S.done(cur); }
#undef PG8_SA
#undef PG8_SB
#undef PG8_STAGE
#undef PG8_LDA
#undef PG8_LDB
#undef PG8_MMA
#undef PG8_WAIT_V
#undef PG8_WAIT_L
#undef PG8_BAR
#undef PG8_SCHED
}
}

DEV void phase_inproj(const Params& p, int l, int hf, int skew, unsigned char* smem) {
  pg8::Gemm g{(const bf16_t*)(p.ws + OFF_XB) + (size_t)hf * TH * DM, (const bf16_t*)(p.ws + OFF_WIN), TH, NPAD, DM};
  pg8::XcdOrder S; S.init(TH, NPAD, skew);
  pg8::EpiIn E{(bf16_t*)(p.ws + OFF_H), NPAD, (float*)(p.ws + OFF_SMALL), SM0 / 256};
  pg8::gemm_phase<pg8::EpiIn, pg8::XcdOrder, true, true>((PG8_LAS unsigned char*)smem, g, S, E);
}

DEV void phase_outproj(const Params& p, int l, int hf, unsigned char* smem) {
  pg8::Gemm g{(const bf16_t*)(p.ws + OFF_MIXED), (const bf16_t*)(p.ws + OFF_WOUT), TH, DM, DI};
  pg8::XcdOrder S; S.init(TH, DM);
  const float* xin = ((l == 0) ? p.x : p.out) + (size_t)hf * TH * DM;
  pg8::EpiOut E{xin, p.out + (size_t)hf * TH * DM, DM, DN_ALPHA};
  pg8::gemm_phase<pg8::EpiOut, pg8::XcdOrder, true, true>((PG8_LAS unsigned char*)smem, g, S, E);
}

DEV void phase_ln(const Params& p, int l, int hf) {
  const int tid = launder(threadIdx.x), lane = tid & 63, w = tid >> 6;
  const float* g = p.ln_g + l * DM; const float* b = p.ln_b + l * DM;
  bf16_t* xb = (bf16_t*)(p.ws + OFF_XB);
  for (int r = blockIdx.x * 8 + w; r < TH; r += gridDim.x * 8) {
    const int row = hf * TH + r;
    float4* rp = (float4*)(p.out + (size_t)row * DM);
    float4 v[4];
    float s = 0.f;
#pragma unroll
    for (int j = 0; j < 4; ++j) { v[j] = rp[j * 64 + lane]; s += (v[j].x + v[j].y) + (v[j].z + v[j].w); }
#pragma unroll
    for (int o = 32; o >= 1; o >>= 1) s += __shfl_xor(s, o);
    const float mu = s * (1.f / DM);
    float q = 0.f;
#pragma unroll
    for (int j = 0; j < 4; ++j) { const float a = v[j].x - mu, bb = v[j].y - mu, cc = v[j].z - mu, d = v[j].w - mu; q += (a * a + bb * bb) + (cc * cc + d * d); }
#pragma unroll
    for (int o = 32; o >= 1; o >>= 1) q += __shfl_xor(q, o);
    const float rstd = rsqrtf(q * (1.f / DM) + 1e-5f);
#pragma unroll
    for (int j = 0; j < 4; ++j) {
      const int col = (j * 64 + lane) * 4;
      const float4 gg = *(const float4*)(g + col), bb = *(const float4*)(b + col);
      float4 o;
      o.x = (v[j].x - mu) * rstd * gg.x + bb.x; o.y = (v[j].y - mu) * rstd * gg.y + bb.y;
      o.z = (v[j].z - mu) * rstd * gg.z + bb.z; o.w = (v[j].w - mu) * rstd * gg.w + bb.w;
      rp[j * 64 + lane] = o;
      if (l == 0) { uint2 pk; pk.x = pk2(o.x, o.y); pk.y = pk2(o.z, o.w); *(uint2*)(xb + (size_t)row * DM + col) = pk; }
    }
  }
}

DEV void attn_item(const Params& p, int l, int item, unsigned char* smem) {
  const int tid = launder(threadIdx.x), lane = tid & 63, w = tid >> 6, r = lane & 31, h = lane >> 5;
  const int qt = item & 15, head = (item >> 4) & 7, bl = item >> 7;
  const int kvh = head >> 2;
  bf16_t* Hh = (bf16_t*)(p.ws + OFF_H);
  const bf16_t* VT = (const bf16_t*)(p.ws + OFF_VT);
  const size_t rowbase = (size_t)bl * SEQ;
  float mq = fabsf(p.q_gain[l * 64 + lane]), mk = fabsf(p.k_gain[l * 64 + lane]);
#pragma unroll
  for (int o = 32; o >= 1; o >>= 1) { mq = fmaxf(mq, __shfl_xor(mq, o)); mk = fmaxf(mk, __shfl_xor(mk, o)); }
  const float M2 = 8.f * mq * mk * LOG2E * 1.01f;
  const int qrow = qt * 256 + w * 32 + r;
  const bf16_t* qp = Hh + (rowbase + qrow) * NPAD + A_Q + head * 64 + 8 * h;
  bf16x8 qf[4];
#pragma unroll
  for (int ks = 0; ks < 4; ++ks) qf[ks] = *(const bf16x8*)(qp + ks * 16);
  f32x16 o0 = zero16(), o1 = zero16();
  float lsum = 0.f;
  const int srow = tid >> 3, sch = (tid & 7) * 8;
  const bf16_t* kp = Hh + (rowbase + srow) * NPAD + A_K + kvh * 64 + sch;
  const bf16_t* vp = VT + ((size_t)((bl * 2 + kvh) * 64 + srow)) * SEQ + sch;
  union PB { bf16x8 v; unsigned u[4]; };
  auto qk = [&](int st, f32x16& s0, f32x16& s1) __attribute__((always_inline)) {
    const bf16_t* sK = (const bf16_t*)(smem + st * 18432);
#pragma unroll
    for (int i = 0; i < 16; ++i) { s0[i] = -M2; s1[i] = -M2; }
#pragma unroll
    for (int ks = 0; ks < 4; ++ks) {
      const bf16x8 a0 = *(const bf16x8*)(sK + r * 72 + ks * 16 + 8 * h);
      const bf16x8 a1 = *(const bf16x8*)(sK + (32 + r) * 72 + ks * 16 + 8 * h);
      s0 = __builtin_amdgcn_mfma_f32_32x32x16_bf16(a0, qf[ks], s0, 0, 0, 0);
      s1 = __builtin_amdgcn_mfma_f32_32x32x16_bf16(a1, qf[ks], s1, 0, 0, 0);
    }
  };
  auto soft = [&](f32x16& s0, f32x16& s1, PB (&pb)[2][2]) __attribute__((always_inline)) {
#pragma unroll
    for (int i = 0; i < 16; ++i) { s0[i] = __builtin_amdgcn_exp2f(s0[i]); s1[i] = __builtin_amdgcn_exp2f(s1[i]); lsum += s0[i] + s1[i]; }
#pragma unroll
    for (int s = 0; s < 2; ++s)
#pragma unroll
      for (int j = 0; j < 4; ++j) {
        pb[0][s].u[j] = pk2(s0[8 * s + 2 * j], s0[8 * s + 2 * j + 1]);
        pb[1][s].u[j] = pk2(s1[8 * s + 2 * j], s1[8 * s + 2 * j + 1]);
      }
  };
  auto pv = [&](int st, const PB (&pb)[2][2]) __attribute__((always_inline)) {
    const bf16_t* sV = (const bf16_t*)(smem + st * 18432 + 9216);
#pragma unroll
    for (int kt2 = 0; kt2 < 2; ++kt2)
#pragma unroll
      for (int s = 0; s < 2; ++s) {
        const int kb = kt2 * 32 + 16 * s + 4 * h;
        union { bf16x8 v; uint2 u[2]; } a0, a1;
        a0.u[0] = *(const uint2*)(sV + r * 72 + kb); a0.u[1] = *(const uint2*)(sV + r * 72 + kb + 8);
        a1.u[0] = *(const uint2*)(sV + (32 + r) * 72 + kb); a1.u[1] = *(const uint2*)(sV + (32 + r) * 72 + kb + 8);
        o0 = __builtin_amdgcn_mfma_f32_32x32x16_bf16(a0.v, pb[kt2][s].v, o0, 0, 0, 0);
        o1 = __builtin_amdgcn_mfma_f32_32x32x16_bf16(a1.v, pb[kt2][s].v, o1, 0, 0, 0);
      }
  };
  auto compute2 = [&](int sta, int stb) __attribute__((always_inline)) {
    f32x16 sa0, sa1, sb0, sb1; PB pa[2][2], pbb[2][2];
    qk(sta, sa0, sa1); qk(stb, sb0, sb1);
    soft(sa0, sa1, pa); pv(sta, pa);
    soft(sb0, sb1, pbb); pv(stb, pbb);
  };
  constexpr int NKT = SEQ / 64;
  auto sstore = [&](int st, const u32x4& kk, const u32x4& vv) __attribute__((always_inline)) {
    *(u32x4*)(smem + st * 18432 + srow * 144 + sch * 2) = kk;
    *(u32x4*)(smem + st * 18432 + 9216 + srow * 144 + sch * 2) = vv;
  };
  u32x4 k0 = *(const u32x4*)kp, v0 = *(const u32x4*)vp;
  u32x4 k1 = *(const u32x4*)(kp + (size_t)64 * NPAD), v1 = *(const u32x4*)(vp + 64);
  sstore(0, k0, v0); sstore(1, k1, v1);
  k0 = *(const u32x4*)(kp + (size_t)2 * 64 * NPAD); v0 = *(const u32x4*)(vp + 2 * 64);
  k1 = *(const u32x4*)(kp + (size_t)3 * 64 * NPAD); v1 = *(const u32x4*)(vp + 3 * 64);
  lds_barrier();
  for (int kt = 0; kt < NKT; kt += 4) {
    sstore(2, k0, v0); sstore(3, k1, v1);
    if (kt + 4 < NKT) {
      k0 = *(const u32x4*)(kp + (size_t)(kt + 4) * 64 * NPAD); v0 = *(const u32x4*)(vp + (kt + 4) * 64);
      k1 = *(const u32x4*)(kp + (size_t)(kt + 5) * 64 * NPAD); v1 = *(const u32x4*)(vp + (kt + 5) * 64);
    }
    compute2(0, 1);
    lds_barrier();
    if (kt + 4 < NKT) {
      sstore(0, k0, v0); sstore(1, k1, v1);
      if (kt + 6 < NKT) {
        k0 = *(const u32x4*)(kp + (size_t)(kt + 6) * 64 * NPAD); v0 = *(const u32x4*)(vp + (kt + 6) * 64);
        k1 = *(const u32x4*)(kp + (size_t)(kt + 7) * 64 * NPAD); v1 = *(const u32x4*)(vp + (kt + 7) * 64);
      }
    }
    compute2(2, 3);
    lds_barrier();
  }
  lsum += __shfl_xor(lsum, 32);
  const float inv = 1.f / lsum;
  const bf16_t* zp = Hh + (rowbase + qrow) * NPAD + A_Z + head * 64;
  bf16_t* op = Hh + (rowbase + qrow) * NPAD + A_Q + head * 64;
#pragma unroll
  for (int dt = 0; dt < 2; ++dt)
#pragma unroll
    for (int g = 0; g < 4; ++g) {
      const int d0 = dt * 32 + 8 * g + 4 * h;
      const uint2 zz = *(const uint2*)(zp + d0);
      const float z0 = bf2f((bf16_t)(zz.x & 0xffff)), z1 = bf2f((bf16_t)(zz.x >> 16)), z2 = bf2f((bf16_t)(zz.y & 0xffff)), z3 = bf2f((bf16_t)(zz.y >> 16));
      const f32x16& oo = dt ? o1 : o0;
      uint2 ov;
      ov.x = pk2(oo[4 * g + 0] * inv * fsilu(z0), oo[4 * g + 1] * inv * fsilu(z1));
      ov.y = pk2(oo[4 * g + 2] * inv * fsilu(z2), oo[4 * g + 3] * inv * fsilu(z3));
      *(uint2*)(op + d0) = ov;
    }
  lds_barrier();
}

constexpr int L_QT = 0, L_KT = 17408, L_QC = 34816, L_KHT = 52224, L_VT = 70656, L_P = 89088, L_ST = 98304, L_RAW = 89088,
              L_D = 138240, L_TOT = 138752, L_ACS = 142848, L_DT = 143104, L_LOW = 143360;

template <int K, int V> struct ScanGeom {
  static constexpr int KP = K + 8;
  static constexpr int NS = (K / 32) * (V / 32) / 8;
};

template <int K, int V>
DEV void scan_write_state(unsigned char* smem, const f32x16* S, int w, int lane) {
  constexpr int KP = K + 8, NS = ScanGeom<K, V>::NS, NVT = V / 32;
  bf16_t* sST = (bf16_t*)(smem + L_ST);
  const int c = lane & 31, h = lane >> 5;
#pragma unroll
  for (int i = 0; i < NS; ++i) {
    const int tile = w * NS + i, kt = tile / NVT, nt = tile % NVT;
#pragma unroll
    for (int g = 0; g < 4; ++g) {
      uint2 o; o.x = pk2(S[i][4 * g + 0], S[i][4 * g + 1]); o.y = pk2(S[i][4 * g + 2], S[i][4 * g + 3]);
      *(uint2*)(sST + (nt * 32 + c) * KP + kt * 32 + 8 * g + 4 * h) = o;
    }
  }
}

template <int K, int V, bool SSDM>
DEV void scan_core(unsigned char* smem, f32x16* S, bf16_t* orow0, int dir, int w, int lane, bool do_out) {
  constexpr int KP = K + 8, NS = ScanGeom<K, V>::NS, NVT = V / 32, NOT = 2 * NVT;
  const bf16_t* sQt = (const bf16_t*)(smem + L_QT); const bf16_t* sKt = (const bf16_t*)(smem + L_KT);
  const bf16_t* sQc = (const bf16_t*)(smem + L_QC); const bf16_t* sKhT = (const bf16_t*)(smem + L_KHT);
  const bf16_t* sVT = (const bf16_t*)(smem + L_VT); bf16_t* sP = (bf16_t*)(smem + L_P);
  const bf16_t* sST = (const bf16_t*)(smem + L_ST); const float* sD = (const float*)(smem + L_D);
  const float* sAcs = (const float*)(smem + L_ACS);
  const int c = lane & 31, h = lane >> 5;
  if (do_out) scan_write_state<K, V>(smem, S, w, lane);
  if (do_out && w < 4) {
    const int tt = w >> 1, st = w & 1;
    f32x16 acc = zero16();
    if (st <= tt) mma32<K>(acc, sQt + tt * 32 * KP, KP, sKt + st * 32 * KP, KP, lane);
#pragma unroll
    for (int reg = 0; reg < 16; ++reg) {
      const int tau = tt * 32 + rowoff(reg, h), sig = st * 32 + c;
      float v = 0.f;
      if (sig <= tau) { v = acc[reg]; if (SSDM) v *= ex2(sAcs[tau] - sAcs[sig]); }
      sP[tau * 72 + sig] = f2bf(v);
    }
  }
  lds_barrier();
  if (do_out && w < NOT) {
    const int tt = w / NVT, nt = w % NVT;
    f32x16 acc = zero16();
    mma32<64>(acc, sP + tt * 32 * 72, 72, sVT + nt * 32 * 72, 72, lane);
    mma32<K>(acc, sQc + tt * 32 * KP, KP, sST + nt * 32 * KP, KP, lane);
#pragma unroll
    for (int reg = 0; reg < 16; ++reg) {
      const int tau = tt * 32 + rowoff(reg, h);
      const int tok = dir ? (63 - tau) : tau;
      orow0[(size_t)tok * 512 + nt * 32 + c] = f2bf(acc[reg]);
    }
  }
#pragma unroll
  for (int i = 0; i < NS; ++i) {
    const int tile = w * NS + i, kt = tile / NVT, nt = tile % NVT;
#pragma unroll
    for (int reg = 0; reg < 16; ++reg) S[i][reg] *= sD[kt * 32 + rowoff(reg, h)];
    mma32<64>(S[i], sKhT + kt * 32 * 72, 72, sVT + nt * 32 * 72, 72, lane);
  }
  lds_barrier();
}

template <int K, int V>
DEV void state_store(float* buf, const f32x16* S, int w, int lane) {
  constexpr int NS = ScanGeom<K, V>::NS, NVT = V / 32;
  const int c = lane & 31, h = lane >> 5;
#pragma unroll
  for (int i = 0; i < NS; ++i) {
    const int tile = w * NS + i, kt = tile / NVT, nt = tile % NVT;
#pragma unroll
    for (int reg = 0; reg < 16; ++reg) buf[(kt * 32 + rowoff(reg, h)) * V + nt * 32 + c] = S[i][reg];
  }
}
template <int K, int V>
DEV void state_load(const float* buf, f32x16* S, int w, int lane) {
  constexpr int NS = ScanGeom<K, V>::NS, NVT = V / 32;
  const int c = lane & 31, h = lane >> 5;
#pragma unroll
  for (int i = 0; i < NS; ++i) {
    const int tile = w * NS + i, kt = tile / NVT, nt = tile % NVT;
#pragma unroll
    for (int reg = 0; reg < 16; ++reg) S[i][reg] = buf[(kt * 32 + rowoff(reg, h)) * V + nt * 32 + c];
  }
}

DEV void store16(bf16_t* dst, const float* v) {
  uint4 a, b;
  a.x = pk2(v[0], v[1]); a.y = pk2(v[2], v[3]); a.z = pk2(v[4], v[5]); a.w = pk2(v[6], v[7]);
  b.x = pk2(v[8], v[9]); b.y = pk2(v[10], v[11]); b.z = pk2(v[12], v[13]); b.w = pk2(v[14], v[15]);
  ((uint4*)dst)[0] = a; ((uint4*)dst)[1] = b;
}
DEV void gather16(bf16_t* dst, const bf16_t* src, int stride) {
  unsigned u[8];
#pragma unroll
  for (int i = 0; i < 8; ++i) u[i] = (unsigned)src[(2 * i) * stride] | ((unsigned)src[(2 * i + 1) * stride] << 16);
  ((uint4*)dst)[0] = make_uint4(u[0], u[1], u[2], u[3]); ((uint4*)dst)[1] = make_uint4(u[4], u[5], u[6], u[7]);
}

DEV void hgrn_item(const Params& p, int l, int it, int seg, int mode, unsigned char* smem) {
  const int bl = it >> 3, head = (it >> 1) & 3, dir = it & 1;
  const bool do_out = (mode == 3);
  constexpr int K = 128, V = 128, KP = 136, KPW = 68;
  const int tid = launder(threadIdx.x), lane = tid & 63, w = tid >> 6;
  const int cp = tid & 63, tg = tid >> 6, ch0 = 2 * cp;
  const bf16_t* Hh = (const bf16_t*)(p.ws + OFF_H);
  bf16_t* OB = (bf16_t*)(p.ws + OFF_OBUF) + (size_t)(0 * 2 + dir) * TH * 512;
  const size_t rowbase = (size_t)bl * SEQ;
  float lb0 = 0.f, lb1 = 0.f;
  if (l > 0) {
    lb0 = fsigmoid(p.lb_logits[512 + head * 128 + ch0] - p.lb_logits[head * 128 + ch0]);
    lb1 = fsigmoid(p.lb_logits[512 + head * 128 + ch0 + 1] - p.lb_logits[head * 128 + ch0 + 1]);
  }
  const float om0 = 1.f - lb0, om1 = 1.f - lb1;
  const int fbase = dir ? H_FB : H_FF;
  unsigned* sQt = (unsigned*)(smem + L_QT); unsigned* sKt = (unsigned*)(smem + L_KT); unsigned* sQc = (unsigned*)(smem + L_QC);
  bf16_t* sKhT = (bf16_t*)(smem + L_KHT); bf16_t* sVT = (bf16_t*)(smem + L_VT);
  float* sD = (float*)(smem + L_D); float* sTot = (float*)(smem + L_TOT);
  f32x16 S[2]; S[0] = zero16(); S[1] = zero16();
  float* sbuf = (float*)(p.ws + OFF_SB0) + ((size_t)it * NSEG + seg) * 16384;
  if (do_out) state_load<K, V>(sbuf, S, w, lane);
  float dlog0 = 0.f, dlog1 = 0.f;
  unsigned pf[8], pq[8], pv[8];
  auto gload = [&](int cidx) __attribute__((always_inline)) {
    const int chunk = dir ? (63 - cidx) : cidx;
#pragma unroll
    for (int i = 0; i < 8; ++i) {
      const int tau = 8 * tg + i;
      const int tok = chunk * 64 + (dir ? (63 - tau) : tau);
      const unsigned* rp = (const unsigned*)(Hh + (rowbase + tok) * NPAD + head * 128) + cp;
      pf[i] = rp[fbase / 2]; pv[i] = rp[H_I / 2];
      pq[i] = do_out ? rp[H_Q / 2] : 0u;
    }
  };
  gload(seg * SLEN);
  for (int ci = 0; ci < SLEN; ++ci) {
    const int cidx = seg * SLEN + ci;
    const int chunk = dir ? (63 - cidx) : cidx;
    float g0[8], g1[8], kx0[8], kx1[8];
    float r0 = 0.f, r1 = 0.f;
#pragma unroll
    for (int i = 0; i < 8; ++i) {
      const float e0 = ex2(fminf(-lo16(pf[i]) * LOG2E, 80.f)), e1 = ex2(fminf(-hi16(pf[i]) * LOG2E, 80.f));
      const float s0 = frcp(1.f + e0), s1 = frcp(1.f + e1);
      r0 += lg2(lb0 + om0 * s0); r1 += lg2(lb1 + om1 * s1);
      g0[i] = r0; g1[i] = r1;
      kx0[i] = om0 * e0 * s0; kx1[i] = om1 * e1 * s1;
    }
    *(float2*)(sTot + tg * 128 + ch0) = make_float2(r0, r1);
    unsigned vv[8], qq[8];
#pragma unroll
    for (int i = 0; i < 8; ++i) { vv[i] = pv[i]; qq[i] = pq[i]; }
    lds_barrier();
    if (ci + 1 < SLEN) gload(cidx + 1);
    float off0 = 0.f, off1 = 0.f, ref0 = 0.f, ref1 = 0.f, be0 = 0.f, be1 = 0.f;
#pragma unroll
    for (int j = 0; j < 8; ++j) {
      const float2 t = *(const float2*)(sTot + j * 128 + ch0);
      if (j < tg) { off0 += t.x; off1 += t.y; }
      if (j < 4) { ref0 += t.x; ref1 += t.y; }
      be0 += t.x; be1 += t.y;
    }
    dlog0 += be0; dlog1 += be1;
    const float eref0 = ex2(ref0), eref1 = ex2(ref1), ebr0 = ex2(be0 - ref0), ebr1 = ex2(be1 - ref1);
    const float d0 = off0 - ref0, d1 = off1 - ref1;
    float kh0[8], kh1[8];
#pragma unroll
    for (int i = 0; i < 8; ++i) {
      const int tau = 8 * tg + i;
      const float E0 = ex2(g0[i] + d0), E1 = ex2(g1[i] + d1);
      const float kt0 = kx0[i] * frcp(E0), kt1 = kx1[i] * frcp(E1);
      if (do_out) {
        const float qt0 = lo16(qq[i]) * E0, qt1 = hi16(qq[i]) * E1;
        sQt[tau * KPW + cp] = cvtpk(qt0, qt1);
        sKt[tau * KPW + cp] = cvtpk(kt0, kt1);
        sQc[tau * KPW + cp] = cvtpk(qt0 * eref0, qt1 * eref1);
      }
      kh0[i] = kt0 * ebr0; kh1[i] = kt1 * ebr1;
    }
    *(u32x4*)(sKhT + ch0 * 72 + 8 * tg) = (u32x4){cvtpk(kh0[0], kh0[1]), cvtpk(kh0[2], kh0[3]), cvtpk(kh0[4], kh0[5]), cvtpk(kh0[6], kh0[7])};
    *(u32x4*)(sKhT + (ch0 + 1) * 72 + 8 * tg) = (u32x4){cvtpk(kh1[0], kh1[1]), cvtpk(kh1[2], kh1[3]), cvtpk(kh1[4], kh1[5]), cvtpk(kh1[6], kh1[7])};
    *(u32x4*)(sVT + ch0 * 72 + 8 * tg) = (u32x4){(vv[0] & 0xffffu) | (vv[1] << 16), (vv[2] & 0xffffu) | (vv[3] << 16), (vv[4] & 0xffffu) | (vv[5] << 16), (vv[6] & 0xffffu) | (vv[7] << 16)};
    *(u32x4*)(sVT + (ch0 + 1) * 72 + 8 * tg) = (u32x4){(vv[0] >> 16) | (vv[1] & 0xffff0000u), (vv[2] >> 16) | (vv[3] & 0xffff0000u), (vv[4] >> 16) | (vv[5] & 0xffff0000u), (vv[6] >> 16) | (vv[7] & 0xffff0000u)};
    if (tg == 0) *(float2*)(sD + ch0) = make_float2(ex2(be0), ex2(be1));
    lds_barrier();
    scan_core<K, V, false>(smem, S, OB + (rowbase + (size_t)chunk * 64) * 512 + head * 128, dir, w, lane, do_out);
  }
  if (!do_out) {
    state_store<K, V>(sbuf, S, w, lane);
    if (tg == 0) *(float2*)((float*)(p.ws + OFF_DB) + ((size_t)it * NSEG + seg) * 128 + ch0) = make_float2(ex2(dlog0), ex2(dlog1));
  }
}

DEV void gla_item(const Params& p, int l, int it, int seg, int mode, unsigned char* smem) {
  const int j16 = it - 16, bl = j16 >> 3, head = (j16 >> 1) & 3, dir = j16 & 1;
  const bool do_out = (mode == 3);
  constexpr int K = 64, V = 128, KP = 72, KPW = 36;
  const int tid = launder(threadIdx.x), lane = tid & 63, w = tid >> 6;
  const int cp = tid & 31, tg = tid >> 5, ch0 = 2 * cp;
  const int vp2 = tid & 63, vg = tid >> 6;
  const bf16_t* Hh = (const bf16_t*)(p.ws + OFF_H);
  const float* SMALL = (const float*)(p.ws + OFF_SMALL);
  bf16_t* OB = (bf16_t*)(p.ws + OFF_OBUF) + (size_t)(2 * 2 + dir) * TH * 512;
  const size_t rowbase = (size_t)bl * SEQ;
  unsigned* sQt = (unsigned*)(smem + L_QT); unsigned* sKt = (unsigned*)(smem + L_KT); unsigned* sQc = (unsigned*)(smem + L_QC);
  bf16_t* sKhT = (bf16_t*)(smem + L_KHT); bf16_t* sVT = (bf16_t*)(smem + L_VT);
  float* sD = (float*)(smem + L_D); float* sTot = (float*)(smem + L_TOT); float* sLow = (float*)(smem + L_LOW);
  const unsigned* rawQ = (const unsigned*)(smem + L_RAW); const unsigned* rawK = rawQ + 2048; const unsigned* rawV = rawQ + 4096;
  float* sG = (float*)(smem + L_RAW + 32768);
  float w2a[16], w2b[16];
#pragma unroll
  for (int r = 0; r < 16; ++r) {
    const float* wp = p.gk_w2 + ((size_t)(l * 2 + dir) * 16 + r) * 256 + head * 64 + ch0;
    w2a[r] = wp[0]; w2b[r] = wp[1];
  }
  const float gb0 = p.gk_b[(l * 2 + dir) * 256 + head * 64 + ch0], gb1 = p.gk_b[(l * 2 + dir) * 256 + head * 64 + ch0 + 1];
  f32x16 S[1]; S[0] = zero16();
  float* sbuf = (float*)(p.ws + OFF_SB1) + ((size_t)j16 * NSEG + seg) * 8192;
  if (do_out) state_load<K, V>(sbuf, S, w, lane);
  float dlog0 = 0.f, dlog1 = 0.f;
  u32x4 pre[4];
  float plow0, plow1;
  const int qrow = tid >> 3, qc8 = (tid & 7) * 8, vrow0 = tid >> 4, vc16 = (tid & 15) * 8;
  auto gload = [&](int cidx) __attribute__((always_inline)) {
    const int chunk = dir ? (63 - cidx) : cidx;
    {
      const int tok = chunk * 64 + (dir ? (63 - qrow) : qrow);
      const bf16_t* rp = Hh + (rowbase + tok) * NPAD + head * 64 + qc8;
      if (do_out) pre[0] = *(const u32x4*)(rp + G_Q);
      pre[1] = *(const u32x4*)(rp + G_K);
      const float* lp = SMALL + (rowbase + tok) * 48 + 16 + dir * 16 + (tid & 7) * 2; plow0 = lp[0]; plow1 = lp[1];
    }
#pragma unroll
    for (int j = 0; j < 2; ++j) {
      const int row = vrow0 + 32 * j;
      const int tok = chunk * 64 + (dir ? (63 - row) : row);
      pre[2 + j] = *(const u32x4*)(Hh + (rowbase + tok) * NPAD + G_V + head * 128 + vc16);
    }
  };
  gload(seg * SLEN);
  for (int ci = 0; ci < SLEN; ++ci) {
    const int cidx = seg * SLEN + ci;
    const int chunk = dir ? (63 - cidx) : cidx;
    {
      unsigned char* d = smem + L_RAW + qrow * 128 + qc8 * 2;
      if (do_out) *(u32x4*)d = pre[0];
      *(u32x4*)(d + 8192) = pre[1];
      sLow[qrow * 16 + (tid & 7) * 2] = plow0; sLow[qrow * 16 + (tid & 7) * 2 + 1] = plow1;
#pragma unroll
      for (int j = 0; j < 2; ++j) *(u32x4*)(smem + L_RAW + 16384 + (vrow0 + 32 * j) * 256 + vc16 * 2) = pre[2 + j];
    }
    lds_barrier();
    if (ci + 1 < SLEN) gload(cidx + 1);
    float r0 = 0.f, r1 = 0.f;
#pragma unroll
    for (int i = 0; i < 4; ++i) {
      const int tau = 4 * tg + i;
      float g0 = gb0, g1 = gb1;
#pragma unroll
      for (int r4 = 0; r4 < 4; ++r4) {
        const float4 lw = *(const float4*)(sLow + tau * 16 + 4 * r4);
        g0 += lw.x * w2a[4 * r4] + lw.y * w2a[4 * r4 + 1] + lw.z * w2a[4 * r4 + 2] + lw.w * w2a[4 * r4 + 3];
        g1 += lw.x * w2b[4 * r4] + lw.y * w2b[4 * r4 + 1] + lw.z * w2b[4 * r4 + 2] + lw.w * w2b[4 * r4 + 3];
      }
      const float l0 = (fminf(g0, 0.f) * LOG2E - lg2(1.f + ex2(-fabsf(g0) * LOG2E))) * (1.f / 16.f);
      const float l1 = (fminf(g1, 0.f) * LOG2E - lg2(1.f + ex2(-fabsf(g1) * LOG2E))) * (1.f / 16.f);
      *(float2*)(sG + tau * 64 + ch0) = make_float2(l0, l1);
      r0 += l0; r1 += l1;
    }
    *(float2*)(sTot + tg * 64 + ch0) = make_float2(r0, r1);
    lds_barrier();
    float off0 = 0.f, off1 = 0.f, ref0 = 0.f, ref1 = 0.f, be0 = 0.f, be1 = 0.f;
#pragma unroll
    for (int j = 0; j < 16; ++j) {
      const float2 t = *(const float2*)(sTot + j * 64 + ch0);
      if (j < tg) { off0 += t.x; off1 += t.y; }
      if (j < 8) { ref0 += t.x; ref1 += t.y; }
      be0 += t.x; be1 += t.y;
    }
    dlog0 += be0; dlog1 += be1;
    const float eref0 = ex2(ref0), eref1 = ex2(ref1), ebr0 = ex2(be0 - ref0), ebr1 = ex2(be1 - ref1);
    float b0 = off0, b1 = off1;
    float kh0[4], kh1[4];
#pragma unroll
    for (int i = 0; i < 4; ++i) {
      const int tau = 4 * tg + i;
      const float2 gg = *(const float2*)(sG + tau * 64 + ch0);
      b0 += gg.x; b1 += gg.y;
      const float E0 = ex2(b0 - ref0), E1 = ex2(b1 - ref1);
      const unsigned uk = rawK[tau * 32 + cp];
      const float kt0 = lo16(uk) * frcp(E0), kt1 = hi16(uk) * frcp(E1);
      if (do_out) {
        const unsigned uq = rawQ[tau * 32 + cp];
        const float qt0 = lo16(uq) * E0, qt1 = hi16(uq) * E1;
        sQt[tau * KPW + cp] = cvtpk(qt0, qt1);
        sKt[tau * KPW + cp] = cvtpk(kt0, kt1);
        sQc[tau * KPW + cp] = cvtpk(qt0 * eref0, qt1 * eref1);
      }
      kh0[i] = kt0 * ebr0; kh1[i] = kt1 * ebr1;
    }
    *(uint2*)(sKhT + ch0 * 72 + 4 * tg) = make_uint2(cvtpk(kh0[0], kh0[1]), cvtpk(kh0[2], kh0[3]));
    *(uint2*)(sKhT + (ch0 + 1) * 72 + 4 * tg) = make_uint2(cvtpk(kh1[0], kh1[1]), cvtpk(kh1[2], kh1[3]));
    {
      unsigned vv[8];
#pragma unroll
      for (int i = 0; i < 8; ++i) vv[i] = rawV[(8 * vg + i) * 64 + vp2];
      *(u32x4*)(sVT + (2 * vp2) * 72 + 8 * vg) = (u32x4){(vv[0] & 0xffffu) | (vv[1] << 16), (vv[2] & 0xffffu) | (vv[3] << 16), (vv[4] & 0xffffu) | (vv[5] << 16), (vv[6] & 0xffffu) | (vv[7] << 16)};
      *(u32x4*)(sVT + (2 * vp2 + 1) * 72 + 8 * vg) = (u32x4){(vv[0] >> 16) | (vv[1] & 0xffff0000u), (vv[2] >> 16) | (vv[3] & 0xffff0000u), (vv[4] >> 16) | (vv[5] & 0xffff0000u), (vv[6] >> 16) | (vv[7] & 0xffff0000u)};
    }
    if (tg == 0) *(float2*)(sD + ch0) = make_float2(ex2(be0), ex2(be1));
    lds_barrier();
    scan_core<K, V, false>(smem, S, OB + (rowbase + (size_t)chunk * 64) * 512 + head * 128, dir, w, lane, do_out);
  }
  if (!do_out) {
    state_store<K, V>(sbuf, S, w, lane);
    if (tg == 0) *(float2*)((float*)(p.ws + OFF_DB) + ((size_t)it * NSEG + seg) * 128 + ch0) = make_float2(ex2(dlog0), ex2(dlog1));
  }
}

DEV void ssd_item(const Params& p, int l, int it, int seg, int mode, unsigned char* smem) {
  const int j32 = it - 32, bl = j32 >> 4, head = (j32 >> 1) & 7, dir = j32 & 1;
  const bool do_out = (mode == 3);
  constexpr int K = 128, V = 64, KP = 136, KPW = 68;
  const int tid = launder(threadIdx.x), lane = tid & 63, w = tid >> 6;
  const int cp = tid & 63, tg = tid >> 6, n0 = 2 * cp;
  const int pp = tid & 63;
  const int grp = head >> 2;
  const bf16_t* U = (const bf16_t*)(p.ws + OFF_U);
  const float* SMALL = (const float*)(p.ws + OFF_SMALL);
  bf16_t* OB = (bf16_t*)(p.ws + OFF_OBUF) + (size_t)(1 * 2 + dir) * TH * 512;
  const size_t rowbase = (size_t)bl * SEQ;
  const unsigned* sQt = (const unsigned*)(smem + L_QT); const unsigned* sKt = (const unsigned*)(smem + L_KT); unsigned* sQc = (unsigned*)(smem + L_QC);
  bf16_t* sKhT = (bf16_t*)(smem + L_KHT); bf16_t* sVT = (bf16_t*)(smem + L_VT);
  float* sD = (float*)(smem + L_D); float* sAcs = (float*)(smem + L_ACS); float* sDt = (float*)(smem + L_DT);
  const bf16_t* rawX = (const bf16_t*)(smem + L_RAW);
  const float dtb = p.dt_bias[(l * 2 + dir) * 8 + head];
  const float Acoef = -__expf(p.a_log[(l * 2 + dir) * 8 + head]) * LOG2E;
  f32x16 S[1]; S[0] = zero16();
  float* sbuf = (float*)(p.ws + OFF_SB2) + ((size_t)j32 * NSEG + seg) * 8192;
  if (do_out) state_load<K, V>(sbuf, S, w, lane);
  float dlog = 0.f;
  u32x4 pre[5];
  float rdt = 0.f;
  const int prow0 = tid >> 4, pc16 = (tid & 15) * 8, xrow = tid >> 3, xc8 = (tid & 7) * 8;
  auto gload = [&](int cidx) __attribute__((always_inline)) {
    const int chunk = dir ? (63 - cidx) : cidx;
#pragma unroll
    for (int j = 0; j < 2; ++j) {
      const int row = prow0 + 32 * j;
      const int tok = chunk * 64 + (dir ? (63 - row) : row);
      const bf16_t* rp = U + (rowbase + tok) * 1024 + grp * 128 + pc16;
      pre[j] = *(const u32x4*)(rp + 512);
      if (do_out) pre[2 + j] = *(const u32x4*)(rp + 768);
    }
    {
      const int tok = chunk * 64 + (dir ? (63 - xrow) : xrow);
      pre[4] = *(const u32x4*)(U + (rowbase + tok) * 1024 + head * 64 + xc8);
    }
    if (w == 0) {
      const int tok = chunk * 64 + (dir ? (63 - lane) : lane);
      rdt = SMALL[(rowbase + tok) * 48 + dir * 8 + head];
    }
  };
  gload(seg * SLEN);
  for (int ci = 0; ci < SLEN; ++ci) {
    const int cidx = seg * SLEN + ci;
    const int chunk = dir ? (63 - cidx) : cidx;
#pragma unroll
    for (int j = 0; j < 2; ++j) {
      const int row = prow0 + 32 * j;
      *(u32x4*)(smem + L_KT + row * (KP * 2) + pc16 * 2) = pre[j];
      if (do_out) *(u32x4*)(smem + L_QT + row * (KP * 2) + pc16 * 2) = pre[2 + j];
    }
    *(u32x4*)(smem + L_RAW + xrow * 128 + xc8 * 2) = pre[4];
    if (w == 0) {
      const float xx = rdt + dtb;
      const float dt = (xx > 20.f) ? xx : log1pf(__expf(xx));
      float a = dt * Acoef;
#pragma unroll
      for (int o = 1; o < 64; o <<= 1) { const float t = __shfl_up(a, o); if (lane >= o) a += t; }
      sAcs[lane] = a; sDt[lane] = dt;
    }
    lds_barrier();
    if (ci + 1 < SLEN) gload(cidx + 1);
    const float aend = sAcs[63];
    dlog += aend;
    {
      float kh0[8], kh1[8];
#pragma unroll
      for (int i = 0; i < 8; ++i) {
        const int tau = 8 * tg + i;
        const float ac = sAcs[tau];
        const unsigned ub = sKt[tau * KPW + cp];
        const float eb = ex2(aend - ac);
        kh0[i] = lo16(ub) * eb; kh1[i] = hi16(ub) * eb;
        if (do_out) {
          const unsigned uc = sQt[tau * KPW + cp];
          const float ea = ex2(ac);
          sQc[tau * KPW + cp] = cvtpk(lo16(uc) * ea, hi16(uc) * ea);
        }
      }
      *(u32x4*)(sKhT + n0 * 72 + 8 * tg) = (u32x4){cvtpk(kh0[0], kh0[1]), cvtpk(kh0[2], kh0[3]), cvtpk(kh0[4], kh0[5]), cvtpk(kh0[6], kh0[7])};
      *(u32x4*)(sKhT + (n0 + 1) * 72 + 8 * tg) = (u32x4){cvtpk(kh1[0], kh1[1]), cvtpk(kh1[2], kh1[3]), cvtpk(kh1[4], kh1[5]), cvtpk(kh1[6], kh1[7])};
      float xv[8];
#pragma unroll
      for (int i = 0; i < 8; ++i) { const int tau = 8 * tg + i; xv[i] = bf2f(rawX[tau * 64 + pp]) * sDt[tau]; }
      *(u32x4*)(sVT + pp * 72 + 8 * tg) = (u32x4){cvtpk(xv[0], xv[1]), cvtpk(xv[2], xv[3]), cvtpk(xv[4], xv[5]), cvtpk(xv[6], xv[7])};
      if (tg == 0) *(float2*)(sD + n0) = make_float2(ex2(aend), ex2(aend));
    }
    lds_barrier();
    scan_core<K, V, true>(smem, S, OB + (rowbase + (size_t)chunk * 64) * 512 + head * 64, dir, w, lane, do_out);
  }
  if (!do_out) {
    state_store<K, V>(sbuf, S, w, lane);
    if (tg == 0) *(float2*)((float*)(p.ws + OFF_DB) + ((size_t)it * NSEG + seg) * 128 + n0) = make_float2(ex2(dlog), ex2(dlog));
  }
}

DEV void phase_prep(const Params& p, int l, int hf, unsigned char* smem) {
  const int tid = launder(threadIdx.x), lane = tid & 63, w = tid >> 6;
  bf16_t* Hh = (bf16_t*)(p.ws + OFF_H);
  {
    const int cg8 = (tid & 127) * 8, rsub = tid >> 7;
    bf16_t* U = (bf16_t*)(p.ws + OFF_U);
    const float* cw = p.conv_w + (size_t)l * 5 * 1024; const float* cb = p.conv_b + (size_t)l * 1024;
    float wv[5][8], bv[8];
#pragma unroll
    for (int j = 0; j < 5; ++j)
#pragma unroll
      for (int e = 0; e < 8; ++e) wv[j][e] = cw[j * 1024 + cg8 + e];
#pragma unroll
    for (int e = 0; e < 8; ++e) bv[e] = cb[cg8 + e];
    for (int r = blockIdx.x * 4 + rsub; r < TH; r += gridDim.x * 4) {
      const int t = r & (SEQ - 1);
      float u[8];
#pragma unroll
      for (int e = 0; e < 8; ++e) u[e] = bv[e];
#pragma unroll
      for (int j = 0; j < 5; ++j) {
        const int s = t + j - 2;
        if (s >= 0 && s < SEQ) {
          const u32x4 x = *(const u32x4*)(Hh + (size_t)(r + j - 2) * NPAD + S_X + cg8);
#pragma unroll
          for (int e = 0; e < 4; ++e) { u[2 * e] += wv[j][2 * e] * lo16(x[e]); u[2 * e + 1] += wv[j][2 * e + 1] * hi16(x[e]); }
        }
      }
      u32x4 o;
#pragma unroll
      for (int e = 0; e < 4; ++e) {
        const float a = u[2 * e] * frcp(1.f + ex2(fminf(-u[2 * e] * LOG2E, 80.f)));
        const float b = u[2 * e + 1] * frcp(1.f + ex2(fminf(-u[2 * e + 1] * LOG2E, 80.f)));
        o[e] = cvtpk(a, b);
      }
      *(u32x4*)(U + (size_t)r * 1024 + cg8) = o;
    }
  }
  {
    const float2* tabg = (const float2*)(p.ws + OFF_TAB);
    float2* stab = (float2*)smem;
    lds_barrier();
    for (int i = tid; i < 1024; i += NT) stab[i] = tabg[i];
    lds_barrier();
    const int i16 = lane & 15, grp = lane >> 4;
    const float* gq = p.q_gain + l * 64 + 4 * i16; const float* gk = p.k_gain + l * 64 + 4 * i16;
    const float gqv[4] = {gq[0], gq[1], gq[2], gq[3]}, gkv[4] = {gk[0], gk[1], gk[2], gk[3]};
    constexpr int NQ = TH * 10 / 4, UNR = 5;
    const int nw = gridDim.x * 8;
    for (int pq0 = blockIdx.x * 8 + w; pq0 < NQ; pq0 += nw * UNR) {
      uint2 xr[UNR]; bf16_t* ptr[UNR]; int rowv[UNR]; bool isqv[UNR]; bool ok[UNR];
#pragma unroll
      for (int u = 0; u < UNR; ++u) {
        const int pq = pq0 + u * nw;
        ok[u] = pq < NQ;
        const int pi = (ok[u] ? pq : 0) * 4 + grp, row = pi / 10, hd = pi - row * 10;
        rowv[u] = row; isqv[u] = hd < 8;
        ptr[u] = Hh + (size_t)row * NPAD + (isqv[u] ? (A_Q + hd * 64) : (A_K + (hd - 8) * 64)) + 4 * i16;
        xr[u] = *(const uint2*)ptr[u];
      }
#pragma unroll
      for (int u = 0; u < UNR; ++u) {
        const float x[4] = {lo16(xr[u].x), hi16(xr[u].x), lo16(xr[u].y), hi16(xr[u].y)};
        float ss = x[0] * x[0] + x[1] * x[1] + x[2] * x[2] + x[3] * x[3];
        ss += __shfl_xor(ss, 1); ss += __shfl_xor(ss, 2); ss += __shfl_xor(ss, 4); ss += __shfl_xor(ss, 8);
        const float rstd = rsqrtf(ss * (1.f / 64.f) + 1e-6f);
        const int t = rowv[u] & (SEQ - 1);
        const int pos = (i16 < 8) ? (t >> 6) : (t & 63);
        const float osc = isqv[u] ? QSCALE : 1.f;
        float o[4];
#pragma unroll
        for (int e = 0; e < 4; ++e) {
          const float v = x[e] * rstd * (isqv[u] ? gqv[e] : gkv[e]);
          const float pv = __shfl_xor(v, 4);
          const float2 cs = stab[pos * 16 + 4 * (i16 & 3) + e];
          o[e] = ((i16 & 4) ? (v * cs.x + pv * cs.y) : (v * cs.x - pv * cs.y)) * osc;
        }
        if (ok[u]) *(uint2*)ptr[u] = make_uint2(cvtpk(o[0], o[1]), cvtpk(o[2], o[3]));
      }
    }
  }
  {
    const int c8 = (tid & 63) * 8, rs = tid >> 6;
    for (int r = blockIdx.x * 8 + rs; r < TH; r += gridDim.x * 8) {
      bf16_t* hp = Hh + (size_t)r * NPAD + H_Q + c8;
      u32x4 x = *(const u32x4*)hp;
#pragma unroll
      for (int e = 0; e < 4; ++e) {
        const float a = lo16(x[e]), b = hi16(x[e]);
        x[e] = cvtpk(a * frcp(1.f + ex2(fminf(-a * LOG2E, 80.f))) * 0.08838834764831845f, b * frcp(1.f + ex2(fminf(-b * LOG2E, 80.f))) * 0.08838834764831845f);
      }
      *(u32x4*)hp = x;
      if (c8 < 256) {
        bf16_t* gp = Hh + (size_t)r * NPAD + G_Q + c8;
        u32x4 y = *(const u32x4*)gp;
#pragma unroll
        for (int e = 0; e < 4; ++e) y[e] = cvtpk(lo16(y[e]) * 0.125f, hi16(y[e]) * 0.125f);
        *(u32x4*)gp = y;
      }
    }
  }
  {
    bf16_t* VT = (bf16_t*)(p.ws + OFF_VT);
    bf16_t* sT = (bf16_t*)smem;
    for (int tile = blockIdx.x; tile < TH / 64; tile += gridDim.x) {
      lds_barrier();
#pragma unroll
      for (int j = 0; j < 2; ++j) {
        const int id = tid + 512 * j, rr = id >> 4, c8 = (id & 15) * 8;
        *(u32x4*)(sT + rr * 136 + c8) = *(const u32x4*)(Hh + (size_t)(tile * 64 + rr) * NPAD + A_V + c8);
      }
      lds_barrier();
      const int c = tid >> 2, tq = (tid & 3) * 16;
      unsigned v[16];
#pragma unroll
      for (int i = 0; i < 16; ++i) v[i] = sT[(tq + i) * 136 + c];
      const int row0 = tile * 64, bl = row0 >> 12, t0 = (row0 & (SEQ - 1)) + tq;
      bf16_t* dst = VT + ((size_t)((bl * 2 + (c >> 6)) * 64 + (c & 63))) * SEQ + t0;
      *(u32x4*)dst = (u32x4){v[0] | (v[1] << 16), v[2] | (v[3] << 16), v[4] | (v[5] << 16), v[6] | (v[7] << 16)};
      *(u32x4*)(dst + 8) = (u32x4){v[8] | (v[9] << 16), v[10] | (v[11] << 16), v[12] | (v[13] << 16), v[14] | (v[15] << 16)};
    }
    lds_barrier();
  }
}

DEV void phase_mix(const Params& p, int l, int hf, int slot, int mode, int att_lo, int att_hi, int vid_lo, int vid_hi, unsigned char* smem) {
  unsigned* ctr = (unsigned*)(p.ws + OFF_CTRL) + CTR_WORD0 + slot * 16;
  volatile int* sItem = (volatile int*)(smem + LDS_BYTES - 16);
  const int n_scan = 64 * NSEG;
  int hi = n_scan + (att_hi - att_lo); if (vid_hi < hi) hi = vid_hi;
  for (;;) {
    lds_barrier();
    if (threadIdx.x == 0) *sItem = vid_lo + (int)atomicAdd(ctr, 1u);
    lds_barrier();
    const int vid = *sItem;
    if (vid >= hi) break;
    if (vid < n_scan) {
      const int seg = vid >> 6, it = vid & 63;
      if (mode == 1 && seg == NSEG - 1) continue;
#if PROBE_REP > 0
      if (slot >= 40 && PROBE_TYPE >= 0 && ((it < 16) ? 0 : (it < 32) ? 1 : 2) != PROBE_TYPE) continue;
#endif
      if (it < 16) { if (PH_MASK & 0x100) hgrn_item(p, l, it, seg, mode, smem); }
      else if (it < 32) { if (PH_MASK & 0x200) gla_item(p, l, it, seg, mode, smem); }
      else { if (PH_MASK & 0x400) ssd_item(p, l, it, seg, mode, smem); }
    } else { if (PH_MASK & 0x800) attn_item(p, l, att_lo + (vid - n_scan), smem); }
  }
}

DEV void phase_scan2(const Params& p) {
  const size_t gtid = (size_t)blockIdx.x * NT + threadIdx.x, gsz = (size_t)gridDim.x * NT;
  const float* DB = (const float*)(p.ws + OFF_DB);
  for (size_t e = gtid; e < 655360; e += gsz) {
    float* buf; const float* dp; int stride;
    if (e < 262144) { const int it = (int)(e >> 14), idx = (int)(e & 16383); buf = (float*)(p.ws + OFF_SB0) + (size_t)it * NSEG * 16384 + idx; stride = 16384; dp = DB + (size_t)it * NSEG * 128 + (idx >> 7); }
    else if (e < 393216) { const int e2 = (int)(e - 262144), j = e2 >> 13, idx = e2 & 8191; buf = (float*)(p.ws + OFF_SB1) + (size_t)j * NSEG * 8192 + idx; stride = 8192; dp = DB + (size_t)(16 + j) * NSEG * 128 + (idx >> 7); }
    else { const int e3 = (int)(e - 393216), j = e3 >> 13, idx = e3 & 8191; buf = (float*)(p.ws + OFF_SB2) + (size_t)j * NSEG * 8192 + idx; stride = 8192; dp = DB + (size_t)(32 + j) * NSEG * 128 + (idx >> 6); }
    float u[NSEG - 1], d[NSEG - 1];
#pragma unroll
    for (int sg = 0; sg < NSEG - 1; ++sg) { u[sg] = buf[(size_t)sg * stride]; d[sg] = dp[sg * 128]; }
    float st = 0.f;
#pragma unroll
    for (int sg = 0; sg < NSEG; ++sg) { buf[(size_t)sg * stride] = st; if (sg < NSEG - 1) st = d[sg] * st + u[sg]; }
  }
}

DEV void phase_fin(const Params& p, int l, int hf) {
  const int tid = launder(threadIdx.x), lane = tid & 63, w = tid >> 6;
  const bf16_t* Hh = (const bf16_t*)(p.ws + OFF_H);
  const bf16_t* OB = (const bf16_t*)(p.ws + OFF_OBUF);
  bf16_t* MX = (bf16_t*)(p.ws + OFF_MIXED);
  const int c0 = lane * 8;
  const float* cw = p.conv_w + (size_t)l * 5 * 1024; const float* cb = p.conv_b + (size_t)l * 1024;
  for (int r = blockIdx.x * 8 + w; r < TH; r += gridDim.x * 8) {
    const bf16_t* hrow = Hh + (size_t)r * NPAD;
    *(u32x4*)(MX + (size_t)r * DI + c0) = *(const u32x4*)(hrow + A_Q + c0);
    {
      const uint4 a = *(const uint4*)(OB + ((size_t)0 * TH + r) * 512 + c0), b = *(const uint4*)(OB + ((size_t)1 * TH + r) * 512 + c0);
      const uint4 z = *(const uint4*)(hrow + H_Z + c0);
      const unsigned au[4] = {a.x, a.y, a.z, a.w}, bu[4] = {b.x, b.y, b.z, b.w}, zu[4] = {z.x, z.y, z.z, z.w};
      float o[8]; float ss = 0.f;
#pragma unroll
      for (int j = 0; j < 4; ++j) {
        o[2 * j] = bf2f((bf16_t)(au[j] & 0xffff)) + bf2f((bf16_t)(bu[j] & 0xffff));
        o[2 * j + 1] = bf2f((bf16_t)(au[j] >> 16)) + bf2f((bf16_t)(bu[j] >> 16));
        ss += o[2 * j] * o[2 * j] + o[2 * j + 1] * o[2 * j + 1];
      }
#pragma unroll
      for (int of = 32; of >= 1; of >>= 1) ss += __shfl_xor(ss, of);
      const float rstd = rsqrtf(ss * (1.f / 512.f) + 1e-6f);
      float y[8];
#pragma unroll
      for (int j = 0; j < 8; ++j) {
        const float zz = bf2f((bf16_t)((j & 1) ? (zu[j >> 1] >> 16) : (zu[j >> 1] & 0xffff)));
        y[j] = o[j] * rstd * p.hgrn_norm[l * 512 + c0 + j] * fsilu(zz);
      }
      uint4 ov; ov.x = pk2(y[0], y[1]); ov.y = pk2(y[2], y[3]); ov.z = pk2(y[4], y[5]); ov.w = pk2(y[6], y[7]);
      *(uint4*)(MX + (size_t)r * DI + 512 + c0) = ov;
    }
    {
      const uint4 a = *(const uint4*)(OB + ((size_t)4 * TH + r) * 512 + c0), b = *(const uint4*)(OB + ((size_t)5 * TH + r) * 512 + c0);
      const uint4 z = *(const uint4*)(hrow + G_Z + c0);
      const unsigned au[4] = {a.x, a.y, a.z, a.w}, bu[4] = {b.x, b.y, b.z, b.w}, zu[4] = {z.x, z.y, z.z, z.w};
      float o[8]; float ss = 0.f;
#pragma unroll
      for (int j = 0; j < 4; ++j) {
        o[2 * j] = bf2f((bf16_t)(au[j] & 0xffff)) + bf2f((bf16_t)(bu[j] & 0xffff));
        o[2 * j + 1] = bf2f((bf16_t)(au[j] >> 16)) + bf2f((bf16_t)(bu[j] >> 16));
        ss += o[2 * j] * o[2 * j] + o[2 * j + 1] * o[2 * j + 1];
      }
#pragma unroll
      for (int of = 8; of >= 1; of >>= 1) ss += __shfl_xor(ss, of);
      const float rstd = rsqrtf(ss * (1.f / 128.f) + 1e-6f);
      float y[8];
#pragma unroll
      for (int j = 0; j < 8; ++j) {
        const float zz = bf2f((bf16_t)((j & 1) ? (zu[j >> 1] >> 16) : (zu[j >> 1] & 0xffff)));
        y[j] = o[j] * rstd * p.gla_norm[l * 128 + ((c0 + j) & 127)] * fsilu(zz);
      }
      uint4 ov; ov.x = pk2(y[0], y[1]); ov.y = pk2(y[2], y[3]); ov.z = pk2(y[4], y[5]); ov.w = pk2(y[6], y[7]);
      *(uint4*)(MX + (size_t)r * DI + 1536 + c0) = ov;
    }
    {
      const uint4 a = *(const uint4*)(OB + ((size_t)2 * TH + r) * 512 + c0), b = *(const uint4*)(OB + ((size_t)3 * TH + r) * 512 + c0);
      const uint4 z = *(const uint4*)(hrow + S_Z + c0);
      const unsigned au[4] = {a.x, a.y, a.z, a.w}, bu[4] = {b.x, b.y, b.z, b.w}, zu[4] = {z.x, z.y, z.z, z.w};
      float u[8];
#pragma unroll
      for (int j = 0; j < 8; ++j) u[j] = cb[c0 + j];
      const int t = r & (SEQ - 1);
#pragma unroll
      for (int jj = 0; jj < 5; ++jj) {
        const int s = t + jj - 2;
        if (s >= 0 && s < SEQ) {
          const uint4 xr = *(const uint4*)(Hh + (size_t)(r + jj - 2) * NPAD + S_X + c0);
          const unsigned xu[4] = {xr.x, xr.y, xr.z, xr.w};
#pragma unroll
          for (int j = 0; j < 8; ++j) {
            const float xv = bf2f((bf16_t)((j & 1) ? (xu[j >> 1] >> 16) : (xu[j >> 1] & 0xffff)));
            u[j] += cw[jj * 1024 + c0 + j] * xv;
          }
        }
      }
      const float dsk = p.ssd_d[l * 8 + (c0 >> 6)];
      float y[8]; float ss = 0.f;
#pragma unroll
      for (int j = 0; j < 8; ++j) {
        const float of = bf2f((bf16_t)((j & 1) ? (au[j >> 1] >> 16) : (au[j >> 1] & 0xffff)));
        const float ob = bf2f((bf16_t)((j & 1) ? (bu[j >> 1] >> 16) : (bu[j >> 1] & 0xffff)));
        const float zz = bf2f((bf16_t)((j & 1) ? (zu[j >> 1] >> 16) : (zu[j >> 1] & 0xffff)));
        y[j] = (of + ob + dsk * fsilu(u[j])) * fsilu(zz);
        ss += y[j] * y[j];
      }
#pragma unroll
      for (int of = 32; of >= 1; of >>= 1) ss += __shfl_xor(ss, of);
      const float rstd = rsqrtf(ss * (1.f / 512.f) + 1e-6f);
#pragma unroll
      for (int j = 0; j < 8; ++j) y[j] = y[j] * rstd * p.ssd_norm[l * 512 + c0 + j];
      uint4 ov; ov.x = pk2(y[0], y[1]); ov.y = pk2(y[2], y[3]); ov.z = pk2(y[4], y[5]); ov.w = pk2(y[6], y[7]);
      *(uint4*)(MX + (size_t)r * DI + 1024 + c0) = ov;
    }
  }
}


#define XB_TMO      128
#define XB_XCNT(j)  (256  + 64 * (j))
#define XB_XSUB(j)  (1280 + 64 * (j))
#define XB_XGEN(j)  (2304 + 64 * (j))
#define XB_TOP      3328
#define XB_TOPGEN   3392
#define XB_SPIN_CAP (1u << 22)
#define LAS __attribute__((address_space(3)))
DEV unsigned xb_ld(unsigned* p) { return __hip_atomic_load(p, __ATOMIC_RELAXED, __HIP_MEMORY_SCOPE_AGENT); }
DEV unsigned xb_add(unsigned* p, unsigned v) { return __hip_atomic_fetch_add(p, v, __ATOMIC_RELAXED, __HIP_MEMORY_SCOPE_AGENT); }
DEV unsigned xb_xcc_id() { return (unsigned)__builtin_amdgcn_s_getreg((3 << 11) | 20) & 0xFu; }
#define XB_SPIN(cond, bar) do { unsigned _sp = 0; while (cond) { __builtin_amdgcn_s_sleep(1); \
    if ((++_sp & 255u) == 0u) { if (xb_ld(&(bar)[XB_TMO])) break; if (_sp > XB_SPIN_CAP) { atomicAdd(&(bar)[XB_TMO], 1u); break; } } } } while (0)
struct XcdBarrier { unsigned* bar; unsigned x; volatile LAS unsigned* st; };
DEV XcdBarrier xcd_barrier_post(unsigned* bar, volatile LAS unsigned* st) {
  XcdBarrier b; b.bar = bar; b.x = xb_xcc_id(); b.st = st;
  if (threadIdx.x == 0) (void)xb_add(&bar[XB_XCNT(b.x)], 1u);
  return b;
}
DEV void xcd_barrier_complete(unsigned* bar, unsigned x, unsigned& nloc, unsigned& nx) {
  const unsigned G = gridDim.x * gridDim.y * gridDim.z;
  unsigned sum, cnt, mine, sp = 0u;
  for (;;) {
    sum = 0u; cnt = 0u; mine = 0u;
#pragma unroll
    for (unsigned j = 0; j < 16; ++j) { const unsigned c = xb_ld(&bar[XB_XCNT(j)]); sum += c; cnt += (c > 0u) ? 1u : 0u; mine = (j == x) ? c : mine; }
    if (sum == G) break;
    __builtin_amdgcn_s_sleep(1);
    if ((++sp & 255u) == 0u) { if (xb_ld(&bar[XB_TMO])) break; if (sp > XB_SPIN_CAP) { atomicAdd(&bar[XB_TMO], 1u); break; } }
  }
  nloc = mine > 0u ? mine : 1u; nx = cnt > 0u ? cnt : 1u;
}
DEV void xcd_barrier(const XcdBarrier& b) {
  asm volatile("s_waitcnt vmcnt(0)" ::: "memory");
  __syncthreads();
  if (threadIdx.x == 0) {
    unsigned* bar = b.bar;
    __builtin_amdgcn_s_waitcnt(0);
    unsigned nloc = b.st[0], nx = b.st[1];
    if (nloc == 0u) { xcd_barrier_complete(bar, b.x, nloc, nx); b.st[0] = nloc; b.st[1] = nx; }
    const unsigned old = xb_add(&bar[XB_XSUB(b.x)], 1u);
    const unsigned gen = old / nloc;
    if (old + 1u == (gen + 1u) * nloc) {
      __builtin_amdgcn_fence(__ATOMIC_RELEASE, "agent");
      asm volatile("s_waitcnt vmcnt(0)" ::: "memory");
      const unsigned og = xb_add(&bar[XB_TOP], 1u);
      const unsigned tg = og / nx;
      if (og + 1u == (tg + 1u) * nx) xb_add(&bar[XB_TOPGEN], 1u);
      else XB_SPIN(xb_ld(&bar[XB_TOPGEN]) == tg, bar);
      __builtin_amdgcn_fence(__ATOMIC_ACQUIRE, "agent");
      xb_add(&bar[XB_XGEN(b.x)], 1u);
      asm volatile("s_waitcnt vmcnt(0)" ::: "memory");
    } else {
      XB_SPIN(xb_ld(&bar[XB_XGEN(b.x)]) == gen, bar);
      __builtin_amdgcn_fence(__ATOMIC_ACQUIRE, "agent");
      asm volatile("s_waitcnt vmcnt(0)" ::: "memory");
    }
  }
  __syncthreads();
}

DEV void run_phase(const Params& p, int ph, int rep, unsigned char* smem) {
  if (ph == 0) { if (PH_MASK & 1) { phase_pro(p, smem); convert_weights(p, 0, 3, smem); } return; }
  if (ph == 25) { if (PH_MASK & 16) phase_outproj(p, 1, 1, smem); return; }
  if (ph == 26) { if (PH_MASK & 32) phase_ln(p, 1, 1); return; }
  const int q = ph - 1, blk = q / 6, st = q % 6, l = blk >> 1, hf = blk & 1;
  if (st == 0) {
    if (blk > 0 && (PH_MASK & 16)) phase_outproj(p, (blk - 1) >> 1, (blk - 1) & 1, smem);
    if (PH_MASK & 2) phase_inproj(p, l, hf, blk > 0 ? 16 : 0, smem);
  } else if (st == 1) {
    if (blk > 0 && (PH_MASK & 32)) phase_ln(p, (blk - 1) >> 1, (blk - 1) & 1);
    if (PH_MASK & 4) phase_prep(p, l, hf, smem);
    if ((PH_MASK & 1) && blk == 1) convert_weights(p, 1, 1, smem);
    if ((PH_MASK & 1) && blk == 2) convert_weights(p, 1, 2, smem);
  }
  else if (st == 2) { if (PH_MASK & 0xF00) phase_mix(p, l, hf, ph + 40 * rep, 1, 0, ATT_SPLIT, rep ? PROBE_LO : 0, rep ? PROBE_HI : 100000, smem); }
  else if (st == 3) { if (PH_MASK & 0x700) phase_scan2(p); }
  else if (st == 4) { if (PH_MASK & 0xF00) phase_mix(p, l, hf, ph + 40 * rep, 3, ATT_SPLIT, 256, rep ? PROBE_LO : 0, rep ? PROBE_HI : 100000, smem); }
  else { if (PH_MASK & 8) phase_fin(p, l, hf); }
}
__global__ void __launch_bounds__(NT) mega(Params p) {
  extern __shared__ __attribute__((aligned(16))) unsigned char smem[];
#if ONE_LAUNCH
  volatile LAS unsigned* xst = (volatile LAS unsigned*)(smem + LDS_BYTES - 32);
  if (threadIdx.x == 0) { xst[0] = 0u; xst[1] = 0u; }
  __syncthreads();
  XcdBarrier xb = xcd_barrier_post((unsigned*)(p.ws + OFF_CTRL), xst);
#endif
  Params* lp = (Params*)(smem + 147456);
  if (threadIdx.x == 0) *lp = p;
  __syncthreads();
  const int ph_begin = p.phase_begin, ph_end = p.phase_end;
  for (int ph = ph_begin; ph < ph_end; ++ph) {
    int nrep = 0;
#if PROBE_REP > 0
    {
      const int q = ph - 1, st = q % 6;
      const bool idem = (ph >= 1 && ph <= 24) && (st == PROBE_ST) && (st >= 2);
      if (idem) nrep = PROBE_REP;
    }
#endif
    for (int r = 0; r <= nrep; ++r) {
      run_phase(*lp, ph, r, smem);
#if ONE_LAUNCH
      if (r < nrep || ph + 1 < ph_end) xcd_barrier(xb);
#endif
    }
  }
}

extern "C" void kernel_launch(void* const* d_in, const int* in_sizes, int n_in, void* d_out, int out_size, void* d_ws, size_t ws_size,
                              hipStream_t stream) {
  static int grid_blocks = 0;
  if (!grid_blocks) {
    int dev = 0, cus = 0, per_cu = 0;
    hipGetDevice(&dev);
    hipDeviceGetAttribute(&cus, hipDeviceAttributeMultiprocessorCount, dev);
    hipFuncSetAttribute((const void*)mega, hipFuncAttributeMaxDynamicSharedMemorySize, LDS_BYTES);
    hipOccupancyMaxActiveBlocksPerMultiprocessor(&per_cu, mega, NT, LDS_BYTES);
    if (per_cu < 1) per_cu = 1;
    grid_blocks = cus;
  }
  Params p{};
  p.x = (const float*)d_in[0]; p.w_in = (const float*)d_in[1]; p.q_gain = (const float*)d_in[2]; p.k_gain = (const float*)d_in[3];
  p.lb_logits = (const float*)d_in[4]; p.hgrn_norm = (const float*)d_in[5]; p.conv_w = (const float*)d_in[6]; p.conv_b = (const float*)d_in[7];
  p.dt_bias = (const float*)d_in[8]; p.a_log = (const float*)d_in[9]; p.ssd_d = (const float*)d_in[10]; p.ssd_norm = (const float*)d_in[11];
  p.gk_w2 = (const float*)d_in[12]; p.gk_b = (const float*)d_in[13]; p.gla_norm = (const float*)d_in[14]; p.w_out = (const float*)d_in[15];
  p.ln_g = (const float*)d_in[16]; p.ln_b = (const float*)d_in[17];
  p.out = (float*)d_out; p.ws = (unsigned char*)d_ws;
  hipMemsetAsync(d_ws, 0, CTRL_BYTES, stream);
#if ONE_LAUNCH
  p.phase_begin = 0; p.phase_end = NPHASE;
  void* args[] = {&p};
  (void)args;
  hipLaunchKernelGGL(mega, dim3(grid_blocks), dim3(NT), LDS_BYTES, stream, p);
#else
  for (int ph = 0; ph < NPHASE; ++ph) {
    p.phase_begin = ph; p.phase_end = ph + 1;
    hipLaunchKernelGGL(mega, dim3(grid_blocks), dim3(NT), LDS_BYTES, stream, p);
  }
#endif
}
```

```cpp
#include <hip/hip_runtime.h>
#include <hip/hip_cooperative_groups.h>
#include <stdint.h>
#include <stdio.h>
namespace cg = cooperative_groups;

#ifndef ONE_LAUNCH
#define ONE_LAUNCH 1
#endif

#ifndef PH_MASK
#define PH_MASK 0xFFF
#endif
#ifndef PROBE_ST
#define PROBE_ST -1
#endif
#ifndef PROBE_REP
#define PROBE_REP 0
#endif
#ifndef PROBE_TYPE
#define PROBE_TYPE -1
#endif
#ifndef PROBE_LO
#define PROBE_LO 0
#endif
#ifndef PROBE_HI
#define PROBE_HI 100000
#endif
#define DEV __device__ __forceinline__
typedef unsigned short bf16_t;
typedef short bf16x8 __attribute__((ext_vector_type(8)));
typedef float f32x16 __attribute__((ext_vector_type(16)));
typedef unsigned u32x4 __attribute__((ext_vector_type(4)));

constexpr int NT = 512;
constexpr int T_ALL = 16384, TH = 8192, SEQ = 4096, DM = 1024, NPAD = 7168, DI = 2048, NIN = 6960;
constexpr int A_Q = 0, A_K = 512, A_V = 640, A_Z = 768, H_Q = 1280, H_FF = 1792, H_FB = 2304, H_I = 2816, H_Z = 3328,
              S_X = 3840, S_Z = 4864, G_Q = 5376, G_K = 5632, G_V = 5888, G_Z = 6400, SM0 = 6912;
constexpr size_t OFF_CTRL = 0, OFF_TAB = 65536, OFF_XB = 131072;
constexpr size_t OFF_WIN = OFF_XB + (size_t)T_ALL * DM * 2;
constexpr size_t OFF_WOUT = OFF_WIN + (size_t)NPAD * DM * 2;
constexpr size_t OFF_H = OFF_WOUT + (size_t)DM * DI * 2;
constexpr size_t OFF_SMALL = OFF_H + (size_t)TH * NPAD * 2;
constexpr size_t OFF_OBUF = OFF_SMALL + (size_t)TH * 48 * 4;
constexpr size_t OFF_VT = OFF_OBUF + (size_t)6 * TH * 512 * 2;
constexpr size_t OFF_DB = OFF_VT + (size_t)2 * 2 * 64 * SEQ * 2;
constexpr int NSEG = 4, SLEN = 64 / NSEG;
constexpr size_t OFF_MIXED = OFF_DB + (size_t)64 * NSEG * 128 * 4;
constexpr size_t OFF_SB0 = OFF_MIXED, OFF_SB1 = OFF_SB0 + (size_t)16 * NSEG * 16384 * 4, OFF_SB2 = OFF_SB1 + (size_t)16 * NSEG * 8192 * 4;
constexpr size_t OFF_U = OFF_SB2 + (size_t)32 * NSEG * 8192 * 4;
constexpr size_t OFF_G = OFF_U + (size_t)TH * 1024 * 2;
constexpr size_t WS_END = (OFF_G + (size_t)TH * 512 * 2 > OFF_MIXED + (size_t)TH * DI * 2) ? (OFF_G + (size_t)TH * 512 * 2) : (OFF_MIXED + (size_t)TH * DI * 2);
static_assert(OFF_MIXED + (size_t)TH * DI * 2 <= WS_END, "MIXED must fit");
static_assert(WS_END <= 268435456, "workspace");
constexpr size_t CTRL_BYTES = 65536;
constexpr int CTR_WORD0 = 4096;
constexpr int LDS_BYTES = 148480;
constexpr float LOG2E = 1.4426950408889634f;
constexpr float QSCALE = 0.125f * LOG2E;
constexpr float DN_ALPHA = 1.4142135623730951f;
constexpr int NPHASE = 27;
constexpr int ATT_SPLIT = 144;

struct Params {
  const float* x; const float* w_in; const float* q_gain; const float* k_gain; const float* lb_logits; const float* hgrn_norm;
  const float* conv_w; const float* conv_b; const float* dt_bias; const float* a_log; const float* ssd_d; const float* ssd_norm;
  const float* gk_w2; const float* gk_b; const float* gla_norm; const float* w_out; const float* ln_g; const float* ln_b;
  float* out; unsigned char* ws;
  int phase_begin, phase_end;
};

DEV void lds_barrier() { asm volatile("s_waitcnt lgkmcnt(0)" ::: "memory"); __builtin_amdgcn_s_barrier(); asm volatile("" ::: "memory"); }
DEV int launder(int v) { asm volatile("" : "+v"(v)); return v; }
DEV float bf2f(bf16_t v) { return __uint_as_float(((unsigned)v) << 16); }
DEV bf16_t f2bf(float f) { unsigned u = __float_as_uint(f); u += 0x7fffu + ((u >> 16) & 1u); return (bf16_t)(u >> 16); }
typedef __bf16 bf16x2_t __attribute__((ext_vector_type(2)));
typedef float f32x2_t __attribute__((ext_vector_type(2)));
DEV unsigned pk2(float lo, float hi) { const f32x2_t f = {lo, hi}; const bf16x2_t b = __builtin_convertvector(f, bf16x2_t); return __builtin_bit_cast(unsigned, b); }
DEV float fsigmoid(float x) { return 1.f / (1.f + __expf(-x)); }
DEV float fsilu(float x) { return x / (1.f + __expf(-x)); }
DEV unsigned cvtpk(float lo, float hi) { return pk2(lo, hi); }
DEV float ex2(float x) { return __builtin_amdgcn_exp2f(x); }
DEV float lg2(float x) { return __builtin_amdgcn_logf(x); }
DEV float frcp(float x) { return __builtin_amdgcn_rcpf(x); }
DEV float lo16(unsigned u) { return __uint_as_float(u << 16); }
DEV float hi16(unsigned u) { return __uint_as_float(u & 0xffff0000u); }
DEV int rowoff(int reg, int h) { return (reg & 3) + 8 * (reg >> 2) + 4 * h; }
DEV f32x16 zero16() { f32x16 z;
#pragma unroll
  for (int i = 0; i < 16; ++i) z[i] = 0.f; return z; }

template <int KD>
DEV void mma32(f32x16& acc, const bf16_t* a, int lda, const bf16_t* b, int ldb, int lane) {
  const int r = lane & 31, h = lane >> 5;
  const bf16_t* ap = a + r * lda + 8 * h;
  const bf16_t* bp = b + r * ldb + 8 * h;
#pragma unroll 4
  for (int k = 0; k < KD; k += 16) {
    bf16x8 av = *(const bf16x8*)(ap + k);
    bf16x8 bv = *(const bf16x8*)(bp + k);
    acc = __builtin_amdgcn_mfma_f32_32x32x16_bf16(av, bv, acc, 0, 0, 0);
  }
}

DEV int orig_col(int n) {
  if (n < 4864) return n;
  if (n < 6400) return n + 16;
  if (n < 6912) return n + 48;
  if (n < 6928) return n - 2048;
  if (n < 6960) return n - 512;
  return -1;
}

DEV void convert_weights(const Params& p, int l, int which, unsigned char* smem) {
  float* s = (float*)smem;
  const int tid = launder(threadIdx.x);
  const float* win = p.w_in + (size_t)l * DM * NIN;
  const float* wout = p.w_out + (size_t)l * DI * DM;
  bf16_t* wint = (bf16_t*)(p.ws + OFF_WIN);
  bf16_t* woutt = (bf16_t*)(p.ws + OFF_WOUT);
  const int n_in_tiles = (NPAD / 64) * (DM / 64);
  const int n_out_tiles = (DM / 64) * (DI / 64);
  const int it_lo = (which & 1) ? 0 : n_in_tiles, it_hi = (which & 2) ? (n_in_tiles + n_out_tiles) : n_in_tiles;
  for (int it = it_lo + blockIdx.x; it < it_hi; it += gridDim.x) {
    lds_barrier();
    if (it < n_in_tiles) {
      const int n0 = (it / 16) * 64, k0 = (it % 16) * 64;
#pragma unroll
      for (int e = 0; e < 8; ++e) {
        const int idx = e * NT + tid, kk = idx >> 6, nn = idx & 63;
        const int oc = orig_col(n0 + nn);
        s[kk * 65 + nn] = (oc >= 0) ? win[(size_t)(k0 + kk) * NIN + oc] : 0.f;
      }
      lds_barrier();
      const int n = tid >> 3, kc = (tid & 7) * 8;
      uint4 o;
      o.x = pk2(s[(kc + 0) * 65 + n], s[(kc + 1) * 65 + n]); o.y = pk2(s[(kc + 2) * 65 + n], s[(kc + 3) * 65 + n]);
      o.z = pk2(s[(kc + 4) * 65 + n], s[(kc + 5) * 65 + n]); o.w = pk2(s[(kc + 6) * 65 + n], s[(kc + 7) * 65 + n]);
      *(uint4*)(wint + (size_t)(n0 + n) * DM + k0 + kc) = o;
    } else {
      const int j = it - n_in_tiles;
      const int n0 = (j / 32) * 64, k0 = (j % 32) * 64;
#pragma unroll
      for (int e = 0; e < 8; ++e) {
        const int idx = e * NT + tid, kk = idx >> 6, nn = idx & 63;
        s[kk * 65 + nn] = wout[(size_t)(k0 + kk) * DM + n0 + nn];
      }
      lds_barrier();
      const int n = tid >> 3, kc = (tid & 7) * 8;
      uint4 o;
      o.x = pk2(s[(kc + 0) * 65 + n], s[(kc + 1) * 65 + n]); o.y = pk2(s[(kc + 2) * 65 + n], s[(kc + 3) * 65 + n]);
      o.z = pk2(s[(kc + 4) * 65 + n], s[(kc + 5) * 65 + n]); o.w = pk2(s[(kc + 6) * 65 + n], s[(kc + 7) * 65 + n]);
      *(uint4*)(woutt + (size_t)(n0 + n) * DI + k0 + kc) = o;
    }
  }
  lds_barrier();
}

DEV void fsincos(float x, float& s, float& c) {
  const float k = rintf(x * 0.63661977236758134308f);
  float r = fmaf(-k, 1.5707855225e+00f, x);
  r = fmaf(-k, 1.0804273188e-05f, r);
  r = fmaf(-k, 6.0770999344e-11f, r);
  const float r2 = r * r;
  float ps = fmaf(r2, 2.7557319224e-06f, -1.9841269841e-04f);
  ps = fmaf(ps, r2, 8.3333333333e-03f); ps = fmaf(ps, r2, -1.6666666667e-01f);
  const float sinr = fmaf(ps * r2, r, r);
  float pc = fmaf(r2, -2.7557319224e-07f, 2.4801587302e-05f);
  pc = fmaf(pc, r2, -1.3888888889e-03f); pc = fmaf(pc, r2, 4.1666666667e-02f); pc = fmaf(pc, r2, -0.5f);
  const float cosr = fmaf(pc, r2, 1.0f);
  const int q = ((int)k) & 3;
  if (q == 0) { s = sinr; c = cosr; }
  else if (q == 1) { s = cosr; c = -sinr; }
  else if (q == 2) { s = -sinr; c = -cosr; }
  else { s = -cosr; c = sinr; }
}

DEV void phase_pro(const Params& p, unsigned char* smem) {
  const int tid = launder(threadIdx.x);
  const size_t gtid = (size_t)blockIdx.x * NT + tid, gsz = (size_t)gridDim.x * NT;
  const float4* x4 = (const float4*)p.x;
  uint4* xb4 = (uint4*)(p.ws + OFF_XB);
  for (size_t i = gtid; i < (size_t)T_ALL * DM / 8; i += gsz) {
    const float4 a = x4[2 * i], b = x4[2 * i + 1];
    uint4 o; o.x = pk2(a.x, a.y); o.y = pk2(a.z, a.w); o.z = pk2(b.x, b.y); o.w = pk2(b.z, b.w);
    xb4[i] = o;
  }
  if (blockIdx.x == 0) {
    float2* tab = (float2*)(p.ws + OFF_TAB);
    for (int i = tid; i < 64 * 16; i += NT) {
      const int pos = i >> 4, fi = i & 15;
      const float invf = exp2f(-(float)fi * (13.287712379549449f / 16.0f));
      const float ang = (float)pos * invf;
      float sn, cs; fsincos(ang, sn, cs);
      tab[i] = make_float2(cs, sn);
    }
  }
}

namespace pg8 {
#define PG8_LAS __attribute__((address_space(3)))
typedef unsigned short bf16_t;
typedef short bf16x8 __attribute__((ext_vector_type(8)));
typedef float f32x4 __attribute__((ext_vector_type(4)));
typedef unsigned u32x4 __attribute__((ext_vector_type(4)));
constexpr int BM = 256, BK = 64, HALF = 128, HTB = HALF * BK * 2  , STAGE_BYTES = 8 * HTB, NXCD = 8, WGM = 8;

__host__ __device__ __forceinline__ int lds_byte(int r, int c) { const int st = (r >> 4) * 2 + (c >> 5), rr = r & 15, cc = c & 31, ob = rr * 64 + cc * 2; return st * 1024 + (ob ^ (((ob >> 9) & 1) << 5)); }
__host__ __device__ __forceinline__ void stage_rc(int b, int& R, int& C) { const int st = b / 1024, sb = b % 1024, swz = sb ^ (((sb >> 9) & 1) << 5); R = (st >> 1) * 16 + swz / 64; C = (st & 1) * 32 + (swz % 64) / 2; }
__host__ __device__ __forceinline__ int perm32(int rho) { const int n = rho >> 4, i = rho & 15; return 8 * (i >> 2) + 4 * n + (i & 3); }

struct Unit { int pm, pn; };
struct Gemm { const bf16_t* A; const bf16_t* Bt; int M, N, K; };

__device__ __forceinline__ unsigned cvt_pk_bf16(float lo, float hi) { unsigned r; asm volatile("v_cvt_pk_bf16_f32 %0, %1, %2" : "=v"(r) : "v"(lo), "v"(hi)); return r; }

struct XcdOrder {
    int rpx, nN, x, c, ncu, skew;
    __device__ void init(int M, int N, int skew_ = 0) { rpx = (M / BM) / NXCD; nN = N / BM; x = blockIdx.x & 7; c = blockIdx.x >> 3; ncu = gridDim.x >> 3; skew = skew_; }
    __device__ bool next(int i, Unit& u) const {
        const int total = rpx * nN, full = (total / ncu) * ncu;
        int j = c + i * ncu;
        if (skew > 0 && j >= full) { const int cc = c - skew; j = (cc >= 0 && i == total / ncu) ? full + cc : total; }
        if (j >= total) return false; u.pm = rpx * x + (j % rpx); u.pn = j / rpx; return true; }
    __device__ __forceinline__ void a_ready(const Unit&) const {}
    __device__ __forceinline__ void done(const Unit&) const {}
};
struct EpiIn {
    static constexpr bool PERM = true, AFTER_DRAIN = false;
    bf16_t* O; int ldc; float* small; int small_pn;
    __device__ __forceinline__ void operator()(const f32x4 (&acc)[2][2][4][2], const Unit& u, int wr, int wc, int fr, int fq) const {
        const int row0 = u.pm * BM + wr * 64 + fr, col0 = u.pn * BM + wc * 32 + 8 * fq;
        if (u.pn == small_pn) {
            const int c = wc * 32 + 8 * fq;
            if (c < 48) {
#pragma unroll
                for (int ai = 0; ai < 2; ++ai)
#pragma unroll
                    for (int m = 0; m < 4; ++m) { float* rp = small + (size_t)(row0 + ai * HALF + m * 16) * 48 + c; *(f32x4*)rp = acc[ai][0][m][0]; *(f32x4*)(rp + 4) = acc[ai][0][m][1]; }
            }
            return;
        }
#pragma unroll
        for (int ai = 0; ai < 2; ++ai)
#pragma unroll
            for (int m = 0; m < 4; ++m) { bf16_t* rowp = O + (size_t)(row0 + ai * HALF + m * 16) * ldc + col0;
#pragma unroll
                for (int bj = 0; bj < 2; ++bj) { const f32x4 v0 = acc[ai][bj][m][0], v1 = acc[ai][bj][m][1];
                    u32x4 w; w.x = cvt_pk_bf16(v0[0], v0[1]); w.y = cvt_pk_bf16(v0[2], v0[3]); w.z = cvt_pk_bf16(v1[0], v1[1]); w.w = cvt_pk_bf16(v1[2], v1[3]);
                    *(u32x4*)(rowp + bj * HALF) = w; } }
    }
};
struct EpiOut {
    static constexpr bool PERM = true, AFTER_DRAIN = false;
    const float* X; float* Y; int ldc; float alpha;
    __device__ __forceinline__ void operator()(const f32x4 (&acc)[2][2][4][2], const Unit& u, int wr, int wc, int fr, int fq) const {
        const int row0 = u.pm * BM + wr * 64 + fr, col0 = u.pn * BM + wc * 32 + 8 * fq;
#pragma unroll
        for (int ai = 0; ai < 2; ++ai)
#pragma unroll
            for (int m = 0; m < 4; ++m) { const size_t off = (size_t)(row0 + ai * HALF + m * 16) * ldc + col0;
#pragma unroll
                for (int bj = 0; bj < 2; ++bj) { const f32x4 x0 = *(const f32x4*)(X + off + bj * HALF), x1 = *(const f32x4*)(X + off + bj * HALF + 4);
                    *(f32x4*)(Y + off + bj * HALF) = x0 * alpha + acc[ai][bj][m][0]; *(f32x4*)(Y + off + bj * HALF + 4) = x1 * alpha + acc[ai][bj][m][1]; } }
    }
};

template <class Epi, class Sched, bool ALIGN_EPI = false, bool SP2 = false>
__device__ __forceinline__ void gemm_phase(PG8_LAS unsigned char* lds, const Gemm g, const Sched& S, const Epi& E) {
    const int tid = launder((int)threadIdx.x), wid = __builtin_amdgcn_readfirstlane(tid >> 6), lane = tid & 63, wr = wid >> 2, wc = wid & 3, fr = lane & 15, fq = lane >> 4;
    const int K = g.K, nt = K / BK;
    unsigned voffA[2], voffB[2];
#pragma unroll
    for (int i = 0; i < 2; ++i) { int R, C; stage_rc(tid * 16 + i * 8192, R, C); const int Rb = Epi::PERM ? ((R & ~31) + perm32(R & 31)) : R;
        voffA[i] = (unsigned)(R * K + C) * 2u; voffB[i] = (unsigned)(Rb * K + C) * 2u; }
    const size_t kstep = (size_t)(BK * 2);
    const size_t hstep = (size_t)HALF * K * 2;
    const size_t tstep = 2 * hstep;
    const unsigned ldsw = (unsigned)wid * 1024u;
    const int aoff = lds_byte(wr * 64 + fr, fq * 8), boff = lds_byte(wc * 32 + fr, fq * 8);
#define PG8_SA(b, h) (((b) * 2 + (h)) * HTB)
#define PG8_SB(b, h) ((4 + (b) * 2 + (h)) * HTB)
#define PG8_STAGE(bufoff, gbase, voff) do { _Pragma("unroll") for (int _i = 0; _i < 2; ++_i) \
        __builtin_amdgcn_global_load_lds((const unsigned*)((const char*)(gbase) + (voff)[_i]), (PG8_LAS unsigned*)(lds + (bufoff) + ldsw + _i * 8192), 16, 0, 0); } while (0)
#define PG8_LDA(dst, b, h) do { _Pragma("unroll") for (int m = 0; m < 4; ++m) _Pragma("unroll") for (int k = 0; k < 2; ++k) dst[m][k] = *(const PG8_LAS bf16x8*)(lds + PG8_SA(b, h) + aoff + m * 2048 + k * 1024); } while (0)
#define PG8_LDB(dst, b, h) do { _Pragma("unroll") for (int n = 0; n < 2; ++n) _Pragma("unroll") for (int k = 0; k < 2; ++k) dst[n][k] = *(const PG8_LAS bf16x8*)(lds + PG8_SB(b, h) + boff + n * 2048 + k * 1024); } while (0)
#define PG8_MMA(ai, bj, At, Bt) do { __builtin_amdgcn_s_setprio(1); _Pragma("unroll") for (int m = 0; m < 4; ++m) _Pragma("unroll") for (int n = 0; n < 2; ++n) _Pragma("unroll") for (int k = 0; k < 2; ++k) \
        acc[ai][bj][m][n] = __builtin_amdgcn_mfma_f32_16x16x32_bf16(Bt[n][k], At[m][k], acc[ai][bj][m][n], 0, 0, 0); __builtin_amdgcn_s_setprio(0); } while (0)
#define PG8_WAIT_V(n) asm volatile("s_waitcnt vmcnt(" #n ")" ::: "memory")
#define PG8_WAIT_L(n) asm volatile("s_waitcnt lgkmcnt(" #n ")" ::: "memory")
#define PG8_BAR __builtin_amdgcn_s_barrier()
#define PG8_SCHED __builtin_amdgcn_sched_barrier(0)
    Unit cur, nxt; int ui = 0;
    if (!S.next(0, cur)) return;
    f32x4 acc[2][2][4][2];
#pragma unroll
    for (int a = 0; a < 2; ++a)
#pragma unroll
        for (int b = 0; b < 2; ++b)
#pragma unroll
            for (int m = 0; m < 4; ++m)
#pragma unroll
                for (int n = 0; n < 2; ++n) acc[a][b][m][n] = (f32x4){0.f, 0.f, 0.f, 0.f};
    bf16x8 At[4][2], B0[2][2], B1[2][2];
    const char* cA = (const char*)g.A + (size_t)cur.pm * tstep; const char* cB = (const char*)g.Bt + (size_t)cur.pn * tstep;
    S.a_ready(cur);
    if constexpr (SP2) {
        PG8_STAGE(PG8_SB(0, 0), cB, voffB); PG8_STAGE(PG8_SB(0, 1), cB + hstep, voffB); PG8_STAGE(PG8_SA(0, 0), cA, voffA); PG8_STAGE(PG8_SA(0, 1), cA + hstep, voffA);
        if (wr == 1) PG8_BAR;
        PG8_WAIT_V(2); PG8_BAR;
        PG8_STAGE(PG8_SB(1, 0), cB + kstep, voffB); PG8_STAGE(PG8_SA(1, 0), cA + kstep, voffA); PG8_STAGE(PG8_SB(1, 1), cB + hstep + kstep, voffB);
        PG8_WAIT_V(6); PG8_BAR;
    } else {
        PG8_STAGE(PG8_SB(0, 0), cB, voffB); PG8_STAGE(PG8_SA(0, 0), cA, voffA); PG8_STAGE(PG8_SB(0, 1), cB + hstep, voffB); PG8_STAGE(PG8_SA(0, 1), cA + hstep, voffA);
        if (wr == 1) PG8_BAR;
        PG8_WAIT_V(4); PG8_BAR;
        PG8_STAGE(PG8_SB(1, 0), cB + kstep, voffB); PG8_STAGE(PG8_SA(1, 0), cA + kstep, voffA); PG8_STAGE(PG8_SB(1, 1), cB + hstep + kstep, voffB);
        PG8_WAIT_V(6); PG8_BAR;
    }
    for (;;) {
        const bool has_next = S.next(ui + 1, nxt);
        const char* nA = has_next ? (const char*)g.A + (size_t)nxt.pm * tstep : cA; const char* nB = has_next ? (const char*)g.Bt + (size_t)nxt.pn * tstep : cB;
        for (int t = 0; t < nt; t += 2) {
            const bool last = (t == nt - 2);
            const char* a1 = cA + (size_t)(t + 1) * kstep;
            const char* a2 = last ? nA : cA + (size_t)(t + 2) * kstep; const char* b2 = last ? nB : cB + (size_t)(t + 2) * kstep;
            const char* a3 = a2 + kstep; const char* b3 = b2 + kstep;
            if (last && has_next) S.a_ready(nxt);
            if constexpr (SP2) {
            PG8_LDB(B0, 0, 0); PG8_LDB(B1, 0, 1); PG8_SCHED; PG8_LDA(At, 0, 0); PG8_STAGE(PG8_SA(1, 1), a1 + hstep, voffA);
            PG8_WAIT_V(8); PG8_WAIT_L(0); PG8_BAR; PG8_MMA(0, 0, At, B0); PG8_MMA(0, 1, At, B1); PG8_BAR; PG8_SCHED;
            PG8_LDA(At, 0, 1); PG8_STAGE(PG8_SB(0, 0), b2, voffB); PG8_STAGE(PG8_SB(0, 1), b2 + hstep, voffB); PG8_STAGE(PG8_SA(0, 0), a2, voffA);
            PG8_WAIT_V(8); PG8_WAIT_L(0); PG8_BAR; PG8_MMA(1, 0, At, B0); PG8_MMA(1, 1, At, B1); PG8_BAR; PG8_SCHED;
            PG8_LDB(B0, 1, 0); PG8_LDB(B1, 1, 1); PG8_SCHED; PG8_LDA(At, 1, 0); PG8_STAGE(PG8_SA(0, 1), a2 + hstep, voffA);
            PG8_WAIT_V(8); PG8_WAIT_L(0); PG8_BAR; PG8_MMA(0, 0, At, B0); PG8_MMA(0, 1, At, B1); PG8_BAR; PG8_SCHED;
            PG8_LDA(At, 1, 1); PG8_STAGE(PG8_SB(1, 0), b3, voffB); PG8_STAGE(PG8_SB(1, 1), b3 + hstep, voffB); PG8_STAGE(PG8_SA(1, 0), a3, voffA);
            PG8_WAIT_V(8); PG8_WAIT_L(0); PG8_BAR; PG8_MMA(1, 0, At, B0); PG8_MMA(1, 1, At, B1); PG8_BAR; PG8_SCHED;
            } else {
            PG8_LDB(B0, 0, 0); PG8_SCHED; PG8_LDA(At, 0, 0); PG8_STAGE(PG8_SA(1, 1), a1 + hstep, voffA);
            PG8_WAIT_L(8); PG8_BAR; PG8_WAIT_L(0); PG8_MMA(0, 0, At, B0); PG8_BAR; PG8_SCHED;
            PG8_LDB(B1, 0, 1); PG8_STAGE(PG8_SB(0, 0), b2, voffB);
            PG8_BAR; PG8_WAIT_L(0); PG8_MMA(0, 1, At, B1); PG8_BAR;
            PG8_LDA(At, 0, 1); PG8_STAGE(PG8_SA(0, 0), a2, voffA);
            PG8_BAR; PG8_WAIT_L(0); PG8_MMA(1, 0, At, B0); PG8_BAR; PG8_SCHED;
            PG8_STAGE(PG8_SB(0, 1), b2 + hstep, voffB);
            PG8_WAIT_V(6); PG8_BAR; PG8_MMA(1, 1, At, B1); PG8_BAR;
            PG8_LDB(B0, 1, 0); PG8_SCHED; PG8_LDA(At, 1, 0); PG8_STAGE(PG8_SA(0, 1), a2 + hstep, voffA);
            PG8_WAIT_L(8); PG8_BAR; PG8_WAIT_L(0); PG8_MMA(0, 0, At, B0); PG8_BAR; PG8_SCHED;
            PG8_LDB(B1, 1, 1); PG8_STAGE(PG8_SB(1, 0), b3, voffB);
            PG8_BAR; PG8_WAIT_L(0); PG8_MMA(0, 1, At, B1); PG8_BAR;
            PG8_LDA(At, 1, 1); PG8_STAGE(PG8_SA(1, 0), a3, voffA);
            PG8_BAR; PG8_WAIT_L(0); PG8_MMA(1, 0, At, B0); PG8_BAR; PG8_SCHED;
            PG8_STAGE(PG8_SB(1, 1), b3 + hstep, voffB);
            PG8_WAIT_V(6); PG8_BAR; PG8_MMA(1, 1, At, B1); PG8_BAR;
            }
        }
        if constexpr (ALIGN_EPI) { if (wr == 0) PG8_BAR; }
        if constexpr (!Epi::AFTER_DRAIN) { E(acc, cur, wr, wc, fr, fq); S.done(cur); }
        if (!has_next) break;
#pragma unroll
        for (int a = 0; a < 2; ++a)
#pragma unroll
            for (int b = 0; b < 2; ++b)
#pragma unroll
                for (int m = 0; m < 4; ++m)
#pragma unroll
                    for (int n = 0; n < 2; ++n) acc[a][b][m][n] = (f32x4){0.f, 0.f, 0.f, 0.f};
        cur = nxt; cA = nA; cB = nB; ++ui;
        if constexpr (ALIGN_EPI) { if (wr == 1) PG8_BAR; }
    }
    PG8_WAIT_V(0);
    if constexpr (!ALIGN_EPI) { if (wr == 0) PG8_BAR; }
    PG8_BAR;
    if constexpr (Epi::AFTER_DRAIN) { E.fused(acc, cur, wr, wc, fr, fq, lds, wid, lane); S.done(cur); }
#undef PG8_SA
#undef PG8_SB
#undef PG8_STAGE
#undef PG8_LDA
#undef PG8_LDB
#undef PG8_MMA
#undef PG8_WAIT_V
#undef PG8_WAIT_L
#undef PG8_BAR
#undef PG8_SCHED
}
}

DEV void phase_inproj(const Params& p, int l, int hf, int skew, unsigned char* smem) {
  pg8::Gemm g{(const bf16_t*)(p.ws + OFF_XB) + (size_t)hf * TH * DM, (const bf16_t*)(p.ws + OFF_WIN), TH, NPAD, DM};
  pg8::XcdOrder S; S.init(TH, NPAD, skew);
  pg8::EpiIn E{(bf16_t*)(p.ws + OFF_H), NPAD, (float*)(p.ws + OFF_SMALL), SM0 / 256};
  pg8::gemm_phase<pg8::EpiIn, pg8::XcdOrder, true, true>((PG8_LAS unsigned char*)smem, g, S, E);
}

DEV void phase_outproj(const Params& p, int l, int hf, unsigned char* smem) {
  pg8::Gemm g{(const bf16_t*)(p.ws + OFF_MIXED), (const bf16_t*)(p.ws + OFF_WOUT), TH, DM, DI};
  pg8::XcdOrder S; S.init(TH, DM);
  const float* xin = ((l == 0) ? p.x : p.out) + (size_t)hf * TH * DM;
  pg8::EpiOut E{xin, p.out + (size_t)hf * TH * DM, DM, DN_ALPHA};
  pg8::gemm_phase<pg8::EpiOut, pg8::XcdOrder, true, true>((PG8_LAS unsigned char*)smem, g, S, E);
}

DEV void phase_ln(const Params& p, int l, int hf) {
  const int tid = launder(threadIdx.x), lane = tid & 63, w = tid >> 6;
  const float* g = p.ln_g + l * DM; const float* b = p.ln_b + l * DM;
  bf16_t* xb = (bf16_t*)(p.ws + OFF_XB);
  for (int r = blockIdx.x * 8 + w; r < TH; r += gridDim.x * 8) {
    const int row = hf * TH + r;
    float4* rp = (float4*)(p.out + (size_t)row * DM);
    float4 v[4];
    float s = 0.f;
#pragma unroll
    for (int j = 0; j < 4; ++j) { v[j] = rp[j * 64 + lane]; s += (v[j].x + v[j].y) + (v[j].z + v[j].w); }
#pragma unroll
    for (int o = 32; o >= 1; o >>= 1) s += __shfl_xor(s, o);
    const float mu = s * (1.f / DM);
    float q = 0.f;
#pragma unroll
    for (int j = 0; j < 4; ++j) { const float a = v[j].x - mu, bb = v[j].y - mu, cc = v[j].z - mu, d = v[j].w - mu; q += (a * a + bb * bb) + (cc * cc + d * d); }
#pragma unroll
    for (int o = 32; o >= 1; o >>= 1) q += __shfl_xor(q, o);
    const float rstd = rsqrtf(q * (1.f / DM) + 1e-5f);
#pragma unroll
    for (int j = 0; j < 4; ++j) {
      const int col = (j * 64 + lane) * 4;
      const float4 gg = *(const float4*)(g + col), bb = *(const float4*)(b + col);
      float4 o;
      o.x = (v[j].x - mu) * rstd * gg.x + bb.x; o.y = (v[j].y - mu) * rstd * gg.y + bb.y;
      o.z = (v[j].z - mu) * rstd * gg.z + bb.z; o.w = (v[j].w - mu) * rstd * gg.w + bb.w;
      rp[j * 64 + lane] = o;
      if (l == 0) { uint2 pk; pk.x = pk2(o.x, o.y); pk.y = pk2(o.z, o.w); *(uint2*)(xb + (size_t)row * DM + col) = pk; }
    }
  }
}

DEV void attn_item(const Params& p, int l, int item, unsigned char* smem) {
  const int tid = launder(threadIdx.x), lane = tid & 63, w = tid >> 6, r = lane & 31, h = lane >> 5;
  const int qt = item & 15, head = (item >> 4) & 7, bl = item >> 7;
  const int kvh = head >> 2;
  bf16_t* Hh = (bf16_t*)(p.ws + OFF_H);
  const bf16_t* VT = (const bf16_t*)(p.ws + OFF_VT);
  const size_t rowbase = (size_t)bl * SEQ;
  float mq = fabsf(p.q_gain[l * 64 + lane]), mk = fabsf(p.k_gain[l * 64 + lane]);
#pragma unroll
  for (int o = 32; o >= 1; o >>= 1) { mq = fmaxf(mq, __shfl_xor(mq, o)); mk = fmaxf(mk, __shfl_xor(mk, o)); }
  const float M2 = 8.f * mq * mk * LOG2E * 1.01f;
  const int qrow = qt * 256 + w * 32 + r;
  const bf16_t* qp = Hh + (rowbase + qrow) * NPAD + A_Q + head * 64 + 8 * h;
  bf16x8 qf[4];
#pragma unroll
  for (int ks = 0; ks < 4; ++ks) qf[ks] = *(const bf16x8*)(qp + ks * 16);
  f32x16 o0 = zero16(), o1 = zero16();
  float lsum = 0.f;
  const int srow = tid >> 3, sch = (tid & 7) * 8;
  const bf16_t* kp = Hh + (rowbase + srow) * NPAD + A_K + kvh * 64 + sch;
  const bf16_t* vp = VT + ((size_t)((bl * 2 + kvh) * 64 + srow)) * SEQ + sch;
  union PB { bf16x8 v; unsigned u[4]; };
  auto qk = [&](int st, f32x16& s0, f32x16& s1) __attribute__((always_inline)) {
    const bf16_t* sK = (const bf16_t*)(smem + st * 18432);
#pragma unroll
    for (int i = 0; i < 16; ++i) { s0[i] = -M2; s1[i] = -M2; }
#pragma unroll
    for (int ks = 0; ks < 4; ++ks) {
      const bf16x8 a0 = *(const bf16x8*)(sK + r * 72 + ks * 16 + 8 * h);
      const bf16x8 a1 = *(const bf16x8*)(sK + (32 + r) * 72 + ks * 16 + 8 * h);
      s0 = __builtin_amdgcn_mfma_f32_32x32x16_bf16(a0, qf[ks], s0, 0, 0, 0);
      s1 = __builtin_amdgcn_mfma_f32_32x32x16_bf16(a1, qf[ks], s1, 0, 0, 0);
    }
  };
  auto soft = [&](f32x16& s0, f32x16& s1, PB (&pb)[2][2]) __attribute__((always_inline)) {
#pragma unroll
    for (int i = 0; i < 16; ++i) { s0[i] = __builtin_amdgcn_exp2f(s0[i]); s1[i] = __builtin_amdgcn_exp2f(s1[i]); lsum += s0[i] + s1[i]; }
#pragma unroll
    for (int s = 0; s < 2; ++s)
#pragma unroll
      for (int j = 0; j < 4; ++j) {
        pb[0][s].u[j] = pk2(s0[8 * s + 2 * j], s0[8 * s + 2 * j + 1]);
        pb[1][s].u[j] = pk2(s1[8 * s + 2 * j], s1[8 * s + 2 * j + 1]);
      }
  };
  auto pv = [&](int st, const PB (&pb)[2][2]) __attribute__((always_inline)) {
    const bf16_t* sV = (const bf16_t*)(smem + st * 18432 + 9216);
#pragma unroll
    for (int kt2 = 0; kt2 < 2; ++kt2)
#pragma unroll
      for (int s = 0; s < 2; ++s) {
        const int kb = kt2 * 32 + 16 * s + 4 * h;
        union { bf16x8 v; uint2 u[2]; } a0, a1;
        a0.u[0] = *(const uint2*)(sV + r * 72 + kb); a0.u[1] = *(const uint2*)(sV + r * 72 + kb + 8);
        a1.u[0] = *(const uint2*)(sV + (32 + r) * 72 + kb); a1.u[1] = *(const uint2*)(sV + (32 + r) * 72 + kb + 8);
        o0 = __builtin_amdgcn_mfma_f32_32x32x16_bf16(a0.v, pb[kt2][s].v, o0, 0, 0, 0);
        o1 = __builtin_amdgcn_mfma_f32_32x32x16_bf16(a1.v, pb[kt2][s].v, o1, 0, 0, 0);
      }
  };
  auto compute2 = [&](int sta, int stb) __attribute__((always_inline)) {
    f32x16 sa0, sa1, sb0, sb1; PB pa[2][2], pbb[2][2];
    qk(sta, sa0, sa1); qk(stb, sb0, sb1);
    soft(sa0, sa1, pa); pv(sta, pa);
    soft(sb0, sb1, pbb); pv(stb, pbb);
  };
  constexpr int NKT = SEQ / 64;
  auto sstore = [&](int st, const u32x4& kk, const u32x4& vv) __attribute__((always_inline)) {
    *(u32x4*)(smem + st * 18432 + srow * 144 + sch * 2) = kk;
    *(u32x4*)(smem + st * 18432 + 9216 + srow * 144 + sch * 2) = vv;
  };
  u32x4 k0 = *(const u32x4*)kp, v0 = *(const u32x4*)vp;
  u32x4 k1 = *(const u32x4*)(kp + (size_t)64 * NPAD), v1 = *(const u32x4*)(vp + 64);
  sstore(0, k0, v0); sstore(1, k1, v1);
  k0 = *(const u32x4*)(kp + (size_t)2 * 64 * NPAD); v0 = *(const u32x4*)(vp + 2 * 64);
  k1 = *(const u32x4*)(kp + (size_t)3 * 64 * NPAD); v1 = *(const u32x4*)(vp + 3 * 64);
  lds_barrier();
  for (int kt = 0; kt < NKT; kt += 4) {
    sstore(2, k0, v0); sstore(3, k1, v1);
    if (kt + 4 < NKT) {
      k0 = *(const u32x4*)(kp + (size_t)(kt + 4) * 64 * NPAD); v0 = *(const u32x4*)(vp + (kt + 4) * 64);
      k1 = *(const u32x4*)(kp + (size_t)(kt + 5) * 64 * NPAD); v1 = *(const u32x4*)(vp + (kt + 5) * 64);
    }
    compute2(0, 1);
    lds_barrier();
    if (kt + 4 < NKT) {
      sstore(0, k0, v0); sstore(1, k1, v1);
      if (kt + 6 < NKT) {
        k0 = *(const u32x4*)(kp + (size_t)(kt + 6) * 64 * NPAD); v0 = *(const u32x4*)(vp + (kt + 6) * 64);
        k1 = *(const u32x4*)(kp + (size_t)(kt + 7) * 64 * NPAD); v1 = *(const u32x4*)(vp + (kt + 7) * 64);
      }
    }
    compute2(2, 3);
    lds_barrier();
  }
  lsum += __shfl_xor(lsum, 32);
  const float inv = 1.f / lsum;
  const bf16_t* zp = Hh + (rowbase + qrow) * NPAD + A_Z + head * 64;
  bf16_t* op = Hh + (rowbase + qrow) * NPAD + A_Q + head * 64;
#pragma unroll
  for (int dt = 0; dt < 2; ++dt)
#pragma unroll
    for (int g = 0; g < 4; ++g) {
      const int d0 = dt * 32 + 8 * g + 4 * h;
      const uint2 zz = *(const uint2*)(zp + d0);
      const float z0 = bf2f((bf16_t)(zz.x & 0xffff)), z1 = bf2f((bf16_t)(zz.x >> 16)), z2 = bf2f((bf16_t)(zz.y & 0xffff)), z3 = bf2f((bf16_t)(zz.y >> 16));
      const f32x16& oo = dt ? o1 : o0;
      uint2 ov;
      ov.x = pk2(oo[4 * g + 0] * inv * fsilu(z0), oo[4 * g + 1] * inv * fsilu(z1));
      ov.y = pk2(oo[4 * g + 2] * inv * fsilu(z2), oo[4 * g + 3] * inv * fsilu(z3));
      *(uint2*)(op + d0) = ov;
    }
  lds_barrier();
}

constexpr int L_QT = 0, L_KT = 17408, L_QC = 34816, L_KHT = 52224, L_VT = 70656, L_ST = 89088,
              L_D = 123904, L_TOT = 124416, L_ACS = 128512, L_DT = 129024;

template <int K, int V> struct ScanGeom {
  static constexpr int KP = K + 8;
  static constexpr int NS = (K / 32) * (V / 32) / 8;
};

template <int K, int V>
DEV void scan_write_state(unsigned char* smem, const f32x16* S, int w, int lane) {
  constexpr int KP = K + 8, NS = ScanGeom<K, V>::NS, NVT = V / 32;
  bf16_t* sST = (bf16_t*)(smem + L_ST);
  const int c = lane & 31, h = lane >> 5;
#pragma unroll
  for (int i = 0; i < NS; ++i) {
    const int tile = w * NS + i, kt = tile / NVT, nt = tile % NVT;
#pragma unroll
    for (int g = 0; g < 4; ++g) {
      uint2 o; o.x = pk2(S[i][4 * g + 0], S[i][4 * g + 1]); o.y = pk2(S[i][4 * g + 2], S[i][4 * g + 3]);
      *(uint2*)(sST + (nt * 32 + c) * KP + kt * 32 + 8 * g + 4 * h) = o;
    }
  }
}

template <int K, int V, bool SSDM>
DEV void scan_core(unsigned char* smem, f32x16* S, bf16_t* orow0, int dir, int w, int lane, bool do_out, const float* sAcs) {
  constexpr int KP = K + 8, NS = ScanGeom<K, V>::NS, NVT = V / 32, NOT = 2 * NVT;
  const bf16_t* sQt = (const bf16_t*)(smem + L_QT); const bf16_t* sKt = (const bf16_t*)(smem + L_KT);
  const bf16_t* sQc = (const bf16_t*)(smem + L_QC); const bf16_t* sKhT = (const bf16_t*)(smem + L_KHT);
  const bf16_t* sVT = (const bf16_t*)(smem + L_VT);
  const bf16_t* sST = (const bf16_t*)(smem + L_ST); const float* sD = (const float*)(smem + L_D);
  const int c = lane & 31, h = lane >> 5;
  if (do_out && w < NOT) {
    const int tt = w / NVT, nt = w % NVT;
    f32x16 acc = zero16();
#pragma unroll
    for (int st = 0; st < 2; ++st) {
      if (st <= tt) {
        f32x16 pt = zero16();
        mma32<K>(pt, sKt + st * 32 * KP, KP, sQt + tt * 32 * KP, KP, lane);
        const int tau = tt * 32 + c;
        const float at = SSDM ? sAcs[tau] : 0.f;
#pragma unroll
        for (int reg = 0; reg < 16; ++reg) {
          const int sig = st * 32 + rowoff(reg, h);
          float v = pt[reg];
          if (SSDM) v *= ex2(at - sAcs[sig]);
          pt[reg] = (sig <= tau) ? v : 0.f;
        }
#pragma unroll
        for (int s2 = 0; s2 < 2; ++s2) {
          union { bf16x8 v; unsigned u[4]; } pa;
#pragma unroll
          for (int j = 0; j < 4; ++j) pa.u[j] = pk2(pt[8 * s2 + 2 * j], pt[8 * s2 + 2 * j + 1]);
          const int kb = st * 32 + 16 * s2 + 4 * h;
          union { bf16x8 v; uint2 u[2]; } vb;
          vb.u[0] = *(const uint2*)(sVT + (nt * 32 + c) * 72 + kb); vb.u[1] = *(const uint2*)(sVT + (nt * 32 + c) * 72 + kb + 8);
          acc = __builtin_amdgcn_mfma_f32_32x32x16_bf16(pa.v, vb.v, acc, 0, 0, 0);
        }
      }
    }
    mma32<K>(acc, sQc + tt * 32 * KP, KP, sST + nt * 32 * KP, KP, lane);
#pragma unroll
    for (int reg = 0; reg < 16; ++reg) {
      const int tau = tt * 32 + rowoff(reg, h);
      const int tok = dir ? (63 - tau) : tau;
      orow0[(size_t)tok * 512 + nt * 32 + c] = f2bf(acc[reg]);
    }
  }
#pragma unroll
  for (int i = 0; i < NS; ++i) {
    const int tile = w * NS + i, kt = tile / NVT, nt = tile % NVT;
#pragma unroll
    for (int reg = 0; reg < 16; ++reg) S[i][reg] *= sD[kt * 32 + rowoff(reg, h)];
    mma32<64>(S[i], sKhT + kt * 32 * 72, 72, sVT + nt * 32 * 72, 72, lane);
  }
}

template <int K, int V>
DEV void state_store(float* buf, const f32x16* S, int w, int lane) {
  constexpr int NS = ScanGeom<K, V>::NS, NVT = V / 32;
  const int c = lane & 31, h = lane >> 5;
#pragma unroll
  for (int i = 0; i < NS; ++i) {
    const int tile = w * NS + i, kt = tile / NVT, nt = tile % NVT;
#pragma unroll
    for (int reg = 0; reg < 16; ++reg) buf[(kt * 32 + rowoff(reg, h)) * V + nt * 32 + c] = S[i][reg];
  }
}
template <int K, int V>
DEV void state_load(const float* buf, f32x16* S, int w, int lane) {
  constexpr int NS = ScanGeom<K, V>::NS, NVT = V / 32;
  const int c = lane & 31, h = lane >> 5;
#pragma unroll
  for (int i = 0; i < NS; ++i) {
    const int tile = w * NS + i, kt = tile / NVT, nt = tile % NVT;
#pragma unroll
    for (int reg = 0; reg < 16; ++reg) S[i][reg] = buf[(kt * 32 + rowoff(reg, h)) * V + nt * 32 + c];
  }
}

#define PACK8_LO(v) (u32x4){((v)[0] & 0xffffu) | ((v)[1] << 16), ((v)[2] & 0xffffu) | ((v)[3] << 16), ((v)[4] & 0xffffu) | ((v)[5] << 16), ((v)[6] & 0xffffu) | ((v)[7] << 16)}
#define PACK8_HI(v) (u32x4){((v)[0] >> 16) | ((v)[1] & 0xffff0000u), ((v)[2] >> 16) | ((v)[3] & 0xffff0000u), ((v)[4] >> 16) | ((v)[5] & 0xffff0000u), ((v)[6] >> 16) | ((v)[7] & 0xffff0000u)}
#define CVT8(f) (u32x4){pk2((f)[0], (f)[1]), pk2((f)[2], (f)[3]), pk2((f)[4], (f)[5]), pk2((f)[6], (f)[7])}


DEV void hgrn_item(const Params& p, int l, int it, int seg, int mode, unsigned char* smem) {
  const int bl = it >> 3, head = (it >> 1) & 3, dir = it & 1;
  const bool do_out = (mode == 3);
  constexpr int K = 128, V = 128, KPW = 68;
  const int tid = launder(threadIdx.x), lane = tid & 63, w = tid >> 6;
  const int cp = tid & 63, tg = tid >> 6, ch0 = 2 * cp;
  const bf16_t* Hh = (const bf16_t*)(p.ws + OFF_H);
  bf16_t* OB = (bf16_t*)(p.ws + OFF_OBUF) + (size_t)(0 * 2 + dir) * TH * 512;
  const size_t rowbase = (size_t)bl * SEQ;
  float lb0 = 0.f, lb1 = 0.f;
  if (l > 0) {
    lb0 = fsigmoid(p.lb_logits[512 + head * 128 + ch0] - p.lb_logits[head * 128 + ch0]);
    lb1 = fsigmoid(p.lb_logits[512 + head * 128 + ch0 + 1] - p.lb_logits[head * 128 + ch0 + 1]);
  }
  const float om0 = 1.f - lb0, om1 = 1.f - lb1;
  const int fbase = dir ? H_FB : H_FF;
  unsigned* sQt = (unsigned*)(smem + L_QT); unsigned* sKt = (unsigned*)(smem + L_KT); unsigned* sQc = (unsigned*)(smem + L_QC);
  bf16_t* sKhT = (bf16_t*)(smem + L_KHT); bf16_t* sVT = (bf16_t*)(smem + L_VT);
  float* sD = (float*)(smem + L_D); float* sTot = (float*)(smem + L_TOT);
  f32x16 S[2]; S[0] = zero16(); S[1] = zero16();
  float* sbuf = (float*)(p.ws + OFF_SB0) + ((size_t)it * NSEG + seg) * 16384;
  if (do_out) state_load<K, V>(sbuf, S, w, lane);
  float dlog0 = 0.f, dlog1 = 0.f;
  unsigned pf[8], qq[8], vv[8];
  float g0[8], g1[8], kx0[8], kx1[8];
  auto gloadA = [&](int cidx) __attribute__((always_inline)) {
    const int chunk = dir ? (63 - cidx) : cidx;
#pragma unroll
    for (int i = 0; i < 8; ++i) {
      const int tau = 8 * tg + i;
      const int tok = chunk * 64 + (dir ? (63 - tau) : tau);
      pf[i] = ((const unsigned*)(Hh + (rowbase + tok) * NPAD + head * 128 + fbase))[cp];
    }
  };
  auto gloadB = [&](int cidx) __attribute__((always_inline)) {
    const int chunk = dir ? (63 - cidx) : cidx;
#pragma unroll
    for (int i = 0; i < 8; ++i) {
      const int tau = 8 * tg + i;
      const int tok = chunk * 64 + (dir ? (63 - tau) : tau);
      const unsigned* rp = (const unsigned*)(Hh + (rowbase + tok) * NPAD + head * 128) + cp;
      vv[i] = rp[H_I / 2];
      qq[i] = do_out ? rp[H_Q / 2] : 0u;
    }
  };
  auto stage1 = [&]() __attribute__((always_inline)) {
    float r0 = 0.f, r1 = 0.f;
#pragma unroll
    for (int i = 0; i < 8; ++i) {
      const float e0 = ex2(fminf(-lo16(pf[i]) * LOG2E, 80.f)), e1 = ex2(fminf(-hi16(pf[i]) * LOG2E, 80.f));
      const float s0 = frcp(1.f + e0), s1 = frcp(1.f + e1);
      r0 += lg2(lb0 + om0 * s0); r1 += lg2(lb1 + om1 * s1);
      g0[i] = r0; g1[i] = r1;
      kx0[i] = om0 * e0 * s0; kx1[i] = om1 * e1 * s1;
    }
    *(float2*)(sTot + tg * 128 + ch0) = make_float2(r0, r1);
  };
  gloadA(seg * SLEN); gloadB(seg * SLEN);
  stage1();
  if (SLEN > 1) gloadA(seg * SLEN + 1);
  for (int ci = 0; ci < SLEN; ++ci) {
    const int cidx = seg * SLEN + ci;
    const int chunk = dir ? (63 - cidx) : cidx;
    lds_barrier();
    float off0 = 0.f, off1 = 0.f, ref0 = 0.f, ref1 = 0.f, be0 = 0.f, be1 = 0.f;
#pragma unroll
    for (int j = 0; j < 8; ++j) {
      const float2 t = *(const float2*)(sTot + j * 128 + ch0);
      if (j < tg) { off0 += t.x; off1 += t.y; }
      if (j < 4) { ref0 += t.x; ref1 += t.y; }
      be0 += t.x; be1 += t.y;
    }
    dlog0 += be0; dlog1 += be1;
    const float eref0 = ex2(ref0), eref1 = ex2(ref1), ebr0 = ex2(be0 - ref0), ebr1 = ex2(be1 - ref1);
    const float d0 = off0 - ref0, d1 = off1 - ref1;
    float kh0[8], kh1[8];
#pragma unroll
    for (int i = 0; i < 8; ++i) {
      const int tau = 8 * tg + i;
      const float E0 = ex2(g0[i] + d0), E1 = ex2(g1[i] + d1);
      const float kt0 = kx0[i] * frcp(E0), kt1 = kx1[i] * frcp(E1);
      if (do_out) {
        const float qt0 = lo16(qq[i]) * E0, qt1 = hi16(qq[i]) * E1;
        sQt[tau * KPW + cp] = pk2(qt0, qt1);
        sKt[tau * KPW + cp] = pk2(kt0, kt1);
        sQc[tau * KPW + cp] = pk2(qt0 * eref0, qt1 * eref1);
      }
      kh0[i] = kt0 * ebr0; kh1[i] = kt1 * ebr1;
    }
    *(u32x4*)(sKhT + ch0 * 72 + 8 * tg) = CVT8(kh0);
    *(u32x4*)(sKhT + (ch0 + 1) * 72 + 8 * tg) = CVT8(kh1);
    *(u32x4*)(sVT + ch0 * 72 + 8 * tg) = PACK8_LO(vv);
    *(u32x4*)(sVT + (ch0 + 1) * 72 + 8 * tg) = PACK8_HI(vv);
    if (tg == 0) *(float2*)(sD + ch0) = make_float2(ex2(be0), ex2(be1));
    if (do_out) scan_write_state<K, V>(smem, S, w, lane);
    if (ci + 1 < SLEN) gloadB(cidx + 1);
    lds_barrier();
    scan_core<K, V, false>(smem, S, OB + (rowbase + (size_t)chunk * 64) * 512 + head * 128, dir, w, lane, do_out, nullptr);
    if (ci + 1 < SLEN) { stage1(); if (ci + 2 < SLEN) gloadA(cidx + 2); }
  }
  if (!do_out) {
    state_store<K, V>(sbuf, S, w, lane);
    if (tg == 0) *(float2*)((float*)(p.ws + OFF_DB) + ((size_t)it * NSEG + seg) * 128 + ch0) = make_float2(ex2(dlog0), ex2(dlog1));
  }
  lds_barrier();
}

DEV void gla_item(const Params& p, int l, int it, int seg, int mode, unsigned char* smem) {
  const int j16 = it - 16, bl = j16 >> 3, head = (j16 >> 1) & 3, dir = j16 & 1;
  const bool do_out = (mode == 3);
  constexpr int K = 64, V = 128, KPW = 36;
  const int tid = launder(threadIdx.x), lane = tid & 63, w = tid >> 6;
  const int cp = tid & 31, tg = tid >> 5, ch0 = 2 * cp;
  const int vp2 = tid & 63, vg = tid >> 6;
  const bf16_t* Hh = (const bf16_t*)(p.ws + OFF_H);
  const bf16_t* Gb = (const bf16_t*)(p.ws + OFF_G);
  bf16_t* OB = (bf16_t*)(p.ws + OFF_OBUF) + (size_t)(2 * 2 + dir) * TH * 512;
  const size_t rowbase = (size_t)bl * SEQ;
  unsigned* sQt = (unsigned*)(smem + L_QT); unsigned* sKt = (unsigned*)(smem + L_KT); unsigned* sQc = (unsigned*)(smem + L_QC);
  bf16_t* sKhT = (bf16_t*)(smem + L_KHT); bf16_t* sVT = (bf16_t*)(smem + L_VT);
  float* sD = (float*)(smem + L_D); float* sTot = (float*)(smem + L_TOT);
  f32x16 S[1]; S[0] = zero16();
  float* sbuf = (float*)(p.ws + OFF_SB1) + ((size_t)j16 * NSEG + seg) * 8192;
  if (do_out) state_load<K, V>(sbuf, S, w, lane);
  float dlog0 = 0.f, dlog1 = 0.f;
  unsigned pg[4];
  float g0[4], g1[4]; unsigned kk[4], qq[4], vv[8];
  auto gloadA = [&](int cidx) __attribute__((always_inline)) {
    const int chunk = dir ? (63 - cidx) : cidx;
#pragma unroll
    for (int i = 0; i < 4; ++i) {
      const int tau = 4 * tg + i;
      const int tok = chunk * 64 + (dir ? (63 - tau) : tau);
      pg[i] = ((const unsigned*)(Gb + (rowbase + tok) * 512 + dir * 256 + head * 64))[cp];
    }
  };
  auto gloadB = [&](int cidx) __attribute__((always_inline)) {
    const int chunk = dir ? (63 - cidx) : cidx;
#pragma unroll
    for (int i = 0; i < 4; ++i) {
      const int tau = 4 * tg + i;
      const int tok = chunk * 64 + (dir ? (63 - tau) : tau);
      const unsigned* rp = (const unsigned*)(Hh + (rowbase + tok) * NPAD + head * 64) + cp;
      kk[i] = rp[G_K / 2]; qq[i] = do_out ? rp[G_Q / 2] : 0u;
    }
#pragma unroll
    for (int i = 0; i < 8; ++i) {
      const int tau = 8 * vg + i;
      const int tok = chunk * 64 + (dir ? (63 - tau) : tau);
      vv[i] = ((const unsigned*)(Hh + (rowbase + tok) * NPAD + G_V + head * 128))[vp2];
    }
  };
  auto stage1 = [&]() __attribute__((always_inline)) {
    float r0 = 0.f, r1 = 0.f;
#pragma unroll
    for (int i = 0; i < 4; ++i) { r0 += lo16(pg[i]); r1 += hi16(pg[i]); g0[i] = r0; g1[i] = r1; }
    *(float2*)(sTot + tg * 64 + ch0) = make_float2(r0, r1);
  };
  gloadA(seg * SLEN); gloadB(seg * SLEN);
  stage1();
  if (SLEN > 1) gloadA(seg * SLEN + 1);
  for (int ci = 0; ci < SLEN; ++ci) {
    const int cidx = seg * SLEN + ci;
    const int chunk = dir ? (63 - cidx) : cidx;
    lds_barrier();
    float off0 = 0.f, off1 = 0.f, ref0 = 0.f, ref1 = 0.f, be0 = 0.f, be1 = 0.f;
#pragma unroll
    for (int j = 0; j < 16; ++j) {
      const float2 t = *(const float2*)(sTot + j * 64 + ch0);
      if (j < tg) { off0 += t.x; off1 += t.y; }
      if (j < 8) { ref0 += t.x; ref1 += t.y; }
      be0 += t.x; be1 += t.y;
    }
    dlog0 += be0; dlog1 += be1;
    const float eref0 = ex2(ref0), eref1 = ex2(ref1), ebr0 = ex2(be0 - ref0), ebr1 = ex2(be1 - ref1);
    const float d0 = off0 - ref0, d1 = off1 - ref1;
    float kh0[4], kh1[4];
#pragma unroll
    for (int i = 0; i < 4; ++i) {
      const int tau = 4 * tg + i;
      const float E0 = ex2(g0[i] + d0), E1 = ex2(g1[i] + d1);
      const float kt0 = lo16(kk[i]) * frcp(E0), kt1 = hi16(kk[i]) * frcp(E1);
      if (do_out) {
        const float qt0 = lo16(qq[i]) * E0, qt1 = hi16(qq[i]) * E1;
        sQt[tau * KPW + cp] = pk2(qt0, qt1);
        sKt[tau * KPW + cp] = pk2(kt0, kt1);
        sQc[tau * KPW + cp] = pk2(qt0 * eref0, qt1 * eref1);
      }
      kh0[i] = kt0 * ebr0; kh1[i] = kt1 * ebr1;
    }
    *(uint2*)(sKhT + ch0 * 72 + 4 * tg) = make_uint2(pk2(kh0[0], kh0[1]), pk2(kh0[2], kh0[3]));
    *(uint2*)(sKhT + (ch0 + 1) * 72 + 4 * tg) = make_uint2(pk2(kh1[0], kh1[1]), pk2(kh1[2], kh1[3]));
    *(u32x4*)(sVT + (2 * vp2) * 72 + 8 * vg) = PACK8_LO(vv);
    *(u32x4*)(sVT + (2 * vp2 + 1) * 72 + 8 * vg) = PACK8_HI(vv);
    if (tg == 0) *(float2*)(sD + ch0) = make_float2(ex2(be0), ex2(be1));
    if (do_out) scan_write_state<K, V>(smem, S, w, lane);
    if (ci + 1 < SLEN) gloadB(cidx + 1);
    lds_barrier();
    scan_core<K, V, false>(smem, S, OB + (rowbase + (size_t)chunk * 64) * 512 + head * 128, dir, w, lane, do_out, nullptr);
    if (ci + 1 < SLEN) { stage1(); if (ci + 2 < SLEN) gloadA(cidx + 2); }
  }
  if (!do_out) {
    state_store<K, V>(sbuf, S, w, lane);
    if (tg == 0) *(float2*)((float*)(p.ws + OFF_DB) + ((size_t)it * NSEG + seg) * 128 + ch0) = make_float2(ex2(dlog0), ex2(dlog1));
  }
  lds_barrier();
}

DEV void ssd_item(const Params& p, int l, int it, int seg, int mode, unsigned char* smem) {
  const int j32 = it - 32, bl = j32 >> 4, head = (j32 >> 1) & 7, dir = j32 & 1;
  const bool do_out = (mode == 3);
  constexpr int K = 128, V = 64, KPW = 68;
  const int tid = launder(threadIdx.x), lane = tid & 63, w = tid >> 6;
  const int cp = tid & 63, tg = tid >> 6, n0 = 2 * cp;
  const int xp = tid & 31, xg = tid >> 5;
  const int grp = head >> 2;
  const bf16_t* U = (const bf16_t*)(p.ws + OFF_U);
  const float* SMALL = (const float*)(p.ws + OFF_SMALL);
  bf16_t* OB = (bf16_t*)(p.ws + OFF_OBUF) + (size_t)(1 * 2 + dir) * TH * 512;
  const size_t rowbase = (size_t)bl * SEQ;
  unsigned* sQt = (unsigned*)(smem + L_QT); unsigned* sKt = (unsigned*)(smem + L_KT); unsigned* sQc = (unsigned*)(smem + L_QC);
  bf16_t* sKhT = (bf16_t*)(smem + L_KHT); bf16_t* sVT = (bf16_t*)(smem + L_VT);
  float* sD = (float*)(smem + L_D);
  const float dtb = p.dt_bias[(l * 2 + dir) * 8 + head];
  const float Acoef = -__expf(p.a_log[(l * 2 + dir) * 8 + head]) * LOG2E;
  f32x16 S[1]; S[0] = zero16();
  float* sbuf = (float*)(p.ws + OFF_SB2) + ((size_t)j32 * NSEG + seg) * 8192;
  if (do_out) state_load<K, V>(sbuf, S, w, lane);
  float dlog = 0.f;
  unsigned bb[8], cc[8], xx[4];
  float rdt = 0.f;
  auto gloadA = [&](int cidx) __attribute__((always_inline)) {
    const int chunk = dir ? (63 - cidx) : cidx;
    if (w == 0) {
      const int tok = chunk * 64 + (dir ? (63 - lane) : lane);
      rdt = SMALL[(rowbase + tok) * 48 + dir * 8 + head];
    }
  };
  auto gloadB = [&](int cidx) __attribute__((always_inline)) {
    const int chunk = dir ? (63 - cidx) : cidx;
#pragma unroll
    for (int i = 0; i < 8; ++i) {
      const int tau = 8 * tg + i;
      const int tok = chunk * 64 + (dir ? (63 - tau) : tau);
      const unsigned* rp = (const unsigned*)(U + (rowbase + tok) * 1024 + grp * 128) + cp;
      bb[i] = rp[512 / 2]; cc[i] = do_out ? rp[768 / 2] : 0u;
    }
#pragma unroll
    for (int i = 0; i < 4; ++i) {
      const int tau = 4 * xg + i;
      const int tok = chunk * 64 + (dir ? (63 - tau) : tau);
      xx[i] = ((const unsigned*)(U + (rowbase + tok) * 1024 + head * 64))[xp];
    }
  };
  auto stage1 = [&](int par) __attribute__((always_inline)) {
    if (w == 0) {
      const float xv = rdt + dtb;
      const float dt = (xv > 20.f) ? xv : log1pf(__expf(xv));
      float a = dt * Acoef;
#pragma unroll
      for (int o = 1; o < 64; o <<= 1) { const float t = __shfl_up(a, o); if (lane >= o) a += t; }
      ((float*)(smem + L_ACS))[par * 64 + lane] = a; ((float*)(smem + L_DT))[par * 64 + lane] = dt;
    }
  };
  gloadA(seg * SLEN); gloadB(seg * SLEN);
  stage1(0);
  if (SLEN > 1) gloadA(seg * SLEN + 1);
  for (int ci = 0; ci < SLEN; ++ci) {
    const int cidx = seg * SLEN + ci;
    const int chunk = dir ? (63 - cidx) : cidx;
    const float* sAcs = (const float*)(smem + L_ACS) + (ci & 1) * 64;
    const float* sDt = (const float*)(smem + L_DT) + (ci & 1) * 64;
    lds_barrier();
    const float aend = sAcs[63];
    dlog += aend;
    {
      float kh0[8], kh1[8];
#pragma unroll
      for (int i = 0; i < 8; ++i) {
        const int tau = 8 * tg + i;
        const float ac = sAcs[tau];
        const float eb = ex2(aend - ac);
        kh0[i] = lo16(bb[i]) * eb; kh1[i] = hi16(bb[i]) * eb;
        if (do_out) {
          const float ea = ex2(ac);
          sKt[tau * KPW + cp] = bb[i];
          sQt[tau * KPW + cp] = cc[i];
          sQc[tau * KPW + cp] = pk2(lo16(cc[i]) * ea, hi16(cc[i]) * ea);
        }
      }
      *(u32x4*)(sKhT + n0 * 72 + 8 * tg) = CVT8(kh0);
      *(u32x4*)(sKhT + (n0 + 1) * 72 + 8 * tg) = CVT8(kh1);
      float x0[4], x1[4];
#pragma unroll
      for (int i = 0; i < 4; ++i) { const float dtv = sDt[4 * xg + i]; x0[i] = lo16(xx[i]) * dtv; x1[i] = hi16(xx[i]) * dtv; }
      *(uint2*)(sVT + (2 * xp) * 72 + 4 * xg) = make_uint2(pk2(x0[0], x0[1]), pk2(x0[2], x0[3]));
      *(uint2*)(sVT + (2 * xp + 1) * 72 + 4 * xg) = make_uint2(pk2(x1[0], x1[1]), pk2(x1[2], x1[3]));
      if (tg == 0) *(float2*)(sD + n0) = make_float2(ex2(aend), ex2(aend));
    }
    if (do_out) scan_write_state<K, V>(smem, S, w, lane);
    if (ci + 1 < SLEN) gloadB(cidx + 1);
    lds_barrier();
    scan_core<K, V, true>(smem, S, OB + (rowbase + (size_t)chunk * 64) * 512 + head * 64, dir, w, lane, do_out, sAcs);
    if (ci + 1 < SLEN) { stage1((ci + 1) & 1); if (ci + 2 < SLEN) gloadA(cidx + 2); }
  }
  if (!do_out) {
    state_store<K, V>(sbuf, S, w, lane);
    if (tg == 0) *(float2*)((float*)(p.ws + OFF_DB) + ((size_t)it * NSEG + seg) * 128 + n0) = make_float2(ex2(dlog), ex2(dlog));
  }
  lds_barrier();
}

DEV void phase_prep(const Params& p, int l, int hf, int rep, unsigned char* smem) {
  const int tid = launder(threadIdx.x), lane = tid & 63;
  bf16_t* Hh = (bf16_t*)(p.ws + OFF_H);
  bf16_t* U = (bf16_t*)(p.ws + OFF_U);
  bf16_t* Gb = (bf16_t*)(p.ws + OFF_G);
  bf16_t* VT = (bf16_t*)(p.ws + OFF_VT);
  const float* SMALLp = (const float*)(p.ws + OFF_SMALL);
  float2* stab = (float2*)smem;
  float* slow = (float*)(smem + 8192);
  bf16_t* sT = (bf16_t*)(smem + 12288);
  {
    const float2* tabg = (const float2*)(p.ws + OFF_TAB);
    for (int i = tid; i < 1024; i += NT) stab[i] = tabg[i];
  }
  const int cg8 = (tid & 127) * 8, rsub = tid >> 7;
  const float* cw = p.conv_w + (size_t)l * 5 * 1024; const float* cb = p.conv_b + (size_t)l * 1024;
  float wv[5][8], bv[8];
#pragma unroll
  for (int j = 0; j < 5; ++j)
#pragma unroll
    for (int e = 0; e < 8; ++e) wv[j][e] = cw[j * 1024 + cg8 + e];
#pragma unroll
  for (int e = 0; e < 8; ++e) bv[e] = cb[cg8 + e];
  const int gd = tid >> 8, gc = tid & 255;
  const int i16 = lane & 15;
  const float* gq = p.q_gain + l * 64 + 4 * i16; const float* gk = p.k_gain + l * 64 + 4 * i16;
  const float gqv[4] = {gq[0], gq[1], gq[2], gq[3]}, gkv[4] = {gk[0], gk[1], gk[2], gk[3]};
  for (int grp = blockIdx.x; grp < TH / 32; grp += gridDim.x) {
    const int r0 = grp * 32;
    lds_barrier();
    const u32x4 vt = *(const u32x4*)(Hh + (size_t)(r0 + (tid >> 4)) * NPAD + A_V + (tid & 15) * 8);
    const float2 lowv = *(const float2*)(SMALLp + (size_t)(r0 + (tid >> 4)) * 48 + 16 + (tid & 15) * 2);
    *(u32x4*)(sT + (tid >> 4) * 136 + (tid & 15) * 8) = vt;
    *(float2*)(slow + (tid >> 4) * 32 + (tid & 15) * 2) = lowv;
#pragma unroll 1
    for (int ps = 0; ps < 2; ++ps) {
      const int ra = r0 + 16 * ps + 4 * rsub, ta = ra & (SEQ - 1);
      u32x4 xc[8];
#pragma unroll
      for (int m = 0; m < 8; ++m) {
        const int sq = ta + m - 2;
        xc[m] = (u32x4){0u, 0u, 0u, 0u};
        if (sq >= 0 && sq < SEQ) xc[m] = *(const u32x4*)(Hh + (size_t)(ra + m - 2) * NPAD + S_X + cg8);
      }
#pragma unroll
      for (int o4 = 0; o4 < 4; ++o4) {
        float u[8];
#pragma unroll
        for (int e = 0; e < 8; ++e) u[e] = bv[e];
#pragma unroll
        for (int j = 0; j < 5; ++j)
#pragma unroll
          for (int e = 0; e < 4; ++e) { u[2 * e] += wv[j][2 * e] * lo16(xc[o4 + j][e]); u[2 * e + 1] += wv[j][2 * e + 1] * hi16(xc[o4 + j][e]); }
        u32x4 o;
#pragma unroll
        for (int e = 0; e < 4; ++e) {
          const float a = u[2 * e] * frcp(1.f + ex2(fminf(-u[2 * e] * LOG2E, 80.f)));
          const float b = u[2 * e + 1] * frcp(1.f + ex2(fminf(-u[2 * e + 1] * LOG2E, 80.f)));
          o[e] = pk2(a, b);
        }
        *(u32x4*)(U + (size_t)(ra + o4) * 1024 + cg8) = o;
      }
    }
    lds_barrier();
    if (rep == 0) {
      u32x4 hq[6];
#pragma unroll
      for (int u = 0; u < 6; ++u) {
        const int id = u * 512 + tid, row = r0 + id / 96, c96 = id % 96;
        hq[u] = *(const u32x4*)(Hh + (size_t)row * NPAD + ((c96 < 64) ? (H_Q + c96 * 8) : (G_Q + (c96 - 64) * 8)));
      }
#pragma unroll 1
      for (int ub = 0; ub < 10; ub += 5) {
        uint2 xq[5];
#pragma unroll
        for (int u = 0; u < 5; ++u) {
          const int pi = (ub + u) * 32 + (tid >> 4), row = r0 + pi / 10, hd = pi % 10;
          xq[u] = *(const uint2*)(Hh + (size_t)row * NPAD + ((hd < 8) ? (A_Q + hd * 64) : (A_K + (hd - 8) * 64)) + 4 * i16);
        }
#pragma unroll
        for (int u = 0; u < 5; ++u) {
          const int pi = (ub + u) * 32 + (tid >> 4), row = r0 + pi / 10, hd = pi % 10;
          const bool isq = hd < 8;
          const float x[4] = {lo16(xq[u].x), hi16(xq[u].x), lo16(xq[u].y), hi16(xq[u].y)};
          float ss = x[0] * x[0] + x[1] * x[1] + x[2] * x[2] + x[3] * x[3];
          ss += __shfl_xor(ss, 1); ss += __shfl_xor(ss, 2); ss += __shfl_xor(ss, 4); ss += __shfl_xor(ss, 8);
          const float rstd = rsqrtf(ss * (1.f / 64.f) + 1e-6f);
          const int t = row & (SEQ - 1);
          const int pos = (i16 < 8) ? (t >> 6) : (t & 63);
          const float osc = isq ? QSCALE : 1.f;
          float o[4];
#pragma unroll
          for (int e = 0; e < 4; ++e) {
            const float v = x[e] * rstd * (isq ? gqv[e] : gkv[e]);
            const float pv = __shfl_xor(v, 4);
            const float2 cs = stab[pos * 16 + 4 * (i16 & 3) + e];
            o[e] = ((i16 & 4) ? (v * cs.x + pv * cs.y) : (v * cs.x - pv * cs.y)) * osc;
          }
          *(uint2*)(Hh + (size_t)row * NPAD + (isq ? (A_Q + hd * 64) : (A_K + (hd - 8) * 64)) + 4 * i16) = make_uint2(pk2(o[0], o[1]), pk2(o[2], o[3]));
        }
      }
#pragma unroll
      for (int u = 0; u < 6; ++u) {
        const int id = u * 512 + tid, row = r0 + id / 96, c96 = id % 96;
        u32x4 x = hq[u];
        if (c96 < 64) {
#pragma unroll
          for (int e = 0; e < 4; ++e) {
            const float a = lo16(x[e]), b = hi16(x[e]);
            x[e] = pk2(a * frcp(1.f + ex2(fminf(-a * LOG2E, 80.f))) * 0.08838834764831845f, b * frcp(1.f + ex2(fminf(-b * LOG2E, 80.f))) * 0.08838834764831845f);
          }
        } else {
#pragma unroll
          for (int e = 0; e < 4; ++e) x[e] = pk2(lo16(x[e]) * 0.125f, hi16(x[e]) * 0.125f);
        }
        *(u32x4*)(Hh + (size_t)row * NPAD + ((c96 < 64) ? (H_Q + c96 * 8) : (G_Q + (c96 - 64) * 8))) = x;
      }
    }
    float w2c[16];
#pragma unroll
    for (int r = 0; r < 16; ++r) w2c[r] = p.gk_w2[((size_t)(l * 2 + gd) * 16 + r) * 256 + gc];
    const float gbias = p.gk_b[(l * 2 + gd) * 256 + gc];
#pragma unroll 4
    for (int rr = 0; rr < 32; ++rr) {
      const float4* lp4 = (const float4*)(slow + rr * 32 + gd * 16);
      float gkk = gbias;
#pragma unroll
      for (int r4 = 0; r4 < 4; ++r4) { const float4 lw = lp4[r4]; gkk += lw.x * w2c[4 * r4] + lw.y * w2c[4 * r4 + 1] + lw.z * w2c[4 * r4 + 2] + lw.w * w2c[4 * r4 + 3]; }
      const float l2 = (fminf(gkk, 0.f) * LOG2E - lg2(1.f + ex2(-fabsf(gkk) * LOG2E))) * (1.f / 16.f);
      Gb[(size_t)(r0 + rr) * 512 + tid] = f2bf(l2);
    }
    {
      const int c = tid >> 2, tq = (tid & 3) * 8;
      unsigned v[8];
#pragma unroll
      for (int i = 0; i < 8; ++i) v[i] = sT[(tq + i) * 136 + c];
      const int bl = r0 >> 12, t0 = (r0 & (SEQ - 1)) + tq;
      *(u32x4*)(VT + ((size_t)((bl * 2 + (c >> 6)) * 64 + (c & 63))) * SEQ + t0) = (u32x4){v[0] | (v[1] << 16), v[2] | (v[3] << 16), v[4] | (v[5] << 16), v[6] | (v[7] << 16)};
    }
  }
  lds_barrier();
}

DEV void phase_mix(const Params& p, int l, int hf, int slot, int mode, int att_lo, int att_hi, int vid_lo, int vid_hi, unsigned char* smem) {
  unsigned* ctr = (unsigned*)(p.ws + OFF_CTRL) + CTR_WORD0 + slot * 16;
  volatile int* sItem = (volatile int*)(smem + LDS_BYTES - 16);
  const int n_scan = 64 * NSEG;
  int hi = n_scan + (att_hi - att_lo); if (vid_hi < hi) hi = vid_hi;
  for (;;) {
    lds_barrier();
    if (threadIdx.x == 0) *sItem = vid_lo + (int)atomicAdd(ctr, 1u);
    lds_barrier();
    const int vid = *sItem;
    if (vid >= hi) break;
    if (vid < n_scan) {
      const int seg = vid >> 6, it = vid & 63;
      if (mode == 1 && seg == NSEG - 1) continue;
#if PROBE_REP > 0
      if (slot >= 40 && PROBE_TYPE >= 0 && ((it < 16) ? 0 : (it < 32) ? 1 : 2) != PROBE_TYPE) continue;
#endif
      if (it < 16) { if (PH_MASK & 0x100) hgrn_item(p, l, it, seg, mode, smem); }
      else if (it < 32) { if (PH_MASK & 0x200) gla_item(p, l, it, seg, mode, smem); }
      else { if (PH_MASK & 0x400) ssd_item(p, l, it, seg, mode, smem); }
    } else { if (PH_MASK & 0x800) attn_item(p, l, att_lo + (vid - n_scan), smem); }
  }
}

DEV void phase_scan2(const Params& p) {
  const size_t gtid = (size_t)blockIdx.x * NT + threadIdx.x, gsz = (size_t)gridDim.x * NT;
  const float* DB = (const float*)(p.ws + OFF_DB);
  for (size_t e = gtid; e < 655360; e += gsz) {
    float* buf; const float* dp; int stride;
    if (e < 262144) { const int it = (int)(e >> 14), idx = (int)(e & 16383); buf = (float*)(p.ws + OFF_SB0) + (size_t)it * NSEG * 16384 + idx; stride = 16384; dp = DB + (size_t)it * NSEG * 128 + (idx >> 7); }
    else if (e < 393216) { const int e2 = (int)(e - 262144), j = e2 >> 13, idx = e2 & 8191; buf = (float*)(p.ws + OFF_SB1) + (size_t)j * NSEG * 8192 + idx; stride = 8192; dp = DB + (size_t)(16 + j) * NSEG * 128 + (idx >> 7); }
    else { const int e3 = (int)(e - 393216), j = e3 >> 13, idx = e3 & 8191; buf = (float*)(p.ws + OFF_SB2) + (size_t)j * NSEG * 8192 + idx; stride = 8192; dp = DB + (size_t)(32 + j) * NSEG * 128 + (idx >> 6); }
    float u[NSEG - 1], d[NSEG - 1];
#pragma unroll
    for (int sg = 0; sg < NSEG - 1; ++sg) { u[sg] = buf[(size_t)sg * stride]; d[sg] = dp[sg * 128]; }
    float st = 0.f;
#pragma unroll
    for (int sg = 0; sg < NSEG; ++sg) { buf[(size_t)sg * stride] = st; if (sg < NSEG - 1) st = d[sg] * st + u[sg]; }
  }
}

DEV void phase_fin(const Params& p, int l, int hf) {
  const int tid = launder(threadIdx.x), lane = tid & 63, w = tid >> 6;
  const bf16_t* Hh = (const bf16_t*)(p.ws + OFF_H);
  const bf16_t* OB = (const bf16_t*)(p.ws + OFF_OBUF);
  bf16_t* MX = (bf16_t*)(p.ws + OFF_MIXED);
  const int c0 = lane * 8;
  const float* cw = p.conv_w + (size_t)l * 5 * 1024; const float* cb = p.conv_b + (size_t)l * 1024;
  for (int r = blockIdx.x * 8 + w; r < TH; r += gridDim.x * 8) {
    const bf16_t* hrow = Hh + (size_t)r * NPAD;
    *(u32x4*)(MX + (size_t)r * DI + c0) = *(const u32x4*)(hrow + A_Q + c0);
    {
      const uint4 a = *(const uint4*)(OB + ((size_t)0 * TH + r) * 512 + c0), b = *(const uint4*)(OB + ((size_t)1 * TH + r) * 512 + c0);
      const uint4 z = *(const uint4*)(hrow + H_Z + c0);
      const unsigned au[4] = {a.x, a.y, a.z, a.w}, bu[4] = {b.x, b.y, b.z, b.w}, zu[4] = {z.x, z.y, z.z, z.w};
      float o[8]; float ss = 0.f;
#pragma unroll
      for (int j = 0; j < 4; ++j) {
        o[2 * j] = bf2f((bf16_t)(au[j] & 0xffff)) + bf2f((bf16_t)(bu[j] & 0xffff));
        o[2 * j + 1] = bf2f((bf16_t)(au[j] >> 16)) + bf2f((bf16_t)(bu[j] >> 16));
        ss += o[2 * j] * o[2 * j] + o[2 * j + 1] * o[2 * j + 1];
      }
#pragma unroll
      for (int of = 32; of >= 1; of >>= 1) ss += __shfl_xor(ss, of);
      const float rstd = rsqrtf(ss * (1.f / 512.f) + 1e-6f);
      float y[8];
#pragma unroll
      for (int j = 0; j < 8; ++j) {
        const float zz = bf2f((bf16_t)((j & 1) ? (zu[j >> 1] >> 16) : (zu[j >> 1] & 0xffff)));
        y[j] = o[j] * rstd * p.hgrn_norm[l * 512 + c0 + j] * fsilu(zz);
      }
      uint4 ov; ov.x = pk2(y[0], y[1]); ov.y = pk2(y[2], y[3]); ov.z = pk2(y[4], y[5]); ov.w = pk2(y[6], y[7]);
      *(uint4*)(MX + (size_t)r * DI + 512 + c0) = ov;
    }
    {
      const uint4 a = *(const uint4*)(OB + ((size_t)4 * TH + r) * 512 + c0), b = *(const uint4*)(OB + ((size_t)5 * TH + r) * 512 + c0);
      const uint4 z = *(const uint4*)(hrow + G_Z + c0);
      const unsigned au[4] = {a.x, a.y, a.z, a.w}, bu[4] = {b.x, b.y, b.z, b.w}, zu[4] = {z.x, z.y, z.z, z.w};
      float o[8]; float ss = 0.f;
#pragma unroll
      for (int j = 0; j < 4; ++j) {
        o[2 * j] = bf2f((bf16_t)(au[j] & 0xffff)) + bf2f((bf16_t)(bu[j] & 0xffff));
        o[2 * j + 1] = bf2f((bf16_t)(au[j] >> 16)) + bf2f((bf16_t)(bu[j] >> 16));
        ss += o[2 * j] * o[2 * j] + o[2 * j + 1] * o[2 * j + 1];
      }
#pragma unroll
      for (int of = 8; of >= 1; of >>= 1) ss += __shfl_xor(ss, of);
      const float rstd = rsqrtf(ss * (1.f / 128.f) + 1e-6f);
      float y[8];
#pragma unroll
      for (int j = 0; j < 8; ++j) {
        const float zz = bf2f((bf16_t)((j & 1) ? (zu[j >> 1] >> 16) : (zu[j >> 1] & 0xffff)));
        y[j] = o[j] * rstd * p.gla_norm[l * 128 + ((c0 + j) & 127)] * fsilu(zz);
      }
      uint4 ov; ov.x = pk2(y[0], y[1]); ov.y = pk2(y[2], y[3]); ov.z = pk2(y[4], y[5]); ov.w = pk2(y[6], y[7]);
      *(uint4*)(MX + (size_t)r * DI + 1536 + c0) = ov;
    }
    {
      const uint4 a = *(const uint4*)(OB + ((size_t)2 * TH + r) * 512 + c0), b = *(const uint4*)(OB + ((size_t)3 * TH + r) * 512 + c0);
      const uint4 z = *(const uint4*)(hrow + S_Z + c0);
      const unsigned au[4] = {a.x, a.y, a.z, a.w}, bu[4] = {b.x, b.y, b.z, b.w}, zu[4] = {z.x, z.y, z.z, z.w};
      float u[8];
#pragma unroll
      for (int j = 0; j < 8; ++j) u[j] = cb[c0 + j];
      const int t = r & (SEQ - 1);
#pragma unroll
      for (int jj = 0; jj < 5; ++jj) {
        const int s = t + jj - 2;
        if (s >= 0 && s < SEQ) {
          const uint4 xr = *(const uint4*)(Hh + (size_t)(r + jj - 2) * NPAD + S_X + c0);
          const unsigned xu[4] = {xr.x, xr.y, xr.z, xr.w};
#pragma unroll
          for (int j = 0; j < 8; ++j) {
            const float xv = bf2f((bf16_t)((j & 1) ? (xu[j >> 1] >> 16) : (xu[j >> 1] & 0xffff)));
            u[j] += cw[jj * 1024 + c0 + j] * xv;
          }
        }
      }
      const float dsk = p.ssd_d[l * 8 + (c0 >> 6)];
      float y[8]; float ss = 0.f;
#pragma unroll
      for (int j = 0; j < 8; ++j) {
        const float of = bf2f((bf16_t)((j & 1) ? (au[j >> 1] >> 16) : (au[j >> 1] & 0xffff)));
        const float ob = bf2f((bf16_t)((j & 1) ? (bu[j >> 1] >> 16) : (bu[j >> 1] & 0xffff)));
        const float zz = bf2f((bf16_t)((j & 1) ? (zu[j >> 1] >> 16) : (zu[j >> 1] & 0xffff)));
        y[j] = (of + ob + dsk * fsilu(u[j])) * fsilu(zz);
        ss += y[j] * y[j];
      }
#pragma unroll
      for (int of = 32; of >= 1; of >>= 1) ss += __shfl_xor(ss, of);
      const float rstd = rsqrtf(ss * (1.f / 512.f) + 1e-6f);
#pragma unroll
      for (int j = 0; j < 8; ++j) y[j] = y[j] * rstd * p.ssd_norm[l * 512 + c0 + j];
      uint4 ov; ov.x = pk2(y[0], y[1]); ov.y = pk2(y[2], y[3]); ov.z = pk2(y[4], y[5]); ov.w = pk2(y[6], y[7]);
      *(uint4*)(MX + (size_t)r * DI + 1024 + c0) = ov;
    }
  }
}


#define XB_TMO      128
#define XB_XCNT(j)  (256  + 64 * (j))
#define XB_XSUB(j)  (1280 + 64 * (j))
#define XB_XGEN(j)  (2304 + 64 * (j))
#define XB_TOP      3328
#define XB_TOPGEN   3392
#define XB_SPIN_CAP (1u << 22)
#define LAS __attribute__((address_space(3)))
DEV unsigned xb_ld(unsigned* p) { return __hip_atomic_load(p, __ATOMIC_RELAXED, __HIP_MEMORY_SCOPE_AGENT); }
DEV unsigned xb_add(unsigned* p, unsigned v) { return __hip_atomic_fetch_add(p, v, __ATOMIC_RELAXED, __HIP_MEMORY_SCOPE_AGENT); }
DEV unsigned xb_xcc_id() { return (unsigned)__builtin_amdgcn_s_getreg((3 << 11) | 20) & 0xFu; }
#define XB_SPIN(cond, bar) do { unsigned _sp = 0; while (cond) { __builtin_amdgcn_s_sleep(1); \
    if ((++_sp & 255u) == 0u) { if (xb_ld(&(bar)[XB_TMO])) break; if (_sp > XB_SPIN_CAP) { atomicAdd(&(bar)[XB_TMO], 1u); break; } } } } while (0)
struct XcdBarrier { unsigned* bar; unsigned x; volatile LAS unsigned* st; };
DEV XcdBarrier xcd_barrier_post(unsigned* bar, volatile LAS unsigned* st) {
  XcdBarrier b; b.bar = bar; b.x = xb_xcc_id(); b.st = st;
  if (threadIdx.x == 0) (void)xb_add(&bar[XB_XCNT(b.x)], 1u);
  return b;
}
DEV void xcd_barrier_complete(unsigned* bar, unsigned x, unsigned& nloc, unsigned& nx) {
  const unsigned G = gridDim.x * gridDim.y * gridDim.z;
  unsigned sum, cnt, mine, sp = 0u;
  for (;;) {
    sum = 0u; cnt = 0u; mine = 0u;
#pragma unroll
    for (unsigned j = 0; j < 16; ++j) { const unsigned c = xb_ld(&bar[XB_XCNT(j)]); sum += c; cnt += (c > 0u) ? 1u : 0u; mine = (j == x) ? c : mine; }
    if (sum == G) break;
    __builtin_amdgcn_s_sleep(1);
    if ((++sp & 255u) == 0u) { if (xb_ld(&bar[XB_TMO])) break; if (sp > XB_SPIN_CAP) { atomicAdd(&bar[XB_TMO], 1u); break; } }
  }
  nloc = mine > 0u ? mine : 1u; nx = cnt > 0u ? cnt : 1u;
}
DEV void xcd_barrier(const XcdBarrier& b) {
  asm volatile("s_waitcnt vmcnt(0)" ::: "memory");
  __syncthreads();
  if (threadIdx.x == 0) {
    unsigned* bar = b.bar;
    __builtin_amdgcn_s_waitcnt(0);
    unsigned nloc = b.st[0], nx = b.st[1];
    if (nloc == 0u) { xcd_barrier_complete(bar, b.x, nloc, nx); b.st[0] = nloc; b.st[1] = nx; }
    const unsigned old = xb_add(&bar[XB_XSUB(b.x)], 1u);
    const unsigned gen = old / nloc;
    if (old + 1u == (gen + 1u) * nloc) {
      __builtin_amdgcn_fence(__ATOMIC_RELEASE, "agent");
      asm volatile("s_waitcnt vmcnt(0)" ::: "memory");
      const unsigned og = xb_add(&bar[XB_TOP], 1u);
      const unsigned tg = og / nx;
      if (og + 1u == (tg + 1u) * nx) xb_add(&bar[XB_TOPGEN], 1u);
      else XB_SPIN(xb_ld(&bar[XB_TOPGEN]) == tg, bar);
      __builtin_amdgcn_fence(__ATOMIC_ACQUIRE, "agent");
      xb_add(&bar[XB_XGEN(b.x)], 1u);
      asm volatile("s_waitcnt vmcnt(0)" ::: "memory");
    } else {
      XB_SPIN(xb_ld(&bar[XB_XGEN(b.x)]) == gen, bar);
      __builtin_amdgcn_fence(__ATOMIC_ACQUIRE, "agent");
      asm volatile("s_waitcnt vmcnt(0)" ::: "memory");
    }
  }
  __syncthreads();
}

DEV void run_phase(const Params& p, int ph, int rep, unsigned char* smem) {
  if (ph == 0) { if (PH_MASK & 1) { phase_pro(p, smem); convert_weights(p, 0, 3, smem); } return; }
  if (ph == 25) { if (PH_MASK & 16) phase_outproj(p, 1, 1, smem); return; }
  if (ph == 26) { if (PH_MASK & 32) phase_ln(p, 1, 1); return; }
  const int q = ph - 1, blk = q / 6, st = q % 6, l = blk >> 1, hf = blk & 1;
  if (st == 0) {
    if (blk > 0 && (PH_MASK & 16)) phase_outproj(p, (blk - 1) >> 1, (blk - 1) & 1, smem);
    if (PH_MASK & 2) phase_inproj(p, l, hf, blk > 0 ? 16 : 0, smem);
  } else if (st == 1) {
    if (blk > 0 && rep == 0 && (PH_MASK & 32)) phase_ln(p, (blk - 1) >> 1, (blk - 1) & 1);
    if (PH_MASK & 4) phase_prep(p, l, hf, rep, smem);
    if ((PH_MASK & 1) && rep == 0 && blk == 1) convert_weights(p, 1, 1, smem);
    if ((PH_MASK & 1) && rep == 0 && blk == 2) convert_weights(p, 1, 2, smem);
  }
  else if (st == 2) { if (PH_MASK & 0xF00) phase_mix(p, l, hf, ph + 40 * rep, 1, 0, ATT_SPLIT, rep ? PROBE_LO : 0, rep ? PROBE_HI : 100000, smem); }
  else if (st == 3) { if (PH_MASK & 0x700) phase_scan2(p); }
  else if (st == 4) { if (PH_MASK & 0xF00) phase_mix(p, l, hf, ph + 40 * rep, 3, ATT_SPLIT, 256, rep ? PROBE_LO : 0, rep ? PROBE_HI : 100000, smem); }
  else { if (PH_MASK & 8) phase_fin(p, l, hf); }
}
__global__ void __launch_bounds__(NT) mega(Params p) {
  extern __shared__ __attribute__((aligned(16))) unsigned char smem[];
#if ONE_LAUNCH
  volatile LAS unsigned* xst = (volatile LAS unsigned*)(smem + LDS_BYTES - 32);
  if (threadIdx.x == 0) { xst[0] = 0u; xst[1] = 0u; }
  __syncthreads();
  XcdBarrier xb = xcd_barrier_post((unsigned*)(p.ws + OFF_CTRL), xst);
#endif
  Params* lp = (Params*)(smem + 147456);
  if (threadIdx.x == 0) *lp = p;
  __syncthreads();
  const int ph_begin = p.phase_begin, ph_end = p.phase_end;
  for (int ph = ph_begin; ph < ph_end; ++ph) {
    int nrep = 0;
#if PROBE_REP > 0
    {
      const int q = ph - 1, st = q % 6;
      const bool idem = (ph >= 1 && ph <= 24) && (st == PROBE_ST) && (st >= 1);
      if (idem) nrep = PROBE_REP;
    }
#endif
    for (int r = 0; r <= nrep; ++r) {
      run_phase(*lp, ph, r, smem);
#if ONE_LAUNCH
      if (r < nrep || ph + 1 < ph_end) xcd_barrier(xb);
#endif
    }
  }
}

extern "C" void kernel_launch(void* const* d_in, const int* in_sizes, int n_in, void* d_out, int out_size, void* d_ws, size_t ws_size,
                              hipStream_t stream) {
  static int grid_blocks = 0;
  if (!grid_blocks) {
    int dev = 0, cus = 0, per_cu = 0;
    hipGetDevice(&dev);
    hipDeviceGetAttribute(&cus, hipDeviceAttributeMultiprocessorCount, dev);
    hipFuncSetAttribute((const void*)mega, hipFuncAttributeMaxDynamicSharedMemorySize, LDS_BYTES);
    hipOccupancyMaxActiveBlocksPerMultiprocessor(&per_cu, mega, NT, LDS_BYTES);
    if (per_cu < 1) per_cu = 1;
    grid_blocks = cus;
  }
  Params p{};
  p.x = (const float*)d_in[0]; p.w_in = (const float*)d_in[1]; p.q_gain = (const float*)d_in[2]; p.k_gain = (const float*)d_in[3];
  p.lb_logits = (const float*)d_in[4]; p.hgrn_norm = (const float*)d_in[5]; p.conv_w = (const float*)d_in[6]; p.conv_b = (const float*)d_in[7];
  p.dt_bias = (const float*)d_in[8]; p.a_log = (const float*)d_in[9]; p.ssd_d = (const float*)d_in[10]; p.ssd_norm = (const float*)d_in[11];
  p.gk_w2 = (const float*)d_in[12]; p.gk_b = (const float*)d_in[13]; p.gla_norm = (const float*)d_in[14]; p.w_out = (const float*)d_in[15];
  p.ln_g = (const float*)d_in[16]; p.ln_b = (const float*)d_in[17];
  p.out = (float*)d_out; p.ws = (unsigned char*)d_ws;
  hipMemsetAsync(d_ws, 0, CTRL_BYTES, stream);
#if ONE_LAUNCH
  p.phase_begin = 0; p.phase_end = NPHASE;
  void* args[] = {&p};
  (void)args;
  hipLaunchKernelGGL(mega, dim3(grid_blocks), dim3(NT), LDS_BYTES, stream, p);
#else
  for (int ph = 0; ph < NPHASE; ++ph) {
    p.phase_begin = ph; p.phase_end = ph + 1;
    hipLaunchKernelGGL(mega, dim3(grid_blocks), dim3(NT), LDS_BYTES, stream, p);
  }
#endif
}
```

```cpp
#include <hip/hip_runtime.h>
#include <hip/hip_cooperative_groups.h>
#include <stdint.h>
#include <stdio.h>
namespace cg = cooperative_groups;

#ifndef ONE_LAUNCH
#define ONE_LAUNCH 1
#endif

#ifndef PH_MASK
#define PH_MASK 0xFFF
#endif
#ifndef PROBE_ST
#define PROBE_ST -1
#endif
#ifndef PROBE_REP
#define PROBE_REP 0
#endif
#ifndef PROBE_TYPE
#define PROBE_TYPE -1
#endif
#ifndef PROBE_LO
#define PROBE_LO 0
#endif
#ifndef PROBE_HI
#define PROBE_HI 100000
#endif
#define DEV __device__ __forceinline__
typedef unsigned short bf16_t;
typedef short bf16x8 __attribute__((ext_vector_type(8)));
typedef float f32x16 __attribute__((ext_vector_type(16)));
typedef unsigned u32x4 __attribute__((ext_vector_type(4)));
typedef float f32x4 __attribute__((ext_vector_type(4)));

constexpr int NT = 512;
constexpr int T_ALL = 16384, TH = 8192, SEQ = 4096, DM = 1024, NPAD = 7168, DI = 2048, NIN = 6960;
constexpr int A_Q = 0, A_K = 512, A_V = 640, A_Z = 768, H_Q = 1280, H_FF = 1792, H_FB = 2304, H_I = 2816, H_Z = 3328,
              S_X = 3840, S_Z = 4864, G_Q = 5376, G_K = 5632, G_V = 5888, G_Z = 6400, SM0 = 6912;
constexpr size_t OFF_CTRL = 0, OFF_TAB = 65536, OFF_XB = 131072;
constexpr size_t OFF_WIN = OFF_XB + (size_t)T_ALL * DM * 2;
constexpr size_t OFF_WOUT = OFF_WIN + (size_t)NPAD * DM * 2;
constexpr size_t OFF_H = OFF_WOUT + (size_t)DM * DI * 2;
constexpr size_t OFF_SMALL = OFF_H + (size_t)TH * NPAD * 2;
constexpr size_t OFF_OBUF = OFF_SMALL + (size_t)TH * 48 * 4;
constexpr size_t OFF_VT = OFF_OBUF + (size_t)6 * TH * 512 * 2;
constexpr size_t OFF_DB = OFF_VT + (size_t)2 * 2 * 64 * SEQ * 2;
constexpr int NSEG = 4, SLEN = 64 / NSEG;
constexpr size_t OFF_MIXED = OFF_DB + (size_t)64 * NSEG * 128 * 4;
constexpr size_t OFF_SB0 = OFF_MIXED, OFF_SB1 = OFF_SB0 + (size_t)16 * NSEG * 16384 * 4, OFF_SB2 = OFF_SB1 + (size_t)16 * NSEG * 8192 * 4;
constexpr size_t OFF_U = OFF_SB2 + (size_t)32 * NSEG * 8192 * 4;
constexpr size_t OFF_G = OFF_U + (size_t)TH * 1024 * 2;
constexpr size_t WS_END = (OFF_G + (size_t)TH * 512 * 2 > OFF_MIXED + (size_t)TH * DI * 2) ? (OFF_G + (size_t)TH * 512 * 2) : (OFF_MIXED + (size_t)TH * DI * 2);
static_assert(OFF_MIXED + (size_t)TH * DI * 2 <= WS_END, "MIXED must fit");
static_assert(WS_END <= 268435456, "workspace");
constexpr size_t CTRL_BYTES = 65536;
constexpr int CTR_WORD0 = 4096;
constexpr int LDS_BYTES = 148480;
constexpr float LOG2E = 1.4426950408889634f;
constexpr float QSCALE = 0.125f * LOG2E;
constexpr float DN_ALPHA = 1.4142135623730951f;
constexpr int NPHASE = 27;
constexpr int ATT_SPLIT = 144;

struct Params {
  const float* x; const float* w_in; const float* q_gain; const float* k_gain; const float* lb_logits; const float* hgrn_norm;
  const float* conv_w; const float* conv_b; const float* dt_bias; const float* a_log; const float* ssd_d; const float* ssd_norm;
  const float* gk_w2; const float* gk_b; const float* gla_norm; const float* w_out; const float* ln_g; const float* ln_b;
  float* out; unsigned char* ws;
  int phase_begin, phase_end;
};

DEV void lds_barrier() { asm volatile("s_waitcnt lgkmcnt(0)" ::: "memory"); __builtin_amdgcn_s_barrier(); asm volatile("" ::: "memory"); }
DEV int launder(int v) { asm volatile("" : "+v"(v)); return v; }
DEV float bf2f(bf16_t v) { return __uint_as_float(((unsigned)v) << 16); }
DEV bf16_t f2bf(float f) { unsigned u = __float_as_uint(f); u += 0x7fffu + ((u >> 16) & 1u); return (bf16_t)(u >> 16); }
typedef __bf16 bf16x2_t __attribute__((ext_vector_type(2)));
typedef float f32x2_t __attribute__((ext_vector_type(2)));
DEV unsigned pk2(float lo, float hi) { const f32x2_t f = {lo, hi}; const bf16x2_t b = __builtin_convertvector(f, bf16x2_t); return __builtin_bit_cast(unsigned, b); }
DEV float fsigmoid(float x) { return 1.f / (1.f + __expf(-x)); }
DEV float fsilu(float x) { return x / (1.f + __expf(-x)); }
DEV unsigned cvtpk(float lo, float hi) { return pk2(lo, hi); }
DEV float ex2(float x) { return __builtin_amdgcn_exp2f(x); }
DEV float lg2(float x) { return __builtin_amdgcn_logf(x); }
DEV float frcp(float x) { return __builtin_amdgcn_rcpf(x); }
DEV float lo16(unsigned u) { return __uint_as_float(u << 16); }
DEV float hi16(unsigned u) { return __uint_as_float(u & 0xffff0000u); }
DEV int rowoff(int reg, int h) { return (reg & 3) + 8 * (reg >> 2) + 4 * h; }
DEV f32x16 zero16() { f32x16 z;
#pragma unroll
  for (int i = 0; i < 16; ++i) z[i] = 0.f; return z; }

template <int KD>
DEV void mma32(f32x16& acc, const bf16_t* a, int lda, const bf16_t* b, int ldb, int lane) {
  const int r = lane & 31, h = lane >> 5;
  const bf16_t* ap = a + r * lda + 8 * h;
  const bf16_t* bp = b + r * ldb + 8 * h;
#pragma unroll 4
  for (int k = 0; k < KD; k += 16) {
    bf16x8 av = *(const bf16x8*)(ap + k);
    bf16x8 bv = *(const bf16x8*)(bp + k);
    acc = __builtin_amdgcn_mfma_f32_32x32x16_bf16(av, bv, acc, 0, 0, 0);
  }
}

DEV int orig_col(int n) {
  if (n < 4864) return n;
  if (n < 6400) return n + 16;
  if (n < 6912) return n + 48;
  if (n < 6928) return n - 2048;
  if (n < 6960) return n - 512;
  return -1;
}

DEV void convert_weights(const Params& p, int l, int which, unsigned char* smem) {
  float* s = (float*)smem;
  const int tid = launder(threadIdx.x);
  const float* win = p.w_in + (size_t)l * DM * NIN;
  const float* wout = p.w_out + (size_t)l * DI * DM;
  bf16_t* wint = (bf16_t*)(p.ws + OFF_WIN);
  bf16_t* woutt = (bf16_t*)(p.ws + OFF_WOUT);
  const int n_in_tiles = (NPAD / 64) * (DM / 64);
  const int n_out_tiles = (DM / 64) * (DI / 64);
  const int it_lo = (which & 1) ? 0 : n_in_tiles, it_hi = (which & 2) ? (n_in_tiles + n_out_tiles) : n_in_tiles;
  for (int it = it_lo + blockIdx.x; it < it_hi; it += gridDim.x) {
    lds_barrier();
    if (it < n_in_tiles) {
      const int n0 = (it / 16) * 64, k0 = (it % 16) * 64;
#pragma unroll
      for (int e = 0; e < 8; ++e) {
        const int idx = e * NT + tid, kk = idx >> 6, nn = idx & 63;
        const int oc = orig_col(n0 + nn);
        s[kk * 65 + nn] = (oc >= 0) ? win[(size_t)(k0 + kk) * NIN + oc] : 0.f;
      }
      lds_barrier();
      const int n = tid >> 3, kc = (tid & 7) * 8;
      uint4 o;
      o.x = pk2(s[(kc + 0) * 65 + n], s[(kc + 1) * 65 + n]); o.y = pk2(s[(kc + 2) * 65 + n], s[(kc + 3) * 65 + n]);
      o.z = pk2(s[(kc + 4) * 65 + n], s[(kc + 5) * 65 + n]); o.w = pk2(s[(kc + 6) * 65 + n], s[(kc + 7) * 65 + n]);
      *(uint4*)(wint + (size_t)(n0 + n) * DM + k0 + kc) = o;
    } else {
      const int j = it - n_in_tiles;
      const int n0 = (j / 32) * 64, k0 = (j % 32) * 64;
#pragma unroll
      for (int e = 0; e < 8; ++e) {
        const int idx = e * NT + tid, kk = idx >> 6, nn = idx & 63;
        s[kk * 65 + nn] = wout[(size_t)(k0 + kk) * DM + n0 + nn];
      }
      lds_barrier();
      const int n = tid >> 3, kc = (tid & 7) * 8;
      uint4 o;
      o.x = pk2(s[(kc + 0) * 65 + n], s[(kc + 1) * 65 + n]); o.y = pk2(s[(kc + 2) * 65 + n], s[(kc + 3) * 65 + n]);
      o.z = pk2(s[(kc + 4) * 65 + n], s[(kc + 5) * 65 + n]); o.w = pk2(s[(kc + 6) * 65 + n], s[(kc + 7) * 65 + n]);
      *(uint4*)(woutt + (size_t)(n0 + n) * DI + k0 + kc) = o;
    }
  }
  lds_barrier();
}

DEV void fsincos(float x, float& s, float& c) {
  const float k = rintf(x * 0.63661977236758134308f);
  float r = fmaf(-k, 1.5707855225e+00f, x);
  r = fmaf(-k, 1.0804273188e-05f, r);
  r = fmaf(-k, 6.0770999344e-11f, r);
  const float r2 = r * r;
  float ps = fmaf(r2, 2.7557319224e-06f, -1.9841269841e-04f);
  ps = fmaf(ps, r2, 8.3333333333e-03f); ps = fmaf(ps, r2, -1.6666666667e-01f);
  const float sinr = fmaf(ps * r2, r, r);
  float pc = fmaf(r2, -2.7557319224e-07f, 2.4801587302e-05f);
  pc = fmaf(pc, r2, -1.3888888889e-03f); pc = fmaf(pc, r2, 4.1666666667e-02f); pc = fmaf(pc, r2, -0.5f);
  const float cosr = fmaf(pc, r2, 1.0f);
  const int q = ((int)k) & 3;
  if (q == 0) { s = sinr; c = cosr; }
  else if (q == 1) { s = cosr; c = -sinr; }
  else if (q == 2) { s = -sinr; c = -cosr; }
  else { s = -cosr; c = sinr; }
}

DEV void phase_pro(const Params& p, unsigned char* smem) {
  const int tid = launder(threadIdx.x);
  const size_t gtid = (size_t)blockIdx.x * NT + tid, gsz = (size_t)gridDim.x * NT;
  const float4* x4 = (const float4*)p.x;
  uint4* xb4 = (uint4*)(p.ws + OFF_XB);
  for (size_t i = gtid; i < (size_t)T_ALL * DM / 8; i += gsz) {
    const float4 a = x4[2 * i], b = x4[2 * i + 1];
    uint4 o; o.x = pk2(a.x, a.y); o.y = pk2(a.z, a.w); o.z = pk2(b.x, b.y); o.w = pk2(b.z, b.w);
    xb4[i] = o;
  }
  if (blockIdx.x == 0) {
    float2* tab = (float2*)(p.ws + OFF_TAB);
    for (int i = tid; i < 64 * 16; i += NT) {
      const int pos = i >> 4, fi = i & 15;
      const float invf = exp2f(-(float)fi * (13.287712379549449f / 16.0f));
      const float ang = (float)pos * invf;
      float sn, cs; fsincos(ang, sn, cs);
      tab[i] = make_float2(cs, sn);
    }
  }
}

namespace pg8 {
#define PG8_LAS __attribute__((address_space(3)))
typedef unsigned short bf16_t;
typedef short bf16x8 __attribute__((ext_vector_type(8)));
typedef float f32x4 __attribute__((ext_vector_type(4)));
typedef unsigned u32x4 __attribute__((ext_vector_type(4)));
constexpr int BM = 256, BK = 64, HALF = 128, HTB = HALF * BK * 2  , STAGE_BYTES = 8 * HTB, NXCD = 8, WGM = 8;

__host__ __device__ __forceinline__ int lds_byte(int r, int c) { const int st = (r >> 4) * 2 + (c >> 5), rr = r & 15, cc = c & 31, ob = rr * 64 + cc * 2; return st * 1024 + (ob ^ (((ob >> 9) & 1) << 5)); }
__host__ __device__ __forceinline__ void stage_rc(int b, int& R, int& C) { const int st = b / 1024, sb = b % 1024, swz = sb ^ (((sb >> 9) & 1) << 5); R = (st >> 1) * 16 + swz / 64; C = (st & 1) * 32 + (swz % 64) / 2; }
__host__ __device__ __forceinline__ int perm32(int rho) { const int n = rho >> 4, i = rho & 15; return 8 * (i >> 2) + 4 * n + (i & 3); }

struct Unit { int pm, pn; };
struct Gemm { const bf16_t* A; const bf16_t* Bt; int M, N, K; };

__device__ __forceinline__ unsigned cvt_pk_bf16(float lo, float hi) { unsigned r; asm volatile("v_cvt_pk_bf16_f32 %0, %1, %2" : "=v"(r) : "v"(lo), "v"(hi)); return r; }

struct XcdOrder {
    int rpx, nN, x, c, ncu, skew;
    __device__ void init(int M, int N, int skew_ = 0) { rpx = (M / BM) / NXCD; nN = N / BM; x = blockIdx.x & 7; c = blockIdx.x >> 3; ncu = gridDim.x >> 3; skew = skew_; }
    __device__ bool next(int i, Unit& u) const {
        const int total = rpx * nN, full = (total / ncu) * ncu;
        int j = c + i * ncu;
        if (skew > 0 && j >= full) { const int cc = c - skew; j = (cc >= 0 && i == total / ncu) ? full + cc : total; }
        if (j >= total) return false; u.pm = rpx * x + (j % rpx); u.pn = j / rpx; return true; }
    __device__ __forceinline__ void a_ready(const Unit&) const {}
    __device__ __forceinline__ void done(const Unit&) const {}
};
struct EpiIn {
    static constexpr bool PERM = true, AFTER_DRAIN = false;
    bf16_t* O; int ldc; float* small; int small_pn;
    __device__ __forceinline__ void operator()(const f32x4 (&acc)[2][2][4][2], const Unit& u, int wr, int wc, int fr, int fq) const {
        const int row0 = u.pm * BM + wr * 64 + fr, col0 = u.pn * BM + wc * 32 + 8 * fq;
        if (u.pn == small_pn) {
            const int c = wc * 32 + 8 * fq;
            if (c < 48) {
#pragma unroll
                for (int ai = 0; ai < 2; ++ai)
#pragma unroll
                    for (int m = 0; m < 4; ++m) { float* rp = small + (size_t)(row0 + ai * HALF + m * 16) * 48 + c; *(f32x4*)rp = acc[ai][0][m][0]; *(f32x4*)(rp + 4) = acc[ai][0][m][1]; }
            }
            return;
        }
#pragma unroll
        for (int ai = 0; ai < 2; ++ai)
#pragma unroll
            for (int m = 0; m < 4; ++m) { bf16_t* rowp = O + (size_t)(row0 + ai * HALF + m * 16) * ldc + col0;
#pragma unroll
                for (int bj = 0; bj < 2; ++bj) { const f32x4 v0 = acc[ai][bj][m][0], v1 = acc[ai][bj][m][1];
                    u32x4 w; w.x = cvt_pk_bf16(v0[0], v0[1]); w.y = cvt_pk_bf16(v0[2], v0[3]); w.z = cvt_pk_bf16(v1[0], v1[1]); w.w = cvt_pk_bf16(v1[2], v1[3]);
                    *(u32x4*)(rowp + bj * HALF) = w; } }
    }
};
struct EpiOut {
    static constexpr bool PERM = true, AFTER_DRAIN = false;
    const float* X; float* Y; int ldc; float alpha;
    __device__ __forceinline__ void operator()(const f32x4 (&acc)[2][2][4][2], const Unit& u, int wr, int wc, int fr, int fq) const {
        const int row0 = u.pm * BM + wr * 64 + fr, col0 = u.pn * BM + wc * 32 + 8 * fq;
#pragma unroll
        for (int ai = 0; ai < 2; ++ai)
#pragma unroll
            for (int m = 0; m < 4; ++m) { const size_t off = (size_t)(row0 + ai * HALF + m * 16) * ldc + col0;
#pragma unroll
                for (int bj = 0; bj < 2; ++bj) { const f32x4 x0 = *(const f32x4*)(X + off + bj * HALF), x1 = *(const f32x4*)(X + off + bj * HALF + 4);
                    *(f32x4*)(Y + off + bj * HALF) = x0 * alpha + acc[ai][bj][m][0]; *(f32x4*)(Y + off + bj * HALF + 4) = x1 * alpha + acc[ai][bj][m][1]; } }
    }
};

template <class Epi, class Sched, bool ALIGN_EPI = false, bool SP2 = false>
__device__ __forceinline__ void gemm_phase(PG8_LAS unsigned char* lds, const Gemm g, const Sched& S, const Epi& E) {
    const int tid = launder((int)threadIdx.x), wid = __builtin_amdgcn_readfirstlane(tid >> 6), lane = tid & 63, wr = wid >> 2, wc = wid & 3, fr = lane & 15, fq = lane >> 4;
    const int K = g.K, nt = K / BK;
    unsigned voffA[2], voffB[2];
#pragma unroll
    for (int i = 0; i < 2; ++i) { int R, C; stage_rc(tid * 16 + i * 8192, R, C); const int Rb = Epi::PERM ? ((R & ~31) + perm32(R & 31)) : R;
        voffA[i] = (unsigned)(R * K + C) * 2u; voffB[i] = (unsigned)(Rb * K + C) * 2u; }
    const size_t kstep = (size_t)(BK * 2);
    const size_t hstep = (size_t)HALF * K * 2;
    const size_t tstep = 2 * hstep;
    const unsigned ldsw = (unsigned)wid * 1024u;
    const int aoff = lds_byte(wr * 64 + fr, fq * 8), boff = lds_byte(wc * 32 + fr, fq * 8);
#define PG8_SA(b, h) (((b) * 2 + (h)) * HTB)
#define PG8_SB(b, h) ((4 + (b) * 2 + (h)) * HTB)
#define PG8_STAGE(bufoff, gbase, voff) do { _Pragma("unroll") for (int _i = 0; _i < 2; ++_i) \
        __builtin_amdgcn_global_load_lds((const unsigned*)((const char*)(gbase) + (voff)[_i]), (PG8_LAS unsigned*)(lds + (bufoff) + ldsw + _i * 8192), 16, 0, 0); } while (0)
#define PG8_LDA(dst, b, h) do { _Pragma("unroll") for (int m = 0; m < 4; ++m) _Pragma("unroll") for (int k = 0; k < 2; ++k) dst[m][k] = *(const PG8_LAS bf16x8*)(lds + PG8_SA(b, h) + aoff + m * 2048 + k * 1024); } while (0)
#define PG8_LDB(dst, b, h) do { _Pragma("unroll") for (int n = 0; n < 2; ++n) _Pragma("unroll") for (int k = 0; k < 2; ++k) dst[n][k] = *(const PG8_LAS bf16x8*)(lds + PG8_SB(b, h) + boff + n * 2048 + k * 1024); } while (0)
#define PG8_MMA(ai, bj, At, Bt) do { __builtin_amdgcn_s_setprio(1); _Pragma("unroll") for (int m = 0; m < 4; ++m) _Pragma("unroll") for (int n = 0; n < 2; ++n) _Pragma("unroll") for (int k = 0; k < 2; ++k) \
        acc[ai][bj][m][n] = __builtin_amdgcn_mfma_f32_16x16x32_bf16(Bt[n][k], At[m][k], acc[ai][bj][m][n], 0, 0, 0); __builtin_amdgcn_s_setprio(0); } while (0)
#define PG8_WAIT_V(n) asm volatile("s_waitcnt vmcnt(" #n ")" ::: "memory")
#define PG8_WAIT_L(n) asm volatile("s_waitcnt lgkmcnt(" #n ")" ::: "memory")
#define PG8_BAR __builtin_amdgcn_s_barrier()
#define PG8_SCHED __builtin_amdgcn_sched_barrier(0)
    Unit cur, nxt; int ui = 0;
    if (!S.next(0, cur)) return;
    f32x4 acc[2][2][4][2];
#pragma unroll
    for (int a = 0; a < 2; ++a)
#pragma unroll
        for (int b = 0; b < 2; ++b)
#pragma unroll
            for (int m = 0; m < 4; ++m)
#pragma unroll
                for (int n = 0; n < 2; ++n) acc[a][b][m][n] = (f32x4){0.f, 0.f, 0.f, 0.f};
    bf16x8 At[4][2], B0[2][2], B1[2][2];
    const char* cA = (const char*)g.A + (size_t)cur.pm * tstep; const char* cB = (const char*)g.Bt + (size_t)cur.pn * tstep;
    S.a_ready(cur);
    if constexpr (SP2) {
        PG8_STAGE(PG8_SB(0, 0), cB, voffB); PG8_STAGE(PG8_SB(0, 1), cB + hstep, voffB); PG8_STAGE(PG8_SA(0, 0), cA, voffA); PG8_STAGE(PG8_SA(0, 1), cA + hstep, voffA);
        if (wr == 1) PG8_BAR;
        PG8_WAIT_V(2); PG8_BAR;
        PG8_STAGE(PG8_SB(1, 0), cB + kstep, voffB); PG8_STAGE(PG8_SA(1, 0), cA + kstep, voffA); PG8_STAGE(PG8_SB(1, 1), cB + hstep + kstep, voffB);
        PG8_WAIT_V(6); PG8_BAR;
    } else {
        PG8_STAGE(PG8_SB(0, 0), cB, voffB); PG8_STAGE(PG8_SA(0, 0), cA, voffA); PG8_STAGE(PG8_SB(0, 1), cB + hstep, voffB); PG8_STAGE(PG8_SA(0, 1), cA + hstep, voffA);
        if (wr == 1) PG8_BAR;
        PG8_WAIT_V(4); PG8_BAR;
        PG8_STAGE(PG8_SB(1, 0), cB + kstep, voffB); PG8_STAGE(PG8_SA(1, 0), cA + kstep, voffA); PG8_STAGE(PG8_SB(1, 1), cB + hstep + kstep, voffB);
        PG8_WAIT_V(6); PG8_BAR;
    }
    for (;;) {
        const bool has_next = S.next(ui + 1, nxt);
        const char* nA = has_next ? (const char*)g.A + (size_t)nxt.pm * tstep : cA; const char* nB = has_next ? (const char*)g.Bt + (size_t)nxt.pn * tstep : cB;
        for (int t = 0; t < nt; t += 2) {
            const bool last = (t == nt - 2);
            const char* a1 = cA + (size_t)(t + 1) * kstep;
            const char* a2 = last ? nA : cA + (size_t)(t + 2) * kstep; const char* b2 = last ? nB : cB + (size_t)(t + 2) * kstep;
            const char* a3 = a2 + kstep; const char* b3 = b2 + kstep;
            if (last && has_next) S.a_ready(nxt);
            if constexpr (SP2) {
            PG8_LDB(B0, 0, 0); PG8_LDB(B1, 0, 1); PG8_SCHED; PG8_LDA(At, 0, 0); PG8_STAGE(PG8_SA(1, 1), a1 + hstep, voffA);
            PG8_WAIT_V(8); PG8_WAIT_L(0); PG8_BAR; PG8_MMA(0, 0, At, B0); PG8_MMA(0, 1, At, B1); PG8_BAR; PG8_SCHED;
            PG8_LDA(At, 0, 1); PG8_STAGE(PG8_SB(0, 0), b2, voffB); PG8_STAGE(PG8_SB(0, 1), b2 + hstep, voffB); PG8_STAGE(PG8_SA(0, 0), a2, voffA);
            PG8_WAIT_V(8); PG8_WAIT_L(0); PG8_BAR; PG8_MMA(1, 0, At, B0); PG8_MMA(1, 1, At, B1); PG8_BAR; PG8_SCHED;
            PG8_LDB(B0, 1, 0); PG8_LDB(B1, 1, 1); PG8_SCHED; PG8_LDA(At, 1, 0); PG8_STAGE(PG8_SA(0, 1), a2 + hstep, voffA);
            PG8_WAIT_V(8); PG8_WAIT_L(0); PG8_BAR; PG8_MMA(0, 0, At, B0); PG8_MMA(0, 1, At, B1); PG8_BAR; PG8_SCHED;
            PG8_LDA(At, 1, 1); PG8_STAGE(PG8_SB(1, 0), b3, voffB); PG8_STAGE(PG8_SB(1, 1), b3 + hstep, voffB); PG8_STAGE(PG8_SA(1, 0), a3, voffA);
            PG8_WAIT_V(8); PG8_WAIT_L(0); PG8_BAR; PG8_MMA(1, 0, At, B0); PG8_MMA(1, 1, At, B1); PG8_BAR; PG8_SCHED;
            } else {
            PG8_LDB(B0, 0, 0); PG8_SCHED; PG8_LDA(At, 0, 0); PG8_STAGE(PG8_SA(1, 1), a1 + hstep, voffA);
            PG8_WAIT_L(8); PG8_BAR; PG8_WAIT_L(0); PG8_MMA(0, 0, At, B0); PG8_BAR; PG8_SCHED;
            PG8_LDB(B1, 0, 1); PG8_STAGE(PG8_SB(0, 0), b2, voffB);
            PG8_BAR; PG8_WAIT_L(0); PG8_MMA(0, 1, At, B1); PG8_BAR;
            PG8_LDA(At, 0, 1); PG8_STAGE(PG8_SA(0, 0), a2, voffA);
            PG8_BAR; PG8_WAIT_L(0); PG8_MMA(1, 0, At, B0); PG8_BAR; PG8_SCHED;
            PG8_STAGE(PG8_SB(0, 1), b2 + hstep, voffB);
            PG8_WAIT_V(6); PG8_BAR; PG8_MMA(1, 1, At, B1); PG8_BAR;
            PG8_LDB(B0, 1, 0); PG8_SCHED; PG8_LDA(At, 1, 0); PG8_STAGE(PG8_SA(0, 1), a2 + hstep, voffA);
            PG8_WAIT_L(8); PG8_BAR; PG8_WAIT_L(0); PG8_MMA(0, 0, At, B0); PG8_BAR; PG8_SCHED;
            PG8_LDB(B1, 1, 1); PG8_STAGE(PG8_SB(1, 0), b3, voffB);
            PG8_BAR; PG8_WAIT_L(0); PG8_MMA(0, 1, At, B1); PG8_BAR;
            PG8_LDA(At, 1, 1); PG8_STAGE(PG8_SA(1, 0), a3, voffA);
            PG8_BAR; PG8_WAIT_L(0); PG8_MMA(1, 0, At, B0); PG8_BAR; PG8_SCHED;
            PG8_STAGE(PG8_SB(1, 1), b3 + hstep, voffB);
            PG8_WAIT_V(6); PG8_BAR; PG8_MMA(1, 1, At, B1); PG8_BAR;
            }
        }
        if constexpr (ALIGN_EPI) { if (wr == 0) PG8_BAR; }
        if constexpr (!Epi::AFTER_DRAIN) { E(acc, cur, wr, wc, fr, fq); S.done(cur); }
        if (!has_next) break;
#pragma unroll
        for (int a = 0; a < 2; ++a)
#pragma unroll
            for (int b = 0; b < 2; ++b)
#pragma unroll
                for (int m = 0; m < 4; ++m)
#pragma unroll
                    for (int n = 0; n < 2; ++n) acc[a][b][m][n] = (f32x4){0.f, 0.f, 0.f, 0.f};
        cur = nxt; cA = nA; cB = nB; ++ui;
        if constexpr (ALIGN_EPI) { if (wr == 1) PG8_BAR; }
    }
    PG8_WAIT_V(0);
    if constexpr (!ALIGN_EPI) { if (wr == 0) PG8_BAR; }
    PG8_BAR;
    if constexpr (Epi::AFTER_DRAIN) { E.fused(acc, cur, wr, wc, fr, fq, lds, wid, lane); S.done(cur); }
#undef PG8_SA
#undef PG8_SB
#undef PG8_STAGE
#undef PG8_LDA
#undef PG8_LDB
#undef PG8_MMA
#undef PG8_WAIT_V
#undef PG8_WAIT_L
#undef PG8_BAR
#undef PG8_SCHED
}
}

DEV void phase_inproj(const Params& p, int l, int hf, int skew, unsigned char* smem) {
  pg8::Gemm g{(const bf16_t*)(p.ws + OFF_XB) + (size_t)hf * TH * DM, (const bf16_t*)(p.ws + OFF_WIN), TH, NPAD, DM};
  pg8::XcdOrder S; S.init(TH, NPAD, skew);
  pg8::EpiIn E{(bf16_t*)(p.ws + OFF_H), NPAD, (float*)(p.ws + OFF_SMALL), SM0 / 256};
  pg8::gemm_phase<pg8::EpiIn, pg8::XcdOrder, true, true>((PG8_LAS unsigned char*)smem, g, S, E);
}

DEV void phase_outproj(const Params& p, int l, int hf, unsigned char* smem) {
  pg8::Gemm g{(const bf16_t*)(p.ws + OFF_MIXED), (const bf16_t*)(p.ws + OFF_WOUT), TH, DM, DI};
  pg8::XcdOrder S; S.init(TH, DM);
  const float* xin = ((l == 0) ? p.x : p.out) + (size_t)hf * TH * DM;
  pg8::EpiOut E{xin, p.out + (size_t)hf * TH * DM, DM, DN_ALPHA};
  pg8::gemm_phase<pg8::EpiOut, pg8::XcdOrder, true, true>((PG8_LAS unsigned char*)smem, g, S, E);
}

DEV void phase_ln(const Params& p, int l, int hf) {
  const int tid = launder(threadIdx.x), lane = tid & 63, w = tid >> 6;
  const float* g = p.ln_g + l * DM; const float* b = p.ln_b + l * DM;
  bf16_t* xb = (bf16_t*)(p.ws + OFF_XB);
  for (int r0 = (blockIdx.x * 8 + w) * 4; r0 < TH; r0 += gridDim.x * 32) {
    f32x4 v[4][4];
#pragma unroll
    for (int i = 0; i < 4; ++i)
#pragma unroll
      for (int j = 0; j < 4; ++j) v[i][j] = ((const f32x4*)(p.out + (size_t)(hf * TH + r0 + i) * DM))[j * 64 + lane];
    f32x4 gg[4], bb[4];
#pragma unroll
    for (int j = 0; j < 4; ++j) { gg[j] = ((const f32x4*)g)[j * 64 + lane]; bb[j] = ((const f32x4*)b)[j * 64 + lane]; }
#pragma unroll
    for (int i = 0; i < 4; ++i) {
      const int row = hf * TH + r0 + i;
      float sm = 0.f;
#pragma unroll
      for (int j = 0; j < 4; ++j) sm += (v[i][j][0] + v[i][j][1]) + (v[i][j][2] + v[i][j][3]);
#pragma unroll
      for (int o = 32; o >= 1; o >>= 1) sm += __shfl_xor(sm, o);
      const float mu = sm * (1.f / DM);
      float q = 0.f;
#pragma unroll
      for (int j = 0; j < 4; ++j) { const f32x4 d = v[i][j] - mu; q += (d[0] * d[0] + d[1] * d[1]) + (d[2] * d[2] + d[3] * d[3]); }
#pragma unroll
      for (int o = 32; o >= 1; o >>= 1) q += __shfl_xor(q, o);
      const float rstd = rsqrtf(q * (1.f / DM) + 1e-5f);
#pragma unroll
      for (int j = 0; j < 4; ++j) {
        const f32x4 o = (v[i][j] - mu) * rstd * gg[j] + bb[j];
        ((f32x4*)(p.out + (size_t)row * DM))[j * 64 + lane] = o;
        if (l == 0) *(uint2*)(xb + (size_t)row * DM + (j * 64 + lane) * 4) = make_uint2(pk2(o[0], o[1]), pk2(o[2], o[3]));
      }
    }
  }
}

DEV void attn_item(const Params& p, int l, int item, unsigned char* smem) {
  const int tid = launder(threadIdx.x), lane = tid & 63, w = tid >> 6, r = lane & 31, h = lane >> 5;
  const int qt = item & 15, head = (item >> 4) & 7, bl = item >> 7;
  const int kvh = head >> 2;
  bf16_t* Hh = (bf16_t*)(p.ws + OFF_H);
  const bf16_t* VT = (const bf16_t*)(p.ws + OFF_VT);
  const size_t rowbase = (size_t)bl * SEQ;
  float mq = fabsf(p.q_gain[l * 64 + lane]), mk = fabsf(p.k_gain[l * 64 + lane]);
#pragma unroll
  for (int o = 32; o >= 1; o >>= 1) { mq = fmaxf(mq, __shfl_xor(mq, o)); mk = fmaxf(mk, __shfl_xor(mk, o)); }
  const float M2 = 8.f * mq * mk * LOG2E * 1.01f;
  const int qrow = qt * 256 + w * 32 + r;
  const bf16_t* qp = Hh + (rowbase + qrow) * NPAD + A_Q + head * 64 + 8 * h;
  bf16x8 qf[4];
#pragma unroll
  for (int ks = 0; ks < 4; ++ks) qf[ks] = *(const bf16x8*)(qp + ks * 16);
  f32x16 o0 = zero16(), o1 = zero16();
  float lsum = 0.f;
  const int srow = tid >> 3, sch = (tid & 7) * 8;
  const bf16_t* kp = Hh + (rowbase + srow) * NPAD + A_K + kvh * 64 + sch;
  const bf16_t* vp = VT + ((size_t)((bl * 2 + kvh) * 64 + srow)) * SEQ + sch;
  union PB { bf16x8 v; unsigned u[4]; };
  auto qk = [&](int st, f32x16& s0, f32x16& s1) __attribute__((always_inline)) {
    const bf16_t* sK = (const bf16_t*)(smem + st * 18432);
#pragma unroll
    for (int i = 0; i < 16; ++i) { s0[i] = -M2; s1[i] = -M2; }
#pragma unroll
    for (int ks = 0; ks < 4; ++ks) {
      const bf16x8 a0 = *(const bf16x8*)(sK + r * 72 + ks * 16 + 8 * h);
      const bf16x8 a1 = *(const bf16x8*)(sK + (32 + r) * 72 + ks * 16 + 8 * h);
      s0 = __builtin_amdgcn_mfma_f32_32x32x16_bf16(a0, qf[ks], s0, 0, 0, 0);
      s1 = __builtin_amdgcn_mfma_f32_32x32x16_bf16(a1, qf[ks], s1, 0, 0, 0);
    }
  };
  auto soft = [&](f32x16& s0, f32x16& s1, PB (&pb)[2][2]) __attribute__((always_inline)) {
#pragma unroll
    for (int i = 0; i < 16; ++i) { s0[i] = __builtin_amdgcn_exp2f(s0[i]); s1[i] = __builtin_amdgcn_exp2f(s1[i]); lsum += s0[i] + s1[i]; }
#pragma unroll
    for (int s = 0; s < 2; ++s)
#pragma unroll
      for (int j = 0; j < 4; ++j) {
        pb[0][s].u[j] = pk2(s0[8 * s + 2 * j], s0[8 * s + 2 * j + 1]);
        pb[1][s].u[j] = pk2(s1[8 * s + 2 * j], s1[8 * s + 2 * j + 1]);
      }
  };
  auto pv = [&](int st, const PB (&pb)[2][2]) __attribute__((always_inline)) {
    const bf16_t* sV = (const bf16_t*)(smem + st * 18432 + 9216);
#pragma unroll
    for (int kt2 = 0; kt2 < 2; ++kt2)
#pragma unroll
      for (int s = 0; s < 2; ++s) {
        const int kb = kt2 * 32 + 16 * s + 4 * h;
        union { bf16x8 v; uint2 u[2]; } a0, a1;
        a0.u[0] = *(const uint2*)(sV + r * 72 + kb); a0.u[1] = *(const uint2*)(sV + r * 72 + kb + 8);
        a1.u[0] = *(const uint2*)(sV + (32 + r) * 72 + kb); a1.u[1] = *(const uint2*)(sV + (32 + r) * 72 + kb + 8);
        o0 = __builtin_amdgcn_mfma_f32_32x32x16_bf16(a0.v, pb[kt2][s].v, o0, 0, 0, 0);
        o1 = __builtin_amdgcn_mfma_f32_32x32x16_bf16(a1.v, pb[kt2][s].v, o1, 0, 0, 0);
      }
  };
  auto compute2 = [&](int sta, int stb) __attribute__((always_inline)) {
    f32x16 sa0, sa1, sb0, sb1; PB pa[2][2], pbb[2][2];
    qk(sta, sa0, sa1); qk(stb, sb0, sb1);
    soft(sa0, sa1, pa); pv(sta, pa);
    soft(sb0, sb1, pbb); pv(stb, pbb);
  };
  constexpr int NKT = SEQ / 64;
  auto sstore = [&](int st, const u32x4& kk, const u32x4& vv) __attribute__((always_inline)) {
    *(u32x4*)(smem + st * 18432 + srow * 144 + sch * 2) = kk;
    *(u32x4*)(smem + st * 18432 + 9216 + srow * 144 + sch * 2) = vv;
  };
  u32x4 k0 = *(const u32x4*)kp, v0 = *(const u32x4*)vp;
  u32x4 k1 = *(const u32x4*)(kp + (size_t)64 * NPAD), v1 = *(const u32x4*)(vp + 64);
  sstore(0, k0, v0); sstore(1, k1, v1);
  k0 = *(const u32x4*)(kp + (size_t)2 * 64 * NPAD); v0 = *(const u32x4*)(vp + 2 * 64);
  k1 = *(const u32x4*)(kp + (size_t)3 * 64 * NPAD); v1 = *(const u32x4*)(vp + 3 * 64);
  lds_barrier();
  for (int kt = 0; kt < NKT; kt += 4) {
    sstore(2, k0, v0); sstore(3, k1, v1);
    if (kt + 4 < NKT) {
      k0 = *(const u32x4*)(kp + (size_t)(kt + 4) * 64 * NPAD); v0 = *(const u32x4*)(vp + (kt + 4) * 64);
      k1 = *(const u32x4*)(kp + (size_t)(kt + 5) * 64 * NPAD); v1 = *(const u32x4*)(vp + (kt + 5) * 64);
    }
    compute2(0, 1);
    lds_barrier();
    if (kt + 4 < NKT) {
      sstore(0, k0, v0); sstore(1, k1, v1);
      if (kt + 6 < NKT) {
        k0 = *(const u32x4*)(kp + (size_t)(kt + 6) * 64 * NPAD); v0 = *(const u32x4*)(vp + (kt + 6) * 64);
        k1 = *(const u32x4*)(kp + (size_t)(kt + 7) * 64 * NPAD); v1 = *(const u32x4*)(vp + (kt + 7) * 64);
      }
    }
    compute2(2, 3);
    lds_barrier();
  }
  lsum += __shfl_xor(lsum, 32);
  const float inv = 1.f / lsum;
  const bf16_t* zp = Hh + (rowbase + qrow) * NPAD + A_Z + head * 64;
  bf16_t* op = Hh + (rowbase + qrow) * NPAD + A_Q + head * 64;
#pragma unroll
  for (int dt = 0; dt < 2; ++dt)
#pragma unroll
    for (int g = 0; g < 4; ++g) {
      const int d0 = dt * 32 + 8 * g + 4 * h;
      const uint2 zz = *(const uint2*)(zp + d0);
      const float z0 = bf2f((bf16_t)(zz.x & 0xffff)), z1 = bf2f((bf16_t)(zz.x >> 16)), z2 = bf2f((bf16_t)(zz.y & 0xffff)), z3 = bf2f((bf16_t)(zz.y >> 16));
      const f32x16& oo = dt ? o1 : o0;
      uint2 ov;
      ov.x = pk2(oo[4 * g + 0] * inv * fsilu(z0), oo[4 * g + 1] * inv * fsilu(z1));
      ov.y = pk2(oo[4 * g + 2] * inv * fsilu(z2), oo[4 * g + 3] * inv * fsilu(z3));
      *(uint2*)(op + d0) = ov;
    }
  lds_barrier();
}

constexpr int L_QT = 0, L_KT = 17408, L_QC = 34816, L_KHT = 52224, L_VT = 70656, L_ST = 89088,
              L_D = 123904, L_TOT = 124416, L_ACS = 128512, L_DT = 129024;

template <int K, int V> struct ScanGeom {
  static constexpr int KP = K + 8;
  static constexpr int NS = (K / 32) * (V / 32) / 8;
};

template <int K, int V>
DEV void scan_write_state(unsigned char* smem, const f32x16* S, int w, int lane) {
  constexpr int KP = K + 8, NS = ScanGeom<K, V>::NS, NVT = V / 32;
  bf16_t* sST = (bf16_t*)(smem + L_ST);
  const int c = lane & 31, h = lane >> 5;
#pragma unroll
  for (int i = 0; i < NS; ++i) {
    const int tile = w * NS + i, kt = tile / NVT, nt = tile % NVT;
#pragma unroll
    for (int g = 0; g < 4; ++g) {
      uint2 o; o.x = pk2(S[i][4 * g + 0], S[i][4 * g + 1]); o.y = pk2(S[i][4 * g + 2], S[i][4 * g + 3]);
      *(uint2*)(sST + (nt * 32 + c) * KP + kt * 32 + 8 * g + 4 * h) = o;
    }
  }
}

template <int K, int V, bool SSDM>
DEV void scan_core(unsigned char* smem, f32x16* S, bf16_t* orow0, int dir, int w, int lane, bool do_out, const float* sAcs) {
  constexpr int KP = K + 8, NS = ScanGeom<K, V>::NS, NVT = V / 32, NOT = 2 * NVT;
  const bf16_t* sQt = (const bf16_t*)(smem + L_QT); const bf16_t* sKt = (const bf16_t*)(smem + L_KT);
  const bf16_t* sQc = (const bf16_t*)(smem + L_QC); const bf16_t* sKhT = (const bf16_t*)(smem + L_KHT);
  const bf16_t* sVT = (const bf16_t*)(smem + L_VT);
  const bf16_t* sST = (const bf16_t*)(smem + L_ST); const float* sD = (const float*)(smem + L_D);
  const int c = lane & 31, h = lane >> 5;
  if (do_out && w < NOT) {
    const int tt = w / NVT, nt = w % NVT;
    f32x16 acc = zero16();
#pragma unroll
    for (int st = 0; st < 2; ++st) {
      if (st <= tt) {
        f32x16 pt = zero16();
        mma32<K>(pt, sKt + st * 32 * KP, KP, sQt + tt * 32 * KP, KP, lane);
        const int tau = tt * 32 + c;
        const float at = SSDM ? sAcs[tau] : 0.f;
#pragma unroll
        for (int reg = 0; reg < 16; ++reg) {
          const int sig = st * 32 + rowoff(reg, h);
          float v = pt[reg];
          if (SSDM) v *= ex2(at - sAcs[sig]);
          pt[reg] = (sig <= tau) ? v : 0.f;
        }
#pragma unroll
        for (int s2 = 0; s2 < 2; ++s2) {
          union { bf16x8 v; unsigned u[4]; } pa;
#pragma unroll
          for (int j = 0; j < 4; ++j) pa.u[j] = pk2(pt[8 * s2 + 2 * j], pt[8 * s2 + 2 * j + 1]);
          const int kb = st * 32 + 16 * s2 + 4 * h;
          union { bf16x8 v; uint2 u[2]; } vb;
          vb.u[0] = *(const uint2*)(sVT + (nt * 32 + c) * 72 + kb); vb.u[1] = *(const uint2*)(sVT + (nt * 32 + c) * 72 + kb + 8);
          acc = __builtin_amdgcn_mfma_f32_32x32x16_bf16(pa.v, vb.v, acc, 0, 0, 0);
        }
      }
    }
    mma32<K>(acc, sQc + tt * 32 * KP, KP, sST + nt * 32 * KP, KP, lane);
#pragma unroll
    for (int reg = 0; reg < 16; ++reg) {
      const int tau = tt * 32 + rowoff(reg, h);
      const int tok = dir ? (63 - tau) : tau;
      orow0[(size_t)tok * 512 + nt * 32 + c] = f2bf(acc[reg]);
    }
  }
#pragma unroll
  for (int i = 0; i < NS; ++i) {
    const int tile = w * NS + i, kt = tile / NVT, nt = tile % NVT;
#pragma unroll
    for (int reg = 0; reg < 16; ++reg) S[i][reg] *= sD[kt * 32 + rowoff(reg, h)];
    mma32<64>(S[i], sKhT + kt * 32 * 72, 72, sVT + nt * 32 * 72, 72, lane);
  }
}

template <int K, int V>
DEV void state_store(float* buf, const f32x16* S, int w, int lane) {
  constexpr int NS = ScanGeom<K, V>::NS, NVT = V / 32;
  const int c = lane & 31, h = lane >> 5;
#pragma unroll
  for (int i = 0; i < NS; ++i) {
    const int tile = w * NS + i, kt = tile / NVT, nt = tile % NVT;
#pragma unroll
    for (int reg = 0; reg < 16; ++reg) buf[(kt * 32 + rowoff(reg, h)) * V + nt * 32 + c] = S[i][reg];
  }
}
template <int K, int V>
DEV void state_load(const float* buf, f32x16* S, int w, int lane) {
  constexpr int NS = ScanGeom<K, V>::NS, NVT = V / 32;
  const int c = lane & 31, h = lane >> 5;
#pragma unroll
  for (int i = 0; i < NS; ++i) {
    const int tile = w * NS + i, kt = tile / NVT, nt = tile % NVT;
#pragma unroll
    for (int reg = 0; reg < 16; ++reg) S[i][reg] = buf[(kt * 32 + rowoff(reg, h)) * V + nt * 32 + c];
  }
}

#define PACK8_LO(v) (u32x4){((v)[0] & 0xffffu) | ((v)[1] << 16), ((v)[2] & 0xffffu) | ((v)[3] << 16), ((v)[4] & 0xffffu) | ((v)[5] << 16), ((v)[6] & 0xffffu) | ((v)[7] << 16)}
#define PACK8_HI(v) (u32x4){((v)[0] >> 16) | ((v)[1] & 0xffff0000u), ((v)[2] >> 16) | ((v)[3] & 0xffff0000u), ((v)[4] >> 16) | ((v)[5] & 0xffff0000u), ((v)[6] >> 16) | ((v)[7] & 0xffff0000u)}
#define CVT8(f) (u32x4){pk2((f)[0], (f)[1]), pk2((f)[2], (f)[3]), pk2((f)[4], (f)[5]), pk2((f)[6], (f)[7])}


DEV void hgrn_item(const Params& p, int l, int it, int seg, int mode, unsigned char* smem) {
  const int bl = it >> 3, head = (it >> 1) & 3, dir = it & 1;
  const bool do_out = (mode == 3);
  constexpr int K = 128, V = 128, KPW = 68;
  const int tid = launder(threadIdx.x), lane = tid & 63, w = tid >> 6;
  const int cp = tid & 63, tg = tid >> 6, ch0 = 2 * cp;
  const bf16_t* Hh = (const bf16_t*)(p.ws + OFF_H);
  bf16_t* OB = (bf16_t*)(p.ws + OFF_OBUF) + (size_t)(0 * 2 + dir) * TH * 512;
  const size_t rowbase = (size_t)bl * SEQ;
  float lb0 = 0.f, lb1 = 0.f;
  if (l > 0) {
    lb0 = fsigmoid(p.lb_logits[512 + head * 128 + ch0] - p.lb_logits[head * 128 + ch0]);
    lb1 = fsigmoid(p.lb_logits[512 + head * 128 + ch0 + 1] - p.lb_logits[head * 128 + ch0 + 1]);
  }
  const float om0 = 1.f - lb0, om1 = 1.f - lb1;
  const int fbase = dir ? H_FB : H_FF;
  unsigned* sQt = (unsigned*)(smem + L_QT); unsigned* sKt = (unsigned*)(smem + L_KT); unsigned* sQc = (unsigned*)(smem + L_QC);
  bf16_t* sKhT = (bf16_t*)(smem + L_KHT); bf16_t* sVT = (bf16_t*)(smem + L_VT);
  float* sD = (float*)(smem + L_D); float* sTot = (float*)(smem + L_TOT);
  f32x16 S[2]; S[0] = zero16(); S[1] = zero16();
  float* sbuf = (float*)(p.ws + OFF_SB0) + ((size_t)it * NSEG + seg) * 16384;
  if (do_out) state_load<K, V>(sbuf, S, w, lane);
  float dlog0 = 0.f, dlog1 = 0.f;
  unsigned pf[8], qq[8], vv[8];
  float g0[8], g1[8], kx0[8], kx1[8];
  auto gloadA = [&](int cidx) __attribute__((always_inline)) {
    const int chunk = dir ? (63 - cidx) : cidx;
#pragma unroll
    for (int i = 0; i < 8; ++i) {
      const int tau = 8 * tg + i;
      const int tok = chunk * 64 + (dir ? (63 - tau) : tau);
      pf[i] = ((const unsigned*)(Hh + (rowbase + tok) * NPAD + head * 128 + fbase))[cp];
    }
  };
  auto gloadB = [&](int cidx) __attribute__((always_inline)) {
    const int chunk = dir ? (63 - cidx) : cidx;
#pragma unroll
    for (int i = 0; i < 8; ++i) {
      const int tau = 8 * tg + i;
      const int tok = chunk * 64 + (dir ? (63 - tau) : tau);
      const unsigned* rp = (const unsigned*)(Hh + (rowbase + tok) * NPAD + head * 128) + cp;
      vv[i] = rp[H_I / 2];
      qq[i] = do_out ? rp[H_Q / 2] : 0u;
    }
  };
  auto stage1 = [&]() __attribute__((always_inline)) {
    float r0 = 0.f, r1 = 0.f;
#pragma unroll
    for (int i = 0; i < 8; ++i) {
      const float e0 = ex2(fminf(-lo16(pf[i]) * LOG2E, 80.f)), e1 = ex2(fminf(-hi16(pf[i]) * LOG2E, 80.f));
      const float s0 = frcp(1.f + e0), s1 = frcp(1.f + e1);
      r0 += lg2(lb0 + om0 * s0); r1 += lg2(lb1 + om1 * s1);
      g0[i] = r0; g1[i] = r1;
      kx0[i] = om0 * e0 * s0; kx1[i] = om1 * e1 * s1;
    }
    *(float2*)(sTot + tg * 128 + ch0) = make_float2(r0, r1);
  };
  gloadA(seg * SLEN); gloadB(seg * SLEN);
  stage1();
  if (SLEN > 1) gloadA(seg * SLEN + 1);
  for (int ci = 0; ci < SLEN; ++ci) {
    const int cidx = seg * SLEN + ci;
    const int chunk = dir ? (63 - cidx) : cidx;
    lds_barrier();
    float off0 = 0.f, off1 = 0.f, ref0 = 0.f, ref1 = 0.f, be0 = 0.f, be1 = 0.f;
#pragma unroll
    for (int j = 0; j < 8; ++j) {
      const float2 t = *(const float2*)(sTot + j * 128 + ch0);
      if (j < tg) { off0 += t.x; off1 += t.y; }
      if (j < 4) { ref0 += t.x; ref1 += t.y; }
      be0 += t.x; be1 += t.y;
    }
    dlog0 += be0; dlog1 += be1;
    const float eref0 = ex2(ref0), eref1 = ex2(ref1), ebr0 = ex2(be0 - ref0), ebr1 = ex2(be1 - ref1);
    const float d0 = off0 - ref0, d1 = off1 - ref1;
    float kh0[8], kh1[8];
#pragma unroll
    for (int i = 0; i < 8; ++i) {
      const int tau = 8 * tg + i;
      const float E0 = ex2(g0[i] + d0), E1 = ex2(g1[i] + d1);
      const float kt0 = kx0[i] * frcp(E0), kt1 = kx1[i] * frcp(E1);
      if (do_out) {
        const float qt0 = lo16(qq[i]) * E0, qt1 = hi16(qq[i]) * E1;
        sQt[tau * KPW + cp] = pk2(qt0, qt1);
        sKt[tau * KPW + cp] = pk2(kt0, kt1);
        sQc[tau * KPW + cp] = pk2(qt0 * eref0, qt1 * eref1);
      }
      kh0[i] = kt0 * ebr0; kh1[i] = kt1 * ebr1;
    }
    *(u32x4*)(sKhT + ch0 * 72 + 8 * tg) = CVT8(kh0);
    *(u32x4*)(sKhT + (ch0 + 1) * 72 + 8 * tg) = CVT8(kh1);
    *(u32x4*)(sVT + ch0 * 72 + 8 * tg) = PACK8_LO(vv);
    *(u32x4*)(sVT + (ch0 + 1) * 72 + 8 * tg) = PACK8_HI(vv);
    if (tg == 0) *(float2*)(sD + ch0) = make_float2(ex2(be0), ex2(be1));
    if (do_out) scan_write_state<K, V>(smem, S, w, lane);
    if (ci + 1 < SLEN) gloadB(cidx + 1);
    lds_barrier();
    scan_core<K, V, false>(smem, S, OB + (rowbase + (size_t)chunk * 64) * 512 + head * 128, dir, w, lane, do_out, nullptr);
    if (ci + 1 < SLEN) { stage1(); if (ci + 2 < SLEN) gloadA(cidx + 2); }
  }
  if (!do_out) {
    state_store<K, V>(sbuf, S, w, lane);
    if (tg == 0) *(float2*)((float*)(p.ws + OFF_DB) + ((size_t)it * NSEG + seg) * 128 + ch0) = make_float2(ex2(dlog0), ex2(dlog1));
  }
  lds_barrier();
}

DEV void gla_item(const Params& p, int l, int it, int seg, int mode, unsigned char* smem) {
  const int j16 = it - 16, bl = j16 >> 3, head = (j16 >> 1) & 3, dir = j16 & 1;
  const bool do_out = (mode == 3);
  constexpr int K = 64, V = 128, KPW = 36;
  const int tid = launder(threadIdx.x), lane = tid & 63, w = tid >> 6;
  const int cp = tid & 31, tg = tid >> 5, ch0 = 2 * cp;
  const int vp2 = tid & 63, vg = tid >> 6;
  const bf16_t* Hh = (const bf16_t*)(p.ws + OFF_H);
  const bf16_t* Gb = (const bf16_t*)(p.ws + OFF_G);
  bf16_t* OB = (bf16_t*)(p.ws + OFF_OBUF) + (size_t)(2 * 2 + dir) * TH * 512;
  const size_t rowbase = (size_t)bl * SEQ;
  unsigned* sQt = (unsigned*)(smem + L_QT); unsigned* sKt = (unsigned*)(smem + L_KT); unsigned* sQc = (unsigned*)(smem + L_QC);
  bf16_t* sKhT = (bf16_t*)(smem + L_KHT); bf16_t* sVT = (bf16_t*)(smem + L_VT);
  float* sD = (float*)(smem + L_D); float* sTot = (float*)(smem + L_TOT);
  f32x16 S[1]; S[0] = zero16();
  float* sbuf = (float*)(p.ws + OFF_SB1) + ((size_t)j16 * NSEG + seg) * 8192;
  if (do_out) state_load<K, V>(sbuf, S, w, lane);
  float dlog0 = 0.f, dlog1 = 0.f;
  unsigned pg[4];
  float g0[4], g1[4]; unsigned kk[4], qq[4], vv[8];
  auto gloadA = [&](int cidx) __attribute__((always_inline)) {
    const int chunk = dir ? (63 - cidx) : cidx;
#pragma unroll
    for (int i = 0; i < 4; ++i) {
      const int tau = 4 * tg + i;
      const int tok = chunk * 64 + (dir ? (63 - tau) : tau);
      pg[i] = ((const unsigned*)(Gb + (rowbase + tok) * 512 + dir * 256 + head * 64))[cp];
    }
  };
  auto gloadB = [&](int cidx) __attribute__((always_inline)) {
    const int chunk = dir ? (63 - cidx) : cidx;
#pragma unroll
    for (int i = 0; i < 4; ++i) {
      const int tau = 4 * tg + i;
      const int tok = chunk * 64 + (dir ? (63 - tau) : tau);
      const unsigned* rp = (const unsigned*)(Hh + (rowbase + tok) * NPAD + head * 64) + cp;
      kk[i] = rp[G_K / 2]; qq[i] = do_out ? rp[G_Q / 2] : 0u;
    }
#pragma unroll
    for (int i = 0; i < 8; ++i) {
      const int tau = 8 * vg + i;
      const int tok = chunk * 64 + (dir ? (63 - tau) : tau);
      vv[i] = ((const unsigned*)(Hh + (rowbase + tok) * NPAD + G_V + head * 128))[vp2];
    }
  };
  auto stage1 = [&]() __attribute__((always_inline)) {
    float r0 = 0.f, r1 = 0.f;
#pragma unroll
    for (int i = 0; i < 4; ++i) { r0 += lo16(pg[i]); r1 += hi16(pg[i]); g0[i] = r0; g1[i] = r1; }
    *(float2*)(sTot + tg * 64 + ch0) = make_float2(r0, r1);
  };
  gloadA(seg * SLEN); gloadB(seg * SLEN);
  stage1();
  if (SLEN > 1) gloadA(seg * SLEN + 1);
  for (int ci = 0; ci < SLEN; ++ci) {
    const int cidx = seg * SLEN + ci;
    const int chunk = dir ? (63 - cidx) : cidx;
    lds_barrier();
    float off0 = 0.f, off1 = 0.f, ref0 = 0.f, ref1 = 0.f, be0 = 0.f, be1 = 0.f;
#pragma unroll
    for (int j = 0; j < 16; ++j) {
      const float2 t = *(const float2*)(sTot + j * 64 + ch0);
      if (j < tg) { off0 += t.x; off1 += t.y; }
      if (j < 8) { ref0 += t.x; ref1 += t.y; }
      be0 += t.x; be1 += t.y;
    }
    dlog0 += be0; dlog1 += be1;
    const float eref0 = ex2(ref0), eref1 = ex2(ref1), ebr0 = ex2(be0 - ref0), ebr1 = ex2(be1 - ref1);
    const float d0 = off0 - ref0, d1 = off1 - ref1;
    float kh0[4], kh1[4];
#pragma unroll
    for (int i = 0; i < 4; ++i) {
      const int tau = 4 * tg + i;
      const float E0 = ex2(g0[i] + d0), E1 = ex2(g1[i] + d1);
      const float kt0 = lo16(kk[i]) * frcp(E0), kt1 = hi16(kk[i]) * frcp(E1);
      if (do_out) {
        const float qt0 = lo16(qq[i]) * E0, qt1 = hi16(qq[i]) * E1;
        sQt[tau * KPW + cp] = pk2(qt0, qt1);
        sKt[tau * KPW + cp] = pk2(kt0, kt1);
        sQc[tau * KPW + cp] = pk2(qt0 * eref0, qt1 * eref1);
      }
      kh0[i] = kt0 * ebr0; kh1[i] = kt1 * ebr1;
    }
    *(uint2*)(sKhT + ch0 * 72 + 4 * tg) = make_uint2(pk2(kh0[0], kh0[1]), pk2(kh0[2], kh0[3]));
    *(uint2*)(sKhT + (ch0 + 1) * 72 + 4 * tg) = make_uint2(pk2(kh1[0], kh1[1]), pk2(kh1[2], kh1[3]));
    *(u32x4*)(sVT + (2 * vp2) * 72 + 8 * vg) = PACK8_LO(vv);
    *(u32x4*)(sVT + (2 * vp2 + 1) * 72 + 8 * vg) = PACK8_HI(vv);
    if (tg == 0) *(float2*)(sD + ch0) = make_float2(ex2(be0), ex2(be1));
    if (do_out) scan_write_state<K, V>(smem, S, w, lane);
    if (ci + 1 < SLEN) gloadB(cidx + 1);
    lds_barrier();
    scan_core<K, V, false>(smem, S, OB + (rowbase + (size_t)chunk * 64) * 512 + head * 128, dir, w, lane, do_out, nullptr);
    if (ci + 1 < SLEN) { stage1(); if (ci + 2 < SLEN) gloadA(cidx + 2); }
  }
  if (!do_out) {
    state_store<K, V>(sbuf, S, w, lane);
    if (tg == 0) *(float2*)((float*)(p.ws + OFF_DB) + ((size_t)it * NSEG + seg) * 128 + ch0) = make_float2(ex2(dlog0), ex2(dlog1));
  }
  lds_barrier();
}

DEV void ssd_item(const Params& p, int l, int it, int seg, int mode, unsigned char* smem) {
  const int j32 = it - 32, bl = j32 >> 4, head = (j32 >> 1) & 7, dir = j32 & 1;
  const bool do_out = (mode == 3);
  constexpr int K = 128, V = 64, KPW = 68;
  const int tid = launder(threadIdx.x), lane = tid & 63, w = tid >> 6;
  const int cp = tid & 63, tg = tid >> 6, n0 = 2 * cp;
  const int xp = tid & 31, xg = tid >> 5;
  const int grp = head >> 2;
  const bf16_t* U = (const bf16_t*)(p.ws + OFF_U);
  const float* SMALL = (const float*)(p.ws + OFF_SMALL);
  bf16_t* OB = (bf16_t*)(p.ws + OFF_OBUF) + (size_t)(1 * 2 + dir) * TH * 512;
  const size_t rowbase = (size_t)bl * SEQ;
  unsigned* sQt = (unsigned*)(smem + L_QT); unsigned* sKt = (unsigned*)(smem + L_KT); unsigned* sQc = (unsigned*)(smem + L_QC);
  bf16_t* sKhT = (bf16_t*)(smem + L_KHT); bf16_t* sVT = (bf16_t*)(smem + L_VT);
  float* sD = (float*)(smem + L_D);
  const float dtb = p.dt_bias[(l * 2 + dir) * 8 + head];
  const float Acoef = -__expf(p.a_log[(l * 2 + dir) * 8 + head]) * LOG2E;
  f32x16 S[1]; S[0] = zero16();
  float* sbuf = (float*)(p.ws + OFF_SB2) + ((size_t)j32 * NSEG + seg) * 8192;
  if (do_out) state_load<K, V>(sbuf, S, w, lane);
  float dlog = 0.f;
  unsigned bb[8], cc[8], xx[4];
  float rdt = 0.f;
  auto gloadA = [&](int cidx) __attribute__((always_inline)) {
    const int chunk = dir ? (63 - cidx) : cidx;
    if (w == 0) {
      const int tok = chunk * 64 + (dir ? (63 - lane) : lane);
      rdt = SMALL[(rowbase + tok) * 48 + dir * 8 + head];
    }
  };
  auto gloadB = [&](int cidx) __attribute__((always_inline)) {
    const int chunk = dir ? (63 - cidx) : cidx;
#pragma unroll
    for (int i = 0; i < 8; ++i) {
      const int tau = 8 * tg + i;
      const int tok = chunk * 64 + (dir ? (63 - tau) : tau);
      const unsigned* rp = (const unsigned*)(U + (rowbase + tok) * 1024 + grp * 128) + cp;
      bb[i] = rp[512 / 2]; cc[i] = do_out ? rp[768 / 2] : 0u;
    }
#pragma unroll
    for (int i = 0; i < 4; ++i) {
      const int tau = 4 * xg + i;
      const int tok = chunk * 64 + (dir ? (63 - tau) : tau);
      xx[i] = ((const unsigned*)(U + (rowbase + tok) * 1024 + head * 64))[xp];
    }
  };
  auto stage1 = [&](int par) __attribute__((always_inline)) {
    if (w == 0) {
      const float xv = rdt + dtb;
      const float dt = (xv > 20.f) ? xv : log1pf(__expf(xv));
      float a = dt * Acoef;
#pragma unroll
      for (int o = 1; o < 64; o <<= 1) { const float t = __shfl_up(a, o); if (lane >= o) a += t; }
      ((float*)(smem + L_ACS))[par * 64 + lane] = a; ((float*)(smem + L_DT))[par * 64 + lane] = dt;
    }
  };
  gloadA(seg * SLEN); gloadB(seg * SLEN);
  stage1(0);
  if (SLEN > 1) gloadA(seg * SLEN + 1);
  for (int ci = 0; ci < SLEN; ++ci) {
    const int cidx = seg * SLEN + ci;
    const int chunk = dir ? (63 - cidx) : cidx;
    const float* sAcs = (const float*)(smem + L_ACS) + (ci & 1) * 64;
    const float* sDt = (const float*)(smem + L_DT) + (ci & 1) * 64;
    lds_barrier();
    const float aend = sAcs[63];
    dlog += aend;
    {
      float kh0[8], kh1[8];
#pragma unroll
      for (int i = 0; i < 8; ++i) {
        const int tau = 8 * tg + i;
        const float ac = sAcs[tau];
        const float eb = ex2(aend - ac);
        kh0[i] = lo16(bb[i]) * eb; kh1[i] = hi16(bb[i]) * eb;
        if (do_out) {
          const float ea = ex2(ac);
          sKt[tau * KPW + cp] = bb[i];
          sQt[tau * KPW + cp] = cc[i];
          sQc[tau * KPW + cp] = pk2(lo16(cc[i]) * ea, hi16(cc[i]) * ea);
        }
      }
      *(u32x4*)(sKhT + n0 * 72 + 8 * tg) = CVT8(kh0);
      *(u32x4*)(sKhT + (n0 + 1) * 72 + 8 * tg) = CVT8(kh1);
      float x0[4], x1[4];
#pragma unroll
      for (int i = 0; i < 4; ++i) { const float dtv = sDt[4 * xg + i]; x0[i] = lo16(xx[i]) * dtv; x1[i] = hi16(xx[i]) * dtv; }
      *(uint2*)(sVT + (2 * xp) * 72 + 4 * xg) = make_uint2(pk2(x0[0], x0[1]), pk2(x0[2], x0[3]));
      *(uint2*)(sVT + (2 * xp + 1) * 72 + 4 * xg) = make_uint2(pk2(x1[0], x1[1]), pk2(x1[2], x1[3]));
      if (tg == 0) *(float2*)(sD + n0) = make_float2(ex2(aend), ex2(aend));
    }
    if (do_out) scan_write_state<K, V>(smem, S, w, lane);
    if (ci + 1 < SLEN) gloadB(cidx + 1);
    lds_barrier();
    scan_core<K, V, true>(smem, S, OB + (rowbase + (size_t)chunk * 64) * 512 + head * 64, dir, w, lane, do_out, sAcs);
    if (ci + 1 < SLEN) { stage1((ci + 1) & 1); if (ci + 2 < SLEN) gloadA(cidx + 2); }
  }
  if (!do_out) {
    state_store<K, V>(sbuf, S, w, lane);
    if (tg == 0) *(float2*)((float*)(p.ws + OFF_DB) + ((size_t)it * NSEG + seg) * 128 + n0) = make_float2(ex2(dlog), ex2(dlog));
  }
  lds_barrier();
}

DEV void phase_prep(const Params& p, int l, int hf, int rep, unsigned char* smem) {
  const int tid = launder(threadIdx.x), lane = tid & 63;
  bf16_t* Hh = (bf16_t*)(p.ws + OFF_H);
  bf16_t* U = (bf16_t*)(p.ws + OFF_U);
  bf16_t* Gb = (bf16_t*)(p.ws + OFF_G);
  bf16_t* VT = (bf16_t*)(p.ws + OFF_VT);
  const float* SMALLp = (const float*)(p.ws + OFF_SMALL);
  float2* stab = (float2*)smem;
  float* slow = (float*)(smem + 8192);
  bf16_t* sT = (bf16_t*)(smem + 12288);
  {
    const float2* tabg = (const float2*)(p.ws + OFF_TAB);
    for (int i = tid; i < 1024; i += NT) stab[i] = tabg[i];
  }
  const int cg8 = (tid & 127) * 8, rsub = tid >> 7;
  const float* cw = p.conv_w + (size_t)l * 5 * 1024; const float* cb = p.conv_b + (size_t)l * 1024;
  float wv[5][8], bv[8];
#pragma unroll
  for (int j = 0; j < 5; ++j)
#pragma unroll
    for (int e = 0; e < 8; ++e) wv[j][e] = cw[j * 1024 + cg8 + e];
#pragma unroll
  for (int e = 0; e < 8; ++e) bv[e] = cb[cg8 + e];
  const int gd = tid >> 8, gc = tid & 255;
  const int i16 = lane & 15;
  const float* gq = p.q_gain + l * 64 + 4 * i16; const float* gk = p.k_gain + l * 64 + 4 * i16;
  const float gqv[4] = {gq[0], gq[1], gq[2], gq[3]}, gkv[4] = {gk[0], gk[1], gk[2], gk[3]};
  for (int grp = blockIdx.x; grp < TH / 32; grp += gridDim.x) {
    const int r0 = grp * 32;
    lds_barrier();
    const u32x4 vt = *(const u32x4*)(Hh + (size_t)(r0 + (tid >> 4)) * NPAD + A_V + (tid & 15) * 8);
    const float2 lowv = *(const float2*)(SMALLp + (size_t)(r0 + (tid >> 4)) * 48 + 16 + (tid & 15) * 2);
    *(u32x4*)(sT + (tid >> 4) * 136 + (tid & 15) * 8) = vt;
    *(float2*)(slow + (tid >> 4) * 32 + (tid & 15) * 2) = lowv;
#pragma unroll 1
    for (int ps = 0; ps < 2; ++ps) {
      const int ra = r0 + 16 * ps + 4 * rsub, ta = ra & (SEQ - 1);
      u32x4 xc[8];
#pragma unroll
      for (int m = 0; m < 8; ++m) {
        const int sq = ta + m - 2;
        xc[m] = (u32x4){0u, 0u, 0u, 0u};
        if (sq >= 0 && sq < SEQ) xc[m] = *(const u32x4*)(Hh + (size_t)(ra + m - 2) * NPAD + S_X + cg8);
      }
#pragma unroll
      for (int o4 = 0; o4 < 4; ++o4) {
        float u[8];
#pragma unroll
        for (int e = 0; e < 8; ++e) u[e] = bv[e];
#pragma unroll
        for (int j = 0; j < 5; ++j)
#pragma unroll
          for (int e = 0; e < 4; ++e) { u[2 * e] += wv[j][2 * e] * lo16(xc[o4 + j][e]); u[2 * e + 1] += wv[j][2 * e + 1] * hi16(xc[o4 + j][e]); }
        u32x4 o;
#pragma unroll
        for (int e = 0; e < 4; ++e) {
          const float a = u[2 * e] * frcp(1.f + ex2(fminf(-u[2 * e] * LOG2E, 80.f)));
          const float b = u[2 * e + 1] * frcp(1.f + ex2(fminf(-u[2 * e + 1] * LOG2E, 80.f)));
          o[e] = pk2(a, b);
        }
        *(u32x4*)(U + (size_t)(ra + o4) * 1024 + cg8) = o;
      }
    }
    lds_barrier();
    if (rep == 0) {
      u32x4 hq[6];
#pragma unroll
      for (int u = 0; u < 6; ++u) {
        const int id = u * 512 + tid, row = r0 + id / 96, c96 = id % 96;
        hq[u] = *(const u32x4*)(Hh + (size_t)row * NPAD + ((c96 < 64) ? (H_Q + c96 * 8) : (G_Q + (c96 - 64) * 8)));
      }
#pragma unroll 1
      for (int ub = 0; ub < 10; ub += 5) {
        uint2 xq[5];
#pragma unroll
        for (int u = 0; u < 5; ++u) {
          const int pi = (ub + u) * 32 + (tid >> 4), row = r0 + pi / 10, hd = pi % 10;
          xq[u] = *(const uint2*)(Hh + (size_t)row * NPAD + ((hd < 8) ? (A_Q + hd * 64) : (A_K + (hd - 8) * 64)) + 4 * i16);
        }
#pragma unroll
        for (int u = 0; u < 5; ++u) {
          const int pi = (ub + u) * 32 + (tid >> 4), row = r0 + pi / 10, hd = pi % 10;
          const bool isq = hd < 8;
          const float x[4] = {lo16(xq[u].x), hi16(xq[u].x), lo16(xq[u].y), hi16(xq[u].y)};
          float ss = x[0] * x[0] + x[1] * x[1] + x[2] * x[2] + x[3] * x[3];
          ss += __shfl_xor(ss, 1); ss += __shfl_xor(ss, 2); ss += __shfl_xor(ss, 4); ss += __shfl_xor(ss, 8);
          const float rstd = rsqrtf(ss * (1.f / 64.f) + 1e-6f);
          const int t = row & (SEQ - 1);
          const int pos = (i16 < 8) ? (t >> 6) : (t & 63);
          const float osc = isq ? QSCALE : 1.f;
          float o[4];
#pragma unroll
          for (int e = 0; e < 4; ++e) {
            const float v = x[e] * rstd * (isq ? gqv[e] : gkv[e]);
            const float pv = __shfl_xor(v, 4);
            const float2 cs = stab[pos * 16 + 4 * (i16 & 3) + e];
            o[e] = ((i16 & 4) ? (v * cs.x + pv * cs.y) : (v * cs.x - pv * cs.y)) * osc;
          }
          *(uint2*)(Hh + (size_t)row * NPAD + (isq ? (A_Q + hd * 64) : (A_K + (hd - 8) * 64)) + 4 * i16) = make_uint2(pk2(o[0], o[1]), pk2(o[2], o[3]));
        }
      }
#pragma unroll
      for (int u = 0; u < 6; ++u) {
        const int id = u * 512 + tid, row = r0 + id / 96, c96 = id % 96;
        u32x4 x = hq[u];
        if (c96 < 64) {
#pragma unroll
          for (int e = 0; e < 4; ++e) {
            const float a = lo16(x[e]), b = hi16(x[e]);
            x[e] = pk2(a * frcp(1.f + ex2(fminf(-a * LOG2E, 80.f))) * 0.08838834764831845f, b * frcp(1.f + ex2(fminf(-b * LOG2E, 80.f))) * 0.08838834764831845f);
          }
        } else {
#pragma unroll
          for (int e = 0; e < 4; ++e) x[e] = pk2(lo16(x[e]) * 0.125f, hi16(x[e]) * 0.125f);
        }
        *(u32x4*)(Hh + (size_t)row * NPAD + ((c96 < 64) ? (H_Q + c96 * 8) : (G_Q + (c96 - 64) * 8))) = x;
      }
    }
    float w2c[16];
#pragma unroll
    for (int r = 0; r < 16; ++r) w2c[r] = p.gk_w2[((size_t)(l * 2 + gd) * 16 + r) * 256 + gc];
    const float gbias = p.gk_b[(l * 2 + gd) * 256 + gc];
#pragma unroll 4
    for (int rr = 0; rr < 32; ++rr) {
      const float4* lp4 = (const float4*)(slow + rr * 32 + gd * 16);
      float gkk = gbias;
#pragma unroll
      for (int r4 = 0; r4 < 4; ++r4) { const float4 lw = lp4[r4]; gkk += lw.x * w2c[4 * r4] + lw.y * w2c[4 * r4 + 1] + lw.z * w2c[4 * r4 + 2] + lw.w * w2c[4 * r4 + 3]; }
      const float l2 = (fminf(gkk, 0.f) * LOG2E - lg2(1.f + ex2(-fabsf(gkk) * LOG2E))) * (1.f / 16.f);
      Gb[(size_t)(r0 + rr) * 512 + tid] = f2bf(l2);
    }
    {
      const int c = tid >> 2, tq = (tid & 3) * 8;
      unsigned v[8];
#pragma unroll
      for (int i = 0; i < 8; ++i) v[i] = sT[(tq + i) * 136 + c];
      const int bl = r0 >> 12, t0 = (r0 & (SEQ - 1)) + tq;
      *(u32x4*)(VT + ((size_t)((bl * 2 + (c >> 6)) * 64 + (c & 63))) * SEQ + t0) = (u32x4){v[0] | (v[1] << 16), v[2] | (v[3] << 16), v[4] | (v[5] << 16), v[6] | (v[7] << 16)};
    }
  }
  lds_barrier();
}

DEV void phase_mix(const Params& p, int l, int hf, int slot, int mode, int att_lo, int att_hi, int vid_lo, int vid_hi, unsigned char* smem) {
  unsigned* ctr = (unsigned*)(p.ws + OFF_CTRL) + CTR_WORD0 + slot * 16;
  volatile int* sItem = (volatile int*)(smem + LDS_BYTES - 16);
  const int n_scan = 64 * NSEG;
  int hi = n_scan + (att_hi - att_lo); if (vid_hi < hi) hi = vid_hi;
  for (;;) {
    lds_barrier();
    if (threadIdx.x == 0) *sItem = vid_lo + (int)atomicAdd(ctr, 1u);
    lds_barrier();
    const int vid = *sItem;
    if (vid >= hi) break;
    if (vid < n_scan) {
      const int seg = vid >> 6, it = vid & 63;
      if (mode == 1 && seg == NSEG - 1) continue;
#if PROBE_REP > 0
      if (slot >= 40 && PROBE_TYPE >= 0 && ((it < 16) ? 0 : (it < 32) ? 1 : 2) != PROBE_TYPE) continue;
#endif
      if (it < 16) { if (PH_MASK & 0x100) hgrn_item(p, l, it, seg, mode, smem); }
      else if (it < 32) { if (PH_MASK & 0x200) gla_item(p, l, it, seg, mode, smem); }
      else { if (PH_MASK & 0x400) ssd_item(p, l, it, seg, mode, smem); }
    } else { if (PH_MASK & 0x800) attn_item(p, l, att_lo + (vid - n_scan), smem); }
  }
}

DEV void phase_scan2(const Params& p) {
  const size_t gtid = (size_t)blockIdx.x * NT + threadIdx.x, gsz = (size_t)gridDim.x * NT;
  const float* DB = (const float*)(p.ws + OFF_DB);
  for (size_t e = gtid; e < 655360; e += gsz) {
    float* buf; const float* dp; int stride;
    if (e < 262144) { const int it = (int)(e >> 14), idx = (int)(e & 16383); buf = (float*)(p.ws + OFF_SB0) + (size_t)it * NSEG * 16384 + idx; stride = 16384; dp = DB + (size_t)it * NSEG * 128 + (idx >> 7); }
    else if (e < 393216) { const int e2 = (int)(e - 262144), j = e2 >> 13, idx = e2 & 8191; buf = (float*)(p.ws + OFF_SB1) + (size_t)j * NSEG * 8192 + idx; stride = 8192; dp = DB + (size_t)(16 + j) * NSEG * 128 + (idx >> 7); }
    else { const int e3 = (int)(e - 393216), j = e3 >> 13, idx = e3 & 8191; buf = (float*)(p.ws + OFF_SB2) + (size_t)j * NSEG * 8192 + idx; stride = 8192; dp = DB + (size_t)(32 + j) * NSEG * 128 + (idx >> 6); }
    float u[NSEG - 1], d[NSEG - 1];
#pragma unroll
    for (int sg = 0; sg < NSEG - 1; ++sg) { u[sg] = buf[(size_t)sg * stride]; d[sg] = dp[sg * 128]; }
    float st = 0.f;
#pragma unroll
    for (int sg = 0; sg < NSEG; ++sg) { buf[(size_t)sg * stride] = st; if (sg < NSEG - 1) st = d[sg] * st + u[sg]; }
  }
}

DEV float bfe(const u32x4& v, int j) { return (j & 1) ? hi16(v[j >> 1]) : lo16(v[j >> 1]); }
DEV void phase_fin(const Params& p, int l, int hf) {
  const int tid = launder(threadIdx.x), lane = tid & 63, w = tid >> 6;
  const bf16_t* Hh = (const bf16_t*)(p.ws + OFF_H);
  const bf16_t* OB = (const bf16_t*)(p.ws + OFF_OBUF);
  bf16_t* MX = (bf16_t*)(p.ws + OFF_MIXED);
  const int c0 = lane * 8;
  const float* cw = p.conv_w + (size_t)l * 5 * 1024; const float* cb = p.conv_b + (size_t)l * 1024;
  for (int r0 = (blockIdx.x * 8 + w) * 4; r0 < TH; r0 += gridDim.x * 32) {
    {
      u32x4 at[4], a[4], b[4], z[4];
#pragma unroll
      for (int i = 0; i < 4; ++i) {
        const bf16_t* hrow = Hh + (size_t)(r0 + i) * NPAD;
        at[i] = *(const u32x4*)(hrow + A_Q + c0);
        a[i] = *(const u32x4*)(OB + ((size_t)0 * TH + r0 + i) * 512 + c0); b[i] = *(const u32x4*)(OB + ((size_t)1 * TH + r0 + i) * 512 + c0);
        z[i] = *(const u32x4*)(hrow + H_Z + c0);
      }
      float gn[8];
#pragma unroll
      for (int j = 0; j < 8; ++j) gn[j] = p.hgrn_norm[l * 512 + c0 + j];
#pragma unroll
      for (int i = 0; i < 4; ++i) {
        *(u32x4*)(MX + (size_t)(r0 + i) * DI + c0) = at[i];
        float o[8]; float ss = 0.f;
#pragma unroll
        for (int j = 0; j < 8; ++j) { o[j] = bfe(a[i], j) + bfe(b[i], j); ss += o[j] * o[j]; }
#pragma unroll
        for (int of = 32; of >= 1; of >>= 1) ss += __shfl_xor(ss, of);
        const float rstd = rsqrtf(ss * (1.f / 512.f) + 1e-6f);
        float y[8];
#pragma unroll
        for (int j = 0; j < 8; ++j) { const float zz = bfe(z[i], j); y[j] = o[j] * rstd * gn[j] * (zz * frcp(1.f + ex2(fminf(-zz * LOG2E, 80.f)))); }
        *(u32x4*)(MX + (size_t)(r0 + i) * DI + 512 + c0) = (u32x4){pk2(y[0], y[1]), pk2(y[2], y[3]), pk2(y[4], y[5]), pk2(y[6], y[7])};
      }
    }
    {
      u32x4 a[4], b[4], z[4];
#pragma unroll
      for (int i = 0; i < 4; ++i) {
        a[i] = *(const u32x4*)(OB + ((size_t)4 * TH + r0 + i) * 512 + c0); b[i] = *(const u32x4*)(OB + ((size_t)5 * TH + r0 + i) * 512 + c0);
        z[i] = *(const u32x4*)(Hh + (size_t)(r0 + i) * NPAD + G_Z + c0);
      }
      float gn[8];
#pragma unroll
      for (int j = 0; j < 8; ++j) gn[j] = p.gla_norm[l * 128 + ((c0 + j) & 127)];
#pragma unroll
      for (int i = 0; i < 4; ++i) {
        float o[8]; float ss = 0.f;
#pragma unroll
        for (int j = 0; j < 8; ++j) { o[j] = bfe(a[i], j) + bfe(b[i], j); ss += o[j] * o[j]; }
#pragma unroll
        for (int of = 8; of >= 1; of >>= 1) ss += __shfl_xor(ss, of);
        const float rstd = rsqrtf(ss * (1.f / 128.f) + 1e-6f);
        float y[8];
#pragma unroll
        for (int j = 0; j < 8; ++j) { const float zz = bfe(z[i], j); y[j] = o[j] * rstd * gn[j] * (zz * frcp(1.f + ex2(fminf(-zz * LOG2E, 80.f)))); }
        *(u32x4*)(MX + (size_t)(r0 + i) * DI + 1536 + c0) = (u32x4){pk2(y[0], y[1]), pk2(y[2], y[3]), pk2(y[4], y[5]), pk2(y[6], y[7])};
      }
    }
    {
      u32x4 a[4], b[4], z[4], xr[8];
      const int t0 = r0 & (SEQ - 1);
#pragma unroll
      for (int i = 0; i < 4; ++i) {
        a[i] = *(const u32x4*)(OB + ((size_t)2 * TH + r0 + i) * 512 + c0); b[i] = *(const u32x4*)(OB + ((size_t)3 * TH + r0 + i) * 512 + c0);
        z[i] = *(const u32x4*)(Hh + (size_t)(r0 + i) * NPAD + S_Z + c0);
      }
#pragma unroll
      for (int m = 0; m < 8; ++m) {
        const int sq = t0 + m - 2;
        xr[m] = (u32x4){0u, 0u, 0u, 0u};
        if (sq >= 0 && sq < SEQ) xr[m] = *(const u32x4*)(Hh + (size_t)(r0 + m - 2) * NPAD + S_X + c0);
      }
      float gn[8], cbv[8];
#pragma unroll
      for (int j = 0; j < 8; ++j) { gn[j] = p.ssd_norm[l * 512 + c0 + j]; cbv[j] = cb[c0 + j]; }
      const float dsk = p.ssd_d[l * 8 + (c0 >> 6)];
#pragma unroll
      for (int i = 0; i < 4; ++i) {
        float u[8];
#pragma unroll
        for (int j = 0; j < 8; ++j) u[j] = cbv[j];
#pragma unroll
        for (int jj = 0; jj < 5; ++jj)
#pragma unroll
          for (int j = 0; j < 8; ++j) u[j] += cw[jj * 1024 + c0 + j] * bfe(xr[i + jj], j);
        float y[8]; float ss = 0.f;
#pragma unroll
        for (int j = 0; j < 8; ++j) {
          const float zz = bfe(z[i], j);
          const float xs = u[j] * frcp(1.f + ex2(fminf(-u[j] * LOG2E, 80.f)));
          y[j] = (bfe(a[i], j) + bfe(b[i], j) + dsk * xs) * (zz * frcp(1.f + ex2(fminf(-zz * LOG2E, 80.f))));
          ss += y[j] * y[j];
        }
#pragma unroll
        for (int of = 32; of >= 1; of >>= 1) ss += __shfl_xor(ss, of);
        const float rstd = rsqrtf(ss * (1.f / 512.f) + 1e-6f);
#pragma unroll
        for (int j = 0; j < 8; ++j) y[j] = y[j] * rstd * gn[j];
        *(u32x4*)(MX + (size_t)(r0 + i) * DI + 1024 + c0) = (u32x4){pk2(y[0], y[1]), pk2(y[2], y[3]), pk2(y[4], y[5]), pk2(y[6], y[7])};
      }
    }
  }
}

#define XB_TMO      128
#define XB_XCNT(j)  (256  + 64 * (j))
#define XB_XSUB(j)  (1280 + 64 * (j))
#define XB_XGEN(j)  (2304 + 64 * (j))
#define XB_TOP      3328
#define XB_TOPGEN   3392
#define XB_SPIN_CAP (1u << 22)
#define LAS __attribute__((address_space(3)))
DEV unsigned xb_ld(unsigned* p) { return __hip_atomic_load(p, __ATOMIC_RELAXED, __HIP_MEMORY_SCOPE_AGENT); }
DEV unsigned xb_add(unsigned* p, unsigned v) { return __hip_atomic_fetch_add(p, v, __ATOMIC_RELAXED, __HIP_MEMORY_SCOPE_AGENT); }
DEV unsigned xb_xcc_id() { return (unsigned)__builtin_amdgcn_s_getreg((3 << 11) | 20) & 0xFu; }
#define XB_SPIN(cond, bar) do { unsigned _sp = 0; while (cond) { __builtin_amdgcn_s_sleep(1); \
    if ((++_sp & 255u) == 0u) { if (xb_ld(&(bar)[XB_TMO])) break; if (_sp > XB_SPIN_CAP) { atomicAdd(&(bar)[XB_TMO], 1u); break; } } } } while (0)
struct XcdBarrier { unsigned* bar; unsigned x; volatile LAS unsigned* st; };
DEV XcdBarrier xcd_barrier_post(unsigned* bar, volatile LAS unsigned* st) {
  XcdBarrier b; b.bar = bar; b.x = xb_xcc_id(); b.st = st;
  if (threadIdx.x == 0) (void)xb_add(&bar[XB_XCNT(b.x)], 1u);
  return b;
}
DEV void xcd_barrier_complete(unsigned* bar, unsigned x, unsigned& nloc, unsigned& nx) {
  const unsigned G = gridDim.x * gridDim.y * gridDim.z;
  unsigned sum, cnt, mine, sp = 0u;
  for (;;) {
    sum = 0u; cnt = 0u; mine = 0u;
#pragma unroll
    for (unsigned j = 0; j < 16; ++j) { const unsigned c = xb_ld(&bar[XB_XCNT(j)]); sum += c; cnt += (c > 0u) ? 1u : 0u; mine = (j == x) ? c : mine; }
    if (sum == G) break;
    __builtin_amdgcn_s_sleep(1);
    if ((++sp & 255u) == 0u) { if (xb_ld(&bar[XB_TMO])) break; if (sp > XB_SPIN_CAP) { atomicAdd(&bar[XB_TMO], 1u); break; } }
  }
  nloc = mine > 0u ? mine : 1u; nx = cnt > 0u ? cnt : 1u;
}
DEV void xcd_barrier(const XcdBarrier& b) {
  asm volatile("s_waitcnt vmcnt(0)" ::: "memory");
  __syncthreads();
  if (threadIdx.x == 0) {
    unsigned* bar = b.bar;
    __builtin_amdgcn_s_waitcnt(0);
    unsigned nloc = b.st[0], nx = b.st[1];
    if (nloc == 0u) { xcd_barrier_complete(bar, b.x, nloc, nx); b.st[0] = nloc; b.st[1] = nx; }
    const unsigned old = xb_add(&bar[XB_XSUB(b.x)], 1u);
    const unsigned gen = old / nloc;
    if (old + 1u == (gen + 1u) * nloc) {
      __builtin_amdgcn_fence(__ATOMIC_RELEASE, "agent");
      asm volatile("s_waitcnt vmcnt(0)" ::: "memory");
      const unsigned og = xb_add(&bar[XB_TOP], 1u);
      const unsigned tg = og / nx;
      if (og + 1u == (tg + 1u) * nx) xb_add(&bar[XB_TOPGEN], 1u);
      else XB_SPIN(xb_ld(&bar[XB_TOPGEN]) == tg, bar);
      __builtin_amdgcn_fence(__ATOMIC_ACQUIRE, "agent");
      xb_add(&bar[XB_XGEN(b.x)], 1u);
      asm volatile("s_waitcnt vmcnt(0)" ::: "memory");
    } else {
      XB_SPIN(xb_ld(&bar[XB_XGEN(b.x)]) == gen, bar);
      __builtin_amdgcn_fence(__ATOMIC_ACQUIRE, "agent");
      asm volatile("s_waitcnt vmcnt(0)" ::: "memory");
    }
  }
  __syncthreads();
}

DEV void run_phase(const Params& p, int ph, int rep, unsigned char* smem) {
  if (ph == 0) { if (PH_MASK & 1) { phase_pro(p, smem); convert_weights(p, 0, 3, smem); } return; }
  if (ph == 25) { if (PH_MASK & 16) phase_outproj(p, 1, 1, smem); return; }
  if (ph == 26) { if (PH_MASK & 32) phase_ln(p, 1, 1); return; }
  const int q = ph - 1, blk = q / 6, st = q % 6, l = blk >> 1, hf = blk & 1;
  if (st == 0) {
    if (blk > 0 && (PH_MASK & 16)) phase_outproj(p, (blk - 1) >> 1, (blk - 1) & 1, smem);
    if (PH_MASK & 2) phase_inproj(p, l, hf, blk > 0 ? 16 : 0, smem);
  } else if (st == 1) {
    if (blk > 0 && rep == 0 && (PH_MASK & 32)) phase_ln(p, (blk - 1) >> 1, (blk - 1) & 1);
    if (PH_MASK & 4) phase_prep(p, l, hf, rep, smem);
    if ((PH_MASK & 1) && rep == 0 && blk == 1) convert_weights(p, 1, 1, smem);
    if ((PH_MASK & 1) && rep == 0 && blk == 2) convert_weights(p, 1, 2, smem);
  }
  else if (st == 2) { if (PH_MASK & 0xF00) phase_mix(p, l, hf, ph + 40 * rep, 1, 0, ATT_SPLIT, rep ? PROBE_LO : 0, rep ? PROBE_HI : 100000, smem); }
  else if (st == 3) { if (PH_MASK & 0x700) phase_scan2(p); }
  else if (st == 4) { if (PH_MASK & 0xF00) phase_mix(p, l, hf, ph + 40 * rep, 3, ATT_SPLIT, 256, rep ? PROBE_LO : 0, rep ? PROBE_HI : 100000, smem); }
  else { if (PH_MASK & 8) phase_fin(p, l, hf); }
}
__global__ void __launch_bounds__(NT) mega(Params p) {
  extern __shared__ __attribute__((aligned(16))) unsigned char smem[];
#if ONE_LAUNCH
  volatile LAS unsigned* xst = (volatile LAS unsigned*)(smem + LDS_BYTES - 32);
  if (threadIdx.x == 0) { xst[0] = 0u; xst[1] = 0u; }
  __syncthreads();
  XcdBarrier xb = xcd_barrier_post((unsigned*)(p.ws + OFF_CTRL), xst);
#endif
  Params* lp = (Params*)(smem + 147456);
  if (threadIdx.x == 0) *lp = p;
  __syncthreads();
  const int ph_begin = p.phase_begin, ph_end = p.phase_end;
  for (int ph = ph_begin; ph < ph_end; ++ph) {
    int nrep = 0;
#if PROBE_REP > 0
    {
      const int q = ph - 1, st = q % 6;
      const bool idem = (ph >= 1 && ph <= 24) && (st == PROBE_ST) && (st >= 1);
      if (idem) nrep = PROBE_REP;
    }
#endif
    for (int r = 0; r <= nrep; ++r) {
      run_phase(*lp, ph, r, smem);
#if ONE_LAUNCH
      if (r < nrep || ph + 1 < ph_end) xcd_barrier(xb);
#endif
    }
  }
}

extern "C" void kernel_launch(void* const* d_in, const int* in_sizes, int n_in, void* d_out, int out_size, void* d_ws, size_t ws_size,
                              hipStream_t stream) {
  static int grid_blocks = 0;
  if (!grid_blocks) {
    int dev = 0, cus = 0, per_cu = 0;
    hipGetDevice(&dev);
    hipDeviceGetAttribute(&cus, hipDeviceAttributeMultiprocessorCount, dev);
    hipFuncSetAttribute((const void*)mega, hipFuncAttributeMaxDynamicSharedMemorySize, LDS_BYTES);
    hipOccupancyMaxActiveBlocksPerMultiprocessor(&per_cu, mega, NT, LDS_BYTES);
    if (per_cu < 1) per_cu = 1;
    grid_blocks = cus;
  }
  Params p{};
  p.x = (const float*)d_in[0]; p.w_in = (const float*)d_in[1]; p.q_gain = (const float*)d_in[2]; p.k_gain = (const float*)d_in[3];
  p.lb_logits = (const float*)d_in[4]; p.hgrn_norm = (const float*)d_in[5]; p.conv_w = (const float*)d_in[6]; p.conv_b = (const float*)d_in[7];
  p.dt_bias = (const float*)d_in[8]; p.a_log = (const float*)d_in[9]; p.ssd_d = (const float*)d_in[10]; p.ssd_norm = (const float*)d_in[11];
  p.gk_w2 = (const float*)d_in[12]; p.gk_b = (const float*)d_in[13]; p.gla_norm = (const float*)d_in[14]; p.w_out = (const float*)d_in[15];
  p.ln_g = (const float*)d_in[16]; p.ln_b = (const float*)d_in[17];
  p.out = (float*)d_out; p.ws = (unsigned char*)d_ws;
  hipMemsetAsync(d_ws, 0, CTRL_BYTES, stream);
#if ONE_LAUNCH
  p.phase_begin = 0; p.phase_end = NPHASE;
  void* args[] = {&p};
  (void)args;
  hipLaunchKernelGGL(mega, dim3(grid_blocks), dim3(NT), LDS_BYTES, stream, p);
#else
  for (int ph = 0; ph < NPHASE; ++ph) {
    p.phase_begin = ph; p.phase_end = ph + 1;
    hipLaunchKernelGGL(mega, dim3(grid_blocks), dim3(NT), LDS_BYTES, stream, p);
  }
#endif
}
```

```cpp
#include <hip/hip_runtime.h>
#include <hip/hip_cooperative_groups.h>
#include <stdint.h>
#include <stdio.h>
namespace cg = cooperative_groups;

#ifndef ONE_LAUNCH
#define ONE_LAUNCH 1
#endif

#ifndef PH_MASK
#define PH_MASK 0xFFF
#endif
#ifndef PROBE_ST
#define PROBE_ST -1
#endif
#ifndef PROBE_REP
#define PROBE_REP 0
#endif
#ifndef PROBE_TYPE
#define PROBE_TYPE -1
#endif
#ifndef PROBE_LO
#define PROBE_LO 0
#endif
#ifndef PROBE_HI
#define PROBE_HI 100000
#endif
#define DEV __device__ __forceinline__
typedef unsigned short bf16_t;
typedef short bf16x8 __attribute__((ext_vector_type(8)));
typedef float f32x16 __attribute__((ext_vector_type(16)));
typedef unsigned u32x4 __attribute__((ext_vector_type(4)));
typedef float f32x4 __attribute__((ext_vector_type(4)));

constexpr int NT = 512;
constexpr int T_ALL = 16384, TH = 8192, SEQ = 4096, DM = 1024, NPAD = 7168, DI = 2048, NIN = 6960;
constexpr int A_Q = 0, A_K = 512, A_V = 640, A_Z = 768, H_Q = 1280, H_FF = 1792, H_FB = 2304, H_I = 2816, H_Z = 3328,
              S_X = 3840, S_Z = 4864, G_Q = 5376, G_K = 5632, G_V = 5888, G_Z = 6400, SM0 = 6912;
constexpr size_t OFF_CTRL = 0, OFF_TAB = 65536, OFF_XB = 131072;
constexpr size_t OFF_WIN = OFF_XB + (size_t)T_ALL * DM * 2;
constexpr size_t OFF_WOUT = OFF_WIN + (size_t)NPAD * DM * 2;
constexpr size_t OFF_H = OFF_WOUT + (size_t)DM * DI * 2;
constexpr size_t OFF_SMALL = OFF_H + (size_t)TH * NPAD * 2;
constexpr size_t OFF_OBUF = OFF_SMALL + (size_t)TH * 48 * 4;
constexpr size_t OFF_VT = OFF_OBUF + (size_t)6 * TH * 512 * 2;
constexpr size_t OFF_DB = OFF_VT + (size_t)2 * 2 * 64 * SEQ * 2;
constexpr int NSEG = 4, SLEN = 64 / NSEG;
constexpr size_t OFF_MIXED = OFF_DB + (size_t)64 * NSEG * 128 * 4;
constexpr size_t OFF_SB0 = OFF_MIXED, OFF_SB1 = OFF_SB0 + (size_t)16 * NSEG * 16384 * 4, OFF_SB2 = OFF_SB1 + (size_t)16 * NSEG * 8192 * 4;
constexpr size_t OFF_U = OFF_SB2 + (size_t)32 * NSEG * 8192 * 4;
constexpr size_t OFF_G = OFF_U + (size_t)TH * 1024 * 2;
constexpr size_t WS_END = (OFF_G + (size_t)TH * 512 * 2 > OFF_MIXED + (size_t)TH * DI * 2) ? (OFF_G + (size_t)TH * 512 * 2) : (OFF_MIXED + (size_t)TH * DI * 2);
static_assert(OFF_MIXED + (size_t)TH * DI * 2 <= WS_END, "MIXED must fit");
static_assert(WS_END <= 268435456, "workspace");
constexpr size_t CTRL_BYTES = 65536;
constexpr int CTR_WORD0 = 4096;
constexpr int LDS_BYTES = 148480;
constexpr float LOG2E = 1.4426950408889634f;
constexpr float QSCALE = 0.125f * LOG2E;
constexpr float DN_ALPHA = 1.4142135623730951f;
constexpr int NPHASE = 27;
constexpr int ATT_SPLIT = 256;

struct Params {
  const float* x; const float* w_in; const float* q_gain; const float* k_gain; const float* lb_logits; const float* hgrn_norm;
  const float* conv_w; const float* conv_b; const float* dt_bias; const float* a_log; const float* ssd_d; const float* ssd_norm;
  const float* gk_w2; const float* gk_b; const float* gla_norm; const float* w_out; const float* ln_g; const float* ln_b;
  float* out; unsigned char* ws;
  int phase_begin, phase_end;
};

DEV void lds_barrier() { asm volatile("s_waitcnt lgkmcnt(0)" ::: "memory"); __builtin_amdgcn_s_barrier(); asm volatile("" ::: "memory"); }
DEV int launder(int v) { asm volatile("" : "+v"(v)); return v; }
DEV float bf2f(bf16_t v) { return __uint_as_float(((unsigned)v) << 16); }
DEV bf16_t f2bf(float f) { unsigned u = __float_as_uint(f); u += 0x7fffu + ((u >> 16) & 1u); return (bf16_t)(u >> 16); }
typedef __bf16 bf16x2_t __attribute__((ext_vector_type(2)));
typedef float f32x2_t __attribute__((ext_vector_type(2)));
DEV unsigned pk2(float lo, float hi) { const f32x2_t f = {lo, hi}; const bf16x2_t b = __builtin_convertvector(f, bf16x2_t); return __builtin_bit_cast(unsigned, b); }
DEV float fsigmoid(float x) { return 1.f / (1.f + __expf(-x)); }
DEV float fsilu(float x) { return x / (1.f + __expf(-x)); }
DEV unsigned cvtpk(float lo, float hi) { return pk2(lo, hi); }
DEV float ex2(float x) { return __builtin_amdgcn_exp2f(x); }
DEV float lg2(float x) { return __builtin_amdgcn_logf(x); }
DEV float frcp(float x) { return __builtin_amdgcn_rcpf(x); }
DEV float lo16(unsigned u) { return __uint_as_float(u << 16); }
DEV float hi16(unsigned u) { return __uint_as_float(u & 0xffff0000u); }
DEV int rowoff(int reg, int h) { return (reg & 3) + 8 * (reg >> 2) + 4 * h; }
DEV f32x16 zero16() { f32x16 z;
#pragma unroll
  for (int i = 0; i < 16; ++i) z[i] = 0.f; return z; }

template <int KD>
DEV void mma32(f32x16& acc, const bf16_t* a, int lda, const bf16_t* b, int ldb, int lane) {
  const int r = lane & 31, h = lane >> 5;
  const bf16_t* ap = a + r * lda + 8 * h;
  const bf16_t* bp = b + r * ldb + 8 * h;
#pragma unroll 4
  for (int k = 0; k < KD; k += 16) {
    bf16x8 av = *(const bf16x8*)(ap + k);
    bf16x8 bv = *(const bf16x8*)(bp + k);
    acc = __builtin_amdgcn_mfma_f32_32x32x16_bf16(av, bv, acc, 0, 0, 0);
  }
}

DEV int orig_col(int n) {
  if (n < 4864) return n;
  if (n < 6400) return n + 16;
  if (n < 6912) return n + 48;
  if (n < 6928) return n - 2048;
  if (n < 6960) return n - 512;
  return -1;
}

DEV void convert_weights(const Params& p, int l, int which, unsigned char* smem) {
  float* s = (float*)smem;
  const int tid = launder(threadIdx.x);
  const float* win = p.w_in + (size_t)l * DM * NIN;
  const float* wout = p.w_out + (size_t)l * DI * DM;
  bf16_t* wint = (bf16_t*)(p.ws + OFF_WIN);
  bf16_t* woutt = (bf16_t*)(p.ws + OFF_WOUT);
  const int n_in_tiles = (NPAD / 64) * (DM / 64);
  const int n_out_tiles = (DM / 64) * (DI / 64);
  const int it_lo = (which & 1) ? 0 : n_in_tiles, it_hi = (which & 2) ? (n_in_tiles + n_out_tiles) : n_in_tiles;
  for (int it = it_lo + blockIdx.x; it < it_hi; it += gridDim.x) {
    lds_barrier();
    if (it < n_in_tiles) {
      const int n0 = (it / 16) * 64, k0 = (it % 16) * 64;
#pragma unroll
      for (int e = 0; e < 8; ++e) {
        const int idx = e * NT + tid, kk = idx >> 6, nn = idx & 63;
        const int oc = orig_col(n0 + nn);
        s[kk * 65 + nn] = (oc >= 0) ? win[(size_t)(k0 + kk) * NIN + oc] : 0.f;
      }
      lds_barrier();
      const int n = tid >> 3, kc = (tid & 7) * 8;
      uint4 o;
      o.x = pk2(s[(kc + 0) * 65 + n], s[(kc + 1) * 65 + n]); o.y = pk2(s[(kc + 2) * 65 + n], s[(kc + 3) * 65 + n]);
      o.z = pk2(s[(kc + 4) * 65 + n], s[(kc + 5) * 65 + n]); o.w = pk2(s[(kc + 6) * 65 + n], s[(kc + 7) * 65 + n]);
      *(uint4*)(wint + (size_t)(n0 + n) * DM + k0 + kc) = o;
    } else {
      const int j = it - n_in_tiles;
      const int n0 = (j / 32) * 64, k0 = (j % 32) * 64;
#pragma unroll
      for (int e = 0; e < 8; ++e) {
        const int idx = e * NT + tid, kk = idx >> 6, nn = idx & 63;
        s[kk * 65 + nn] = wout[(size_t)(k0 + kk) * DM + n0 + nn];
      }
      lds_barrier();
      const int n = tid >> 3, kc = (tid & 7) * 8;
      uint4 o;
      o.x = pk2(s[(kc + 0) * 65 + n], s[(kc + 1) * 65 + n]); o.y = pk2(s[(kc + 2) * 65 + n], s[(kc + 3) * 65 + n]);
      o.z = pk2(s[(kc + 4) * 65 + n], s[(kc + 5) * 65 + n]); o.w = pk2(s[(kc + 6) * 65 + n], s[(kc + 7) * 65 + n]);
      *(uint4*)(woutt + (size_t)(n0 + n) * DI + k0 + kc) = o;
    }
  }
  lds_barrier();
}

DEV void fsincos(float x, float& s, float& c) {
  const float k = rintf(x * 0.63661977236758134308f);
  float r = fmaf(-k, 1.5707855225e+00f, x);
  r = fmaf(-k, 1.0804273188e-05f, r);
  r = fmaf(-k, 6.0770999344e-11f, r);
  const float r2 = r * r;
  float ps = fmaf(r2, 2.7557319224e-06f, -1.9841269841e-04f);
  ps = fmaf(ps, r2, 8.3333333333e-03f); ps = fmaf(ps, r2, -1.6666666667e-01f);
  const float sinr = fmaf(ps * r2, r, r);
  float pc = fmaf(r2, -2.7557319224e-07f, 2.4801587302e-05f);
  pc = fmaf(pc, r2, -1.3888888889e-03f); pc = fmaf(pc, r2, 4.1666666667e-02f); pc = fmaf(pc, r2, -0.5f);
  const float cosr = fmaf(pc, r2, 1.0f);
  const int q = ((int)k) & 3;
  if (q == 0) { s = sinr; c = cosr; }
  else if (q == 1) { s = cosr; c = -sinr; }
  else if (q == 2) { s = -sinr; c = -cosr; }
  else { s = -cosr; c = sinr; }
}

DEV void phase_pro(const Params& p, unsigned char* smem) {
  const int tid = launder(threadIdx.x);
  const size_t gtid = (size_t)blockIdx.x * NT + tid, gsz = (size_t)gridDim.x * NT;
  const float4* x4 = (const float4*)p.x;
  uint4* xb4 = (uint4*)(p.ws + OFF_XB);
  for (size_t i = gtid; i < (size_t)T_ALL * DM / 8; i += gsz) {
    const float4 a = x4[2 * i], b = x4[2 * i + 1];
    uint4 o; o.x = pk2(a.x, a.y); o.y = pk2(a.z, a.w); o.z = pk2(b.x, b.y); o.w = pk2(b.z, b.w);
    xb4[i] = o;
  }
  if (blockIdx.x == 0) {
    float2* tab = (float2*)(p.ws + OFF_TAB);
    for (int i = tid; i < 64 * 16; i += NT) {
      const int pos = i >> 4, fi = i & 15;
      const float invf = exp2f(-(float)fi * (13.287712379549449f / 16.0f));
      const float ang = (float)pos * invf;
      float sn, cs; fsincos(ang, sn, cs);
      tab[i] = make_float2(cs, sn);
    }
  }
}

namespace pg8 {
#define PG8_LAS __attribute__((address_space(3)))
typedef unsigned short bf16_t;
typedef short bf16x8 __attribute__((ext_vector_type(8)));
typedef float f32x4 __attribute__((ext_vector_type(4)));
typedef unsigned u32x4 __attribute__((ext_vector_type(4)));
constexpr int BM = 256, BK = 64, HALF = 128, HTB = HALF * BK * 2  , STAGE_BYTES = 8 * HTB, NXCD = 8, WGM = 8;

__host__ __device__ __forceinline__ int lds_byte(int r, int c) { const int st = (r >> 4) * 2 + (c >> 5), rr = r & 15, cc = c & 31, ob = rr * 64 + cc * 2; return st * 1024 + (ob ^ (((ob >> 9) & 1) << 5)); }
__host__ __device__ __forceinline__ void stage_rc(int b, int& R, int& C) { const int st = b / 1024, sb = b % 1024, swz = sb ^ (((sb >> 9) & 1) << 5); R = (st >> 1) * 16 + swz / 64; C = (st & 1) * 32 + (swz % 64) / 2; }
__host__ __device__ __forceinline__ int perm32(int rho) { const int n = rho >> 4, i = rho & 15; return 8 * (i >> 2) + 4 * n + (i & 3); }

struct Unit { int pm, pn; };
struct Gemm { const bf16_t* A; const bf16_t* Bt; int M, N, K; };

__device__ __forceinline__ unsigned cvt_pk_bf16(float lo, float hi) { unsigned r; asm volatile("v_cvt_pk_bf16_f32 %0, %1, %2" : "=v"(r) : "v"(lo), "v"(hi)); return r; }

struct XcdOrder {
    int rpx, nN, x, c, ncu, skew;
    __device__ void init(int M, int N, int skew_ = 0) { rpx = (M / BM) / NXCD; nN = N / BM; x = blockIdx.x & 7; c = blockIdx.x >> 3; ncu = gridDim.x >> 3; skew = skew_; }
    __device__ bool next(int i, Unit& u) const {
        const int total = rpx * nN, full = (total / ncu) * ncu;
        int j = c + i * ncu;
        if (skew > 0 && j >= full) { const int cc = c - skew; j = (cc >= 0 && i == total / ncu) ? full + cc : total; }
        if (j >= total) return false; u.pm = rpx * x + (j % rpx); u.pn = j / rpx; return true; }
    __device__ __forceinline__ void a_ready(const Unit&) const {}
    __device__ __forceinline__ void done(const Unit&) const {}
};
struct EpiIn {
    static constexpr bool PERM = true, AFTER_DRAIN = false;
    bf16_t* O; int ldc; float* small; int small_pn;
    __device__ __forceinline__ void operator()(const f32x4 (&acc)[2][2][4][2], const Unit& u, int wr, int wc, int fr, int fq) const {
        const int row0 = u.pm * BM + wr * 64 + fr, col0 = u.pn * BM + wc * 32 + 8 * fq;
        if (u.pn == small_pn) {
            const int c = wc * 32 + 8 * fq;
            if (c < 48) {
#pragma unroll
                for (int ai = 0; ai < 2; ++ai)
#pragma unroll
                    for (int m = 0; m < 4; ++m) { float* rp = small + (size_t)(row0 + ai * HALF + m * 16) * 48 + c; *(f32x4*)rp = acc[ai][0][m][0]; *(f32x4*)(rp + 4) = acc[ai][0][m][1]; }
            }
            return;
        }
#pragma unroll
        for (int ai = 0; ai < 2; ++ai)
#pragma unroll
            for (int m = 0; m < 4; ++m) { bf16_t* rowp = O + (size_t)(row0 + ai * HALF + m * 16) * ldc + col0;
#pragma unroll
                for (int bj = 0; bj < 2; ++bj) { const f32x4 v0 = acc[ai][bj][m][0], v1 = acc[ai][bj][m][1];
                    u32x4 w; w.x = cvt_pk_bf16(v0[0], v0[1]); w.y = cvt_pk_bf16(v0[2], v0[3]); w.z = cvt_pk_bf16(v1[0], v1[1]); w.w = cvt_pk_bf16(v1[2], v1[3]);
                    *(u32x4*)(rowp + bj * HALF) = w; } }
    }
};
struct EpiOut {
    static constexpr bool PERM = true, AFTER_DRAIN = false;
    const float* X; float* Y; int ldc; float alpha;
    __device__ __forceinline__ void operator()(const f32x4 (&acc)[2][2][4][2], const Unit& u, int wr, int wc, int fr, int fq) const {
        const int row0 = u.pm * BM + wr * 64 + fr, col0 = u.pn * BM + wc * 32 + 8 * fq;
#pragma unroll
        for (int ai = 0; ai < 2; ++ai)
#pragma unroll
            for (int m = 0; m < 4; ++m) { const size_t off = (size_t)(row0 + ai * HALF + m * 16) * ldc + col0;
#pragma unroll
                for (int bj = 0; bj < 2; ++bj) { const f32x4 x0 = *(const f32x4*)(X + off + bj * HALF), x1 = *(const f32x4*)(X + off + bj * HALF + 4);
                    *(f32x4*)(Y + off + bj * HALF) = x0 * alpha + acc[ai][bj][m][0]; *(f32x4*)(Y + off + bj * HALF + 4) = x1 * alpha + acc[ai][bj][m][1]; } }
    }
};

template <class Epi, class Sched, bool ALIGN_EPI = false, bool SP2 = false>
__device__ __forceinline__ void gemm_phase(PG8_LAS unsigned char* lds, const Gemm g, const Sched& S, const Epi& E) {
    const int tid = launder((int)threadIdx.x), wid = __builtin_amdgcn_readfirstlane(tid >> 6), lane = tid & 63, wr = wid >> 2, wc = wid & 3, fr = lane & 15, fq = lane >> 4;
    const int K = g.K, nt = K / BK;
    unsigned voffA[2], voffB[2];
#pragma unroll
    for (int i = 0; i < 2; ++i) { int R, C; stage_rc(tid * 16 + i * 8192, R, C); const int Rb = Epi::PERM ? ((R & ~31) + perm32(R & 31)) : R;
        voffA[i] = (unsigned)(R * K + C) * 2u; voffB[i] = (unsigned)(Rb * K + C) * 2u; }
    const size_t kstep = (size_t)(BK * 2);
    const size_t hstep = (size_t)HALF * K * 2;
    const size_t tstep = 2 * hstep;
    const unsigned ldsw = (unsigned)wid * 1024u;
    const int aoff = lds_byte(wr * 64 + fr, fq * 8), boff = lds_byte(wc * 32 + fr, fq * 8);
#define PG8_SA(b, h) (((b) * 2 + (h)) * HTB)
#define PG8_SB(b, h) ((4 + (b) * 2 + (h)) * HTB)
#define PG8_STAGE(bufoff, gbase, voff) do { _Pragma("unroll") for (int _i = 0; _i < 2; ++_i) \
        __builtin_amdgcn_global_load_lds((const unsigned*)((const char*)(gbase) + (voff)[_i]), (PG8_LAS unsigned*)(lds + (bufoff) + ldsw + _i * 8192), 16, 0, 0); } while (0)
#define PG8_LDA(dst, b, h) do { _Pragma("unroll") for (int m = 0; m < 4; ++m) _Pragma("unroll") for (int k = 0; k < 2; ++k) dst[m][k] = *(const PG8_LAS bf16x8*)(lds + PG8_SA(b, h) + aoff + m * 2048 + k * 1024); } while (0)
#define PG8_LDB(dst, b, h) do { _Pragma("unroll") for (int n = 0; n < 2; ++n) _Pragma("unroll") for (int k = 0; k < 2; ++k) dst[n][k] = *(const PG8_LAS bf16x8*)(lds + PG8_SB(b, h) + boff + n * 2048 + k * 1024); } while (0)
#define PG8_MMA(ai, bj, At, Bt) do { __builtin_amdgcn_s_setprio(1); _Pragma("unroll") for (int m = 0; m < 4; ++m) _Pragma("unroll") for (int n = 0; n < 2; ++n) _Pragma("unroll") for (int k = 0; k < 2; ++k) \
        acc[ai][bj][m][n] = __builtin_amdgcn_mfma_f32_16x16x32_bf16(Bt[n][k], At[m][k], acc[ai][bj][m][n], 0, 0, 0); __builtin_amdgcn_s_setprio(0); } while (0)
#define PG8_WAIT_V(n) asm volatile("s_waitcnt vmcnt(" #n ")" ::: "memory")
#define PG8_WAIT_L(n) asm volatile("s_waitcnt lgkmcnt(" #n ")" ::: "memory")
#define PG8_BAR __builtin_amdgcn_s_barrier()
#define PG8_SCHED __builtin_amdgcn_sched_barrier(0)
    Unit cur, nxt; int ui = 0;
    if (!S.next(0, cur)) return;
    f32x4 acc[2][2][4][2];
#pragma unroll
    for (int a = 0; a < 2; ++a)
#pragma unroll
        for (int b = 0; b < 2; ++b)
#pragma unroll
            for (int m = 0; m < 4; ++m)
#pragma unroll
                for (int n = 0; n < 2; ++n) acc[a][b][m][n] = (f32x4){0.f, 0.f, 0.f, 0.f};
    bf16x8 At[4][2], B0[2][2], B1[2][2];
    const char* cA = (const char*)g.A + (size_t)cur.pm * tstep; const char* cB = (const char*)g.Bt + (size_t)cur.pn * tstep;
    S.a_ready(cur);
    if constexpr (SP2) {
        PG8_STAGE(PG8_SB(0, 0), cB, voffB); PG8_STAGE(PG8_SB(0, 1), cB + hstep, voffB); PG8_STAGE(PG8_SA(0, 0), cA, voffA); PG8_STAGE(PG8_SA(0, 1), cA + hstep, voffA);
        if (wr == 1) PG8_BAR;
        PG8_WAIT_V(2); PG8_BAR;
        PG8_STAGE(PG8_SB(1, 0), cB + kstep, voffB); PG8_STAGE(PG8_SA(1, 0), cA + kstep, voffA); PG8_STAGE(PG8_SB(1, 1), cB + hstep + kstep, voffB);
        PG8_WAIT_V(6); PG8_BAR;
    } else {
        PG8_STAGE(PG8_SB(0, 0), cB, voffB); PG8_STAGE(PG8_SA(0, 0), cA, voffA); PG8_STAGE(PG8_SB(0, 1), cB + hstep, voffB); PG8_STAGE(PG8_SA(0, 1), cA + hstep, voffA);
        if (wr == 1) PG8_BAR;
        PG8_WAIT_V(4); PG8_BAR;
        PG8_STAGE(PG8_SB(1, 0), cB + kstep, voffB); PG8_STAGE(PG8_SA(1, 0), cA + kstep, voffA); PG8_STAGE(PG8_SB(1, 1), cB + hstep + kstep, voffB);
        PG8_WAIT_V(6); PG8_BAR;
    }
    for (;;) {
        const bool has_next = S.next(ui + 1, nxt);
        const char* nA = has_next ? (const char*)g.A + (size_t)nxt.pm * tstep : cA; const char* nB = has_next ? (const char*)g.Bt + (size_t)nxt.pn * tstep : cB;
        for (int t = 0; t < nt; t += 2) {
            const bool last = (t == nt - 2);
            const char* a1 = cA + (size_t)(t + 1) * kstep;
            const char* a2 = last ? nA : cA + (size_t)(t + 2) * kstep; const char* b2 = last ? nB : cB + (size_t)(t + 2) * kstep;
            const char* a3 = a2 + kstep; const char* b3 = b2 + kstep;
            if (last && has_next) S.a_ready(nxt);
            if constexpr (SP2) {
            PG8_LDB(B0, 0, 0); PG8_LDB(B1, 0, 1); PG8_SCHED; PG8_LDA(At, 0, 0); PG8_STAGE(PG8_SA(1, 1), a1 + hstep, voffA);
            PG8_WAIT_V(8); PG8_WAIT_L(0); PG8_BAR; PG8_MMA(0, 0, At, B0); PG8_MMA(0, 1, At, B1); PG8_BAR; PG8_SCHED;
            PG8_LDA(At, 0, 1); PG8_STAGE(PG8_SB(0, 0), b2, voffB); PG8_STAGE(PG8_SB(0, 1), b2 + hstep, voffB); PG8_STAGE(PG8_SA(0, 0), a2, voffA);
            PG8_WAIT_V(8); PG8_WAIT_L(0); PG8_BAR; PG8_MMA(1, 0, At, B0); PG8_MMA(1, 1, At, B1); PG8_BAR; PG8_SCHED;
            PG8_LDB(B0, 1, 0); PG8_LDB(B1, 1, 1); PG8_SCHED; PG8_LDA(At, 1, 0); PG8_STAGE(PG8_SA(0, 1), a2 + hstep, voffA);
            PG8_WAIT_V(8); PG8_WAIT_L(0); PG8_BAR; PG8_MMA(0, 0, At, B0); PG8_MMA(0, 1, At, B1); PG8_BAR; PG8_SCHED;
            PG8_LDA(At, 1, 1); PG8_STAGE(PG8_SB(1, 0), b3, voffB); PG8_STAGE(PG8_SB(1, 1), b3 + hstep, voffB); PG8_STAGE(PG8_SA(1, 0), a3, voffA);
            PG8_WAIT_V(8); PG8_WAIT_L(0); PG8_BAR; PG8_MMA(1, 0, At, B0); PG8_MMA(1, 1, At, B1); PG8_BAR; PG8_SCHED;
            } else {
            PG8_LDB(B0, 0, 0); PG8_SCHED; PG8_LDA(At, 0, 0); PG8_STAGE(PG8_SA(1, 1), a1 + hstep, voffA);
            PG8_WAIT_L(8); PG8_BAR; PG8_WAIT_L(0); PG8_MMA(0, 0, At, B0); PG8_BAR; PG8_SCHED;
            PG8_LDB(B1, 0, 1); PG8_STAGE(PG8_SB(0, 0), b2, voffB);
            PG8_BAR; PG8_WAIT_L(0); PG8_MMA(0, 1, At, B1); PG8_BAR;
            PG8_LDA(At, 0, 1); PG8_STAGE(PG8_SA(0, 0), a2, voffA);
            PG8_BAR; PG8_WAIT_L(0); PG8_MMA(1, 0, At, B0); PG8_BAR; PG8_SCHED;
            PG8_STAGE(PG8_SB(0, 1), b2 + hstep, voffB);
            PG8_WAIT_V(6); PG8_BAR; PG8_MMA(1, 1, At, B1); PG8_BAR;
            PG8_LDB(B0, 1, 0); PG8_SCHED; PG8_LDA(At, 1, 0); PG8_STAGE(PG8_SA(0, 1), a2 + hstep, voffA);
            PG8_WAIT_L(8); PG8_BAR; PG8_WAIT_L(0); PG8_MMA(0, 0, At, B0); PG8_BAR; PG8_SCHED;
            PG8_LDB(B1, 1, 1); PG8_STAGE(PG8_SB(1, 0), b3, voffB);
            PG8_BAR; PG8_WAIT_L(0); PG8_MMA(0, 1, At, B1); PG8_BAR;
            PG8_LDA(At, 1, 1); PG8_STAGE(PG8_SA(1, 0), a3, voffA);
            PG8_BAR; PG8_WAIT_L(0); PG8_MMA(1, 0, At, B0); PG8_BAR; PG8_SCHED;
            PG8_STAGE(PG8_SB(1, 1), b3 + hstep, voffB);
            PG8_WAIT_V(6); PG8_BAR; PG8_MMA(1, 1, At, B1); PG8_BAR;
            }
        }
        if constexpr (ALIGN_EPI) { if (wr == 0) PG8_BAR; }
        if constexpr (!Epi::AFTER_DRAIN) { E(acc, cur, wr, wc, fr, fq); S.done(cur); }
        if (!has_next) break;
#pragma unroll
        for (int a = 0; a < 2; ++a)
#pragma unroll
            for (int b = 0; b < 2; ++b)
#pragma unroll
                for (int m = 0; m < 4; ++m)
#pragma unroll
                    for (int n = 0; n < 2; ++n) acc[a][b][m][n] = (f32x4){0.f, 0.f, 0.f, 0.f};
        cur = nxt; cA = nA; cB = nB; ++ui;
        if constexpr (ALIGN_EPI) { if (wr == 1) PG8_BAR; }
    }
    PG8_WAIT_V(0);
    if constexpr (!ALIGN_EPI) { if (wr == 0) PG8_BAR; }
    PG8_BAR;
    if constexpr (Epi::AFTER_DRAIN) { E.fused(acc, cur, wr, wc, fr, fq, lds, wid, lane); S.done(cur); }
#undef PG8_SA
#undef PG8_SB
#undef PG8_STAGE
#undef PG8_LDA
#undef PG8_LDB
#undef PG8_MMA
#undef PG8_WAIT_V
#undef PG8_WAIT_L
#undef PG8_BAR
#undef PG8_SCHED
}
}

DEV void phase_inproj(const Params& p, int l, int hf, int skew, unsigned char* smem) {
  pg8::Gemm g{(const bf16_t*)(p.ws + OFF_XB) + (size_t)hf * TH * DM, (const bf16_t*)(p.ws + OFF_WIN), TH, NPAD, DM};
  pg8::XcdOrder S; S.init(TH, NPAD, skew);
  pg8::EpiIn E{(bf16_t*)(p.ws + OFF_H), NPAD, (float*)(p.ws + OFF_SMALL), SM0 / 256};
  pg8::gemm_phase<pg8::EpiIn, pg8::XcdOrder, true, true>((PG8_LAS unsigned char*)smem, g, S, E);
}

DEV void phase_outproj(const Params& p, int l, int hf, unsigned char* smem) {
  pg8::Gemm g{(const bf16_t*)(p.ws + OFF_MIXED), (const bf16_t*)(p.ws + OFF_WOUT), TH, DM, DI};
  pg8::XcdOrder S; S.init(TH, DM);
  const float* xin = ((l == 0) ? p.x : p.out) + (size_t)hf * TH * DM;
  pg8::EpiOut E{xin, p.out + (size_t)hf * TH * DM, DM, DN_ALPHA};
  pg8::gemm_phase<pg8::EpiOut, pg8::XcdOrder, true, true>((PG8_LAS unsigned char*)smem, g, S, E);
}

DEV void phase_ln(const Params& p, int l, int hf) {
  const int tid = launder(threadIdx.x), lane = tid & 63, w = tid >> 6;
  const float* g = p.ln_g + l * DM; const float* b = p.ln_b + l * DM;
  bf16_t* xb = (bf16_t*)(p.ws + OFF_XB);
  for (int r0 = (blockIdx.x * 8 + w) * 4; r0 < TH; r0 += gridDim.x * 32) {
    f32x4 v[4][4];
#pragma unroll
    for (int i = 0; i < 4; ++i)
#pragma unroll
      for (int j = 0; j < 4; ++j) v[i][j] = ((const f32x4*)(p.out + (size_t)(hf * TH + r0 + i) * DM))[j * 64 + lane];
    f32x4 gg[4], bb[4];
#pragma unroll
    for (int j = 0; j < 4; ++j) { gg[j] = ((const f32x4*)g)[j * 64 + lane]; bb[j] = ((const f32x4*)b)[j * 64 + lane]; }
#pragma unroll
    for (int i = 0; i < 4; ++i) {
      const int row = hf * TH + r0 + i;
      float sm = 0.f;
#pragma unroll
      for (int j = 0; j < 4; ++j) sm += (v[i][j][0] + v[i][j][1]) + (v[i][j][2] + v[i][j][3]);
#pragma unroll
      for (int o = 32; o >= 1; o >>= 1) sm += __shfl_xor(sm, o);
      const float mu = sm * (1.f / DM);
      float q = 0.f;
#pragma unroll
      for (int j = 0; j < 4; ++j) { const f32x4 d = v[i][j] - mu; q += (d[0] * d[0] + d[1] * d[1]) + (d[2] * d[2] + d[3] * d[3]); }
#pragma unroll
      for (int o = 32; o >= 1; o >>= 1) q += __shfl_xor(q, o);
      const float rstd = rsqrtf(q * (1.f / DM) + 1e-5f);
#pragma unroll
      for (int j = 0; j < 4; ++j) {
        const f32x4 o = (v[i][j] - mu) * rstd * gg[j] + bb[j];
        ((f32x4*)(p.out + (size_t)row * DM))[j * 64 + lane] = o;
        if (l == 0) *(uint2*)(xb + (size_t)row * DM + (j * 64 + lane) * 4) = make_uint2(pk2(o[0], o[1]), pk2(o[2], o[3]));
      }
    }
  }
}

DEV void attn_item(const Params& p, int l, int item, unsigned char* smem) {
  const int tid = launder(threadIdx.x), lane = tid & 63, w = tid >> 6, r = lane & 31, h = lane >> 5;
  const int qt = item & 15, head = (item >> 4) & 7, bl = item >> 7;
  const int kvh = head >> 2;
  bf16_t* Hh = (bf16_t*)(p.ws + OFF_H);
  const bf16_t* VT = (const bf16_t*)(p.ws + OFF_VT);
  const size_t rowbase = (size_t)bl * SEQ;
  float mq = fabsf(p.q_gain[l * 64 + lane]), mk = fabsf(p.k_gain[l * 64 + lane]);
#pragma unroll
  for (int o = 32; o >= 1; o >>= 1) { mq = fmaxf(mq, __shfl_xor(mq, o)); mk = fmaxf(mk, __shfl_xor(mk, o)); }
  const float M2 = 8.f * mq * mk * LOG2E * 1.01f;
  const int qrow = qt * 256 + w * 32 + r;
  const bf16_t* qp = Hh + (rowbase + qrow) * NPAD + A_Q + head * 64 + 8 * h;
  bf16x8 qf[4];
#pragma unroll
  for (int ks = 0; ks < 4; ++ks) qf[ks] = *(const bf16x8*)(qp + ks * 16);
  f32x16 o0 = zero16(), o1 = zero16();
  float lsum = 0.f;
  const int srow = tid >> 3, sch = (tid & 7) * 8;
  const bf16_t* kp = Hh + (rowbase + srow) * NPAD + A_K + kvh * 64 + sch;
  const bf16_t* vp = VT + ((size_t)((bl * 2 + kvh) * 64 + srow)) * SEQ + sch;
  union PB { bf16x8 v; unsigned u[4]; };
  auto qk = [&](int st, f32x16& s0, f32x16& s1) __attribute__((always_inline)) {
    const bf16_t* sK = (const bf16_t*)(smem + st * 18432);
#pragma unroll
    for (int i = 0; i < 16; ++i) { s0[i] = -M2; s1[i] = -M2; }
#pragma unroll
    for (int ks = 0; ks < 4; ++ks) {
      const bf16x8 a0 = *(const bf16x8*)(sK + r * 72 + ks * 16 + 8 * h);
      const bf16x8 a1 = *(const bf16x8*)(sK + (32 + r) * 72 + ks * 16 + 8 * h);
      s0 = __builtin_amdgcn_mfma_f32_32x32x16_bf16(a0, qf[ks], s0, 0, 0, 0);
      s1 = __builtin_amdgcn_mfma_f32_32x32x16_bf16(a1, qf[ks], s1, 0, 0, 0);
    }
  };
  auto soft = [&](f32x16& s0, f32x16& s1, PB (&pb)[2][2]) __attribute__((always_inline)) {
#pragma unroll
    for (int i = 0; i < 16; ++i) { s0[i] = __builtin_amdgcn_exp2f(s0[i]); s1[i] = __builtin_amdgcn_exp2f(s1[i]); lsum += s0[i] + s1[i]; }
#pragma unroll
    for (int s = 0; s < 2; ++s)
#pragma unroll
      for (int j = 0; j < 4; ++j) {
        pb[0][s].u[j] = pk2(s0[8 * s + 2 * j], s0[8 * s + 2 * j + 1]);
        pb[1][s].u[j] = pk2(s1[8 * s + 2 * j], s1[8 * s + 2 * j + 1]);
      }
  };
  auto pv = [&](int st, const PB (&pb)[2][2]) __attribute__((always_inline)) {
    const bf16_t* sV = (const bf16_t*)(smem + st * 18432 + 9216);
#pragma unroll
    for (int kt2 = 0; kt2 < 2; ++kt2)
#pragma unroll
      for (int s = 0; s < 2; ++s) {
        const int kb = kt2 * 32 + 16 * s + 4 * h;
        union { bf16x8 v; uint2 u[2]; } a0, a1;
        a0.u[0] = *(const uint2*)(sV + r * 72 + kb); a0.u[1] = *(const uint2*)(sV + r * 72 + kb + 8);
        a1.u[0] = *(const uint2*)(sV + (32 + r) * 72 + kb); a1.u[1] = *(const uint2*)(sV + (32 + r) * 72 + kb + 8);
        o0 = __builtin_amdgcn_mfma_f32_32x32x16_bf16(a0.v, pb[kt2][s].v, o0, 0, 0, 0);
        o1 = __builtin_amdgcn_mfma_f32_32x32x16_bf16(a1.v, pb[kt2][s].v, o1, 0, 0, 0);
      }
  };
  auto compute2 = [&](int sta, int stb) __attribute__((always_inline)) {
    f32x16 sa0, sa1, sb0, sb1; PB pa[2][2], pbb[2][2];
    qk(sta, sa0, sa1); qk(stb, sb0, sb1);
    soft(sa0, sa1, pa); pv(sta, pa);
    soft(sb0, sb1, pbb); pv(stb, pbb);
  };
  constexpr int NKT = SEQ / 64;
  auto sstore = [&](int st, const u32x4& kk, const u32x4& vv) __attribute__((always_inline)) {
    *(u32x4*)(smem + st * 18432 + srow * 144 + sch * 2) = kk;
    *(u32x4*)(smem + st * 18432 + 9216 + srow * 144 + sch * 2) = vv;
  };
  u32x4 k0 = *(const u32x4*)kp, v0 = *(const u32x4*)vp;
  u32x4 k1 = *(const u32x4*)(kp + (size_t)64 * NPAD), v1 = *(const u32x4*)(vp + 64);
  sstore(0, k0, v0); sstore(1, k1, v1);
  k0 = *(const u32x4*)(kp + (size_t)2 * 64 * NPAD); v0 = *(const u32x4*)(vp + 2 * 64);
  k1 = *(const u32x4*)(kp + (size_t)3 * 64 * NPAD); v1 = *(const u32x4*)(vp + 3 * 64);
  lds_barrier();
  for (int kt = 0; kt < NKT; kt += 4) {
    sstore(2, k0, v0); sstore(3, k1, v1);
    if (kt + 4 < NKT) {
      k0 = *(const u32x4*)(kp + (size_t)(kt + 4) * 64 * NPAD); v0 = *(const u32x4*)(vp + (kt + 4) * 64);
      k1 = *(const u32x4*)(kp + (size_t)(kt + 5) * 64 * NPAD); v1 = *(const u32x4*)(vp + (kt + 5) * 64);
    }
    compute2(0, 1);
    lds_barrier();
    if (kt + 4 < NKT) {
      sstore(0, k0, v0); sstore(1, k1, v1);
      if (kt + 6 < NKT) {
        k0 = *(const u32x4*)(kp + (size_t)(kt + 6) * 64 * NPAD); v0 = *(const u32x4*)(vp + (kt + 6) * 64);
        k1 = *(const u32x4*)(kp + (size_t)(kt + 7) * 64 * NPAD); v1 = *(const u32x4*)(vp + (kt + 7) * 64);
      }
    }
    compute2(2, 3);
    lds_barrier();
  }
  lsum += __shfl_xor(lsum, 32);
  const float inv = 1.f / lsum;
  const bf16_t* zp = Hh + (rowbase + qrow) * NPAD + A_Z + head * 64;
  bf16_t* op = Hh + (rowbase + qrow) * NPAD + A_Q + head * 64;
#pragma unroll
  for (int dt = 0; dt < 2; ++dt)
#pragma unroll
    for (int g = 0; g < 4; ++g) {
      const int d0 = dt * 32 + 8 * g + 4 * h;
      const uint2 zz = *(const uint2*)(zp + d0);
      const float z0 = bf2f((bf16_t)(zz.x & 0xffff)), z1 = bf2f((bf16_t)(zz.x >> 16)), z2 = bf2f((bf16_t)(zz.y & 0xffff)), z3 = bf2f((bf16_t)(zz.y >> 16));
      const f32x16& oo = dt ? o1 : o0;
      uint2 ov;
      ov.x = pk2(oo[4 * g + 0] * inv * fsilu(z0), oo[4 * g + 1] * inv * fsilu(z1));
      ov.y = pk2(oo[4 * g + 2] * inv * fsilu(z2), oo[4 * g + 3] * inv * fsilu(z3));
      *(uint2*)(op + d0) = ov;
    }
  lds_barrier();
}

constexpr int L_QT = 0, L_KT = 17408, L_QC = 34816, L_KHT = 52224, L_VT = 70656, L_ST = 89088,
              L_D = 123904, L_TOT = 124416, L_ACS = 128512, L_DT = 129024;

template <int K, int V> struct ScanGeom {
  static constexpr int KP = K + 8;
  static constexpr int NS = (K / 32) * (V / 32) / 8;
};

template <int K, int V>
DEV void scan_write_state(unsigned char* smem, const f32x16* S, int w, int lane) {
  constexpr int KP = K + 8, NS = ScanGeom<K, V>::NS, NVT = V / 32;
  bf16_t* sST = (bf16_t*)(smem + L_ST);
  const int c = lane & 31, h = lane >> 5;
#pragma unroll
  for (int i = 0; i < NS; ++i) {
    const int tile = w * NS + i, kt = tile / NVT, nt = tile % NVT;
#pragma unroll
    for (int g = 0; g < 4; ++g) {
      uint2 o; o.x = pk2(S[i][4 * g + 0], S[i][4 * g + 1]); o.y = pk2(S[i][4 * g + 2], S[i][4 * g + 3]);
      *(uint2*)(sST + (nt * 32 + c) * KP + kt * 32 + 8 * g + 4 * h) = o;
    }
  }
}

template <int K, int V, bool SSDM>
DEV void scan_core(unsigned char* smem, f32x16* S, bf16_t* orow0, int dir, int w, int lane, bool do_out, const float* sAcs) {
  constexpr int KP = K + 8, NS = ScanGeom<K, V>::NS, NVT = V / 32, NOT = 2 * NVT;
  const bf16_t* sQt = (const bf16_t*)(smem + L_QT); const bf16_t* sKt = (const bf16_t*)(smem + L_KT);
  const bf16_t* sQc = (const bf16_t*)(smem + L_QC); const bf16_t* sKhT = (const bf16_t*)(smem + L_KHT);
  const bf16_t* sVT = (const bf16_t*)(smem + L_VT);
  const bf16_t* sST = (const bf16_t*)(smem + L_ST); const float* sD = (const float*)(smem + L_D);
  const int c = lane & 31, h = lane >> 5;
  if (do_out && w < NOT) {
    const int tt = w / NVT, nt = w % NVT;
    f32x16 acc = zero16();
#pragma unroll
    for (int st = 0; st < 2; ++st) {
      if (st <= tt) {
        f32x16 pt = zero16();
        mma32<K>(pt, sKt + st * 32 * KP, KP, sQt + tt * 32 * KP, KP, lane);
        const int tau = tt * 32 + c;
        const float at = SSDM ? sAcs[tau] : 0.f;
#pragma unroll
        for (int reg = 0; reg < 16; ++reg) {
          const int sig = st * 32 + rowoff(reg, h);
          float v = pt[reg];
          if (SSDM) v *= ex2(at - sAcs[sig]);
          pt[reg] = (sig <= tau) ? v : 0.f;
        }
#pragma unroll
        for (int s2 = 0; s2 < 2; ++s2) {
          union { bf16x8 v; unsigned u[4]; } pa;
#pragma unroll
          for (int j = 0; j < 4; ++j) pa.u[j] = pk2(pt[8 * s2 + 2 * j], pt[8 * s2 + 2 * j + 1]);
          const int kb = st * 32 + 16 * s2 + 4 * h;
          union { bf16x8 v; uint2 u[2]; } vb;
          vb.u[0] = *(const uint2*)(sVT + (nt * 32 + c) * 72 + kb); vb.u[1] = *(const uint2*)(sVT + (nt * 32 + c) * 72 + kb + 8);
          acc = __builtin_amdgcn_mfma_f32_32x32x16_bf16(pa.v, vb.v, acc, 0, 0, 0);
        }
      }
    }
    mma32<K>(acc, sQc + tt * 32 * KP, KP, sST + nt * 32 * KP, KP, lane);
#pragma unroll
    for (int reg = 0; reg < 16; ++reg) {
      const int tau = tt * 32 + rowoff(reg, h);
      const int tok = dir ? (63 - tau) : tau;
      orow0[(size_t)tok * 512 + nt * 32 + c] = f2bf(acc[reg]);
    }
  }
#pragma unroll
  for (int i = 0; i < NS; ++i) {
    const int tile = w * NS + i, kt = tile / NVT, nt = tile % NVT;
#pragma unroll
    for (int reg = 0; reg < 16; ++reg) S[i][reg] *= sD[kt * 32 + rowoff(reg, h)];
    mma32<64>(S[i], sKhT + kt * 32 * 72, 72, sVT + nt * 32 * 72, 72, lane);
  }
}

template <int K, int V>
DEV void state_store(float* buf, const f32x16* S, int w, int lane) {
  constexpr int NS = ScanGeom<K, V>::NS, NVT = V / 32;
  const int c = lane & 31, h = lane >> 5;
#pragma unroll
  for (int i = 0; i < NS; ++i) {
    const int tile = w * NS + i, kt = tile / NVT, nt = tile % NVT;
#pragma unroll
    for (int reg = 0; reg < 16; ++reg) buf[(kt * 32 + rowoff(reg, h)) * V + nt * 32 + c] = S[i][reg];
  }
}
template <int K, int V>
DEV void state_load(const float* buf, f32x16* S, int w, int lane) {
  constexpr int NS = ScanGeom<K, V>::NS, NVT = V / 32;
  const int c = lane & 31, h = lane >> 5;
#pragma unroll
  for (int i = 0; i < NS; ++i) {
    const int tile = w * NS + i, kt = tile / NVT, nt = tile % NVT;
#pragma unroll
    for (int reg = 0; reg < 16; ++reg) S[i][reg] = buf[(kt * 32 + rowoff(reg, h)) * V + nt * 32 + c];
  }
}

#define PACK8_LO(v) (u32x4){((v)[0] & 0xffffu) | ((v)[1] << 16), ((v)[2] & 0xffffu) | ((v)[3] << 16), ((v)[4] & 0xffffu) | ((v)[5] << 16), ((v)[6] & 0xffffu) | ((v)[7] << 16)}
#define PACK8_HI(v) (u32x4){((v)[0] >> 16) | ((v)[1] & 0xffff0000u), ((v)[2] >> 16) | ((v)[3] & 0xffff0000u), ((v)[4] >> 16) | ((v)[5] & 0xffff0000u), ((v)[6] >> 16) | ((v)[7] & 0xffff0000u)}
#define CVT8(f) (u32x4){pk2((f)[0], (f)[1]), pk2((f)[2], (f)[3]), pk2((f)[4], (f)[5]), pk2((f)[6], (f)[7])}


DEV void hgrn_item(const Params& p, int l, int it, int seg, int mode, unsigned char* smem) {
  const int bl = it >> 3, head = (it >> 1) & 3, dir = it & 1;
  const bool do_out = (mode == 3);
  constexpr int K = 128, V = 128, KPW = 68;
  const int tid = launder(threadIdx.x), lane = tid & 63, w = tid >> 6;
  const int cp = tid & 63, tg = tid >> 6, ch0 = 2 * cp;
  const bf16_t* Hh = (const bf16_t*)(p.ws + OFF_H);
  bf16_t* OB = (bf16_t*)(p.ws + OFF_OBUF) + (size_t)(0 * 2 + dir) * TH * 512;
  const size_t rowbase = (size_t)bl * SEQ;
  float lb0 = 0.f, lb1 = 0.f;
  if (l > 0) {
    lb0 = fsigmoid(p.lb_logits[512 + head * 128 + ch0] - p.lb_logits[head * 128 + ch0]);
    lb1 = fsigmoid(p.lb_logits[512 + head * 128 + ch0 + 1] - p.lb_logits[head * 128 + ch0 + 1]);
  }
  const float om0 = 1.f - lb0, om1 = 1.f - lb1;
  const int fbase = dir ? H_FB : H_FF;
  unsigned* sQt = (unsigned*)(smem + L_QT); unsigned* sKt = (unsigned*)(smem + L_KT); unsigned* sQc = (unsigned*)(smem + L_QC);
  bf16_t* sKhT = (bf16_t*)(smem + L_KHT); bf16_t* sVT = (bf16_t*)(smem + L_VT);
  float* sD = (float*)(smem + L_D); float* sTot = (float*)(smem + L_TOT);
  f32x16 S[2]; S[0] = zero16(); S[1] = zero16();
  float* sbuf = (float*)(p.ws + OFF_SB0) + ((size_t)it * NSEG + seg) * 16384;
  if (do_out) state_load<K, V>(sbuf, S, w, lane);
  float dlog0 = 0.f, dlog1 = 0.f;
  unsigned pf[8], qq[8], vv[8];
  float g0[8], g1[8], kx0[8], kx1[8];
  auto gloadA = [&](int cidx) __attribute__((always_inline)) {
    const int chunk = dir ? (63 - cidx) : cidx;
#pragma unroll
    for (int i = 0; i < 8; ++i) {
      const int tau = 8 * tg + i;
      const int tok = chunk * 64 + (dir ? (63 - tau) : tau);
      pf[i] = ((const unsigned*)(Hh + (rowbase + tok) * NPAD + head * 128 + fbase))[cp];
    }
  };
  auto gloadB = [&](int cidx) __attribute__((always_inline)) {
    const int chunk = dir ? (63 - cidx) : cidx;
#pragma unroll
    for (int i = 0; i < 8; ++i) {
      const int tau = 8 * tg + i;
      const int tok = chunk * 64 + (dir ? (63 - tau) : tau);
      const unsigned* rp = (const unsigned*)(Hh + (rowbase + tok) * NPAD + head * 128) + cp;
      vv[i] = rp[H_I / 2];
      qq[i] = do_out ? rp[H_Q / 2] : 0u;
    }
  };
  auto stage1 = [&]() __attribute__((always_inline)) {
    float r0 = 0.f, r1 = 0.f;
#pragma unroll
    for (int i = 0; i < 8; ++i) {
      const float e0 = ex2(fminf(-lo16(pf[i]) * LOG2E, 80.f)), e1 = ex2(fminf(-hi16(pf[i]) * LOG2E, 80.f));
      const float s0 = frcp(1.f + e0), s1 = frcp(1.f + e1);
      r0 += lg2(lb0 + om0 * s0); r1 += lg2(lb1 + om1 * s1);
      g0[i] = r0; g1[i] = r1;
      kx0[i] = om0 * e0 * s0; kx1[i] = om1 * e1 * s1;
    }
    *(float2*)(sTot + tg * 128 + ch0) = make_float2(r0, r1);
  };
  gloadA(seg * SLEN); gloadB(seg * SLEN);
  stage1();
  if (SLEN > 1) gloadA(seg * SLEN + 1);
  for (int ci = 0; ci < SLEN; ++ci) {
    const int cidx = seg * SLEN + ci;
    const int chunk = dir ? (63 - cidx) : cidx;
    lds_barrier();
    float off0 = 0.f, off1 = 0.f, ref0 = 0.f, ref1 = 0.f, be0 = 0.f, be1 = 0.f;
#pragma unroll
    for (int j = 0; j < 8; ++j) {
      const float2 t = *(const float2*)(sTot + j * 128 + ch0);
      if (j < tg) { off0 += t.x; off1 += t.y; }
      if (j < 4) { ref0 += t.x; ref1 += t.y; }
      be0 += t.x; be1 += t.y;
    }
    dlog0 += be0; dlog1 += be1;
    const float eref0 = ex2(ref0), eref1 = ex2(ref1), ebr0 = ex2(be0 - ref0), ebr1 = ex2(be1 - ref1);
    const float d0 = off0 - ref0, d1 = off1 - ref1;
    float kh0[8], kh1[8];
#pragma unroll
    for (int i = 0; i < 8; ++i) {
      const int tau = 8 * tg + i;
      const float E0 = ex2(g0[i] + d0), E1 = ex2(g1[i] + d1);
      const float kt0 = kx0[i] * frcp(E0), kt1 = kx1[i] * frcp(E1);
      if (do_out) {
        const float qt0 = lo16(qq[i]) * E0, qt1 = hi16(qq[i]) * E1;
        sQt[tau * KPW + cp] = pk2(qt0, qt1);
        sKt[tau * KPW + cp] = pk2(kt0, kt1);
        sQc[tau * KPW + cp] = pk2(qt0 * eref0, qt1 * eref1);
      }
      kh0[i] = kt0 * ebr0; kh1[i] = kt1 * ebr1;
    }
    *(u32x4*)(sKhT + ch0 * 72 + 8 * tg) = CVT8(kh0);
    *(u32x4*)(sKhT + (ch0 + 1) * 72 + 8 * tg) = CVT8(kh1);
    *(u32x4*)(sVT + ch0 * 72 + 8 * tg) = PACK8_LO(vv);
    *(u32x4*)(sVT + (ch0 + 1) * 72 + 8 * tg) = PACK8_HI(vv);
    if (tg == 0) *(float2*)(sD + ch0) = make_float2(ex2(be0), ex2(be1));
    if (do_out) scan_write_state<K, V>(smem, S, w, lane);
    if (ci + 1 < SLEN) gloadB(cidx + 1);
    lds_barrier();
    scan_core<K, V, false>(smem, S, OB + (rowbase + (size_t)chunk * 64) * 512 + head * 128, dir, w, lane, do_out, nullptr);
    if (ci + 1 < SLEN) { stage1(); if (ci + 2 < SLEN) gloadA(cidx + 2); }
  }
  if (!do_out) {
    state_store<K, V>(sbuf, S, w, lane);
    if (tg == 0) *(float2*)((float*)(p.ws + OFF_DB) + ((size_t)it * NSEG + seg) * 128 + ch0) = make_float2(ex2(dlog0), ex2(dlog1));
  }
  lds_barrier();
}

DEV void gla_item(const Params& p, int l, int it, int seg, int mode, unsigned char* smem) {
  const int j16 = it - 16, bl = j16 >> 3, head = (j16 >> 1) & 3, dir = j16 & 1;
  const bool do_out = (mode == 3);
  constexpr int K = 64, V = 128, KPW = 36;
  const int tid = launder(threadIdx.x), lane = tid & 63, w = tid >> 6;
  const int cp = tid & 31, tg = tid >> 5, ch0 = 2 * cp;
  const int vp2 = tid & 63, vg = tid >> 6;
  const bf16_t* Hh = (const bf16_t*)(p.ws + OFF_H);
  const bf16_t* Gb = (const bf16_t*)(p.ws + OFF_G);
  bf16_t* OB = (bf16_t*)(p.ws + OFF_OBUF) + (size_t)(2 * 2 + dir) * TH * 512;
  const size_t rowbase = (size_t)bl * SEQ;
  unsigned* sQt = (unsigned*)(smem + L_QT); unsigned* sKt = (unsigned*)(smem + L_KT); unsigned* sQc = (unsigned*)(smem + L_QC);
  bf16_t* sKhT = (bf16_t*)(smem + L_KHT); bf16_t* sVT = (bf16_t*)(smem + L_VT);
  float* sD = (float*)(smem + L_D); float* sTot = (float*)(smem + L_TOT);
  f32x16 S[1]; S[0] = zero16();
  float* sbuf = (float*)(p.ws + OFF_SB1) + ((size_t)j16 * NSEG + seg) * 8192;
  if (do_out) state_load<K, V>(sbuf, S, w, lane);
  float dlog0 = 0.f, dlog1 = 0.f;
  unsigned pg[4];
  float g0[4], g1[4]; unsigned kk[4], qq[4], vv[8];
  auto gloadA = [&](int cidx) __attribute__((always_inline)) {
    const int chunk = dir ? (63 - cidx) : cidx;
#pragma unroll
    for (int i = 0; i < 4; ++i) {
      const int tau = 4 * tg + i;
      const int tok = chunk * 64 + (dir ? (63 - tau) : tau);
      pg[i] = ((const unsigned*)(Gb + (rowbase + tok) * 512 + dir * 256 + head * 64))[cp];
    }
  };
  auto gloadB = [&](int cidx) __attribute__((always_inline)) {
    const int chunk = dir ? (63 - cidx) : cidx;
#pragma unroll
    for (int i = 0; i < 4; ++i) {
      const int tau = 4 * tg + i;
      const int tok = chunk * 64 + (dir ? (63 - tau) : tau);
      const unsigned* rp = (const unsigned*)(Hh + (rowbase + tok) * NPAD + head * 64) + cp;
      kk[i] = rp[G_K / 2]; qq[i] = do_out ? rp[G_Q / 2] : 0u;
    }
#pragma unroll
    for (int i = 0; i < 8; ++i) {
      const int tau = 8 * vg + i;
      const int tok = chunk * 64 + (dir ? (63 - tau) : tau);
      vv[i] = ((const unsigned*)(Hh + (rowbase + tok) * NPAD + G_V + head * 128))[vp2];
    }
  };
  auto stage1 = [&]() __attribute__((always_inline)) {
    float r0 = 0.f, r1 = 0.f;
#pragma unroll
    for (int i = 0; i < 4; ++i) { r0 += lo16(pg[i]); r1 += hi16(pg[i]); g0[i] = r0; g1[i] = r1; }
    *(float2*)(sTot + tg * 64 + ch0) = make_float2(r0, r1);
  };
  gloadA(seg * SLEN); gloadB(seg * SLEN);
  stage1();
  if (SLEN > 1) gloadA(seg * SLEN + 1);
  for (int ci = 0; ci < SLEN; ++ci) {
    const int cidx = seg * SLEN + ci;
    const int chunk = dir ? (63 - cidx) : cidx;
    lds_barrier();
    float off0 = 0.f, off1 = 0.f, ref0 = 0.f, ref1 = 0.f, be0 = 0.f, be1 = 0.f;
#pragma unroll
    for (int j = 0; j < 16; ++j) {
      const float2 t = *(const float2*)(sTot + j * 64 + ch0);
      if (j < tg) { off0 += t.x; off1 += t.y; }
      if (j < 8) { ref0 += t.x; ref1 += t.y; }
      be0 += t.x; be1 += t.y;
    }
    dlog0 += be0; dlog1 += be1;
    const float eref0 = ex2(ref0), eref1 = ex2(ref1), ebr0 = ex2(be0 - ref0), ebr1 = ex2(be1 - ref1);
    const float d0 = off0 - ref0, d1 = off1 - ref1;
    float kh0[4], kh1[4];
#pragma unroll
    for (int i = 0; i < 4; ++i) {
      const int tau = 4 * tg + i;
      const float E0 = ex2(g0[i] + d0), E1 = ex2(g1[i] + d1);
      const float kt0 = lo16(kk[i]) * frcp(E0), kt1 = hi16(kk[i]) * frcp(E1);
      if (do_out) {
        const float qt0 = lo16(qq[i]) * E0, qt1 = hi16(qq[i]) * E1;
        sQt[tau * KPW + cp] = pk2(qt0, qt1);
        sKt[tau * KPW + cp] = pk2(kt0, kt1);
        sQc[tau * KPW + cp] = pk2(qt0 * eref0, qt1 * eref1);
      }
      kh0[i] = kt0 * ebr0; kh1[i] = kt1 * ebr1;
    }
    *(uint2*)(sKhT + ch0 * 72 + 4 * tg) = make_uint2(pk2(kh0[0], kh0[1]), pk2(kh0[2], kh0[3]));
    *(uint2*)(sKhT + (ch0 + 1) * 72 + 4 * tg) = make_uint2(pk2(kh1[0], kh1[1]), pk2(kh1[2], kh1[3]));
    *(u32x4*)(sVT + (2 * vp2) * 72 + 8 * vg) = PACK8_LO(vv);
    *(u32x4*)(sVT + (2 * vp2 + 1) * 72 + 8 * vg) = PACK8_HI(vv);
    if (tg == 0) *(float2*)(sD + ch0) = make_float2(ex2(be0), ex2(be1));
    if (do_out) scan_write_state<K, V>(smem, S, w, lane);
    if (ci + 1 < SLEN) gloadB(cidx + 1);
    lds_barrier();
    scan_core<K, V, false>(smem, S, OB + (rowbase + (size_t)chunk * 64) * 512 + head * 128, dir, w, lane, do_out, nullptr);
    if (ci + 1 < SLEN) { stage1(); if (ci + 2 < SLEN) gloadA(cidx + 2); }
  }
  if (!do_out) {
    state_store<K, V>(sbuf, S, w, lane);
    if (tg == 0) *(float2*)((float*)(p.ws + OFF_DB) + ((size_t)it * NSEG + seg) * 128 + ch0) = make_float2(ex2(dlog0), ex2(dlog1));
  }
  lds_barrier();
}

DEV void ssd_item(const Params& p, int l, int it, int seg, int mode, unsigned char* smem) {
  const int j32 = it - 32, bl = j32 >> 4, head = (j32 >> 1) & 7, dir = j32 & 1;
  const bool do_out = (mode == 3);
  constexpr int K = 128, V = 64, KPW = 68;
  const int tid = launder(threadIdx.x), lane = tid & 63, w = tid >> 6;
  const int cp = tid & 63, tg = tid >> 6, n0 = 2 * cp;
  const int xp = tid & 31, xg = tid >> 5;
  const int grp = head >> 2;
  const bf16_t* U = (const bf16_t*)(p.ws + OFF_U);
  const float* SMALL = (const float*)(p.ws + OFF_SMALL);
  bf16_t* OB = (bf16_t*)(p.ws + OFF_OBUF) + (size_t)(1 * 2 + dir) * TH * 512;
  const size_t rowbase = (size_t)bl * SEQ;
  unsigned* sQt = (unsigned*)(smem + L_QT); unsigned* sKt = (unsigned*)(smem + L_KT); unsigned* sQc = (unsigned*)(smem + L_QC);
  bf16_t* sKhT = (bf16_t*)(smem + L_KHT); bf16_t* sVT = (bf16_t*)(smem + L_VT);
  float* sD = (float*)(smem + L_D);
  const float dtb = p.dt_bias[(l * 2 + dir) * 8 + head];
  const float Acoef = -__expf(p.a_log[(l * 2 + dir) * 8 + head]) * LOG2E;
  f32x16 S[1]; S[0] = zero16();
  float* sbuf = (float*)(p.ws + OFF_SB2) + ((size_t)j32 * NSEG + seg) * 8192;
  if (do_out) state_load<K, V>(sbuf, S, w, lane);
  float dlog = 0.f;
  unsigned bb[8], cc[8], xx[4];
  float rdt = 0.f;
  auto gloadA = [&](int cidx) __attribute__((always_inline)) {
    const int chunk = dir ? (63 - cidx) : cidx;
    if (w == 0) {
      const int tok = chunk * 64 + (dir ? (63 - lane) : lane);
      rdt = SMALL[(rowbase + tok) * 48 + dir * 8 + head];
    }
  };
  auto gloadB = [&](int cidx) __attribute__((always_inline)) {
    const int chunk = dir ? (63 - cidx) : cidx;
#pragma unroll
    for (int i = 0; i < 8; ++i) {
      const int tau = 8 * tg + i;
      const int tok = chunk * 64 + (dir ? (63 - tau) : tau);
      const unsigned* rp = (const unsigned*)(U + (rowbase + tok) * 1024 + grp * 128) + cp;
      bb[i] = rp[512 / 2]; cc[i] = do_out ? rp[768 / 2] : 0u;
    }
#pragma unroll
    for (int i = 0; i < 4; ++i) {
      const int tau = 4 * xg + i;
      const int tok = chunk * 64 + (dir ? (63 - tau) : tau);
      xx[i] = ((const unsigned*)(U + (rowbase + tok) * 1024 + head * 64))[xp];
    }
  };
  auto stage1 = [&](int par) __attribute__((always_inline)) {
    if (w == 0) {
      const float xv = rdt + dtb;
      const float dt = (xv > 20.f) ? xv : log1pf(__expf(xv));
      float a = dt * Acoef;
#pragma unroll
      for (int o = 1; o < 64; o <<= 1) { const float t = __shfl_up(a, o); if (lane >= o) a += t; }
      ((float*)(smem + L_ACS))[par * 64 + lane] = a; ((float*)(smem + L_DT))[par * 64 + lane] = dt;
    }
  };
  gloadA(seg * SLEN); gloadB(seg * SLEN);
  stage1(0);
  if (SLEN > 1) gloadA(seg * SLEN + 1);
  for (int ci = 0; ci < SLEN; ++ci) {
    const int cidx = seg * SLEN + ci;
    const int chunk = dir ? (63 - cidx) : cidx;
    const float* sAcs = (const float*)(smem + L_ACS) + (ci & 1) * 64;
    const float* sDt = (const float*)(smem + L_DT) + (ci & 1) * 64;
    lds_barrier();
    const float aend = sAcs[63];
    dlog += aend;
    {
      float kh0[8], kh1[8];
#pragma unroll
      for (int i = 0; i < 8; ++i) {
        const int tau = 8 * tg + i;
        const float ac = sAcs[tau];
        const float eb = ex2(aend - ac);
        kh0[i] = lo16(bb[i]) * eb; kh1[i] = hi16(bb[i]) * eb;
        if (do_out) {
          const float ea = ex2(ac);
          sKt[tau * KPW + cp] = bb[i];
          sQt[tau * KPW + cp] = cc[i];
          sQc[tau * KPW + cp] = pk2(lo16(cc[i]) * ea, hi16(cc[i]) * ea);
        }
      }
      *(u32x4*)(sKhT + n0 * 72 + 8 * tg) = CVT8(kh0);
      *(u32x4*)(sKhT + (n0 + 1) * 72 + 8 * tg) = CVT8(kh1);
      float x0[4], x1[4];
#pragma unroll
      for (int i = 0; i < 4; ++i) { const float dtv = sDt[4 * xg + i]; x0[i] = lo16(xx[i]) * dtv; x1[i] = hi16(xx[i]) * dtv; }
      *(uint2*)(sVT + (2 * xp) * 72 + 4 * xg) = make_uint2(pk2(x0[0], x0[1]), pk2(x0[2], x0[3]));
      *(uint2*)(sVT + (2 * xp + 1) * 72 + 4 * xg) = make_uint2(pk2(x1[0], x1[1]), pk2(x1[2], x1[3]));
      if (tg == 0) *(float2*)(sD + n0) = make_float2(ex2(aend), ex2(aend));
    }
    if (do_out) scan_write_state<K, V>(smem, S, w, lane);
    if (ci + 1 < SLEN) gloadB(cidx + 1);
    lds_barrier();
    scan_core<K, V, true>(smem, S, OB + (rowbase + (size_t)chunk * 64) * 512 + head * 64, dir, w, lane, do_out, sAcs);
    if (ci + 1 < SLEN) { stage1((ci + 1) & 1); if (ci + 2 < SLEN) gloadA(cidx + 2); }
  }
  if (!do_out) {
    state_store<K, V>(sbuf, S, w, lane);
    if (tg == 0) *(float2*)((float*)(p.ws + OFF_DB) + ((size_t)it * NSEG + seg) * 128 + n0) = make_float2(ex2(dlog), ex2(dlog));
  }
  lds_barrier();
}

DEV void phase_prep(const Params& p, int l, int hf, int rep, unsigned char* smem) {
  const int tid = launder(threadIdx.x), lane = tid & 63;
  bf16_t* Hh = (bf16_t*)(p.ws + OFF_H);
  bf16_t* U = (bf16_t*)(p.ws + OFF_U);
  bf16_t* Gb = (bf16_t*)(p.ws + OFF_G);
  bf16_t* VT = (bf16_t*)(p.ws + OFF_VT);
  const float* SMALLp = (const float*)(p.ws + OFF_SMALL);
  float2* stab = (float2*)smem;
  float* slow = (float*)(smem + 8192);
  bf16_t* sT = (bf16_t*)(smem + 12288);
  {
    const float2* tabg = (const float2*)(p.ws + OFF_TAB);
    for (int i = tid; i < 1024; i += NT) stab[i] = tabg[i];
  }
  const int cg8 = (tid & 127) * 8, rsub = tid >> 7;
  const float* cw = p.conv_w + (size_t)l * 5 * 1024; const float* cb = p.conv_b + (size_t)l * 1024;
  float wv[5][8], bv[8];
#pragma unroll
  for (int j = 0; j < 5; ++j)
#pragma unroll
    for (int e = 0; e < 8; ++e) wv[j][e] = cw[j * 1024 + cg8 + e];
#pragma unroll
  for (int e = 0; e < 8; ++e) bv[e] = cb[cg8 + e];
  const int gd = tid >> 8, gc = tid & 255;
  const int i16 = lane & 15;
  const float* gq = p.q_gain + l * 64 + 4 * i16; const float* gk = p.k_gain + l * 64 + 4 * i16;
  const float gqv[4] = {gq[0], gq[1], gq[2], gq[3]}, gkv[4] = {gk[0], gk[1], gk[2], gk[3]};
  for (int grp = blockIdx.x; grp < TH / 32; grp += gridDim.x) {
    const int r0 = grp * 32;
    lds_barrier();
    const u32x4 vt = *(const u32x4*)(Hh + (size_t)(r0 + (tid >> 4)) * NPAD + A_V + (tid & 15) * 8);
    const float2 lowv = *(const float2*)(SMALLp + (size_t)(r0 + (tid >> 4)) * 48 + 16 + (tid & 15) * 2);
    *(u32x4*)(sT + (tid >> 4) * 136 + (tid & 15) * 8) = vt;
    *(float2*)(slow + (tid >> 4) * 32 + (tid & 15) * 2) = lowv;
#pragma unroll 1
    for (int ps = 0; ps < 2; ++ps) {
      const int ra = r0 + 16 * ps + 4 * rsub, ta = ra & (SEQ - 1);
      u32x4 xc[8];
#pragma unroll
      for (int m = 0; m < 8; ++m) {
        const int sq = ta + m - 2;
        xc[m] = (u32x4){0u, 0u, 0u, 0u};
        if (sq >= 0 && sq < SEQ) xc[m] = *(const u32x4*)(Hh + (size_t)(ra + m - 2) * NPAD + S_X + cg8);
      }
#pragma unroll
      for (int o4 = 0; o4 < 4; ++o4) {
        float u[8];
#pragma unroll
        for (int e = 0; e < 8; ++e) u[e] = bv[e];
#pragma unroll
        for (int j = 0; j < 5; ++j)
#pragma unroll
          for (int e = 0; e < 4; ++e) { u[2 * e] += wv[j][2 * e] * lo16(xc[o4 + j][e]); u[2 * e + 1] += wv[j][2 * e + 1] * hi16(xc[o4 + j][e]); }
        u32x4 o;
#pragma unroll
        for (int e = 0; e < 4; ++e) {
          const float a = u[2 * e] * frcp(1.f + ex2(fminf(-u[2 * e] * LOG2E, 80.f)));
          const float b = u[2 * e + 1] * frcp(1.f + ex2(fminf(-u[2 * e + 1] * LOG2E, 80.f)));
          o[e] = pk2(a, b);
        }
        *(u32x4*)(U + (size_t)(ra + o4) * 1024 + cg8) = o;
      }
    }
    lds_barrier();
    if (rep == 0) {
      u32x4 hq[6];
#pragma unroll
      for (int u = 0; u < 6; ++u) {
        const int id = u * 512 + tid, row = r0 + id / 96, c96 = id % 96;
        hq[u] = *(const u32x4*)(Hh + (size_t)row * NPAD + ((c96 < 64) ? (H_Q + c96 * 8) : (G_Q + (c96 - 64) * 8)));
      }
#pragma unroll 1
      for (int ub = 0; ub < 10; ub += 5) {
        uint2 xq[5];
#pragma unroll
        for (int u = 0; u < 5; ++u) {
          const int pi = (ub + u) * 32 + (tid >> 4), row = r0 + pi / 10, hd = pi % 10;
          xq[u] = *(const uint2*)(Hh + (size_t)row * NPAD + ((hd < 8) ? (A_Q + hd * 64) : (A_K + (hd - 8) * 64)) + 4 * i16);
        }
#pragma unroll
        for (int u = 0; u < 5; ++u) {
          const int pi = (ub + u) * 32 + (tid >> 4), row = r0 + pi / 10, hd = pi % 10;
          const bool isq = hd < 8;
          const float x[4] = {lo16(xq[u].x), hi16(xq[u].x), lo16(xq[u].y), hi16(xq[u].y)};
          float ss = x[0] * x[0] + x[1] * x[1] + x[2] * x[2] + x[3] * x[3];
          ss += __shfl_xor(ss, 1); ss += __shfl_xor(ss, 2); ss += __shfl_xor(ss, 4); ss += __shfl_xor(ss, 8);
          const float rstd = rsqrtf(ss * (1.f / 64.f) + 1e-6f);
          const int t = row & (SEQ - 1);
          const int pos = (i16 < 8) ? (t >> 6) : (t & 63);
          const float osc = isq ? QSCALE : 1.f;
          float o[4];
#pragma unroll
          for (int e = 0; e < 4; ++e) {
            const float v = x[e] * rstd * (isq ? gqv[e] : gkv[e]);
            const float pv = __shfl_xor(v, 4);
            const float2 cs = stab[pos * 16 + 4 * (i16 & 3) + e];
            o[e] = ((i16 & 4) ? (v * cs.x + pv * cs.y) : (v * cs.x - pv * cs.y)) * osc;
          }
          *(uint2*)(Hh + (size_t)row * NPAD + (isq ? (A_Q + hd * 64) : (A_K + (hd - 8) * 64)) + 4 * i16) = make_uint2(pk2(o[0], o[1]), pk2(o[2], o[3]));
        }
      }
#pragma unroll
      for (int u = 0; u < 6; ++u) {
        const int id = u * 512 + tid, row = r0 + id / 96, c96 = id % 96;
        u32x4 x = hq[u];
        if (c96 < 64) {
#pragma unroll
          for (int e = 0; e < 4; ++e) {
            const float a = lo16(x[e]), b = hi16(x[e]);
            x[e] = pk2(a * frcp(1.f + ex2(fminf(-a * LOG2E, 80.f))) * 0.08838834764831845f, b * frcp(1.f + ex2(fminf(-b * LOG2E, 80.f))) * 0.08838834764831845f);
          }
        } else {
#pragma unroll
          for (int e = 0; e < 4; ++e) x[e] = pk2(lo16(x[e]) * 0.125f, hi16(x[e]) * 0.125f);
        }
        *(u32x4*)(Hh + (size_t)row * NPAD + ((c96 < 64) ? (H_Q + c96 * 8) : (G_Q + (c96 - 64) * 8))) = x;
      }
    }
    float w2c[16];
#pragma unroll
    for (int r = 0; r < 16; ++r) w2c[r] = p.gk_w2[((size_t)(l * 2 + gd) * 16 + r) * 256 + gc];
    const float gbias = p.gk_b[(l * 2 + gd) * 256 + gc];
#pragma unroll 4
    for (int rr = 0; rr < 32; ++rr) {
      const float4* lp4 = (const float4*)(slow + rr * 32 + gd * 16);
      float gkk = gbias;
#pragma unroll
      for (int r4 = 0; r4 < 4; ++r4) { const float4 lw = lp4[r4]; gkk += lw.x * w2c[4 * r4] + lw.y * w2c[4 * r4 + 1] + lw.z * w2c[4 * r4 + 2] + lw.w * w2c[4 * r4 + 3]; }
      const float l2 = (fminf(gkk, 0.f) * LOG2E - lg2(1.f + ex2(-fabsf(gkk) * LOG2E))) * (1.f / 16.f);
      Gb[(size_t)(r0 + rr) * 512 + tid] = f2bf(l2);
    }
    {
      const int c = tid >> 2, tq = (tid & 3) * 8;
      unsigned v[8];
#pragma unroll
      for (int i = 0; i < 8; ++i) v[i] = sT[(tq + i) * 136 + c];
      const int bl = r0 >> 12, t0 = (r0 & (SEQ - 1)) + tq;
      *(u32x4*)(VT + ((size_t)((bl * 2 + (c >> 6)) * 64 + (c & 63))) * SEQ + t0) = (u32x4){v[0] | (v[1] << 16), v[2] | (v[3] << 16), v[4] | (v[5] << 16), v[6] | (v[7] << 16)};
    }
  }
  lds_barrier();
}

DEV void phase_mix(const Params& p, int l, int hf, int slot, int mode, int att_lo, int att_hi, int vid_lo, int vid_hi, unsigned char* smem) {
  unsigned* ctr = (unsigned*)(p.ws + OFF_CTRL) + CTR_WORD0 + slot * 16;
  volatile int* sItem = (volatile int*)(smem + LDS_BYTES - 16);
  const int n_scan = 64 * NSEG;
  int hi = n_scan + (att_hi - att_lo); if (vid_hi < hi) hi = vid_hi;
  for (;;) {
    lds_barrier();
    if (threadIdx.x == 0) *sItem = vid_lo + (int)atomicAdd(ctr, 1u);
    lds_barrier();
    const int vid = *sItem;
    if (vid >= hi) break;
    if (vid < n_scan) {
      const int seg = vid >> 6, it = vid & 63;
      if (mode == 1 && seg == NSEG - 1) continue;
#if PROBE_REP > 0
      if (slot >= 40 && PROBE_TYPE >= 0 && ((it < 16) ? 0 : (it < 32) ? 1 : 2) != PROBE_TYPE) continue;
#endif
      if (it < 16) { if (PH_MASK & 0x100) hgrn_item(p, l, it, seg, mode, smem); }
      else if (it < 32) { if (PH_MASK & 0x200) gla_item(p, l, it, seg, mode, smem); }
      else { if (PH_MASK & 0x400) ssd_item(p, l, it, seg, mode, smem); }
    } else { if (PH_MASK & 0x800) attn_item(p, l, att_lo + (vid - n_scan), smem); }
  }
}

DEV void phase_scan2(const Params& p) {
  const size_t gtid = (size_t)blockIdx.x * NT + threadIdx.x, gsz = (size_t)gridDim.x * NT;
  const float* DB = (const float*)(p.ws + OFF_DB);
  for (size_t e = gtid; e < 655360; e += gsz) {
    float* buf; const float* dp; int stride;
    if (e < 262144) { const int it = (int)(e >> 14), idx = (int)(e & 16383); buf = (float*)(p.ws + OFF_SB0) + (size_t)it * NSEG * 16384 + idx; stride = 16384; dp = DB + (size_t)it * NSEG * 128 + (idx >> 7); }
    else if (e < 393216) { const int e2 = (int)(e - 262144), j = e2 >> 13, idx = e2 & 8191; buf = (float*)(p.ws + OFF_SB1) + (size_t)j * NSEG * 8192 + idx; stride = 8192; dp = DB + (size_t)(16 + j) * NSEG * 128 + (idx >> 7); }
    else { const int e3 = (int)(e - 393216), j = e3 >> 13, idx = e3 & 8191; buf = (float*)(p.ws + OFF_SB2) + (size_t)j * NSEG * 8192 + idx; stride = 8192; dp = DB + (size_t)(32 + j) * NSEG * 128 + (idx >> 6); }
    float u[NSEG - 1], d[NSEG - 1];
#pragma unroll
    for (int sg = 0; sg < NSEG - 1; ++sg) { u[sg] = buf[(size_t)sg * stride]; d[sg] = dp[sg * 128]; }
    float st = 0.f;
#pragma unroll
    for (int sg = 0; sg < NSEG; ++sg) { buf[(size_t)sg * stride] = st; if (sg < NSEG - 1) st = d[sg] * st + u[sg]; }
  }
}

DEV float bfe(const u32x4& v, int j) { return (j & 1) ? hi16(v[j >> 1]) : lo16(v[j >> 1]); }
DEV void phase_fin(const Params& p, int l, int hf) {
  const int tid = launder(threadIdx.x), lane = tid & 63, w = tid >> 6;
  const bf16_t* Hh = (const bf16_t*)(p.ws + OFF_H);
  const bf16_t* OB = (const bf16_t*)(p.ws + OFF_OBUF);
  bf16_t* MX = (bf16_t*)(p.ws + OFF_MIXED);
  const int c0 = lane * 8;
  const float* cw = p.conv_w + (size_t)l * 5 * 1024; const float* cb = p.conv_b + (size_t)l * 1024;
  for (int r0 = (blockIdx.x * 8 + w) * 4; r0 < TH; r0 += gridDim.x * 32) {
    {
      u32x4 at[4], a[4], b[4], z[4];
#pragma unroll
      for (int i = 0; i < 4; ++i) {
        const bf16_t* hrow = Hh + (size_t)(r0 + i) * NPAD;
        at[i] = *(const u32x4*)(hrow + A_Q + c0);
        a[i] = *(const u32x4*)(OB + ((size_t)0 * TH + r0 + i) * 512 + c0); b[i] = *(const u32x4*)(OB + ((size_t)1 * TH + r0 + i) * 512 + c0);
        z[i] = *(const u32x4*)(hrow + H_Z + c0);
      }
      float gn[8];
#pragma unroll
      for (int j = 0; j < 8; ++j) gn[j] = p.hgrn_norm[l * 512 + c0 + j];
#pragma unroll
      for (int i = 0; i < 4; ++i) {
        *(u32x4*)(MX + (size_t)(r0 + i) * DI + c0) = at[i];
        float o[8]; float ss = 0.f;
#pragma unroll
        for (int j = 0; j < 8; ++j) { o[j] = bfe(a[i], j) + bfe(b[i], j); ss += o[j] * o[j]; }
#pragma unroll
        for (int of = 32; of >= 1; of >>= 1) ss += __shfl_xor(ss, of);
        const float rstd = rsqrtf(ss * (1.f / 512.f) + 1e-6f);
        float y[8];
#pragma unroll
        for (int j = 0; j < 8; ++j) { const float zz = bfe(z[i], j); y[j] = o[j] * rstd * gn[j] * (zz * frcp(1.f + ex2(fminf(-zz * LOG2E, 80.f)))); }
        *(u32x4*)(MX + (size_t)(r0 + i) * DI + 512 + c0) = (u32x4){pk2(y[0], y[1]), pk2(y[2], y[3]), pk2(y[4], y[5]), pk2(y[6], y[7])};
      }
    }
    {
      u32x4 a[4], b[4], z[4];
#pragma unroll
      for (int i = 0; i < 4; ++i) {
        a[i] = *(const u32x4*)(OB + ((size_t)4 * TH + r0 + i) * 512 + c0); b[i] = *(const u32x4*)(OB + ((size_t)5 * TH + r0 + i) * 512 + c0);
        z[i] = *(const u32x4*)(Hh + (size_t)(r0 + i) * NPAD + G_Z + c0);
      }
      float gn[8];
#pragma unroll
      for (int j = 0; j < 8; ++j) gn[j] = p.gla_norm[l * 128 + ((c0 + j) & 127)];
#pragma unroll
      for (int i = 0; i < 4; ++i) {
        float o[8]; float ss = 0.f;
#pragma unroll
        for (int j = 0; j < 8; ++j) { o[j] = bfe(a[i], j) + bfe(b[i], j); ss += o[j] * o[j]; }
#pragma unroll
        for (int of = 8; of >= 1; of >>= 1) ss += __shfl_xor(ss, of);
        const float rstd = rsqrtf(ss * (1.f / 128.f) + 1e-6f);
        float y[8];
#pragma unroll
        for (int j = 0; j < 8; ++j) { const float zz = bfe(z[i], j); y[j] = o[j] * rstd * gn[j] * (zz * frcp(1.f + ex2(fminf(-zz * LOG2E, 80.f)))); }
        *(u32x4*)(MX + (size_t)(r0 + i) * DI + 1536 + c0) = (u32x4){pk2(y[0], y[1]), pk2(y[2], y[3]), pk2(y[4], y[5]), pk2(y[6], y[7])};
      }
    }
    {
      u32x4 a[4], b[4], z[4], xr[8];
      const int t0 = r0 & (SEQ - 1);
#pragma unroll
      for (int i = 0; i < 4; ++i) {
        a[i] = *(const u32x4*)(OB + ((size_t)2 * TH + r0 + i) * 512 + c0); b[i] = *(const u32x4*)(OB + ((size_t)3 * TH + r0 + i) * 512 + c0);
        z[i] = *(const u32x4*)(Hh + (size_t)(r0 + i) * NPAD + S_Z + c0);
      }
#pragma unroll
      for (int m = 0; m < 8; ++m) {
        const int sq = t0 + m - 2;
        xr[m] = (u32x4){0u, 0u, 0u, 0u};
        if (sq >= 0 && sq < SEQ) xr[m] = *(const u32x4*)(Hh + (size_t)(r0 + m - 2) * NPAD + S_X + c0);
      }
      float gn[8], cbv[8];
#pragma unroll
      for (int j = 0; j < 8; ++j) { gn[j] = p.ssd_norm[l * 512 + c0 + j]; cbv[j] = cb[c0 + j]; }
      const float dsk = p.ssd_d[l * 8 + (c0 >> 6)];
#pragma unroll
      for (int i = 0; i < 4; ++i) {
        float u[8];
#pragma unroll
        for (int j = 0; j < 8; ++j) u[j] = cbv[j];
#pragma unroll
        for (int jj = 0; jj < 5; ++jj)
#pragma unroll
          for (int j = 0; j < 8; ++j) u[j] += cw[jj * 1024 + c0 + j] * bfe(xr[i + jj], j);
        float y[8]; float ss = 0.f;
#pragma unroll
        for (int j = 0; j < 8; ++j) {
          const float zz = bfe(z[i], j);
          const float xs = u[j] * frcp(1.f + ex2(fminf(-u[j] * LOG2E, 80.f)));
          y[j] = (bfe(a[i], j) + bfe(b[i], j) + dsk * xs) * (zz * frcp(1.f + ex2(fminf(-zz * LOG2E, 80.f))));
          ss += y[j] * y[j];
        }
#pragma unroll
        for (int of = 32; of >= 1; of >>= 1) ss += __shfl_xor(ss, of);
        const float rstd = rsqrtf(ss * (1.f / 512.f) + 1e-6f);
#pragma unroll
        for (int j = 0; j < 8; ++j) y[j] = y[j] * rstd * gn[j];
        *(u32x4*)(MX + (size_t)(r0 + i) * DI + 1024 + c0) = (u32x4){pk2(y[0], y[1]), pk2(y[2], y[3]), pk2(y[4], y[5]), pk2(y[6], y[7])};
      }
    }
  }
}

#define XB_TMO      128
#define XB_XCNT(j)  (256  + 64 * (j))
#define XB_XSUB(j)  (1280 + 64 * (j))
#define XB_XGEN(j)  (2304 + 64 * (j))
#define XB_TOP      3328
#define XB_TOPGEN   3392
#define XB_SPIN_CAP (1u << 22)
#define LAS __attribute__((address_space(3)))
DEV unsigned xb_ld(unsigned* p) { return __hip_atomic_load(p, __ATOMIC_RELAXED, __HIP_MEMORY_SCOPE_AGENT); }
DEV unsigned xb_add(unsigned* p, unsigned v) { return __hip_atomic_fetch_add(p, v, __ATOMIC_RELAXED, __HIP_MEMORY_SCOPE_AGENT); }
DEV unsigned xb_xcc_id() { return (unsigned)__builtin_amdgcn_s_getreg((3 << 11) | 20) & 0xFu; }
#define XB_SPIN(cond, bar) do { unsigned _sp = 0; while (cond) { __builtin_amdgcn_s_sleep(1); \
    if ((++_sp & 255u) == 0u) { if (xb_ld(&(bar)[XB_TMO])) break; if (_sp > XB_SPIN_CAP) { atomicAdd(&(bar)[XB_TMO], 1u); break; } } } } while (0)
struct XcdBarrier { unsigned* bar; unsigned x; volatile LAS unsigned* st; };
DEV XcdBarrier xcd_barrier_post(unsigned* bar, volatile LAS unsigned* st) {
  XcdBarrier b; b.bar = bar; b.x = xb_xcc_id(); b.st = st;
  if (threadIdx.x == 0) (void)xb_add(&bar[XB_XCNT(b.x)], 1u);
  return b;
}
DEV void xcd_barrier_complete(unsigned* bar, unsigned x, unsigned& nloc, unsigned& nx) {
  const unsigned G = gridDim.x * gridDim.y * gridDim.z;
  unsigned sum, cnt, mine, sp = 0u;
  for (;;) {
    sum = 0u; cnt = 0u; mine = 0u;
#pragma unroll
    for (unsigned j = 0; j < 16; ++j) { const unsigned c = xb_ld(&bar[XB_XCNT(j)]); sum += c; cnt += (c > 0u) ? 1u : 0u; mine = (j == x) ? c : mine; }
    if (sum == G) break;
    __builtin_amdgcn_s_sleep(1);
    if ((++sp & 255u) == 0u) { if (xb_ld(&bar[XB_TMO])) break; if (sp > XB_SPIN_CAP) { atomicAdd(&bar[XB_TMO], 1u); break; } }
  }
  nloc = mine > 0u ? mine : 1u; nx = cnt > 0u ? cnt : 1u;
}
DEV void xcd_barrier(const XcdBarrier& b) {
  asm volatile("s_waitcnt vmcnt(0)" ::: "memory");
  __syncthreads();
  if (threadIdx.x == 0) {
    unsigned* bar = b.bar;
    __builtin_amdgcn_s_waitcnt(0);
    unsigned nloc = b.st[0], nx = b.st[1];
    if (nloc == 0u) { xcd_barrier_complete(bar, b.x, nloc, nx); b.st[0] = nloc; b.st[1] = nx; }
    const unsigned old = xb_add(&bar[XB_XSUB(b.x)], 1u);
    const unsigned gen = old / nloc;
    if (old + 1u == (gen + 1u) * nloc) {
      __builtin_amdgcn_fence(__ATOMIC_RELEASE, "agent");
      asm volatile("s_waitcnt vmcnt(0)" ::: "memory");
      const unsigned og = xb_add(&bar[XB_TOP], 1u);
      const unsigned tg = og / nx;
      if (og + 1u == (tg + 1u) * nx) xb_add(&bar[XB_TOPGEN], 1u);
      else XB_SPIN(xb_ld(&bar[XB_TOPGEN]) == tg, bar);
      __builtin_amdgcn_fence(__ATOMIC_ACQUIRE, "agent");
      xb_add(&bar[XB_XGEN(b.x)], 1u);
      asm volatile("s_waitcnt vmcnt(0)" ::: "memory");
    } else {
      XB_SPIN(xb_ld(&bar[XB_XGEN(b.x)]) == gen, bar);
      __builtin_amdgcn_fence(__ATOMIC_ACQUIRE, "agent");
      asm volatile("s_waitcnt vmcnt(0)" ::: "memory");
    }
  }
  __syncthreads();
}

DEV void run_phase(const Params& p, int ph, int rep, unsigned char* smem) {
  if (ph == 0) { if (PH_MASK & 1) { phase_pro(p, smem); convert_weights(p, 0, 3, smem); } return; }
  if (ph == 25) { if (PH_MASK & 16) phase_outproj(p, 1, 1, smem); return; }
  if (ph == 26) { if (PH_MASK & 32) phase_ln(p, 1, 1); return; }
  const int q = ph - 1, blk = q / 6, st = q % 6, l = blk >> 1, hf = blk & 1;
  if (st == 0) {
    if (blk > 0 && (PH_MASK & 16)) phase_outproj(p, (blk - 1) >> 1, (blk - 1) & 1, smem);
    if (PH_MASK & 2) phase_inproj(p, l, hf, blk > 0 ? 16 : 0, smem);
  } else if (st == 1) {
    if (blk > 0 && rep == 0 && (PH_MASK & 32)) phase_ln(p, (blk - 1) >> 1, (blk - 1) & 1);
    if (PH_MASK & 4) phase_prep(p, l, hf, rep, smem);
    if ((PH_MASK & 1) && rep == 0 && blk == 1) convert_weights(p, 1, 1, smem);
    if ((PH_MASK & 1) && rep == 0 && blk == 2) convert_weights(p, 1, 2, smem);
  }
  else if (st == 2) { if (PH_MASK & 0xF00) phase_mix(p, l, hf, ph + 40 * rep, 1, 0, ATT_SPLIT, rep ? PROBE_LO : 0, rep ? PROBE_HI : 100000, smem); }
  else if (st == 3) { if (PH_MASK & 0x700) phase_scan2(p); }
  else if (st == 4) { if (PH_MASK & 0xF00) phase_mix(p, l, hf, ph + 40 * rep, 3, ATT_SPLIT, 256, rep ? PROBE_LO : 0, rep ? PROBE_HI : 100000, smem); }
  else { if (PH_MASK & 8) phase_fin(p, l, hf); }
}
__global__ void __launch_bounds__(NT) mega(Params p) {
  extern __shared__ __attribute__((aligned(16))) unsigned char smem[];
#if ONE_LAUNCH
  volatile LAS unsigned* xst = (volatile LAS unsigned*)(smem + LDS_BYTES - 32);
  if (threadIdx.x == 0) { xst[0] = 0u; xst[1] = 0u; }
  __syncthreads();
  XcdBarrier xb = xcd_barrier_post((unsigned*)(p.ws + OFF_CTRL), xst);
#endif
  Params* lp = (Params*)(smem + 147456);
  if (threadIdx.x == 0) *lp = p;
  __syncthreads();
  const int ph_begin = p.phase_begin, ph_end = p.phase_end;
  for (int ph = ph_begin; ph < ph_end; ++ph) {
    int nrep = 0;
#if PROBE_REP > 0
    {
      const int q = ph - 1, st = q % 6;
      const bool idem = (ph >= 1 && ph <= 24) && (st == PROBE_ST) && (st >= 1);
      if (idem) nrep = PROBE_REP;
    }
#endif
    for (int r = 0; r <= nrep; ++r) {
      run_phase(*lp, ph, r, smem);
#if ONE_LAUNCH
      if (r < nrep || ph + 1 < ph_end) xcd_barrier(xb);
#endif
    }
  }
}

extern "C" void kernel_launch(void* const* d_in, const int* in_sizes, int n_in, void* d_out, int out_size, void* d_ws, size_t ws_size,
                              hipStream_t stream) {
  static int grid_blocks = 0;
  if (!grid_blocks) {
    int dev = 0, cus = 0, per_cu = 0;
    hipGetDevice(&dev);
    hipDeviceGetAttribute(&cus, hipDeviceAttributeMultiprocessorCount, dev);
    hipFuncSetAttribute((const void*)mega, hipFuncAttributeMaxDynamicSharedMemorySize, LDS_BYTES);
    hipOccupancyMaxActiveBlocksPerMultiprocessor(&per_cu, mega, NT, LDS_BYTES);
    if (per_cu < 1) per_cu = 1;
    grid_blocks = cus;
  }
  Params p{};
  p.x = (const float*)d_in[0]; p.w_in = (const float*)d_in[1]; p.q_gain = (const float*)d_in[2]; p.k_gain = (const float*)d_in[3];
  p.lb_logits = (const float*)d_in[4]; p.hgrn_norm = (const float*)d_in[5]; p.conv_w = (const float*)d_in[6]; p.conv_b = (const float*)d_in[7];
  p.dt_bias = (const float*)d_in[8]; p.a_log = (const float*)d_in[9]; p.ssd_d = (const float*)d_in[10]; p.ssd_norm = (const float*)d_in[11];
  p.gk_w2 = (const float*)d_in[12]; p.gk_b = (const float*)d_in[13]; p.gla_norm = (const float*)d_in[14]; p.w_out = (const float*)d_in[15];
  p.ln_g = (const float*)d_in[16]; p.ln_b = (const float*)d_in[17];
  p.out = (float*)d_out; p.ws = (unsigned char*)d_ws;
  hipMemsetAsync(d_ws, 0, CTRL_BYTES, stream);
#if ONE_LAUNCH
  p.phase_begin = 0; p.phase_end = NPHASE;
  void* args[] = {&p};
  (void)args;
  hipLaunchKernelGGL(mega, dim3(grid_blocks), dim3(NT), LDS_BYTES, stream, p);
#else
  for (int ph = 0; ph < NPHASE; ++ph) {
    p.phase_begin = ph; p.phase_end = ph + 1;
    hipLaunchKernelGGL(mega, dim3(grid_blocks), dim3(NT), LDS_BYTES, stream, p);
  }
#endif
}
```

```cpp
#include <hip/hip_runtime.h>
#include <hip/hip_cooperative_groups.h>
#include <stdint.h>
#include <stdio.h>
namespace cg = cooperative_groups;

#ifndef ONE_LAUNCH
#define ONE_LAUNCH 1
#endif

#ifndef PH_MASK
#define PH_MASK 0xFFF
#endif
#ifndef PROBE_ST
#define PROBE_ST -1
#endif
#ifndef PROBE_REP
#define PROBE_REP 0
#endif
#ifndef PROBE_TYPE
#define PROBE_TYPE -1
#endif
#ifndef PROBE_LO
#define PROBE_LO 0
#endif
#ifndef PROBE_HI
#define PROBE_HI 100000
#endif
#define DEV __device__ __forceinline__
typedef unsigned short bf16_t;
typedef short bf16x8 __attribute__((ext_vector_type(8)));
typedef float f32x16 __attribute__((ext_vector_type(16)));
typedef unsigned u32x4 __attribute__((ext_vector_type(4)));
typedef float f32x4 __attribute__((ext_vector_type(4)));

constexpr int NT = 512;
constexpr int T_ALL = 16384, TH = 8192, SEQ = 4096, DM = 1024, NPAD = 7168, DI = 2048, NIN = 6960;
constexpr int A_Q = 0, A_K = 512, A_V = 640, A_Z = 768, H_Q = 1280, H_FF = 1792, H_FB = 2304, H_I = 2816, H_Z = 3328,
              S_X = 3840, S_Z = 4864, G_Q = 5376, G_K = 5632, G_V = 5888, G_Z = 6400, SM0 = 6912;
constexpr size_t OFF_CTRL = 0, OFF_TAB = 65536, OFF_XB = 131072;
constexpr size_t OFF_WIN = OFF_XB + (size_t)T_ALL * DM * 2;
constexpr size_t OFF_WOUT = OFF_WIN + (size_t)NPAD * DM * 2;
constexpr size_t OFF_H = OFF_WOUT + (size_t)DM * DI * 2;
constexpr size_t OFF_SMALL = OFF_H + (size_t)TH * NPAD * 2;
constexpr size_t OFF_OBUF = OFF_SMALL + (size_t)TH * 48 * 4;
constexpr size_t OFF_VT = OFF_OBUF + (size_t)6 * TH * 512 * 2;
constexpr size_t OFF_DB = OFF_VT + (size_t)2 * 2 * 64 * SEQ * 2;
constexpr int NSEG = 4, SLEN = 64 / NSEG;
constexpr size_t OFF_MIXED = OFF_DB + (size_t)64 * NSEG * 128 * 4;
constexpr size_t OFF_SB0 = OFF_MIXED, OFF_SB1 = OFF_SB0 + (size_t)16 * NSEG * 16384 * 4, OFF_SB2 = OFF_SB1 + (size_t)16 * NSEG * 8192 * 4;
constexpr size_t OFF_U = OFF_SB2 + (size_t)32 * NSEG * 8192 * 4;
constexpr size_t OFF_G = OFF_U + (size_t)TH * 1024 * 2;
constexpr size_t WS_END = (OFF_G + (size_t)TH * 512 * 2 > OFF_MIXED + (size_t)TH * DI * 2) ? (OFF_G + (size_t)TH * 512 * 2) : (OFF_MIXED + (size_t)TH * DI * 2);
static_assert(OFF_MIXED + (size_t)TH * DI * 2 <= WS_END, "MIXED must fit");
static_assert(WS_END <= 268435456, "workspace");
constexpr size_t CTRL_BYTES = 65536;
constexpr int CTR_WORD0 = 4096;
constexpr int LDS_BYTES = 148480;
constexpr float LOG2E = 1.4426950408889634f;
constexpr float QSCALE = 0.125f * LOG2E;
constexpr float DN_ALPHA = 1.4142135623730951f;
constexpr int NPHASE = 23;
constexpr int ATT_SPLIT = 256;

struct Params {
  const float* x; const float* w_in; const float* q_gain; const float* k_gain; const float* lb_logits; const float* hgrn_norm;
  const float* conv_w; const float* conv_b; const float* dt_bias; const float* a_log; const float* ssd_d; const float* ssd_norm;
  const float* gk_w2; const float* gk_b; const float* gla_norm; const float* w_out; const float* ln_g; const float* ln_b;
  float* out; unsigned char* ws;
  int phase_begin, phase_end;
};

DEV void lds_barrier() { asm volatile("s_waitcnt lgkmcnt(0)" ::: "memory"); __builtin_amdgcn_s_barrier(); asm volatile("" ::: "memory"); }
DEV int launder(int v) { asm volatile("" : "+v"(v)); return v; }
DEV float bf2f(bf16_t v) { return __uint_as_float(((unsigned)v) << 16); }
DEV bf16_t f2bf(float f) { unsigned u = __float_as_uint(f); u += 0x7fffu + ((u >> 16) & 1u); return (bf16_t)(u >> 16); }
typedef __bf16 bf16x2_t __attribute__((ext_vector_type(2)));
typedef float f32x2_t __attribute__((ext_vector_type(2)));
DEV unsigned pk2(float lo, float hi) { const f32x2_t f = {lo, hi}; const bf16x2_t b = __builtin_convertvector(f, bf16x2_t); return __builtin_bit_cast(unsigned, b); }
DEV float fsigmoid(float x) { return 1.f / (1.f + __expf(-x)); }
DEV float fsilu(float x) { return x / (1.f + __expf(-x)); }
DEV unsigned cvtpk(float lo, float hi) { return pk2(lo, hi); }
DEV float ex2(float x) { return __builtin_amdgcn_exp2f(x); }
DEV float lg2(float x) { return __builtin_amdgcn_logf(x); }
DEV float frcp(float x) { return __builtin_amdgcn_rcpf(x); }
DEV float lo16(unsigned u) { return __uint_as_float(u << 16); }
DEV float hi16(unsigned u) { return __uint_as_float(u & 0xffff0000u); }
DEV int rowoff(int reg, int h) { return (reg & 3) + 8 * (reg >> 2) + 4 * h; }
DEV f32x16 zero16() { f32x16 z;
#pragma unroll
  for (int i = 0; i < 16; ++i) z[i] = 0.f; return z; }

template <int KD>
DEV void mma32(f32x16& acc, const bf16_t* a, int lda, const bf16_t* b, int ldb, int lane) {
  const int r = lane & 31, h = lane >> 5;
  const bf16_t* ap = a + r * lda + 8 * h;
  const bf16_t* bp = b + r * ldb + 8 * h;
#pragma unroll 4
  for (int k = 0; k < KD; k += 16) {
    bf16x8 av = *(const bf16x8*)(ap + k);
    bf16x8 bv = *(const bf16x8*)(bp + k);
    acc = __builtin_amdgcn_mfma_f32_32x32x16_bf16(av, bv, acc, 0, 0, 0);
  }
}

DEV int orig_col(int n) {
  if (n < 4864) return n;
  if (n < 6400) return n + 16;
  if (n < 6912) return n + 48;
  if (n < 6928) return n - 2048;
  if (n < 6960) return n - 512;
  return -1;
}

DEV void convert_weights(const Params& p, int l, int which, unsigned char* smem) {
  float* s = (float*)smem;
  const int tid = launder(threadIdx.x);
  const float* win = p.w_in + (size_t)l * DM * NIN;
  const float* wout = p.w_out + (size_t)l * DI * DM;
  bf16_t* wint = (bf16_t*)(p.ws + OFF_WIN);
  bf16_t* woutt = (bf16_t*)(p.ws + OFF_WOUT);
  const int n_in_tiles = (NPAD / 64) * (DM / 64);
  const int n_out_tiles = (DM / 64) * (DI / 64);
  const int it_lo = (which & 1) ? 0 : n_in_tiles, it_hi = (which & 2) ? (n_in_tiles + n_out_tiles) : n_in_tiles;
  for (int it = it_lo + blockIdx.x; it < it_hi; it += gridDim.x) {
    lds_barrier();
    if (it < n_in_tiles) {
      const int n0 = (it / 16) * 64, k0 = (it % 16) * 64;
#pragma unroll
      for (int e = 0; e < 8; ++e) {
        const int idx = e * NT + tid, kk = idx >> 6, nn = idx & 63;
        const int oc = orig_col(n0 + nn);
        s[kk * 65 + nn] = (oc >= 0) ? win[(size_t)(k0 + kk) * NIN + oc] : 0.f;
      }
      lds_barrier();
      const int n = tid >> 3, kc = (tid & 7) * 8;
      uint4 o;
      o.x = pk2(s[(kc + 0) * 65 + n], s[(kc + 1) * 65 + n]); o.y = pk2(s[(kc + 2) * 65 + n], s[(kc + 3) * 65 + n]);
      o.z = pk2(s[(kc + 4) * 65 + n], s[(kc + 5) * 65 + n]); o.w = pk2(s[(kc + 6) * 65 + n], s[(kc + 7) * 65 + n]);
      *(uint4*)(wint + (size_t)(n0 + n) * DM + k0 + kc) = o;
    } else {
      const int j = it - n_in_tiles;
      const int n0 = (j / 32) * 64, k0 = (j % 32) * 64;
#pragma unroll
      for (int e = 0; e < 8; ++e) {
        const int idx = e * NT + tid, kk = idx >> 6, nn = idx & 63;
        s[kk * 65 + nn] = wout[(size_t)(k0 + kk) * DM + n0 + nn];
      }
      lds_barrier();
      const int n = tid >> 3, kc = (tid & 7) * 8;
      uint4 o;
      o.x = pk2(s[(kc + 0) * 65 + n], s[(kc + 1) * 65 + n]); o.y = pk2(s[(kc + 2) * 65 + n], s[(kc + 3) * 65 + n]);
      o.z = pk2(s[(kc + 4) * 65 + n], s[(kc + 5) * 65 + n]); o.w = pk2(s[(kc + 6) * 65 + n], s[(kc + 7) * 65 + n]);
      *(uint4*)(woutt + (size_t)(n0 + n) * DI + k0 + kc) = o;
    }
  }
  lds_barrier();
}

DEV void fsincos(float x, float& s, float& c) {
  const float k = rintf(x * 0.63661977236758134308f);
  float r = fmaf(-k, 1.5707855225e+00f, x);
  r = fmaf(-k, 1.0804273188e-05f, r);
  r = fmaf(-k, 6.0770999344e-11f, r);
  const float r2 = r * r;
  float ps = fmaf(r2, 2.7557319224e-06f, -1.9841269841e-04f);
  ps = fmaf(ps, r2, 8.3333333333e-03f); ps = fmaf(ps, r2, -1.6666666667e-01f);
  const float sinr = fmaf(ps * r2, r, r);
  float pc = fmaf(r2, -2.7557319224e-07f, 2.4801587302e-05f);
  pc = fmaf(pc, r2, -1.3888888889e-03f); pc = fmaf(pc, r2, 4.1666666667e-02f); pc = fmaf(pc, r2, -0.5f);
  const float cosr = fmaf(pc, r2, 1.0f);
  const int q = ((int)k) & 3;
  if (q == 0) { s = sinr; c = cosr; }
  else if (q == 1) { s = cosr; c = -sinr; }
  else if (q == 2) { s = -sinr; c = -cosr; }
  else { s = -cosr; c = sinr; }
}

DEV void phase_pro(const Params& p, unsigned char* smem) {
  const int tid = launder(threadIdx.x);
  const size_t gtid = (size_t)blockIdx.x * NT + tid, gsz = (size_t)gridDim.x * NT;
  const float4* x4 = (const float4*)p.x;
  uint4* xb4 = (uint4*)(p.ws + OFF_XB);
  for (size_t i = gtid; i < (size_t)T_ALL * DM / 8; i += gsz) {
    const float4 a = x4[2 * i], b = x4[2 * i + 1];
    uint4 o; o.x = pk2(a.x, a.y); o.y = pk2(a.z, a.w); o.z = pk2(b.x, b.y); o.w = pk2(b.z, b.w);
    xb4[i] = o;
  }
  if (blockIdx.x == 0) {
    float2* tab = (float2*)(p.ws + OFF_TAB);
    for (int i = tid; i < 64 * 16; i += NT) {
      const int pos = i >> 4, fi = i & 15;
      const float invf = exp2f(-(float)fi * (13.287712379549449f / 16.0f));
      const float ang = (float)pos * invf;
      float sn, cs; fsincos(ang, sn, cs);
      tab[i] = make_float2(cs, sn);
    }
  }
}

namespace pg8 {
#define PG8_LAS __attribute__((address_space(3)))
typedef unsigned short bf16_t;
typedef short bf16x8 __attribute__((ext_vector_type(8)));
typedef float f32x4 __attribute__((ext_vector_type(4)));
typedef unsigned u32x4 __attribute__((ext_vector_type(4)));
constexpr int BM = 256, BK = 64, HALF = 128, HTB = HALF * BK * 2  , STAGE_BYTES = 8 * HTB, NXCD = 8, WGM = 8;

__host__ __device__ __forceinline__ int lds_byte(int r, int c) { const int st = (r >> 4) * 2 + (c >> 5), rr = r & 15, cc = c & 31, ob = rr * 64 + cc * 2; return st * 1024 + (ob ^ (((ob >> 9) & 1) << 5)); }
__host__ __device__ __forceinline__ void stage_rc(int b, int& R, int& C) { const int st = b / 1024, sb = b % 1024, swz = sb ^ (((sb >> 9) & 1) << 5); R = (st >> 1) * 16 + swz / 64; C = (st & 1) * 32 + (swz % 64) / 2; }
__host__ __device__ __forceinline__ int perm32(int rho) { const int n = rho >> 4, i = rho & 15; return 8 * (i >> 2) + 4 * n + (i & 3); }

struct Unit { int pm, pn; };
struct Gemm { const bf16_t* A; const bf16_t* Bt; int M, N, K; };

__device__ __forceinline__ unsigned cvt_pk_bf16(float lo, float hi) { unsigned r; asm volatile("v_cvt_pk_bf16_f32 %0, %1, %2" : "=v"(r) : "v"(lo), "v"(hi)); return r; }

struct XcdOrder {
    int rpx, nN, x, c, ncu, skew;
    __device__ void init(int M, int N, int skew_ = 0) { rpx = (M / BM) / NXCD; nN = N / BM; x = blockIdx.x & 7; c = blockIdx.x >> 3; ncu = gridDim.x >> 3; skew = skew_; }
    __device__ bool next(int i, Unit& u) const {
        const int total = rpx * nN, full = (total / ncu) * ncu;
        int j = c + i * ncu;
        if (skew > 0 && j >= full) { const int cc = c - skew; j = (cc >= 0 && i == total / ncu) ? full + cc : total; }
        if (j >= total) return false; u.pm = rpx * x + (j % rpx); u.pn = j / rpx; return true; }
    __device__ __forceinline__ void a_ready(const Unit&) const {}
    __device__ __forceinline__ void done(const Unit&) const {}
};
struct EpiIn {
    static constexpr bool PERM = true, AFTER_DRAIN = false;
    bf16_t* O; int ldc; float* small; int small_pn;
    __device__ __forceinline__ void operator()(const f32x4 (&acc)[2][2][4][2], const Unit& u, int wr, int wc, int fr, int fq) const {
        const int row0 = u.pm * BM + wr * 64 + fr, col0 = u.pn * BM + wc * 32 + 8 * fq;
        if (u.pn == small_pn) {
            const int c = wc * 32 + 8 * fq;
            if (c < 48) {
#pragma unroll
                for (int ai = 0; ai < 2; ++ai)
#pragma unroll
                    for (int m = 0; m < 4; ++m) { float* rp = small + (size_t)(row0 + ai * HALF + m * 16) * 48 + c; *(f32x4*)rp = acc[ai][0][m][0]; *(f32x4*)(rp + 4) = acc[ai][0][m][1]; }
            }
            return;
        }
#pragma unroll
        for (int ai = 0; ai < 2; ++ai)
#pragma unroll
            for (int m = 0; m < 4; ++m) { bf16_t* rowp = O + (size_t)(row0 + ai * HALF + m * 16) * ldc + col0;
#pragma unroll
                for (int bj = 0; bj < 2; ++bj) { const f32x4 v0 = acc[ai][bj][m][0], v1 = acc[ai][bj][m][1];
                    u32x4 w; w.x = cvt_pk_bf16(v0[0], v0[1]); w.y = cvt_pk_bf16(v0[2], v0[3]); w.z = cvt_pk_bf16(v1[0], v1[1]); w.w = cvt_pk_bf16(v1[2], v1[3]);
                    *(u32x4*)(rowp + bj * HALF) = w; } }
    }
};
struct EpiOut {
    static constexpr bool PERM = true, AFTER_DRAIN = false;
    const float* X; float* Y; int ldc; float alpha;
    __device__ __forceinline__ void operator()(const f32x4 (&acc)[2][2][4][2], const Unit& u, int wr, int wc, int fr, int fq) const {
        const int row0 = u.pm * BM + wr * 64 + fr, col0 = u.pn * BM + wc * 32 + 8 * fq;
#pragma unroll
        for (int ai = 0; ai < 2; ++ai)
#pragma unroll
            for (int m = 0; m < 4; ++m) { const size_t off = (size_t)(row0 + ai * HALF + m * 16) * ldc + col0;
#pragma unroll
                for (int bj = 0; bj < 2; ++bj) { const f32x4 x0 = *(const f32x4*)(X + off + bj * HALF), x1 = *(const f32x4*)(X + off + bj * HALF + 4);
                    *(f32x4*)(Y + off + bj * HALF) = x0 * alpha + acc[ai][bj][m][0]; *(f32x4*)(Y + off + bj * HALF + 4) = x1 * alpha + acc[ai][bj][m][1]; } }
    }
};

template <class Epi, class Sched, bool ALIGN_EPI = false, bool SP2 = false>
__device__ __forceinline__ void gemm_phase(PG8_LAS unsigned char* lds, const Gemm g, const Sched& S, const Epi& E) {
    const int tid = launder((int)threadIdx.x), wid = __builtin_amdgcn_readfirstlane(tid >> 6), lane = tid & 63, wr = wid >> 2, wc = wid & 3, fr = lane & 15, fq = lane >> 4;
    const int K = g.K, nt = K / BK;
    unsigned voffA[2], voffB[2];
#pragma unroll
    for (int i = 0; i < 2; ++i) { int R, C; stage_rc(tid * 16 + i * 8192, R, C); const int Rb = Epi::PERM ? ((R & ~31) + perm32(R & 31)) : R;
        voffA[i] = (unsigned)(R * K + C) * 2u; voffB[i] = (unsigned)(Rb * K + C) * 2u; }
    const size_t kstep = (size_t)(BK * 2);
    const size_t hstep = (size_t)HALF * K * 2;
    const size_t tstep = 2 * hstep;
    const unsigned ldsw = (unsigned)wid * 1024u;
    const int aoff = lds_byte(wr * 64 + fr, fq * 8), boff = lds_byte(wc * 32 + fr, fq * 8);
#define PG8_SA(b, h) (((b) * 2 + (h)) * HTB)
#define PG8_SB(b, h) ((4 + (b) * 2 + (h)) * HTB)
#define PG8_STAGE(bufoff, gbase, voff) do { _Pragma("unroll") for (int _i = 0; _i < 2; ++_i) \
        __builtin_amdgcn_global_load_lds((const unsigned*)((const char*)(gbase) + (voff)[_i]), (PG8_LAS unsigned*)(lds + (bufoff) + ldsw + _i * 8192), 16, 0, 0); } while (0)
#define PG8_LDA(dst, b, h) do { _Pragma("unroll") for (int m = 0; m < 4; ++m) _Pragma("unroll") for (int k = 0; k < 2; ++k) dst[m][k] = *(const PG8_LAS bf16x8*)(lds + PG8_SA(b, h) + aoff + m * 2048 + k * 1024); } while (0)
#define PG8_LDB(dst, b, h) do { _Pragma("unroll") for (int n = 0; n < 2; ++n) _Pragma("unroll") for (int k = 0; k < 2; ++k) dst[n][k] = *(const PG8_LAS bf16x8*)(lds + PG8_SB(b, h) + boff + n * 2048 + k * 1024); } while (0)
#define PG8_MMA(ai, bj, At, Bt) do { __builtin_amdgcn_s_setprio(1); _Pragma("unroll") for (int m = 0; m < 4; ++m) _Pragma("unroll") for (int n = 0; n < 2; ++n) _Pragma("unroll") for (int k = 0; k < 2; ++k) \
        acc[ai][bj][m][n] = __builtin_amdgcn_mfma_f32_16x16x32_bf16(Bt[n][k], At[m][k], acc[ai][bj][m][n], 0, 0, 0); __builtin_amdgcn_s_setprio(0); } while (0)
#define PG8_WAIT_V(n) asm volatile("s_waitcnt vmcnt(" #n ")" ::: "memory")
#define PG8_WAIT_L(n) asm volatile("s_waitcnt lgkmcnt(" #n ")" ::: "memory")
#define PG8_BAR __builtin_amdgcn_s_barrier()
#define PG8_SCHED __builtin_amdgcn_sched_barrier(0)
    Unit cur, nxt; int ui = 0;
    if (!S.next(0, cur)) return;
    f32x4 acc[2][2][4][2];
#pragma unroll
    for (int a = 0; a < 2; ++a)
#pragma unroll
        for (int b = 0; b < 2; ++b)
#pragma unroll
            for (int m = 0; m < 4; ++m)
#pragma unroll
                for (int n = 0; n < 2; ++n) acc[a][b][m][n] = (f32x4){0.f, 0.f, 0.f, 0.f};
    bf16x8 At[4][2], B0[2][2], B1[2][2];
    const char* cA = (const char*)g.A + (size_t)cur.pm * tstep; const char* cB = (const char*)g.Bt + (size_t)cur.pn * tstep;
    S.a_ready(cur);
    if constexpr (SP2) {
        PG8_STAGE(PG8_SB(0, 0), cB, voffB); PG8_STAGE(PG8_SB(0, 1), cB + hstep, voffB); PG8_STAGE(PG8_SA(0, 0), cA, voffA); PG8_STAGE(PG8_SA(0, 1), cA + hstep, voffA);
        if (wr == 1) PG8_BAR;
        PG8_WAIT_V(2); PG8_BAR;
        PG8_STAGE(PG8_SB(1, 0), cB + kstep, voffB); PG8_STAGE(PG8_SA(1, 0), cA + kstep, voffA); PG8_STAGE(PG8_SB(1, 1), cB + hstep + kstep, voffB);
        PG8_WAIT_V(6); PG8_BAR;
    } else {
        PG8_STAGE(PG8_SB(0, 0), cB, voffB); PG8_STAGE(PG8_SA(0, 0), cA, voffA); PG8_STAGE(PG8_SB(0, 1), cB + hstep, voffB); PG8_STAGE(PG8_SA(0, 1), cA + hstep, voffA);
        if (wr == 1) PG8_BAR;
        PG8_WAIT_V(4); PG8_BAR;
        PG8_STAGE(PG8_SB(1, 0), cB + kstep, voffB); PG8_STAGE(PG8_SA(1, 0), cA + kstep, voffA); PG8_STAGE(PG8_SB(1, 1), cB + hstep + kstep, voffB);
        PG8_WAIT_V(6); PG8_BAR;
    }
    for (;;) {
        const bool has_next = S.next(ui + 1, nxt);
        const char* nA = has_next ? (const char*)g.A + (size_t)nxt.pm * tstep : cA; const char* nB = has_next ? (const char*)g.Bt + (size_t)nxt.pn * tstep : cB;
        for (int t = 0; t < nt; t += 2) {
            const bool last = (t == nt - 2);
            const char* a1 = cA + (size_t)(t + 1) * kstep;
            const char* a2 = last ? nA : cA + (size_t)(t + 2) * kstep; const char* b2 = last ? nB : cB + (size_t)(t + 2) * kstep;
            const char* a3 = a2 + kstep; const char* b3 = b2 + kstep;
            if (last && has_next) S.a_ready(nxt);
            if constexpr (SP2) {
            PG8_LDB(B0, 0, 0); PG8_LDB(B1, 0, 1); PG8_SCHED; PG8_LDA(At, 0, 0); PG8_STAGE(PG8_SA(1, 1), a1 + hstep, voffA);
            PG8_WAIT_V(8); PG8_WAIT_L(0); PG8_BAR; PG8_MMA(0, 0, At, B0); PG8_MMA(0, 1, At, B1); PG8_BAR; PG8_SCHED;
            PG8_LDA(At, 0, 1); PG8_STAGE(PG8_SB(0, 0), b2, voffB); PG8_STAGE(PG8_SB(0, 1), b2 + hstep, voffB); PG8_STAGE(PG8_SA(0, 0), a2, voffA);
            PG8_WAIT_V(8); PG8_WAIT_L(0); PG8_BAR; PG8_MMA(1, 0, At, B0); PG8_MMA(1, 1, At, B1); PG8_BAR; PG8_SCHED;
            PG8_LDB(B0, 1, 0); PG8_LDB(B1, 1, 1); PG8_SCHED; PG8_LDA(At, 1, 0); PG8_STAGE(PG8_SA(0, 1), a2 + hstep, voffA);
            PG8_WAIT_V(8); PG8_WAIT_L(0); PG8_BAR; PG8_MMA(0, 0, At, B0); PG8_MMA(0, 1, At, B1); PG8_BAR; PG8_SCHED;
            PG8_LDA(At, 1, 1); PG8_STAGE(PG8_SB(1, 0), b3, voffB); PG8_STAGE(PG8_SB(1, 1), b3 + hstep, voffB); PG8_STAGE(PG8_SA(1, 0), a3, voffA);
            PG8_WAIT_V(8); PG8_WAIT_L(0); PG8_BAR; PG8_MMA(1, 0, At, B0); PG8_MMA(1, 1, At, B1); PG8_BAR; PG8_SCHED;
            } else {
            PG8_LDB(B0, 0, 0); PG8_SCHED; PG8_LDA(At, 0, 0); PG8_STAGE(PG8_SA(1, 1), a1 + hstep, voffA);
            PG8_WAIT_L(8); PG8_BAR; PG8_WAIT_L(0); PG8_MMA(0, 0, At, B0); PG8_BAR; PG8_SCHED;
            PG8_LDB(B1, 0, 1); PG8_STAGE(PG8_SB(0, 0), b2, voffB);
            PG8_BAR; PG8_WAIT_L(0); PG8_MMA(0, 1, At, B1); PG8_BAR;
            PG8_LDA(At, 0, 1); PG8_STAGE(PG8_SA(0, 0), a2, voffA);
            PG8_BAR; PG8_WAIT_L(0); PG8_MMA(1, 0, At, B0); PG8_BAR; PG8_SCHED;
            PG8_STAGE(PG8_SB(0, 1), b2 + hstep, voffB);
            PG8_WAIT_V(6); PG8_BAR; PG8_MMA(1, 1, At, B1); PG8_BAR;
            PG8_LDB(B0, 1, 0); PG8_SCHED; PG8_LDA(At, 1, 0); PG8_STAGE(PG8_SA(0, 1), a2 + hstep, voffA);
            PG8_WAIT_L(8); PG8_BAR; PG8_WAIT_L(0); PG8_MMA(0, 0, At, B0); PG8_BAR; PG8_SCHED;
            PG8_LDB(B1, 1, 1); PG8_STAGE(PG8_SB(1, 0), b3, voffB);
            PG8_BAR; PG8_WAIT_L(0); PG8_MMA(0, 1, At, B1); PG8_BAR;
            PG8_LDA(At, 1, 1); PG8_STAGE(PG8_SA(1, 0), a3, voffA);
            PG8_BAR; PG8_WAIT_L(0); PG8_MMA(1, 0, At, B0); PG8_BAR; PG8_SCHED;
            PG8_STAGE(PG8_SB(1, 1), b3 + hstep, voffB);
            PG8_WAIT_V(6); PG8_BAR; PG8_MMA(1, 1, At, B1); PG8_BAR;
            }
        }
        if constexpr (ALIGN_EPI) { if (wr == 0) PG8_BAR; }
        if constexpr (!Epi::AFTER_DRAIN) { E(acc, cur, wr, wc, fr, fq); S.done(cur); }
        if (!has_next) break;
#pragma unroll
        for (int a = 0; a < 2; ++a)
#pragma unroll
            for (int b = 0; b < 2; ++b)
#pragma unroll
                for (int m = 0; m < 4; ++m)
#pragma unroll
                    for (int n = 0; n < 2; ++n) acc[a][b][m][n] = (f32x4){0.f, 0.f, 0.f, 0.f};
        cur = nxt; cA = nA; cB = nB; ++ui;
        if constexpr (ALIGN_EPI) { if (wr == 1) PG8_BAR; }
    }
    PG8_WAIT_V(0);
    if constexpr (!ALIGN_EPI) { if (wr == 0) PG8_BAR; }
    PG8_BAR;
    if constexpr (Epi::AFTER_DRAIN) { E.fused(acc, cur, wr, wc, fr, fq, lds, wid, lane); S.done(cur); }
#undef PG8_SA
#undef PG8_SB
#undef PG8_STAGE
#undef PG8_LDA
#undef PG8_LDB
#undef PG8_MMA
#undef PG8_WAIT_V
#undef PG8_WAIT_L
#undef PG8_BAR
#undef PG8_SCHED
}
}

DEV void phase_inproj(const Params& p, int l, int hf, int skew, unsigned char* smem) {
  pg8::Gemm g{(const bf16_t*)(p.ws + OFF_XB) + (size_t)hf * TH * DM, (const bf16_t*)(p.ws + OFF_WIN), TH, NPAD, DM};
  pg8::XcdOrder S; S.init(TH, NPAD, skew);
  pg8::EpiIn E{(bf16_t*)(p.ws + OFF_H), NPAD, (float*)(p.ws + OFF_SMALL), SM0 / 256};
  pg8::gemm_phase<pg8::EpiIn, pg8::XcdOrder, true, true>((PG8_LAS unsigned char*)smem, g, S, E);
}

DEV void phase_outproj(const Params& p, int l, int hf, unsigned char* smem) {
  pg8::Gemm g{(const bf16_t*)(p.ws + OFF_MIXED), (const bf16_t*)(p.ws + OFF_WOUT), TH, DM, DI};
  pg8::XcdOrder S; S.init(TH, DM);
  const float* xin = ((l == 0) ? p.x : p.out) + (size_t)hf * TH * DM;
  pg8::EpiOut E{xin, p.out + (size_t)hf * TH * DM, DM, DN_ALPHA};
  pg8::gemm_phase<pg8::EpiOut, pg8::XcdOrder, true, true>((PG8_LAS unsigned char*)smem, g, S, E);
}

DEV void phase_ln(const Params& p, int l, int hf) {
  const int tid = launder(threadIdx.x), lane = tid & 63, w = tid >> 6;
  const float* g = p.ln_g + l * DM; const float* b = p.ln_b + l * DM;
  bf16_t* xb = (bf16_t*)(p.ws + OFF_XB);
  for (int r0 = (blockIdx.x * 8 + w) * 4; r0 < TH; r0 += gridDim.x * 32) {
    f32x4 v[4][4];
#pragma unroll
    for (int i = 0; i < 4; ++i)
#pragma unroll
      for (int j = 0; j < 4; ++j) v[i][j] = ((const f32x4*)(p.out + (size_t)(hf * TH + r0 + i) * DM))[j * 64 + lane];
    f32x4 gg[4], bb[4];
#pragma unroll
    for (int j = 0; j < 4; ++j) { gg[j] = ((const f32x4*)g)[j * 64 + lane]; bb[j] = ((const f32x4*)b)[j * 64 + lane]; }
#pragma unroll
    for (int i = 0; i < 4; ++i) {
      const int row = hf * TH + r0 + i;
      float sm = 0.f;
#pragma unroll
      for (int j = 0; j < 4; ++j) sm += (v[i][j][0] + v[i][j][1]) + (v[i][j][2] + v[i][j][3]);
#pragma unroll
      for (int o = 32; o >= 1; o >>= 1) sm += __shfl_xor(sm, o);
      const float mu = sm * (1.f / DM);
      float q = 0.f;
#pragma unroll
      for (int j = 0; j < 4; ++j) { const f32x4 d = v[i][j] - mu; q += (d[0] * d[0] + d[1] * d[1]) + (d[2] * d[2] + d[3] * d[3]); }
#pragma unroll
      for (int o = 32; o >= 1; o >>= 1) q += __shfl_xor(q, o);
      const float rstd = rsqrtf(q * (1.f / DM) + 1e-5f);
#pragma unroll
      for (int j = 0; j < 4; ++j) {
        const f32x4 o = (v[i][j] - mu) * rstd * gg[j] + bb[j];
        ((f32x4*)(p.out + (size_t)row * DM))[j * 64 + lane] = o;
        if (l == 0) *(uint2*)(xb + (size_t)row * DM + (j * 64 + lane) * 4) = make_uint2(pk2(o[0], o[1]), pk2(o[2], o[3]));
      }
    }
  }
}

DEV void attn_item(const Params& p, int l, int item, unsigned char* smem) {
  const int tid = launder(threadIdx.x), lane = tid & 63, w = tid >> 6, r = lane & 31, h = lane >> 5;
  const int qt = item & 15, head = (item >> 4) & 7, bl = item >> 7;
  const int kvh = head >> 2;
  bf16_t* Hh = (bf16_t*)(p.ws + OFF_H);
  const bf16_t* VT = (const bf16_t*)(p.ws + OFF_VT);
  const size_t rowbase = (size_t)bl * SEQ;
  float mq = fabsf(p.q_gain[l * 64 + lane]), mk = fabsf(p.k_gain[l * 64 + lane]);
#pragma unroll
  for (int o = 32; o >= 1; o >>= 1) { mq = fmaxf(mq, __shfl_xor(mq, o)); mk = fmaxf(mk, __shfl_xor(mk, o)); }
  const float M2 = 8.f * mq * mk * LOG2E * 1.01f;
  const int qrow = qt * 256 + w * 32 + r;
  const bf16_t* qp = Hh + (rowbase + qrow) * NPAD + A_Q + head * 64 + 8 * h;
  bf16x8 qf[4];
#pragma unroll
  for (int ks = 0; ks < 4; ++ks) qf[ks] = *(const bf16x8*)(qp + ks * 16);
  f32x16 o0 = zero16(), o1 = zero16();
  float lsum = 0.f;
  const int srow = tid >> 3, sch = (tid & 7) * 8;
  const bf16_t* kp = Hh + (rowbase + srow) * NPAD + A_K + kvh * 64 + sch;
  const bf16_t* vp = VT + ((size_t)((bl * 2 + kvh) * 64 + srow)) * SEQ + sch;
  union PB { bf16x8 v; unsigned u[4]; };
  auto qk = [&](int st, f32x16& s0, f32x16& s1) __attribute__((always_inline)) {
    const bf16_t* sK = (const bf16_t*)(smem + st * 18432);
#pragma unroll
    for (int i = 0; i < 16; ++i) { s0[i] = -M2; s1[i] = -M2; }
#pragma unroll
    for (int ks = 0; ks < 4; ++ks) {
      const bf16x8 a0 = *(const bf16x8*)(sK + r * 72 + ks * 16 + 8 * h);
      const bf16x8 a1 = *(const bf16x8*)(sK + (32 + r) * 72 + ks * 16 + 8 * h);
      s0 = __builtin_amdgcn_mfma_f32_32x32x16_bf16(a0, qf[ks], s0, 0, 0, 0);
      s1 = __builtin_amdgcn_mfma_f32_32x32x16_bf16(a1, qf[ks], s1, 0, 0, 0);
    }
  };
  auto soft = [&](f32x16& s0, f32x16& s1, PB (&pb)[2][2]) __attribute__((always_inline)) {
#pragma unroll
    for (int i = 0; i < 16; ++i) { s0[i] = __builtin_amdgcn_exp2f(s0[i]); s1[i] = __builtin_amdgcn_exp2f(s1[i]); lsum += s0[i] + s1[i]; }
#pragma unroll
    for (int s = 0; s < 2; ++s)
#pragma unroll
      for (int j = 0; j < 4; ++j) {
        pb[0][s].u[j] = pk2(s0[8 * s + 2 * j], s0[8 * s + 2 * j + 1]);
        pb[1][s].u[j] = pk2(s1[8 * s + 2 * j], s1[8 * s + 2 * j + 1]);
      }
  };
  auto pv = [&](int st, const PB (&pb)[2][2]) __attribute__((always_inline)) {
    const bf16_t* sV = (const bf16_t*)(smem + st * 18432 + 9216);
#pragma unroll
    for (int kt2 = 0; kt2 < 2; ++kt2)
#pragma unroll
      for (int s = 0; s < 2; ++s) {
        const int kb = kt2 * 32 + 16 * s + 4 * h;
        union { bf16x8 v; uint2 u[2]; } a0, a1;
        a0.u[0] = *(const uint2*)(sV + r * 72 + kb); a0.u[1] = *(const uint2*)(sV + r * 72 + kb + 8);
        a1.u[0] = *(const uint2*)(sV + (32 + r) * 72 + kb); a1.u[1] = *(const uint2*)(sV + (32 + r) * 72 + kb + 8);
        o0 = __builtin_amdgcn_mfma_f32_32x32x16_bf16(a0.v, pb[kt2][s].v, o0, 0, 0, 0);
        o1 = __builtin_amdgcn_mfma_f32_32x32x16_bf16(a1.v, pb[kt2][s].v, o1, 0, 0, 0);
      }
  };
  auto compute2 = [&](int sta, int stb) __attribute__((always_inline)) {
    f32x16 sa0, sa1, sb0, sb1; PB pa[2][2], pbb[2][2];
    qk(sta, sa0, sa1); qk(stb, sb0, sb1);
    soft(sa0, sa1, pa); pv(sta, pa);
    soft(sb0, sb1, pbb); pv(stb, pbb);
  };
  constexpr int NKT = SEQ / 64;
  auto sstore = [&](int st, const u32x4& kk, const u32x4& vv) __attribute__((always_inline)) {
    *(u32x4*)(smem + st * 18432 + srow * 144 + sch * 2) = kk;
    *(u32x4*)(smem + st * 18432 + 9216 + srow * 144 + sch * 2) = vv;
  };
  u32x4 k0 = *(const u32x4*)kp, v0 = *(const u32x4*)vp;
  u32x4 k1 = *(const u32x4*)(kp + (size_t)64 * NPAD), v1 = *(const u32x4*)(vp + 64);
  sstore(0, k0, v0); sstore(1, k1, v1);
  k0 = *(const u32x4*)(kp + (size_t)2 * 64 * NPAD); v0 = *(const u32x4*)(vp + 2 * 64);
  k1 = *(const u32x4*)(kp + (size_t)3 * 64 * NPAD); v1 = *(const u32x4*)(vp + 3 * 64);
  lds_barrier();
  for (int kt = 0; kt < NKT; kt += 4) {
    sstore(2, k0, v0); sstore(3, k1, v1);
    if (kt + 4 < NKT) {
      k0 = *(const u32x4*)(kp + (size_t)(kt + 4) * 64 * NPAD); v0 = *(const u32x4*)(vp + (kt + 4) * 64);
      k1 = *(const u32x4*)(kp + (size_t)(kt + 5) * 64 * NPAD); v1 = *(const u32x4*)(vp + (kt + 5) * 64);
    }
    compute2(0, 1);
    lds_barrier();
    if (kt + 4 < NKT) {
      sstore(0, k0, v0); sstore(1, k1, v1);
      if (kt + 6 < NKT) {
        k0 = *(const u32x4*)(kp + (size_t)(kt + 6) * 64 * NPAD); v0 = *(const u32x4*)(vp + (kt + 6) * 64);
        k1 = *(const u32x4*)(kp + (size_t)(kt + 7) * 64 * NPAD); v1 = *(const u32x4*)(vp + (kt + 7) * 64);
      }
    }
    compute2(2, 3);
    lds_barrier();
  }
  lsum += __shfl_xor(lsum, 32);
  const float inv = 1.f / lsum;
  const bf16_t* zp = Hh + (rowbase + qrow) * NPAD + A_Z + head * 64;
  bf16_t* op = Hh + (rowbase + qrow) * NPAD + A_Q + head * 64;
#pragma unroll
  for (int dt = 0; dt < 2; ++dt)
#pragma unroll
    for (int g = 0; g < 4; ++g) {
      const int d0 = dt * 32 + 8 * g + 4 * h;
      const uint2 zz = *(const uint2*)(zp + d0);
      const float z0 = bf2f((bf16_t)(zz.x & 0xffff)), z1 = bf2f((bf16_t)(zz.x >> 16)), z2 = bf2f((bf16_t)(zz.y & 0xffff)), z3 = bf2f((bf16_t)(zz.y >> 16));
      const f32x16& oo = dt ? o1 : o0;
      uint2 ov;
      ov.x = pk2(oo[4 * g + 0] * inv * fsilu(z0), oo[4 * g + 1] * inv * fsilu(z1));
      ov.y = pk2(oo[4 * g + 2] * inv * fsilu(z2), oo[4 * g + 3] * inv * fsilu(z3));
      *(uint2*)(op + d0) = ov;
    }
  lds_barrier();
}

constexpr int L_QT = 0, L_KT = 17408, L_QC = 34816, L_KHT = 52224, L_VT = 70656, L_ST = 89088,
              L_D = 123904, L_TOT = 124416, L_ACS = 128512, L_DT = 129024;

template <int K, int V> struct ScanGeom {
  static constexpr int KP = K + 8;
  static constexpr int NS = (K / 32) * (V / 32) / 8;
};

template <int K, int V>
DEV void scan_write_state(unsigned char* smem, const f32x16* S, int w, int lane) {
  constexpr int KP = K + 8, NS = ScanGeom<K, V>::NS, NVT = V / 32;
  bf16_t* sST = (bf16_t*)(smem + L_ST);
  const int c = lane & 31, h = lane >> 5;
#pragma unroll
  for (int i = 0; i < NS; ++i) {
    const int tile = w * NS + i, kt = tile / NVT, nt = tile % NVT;
#pragma unroll
    for (int g = 0; g < 4; ++g) {
      uint2 o; o.x = pk2(S[i][4 * g + 0], S[i][4 * g + 1]); o.y = pk2(S[i][4 * g + 2], S[i][4 * g + 3]);
      *(uint2*)(sST + (nt * 32 + c) * KP + kt * 32 + 8 * g + 4 * h) = o;
    }
  }
}

template <int K, int V, bool SSDM>
DEV void scan_core(unsigned char* smem, f32x16* S, bf16_t* orow0, int dir, int w, int lane, bool do_out, const float* sAcs) {
  constexpr int KP = K + 8, NS = ScanGeom<K, V>::NS, NVT = V / 32, NOT = 2 * NVT;
  const bf16_t* sQt = (const bf16_t*)(smem + L_QT); const bf16_t* sKt = (const bf16_t*)(smem + L_KT);
  const bf16_t* sQc = (const bf16_t*)(smem + L_QC); const bf16_t* sKhT = (const bf16_t*)(smem + L_KHT);
  const bf16_t* sVT = (const bf16_t*)(smem + L_VT);
  const bf16_t* sST = (const bf16_t*)(smem + L_ST); const float* sD = (const float*)(smem + L_D);
  const int c = lane & 31, h = lane >> 5;
  if (do_out && w < NOT) {
    const int tt = w / NVT, nt = w % NVT;
    f32x16 acc = zero16();
#pragma unroll
    for (int st = 0; st < 2; ++st) {
      if (st <= tt) {
        f32x16 pt = zero16();
        mma32<K>(pt, sKt + st * 32 * KP, KP, sQt + tt * 32 * KP, KP, lane);
        const int tau = tt * 32 + c;
        const float at = SSDM ? sAcs[tau] : 0.f;
#pragma unroll
        for (int reg = 0; reg < 16; ++reg) {
          const int sig = st * 32 + rowoff(reg, h);
          float v = pt[reg];
          if (SSDM) v *= ex2(at - sAcs[sig]);
          pt[reg] = (sig <= tau) ? v : 0.f;
        }
#pragma unroll
        for (int s2 = 0; s2 < 2; ++s2) {
          union { bf16x8 v; unsigned u[4]; } pa;
#pragma unroll
          for (int j = 0; j < 4; ++j) pa.u[j] = pk2(pt[8 * s2 + 2 * j], pt[8 * s2 + 2 * j + 1]);
          const int kb = st * 32 + 16 * s2 + 4 * h;
          union { bf16x8 v; uint2 u[2]; } vb;
          vb.u[0] = *(const uint2*)(sVT + (nt * 32 + c) * 72 + kb); vb.u[1] = *(const uint2*)(sVT + (nt * 32 + c) * 72 + kb + 8);
          acc = __builtin_amdgcn_mfma_f32_32x32x16_bf16(pa.v, vb.v, acc, 0, 0, 0);
        }
      }
    }
    mma32<K>(acc, sQc + tt * 32 * KP, KP, sST + nt * 32 * KP, KP, lane);
#pragma unroll
    for (int reg = 0; reg < 16; ++reg) {
      const int tau = tt * 32 + rowoff(reg, h);
      const int tok = dir ? (63 - tau) : tau;
      orow0[(size_t)tok * 512 + nt * 32 + c] = f2bf(acc[reg]);
    }
  }
#pragma unroll
  for (int i = 0; i < NS; ++i) {
    const int tile = w * NS + i, kt = tile / NVT, nt = tile % NVT;
#pragma unroll
    for (int reg = 0; reg < 16; ++reg) S[i][reg] *= sD[kt * 32 + rowoff(reg, h)];
    mma32<64>(S[i], sKhT + kt * 32 * 72, 72, sVT + nt * 32 * 72, 72, lane);
  }
}

template <int K, int V>
DEV void state_store(float* buf, const f32x16* S, int w, int lane) {
  constexpr int NS = ScanGeom<K, V>::NS, NVT = V / 32;
  const int c = lane & 31, h = lane >> 5;
#pragma unroll
  for (int i = 0; i < NS; ++i) {
    const int tile = w * NS + i, kt = tile / NVT, nt = tile % NVT;
#pragma unroll
    for (int reg = 0; reg < 16; ++reg) buf[(kt * 32 + rowoff(reg, h)) * V + nt * 32 + c] = S[i][reg];
  }
}
template <int K, int V>
DEV void state_load(const float* buf, f32x16* S, int w, int lane) {
  constexpr int NS = ScanGeom<K, V>::NS, NVT = V / 32;
  const int c = lane & 31, h = lane >> 5;
#pragma unroll
  for (int i = 0; i < NS; ++i) {
    const int tile = w * NS + i, kt = tile / NVT, nt = tile % NVT;
#pragma unroll
    for (int reg = 0; reg < 16; ++reg) S[i][reg] = buf[(kt * 32 + rowoff(reg, h)) * V + nt * 32 + c];
  }
}

template <int K, int V>
DEV void state_combine(const float* ubase, int ustride, const float* dbase, int seg, f32x16* S, int w, int lane) {
  constexpr int NS = ScanGeom<K, V>::NS, NVT = V / 32;
  const int c = lane & 31, h = lane >> 5;
  for (int j = 0; j < seg; ++j) {
    const float* buf = ubase + (size_t)j * ustride;
    const float* dj = dbase + j * 128;
#pragma unroll
    for (int i = 0; i < NS; ++i) {
      const int tile = w * NS + i, kt = tile / NVT, nt = tile % NVT;
#pragma unroll
      for (int reg = 0; reg < 16; ++reg) {
        const int k = kt * 32 + rowoff(reg, h);
        const float u = buf[k * V + nt * 32 + c];
        S[i][reg] = (j > 0 ? dj[k] * S[i][reg] : 0.f) + u;
      }
    }
  }
}

#define PACK8_LO(v) (u32x4){((v)[0] & 0xffffu) | ((v)[1] << 16), ((v)[2] & 0xffffu) | ((v)[3] << 16), ((v)[4] & 0xffffu) | ((v)[5] << 16), ((v)[6] & 0xffffu) | ((v)[7] << 16)}
#define PACK8_HI(v) (u32x4){((v)[0] >> 16) | ((v)[1] & 0xffff0000u), ((v)[2] >> 16) | ((v)[3] & 0xffff0000u), ((v)[4] >> 16) | ((v)[5] & 0xffff0000u), ((v)[6] >> 16) | ((v)[7] & 0xffff0000u)}
#define CVT8(f) (u32x4){pk2((f)[0], (f)[1]), pk2((f)[2], (f)[3]), pk2((f)[4], (f)[5]), pk2((f)[6], (f)[7])}


DEV void hgrn_item(const Params& p, int l, int it, int seg, int mode, unsigned char* smem) {
  const int bl = it >> 3, head = (it >> 1) & 3, dir = it & 1;
  const bool do_out = (mode == 3);
  constexpr int K = 128, V = 128, KPW = 68;
  const int tid = launder(threadIdx.x), lane = tid & 63, w = tid >> 6;
  const int cp = tid & 63, tg = tid >> 6, ch0 = 2 * cp;
  const bf16_t* Hh = (const bf16_t*)(p.ws + OFF_H);
  bf16_t* OB = (bf16_t*)(p.ws + OFF_OBUF) + (size_t)(0 * 2 + dir) * TH * 512;
  const size_t rowbase = (size_t)bl * SEQ;
  float lb0 = 0.f, lb1 = 0.f;
  if (l > 0) {
    lb0 = fsigmoid(p.lb_logits[512 + head * 128 + ch0] - p.lb_logits[head * 128 + ch0]);
    lb1 = fsigmoid(p.lb_logits[512 + head * 128 + ch0 + 1] - p.lb_logits[head * 128 + ch0 + 1]);
  }
  const float om0 = 1.f - lb0, om1 = 1.f - lb1;
  const int fbase = dir ? H_FB : H_FF;
  unsigned* sQt = (unsigned*)(smem + L_QT); unsigned* sKt = (unsigned*)(smem + L_KT); unsigned* sQc = (unsigned*)(smem + L_QC);
  bf16_t* sKhT = (bf16_t*)(smem + L_KHT); bf16_t* sVT = (bf16_t*)(smem + L_VT);
  float* sD = (float*)(smem + L_D); float* sTot = (float*)(smem + L_TOT);
  f32x16 S[2]; S[0] = zero16(); S[1] = zero16();
  float* sbuf = (float*)(p.ws + OFF_SB0) + ((size_t)it * NSEG + seg) * 16384;
  if (do_out) state_combine<K, V>((const float*)(p.ws + OFF_SB0) + (size_t)it * NSEG * 16384, 16384, (const float*)(p.ws + OFF_DB) + (size_t)it * NSEG * 128, seg, S, w, lane);
  float dlog0 = 0.f, dlog1 = 0.f;
  unsigned pf[8], qq[8], vv[8];
  float g0[8], g1[8], kx0[8], kx1[8];
  auto gloadA = [&](int cidx) __attribute__((always_inline)) {
    const int chunk = dir ? (63 - cidx) : cidx;
#pragma unroll
    for (int i = 0; i < 8; ++i) {
      const int tau = 8 * tg + i;
      const int tok = chunk * 64 + (dir ? (63 - tau) : tau);
      pf[i] = ((const unsigned*)(Hh + (rowbase + tok) * NPAD + head * 128 + fbase))[cp];
    }
  };
  auto gloadB = [&](int cidx) __attribute__((always_inline)) {
    const int chunk = dir ? (63 - cidx) : cidx;
#pragma unroll
    for (int i = 0; i < 8; ++i) {
      const int tau = 8 * tg + i;
      const int tok = chunk * 64 + (dir ? (63 - tau) : tau);
      const unsigned* rp = (const unsigned*)(Hh + (rowbase + tok) * NPAD + head * 128) + cp;
      vv[i] = rp[H_I / 2];
      qq[i] = do_out ? rp[H_Q / 2] : 0u;
    }
  };
  auto stage1 = [&]() __attribute__((always_inline)) {
    float r0 = 0.f, r1 = 0.f;
#pragma unroll
    for (int i = 0; i < 8; ++i) {
      const float e0 = ex2(fminf(-lo16(pf[i]) * LOG2E, 80.f)), e1 = ex2(fminf(-hi16(pf[i]) * LOG2E, 80.f));
      const float s0 = frcp(1.f + e0), s1 = frcp(1.f + e1);
      r0 += lg2(lb0 + om0 * s0); r1 += lg2(lb1 + om1 * s1);
      g0[i] = r0; g1[i] = r1;
      kx0[i] = om0 * e0 * s0; kx1[i] = om1 * e1 * s1;
    }
    *(float2*)(sTot + tg * 128 + ch0) = make_float2(r0, r1);
  };
  gloadA(seg * SLEN); gloadB(seg * SLEN);
  stage1();
  if (SLEN > 1) gloadA(seg * SLEN + 1);
  for (int ci = 0; ci < SLEN; ++ci) {
    const int cidx = seg * SLEN + ci;
    const int chunk = dir ? (63 - cidx) : cidx;
    lds_barrier();
    float off0 = 0.f, off1 = 0.f, ref0 = 0.f, ref1 = 0.f, be0 = 0.f, be1 = 0.f;
#pragma unroll
    for (int j = 0; j < 8; ++j) {
      const float2 t = *(const float2*)(sTot + j * 128 + ch0);
      if (j < tg) { off0 += t.x; off1 += t.y; }
      if (j < 4) { ref0 += t.x; ref1 += t.y; }
      be0 += t.x; be1 += t.y;
    }
    dlog0 += be0; dlog1 += be1;
    const float eref0 = ex2(ref0), eref1 = ex2(ref1), ebr0 = ex2(be0 - ref0), ebr1 = ex2(be1 - ref1);
    const float d0 = off0 - ref0, d1 = off1 - ref1;
    float kh0[8], kh1[8];
#pragma unroll
    for (int i = 0; i < 8; ++i) {
      const int tau = 8 * tg + i;
      const float E0 = ex2(g0[i] + d0), E1 = ex2(g1[i] + d1);
      const float kt0 = kx0[i] * frcp(E0), kt1 = kx1[i] * frcp(E1);
      if (do_out) {
        const float qt0 = lo16(qq[i]) * E0, qt1 = hi16(qq[i]) * E1;
        sQt[tau * KPW + cp] = pk2(qt0, qt1);
        sKt[tau * KPW + cp] = pk2(kt0, kt1);
        sQc[tau * KPW + cp] = pk2(qt0 * eref0, qt1 * eref1);
      }
      kh0[i] = kt0 * ebr0; kh1[i] = kt1 * ebr1;
    }
    *(u32x4*)(sKhT + ch0 * 72 + 8 * tg) = CVT8(kh0);
    *(u32x4*)(sKhT + (ch0 + 1) * 72 + 8 * tg) = CVT8(kh1);
    *(u32x4*)(sVT + ch0 * 72 + 8 * tg) = PACK8_LO(vv);
    *(u32x4*)(sVT + (ch0 + 1) * 72 + 8 * tg) = PACK8_HI(vv);
    if (tg == 0) *(float2*)(sD + ch0) = make_float2(ex2(be0), ex2(be1));
    if (do_out) scan_write_state<K, V>(smem, S, w, lane);
    if (ci + 1 < SLEN) gloadB(cidx + 1);
    lds_barrier();
    scan_core<K, V, false>(smem, S, OB + (rowbase + (size_t)chunk * 64) * 512 + head * 128, dir, w, lane, do_out, nullptr);
    if (ci + 1 < SLEN) { stage1(); if (ci + 2 < SLEN) gloadA(cidx + 2); }
  }
  if (!do_out) {
    state_store<K, V>(sbuf, S, w, lane);
    if (tg == 0) *(float2*)((float*)(p.ws + OFF_DB) + ((size_t)it * NSEG + seg) * 128 + ch0) = make_float2(ex2(dlog0), ex2(dlog1));
  }
  lds_barrier();
}

DEV void gla_item(const Params& p, int l, int it, int seg, int mode, unsigned char* smem) {
  const int j16 = it - 16, bl = j16 >> 3, head = (j16 >> 1) & 3, dir = j16 & 1;
  const bool do_out = (mode == 3);
  constexpr int K = 64, V = 128, KPW = 36;
  const int tid = launder(threadIdx.x), lane = tid & 63, w = tid >> 6;
  const int cp = tid & 31, tg = tid >> 5, ch0 = 2 * cp;
  const int vp2 = tid & 63, vg = tid >> 6;
  const bf16_t* Hh = (const bf16_t*)(p.ws + OFF_H);
  const bf16_t* Gb = (const bf16_t*)(p.ws + OFF_G);
  bf16_t* OB = (bf16_t*)(p.ws + OFF_OBUF) + (size_t)(2 * 2 + dir) * TH * 512;
  const size_t rowbase = (size_t)bl * SEQ;
  unsigned* sQt = (unsigned*)(smem + L_QT); unsigned* sKt = (unsigned*)(smem + L_KT); unsigned* sQc = (unsigned*)(smem + L_QC);
  bf16_t* sKhT = (bf16_t*)(smem + L_KHT); bf16_t* sVT = (bf16_t*)(smem + L_VT);
  float* sD = (float*)(smem + L_D); float* sTot = (float*)(smem + L_TOT);
  f32x16 S[1]; S[0] = zero16();
  float* sbuf = (float*)(p.ws + OFF_SB1) + ((size_t)j16 * NSEG + seg) * 8192;
  if (do_out) state_combine<K, V>((const float*)(p.ws + OFF_SB1) + (size_t)j16 * NSEG * 8192, 8192, (const float*)(p.ws + OFF_DB) + (size_t)it * NSEG * 128, seg, S, w, lane);
  float dlog0 = 0.f, dlog1 = 0.f;
  unsigned pg[4];
  float g0[4], g1[4]; unsigned kk[4], qq[4], vv[8];
  auto gloadA = [&](int cidx) __attribute__((always_inline)) {
    const int chunk = dir ? (63 - cidx) : cidx;
#pragma unroll
    for (int i = 0; i < 4; ++i) {
      const int tau = 4 * tg + i;
      const int tok = chunk * 64 + (dir ? (63 - tau) : tau);
      pg[i] = ((const unsigned*)(Gb + (rowbase + tok) * 512 + dir * 256 + head * 64))[cp];
    }
  };
  auto gloadB = [&](int cidx) __attribute__((always_inline)) {
    const int chunk = dir ? (63 - cidx) : cidx;
#pragma unroll
    for (int i = 0; i < 4; ++i) {
      const int tau = 4 * tg + i;
      const int tok = chunk * 64 + (dir ? (63 - tau) : tau);
      const unsigned* rp = (const unsigned*)(Hh + (rowbase + tok) * NPAD + head * 64) + cp;
      kk[i] = rp[G_K / 2]; qq[i] = do_out ? rp[G_Q / 2] : 0u;
    }
#pragma unroll
    for (int i = 0; i < 8; ++i) {
      const int tau = 8 * vg + i;
      const int tok = chunk * 64 + (dir ? (63 - tau) : tau);
      vv[i] = ((const unsigned*)(Hh + (rowbase + tok) * NPAD + G_V + head * 128))[vp2];
    }
  };
  auto stage1 = [&]() __attribute__((always_inline)) {
    float r0 = 0.f, r1 = 0.f;
#pragma unroll
    for (int i = 0; i < 4; ++i) { r0 += lo16(pg[i]); r1 += hi16(pg[i]); g0[i] = r0; g1[i] = r1; }
    *(float2*)(sTot + tg * 64 + ch0) = make_float2(r0, r1);
  };
  gloadA(seg * SLEN); gloadB(seg * SLEN);
  stage1();
  if (SLEN > 1) gloadA(seg * SLEN + 1);
  for (int ci = 0; ci < SLEN; ++ci) {
    const int cidx = seg * SLEN + ci;
    const int chunk = dir ? (63 - cidx) : cidx;
    lds_barrier();
    float off0 = 0.f, off1 = 0.f, ref0 = 0.f, ref1 = 0.f, be0 = 0.f, be1 = 0.f;
#pragma unroll
    for (int j = 0; j < 16; ++j) {
      const float2 t = *(const float2*)(sTot + j * 64 + ch0);
      if (j < tg) { off0 += t.x; off1 += t.y; }
      if (j < 8) { ref0 += t.x; ref1 += t.y; }
      be0 += t.x; be1 += t.y;
    }
    dlog0 += be0; dlog1 += be1;
    const float eref0 = ex2(ref0), eref1 = ex2(ref1), ebr0 = ex2(be0 - ref0), ebr1 = ex2(be1 - ref1);
    const float d0 = off0 - ref0, d1 = off1 - ref1;
    float kh0[4], kh1[4];
#pragma unroll
    for (int i = 0; i < 4; ++i) {
      const int tau = 4 * tg + i;
      const float E0 = ex2(g0[i] + d0), E1 = ex2(g1[i] + d1);
      const float kt0 = lo16(kk[i]) * frcp(E0), kt1 = hi16(kk[i]) * frcp(E1);
      if (do_out) {
        const float qt0 = lo16(qq[i]) * E0, qt1 = hi16(qq[i]) * E1;
        sQt[tau * KPW + cp] = pk2(qt0, qt1);
        sKt[tau * KPW + cp] = pk2(kt0, kt1);
        sQc[tau * KPW + cp] = pk2(qt0 * eref0, qt1 * eref1);
      }
      kh0[i] = kt0 * ebr0; kh1[i] = kt1 * ebr1;
    }
    *(uint2*)(sKhT + ch0 * 72 + 4 * tg) = make_uint2(pk2(kh0[0], kh0[1]), pk2(kh0[2], kh0[3]));
    *(uint2*)(sKhT + (ch0 + 1) * 72 + 4 * tg) = make_uint2(pk2(kh1[0], kh1[1]), pk2(kh1[2], kh1[3]));
    *(u32x4*)(sVT + (2 * vp2) * 72 + 8 * vg) = PACK8_LO(vv);
    *(u32x4*)(sVT + (2 * vp2 + 1) * 72 + 8 * vg) = PACK8_HI(vv);
    if (tg == 0) *(float2*)(sD + ch0) = make_float2(ex2(be0), ex2(be1));
    if (do_out) scan_write_state<K, V>(smem, S, w, lane);
    if (ci + 1 < SLEN) gloadB(cidx + 1);
    lds_barrier();
    scan_core<K, V, false>(smem, S, OB + (rowbase + (size_t)chunk * 64) * 512 + head * 128, dir, w, lane, do_out, nullptr);
    if (ci + 1 < SLEN) { stage1(); if (ci + 2 < SLEN) gloadA(cidx + 2); }
  }
  if (!do_out) {
    state_store<K, V>(sbuf, S, w, lane);
    if (tg == 0) *(float2*)((float*)(p.ws + OFF_DB) + ((size_t)it * NSEG + seg) * 128 + ch0) = make_float2(ex2(dlog0), ex2(dlog1));
  }
  lds_barrier();
}

DEV void ssd_item(const Params& p, int l, int it, int seg, int mode, unsigned char* smem) {
  const int j32 = it - 32, bl = j32 >> 4, head = (j32 >> 1) & 7, dir = j32 & 1;
  const bool do_out = (mode == 3);
  constexpr int K = 128, V = 64, KPW = 68;
  const int tid = launder(threadIdx.x), lane = tid & 63, w = tid >> 6;
  const int cp = tid & 63, tg = tid >> 6, n0 = 2 * cp;
  const int xp = tid & 31, xg = tid >> 5;
  const int grp = head >> 2;
  const bf16_t* U = (const bf16_t*)(p.ws + OFF_U);
  const float* SMALL = (const float*)(p.ws + OFF_SMALL);
  bf16_t* OB = (bf16_t*)(p.ws + OFF_OBUF) + (size_t)(1 * 2 + dir) * TH * 512;
  const size_t rowbase = (size_t)bl * SEQ;
  unsigned* sQt = (unsigned*)(smem + L_QT); unsigned* sKt = (unsigned*)(smem + L_KT); unsigned* sQc = (unsigned*)(smem + L_QC);
  bf16_t* sKhT = (bf16_t*)(smem + L_KHT); bf16_t* sVT = (bf16_t*)(smem + L_VT);
  float* sD = (float*)(smem + L_D);
  const float dtb = p.dt_bias[(l * 2 + dir) * 8 + head];
  const float Acoef = -__expf(p.a_log[(l * 2 + dir) * 8 + head]) * LOG2E;
  f32x16 S[1]; S[0] = zero16();
  float* sbuf = (float*)(p.ws + OFF_SB2) + ((size_t)j32 * NSEG + seg) * 8192;
  if (do_out) state_combine<K, V>((const float*)(p.ws + OFF_SB2) + (size_t)j32 * NSEG * 8192, 8192, (const float*)(p.ws + OFF_DB) + (size_t)it * NSEG * 128, seg, S, w, lane);
  float dlog = 0.f;
  unsigned bb[8], cc[8], xx[4];
  float rdt = 0.f;
  auto gloadA = [&](int cidx) __attribute__((always_inline)) {
    const int chunk = dir ? (63 - cidx) : cidx;
    if (w == 0) {
      const int tok = chunk * 64 + (dir ? (63 - lane) : lane);
      rdt = SMALL[(rowbase + tok) * 48 + dir * 8 + head];
    }
  };
  auto gloadB = [&](int cidx) __attribute__((always_inline)) {
    const int chunk = dir ? (63 - cidx) : cidx;
#pragma unroll
    for (int i = 0; i < 8; ++i) {
      const int tau = 8 * tg + i;
      const int tok = chunk * 64 + (dir ? (63 - tau) : tau);
      const unsigned* rp = (const unsigned*)(U + (rowbase + tok) * 1024 + grp * 128) + cp;
      bb[i] = rp[512 / 2]; cc[i] = do_out ? rp[768 / 2] : 0u;
    }
#pragma unroll
    for (int i = 0; i < 4; ++i) {
      const int tau = 4 * xg + i;
      const int tok = chunk * 64 + (dir ? (63 - tau) : tau);
      xx[i] = ((const unsigned*)(U + (rowbase + tok) * 1024 + head * 64))[xp];
    }
  };
  auto stage1 = [&](int par) __attribute__((always_inline)) {
    if (w == 0) {
      const float xv = rdt + dtb;
      const float dt = (xv > 20.f) ? xv : log1pf(__expf(xv));
      float a = dt * Acoef;
#pragma unroll
      for (int o = 1; o < 64; o <<= 1) { const float t = __shfl_up(a, o); if (lane >= o) a += t; }
      ((float*)(smem + L_ACS))[par * 64 + lane] = a; ((float*)(smem + L_DT))[par * 64 + lane] = dt;
    }
  };
  gloadA(seg * SLEN); gloadB(seg * SLEN);
  stage1(0);
  if (SLEN > 1) gloadA(seg * SLEN + 1);
  for (int ci = 0; ci < SLEN; ++ci) {
    const int cidx = seg * SLEN + ci;
    const int chunk = dir ? (63 - cidx) : cidx;
    const float* sAcs = (const float*)(smem + L_ACS) + (ci & 1) * 64;
    const float* sDt = (const float*)(smem + L_DT) + (ci & 1) * 64;
    lds_barrier();
    const float aend = sAcs[63];
    dlog += aend;
    {
      float kh0[8], kh1[8];
#pragma unroll
      for (int i = 0; i < 8; ++i) {
        const int tau = 8 * tg + i;
        const float ac = sAcs[tau];
        const float eb = ex2(aend - ac);
        kh0[i] = lo16(bb[i]) * eb; kh1[i] = hi16(bb[i]) * eb;
        if (do_out) {
          const float ea = ex2(ac);
          sKt[tau * KPW + cp] = bb[i];
          sQt[tau * KPW + cp] = cc[i];
          sQc[tau * KPW + cp] = pk2(lo16(cc[i]) * ea, hi16(cc[i]) * ea);
        }
      }
      *(u32x4*)(sKhT + n0 * 72 + 8 * tg) = CVT8(kh0);
      *(u32x4*)(sKhT + (n0 + 1) * 72 + 8 * tg) = CVT8(kh1);
      float x0[4], x1[4];
#pragma unroll
      for (int i = 0; i < 4; ++i) { const float dtv = sDt[4 * xg + i]; x0[i] = lo16(xx[i]) * dtv; x1[i] = hi16(xx[i]) * dtv; }
      *(uint2*)(sVT + (2 * xp) * 72 + 4 * xg) = make_uint2(pk2(x0[0], x0[1]), pk2(x0[2], x0[3]));
      *(uint2*)(sVT + (2 * xp + 1) * 72 + 4 * xg) = make_uint2(pk2(x1[0], x1[1]), pk2(x1[2], x1[3]));
      if (tg == 0) *(float2*)(sD + n0) = make_float2(ex2(aend), ex2(aend));
    }
    if (do_out) scan_write_state<K, V>(smem, S, w, lane);
    if (ci + 1 < SLEN) gloadB(cidx + 1);
    lds_barrier();
    scan_core<K, V, true>(smem, S, OB + (rowbase + (size_t)chunk * 64) * 512 + head * 64, dir, w, lane, do_out, sAcs);
    if (ci + 1 < SLEN) { stage1((ci + 1) & 1); if (ci + 2 < SLEN) gloadA(cidx + 2); }
  }
  if (!do_out) {
    state_store<K, V>(sbuf, S, w, lane);
    if (tg == 0) *(float2*)((float*)(p.ws + OFF_DB) + ((size_t)it * NSEG + seg) * 128 + n0) = make_float2(ex2(dlog), ex2(dlog));
  }
  lds_barrier();
}

DEV void phase_prep(const Params& p, int l, int hf, int rep, unsigned char* smem) {
  const int tid = launder(threadIdx.x), lane = tid & 63;
  bf16_t* Hh = (bf16_t*)(p.ws + OFF_H);
  bf16_t* U = (bf16_t*)(p.ws + OFF_U);
  bf16_t* Gb = (bf16_t*)(p.ws + OFF_G);
  bf16_t* VT = (bf16_t*)(p.ws + OFF_VT);
  const float* SMALLp = (const float*)(p.ws + OFF_SMALL);
  float2* stab = (float2*)smem;
  float* slow = (float*)(smem + 8192);
  bf16_t* sT = (bf16_t*)(smem + 12288);
  {
    const float2* tabg = (const float2*)(p.ws + OFF_TAB);
    for (int i = tid; i < 1024; i += NT) stab[i] = tabg[i];
  }
  const int cg8 = (tid & 127) * 8, rsub = tid >> 7;
  const float* cw = p.conv_w + (size_t)l * 5 * 1024; const float* cb = p.conv_b + (size_t)l * 1024;
  float wv[5][8], bv[8];
#pragma unroll
  for (int j = 0; j < 5; ++j)
#pragma unroll
    for (int e = 0; e < 8; ++e) wv[j][e] = cw[j * 1024 + cg8 + e];
#pragma unroll
  for (int e = 0; e < 8; ++e) bv[e] = cb[cg8 + e];
  const int gd = tid >> 8, gc = tid & 255;
  const int i16 = lane & 15;
  const float* gq = p.q_gain + l * 64 + 4 * i16; const float* gk = p.k_gain + l * 64 + 4 * i16;
  const float gqv[4] = {gq[0], gq[1], gq[2], gq[3]}, gkv[4] = {gk[0], gk[1], gk[2], gk[3]};
  for (int grp = blockIdx.x; grp < TH / 32; grp += gridDim.x) {
    const int r0 = grp * 32;
    lds_barrier();
    const u32x4 vt = *(const u32x4*)(Hh + (size_t)(r0 + (tid >> 4)) * NPAD + A_V + (tid & 15) * 8);
    const float2 lowv = *(const float2*)(SMALLp + (size_t)(r0 + (tid >> 4)) * 48 + 16 + (tid & 15) * 2);
    *(u32x4*)(sT + (tid >> 4) * 136 + (tid & 15) * 8) = vt;
    *(float2*)(slow + (tid >> 4) * 32 + (tid & 15) * 2) = lowv;
#pragma unroll 1
    for (int ps = 0; ps < 2; ++ps) {
      const int ra = r0 + 16 * ps + 4 * rsub, ta = ra & (SEQ - 1);
      u32x4 xc[8];
#pragma unroll
      for (int m = 0; m < 8; ++m) {
        const int sq = ta + m - 2;
        xc[m] = (u32x4){0u, 0u, 0u, 0u};
        if (sq >= 0 && sq < SEQ) xc[m] = *(const u32x4*)(Hh + (size_t)(ra + m - 2) * NPAD + S_X + cg8);
      }
#pragma unroll
      for (int o4 = 0; o4 < 4; ++o4) {
        float u[8];
#pragma unroll
        for (int e = 0; e < 8; ++e) u[e] = bv[e];
#pragma unroll
        for (int j = 0; j < 5; ++j)
#pragma unroll
          for (int e = 0; e < 4; ++e) { u[2 * e] += wv[j][2 * e] * lo16(xc[o4 + j][e]); u[2 * e + 1] += wv[j][2 * e + 1] * hi16(xc[o4 + j][e]); }
        u32x4 o;
#pragma unroll
        for (int e = 0; e < 4; ++e) {
          const float a = u[2 * e] * frcp(1.f + ex2(fminf(-u[2 * e] * LOG2E, 80.f)));
          const float b = u[2 * e + 1] * frcp(1.f + ex2(fminf(-u[2 * e + 1] * LOG2E, 80.f)));
          o[e] = pk2(a, b);
        }
        *(u32x4*)(U + (size_t)(ra + o4) * 1024 + cg8) = o;
      }
    }
    lds_barrier();
    if (rep == 0) {
      u32x4 hq[6];
#pragma unroll
      for (int u = 0; u < 6; ++u) {
        const int id = u * 512 + tid, row = r0 + id / 96, c96 = id % 96;
        hq[u] = *(const u32x4*)(Hh + (size_t)row * NPAD + ((c96 < 64) ? (H_Q + c96 * 8) : (G_Q + (c96 - 64) * 8)));
      }
#pragma unroll 1
      for (int ub = 0; ub < 10; ub += 5) {
        uint2 xq[5];
#pragma unroll
        for (int u = 0; u < 5; ++u) {
          const int pi = (ub + u) * 32 + (tid >> 4), row = r0 + pi / 10, hd = pi % 10;
          xq[u] = *(const uint2*)(Hh + (size_t)row * NPAD + ((hd < 8) ? (A_Q + hd * 64) : (A_K + (hd - 8) * 64)) + 4 * i16);
        }
#pragma unroll
        for (int u = 0; u < 5; ++u) {
          const int pi = (ub + u) * 32 + (tid >> 4), row = r0 + pi / 10, hd = pi % 10;
          const bool isq = hd < 8;
          const float x[4] = {lo16(xq[u].x), hi16(xq[u].x), lo16(xq[u].y), hi16(xq[u].y)};
          float ss = x[0] * x[0] + x[1] * x[1] + x[2] * x[2] + x[3] * x[3];
          ss += __shfl_xor(ss, 1); ss += __shfl_xor(ss, 2); ss += __shfl_xor(ss, 4); ss += __shfl_xor(ss, 8);
          const float rstd = rsqrtf(ss * (1.f / 64.f) + 1e-6f);
          const int t = row & (SEQ - 1);
          const int pos = (i16 < 8) ? (t >> 6) : (t & 63);
          const float osc = isq ? QSCALE : 1.f;
          float o[4];
#pragma unroll
          for (int e = 0; e < 4; ++e) {
            const float v = x[e] * rstd * (isq ? gqv[e] : gkv[e]);
            const float pv = __shfl_xor(v, 4);
            const float2 cs = stab[pos * 16 + 4 * (i16 & 3) + e];
            o[e] = ((i16 & 4) ? (v * cs.x + pv * cs.y) : (v * cs.x - pv * cs.y)) * osc;
          }
          *(uint2*)(Hh + (size_t)row * NPAD + (isq ? (A_Q + hd * 64) : (A_K + (hd - 8) * 64)) + 4 * i16) = make_uint2(pk2(o[0], o[1]), pk2(o[2], o[3]));
        }
      }
#pragma unroll
      for (int u = 0; u < 6; ++u) {
        const int id = u * 512 + tid, row = r0 + id / 96, c96 = id % 96;
        u32x4 x = hq[u];
        if (c96 < 64) {
#pragma unroll
          for (int e = 0; e < 4; ++e) {
            const float a = lo16(x[e]), b = hi16(x[e]);
            x[e] = pk2(a * frcp(1.f + ex2(fminf(-a * LOG2E, 80.f))) * 0.08838834764831845f, b * frcp(1.f + ex2(fminf(-b * LOG2E, 80.f))) * 0.08838834764831845f);
          }
        } else {
#pragma unroll
          for (int e = 0; e < 4; ++e) x[e] = pk2(lo16(x[e]) * 0.125f, hi16(x[e]) * 0.125f);
        }
        *(u32x4*)(Hh + (size_t)row * NPAD + ((c96 < 64) ? (H_Q + c96 * 8) : (G_Q + (c96 - 64) * 8))) = x;
      }
    }
    float w2c[16];
#pragma unroll
    for (int r = 0; r < 16; ++r) w2c[r] = p.gk_w2[((size_t)(l * 2 + gd) * 16 + r) * 256 + gc];
    const float gbias = p.gk_b[(l * 2 + gd) * 256 + gc];
#pragma unroll 4
    for (int rr = 0; rr < 32; ++rr) {
      const float4* lp4 = (const float4*)(slow + rr * 32 + gd * 16);
      float gkk = gbias;
#pragma unroll
      for (int r4 = 0; r4 < 4; ++r4) { const float4 lw = lp4[r4]; gkk += lw.x * w2c[4 * r4] + lw.y * w2c[4 * r4 + 1] + lw.z * w2c[4 * r4 + 2] + lw.w * w2c[4 * r4 + 3]; }
      const float l2 = (fminf(gkk, 0.f) * LOG2E - lg2(1.f + ex2(-fabsf(gkk) * LOG2E))) * (1.f / 16.f);
      Gb[(size_t)(r0 + rr) * 512 + tid] = f2bf(l2);
    }
    {
      const int c = tid >> 2, tq = (tid & 3) * 8;
      unsigned v[8];
#pragma unroll
      for (int i = 0; i < 8; ++i) v[i] = sT[(tq + i) * 136 + c];
      const int bl = r0 >> 12, t0 = (r0 & (SEQ - 1)) + tq;
      *(u32x4*)(VT + ((size_t)((bl * 2 + (c >> 6)) * 64 + (c & 63))) * SEQ + t0) = (u32x4){v[0] | (v[1] << 16), v[2] | (v[3] << 16), v[4] | (v[5] << 16), v[6] | (v[7] << 16)};
    }
  }
  lds_barrier();
}

DEV void phase_mix(const Params& p, int l, int hf, int slot, int mode, int att_lo, int att_hi, int vid_lo, int vid_hi, unsigned char* smem) {
  unsigned* ctr = (unsigned*)(p.ws + OFF_CTRL) + CTR_WORD0 + slot * 16;
  volatile int* sItem = (volatile int*)(smem + LDS_BYTES - 16);
  const int n_scan = 64 * NSEG;
  int hi = n_scan + (att_hi - att_lo); if (vid_hi < hi) hi = vid_hi;
  for (;;) {
    lds_barrier();
    if (threadIdx.x == 0) *sItem = vid_lo + (int)atomicAdd(ctr, 1u);
    lds_barrier();
    const int vid = *sItem;
    if (vid >= hi) break;
    if (vid < n_scan) {
      const int seg = vid >> 6, it = vid & 63;
      if (mode == 1 && seg == NSEG - 1) continue;
#if PROBE_REP > 0
      if (slot >= 40 && PROBE_TYPE >= 0 && ((it < 16) ? 0 : (it < 32) ? 1 : 2) != PROBE_TYPE) continue;
#endif
      if (it < 16) { if (PH_MASK & 0x100) hgrn_item(p, l, it, seg, mode, smem); }
      else if (it < 32) { if (PH_MASK & 0x200) gla_item(p, l, it, seg, mode, smem); }
      else { if (PH_MASK & 0x400) ssd_item(p, l, it, seg, mode, smem); }
    } else { if (PH_MASK & 0x800) attn_item(p, l, att_lo + (vid - n_scan), smem); }
  }
}

DEV void phase_scan2(const Params& p) {
  const size_t gtid = (size_t)blockIdx.x * NT + threadIdx.x, gsz = (size_t)gridDim.x * NT;
  const float* DB = (const float*)(p.ws + OFF_DB);
  for (size_t e = gtid; e < 655360; e += gsz) {
    float* buf; const float* dp; int stride;
    if (e < 262144) { const int it = (int)(e >> 14), idx = (int)(e & 16383); buf = (float*)(p.ws + OFF_SB0) + (size_t)it * NSEG * 16384 + idx; stride = 16384; dp = DB + (size_t)it * NSEG * 128 + (idx >> 7); }
    else if (e < 393216) { const int e2 = (int)(e - 262144), j = e2 >> 13, idx = e2 & 8191; buf = (float*)(p.ws + OFF_SB1) + (size_t)j * NSEG * 8192 + idx; stride = 8192; dp = DB + (size_t)(16 + j) * NSEG * 128 + (idx >> 7); }
    else { const int e3 = (int)(e - 393216), j = e3 >> 13, idx = e3 & 8191; buf = (float*)(p.ws + OFF_SB2) + (size_t)j * NSEG * 8192 + idx; stride = 8192; dp = DB + (size_t)(32 + j) * NSEG * 128 + (idx >> 6); }
    float u[NSEG - 1], d[NSEG - 1];
#pragma unroll
    for (int sg = 0; sg < NSEG - 1; ++sg) { u[sg] = buf[(size_t)sg * stride]; d[sg] = dp[sg * 128]; }
    float st = 0.f;
#pragma unroll
    for (int sg = 0; sg < NSEG; ++sg) { buf[(size_t)sg * stride] = st; if (sg < NSEG - 1) st = d[sg] * st + u[sg]; }
  }
}

DEV float bfe(const u32x4& v, int j) { return (j & 1) ? hi16(v[j >> 1]) : lo16(v[j >> 1]); }
DEV void phase_fin(const Params& p, int l, int hf) {
  const int tid = launder(threadIdx.x), lane = tid & 63, w = tid >> 6;
  const bf16_t* Hh = (const bf16_t*)(p.ws + OFF_H);
  const bf16_t* OB = (const bf16_t*)(p.ws + OFF_OBUF);
  bf16_t* MX = (bf16_t*)(p.ws + OFF_MIXED);
  const int c0 = lane * 8;
  const float* cw = p.conv_w + (size_t)l * 5 * 1024; const float* cb = p.conv_b + (size_t)l * 1024;
  for (int r0 = (blockIdx.x * 8 + w) * 4; r0 < TH; r0 += gridDim.x * 32) {
    {
      u32x4 at[4], a[4], b[4], z[4];
#pragma unroll
      for (int i = 0; i < 4; ++i) {
        const bf16_t* hrow = Hh + (size_t)(r0 + i) * NPAD;
        at[i] = *(const u32x4*)(hrow + A_Q + c0);
        a[i] = *(const u32x4*)(OB + ((size_t)0 * TH + r0 + i) * 512 + c0); b[i] = *(const u32x4*)(OB + ((size_t)1 * TH + r0 + i) * 512 + c0);
        z[i] = *(const u32x4*)(hrow + H_Z + c0);
      }
      float gn[8];
#pragma unroll
      for (int j = 0; j < 8; ++j) gn[j] = p.hgrn_norm[l * 512 + c0 + j];
#pragma unroll
      for (int i = 0; i < 4; ++i) {
        *(u32x4*)(MX + (size_t)(r0 + i) * DI + c0) = at[i];
        float o[8]; float ss = 0.f;
#pragma unroll
        for (int j = 0; j < 8; ++j) { o[j] = bfe(a[i], j) + bfe(b[i], j); ss += o[j] * o[j]; }
#pragma unroll
        for (int of = 32; of >= 1; of >>= 1) ss += __shfl_xor(ss, of);
        const float rstd = rsqrtf(ss * (1.f / 512.f) + 1e-6f);
        float y[8];
#pragma unroll
        for (int j = 0; j < 8; ++j) { const float zz = bfe(z[i], j); y[j] = o[j] * rstd * gn[j] * (zz * frcp(1.f + ex2(fminf(-zz * LOG2E, 80.f)))); }
        *(u32x4*)(MX + (size_t)(r0 + i) * DI + 512 + c0) = (u32x4){pk2(y[0], y[1]), pk2(y[2], y[3]), pk2(y[4], y[5]), pk2(y[6], y[7])};
      }
    }
    {
      u32x4 a[4], b[4], z[4];
#pragma unroll
      for (int i = 0; i < 4; ++i) {
        a[i] = *(const u32x4*)(OB + ((size_t)4 * TH + r0 + i) * 512 + c0); b[i] = *(const u32x4*)(OB + ((size_t)5 * TH + r0 + i) * 512 + c0);
        z[i] = *(const u32x4*)(Hh + (size_t)(r0 + i) * NPAD + G_Z + c0);
      }
      float gn[8];
#pragma unroll
      for (int j = 0; j < 8; ++j) gn[j] = p.gla_norm[l * 128 + ((c0 + j) & 127)];
#pragma unroll
      for (int i = 0; i < 4; ++i) {
        float o[8]; float ss = 0.f;
#pragma unroll
        for (int j = 0; j < 8; ++j) { o[j] = bfe(a[i], j) + bfe(b[i], j); ss += o[j] * o[j]; }
#pragma unroll
        for (int of = 8; of >= 1; of >>= 1) ss += __shfl_xor(ss, of);
        const float rstd = rsqrtf(ss * (1.f / 128.f) + 1e-6f);
        float y[8];
#pragma unroll
        for (int j = 0; j < 8; ++j) { const float zz = bfe(z[i], j); y[j] = o[j] * rstd * gn[j] * (zz * frcp(1.f + ex2(fminf(-zz * LOG2E, 80.f)))); }
        *(u32x4*)(MX + (size_t)(r0 + i) * DI + 1536 + c0) = (u32x4){pk2(y[0], y[1]), pk2(y[2], y[3]), pk2(y[4], y[5]), pk2(y[6], y[7])};
      }
    }
    {
      u32x4 a[4], b[4], z[4], xr[8];
      const int t0 = r0 & (SEQ - 1);
#pragma unroll
      for (int i = 0; i < 4; ++i) {
        a[i] = *(const u32x4*)(OB + ((size_t)2 * TH + r0 + i) * 512 + c0); b[i] = *(const u32x4*)(OB + ((size_t)3 * TH + r0 + i) * 512 + c0);
        z[i] = *(const u32x4*)(Hh + (size_t)(r0 + i) * NPAD + S_Z + c0);
      }
#pragma unroll
      for (int m = 0; m < 8; ++m) {
        const int sq = t0 + m - 2;
        xr[m] = (u32x4){0u, 0u, 0u, 0u};
        if (sq >= 0 && sq < SEQ) xr[m] = *(const u32x4*)(Hh + (size_t)(r0 + m - 2) * NPAD + S_X + c0);
      }
      float gn[8], cbv[8];
#pragma unroll
      for (int j = 0; j < 8; ++j) { gn[j] = p.ssd_norm[l * 512 + c0 + j]; cbv[j] = cb[c0 + j]; }
      const float dsk = p.ssd_d[l * 8 + (c0 >> 6)];
#pragma unroll
      for (int i = 0; i < 4; ++i) {
        float u[8];
#pragma unroll
        for (int j = 0; j < 8; ++j) u[j] = cbv[j];
#pragma unroll
        for (int jj = 0; jj < 5; ++jj)
#pragma unroll
          for (int j = 0; j < 8; ++j) u[j] += cw[jj * 1024 + c0 + j] * bfe(xr[i + jj], j);
        float y[8]; float ss = 0.f;
#pragma unroll
        for (int j = 0; j < 8; ++j) {
          const float zz = bfe(z[i], j);
          const float xs = u[j] * frcp(1.f + ex2(fminf(-u[j] * LOG2E, 80.f)));
          y[j] = (bfe(a[i], j) + bfe(b[i], j) + dsk * xs) * (zz * frcp(1.f + ex2(fminf(-zz * LOG2E, 80.f))));
          ss += y[j] * y[j];
        }
#pragma unroll
        for (int of = 32; of >= 1; of >>= 1) ss += __shfl_xor(ss, of);
        const float rstd = rsqrtf(ss * (1.f / 512.f) + 1e-6f);
#pragma unroll
        for (int j = 0; j < 8; ++j) y[j] = y[j] * rstd * gn[j];
        *(u32x4*)(MX + (size_t)(r0 + i) * DI + 1024 + c0) = (u32x4){pk2(y[0], y[1]), pk2(y[2], y[3]), pk2(y[4], y[5]), pk2(y[6], y[7])};
      }
    }
  }
}

#define XB_TMO      128
#define XB_XCNT(j)  (256  + 64 * (j))
#define XB_XSUB(j)  (1280 + 64 * (j))
#define XB_XGEN(j)  (2304 + 64 * (j))
#define XB_TOP      3328
#define XB_TOPGEN   3392
#define XB_SPIN_CAP (1u << 22)
#define LAS __attribute__((address_space(3)))
DEV unsigned xb_ld(unsigned* p) { return __hip_atomic_load(p, __ATOMIC_RELAXED, __HIP_MEMORY_SCOPE_AGENT); }
DEV unsigned xb_add(unsigned* p, unsigned v) { return __hip_atomic_fetch_add(p, v, __ATOMIC_RELAXED, __HIP_MEMORY_SCOPE_AGENT); }
DEV unsigned xb_xcc_id() { return (unsigned)__builtin_amdgcn_s_getreg((3 << 11) | 20) & 0xFu; }
#define XB_SPIN(cond, bar) do { unsigned _sp = 0; while (cond) { __builtin_amdgcn_s_sleep(1); \
    if ((++_sp & 255u) == 0u) { if (xb_ld(&(bar)[XB_TMO])) break; if (_sp > XB_SPIN_CAP) { atomicAdd(&(bar)[XB_TMO], 1u); break; } } } } while (0)
struct XcdBarrier { unsigned* bar; unsigned x; volatile LAS unsigned* st; };
DEV XcdBarrier xcd_barrier_post(unsigned* bar, volatile LAS unsigned* st) {
  XcdBarrier b; b.bar = bar; b.x = xb_xcc_id(); b.st = st;
  if (threadIdx.x == 0) (void)xb_add(&bar[XB_XCNT(b.x)], 1u);
  return b;
}
DEV void xcd_barrier_complete(unsigned* bar, unsigned x, unsigned& nloc, unsigned& nx) {
  const unsigned G = gridDim.x * gridDim.y * gridDim.z;
  unsigned sum, cnt, mine, sp = 0u;
  for (;;) {
    sum = 0u; cnt = 0u; mine = 0u;
#pragma unroll
    for (unsigned j = 0; j < 16; ++j) { const unsigned c = xb_ld(&bar[XB_XCNT(j)]); sum += c; cnt += (c > 0u) ? 1u : 0u; mine = (j == x) ? c : mine; }
    if (sum == G) break;
    __builtin_amdgcn_s_sleep(1);
    if ((++sp & 255u) == 0u) { if (xb_ld(&bar[XB_TMO])) break; if (sp > XB_SPIN_CAP) { atomicAdd(&bar[XB_TMO], 1u); break; } }
  }
  nloc = mine > 0u ? mine : 1u; nx = cnt > 0u ? cnt : 1u;
}
DEV void xcd_barrier(const XcdBarrier& b) {
  asm volatile("s_waitcnt vmcnt(0)" ::: "memory");
  __syncthreads();
  if (threadIdx.x == 0) {
    unsigned* bar = b.bar;
    __builtin_amdgcn_s_waitcnt(0);
    unsigned nloc = b.st[0], nx = b.st[1];
    if (nloc == 0u) { xcd_barrier_complete(bar, b.x, nloc, nx); b.st[0] = nloc; b.st[1] = nx; }
    const unsigned old = xb_add(&bar[XB_XSUB(b.x)], 1u);
    const unsigned gen = old / nloc;
    if (old + 1u == (gen + 1u) * nloc) {
      __builtin_amdgcn_fence(__ATOMIC_RELEASE, "agent");
      asm volatile("s_waitcnt vmcnt(0)" ::: "memory");
      const unsigned og = xb_add(&bar[XB_TOP], 1u);
      const unsigned tg = og / nx;
      if (og + 1u == (tg + 1u) * nx) xb_add(&bar[XB_TOPGEN], 1u);
      else XB_SPIN(xb_ld(&bar[XB_TOPGEN]) == tg, bar);
      __builtin_amdgcn_fence(__ATOMIC_ACQUIRE, "agent");
      xb_add(&bar[XB_XGEN(b.x)], 1u);
      asm volatile("s_waitcnt vmcnt(0)" ::: "memory");
    } else {
      XB_SPIN(xb_ld(&bar[XB_XGEN(b.x)]) == gen, bar);
      __builtin_amdgcn_fence(__ATOMIC_ACQUIRE, "agent");
      asm volatile("s_waitcnt vmcnt(0)" ::: "memory");
    }
  }
  __syncthreads();
}

DEV void run_phase(const Params& p, int ph, int rep, unsigned char* smem) {
  if (ph == 0) { if (PH_MASK & 1) { phase_pro(p, smem); convert_weights(p, 0, 3, smem); } return; }
  if (ph == 21) { if (PH_MASK & 16) phase_outproj(p, 1, 1, smem); return; }
  if (ph == 22) { if (PH_MASK & 32) phase_ln(p, 1, 1); return; }
  const int q = ph - 1, blk = q / 5, st = q % 5, l = blk >> 1, hf = blk & 1;
  if (st == 0) {
    if (blk > 0 && (PH_MASK & 16)) phase_outproj(p, (blk - 1) >> 1, (blk - 1) & 1, smem);
    if (PH_MASK & 2) phase_inproj(p, l, hf, blk > 0 ? 16 : 0, smem);
  } else if (st == 1) {
    if (blk > 0 && rep == 0 && (PH_MASK & 32)) phase_ln(p, (blk - 1) >> 1, (blk - 1) & 1);
    if (PH_MASK & 4) phase_prep(p, l, hf, rep, smem);
    if ((PH_MASK & 1) && rep == 0 && blk == 1) convert_weights(p, 1, 1, smem);
    if ((PH_MASK & 1) && rep == 0 && blk == 2) convert_weights(p, 1, 2, smem);
  }
  else if (st == 2) { if (PH_MASK & 0xF00) phase_mix(p, l, hf, ph + 40 * rep, 1, 0, ATT_SPLIT, rep ? PROBE_LO : 0, rep ? PROBE_HI : 100000, smem); }
  else if (st == 3) { if (PH_MASK & 0xF00) phase_mix(p, l, hf, ph + 40 * rep, 3, ATT_SPLIT, 256, rep ? PROBE_LO : 0, rep ? PROBE_HI : 100000, smem); }
  else { if (PH_MASK & 8) phase_fin(p, l, hf); }
}
__global__ void __launch_bounds__(NT) mega(Params p) {
  extern __shared__ __attribute__((aligned(16))) unsigned char smem[];
#if ONE_LAUNCH
  volatile LAS unsigned* xst = (volatile LAS unsigned*)(smem + LDS_BYTES - 32);
  if (threadIdx.x == 0) { xst[0] = 0u; xst[1] = 0u; }
  __syncthreads();
  XcdBarrier xb = xcd_barrier_post((unsigned*)(p.ws + OFF_CTRL), xst);
#endif
  Params* lp = (Params*)(smem + 147456);
  if (threadIdx.x == 0) *lp = p;
  __syncthreads();
  const int ph_begin = p.phase_begin, ph_end = p.phase_end;
  for (int ph = ph_begin; ph < ph_end; ++ph) {
    int nrep = 0;
#if PROBE_REP > 0
    {
      const int q = ph - 1, st = q % 5;
      const bool idem = (ph >= 1 && ph <= 20) && (st == PROBE_ST) && (st >= 1);
      if (idem) nrep = PROBE_REP;
    }
#endif
    for (int r = 0; r <= nrep; ++r) {
      run_phase(*lp, ph, r, smem);
#if ONE_LAUNCH
      if (r < nrep || ph + 1 < ph_end) xcd_barrier(xb);
#endif
    }
  }
}

extern "C" void kernel_launch(void* const* d_in, const int* in_sizes, int n_in, void* d_out, int out_size, void* d_ws, size_t ws_size,
                              hipStream_t stream) {
  static int grid_blocks = 0;
  if (!grid_blocks) {
    int dev = 0, cus = 0, per_cu = 0;
    hipGetDevice(&dev);
    hipDeviceGetAttribute(&cus, hipDeviceAttributeMultiprocessorCount, dev);
    hipFuncSetAttribute((const void*)mega, hipFuncAttributeMaxDynamicSharedMemorySize, LDS_BYTES);
    hipOccupancyMaxActiveBlocksPerMultiprocessor(&per_cu, mega, NT, LDS_BYTES);
    if (per_cu < 1) per_cu = 1;
    grid_blocks = cus;
  }
  Params p{};
  p.x = (const float*)d_in[0]; p.w_in = (const float*)d_in[1]; p.q_gain = (const float*)d_in[2]; p.k_gain = (const float*)d_in[3];
  p.lb_logits = (const float*)d_in[4]; p.hgrn_norm = (const float*)d_in[5]; p.conv_w = (const float*)d_in[6]; p.conv_b = (const float*)d_in[7];
  p.dt_bias = (const float*)d_in[8]; p.a_log = (const float*)d_in[9]; p.ssd_d = (const float*)d_in[10]; p.ssd_norm = (const float*)d_in[11];
  p.gk_w2 = (const float*)d_in[12]; p.gk_b = (const float*)d_in[13]; p.gla_norm = (const float*)d_in[14]; p.w_out = (const float*)d_in[15];
  p.ln_g = (const float*)d_in[16]; p.ln_b = (const float*)d_in[17];
  p.out = (float*)d_out; p.ws = (unsigned char*)d_ws;
  hipMemsetAsync(d_ws, 0, CTRL_BYTES, stream);
#if ONE_LAUNCH
  p.phase_begin = 0; p.phase_end = NPHASE;
  void* args[] = {&p};
  (void)args;
  hipLaunchKernelGGL(mega, dim3(grid_blocks), dim3(NT), LDS_BYTES, stream, p);
#else
  for (int ph = 0; ph < NPHASE; ++ph) {
    p.phase_begin = ph; p.phase_end = ph + 1;
    hipLaunchKernelGGL(mega, dim3(grid_blocks), dim3(NT), LDS_BYTES, stream, p);
  }
#endif
}
```

```cpp
#include <hip/hip_runtime.h>
#include <hip/hip_cooperative_groups.h>
#include <stdint.h>
#include <stdio.h>
namespace cg = cooperative_groups;

#ifndef ONE_LAUNCH
#define ONE_LAUNCH 1
#endif

#ifndef PH_MASK
#define PH_MASK 0xFFF
#endif
#ifndef PROBE_ST
#define PROBE_ST -1
#endif
#ifndef PROBE_REP
#define PROBE_REP 0
#endif
#ifndef PROBE_TYPE
#define PROBE_TYPE -1
#endif
#ifndef PROBE_LO
#define PROBE_LO 0
#endif
#ifndef PROBE_HI
#define PROBE_HI 100000
#endif
#define DEV __device__ __forceinline__
typedef unsigned short bf16_t;
typedef short bf16x8 __attribute__((ext_vector_type(8)));
typedef float f32x16 __attribute__((ext_vector_type(16)));
typedef unsigned u32x4 __attribute__((ext_vector_type(4)));
typedef float f32x4 __attribute__((ext_vector_type(4)));

constexpr int NT = 512;
constexpr int T_ALL = 16384, TH = 8192, SEQ = 4096, DM = 1024, NPAD = 7168, DI = 2048, NIN = 6960;
constexpr int A_Q = 0, A_K = 512, A_V = 640, A_Z = 768, H_Q = 1280, H_FF = 1792, H_FB = 2304, H_I = 2816, H_Z = 3328,
              S_X = 3840, S_Z = 4864, G_Q = 5376, G_K = 5632, G_V = 5888, G_Z = 6400, SM0 = 6912;
constexpr size_t OFF_CTRL = 0, OFF_TAB = 65536, OFF_XB = 131072;
constexpr size_t OFF_WIN = OFF_XB + (size_t)T_ALL * DM * 2;
constexpr size_t OFF_WOUT = OFF_WIN + (size_t)NPAD * DM * 2;
constexpr size_t OFF_H = OFF_WOUT + (size_t)DM * DI * 2;
constexpr size_t OFF_SMALL = OFF_H + (size_t)TH * NPAD * 2;
constexpr size_t OFF_OBUF = OFF_SMALL + (size_t)TH * 48 * 4;
constexpr size_t OFF_VT = OFF_OBUF + (size_t)6 * TH * 512 * 2;
constexpr size_t OFF_DB = OFF_VT + (size_t)2 * 2 * 64 * SEQ * 2;
constexpr int NSEG = 4, SLEN = 64 / NSEG;
constexpr size_t OFF_MIXED = OFF_DB + (size_t)64 * NSEG * 128 * 4;
constexpr size_t OFF_SB0 = OFF_MIXED, OFF_SB1 = OFF_SB0 + (size_t)16 * NSEG * 16384 * 4, OFF_SB2 = OFF_SB1 + (size_t)16 * NSEG * 8192 * 4;
constexpr size_t OFF_U = OFF_SB2 + (size_t)32 * NSEG * 8192 * 4;
constexpr size_t OFF_G = OFF_U + (size_t)TH * 1024 * 2;
constexpr size_t WS_END = (OFF_G + (size_t)TH * 512 * 2 > OFF_MIXED + (size_t)TH * DI * 2) ? (OFF_G + (size_t)TH * 512 * 2) : (OFF_MIXED + (size_t)TH * DI * 2);
static_assert(OFF_MIXED + (size_t)TH * DI * 2 <= WS_END, "MIXED must fit");
static_assert(WS_END <= 268435456, "workspace");
constexpr size_t CTRL_BYTES = 65536;
constexpr int CTR_WORD0 = 4096;
constexpr int LDS_BYTES = 148480;
constexpr float LOG2E = 1.4426950408889634f;
constexpr float QSCALE = 0.125f * LOG2E;
constexpr float DN_ALPHA = 1.4142135623730951f;
constexpr int NPHASE = 23;
constexpr int ATT_SPLIT = 256;

struct Params {
  const float* x; const float* w_in; const float* q_gain; const float* k_gain; const float* lb_logits; const float* hgrn_norm;
  const float* conv_w; const float* conv_b; const float* dt_bias; const float* a_log; const float* ssd_d; const float* ssd_norm;
  const float* gk_w2; const float* gk_b; const float* gla_norm; const float* w_out; const float* ln_g; const float* ln_b;
  float* out; unsigned char* ws;
  int phase_begin, phase_end;
};

DEV void lds_barrier() { asm volatile("s_waitcnt lgkmcnt(0)" ::: "memory"); __builtin_amdgcn_s_barrier(); asm volatile("" ::: "memory"); }
DEV int launder(int v) { asm volatile("" : "+v"(v)); return v; }
DEV float bf2f(bf16_t v) { return __uint_as_float(((unsigned)v) << 16); }
DEV bf16_t f2bf(float f) { unsigned u = __float_as_uint(f); u += 0x7fffu + ((u >> 16) & 1u); return (bf16_t)(u >> 16); }
typedef __bf16 bf16x2_t __attribute__((ext_vector_type(2)));
typedef float f32x2_t __attribute__((ext_vector_type(2)));
DEV unsigned pk2(float lo, float hi) { const f32x2_t f = {lo, hi}; const bf16x2_t b = __builtin_convertvector(f, bf16x2_t); return __builtin_bit_cast(unsigned, b); }
DEV float fsigmoid(float x) { return 1.f / (1.f + __expf(-x)); }
DEV float fsilu(float x) { return x / (1.f + __expf(-x)); }
DEV unsigned cvtpk(float lo, float hi) { return pk2(lo, hi); }
DEV float ex2(float x) { return __builtin_amdgcn_exp2f(x); }
DEV float lg2(float x) { return __builtin_amdgcn_logf(x); }
DEV float frcp(float x) { return __builtin_amdgcn_rcpf(x); }
DEV float lo16(unsigned u) { return __uint_as_float(u << 16); }
DEV float hi16(unsigned u) { return __uint_as_float(u & 0xffff0000u); }
DEV int rowoff(int reg, int h) { return (reg & 3) + 8 * (reg >> 2) + 4 * h; }
DEV f32x16 zero16() { f32x16 z;
#pragma unroll
  for (int i = 0; i < 16; ++i) z[i] = 0.f; return z; }

template <int KD>
DEV void mma32(f32x16& acc, const bf16_t* a, int lda, const bf16_t* b, int ldb, int lane) {
  const int r = lane & 31, h = lane >> 5;
  const bf16_t* ap = a + r * lda + 8 * h;
  const bf16_t* bp = b + r * ldb + 8 * h;
#pragma unroll 4
  for (int k = 0; k < KD; k += 16) {
    bf16x8 av = *(const bf16x8*)(ap + k);
    bf16x8 bv = *(const bf16x8*)(bp + k);
    acc = __builtin_amdgcn_mfma_f32_32x32x16_bf16(av, bv, acc, 0, 0, 0);
  }
}

DEV int orig_col(int n) {
  if (n < 4864) return n;
  if (n < 6400) return n + 16;
  if (n < 6912) return n + 48;
  if (n < 6928) return n - 2048;
  if (n < 6960) return n - 512;
  return -1;
}

DEV void convert_weights(const Params& p, int l, int which, unsigned char* smem) {
  float* s = (float*)smem;
  const int tid = launder(threadIdx.x);
  const float* win = p.w_in + (size_t)l * DM * NIN;
  const float* wout = p.w_out + (size_t)l * DI * DM;
  bf16_t* wint = (bf16_t*)(p.ws + OFF_WIN);
  bf16_t* woutt = (bf16_t*)(p.ws + OFF_WOUT);
  const int n_in_tiles = (NPAD / 64) * (DM / 64);
  const int n_out_tiles = (DM / 64) * (DI / 64);
  const int it_lo = (which & 1) ? 0 : n_in_tiles, it_hi = (which & 2) ? (n_in_tiles + n_out_tiles) : n_in_tiles;
  for (int it = it_lo + blockIdx.x; it < it_hi; it += gridDim.x) {
    lds_barrier();
    if (it < n_in_tiles) {
      const int n0 = (it / 16) * 64, k0 = (it % 16) * 64;
#pragma unroll
      for (int e = 0; e < 8; ++e) {
        const int idx = e * NT + tid, kk = idx >> 6, nn = idx & 63;
        const int oc = orig_col(n0 + nn);
        s[kk * 65 + nn] = (oc >= 0) ? win[(size_t)(k0 + kk) * NIN + oc] : 0.f;
      }
      lds_barrier();
      const int n = tid >> 3, kc = (tid & 7) * 8;
      uint4 o;
      o.x = pk2(s[(kc + 0) * 65 + n], s[(kc + 1) * 65 + n]); o.y = pk2(s[(kc + 2) * 65 + n], s[(kc + 3) * 65 + n]);
      o.z = pk2(s[(kc + 4) * 65 + n], s[(kc + 5) * 65 + n]); o.w = pk2(s[(kc + 6) * 65 + n], s[(kc + 7) * 65 + n]);
      *(uint4*)(wint + (size_t)(n0 + n) * DM + k0 + kc) = o;
    } else {
      const int j = it - n_in_tiles;
      const int n0 = (j / 32) * 64, k0 = (j % 32) * 64;
#pragma unroll
      for (int e = 0; e < 8; ++e) {
        const int idx = e * NT + tid, kk = idx >> 6, nn = idx & 63;
        s[kk * 65 + nn] = wout[(size_t)(k0 + kk) * DM + n0 + nn];
      }
      lds_barrier();
      const int n = tid >> 3, kc = (tid & 7) * 8;
      uint4 o;
      o.x = pk2(s[(kc + 0) * 65 + n], s[(kc + 1) * 65 + n]); o.y = pk2(s[(kc + 2) * 65 + n], s[(kc + 3) * 65 + n]);
      o.z = pk2(s[(kc + 4) * 65 + n], s[(kc + 5) * 65 + n]); o.w = pk2(s[(kc + 6) * 65 + n], s[(kc + 7) * 65 + n]);
      *(uint4*)(woutt + (size_t)(n0 + n) * DI + k0 + kc) = o;
    }
  }
  lds_barrier();
}

DEV void fsincos(float x, float& s, float& c) {
  const float k = rintf(x * 0.63661977236758134308f);
  float r = fmaf(-k, 1.5707855225e+00f, x);
  r = fmaf(-k, 1.0804273188e-05f, r);
  r = fmaf(-k, 6.0770999344e-11f, r);
  const float r2 = r * r;
  float ps = fmaf(r2, 2.7557319224e-06f, -1.9841269841e-04f);
  ps = fmaf(ps, r2, 8.3333333333e-03f); ps = fmaf(ps, r2, -1.6666666667e-01f);
  const float sinr = fmaf(ps * r2, r, r);
  float pc = fmaf(r2, -2.7557319224e-07f, 2.4801587302e-05f);
  pc = fmaf(pc, r2, -1.3888888889e-03f); pc = fmaf(pc, r2, 4.1666666667e-02f); pc = fmaf(pc, r2, -0.5f);
  const float cosr = fmaf(pc, r2, 1.0f);
  const int q = ((int)k) & 3;
  if (q == 0) { s = sinr; c = cosr; }
  else if (q == 1) { s = cosr; c = -sinr; }
  else if (q == 2) { s = -sinr; c = -cosr; }
  else { s = -cosr; c = sinr; }
}

DEV void phase_pro(const Params& p, unsigned char* smem) {
  const int tid = launder(threadIdx.x);
  const size_t gtid = (size_t)blockIdx.x * NT + tid, gsz = (size_t)gridDim.x * NT;
  const float4* x4 = (const float4*)p.x;
  uint4* xb4 = (uint4*)(p.ws + OFF_XB);
  for (size_t i = gtid; i < (size_t)T_ALL * DM / 8; i += gsz) {
    const float4 a = x4[2 * i], b = x4[2 * i + 1];
    uint4 o; o.x = pk2(a.x, a.y); o.y = pk2(a.z, a.w); o.z = pk2(b.x, b.y); o.w = pk2(b.z, b.w);
    xb4[i] = o;
  }
  if (blockIdx.x == 0) {
    float2* tab = (float2*)(p.ws + OFF_TAB);
    for (int i = tid; i < 64 * 16; i += NT) {
      const int pos = i >> 4, fi = i & 15;
      const float invf = exp2f(-(float)fi * (13.287712379549449f / 16.0f));
      const float ang = (float)pos * invf;
      float sn, cs; fsincos(ang, sn, cs);
      tab[i] = make_float2(cs, sn);
    }
  }
}

namespace pg8 {
#define PG8_LAS __attribute__((address_space(3)))
typedef unsigned short bf16_t;
typedef short bf16x8 __attribute__((ext_vector_type(8)));
typedef float f32x4 __attribute__((ext_vector_type(4)));
typedef unsigned u32x4 __attribute__((ext_vector_type(4)));
constexpr int BM = 256, BK = 64, HALF = 128, HTB = HALF * BK * 2  , STAGE_BYTES = 8 * HTB, NXCD = 8, WGM = 8;

__host__ __device__ __forceinline__ int lds_byte(int r, int c) { const int st = (r >> 4) * 2 + (c >> 5), rr = r & 15, cc = c & 31, ob = rr * 64 + cc * 2; return st * 1024 + (ob ^ (((ob >> 9) & 1) << 5)); }
__host__ __device__ __forceinline__ void stage_rc(int b, int& R, int& C) { const int st = b / 1024, sb = b % 1024, swz = sb ^ (((sb >> 9) & 1) << 5); R = (st >> 1) * 16 + swz / 64; C = (st & 1) * 32 + (swz % 64) / 2; }
__host__ __device__ __forceinline__ int perm32(int rho) { const int n = rho >> 4, i = rho & 15; return 8 * (i >> 2) + 4 * n + (i & 3); }

struct Unit { int pm, pn; };
struct Gemm { const bf16_t* A; const bf16_t* Bt; int M, N, K; };

__device__ __forceinline__ unsigned cvt_pk_bf16(float lo, float hi) { unsigned r; asm volatile("v_cvt_pk_bf16_f32 %0, %1, %2" : "=v"(r) : "v"(lo), "v"(hi)); return r; }

struct XcdOrder {
    int rpx, nN, x, c, ncu, skew;
    __device__ void init(int M, int N, int skew_ = 0) { rpx = (M / BM) / NXCD; nN = N / BM; x = blockIdx.x & 7; c = blockIdx.x >> 3; ncu = gridDim.x >> 3; skew = skew_; }
    __device__ bool next(int i, Unit& u) const {
        const int total = rpx * nN, full = (total / ncu) * ncu;
        int j = c + i * ncu;
        if (skew > 0 && j >= full) { const int cc = c - skew; j = (cc >= 0 && i == total / ncu) ? full + cc : total; }
        if (j >= total) return false; u.pm = rpx * x + (j % rpx); u.pn = j / rpx; return true; }
    __device__ __forceinline__ void a_ready(const Unit&) const {}
    __device__ __forceinline__ void done(const Unit&) const {}
};
struct EpiIn {
    static constexpr bool PERM = true, AFTER_DRAIN = false;
    bf16_t* O; int ldc; float* small; int small_pn;
    __device__ __forceinline__ void operator()(const f32x4 (&acc)[2][2][4][2], const Unit& u, int wr, int wc, int fr, int fq) const {
        const int row0 = u.pm * BM + wr * 64 + fr, col0 = u.pn * BM + wc * 32 + 8 * fq;
        if (u.pn == small_pn) {
            const int c = wc * 32 + 8 * fq;
            if (c < 48) {
#pragma unroll
                for (int ai = 0; ai < 2; ++ai)
#pragma unroll
                    for (int m = 0; m < 4; ++m) { float* rp = small + (size_t)(row0 + ai * HALF + m * 16) * 48 + c; *(f32x4*)rp = acc[ai][0][m][0]; *(f32x4*)(rp + 4) = acc[ai][0][m][1]; }
            }
            return;
        }
#pragma unroll
        for (int ai = 0; ai < 2; ++ai)
#pragma unroll
            for (int m = 0; m < 4; ++m) { bf16_t* rowp = O + (size_t)(row0 + ai * HALF + m * 16) * ldc + col0;
#pragma unroll
                for (int bj = 0; bj < 2; ++bj) { const f32x4 v0 = acc[ai][bj][m][0], v1 = acc[ai][bj][m][1];
                    u32x4 w; w.x = cvt_pk_bf16(v0[0], v0[1]); w.y = cvt_pk_bf16(v0[2], v0[3]); w.z = cvt_pk_bf16(v1[0], v1[1]); w.w = cvt_pk_bf16(v1[2], v1[3]);
                    *(u32x4*)(rowp + bj * HALF) = w; } }
    }
};
struct EpiOut {
    static constexpr bool PERM = true, AFTER_DRAIN = false;
    const float* X; float* Y; int ldc; float alpha;
    __device__ __forceinline__ void operator()(const f32x4 (&acc)[2][2][4][2], const Unit& u, int wr, int wc, int fr, int fq) const {
        const int row0 = u.pm * BM + wr * 64 + fr, col0 = u.pn * BM + wc * 32 + 8 * fq;
#pragma unroll
        for (int ai = 0; ai < 2; ++ai)
#pragma unroll
            for (int m = 0; m < 4; ++m) { const size_t off = (size_t)(row0 + ai * HALF + m * 16) * ldc + col0;
#pragma unroll
                for (int bj = 0; bj < 2; ++bj) { const f32x4 x0 = *(const f32x4*)(X + off + bj * HALF), x1 = *(const f32x4*)(X + off + bj * HALF + 4);
                    *(f32x4*)(Y + off + bj * HALF) = x0 * alpha + acc[ai][bj][m][0]; *(f32x4*)(Y + off + bj * HALF + 4) = x1 * alpha + acc[ai][bj][m][1]; } }
    }
};

template <class Epi, class Sched, bool ALIGN_EPI = false, bool SP2 = false>
__device__ __forceinline__ void gemm_phase(PG8_LAS unsigned char* lds, const Gemm g, const Sched& S, const Epi& E) {
    const int tid = launder((int)threadIdx.x), wid = __builtin_amdgcn_readfirstlane(tid >> 6), lane = tid & 63, wr = wid >> 2, wc = wid & 3, fr = lane & 15, fq = lane >> 4;
    const int K = g.K, nt = K / BK;
    unsigned voffA[2], voffB[2];
#pragma unroll
    for (int i = 0; i < 2; ++i) { int R, C; stage_rc(tid * 16 + i * 8192, R, C); const int Rb = Epi::PERM ? ((R & ~31) + perm32(R & 31)) : R;
        voffA[i] = (unsigned)(R * K + C) * 2u; voffB[i] = (unsigned)(Rb * K + C) * 2u; }
    const size_t kstep = (size_t)(BK * 2);
    const size_t hstep = (size_t)HALF * K * 2;
    const size_t tstep = 2 * hstep;
    const unsigned ldsw = (unsigned)wid * 1024u;
    const int aoff = lds_byte(wr * 64 + fr, fq * 8), boff = lds_byte(wc * 32 + fr, fq * 8);
#define PG8_SA(b, h) (((b) * 2 + (h)) * HTB)
#define PG8_SB(b, h) ((4 + (b) * 2 + (h)) * HTB)
#define PG8_STAGE(bufoff, gbase, voff) do { _Pragma("unroll") for (int _i = 0; _i < 2; ++_i) \
        __builtin_amdgcn_global_load_lds((const unsigned*)((const char*)(gbase) + (voff)[_i]), (PG8_LAS unsigned*)(lds + (bufoff) + ldsw + _i * 8192), 16, 0, 0); } while (0)
#define PG8_LDA(dst, b, h) do { _Pragma("unroll") for (int m = 0; m < 4; ++m) _Pragma("unroll") for (int k = 0; k < 2; ++k) dst[m][k] = *(const PG8_LAS bf16x8*)(lds + PG8_SA(b, h) + aoff + m * 2048 + k * 1024); } while (0)
#define PG8_LDB(dst, b, h) do { _Pragma("unroll") for (int n = 0; n < 2; ++n) _Pragma("unroll") for (int k = 0; k < 2; ++k) dst[n][k] = *(const PG8_LAS bf16x8*)(lds + PG8_SB(b, h) + boff + n * 2048 + k * 1024); } while (0)
#define PG8_MMA(ai, bj, At, Bt) do { __builtin_amdgcn_s_setprio(1); _Pragma("unroll") for (int m = 0; m < 4; ++m) _Pragma("unroll") for (int n = 0; n < 2; ++n) _Pragma("unroll") for (int k = 0; k < 2; ++k) \
        acc[ai][bj][m][n] = __builtin_amdgcn_mfma_f32_16x16x32_bf16(Bt[n][k], At[m][k], acc[ai][bj][m][n], 0, 0, 0); __builtin_amdgcn_s_setprio(0); } while (0)
#define PG8_WAIT_V(n) asm volatile("s_waitcnt vmcnt(" #n ")" ::: "memory")
#define PG8_WAIT_L(n) asm volatile("s_waitcnt lgkmcnt(" #n ")" ::: "memory")
#define PG8_BAR __builtin_amdgcn_s_barrier()
#define PG8_SCHED __builtin_amdgcn_sched_barrier(0)
    Unit cur, nxt; int ui = 0;
    if (!S.next(0, cur)) return;
    f32x4 acc[2][2][4][2];
#pragma unroll
    for (int a = 0; a < 2; ++a)
#pragma unroll
        for (int b = 0; b < 2; ++b)
#pragma unroll
            for (int m = 0; m < 4; ++m)
#pragma unroll
                for (int n = 0; n < 2; ++n) acc[a][b][m][n] = (f32x4){0.f, 0.f, 0.f, 0.f};
    bf16x8 At[4][2], B0[2][2], B1[2][2];
    const char* cA = (const char*)g.A + (size_t)cur.pm * tstep; const char* cB = (const char*)g.Bt + (size_t)cur.pn * tstep;
    S.a_ready(cur);
    if constexpr (SP2) {
        PG8_STAGE(PG8_SB(0, 0), cB, voffB); PG8_STAGE(PG8_SB(0, 1), cB + hstep, voffB); PG8_STAGE(PG8_SA(0, 0), cA, voffA); PG8_STAGE(PG8_SA(0, 1), cA + hstep, voffA);
        if (wr == 1) PG8_BAR;
        PG8_WAIT_V(2); PG8_BAR;
        PG8_STAGE(PG8_SB(1, 0), cB + kstep, voffB); PG8_STAGE(PG8_SA(1, 0), cA + kstep, voffA); PG8_STAGE(PG8_SB(1, 1), cB + hstep + kstep, voffB);
        PG8_WAIT_V(6); PG8_BAR;
    } else {
        PG8_STAGE(PG8_SB(0, 0), cB, voffB); PG8_STAGE(PG8_SA(0, 0), cA, voffA); PG8_STAGE(PG8_SB(0, 1), cB + hstep, voffB); PG8_STAGE(PG8_SA(0, 1), cA + hstep, voffA);
        if (wr == 1) PG8_BAR;
        PG8_WAIT_V(4); PG8_BAR;
        PG8_STAGE(PG8_SB(1, 0), cB + kstep, voffB); PG8_STAGE(PG8_SA(1, 0), cA + kstep, voffA); PG8_STAGE(PG8_SB(1, 1), cB + hstep + kstep, voffB);
        PG8_WAIT_V(6); PG8_BAR;
    }
    for (;;) {
        const bool has_next = S.next(ui + 1, nxt);
        const char* nA = has_next ? (const char*)g.A + (size_t)nxt.pm * tstep : cA; const char* nB = has_next ? (const char*)g.Bt + (size_t)nxt.pn * tstep : cB;
        for (int t = 0; t < nt; t += 2) {
            const bool last = (t == nt - 2);
            const char* a1 = cA + (size_t)(t + 1) * kstep;
            const char* a2 = last ? nA : cA + (size_t)(t + 2) * kstep; const char* b2 = last ? nB : cB + (size_t)(t + 2) * kstep;
            const char* a3 = a2 + kstep; const char* b3 = b2 + kstep;
            if (last && has_next) S.a_ready(nxt);
            if constexpr (SP2) {
            PG8_LDB(B0, 0, 0); PG8_LDB(B1, 0, 1); PG8_SCHED; PG8_LDA(At, 0, 0); PG8_STAGE(PG8_SA(1, 1), a1 + hstep, voffA);
            PG8_WAIT_V(8); PG8_WAIT_L(0); PG8_BAR; PG8_MMA(0, 0, At, B0); PG8_MMA(0, 1, At, B1); PG8_BAR; PG8_SCHED;
            PG8_LDA(At, 0, 1); PG8_STAGE(PG8_SB(0, 0), b2, voffB); PG8_STAGE(PG8_SB(0, 1), b2 + hstep, voffB); PG8_STAGE(PG8_SA(0, 0), a2, voffA);
            PG8_WAIT_V(8); PG8_WAIT_L(0); PG8_BAR; PG8_MMA(1, 0, At, B0); PG8_MMA(1, 1, At, B1); PG8_BAR; PG8_SCHED;
            PG8_LDB(B0, 1, 0); PG8_LDB(B1, 1, 1); PG8_SCHED; PG8_LDA(At, 1, 0); PG8_STAGE(PG8_SA(0, 1), a2 + hstep, voffA);
            PG8_WAIT_V(8); PG8_WAIT_L(0); PG8_BAR; PG8_MMA(0, 0, At, B0); PG8_MMA(0, 1, At, B1); PG8_BAR; PG8_SCHED;
            PG8_LDA(At, 1, 1); PG8_STAGE(PG8_SB(1, 0), b3, voffB); PG8_STAGE(PG8_SB(1, 1), b3 + hstep, voffB); PG8_STAGE(PG8_SA(1, 0), a3, voffA);
            PG8_WAIT_V(8); PG8_WAIT_L(0); PG8_BAR; PG8_MMA(1, 0, At, B0); PG8_MMA(1, 1, At, B1); PG8_BAR; PG8_SCHED;
            } else {
            PG8_LDB(B0, 0, 0); PG8_SCHED; PG8_LDA(At, 0, 0); PG8_STAGE(PG8_SA(1, 1), a1 + hstep, voffA);
            PG8_WAIT_L(8); PG8_BAR; PG8_WAIT_L(0); PG8_MMA(0, 0, At, B0); PG8_BAR; PG8_SCHED;
            PG8_LDB(B1, 0, 1); PG8_STAGE(PG8_SB(0, 0), b2, voffB);
            PG8_BAR; PG8_WAIT_L(0); PG8_MMA(0, 1, At, B1); PG8_BAR;
            PG8_LDA(At, 0, 1); PG8_STAGE(PG8_SA(0, 0), a2, voffA);
            PG8_BAR; PG8_WAIT_L(0); PG8_MMA(1, 0, At, B0); PG8_BAR; PG8_SCHED;
            PG8_STAGE(PG8_SB(0, 1), b2 + hstep, voffB);
            PG8_WAIT_V(6); PG8_BAR; PG8_MMA(1, 1, At, B1); PG8_BAR;
            PG8_LDB(B0, 1, 0); PG8_SCHED; PG8_LDA(At, 1, 0); PG8_STAGE(PG8_SA(0, 1), a2 + hstep, voffA);
            PG8_WAIT_L(8); PG8_BAR; PG8_WAIT_L(0); PG8_MMA(0, 0, At, B0); PG8_BAR; PG8_SCHED;
            PG8_LDB(B1, 1, 1); PG8_STAGE(PG8_SB(1, 0), b3, voffB);
            PG8_BAR; PG8_WAIT_L(0); PG8_MMA(0, 1, At, B1); PG8_BAR;
            PG8_LDA(At, 1, 1); PG8_STAGE(PG8_SA(1, 0), a3, voffA);
            PG8_BAR; PG8_WAIT_L(0); PG8_MMA(1, 0, At, B0); PG8_BAR; PG8_SCHED;
            PG8_STAGE(PG8_SB(1, 1), b3 + hstep, voffB);
            PG8_WAIT_V(6); PG8_BAR; PG8_MMA(1, 1, At, B1); PG8_BAR;
            }
        }
        if constexpr (ALIGN_EPI) { if (wr == 0) PG8_BAR; }
        if constexpr (!Epi::AFTER_DRAIN) { E(acc, cur, wr, wc, fr, fq); S.done(cur); }
        if (!has_next) break;
#pragma unroll
        for (int a = 0; a < 2; ++a)
#pragma unroll
            for (int b = 0; b < 2; ++b)
#pragma unroll
                for (int m = 0; m < 4; ++m)
#pragma unroll
                    for (int n = 0; n < 2; ++n) acc[a][b][m][n] = (f32x4){0.f, 0.f, 0.f, 0.f};
        cur = nxt; cA = nA; cB = nB; ++ui;
        if constexpr (ALIGN_EPI) { if (wr == 1) PG8_BAR; }
    }
    PG8_WAIT_V(0);
    if constexpr (!ALIGN_EPI) { if (wr == 0) PG8_BAR; }
    PG8_BAR;
    if constexpr (Epi::AFTER_DRAIN) { E.fused(acc, cur, wr, wc, fr, fq, lds, wid, lane); S.done(cur); }
#undef PG8_SA
#undef PG8_SB
#undef PG8_STAGE
#undef PG8_LDA
#undef PG8_LDB
#undef PG8_MMA
#undef PG8_WAIT_V
#undef PG8_WAIT_L
#undef PG8_BAR
#undef PG8_SCHED
}
}

DEV void phase_inproj(const Params& p, int l, int hf, int skew, unsigned char* smem) {
  pg8::Gemm g{(const bf16_t*)(p.ws + OFF_XB) + (size_t)hf * TH * DM, (const bf16_t*)(p.ws + OFF_WIN), TH, NPAD, DM};
  pg8::XcdOrder S; S.init(TH, NPAD, skew);
  pg8::EpiIn E{(bf16_t*)(p.ws + OFF_H), NPAD, (float*)(p.ws + OFF_SMALL), SM0 / 256};
  pg8::gemm_phase<pg8::EpiIn, pg8::XcdOrder, true, true>((PG8_LAS unsigned char*)smem, g, S, E);
}

DEV void phase_outproj(const Params& p, int l, int hf, unsigned char* smem) {
  pg8::Gemm g{(const bf16_t*)(p.ws + OFF_MIXED), (const bf16_t*)(p.ws + OFF_WOUT), TH, DM, DI};
  pg8::XcdOrder S; S.init(TH, DM);
  const float* xin = ((l == 0) ? p.x : p.out) + (size_t)hf * TH * DM;
  pg8::EpiOut E{xin, p.out + (size_t)hf * TH * DM, DM, DN_ALPHA};
  pg8::gemm_phase<pg8::EpiOut, pg8::XcdOrder, true, true>((PG8_LAS unsigned char*)smem, g, S, E);
}

DEV void phase_ln(const Params& p, int l, int hf) {
  const int tid = launder(threadIdx.x), lane = tid & 63, w = tid >> 6;
  const float* g = p.ln_g + l * DM; const float* b = p.ln_b + l * DM;
  bf16_t* xb = (bf16_t*)(p.ws + OFF_XB);
  for (int r0 = (blockIdx.x * 8 + w) * 4; r0 < TH; r0 += gridDim.x * 32) {
    f32x4 v[4][4];
#pragma unroll
    for (int i = 0; i < 4; ++i)
#pragma unroll
      for (int j = 0; j < 4; ++j) v[i][j] = ((const f32x4*)(p.out + (size_t)(hf * TH + r0 + i) * DM))[j * 64 + lane];
    f32x4 gg[4], bb[4];
#pragma unroll
    for (int j = 0; j < 4; ++j) { gg[j] = ((const f32x4*)g)[j * 64 + lane]; bb[j] = ((const f32x4*)b)[j * 64 + lane]; }
#pragma unroll
    for (int i = 0; i < 4; ++i) {
      const int row = hf * TH + r0 + i;
      float sm = 0.f;
#pragma unroll
      for (int j = 0; j < 4; ++j) sm += (v[i][j][0] + v[i][j][1]) + (v[i][j][2] + v[i][j][3]);
#pragma unroll
      for (int o = 32; o >= 1; o >>= 1) sm += __shfl_xor(sm, o);
      const float mu = sm * (1.f / DM);
      float q = 0.f;
#pragma unroll
      for (int j = 0; j < 4; ++j) { const f32x4 d = v[i][j] - mu; q += (d[0] * d[0] + d[1] * d[1]) + (d[2] * d[2] + d[3] * d[3]); }
#pragma unroll
      for (int o = 32; o >= 1; o >>= 1) q += __shfl_xor(q, o);
      const float rstd = rsqrtf(q * (1.f / DM) + 1e-5f);
#pragma unroll
      for (int j = 0; j < 4; ++j) {
        const f32x4 o = (v[i][j] - mu) * rstd * gg[j] + bb[j];
        ((f32x4*)(p.out + (size_t)row * DM))[j * 64 + lane] = o;
        if (l == 0) *(uint2*)(xb + (size_t)row * DM + (j * 64 + lane) * 4) = make_uint2(pk2(o[0], o[1]), pk2(o[2], o[3]));
      }
    }
  }
}

DEV void attn_item(const Params& p, int l, int item, unsigned char* smem) {
  const int tid = launder(threadIdx.x), lane = tid & 63, w = tid >> 6, r = lane & 31, h = lane >> 5;
  const int qt = item & 15, head = (item >> 4) & 7, bl = item >> 7;
  const int kvh = head >> 2;
  bf16_t* Hh = (bf16_t*)(p.ws + OFF_H);
  const bf16_t* VT = (const bf16_t*)(p.ws + OFF_VT);
  const size_t rowbase = (size_t)bl * SEQ;
  float mq = fabsf(p.q_gain[l * 64 + lane]), mk = fabsf(p.k_gain[l * 64 + lane]);
#pragma unroll
  for (int o = 32; o >= 1; o >>= 1) { mq = fmaxf(mq, __shfl_xor(mq, o)); mk = fmaxf(mk, __shfl_xor(mk, o)); }
  const float M2 = 8.f * mq * mk * LOG2E * 1.01f;
  const int qrow = qt * 256 + w * 32 + r;
  const bf16_t* qp = Hh + (rowbase + qrow) * NPAD + A_Q + head * 64 + 8 * h;
  bf16x8 qf[4];
#pragma unroll
  for (int ks = 0; ks < 4; ++ks) qf[ks] = *(const bf16x8*)(qp + ks * 16);
  f32x16 o0 = zero16(), o1 = zero16();
  f32x2_t lsum2 = {0.f, 0.f};
  const int srow = tid >> 3, sch = (tid & 7) * 8;
  const bf16_t* kp = Hh + (rowbase + srow) * NPAD + A_K + kvh * 64 + sch;
  const bf16_t* vp = VT + ((size_t)((bl * 2 + kvh) * 64 + srow)) * SEQ + sch;
  union PB { bf16x8 v; unsigned u[4]; };
  auto qk = [&](int st, f32x16& s0, f32x16& s1) __attribute__((always_inline)) {
    const bf16_t* sK = (const bf16_t*)(smem + st * 18432);
#pragma unroll
    for (int i = 0; i < 16; ++i) { s0[i] = -M2; s1[i] = -M2; }
#pragma unroll
    for (int ks = 0; ks < 4; ++ks) {
      const bf16x8 a0 = *(const bf16x8*)(sK + r * 72 + ks * 16 + 8 * h);
      const bf16x8 a1 = *(const bf16x8*)(sK + (32 + r) * 72 + ks * 16 + 8 * h);
      s0 = __builtin_amdgcn_mfma_f32_32x32x16_bf16(a0, qf[ks], s0, 0, 0, 0);
      s1 = __builtin_amdgcn_mfma_f32_32x32x16_bf16(a1, qf[ks], s1, 0, 0, 0);
    }
  };
  auto soft = [&](f32x16& s0, f32x16& s1, PB (&pb)[2][2]) __attribute__((always_inline)) {
#pragma unroll
    for (int i = 0; i < 16; ++i) { s0[i] = __builtin_amdgcn_exp2f(s0[i]); s1[i] = __builtin_amdgcn_exp2f(s1[i]); lsum2 += (f32x2_t){s0[i], s1[i]}; }
#pragma unroll
    for (int s = 0; s < 2; ++s)
#pragma unroll
      for (int j = 0; j < 4; ++j) {
        pb[0][s].u[j] = pk2(s0[8 * s + 2 * j], s0[8 * s + 2 * j + 1]);
        pb[1][s].u[j] = pk2(s1[8 * s + 2 * j], s1[8 * s + 2 * j + 1]);
      }
  };
  auto pv = [&](int st, const PB (&pb)[2][2]) __attribute__((always_inline)) {
    const bf16_t* sV = (const bf16_t*)(smem + st * 18432 + 9216);
#pragma unroll
    for (int kt2 = 0; kt2 < 2; ++kt2)
#pragma unroll
      for (int s = 0; s < 2; ++s) {
        const int kb = kt2 * 32 + 16 * s + 4 * h;
        union { bf16x8 v; uint2 u[2]; } a0, a1;
        a0.u[0] = *(const uint2*)(sV + r * 72 + kb); a0.u[1] = *(const uint2*)(sV + r * 72 + kb + 8);
        a1.u[0] = *(const uint2*)(sV + (32 + r) * 72 + kb); a1.u[1] = *(const uint2*)(sV + (32 + r) * 72 + kb + 8);
        o0 = __builtin_amdgcn_mfma_f32_32x32x16_bf16(a0.v, pb[kt2][s].v, o0, 0, 0, 0);
        o1 = __builtin_amdgcn_mfma_f32_32x32x16_bf16(a1.v, pb[kt2][s].v, o1, 0, 0, 0);
      }
  };
  auto compute2 = [&](int sta, int stb) __attribute__((always_inline)) {
    f32x16 sa0, sa1, sb0, sb1; PB pa[2][2], pbb[2][2];
    qk(sta, sa0, sa1); qk(stb, sb0, sb1);
    soft(sa0, sa1, pa); pv(sta, pa);
    soft(sb0, sb1, pbb); pv(stb, pbb);
  };
  constexpr int NKT = SEQ / 64;
  auto sstore = [&](int st, const u32x4& kk, const u32x4& vv) __attribute__((always_inline)) {
    *(u32x4*)(smem + st * 18432 + srow * 144 + sch * 2) = kk;
    *(u32x4*)(smem + st * 18432 + 9216 + srow * 144 + sch * 2) = vv;
  };
  u32x4 k0 = *(const u32x4*)kp, v0 = *(const u32x4*)vp;
  u32x4 k1 = *(const u32x4*)(kp + (size_t)64 * NPAD), v1 = *(const u32x4*)(vp + 64);
  sstore(0, k0, v0); sstore(1, k1, v1);
  k0 = *(const u32x4*)(kp + (size_t)2 * 64 * NPAD); v0 = *(const u32x4*)(vp + 2 * 64);
  k1 = *(const u32x4*)(kp + (size_t)3 * 64 * NPAD); v1 = *(const u32x4*)(vp + 3 * 64);
  lds_barrier();
  for (int kt = 0; kt < NKT; kt += 4) {
    sstore(2, k0, v0); sstore(3, k1, v1);
    if (kt + 4 < NKT) {
      k0 = *(const u32x4*)(kp + (size_t)(kt + 4) * 64 * NPAD); v0 = *(const u32x4*)(vp + (kt + 4) * 64);
      k1 = *(const u32x4*)(kp + (size_t)(kt + 5) * 64 * NPAD); v1 = *(const u32x4*)(vp + (kt + 5) * 64);
    }
    compute2(0, 1);
    lds_barrier();
    if (kt + 4 < NKT) {
      sstore(0, k0, v0); sstore(1, k1, v1);
      if (kt + 6 < NKT) {
        k0 = *(const u32x4*)(kp + (size_t)(kt + 6) * 64 * NPAD); v0 = *(const u32x4*)(vp + (kt + 6) * 64);
        k1 = *(const u32x4*)(kp + (size_t)(kt + 7) * 64 * NPAD); v1 = *(const u32x4*)(vp + (kt + 7) * 64);
      }
    }
    compute2(2, 3);
    lds_barrier();
  }
  float lsum = lsum2[0] + lsum2[1];
  lsum += __shfl_xor(lsum, 32);
  const float inv = 1.f / lsum;
  const bf16_t* zp = Hh + (rowbase + qrow) * NPAD + A_Z + head * 64;
  bf16_t* op = Hh + (rowbase + qrow) * NPAD + A_Q + head * 64;
#pragma unroll
  for (int dt = 0; dt < 2; ++dt)
#pragma unroll
    for (int g = 0; g < 4; ++g) {
      const int d0 = dt * 32 + 8 * g + 4 * h;
      const uint2 zz = *(const uint2*)(zp + d0);
      const float z0 = bf2f((bf16_t)(zz.x & 0xffff)), z1 = bf2f((bf16_t)(zz.x >> 16)), z2 = bf2f((bf16_t)(zz.y & 0xffff)), z3 = bf2f((bf16_t)(zz.y >> 16));
      const f32x16& oo = dt ? o1 : o0;
      uint2 ov;
      ov.x = pk2(oo[4 * g + 0] * inv * fsilu(z0), oo[4 * g + 1] * inv * fsilu(z1));
      ov.y = pk2(oo[4 * g + 2] * inv * fsilu(z2), oo[4 * g + 3] * inv * fsilu(z3));
      *(uint2*)(op + d0) = ov;
    }
  lds_barrier();
}

constexpr int L_QT = 0, L_KT = 17408, L_QC = 34816, L_KHT = 52224, L_VT = 70656, L_ST = 89088,
              L_D = 123904, L_TOT = 124416, L_ACS = 128512, L_DT = 129024;

template <int K, int V> struct ScanGeom {
  static constexpr int KP = K + 8;
  static constexpr int NS = (K / 32) * (V / 32) / 8;
};

template <int K, int V>
DEV void scan_write_state(unsigned char* smem, const f32x16* S, int w, int lane) {
  constexpr int KP = K + 8, NS = ScanGeom<K, V>::NS, NVT = V / 32;
  bf16_t* sST = (bf16_t*)(smem + L_ST);
  const int c = lane & 31, h = lane >> 5;
#pragma unroll
  for (int i = 0; i < NS; ++i) {
    const int tile = w * NS + i, kt = tile / NVT, nt = tile % NVT;
#pragma unroll
    for (int g = 0; g < 4; ++g) {
      uint2 o; o.x = pk2(S[i][4 * g + 0], S[i][4 * g + 1]); o.y = pk2(S[i][4 * g + 2], S[i][4 * g + 3]);
      *(uint2*)(sST + (nt * 32 + c) * KP + kt * 32 + 8 * g + 4 * h) = o;
    }
  }
}

template <int K, int V, bool SSDM>
DEV void scan_core(unsigned char* smem, f32x16* S, bf16_t* orow0, int dir, int w, int lane, bool do_out, const float* sAcs) {
  constexpr int KP = K + 8, NS = ScanGeom<K, V>::NS, NVT = V / 32, NOT = 2 * NVT;
  const bf16_t* sQt = (const bf16_t*)(smem + L_QT); const bf16_t* sKt = (const bf16_t*)(smem + L_KT);
  const bf16_t* sQc = (const bf16_t*)(smem + L_QC); const bf16_t* sKhT = (const bf16_t*)(smem + L_KHT);
  const bf16_t* sVT = (const bf16_t*)(smem + L_VT);
  const bf16_t* sST = (const bf16_t*)(smem + L_ST); const float* sD = (const float*)(smem + L_D);
  const int c = lane & 31, h = lane >> 5;
  if (do_out && w < NOT) {
    const int tt = w / NVT, nt = w % NVT;
    f32x16 acc = zero16();
#pragma unroll
    for (int st = 0; st < 2; ++st) {
      if (st <= tt) {
        f32x16 pt = zero16();
        mma32<K>(pt, sKt + st * 32 * KP, KP, sQt + tt * 32 * KP, KP, lane);
        const int tau = tt * 32 + c;
        const float at = SSDM ? sAcs[tau] : 0.f;
#pragma unroll
        for (int reg = 0; reg < 16; ++reg) {
          const int sig = st * 32 + rowoff(reg, h);
          float v = pt[reg];
          if (SSDM) v *= ex2(at - sAcs[sig]);
          pt[reg] = (sig <= tau) ? v : 0.f;
        }
#pragma unroll
        for (int s2 = 0; s2 < 2; ++s2) {
          union { bf16x8 v; unsigned u[4]; } pa;
#pragma unroll
          for (int j = 0; j < 4; ++j) pa.u[j] = pk2(pt[8 * s2 + 2 * j], pt[8 * s2 + 2 * j + 1]);
          const int kb = st * 32 + 16 * s2 + 4 * h;
          union { bf16x8 v; uint2 u[2]; } vb;
          vb.u[0] = *(const uint2*)(sVT + (nt * 32 + c) * 72 + kb); vb.u[1] = *(const uint2*)(sVT + (nt * 32 + c) * 72 + kb + 8);
          acc = __builtin_amdgcn_mfma_f32_32x32x16_bf16(pa.v, vb.v, acc, 0, 0, 0);
        }
      }
    }
    mma32<K>(acc, sQc + tt * 32 * KP, KP, sST + nt * 32 * KP, KP, lane);
#pragma unroll
    for (int reg = 0; reg < 16; ++reg) {
      const int tau = tt * 32 + rowoff(reg, h);
      const int tok = dir ? (63 - tau) : tau;
      orow0[(size_t)tok * 512 + nt * 32 + c] = f2bf(acc[reg]);
    }
  }
#pragma unroll
  for (int i = 0; i < NS; ++i) {
    const int tile = w * NS + i, kt = tile / NVT, nt = tile % NVT;
#pragma unroll
    for (int reg = 0; reg < 16; ++reg) S[i][reg] *= sD[kt * 32 + rowoff(reg, h)];
    mma32<64>(S[i], sKhT + kt * 32 * 72, 72, sVT + nt * 32 * 72, 72, lane);
  }
}

template <int K, int V>
DEV void state_store(float* buf, const f32x16* S, int w, int lane) {
  constexpr int NS = ScanGeom<K, V>::NS, NVT = V / 32;
  const int c = lane & 31, h = lane >> 5;
#pragma unroll
  for (int i = 0; i < NS; ++i) {
    const int tile = w * NS + i, kt = tile / NVT, nt = tile % NVT;
#pragma unroll
    for (int reg = 0; reg < 16; ++reg) buf[(kt * 32 + rowoff(reg, h)) * V + nt * 32 + c] = S[i][reg];
  }
}
template <int K, int V>
DEV void state_load(const float* buf, f32x16* S, int w, int lane) {
  constexpr int NS = ScanGeom<K, V>::NS, NVT = V / 32;
  const int c = lane & 31, h = lane >> 5;
#pragma unroll
  for (int i = 0; i < NS; ++i) {
    const int tile = w * NS + i, kt = tile / NVT, nt = tile % NVT;
#pragma unroll
    for (int reg = 0; reg < 16; ++reg) S[i][reg] = buf[(kt * 32 + rowoff(reg, h)) * V + nt * 32 + c];
  }
}

template <int K, int V>
DEV void state_combine(const float* ubase, int ustride, const float* dbase, int seg, f32x16* S, int w, int lane) {
  constexpr int NS = ScanGeom<K, V>::NS, NVT = V / 32;
  const int c = lane & 31, h = lane >> 5;
  for (int j = 0; j < seg; ++j) {
    const float* buf = ubase + (size_t)j * ustride;
    const float* dj = dbase + j * 128;
#pragma unroll
    for (int i = 0; i < NS; ++i) {
      const int tile = w * NS + i, kt = tile / NVT, nt = tile % NVT;
#pragma unroll
      for (int reg = 0; reg < 16; ++reg) {
        const int k = kt * 32 + rowoff(reg, h);
        const float u = buf[k * V + nt * 32 + c];
        S[i][reg] = (j > 0 ? dj[k] * S[i][reg] : 0.f) + u;
      }
    }
  }
}

#define PACK8_LO(v) (u32x4){((v)[0] & 0xffffu) | ((v)[1] << 16), ((v)[2] & 0xffffu) | ((v)[3] << 16), ((v)[4] & 0xffffu) | ((v)[5] << 16), ((v)[6] & 0xffffu) | ((v)[7] << 16)}
#define PACK8_HI(v) (u32x4){((v)[0] >> 16) | ((v)[1] & 0xffff0000u), ((v)[2] >> 16) | ((v)[3] & 0xffff0000u), ((v)[4] >> 16) | ((v)[5] & 0xffff0000u), ((v)[6] >> 16) | ((v)[7] & 0xffff0000u)}
#define CVT8(f) (u32x4){pk2((f)[0], (f)[1]), pk2((f)[2], (f)[3]), pk2((f)[4], (f)[5]), pk2((f)[6], (f)[7])}


DEV void hgrn_item(const Params& p, int l, int it, int seg, int mode, unsigned char* smem) {
  const int bl = it >> 3, head = (it >> 1) & 3, dir = it & 1;
  const bool do_out = (mode == 3);
  constexpr int K = 128, V = 128, KPW = 68;
  const int tid = launder(threadIdx.x), lane = tid & 63, w = tid >> 6;
  const int cp = tid & 63, tg = tid >> 6, ch0 = 2 * cp;
  const bf16_t* Hh = (const bf16_t*)(p.ws + OFF_H);
  bf16_t* OB = (bf16_t*)(p.ws + OFF_OBUF) + (size_t)(0 * 2 + dir) * TH * 512;
  const size_t rowbase = (size_t)bl * SEQ;
  float lb0 = 0.f, lb1 = 0.f;
  if (l > 0) {
    lb0 = fsigmoid(p.lb_logits[512 + head * 128 + ch0] - p.lb_logits[head * 128 + ch0]);
    lb1 = fsigmoid(p.lb_logits[512 + head * 128 + ch0 + 1] - p.lb_logits[head * 128 + ch0 + 1]);
  }
  const float om0 = 1.f - lb0, om1 = 1.f - lb1;
  const int fbase = dir ? H_FB : H_FF;
  unsigned* sQt = (unsigned*)(smem + L_QT); unsigned* sKt = (unsigned*)(smem + L_KT); unsigned* sQc = (unsigned*)(smem + L_QC);
  bf16_t* sKhT = (bf16_t*)(smem + L_KHT); bf16_t* sVT = (bf16_t*)(smem + L_VT);
  float* sD = (float*)(smem + L_D); float* sTot = (float*)(smem + L_TOT);
  f32x16 S[2]; S[0] = zero16(); S[1] = zero16();
  float* sbuf = (float*)(p.ws + OFF_SB0) + ((size_t)it * NSEG + seg) * 16384;
  if (do_out) state_combine<K, V>((const float*)(p.ws + OFF_SB0) + (size_t)it * NSEG * 16384, 16384, (const float*)(p.ws + OFF_DB) + (size_t)it * NSEG * 128, seg, S, w, lane);
  float dlog0 = 0.f, dlog1 = 0.f;
  unsigned pf[8], qq[8], vv[8];
  float g0[8], g1[8], kx0[8], kx1[8];
  auto gloadA = [&](int cidx) __attribute__((always_inline)) {
    const int chunk = dir ? (63 - cidx) : cidx;
#pragma unroll
    for (int i = 0; i < 8; ++i) {
      const int tau = 8 * tg + i;
      const int tok = chunk * 64 + (dir ? (63 - tau) : tau);
      pf[i] = ((const unsigned*)(Hh + (rowbase + tok) * NPAD + head * 128 + fbase))[cp];
    }
  };
  auto gloadB = [&](int cidx) __attribute__((always_inline)) {
    const int chunk = dir ? (63 - cidx) : cidx;
#pragma unroll
    for (int i = 0; i < 8; ++i) {
      const int tau = 8 * tg + i;
      const int tok = chunk * 64 + (dir ? (63 - tau) : tau);
      const unsigned* rp = (const unsigned*)(Hh + (rowbase + tok) * NPAD + head * 128) + cp;
      vv[i] = rp[H_I / 2];
      qq[i] = do_out ? rp[H_Q / 2] : 0u;
    }
  };
  auto stage1 = [&]() __attribute__((always_inline)) {
    float r0 = 0.f, r1 = 0.f;
#pragma unroll
    for (int i = 0; i < 8; ++i) {
      const float e0 = ex2(fminf(-lo16(pf[i]) * LOG2E, 80.f)), e1 = ex2(fminf(-hi16(pf[i]) * LOG2E, 80.f));
      const float s0 = frcp(1.f + e0), s1 = frcp(1.f + e1);
      r0 += lg2(lb0 + om0 * s0); r1 += lg2(lb1 + om1 * s1);
      g0[i] = r0; g1[i] = r1;
      kx0[i] = om0 * e0 * s0; kx1[i] = om1 * e1 * s1;
    }
    *(float2*)(sTot + tg * 128 + ch0) = make_float2(r0, r1);
  };
  gloadA(seg * SLEN); gloadB(seg * SLEN);
  stage1();
  if (SLEN > 1) gloadA(seg * SLEN + 1);
  for (int ci = 0; ci < SLEN; ++ci) {
    const int cidx = seg * SLEN + ci;
    const int chunk = dir ? (63 - cidx) : cidx;
    lds_barrier();
    float off0 = 0.f, off1 = 0.f, ref0 = 0.f, ref1 = 0.f, be0 = 0.f, be1 = 0.f;
#pragma unroll
    for (int j = 0; j < 8; ++j) {
      const float2 t = *(const float2*)(sTot + j * 128 + ch0);
      if (j < tg) { off0 += t.x; off1 += t.y; }
      if (j < 4) { ref0 += t.x; ref1 += t.y; }
      be0 += t.x; be1 += t.y;
    }
    dlog0 += be0; dlog1 += be1;
    const float eref0 = ex2(ref0), eref1 = ex2(ref1), ebr0 = ex2(be0 - ref0), ebr1 = ex2(be1 - ref1);
    const float d0 = off0 - ref0, d1 = off1 - ref1;
    float kh0[8], kh1[8];
#pragma unroll
    for (int i = 0; i < 8; ++i) {
      const int tau = 8 * tg + i;
      const float E0 = ex2(g0[i] + d0), E1 = ex2(g1[i] + d1);
      const float kt0 = kx0[i] * frcp(E0), kt1 = kx1[i] * frcp(E1);
      if (do_out) {
        const float qt0 = lo16(qq[i]) * E0, qt1 = hi16(qq[i]) * E1;
        sQt[tau * KPW + cp] = pk2(qt0, qt1);
        sKt[tau * KPW + cp] = pk2(kt0, kt1);
        sQc[tau * KPW + cp] = pk2(qt0 * eref0, qt1 * eref1);
      }
      kh0[i] = kt0 * ebr0; kh1[i] = kt1 * ebr1;
    }
    *(u32x4*)(sKhT + ch0 * 72 + 8 * tg) = CVT8(kh0);
    *(u32x4*)(sKhT + (ch0 + 1) * 72 + 8 * tg) = CVT8(kh1);
    *(u32x4*)(sVT + ch0 * 72 + 8 * tg) = PACK8_LO(vv);
    *(u32x4*)(sVT + (ch0 + 1) * 72 + 8 * tg) = PACK8_HI(vv);
    if (tg == 0) *(float2*)(sD + ch0) = make_float2(ex2(be0), ex2(be1));
    if (do_out) scan_write_state<K, V>(smem, S, w, lane);
    if (ci + 1 < SLEN) gloadB(cidx + 1);
    lds_barrier();
    scan_core<K, V, false>(smem, S, OB + (rowbase + (size_t)chunk * 64) * 512 + head * 128, dir, w, lane, do_out, nullptr);
    if (ci + 1 < SLEN) { stage1(); if (ci + 2 < SLEN) gloadA(cidx + 2); }
  }
  if (!do_out) {
    state_store<K, V>(sbuf, S, w, lane);
    if (tg == 0) *(float2*)((float*)(p.ws + OFF_DB) + ((size_t)it * NSEG + seg) * 128 + ch0) = make_float2(ex2(dlog0), ex2(dlog1));
  }
  lds_barrier();
}

DEV void gla_item(const Params& p, int l, int it, int seg, int mode, unsigned char* smem) {
  const int j16 = it - 16, bl = j16 >> 3, head = (j16 >> 1) & 3, dir = j16 & 1;
  const bool do_out = (mode == 3);
  constexpr int K = 64, V = 128, KPW = 36;
  const int tid = launder(threadIdx.x), lane = tid & 63, w = tid >> 6;
  const int cp = tid & 31, tg = tid >> 5, ch0 = 2 * cp;
  const int vp2 = tid & 63, vg = tid >> 6;
  const bf16_t* Hh = (const bf16_t*)(p.ws + OFF_H);
  const bf16_t* Gb = (const bf16_t*)(p.ws + OFF_G);
  bf16_t* OB = (bf16_t*)(p.ws + OFF_OBUF) + (size_t)(2 * 2 + dir) * TH * 512;
  const size_t rowbase = (size_t)bl * SEQ;
  unsigned* sQt = (unsigned*)(smem + L_QT); unsigned* sKt = (unsigned*)(smem + L_KT); unsigned* sQc = (unsigned*)(smem + L_QC);
  bf16_t* sKhT = (bf16_t*)(smem + L_KHT); bf16_t* sVT = (bf16_t*)(smem + L_VT);
  float* sD = (float*)(smem + L_D); float* sTot = (float*)(smem + L_TOT);
  f32x16 S[1]; S[0] = zero16();
  float* sbuf = (float*)(p.ws + OFF_SB1) + ((size_t)j16 * NSEG + seg) * 8192;
  if (do_out) state_combine<K, V>((const float*)(p.ws + OFF_SB1) + (size_t)j16 * NSEG * 8192, 8192, (const float*)(p.ws + OFF_DB) + (size_t)it * NSEG * 128, seg, S, w, lane);
  float dlog0 = 0.f, dlog1 = 0.f;
  unsigned pg[4];
  float g0[4], g1[4]; unsigned kk[4], qq[4], vv[8];
  auto gloadA = [&](int cidx) __attribute__((always_inline)) {
    const int chunk = dir ? (63 - cidx) : cidx;
#pragma unroll
    for (int i = 0; i < 4; ++i) {
      const int tau = 4 * tg + i;
      const int tok = chunk * 64 + (dir ? (63 - tau) : tau);
      pg[i] = ((const unsigned*)(Gb + (rowbase + tok) * 512 + dir * 256 + head * 64))[cp];
    }
  };
  auto gloadB = [&](int cidx) __attribute__((always_inline)) {
    const int chunk = dir ? (63 - cidx) : cidx;
#pragma unroll
    for (int i = 0; i < 4; ++i) {
      const int tau = 4 * tg + i;
      const int tok = chunk * 64 + (dir ? (63 - tau) : tau);
      const unsigned* rp = (const unsigned*)(Hh + (rowbase + tok) * NPAD + head * 64) + cp;
      kk[i] = rp[G_K / 2]; qq[i] = do_out ? rp[G_Q / 2] : 0u;
    }
#pragma unroll
    for (int i = 0; i < 8; ++i) {
      const int tau = 8 * vg + i;
      const int tok = chunk * 64 + (dir ? (63 - tau) : tau);
      vv[i] = ((const unsigned*)(Hh + (rowbase + tok) * NPAD + G_V + head * 128))[vp2];
    }
  };
  auto stage1 = [&]() __attribute__((always_inline)) {
    float r0 = 0.f, r1 = 0.f;
#pragma unroll
    for (int i = 0; i < 4; ++i) { r0 += lo16(pg[i]); r1 += hi16(pg[i]); g0[i] = r0; g1[i] = r1; }
    *(float2*)(sTot + tg * 64 + ch0) = make_float2(r0, r1);
  };
  gloadA(seg * SLEN); gloadB(seg * SLEN);
  stage1();
  if (SLEN > 1) gloadA(seg * SLEN + 1);
  for (int ci = 0; ci < SLEN; ++ci) {
    const int cidx = seg * SLEN + ci;
    const int chunk = dir ? (63 - cidx) : cidx;
    lds_barrier();
    float off0 = 0.f, off1 = 0.f, ref0 = 0.f, ref1 = 0.f, be0 = 0.f, be1 = 0.f;
#pragma unroll
    for (int j = 0; j < 16; ++j) {
      const float2 t = *(const float2*)(sTot + j * 64 + ch0);
      if (j < tg) { off0 += t.x; off1 += t.y; }
      if (j < 8) { ref0 += t.x; ref1 += t.y; }
      be0 += t.x; be1 += t.y;
    }
    dlog0 += be0; dlog1 += be1;
    const float eref0 = ex2(ref0), eref1 = ex2(ref1), ebr0 = ex2(be0 - ref0), ebr1 = ex2(be1 - ref1);
    const float d0 = off0 - ref0, d1 = off1 - ref1;
    float kh0[4], kh1[4];
#pragma unroll
    for (int i = 0; i < 4; ++i) {
      const int tau = 4 * tg + i;
      const float E0 = ex2(g0[i] + d0), E1 = ex2(g1[i] + d1);
      const float kt0 = lo16(kk[i]) * frcp(E0), kt1 = hi16(kk[i]) * frcp(E1);
      if (do_out) {
        const float qt0 = lo16(qq[i]) * E0, qt1 = hi16(qq[i]) * E1;
        sQt[tau * KPW + cp] = pk2(qt0, qt1);
        sKt[tau * KPW + cp] = pk2(kt0, kt1);
        sQc[tau * KPW + cp] = pk2(qt0 * eref0, qt1 * eref1);
      }
      kh0[i] = kt0 * ebr0; kh1[i] = kt1 * ebr1;
    }
    *(uint2*)(sKhT + ch0 * 72 + 4 * tg) = make_uint2(pk2(kh0[0], kh0[1]), pk2(kh0[2], kh0[3]));
    *(uint2*)(sKhT + (ch0 + 1) * 72 + 4 * tg) = make_uint2(pk2(kh1[0], kh1[1]), pk2(kh1[2], kh1[3]));
    *(u32x4*)(sVT + (2 * vp2) * 72 + 8 * vg) = PACK8_LO(vv);
    *(u32x4*)(sVT + (2 * vp2 + 1) * 72 + 8 * vg) = PACK8_HI(vv);
    if (tg == 0) *(float2*)(sD + ch0) = make_float2(ex2(be0), ex2(be1));
    if (do_out) scan_write_state<K, V>(smem, S, w, lane);
    if (ci + 1 < SLEN) gloadB(cidx + 1);
    lds_barrier();
    scan_core<K, V, false>(smem, S, OB + (rowbase + (size_t)chunk * 64) * 512 + head * 128, dir, w, lane, do_out, nullptr);
    if (ci + 1 < SLEN) { stage1(); if (ci + 2 < SLEN) gloadA(cidx + 2); }
  }
  if (!do_out) {
    state_store<K, V>(sbuf, S, w, lane);
    if (tg == 0) *(float2*)((float*)(p.ws + OFF_DB) + ((size_t)it * NSEG + seg) * 128 + ch0) = make_float2(ex2(dlog0), ex2(dlog1));
  }
  lds_barrier();
}

DEV void ssd_item(const Params& p, int l, int it, int seg, int mode, unsigned char* smem) {
  const int j32 = it - 32, bl = j32 >> 4, head = (j32 >> 1) & 7, dir = j32 & 1;
  const bool do_out = (mode == 3);
  constexpr int K = 128, V = 64, KPW = 68;
  const int tid = launder(threadIdx.x), lane = tid & 63, w = tid >> 6;
  const int cp = tid & 63, tg = tid >> 6, n0 = 2 * cp;
  const int xp = tid & 31, xg = tid >> 5;
  const int grp = head >> 2;
  const bf16_t* U = (const bf16_t*)(p.ws + OFF_U);
  const float* SMALL = (const float*)(p.ws + OFF_SMALL);
  bf16_t* OB = (bf16_t*)(p.ws + OFF_OBUF) + (size_t)(1 * 2 + dir) * TH * 512;
  const size_t rowbase = (size_t)bl * SEQ;
  unsigned* sQt = (unsigned*)(smem + L_QT); unsigned* sKt = (unsigned*)(smem + L_KT); unsigned* sQc = (unsigned*)(smem + L_QC);
  bf16_t* sKhT = (bf16_t*)(smem + L_KHT); bf16_t* sVT = (bf16_t*)(smem + L_VT);
  float* sD = (float*)(smem + L_D);
  const float dtb = p.dt_bias[(l * 2 + dir) * 8 + head];
  const float Acoef = -__expf(p.a_log[(l * 2 + dir) * 8 + head]) * LOG2E;
  f32x16 S[1]; S[0] = zero16();
  float* sbuf = (float*)(p.ws + OFF_SB2) + ((size_t)j32 * NSEG + seg) * 8192;
  if (do_out) state_combine<K, V>((const float*)(p.ws + OFF_SB2) + (size_t)j32 * NSEG * 8192, 8192, (const float*)(p.ws + OFF_DB) + (size_t)it * NSEG * 128, seg, S, w, lane);
  float dlog = 0.f;
  unsigned bb[8], cc[8], xx[4];
  float rdt = 0.f;
  auto gloadA = [&](int cidx) __attribute__((always_inline)) {
    const int chunk = dir ? (63 - cidx) : cidx;
    if (w == 0) {
      const int tok = chunk * 64 + (dir ? (63 - lane) : lane);
      rdt = SMALL[(rowbase + tok) * 48 + dir * 8 + head];
    }
  };
  auto gloadB = [&](int cidx) __attribute__((always_inline)) {
    const int chunk = dir ? (63 - cidx) : cidx;
#pragma unroll
    for (int i = 0; i < 8; ++i) {
      const int tau = 8 * tg + i;
      const int tok = chunk * 64 + (dir ? (63 - tau) : tau);
      const unsigned* rp = (const unsigned*)(U + (rowbase + tok) * 1024 + grp * 128) + cp;
      bb[i] = rp[512 / 2]; cc[i] = do_out ? rp[768 / 2] : 0u;
    }
#pragma unroll
    for (int i = 0; i < 4; ++i) {
      const int tau = 4 * xg + i;
      const int tok = chunk * 64 + (dir ? (63 - tau) : tau);
      xx[i] = ((const unsigned*)(U + (rowbase + tok) * 1024 + head * 64))[xp];
    }
  };
  auto stage1 = [&](int par) __attribute__((always_inline)) {
    if (w == 0) {
      const float xv = rdt + dtb;
      const float dt = (xv > 20.f) ? xv : log1pf(__expf(xv));
      float a = dt * Acoef;
#pragma unroll
      for (int o = 1; o < 64; o <<= 1) { const float t = __shfl_up(a, o); if (lane >= o) a += t; }
      ((float*)(smem + L_ACS))[par * 64 + lane] = a; ((float*)(smem + L_DT))[par * 64 + lane] = dt;
    }
  };
  gloadA(seg * SLEN); gloadB(seg * SLEN);
  stage1(0);
  if (SLEN > 1) gloadA(seg * SLEN + 1);
  for (int ci = 0; ci < SLEN; ++ci) {
    const int cidx = seg * SLEN + ci;
    const int chunk = dir ? (63 - cidx) : cidx;
    const float* sAcs = (const float*)(smem + L_ACS) + (ci & 1) * 64;
    const float* sDt = (const float*)(smem + L_DT) + (ci & 1) * 64;
    lds_barrier();
    const float aend = sAcs[63];
    dlog += aend;
    {
      float kh0[8], kh1[8];
#pragma unroll
      for (int i = 0; i < 8; ++i) {
        const int tau = 8 * tg + i;
        const float ac = sAcs[tau];
        const float eb = ex2(aend - ac);
        kh0[i] = lo16(bb[i]) * eb; kh1[i] = hi16(bb[i]) * eb;
        if (do_out) {
          const float ea = ex2(ac);
          sKt[tau * KPW + cp] = bb[i];
          sQt[tau * KPW + cp] = cc[i];
          sQc[tau * KPW + cp] = pk2(lo16(cc[i]) * ea, hi16(cc[i]) * ea);
        }
      }
      *(u32x4*)(sKhT + n0 * 72 + 8 * tg) = CVT8(kh0);
      *(u32x4*)(sKhT + (n0 + 1) * 72 + 8 * tg) = CVT8(kh1);
      float x0[4], x1[4];
#pragma unroll
      for (int i = 0; i < 4; ++i) { const float dtv = sDt[4 * xg + i]; x0[i] = lo16(xx[i]) * dtv; x1[i] = hi16(xx[i]) * dtv; }
      *(uint2*)(sVT + (2 * xp) * 72 + 4 * xg) = make_uint2(pk2(x0[0], x0[1]), pk2(x0[2], x0[3]));
      *(uint2*)(sVT + (2 * xp + 1) * 72 + 4 * xg) = make_uint2(pk2(x1[0], x1[1]), pk2(x1[2], x1[3]));
      if (tg == 0) *(float2*)(sD + n0) = make_float2(ex2(aend), ex2(aend));
    }
    if (do_out) scan_write_state<K, V>(smem, S, w, lane);
    if (ci + 1 < SLEN) gloadB(cidx + 1);
    lds_barrier();
    scan_core<K, V, true>(smem, S, OB + (rowbase + (size_t)chunk * 64) * 512 + head * 64, dir, w, lane, do_out, sAcs);
    if (ci + 1 < SLEN) { stage1((ci + 1) & 1); if (ci + 2 < SLEN) gloadA(cidx + 2); }
  }
  if (!do_out) {
    state_store<K, V>(sbuf, S, w, lane);
    if (tg == 0) *(float2*)((float*)(p.ws + OFF_DB) + ((size_t)it * NSEG + seg) * 128 + n0) = make_float2(ex2(dlog), ex2(dlog));
  }
  lds_barrier();
}

DEV void phase_prep(const Params& p, int l, int hf, int rep, unsigned char* smem) {
  const int tid = launder(threadIdx.x), lane = tid & 63;
  bf16_t* Hh = (bf16_t*)(p.ws + OFF_H);
  bf16_t* U = (bf16_t*)(p.ws + OFF_U);
  bf16_t* Gb = (bf16_t*)(p.ws + OFF_G);
  bf16_t* VT = (bf16_t*)(p.ws + OFF_VT);
  const float* SMALLp = (const float*)(p.ws + OFF_SMALL);
  float2* stab = (float2*)smem;
  float* slow = (float*)(smem + 8192);
  bf16_t* sT = (bf16_t*)(smem + 12288);
  {
    const float2* tabg = (const float2*)(p.ws + OFF_TAB);
    for (int i = tid; i < 1024; i += NT) stab[i] = tabg[i];
  }
  const int cg8 = (tid & 127) * 8, rsub = tid >> 7;
  const float* cw = p.conv_w + (size_t)l * 5 * 1024; const float* cb = p.conv_b + (size_t)l * 1024;
  float wv[5][8], bv[8];
#pragma unroll
  for (int j = 0; j < 5; ++j)
#pragma unroll
    for (int e = 0; e < 8; ++e) wv[j][e] = cw[j * 1024 + cg8 + e];
#pragma unroll
  for (int e = 0; e < 8; ++e) bv[e] = cb[cg8 + e];
  const int gd = tid >> 8, gc = tid & 255;
  const int i16 = lane & 15;
  const float* gq = p.q_gain + l * 64 + 4 * i16; const float* gk = p.k_gain + l * 64 + 4 * i16;
  const float gqv[4] = {gq[0], gq[1], gq[2], gq[3]}, gkv[4] = {gk[0], gk[1], gk[2], gk[3]};
  for (int grp = blockIdx.x; grp < TH / 32; grp += gridDim.x) {
    const int r0 = grp * 32;
    lds_barrier();
    const u32x4 vt = *(const u32x4*)(Hh + (size_t)(r0 + (tid >> 4)) * NPAD + A_V + (tid & 15) * 8);
    const float2 lowv = *(const float2*)(SMALLp + (size_t)(r0 + (tid >> 4)) * 48 + 16 + (tid & 15) * 2);
    *(u32x4*)(sT + (tid >> 4) * 136 + (tid & 15) * 8) = vt;
    *(float2*)(slow + (tid >> 4) * 32 + (tid & 15) * 2) = lowv;
#pragma unroll 1
    for (int ps = 0; ps < 2; ++ps) {
      const int ra = r0 + 16 * ps + 4 * rsub, ta = ra & (SEQ - 1);
      u32x4 xc[8];
#pragma unroll
      for (int m = 0; m < 8; ++m) {
        const int sq = ta + m - 2;
        xc[m] = (u32x4){0u, 0u, 0u, 0u};
        if (sq >= 0 && sq < SEQ) xc[m] = *(const u32x4*)(Hh + (size_t)(ra + m - 2) * NPAD + S_X + cg8);
      }
#pragma unroll
      for (int o4 = 0; o4 < 4; ++o4) {
        float u[8];
#pragma unroll
        for (int e = 0; e < 8; ++e) u[e] = bv[e];
#pragma unroll
        for (int j = 0; j < 5; ++j)
#pragma unroll
          for (int e = 0; e < 4; ++e) { u[2 * e] += wv[j][2 * e] * lo16(xc[o4 + j][e]); u[2 * e + 1] += wv[j][2 * e + 1] * hi16(xc[o4 + j][e]); }
        u32x4 o;
#pragma unroll
        for (int e = 0; e < 4; ++e) {
          const float a = u[2 * e] * frcp(1.f + ex2(fminf(-u[2 * e] * LOG2E, 80.f)));
          const float b = u[2 * e + 1] * frcp(1.f + ex2(fminf(-u[2 * e + 1] * LOG2E, 80.f)));
          o[e] = pk2(a, b);
        }
        *(u32x4*)(U + (size_t)(ra + o4) * 1024 + cg8) = o;
      }
    }
    lds_barrier();
    if (rep == 0) {
      u32x4 hq[6];
#pragma unroll
      for (int u = 0; u < 6; ++u) {
        const int id = u * 512 + tid, row = r0 + id / 96, c96 = id % 96;
        hq[u] = *(const u32x4*)(Hh + (size_t)row * NPAD + ((c96 < 64) ? (H_Q + c96 * 8) : (G_Q + (c96 - 64) * 8)));
      }
#pragma unroll 1
      for (int ub = 0; ub < 10; ub += 5) {
        uint2 xq[5];
#pragma unroll
        for (int u = 0; u < 5; ++u) {
          const int pi = (ub + u) * 32 + (tid >> 4), row = r0 + pi / 10, hd = pi % 10;
          xq[u] = *(const uint2*)(Hh + (size_t)row * NPAD + ((hd < 8) ? (A_Q + hd * 64) : (A_K + (hd - 8) * 64)) + 4 * i16);
        }
#pragma unroll
        for (int u = 0; u < 5; ++u) {
          const int pi = (ub + u) * 32 + (tid >> 4), row = r0 + pi / 10, hd = pi % 10;
          const bool isq = hd < 8;
          const float x[4] = {lo16(xq[u].x), hi16(xq[u].x), lo16(xq[u].y), hi16(xq[u].y)};
          float ss = x[0] * x[0] + x[1] * x[1] + x[2] * x[2] + x[3] * x[3];
          ss += __shfl_xor(ss, 1); ss += __shfl_xor(ss, 2); ss += __shfl_xor(ss, 4); ss += __shfl_xor(ss, 8);
          const float rstd = rsqrtf(ss * (1.f / 64.f) + 1e-6f);
          const int t = row & (SEQ - 1);
          const int pos = (i16 < 8) ? (t >> 6) : (t & 63);
          const float osc = isq ? QSCALE : 1.f;
          float o[4];
#pragma unroll
          for (int e = 0; e < 4; ++e) {
            const float v = x[e] * rstd * (isq ? gqv[e] : gkv[e]);
            const float pv = __shfl_xor(v, 4);
            const float2 cs = stab[pos * 16 + 4 * (i16 & 3) + e];
            o[e] = ((i16 & 4) ? (v * cs.x + pv * cs.y) : (v * cs.x - pv * cs.y)) * osc;
          }
          *(uint2*)(Hh + (size_t)row * NPAD + (isq ? (A_Q + hd * 64) : (A_K + (hd - 8) * 64)) + 4 * i16) = make_uint2(pk2(o[0], o[1]), pk2(o[2], o[3]));
        }
      }
#pragma unroll
      for (int u = 0; u < 6; ++u) {
        const int id = u * 512 + tid, row = r0 + id / 96, c96 = id % 96;
        u32x4 x = hq[u];
        if (c96 < 64) {
#pragma unroll
          for (int e = 0; e < 4; ++e) {
            const float a = lo16(x[e]), b = hi16(x[e]);
            x[e] = pk2(a * frcp(1.f + ex2(fminf(-a * LOG2E, 80.f))) * 0.08838834764831845f, b * frcp(1.f + ex2(fminf(-b * LOG2E, 80.f))) * 0.08838834764831845f);
          }
        } else {
#pragma unroll
          for (int e = 0; e < 4; ++e) x[e] = pk2(lo16(x[e]) * 0.125f, hi16(x[e]) * 0.125f);
        }
        *(u32x4*)(Hh + (size_t)row * NPAD + ((c96 < 64) ? (H_Q + c96 * 8) : (G_Q + (c96 - 64) * 8))) = x;
      }
    }
    float w2c[16];
#pragma unroll
    for (int r = 0; r < 16; ++r) w2c[r] = p.gk_w2[((size_t)(l * 2 + gd) * 16 + r) * 256 + gc];
    const float gbias = p.gk_b[(l * 2 + gd) * 256 + gc];
#pragma unroll 4
    for (int rr = 0; rr < 32; ++rr) {
      const float4* lp4 = (const float4*)(slow + rr * 32 + gd * 16);
      float gkk = gbias;
#pragma unroll
      for (int r4 = 0; r4 < 4; ++r4) { const float4 lw = lp4[r4]; gkk += lw.x * w2c[4 * r4] + lw.y * w2c[4 * r4 + 1] + lw.z * w2c[4 * r4 + 2] + lw.w * w2c[4 * r4 + 3]; }
      const float l2 = (fminf(gkk, 0.f) * LOG2E - lg2(1.f + ex2(-fabsf(gkk) * LOG2E))) * (1.f / 16.f);
      Gb[(size_t)(r0 + rr) * 512 + tid] = f2bf(l2);
    }
    {
      const int c = tid >> 2, tq = (tid & 3) * 8;
      unsigned v[8];
#pragma unroll
      for (int i = 0; i < 8; ++i) v[i] = sT[(tq + i) * 136 + c];
      const int bl = r0 >> 12, t0 = (r0 & (SEQ - 1)) + tq;
      *(u32x4*)(VT + ((size_t)((bl * 2 + (c >> 6)) * 64 + (c & 63))) * SEQ + t0) = (u32x4){v[0] | (v[1] << 16), v[2] | (v[3] << 16), v[4] | (v[5] << 16), v[6] | (v[7] << 16)};
    }
  }
  lds_barrier();
}

DEV void phase_mix(const Params& p, int l, int hf, int slot, int mode, int att_lo, int att_hi, int vid_lo, int vid_hi, unsigned char* smem) {
  unsigned* ctr = (unsigned*)(p.ws + OFF_CTRL) + CTR_WORD0 + slot * 16;
  volatile int* sItem = (volatile int*)(smem + LDS_BYTES - 16);
  const int n_scan = 64 * NSEG;
  int hi = n_scan + (att_hi - att_lo); if (vid_hi < hi) hi = vid_hi;
  for (;;) {
    lds_barrier();
    if (threadIdx.x == 0) *sItem = vid_lo + (int)atomicAdd(ctr, 1u);
    lds_barrier();
    const int vid = *sItem;
    if (vid >= hi) break;
    if (vid < n_scan) {
      const int seg = vid >> 6, it = vid & 63;
      if (mode == 1 && seg == NSEG - 1) continue;
#if PROBE_REP > 0
      if (slot >= 40 && PROBE_TYPE >= 0 && ((it < 16) ? 0 : (it < 32) ? 1 : 2) != PROBE_TYPE) continue;
#endif
      if (it < 16) { if (PH_MASK & 0x100) hgrn_item(p, l, it, seg, mode, smem); }
      else if (it < 32) { if (PH_MASK & 0x200) gla_item(p, l, it, seg, mode, smem); }
      else { if (PH_MASK & 0x400) ssd_item(p, l, it, seg, mode, smem); }
    } else { if (PH_MASK & 0x800) attn_item(p, l, att_lo + (vid - n_scan), smem); }
  }
}

DEV void phase_scan2(const Params& p) {
  const size_t gtid = (size_t)blockIdx.x * NT + threadIdx.x, gsz = (size_t)gridDim.x * NT;
  const float* DB = (const float*)(p.ws + OFF_DB);
  for (size_t e = gtid; e < 655360; e += gsz) {
    float* buf; const float* dp; int stride;
    if (e < 262144) { const int it = (int)(e >> 14), idx = (int)(e & 16383); buf = (float*)(p.ws + OFF_SB0) + (size_t)it * NSEG * 16384 + idx; stride = 16384; dp = DB + (size_t)it * NSEG * 128 + (idx >> 7); }
    else if (e < 393216) { const int e2 = (int)(e - 262144), j = e2 >> 13, idx = e2 & 8191; buf = (float*)(p.ws + OFF_SB1) + (size_t)j * NSEG * 8192 + idx; stride = 8192; dp = DB + (size_t)(16 + j) * NSEG * 128 + (idx >> 7); }
    else { const int e3 = (int)(e - 393216), j = e3 >> 13, idx = e3 & 8191; buf = (float*)(p.ws + OFF_SB2) + (size_t)j * NSEG * 8192 + idx; stride = 8192; dp = DB + (size_t)(32 + j) * NSEG * 128 + (idx >> 6); }
    float u[NSEG - 1], d[NSEG - 1];
#pragma unroll
    for (int sg = 0; sg < NSEG - 1; ++sg) { u[sg] = buf[(size_t)sg * stride]; d[sg] = dp[sg * 128]; }
    float st = 0.f;
#pragma unroll
    for (int sg = 0; sg < NSEG; ++sg) { buf[(size_t)sg * stride] = st; if (sg < NSEG - 1) st = d[sg] * st + u[sg]; }
  }
}

DEV float bfe(const u32x4& v, int j) { return (j & 1) ? hi16(v[j >> 1]) : lo16(v[j >> 1]); }
DEV void phase_fin(const Params& p, int l, int hf) {
  const int tid = launder(threadIdx.x), lane = tid & 63, w = tid >> 6;
  const bf16_t* Hh = (const bf16_t*)(p.ws + OFF_H);
  const bf16_t* OB = (const bf16_t*)(p.ws + OFF_OBUF);
  bf16_t* MX = (bf16_t*)(p.ws + OFF_MIXED);
  const int c0 = lane * 8;
  const float* cw = p.conv_w + (size_t)l * 5 * 1024; const float* cb = p.conv_b + (size_t)l * 1024;
  for (int r0 = (blockIdx.x * 8 + w) * 4; r0 < TH; r0 += gridDim.x * 32) {
    {
      u32x4 at[4], a[4], b[4], z[4];
#pragma unroll
      for (int i = 0; i < 4; ++i) {
        const bf16_t* hrow = Hh + (size_t)(r0 + i) * NPAD;
        at[i] = *(const u32x4*)(hrow + A_Q + c0);
        a[i] = *(const u32x4*)(OB + ((size_t)0 * TH + r0 + i) * 512 + c0); b[i] = *(const u32x4*)(OB + ((size_t)1 * TH + r0 + i) * 512 + c0);
        z[i] = *(const u32x4*)(hrow + H_Z + c0);
      }
      float gn[8];
#pragma unroll
      for (int j = 0; j < 8; ++j) gn[j] = p.hgrn_norm[l * 512 + c0 + j];
#pragma unroll
      for (int i = 0; i < 4; ++i) {
        *(u32x4*)(MX + (size_t)(r0 + i) * DI + c0) = at[i];
        float o[8]; float ss = 0.f;
#pragma unroll
        for (int j = 0; j < 8; ++j) { o[j] = bfe(a[i], j) + bfe(b[i], j); ss += o[j] * o[j]; }
#pragma unroll
        for (int of = 32; of >= 1; of >>= 1) ss += __shfl_xor(ss, of);
        const float rstd = rsqrtf(ss * (1.f / 512.f) + 1e-6f);
        float y[8];
#pragma unroll
        for (int j = 0; j < 8; ++j) { const float zz = bfe(z[i], j); y[j] = o[j] * rstd * gn[j] * (zz * frcp(1.f + ex2(fminf(-zz * LOG2E, 80.f)))); }
        *(u32x4*)(MX + (size_t)(r0 + i) * DI + 512 + c0) = (u32x4){pk2(y[0], y[1]), pk2(y[2], y[3]), pk2(y[4], y[5]), pk2(y[6], y[7])};
      }
    }
    {
      u32x4 a[4], b[4], z[4];
#pragma unroll
      for (int i = 0; i < 4; ++i) {
        a[i] = *(const u32x4*)(OB + ((size_t)4 * TH + r0 + i) * 512 + c0); b[i] = *(const u32x4*)(OB + ((size_t)5 * TH + r0 + i) * 512 + c0);
        z[i] = *(const u32x4*)(Hh + (size_t)(r0 + i) * NPAD + G_Z + c0);
      }
      float gn[8];
#pragma unroll
      for (int j = 0; j < 8; ++j) gn[j] = p.gla_norm[l * 128 + ((c0 + j) & 127)];
#pragma unroll
      for (int i = 0; i < 4; ++i) {
        float o[8]; float ss = 0.f;
#pragma unroll
        for (int j = 0; j < 8; ++j) { o[j] = bfe(a[i], j) + bfe(b[i], j); ss += o[j] * o[j]; }
#pragma unroll
        for (int of = 8; of >= 1; of >>= 1) ss += __shfl_xor(ss, of);
        const float rstd = rsqrtf(ss * (1.f / 128.f) + 1e-6f);
        float y[8];
#pragma unroll
        for (int j = 0; j < 8; ++j) { const float zz = bfe(z[i], j); y[j] = o[j] * rstd * gn[j] * (zz * frcp(1.f + ex2(fminf(-zz * LOG2E, 80.f)))); }
        *(u32x4*)(MX + (size_t)(r0 + i) * DI + 1536 + c0) = (u32x4){pk2(y[0], y[1]), pk2(y[2], y[3]), pk2(y[4], y[5]), pk2(y[6], y[7])};
      }
    }
    {
      u32x4 a[4], b[4], z[4], xr[8];
      const int t0 = r0 & (SEQ - 1);
#pragma unroll
      for (int i = 0; i < 4; ++i) {
        a[i] = *(const u32x4*)(OB + ((size_t)2 * TH + r0 + i) * 512 + c0); b[i] = *(const u32x4*)(OB + ((size_t)3 * TH + r0 + i) * 512 + c0);
        z[i] = *(const u32x4*)(Hh + (size_t)(r0 + i) * NPAD + S_Z + c0);
      }
#pragma unroll
      for (int m = 0; m < 8; ++m) {
        const int sq = t0 + m - 2;
        xr[m] = (u32x4){0u, 0u, 0u, 0u};
        if (sq >= 0 && sq < SEQ) xr[m] = *(const u32x4*)(Hh + (size_t)(r0 + m - 2) * NPAD + S_X + c0);
      }
      float gn[8], cbv[8];
#pragma unroll
      for (int j = 0; j < 8; ++j) { gn[j] = p.ssd_norm[l * 512 + c0 + j]; cbv[j] = cb[c0 + j]; }
      const float dsk = p.ssd_d[l * 8 + (c0 >> 6)];
#pragma unroll
      for (int i = 0; i < 4; ++i) {
        float u[8];
#pragma unroll
        for (int j = 0; j < 8; ++j) u[j] = cbv[j];
#pragma unroll
        for (int jj = 0; jj < 5; ++jj)
#pragma unroll
          for (int j = 0; j < 8; ++j) u[j] += cw[jj * 1024 + c0 + j] * bfe(xr[i + jj], j);
        float y[8]; float ss = 0.f;
#pragma unroll
        for (int j = 0; j < 8; ++j) {
          const float zz = bfe(z[i], j);
          const float xs = u[j] * frcp(1.f + ex2(fminf(-u[j] * LOG2E, 80.f)));
          y[j] = (bfe(a[i], j) + bfe(b[i], j) + dsk * xs) * (zz * frcp(1.f + ex2(fminf(-zz * LOG2E, 80.f))));
          ss += y[j] * y[j];
        }
#pragma unroll
        for (int of = 32; of >= 1; of >>= 1) ss += __shfl_xor(ss, of);
        const float rstd = rsqrtf(ss * (1.f / 512.f) + 1e-6f);
#pragma unroll
        for (int j = 0; j < 8; ++j) y[j] = y[j] * rstd * gn[j];
        *(u32x4*)(MX + (size_t)(r0 + i) * DI + 1024 + c0) = (u32x4){pk2(y[0], y[1]), pk2(y[2], y[3]), pk2(y[4], y[5]), pk2(y[6], y[7])};
      }
    }
  }
}

#define XB_TMO      128
#define XB_XCNT(j)  (256  + 64 * (j))
#define XB_XSUB(j)  (1280 + 64 * (j))
#define XB_XGEN(j)  (2304 + 64 * (j))
#define XB_TOP      3328
#define XB_TOPGEN   3392
#define XB_SPIN_CAP (1u << 22)
#define LAS __attribute__((address_space(3)))
DEV unsigned xb_ld(unsigned* p) { return __hip_atomic_load(p, __ATOMIC_RELAXED, __HIP_MEMORY_SCOPE_AGENT); }
DEV unsigned xb_add(unsigned* p, unsigned v) { return __hip_atomic_fetch_add(p, v, __ATOMIC_RELAXED, __HIP_MEMORY_SCOPE_AGENT); }
DEV unsigned xb_xcc_id() { return (unsigned)__builtin_amdgcn_s_getreg((3 << 11) | 20) & 0xFu; }
#define XB_SPIN(cond, bar) do { unsigned _sp = 0; while (cond) { __builtin_amdgcn_s_sleep(1); \
    if ((++_sp & 255u) == 0u) { if (xb_ld(&(bar)[XB_TMO])) break; if (_sp > XB_SPIN_CAP) { atomicAdd(&(bar)[XB_TMO], 1u); break; } } } } while (0)
struct XcdBarrier { unsigned* bar; unsigned x; volatile LAS unsigned* st; };
DEV XcdBarrier xcd_barrier_post(unsigned* bar, volatile LAS unsigned* st) {
  XcdBarrier b; b.bar = bar; b.x = xb_xcc_id(); b.st = st;
  if (threadIdx.x == 0) (void)xb_add(&bar[XB_XCNT(b.x)], 1u);
  return b;
}
DEV void xcd_barrier_complete(unsigned* bar, unsigned x, unsigned& nloc, unsigned& nx) {
  const unsigned G = gridDim.x * gridDim.y * gridDim.z;
  unsigned sum, cnt, mine, sp = 0u;
  for (;;) {
    sum = 0u; cnt = 0u; mine = 0u;
#pragma unroll
    for (unsigned j = 0; j < 16; ++j) { const unsigned c = xb_ld(&bar[XB_XCNT(j)]); sum += c; cnt += (c > 0u) ? 1u : 0u; mine = (j == x) ? c : mine; }
    if (sum == G) break;
    __builtin_amdgcn_s_sleep(1);
    if ((++sp & 255u) == 0u) { if (xb_ld(&bar[XB_TMO])) break; if (sp > XB_SPIN_CAP) { atomicAdd(&bar[XB_TMO], 1u); break; } }
  }
  nloc = mine > 0u ? mine : 1u; nx = cnt > 0u ? cnt : 1u;
}
DEV void xcd_barrier(const XcdBarrier& b) {
  asm volatile("s_waitcnt vmcnt(0)" ::: "memory");
  __syncthreads();
  if (threadIdx.x == 0) {
    unsigned* bar = b.bar;
    __builtin_amdgcn_s_waitcnt(0);
    unsigned nloc = b.st[0], nx = b.st[1];
    if (nloc == 0u) { xcd_barrier_complete(bar, b.x, nloc, nx); b.st[0] = nloc; b.st[1] = nx; }
    const unsigned old = xb_add(&bar[XB_XSUB(b.x)], 1u);
    const unsigned gen = old / nloc;
    if (old + 1u == (gen + 1u) * nloc) {
      __builtin_amdgcn_fence(__ATOMIC_RELEASE, "agent");
      asm volatile("s_waitcnt vmcnt(0)" ::: "memory");
      const unsigned og = xb_add(&bar[XB_TOP], 1u);
      const unsigned tg = og / nx;
      if (og + 1u == (tg + 1u) * nx) xb_add(&bar[XB_TOPGEN], 1u);
      else XB_SPIN(xb_ld(&bar[XB_TOPGEN]) == tg, bar);
      __builtin_amdgcn_fence(__ATOMIC_ACQUIRE, "agent");
      xb_add(&bar[XB_XGEN(b.x)], 1u);
      asm volatile("s_waitcnt vmcnt(0)" ::: "memory");
    } else {
      XB_SPIN(xb_ld(&bar[XB_XGEN(b.x)]) == gen, bar);
      __builtin_amdgcn_fence(__ATOMIC_ACQUIRE, "agent");
      asm volatile("s_waitcnt vmcnt(0)" ::: "memory");
    }
  }
  __syncthreads();
}

DEV void run_phase(const Params& p, int ph, int rep, unsigned char* smem) {
  if (ph == 0) { if (PH_MASK & 1) { phase_pro(p, smem); convert_weights(p, 0, 3, smem); } return; }
  if (ph == 21) { if (PH_MASK & 16) phase_outproj(p, 1, 1, smem); return; }
  if (ph == 22) { if (PH_MASK & 32) phase_ln(p, 1, 1); return; }
  const int q = ph - 1, blk = q / 5, st = q % 5, l = blk >> 1, hf = blk & 1;
  if (st == 0) {
    if (blk > 0 && (PH_MASK & 16)) phase_outproj(p, (blk - 1) >> 1, (blk - 1) & 1, smem);
    if (PH_MASK & 2) phase_inproj(p, l, hf, blk > 0 ? 16 : 0, smem);
  } else if (st == 1) {
    if (blk > 0 && rep == 0 && (PH_MASK & 32)) phase_ln(p, (blk - 1) >> 1, (blk - 1) & 1);
    if (PH_MASK & 4) phase_prep(p, l, hf, rep, smem);
    if ((PH_MASK & 1) && rep == 0 && blk == 1) convert_weights(p, 1, 1, smem);
    if ((PH_MASK & 1) && rep == 0 && blk == 2) convert_weights(p, 1, 2, smem);
  }
  else if (st == 2) { if (PH_MASK & 0xF00) phase_mix(p, l, hf, ph + 40 * rep, 1, 0, ATT_SPLIT, rep ? PROBE_LO : 0, rep ? PROBE_HI : 100000, smem); }
  else if (st == 3) { if (PH_MASK & 0xF00) phase_mix(p, l, hf, ph + 40 * rep, 3, ATT_SPLIT, 256, rep ? PROBE_LO : 0, rep ? PROBE_HI : 100000, smem); }
  else { if (PH_MASK & 8) phase_fin(p, l, hf); }
}
__global__ void __launch_bounds__(NT) mega(Params p) {
  extern __shared__ __attribute__((aligned(16))) unsigned char smem[];
#if ONE_LAUNCH
  volatile LAS unsigned* xst = (volatile LAS unsigned*)(smem + LDS_BYTES - 32);
  if (threadIdx.x == 0) { xst[0] = 0u; xst[1] = 0u; }
  __syncthreads();
  XcdBarrier xb = xcd_barrier_post((unsigned*)(p.ws + OFF_CTRL), xst);
#endif
  Params* lp = (Params*)(smem + 147456);
  if (threadIdx.x == 0) *lp = p;
  __syncthreads();
  const int ph_begin = p.phase_begin, ph_end = p.phase_end;
  for (int ph = ph_begin; ph < ph_end; ++ph) {
    int nrep = 0;
#if PROBE_REP > 0
    {
      const int q = ph - 1, st = q % 5;
      const bool idem = (ph >= 1 && ph <= 20) && (st == PROBE_ST) && (st >= 1);
      if (idem) nrep = PROBE_REP;
    }
#endif
    for (int r = 0; r <= nrep; ++r) {
      run_phase(*lp, ph, r, smem);
#if ONE_LAUNCH
      if (r < nrep || ph + 1 < ph_end) xcd_barrier(xb);
#endif
    }
  }
}

extern "C" void kernel_launch(void* const* d_in, const int* in_sizes, int n_in, void* d_out, int out_size, void* d_ws, size_t ws_size,
                              hipStream_t stream) {
  static int grid_blocks = 0;
  if (!grid_blocks) {
    int dev = 0, cus = 0, per_cu = 0;
    hipGetDevice(&dev);
    hipDeviceGetAttribute(&cus, hipDeviceAttributeMultiprocessorCount, dev);
    hipFuncSetAttribute((const void*)mega, hipFuncAttributeMaxDynamicSharedMemorySize, LDS_BYTES);
    hipOccupancyMaxActiveBlocksPerMultiprocessor(&per_cu, mega, NT, LDS_BYTES);
    if (per_cu < 1) per_cu = 1;
    grid_blocks = cus;
  }
  Params p{};
  p.x = (const float*)d_in[0]; p.w_in = (const float*)d_in[1]; p.q_gain = (const float*)d_in[2]; p.k_gain = (const float*)d_in[3];
  p.lb_logits = (const float*)d_in[4]; p.hgrn_norm = (const float*)d_in[5]; p.conv_w = (const float*)d_in[6]; p.conv_b = (const float*)d_in[7];
  p.dt_bias = (const float*)d_in[8]; p.a_log = (const float*)d_in[9]; p.ssd_d = (const float*)d_in[10]; p.ssd_norm = (const float*)d_in[11];
  p.gk_w2 = (const float*)d_in[12]; p.gk_b = (const float*)d_in[13]; p.gla_norm = (const float*)d_in[14]; p.w_out = (const float*)d_in[15];
  p.ln_g = (const float*)d_in[16]; p.ln_b = (const float*)d_in[17];
  p.out = (float*)d_out; p.ws = (unsigned char*)d_ws;
  hipMemsetAsync(d_ws, 0, CTRL_BYTES, stream);
#if ONE_LAUNCH
  p.phase_begin = 0; p.phase_end = NPHASE;
  void* args[] = {&p};
  (void)args;
  hipLaunchKernelGGL(mega, dim3(grid_blocks), dim3(NT), LDS_BYTES, stream, p);
#else
  for (int ph = 0; ph < NPHASE; ++ph) {
    p.phase_begin = ph; p.phase_end = ph + 1;
    hipLaunchKernelGGL(mega, dim3(grid_blocks), dim3(NT), LDS_BYTES, stream, p);
  }
#endif
}
```

```cpp
#include <hip/hip_runtime.h>
#include <hip/hip_cooperative_groups.h>
#include <stdint.h>
#include <stdio.h>
namespace cg = cooperative_groups;

#ifndef ONE_LAUNCH
#define ONE_LAUNCH 1
#endif

#ifndef PH_MASK
#define PH_MASK 0xFFF
#endif
#ifndef PROBE_ST
#define PROBE_ST -1
#endif
#ifndef PROBE_REP
#define PROBE_REP 0
#endif
#ifndef PROBE_TYPE
#define PROBE_TYPE -1
#endif
#ifndef PROBE_LO
#define PROBE_LO 0
#endif
#ifndef PROBE_HI
#define PROBE_HI 100000
#endif
#define DEV __device__ __forceinline__
typedef unsigned short bf16_t;
typedef short bf16x8 __attribute__((ext_vector_type(8)));
typedef float f32x16 __attribute__((ext_vector_type(16)));
typedef unsigned u32x4 __attribute__((ext_vector_type(4)));
typedef float f32x4 __attribute__((ext_vector_type(4)));

constexpr int NT = 512;
constexpr int T_ALL = 16384, TH = 8192, SEQ = 4096, DM = 1024, NPAD = 7168, DI = 2048, NIN = 6960;
constexpr int A_Q = 0, A_K = 512, A_V = 640, A_Z = 768, H_Q = 1280, H_FF = 1792, H_FB = 2304, H_I = 2816, H_Z = 3328,
              S_X = 3840, S_Z = 4864, G_Q = 5376, G_K = 5632, G_V = 5888, G_Z = 6400, SM0 = 6912;
constexpr size_t OFF_CTRL = 0, OFF_TAB = 65536, OFF_XB = 131072;
constexpr size_t OFF_WIN = OFF_XB + (size_t)T_ALL * DM * 2;
constexpr size_t OFF_WOUT = OFF_WIN + (size_t)NPAD * DM * 2;
constexpr size_t OFF_H = OFF_WOUT + (size_t)DM * DI * 2;
constexpr size_t OFF_SMALL = OFF_H + (size_t)TH * NPAD * 2;
constexpr size_t OFF_OBUF = OFF_SMALL + (size_t)TH * 48 * 4;
constexpr size_t OFF_VT = OFF_OBUF + (size_t)6 * TH * 512 * 2;
constexpr size_t OFF_DB = OFF_VT + (size_t)2 * 2 * 64 * SEQ * 2;
constexpr int NSEG = 4, SLEN = 64 / NSEG;
constexpr size_t OFF_MIXED = OFF_DB + (size_t)64 * NSEG * 128 * 4;
constexpr size_t OFF_SB0 = OFF_MIXED, OFF_SB1 = OFF_SB0 + (size_t)16 * NSEG * 16384 * 4, OFF_SB2 = OFF_SB1 + (size_t)16 * NSEG * 8192 * 4;
constexpr size_t OFF_U = OFF_SB2 + (size_t)32 * NSEG * 8192 * 4;
constexpr size_t OFF_G = OFF_U + (size_t)TH * 1024 * 2;
constexpr size_t WS_END = (OFF_G + (size_t)TH * 512 * 2 > OFF_MIXED + (size_t)TH * DI * 2) ? (OFF_G + (size_t)TH * 512 * 2) : (OFF_MIXED + (size_t)TH * DI * 2);
static_assert(OFF_MIXED + (size_t)TH * DI * 2 <= WS_END, "MIXED must fit");
static_assert(WS_END <= 268435456, "workspace");
constexpr size_t CTRL_BYTES = 65536;
constexpr int CTR_WORD0 = 4096;
constexpr int LDS_BYTES = 148480;
constexpr float LOG2E = 1.4426950408889634f;
constexpr float QSCALE = 0.125f * LOG2E;
constexpr float DN_ALPHA = 1.4142135623730951f;
constexpr int NPHASE = 23;
constexpr int ATT_SPLIT = 256;

struct Params {
  const float* x; const float* w_in; const float* q_gain; const float* k_gain; const float* lb_logits; const float* hgrn_norm;
  const float* conv_w; const float* conv_b; const float* dt_bias; const float* a_log; const float* ssd_d; const float* ssd_norm;
  const float* gk_w2; const float* gk_b; const float* gla_norm; const float* w_out; const float* ln_g; const float* ln_b;
  float* out; unsigned char* ws;
  int phase_begin, phase_end;
};

DEV void lds_barrier() { asm volatile("s_waitcnt lgkmcnt(0)" ::: "memory"); __builtin_amdgcn_s_barrier(); asm volatile("" ::: "memory"); }
DEV int launder(int v) { asm volatile("" : "+v"(v)); return v; }
DEV float bf2f(bf16_t v) { return __uint_as_float(((unsigned)v) << 16); }
DEV bf16_t f2bf(float f) { unsigned u = __float_as_uint(f); u += 0x7fffu + ((u >> 16) & 1u); return (bf16_t)(u >> 16); }
typedef __bf16 bf16x2_t __attribute__((ext_vector_type(2)));
typedef float f32x2_t __attribute__((ext_vector_type(2)));
DEV unsigned pk2(float lo, float hi) { const f32x2_t f = {lo, hi}; const bf16x2_t b = __builtin_convertvector(f, bf16x2_t); return __builtin_bit_cast(unsigned, b); }
DEV float fsigmoid(float x) { return 1.f / (1.f + __expf(-x)); }
DEV float fsilu(float x) { return x / (1.f + __expf(-x)); }
DEV unsigned cvtpk(float lo, float hi) { return pk2(lo, hi); }
DEV float ex2(float x) { return __builtin_amdgcn_exp2f(x); }
DEV float lg2(float x) { return __builtin_amdgcn_logf(x); }
DEV float frcp(float x) { return __builtin_amdgcn_rcpf(x); }
DEV float lo16(unsigned u) { return __uint_as_float(u << 16); }
DEV float hi16(unsigned u) { return __uint_as_float(u & 0xffff0000u); }
DEV int rowoff(int reg, int h) { return (reg & 3) + 8 * (reg >> 2) + 4 * h; }
DEV f32x16 zero16() { f32x16 z;
#pragma unroll
  for (int i = 0; i < 16; ++i) z[i] = 0.f; return z; }

template <int KD>
DEV void mma32(f32x16& acc, const bf16_t* a, int lda, const bf16_t* b, int ldb, int lane) {
  const int r = lane & 31, h = lane >> 5;
  const bf16_t* ap = a + r * lda + 8 * h;
  const bf16_t* bp = b + r * ldb + 8 * h;
#pragma unroll 4
  for (int k = 0; k < KD; k += 16) {
    bf16x8 av = *(const bf16x8*)(ap + k);
    bf16x8 bv = *(const bf16x8*)(bp + k);
    acc = __builtin_amdgcn_mfma_f32_32x32x16_bf16(av, bv, acc, 0, 0, 0);
  }
}

DEV int orig_col(int n) {
  if (n < 4864) return n;
  if (n < 6400) return n + 16;
  if (n < 6912) return n + 48;
  if (n < 6928) return n - 2048;
  if (n < 6960) return n - 512;
  return -1;
}

DEV void convert_weights(const Params& p, int l, int which, unsigned char* smem) {
  float* s = (float*)smem;
  const int tid = launder(threadIdx.x);
  const float* win = p.w_in + (size_t)l * DM * NIN;
  const float* wout = p.w_out + (size_t)l * DI * DM;
  bf16_t* wint = (bf16_t*)(p.ws + OFF_WIN);
  bf16_t* woutt = (bf16_t*)(p.ws + OFF_WOUT);
  const int n_in_tiles = (NPAD / 64) * (DM / 64);
  const int n_out_tiles = (DM / 64) * (DI / 64);
  const int it_lo = (which & 1) ? 0 : n_in_tiles, it_hi = (which & 2) ? (n_in_tiles + n_out_tiles) : n_in_tiles;
  for (int it = it_lo + blockIdx.x; it < it_hi; it += gridDim.x) {
    lds_barrier();
    if (it < n_in_tiles) {
      const int n0 = (it / 16) * 64, k0 = (it % 16) * 64;
#pragma unroll
      for (int e = 0; e < 8; ++e) {
        const int idx = e * NT + tid, kk = idx >> 6, nn = idx & 63;
        const int oc = orig_col(n0 + nn);
        s[kk * 65 + nn] = (oc >= 0) ? win[(size_t)(k0 + kk) * NIN + oc] : 0.f;
      }
      lds_barrier();
      const int n = tid >> 3, kc = (tid & 7) * 8;
      uint4 o;
      o.x = pk2(s[(kc + 0) * 65 + n], s[(kc + 1) * 65 + n]); o.y = pk2(s[(kc + 2) * 65 + n], s[(kc + 3) * 65 + n]);
      o.z = pk2(s[(kc + 4) * 65 + n], s[(kc + 5) * 65 + n]); o.w = pk2(s[(kc + 6) * 65 + n], s[(kc + 7) * 65 + n]);
      *(uint4*)(wint + (size_t)(n0 + n) * DM + k0 + kc) = o;
    } else {
      const int j = it - n_in_tiles;
      const int n0 = (j / 32) * 64, k0 = (j % 32) * 64;
#pragma unroll
      for (int e = 0; e < 8; ++e) {
        const int idx = e * NT + tid, kk = idx >> 6, nn = idx & 63;
        s[kk * 65 + nn] = wout[(size_t)(k0 + kk) * DM + n0 + nn];
      }
      lds_barrier();
      const int n = tid >> 3, kc = (tid & 7) * 8;
      uint4 o;
      o.x = pk2(s[(kc + 0) * 65 + n], s[(kc + 1) * 65 + n]); o.y = pk2(s[(kc + 2) * 65 + n], s[(kc + 3) * 65 + n]);
      o.z = pk2(s[(kc + 4) * 65 + n], s[(kc + 5) * 65 + n]); o.w = pk2(s[(kc + 6) * 65 + n], s[(kc + 7) * 65 + n]);
      *(uint4*)(woutt + (size_t)(n0 + n) * DI + k0 + kc) = o;
    }
  }
  lds_barrier();
}

DEV void fsincos(float x, float& s, float& c) {
  const float k = rintf(x * 0.63661977236758134308f);
  float r = fmaf(-k, 1.5707855225e+00f, x);
  r = fmaf(-k, 1.0804273188e-05f, r);
  r = fmaf(-k, 6.0770999344e-11f, r);
  const float r2 = r * r;
  float ps = fmaf(r2, 2.7557319224e-06f, -1.9841269841e-04f);
  ps = fmaf(ps, r2, 8.3333333333e-03f); ps = fmaf(ps, r2, -1.6666666667e-01f);
  const float sinr = fmaf(ps * r2, r, r);
  float pc = fmaf(r2, -2.7557319224e-07f, 2.4801587302e-05f);
  pc = fmaf(pc, r2, -1.3888888889e-03f); pc = fmaf(pc, r2, 4.1666666667e-02f); pc = fmaf(pc, r2, -0.5f);
  const float cosr = fmaf(pc, r2, 1.0f);
  const int q = ((int)k) & 3;
  if (q == 0) { s = sinr; c = cosr; }
  else if (q == 1) { s = cosr; c = -sinr; }
  else if (q == 2) { s = -sinr; c = -cosr; }
  else { s = -cosr; c = sinr; }
}

DEV void phase_pro(const Params& p, unsigned char* smem) {
  const int tid = launder(threadIdx.x);
  const size_t gtid = (size_t)blockIdx.x * NT + tid, gsz = (size_t)gridDim.x * NT;
  const float4* x4 = (const float4*)p.x;
  uint4* xb4 = (uint4*)(p.ws + OFF_XB);
  for (size_t i = gtid; i < (size_t)T_ALL * DM / 8; i += gsz) {
    const float4 a = x4[2 * i], b = x4[2 * i + 1];
    uint4 o; o.x = pk2(a.x, a.y); o.y = pk2(a.z, a.w); o.z = pk2(b.x, b.y); o.w = pk2(b.z, b.w);
    xb4[i] = o;
  }
  if (blockIdx.x == 0) {
    float2* tab = (float2*)(p.ws + OFF_TAB);
    for (int i = tid; i < 64 * 16; i += NT) {
      const int pos = i >> 4, fi = i & 15;
      const float invf = exp2f(-(float)fi * (13.287712379549449f / 16.0f));
      const float ang = (float)pos * invf;
      float sn, cs; fsincos(ang, sn, cs);
      tab[i] = make_float2(cs, sn);
    }
  }
}

namespace pg8 {
#define PG8_LAS __attribute__((address_space(3)))
typedef unsigned short bf16_t;
typedef short bf16x8 __attribute__((ext_vector_type(8)));
typedef float f32x4 __attribute__((ext_vector_type(4)));
typedef unsigned u32x4 __attribute__((ext_vector_type(4)));
constexpr int BM = 256, BK = 64, HALF = 128, HTB = HALF * BK * 2  , STAGE_BYTES = 8 * HTB, NXCD = 8, WGM = 8;

__host__ __device__ __forceinline__ int lds_byte(int r, int c) { const int st = (r >> 4) * 2 + (c >> 5), rr = r & 15, cc = c & 31, ob = rr * 64 + cc * 2; return st * 1024 + (ob ^ (((ob >> 9) & 1) << 5)); }
__host__ __device__ __forceinline__ void stage_rc(int b, int& R, int& C) { const int st = b / 1024, sb = b % 1024, swz = sb ^ (((sb >> 9) & 1) << 5); R = (st >> 1) * 16 + swz / 64; C = (st & 1) * 32 + (swz % 64) / 2; }
__host__ __device__ __forceinline__ int perm32(int rho) { const int n = rho >> 4, i = rho & 15; return 8 * (i >> 2) + 4 * n + (i & 3); }

struct Unit { int pm, pn; };
struct Gemm { const bf16_t* A; const bf16_t* Bt; int M, N, K; };

__device__ __forceinline__ unsigned cvt_pk_bf16(float lo, float hi) { unsigned r; asm volatile("v_cvt_pk_bf16_f32 %0, %1, %2" : "=v"(r) : "v"(lo), "v"(hi)); return r; }

struct XcdOrder {
    int rpx, nN, x, c, ncu, skew;
    __device__ void init(int M, int N, int skew_ = 0) { rpx = (M / BM) / NXCD; nN = N / BM; x = blockIdx.x & 7; c = blockIdx.x >> 3; ncu = gridDim.x >> 3; skew = skew_; }
    __device__ bool next(int i, Unit& u) const {
        const int total = rpx * nN, full = (total / ncu) * ncu;
        int j = c + i * ncu;
        if (skew > 0 && j >= full) { const int cc = c - skew; j = (cc >= 0 && i == total / ncu) ? full + cc : total; }
        if (j >= total) return false; u.pm = rpx * x + (j % rpx); u.pn = j / rpx; return true; }
    __device__ __forceinline__ void a_ready(const Unit&) const {}
    __device__ __forceinline__ void done(const Unit&) const {}
};
struct EpiIn {
    static constexpr bool PERM = true, AFTER_DRAIN = false;
    bf16_t* O; int ldc; float* small; int small_pn;
    __device__ __forceinline__ void operator()(const f32x4 (&acc)[2][2][4][2], const Unit& u, int wr, int wc, int fr, int fq) const {
        const int row0 = u.pm * BM + wr * 64 + fr, col0 = u.pn * BM + wc * 32 + 8 * fq;
        if (u.pn == small_pn) {
            const int c = wc * 32 + 8 * fq;
            if (c < 48) {
#pragma unroll
                for (int ai = 0; ai < 2; ++ai)
#pragma unroll
                    for (int m = 0; m < 4; ++m) { float* rp = small + (size_t)(row0 + ai * HALF + m * 16) * 48 + c; *(f32x4*)rp = acc[ai][0][m][0]; *(f32x4*)(rp + 4) = acc[ai][0][m][1]; }
            }
            return;
        }
        const int act = (u.pn == 5 || u.pn == 6) ? 1 : ((u.pn == 21) ? 2 : 0);
#pragma unroll
        for (int ai = 0; ai < 2; ++ai)
#pragma unroll
            for (int m = 0; m < 4; ++m) { bf16_t* rowp = O + (size_t)(row0 + ai * HALF + m * 16) * ldc + col0;
#pragma unroll
                for (int bj = 0; bj < 2; ++bj) { f32x4 v0 = acc[ai][bj][m][0], v1 = acc[ai][bj][m][1];
                    if (act == 1) {
#pragma unroll
                        for (int e = 0; e < 4; ++e) {
                            v0[e] = v0[e] * __builtin_amdgcn_rcpf(1.f + __builtin_amdgcn_exp2f(fminf(-v0[e] * 1.4426950408889634f, 80.f))) * 0.08838834764831845f;
                            v1[e] = v1[e] * __builtin_amdgcn_rcpf(1.f + __builtin_amdgcn_exp2f(fminf(-v1[e] * 1.4426950408889634f, 80.f))) * 0.08838834764831845f; }
                    } else if (act == 2) { v0 = v0 * 0.125f; v1 = v1 * 0.125f; }
                    u32x4 w; w.x = cvt_pk_bf16(v0[0], v0[1]); w.y = cvt_pk_bf16(v0[2], v0[3]); w.z = cvt_pk_bf16(v1[0], v1[1]); w.w = cvt_pk_bf16(v1[2], v1[3]);
                    *(u32x4*)(rowp + bj * HALF) = w; } }
    }
};
struct EpiOut {
    static constexpr bool PERM = true, AFTER_DRAIN = false;
    const float* X; float* Y; int ldc; float alpha;
    __device__ __forceinline__ void operator()(const f32x4 (&acc)[2][2][4][2], const Unit& u, int wr, int wc, int fr, int fq) const {
        const int row0 = u.pm * BM + wr * 64 + fr, col0 = u.pn * BM + wc * 32 + 8 * fq;
#pragma unroll
        for (int ai = 0; ai < 2; ++ai)
#pragma unroll
            for (int m = 0; m < 4; ++m) { const size_t off = (size_t)(row0 + ai * HALF + m * 16) * ldc + col0;
#pragma unroll
                for (int bj = 0; bj < 2; ++bj) { const f32x4 x0 = *(const f32x4*)(X + off + bj * HALF), x1 = *(const f32x4*)(X + off + bj * HALF + 4);
                    *(f32x4*)(Y + off + bj * HALF) = x0 * alpha + acc[ai][bj][m][0]; *(f32x4*)(Y + off + bj * HALF + 4) = x1 * alpha + acc[ai][bj][m][1]; } }
    }
};

template <class Epi, class Sched, bool ALIGN_EPI = false, bool SP2 = false>
__device__ __forceinline__ void gemm_phase(PG8_LAS unsigned char* lds, const Gemm g, const Sched& S, const Epi& E) {
    const int tid = launder((int)threadIdx.x), wid = __builtin_amdgcn_readfirstlane(tid >> 6), lane = tid & 63, wr = wid >> 2, wc = wid & 3, fr = lane & 15, fq = lane >> 4;
    const int K = g.K, nt = K / BK;
    unsigned voffA[2], voffB[2];
#pragma unroll
    for (int i = 0; i < 2; ++i) { int R, C; stage_rc(tid * 16 + i * 8192, R, C); const int Rb = Epi::PERM ? ((R & ~31) + perm32(R & 31)) : R;
        voffA[i] = (unsigned)(R * K + C) * 2u; voffB[i] = (unsigned)(Rb * K + C) * 2u; }
    const size_t kstep = (size_t)(BK * 2);
    const size_t hstep = (size_t)HALF * K * 2;
    const size_t tstep = 2 * hstep;
    const unsigned ldsw = (unsigned)wid * 1024u;
    const int aoff = lds_byte(wr * 64 + fr, fq * 8), boff = lds_byte(wc * 32 + fr, fq * 8);
#define PG8_SA(b, h) (((b) * 2 + (h)) * HTB)
#define PG8_SB(b, h) ((4 + (b) * 2 + (h)) * HTB)
#define PG8_STAGE(bufoff, gbase, voff) do { _Pragma("unroll") for (int _i = 0; _i < 2; ++_i) \
        __builtin_amdgcn_global_load_lds((const unsigned*)((const char*)(gbase) + (voff)[_i]), (PG8_LAS unsigned*)(lds + (bufoff) + ldsw + _i * 8192), 16, 0, 0); } while (0)
#define PG8_LDA(dst, b, h) do { _Pragma("unroll") for (int m = 0; m < 4; ++m) _Pragma("unroll") for (int k = 0; k < 2; ++k) dst[m][k] = *(const PG8_LAS bf16x8*)(lds + PG8_SA(b, h) + aoff + m * 2048 + k * 1024); } while (0)
#define PG8_LDB(dst, b, h) do { _Pragma("unroll") for (int n = 0; n < 2; ++n) _Pragma("unroll") for (int k = 0; k < 2; ++k) dst[n][k] = *(const PG8_LAS bf16x8*)(lds + PG8_SB(b, h) + boff + n * 2048 + k * 1024); } while (0)
#define PG8_MMA(ai, bj, At, Bt) do { __builtin_amdgcn_s_setprio(1); _Pragma("unroll") for (int m = 0; m < 4; ++m) _Pragma("unroll") for (int n = 0; n < 2; ++n) _Pragma("unroll") for (int k = 0; k < 2; ++k) \
        acc[ai][bj][m][n] = __builtin_amdgcn_mfma_f32_16x16x32_bf16(Bt[n][k], At[m][k], acc[ai][bj][m][n], 0, 0, 0); __builtin_amdgcn_s_setprio(0); } while (0)
#define PG8_WAIT_V(n) asm volatile("s_waitcnt vmcnt(" #n ")" ::: "memory")
#define PG8_WAIT_L(n) asm volatile("s_waitcnt lgkmcnt(" #n ")" ::: "memory")
#define PG8_BAR __builtin_amdgcn_s_barrier()
#define PG8_SCHED __builtin_amdgcn_sched_barrier(0)
    Unit cur, nxt; int ui = 0;
    if (!S.next(0, cur)) return;
    f32x4 acc[2][2][4][2];
#pragma unroll
    for (int a = 0; a < 2; ++a)
#pragma unroll
        for (int b = 0; b < 2; ++b)
#pragma unroll
            for (int m = 0; m < 4; ++m)
#pragma unroll
                for (int n = 0; n < 2; ++n) acc[a][b][m][n] = (f32x4){0.f, 0.f, 0.f, 0.f};
    bf16x8 At[4][2], B0[2][2], B1[2][2];
    const char* cA = (const char*)g.A + (size_t)cur.pm * tstep; const char* cB = (const char*)g.Bt + (size_t)cur.pn * tstep;
    S.a_ready(cur);
    if constexpr (SP2) {
        PG8_STAGE(PG8_SB(0, 0), cB, voffB); PG8_STAGE(PG8_SB(0, 1), cB + hstep, voffB); PG8_STAGE(PG8_SA(0, 0), cA, voffA); PG8_STAGE(PG8_SA(0, 1), cA + hstep, voffA);
        if (wr == 1) PG8_BAR;
        PG8_WAIT_V(2); PG8_BAR;
        PG8_STAGE(PG8_SB(1, 0), cB + kstep, voffB); PG8_STAGE(PG8_SA(1, 0), cA + kstep, voffA); PG8_STAGE(PG8_SB(1, 1), cB + hstep + kstep, voffB);
        PG8_WAIT_V(6); PG8_BAR;
    } else {
        PG8_STAGE(PG8_SB(0, 0), cB, voffB); PG8_STAGE(PG8_SA(0, 0), cA, voffA); PG8_STAGE(PG8_SB(0, 1), cB + hstep, voffB); PG8_STAGE(PG8_SA(0, 1), cA + hstep, voffA);
        if (wr == 1) PG8_BAR;
        PG8_WAIT_V(4); PG8_BAR;
        PG8_STAGE(PG8_SB(1, 0), cB + kstep, voffB); PG8_STAGE(PG8_SA(1, 0), cA + kstep, voffA); PG8_STAGE(PG8_SB(1, 1), cB + hstep + kstep, voffB);
        PG8_WAIT_V(6); PG8_BAR;
    }
    for (;;) {
        const bool has_next = S.next(ui + 1, nxt);
        const char* nA = has_next ? (const char*)g.A + (size_t)nxt.pm * tstep : cA; const char* nB = has_next ? (const char*)g.Bt + (size_t)nxt.pn * tstep : cB;
        for (int t = 0; t < nt; t += 2) {
            const bool last = (t == nt - 2);
            const char* a1 = cA + (size_t)(t + 1) * kstep;
            const char* a2 = last ? nA : cA + (size_t)(t + 2) * kstep; const char* b2 = last ? nB : cB + (size_t)(t + 2) * kstep;
            const char* a3 = a2 + kstep; const char* b3 = b2 + kstep;
            if (last && has_next) S.a_ready(nxt);
            if constexpr (SP2) {
            PG8_LDB(B0, 0, 0); PG8_LDB(B1, 0, 1); PG8_SCHED; PG8_LDA(At, 0, 0); PG8_STAGE(PG8_SA(1, 1), a1 + hstep, voffA);
            PG8_WAIT_V(8); PG8_WAIT_L(0); PG8_BAR; PG8_MMA(0, 0, At, B0); PG8_MMA(0, 1, At, B1); PG8_BAR; PG8_SCHED;
            PG8_LDA(At, 0, 1); PG8_STAGE(PG8_SB(0, 0), b2, voffB); PG8_STAGE(PG8_SB(0, 1), b2 + hstep, voffB); PG8_STAGE(PG8_SA(0, 0), a2, voffA);
            PG8_WAIT_V(8); PG8_WAIT_L(0); PG8_BAR; PG8_MMA(1, 0, At, B0); PG8_MMA(1, 1, At, B1); PG8_BAR; PG8_SCHED;
            PG8_LDB(B0, 1, 0); PG8_LDB(B1, 1, 1); PG8_SCHED; PG8_LDA(At, 1, 0); PG8_STAGE(PG8_SA(0, 1), a2 + hstep, voffA);
            PG8_WAIT_V(8); PG8_WAIT_L(0); PG8_BAR; PG8_MMA(0, 0, At, B0); PG8_MMA(0, 1, At, B1); PG8_BAR; PG8_SCHED;
            PG8_LDA(At, 1, 1); PG8_STAGE(PG8_SB(1, 0), b3, voffB); PG8_STAGE(PG8_SB(1, 1), b3 + hstep, voffB); PG8_STAGE(PG8_SA(1, 0), a3, voffA);
            PG8_WAIT_V(8); PG8_WAIT_L(0); PG8_BAR; PG8_MMA(1, 0, At, B0); PG8_MMA(1, 1, At, B1); PG8_BAR; PG8_SCHED;
            } else {
            PG8_LDB(B0, 0, 0); PG8_SCHED; PG8_LDA(At, 0, 0); PG8_STAGE(PG8_SA(1, 1), a1 + hstep, voffA);
            PG8_WAIT_L(8); PG8_BAR; PG8_WAIT_L(0); PG8_MMA(0, 0, At, B0); PG8_BAR; PG8_SCHED;
            PG8_LDB(B1, 0, 1); PG8_STAGE(PG8_SB(0, 0), b2, voffB);
            PG8_BAR; PG8_WAIT_L(0); PG8_MMA(0, 1, At, B1); PG8_BAR;
            PG8_LDA(At, 0, 1); PG8_STAGE(PG8_SA(0, 0), a2, voffA);
            PG8_BAR; PG8_WAIT_L(0); PG8_MMA(1, 0, At, B0); PG8_BAR; PG8_SCHED;
            PG8_STAGE(PG8_SB(0, 1), b2 + hstep, voffB);
            PG8_WAIT_V(6); PG8_BAR; PG8_MMA(1, 1, At, B1); PG8_BAR;
            PG8_LDB(B0, 1, 0); PG8_SCHED; PG8_LDA(At, 1, 0); PG8_STAGE(PG8_SA(0, 1), a2 + hstep, voffA);
            PG8_WAIT_L(8); PG8_BAR; PG8_WAIT_L(0); PG8_MMA(0, 0, At, B0); PG8_BAR; PG8_SCHED;
            PG8_LDB(B1, 1, 1); PG8_STAGE(PG8_SB(1, 0), b3, voffB);
            PG8_BAR; PG8_WAIT_L(0); PG8_MMA(0, 1, At, B1); PG8_BAR;
            PG8_LDA(At, 1, 1); PG8_STAGE(PG8_SA(1, 0), a3, voffA);
            PG8_BAR; PG8_WAIT_L(0); PG8_MMA(1, 0, At, B0); PG8_BAR; PG8_SCHED;
            PG8_STAGE(PG8_SB(1, 1), b3 + hstep, voffB);
            PG8_WAIT_V(6); PG8_BAR; PG8_MMA(1, 1, At, B1); PG8_BAR;
            }
        }
        if constexpr (ALIGN_EPI) { if (wr == 0) PG8_BAR; }
        if constexpr (!Epi::AFTER_DRAIN) { E(acc, cur, wr, wc, fr, fq); S.done(cur); }
        if (!has_next) break;
#pragma unroll
        for (int a = 0; a < 2; ++a)
#pragma unroll
            for (int b = 0; b < 2; ++b)
#pragma unroll
                for (int m = 0; m < 4; ++m)
#pragma unroll
                    for (int n = 0; n < 2; ++n) acc[a][b][m][n] = (f32x4){0.f, 0.f, 0.f, 0.f};
        cur = nxt; cA = nA; cB = nB; ++ui;
        if constexpr (ALIGN_EPI) { if (wr == 1) PG8_BAR; }
    }
    PG8_WAIT_V(0);
    if constexpr (!ALIGN_EPI) { if (wr == 0) PG8_BAR; }
    PG8_BAR;
    if constexpr (Epi::AFTER_DRAIN) { E.fused(acc, cur, wr, wc, fr, fq, lds, wid, lane); S.done(cur); }
#undef PG8_SA
#undef PG8_SB
#undef PG8_STAGE
#undef PG8_LDA
#undef PG8_LDB
#undef PG8_MMA
#undef PG8_WAIT_V
#undef PG8_WAIT_L
#undef PG8_BAR
#undef PG8_SCHED
}
}

DEV void phase_inproj(const Params& p, int l, int hf, int skew, unsigned char* smem) {
  pg8::Gemm g{(const bf16_t*)(p.ws + OFF_XB) + (size_t)hf * TH * DM, (const bf16_t*)(p.ws + OFF_WIN), TH, NPAD, DM};
  pg8::XcdOrder S; S.init(TH, NPAD, skew);
  pg8::EpiIn E{(bf16_t*)(p.ws + OFF_H), NPAD, (float*)(p.ws + OFF_SMALL), SM0 / 256};
  pg8::gemm_phase<pg8::EpiIn, pg8::XcdOrder, true, true>((PG8_LAS unsigned char*)smem, g, S, E);
}

DEV void phase_outproj(const Params& p, int l, int hf, unsigned char* smem) {
  pg8::Gemm g{(const bf16_t*)(p.ws + OFF_MIXED), (const bf16_t*)(p.ws + OFF_WOUT), TH, DM, DI};
  pg8::XcdOrder S; S.init(TH, DM);
  const float* xin = ((l == 0) ? p.x : p.out) + (size_t)hf * TH * DM;
  pg8::EpiOut E{xin, p.out + (size_t)hf * TH * DM, DM, DN_ALPHA};
  pg8::gemm_phase<pg8::EpiOut, pg8::XcdOrder, true, true>((PG8_LAS unsigned char*)smem, g, S, E);
}

DEV void phase_ln(const Params& p, int l, int hf) {
  const int tid = launder(threadIdx.x), lane = tid & 63, w = tid >> 6;
  const float* g = p.ln_g + l * DM; const float* b = p.ln_b + l * DM;
  bf16_t* xb = (bf16_t*)(p.ws + OFF_XB);
  for (int r0 = (blockIdx.x * 8 + w) * 4; r0 < TH; r0 += gridDim.x * 32) {
    f32x4 v[4][4];
#pragma unroll
    for (int i = 0; i < 4; ++i)
#pragma unroll
      for (int j = 0; j < 4; ++j) v[i][j] = ((const f32x4*)(p.out + (size_t)(hf * TH + r0 + i) * DM))[j * 64 + lane];
    f32x4 gg[4], bb[4];
#pragma unroll
    for (int j = 0; j < 4; ++j) { gg[j] = ((const f32x4*)g)[j * 64 + lane]; bb[j] = ((const f32x4*)b)[j * 64 + lane]; }
#pragma unroll
    for (int i = 0; i < 4; ++i) {
      const int row = hf * TH + r0 + i;
      float sm = 0.f;
#pragma unroll
      for (int j = 0; j < 4; ++j) sm += (v[i][j][0] + v[i][j][1]) + (v[i][j][2] + v[i][j][3]);
#pragma unroll
      for (int o = 32; o >= 1; o >>= 1) sm += __shfl_xor(sm, o);
      const float mu = sm * (1.f / DM);
      float q = 0.f;
#pragma unroll
      for (int j = 0; j < 4; ++j) { const f32x4 d = v[i][j] - mu; q += (d[0] * d[0] + d[1] * d[1]) + (d[2] * d[2] + d[3] * d[3]); }
#pragma unroll
      for (int o = 32; o >= 1; o >>= 1) q += __shfl_xor(q, o);
      const float rstd = rsqrtf(q * (1.f / DM) + 1e-5f);
#pragma unroll
      for (int j = 0; j < 4; ++j) {
        const f32x4 o = (v[i][j] - mu) * rstd * gg[j] + bb[j];
        ((f32x4*)(p.out + (size_t)row * DM))[j * 64 + lane] = o;
        if (l == 0) *(uint2*)(xb + (size_t)row * DM + (j * 64 + lane) * 4) = make_uint2(pk2(o[0], o[1]), pk2(o[2], o[3]));
      }
    }
  }
}

DEV void attn_item(const Params& p, int l, int item, unsigned char* smem) {
  const int tid = launder(threadIdx.x), lane = tid & 63, w = tid >> 6, r = lane & 31, h = lane >> 5;
  const int qt = item & 15, head = (item >> 4) & 7, bl = item >> 7;
  const int kvh = head >> 2;
  bf16_t* Hh = (bf16_t*)(p.ws + OFF_H);
  const bf16_t* VT = (const bf16_t*)(p.ws + OFF_VT);
  const size_t rowbase = (size_t)bl * SEQ;
  float mq = fabsf(p.q_gain[l * 64 + lane]), mk = fabsf(p.k_gain[l * 64 + lane]);
#pragma unroll
  for (int o = 32; o >= 1; o >>= 1) { mq = fmaxf(mq, __shfl_xor(mq, o)); mk = fmaxf(mk, __shfl_xor(mk, o)); }
  const float M2 = 8.f * mq * mk * LOG2E * 1.01f;
  const int qrow = qt * 256 + w * 32 + r;
  const bf16_t* qp = Hh + (rowbase + qrow) * NPAD + A_Q + head * 64 + 8 * h;
  bf16x8 qf[4];
#pragma unroll
  for (int ks = 0; ks < 4; ++ks) qf[ks] = *(const bf16x8*)(qp + ks * 16);
  f32x16 o0 = zero16(), o1 = zero16();
  f32x2_t lsum2 = {0.f, 0.f};
  const int srow = tid >> 3, sch = (tid & 7) * 8;
  const bf16_t* kp = Hh + (rowbase + srow) * NPAD + A_K + kvh * 64 + sch;
  const bf16_t* vp = VT + ((size_t)((bl * 2 + kvh) * 64 + srow)) * SEQ + sch;
  union PB { bf16x8 v; unsigned u[4]; };
  auto qk = [&](int st, f32x16& s0, f32x16& s1) __attribute__((always_inline)) {
    const bf16_t* sK = (const bf16_t*)(smem + st * 18432);
#pragma unroll
    for (int i = 0; i < 16; ++i) { s0[i] = -M2; s1[i] = -M2; }
#pragma unroll
    for (int ks = 0; ks < 4; ++ks) {
      const bf16x8 a0 = *(const bf16x8*)(sK + r * 72 + ks * 16 + 8 * h);
      const bf16x8 a1 = *(const bf16x8*)(sK + (32 + r) * 72 + ks * 16 + 8 * h);
      s0 = __builtin_amdgcn_mfma_f32_32x32x16_bf16(a0, qf[ks], s0, 0, 0, 0);
      s1 = __builtin_amdgcn_mfma_f32_32x32x16_bf16(a1, qf[ks], s1, 0, 0, 0);
    }
  };
  auto soft = [&](f32x16& s0, f32x16& s1, PB (&pb)[2][2]) __attribute__((always_inline)) {
#pragma unroll
    for (int i = 0; i < 16; ++i) { s0[i] = __builtin_amdgcn_exp2f(s0[i]); s1[i] = __builtin_amdgcn_exp2f(s1[i]); lsum2 += (f32x2_t){s0[i], s1[i]}; }
#pragma unroll
    for (int s = 0; s < 2; ++s)
#pragma unroll
      for (int j = 0; j < 4; ++j) {
        pb[0][s].u[j] = pk2(s0[8 * s + 2 * j], s0[8 * s + 2 * j + 1]);
        pb[1][s].u[j] = pk2(s1[8 * s + 2 * j], s1[8 * s + 2 * j + 1]);
      }
  };
  auto pv = [&](int st, const PB (&pb)[2][2]) __attribute__((always_inline)) {
    const bf16_t* sV = (const bf16_t*)(smem + st * 18432 + 9216);
#pragma unroll
    for (int kt2 = 0; kt2 < 2; ++kt2)
#pragma unroll
      for (int s = 0; s < 2; ++s) {
        const int kb = kt2 * 32 + 16 * s + 4 * h;
        union { bf16x8 v; uint2 u[2]; } a0, a1;
        a0.u[0] = *(const uint2*)(sV + r * 72 + kb); a0.u[1] = *(const uint2*)(sV + r * 72 + kb + 8);
        a1.u[0] = *(const uint2*)(sV + (32 + r) * 72 + kb); a1.u[1] = *(const uint2*)(sV + (32 + r) * 72 + kb + 8);
        o0 = __builtin_amdgcn_mfma_f32_32x32x16_bf16(a0.v, pb[kt2][s].v, o0, 0, 0, 0);
        o1 = __builtin_amdgcn_mfma_f32_32x32x16_bf16(a1.v, pb[kt2][s].v, o1, 0, 0, 0);
      }
  };
  auto compute2 = [&](int sta, int stb) __attribute__((always_inline)) {
    f32x16 sa0, sa1, sb0, sb1; PB pa[2][2], pbb[2][2];
    qk(sta, sa0, sa1); qk(stb, sb0, sb1);
    soft(sa0, sa1, pa); pv(sta, pa);
    soft(sb0, sb1, pbb); pv(stb, pbb);
  };
  constexpr int NKT = SEQ / 64;
  auto sstore = [&](int st, const u32x4& kk, const u32x4& vv) __attribute__((always_inline)) {
    *(u32x4*)(smem + st * 18432 + srow * 144 + sch * 2) = kk;
    *(u32x4*)(smem + st * 18432 + 9216 + srow * 144 + sch * 2) = vv;
  };
  u32x4 k0 = *(const u32x4*)kp, v0 = *(const u32x4*)vp;
  u32x4 k1 = *(const u32x4*)(kp + (size_t)64 * NPAD), v1 = *(const u32x4*)(vp + 64);
  sstore(0, k0, v0); sstore(1, k1, v1);
  k0 = *(const u32x4*)(kp + (size_t)2 * 64 * NPAD); v0 = *(const u32x4*)(vp + 2 * 64);
  k1 = *(const u32x4*)(kp + (size_t)3 * 64 * NPAD); v1 = *(const u32x4*)(vp + 3 * 64);
  lds_barrier();
  for (int kt = 0; kt < NKT; kt += 4) {
    sstore(2, k0, v0); sstore(3, k1, v1);
    if (kt + 4 < NKT) {
      k0 = *(const u32x4*)(kp + (size_t)(kt + 4) * 64 * NPAD); v0 = *(const u32x4*)(vp + (kt + 4) * 64);
      k1 = *(const u32x4*)(kp + (size_t)(kt + 5) * 64 * NPAD); v1 = *(const u32x4*)(vp + (kt + 5) * 64);
    }
    compute2(0, 1);
    lds_barrier();
    if (kt + 4 < NKT) {
      sstore(0, k0, v0); sstore(1, k1, v1);
      if (kt + 6 < NKT) {
        k0 = *(const u32x4*)(kp + (size_t)(kt + 6) * 64 * NPAD); v0 = *(const u32x4*)(vp + (kt + 6) * 64);
        k1 = *(const u32x4*)(kp + (size_t)(kt + 7) * 64 * NPAD); v1 = *(const u32x4*)(vp + (kt + 7) * 64);
      }
    }
    compute2(2, 3);
    lds_barrier();
  }
  float lsum = lsum2[0] + lsum2[1];
  lsum += __shfl_xor(lsum, 32);
  const float inv = 1.f / lsum;
  const bf16_t* zp = Hh + (rowbase + qrow) * NPAD + A_Z + head * 64;
  bf16_t* op = Hh + (rowbase + qrow) * NPAD + A_Q + head * 64;
#pragma unroll
  for (int dt = 0; dt < 2; ++dt)
#pragma unroll
    for (int g = 0; g < 4; ++g) {
      const int d0 = dt * 32 + 8 * g + 4 * h;
      const uint2 zz = *(const uint2*)(zp + d0);
      const float z0 = bf2f((bf16_t)(zz.x & 0xffff)), z1 = bf2f((bf16_t)(zz.x >> 16)), z2 = bf2f((bf16_t)(zz.y & 0xffff)), z3 = bf2f((bf16_t)(zz.y >> 16));
      const f32x16& oo = dt ? o1 : o0;
      uint2 ov;
      ov.x = pk2(oo[4 * g + 0] * inv * fsilu(z0), oo[4 * g + 1] * inv * fsilu(z1));
      ov.y = pk2(oo[4 * g + 2] * inv * fsilu(z2), oo[4 * g + 3] * inv * fsilu(z3));
      *(uint2*)(op + d0) = ov;
    }
  lds_barrier();
}

constexpr int L_QT = 0, L_KT = 17408, L_QC = 34816, L_KHT = 52224, L_VT = 70656, L_ST = 89088,
              L_D = 123904, L_TOT = 124416, L_ACS = 128512, L_DT = 129024;

template <int K, int V> struct ScanGeom {
  static constexpr int KP = K + 8;
  static constexpr int NS = (K / 32) * (V / 32) / 8;
};

template <int K, int V>
DEV void scan_write_state(unsigned char* smem, const f32x16* S, int w, int lane) {
  constexpr int KP = K + 8, NS = ScanGeom<K, V>::NS, NVT = V / 32;
  bf16_t* sST = (bf16_t*)(smem + L_ST);
  const int c = lane & 31, h = lane >> 5;
#pragma unroll
  for (int i = 0; i < NS; ++i) {
    const int tile = w * NS + i, kt = tile / NVT, nt = tile % NVT;
#pragma unroll
    for (int g = 0; g < 4; ++g) {
      uint2 o; o.x = pk2(S[i][4 * g + 0], S[i][4 * g + 1]); o.y = pk2(S[i][4 * g + 2], S[i][4 * g + 3]);
      *(uint2*)(sST + (nt * 32 + c) * KP + kt * 32 + 8 * g + 4 * h) = o;
    }
  }
}

template <int K, int V, bool SSDM>
DEV void scan_core(unsigned char* smem, f32x16* S, bf16_t* orow0, int dir, int w, int lane, bool do_out, const float* sAcs) {
  constexpr int KP = K + 8, NS = ScanGeom<K, V>::NS, NVT = V / 32, NOT = 2 * NVT;
  const bf16_t* sQt = (const bf16_t*)(smem + L_QT); const bf16_t* sKt = (const bf16_t*)(smem + L_KT);
  const bf16_t* sQc = (const bf16_t*)(smem + L_QC); const bf16_t* sKhT = (const bf16_t*)(smem + L_KHT);
  const bf16_t* sVT = (const bf16_t*)(smem + L_VT);
  const bf16_t* sST = (const bf16_t*)(smem + L_ST); const float* sD = (const float*)(smem + L_D);
  const int c = lane & 31, h = lane >> 5;
  if (do_out && w < NOT) {
    const int tt = w / NVT, nt = w % NVT;
    f32x16 acc = zero16();
#pragma unroll
    for (int st = 0; st < 2; ++st) {
      if (st <= tt) {
        f32x16 pt = zero16();
        mma32<K>(pt, sKt + st * 32 * KP, KP, sQt + tt * 32 * KP, KP, lane);
        const int tau = tt * 32 + c;
        const float at = SSDM ? sAcs[tau] : 0.f;
#pragma unroll
        for (int reg = 0; reg < 16; ++reg) {
          const int sig = st * 32 + rowoff(reg, h);
          float v = pt[reg];
          if (SSDM) v *= ex2(at - sAcs[sig]);
          pt[reg] = (sig <= tau) ? v : 0.f;
        }
#pragma unroll
        for (int s2 = 0; s2 < 2; ++s2) {
          union { bf16x8 v; unsigned u[4]; } pa;
#pragma unroll
          for (int j = 0; j < 4; ++j) pa.u[j] = pk2(pt[8 * s2 + 2 * j], pt[8 * s2 + 2 * j + 1]);
          const int kb = st * 32 + 16 * s2 + 4 * h;
          union { bf16x8 v; uint2 u[2]; } vb;
          vb.u[0] = *(const uint2*)(sVT + (nt * 32 + c) * 72 + kb); vb.u[1] = *(const uint2*)(sVT + (nt * 32 + c) * 72 + kb + 8);
          acc = __builtin_amdgcn_mfma_f32_32x32x16_bf16(pa.v, vb.v, acc, 0, 0, 0);
        }
      }
    }
    mma32<K>(acc, sQc + tt * 32 * KP, KP, sST + nt * 32 * KP, KP, lane);
#pragma unroll
    for (int reg = 0; reg < 16; ++reg) {
      const int tau = tt * 32 + rowoff(reg, h);
      const int tok = dir ? (63 - tau) : tau;
      orow0[(size_t)tok * 512 + nt * 32 + c] = f2bf(acc[reg]);
    }
  }
#pragma unroll
  for (int i = 0; i < NS; ++i) {
    const int tile = w * NS + i, kt = tile / NVT, nt = tile % NVT;
#pragma unroll
    for (int reg = 0; reg < 16; ++reg) S[i][reg] *= sD[kt * 32 + rowoff(reg, h)];
    mma32<64>(S[i], sKhT + kt * 32 * 72, 72, sVT + nt * 32 * 72, 72, lane);
  }
}

template <int K, int V>
DEV void state_store(float* buf, const f32x16* S, int w, int lane) {
  constexpr int NS = ScanGeom<K, V>::NS, NVT = V / 32;
  const int c = lane & 31, h = lane >> 5;
#pragma unroll
  for (int i = 0; i < NS; ++i) {
    const int tile = w * NS + i, kt = tile / NVT, nt = tile % NVT;
#pragma unroll
    for (int reg = 0; reg < 16; ++reg) buf[(kt * 32 + rowoff(reg, h)) * V + nt * 32 + c] = S[i][reg];
  }
}
template <int K, int V>
DEV void state_load(const float* buf, f32x16* S, int w, int lane) {
  constexpr int NS = ScanGeom<K, V>::NS, NVT = V / 32;
  const int c = lane & 31, h = lane >> 5;
#pragma unroll
  for (int i = 0; i < NS; ++i) {
    const int tile = w * NS + i, kt = tile / NVT, nt = tile % NVT;
#pragma unroll
    for (int reg = 0; reg < 16; ++reg) S[i][reg] = buf[(kt * 32 + rowoff(reg, h)) * V + nt * 32 + c];
  }
}

template <int K, int V>
DEV void state_combine(const float* ubase, int ustride, const float* dbase, int seg, f32x16* S, int w, int lane) {
  constexpr int NS = ScanGeom<K, V>::NS, NVT = V / 32;
  const int c = lane & 31, h = lane >> 5;
  for (int j = 0; j < seg; ++j) {
    const float* buf = ubase + (size_t)j * ustride;
    const float* dj = dbase + j * 128;
#pragma unroll
    for (int i = 0; i < NS; ++i) {
      const int tile = w * NS + i, kt = tile / NVT, nt = tile % NVT;
#pragma unroll
      for (int reg = 0; reg < 16; ++reg) {
        const int k = kt * 32 + rowoff(reg, h);
        const float u = buf[k * V + nt * 32 + c];
        S[i][reg] = (j > 0 ? dj[k] * S[i][reg] : 0.f) + u;
      }
    }
  }
}

#define PACK8_LO(v) (u32x4){((v)[0] & 0xffffu) | ((v)[1] << 16), ((v)[2] & 0xffffu) | ((v)[3] << 16), ((v)[4] & 0xffffu) | ((v)[5] << 16), ((v)[6] & 0xffffu) | ((v)[7] << 16)}
#define PACK8_HI(v) (u32x4){((v)[0] >> 16) | ((v)[1] & 0xffff0000u), ((v)[2] >> 16) | ((v)[3] & 0xffff0000u), ((v)[4] >> 16) | ((v)[5] & 0xffff0000u), ((v)[6] >> 16) | ((v)[7] & 0xffff0000u)}
#define CVT8(f) (u32x4){pk2((f)[0], (f)[1]), pk2((f)[2], (f)[3]), pk2((f)[4], (f)[5]), pk2((f)[6], (f)[7])}


DEV void hgrn_item(const Params& p, int l, int it, int seg, int mode, unsigned char* smem) {
  const int bl = it >> 3, head = (it >> 1) & 3, dir = it & 1;
  const bool do_out = (mode == 3);
  constexpr int K = 128, V = 128, KPW = 68;
  const int tid = launder(threadIdx.x), lane = tid & 63, w = tid >> 6;
  const int cp = tid & 63, tg = tid >> 6, ch0 = 2 * cp;
  const bf16_t* Hh = (const bf16_t*)(p.ws + OFF_H);
  bf16_t* OB = (bf16_t*)(p.ws + OFF_OBUF) + (size_t)(0 * 2 + dir) * TH * 512;
  const size_t rowbase = (size_t)bl * SEQ;
  float lb0 = 0.f, lb1 = 0.f;
  if (l > 0) {
    lb0 = fsigmoid(p.lb_logits[512 + head * 128 + ch0] - p.lb_logits[head * 128 + ch0]);
    lb1 = fsigmoid(p.lb_logits[512 + head * 128 + ch0 + 1] - p.lb_logits[head * 128 + ch0 + 1]);
  }
  const float om0 = 1.f - lb0, om1 = 1.f - lb1;
  const int fbase = dir ? H_FB : H_FF;
  unsigned* sQt = (unsigned*)(smem + L_QT); unsigned* sKt = (unsigned*)(smem + L_KT); unsigned* sQc = (unsigned*)(smem + L_QC);
  bf16_t* sKhT = (bf16_t*)(smem + L_KHT); bf16_t* sVT = (bf16_t*)(smem + L_VT);
  float* sD = (float*)(smem + L_D); float* sTot = (float*)(smem + L_TOT);
  f32x16 S[2]; S[0] = zero16(); S[1] = zero16();
  float* sbuf = (float*)(p.ws + OFF_SB0) + ((size_t)it * NSEG + seg) * 16384;
  if (do_out) state_combine<K, V>((const float*)(p.ws + OFF_SB0) + (size_t)it * NSEG * 16384, 16384, (const float*)(p.ws + OFF_DB) + (size_t)it * NSEG * 128, seg, S, w, lane);
  float dlog0 = 0.f, dlog1 = 0.f;
  unsigned pf[8], qq[8], vv[8];
  float g0[8], g1[8], kx0[8], kx1[8];
  auto gloadA = [&](int cidx) __attribute__((always_inline)) {
    const int chunk = dir ? (63 - cidx) : cidx;
#pragma unroll
    for (int i = 0; i < 8; ++i) {
      const int tau = 8 * tg + i;
      const int tok = chunk * 64 + (dir ? (63 - tau) : tau);
      pf[i] = ((const unsigned*)(Hh + (rowbase + tok) * NPAD + head * 128 + fbase))[cp];
    }
  };
  auto gloadB = [&](int cidx) __attribute__((always_inline)) {
    const int chunk = dir ? (63 - cidx) : cidx;
#pragma unroll
    for (int i = 0; i < 8; ++i) {
      const int tau = 8 * tg + i;
      const int tok = chunk * 64 + (dir ? (63 - tau) : tau);
      const unsigned* rp = (const unsigned*)(Hh + (rowbase + tok) * NPAD + head * 128) + cp;
      vv[i] = rp[H_I / 2];
      qq[i] = do_out ? rp[H_Q / 2] : 0u;
    }
  };
  auto stage1 = [&]() __attribute__((always_inline)) {
    float r0 = 0.f, r1 = 0.f;
#pragma unroll
    for (int i = 0; i < 8; ++i) {
      const float e0 = ex2(fminf(-lo16(pf[i]) * LOG2E, 80.f)), e1 = ex2(fminf(-hi16(pf[i]) * LOG2E, 80.f));
      const float s0 = frcp(1.f + e0), s1 = frcp(1.f + e1);
      r0 += lg2(lb0 + om0 * s0); r1 += lg2(lb1 + om1 * s1);
      g0[i] = r0; g1[i] = r1;
      kx0[i] = om0 * e0 * s0; kx1[i] = om1 * e1 * s1;
    }
    *(float2*)(sTot + tg * 128 + ch0) = make_float2(r0, r1);
  };
  gloadA(seg * SLEN); gloadB(seg * SLEN);
  stage1();
  if (SLEN > 1) gloadA(seg * SLEN + 1);
  for (int ci = 0; ci < SLEN; ++ci) {
    const int cidx = seg * SLEN + ci;
    const int chunk = dir ? (63 - cidx) : cidx;
    lds_barrier();
    float off0 = 0.f, off1 = 0.f, ref0 = 0.f, ref1 = 0.f, be0 = 0.f, be1 = 0.f;
#pragma unroll
    for (int j = 0; j < 8; ++j) {
      const float2 t = *(const float2*)(sTot + j * 128 + ch0);
      if (j < tg) { off0 += t.x; off1 += t.y; }
      if (j < 4) { ref0 += t.x; ref1 += t.y; }
      be0 += t.x; be1 += t.y;
    }
    dlog0 += be0; dlog1 += be1;
    const float eref0 = ex2(ref0), eref1 = ex2(ref1), ebr0 = ex2(be0 - ref0), ebr1 = ex2(be1 - ref1);
    const float d0 = off0 - ref0, d1 = off1 - ref1;
    float kh0[8], kh1[8];
#pragma unroll
    for (int i = 0; i < 8; ++i) {
      const int tau = 8 * tg + i;
      const float E0 = ex2(g0[i] + d0), E1 = ex2(g1[i] + d1);
      const float kt0 = kx0[i] * frcp(E0), kt1 = kx1[i] * frcp(E1);
      if (do_out) {
        const float qt0 = lo16(qq[i]) * E0, qt1 = hi16(qq[i]) * E1;
        sQt[tau * KPW + cp] = pk2(qt0, qt1);
        sKt[tau * KPW + cp] = pk2(kt0, kt1);
        sQc[tau * KPW + cp] = pk2(qt0 * eref0, qt1 * eref1);
      }
      kh0[i] = kt0 * ebr0; kh1[i] = kt1 * ebr1;
    }
    *(u32x4*)(sKhT + ch0 * 72 + 8 * tg) = CVT8(kh0);
    *(u32x4*)(sKhT + (ch0 + 1) * 72 + 8 * tg) = CVT8(kh1);
    *(u32x4*)(sVT + ch0 * 72 + 8 * tg) = PACK8_LO(vv);
    *(u32x4*)(sVT + (ch0 + 1) * 72 + 8 * tg) = PACK8_HI(vv);
    if (tg == 0) *(float2*)(sD + ch0) = make_float2(ex2(be0), ex2(be1));
    if (do_out) scan_write_state<K, V>(smem, S, w, lane);
    if (ci + 1 < SLEN) gloadB(cidx + 1);
    lds_barrier();
    scan_core<K, V, false>(smem, S, OB + (rowbase + (size_t)chunk * 64) * 512 + head * 128, dir, w, lane, do_out, nullptr);
    if (ci + 1 < SLEN) { stage1(); if (ci + 2 < SLEN) gloadA(cidx + 2); }
  }
  if (!do_out) {
    state_store<K, V>(sbuf, S, w, lane);
    if (tg == 0) *(float2*)((float*)(p.ws + OFF_DB) + ((size_t)it * NSEG + seg) * 128 + ch0) = make_float2(ex2(dlog0), ex2(dlog1));
  }
  lds_barrier();
}

DEV void gla_item(const Params& p, int l, int it, int seg, int mode, unsigned char* smem) {
  const int j16 = it - 16, bl = j16 >> 3, head = (j16 >> 1) & 3, dir = j16 & 1;
  const bool do_out = (mode == 3);
  constexpr int K = 64, V = 128, KPW = 36;
  const int tid = launder(threadIdx.x), lane = tid & 63, w = tid >> 6;
  const int cp = tid & 31, tg = tid >> 5, ch0 = 2 * cp;
  const int vp2 = tid & 63, vg = tid >> 6;
  const bf16_t* Hh = (const bf16_t*)(p.ws + OFF_H);
  const bf16_t* Gb = (const bf16_t*)(p.ws + OFF_G);
  bf16_t* OB = (bf16_t*)(p.ws + OFF_OBUF) + (size_t)(2 * 2 + dir) * TH * 512;
  const size_t rowbase = (size_t)bl * SEQ;
  unsigned* sQt = (unsigned*)(smem + L_QT); unsigned* sKt = (unsigned*)(smem + L_KT); unsigned* sQc = (unsigned*)(smem + L_QC);
  bf16_t* sKhT = (bf16_t*)(smem + L_KHT); bf16_t* sVT = (bf16_t*)(smem + L_VT);
  float* sD = (float*)(smem + L_D); float* sTot = (float*)(smem + L_TOT);
  f32x16 S[1]; S[0] = zero16();
  float* sbuf = (float*)(p.ws + OFF_SB1) + ((size_t)j16 * NSEG + seg) * 8192;
  if (do_out) state_combine<K, V>((const float*)(p.ws + OFF_SB1) + (size_t)j16 * NSEG * 8192, 8192, (const float*)(p.ws + OFF_DB) + (size_t)it * NSEG * 128, seg, S, w, lane);
  float dlog0 = 0.f, dlog1 = 0.f;
  unsigned pg[4];
  float g0[4], g1[4]; unsigned kk[4], qq[4], vv[8];
  auto gloadA = [&](int cidx) __attribute__((always_inline)) {
    const int chunk = dir ? (63 - cidx) : cidx;
#pragma unroll
    for (int i = 0; i < 4; ++i) {
      const int tau = 4 * tg + i;
      const int tok = chunk * 64 + (dir ? (63 - tau) : tau);
      pg[i] = ((const unsigned*)(Gb + (rowbase + tok) * 512 + dir * 256 + head * 64))[cp];
    }
  };
  auto gloadB = [&](int cidx) __attribute__((always_inline)) {
    const int chunk = dir ? (63 - cidx) : cidx;
#pragma unroll
    for (int i = 0; i < 4; ++i) {
      const int tau = 4 * tg + i;
      const int tok = chunk * 64 + (dir ? (63 - tau) : tau);
      const unsigned* rp = (const unsigned*)(Hh + (rowbase + tok) * NPAD + head * 64) + cp;
      kk[i] = rp[G_K / 2]; qq[i] = do_out ? rp[G_Q / 2] : 0u;
    }
#pragma unroll
    for (int i = 0; i < 8; ++i) {
      const int tau = 8 * vg + i;
      const int tok = chunk * 64 + (dir ? (63 - tau) : tau);
      vv[i] = ((const unsigned*)(Hh + (rowbase + tok) * NPAD + G_V + head * 128))[vp2];
    }
  };
  auto stage1 = [&]() __attribute__((always_inline)) {
    float r0 = 0.f, r1 = 0.f;
#pragma unroll
    for (int i = 0; i < 4; ++i) { r0 += lo16(pg[i]); r1 += hi16(pg[i]); g0[i] = r0; g1[i] = r1; }
    *(float2*)(sTot + tg * 64 + ch0) = make_float2(r0, r1);
  };
  gloadA(seg * SLEN); gloadB(seg * SLEN);
  stage1();
  if (SLEN > 1) gloadA(seg * SLEN + 1);
  for (int ci = 0; ci < SLEN; ++ci) {
    const int cidx = seg * SLEN + ci;
    const int chunk = dir ? (63 - cidx) : cidx;
    lds_barrier();
    float off0 = 0.f, off1 = 0.f, ref0 = 0.f, ref1 = 0.f, be0 = 0.f, be1 = 0.f;
#pragma unroll
    for (int j = 0; j < 16; ++j) {
      const float2 t = *(const float2*)(sTot + j * 64 + ch0);
      if (j < tg) { off0 += t.x; off1 += t.y; }
      if (j < 8) { ref0 += t.x; ref1 += t.y; }
      be0 += t.x; be1 += t.y;
    }
    dlog0 += be0; dlog1 += be1;
    const float eref0 = ex2(ref0), eref1 = ex2(ref1), ebr0 = ex2(be0 - ref0), ebr1 = ex2(be1 - ref1);
    const float d0 = off0 - ref0, d1 = off1 - ref1;
    float kh0[4], kh1[4];
#pragma unroll
    for (int i = 0; i < 4; ++i) {
      const int tau = 4 * tg + i;
      const float E0 = ex2(g0[i] + d0), E1 = ex2(g1[i] + d1);
      const float kt0 = lo16(kk[i]) * frcp(E0), kt1 = hi16(kk[i]) * frcp(E1);
      if (do_out) {
        const float qt0 = lo16(qq[i]) * E0, qt1 = hi16(qq[i]) * E1;
        sQt[tau * KPW + cp] = pk2(qt0, qt1);
        sKt[tau * KPW + cp] = pk2(kt0, kt1);
        sQc[tau * KPW + cp] = pk2(qt0 * eref0, qt1 * eref1);
      }
      kh0[i] = kt0 * ebr0; kh1[i] = kt1 * ebr1;
    }
    *(uint2*)(sKhT + ch0 * 72 + 4 * tg) = make_uint2(pk2(kh0[0], kh0[1]), pk2(kh0[2], kh0[3]));
    *(uint2*)(sKhT + (ch0 + 1) * 72 + 4 * tg) = make_uint2(pk2(kh1[0], kh1[1]), pk2(kh1[2], kh1[3]));
    *(u32x4*)(sVT + (2 * vp2) * 72 + 8 * vg) = PACK8_LO(vv);
    *(u32x4*)(sVT + (2 * vp2 + 1) * 72 + 8 * vg) = PACK8_HI(vv);
    if (tg == 0) *(float2*)(sD + ch0) = make_float2(ex2(be0), ex2(be1));
    if (do_out) scan_write_state<K, V>(smem, S, w, lane);
    if (ci + 1 < SLEN) gloadB(cidx + 1);
    lds_barrier();
    scan_core<K, V, false>(smem, S, OB + (rowbase + (size_t)chunk * 64) * 512 + head * 128, dir, w, lane, do_out, nullptr);
    if (ci + 1 < SLEN) { stage1(); if (ci + 2 < SLEN) gloadA(cidx + 2); }
  }
  if (!do_out) {
    state_store<K, V>(sbuf, S, w, lane);
    if (tg == 0) *(float2*)((float*)(p.ws + OFF_DB) + ((size_t)it * NSEG + seg) * 128 + ch0) = make_float2(ex2(dlog0), ex2(dlog1));
  }
  lds_barrier();
}

DEV void ssd_item(const Params& p, int l, int it, int seg, int mode, unsigned char* smem) {
  const int j32 = it - 32, bl = j32 >> 4, head = (j32 >> 1) & 7, dir = j32 & 1;
  const bool do_out = (mode == 3);
  constexpr int K = 128, V = 64, KPW = 68;
  const int tid = launder(threadIdx.x), lane = tid & 63, w = tid >> 6;
  const int cp = tid & 63, tg = tid >> 6, n0 = 2 * cp;
  const int xp = tid & 31, xg = tid >> 5;
  const int grp = head >> 2;
  const bf16_t* U = (const bf16_t*)(p.ws + OFF_U);
  const float* SMALL = (const float*)(p.ws + OFF_SMALL);
  bf16_t* OB = (bf16_t*)(p.ws + OFF_OBUF) + (size_t)(1 * 2 + dir) * TH * 512;
  const size_t rowbase = (size_t)bl * SEQ;
  unsigned* sQt = (unsigned*)(smem + L_QT); unsigned* sKt = (unsigned*)(smem + L_KT); unsigned* sQc = (unsigned*)(smem + L_QC);
  bf16_t* sKhT = (bf16_t*)(smem + L_KHT); bf16_t* sVT = (bf16_t*)(smem + L_VT);
  float* sD = (float*)(smem + L_D);
  const float dtb = p.dt_bias[(l * 2 + dir) * 8 + head];
  const float Acoef = -__expf(p.a_log[(l * 2 + dir) * 8 + head]) * LOG2E;
  f32x16 S[1]; S[0] = zero16();
  float* sbuf = (float*)(p.ws + OFF_SB2) + ((size_t)j32 * NSEG + seg) * 8192;
  if (do_out) state_combine<K, V>((const float*)(p.ws + OFF_SB2) + (size_t)j32 * NSEG * 8192, 8192, (const float*)(p.ws + OFF_DB) + (size_t)it * NSEG * 128, seg, S, w, lane);
  float dlog = 0.f;
  unsigned bb[8], cc[8], xx[4];
  float rdt = 0.f;
  auto gloadA = [&](int cidx) __attribute__((always_inline)) {
    const int chunk = dir ? (63 - cidx) : cidx;
    if (w == 0) {
      const int tok = chunk * 64 + (dir ? (63 - lane) : lane);
      rdt = SMALL[(rowbase + tok) * 48 + dir * 8 + head];
    }
  };
  auto gloadB = [&](int cidx) __attribute__((always_inline)) {
    const int chunk = dir ? (63 - cidx) : cidx;
#pragma unroll
    for (int i = 0; i < 8; ++i) {
      const int tau = 8 * tg + i;
      const int tok = chunk * 64 + (dir ? (63 - tau) : tau);
      const unsigned* rp = (const unsigned*)(U + (rowbase + tok) * 1024 + grp * 128) + cp;
      bb[i] = rp[512 / 2]; cc[i] = do_out ? rp[768 / 2] : 0u;
    }
#pragma unroll
    for (int i = 0; i < 4; ++i) {
      const int tau = 4 * xg + i;
      const int tok = chunk * 64 + (dir ? (63 - tau) : tau);
      xx[i] = ((const unsigned*)(U + (rowbase + tok) * 1024 + head * 64))[xp];
    }
  };
  auto stage1 = [&](int par) __attribute__((always_inline)) {
    if (w == 0) {
      const float xv = rdt + dtb;
      const float dt = (xv > 20.f) ? xv : log1pf(__expf(xv));
      float a = dt * Acoef;
#pragma unroll
      for (int o = 1; o < 64; o <<= 1) { const float t = __shfl_up(a, o); if (lane >= o) a += t; }
      ((float*)(smem + L_ACS))[par * 64 + lane] = a; ((float*)(smem + L_DT))[par * 64 + lane] = dt;
    }
  };
  gloadA(seg * SLEN); gloadB(seg * SLEN);
  stage1(0);
  if (SLEN > 1) gloadA(seg * SLEN + 1);
  for (int ci = 0; ci < SLEN; ++ci) {
    const int cidx = seg * SLEN + ci;
    const int chunk = dir ? (63 - cidx) : cidx;
    const float* sAcs = (const float*)(smem + L_ACS) + (ci & 1) * 64;
    const float* sDt = (const float*)(smem + L_DT) + (ci & 1) * 64;
    lds_barrier();
    const float aend = sAcs[63];
    dlog += aend;
    {
      float kh0[8], kh1[8];
#pragma unroll
      for (int i = 0; i < 8; ++i) {
        const int tau = 8 * tg + i;
        const float ac = sAcs[tau];
        const float eb = ex2(aend - ac);
        kh0[i] = lo16(bb[i]) * eb; kh1[i] = hi16(bb[i]) * eb;
        if (do_out) {
          const float ea = ex2(ac);
          sKt[tau * KPW + cp] = bb[i];
          sQt[tau * KPW + cp] = cc[i];
          sQc[tau * KPW + cp] = pk2(lo16(cc[i]) * ea, hi16(cc[i]) * ea);
        }
      }
      *(u32x4*)(sKhT + n0 * 72 + 8 * tg) = CVT8(kh0);
      *(u32x4*)(sKhT + (n0 + 1) * 72 + 8 * tg) = CVT8(kh1);
      float x0[4], x1[4];
#pragma unroll
      for (int i = 0; i < 4; ++i) { const float dtv = sDt[4 * xg + i]; x0[i] = lo16(xx[i]) * dtv; x1[i] = hi16(xx[i]) * dtv; }
      *(uint2*)(sVT + (2 * xp) * 72 + 4 * xg) = make_uint2(pk2(x0[0], x0[1]), pk2(x0[2], x0[3]));
      *(uint2*)(sVT + (2 * xp + 1) * 72 + 4 * xg) = make_uint2(pk2(x1[0], x1[1]), pk2(x1[2], x1[3]));
      if (tg == 0) *(float2*)(sD + n0) = make_float2(ex2(aend), ex2(aend));
    }
    if (do_out) scan_write_state<K, V>(smem, S, w, lane);
    if (ci + 1 < SLEN) gloadB(cidx + 1);
    lds_barrier();
    scan_core<K, V, true>(smem, S, OB + (rowbase + (size_t)chunk * 64) * 512 + head * 64, dir, w, lane, do_out, sAcs);
    if (ci + 1 < SLEN) { stage1((ci + 1) & 1); if (ci + 2 < SLEN) gloadA(cidx + 2); }
  }
  if (!do_out) {
    state_store<K, V>(sbuf, S, w, lane);
    if (tg == 0) *(float2*)((float*)(p.ws + OFF_DB) + ((size_t)it * NSEG + seg) * 128 + n0) = make_float2(ex2(dlog), ex2(dlog));
  }
  lds_barrier();
}

DEV void phase_prep(const Params& p, int l, int hf, int rep, unsigned char* smem) {
  const int tid = launder(threadIdx.x), lane = tid & 63;
  bf16_t* Hh = (bf16_t*)(p.ws + OFF_H);
  bf16_t* U = (bf16_t*)(p.ws + OFF_U);
  bf16_t* Gb = (bf16_t*)(p.ws + OFF_G);
  bf16_t* VT = (bf16_t*)(p.ws + OFF_VT);
  const float* SMALLp = (const float*)(p.ws + OFF_SMALL);
  float2* stab = (float2*)smem;
  float* slow = (float*)(smem + 8192);
  bf16_t* sT = (bf16_t*)(smem + 12288);
  {
    const float2* tabg = (const float2*)(p.ws + OFF_TAB);
    for (int i = tid; i < 1024; i += NT) stab[i] = tabg[i];
  }
  const int cg8 = (tid & 127) * 8, rsub = tid >> 7;
  const float* cw = p.conv_w + (size_t)l * 5 * 1024; const float* cb = p.conv_b + (size_t)l * 1024;
  float wv[5][8], bv[8];
#pragma unroll
  for (int j = 0; j < 5; ++j)
#pragma unroll
    for (int e = 0; e < 8; ++e) wv[j][e] = cw[j * 1024 + cg8 + e];
#pragma unroll
  for (int e = 0; e < 8; ++e) bv[e] = cb[cg8 + e];
  const int gd = tid >> 8, gc = tid & 255;
  const int i16 = lane & 15;
  const float* gq = p.q_gain + l * 64 + 4 * i16; const float* gk = p.k_gain + l * 64 + 4 * i16;
  const float gqv[4] = {gq[0], gq[1], gq[2], gq[3]}, gkv[4] = {gk[0], gk[1], gk[2], gk[3]};
  for (int grp = blockIdx.x; grp < TH / 32; grp += gridDim.x) {
    const int r0 = grp * 32;
    lds_barrier();
    const u32x4 vt = *(const u32x4*)(Hh + (size_t)(r0 + (tid >> 4)) * NPAD + A_V + (tid & 15) * 8);
    const float2 lowv = *(const float2*)(SMALLp + (size_t)(r0 + (tid >> 4)) * 48 + 16 + (tid & 15) * 2);
    *(u32x4*)(sT + (tid >> 4) * 136 + (tid & 15) * 8) = vt;
    *(float2*)(slow + (tid >> 4) * 32 + (tid & 15) * 2) = lowv;
#pragma unroll 1
    for (int ps = 0; ps < 2; ++ps) {
      const int ra = r0 + 16 * ps + 4 * rsub, ta = ra & (SEQ - 1);
      u32x4 xc[8];
#pragma unroll
      for (int m = 0; m < 8; ++m) {
        const int sq = ta + m - 2;
        xc[m] = (u32x4){0u, 0u, 0u, 0u};
        if (sq >= 0 && sq < SEQ) xc[m] = *(const u32x4*)(Hh + (size_t)(ra + m - 2) * NPAD + S_X + cg8);
      }
#pragma unroll
      for (int o4 = 0; o4 < 4; ++o4) {
        float u[8];
#pragma unroll
        for (int e = 0; e < 8; ++e) u[e] = bv[e];
#pragma unroll
        for (int j = 0; j < 5; ++j)
#pragma unroll
          for (int e = 0; e < 4; ++e) { u[2 * e] += wv[j][2 * e] * lo16(xc[o4 + j][e]); u[2 * e + 1] += wv[j][2 * e + 1] * hi16(xc[o4 + j][e]); }
        u32x4 o;
#pragma unroll
        for (int e = 0; e < 4; ++e) {
          const float a = u[2 * e] * frcp(1.f + ex2(fminf(-u[2 * e] * LOG2E, 80.f)));
          const float b = u[2 * e + 1] * frcp(1.f + ex2(fminf(-u[2 * e + 1] * LOG2E, 80.f)));
          o[e] = pk2(a, b);
        }
        *(u32x4*)(U + (size_t)(ra + o4) * 1024 + cg8) = o;
      }
    }
    lds_barrier();
    if (rep == 0) {
#pragma unroll 1
      for (int ub = 0; ub < 10; ub += 5) {
        uint2 xq[5];
#pragma unroll
        for (int u = 0; u < 5; ++u) {
          const int pi = (ub + u) * 32 + (tid >> 4), row = r0 + pi / 10, hd = pi % 10;
          xq[u] = *(const uint2*)(Hh + (size_t)row * NPAD + ((hd < 8) ? (A_Q + hd * 64) : (A_K + (hd - 8) * 64)) + 4 * i16);
        }
#pragma unroll
        for (int u = 0; u < 5; ++u) {
          const int pi = (ub + u) * 32 + (tid >> 4), row = r0 + pi / 10, hd = pi % 10;
          const bool isq = hd < 8;
          const float x[4] = {lo16(xq[u].x), hi16(xq[u].x), lo16(xq[u].y), hi16(xq[u].y)};
          float ss = x[0] * x[0] + x[1] * x[1] + x[2] * x[2] + x[3] * x[3];
          ss += __shfl_xor(ss, 1); ss += __shfl_xor(ss, 2); ss += __shfl_xor(ss, 4); ss += __shfl_xor(ss, 8);
          const float rstd = rsqrtf(ss * (1.f / 64.f) + 1e-6f);
          const int t = row & (SEQ - 1);
          const int pos = (i16 < 8) ? (t >> 6) : (t & 63);
          const float osc = isq ? QSCALE : 1.f;
          float o[4];
#pragma unroll
          for (int e = 0; e < 4; ++e) {
            const float v = x[e] * rstd * (isq ? gqv[e] : gkv[e]);
            const float pv = __shfl_xor(v, 4);
            const float2 cs = stab[pos * 16 + 4 * (i16 & 3) + e];
            o[e] = ((i16 & 4) ? (v * cs.x + pv * cs.y) : (v * cs.x - pv * cs.y)) * osc;
          }
          *(uint2*)(Hh + (size_t)row * NPAD + (isq ? (A_Q + hd * 64) : (A_K + (hd - 8) * 64)) + 4 * i16) = make_uint2(pk2(o[0], o[1]), pk2(o[2], o[3]));
        }
      }
    }
    float w2c[16];
#pragma unroll
    for (int r = 0; r < 16; ++r) w2c[r] = p.gk_w2[((size_t)(l * 2 + gd) * 16 + r) * 256 + gc];
    const float gbias = p.gk_b[(l * 2 + gd) * 256 + gc];
#pragma unroll 4
    for (int rr = 0; rr < 32; ++rr) {
      const float4* lp4 = (const float4*)(slow + rr * 32 + gd * 16);
      float gkk = gbias;
#pragma unroll
      for (int r4 = 0; r4 < 4; ++r4) { const float4 lw = lp4[r4]; gkk += lw.x * w2c[4 * r4] + lw.y * w2c[4 * r4 + 1] + lw.z * w2c[4 * r4 + 2] + lw.w * w2c[4 * r4 + 3]; }
      const float l2 = (fminf(gkk, 0.f) * LOG2E - lg2(1.f + ex2(-fabsf(gkk) * LOG2E))) * (1.f / 16.f);
      Gb[(size_t)(r0 + rr) * 512 + tid] = f2bf(l2);
    }
    {
      const int c = tid >> 2, tq = (tid & 3) * 8;
      unsigned v[8];
#pragma unroll
      for (int i = 0; i < 8; ++i) v[i] = sT[(tq + i) * 136 + c];
      const int bl = r0 >> 12, t0 = (r0 & (SEQ - 1)) + tq;
      *(u32x4*)(VT + ((size_t)((bl * 2 + (c >> 6)) * 64 + (c & 63))) * SEQ + t0) = (u32x4){v[0] | (v[1] << 16), v[2] | (v[3] << 16), v[4] | (v[5] << 16), v[6] | (v[7] << 16)};
    }
  }
  lds_barrier();
}

DEV void phase_mix(const Params& p, int l, int hf, int slot, int mode, int att_lo, int att_hi, int vid_lo, int vid_hi, unsigned char* smem) {
  unsigned* ctr = (unsigned*)(p.ws + OFF_CTRL) + CTR_WORD0 + slot * 16;
  volatile int* sItem = (volatile int*)(smem + LDS_BYTES - 16);
  const int n_scan = 64 * NSEG;
  int hi = n_scan + (att_hi - att_lo); if (vid_hi < hi) hi = vid_hi;
  for (;;) {
    lds_barrier();
    if (threadIdx.x == 0) *sItem = vid_lo + (int)atomicAdd(ctr, 1u);
    lds_barrier();
    const int vid = *sItem;
    if (vid >= hi) break;
    if (vid < n_scan) {
      const int seg = vid >> 6, it = vid & 63;
      if (mode == 1 && seg == NSEG - 1) continue;
#if PROBE_REP > 0
      if (slot >= 40 && PROBE_TYPE >= 0 && ((it < 16) ? 0 : (it < 32) ? 1 : 2) != PROBE_TYPE) continue;
#endif
      if (it < 16) { if (PH_MASK & 0x100) hgrn_item(p, l, it, seg, mode, smem); }
      else if (it < 32) { if (PH_MASK & 0x200) gla_item(p, l, it, seg, mode, smem); }
      else { if (PH_MASK & 0x400) ssd_item(p, l, it, seg, mode, smem); }
    } else { if (PH_MASK & 0x800) attn_item(p, l, att_lo + (vid - n_scan), smem); }
  }
}

DEV void phase_scan2(const Params& p) {
  const size_t gtid = (size_t)blockIdx.x * NT + threadIdx.x, gsz = (size_t)gridDim.x * NT;
  const float* DB = (const float*)(p.ws + OFF_DB);
  for (size_t e = gtid; e < 655360; e += gsz) {
    float* buf; const float* dp; int stride;
    if (e < 262144) { const int it = (int)(e >> 14), idx = (int)(e & 16383); buf = (float*)(p.ws + OFF_SB0) + (size_t)it * NSEG * 16384 + idx; stride = 16384; dp = DB + (size_t)it * NSEG * 128 + (idx >> 7); }
    else if (e < 393216) { const int e2 = (int)(e - 262144), j = e2 >> 13, idx = e2 & 8191; buf = (float*)(p.ws + OFF_SB1) + (size_t)j * NSEG * 8192 + idx; stride = 8192; dp = DB + (size_t)(16 + j) * NSEG * 128 + (idx >> 7); }
    else { const int e3 = (int)(e - 393216), j = e3 >> 13, idx = e3 & 8191; buf = (float*)(p.ws + OFF_SB2) + (size_t)j * NSEG * 8192 + idx; stride = 8192; dp = DB + (size_t)(32 + j) * NSEG * 128 + (idx >> 6); }
    float u[NSEG - 1], d[NSEG - 1];
#pragma unroll
    for (int sg = 0; sg < NSEG - 1; ++sg) { u[sg] = buf[(size_t)sg * stride]; d[sg] = dp[sg * 128]; }
    float st = 0.f;
#pragma unroll
    for (int sg = 0; sg < NSEG; ++sg) { buf[(size_t)sg * stride] = st; if (sg < NSEG - 1) st = d[sg] * st + u[sg]; }
  }
}

DEV float bfe(const u32x4& v, int j) { return (j & 1) ? hi16(v[j >> 1]) : lo16(v[j >> 1]); }
DEV void phase_fin(const Params& p, int l, int hf) {
  const int tid = launder(threadIdx.x), lane = tid & 63, w = tid >> 6;
  const bf16_t* Hh = (const bf16_t*)(p.ws + OFF_H);
  const bf16_t* OB = (const bf16_t*)(p.ws + OFF_OBUF);
  bf16_t* MX = (bf16_t*)(p.ws + OFF_MIXED);
  const int c0 = lane * 8;
  const float* cw = p.conv_w + (size_t)l * 5 * 1024; const float* cb = p.conv_b + (size_t)l * 1024;
  for (int r0 = (blockIdx.x * 8 + w) * 4; r0 < TH; r0 += gridDim.x * 32) {
    {
      u32x4 at[4], a[4], b[4], z[4];
#pragma unroll
      for (int i = 0; i < 4; ++i) {
        const bf16_t* hrow = Hh + (size_t)(r0 + i) * NPAD;
        at[i] = *(const u32x4*)(hrow + A_Q + c0);
        a[i] = *(const u32x4*)(OB + ((size_t)0 * TH + r0 + i) * 512 + c0); b[i] = *(const u32x4*)(OB + ((size_t)1 * TH + r0 + i) * 512 + c0);
        z[i] = *(const u32x4*)(hrow + H_Z + c0);
      }
      float gn[8];
#pragma unroll
      for (int j = 0; j < 8; ++j) gn[j] = p.hgrn_norm[l * 512 + c0 + j];
#pragma unroll
      for (int i = 0; i < 4; ++i) {
        *(u32x4*)(MX + (size_t)(r0 + i) * DI + c0) = at[i];
        float o[8]; float ss = 0.f;
#pragma unroll
        for (int j = 0; j < 8; ++j) { o[j] = bfe(a[i], j) + bfe(b[i], j); ss += o[j] * o[j]; }
#pragma unroll
        for (int of = 32; of >= 1; of >>= 1) ss += __shfl_xor(ss, of);
        const float rstd = rsqrtf(ss * (1.f / 512.f) + 1e-6f);
        float y[8];
#pragma unroll
        for (int j = 0; j < 8; ++j) { const float zz = bfe(z[i], j); y[j] = o[j] * rstd * gn[j] * (zz * frcp(1.f + ex2(fminf(-zz * LOG2E, 80.f)))); }
        *(u32x4*)(MX + (size_t)(r0 + i) * DI + 512 + c0) = (u32x4){pk2(y[0], y[1]), pk2(y[2], y[3]), pk2(y[4], y[5]), pk2(y[6], y[7])};
      }
    }
    {
      u32x4 a[4], b[4], z[4];
#pragma unroll
      for (int i = 0; i < 4; ++i) {
        a[i] = *(const u32x4*)(OB + ((size_t)4 * TH + r0 + i) * 512 + c0); b[i] = *(const u32x4*)(OB + ((size_t)5 * TH + r0 + i) * 512 + c0);
        z[i] = *(const u32x4*)(Hh + (size_t)(r0 + i) * NPAD + G_Z + c0);
      }
      float gn[8];
#pragma unroll
      for (int j = 0; j < 8; ++j) gn[j] = p.gla_norm[l * 128 + ((c0 + j) & 127)];
#pragma unroll
      for (int i = 0; i < 4; ++i) {
        float o[8]; float ss = 0.f;
#pragma unroll
        for (int j = 0; j < 8; ++j) { o[j] = bfe(a[i], j) + bfe(b[i], j); ss += o[j] * o[j]; }
#pragma unroll
        for (int of = 8; of >= 1; of >>= 1) ss += __shfl_xor(ss, of);
        const float rstd = rsqrtf(ss * (1.f / 128.f) + 1e-6f);
        float y[8];
#pragma unroll
        for (int j = 0; j < 8; ++j) { const float zz = bfe(z[i], j); y[j] = o[j] * rstd * gn[j] * (zz * frcp(1.f + ex2(fminf(-zz * LOG2E, 80.f)))); }
        *(u32x4*)(MX + (size_t)(r0 + i) * DI + 1536 + c0) = (u32x4){pk2(y[0], y[1]), pk2(y[2], y[3]), pk2(y[4], y[5]), pk2(y[6], y[7])};
      }
    }
    {
      u32x4 a[4], b[4], z[4], xr[8];
      const int t0 = r0 & (SEQ - 1);
#pragma unroll
      for (int i = 0; i < 4; ++i) {
        a[i] = *(const u32x4*)(OB + ((size_t)2 * TH + r0 + i) * 512 + c0); b[i] = *(const u32x4*)(OB + ((size_t)3 * TH + r0 + i) * 512 + c0);
        z[i] = *(const u32x4*)(Hh + (size_t)(r0 + i) * NPAD + S_Z + c0);
      }
#pragma unroll
      for (int m = 0; m < 8; ++m) {
        const int sq = t0 + m - 2;
        xr[m] = (u32x4){0u, 0u, 0u, 0u};
        if (sq >= 0 && sq < SEQ) xr[m] = *(const u32x4*)(Hh + (size_t)(r0 + m - 2) * NPAD + S_X + c0);
      }
      float gn[8], cbv[8];
#pragma unroll
      for (int j = 0; j < 8; ++j) { gn[j] = p.ssd_norm[l * 512 + c0 + j]; cbv[j] = cb[c0 + j]; }
      const float dsk = p.ssd_d[l * 8 + (c0 >> 6)];
#pragma unroll
      for (int i = 0; i < 4; ++i) {
        float u[8];
#pragma unroll
        for (int j = 0; j < 8; ++j) u[j] = cbv[j];
#pragma unroll
        for (int jj = 0; jj < 5; ++jj)
#pragma unroll
          for (int j = 0; j < 8; ++j) u[j] += cw[jj * 1024 + c0 + j] * bfe(xr[i + jj], j);
        float y[8]; float ss = 0.f;
#pragma unroll
        for (int j = 0; j < 8; ++j) {
          const float zz = bfe(z[i], j);
          const float xs = u[j] * frcp(1.f + ex2(fminf(-u[j] * LOG2E, 80.f)));
          y[j] = (bfe(a[i], j) + bfe(b[i], j) + dsk * xs) * (zz * frcp(1.f + ex2(fminf(-zz * LOG2E, 80.f))));
          ss += y[j] * y[j];
        }
#pragma unroll
        for (int of = 32; of >= 1; of >>= 1) ss += __shfl_xor(ss, of);
        const float rstd = rsqrtf(ss * (1.f / 512.f) + 1e-6f);
#pragma unroll
        for (int j = 0; j < 8; ++j) y[j] = y[j] * rstd * gn[j];
        *(u32x4*)(MX + (size_t)(r0 + i) * DI + 1024 + c0) = (u32x4){pk2(y[0], y[1]), pk2(y[2], y[3]), pk2(y[4], y[5]), pk2(y[6], y[7])};
      }
    }
  }
}

#define XB_TMO      128
#define XB_XCNT(j)  (256  + 64 * (j))
#define XB_XSUB(j)  (1280 + 64 * (j))
#define XB_XGEN(j)  (2304 + 64 * (j))
#define XB_TOP      3328
#define XB_TOPGEN   3392
#define XB_SPIN_CAP (1u << 22)
#define LAS __attribute__((address_space(3)))
DEV unsigned xb_ld(unsigned* p) { return __hip_atomic_load(p, __ATOMIC_RELAXED, __HIP_MEMORY_SCOPE_AGENT); }
DEV unsigned xb_add(unsigned* p, unsigned v) { return __hip_atomic_fetch_add(p, v, __ATOMIC_RELAXED, __HIP_MEMORY_SCOPE_AGENT); }
DEV unsigned xb_xcc_id() { return (unsigned)__builtin_amdgcn_s_getreg((3 << 11) | 20) & 0xFu; }
#define XB_SPIN(cond, bar) do { unsigned _sp = 0; while (cond) { __builtin_amdgcn_s_sleep(1); \
    if ((++_sp & 255u) == 0u) { if (xb_ld(&(bar)[XB_TMO])) break; if (_sp > XB_SPIN_CAP) { atomicAdd(&(bar)[XB_TMO], 1u); break; } } } } while (0)
struct XcdBarrier { unsigned* bar; unsigned x; volatile LAS unsigned* st; };
DEV XcdBarrier xcd_barrier_post(unsigned* bar, volatile LAS unsigned* st) {
  XcdBarrier b; b.bar = bar; b.x = xb_xcc_id(); b.st = st;
  if (threadIdx.x == 0) (void)xb_add(&bar[XB_XCNT(b.x)], 1u);
  return b;
}
DEV void xcd_barrier_complete(unsigned* bar, unsigned x, unsigned& nloc, unsigned& nx) {
  const unsigned G = gridDim.x * gridDim.y * gridDim.z;
  unsigned sum, cnt, mine, sp = 0u;
  for (;;) {
    sum = 0u; cnt = 0u; mine = 0u;
#pragma unroll
    for (unsigned j = 0; j < 16; ++j) { const unsigned c = xb_ld(&bar[XB_XCNT(j)]); sum += c; cnt += (c > 0u) ? 1u : 0u; mine = (j == x) ? c : mine; }
    if (sum == G) break;
    __builtin_amdgcn_s_sleep(1);
    if ((++sp & 255u) == 0u) { if (xb_ld(&bar[XB_TMO])) break; if (sp > XB_SPIN_CAP) { atomicAdd(&bar[XB_TMO], 1u); break; } }
  }
  nloc = mine > 0u ? mine : 1u; nx = cnt > 0u ? cnt : 1u;
}
DEV void xcd_barrier(const XcdBarrier& b) {
  asm volatile("s_waitcnt vmcnt(0)" ::: "memory");
  __syncthreads();
  if (threadIdx.x == 0) {
    unsigned* bar = b.bar;
    __builtin_amdgcn_s_waitcnt(0);
    unsigned nloc = b.st[0], nx = b.st[1];
    if (nloc == 0u) { xcd_barrier_complete(bar, b.x, nloc, nx); b.st[0] = nloc; b.st[1] = nx; }
    const unsigned old = xb_add(&bar[XB_XSUB(b.x)], 1u);
    const unsigned gen = old / nloc;
    if (old + 1u == (gen + 1u) * nloc) {
      __builtin_amdgcn_fence(__ATOMIC_RELEASE, "agent");
      asm volatile("s_waitcnt vmcnt(0)" ::: "memory");
      const unsigned og = xb_add(&bar[XB_TOP], 1u);
      const unsigned tg = og / nx;
      if (og + 1u == (tg + 1u) * nx) xb_add(&bar[XB_TOPGEN], 1u);
      else XB_SPIN(xb_ld(&bar[XB_TOPGEN]) == tg, bar);
      __builtin_amdgcn_fence(__ATOMIC_ACQUIRE, "agent");
      xb_add(&bar[XB_XGEN(b.x)], 1u);
      asm volatile("s_waitcnt vmcnt(0)" ::: "memory");
    } else {
      XB_SPIN(xb_ld(&bar[XB_XGEN(b.x)]) == gen, bar);
      __builtin_amdgcn_fence(__ATOMIC_ACQUIRE, "agent");
      asm volatile("s_waitcnt vmcnt(0)" ::: "memory");
    }
  }
  __syncthreads();
}

DEV void run_phase(const Params& p, int ph, int rep, unsigned char* smem) {
  if (ph == 0) { if (PH_MASK & 1) { phase_pro(p, smem); convert_weights(p, 0, 3, smem); } return; }
  if (ph == 21) { if (PH_MASK & 16) phase_outproj(p, 1, 1, smem); return; }
  if (ph == 22) { if (PH_MASK & 32) phase_ln(p, 1, 1); return; }
  const int q = ph - 1, blk = q / 5, st = q % 5, l = blk >> 1, hf = blk & 1;
  if (st == 0) {
    if (blk > 0 && (PH_MASK & 16)) phase_outproj(p, (blk - 1) >> 1, (blk - 1) & 1, smem);
    if (PH_MASK & 2) phase_inproj(p, l, hf, blk > 0 ? 16 : 0, smem);
  } else if (st == 1) {
    if (blk > 0 && rep == 0 && (PH_MASK & 32)) phase_ln(p, (blk - 1) >> 1, (blk - 1) & 1);
    if (PH_MASK & 4) phase_prep(p, l, hf, rep, smem);
    if ((PH_MASK & 1) && rep == 0 && blk == 1) convert_weights(p, 1, 1, smem);
    if ((PH_MASK & 1) && rep == 0 && blk == 2) convert_weights(p, 1, 2, smem);
  }
  else if (st == 2) { if (PH_MASK & 0xF00) phase_mix(p, l, hf, ph + 40 * rep, 1, 0, ATT_SPLIT, rep ? PROBE_LO : 0, rep ? PROBE_HI : 100000, smem); }
  else if (st == 3) { if (PH_MASK & 0xF00) phase_mix(p, l, hf, ph + 40 * rep, 3, ATT_SPLIT, 256, rep ? PROBE_LO : 0, rep ? PROBE_HI : 100000, smem); }
  else { if (PH_MASK & 8) phase_fin(p, l, hf); }
}
__global__ void __launch_bounds__(NT) mega(Params p) {
  extern __shared__ __attribute__((aligned(16))) unsigned char smem[];
#if ONE_LAUNCH
  volatile LAS unsigned* xst = (volatile LAS unsigned*)(smem + LDS_BYTES - 32);
  if (threadIdx.x == 0) { xst[0] = 0u; xst[1] = 0u; }
  __syncthreads();
  XcdBarrier xb = xcd_barrier_post((unsigned*)(p.ws + OFF_CTRL), xst);
#endif
  Params* lp = (Params*)(smem + 147456);
  if (threadIdx.x == 0) *lp = p;
  __syncthreads();
  const int ph_begin = p.phase_begin, ph_end = p.phase_end;
  for (int ph = ph_begin; ph < ph_end; ++ph) {
    int nrep = 0;
#if PROBE_REP > 0
    {
      const int q = ph - 1, st = q % 5;
      const bool idem = (ph >= 1 && ph <= 20) && (st == PROBE_ST) && (st >= 1);
      if (idem) nrep = PROBE_REP;
    }
#endif
    for (int r = 0; r <= nrep; ++r) {
      run_phase(*lp, ph, r, smem);
#if ONE_LAUNCH
      if (r < nrep || ph + 1 < ph_end) xcd_barrier(xb);
#endif
    }
  }
}

extern "C" void kernel_launch(void* const* d_in, const int* in_sizes, int n_in, void* d_out, int out_size, void* d_ws, size_t ws_size,
                              hipStream_t stream) {
  static int grid_blocks = 0;
  if (!grid_blocks) {
    int dev = 0, cus = 0, per_cu = 0;
    hipGetDevice(&dev);
    hipDeviceGetAttribute(&cus, hipDeviceAttributeMultiprocessorCount, dev);
    hipFuncSetAttribute((const void*)mega, hipFuncAttributeMaxDynamicSharedMemorySize, LDS_BYTES);
    hipOccupancyMaxActiveBlocksPerMultiprocessor(&per_cu, mega, NT, LDS_BYTES);
    if (per_cu < 1) per_cu = 1;
    grid_blocks = cus;
  }
  Params p{};
  p.x = (const float*)d_in[0]; p.w_in = (const float*)d_in[1]; p.q_gain = (const float*)d_in[2]; p.k_gain = (const float*)d_in[3];
  p.lb_logits = (const float*)d_in[4]; p.hgrn_norm = (const float*)d_in[5]; p.conv_w = (const float*)d_in[6]; p.conv_b = (const float*)d_in[7];
  p.dt_bias = (const float*)d_in[8]; p.a_log = (const float*)d_in[9]; p.ssd_d = (const float*)d_in[10]; p.ssd_norm = (const float*)d_in[11];
  p.gk_w2 = (const float*)d_in[12]; p.gk_b = (const float*)d_in[13]; p.gla_norm = (const float*)d_in[14]; p.w_out = (const float*)d_in[15];
  p.ln_g = (const float*)d_in[16]; p.ln_b = (const float*)d_in[17];
  p.out = (float*)d_out; p.ws = (unsigned char*)d_ws;
  hipMemsetAsync(d_ws, 0, CTRL_BYTES, stream);
#if ONE_LAUNCH
  p.phase_begin = 0; p.phase_end = NPHASE;
  void* args[] = {&p};
  (void)args;
  hipLaunchKernelGGL(mega, dim3(grid_blocks), dim3(NT), LDS_BYTES, stream, p);
#else
  for (int ph = 0; ph < NPHASE; ++ph) {
    p.phase_begin = ph; p.phase_end = ph + 1;
    hipLaunchKernelGGL(mega, dim3(grid_blocks), dim3(NT), LDS_BYTES, stream, p);
  }
#endif
}
```

```cpp
#include <hip/hip_runtime.h>
#include <hip/hip_cooperative_groups.h>
#include <stdint.h>
#include <stdio.h>
namespace cg = cooperative_groups;

#ifndef ONE_LAUNCH
#define ONE_LAUNCH 1
#endif

#ifndef PH_MASK
#define PH_MASK 0xFFF
#endif
#ifndef PROBE_ST
#define PROBE_ST -1
#endif
#ifndef PROBE_REP
#define PROBE_REP 0
#endif
#ifndef PROBE_TYPE
#define PROBE_TYPE -1
#endif
#ifndef PROBE_LO
#define PROBE_LO 0
#endif
#ifndef PROBE_HI
#define PROBE_HI 100000
#endif
#define DEV __device__ __forceinline__
typedef unsigned short bf16_t;
typedef short bf16x8 __attribute__((ext_vector_type(8)));
typedef float f32x16 __attribute__((ext_vector_type(16)));
typedef unsigned u32x4 __attribute__((ext_vector_type(4)));
typedef float f32x4 __attribute__((ext_vector_type(4)));

constexpr int NT = 512;
constexpr int T_ALL = 16384, TH = 8192, SEQ = 4096, DM = 1024, NPAD = 7168, DI = 2048, NIN = 6960;
constexpr int A_Q = 0, A_K = 512, A_V = 640, A_Z = 768, H_Q = 1280, H_FF = 1792, H_FB = 2304, H_I = 2816, H_Z = 3328,
              S_X = 3840, S_Z = 4864, G_Q = 5376, G_K = 5632, G_V = 5888, G_Z = 6400, SM0 = 6912;
constexpr size_t OFF_CTRL = 0, OFF_TAB = 65536, OFF_XB = 131072;
constexpr size_t OFF_WIN = OFF_XB + (size_t)T_ALL * DM * 2;
constexpr size_t OFF_WOUT = OFF_WIN + (size_t)NPAD * DM * 2;
constexpr size_t OFF_H = OFF_WOUT + (size_t)DM * DI * 2;
constexpr size_t OFF_SMALL = OFF_H + (size_t)TH * NPAD * 2;
constexpr size_t OFF_OBUF = OFF_SMALL + (size_t)TH * 48 * 4;
constexpr size_t OFF_VT = OFF_OBUF + (size_t)6 * TH * 512 * 2;
constexpr size_t OFF_DB = OFF_VT + (size_t)2 * 2 * 64 * SEQ * 2;
constexpr int NSEG = 4, SLEN = 64 / NSEG;
constexpr size_t OFF_MIXED = OFF_DB + (size_t)64 * NSEG * 128 * 4;
constexpr size_t OFF_SB0 = OFF_MIXED, OFF_SB1 = OFF_SB0 + (size_t)16 * NSEG * 16384 * 4, OFF_SB2 = OFF_SB1 + (size_t)16 * NSEG * 8192 * 4;
constexpr size_t OFF_U = OFF_SB2 + (size_t)32 * NSEG * 8192 * 4;
constexpr size_t OFF_G = OFF_U + (size_t)TH * 1024 * 2;
constexpr size_t WS_END = (OFF_G + (size_t)TH * 512 * 2 > OFF_MIXED + (size_t)TH * DI * 2) ? (OFF_G + (size_t)TH * 512 * 2) : (OFF_MIXED + (size_t)TH * DI * 2);
static_assert(OFF_MIXED + (size_t)TH * DI * 2 <= WS_END, "MIXED must fit");
static_assert(WS_END <= 268435456, "workspace");
constexpr size_t CTRL_BYTES = 65536;
constexpr int CTR_WORD0 = 4096;
constexpr int LDS_BYTES = 148480;
constexpr float LOG2E = 1.4426950408889634f;
constexpr float QSCALE = 0.125f * LOG2E;
constexpr float DN_ALPHA = 1.4142135623730951f;
constexpr int NPHASE = 23;
constexpr int ATT_SPLIT = 256;

struct Params {
  const float* x; const float* w_in; const float* q_gain; const float* k_gain; const float* lb_logits; const float* hgrn_norm;
  const float* conv_w; const float* conv_b; const float* dt_bias; const float* a_log; const float* ssd_d; const float* ssd_norm;
  const float* gk_w2; const float* gk_b; const float* gla_norm; const float* w_out; const float* ln_g; const float* ln_b;
  float* out; unsigned char* ws;
  int phase_begin, phase_end;
};
#define GAS __attribute__((address_space(1)))
struct ParamsG {
  GAS const float* x; GAS const float* w_in; GAS const float* q_gain; GAS const float* k_gain; GAS const float* lb_logits; GAS const float* hgrn_norm;
  GAS const float* conv_w; GAS const float* conv_b; GAS const float* dt_bias; GAS const float* a_log; GAS const float* ssd_d; GAS const float* ssd_norm;
  GAS const float* gk_w2; GAS const float* gk_b; GAS const float* gla_norm; GAS const float* w_out; GAS const float* ln_g; GAS const float* ln_b;
  GAS float* out; GAS unsigned char* ws;
};

DEV void lds_barrier() { asm volatile("s_waitcnt lgkmcnt(0)" ::: "memory"); __builtin_amdgcn_s_barrier(); asm volatile("" ::: "memory"); }
DEV int launder(int v) { asm volatile("" : "+v"(v)); return v; }
DEV float bf2f(bf16_t v) { return __uint_as_float(((unsigned)v) << 16); }
DEV bf16_t f2bf(float f) { unsigned u = __float_as_uint(f); u += 0x7fffu + ((u >> 16) & 1u); return (bf16_t)(u >> 16); }
typedef __bf16 bf16x2_t __attribute__((ext_vector_type(2)));
typedef float f32x2_t __attribute__((ext_vector_type(2)));
DEV unsigned pk2(float lo, float hi) { const f32x2_t f = {lo, hi}; const bf16x2_t b = __builtin_convertvector(f, bf16x2_t); return __builtin_bit_cast(unsigned, b); }
DEV float fsigmoid(float x) { return 1.f / (1.f + __expf(-x)); }
DEV float fsilu(float x) { return x / (1.f + __expf(-x)); }
DEV unsigned cvtpk(float lo, float hi) { return pk2(lo, hi); }
DEV float ex2(float x) { return __builtin_amdgcn_exp2f(x); }
DEV float lg2(float x) { return __builtin_amdgcn_logf(x); }
DEV float frcp(float x) { return __builtin_amdgcn_rcpf(x); }
DEV float lo16(unsigned u) { return __uint_as_float(u << 16); }
DEV float hi16(unsigned u) { return __uint_as_float(u & 0xffff0000u); }
DEV int rowoff(int reg, int h) { return (reg & 3) + 8 * (reg >> 2) + 4 * h; }
DEV f32x16 zero16() { f32x16 z;
#pragma unroll
  for (int i = 0; i < 16; ++i) z[i] = 0.f; return z; }

template <int KD>
DEV void mma32(f32x16& acc, const bf16_t* a, int lda, const bf16_t* b, int ldb, int lane) {
  const int r = lane & 31, h = lane >> 5;
  const bf16_t* ap = a + r * lda + 8 * h;
  const bf16_t* bp = b + r * ldb + 8 * h;
#pragma unroll 4
  for (int k = 0; k < KD; k += 16) {
    bf16x8 av = *(const bf16x8*)(ap + k);
    bf16x8 bv = *(const bf16x8*)(bp + k);
    acc = __builtin_amdgcn_mfma_f32_32x32x16_bf16(av, bv, acc, 0, 0, 0);
  }
}

DEV int orig_col(int n) {
  if (n < 4864) return n;
  if (n < 6400) return n + 16;
  if (n < 6912) return n + 48;
  if (n < 6928) return n - 2048;
  if (n < 6960) return n - 512;
  return -1;
}

DEV void convert_weights(const ParamsG& p, int l, int which, unsigned char* smem) {
  float* s = (float*)smem;
  const int tid = launder(threadIdx.x);
  const float* win = (const float*)(p.w_in + (size_t)l * DM * NIN);
  const float* wout = (const float*)(p.w_out + (size_t)l * DI * DM);
  bf16_t* wint = (bf16_t*)(p.ws + OFF_WIN);
  bf16_t* woutt = (bf16_t*)(p.ws + OFF_WOUT);
  const int n_in_tiles = (NPAD / 64) * (DM / 64);
  const int n_out_tiles = (DM / 64) * (DI / 64);
  const int it_lo = (which & 1) ? 0 : n_in_tiles, it_hi = (which & 2) ? (n_in_tiles + n_out_tiles) : n_in_tiles;
  for (int it = it_lo + blockIdx.x; it < it_hi; it += gridDim.x) {
    lds_barrier();
    if (it < n_in_tiles) {
      const int n0 = (it / 16) * 64, k0 = (it % 16) * 64;
#pragma unroll
      for (int e = 0; e < 8; ++e) {
        const int idx = e * NT + tid, kk = idx >> 6, nn = idx & 63;
        const int oc = orig_col(n0 + nn);
        s[kk * 65 + nn] = (oc >= 0) ? win[(size_t)(k0 + kk) * NIN + oc] : 0.f;
      }
      lds_barrier();
      const int n = tid >> 3, kc = (tid & 7) * 8;
      uint4 o;
      o.x = pk2(s[(kc + 0) * 65 + n], s[(kc + 1) * 65 + n]); o.y = pk2(s[(kc + 2) * 65 + n], s[(kc + 3) * 65 + n]);
      o.z = pk2(s[(kc + 4) * 65 + n], s[(kc + 5) * 65 + n]); o.w = pk2(s[(kc + 6) * 65 + n], s[(kc + 7) * 65 + n]);
      *(uint4*)(wint + (size_t)(n0 + n) * DM + k0 + kc) = o;
    } else {
      const int j = it - n_in_tiles;
      const int n0 = (j / 32) * 64, k0 = (j % 32) * 64;
#pragma unroll
      for (int e = 0; e < 8; ++e) {
        const int idx = e * NT + tid, kk = idx >> 6, nn = idx & 63;
        s[kk * 65 + nn] = wout[(size_t)(k0 + kk) * DM + n0 + nn];
      }
      lds_barrier();
      const int n = tid >> 3, kc = (tid & 7) * 8;
      uint4 o;
      o.x = pk2(s[(kc + 0) * 65 + n], s[(kc + 1) * 65 + n]); o.y = pk2(s[(kc + 2) * 65 + n], s[(kc + 3) * 65 + n]);
      o.z = pk2(s[(kc + 4) * 65 + n], s[(kc + 5) * 65 + n]); o.w = pk2(s[(kc + 6) * 65 + n], s[(kc + 7) * 65 + n]);
      *(uint4*)(woutt + (size_t)(n0 + n) * DI + k0 + kc) = o;
    }
  }
  lds_barrier();
}

DEV void fsincos(float x, float& s, float& c) {
  const float k = rintf(x * 0.63661977236758134308f);
  float r = fmaf(-k, 1.5707855225e+00f, x);
  r = fmaf(-k, 1.0804273188e-05f, r);
  r = fmaf(-k, 6.0770999344e-11f, r);
  const float r2 = r * r;
  float ps = fmaf(r2, 2.7557319224e-06f, -1.9841269841e-04f);
  ps = fmaf(ps, r2, 8.3333333333e-03f); ps = fmaf(ps, r2, -1.6666666667e-01f);
  const float sinr = fmaf(ps * r2, r, r);
  float pc = fmaf(r2, -2.7557319224e-07f, 2.4801587302e-05f);
  pc = fmaf(pc, r2, -1.3888888889e-03f); pc = fmaf(pc, r2, 4.1666666667e-02f); pc = fmaf(pc, r2, -0.5f);
  const float cosr = fmaf(pc, r2, 1.0f);
  const int q = ((int)k) & 3;
  if (q == 0) { s = sinr; c = cosr; }
  else if (q == 1) { s = cosr; c = -sinr; }
  else if (q == 2) { s = -sinr; c = -cosr; }
  else { s = -cosr; c = sinr; }
}

DEV void phase_pro(const ParamsG& p, unsigned char* smem) {
  const int tid = launder(threadIdx.x);
  const size_t gtid = (size_t)blockIdx.x * NT + tid, gsz = (size_t)gridDim.x * NT;
  const float4* x4 = (const float4*)p.x;
  uint4* xb4 = (uint4*)(p.ws + OFF_XB);
  for (size_t i = gtid; i < (size_t)T_ALL * DM / 8; i += gsz) {
    const float4 a = x4[2 * i], b = x4[2 * i + 1];
    uint4 o; o.x = pk2(a.x, a.y); o.y = pk2(a.z, a.w); o.z = pk2(b.x, b.y); o.w = pk2(b.z, b.w);
    xb4[i] = o;
  }
  if (blockIdx.x == 0) {
    float2* tab = (float2*)(p.ws + OFF_TAB);
    for (int i = tid; i < 64 * 16; i += NT) {
      const int pos = i >> 4, fi = i & 15;
      const float invf = exp2f(-(float)fi * (13.287712379549449f / 16.0f));
      const float ang = (float)pos * invf;
      float sn, cs; fsincos(ang, sn, cs);
      tab[i] = make_float2(cs, sn);
    }
  }
}

namespace pg8 {
#define PG8_LAS __attribute__((address_space(3)))
typedef unsigned short bf16_t;
typedef short bf16x8 __attribute__((ext_vector_type(8)));
typedef float f32x4 __attribute__((ext_vector_type(4)));
typedef unsigned u32x4 __attribute__((ext_vector_type(4)));
constexpr int BM = 256, BK = 64, HALF = 128, HTB = HALF * BK * 2  , STAGE_BYTES = 8 * HTB, NXCD = 8, WGM = 8;

__host__ __device__ __forceinline__ int lds_byte(int r, int c) { const int st = (r >> 4) * 2 + (c >> 5), rr = r & 15, cc = c & 31, ob = rr * 64 + cc * 2; return st * 1024 + (ob ^ (((ob >> 9) & 1) << 5)); }
__host__ __device__ __forceinline__ void stage_rc(int b, int& R, int& C) { const int st = b / 1024, sb = b % 1024, swz = sb ^ (((sb >> 9) & 1) << 5); R = (st >> 1) * 16 + swz / 64; C = (st & 1) * 32 + (swz % 64) / 2; }
__host__ __device__ __forceinline__ int perm32(int rho) { const int n = rho >> 4, i = rho & 15; return 8 * (i >> 2) + 4 * n + (i & 3); }

struct Unit { int pm, pn; };
struct Gemm { const bf16_t* A; const bf16_t* Bt; int M, N, K; };

__device__ __forceinline__ unsigned cvt_pk_bf16(float lo, float hi) { unsigned r; asm volatile("v_cvt_pk_bf16_f32 %0, %1, %2" : "=v"(r) : "v"(lo), "v"(hi)); return r; }

struct XcdOrder {
    int rpx, nN, x, c, ncu, skew;
    __device__ void init(int M, int N, int skew_ = 0) { rpx = (M / BM) / NXCD; nN = N / BM; x = blockIdx.x & 7; c = blockIdx.x >> 3; ncu = gridDim.x >> 3; skew = skew_; }
    __device__ bool next(int i, Unit& u) const {
        const int total = rpx * nN, full = (total / ncu) * ncu;
        int j = c + i * ncu;
        if (skew > 0 && j >= full) { const int cc = c - skew; j = (cc >= 0 && i == total / ncu) ? full + cc : total; }
        if (j >= total) return false; u.pm = rpx * x + (j % rpx); u.pn = j / rpx; return true; }
    __device__ __forceinline__ void a_ready(const Unit&) const {}
    __device__ __forceinline__ void done(const Unit&) const {}
};
struct EpiIn {
    static constexpr bool PERM = true, AFTER_DRAIN = false;
    bf16_t* O; int ldc; float* small; int small_pn;
    __device__ __forceinline__ void operator()(const f32x4 (&acc)[2][2][4][2], const Unit& u, int wr, int wc, int fr, int fq) const {
        const int row0 = u.pm * BM + wr * 64 + fr, col0 = u.pn * BM + wc * 32 + 8 * fq;
        if (u.pn == small_pn) {
            const int c = wc * 32 + 8 * fq;
            if (c < 48) {
#pragma unroll
                for (int ai = 0; ai < 2; ++ai)
#pragma unroll
                    for (int m = 0; m < 4; ++m) { float* rp = small + (size_t)(row0 + ai * HALF + m * 16) * 48 + c; *(f32x4*)rp = acc[ai][0][m][0]; *(f32x4*)(rp + 4) = acc[ai][0][m][1]; }
            }
            return;
        }
        const int act = (u.pn == 5 || u.pn == 6) ? 1 : ((u.pn == 21) ? 2 : 0);
#pragma unroll
        for (int ai = 0; ai < 2; ++ai)
#pragma unroll
            for (int m = 0; m < 4; ++m) { bf16_t* rowp = O + (size_t)(row0 + ai * HALF + m * 16) * ldc + col0;
#pragma unroll
                for (int bj = 0; bj < 2; ++bj) { f32x4 v0 = acc[ai][bj][m][0], v1 = acc[ai][bj][m][1];
                    if (act == 1) {
#pragma unroll
                        for (int e = 0; e < 4; ++e) {
                            v0[e] = v0[e] * __builtin_amdgcn_rcpf(1.f + __builtin_amdgcn_exp2f(fminf(-v0[e] * 1.4426950408889634f, 80.f))) * 0.08838834764831845f;
                            v1[e] = v1[e] * __builtin_amdgcn_rcpf(1.f + __builtin_amdgcn_exp2f(fminf(-v1[e] * 1.4426950408889634f, 80.f))) * 0.08838834764831845f; }
                    } else if (act == 2) { v0 = v0 * 0.125f; v1 = v1 * 0.125f; }
                    u32x4 w; w.x = cvt_pk_bf16(v0[0], v0[1]); w.y = cvt_pk_bf16(v0[2], v0[3]); w.z = cvt_pk_bf16(v1[0], v1[1]); w.w = cvt_pk_bf16(v1[2], v1[3]);
                    *(u32x4*)(rowp + bj * HALF) = w; } }
    }
};
struct EpiOut {
    static constexpr bool PERM = true, AFTER_DRAIN = false;
    const float* X; float* Y; int ldc; float alpha;
    __device__ __forceinline__ void operator()(const f32x4 (&acc)[2][2][4][2], const Unit& u, int wr, int wc, int fr, int fq) const {
        const int row0 = u.pm * BM + wr * 64 + fr, col0 = u.pn * BM + wc * 32 + 8 * fq;
#pragma unroll
        for (int ai = 0; ai < 2; ++ai)
#pragma unroll
            for (int m = 0; m < 4; ++m) { const size_t off = (size_t)(row0 + ai * HALF + m * 16) * ldc + col0;
#pragma unroll
                for (int bj = 0; bj < 2; ++bj) { const f32x4 x0 = *(const f32x4*)(X + off + bj * HALF), x1 = *(const f32x4*)(X + off + bj * HALF + 4);
                    *(f32x4*)(Y + off + bj * HALF) = x0 * alpha + acc[ai][bj][m][0]; *(f32x4*)(Y + off + bj * HALF + 4) = x1 * alpha + acc[ai][bj][m][1]; } }
    }
};

template <class Epi, class Sched, bool ALIGN_EPI = false, bool SP2 = false>
__device__ __forceinline__ void gemm_phase(PG8_LAS unsigned char* lds, const Gemm g, const Sched& S, const Epi& E) {
    const int tid = launder((int)threadIdx.x), wid = __builtin_amdgcn_readfirstlane(tid >> 6), lane = tid & 63, wr = wid >> 2, wc = wid & 3, fr = lane & 15, fq = lane >> 4;
    const int K = g.K, nt = K / BK;
    unsigned voffA[2], voffB[2];
#pragma unroll
    for (int i = 0; i < 2; ++i) { int R, C; stage_rc(tid * 16 + i * 8192, R, C); const int Rb = Epi::PERM ? ((R & ~31) + perm32(R & 31)) : R;
        voffA[i] = (unsigned)(R * K + C) * 2u; voffB[i] = (unsigned)(Rb * K + C) * 2u; }
    const size_t kstep = (size_t)(BK * 2);
    const size_t hstep = (size_t)HALF * K * 2;
    const size_t tstep = 2 * hstep;
    const unsigned ldsw = (unsigned)wid * 1024u;
    const int aoff = lds_byte(wr * 64 + fr, fq * 8), boff = lds_byte(wc * 32 + fr, fq * 8);
#define PG8_SA(b, h) (((b) * 2 + (h)) * HTB)
#define PG8_SB(b, h) ((4 + (b) * 2 + (h)) * HTB)
#define PG8_STAGE(bufoff, gbase, voff) do { _Pragma("unroll") for (int _i = 0; _i < 2; ++_i) \
        __builtin_amdgcn_global_load_lds((const unsigned*)((const char*)(gbase) + (voff)[_i]), (PG8_LAS unsigned*)(lds + (bufoff) + ldsw + _i * 8192), 16, 0, 0); } while (0)
#define PG8_LDA(dst, b, h) do { _Pragma("unroll") for (int m = 0; m < 4; ++m) _Pragma("unroll") for (int k = 0; k < 2; ++k) dst[m][k] = *(const PG8_LAS bf16x8*)(lds + PG8_SA(b, h) + aoff + m * 2048 + k * 1024); } while (0)
#define PG8_LDB(dst, b, h) do { _Pragma("unroll") for (int n = 0; n < 2; ++n) _Pragma("unroll") for (int k = 0; k < 2; ++k) dst[n][k] = *(const PG8_LAS bf16x8*)(lds + PG8_SB(b, h) + boff + n * 2048 + k * 1024); } while (0)
#define PG8_MMA(ai, bj, At, Bt) do { __builtin_amdgcn_s_setprio(1); _Pragma("unroll") for (int m = 0; m < 4; ++m) _Pragma("unroll") for (int n = 0; n < 2; ++n) _Pragma("unroll") for (int k = 0; k < 2; ++k) \
        acc[ai][bj][m][n] = __builtin_amdgcn_mfma_f32_16x16x32_bf16(Bt[n][k], At[m][k], acc[ai][bj][m][n], 0, 0, 0); __builtin_amdgcn_s_setprio(0); } while (0)
#define PG8_WAIT_V(n) asm volatile("s_waitcnt vmcnt(" #n ")" ::: "memory")
#define PG8_WAIT_L(n) asm volatile("s_waitcnt lgkmcnt(" #n ")" ::: "memory")
#define PG8_BAR __builtin_amdgcn_s_barrier()
#define PG8_SCHED __builtin_amdgcn_sched_barrier(0)
    Unit cur, nxt; int ui = 0;
    if (!S.next(0, cur)) return;
    f32x4 acc[2][2][4][2];
#pragma unroll
    for (int a = 0; a < 2; ++a)
#pragma unroll
        for (int b = 0; b < 2; ++b)
#pragma unroll
            for (int m = 0; m < 4; ++m)
#pragma unroll
                for (int n = 0; n < 2; ++n) acc[a][b][m][n] = (f32x4){0.f, 0.f, 0.f, 0.f};
    bf16x8 At[4][2], B0[2][2], B1[2][2];
    const char* cA = (const char*)g.A + (size_t)cur.pm * tstep; const char* cB = (const char*)g.Bt + (size_t)cur.pn * tstep;
    S.a_ready(cur);
    if constexpr (SP2) {
        PG8_STAGE(PG8_SB(0, 0), cB, voffB); PG8_STAGE(PG8_SB(0, 1), cB + hstep, voffB); PG8_STAGE(PG8_SA(0, 0), cA, voffA); PG8_STAGE(PG8_SA(0, 1), cA + hstep, voffA);
        if (wr == 1) PG8_BAR;
        PG8_WAIT_V(2); PG8_BAR;
        PG8_STAGE(PG8_SB(1, 0), cB + kstep, voffB); PG8_STAGE(PG8_SA(1, 0), cA + kstep, voffA); PG8_STAGE(PG8_SB(1, 1), cB + hstep + kstep, voffB);
        PG8_WAIT_V(6); PG8_BAR;
    } else {
        PG8_STAGE(PG8_SB(0, 0), cB, voffB); PG8_STAGE(PG8_SA(0, 0), cA, voffA); PG8_STAGE(PG8_SB(0, 1), cB + hstep, voffB); PG8_STAGE(PG8_SA(0, 1), cA + hstep, voffA);
        if (wr == 1) PG8_BAR;
        PG8_WAIT_V(4); PG8_BAR;
        PG8_STAGE(PG8_SB(1, 0), cB + kstep, voffB); PG8_STAGE(PG8_SA(1, 0), cA + kstep, voffA); PG8_STAGE(PG8_SB(1, 1), cB + hstep + kstep, voffB);
        PG8_WAIT_V(6); PG8_BAR;
    }
    for (;;) {
        const bool has_next = S.next(ui + 1, nxt);
        const char* nA = has_next ? (const char*)g.A + (size_t)nxt.pm * tstep : cA; const char* nB = has_next ? (const char*)g.Bt + (size_t)nxt.pn * tstep : cB;
        for (int t = 0; t < nt; t += 2) {
            const bool last = (t == nt - 2);
            const char* a1 = cA + (size_t)(t + 1) * kstep;
            const char* a2 = last ? nA : cA + (size_t)(t + 2) * kstep; const char* b2 = last ? nB : cB + (size_t)(t + 2) * kstep;
            const char* a3 = a2 + kstep; const char* b3 = b2 + kstep;
            if (last && has_next) S.a_ready(nxt);
            if constexpr (SP2) {
            PG8_LDB(B0, 0, 0); PG8_LDB(B1, 0, 1); PG8_SCHED; PG8_LDA(At, 0, 0); PG8_STAGE(PG8_SA(1, 1), a1 + hstep, voffA);
            PG8_WAIT_V(8); PG8_WAIT_L(0); PG8_BAR; PG8_MMA(0, 0, At, B0); PG8_MMA(0, 1, At, B1); PG8_BAR; PG8_SCHED;
            PG8_LDA(At, 0, 1); PG8_STAGE(PG8_SB(0, 0), b2, voffB); PG8_STAGE(PG8_SB(0, 1), b2 + hstep, voffB); PG8_STAGE(PG8_SA(0, 0), a2, voffA);
            PG8_WAIT_V(8); PG8_WAIT_L(0); PG8_BAR; PG8_MMA(1, 0, At, B0); PG8_MMA(1, 1, At, B1); PG8_BAR; PG8_SCHED;
            PG8_LDB(B0, 1, 0); PG8_LDB(B1, 1, 1); PG8_SCHED; PG8_LDA(At, 1, 0); PG8_STAGE(PG8_SA(0, 1), a2 + hstep, voffA);
            PG8_WAIT_V(8); PG8_WAIT_L(0); PG8_BAR; PG8_MMA(0, 0, At, B0); PG8_MMA(0, 1, At, B1); PG8_BAR; PG8_SCHED;
            PG8_LDA(At, 1, 1); PG8_STAGE(PG8_SB(1, 0), b3, voffB); PG8_STAGE(PG8_SB(1, 1), b3 + hstep, voffB); PG8_STAGE(PG8_SA(1, 0), a3, voffA);
            PG8_WAIT_V(8); PG8_WAIT_L(0); PG8_BAR; PG8_MMA(1, 0, At, B0); PG8_MMA(1, 1, At, B1); PG8_BAR; PG8_SCHED;
            } else {
            PG8_LDB(B0, 0, 0); PG8_SCHED; PG8_LDA(At, 0, 0); PG8_STAGE(PG8_SA(1, 1), a1 + hstep, voffA);
            PG8_WAIT_L(8); PG8_BAR; PG8_WAIT_L(0); PG8_MMA(0, 0, At, B0); PG8_BAR; PG8_SCHED;
            PG8_LDB(B1, 0, 1); PG8_STAGE(PG8_SB(0, 0), b2, voffB);
            PG8_BAR; PG8_WAIT_L(0); PG8_MMA(0, 1, At, B1); PG8_BAR;
            PG8_LDA(At, 0, 1); PG8_STAGE(PG8_SA(0, 0), a2, voffA);
            PG8_BAR; PG8_WAIT_L(0); PG8_MMA(1, 0, At, B0); PG8_BAR; PG8_SCHED;
            PG8_STAGE(PG8_SB(0, 1), b2 + hstep, voffB);
            PG8_WAIT_V(6); PG8_BAR; PG8_MMA(1, 1, At, B1); PG8_BAR;
            PG8_LDB(B0, 1, 0); PG8_SCHED; PG8_LDA(At, 1, 0); PG8_STAGE(PG8_SA(0, 1), a2 + hstep, voffA);
            PG8_WAIT_L(8); PG8_BAR; PG8_WAIT_L(0); PG8_MMA(0, 0, At, B0); PG8_BAR; PG8_SCHED;
            PG8_LDB(B1, 1, 1); PG8_STAGE(PG8_SB(1, 0), b3, voffB);
            PG8_BAR; PG8_WAIT_L(0); PG8_MMA(0, 1, At, B1); PG8_BAR;
            PG8_LDA(At, 1, 1); PG8_STAGE(PG8_SA(1, 0), a3, voffA);
            PG8_BAR; PG8_WAIT_L(0); PG8_MMA(1, 0, At, B0); PG8_BAR; PG8_SCHED;
            PG8_STAGE(PG8_SB(1, 1), b3 + hstep, voffB);
            PG8_WAIT_V(6); PG8_BAR; PG8_MMA(1, 1, At, B1); PG8_BAR;
            }
        }
        if constexpr (ALIGN_EPI) { if (wr == 0) PG8_BAR; }
        if constexpr (!Epi::AFTER_DRAIN) { E(acc, cur, wr, wc, fr, fq); S.done(cur); }
        if (!has_next) break;
#pragma unroll
        for (int a = 0; a < 2; ++a)
#pragma unroll
            for (int b = 0; b < 2; ++b)
#pragma unroll
                for (int m = 0; m < 4; ++m)
#pragma unroll
                    for (int n = 0; n < 2; ++n) acc[a][b][m][n] = (f32x4){0.f, 0.f, 0.f, 0.f};
        cur = nxt; cA = nA; cB = nB; ++ui;
        if constexpr (ALIGN_EPI) { if (wr == 1) PG8_BAR; }
    }
    PG8_WAIT_V(0);
    if constexpr (!ALIGN_EPI) { if (wr == 0) PG8_BAR; }
    PG8_BAR;
    if constexpr (Epi::AFTER_DRAIN) { E.fused(acc, cur, wr, wc, fr, fq, lds, wid, lane); S.done(cur); }
#undef PG8_SA
#undef PG8_SB
#undef PG8_STAGE
#undef PG8_LDA
#undef PG8_LDB
#undef PG8_MMA
#undef PG8_WAIT_V
#undef PG8_WAIT_L
#undef PG8_BAR
#undef PG8_SCHED
}
}

DEV void phase_inproj(const ParamsG& p, int l, int hf, int skew, unsigned char* smem) {
  pg8::Gemm g{(const bf16_t*)(p.ws + OFF_XB) + (size_t)hf * TH * DM, (const bf16_t*)(p.ws + OFF_WIN), TH, NPAD, DM};
  pg8::XcdOrder S; S.init(TH, NPAD, skew);
  pg8::EpiIn E{(bf16_t*)(p.ws + OFF_H), NPAD, (float*)(p.ws + OFF_SMALL), SM0 / 256};
  pg8::gemm_phase<pg8::EpiIn, pg8::XcdOrder, true, true>((PG8_LAS unsigned char*)smem, g, S, E);
}

DEV void phase_outproj(const ParamsG& p, int l, int hf, unsigned char* smem) {
  pg8::Gemm g{(const bf16_t*)(p.ws + OFF_MIXED), (const bf16_t*)(p.ws + OFF_WOUT), TH, DM, DI};
  pg8::XcdOrder S; S.init(TH, DM);
  const float* xin = (const float*)(((l == 0) ? p.x : (GAS const float*)p.out) + (size_t)hf * TH * DM);
  pg8::EpiOut E{xin, (float*)(p.out + (size_t)hf * TH * DM), DM, DN_ALPHA};
  pg8::gemm_phase<pg8::EpiOut, pg8::XcdOrder, true, true>((PG8_LAS unsigned char*)smem, g, S, E);
}

DEV void phase_ln(const ParamsG& p, int l, int hf) {
  const int tid = launder(threadIdx.x), lane = tid & 63, w = tid >> 6;
  const float* g = (const float*)(p.ln_g + l * DM); const float* b = (const float*)(p.ln_b + l * DM);
  bf16_t* xb = (bf16_t*)(p.ws + OFF_XB);
  for (int r0 = (blockIdx.x * 8 + w) * 4; r0 < TH; r0 += gridDim.x * 32) {
    f32x4 v[4][4];
#pragma unroll
    for (int i = 0; i < 4; ++i)
#pragma unroll
      for (int j = 0; j < 4; ++j) v[i][j] = ((const f32x4*)(p.out + (size_t)(hf * TH + r0 + i) * DM))[j * 64 + lane];
    f32x4 gg[4], bb[4];
#pragma unroll
    for (int j = 0; j < 4; ++j) { gg[j] = ((const f32x4*)g)[j * 64 + lane]; bb[j] = ((const f32x4*)b)[j * 64 + lane]; }
#pragma unroll
    for (int i = 0; i < 4; ++i) {
      const int row = hf * TH + r0 + i;
      float sm = 0.f;
#pragma unroll
      for (int j = 0; j < 4; ++j) sm += (v[i][j][0] + v[i][j][1]) + (v[i][j][2] + v[i][j][3]);
#pragma unroll
      for (int o = 32; o >= 1; o >>= 1) sm += __shfl_xor(sm, o);
      const float mu = sm * (1.f / DM);
      float q = 0.f;
#pragma unroll
      for (int j = 0; j < 4; ++j) { const f32x4 d = v[i][j] - mu; q += (d[0] * d[0] + d[1] * d[1]) + (d[2] * d[2] + d[3] * d[3]); }
#pragma unroll
      for (int o = 32; o >= 1; o >>= 1) q += __shfl_xor(q, o);
      const float rstd = rsqrtf(q * (1.f / DM) + 1e-5f);
#pragma unroll
      for (int j = 0; j < 4; ++j) {
        const f32x4 o = (v[i][j] - mu) * rstd * gg[j] + bb[j];
        ((f32x4*)(p.out + (size_t)row * DM))[j * 64 + lane] = o;
        if (l == 0) *(uint2*)(xb + (size_t)row * DM + (j * 64 + lane) * 4) = make_uint2(pk2(o[0], o[1]), pk2(o[2], o[3]));
      }
    }
  }
}

DEV void attn_item(const ParamsG& p, int l, int item, unsigned char* smem) {
  const int tid = launder(threadIdx.x), lane = tid & 63, w = tid >> 6, r = lane & 31, h = lane >> 5;
  const int qt = item & 15, head = (item >> 4) & 7, bl = item >> 7;
  const int kvh = head >> 2;
  bf16_t* Hh = (bf16_t*)(p.ws + OFF_H);
  const bf16_t* VT = (const bf16_t*)(p.ws + OFF_VT);
  const size_t rowbase = (size_t)bl * SEQ;
  float mq = fabsf(p.q_gain[l * 64 + lane]), mk = fabsf(p.k_gain[l * 64 + lane]);
#pragma unroll
  for (int o = 32; o >= 1; o >>= 1) { mq = fmaxf(mq, __shfl_xor(mq, o)); mk = fmaxf(mk, __shfl_xor(mk, o)); }
  const float M2 = 8.f * mq * mk * LOG2E * 1.01f;
  const int qrow = qt * 256 + w * 32 + r;
  const bf16_t* qp = Hh + (rowbase + qrow) * NPAD + A_Q + head * 64 + 8 * h;
  bf16x8 qf[4];
#pragma unroll
  for (int ks = 0; ks < 4; ++ks) qf[ks] = *(const bf16x8*)(qp + ks * 16);
  f32x16 o0 = zero16(), o1 = zero16();
  f32x2_t lsum2 = {0.f, 0.f};
  const int srow = tid >> 3, sch = (tid & 7) * 8;
  const bf16_t* kp = Hh + (rowbase + srow) * NPAD + A_K + kvh * 64 + sch;
  const bf16_t* vp = VT + ((size_t)((bl * 2 + kvh) * 64 + srow)) * SEQ + sch;
  union PB { bf16x8 v; unsigned u[4]; };
  auto qk = [&](int st, f32x16& s0, f32x16& s1) __attribute__((always_inline)) {
    const bf16_t* sK = (const bf16_t*)(smem + st * 18432);
#pragma unroll
    for (int i = 0; i < 16; ++i) { s0[i] = -M2; s1[i] = -M2; }
#pragma unroll
    for (int ks = 0; ks < 4; ++ks) {
      const bf16x8 a0 = *(const bf16x8*)(sK + r * 72 + ks * 16 + 8 * h);
      const bf16x8 a1 = *(const bf16x8*)(sK + (32 + r) * 72 + ks * 16 + 8 * h);
      s0 = __builtin_amdgcn_mfma_f32_32x32x16_bf16(a0, qf[ks], s0, 0, 0, 0);
      s1 = __builtin_amdgcn_mfma_f32_32x32x16_bf16(a1, qf[ks], s1, 0, 0, 0);
    }
  };
  auto soft = [&](f32x16& s0, f32x16& s1, PB (&pb)[2][2]) __attribute__((always_inline)) {
#pragma unroll
    for (int i = 0; i < 16; ++i) { s0[i] = __builtin_amdgcn_exp2f(s0[i]); s1[i] = __builtin_amdgcn_exp2f(s1[i]); lsum2 += (f32x2_t){s0[i], s1[i]}; }
#pragma unroll
    for (int s = 0; s < 2; ++s)
#pragma unroll
      for (int j = 0; j < 4; ++j) {
        pb[0][s].u[j] = pk2(s0[8 * s + 2 * j], s0[8 * s + 2 * j + 1]);
        pb[1][s].u[j] = pk2(s1[8 * s + 2 * j], s1[8 * s + 2 * j + 1]);
      }
  };
  auto pv = [&](int st, const PB (&pb)[2][2]) __attribute__((always_inline)) {
    const bf16_t* sV = (const bf16_t*)(smem + st * 18432 + 9216);
#pragma unroll
    for (int kt2 = 0; kt2 < 2; ++kt2)
#pragma unroll
      for (int s = 0; s < 2; ++s) {
        const int kb = kt2 * 32 + 16 * s + 4 * h;
        union { bf16x8 v; uint2 u[2]; } a0, a1;
        a0.u[0] = *(const uint2*)(sV + r * 72 + kb); a0.u[1] = *(const uint2*)(sV + r * 72 + kb + 8);
        a1.u[0] = *(const uint2*)(sV + (32 + r) * 72 + kb); a1.u[1] = *(const uint2*)(sV + (32 + r) * 72 + kb + 8);
        o0 = __builtin_amdgcn_mfma_f32_32x32x16_bf16(a0.v, pb[kt2][s].v, o0, 0, 0, 0);
        o1 = __builtin_amdgcn_mfma_f32_32x32x16_bf16(a1.v, pb[kt2][s].v, o1, 0, 0, 0);
      }
  };
  auto compute2 = [&](int sta, int stb) __attribute__((always_inline)) {
    f32x16 sa0, sa1, sb0, sb1; PB pa[2][2], pbb[2][2];
    qk(sta, sa0, sa1); qk(stb, sb0, sb1);
    soft(sa0, sa1, pa); pv(sta, pa);
    soft(sb0, sb1, pbb); pv(stb, pbb);
  };
  constexpr int NKT = SEQ / 64;
  auto sstore = [&](int st, const u32x4& kk, const u32x4& vv) __attribute__((always_inline)) {
    *(u32x4*)(smem + st * 18432 + srow * 144 + sch * 2) = kk;
    *(u32x4*)(smem + st * 18432 + 9216 + srow * 144 + sch * 2) = vv;
  };
  u32x4 k0 = *(const u32x4*)kp, v0 = *(const u32x4*)vp;
  u32x4 k1 = *(const u32x4*)(kp + (size_t)64 * NPAD), v1 = *(const u32x4*)(vp + 64);
  sstore(0, k0, v0); sstore(1, k1, v1);
  k0 = *(const u32x4*)(kp + (size_t)2 * 64 * NPAD); v0 = *(const u32x4*)(vp + 2 * 64);
  k1 = *(const u32x4*)(kp + (size_t)3 * 64 * NPAD); v1 = *(const u32x4*)(vp + 3 * 64);
  lds_barrier();
  for (int kt = 0; kt < NKT; kt += 4) {
    sstore(2, k0, v0); sstore(3, k1, v1);
    if (kt + 4 < NKT) {
      k0 = *(const u32x4*)(kp + (size_t)(kt + 4) * 64 * NPAD); v0 = *(const u32x4*)(vp + (kt + 4) * 64);
      k1 = *(const u32x4*)(kp + (size_t)(kt + 5) * 64 * NPAD); v1 = *(const u32x4*)(vp + (kt + 5) * 64);
    }
    compute2(0, 1);
    lds_barrier();
    if (kt + 4 < NKT) {
      sstore(0, k0, v0); sstore(1, k1, v1);
      if (kt + 6 < NKT) {
        k0 = *(const u32x4*)(kp + (size_t)(kt + 6) * 64 * NPAD); v0 = *(const u32x4*)(vp + (kt + 6) * 64);
        k1 = *(const u32x4*)(kp + (size_t)(kt + 7) * 64 * NPAD); v1 = *(const u32x4*)(vp + (kt + 7) * 64);
      }
    }
    compute2(2, 3);
    lds_barrier();
  }
  float lsum = lsum2[0] + lsum2[1];
  lsum += __shfl_xor(lsum, 32);
  const float inv = 1.f / lsum;
  const bf16_t* zp = Hh + (rowbase + qrow) * NPAD + A_Z + head * 64;
  bf16_t* op = Hh + (rowbase + qrow) * NPAD + A_Q + head * 64;
#pragma unroll
  for (int dt = 0; dt < 2; ++dt)
#pragma unroll
    for (int g = 0; g < 4; ++g) {
      const int d0 = dt * 32 + 8 * g + 4 * h;
      const uint2 zz = *(const uint2*)(zp + d0);
      const float z0 = bf2f((bf16_t)(zz.x & 0xffff)), z1 = bf2f((bf16_t)(zz.x >> 16)), z2 = bf2f((bf16_t)(zz.y & 0xffff)), z3 = bf2f((bf16_t)(zz.y >> 16));
      const f32x16& oo = dt ? o1 : o0;
      uint2 ov;
      ov.x = pk2(oo[4 * g + 0] * inv * fsilu(z0), oo[4 * g + 1] * inv * fsilu(z1));
      ov.y = pk2(oo[4 * g + 2] * inv * fsilu(z2), oo[4 * g + 3] * inv * fsilu(z3));
      *(uint2*)(op + d0) = ov;
    }
  lds_barrier();
}

constexpr int L_QT = 0, L_KT = 17408, L_QC = 34816, L_KHT = 52224, L_VT = 70656, L_ST = 89088,
              L_D = 123904, L_TOT = 124416, L_ACS = 128512, L_DT = 129024;

template <int K, int V> struct ScanGeom {
  static constexpr int KP = K + 8;
  static constexpr int NS = (K / 32) * (V / 32) / 8;
};

template <int K, int V>
DEV void scan_write_state(unsigned char* smem, const f32x16* S, int w, int lane) {
  constexpr int KP = K + 8, NS = ScanGeom<K, V>::NS, NVT = V / 32;
  bf16_t* sST = (bf16_t*)(smem + L_ST);
  const int c = lane & 31, h = lane >> 5;
#pragma unroll
  for (int i = 0; i < NS; ++i) {
    const int tile = w * NS + i, kt = tile / NVT, nt = tile % NVT;
#pragma unroll
    for (int g = 0; g < 4; ++g) {
      uint2 o; o.x = pk2(S[i][4 * g + 0], S[i][4 * g + 1]); o.y = pk2(S[i][4 * g + 2], S[i][4 * g + 3]);
      *(uint2*)(sST + (nt * 32 + c) * KP + kt * 32 + 8 * g + 4 * h) = o;
    }
  }
}

template <int K, int V, bool SSDM>
DEV void scan_core(unsigned char* smem, f32x16* S, bf16_t* orow0, int dir, int w, int lane, bool do_out, const float* sAcs) {
  constexpr int KP = K + 8, NS = ScanGeom<K, V>::NS, NVT = V / 32, NOT = 2 * NVT;
  const bf16_t* sQt = (const bf16_t*)(smem + L_QT); const bf16_t* sKt = (const bf16_t*)(smem + L_KT);
  const bf16_t* sQc = (const bf16_t*)(smem + L_QC); const bf16_t* sKhT = (const bf16_t*)(smem + L_KHT);
  const bf16_t* sVT = (const bf16_t*)(smem + L_VT);
  const bf16_t* sST = (const bf16_t*)(smem + L_ST); const float* sD = (const float*)(smem + L_D);
  const int c = lane & 31, h = lane >> 5;
  if (do_out && w < NOT) {
    const int tt = w / NVT, nt = w % NVT;
    f32x16 acc = zero16();
#pragma unroll
    for (int st = 0; st < 2; ++st) {
      if (st <= tt) {
        f32x16 pt = zero16();
        mma32<K>(pt, sKt + st * 32 * KP, KP, sQt + tt * 32 * KP, KP, lane);
        const int tau = tt * 32 + c;
        const float at = SSDM ? sAcs[tau] : 0.f;
#pragma unroll
        for (int reg = 0; reg < 16; ++reg) {
          const int sig = st * 32 + rowoff(reg, h);
          float v = pt[reg];
          if (SSDM) v *= ex2(at - sAcs[sig]);
          pt[reg] = (sig <= tau) ? v : 0.f;
        }
#pragma unroll
        for (int s2 = 0; s2 < 2; ++s2) {
          union { bf16x8 v; unsigned u[4]; } pa;
#pragma unroll
          for (int j = 0; j < 4; ++j) pa.u[j] = pk2(pt[8 * s2 + 2 * j], pt[8 * s2 + 2 * j + 1]);
          const int kb = st * 32 + 16 * s2 + 4 * h;
          union { bf16x8 v; uint2 u[2]; } vb;
          vb.u[0] = *(const uint2*)(sVT + (nt * 32 + c) * 72 + kb); vb.u[1] = *(const uint2*)(sVT + (nt * 32 + c) * 72 + kb + 8);
          acc = __builtin_amdgcn_mfma_f32_32x32x16_bf16(pa.v, vb.v, acc, 0, 0, 0);
        }
      }
    }
    mma32<K>(acc, sQc + tt * 32 * KP, KP, sST + nt * 32 * KP, KP, lane);
#pragma unroll
    for (int reg = 0; reg < 16; ++reg) {
      const int tau = tt * 32 + rowoff(reg, h);
      const int tok = dir ? (63 - tau) : tau;
      orow0[(size_t)tok * 512 + nt * 32 + c] = f2bf(acc[reg]);
    }
  }
#pragma unroll
  for (int i = 0; i < NS; ++i) {
    const int tile = w * NS + i, kt = tile / NVT, nt = tile % NVT;
#pragma unroll
    for (int reg = 0; reg < 16; ++reg) S[i][reg] *= sD[kt * 32 + rowoff(reg, h)];
    mma32<64>(S[i], sKhT + kt * 32 * 72, 72, sVT + nt * 32 * 72, 72, lane);
  }
}

template <int K, int V>
DEV void state_store(float* buf, const f32x16* S, int w, int lane) {
  constexpr int NS = ScanGeom<K, V>::NS, NVT = V / 32;
  const int c = lane & 31, h = lane >> 5;
#pragma unroll
  for (int i = 0; i < NS; ++i) {
    const int tile = w * NS + i, kt = tile / NVT, nt = tile % NVT;
#pragma unroll
    for (int reg = 0; reg < 16; ++reg) buf[(kt * 32 + rowoff(reg, h)) * V + nt * 32 + c] = S[i][reg];
  }
}
template <int K, int V>
DEV void state_load(const float* buf, f32x16* S, int w, int lane) {
  constexpr int NS = ScanGeom<K, V>::NS, NVT = V / 32;
  const int c = lane & 31, h = lane >> 5;
#pragma unroll
  for (int i = 0; i < NS; ++i) {
    const int tile = w * NS + i, kt = tile / NVT, nt = tile % NVT;
#pragma unroll
    for (int reg = 0; reg < 16; ++reg) S[i][reg] = buf[(kt * 32 + rowoff(reg, h)) * V + nt * 32 + c];
  }
}

template <int K, int V>
DEV void state_combine(const float* ubase, int ustride, const float* dbase, int seg, f32x16* S, int w, int lane) {
  constexpr int NS = ScanGeom<K, V>::NS, NVT = V / 32;
  const int c = lane & 31, h = lane >> 5;
  for (int j = 0; j < seg; ++j) {
    const float* buf = ubase + (size_t)j * ustride;
    const float* dj = dbase + j * 128;
#pragma unroll
    for (int i = 0; i < NS; ++i) {
      const int tile = w * NS + i, kt = tile / NVT, nt = tile % NVT;
#pragma unroll
      for (int reg = 0; reg < 16; ++reg) {
        const int k = kt * 32 + rowoff(reg, h);
        const float u = buf[k * V + nt * 32 + c];
        S[i][reg] = (j > 0 ? dj[k] * S[i][reg] : 0.f) + u;
      }
    }
  }
}

#define PACK8_LO(v) (u32x4){((v)[0] & 0xffffu) | ((v)[1] << 16), ((v)[2] & 0xffffu) | ((v)[3] << 16), ((v)[4] & 0xffffu) | ((v)[5] << 16), ((v)[6] & 0xffffu) | ((v)[7] << 16)}
#define PACK8_HI(v) (u32x4){((v)[0] >> 16) | ((v)[1] & 0xffff0000u), ((v)[2] >> 16) | ((v)[3] & 0xffff0000u), ((v)[4] >> 16) | ((v)[5] & 0xffff0000u), ((v)[6] >> 16) | ((v)[7] & 0xffff0000u)}
#define CVT8(f) (u32x4){pk2((f)[0], (f)[1]), pk2((f)[2], (f)[3]), pk2((f)[4], (f)[5]), pk2((f)[6], (f)[7])}


DEV void hgrn_item(const ParamsG& p, int l, int it, int seg, int mode, unsigned char* smem) {
  const int bl = it >> 3, head = (it >> 1) & 3, dir = it & 1;
  const bool do_out = (mode == 3);
  constexpr int K = 128, V = 128, KPW = 68;
  const int tid = launder(threadIdx.x), lane = tid & 63, w = tid >> 6;
  const int cp = tid & 63, tg = tid >> 6, ch0 = 2 * cp;
  const bf16_t* Hh = (const bf16_t*)(p.ws + OFF_H);
  bf16_t* OB = (bf16_t*)(p.ws + OFF_OBUF) + (size_t)(0 * 2 + dir) * TH * 512;
  const size_t rowbase = (size_t)bl * SEQ;
  float lb0 = 0.f, lb1 = 0.f;
  if (l > 0) {
    lb0 = fsigmoid(p.lb_logits[512 + head * 128 + ch0] - p.lb_logits[head * 128 + ch0]);
    lb1 = fsigmoid(p.lb_logits[512 + head * 128 + ch0 + 1] - p.lb_logits[head * 128 + ch0 + 1]);
  }
  const float om0 = 1.f - lb0, om1 = 1.f - lb1;
  const int fbase = dir ? H_FB : H_FF;
  unsigned* sQt = (unsigned*)(smem + L_QT); unsigned* sKt = (unsigned*)(smem + L_KT); unsigned* sQc = (unsigned*)(smem + L_QC);
  bf16_t* sKhT = (bf16_t*)(smem + L_KHT); bf16_t* sVT = (bf16_t*)(smem + L_VT);
  float* sD = (float*)(smem + L_D); float* sTot = (float*)(smem + L_TOT);
  f32x16 S[2]; S[0] = zero16(); S[1] = zero16();
  float* sbuf = (float*)(p.ws + OFF_SB0) + ((size_t)it * NSEG + seg) * 16384;
  if (do_out) state_combine<K, V>((const float*)(p.ws + OFF_SB0) + (size_t)it * NSEG * 16384, 16384, (const float*)(p.ws + OFF_DB) + (size_t)it * NSEG * 128, seg, S, w, lane);
  float dlog0 = 0.f, dlog1 = 0.f;
  unsigned pf[8], qq[8], vv[8];
  float g0[8], g1[8], kx0[8], kx1[8];
  auto gloadA = [&](int cidx) __attribute__((always_inline)) {
    const int chunk = dir ? (63 - cidx) : cidx;
#pragma unroll
    for (int i = 0; i < 8; ++i) {
      const int tau = 8 * tg + i;
      const int tok = chunk * 64 + (dir ? (63 - tau) : tau);
      pf[i] = ((const unsigned*)(Hh + (rowbase + tok) * NPAD + head * 128 + fbase))[cp];
    }
  };
  auto gloadB = [&](int cidx) __attribute__((always_inline)) {
    const int chunk = dir ? (63 - cidx) : cidx;
#pragma unroll
    for (int i = 0; i < 8; ++i) {
      const int tau = 8 * tg + i;
      const int tok = chunk * 64 + (dir ? (63 - tau) : tau);
      const unsigned* rp = (const unsigned*)(Hh + (rowbase + tok) * NPAD + head * 128) + cp;
      vv[i] = rp[H_I / 2];
      qq[i] = do_out ? rp[H_Q / 2] : 0u;
    }
  };
  auto stage1 = [&]() __attribute__((always_inline)) {
    float r0 = 0.f, r1 = 0.f;
#pragma unroll
    for (int i = 0; i < 8; ++i) {
      const float e0 = ex2(fminf(-lo16(pf[i]) * LOG2E, 80.f)), e1 = ex2(fminf(-hi16(pf[i]) * LOG2E, 80.f));
      const float s0 = frcp(1.f + e0), s1 = frcp(1.f + e1);
      r0 += lg2(lb0 + om0 * s0); r1 += lg2(lb1 + om1 * s1);
      g0[i] = r0; g1[i] = r1;
      kx0[i] = om0 * e0 * s0; kx1[i] = om1 * e1 * s1;
    }
    *(float2*)(sTot + tg * 128 + ch0) = make_float2(r0, r1);
  };
  gloadA(seg * SLEN); gloadB(seg * SLEN);
  stage1();
  if (SLEN > 1) gloadA(seg * SLEN + 1);
  for (int ci = 0; ci < SLEN; ++ci) {
    const int cidx = seg * SLEN + ci;
    const int chunk = dir ? (63 - cidx) : cidx;
    lds_barrier();
    float off0 = 0.f, off1 = 0.f, ref0 = 0.f, ref1 = 0.f, be0 = 0.f, be1 = 0.f;
#pragma unroll
    for (int j = 0; j < 8; ++j) {
      const float2 t = *(const float2*)(sTot + j * 128 + ch0);
      if (j < tg) { off0 += t.x; off1 += t.y; }
      if (j < 4) { ref0 += t.x; ref1 += t.y; }
      be0 += t.x; be1 += t.y;
    }
    dlog0 += be0; dlog1 += be1;
    const float eref0 = ex2(ref0), eref1 = ex2(ref1), ebr0 = ex2(be0 - ref0), ebr1 = ex2(be1 - ref1);
    const float d0 = off0 - ref0, d1 = off1 - ref1;
    float kh0[8], kh1[8];
#pragma unroll
    for (int i = 0; i < 8; ++i) {
      const int tau = 8 * tg + i;
      const float E0 = ex2(g0[i] + d0), E1 = ex2(g1[i] + d1);
      const float kt0 = kx0[i] * frcp(E0), kt1 = kx1[i] * frcp(E1);
      if (do_out) {
        const float qt0 = lo16(qq[i]) * E0, qt1 = hi16(qq[i]) * E1;
        sQt[tau * KPW + cp] = pk2(qt0, qt1);
        sKt[tau * KPW + cp] = pk2(kt0, kt1);
        sQc[tau * KPW + cp] = pk2(qt0 * eref0, qt1 * eref1);
      }
      kh0[i] = kt0 * ebr0; kh1[i] = kt1 * ebr1;
    }
    *(u32x4*)(sKhT + ch0 * 72 + 8 * tg) = CVT8(kh0);
    *(u32x4*)(sKhT + (ch0 + 1) * 72 + 8 * tg) = CVT8(kh1);
    *(u32x4*)(sVT + ch0 * 72 + 8 * tg) = PACK8_LO(vv);
    *(u32x4*)(sVT + (ch0 + 1) * 72 + 8 * tg) = PACK8_HI(vv);
    if (tg == 0) *(float2*)(sD + ch0) = make_float2(ex2(be0), ex2(be1));
    if (do_out) scan_write_state<K, V>(smem, S, w, lane);
    if (ci + 1 < SLEN) gloadB(cidx + 1);
    lds_barrier();
    scan_core<K, V, false>(smem, S, OB + (rowbase + (size_t)chunk * 64) * 512 + head * 128, dir, w, lane, do_out, nullptr);
    if (ci + 1 < SLEN) { stage1(); if (ci + 2 < SLEN) gloadA(cidx + 2); }
  }
  if (!do_out) {
    state_store<K, V>(sbuf, S, w, lane);
    if (tg == 0) *(float2*)((float*)(p.ws + OFF_DB) + ((size_t)it * NSEG + seg) * 128 + ch0) = make_float2(ex2(dlog0), ex2(dlog1));
  }
  lds_barrier();
}

DEV void gla_item(const ParamsG& p, int l, int it, int seg, int mode, unsigned char* smem) {
  const int j16 = it - 16, bl = j16 >> 3, head = (j16 >> 1) & 3, dir = j16 & 1;
  const bool do_out = (mode == 3);
  constexpr int K = 64, V = 128, KPW = 36;
  const int tid = launder(threadIdx.x), lane = tid & 63, w = tid >> 6;
  const int cp = tid & 31, tg = tid >> 5, ch0 = 2 * cp;
  const int vp2 = tid & 63, vg = tid >> 6;
  const bf16_t* Hh = (const bf16_t*)(p.ws + OFF_H);
  const bf16_t* Gb = (const bf16_t*)(p.ws + OFF_G);
  bf16_t* OB = (bf16_t*)(p.ws + OFF_OBUF) + (size_t)(2 * 2 + dir) * TH * 512;
  const size_t rowbase = (size_t)bl * SEQ;
  unsigned* sQt = (unsigned*)(smem + L_QT); unsigned* sKt = (unsigned*)(smem + L_KT); unsigned* sQc = (unsigned*)(smem + L_QC);
  bf16_t* sKhT = (bf16_t*)(smem + L_KHT); bf16_t* sVT = (bf16_t*)(smem + L_VT);
  float* sD = (float*)(smem + L_D); float* sTot = (float*)(smem + L_TOT);
  f32x16 S[1]; S[0] = zero16();
  float* sbuf = (float*)(p.ws + OFF_SB1) + ((size_t)j16 * NSEG + seg) * 8192;
  if (do_out) state_combine<K, V>((const float*)(p.ws + OFF_SB1) + (size_t)j16 * NSEG * 8192, 8192, (const float*)(p.ws + OFF_DB) + (size_t)it * NSEG * 128, seg, S, w, lane);
  float dlog0 = 0.f, dlog1 = 0.f;
  unsigned pg[4];
  float g0[4], g1[4]; unsigned kk[4], qq[4], vv[8];
  auto gloadA = [&](int cidx) __attribute__((always_inline)) {
    const int chunk = dir ? (63 - cidx) : cidx;
#pragma unroll
    for (int i = 0; i < 4; ++i) {
      const int tau = 4 * tg + i;
      const int tok = chunk * 64 + (dir ? (63 - tau) : tau);
      pg[i] = ((const unsigned*)(Gb + (rowbase + tok) * 512 + dir * 256 + head * 64))[cp];
    }
  };
  auto gloadB = [&](int cidx) __attribute__((always_inline)) {
    const int chunk = dir ? (63 - cidx) : cidx;
#pragma unroll
    for (int i = 0; i < 4; ++i) {
      const int tau = 4 * tg + i;
      const int tok = chunk * 64 + (dir ? (63 - tau) : tau);
      const unsigned* rp = (const unsigned*)(Hh + (rowbase + tok) * NPAD + head * 64) + cp;
      kk[i] = rp[G_K / 2]; qq[i] = do_out ? rp[G_Q / 2] : 0u;
    }
#pragma unroll
    for (int i = 0; i < 8; ++i) {
      const int tau = 8 * vg + i;
      const int tok = chunk * 64 + (dir ? (63 - tau) : tau);
      vv[i] = ((const unsigned*)(Hh + (rowbase + tok) * NPAD + G_V + head * 128))[vp2];
    }
  };
  auto stage1 = [&]() __attribute__((always_inline)) {
    float r0 = 0.f, r1 = 0.f;
#pragma unroll
    for (int i = 0; i < 4; ++i) { r0 += lo16(pg[i]); r1 += hi16(pg[i]); g0[i] = r0; g1[i] = r1; }
    *(float2*)(sTot + tg * 64 + ch0) = make_float2(r0, r1);
  };
  gloadA(seg * SLEN); gloadB(seg * SLEN);
  stage1();
  if (SLEN > 1) gloadA(seg * SLEN + 1);
  for (int ci = 0; ci < SLEN; ++ci) {
    const int cidx = seg * SLEN + ci;
    const int chunk = dir ? (63 - cidx) : cidx;
    lds_barrier();
    float off0 = 0.f, off1 = 0.f, ref0 = 0.f, ref1 = 0.f, be0 = 0.f, be1 = 0.f;
#pragma unroll
    for (int j = 0; j < 16; ++j) {
      const float2 t = *(const float2*)(sTot + j * 64 + ch0);
      if (j < tg) { off0 += t.x; off1 += t.y; }
      if (j < 8) { ref0 += t.x; ref1 += t.y; }
      be0 += t.x; be1 += t.y;
    }
    dlog0 += be0; dlog1 += be1;
    const float eref0 = ex2(ref0), eref1 = ex2(ref1), ebr0 = ex2(be0 - ref0), ebr1 = ex2(be1 - ref1);
    const float d0 = off0 - ref0, d1 = off1 - ref1;
    float kh0[4], kh1[4];
#pragma unroll
    for (int i = 0; i < 4; ++i) {
      const int tau = 4 * tg + i;
      const float E0 = ex2(g0[i] + d0), E1 = ex2(g1[i] + d1);
      const float kt0 = lo16(kk[i]) * frcp(E0), kt1 = hi16(kk[i]) * frcp(E1);
      if (do_out) {
        const float qt0 = lo16(qq[i]) * E0, qt1 = hi16(qq[i]) * E1;
        sQt[tau * KPW + cp] = pk2(qt0, qt1);
        sKt[tau * KPW + cp] = pk2(kt0, kt1);
        sQc[tau * KPW + cp] = pk2(qt0 * eref0, qt1 * eref1);
      }
      kh0[i] = kt0 * ebr0; kh1[i] = kt1 * ebr1;
    }
    *(uint2*)(sKhT + ch0 * 72 + 4 * tg) = make_uint2(pk2(kh0[0], kh0[1]), pk2(kh0[2], kh0[3]));
    *(uint2*)(sKhT + (ch0 + 1) * 72 + 4 * tg) = make_uint2(pk2(kh1[0], kh1[1]), pk2(kh1[2], kh1[3]));
    *(u32x4*)(sVT + (2 * vp2) * 72 + 8 * vg) = PACK8_LO(vv);
    *(u32x4*)(sVT + (2 * vp2 + 1) * 72 + 8 * vg) = PACK8_HI(vv);
    if (tg == 0) *(float2*)(sD + ch0) = make_float2(ex2(be0), ex2(be1));
    if (do_out) scan_write_state<K, V>(smem, S, w, lane);
    if (ci + 1 < SLEN) gloadB(cidx + 1);
    lds_barrier();
    scan_core<K, V, false>(smem, S, OB + (rowbase + (size_t)chunk * 64) * 512 + head * 128, dir, w, lane, do_out, nullptr);
    if (ci + 1 < SLEN) { stage1(); if (ci + 2 < SLEN) gloadA(cidx + 2); }
  }
  if (!do_out) {
    state_store<K, V>(sbuf, S, w, lane);
    if (tg == 0) *(float2*)((float*)(p.ws + OFF_DB) + ((size_t)it * NSEG + seg) * 128 + ch0) = make_float2(ex2(dlog0), ex2(dlog1));
  }
  lds_barrier();
}

DEV void ssd_item(const ParamsG& p, int l, int it, int seg, int mode, unsigned char* smem) {
  const int j32 = it - 32, bl = j32 >> 4, head = (j32 >> 1) & 7, dir = j32 & 1;
  const bool do_out = (mode == 3);
  constexpr int K = 128, V = 64, KPW = 68;
  const int tid = launder(threadIdx.x), lane = tid & 63, w = tid >> 6;
  const int cp = tid & 63, tg = tid >> 6, n0 = 2 * cp;
  const int xp = tid & 31, xg = tid >> 5;
  const int grp = head >> 2;
  const bf16_t* U = (const bf16_t*)(p.ws + OFF_U);
  const float* SMALL = (const float*)(p.ws + OFF_SMALL);
  bf16_t* OB = (bf16_t*)(p.ws + OFF_OBUF) + (size_t)(1 * 2 + dir) * TH * 512;
  const size_t rowbase = (size_t)bl * SEQ;
  unsigned* sQt = (unsigned*)(smem + L_QT); unsigned* sKt = (unsigned*)(smem + L_KT); unsigned* sQc = (unsigned*)(smem + L_QC);
  bf16_t* sKhT = (bf16_t*)(smem + L_KHT); bf16_t* sVT = (bf16_t*)(smem + L_VT);
  float* sD = (float*)(smem + L_D);
  const float dtb = p.dt_bias[(l * 2 + dir) * 8 + head];
  const float Acoef = -__expf(p.a_log[(l * 2 + dir) * 8 + head]) * LOG2E;
  f32x16 S[1]; S[0] = zero16();
  float* sbuf = (float*)(p.ws + OFF_SB2) + ((size_t)j32 * NSEG + seg) * 8192;
  if (do_out) state_combine<K, V>((const float*)(p.ws + OFF_SB2) + (size_t)j32 * NSEG * 8192, 8192, (const float*)(p.ws + OFF_DB) + (size_t)it * NSEG * 128, seg, S, w, lane);
  float dlog = 0.f;
  unsigned bb[8], cc[8], xx[4];
  float rdt = 0.f;
  auto gloadA = [&](int cidx) __attribute__((always_inline)) {
    const int chunk = dir ? (63 - cidx) : cidx;
    if (w == 0) {
      const int tok = chunk * 64 + (dir ? (63 - lane) : lane);
      rdt = SMALL[(rowbase + tok) * 48 + dir * 8 + head];
    }
  };
  auto gloadB = [&](int cidx) __attribute__((always_inline)) {
    const int chunk = dir ? (63 - cidx) : cidx;
#pragma unroll
    for (int i = 0; i < 8; ++i) {
      const int tau = 8 * tg + i;
      const int tok = chunk * 64 + (dir ? (63 - tau) : tau);
      const unsigned* rp = (const unsigned*)(U + (rowbase + tok) * 1024 + grp * 128) + cp;
      bb[i] = rp[512 / 2]; cc[i] = do_out ? rp[768 / 2] : 0u;
    }
#pragma unroll
    for (int i = 0; i < 4; ++i) {
      const int tau = 4 * xg + i;
      const int tok = chunk * 64 + (dir ? (63 - tau) : tau);
      xx[i] = ((const unsigned*)(U + (rowbase + tok) * 1024 + head * 64))[xp];
    }
  };
  auto stage1 = [&](int par) __attribute__((always_inline)) {
    if (w == 0) {
      const float xv = rdt + dtb;
      const float dt = (xv > 20.f) ? xv : log1pf(__expf(xv));
      float a = dt * Acoef;
#pragma unroll
      for (int o = 1; o < 64; o <<= 1) { const float t = __shfl_up(a, o); if (lane >= o) a += t; }
      ((float*)(smem + L_ACS))[par * 64 + lane] = a; ((float*)(smem + L_DT))[par * 64 + lane] = dt;
    }
  };
  gloadA(seg * SLEN); gloadB(seg * SLEN);
  stage1(0);
  if (SLEN > 1) gloadA(seg * SLEN + 1);
  for (int ci = 0; ci < SLEN; ++ci) {
    const int cidx = seg * SLEN + ci;
    const int chunk = dir ? (63 - cidx) : cidx;
    const float* sAcs = (const float*)(smem + L_ACS) + (ci & 1) * 64;
    const float* sDt = (const float*)(smem + L_DT) + (ci & 1) * 64;
    lds_barrier();
    const float aend = sAcs[63];
    dlog += aend;
    {
      float kh0[8], kh1[8];
#pragma unroll
      for (int i = 0; i < 8; ++i) {
        const int tau = 8 * tg + i;
        const float ac = sAcs[tau];
        const float eb = ex2(aend - ac);
        kh0[i] = lo16(bb[i]) * eb; kh1[i] = hi16(bb[i]) * eb;
        if (do_out) {
          const float ea = ex2(ac);
          sKt[tau * KPW + cp] = bb[i];
          sQt[tau * KPW + cp] = cc[i];
          sQc[tau * KPW + cp] = pk2(lo16(cc[i]) * ea, hi16(cc[i]) * ea);
        }
      }
      *(u32x4*)(sKhT + n0 * 72 + 8 * tg) = CVT8(kh0);
      *(u32x4*)(sKhT + (n0 + 1) * 72 + 8 * tg) = CVT8(kh1);
      float x0[4], x1[4];
#pragma unroll
      for (int i = 0; i < 4; ++i) { const float dtv = sDt[4 * xg + i]; x0[i] = lo16(xx[i]) * dtv; x1[i] = hi16(xx[i]) * dtv; }
      *(uint2*)(sVT + (2 * xp) * 72 + 4 * xg) = make_uint2(pk2(x0[0], x0[1]), pk2(x0[2], x0[3]));
      *(uint2*)(sVT + (2 * xp + 1) * 72 + 4 * xg) = make_uint2(pk2(x1[0], x1[1]), pk2(x1[2], x1[3]));
      if (tg == 0) *(float2*)(sD + n0) = make_float2(ex2(aend), ex2(aend));
    }
    if (do_out) scan_write_state<K, V>(smem, S, w, lane);
    if (ci + 1 < SLEN) gloadB(cidx + 1);
    lds_barrier();
    scan_core<K, V, true>(smem, S, OB + (rowbase + (size_t)chunk * 64) * 512 + head * 64, dir, w, lane, do_out, sAcs);
    if (ci + 1 < SLEN) { stage1((ci + 1) & 1); if (ci + 2 < SLEN) gloadA(cidx + 2); }
  }
  if (!do_out) {
    state_store<K, V>(sbuf, S, w, lane);
    if (tg == 0) *(float2*)((float*)(p.ws + OFF_DB) + ((size_t)it * NSEG + seg) * 128 + n0) = make_float2(ex2(dlog), ex2(dlog));
  }
  lds_barrier();
}

DEV void phase_prep(const ParamsG& p, int l, int hf, int rep, unsigned char* smem) {
  const int tid = launder(threadIdx.x), lane = tid & 63;
  bf16_t* Hh = (bf16_t*)(p.ws + OFF_H);
  bf16_t* U = (bf16_t*)(p.ws + OFF_U);
  bf16_t* Gb = (bf16_t*)(p.ws + OFF_G);
  bf16_t* VT = (bf16_t*)(p.ws + OFF_VT);
  const float* SMALLp = (const float*)(p.ws + OFF_SMALL);
  float2* stab = (float2*)smem;
  float* slow = (float*)(smem + 8192);
  bf16_t* sT = (bf16_t*)(smem + 12288);
  {
    const float2* tabg = (const float2*)(p.ws + OFF_TAB);
    for (int i = tid; i < 1024; i += NT) stab[i] = tabg[i];
  }
  const int cg8 = (tid & 127) * 8, rsub = tid >> 7;
  const float* cw = (const float*)(p.conv_w + (size_t)l * 5 * 1024); const float* cb = (const float*)(p.conv_b + (size_t)l * 1024);
  float wv[5][8], bv[8];
#pragma unroll
  for (int j = 0; j < 5; ++j)
#pragma unroll
    for (int e = 0; e < 8; ++e) wv[j][e] = cw[j * 1024 + cg8 + e];
#pragma unroll
  for (int e = 0; e < 8; ++e) bv[e] = cb[cg8 + e];
  const int gd = tid >> 8, gc = tid & 255;
  const int i16 = lane & 15;
  const float* gq = (const float*)(p.q_gain + l * 64 + 4 * i16); const float* gk = (const float*)(p.k_gain + l * 64 + 4 * i16);
  const float gqv[4] = {gq[0], gq[1], gq[2], gq[3]}, gkv[4] = {gk[0], gk[1], gk[2], gk[3]};
  for (int grp = blockIdx.x; grp < TH / 32; grp += gridDim.x) {
    const int r0 = grp * 32;
    lds_barrier();
    const u32x4 vt = *(const u32x4*)(Hh + (size_t)(r0 + (tid >> 4)) * NPAD + A_V + (tid & 15) * 8);
    const float2 lowv = *(const float2*)(SMALLp + (size_t)(r0 + (tid >> 4)) * 48 + 16 + (tid & 15) * 2);
    *(u32x4*)(sT + (tid >> 4) * 136 + (tid & 15) * 8) = vt;
    *(float2*)(slow + (tid >> 4) * 32 + (tid & 15) * 2) = lowv;
#pragma unroll 1
    for (int ps = 0; ps < 2; ++ps) {
      const int ra = r0 + 16 * ps + 4 * rsub, ta = ra & (SEQ - 1);
      u32x4 xc[8];
#pragma unroll
      for (int m = 0; m < 8; ++m) {
        const int sq = ta + m - 2;
        xc[m] = (u32x4){0u, 0u, 0u, 0u};
        if (sq >= 0 && sq < SEQ) xc[m] = *(const u32x4*)(Hh + (size_t)(ra + m - 2) * NPAD + S_X + cg8);
      }
#pragma unroll
      for (int o4 = 0; o4 < 4; ++o4) {
        float u[8];
#pragma unroll
        for (int e = 0; e < 8; ++e) u[e] = bv[e];
#pragma unroll
        for (int j = 0; j < 5; ++j)
#pragma unroll
          for (int e = 0; e < 4; ++e) { u[2 * e] += wv[j][2 * e] * lo16(xc[o4 + j][e]); u[2 * e + 1] += wv[j][2 * e + 1] * hi16(xc[o4 + j][e]); }
        u32x4 o;
#pragma unroll
        for (int e = 0; e < 4; ++e) {
          const float a = u[2 * e] * frcp(1.f + ex2(fminf(-u[2 * e] * LOG2E, 80.f)));
          const float b = u[2 * e + 1] * frcp(1.f + ex2(fminf(-u[2 * e + 1] * LOG2E, 80.f)));
          o[e] = pk2(a, b);
        }
        *(u32x4*)(U + (size_t)(ra + o4) * 1024 + cg8) = o;
      }
    }
    lds_barrier();
    if (rep == 0) {
#pragma unroll 1
      for (int ub = 0; ub < 10; ub += 5) {
        uint2 xq[5];
#pragma unroll
        for (int u = 0; u < 5; ++u) {
          const int pi = (ub + u) * 32 + (tid >> 4), row = r0 + pi / 10, hd = pi % 10;
          xq[u] = *(const uint2*)(Hh + (size_t)row * NPAD + ((hd < 8) ? (A_Q + hd * 64) : (A_K + (hd - 8) * 64)) + 4 * i16);
        }
#pragma unroll
        for (int u = 0; u < 5; ++u) {
          const int pi = (ub + u) * 32 + (tid >> 4), row = r0 + pi / 10, hd = pi % 10;
          const bool isq = hd < 8;
          const float x[4] = {lo16(xq[u].x), hi16(xq[u].x), lo16(xq[u].y), hi16(xq[u].y)};
          float ss = x[0] * x[0] + x[1] * x[1] + x[2] * x[2] + x[3] * x[3];
          ss += __shfl_xor(ss, 1); ss += __shfl_xor(ss, 2); ss += __shfl_xor(ss, 4); ss += __shfl_xor(ss, 8);
          const float rstd = rsqrtf(ss * (1.f / 64.f) + 1e-6f);
          const int t = row & (SEQ - 1);
          const int pos = (i16 < 8) ? (t >> 6) : (t & 63);
          const float osc = isq ? QSCALE : 1.f;
          float o[4];
#pragma unroll
          for (int e = 0; e < 4; ++e) {
            const float v = x[e] * rstd * (isq ? gqv[e] : gkv[e]);
            const float pv = __shfl_xor(v, 4);
            const float2 cs = stab[pos * 16 + 4 * (i16 & 3) + e];
            o[e] = ((i16 & 4) ? (v * cs.x + pv * cs.y) : (v * cs.x - pv * cs.y)) * osc;
          }
          *(uint2*)(Hh + (size_t)row * NPAD + (isq ? (A_Q + hd * 64) : (A_K + (hd - 8) * 64)) + 4 * i16) = make_uint2(pk2(o[0], o[1]), pk2(o[2], o[3]));
        }
      }
    }
    float w2c[16];
#pragma unroll
    for (int r = 0; r < 16; ++r) w2c[r] = p.gk_w2[((size_t)(l * 2 + gd) * 16 + r) * 256 + gc];
    const float gbias = p.gk_b[(l * 2 + gd) * 256 + gc];
#pragma unroll 4
    for (int rr = 0; rr < 32; ++rr) {
      const float4* lp4 = (const float4*)(slow + rr * 32 + gd * 16);
      float gkk = gbias;
#pragma unroll
      for (int r4 = 0; r4 < 4; ++r4) { const float4 lw = lp4[r4]; gkk += lw.x * w2c[4 * r4] + lw.y * w2c[4 * r4 + 1] + lw.z * w2c[4 * r4 + 2] + lw.w * w2c[4 * r4 + 3]; }
      const float l2 = (fminf(gkk, 0.f) * LOG2E - lg2(1.f + ex2(-fabsf(gkk) * LOG2E))) * (1.f / 16.f);
      Gb[(size_t)(r0 + rr) * 512 + tid] = f2bf(l2);
    }
    {
      const int c = tid >> 2, tq = (tid & 3) * 8;
      unsigned v[8];
#pragma unroll
      for (int i = 0; i < 8; ++i) v[i] = sT[(tq + i) * 136 + c];
      const int bl = r0 >> 12, t0 = (r0 & (SEQ - 1)) + tq;
      *(u32x4*)(VT + ((size_t)((bl * 2 + (c >> 6)) * 64 + (c & 63))) * SEQ + t0) = (u32x4){v[0] | (v[1] << 16), v[2] | (v[3] << 16), v[4] | (v[5] << 16), v[6] | (v[7] << 16)};
    }
  }
  lds_barrier();
}

DEV void phase_mix(const ParamsG& p, int l, int hf, int slot, int mode, int att_lo, int att_hi, int vid_lo, int vid_hi, unsigned char* smem) {
  unsigned* ctr = (unsigned*)(p.ws + OFF_CTRL) + CTR_WORD0 + slot * 16;
  volatile int* sItem = (volatile int*)(smem + LDS_BYTES - 16);
  const int n_scan = 64 * NSEG;
  int hi = n_scan + (att_hi - att_lo); if (vid_hi < hi) hi = vid_hi;
  for (;;) {
    lds_barrier();
    if (threadIdx.x == 0) *sItem = vid_lo + (int)atomicAdd(ctr, 1u);
    lds_barrier();
    const int vid = *sItem;
    if (vid >= hi) break;
    if (vid < n_scan) {
      const int seg = vid >> 6, it = vid & 63;
      if (mode == 1 && seg == NSEG - 1) continue;
#if PROBE_REP > 0
      if (slot >= 40 && PROBE_TYPE >= 0 && ((it < 16) ? 0 : (it < 32) ? 1 : 2) != PROBE_TYPE) continue;
#endif
      if (it < 16) { if (PH_MASK & 0x100) hgrn_item(p, l, it, seg, mode, smem); }
      else if (it < 32) { if (PH_MASK & 0x200) gla_item(p, l, it, seg, mode, smem); }
      else { if (PH_MASK & 0x400) ssd_item(p, l, it, seg, mode, smem); }
    } else { if (PH_MASK & 0x800) attn_item(p, l, att_lo + (vid - n_scan), smem); }
  }
}

DEV void phase_scan2(const ParamsG& p) {
  const size_t gtid = (size_t)blockIdx.x * NT + threadIdx.x, gsz = (size_t)gridDim.x * NT;
  const float* DB = (const float*)(p.ws + OFF_DB);
  for (size_t e = gtid; e < 655360; e += gsz) {
    float* buf; const float* dp; int stride;
    if (e < 262144) { const int it = (int)(e >> 14), idx = (int)(e & 16383); buf = (float*)(p.ws + OFF_SB0) + (size_t)it * NSEG * 16384 + idx; stride = 16384; dp = DB + (size_t)it * NSEG * 128 + (idx >> 7); }
    else if (e < 393216) { const int e2 = (int)(e - 262144), j = e2 >> 13, idx = e2 & 8191; buf = (float*)(p.ws + OFF_SB1) + (size_t)j * NSEG * 8192 + idx; stride = 8192; dp = DB + (size_t)(16 + j) * NSEG * 128 + (idx >> 7); }
    else { const int e3 = (int)(e - 393216), j = e3 >> 13, idx = e3 & 8191; buf = (float*)(p.ws + OFF_SB2) + (size_t)j * NSEG * 8192 + idx; stride = 8192; dp = DB + (size_t)(32 + j) * NSEG * 128 + (idx >> 6); }
    float u[NSEG - 1], d[NSEG - 1];
#pragma unroll
    for (int sg = 0; sg < NSEG - 1; ++sg) { u[sg] = buf[(size_t)sg * stride]; d[sg] = dp[sg * 128]; }
    float st = 0.f;
#pragma unroll
    for (int sg = 0; sg < NSEG; ++sg) { buf[(size_t)sg * stride] = st; if (sg < NSEG - 1) st = d[sg] * st + u[sg]; }
  }
}

DEV float bfe(const u32x4& v, int j) { return (j & 1) ? hi16(v[j >> 1]) : lo16(v[j >> 1]); }
DEV void phase_fin(const ParamsG& p, int l, int hf) {
  const int tid = launder(threadIdx.x), lane = tid & 63, w = tid >> 6;
  const bf16_t* Hh = (const bf16_t*)(p.ws + OFF_H);
  const bf16_t* OB = (const bf16_t*)(p.ws + OFF_OBUF);
  bf16_t* MX = (bf16_t*)(p.ws + OFF_MIXED);
  const int c0 = lane * 8;
  const float* cw = (const float*)(p.conv_w + (size_t)l * 5 * 1024); const float* cb = (const float*)(p.conv_b + (size_t)l * 1024);
  for (int r0 = (blockIdx.x * 8 + w) * 4; r0 < TH; r0 += gridDim.x * 32) {
    {
      u32x4 at[4], a[4], b[4], z[4];
#pragma unroll
      for (int i = 0; i < 4; ++i) {
        const bf16_t* hrow = Hh + (size_t)(r0 + i) * NPAD;
        at[i] = *(const u32x4*)(hrow + A_Q + c0);
        a[i] = *(const u32x4*)(OB + ((size_t)0 * TH + r0 + i) * 512 + c0); b[i] = *(const u32x4*)(OB + ((size_t)1 * TH + r0 + i) * 512 + c0);
        z[i] = *(const u32x4*)(hrow + H_Z + c0);
      }
      float gn[8];
#pragma unroll
      for (int j = 0; j < 8; ++j) gn[j] = p.hgrn_norm[l * 512 + c0 + j];
#pragma unroll
      for (int i = 0; i < 4; ++i) {
        *(u32x4*)(MX + (size_t)(r0 + i) * DI + c0) = at[i];
        float o[8]; float ss = 0.f;
#pragma unroll
        for (int j = 0; j < 8; ++j) { o[j] = bfe(a[i], j) + bfe(b[i], j); ss += o[j] * o[j]; }
#pragma unroll
        for (int of = 32; of >= 1; of >>= 1) ss += __shfl_xor(ss, of);
        const float rstd = rsqrtf(ss * (1.f / 512.f) + 1e-6f);
        float y[8];
#pragma unroll
        for (int j = 0; j < 8; ++j) { const float zz = bfe(z[i], j); y[j] = o[j] * rstd * gn[j] * (zz * frcp(1.f + ex2(fminf(-zz * LOG2E, 80.f)))); }
        *(u32x4*)(MX + (size_t)(r0 + i) * DI + 512 + c0) = (u32x4){pk2(y[0], y[1]), pk2(y[2], y[3]), pk2(y[4], y[5]), pk2(y[6], y[7])};
      }
    }
    {
      u32x4 a[4], b[4], z[4];
#pragma unroll
      for (int i = 0; i < 4; ++i) {
        a[i] = *(const u32x4*)(OB + ((size_t)4 * TH + r0 + i) * 512 + c0); b[i] = *(const u32x4*)(OB + ((size_t)5 * TH + r0 + i) * 512 + c0);
        z[i] = *(const u32x4*)(Hh + (size_t)(r0 + i) * NPAD + G_Z + c0);
      }
      float gn[8];
#pragma unroll
      for (int j = 0; j < 8; ++j) gn[j] = p.gla_norm[l * 128 + ((c0 + j) & 127)];
#pragma unroll
      for (int i = 0; i < 4; ++i) {
        float o[8]; float ss = 0.f;
#pragma unroll
        for (int j = 0; j < 8; ++j) { o[j] = bfe(a[i], j) + bfe(b[i], j); ss += o[j] * o[j]; }
#pragma unroll
        for (int of = 8; of >= 1; of >>= 1) ss += __shfl_xor(ss, of);
        const float rstd = rsqrtf(ss * (1.f / 128.f) + 1e-6f);
        float y[8];
#pragma unroll
        for (int j = 0; j < 8; ++j) { const float zz = bfe(z[i], j); y[j] = o[j] * rstd * gn[j] * (zz * frcp(1.f + ex2(fminf(-zz * LOG2E, 80.f)))); }
        *(u32x4*)(MX + (size_t)(r0 + i) * DI + 1536 + c0) = (u32x4){pk2(y[0], y[1]), pk2(y[2], y[3]), pk2(y[4], y[5]), pk2(y[6], y[7])};
      }
    }
    {
      u32x4 a[4], b[4], z[4], xr[8];
      const int t0 = r0 & (SEQ - 1);
#pragma unroll
      for (int i = 0; i < 4; ++i) {
        a[i] = *(const u32x4*)(OB + ((size_t)2 * TH + r0 + i) * 512 + c0); b[i] = *(const u32x4*)(OB + ((size_t)3 * TH + r0 + i) * 512 + c0);
        z[i] = *(const u32x4*)(Hh + (size_t)(r0 + i) * NPAD + S_Z + c0);
      }
#pragma unroll
      for (int m = 0; m < 8; ++m) {
        const int sq = t0 + m - 2;
        xr[m] = (u32x4){0u, 0u, 0u, 0u};
        if (sq >= 0 && sq < SEQ) xr[m] = *(const u32x4*)(Hh + (size_t)(r0 + m - 2) * NPAD + S_X + c0);
      }
      float gn[8], cbv[8];
#pragma unroll
      for (int j = 0; j < 8; ++j) { gn[j] = p.ssd_norm[l * 512 + c0 + j]; cbv[j] = cb[c0 + j]; }
      const float dsk = p.ssd_d[l * 8 + (c0 >> 6)];
#pragma unroll
      for (int i = 0; i < 4; ++i) {
        float u[8];
#pragma unroll
        for (int j = 0; j < 8; ++j) u[j] = cbv[j];
#pragma unroll
        for (int jj = 0; jj < 5; ++jj)
#pragma unroll
          for (int j = 0; j < 8; ++j) u[j] += cw[jj * 1024 + c0 + j] * bfe(xr[i + jj], j);
        float y[8]; float ss = 0.f;
#pragma unroll
        for (int j = 0; j < 8; ++j) {
          const float zz = bfe(z[i], j);
          const float xs = u[j] * frcp(1.f + ex2(fminf(-u[j] * LOG2E, 80.f)));
          y[j] = (bfe(a[i], j) + bfe(b[i], j) + dsk * xs) * (zz * frcp(1.f + ex2(fminf(-zz * LOG2E, 80.f))));
          ss += y[j] * y[j];
        }
#pragma unroll
        for (int of = 32; of >= 1; of >>= 1) ss += __shfl_xor(ss, of);
        const float rstd = rsqrtf(ss * (1.f / 512.f) + 1e-6f);
#pragma unroll
        for (int j = 0; j < 8; ++j) y[j] = y[j] * rstd * gn[j];
        *(u32x4*)(MX + (size_t)(r0 + i) * DI + 1024 + c0) = (u32x4){pk2(y[0], y[1]), pk2(y[2], y[3]), pk2(y[4], y[5]), pk2(y[6], y[7])};
      }
    }
  }
}

#define XB_TMO      128
#define XB_XCNT(j)  (256  + 64 * (j))
#define XB_XSUB(j)  (1280 + 64 * (j))
#define XB_XGEN(j)  (2304 + 64 * (j))
#define XB_TOP      3328
#define XB_TOPGEN   3392
#define XB_SPIN_CAP (1u << 22)
#define LAS __attribute__((address_space(3)))
DEV unsigned xb_ld(unsigned* p) { return __hip_atomic_load(p, __ATOMIC_RELAXED, __HIP_MEMORY_SCOPE_AGENT); }
DEV unsigned xb_add(unsigned* p, unsigned v) { return __hip_atomic_fetch_add(p, v, __ATOMIC_RELAXED, __HIP_MEMORY_SCOPE_AGENT); }
DEV unsigned xb_xcc_id() { return (unsigned)__builtin_amdgcn_s_getreg((3 << 11) | 20) & 0xFu; }
#define XB_SPIN(cond, bar) do { unsigned _sp = 0; while (cond) { __builtin_amdgcn_s_sleep(1); \
    if ((++_sp & 255u) == 0u) { if (xb_ld(&(bar)[XB_TMO])) break; if (_sp > XB_SPIN_CAP) { atomicAdd(&(bar)[XB_TMO], 1u); break; } } } } while (0)
struct XcdBarrier { unsigned* bar; unsigned x; volatile LAS unsigned* st; };
DEV XcdBarrier xcd_barrier_post(unsigned* bar, volatile LAS unsigned* st) {
  XcdBarrier b; b.bar = bar; b.x = xb_xcc_id(); b.st = st;
  if (threadIdx.x == 0) (void)xb_add(&bar[XB_XCNT(b.x)], 1u);
  return b;
}
DEV void xcd_barrier_complete(unsigned* bar, unsigned x, unsigned& nloc, unsigned& nx) {
  const unsigned G = gridDim.x * gridDim.y * gridDim.z;
  unsigned sum, cnt, mine, sp = 0u;
  for (;;) {
    sum = 0u; cnt = 0u; mine = 0u;
#pragma unroll
    for (unsigned j = 0; j < 16; ++j) { const unsigned c = xb_ld(&bar[XB_XCNT(j)]); sum += c; cnt += (c > 0u) ? 1u : 0u; mine = (j == x) ? c : mine; }
    if (sum == G) break;
    __builtin_amdgcn_s_sleep(1);
    if ((++sp & 255u) == 0u) { if (xb_ld(&bar[XB_TMO])) break; if (sp > XB_SPIN_CAP) { atomicAdd(&bar[XB_TMO], 1u); break; } }
  }
  nloc = mine > 0u ? mine : 1u; nx = cnt > 0u ? cnt : 1u;
}
DEV void xcd_barrier(const XcdBarrier& b) {
  asm volatile("s_waitcnt vmcnt(0)" ::: "memory");
  __syncthreads();
  if (threadIdx.x == 0) {
    unsigned* bar = b.bar;
    __builtin_amdgcn_s_waitcnt(0);
    unsigned nloc = b.st[0], nx = b.st[1];
    if (nloc == 0u) { xcd_barrier_complete(bar, b.x, nloc, nx); b.st[0] = nloc; b.st[1] = nx; }
    const unsigned old = xb_add(&bar[XB_XSUB(b.x)], 1u);
    const unsigned gen = old / nloc;
    if (old + 1u == (gen + 1u) * nloc) {
      __builtin_amdgcn_fence(__ATOMIC_RELEASE, "agent");
      asm volatile("s_waitcnt vmcnt(0)" ::: "memory");
      const unsigned og = xb_add(&bar[XB_TOP], 1u);
      const unsigned tg = og / nx;
      if (og + 1u == (tg + 1u) * nx) xb_add(&bar[XB_TOPGEN], 1u);
      else XB_SPIN(xb_ld(&bar[XB_TOPGEN]) == tg, bar);
      __builtin_amdgcn_fence(__ATOMIC_ACQUIRE, "agent");
      xb_add(&bar[XB_XGEN(b.x)], 1u);
      asm volatile("s_waitcnt vmcnt(0)" ::: "memory");
    } else {
      XB_SPIN(xb_ld(&bar[XB_XGEN(b.x)]) == gen, bar);
      __builtin_amdgcn_fence(__ATOMIC_ACQUIRE, "agent");
      asm volatile("s_waitcnt vmcnt(0)" ::: "memory");
    }
  }
  __syncthreads();
}

DEV void run_phase(const ParamsG& p, int ph, int rep, unsigned char* smem) {
  if (ph == 0) { if (PH_MASK & 1) { phase_pro(p, smem); convert_weights(p, 0, 3, smem); } return; }
  if (ph == 21) { if (PH_MASK & 16) phase_outproj(p, 1, 1, smem); return; }
  if (ph == 22) { if (PH_MASK & 32) phase_ln(p, 1, 1); return; }
  const int q = ph - 1, blk = q / 5, st = q % 5, l = blk >> 1, hf = blk & 1;
  if (st == 0) {
    if (blk > 0 && (PH_MASK & 16)) phase_outproj(p, (blk - 1) >> 1, (blk - 1) & 1, smem);
    if (PH_MASK & 2) phase_inproj(p, l, hf, blk > 0 ? 16 : 0, smem);
  } else if (st == 1) {
    if (blk > 0 && rep == 0 && (PH_MASK & 32)) phase_ln(p, (blk - 1) >> 1, (blk - 1) & 1);
    if (PH_MASK & 4) phase_prep(p, l, hf, rep, smem);
    if ((PH_MASK & 1) && rep == 0 && blk == 1) convert_weights(p, 1, 1, smem);
    if ((PH_MASK & 1) && rep == 0 && blk == 2) convert_weights(p, 1, 2, smem);
  }
  else if (st == 2) { if (PH_MASK & 0xF00) phase_mix(p, l, hf, ph + 40 * rep, 1, 0, ATT_SPLIT, rep ? PROBE_LO : 0, rep ? PROBE_HI : 100000, smem); }
  else if (st == 3) { if (PH_MASK & 0xF00) phase_mix(p, l, hf, ph + 40 * rep, 3, ATT_SPLIT, 256, rep ? PROBE_LO : 0, rep ? PROBE_HI : 100000, smem); }
  else { if (PH_MASK & 8) phase_fin(p, l, hf); }
}
__global__ void __launch_bounds__(NT) mega(Params p) {
  extern __shared__ __attribute__((aligned(16))) unsigned char smem[];
#if ONE_LAUNCH
  volatile LAS unsigned* xst = (volatile LAS unsigned*)(smem + LDS_BYTES - 32);
  if (threadIdx.x == 0) { xst[0] = 0u; xst[1] = 0u; }
  __syncthreads();
  XcdBarrier xb = xcd_barrier_post((unsigned*)(p.ws + OFF_CTRL), xst);
#endif
  ParamsG* lp = (ParamsG*)(smem + 147456);
  if (threadIdx.x == 0) {
    lp->x = (GAS const float*)p.x; lp->w_in = (GAS const float*)p.w_in; lp->q_gain = (GAS const float*)p.q_gain; lp->k_gain = (GAS const float*)p.k_gain;
    lp->lb_logits = (GAS const float*)p.lb_logits; lp->hgrn_norm = (GAS const float*)p.hgrn_norm; lp->conv_w = (GAS const float*)p.conv_w; lp->conv_b = (GAS const float*)p.conv_b;
    lp->dt_bias = (GAS const float*)p.dt_bias; lp->a_log = (GAS const float*)p.a_log; lp->ssd_d = (GAS const float*)p.ssd_d; lp->ssd_norm = (GAS const float*)p.ssd_norm;
    lp->gk_w2 = (GAS const float*)p.gk_w2; lp->gk_b = (GAS const float*)p.gk_b; lp->gla_norm = (GAS const float*)p.gla_norm; lp->w_out = (GAS const float*)p.w_out;
    lp->ln_g = (GAS const float*)p.ln_g; lp->ln_b = (GAS const float*)p.ln_b; lp->out = (GAS float*)p.out; lp->ws = (GAS unsigned char*)p.ws;
  }
  __syncthreads();
  const int ph_begin = p.phase_begin, ph_end = p.phase_end;
  for (int ph = ph_begin; ph < ph_end; ++ph) {
    int nrep = 0;
#if PROBE_REP > 0
    {
      const int q = ph - 1, st = q % 5;
      const bool idem = (ph >= 1 && ph <= 20) && (st == PROBE_ST) && (st >= 1);
      if (idem) nrep = PROBE_REP;
    }
#endif
    for (int r = 0; r <= nrep; ++r) {
      run_phase(*lp, ph, r, smem);
#if ONE_LAUNCH
      if (r < nrep || ph + 1 < ph_end) xcd_barrier(xb);
#endif
    }
  }
}

extern "C" void kernel_launch(void* const* d_in, const int* in_sizes, int n_in, void* d_out, int out_size, void* d_ws, size_t ws_size,
                              hipStream_t stream) {
  static int grid_blocks = 0;
  if (!grid_blocks) {
    int dev = 0, cus = 0, per_cu = 0;
    hipGetDevice(&dev);
    hipDeviceGetAttribute(&cus, hipDeviceAttributeMultiprocessorCount, dev);
    hipFuncSetAttribute((const void*)mega, hipFuncAttributeMaxDynamicSharedMemorySize, LDS_BYTES);
    hipOccupancyMaxActiveBlocksPerMultiprocessor(&per_cu, mega, NT, LDS_BYTES);
    if (per_cu < 1) per_cu = 1;
    grid_blocks = cus;
  }
  Params p{};
  p.x = (const float*)d_in[0]; p.w_in = (const float*)d_in[1]; p.q_gain = (const float*)d_in[2]; p.k_gain = (const float*)d_in[3];
  p.lb_logits = (const float*)d_in[4]; p.hgrn_norm = (const float*)d_in[5]; p.conv_w = (const float*)d_in[6]; p.conv_b = (const float*)d_in[7];
  p.dt_bias = (const float*)d_in[8]; p.a_log = (const float*)d_in[9]; p.ssd_d = (const float*)d_in[10]; p.ssd_norm = (const float*)d_in[11];
  p.gk_w2 = (const float*)d_in[12]; p.gk_b = (const float*)d_in[13]; p.gla_norm = (const float*)d_in[14]; p.w_out = (const float*)d_in[15];
  p.ln_g = (const float*)d_in[16]; p.ln_b = (const float*)d_in[17];
  p.out = (float*)d_out; p.ws = (unsigned char*)d_ws;
  hipMemsetAsync(d_ws, 0, CTRL_BYTES, stream);
#if ONE_LAUNCH
  p.phase_begin = 0; p.phase_end = NPHASE;
  void* args[] = {&p};
  (void)args;
  hipLaunchKernelGGL(mega, dim3(grid_blocks), dim3(NT), LDS_BYTES, stream, p);
#else
  for (int ph = 0; ph < NPHASE; ++ph) {
    p.phase_begin = ph; p.phase_end = ph + 1;
    hipLaunchKernelGGL(mega, dim3(grid_blocks), dim3(NT), LDS_BYTES, stream, p);
  }
#endif
}
```

```cpp
#include <hip/hip_runtime.h>
#include <hip/hip_cooperative_groups.h>
#include <stdint.h>
#include <stdio.h>
namespace cg = cooperative_groups;

#ifndef ONE_LAUNCH
#define ONE_LAUNCH 1
#endif

#ifndef PH_MASK
#define PH_MASK 0xFFF
#endif
#ifndef PROBE_ST
#define PROBE_ST -1
#endif
#ifndef PROBE_REP
#define PROBE_REP 0
#endif
#ifndef PROBE_TYPE
#define PROBE_TYPE -1
#endif
#ifndef PROBE_LO
#define PROBE_LO 0
#endif
#ifndef PROBE_HI
#define PROBE_HI 100000
#endif
#define DEV __device__ __forceinline__
typedef unsigned short bf16_t;
typedef short bf16x8 __attribute__((ext_vector_type(8)));
typedef float f32x16 __attribute__((ext_vector_type(16)));
typedef unsigned u32x4 __attribute__((ext_vector_type(4)));
typedef float f32x4 __attribute__((ext_vector_type(4)));

constexpr int NT = 512;
constexpr int T_ALL = 16384, TH = 8192, SEQ = 4096, DM = 1024, NPAD = 7168, DI = 2048, NIN = 6960;
constexpr int A_Q = 0, A_K = 512, A_V = 640, A_Z = 768, H_Q = 1280, H_FF = 1792, H_FB = 2304, H_I = 2816, H_Z = 3328,
              S_X = 3840, S_Z = 4864, G_Q = 5376, G_K = 5632, G_V = 5888, G_Z = 6400, SM0 = 6912;
constexpr size_t OFF_CTRL = 0, OFF_TAB = 65536, OFF_XB = 131072;
constexpr size_t OFF_WIN = OFF_XB + (size_t)T_ALL * DM * 2;
constexpr size_t OFF_WOUT = OFF_WIN + (size_t)NPAD * DM * 2;
constexpr size_t OFF_H = OFF_WOUT + (size_t)DM * DI * 2;
constexpr size_t OFF_SMALL = OFF_H + (size_t)TH * NPAD * 2;
constexpr size_t OFF_OBUF = OFF_SMALL + (size_t)TH * 48 * 4;
constexpr size_t OFF_VT = OFF_OBUF + (size_t)6 * TH * 512 * 2;
constexpr size_t OFF_DB = OFF_VT + (size_t)2 * 2 * 64 * SEQ * 2;
constexpr int NSEG = 4, SLEN = 64 / NSEG;
constexpr size_t OFF_MIXED = OFF_DB + (size_t)64 * NSEG * 128 * 4;
constexpr size_t OFF_SB0 = OFF_MIXED, OFF_SB1 = OFF_SB0 + (size_t)16 * NSEG * 16384 * 4, OFF_SB2 = OFF_SB1 + (size_t)16 * NSEG * 8192 * 4;
constexpr size_t OFF_U = OFF_SB2 + (size_t)32 * NSEG * 8192 * 4;
constexpr size_t OFF_G = OFF_U + (size_t)TH * 1024 * 2;
constexpr size_t WS_END = (OFF_G + (size_t)TH * 512 * 2 > OFF_MIXED + (size_t)TH * DI * 2) ? (OFF_G + (size_t)TH * 512 * 2) : (OFF_MIXED + (size_t)TH * DI * 2);
static_assert(OFF_MIXED + (size_t)TH * DI * 2 <= WS_END, "MIXED must fit");
static_assert(WS_END <= 268435456, "workspace");
constexpr size_t CTRL_BYTES = 65536;
constexpr int CTR_WORD0 = 4096;
constexpr int LDS_BYTES = 148480;
constexpr float LOG2E = 1.4426950408889634f;
constexpr float QSCALE = 0.125f * LOG2E;
constexpr float DN_ALPHA = 1.4142135623730951f;
constexpr int NPHASE = 23;
constexpr int ATT_SPLIT = 256;

struct Params {
  const float* x; const float* w_in; const float* q_gain; const float* k_gain; const float* lb_logits; const float* hgrn_norm;
  const float* conv_w; const float* conv_b; const float* dt_bias; const float* a_log; const float* ssd_d; const float* ssd_norm;
  const float* gk_w2; const float* gk_b; const float* gla_norm; const float* w_out; const float* ln_g; const float* ln_b;
  float* out; unsigned char* ws;
  int phase_begin, phase_end;
};
#define GAS __attribute__((address_space(1)))
struct ParamsG {
  GAS const float* x; GAS const float* w_in; GAS const float* q_gain; GAS const float* k_gain; GAS const float* lb_logits; GAS const float* hgrn_norm;
  GAS const float* conv_w; GAS const float* conv_b; GAS const float* dt_bias; GAS const float* a_log; GAS const float* ssd_d; GAS const float* ssd_norm;
  GAS const float* gk_w2; GAS const float* gk_b; GAS const float* gla_norm; GAS const float* w_out; GAS const float* ln_g; GAS const float* ln_b;
  GAS float* out; GAS unsigned char* ws;
};

DEV void lds_barrier() { asm volatile("s_waitcnt lgkmcnt(0)" ::: "memory"); __builtin_amdgcn_s_barrier(); asm volatile("" ::: "memory"); }
DEV int launder(int v) { asm volatile("" : "+v"(v)); return v; }
DEV float bf2f(bf16_t v) { return __uint_as_float(((unsigned)v) << 16); }
DEV bf16_t f2bf(float f) { unsigned u = __float_as_uint(f); u += 0x7fffu + ((u >> 16) & 1u); return (bf16_t)(u >> 16); }
typedef __bf16 bf16x2_t __attribute__((ext_vector_type(2)));
typedef float f32x2_t __attribute__((ext_vector_type(2)));
DEV unsigned pk2(float lo, float hi) { const f32x2_t f = {lo, hi}; const bf16x2_t b = __builtin_convertvector(f, bf16x2_t); return __builtin_bit_cast(unsigned, b); }
DEV float fsigmoid(float x) { return 1.f / (1.f + __expf(-x)); }
DEV float fsilu(float x) { return x / (1.f + __expf(-x)); }
DEV unsigned cvtpk(float lo, float hi) { return pk2(lo, hi); }
DEV float ex2(float x) { return __builtin_amdgcn_exp2f(x); }
DEV float lg2(float x) { return __builtin_amdgcn_logf(x); }
DEV float frcp(float x) { return __builtin_amdgcn_rcpf(x); }
DEV float lo16(unsigned u) { return __uint_as_float(u << 16); }
DEV float hi16(unsigned u) { return __uint_as_float(u & 0xffff0000u); }
DEV int rowoff(int reg, int h) { return (reg & 3) + 8 * (reg >> 2) + 4 * h; }
DEV f32x16 zero16() { f32x16 z;
#pragma unroll
  for (int i = 0; i < 16; ++i) z[i] = 0.f; return z; }

template <int KD>
DEV void mma32(f32x16& acc, const bf16_t* a, int lda, const bf16_t* b, int ldb, int lane) {
  const int r = lane & 31, h = lane >> 5;
  const bf16_t* ap = a + r * lda + 8 * h;
  const bf16_t* bp = b + r * ldb + 8 * h;
#pragma unroll 4
  for (int k = 0; k < KD; k += 16) {
    bf16x8 av = *(const bf16x8*)(ap + k);
    bf16x8 bv = *(const bf16x8*)(bp + k);
    acc = __builtin_amdgcn_mfma_f32_32x32x16_bf16(av, bv, acc, 0, 0, 0);
  }
}

DEV int orig_col(int n) {
  if (n < 4864) return n;
  if (n < 6400) return n + 16;
  if (n < 6912) return n + 48;
  if (n < 6928) return n - 2048;
  if (n < 6960) return n - 512;
  return -1;
}

DEV void convert_weights(const ParamsG& p, int l, int which, unsigned char* smem) {
  float* s = (float*)smem;
  const int tid = launder(threadIdx.x);
  const float* win = (const float*)(p.w_in + (size_t)l * DM * NIN);
  const float* wout = (const float*)(p.w_out + (size_t)l * DI * DM);
  bf16_t* wint = (bf16_t*)(p.ws + OFF_WIN);
  bf16_t* woutt = (bf16_t*)(p.ws + OFF_WOUT);
  const int n_in_tiles = (NPAD / 64) * (DM / 64);
  const int n_out_tiles = (DM / 64) * (DI / 64);
  const int it_lo = (which & 1) ? 0 : n_in_tiles, it_hi = (which & 2) ? (n_in_tiles + n_out_tiles) : n_in_tiles;
  for (int it = it_lo + blockIdx.x; it < it_hi; it += gridDim.x) {
    lds_barrier();
    if (it < n_in_tiles) {
      const int n0 = (it / 16) * 64, k0 = (it % 16) * 64;
#pragma unroll
      for (int e = 0; e < 8; ++e) {
        const int idx = e * NT + tid, kk = idx >> 6, nn = idx & 63;
        const int oc = orig_col(n0 + nn);
        s[kk * 65 + nn] = (oc >= 0) ? win[(size_t)(k0 + kk) * NIN + oc] : 0.f;
      }
      lds_barrier();
      const int n = tid >> 3, kc = (tid & 7) * 8;
      uint4 o;
      o.x = pk2(s[(kc + 0) * 65 + n], s[(kc + 1) * 65 + n]); o.y = pk2(s[(kc + 2) * 65 + n], s[(kc + 3) * 65 + n]);
      o.z = pk2(s[(kc + 4) * 65 + n], s[(kc + 5) * 65 + n]); o.w = pk2(s[(kc + 6) * 65 + n], s[(kc + 7) * 65 + n]);
      *(uint4*)(wint + (size_t)(n0 + n) * DM + k0 + kc) = o;
    } else {
      const int j = it - n_in_tiles;
      const int n0 = (j / 32) * 64, k0 = (j % 32) * 64;
#pragma unroll
      for (int e = 0; e < 8; ++e) {
        const int idx = e * NT + tid, kk = idx >> 6, nn = idx & 63;
        s[kk * 65 + nn] = wout[(size_t)(k0 + kk) * DM + n0 + nn];
      }
      lds_barrier();
      const int n = tid >> 3, kc = (tid & 7) * 8;
      uint4 o;
      o.x = pk2(s[(kc + 0) * 65 + n], s[(kc + 1) * 65 + n]); o.y = pk2(s[(kc + 2) * 65 + n], s[(kc + 3) * 65 + n]);
      o.z = pk2(s[(kc + 4) * 65 + n], s[(kc + 5) * 65 + n]); o.w = pk2(s[(kc + 6) * 65 + n], s[(kc + 7) * 65 + n]);
      *(uint4*)(woutt + (size_t)(n0 + n) * DI + k0 + kc) = o;
    }
  }
  lds_barrier();
}

DEV void fsincos(float x, float& s, float& c) {
  const float k = rintf(x * 0.63661977236758134308f);
  float r = fmaf(-k, 1.5707855225e+00f, x);
  r = fmaf(-k, 1.0804273188e-05f, r);
  r = fmaf(-k, 6.0770999344e-11f, r);
  const float r2 = r * r;
  float ps = fmaf(r2, 2.7557319224e-06f, -1.9841269841e-04f);
  ps = fmaf(ps, r2, 8.3333333333e-03f); ps = fmaf(ps, r2, -1.6666666667e-01f);
  const float sinr = fmaf(ps * r2, r, r);
  float pc = fmaf(r2, -2.7557319224e-07f, 2.4801587302e-05f);
  pc = fmaf(pc, r2, -1.3888888889e-03f); pc = fmaf(pc, r2, 4.1666666667e-02f); pc = fmaf(pc, r2, -0.5f);
  const float cosr = fmaf(pc, r2, 1.0f);
  const int q = ((int)k) & 3;
  if (q == 0) { s = sinr; c = cosr; }
  else if (q == 1) { s = cosr; c = -sinr; }
  else if (q == 2) { s = -sinr; c = -cosr; }
  else { s = -cosr; c = sinr; }
}

DEV void phase_pro(const ParamsG& p, unsigned char* smem) {
  const int tid = launder(threadIdx.x);
  const size_t gtid = (size_t)blockIdx.x * NT + tid, gsz = (size_t)gridDim.x * NT;
  const float4* x4 = (const float4*)p.x;
  uint4* xb4 = (uint4*)(p.ws + OFF_XB);
  for (size_t i = gtid; i < (size_t)T_ALL * DM / 8; i += gsz) {
    const float4 a = x4[2 * i], b = x4[2 * i + 1];
    uint4 o; o.x = pk2(a.x, a.y); o.y = pk2(a.z, a.w); o.z = pk2(b.x, b.y); o.w = pk2(b.z, b.w);
    xb4[i] = o;
  }
  if (blockIdx.x == 0) {
    float2* tab = (float2*)(p.ws + OFF_TAB);
    for (int i = tid; i < 64 * 16; i += NT) {
      const int pos = i >> 4, fi = i & 15;
      const float invf = exp2f(-(float)fi * (13.287712379549449f / 16.0f));
      const float ang = (float)pos * invf;
      float sn, cs; fsincos(ang, sn, cs);
      tab[i] = make_float2(cs, sn);
    }
  }
}

namespace pg8 {
#define PG8_LAS __attribute__((address_space(3)))
typedef unsigned short bf16_t;
typedef short bf16x8 __attribute__((ext_vector_type(8)));
typedef float f32x4 __attribute__((ext_vector_type(4)));
typedef unsigned u32x4 __attribute__((ext_vector_type(4)));
constexpr int BM = 256, BK = 64, HALF = 128, HTB = HALF * BK * 2  , STAGE_BYTES = 8 * HTB, NXCD = 8, WGM = 8;

__host__ __device__ __forceinline__ int lds_byte(int r, int c) { const int st = (r >> 4) * 2 + (c >> 5), rr = r & 15, cc = c & 31, ob = rr * 64 + cc * 2; return st * 1024 + (ob ^ (((ob >> 9) & 1) << 5)); }
__host__ __device__ __forceinline__ void stage_rc(int b, int& R, int& C) { const int st = b / 1024, sb = b % 1024, swz = sb ^ (((sb >> 9) & 1) << 5); R = (st >> 1) * 16 + swz / 64; C = (st & 1) * 32 + (swz % 64) / 2; }
__host__ __device__ __forceinline__ int perm32(int rho) { const int n = rho >> 4, i = rho & 15; return 8 * (i >> 2) + 4 * n + (i & 3); }

struct Unit { int pm, pn; };
struct Gemm { const bf16_t* A; const bf16_t* Bt; int M, N, K; };

__device__ __forceinline__ unsigned cvt_pk_bf16(float lo, float hi) { unsigned r; asm volatile("v_cvt_pk_bf16_f32 %0, %1, %2" : "=v"(r) : "v"(lo), "v"(hi)); return r; }

struct XcdOrder {
    int rpx, nN, x, c, ncu, skew;
    __device__ void init(int M, int N, int skew_ = 0) { rpx = (M / BM) / NXCD; nN = N / BM; x = blockIdx.x & 7; c = blockIdx.x >> 3; ncu = gridDim.x >> 3; skew = skew_; }
    __device__ bool next(int i, Unit& u) const {
        const int total = rpx * nN, full = (total / ncu) * ncu;
        int j = c + i * ncu;
        if (skew > 0 && j >= full) { const int cc = c - skew; j = (cc >= 0 && i == total / ncu) ? full + cc : total; }
        if (j >= total) return false; u.pm = rpx * x + (j % rpx); u.pn = j / rpx; return true; }
    __device__ __forceinline__ void a_ready(const Unit&) const {}
    __device__ __forceinline__ void done(const Unit&) const {}
};
struct EpiIn {
    static constexpr bool PERM = true, AFTER_DRAIN = false;
    bf16_t* O; int ldc; float* small; int small_pn;
    __device__ __forceinline__ void operator()(const f32x4 (&acc)[2][2][4][2], const Unit& u, int wr, int wc, int fr, int fq) const {
        const int row0 = u.pm * BM + wr * 64 + fr, col0 = u.pn * BM + wc * 32 + 8 * fq;
        if (u.pn == small_pn) {
            const int c = wc * 32 + 8 * fq;
            if (c < 48) {
#pragma unroll
                for (int ai = 0; ai < 2; ++ai)
#pragma unroll
                    for (int m = 0; m < 4; ++m) { float* rp = small + (size_t)(row0 + ai * HALF + m * 16) * 48 + c; *(f32x4*)rp = acc[ai][0][m][0]; *(f32x4*)(rp + 4) = acc[ai][0][m][1]; }
            }
            return;
        }
        const int act = (u.pn == 5 || u.pn == 6) ? 1 : ((u.pn == 21) ? 2 : 0);
#pragma unroll
        for (int ai = 0; ai < 2; ++ai)
#pragma unroll
            for (int m = 0; m < 4; ++m) { bf16_t* rowp = O + (size_t)(row0 + ai * HALF + m * 16) * ldc + col0;
#pragma unroll
                for (int bj = 0; bj < 2; ++bj) { f32x4 v0 = acc[ai][bj][m][0], v1 = acc[ai][bj][m][1];
                    if (act == 1) {
#pragma unroll
                        for (int e = 0; e < 4; ++e) {
                            v0[e] = v0[e] * __builtin_amdgcn_rcpf(1.f + __builtin_amdgcn_exp2f(fminf(-v0[e] * 1.4426950408889634f, 80.f))) * 0.08838834764831845f;
                            v1[e] = v1[e] * __builtin_amdgcn_rcpf(1.f + __builtin_amdgcn_exp2f(fminf(-v1[e] * 1.4426950408889634f, 80.f))) * 0.08838834764831845f; }
                    } else if (act == 2) { v0 = v0 * 0.125f; v1 = v1 * 0.125f; }
                    u32x4 w; w.x = cvt_pk_bf16(v0[0], v0[1]); w.y = cvt_pk_bf16(v0[2], v0[3]); w.z = cvt_pk_bf16(v1[0], v1[1]); w.w = cvt_pk_bf16(v1[2], v1[3]);
                    *(u32x4*)(rowp + bj * HALF) = w; } }
    }
};
struct EpiOut {
    static constexpr bool PERM = true, AFTER_DRAIN = false;
    const float* X; float* Y; int ldc; float alpha;
    __device__ __forceinline__ void operator()(const f32x4 (&acc)[2][2][4][2], const Unit& u, int wr, int wc, int fr, int fq) const {
        const int row0 = u.pm * BM + wr * 64 + fr, col0 = u.pn * BM + wc * 32 + 8 * fq;
#pragma unroll
        for (int ai = 0; ai < 2; ++ai)
#pragma unroll
            for (int m = 0; m < 4; ++m) { const size_t off = (size_t)(row0 + ai * HALF + m * 16) * ldc + col0;
#pragma unroll
                for (int bj = 0; bj < 2; ++bj) { const f32x4 x0 = *(const f32x4*)(X + off + bj * HALF), x1 = *(const f32x4*)(X + off + bj * HALF + 4);
                    *(f32x4*)(Y + off + bj * HALF) = x0 * alpha + acc[ai][bj][m][0]; *(f32x4*)(Y + off + bj * HALF + 4) = x1 * alpha + acc[ai][bj][m][1]; } }
    }
};

template <class Epi, class Sched, bool ALIGN_EPI = false, bool SP2 = false>
__device__ __forceinline__ void gemm_phase(PG8_LAS unsigned char* lds, const Gemm g, const Sched& S, const Epi& E) {
    const int tid = launder((int)threadIdx.x), wid = __builtin_amdgcn_readfirstlane(tid >> 6), lane = tid & 63, wr = wid >> 2, wc = wid & 3, fr = lane & 15, fq = lane >> 4;
    const int K = g.K, nt = K / BK;
    unsigned voffA[2], voffB[2];
#pragma unroll
    for (int i = 0; i < 2; ++i) { int R, C; stage_rc(tid * 16 + i * 8192, R, C); const int Rb = Epi::PERM ? ((R & ~31) + perm32(R & 31)) : R;
        voffA[i] = (unsigned)(R * K + C) * 2u; voffB[i] = (unsigned)(Rb * K + C) * 2u; }
    const size_t kstep = (size_t)(BK * 2);
    const size_t hstep = (size_t)HALF * K * 2;
    const size_t tstep = 2 * hstep;
    const unsigned ldsw = (unsigned)wid * 1024u;
    const int aoff = lds_byte(wr * 64 + fr, fq * 8), boff = lds_byte(wc * 32 + fr, fq * 8);
#define PG8_SA(b, h) (((b) * 2 + (h)) * HTB)
#define PG8_SB(b, h) ((4 + (b) * 2 + (h)) * HTB)
#define PG8_STAGE(bufoff, gbase, voff) do { _Pragma("unroll") for (int _i = 0; _i < 2; ++_i) \
        __builtin_amdgcn_global_load_lds((const unsigned*)((const char*)(gbase) + (voff)[_i]), (PG8_LAS unsigned*)(lds + (bufoff) + ldsw + _i * 8192), 16, 0, 0); } while (0)
#define PG8_LDA(dst, b, h) do { _Pragma("unroll") for (int m = 0; m < 4; ++m) _Pragma("unroll") for (int k = 0; k < 2; ++k) dst[m][k] = *(const PG8_LAS bf16x8*)(lds + PG8_SA(b, h) + aoff + m * 2048 + k * 1024); } while (0)
#define PG8_LDB(dst, b, h) do { _Pragma("unroll") for (int n = 0; n < 2; ++n) _Pragma("unroll") for (int k = 0; k < 2; ++k) dst[n][k] = *(const PG8_LAS bf16x8*)(lds + PG8_SB(b, h) + boff + n * 2048 + k * 1024); } while (0)
#define PG8_MMA(ai, bj, At, Bt) do { __builtin_amdgcn_s_setprio(1); _Pragma("unroll") for (int m = 0; m < 4; ++m) _Pragma("unroll") for (int n = 0; n < 2; ++n) _Pragma("unroll") for (int k = 0; k < 2; ++k) \
        acc[ai][bj][m][n] = __builtin_amdgcn_mfma_f32_16x16x32_bf16(Bt[n][k], At[m][k], acc[ai][bj][m][n], 0, 0, 0); __builtin_amdgcn_s_setprio(0); } while (0)
#define PG8_WAIT_V(n) asm volatile("s_waitcnt vmcnt(" #n ")" ::: "memory")
#define PG8_WAIT_L(n) asm volatile("s_waitcnt lgkmcnt(" #n ")" ::: "memory")
#define PG8_BAR __builtin_amdgcn_s_barrier()
#define PG8_SCHED __builtin_amdgcn_sched_barrier(0)
    Unit cur, nxt; int ui = 0;
    if (!S.next(0, cur)) return;
    f32x4 acc[2][2][4][2];
#pragma unroll
    for (int a = 0; a < 2; ++a)
#pragma unroll
        for (int b = 0; b < 2; ++b)
#pragma unroll
            for (int m = 0; m < 4; ++m)
#pragma unroll
                for (int n = 0; n < 2; ++n) acc[a][b][m][n] = (f32x4){0.f, 0.f, 0.f, 0.f};
    bf16x8 At[4][2], B0[2][2], B1[2][2];
    const char* cA = (const char*)g.A + (size_t)cur.pm * tstep; const char* cB = (const char*)g.Bt + (size_t)cur.pn * tstep;
    S.a_ready(cur);
    if constexpr (SP2) {
        PG8_STAGE(PG8_SB(0, 0), cB, voffB); PG8_STAGE(PG8_SB(0, 1), cB + hstep, voffB); PG8_STAGE(PG8_SA(0, 0), cA, voffA); PG8_STAGE(PG8_SA(0, 1), cA + hstep, voffA);
        if (wr == 1) PG8_BAR;
        PG8_WAIT_V(2); PG8_BAR;
        PG8_STAGE(PG8_SB(1, 0), cB + kstep, voffB); PG8_STAGE(PG8_SA(1, 0), cA + kstep, voffA); PG8_STAGE(PG8_SB(1, 1), cB + hstep + kstep, voffB);
        PG8_WAIT_V(6); PG8_BAR;
    } else {
        PG8_STAGE(PG8_SB(0, 0), cB, voffB); PG8_STAGE(PG8_SA(0, 0), cA, voffA); PG8_STAGE(PG8_SB(0, 1), cB + hstep, voffB); PG8_STAGE(PG8_SA(0, 1), cA + hstep, voffA);
        if (wr == 1) PG8_BAR;
        PG8_WAIT_V(4); PG8_BAR;
        PG8_STAGE(PG8_SB(1, 0), cB + kstep, voffB); PG8_STAGE(PG8_SA(1, 0), cA + kstep, voffA); PG8_STAGE(PG8_SB(1, 1), cB + hstep + kstep, voffB);
        PG8_WAIT_V(6); PG8_BAR;
    }
    for (;;) {
        const bool has_next = S.next(ui + 1, nxt);
        const char* nA = has_next ? (const char*)g.A + (size_t)nxt.pm * tstep : cA; const char* nB = has_next ? (const char*)g.Bt + (size_t)nxt.pn * tstep : cB;
        for (int t = 0; t < nt; t += 2) {
            const bool last = (t == nt - 2);
            const char* a1 = cA + (size_t)(t + 1) * kstep;
            const char* a2 = last ? nA : cA + (size_t)(t + 2) * kstep; const char* b2 = last ? nB : cB + (size_t)(t + 2) * kstep;
            const char* a3 = a2 + kstep; const char* b3 = b2 + kstep;
            if (last && has_next) S.a_ready(nxt);
            if constexpr (SP2) {
            PG8_LDB(B0, 0, 0); PG8_LDB(B1, 0, 1); PG8_SCHED; PG8_LDA(At, 0, 0); PG8_STAGE(PG8_SA(1, 1), a1 + hstep, voffA);
            PG8_WAIT_V(8); PG8_WAIT_L(0); PG8_BAR; PG8_MMA(0, 0, At, B0); PG8_MMA(0, 1, At, B1); PG8_BAR; PG8_SCHED;
            PG8_LDA(At, 0, 1); PG8_STAGE(PG8_SB(0, 0), b2, voffB); PG8_STAGE(PG8_SB(0, 1), b2 + hstep, voffB); PG8_STAGE(PG8_SA(0, 0), a2, voffA);
            PG8_WAIT_V(8); PG8_WAIT_L(0); PG8_BAR; PG8_MMA(1, 0, At, B0); PG8_MMA(1, 1, At, B1); PG8_BAR; PG8_SCHED;
            PG8_LDB(B0, 1, 0); PG8_LDB(B1, 1, 1); PG8_SCHED; PG8_LDA(At, 1, 0); PG8_STAGE(PG8_SA(0, 1), a2 + hstep, voffA);
            PG8_WAIT_V(8); PG8_WAIT_L(0); PG8_BAR; PG8_MMA(0, 0, At, B0); PG8_MMA(0, 1, At, B1); PG8_BAR; PG8_SCHED;
            PG8_LDA(At, 1, 1); PG8_STAGE(PG8_SB(1, 0), b3, voffB); PG8_STAGE(PG8_SB(1, 1), b3 + hstep, voffB); PG8_STAGE(PG8_SA(1, 0), a3, voffA);
            PG8_WAIT_V(8); PG8_WAIT_L(0); PG8_BAR; PG8_MMA(1, 0, At, B0); PG8_MMA(1, 1, At, B1); PG8_BAR; PG8_SCHED;
            } else {
            PG8_LDB(B0, 0, 0); PG8_SCHED; PG8_LDA(At, 0, 0); PG8_STAGE(PG8_SA(1, 1), a1 + hstep, voffA);
            PG8_WAIT_L(8); PG8_BAR; PG8_WAIT_L(0); PG8_MMA(0, 0, At, B0); PG8_BAR; PG8_SCHED;
            PG8_LDB(B1, 0, 1); PG8_STAGE(PG8_SB(0, 0), b2, voffB);
            PG8_BAR; PG8_WAIT_L(0); PG8_MMA(0, 1, At, B1); PG8_BAR;
            PG8_LDA(At, 0, 1); PG8_STAGE(PG8_SA(0, 0), a2, voffA);
            PG8_BAR; PG8_WAIT_L(0); PG8_MMA(1, 0, At, B0); PG8_BAR; PG8_SCHED;
            PG8_STAGE(PG8_SB(0, 1), b2 + hstep, voffB);
            PG8_WAIT_V(6); PG8_BAR; PG8_MMA(1, 1, At, B1); PG8_BAR;
            PG8_LDB(B0, 1, 0); PG8_SCHED; PG8_LDA(At, 1, 0); PG8_STAGE(PG8_SA(0, 1), a2 + hstep, voffA);
            PG8_WAIT_L(8); PG8_BAR; PG8_WAIT_L(0); PG8_MMA(0, 0, At, B0); PG8_BAR; PG8_SCHED;
            PG8_LDB(B1, 1, 1); PG8_STAGE(PG8_SB(1, 0), b3, voffB);
            PG8_BAR; PG8_WAIT_L(0); PG8_MMA(0, 1, At, B1); PG8_BAR;
            PG8_LDA(At, 1, 1); PG8_STAGE(PG8_SA(1, 0), a3, voffA);
            PG8_BAR; PG8_WAIT_L(0); PG8_MMA(1, 0, At, B0); PG8_BAR; PG8_SCHED;
            PG8_STAGE(PG8_SB(1, 1), b3 + hstep, voffB);
            PG8_WAIT_V(6); PG8_BAR; PG8_MMA(1, 1, At, B1); PG8_BAR;
            }
        }
        if constexpr (ALIGN_EPI) { if (wr == 0) PG8_BAR; }
        if constexpr (!Epi::AFTER_DRAIN) { E(acc, cur, wr, wc, fr, fq); S.done(cur); }
        if (!has_next) break;
#pragma unroll
        for (int a = 0; a < 2; ++a)
#pragma unroll
            for (int b = 0; b < 2; ++b)
#pragma unroll
                for (int m = 0; m < 4; ++m)
#pragma unroll
                    for (int n = 0; n < 2; ++n) acc[a][b][m][n] = (f32x4){0.f, 0.f, 0.f, 0.f};
        cur = nxt; cA = nA; cB = nB; ++ui;
        if constexpr (ALIGN_EPI) { if (wr == 1) PG8_BAR; }
    }
    PG8_WAIT_V(0);
    if constexpr (!ALIGN_EPI) { if (wr == 0) PG8_BAR; }
    PG8_BAR;
    if constexpr (Epi::AFTER_DRAIN) { E.fused(acc, cur, wr, wc, fr, fq, lds, wid, lane); S.done(cur); }
#undef PG8_SA
#undef PG8_SB
#undef PG8_STAGE
#undef PG8_LDA
#undef PG8_LDB
#undef PG8_MMA
#undef PG8_WAIT_V
#undef PG8_WAIT_L
#undef PG8_BAR
#undef PG8_SCHED
}
}

DEV void phase_inproj(const ParamsG& p, int l, int hf, int skew, unsigned char* smem) {
  pg8::Gemm g{(const bf16_t*)(p.ws + OFF_XB) + (size_t)hf * TH * DM, (const bf16_t*)(p.ws + OFF_WIN), TH, NPAD, DM};
  pg8::XcdOrder S; S.init(TH, NPAD, skew);
  pg8::EpiIn E{(bf16_t*)(p.ws + OFF_H), NPAD, (float*)(p.ws + OFF_SMALL), SM0 / 256};
  pg8::gemm_phase<pg8::EpiIn, pg8::XcdOrder, true, true>((PG8_LAS unsigned char*)smem, g, S, E);
}

DEV void phase_outproj(const ParamsG& p, int l, int hf, unsigned char* smem) {
  pg8::Gemm g{(const bf16_t*)(p.ws + OFF_MIXED), (const bf16_t*)(p.ws + OFF_WOUT), TH, DM, DI};
  pg8::XcdOrder S; S.init(TH, DM);
  const float* xin = (const float*)(((l == 0) ? p.x : (GAS const float*)p.out) + (size_t)hf * TH * DM);
  pg8::EpiOut E{xin, (float*)(p.out + (size_t)hf * TH * DM), DM, DN_ALPHA};
  pg8::gemm_phase<pg8::EpiOut, pg8::XcdOrder, true, true>((PG8_LAS unsigned char*)smem, g, S, E);
}

DEV void phase_ln(const ParamsG& p, int l, int hf) {
  const int tid = launder(threadIdx.x), lane = tid & 63, w = tid >> 6;
  const float* g = (const float*)(p.ln_g + l * DM); const float* b = (const float*)(p.ln_b + l * DM);
  bf16_t* xb = (bf16_t*)(p.ws + OFF_XB);
  for (int r0 = (blockIdx.x * 8 + w) * 4; r0 < TH; r0 += gridDim.x * 32) {
    f32x4 v[4][4];
#pragma unroll
    for (int i = 0; i < 4; ++i)
#pragma unroll
      for (int j = 0; j < 4; ++j) v[i][j] = ((const f32x4*)(p.out + (size_t)(hf * TH + r0 + i) * DM))[j * 64 + lane];
    f32x4 gg[4], bb[4];
#pragma unroll
    for (int j = 0; j < 4; ++j) { gg[j] = ((const f32x4*)g)[j * 64 + lane]; bb[j] = ((const f32x4*)b)[j * 64 + lane]; }
#pragma unroll
    for (int i = 0; i < 4; ++i) {
      const int row = hf * TH + r0 + i;
      float sm = 0.f;
#pragma unroll
      for (int j = 0; j < 4; ++j) sm += (v[i][j][0] + v[i][j][1]) + (v[i][j][2] + v[i][j][3]);
#pragma unroll
      for (int o = 32; o >= 1; o >>= 1) sm += __shfl_xor(sm, o);
      const float mu = sm * (1.f / DM);
      float q = 0.f;
#pragma unroll
      for (int j = 0; j < 4; ++j) { const f32x4 d = v[i][j] - mu; q += (d[0] * d[0] + d[1] * d[1]) + (d[2] * d[2] + d[3] * d[3]); }
#pragma unroll
      for (int o = 32; o >= 1; o >>= 1) q += __shfl_xor(q, o);
      const float rstd = rsqrtf(q * (1.f / DM) + 1e-5f);
#pragma unroll
      for (int j = 0; j < 4; ++j) {
        const f32x4 o = (v[i][j] - mu) * rstd * gg[j] + bb[j];
        ((f32x4*)(p.out + (size_t)row * DM))[j * 64 + lane] = o;
        if (l == 0) *(uint2*)(xb + (size_t)row * DM + (j * 64 + lane) * 4) = make_uint2(pk2(o[0], o[1]), pk2(o[2], o[3]));
      }
    }
  }
}

DEV void attn_item(const ParamsG& p, int l, int item, unsigned char* smem) {
  const int tid = launder(threadIdx.x), lane = tid & 63, w = tid >> 6, r = lane & 31, h = lane >> 5;
  const int qt = item & 15, head = (item >> 4) & 7, bl = item >> 7;
  const int kvh = head >> 2;
  bf16_t* Hh = (bf16_t*)(p.ws + OFF_H);
  const bf16_t* VT = (const bf16_t*)(p.ws + OFF_VT);
  const size_t rowbase = (size_t)bl * SEQ;
  float mq = fabsf(p.q_gain[l * 64 + lane]), mk = fabsf(p.k_gain[l * 64 + lane]);
#pragma unroll
  for (int o = 32; o >= 1; o >>= 1) { mq = fmaxf(mq, __shfl_xor(mq, o)); mk = fmaxf(mk, __shfl_xor(mk, o)); }
  const float M2 = 8.f * mq * mk * LOG2E * 1.01f;
  const int qrow = qt * 256 + w * 32 + r;
  const bf16_t* qp = Hh + (rowbase + qrow) * NPAD + A_Q + head * 64 + 8 * h;
  bf16x8 qf[4];
#pragma unroll
  for (int ks = 0; ks < 4; ++ks) qf[ks] = *(const bf16x8*)(qp + ks * 16);
  f32x16 o0 = zero16(), o1 = zero16();
  f32x2_t lsum2 = {0.f, 0.f};
  const int srow = tid >> 3, sch = (tid & 7) * 8;
  const bf16_t* kp = Hh + (rowbase + srow) * NPAD + A_K + kvh * 64 + sch;
  const bf16_t* vp = VT + ((size_t)((bl * 2 + kvh) * 64 + srow)) * SEQ + sch;
  union PB { bf16x8 v; unsigned u[4]; };
  auto qk = [&](int st, f32x16& s0, f32x16& s1) __attribute__((always_inline)) {
    const bf16_t* sK = (const bf16_t*)(smem + st * 18432);
#pragma unroll
    for (int i = 0; i < 16; ++i) { s0[i] = -M2; s1[i] = -M2; }
#pragma unroll
    for (int ks = 0; ks < 4; ++ks) {
      const bf16x8 a0 = *(const bf16x8*)(sK + r * 72 + ks * 16 + 8 * h);
      const bf16x8 a1 = *(const bf16x8*)(sK + (32 + r) * 72 + ks * 16 + 8 * h);
      s0 = __builtin_amdgcn_mfma_f32_32x32x16_bf16(a0, qf[ks], s0, 0, 0, 0);
      s1 = __builtin_amdgcn_mfma_f32_32x32x16_bf16(a1, qf[ks], s1, 0, 0, 0);
    }
  };
  auto soft = [&](f32x16& s0, f32x16& s1, PB (&pb)[2][2]) __attribute__((always_inline)) {
#pragma unroll
    for (int i = 0; i < 16; ++i) { s0[i] = __builtin_amdgcn_exp2f(s0[i]); s1[i] = __builtin_amdgcn_exp2f(s1[i]); lsum2 += (f32x2_t){s0[i], s1[i]}; }
#pragma unroll
    for (int s = 0; s < 2; ++s)
#pragma unroll
      for (int j = 0; j < 4; ++j) {
        pb[0][s].u[j] = pk2(s0[8 * s + 2 * j], s0[8 * s + 2 * j + 1]);
        pb[1][s].u[j] = pk2(s1[8 * s + 2 * j], s1[8 * s + 2 * j + 1]);
      }
  };
  auto pv = [&](int st, const PB (&pb)[2][2]) __attribute__((always_inline)) {
    const bf16_t* sV = (const bf16_t*)(smem + st * 18432 + 9216);
#pragma unroll
    for (int kt2 = 0; kt2 < 2; ++kt2)
#pragma unroll
      for (int s = 0; s < 2; ++s) {
        const int kb = kt2 * 32 + 16 * s + 4 * h;
        union { bf16x8 v; uint2 u[2]; } a0, a1;
        a0.u[0] = *(const uint2*)(sV + r * 72 + kb); a0.u[1] = *(const uint2*)(sV + r * 72 + kb + 8);
        a1.u[0] = *(const uint2*)(sV + (32 + r) * 72 + kb); a1.u[1] = *(const uint2*)(sV + (32 + r) * 72 + kb + 8);
        o0 = __builtin_amdgcn_mfma_f32_32x32x16_bf16(a0.v, pb[kt2][s].v, o0, 0, 0, 0);
        o1 = __builtin_amdgcn_mfma_f32_32x32x16_bf16(a1.v, pb[kt2][s].v, o1, 0, 0, 0);
      }
  };
  auto compute2 = [&](int sta, int stb) __attribute__((always_inline)) {
    f32x16 sa0, sa1, sb0, sb1; PB pa[2][2], pbb[2][2];
    qk(sta, sa0, sa1); qk(stb, sb0, sb1);
    soft(sa0, sa1, pa); pv(sta, pa);
    soft(sb0, sb1, pbb); pv(stb, pbb);
  };
  constexpr int NKT = SEQ / 64;
  auto sstore = [&](int st, const u32x4& kk, const u32x4& vv) __attribute__((always_inline)) {
    *(u32x4*)(smem + st * 18432 + srow * 144 + sch * 2) = kk;
    *(u32x4*)(smem + st * 18432 + 9216 + srow * 144 + sch * 2) = vv;
  };
  u32x4 k0 = *(const u32x4*)kp, v0 = *(const u32x4*)vp;
  u32x4 k1 = *(const u32x4*)(kp + (size_t)64 * NPAD), v1 = *(const u32x4*)(vp + 64);
  sstore(0, k0, v0); sstore(1, k1, v1);
  k0 = *(const u32x4*)(kp + (size_t)2 * 64 * NPAD); v0 = *(const u32x4*)(vp + 2 * 64);
  k1 = *(const u32x4*)(kp + (size_t)3 * 64 * NPAD); v1 = *(const u32x4*)(vp + 3 * 64);
  lds_barrier();
  for (int kt = 0; kt < NKT; kt += 4) {
    sstore(2, k0, v0); sstore(3, k1, v1);
    if (kt + 4 < NKT) {
      k0 = *(const u32x4*)(kp + (size_t)(kt + 4) * 64 * NPAD); v0 = *(const u32x4*)(vp + (kt + 4) * 64);
      k1 = *(const u32x4*)(kp + (size_t)(kt + 5) * 64 * NPAD); v1 = *(const u32x4*)(vp + (kt + 5) * 64);
    }
    compute2(0, 1);
    lds_barrier();
    if (kt + 4 < NKT) {
      sstore(0, k0, v0); sstore(1, k1, v1);
      if (kt + 6 < NKT) {
        k0 = *(const u32x4*)(kp + (size_t)(kt + 6) * 64 * NPAD); v0 = *(const u32x4*)(vp + (kt + 6) * 64);
        k1 = *(const u32x4*)(kp + (size_t)(kt + 7) * 64 * NPAD); v1 = *(const u32x4*)(vp + (kt + 7) * 64);
      }
    }
    compute2(2, 3);
    lds_barrier();
  }
  float lsum = lsum2[0] + lsum2[1];
  lsum += __shfl_xor(lsum, 32);
  const float inv = 1.f / lsum;
  const bf16_t* zp = Hh + (rowbase + qrow) * NPAD + A_Z + head * 64;
  bf16_t* op = Hh + (rowbase + qrow) * NPAD + A_Q + head * 64;
#pragma unroll
  for (int dt = 0; dt < 2; ++dt)
#pragma unroll
    for (int g = 0; g < 4; ++g) {
      const int d0 = dt * 32 + 8 * g + 4 * h;
      const uint2 zz = *(const uint2*)(zp + d0);
      const float z0 = bf2f((bf16_t)(zz.x & 0xffff)), z1 = bf2f((bf16_t)(zz.x >> 16)), z2 = bf2f((bf16_t)(zz.y & 0xffff)), z3 = bf2f((bf16_t)(zz.y >> 16));
      const f32x16& oo = dt ? o1 : o0;
      uint2 ov;
      ov.x = pk2(oo[4 * g + 0] * inv * fsilu(z0), oo[4 * g + 1] * inv * fsilu(z1));
      ov.y = pk2(oo[4 * g + 2] * inv * fsilu(z2), oo[4 * g + 3] * inv * fsilu(z3));
      *(uint2*)(op + d0) = ov;
    }
  lds_barrier();
}

constexpr int L_QT = 0, L_KT = 17408, L_QC = 34816, L_KHT = 52224, L_VT = 70656, L_ST = 89088,
              L_D = 123904, L_TOT = 124416, L_ACS = 128512, L_DT = 129024;

template <int K, int V> struct ScanGeom {
  static constexpr int KP = K + 8;
  static constexpr int NS = (K / 32) * (V / 32) / 8;
};

template <int K, int V>
DEV void scan_write_state(unsigned char* smem, const f32x16* S, int w, int lane) {
  constexpr int KP = K + 8, NS = ScanGeom<K, V>::NS, NVT = V / 32;
  bf16_t* sST = (bf16_t*)(smem + L_ST);
  const int c = lane & 31, h = lane >> 5;
#pragma unroll
  for (int i = 0; i < NS; ++i) {
    const int tile = w * NS + i, kt = tile / NVT, nt = tile % NVT;
#pragma unroll
    for (int g = 0; g < 4; ++g) {
      uint2 o; o.x = pk2(S[i][4 * g + 0], S[i][4 * g + 1]); o.y = pk2(S[i][4 * g + 2], S[i][4 * g + 3]);
      *(uint2*)(sST + (nt * 32 + c) * KP + kt * 32 + 8 * g + 4 * h) = o;
    }
  }
}

template <int K, int V, bool SSDM>
DEV void scan_core(unsigned char* smem, f32x16* S, bf16_t* orow0, int dir, int w, int lane, bool do_out, const float* sAcs) {
  constexpr int KP = K + 8, NS = ScanGeom<K, V>::NS, NVT = V / 32, NOT = 2 * NVT;
  const bf16_t* sQt = (const bf16_t*)(smem + L_QT); const bf16_t* sKt = (const bf16_t*)(smem + L_KT);
  const bf16_t* sQc = (const bf16_t*)(smem + L_QC); const bf16_t* sKhT = (const bf16_t*)(smem + L_KHT);
  const bf16_t* sVT = (const bf16_t*)(smem + L_VT);
  const bf16_t* sST = (const bf16_t*)(smem + L_ST); const float* sD = (const float*)(smem + L_D);
  const int c = lane & 31, h = lane >> 5;
  if (do_out && w < NOT) {
    const int tt = w / NVT, nt = w % NVT;
    f32x16 acc = zero16();
#pragma unroll
    for (int st = 0; st < 2; ++st) {
      if (st <= tt) {
        f32x16 pt = zero16();
        mma32<K>(pt, sKt + st * 32 * KP, KP, sQt + tt * 32 * KP, KP, lane);
        const int tau = tt * 32 + c;
        const float at = SSDM ? sAcs[tau] : 0.f;
#pragma unroll
        for (int reg = 0; reg < 16; ++reg) {
          const int sig = st * 32 + rowoff(reg, h);
          float v = pt[reg];
          if (SSDM) v *= ex2(at - sAcs[sig]);
          pt[reg] = (sig <= tau) ? v : 0.f;
        }
#pragma unroll
        for (int s2 = 0; s2 < 2; ++s2) {
          union { bf16x8 v; unsigned u[4]; } pa;
#pragma unroll
          for (int j = 0; j < 4; ++j) pa.u[j] = pk2(pt[8 * s2 + 2 * j], pt[8 * s2 + 2 * j + 1]);
          const int kb = st * 32 + 16 * s2 + 4 * h;
          union { bf16x8 v; uint2 u[2]; } vb;
          vb.u[0] = *(const uint2*)(sVT + (nt * 32 + c) * 72 + kb); vb.u[1] = *(const uint2*)(sVT + (nt * 32 + c) * 72 + kb + 8);
          acc = __builtin_amdgcn_mfma_f32_32x32x16_bf16(pa.v, vb.v, acc, 0, 0, 0);
        }
      }
    }
    mma32<K>(acc, sQc + tt * 32 * KP, KP, sST + nt * 32 * KP, KP, lane);
#pragma unroll
    for (int reg = 0; reg < 16; ++reg) {
      const int tau = tt * 32 + rowoff(reg, h);
      const int tok = dir ? (63 - tau) : tau;
      orow0[(size_t)tok * 512 + nt * 32 + c] = f2bf(acc[reg]);
    }
  }
#pragma unroll
  for (int i = 0; i < NS; ++i) {
    const int tile = w * NS + i, kt = tile / NVT, nt = tile % NVT;
#pragma unroll
    for (int reg = 0; reg < 16; ++reg) S[i][reg] *= sD[kt * 32 + rowoff(reg, h)];
    mma32<64>(S[i], sKhT + kt * 32 * 72, 72, sVT + nt * 32 * 72, 72, lane);
  }
}

template <int K, int V>
DEV void state_store(float* buf, const f32x16* S, int w, int lane) {
  constexpr int NS = ScanGeom<K, V>::NS, NVT = V / 32;
  const int c = lane & 31, h = lane >> 5;
#pragma unroll
  for (int i = 0; i < NS; ++i) {
    const int tile = w * NS + i, kt = tile / NVT, nt = tile % NVT;
#pragma unroll
    for (int reg = 0; reg < 16; ++reg) buf[(kt * 32 + rowoff(reg, h)) * V + nt * 32 + c] = S[i][reg];
  }
}
template <int K, int V>
DEV void state_load(const float* buf, f32x16* S, int w, int lane) {
  constexpr int NS = ScanGeom<K, V>::NS, NVT = V / 32;
  const int c = lane & 31, h = lane >> 5;
#pragma unroll
  for (int i = 0; i < NS; ++i) {
    const int tile = w * NS + i, kt = tile / NVT, nt = tile % NVT;
#pragma unroll
    for (int reg = 0; reg < 16; ++reg) S[i][reg] = buf[(kt * 32 + rowoff(reg, h)) * V + nt * 32 + c];
  }
}

template <int K, int V>
DEV void state_combine(const float* ubase, int ustride, const float* dbase, int seg, f32x16* S, int w, int lane) {
  constexpr int NS = ScanGeom<K, V>::NS, NVT = V / 32;
  const int c = lane & 31, h = lane >> 5;
  for (int j = 0; j < seg; ++j) {
    const float* buf = ubase + (size_t)j * ustride;
    const float* dj = dbase + j * 128;
    float u[NS][16]; f32x4 dv[NS][4];
#pragma unroll
    for (int i = 0; i < NS; ++i) {
      const int tile = w * NS + i, kt = tile / NVT, nt = tile % NVT;
#pragma unroll
      for (int g = 0; g < 4; ++g) dv[i][g] = *(const f32x4*)(dj + kt * 32 + 8 * g + 4 * h);
#pragma unroll
      for (int reg = 0; reg < 16; ++reg) u[i][reg] = buf[(kt * 32 + rowoff(reg, h)) * V + nt * 32 + c];
    }
#pragma unroll
    for (int i = 0; i < NS; ++i)
#pragma unroll
      for (int reg = 0; reg < 16; ++reg) S[i][reg] = (j > 0 ? dv[i][reg >> 2][reg & 3] * S[i][reg] : 0.f) + u[i][reg];
  }
}

#define PACK8_LO(v) (u32x4){((v)[0] & 0xffffu) | ((v)[1] << 16), ((v)[2] & 0xffffu) | ((v)[3] << 16), ((v)[4] & 0xffffu) | ((v)[5] << 16), ((v)[6] & 0xffffu) | ((v)[7] << 16)}
#define PACK8_HI(v) (u32x4){((v)[0] >> 16) | ((v)[1] & 0xffff0000u), ((v)[2] >> 16) | ((v)[3] & 0xffff0000u), ((v)[4] >> 16) | ((v)[5] & 0xffff0000u), ((v)[6] >> 16) | ((v)[7] & 0xffff0000u)}
#define CVT8(f) (u32x4){pk2((f)[0], (f)[1]), pk2((f)[2], (f)[3]), pk2((f)[4], (f)[5]), pk2((f)[6], (f)[7])}


DEV void hgrn_item(const ParamsG& p, int l, int it, int seg, int mode, unsigned char* smem) {
  const int bl = it >> 3, head = (it >> 1) & 3, dir = it & 1;
  const bool do_out = (mode == 3);
  constexpr int K = 128, V = 128, KPW = 68;
  const int tid = launder(threadIdx.x), lane = tid & 63, w = tid >> 6;
  const int cp = tid & 63, tg = tid >> 6, ch0 = 2 * cp;
  const bf16_t* Hh = (const bf16_t*)(p.ws + OFF_H);
  bf16_t* OB = (bf16_t*)(p.ws + OFF_OBUF) + (size_t)(0 * 2 + dir) * TH * 512;
  const size_t rowbase = (size_t)bl * SEQ;
  float lb0 = 0.f, lb1 = 0.f;
  if (l > 0) {
    lb0 = fsigmoid(p.lb_logits[512 + head * 128 + ch0] - p.lb_logits[head * 128 + ch0]);
    lb1 = fsigmoid(p.lb_logits[512 + head * 128 + ch0 + 1] - p.lb_logits[head * 128 + ch0 + 1]);
  }
  const float om0 = 1.f - lb0, om1 = 1.f - lb1;
  const int fbase = dir ? H_FB : H_FF;
  unsigned* sQt = (unsigned*)(smem + L_QT); unsigned* sKt = (unsigned*)(smem + L_KT); unsigned* sQc = (unsigned*)(smem + L_QC);
  bf16_t* sKhT = (bf16_t*)(smem + L_KHT); bf16_t* sVT = (bf16_t*)(smem + L_VT);
  float* sD = (float*)(smem + L_D); float* sTot = (float*)(smem + L_TOT);
  f32x16 S[2]; S[0] = zero16(); S[1] = zero16();
  float* sbuf = (float*)(p.ws + OFF_SB0) + ((size_t)it * NSEG + seg) * 16384;
  if (do_out) state_combine<K, V>((const float*)(p.ws + OFF_SB0) + (size_t)it * NSEG * 16384, 16384, (const float*)(p.ws + OFF_DB) + (size_t)it * NSEG * 128, seg, S, w, lane);
  float dlog0 = 0.f, dlog1 = 0.f;
  unsigned pf[8], qq[8], vv[8];
  float g0[8], g1[8], kx0[8], kx1[8];
  auto gloadA = [&](int cidx) __attribute__((always_inline)) {
    const int chunk = dir ? (63 - cidx) : cidx;
#pragma unroll
    for (int i = 0; i < 8; ++i) {
      const int tau = 8 * tg + i;
      const int tok = chunk * 64 + (dir ? (63 - tau) : tau);
      pf[i] = ((const unsigned*)(Hh + (rowbase + tok) * NPAD + head * 128 + fbase))[cp];
    }
  };
  auto gloadB = [&](int cidx) __attribute__((always_inline)) {
    const int chunk = dir ? (63 - cidx) : cidx;
#pragma unroll
    for (int i = 0; i < 8; ++i) {
      const int tau = 8 * tg + i;
      const int tok = chunk * 64 + (dir ? (63 - tau) : tau);
      const unsigned* rp = (const unsigned*)(Hh + (rowbase + tok) * NPAD + head * 128) + cp;
      vv[i] = rp[H_I / 2];
      qq[i] = do_out ? rp[H_Q / 2] : 0u;
    }
  };
  auto stage1 = [&]() __attribute__((always_inline)) {
    float r0 = 0.f, r1 = 0.f;
#pragma unroll
    for (int i = 0; i < 8; ++i) {
      const float e0 = ex2(fminf(-lo16(pf[i]) * LOG2E, 80.f)), e1 = ex2(fminf(-hi16(pf[i]) * LOG2E, 80.f));
      const float s0 = frcp(1.f + e0), s1 = frcp(1.f + e1);
      r0 += lg2(lb0 + om0 * s0); r1 += lg2(lb1 + om1 * s1);
      g0[i] = r0; g1[i] = r1;
      kx0[i] = om0 * e0 * s0; kx1[i] = om1 * e1 * s1;
    }
    *(float2*)(sTot + tg * 128 + ch0) = make_float2(r0, r1);
  };
  gloadA(seg * SLEN); gloadB(seg * SLEN);
  stage1();
  if (SLEN > 1) gloadA(seg * SLEN + 1);
  for (int ci = 0; ci < SLEN; ++ci) {
    const int cidx = seg * SLEN + ci;
    const int chunk = dir ? (63 - cidx) : cidx;
    lds_barrier();
    float off0 = 0.f, off1 = 0.f, ref0 = 0.f, ref1 = 0.f, be0 = 0.f, be1 = 0.f;
#pragma unroll
    for (int j = 0; j < 8; ++j) {
      const float2 t = *(const float2*)(sTot + j * 128 + ch0);
      if (j < tg) { off0 += t.x; off1 += t.y; }
      if (j < 4) { ref0 += t.x; ref1 += t.y; }
      be0 += t.x; be1 += t.y;
    }
    dlog0 += be0; dlog1 += be1;
    const float eref0 = ex2(ref0), eref1 = ex2(ref1), ebr0 = ex2(be0 - ref0), ebr1 = ex2(be1 - ref1);
    const float d0 = off0 - ref0, d1 = off1 - ref1;
    float kh0[8], kh1[8];
#pragma unroll
    for (int i = 0; i < 8; ++i) {
      const int tau = 8 * tg + i;
      const float E0 = ex2(g0[i] + d0), E1 = ex2(g1[i] + d1);
      const float kt0 = kx0[i] * frcp(E0), kt1 = kx1[i] * frcp(E1);
      if (do_out) {
        const float qt0 = lo16(qq[i]) * E0, qt1 = hi16(qq[i]) * E1;
        sQt[tau * KPW + cp] = pk2(qt0, qt1);
        sKt[tau * KPW + cp] = pk2(kt0, kt1);
        sQc[tau * KPW + cp] = pk2(qt0 * eref0, qt1 * eref1);
      }
      kh0[i] = kt0 * ebr0; kh1[i] = kt1 * ebr1;
    }
    *(u32x4*)(sKhT + ch0 * 72 + 8 * tg) = CVT8(kh0);
    *(u32x4*)(sKhT + (ch0 + 1) * 72 + 8 * tg) = CVT8(kh1);
    *(u32x4*)(sVT + ch0 * 72 + 8 * tg) = PACK8_LO(vv);
    *(u32x4*)(sVT + (ch0 + 1) * 72 + 8 * tg) = PACK8_HI(vv);
    if (tg == 0) *(float2*)(sD + ch0) = make_float2(ex2(be0), ex2(be1));
    if (do_out) scan_write_state<K, V>(smem, S, w, lane);
    if (ci + 1 < SLEN) gloadB(cidx + 1);
    lds_barrier();
    scan_core<K, V, false>(smem, S, OB + (rowbase + (size_t)chunk * 64) * 512 + head * 128, dir, w, lane, do_out, nullptr);
    if (ci + 1 < SLEN) { stage1(); if (ci + 2 < SLEN) gloadA(cidx + 2); }
  }
  if (!do_out) {
    state_store<K, V>(sbuf, S, w, lane);
    if (tg == 0) *(float2*)((float*)(p.ws + OFF_DB) + ((size_t)it * NSEG + seg) * 128 + ch0) = make_float2(ex2(dlog0), ex2(dlog1));
  }
  lds_barrier();
}

DEV void gla_item(const ParamsG& p, int l, int it, int seg, int mode, unsigned char* smem) {
  const int j16 = it - 16, bl = j16 >> 3, head = (j16 >> 1) & 3, dir = j16 & 1;
  const bool do_out = (mode == 3);
  constexpr int K = 64, V = 128, KPW = 36;
  const int tid = launder(threadIdx.x), lane = tid & 63, w = tid >> 6;
  const int cp = tid & 31, tg = tid >> 5, ch0 = 2 * cp;
  const int vp2 = tid & 63, vg = tid >> 6;
  const bf16_t* Hh = (const bf16_t*)(p.ws + OFF_H);
  const bf16_t* Gb = (const bf16_t*)(p.ws + OFF_G);
  bf16_t* OB = (bf16_t*)(p.ws + OFF_OBUF) + (size_t)(2 * 2 + dir) * TH * 512;
  const size_t rowbase = (size_t)bl * SEQ;
  unsigned* sQt = (unsigned*)(smem + L_QT); unsigned* sKt = (unsigned*)(smem + L_KT); unsigned* sQc = (unsigned*)(smem + L_QC);
  bf16_t* sKhT = (bf16_t*)(smem + L_KHT); bf16_t* sVT = (bf16_t*)(smem + L_VT);
  float* sD = (float*)(smem + L_D); float* sTot = (float*)(smem + L_TOT);
  f32x16 S[1]; S[0] = zero16();
  float* sbuf = (float*)(p.ws + OFF_SB1) + ((size_t)j16 * NSEG + seg) * 8192;
  if (do_out) state_combine<K, V>((const float*)(p.ws + OFF_SB1) + (size_t)j16 * NSEG * 8192, 8192, (const float*)(p.ws + OFF_DB) + (size_t)it * NSEG * 128, seg, S, w, lane);
  float dlog0 = 0.f, dlog1 = 0.f;
  unsigned pg[4];
  float g0[4], g1[4]; unsigned kk[4], qq[4], vv[8];
  auto gloadA = [&](int cidx) __attribute__((always_inline)) {
    const int chunk = dir ? (63 - cidx) : cidx;
#pragma unroll
    for (int i = 0; i < 4; ++i) {
      const int tau = 4 * tg + i;
      const int tok = chunk * 64 + (dir ? (63 - tau) : tau);
      pg[i] = ((const unsigned*)(Gb + (rowbase + tok) * 512 + dir * 256 + head * 64))[cp];
    }
  };
  auto gloadB = [&](int cidx) __attribute__((always_inline)) {
    const int chunk = dir ? (63 - cidx) : cidx;
#pragma unroll
    for (int i = 0; i < 4; ++i) {
      const int tau = 4 * tg + i;
      const int tok = chunk * 64 + (dir ? (63 - tau) : tau);
      const unsigned* rp = (const unsigned*)(Hh + (rowbase + tok) * NPAD + head * 64) + cp;
      kk[i] = rp[G_K / 2]; qq[i] = do_out ? rp[G_Q / 2] : 0u;
    }
#pragma unroll
    for (int i = 0; i < 8; ++i) {
      const int tau = 8 * vg + i;
      const int tok = chunk * 64 + (dir ? (63 - tau) : tau);
      vv[i] = ((const unsigned*)(Hh + (rowbase + tok) * NPAD + G_V + head * 128))[vp2];
    }
  };
  auto stage1 = [&]() __attribute__((always_inline)) {
    float r0 = 0.f, r1 = 0.f;
#pragma unroll
    for (int i = 0; i < 4; ++i) { r0 += lo16(pg[i]); r1 += hi16(pg[i]); g0[i] = r0; g1[i] = r1; }
    *(float2*)(sTot + tg * 64 + ch0) = make_float2(r0, r1);
  };
  gloadA(seg * SLEN); gloadB(seg * SLEN);
  stage1();
  if (SLEN > 1) gloadA(seg * SLEN + 1);
  for (int ci = 0; ci < SLEN; ++ci) {
    const int cidx = seg * SLEN + ci;
    const int chunk = dir ? (63 - cidx) : cidx;
    lds_barrier();
    float off0 = 0.f, off1 = 0.f, ref0 = 0.f, ref1 = 0.f, be0 = 0.f, be1 = 0.f;
#pragma unroll
    for (int j = 0; j < 16; ++j) {
      const float2 t = *(const float2*)(sTot + j * 64 + ch0);
      if (j < tg) { off0 += t.x; off1 += t.y; }
      if (j < 8) { ref0 += t.x; ref1 += t.y; }
      be0 += t.x; be1 += t.y;
    }
    dlog0 += be0; dlog1 += be1;
    const float eref0 = ex2(ref0), eref1 = ex2(ref1), ebr0 = ex2(be0 - ref0), ebr1 = ex2(be1 - ref1);
    const float d0 = off0 - ref0, d1 = off1 - ref1;
    float kh0[4], kh1[4];
#pragma unroll
    for (int i = 0; i < 4; ++i) {
      const int tau = 4 * tg + i;
      const float E0 = ex2(g0[i] + d0), E1 = ex2(g1[i] + d1);
      const float kt0 = lo16(kk[i]) * frcp(E0), kt1 = hi16(kk[i]) * frcp(E1);
      if (do_out) {
        const float qt0 = lo16(qq[i]) * E0, qt1 = hi16(qq[i]) * E1;
        sQt[tau * KPW + cp] = pk2(qt0, qt1);
        sKt[tau * KPW + cp] = pk2(kt0, kt1);
        sQc[tau * KPW + cp] = pk2(qt0 * eref0, qt1 * eref1);
      }
      kh0[i] = kt0 * ebr0; kh1[i] = kt1 * ebr1;
    }
    *(uint2*)(sKhT + ch0 * 72 + 4 * tg) = make_uint2(pk2(kh0[0], kh0[1]), pk2(kh0[2], kh0[3]));
    *(uint2*)(sKhT + (ch0 + 1) * 72 + 4 * tg) = make_uint2(pk2(kh1[0], kh1[1]), pk2(kh1[2], kh1[3]));
    *(u32x4*)(sVT + (2 * vp2) * 72 + 8 * vg) = PACK8_LO(vv);
    *(u32x4*)(sVT + (2 * vp2 + 1) * 72 + 8 * vg) = PACK8_HI(vv);
    if (tg == 0) *(float2*)(sD + ch0) = make_float2(ex2(be0), ex2(be1));
    if (do_out) scan_write_state<K, V>(smem, S, w, lane);
    if (ci + 1 < SLEN) gloadB(cidx + 1);
    lds_barrier();
    scan_core<K, V, false>(smem, S, OB + (rowbase + (size_t)chunk * 64) * 512 + head * 128, dir, w, lane, do_out, nullptr);
    if (ci + 1 < SLEN) { stage1(); if (ci + 2 < SLEN) gloadA(cidx + 2); }
  }
  if (!do_out) {
    state_store<K, V>(sbuf, S, w, lane);
    if (tg == 0) *(float2*)((float*)(p.ws + OFF_DB) + ((size_t)it * NSEG + seg) * 128 + ch0) = make_float2(ex2(dlog0), ex2(dlog1));
  }
  lds_barrier();
}

DEV void ssd_item(const ParamsG& p, int l, int it, int seg, int mode, unsigned char* smem) {
  const int j32 = it - 32, bl = j32 >> 4, head = (j32 >> 1) & 7, dir = j32 & 1;
  const bool do_out = (mode == 3);
  constexpr int K = 128, V = 64, KPW = 68;
  const int tid = launder(threadIdx.x), lane = tid & 63, w = tid >> 6;
  const int cp = tid & 63, tg = tid >> 6, n0 = 2 * cp;
  const int xp = tid & 31, xg = tid >> 5;
  const int grp = head >> 2;
  const bf16_t* U = (const bf16_t*)(p.ws + OFF_U);
  const float* SMALL = (const float*)(p.ws + OFF_SMALL);
  bf16_t* OB = (bf16_t*)(p.ws + OFF_OBUF) + (size_t)(1 * 2 + dir) * TH * 512;
  const size_t rowbase = (size_t)bl * SEQ;
  unsigned* sQt = (unsigned*)(smem + L_QT); unsigned* sKt = (unsigned*)(smem + L_KT); unsigned* sQc = (unsigned*)(smem + L_QC);
  bf16_t* sKhT = (bf16_t*)(smem + L_KHT); bf16_t* sVT = (bf16_t*)(smem + L_VT);
  float* sD = (float*)(smem + L_D);
  const float dtb = p.dt_bias[(l * 2 + dir) * 8 + head];
  const float Acoef = -__expf(p.a_log[(l * 2 + dir) * 8 + head]) * LOG2E;
  f32x16 S[1]; S[0] = zero16();
  float* sbuf = (float*)(p.ws + OFF_SB2) + ((size_t)j32 * NSEG + seg) * 8192;
  if (do_out) state_combine<K, V>((const float*)(p.ws + OFF_SB2) + (size_t)j32 * NSEG * 8192, 8192, (const float*)(p.ws + OFF_DB) + (size_t)it * NSEG * 128, seg, S, w, lane);
  float dlog = 0.f;
  unsigned bb[8], cc[8], xx[4];
  float rdt = 0.f;
  auto gloadA = [&](int cidx) __attribute__((always_inline)) {
    const int chunk = dir ? (63 - cidx) : cidx;
    if (w == 0) {
      const int tok = chunk * 64 + (dir ? (63 - lane) : lane);
      rdt = SMALL[(rowbase + tok) * 48 + dir * 8 + head];
    }
  };
  auto gloadB = [&](int cidx) __attribute__((always_inline)) {
    const int chunk = dir ? (63 - cidx) : cidx;
#pragma unroll
    for (int i = 0; i < 8; ++i) {
      const int tau = 8 * tg + i;
      const int tok = chunk * 64 + (dir ? (63 - tau) : tau);
      const unsigned* rp = (const unsigned*)(U + (rowbase + tok) * 1024 + grp * 128) + cp;
      bb[i] = rp[512 / 2]; cc[i] = do_out ? rp[768 / 2] : 0u;
    }
#pragma unroll
    for (int i = 0; i < 4; ++i) {
      const int tau = 4 * xg + i;
      const int tok = chunk * 64 + (dir ? (63 - tau) : tau);
      xx[i] = ((const unsigned*)(U + (rowbase + tok) * 1024 + head * 64))[xp];
    }
  };
  auto stage1 = [&](int par) __attribute__((always_inline)) {
    if (w == 0) {
      const float xv = rdt + dtb;
      const float dt = (xv > 20.f) ? xv : log1pf(__expf(xv));
      float a = dt * Acoef;
#pragma unroll
      for (int o = 1; o < 64; o <<= 1) { const float t = __shfl_up(a, o); if (lane >= o) a += t; }
      ((float*)(smem + L_ACS))[par * 64 + lane] = a; ((float*)(smem + L_DT))[par * 64 + lane] = dt;
    }
  };
  gloadA(seg * SLEN); gloadB(seg * SLEN);
  stage1(0);
  if (SLEN > 1) gloadA(seg * SLEN + 1);
  for (int ci = 0; ci < SLEN; ++ci) {
    const int cidx = seg * SLEN + ci;
    const int chunk = dir ? (63 - cidx) : cidx;
    const float* sAcs = (const float*)(smem + L_ACS) + (ci & 1) * 64;
    const float* sDt = (const float*)(smem + L_DT) + (ci & 1) * 64;
    lds_barrier();
    const float aend = sAcs[63];
    dlog += aend;
    {
      float kh0[8], kh1[8];
#pragma unroll
      for (int i = 0; i < 8; ++i) {
        const int tau = 8 * tg + i;
        const float ac = sAcs[tau];
        const float eb = ex2(aend - ac);
        kh0[i] = lo16(bb[i]) * eb; kh1[i] = hi16(bb[i]) * eb;
        if (do_out) {
          const float ea = ex2(ac);
          sKt[tau * KPW + cp] = bb[i];
          sQt[tau * KPW + cp] = cc[i];
          sQc[tau * KPW + cp] = pk2(lo16(cc[i]) * ea, hi16(cc[i]) * ea);
        }
      }
      *(u32x4*)(sKhT + n0 * 72 + 8 * tg) = CVT8(kh0);
      *(u32x4*)(sKhT + (n0 + 1) * 72 + 8 * tg) = CVT8(kh1);
      float x0[4], x1[4];
#pragma unroll
      for (int i = 0; i < 4; ++i) { const float dtv = sDt[4 * xg + i]; x0[i] = lo16(xx[i]) * dtv; x1[i] = hi16(xx[i]) * dtv; }
      *(uint2*)(sVT + (2 * xp) * 72 + 4 * xg) = make_uint2(pk2(x0[0], x0[1]), pk2(x0[2], x0[3]));
      *(uint2*)(sVT + (2 * xp + 1) * 72 + 4 * xg) = make_uint2(pk2(x1[0], x1[1]), pk2(x1[2], x1[3]));
      if (tg == 0) *(float2*)(sD + n0) = make_float2(ex2(aend), ex2(aend));
    }
    if (do_out) scan_write_state<K, V>(smem, S, w, lane);
    if (ci + 1 < SLEN) gloadB(cidx + 1);
    lds_barrier();
    scan_core<K, V, true>(smem, S, OB + (rowbase + (size_t)chunk * 64) * 512 + head * 64, dir, w, lane, do_out, sAcs);
    if (ci + 1 < SLEN) { stage1((ci + 1) & 1); if (ci + 2 < SLEN) gloadA(cidx + 2); }
  }
  if (!do_out) {
    state_store<K, V>(sbuf, S, w, lane);
    if (tg == 0) *(float2*)((float*)(p.ws + OFF_DB) + ((size_t)it * NSEG + seg) * 128 + n0) = make_float2(ex2(dlog), ex2(dlog));
  }
  lds_barrier();
}

DEV void phase_prep(const ParamsG& p, int l, int hf, int rep, unsigned char* smem) {
  const int tid = launder(threadIdx.x), lane = tid & 63;
  bf16_t* Hh = (bf16_t*)(p.ws + OFF_H);
  bf16_t* U = (bf16_t*)(p.ws + OFF_U);
  bf16_t* Gb = (bf16_t*)(p.ws + OFF_G);
  bf16_t* VT = (bf16_t*)(p.ws + OFF_VT);
  const float* SMALLp = (const float*)(p.ws + OFF_SMALL);
  float2* stab = (float2*)smem;
  float* slow = (float*)(smem + 8192);
  bf16_t* sT = (bf16_t*)(smem + 12288);
  {
    const float2* tabg = (const float2*)(p.ws + OFF_TAB);
    for (int i = tid; i < 1024; i += NT) stab[i] = tabg[i];
  }
  const int cg8 = (tid & 127) * 8, rsub = tid >> 7;
  const float* cw = (const float*)(p.conv_w + (size_t)l * 5 * 1024); const float* cb = (const float*)(p.conv_b + (size_t)l * 1024);
  float wv[5][8], bv[8];
#pragma unroll
  for (int j = 0; j < 5; ++j)
#pragma unroll
    for (int e = 0; e < 8; ++e) wv[j][e] = cw[j * 1024 + cg8 + e];
#pragma unroll
  for (int e = 0; e < 8; ++e) bv[e] = cb[cg8 + e];
  const int gd = tid >> 8, gc = tid & 255;
  const int i16 = lane & 15;
  const float* gq = (const float*)(p.q_gain + l * 64 + 4 * i16); const float* gk = (const float*)(p.k_gain + l * 64 + 4 * i16);
  const float gqv[4] = {gq[0], gq[1], gq[2], gq[3]}, gkv[4] = {gk[0], gk[1], gk[2], gk[3]};
  for (int grp = blockIdx.x; grp < TH / 32; grp += gridDim.x) {
    const int r0 = grp * 32;
    lds_barrier();
    const u32x4 vt = *(const u32x4*)(Hh + (size_t)(r0 + (tid >> 4)) * NPAD + A_V + (tid & 15) * 8);
    const float2 lowv = *(const float2*)(SMALLp + (size_t)(r0 + (tid >> 4)) * 48 + 16 + (tid & 15) * 2);
    *(u32x4*)(sT + (tid >> 4) * 136 + (tid & 15) * 8) = vt;
    *(float2*)(slow + (tid >> 4) * 32 + (tid & 15) * 2) = lowv;
#pragma unroll 1
    for (int ps = 0; ps < 2; ++ps) {
      const int ra = r0 + 16 * ps + 4 * rsub, ta = ra & (SEQ - 1);
      u32x4 xc[8];
#pragma unroll
      for (int m = 0; m < 8; ++m) {
        const int sq = ta + m - 2;
        xc[m] = (u32x4){0u, 0u, 0u, 0u};
        if (sq >= 0 && sq < SEQ) xc[m] = *(const u32x4*)(Hh + (size_t)(ra + m - 2) * NPAD + S_X + cg8);
      }
#pragma unroll
      for (int o4 = 0; o4 < 4; ++o4) {
        float u[8];
#pragma unroll
        for (int e = 0; e < 8; ++e) u[e] = bv[e];
#pragma unroll
        for (int j = 0; j < 5; ++j)
#pragma unroll
          for (int e = 0; e < 4; ++e) { u[2 * e] += wv[j][2 * e] * lo16(xc[o4 + j][e]); u[2 * e + 1] += wv[j][2 * e + 1] * hi16(xc[o4 + j][e]); }
        u32x4 o;
#pragma unroll
        for (int e = 0; e < 4; ++e) {
          const float a = u[2 * e] * frcp(1.f + ex2(fminf(-u[2 * e] * LOG2E, 80.f)));
          const float b = u[2 * e + 1] * frcp(1.f + ex2(fminf(-u[2 * e + 1] * LOG2E, 80.f)));
          o[e] = pk2(a, b);
        }
        *(u32x4*)(U + (size_t)(ra + o4) * 1024 + cg8) = o;
      }
    }
    lds_barrier();
    if (rep == 0) {
#pragma unroll 1
      for (int ub = 0; ub < 10; ub += 5) {
        uint2 xq[5];
#pragma unroll
        for (int u = 0; u < 5; ++u) {
          const int pi = (ub + u) * 32 + (tid >> 4), row = r0 + pi / 10, hd = pi % 10;
          xq[u] = *(const uint2*)(Hh + (size_t)row * NPAD + ((hd < 8) ? (A_Q + hd * 64) : (A_K + (hd - 8) * 64)) + 4 * i16);
        }
#pragma unroll
        for (int u = 0; u < 5; ++u) {
          const int pi = (ub + u) * 32 + (tid >> 4), row = r0 + pi / 10, hd = pi % 10;
          const bool isq = hd < 8;
          const float x[4] = {lo16(xq[u].x), hi16(xq[u].x), lo16(xq[u].y), hi16(xq[u].y)};
          float ss = x[0] * x[0] + x[1] * x[1] + x[2] * x[2] + x[3] * x[3];
          ss += __shfl_xor(ss, 1); ss += __shfl_xor(ss, 2); ss += __shfl_xor(ss, 4); ss += __shfl_xor(ss, 8);
          const float rstd = rsqrtf(ss * (1.f / 64.f) + 1e-6f);
          const int t = row & (SEQ - 1);
          const int pos = (i16 < 8) ? (t >> 6) : (t & 63);
          const float osc = isq ? QSCALE : 1.f;
          float o[4];
#pragma unroll
          for (int e = 0; e < 4; ++e) {
            const float v = x[e] * rstd * (isq ? gqv[e] : gkv[e]);
            const float pv = __shfl_xor(v, 4);
            const float2 cs = stab[pos * 16 + 4 * (i16 & 3) + e];
            o[e] = ((i16 & 4) ? (v * cs.x + pv * cs.y) : (v * cs.x - pv * cs.y)) * osc;
          }
          *(uint2*)(Hh + (size_t)row * NPAD + (isq ? (A_Q + hd * 64) : (A_K + (hd - 8) * 64)) + 4 * i16) = make_uint2(pk2(o[0], o[1]), pk2(o[2], o[3]));
        }
      }
    }
    float w2c[16];
#pragma unroll
    for (int r = 0; r < 16; ++r) w2c[r] = p.gk_w2[((size_t)(l * 2 + gd) * 16 + r) * 256 + gc];
    const float gbias = p.gk_b[(l * 2 + gd) * 256 + gc];
#pragma unroll 4
    for (int rr = 0; rr < 32; ++rr) {
      const float4* lp4 = (const float4*)(slow + rr * 32 + gd * 16);
      float gkk = gbias;
#pragma unroll
      for (int r4 = 0; r4 < 4; ++r4) { const float4 lw = lp4[r4]; gkk += lw.x * w2c[4 * r4] + lw.y * w2c[4 * r4 + 1] + lw.z * w2c[4 * r4 + 2] + lw.w * w2c[4 * r4 + 3]; }
      const float l2 = (fminf(gkk, 0.f) * LOG2E - lg2(1.f + ex2(-fabsf(gkk) * LOG2E))) * (1.f / 16.f);
      Gb[(size_t)(r0 + rr) * 512 + tid] = f2bf(l2);
    }
    {
      const int c = tid >> 2, tq = (tid & 3) * 8;
      unsigned v[8];
#pragma unroll
      for (int i = 0; i < 8; ++i) v[i] = sT[(tq + i) * 136 + c];
      const int bl = r0 >> 12, t0 = (r0 & (SEQ - 1)) + tq;
      *(u32x4*)(VT + ((size_t)((bl * 2 + (c >> 6)) * 64 + (c & 63))) * SEQ + t0) = (u32x4){v[0] | (v[1] << 16), v[2] | (v[3] << 16), v[4] | (v[5] << 16), v[6] | (v[7] << 16)};
    }
  }
  lds_barrier();
}

DEV void phase_mix(const ParamsG& p, int l, int hf, int slot, int mode, int att_lo, int att_hi, int vid_lo, int vid_hi, unsigned char* smem) {
  unsigned* ctr = (unsigned*)(p.ws + OFF_CTRL) + CTR_WORD0 + slot * 16;
  volatile int* sItem = (volatile int*)(smem + LDS_BYTES - 16);
  const int n_scan = 64 * NSEG;
  int hi = n_scan + (att_hi - att_lo); if (vid_hi < hi) hi = vid_hi;
  for (;;) {
    lds_barrier();
    if (threadIdx.x == 0) *sItem = vid_lo + (int)atomicAdd(ctr, 1u);
    lds_barrier();
    const int vid = *sItem;
    if (vid >= hi) break;
    if (vid < n_scan) {
      const int seg = vid >> 6, it = vid & 63;
      if (mode == 1 && seg == NSEG - 1) continue;
#if PROBE_REP > 0
      if (slot >= 40 && PROBE_TYPE >= 0 && ((it < 16) ? 0 : (it < 32) ? 1 : 2) != PROBE_TYPE) continue;
#endif
      if (it < 16) { if (PH_MASK & 0x100) hgrn_item(p, l, it, seg, mode, smem); }
      else if (it < 32) { if (PH_MASK & 0x200) gla_item(p, l, it, seg, mode, smem); }
      else { if (PH_MASK & 0x400) ssd_item(p, l, it, seg, mode, smem); }
    } else { if (PH_MASK & 0x800) attn_item(p, l, att_lo + (vid - n_scan), smem); }
  }
}

DEV void phase_scan2(const ParamsG& p) {
  const size_t gtid = (size_t)blockIdx.x * NT + threadIdx.x, gsz = (size_t)gridDim.x * NT;
  const float* DB = (const float*)(p.ws + OFF_DB);
  for (size_t e = gtid; e < 655360; e += gsz) {
    float* buf; const float* dp; int stride;
    if (e < 262144) { const int it = (int)(e >> 14), idx = (int)(e & 16383); buf = (float*)(p.ws + OFF_SB0) + (size_t)it * NSEG * 16384 + idx; stride = 16384; dp = DB + (size_t)it * NSEG * 128 + (idx >> 7); }
    else if (e < 393216) { const int e2 = (int)(e - 262144), j = e2 >> 13, idx = e2 & 8191; buf = (float*)(p.ws + OFF_SB1) + (size_t)j * NSEG * 8192 + idx; stride = 8192; dp = DB + (size_t)(16 + j) * NSEG * 128 + (idx >> 7); }
    else { const int e3 = (int)(e - 393216), j = e3 >> 13, idx = e3 & 8191; buf = (float*)(p.ws + OFF_SB2) + (size_t)j * NSEG * 8192 + idx; stride = 8192; dp = DB + (size_t)(32 + j) * NSEG * 128 + (idx >> 6); }
    float u[NSEG - 1], d[NSEG - 1];
#pragma unroll
    for (int sg = 0; sg < NSEG - 1; ++sg) { u[sg] = buf[(size_t)sg * stride]; d[sg] = dp[sg * 128]; }
    float st = 0.f;
#pragma unroll
    for (int sg = 0; sg < NSEG; ++sg) { buf[(size_t)sg * stride] = st; if (sg < NSEG - 1) st = d[sg] * st + u[sg]; }
  }
}

DEV float bfe(const u32x4& v, int j) { return (j & 1) ? hi16(v[j >> 1]) : lo16(v[j >> 1]); }
DEV void phase_fin(const ParamsG& p, int l, int hf) {
  const int tid = launder(threadIdx.x), lane = tid & 63, w = tid >> 6;
  const bf16_t* Hh = (const bf16_t*)(p.ws + OFF_H);
  const bf16_t* OB = (const bf16_t*)(p.ws + OFF_OBUF);
  bf16_t* MX = (bf16_t*)(p.ws + OFF_MIXED);
  const int c0 = lane * 8;
  const float* cw = (const float*)(p.conv_w + (size_t)l * 5 * 1024); const float* cb = (const float*)(p.conv_b + (size_t)l * 1024);
  for (int r0 = (blockIdx.x * 8 + w) * 4; r0 < TH; r0 += gridDim.x * 32) {
    {
      u32x4 at[4], a[4], b[4], z[4];
#pragma unroll
      for (int i = 0; i < 4; ++i) {
        const bf16_t* hrow = Hh + (size_t)(r0 + i) * NPAD;
        at[i] = *(const u32x4*)(hrow + A_Q + c0);
        a[i] = *(const u32x4*)(OB + ((size_t)0 * TH + r0 + i) * 512 + c0); b[i] = *(const u32x4*)(OB + ((size_t)1 * TH + r0 + i) * 512 + c0);
        z[i] = *(const u32x4*)(hrow + H_Z + c0);
      }
      float gn[8];
#pragma unroll
      for (int j = 0; j < 8; ++j) gn[j] = p.hgrn_norm[l * 512 + c0 + j];
#pragma unroll
      for (int i = 0; i < 4; ++i) {
        *(u32x4*)(MX + (size_t)(r0 + i) * DI + c0) = at[i];
        float o[8]; float ss = 0.f;
#pragma unroll
        for (int j = 0; j < 8; ++j) { o[j] = bfe(a[i], j) + bfe(b[i], j); ss += o[j] * o[j]; }
#pragma unroll
        for (int of = 32; of >= 1; of >>= 1) ss += __shfl_xor(ss, of);
        const float rstd = rsqrtf(ss * (1.f / 512.f) + 1e-6f);
        float y[8];
#pragma unroll
        for (int j = 0; j < 8; ++j) { const float zz = bfe(z[i], j); y[j] = o[j] * rstd * gn[j] * (zz * frcp(1.f + ex2(fminf(-zz * LOG2E, 80.f)))); }
        *(u32x4*)(MX + (size_t)(r0 + i) * DI + 512 + c0) = (u32x4){pk2(y[0], y[1]), pk2(y[2], y[3]), pk2(y[4], y[5]), pk2(y[6], y[7])};
      }
    }
    {
      u32x4 a[4], b[4], z[4];
#pragma unroll
      for (int i = 0; i < 4; ++i) {
        a[i] = *(const u32x4*)(OB + ((size_t)4 * TH + r0 + i) * 512 + c0); b[i] = *(const u32x4*)(OB + ((size_t)5 * TH + r0 + i) * 512 + c0);
        z[i] = *(const u32x4*)(Hh + (size_t)(r0 + i) * NPAD + G_Z + c0);
      }
      float gn[8];
#pragma unroll
      for (int j = 0; j < 8; ++j) gn[j] = p.gla_norm[l * 128 + ((c0 + j) & 127)];
#pragma unroll
      for (int i = 0; i < 4; ++i) {
        float o[8]; float ss = 0.f;
#pragma unroll
        for (int j = 0; j < 8; ++j) { o[j] = bfe(a[i], j) + bfe(b[i], j); ss += o[j] * o[j]; }
#pragma unroll
        for (int of = 8; of >= 1; of >>= 1) ss += __shfl_xor(ss, of);
        const float rstd = rsqrtf(ss * (1.f / 128.f) + 1e-6f);
        float y[8];
#pragma unroll
        for (int j = 0; j < 8; ++j) { const float zz = bfe(z[i], j); y[j] = o[j] * rstd * gn[j] * (zz * frcp(1.f + ex2(fminf(-zz * LOG2E, 80.f)))); }
        *(u32x4*)(MX + (size_t)(r0 + i) * DI + 1536 + c0) = (u32x4){pk2(y[0], y[1]), pk2(y[2], y[3]), pk2(y[4], y[5]), pk2(y[6], y[7])};
      }
    }
    {
      u32x4 a[4], b[4], z[4], xr[8];
      const int t0 = r0 & (SEQ - 1);
#pragma unroll
      for (int i = 0; i < 4; ++i) {
        a[i] = *(const u32x4*)(OB + ((size_t)2 * TH + r0 + i) * 512 + c0); b[i] = *(const u32x4*)(OB + ((size_t)3 * TH + r0 + i) * 512 + c0);
        z[i] = *(const u32x4*)(Hh + (size_t)(r0 + i) * NPAD + S_Z + c0);
      }
#pragma unroll
      for (int m = 0; m < 8; ++m) {
        const int sq = t0 + m - 2;
        xr[m] = (u32x4){0u, 0u, 0u, 0u};
        if (sq >= 0 && sq < SEQ) xr[m] = *(const u32x4*)(Hh + (size_t)(r0 + m - 2) * NPAD + S_X + c0);
      }
      float gn[8], cbv[8];
#pragma unroll
      for (int j = 0; j < 8; ++j) { gn[j] = p.ssd_norm[l * 512 + c0 + j]; cbv[j] = cb[c0 + j]; }
      const float dsk = p.ssd_d[l * 8 + (c0 >> 6)];
#pragma unroll
      for (int i = 0; i < 4; ++i) {
        float u[8];
#pragma unroll
        for (int j = 0; j < 8; ++j) u[j] = cbv[j];
#pragma unroll
        for (int jj = 0; jj < 5; ++jj)
#pragma unroll
          for (int j = 0; j < 8; ++j) u[j] += cw[jj * 1024 + c0 + j] * bfe(xr[i + jj], j);
        float y[8]; float ss = 0.f;
#pragma unroll
        for (int j = 0; j < 8; ++j) {
          const float zz = bfe(z[i], j);
          const float xs = u[j] * frcp(1.f + ex2(fminf(-u[j] * LOG2E, 80.f)));
          y[j] = (bfe(a[i], j) + bfe(b[i], j) + dsk * xs) * (zz * frcp(1.f + ex2(fminf(-zz * LOG2E, 80.f))));
          ss += y[j] * y[j];
        }
#pragma unroll
        for (int of = 32; of >= 1; of >>= 1) ss += __shfl_xor(ss, of);
        const float rstd = rsqrtf(ss * (1.f / 512.f) + 1e-6f);
#pragma unroll
        for (int j = 0; j < 8; ++j) y[j] = y[j] * rstd * gn[j];
        *(u32x4*)(MX + (size_t)(r0 + i) * DI + 1024 + c0) = (u32x4){pk2(y[0], y[1]), pk2(y[2], y[3]), pk2(y[4], y[5]), pk2(y[6], y[7])};
      }
    }
  }
}

#define XB_TMO      128
#define XB_XCNT(j)  (256  + 64 * (j))
#define XB_XSUB(j)  (1280 + 64 * (j))
#define XB_XGEN(j)  (2304 + 64 * (j))
#define XB_TOP      3328
#define XB_TOPGEN   3392
#define XB_SPIN_CAP (1u << 22)
#define LAS __attribute__((address_space(3)))
DEV unsigned xb_ld(unsigned* p) { return __hip_atomic_load(p, __ATOMIC_RELAXED, __HIP_MEMORY_SCOPE_AGENT); }
DEV unsigned xb_add(unsigned* p, unsigned v) { return __hip_atomic_fetch_add(p, v, __ATOMIC_RELAXED, __HIP_MEMORY_SCOPE_AGENT); }
DEV unsigned xb_xcc_id() { return (unsigned)__builtin_amdgcn_s_getreg((3 << 11) | 20) & 0xFu; }
#define XB_SPIN(cond, bar) do { unsigned _sp = 0; while (cond) { __builtin_amdgcn_s_sleep(1); \
    if ((++_sp & 255u) == 0u) { if (xb_ld(&(bar)[XB_TMO])) break; if (_sp > XB_SPIN_CAP) { atomicAdd(&(bar)[XB_TMO], 1u); break; } } } } while (0)
struct XcdBarrier { unsigned* bar; unsigned x; volatile LAS unsigned* st; };
DEV XcdBarrier xcd_barrier_post(unsigned* bar, volatile LAS unsigned* st) {
  XcdBarrier b; b.bar = bar; b.x = xb_xcc_id(); b.st = st;
  if (threadIdx.x == 0) (void)xb_add(&bar[XB_XCNT(b.x)], 1u);
  return b;
}
DEV void xcd_barrier_complete(unsigned* bar, unsigned x, unsigned& nloc, unsigned& nx) {
  const unsigned G = gridDim.x * gridDim.y * gridDim.z;
  unsigned sum, cnt, mine, sp = 0u;
  for (;;) {
    sum = 0u; cnt = 0u; mine = 0u;
#pragma unroll
    for (unsigned j = 0; j < 16; ++j) { const unsigned c = xb_ld(&bar[XB_XCNT(j)]); sum += c; cnt += (c > 0u) ? 1u : 0u; mine = (j == x) ? c : mine; }
    if (sum == G) break;
    __builtin_amdgcn_s_sleep(1);
    if ((++sp & 255u) == 0u) { if (xb_ld(&bar[XB_TMO])) break; if (sp > XB_SPIN_CAP) { atomicAdd(&bar[XB_TMO], 1u); break; } }
  }
  nloc = mine > 0u ? mine : 1u; nx = cnt > 0u ? cnt : 1u;
}
DEV void xcd_barrier(const XcdBarrier& b) {
  asm volatile("s_waitcnt vmcnt(0)" ::: "memory");
  __syncthreads();
  if (threadIdx.x == 0) {
    unsigned* bar = b.bar;
    __builtin_amdgcn_s_waitcnt(0);
    unsigned nloc = b.st[0], nx = b.st[1];
    if (nloc == 0u) { xcd_barrier_complete(bar, b.x, nloc, nx); b.st[0] = nloc; b.st[1] = nx; }
    const unsigned old = xb_add(&bar[XB_XSUB(b.x)], 1u);
    const unsigned gen = old / nloc;
    if (old + 1u == (gen + 1u) * nloc) {
      __builtin_amdgcn_fence(__ATOMIC_RELEASE, "agent");
      asm volatile("s_waitcnt vmcnt(0)" ::: "memory");
      const unsigned og = xb_add(&bar[XB_TOP], 1u);
      const unsigned tg = og / nx;
      if (og + 1u == (tg + 1u) * nx) xb_add(&bar[XB_TOPGEN], 1u);
      else XB_SPIN(xb_ld(&bar[XB_TOPGEN]) == tg, bar);
      __builtin_amdgcn_fence(__ATOMIC_ACQUIRE, "agent");
      xb_add(&bar[XB_XGEN(b.x)], 1u);
      asm volatile("s_waitcnt vmcnt(0)" ::: "memory");
    } else {
      XB_SPIN(xb_ld(&bar[XB_XGEN(b.x)]) == gen, bar);
      __builtin_amdgcn_fence(__ATOMIC_ACQUIRE, "agent");
      asm volatile("s_waitcnt vmcnt(0)" ::: "memory");
    }
  }
  __syncthreads();
}

DEV void run_phase(const ParamsG& p, int ph, int rep, unsigned char* smem) {
  if (ph == 0) { if (PH_MASK & 1) { phase_pro(p, smem); convert_weights(p, 0, 3, smem); } return; }
  if (ph == 21) { if (PH_MASK & 16) phase_outproj(p, 1, 1, smem); return; }
  if (ph == 22) { if (PH_MASK & 32) phase_ln(p, 1, 1); return; }
  const int q = ph - 1, blk = q / 5, st = q % 5, l = blk >> 1, hf = blk & 1;
  if (st == 0) {
    if (blk > 0 && (PH_MASK & 16)) phase_outproj(p, (blk - 1) >> 1, (blk - 1) & 1, smem);
    if (PH_MASK & 2) phase_inproj(p, l, hf, blk > 0 ? 16 : 0, smem);
  } else if (st == 1) {
    if (blk > 0 && rep == 0 && (PH_MASK & 32)) phase_ln(p, (blk - 1) >> 1, (blk - 1) & 1);
    if (PH_MASK & 4) phase_prep(p, l, hf, rep, smem);
    if ((PH_MASK & 1) && rep == 0 && blk == 1) convert_weights(p, 1, 1, smem);
    if ((PH_MASK & 1) && rep == 0 && blk == 2) convert_weights(p, 1, 2, smem);
  }
  else if (st == 2) { if (PH_MASK & 0xF00) phase_mix(p, l, hf, ph + 40 * rep, 1, 0, ATT_SPLIT, rep ? PROBE_LO : 0, rep ? PROBE_HI : 100000, smem); }
  else if (st == 3) { if (PH_MASK & 0xF00) phase_mix(p, l, hf, ph + 40 * rep, 3, ATT_SPLIT, 256, rep ? PROBE_LO : 0, rep ? PROBE_HI : 100000, smem); }
  else { if (PH_MASK & 8) phase_fin(p, l, hf); }
}
__global__ void __launch_bounds__(NT) mega(Params p) {
  extern __shared__ __attribute__((aligned(16))) unsigned char smem[];
#if ONE_LAUNCH
  volatile LAS unsigned* xst = (volatile LAS unsigned*)(smem + LDS_BYTES - 32);
  if (threadIdx.x == 0) { xst[0] = 0u; xst[1] = 0u; }
  __syncthreads();
  XcdBarrier xb = xcd_barrier_post((unsigned*)(p.ws + OFF_CTRL), xst);
#endif
  ParamsG* lp = (ParamsG*)(smem + 147456);
  if (threadIdx.x == 0) {
    lp->x = (GAS const float*)p.x; lp->w_in = (GAS const float*)p.w_in; lp->q_gain = (GAS const float*)p.q_gain; lp->k_gain = (GAS const float*)p.k_gain;
    lp->lb_logits = (GAS const float*)p.lb_logits; lp->hgrn_norm = (GAS const float*)p.hgrn_norm; lp->conv_w = (GAS const float*)p.conv_w; lp->conv_b = (GAS const float*)p.conv_b;
    lp->dt_bias = (GAS const float*)p.dt_bias; lp->a_log = (GAS const float*)p.a_log; lp->ssd_d = (GAS const float*)p.ssd_d; lp->ssd_norm = (GAS const float*)p.ssd_norm;
    lp->gk_w2 = (GAS const float*)p.gk_w2; lp->gk_b = (GAS const float*)p.gk_b; lp->gla_norm = (GAS const float*)p.gla_norm; lp->w_out = (GAS const float*)p.w_out;
    lp->ln_g = (GAS const float*)p.ln_g; lp->ln_b = (GAS const float*)p.ln_b; lp->out = (GAS float*)p.out; lp->ws = (GAS unsigned char*)p.ws;
  }
  __syncthreads();
  const int ph_begin = p.phase_begin, ph_end = p.phase_end;
  for (int ph = ph_begin; ph < ph_end; ++ph) {
    int nrep = 0;
#if PROBE_REP > 0
    {
      const int q = ph - 1, st = q % 5;
      const bool idem = (ph >= 1 && ph <= 20) && (st == PROBE_ST) && (st >= 1);
      if (idem) nrep = PROBE_REP;
    }
#endif
    for (int r = 0; r <= nrep; ++r) {
      run_phase(*lp, ph, r, smem);
#if ONE_LAUNCH
      if (r < nrep || ph + 1 < ph_end) xcd_barrier(xb);
#endif
    }
  }
}

extern "C" void kernel_launch(void* const* d_in, const int* in_sizes, int n_in, void* d_out, int out_size, void* d_ws, size_t ws_size,
                              hipStream_t stream) {
  static int grid_blocks = 0;
  if (!grid_blocks) {
    int dev = 0, cus = 0, per_cu = 0;
    hipGetDevice(&dev);
    hipDeviceGetAttribute(&cus, hipDeviceAttributeMultiprocessorCount, dev);
    hipFuncSetAttribute((const void*)mega, hipFuncAttributeMaxDynamicSharedMemorySize, LDS_BYTES);
    hipOccupancyMaxActiveBlocksPerMultiprocessor(&per_cu, mega, NT, LDS_BYTES);
    if (per_cu < 1) per_cu = 1;
    grid_blocks = cus;
  }
  Params p{};
  p.x = (const float*)d_in[0]; p.w_in = (const float*)d_in[1]; p.q_gain = (const float*)d_in[2]; p.k_gain = (const float*)d_in[3];
  p.lb_logits = (const float*)d_in[4]; p.hgrn_norm = (const float*)d_in[5]; p.conv_w = (const float*)d_in[6]; p.conv_b = (const float*)d_in[7];
  p.dt_bias = (const float*)d_in[8]; p.a_log = (const float*)d_in[9]; p.ssd_d = (const float*)d_in[10]; p.ssd_norm = (const float*)d_in[11];
  p.gk_w2 = (const float*)d_in[12]; p.gk_b = (const float*)d_in[13]; p.gla_norm = (const float*)d_in[14]; p.w_out = (const float*)d_in[15];
  p.ln_g = (const float*)d_in[16]; p.ln_b = (const float*)d_in[17];
  p.out = (float*)d_out; p.ws = (unsigned char*)d_ws;
  hipMemsetAsync(d_ws, 0, CTRL_BYTES, stream);
#if ONE_LAUNCH
  p.phase_begin = 0; p.phase_end = NPHASE;
  void* args[] = {&p};
  (void)args;
  hipLaunchKernelGGL(mega, dim3(grid_blocks), dim3(NT), LDS_BYTES, stream, p);
#else
  for (int ph = 0; ph < NPHASE; ++ph) {
    p.phase_begin = ph; p.phase_end = ph + 1;
    hipLaunchKernelGGL(mega, dim3(grid_blocks), dim3(NT), LDS_BYTES, stream, p);
  }
#endif
}
```

```cpp
#include <hip/hip_runtime.h>
#include <hip/hip_cooperative_groups.h>
#include <stdint.h>
#include <stdio.h>
namespace cg = cooperative_groups;

#ifndef ONE_LAUNCH
#define ONE_LAUNCH 1
#endif

#ifndef PH_MASK
#define PH_MASK 0xFFF
#endif
#ifndef PROBE_ST
#define PROBE_ST -1
#endif
#ifndef PROBE_REP
#define PROBE_REP 0
#endif
#ifndef PROBE_PHMAX
#define PROBE_PHMAX 0
#endif
#ifndef PROBE_PHMIN
#define PROBE_PHMIN 0
#endif
#ifndef PROBE_TYPE
#define PROBE_TYPE -1
#endif
#ifndef PROBE_LO
#define PROBE_LO 0
#endif
#ifndef PROBE_HI
#define PROBE_HI 100000
#endif
#define DEV __device__ __forceinline__
typedef unsigned short bf16_t;
typedef short bf16x8 __attribute__((ext_vector_type(8)));
typedef float f32x16 __attribute__((ext_vector_type(16)));
typedef unsigned u32x4 __attribute__((ext_vector_type(4)));
typedef float f32x4 __attribute__((ext_vector_type(4)));

constexpr int NT = 512;
constexpr int T_ALL = 16384, TH = 8192, SEQ = 4096, DM = 1024, NPAD = 7168, DI = 2048, NIN = 6960;
constexpr int A_Q = 0, A_K = 512, A_V = 640, A_Z = 768, H_Q = 1280, H_FF = 1792, H_FB = 2304, H_I = 2816, H_Z = 3328,
              S_X = 3840, S_Z = 4864, G_Q = 5376, G_K = 5632, G_V = 5888, G_Z = 6400, SM0 = 6912;
constexpr size_t OFF_CTRL = 0, OFF_TAB = 65536, OFF_XB = 131072;
constexpr size_t OFF_WIN = OFF_XB + (size_t)T_ALL * DM * 2;
constexpr size_t OFF_WOUT = OFF_WIN + (size_t)NPAD * DM * 2;
constexpr size_t OFF_H = OFF_WOUT + (size_t)DM * DI * 2;
constexpr size_t OFF_SMALL = OFF_H + (size_t)TH * NPAD * 2;
constexpr size_t OFF_OBUF = OFF_SMALL + (size_t)TH * 48 * 4;
constexpr size_t OFF_VT = OFF_OBUF + (size_t)6 * TH * 512 * 2;
constexpr size_t OFF_DB = OFF_VT + (size_t)2 * 2 * 64 * SEQ * 2;
constexpr int NSEG = 4, SLEN = 64 / NSEG;
constexpr size_t OFF_MIXED = OFF_DB + (size_t)64 * NSEG * 128 * 4;
constexpr size_t OFF_SB0 = OFF_MIXED, OFF_SB1 = OFF_SB0 + (size_t)16 * NSEG * 16384 * 4, OFF_SB2 = OFF_SB1 + (size_t)16 * NSEG * 8192 * 4;
constexpr size_t OFF_U = OFF_SB2 + (size_t)32 * NSEG * 8192 * 4;
constexpr size_t OFF_G = OFF_U + (size_t)TH * 1024 * 2;
constexpr size_t WS_END = (OFF_G + (size_t)TH * 512 * 2 > OFF_MIXED + (size_t)TH * DI * 2) ? (OFF_G + (size_t)TH * 512 * 2) : (OFF_MIXED + (size_t)TH * DI * 2);
static_assert(OFF_MIXED + (size_t)TH * DI * 2 <= WS_END, "MIXED must fit");
static_assert(WS_END <= 268435456, "workspace");
constexpr size_t CTRL_BYTES = 65536;
constexpr int CTR_WORD0 = 4096;
constexpr int LDS_BYTES = 148480;
constexpr float LOG2E = 1.4426950408889634f;
constexpr float QSCALE = 0.125f * LOG2E;
constexpr float DN_ALPHA = 1.4142135623730951f;
constexpr int NPHASE = 23;
constexpr int ATT_SPLIT = 256;

struct Params {
  const float* x; const float* w_in; const float* q_gain; const float* k_gain; const float* lb_logits; const float* hgrn_norm;
  const float* conv_w; const float* conv_b; const float* dt_bias; const float* a_log; const float* ssd_d; const float* ssd_norm;
  const float* gk_w2; const float* gk_b; const float* gla_norm; const float* w_out; const float* ln_g; const float* ln_b;
  float* out; unsigned char* ws;
  int phase_begin, phase_end;
};
#define GAS __attribute__((address_space(1)))
struct ParamsG {
  GAS const float* x; GAS const float* w_in; GAS const float* q_gain; GAS const float* k_gain; GAS const float* lb_logits; GAS const float* hgrn_norm;
  GAS const float* conv_w; GAS const float* conv_b; GAS const float* dt_bias; GAS const float* a_log; GAS const float* ssd_d; GAS const float* ssd_norm;
  GAS const float* gk_w2; GAS const float* gk_b; GAS const float* gla_norm; GAS const float* w_out; GAS const float* ln_g; GAS const float* ln_b;
  GAS float* out; GAS unsigned char* ws;
};

DEV void lds_barrier() { asm volatile("s_waitcnt lgkmcnt(0)" ::: "memory"); __builtin_amdgcn_s_barrier(); asm volatile("" ::: "memory"); }
DEV int launder(int v) { asm volatile("" : "+v"(v)); return v; }
DEV float bf2f(bf16_t v) { return __uint_as_float(((unsigned)v) << 16); }
DEV bf16_t f2bf(float f) { unsigned u = __float_as_uint(f); u += 0x7fffu + ((u >> 16) & 1u); return (bf16_t)(u >> 16); }
typedef __bf16 bf16x2_t __attribute__((ext_vector_type(2)));
typedef float f32x2_t __attribute__((ext_vector_type(2)));
DEV unsigned pk2(float lo, float hi) { const f32x2_t f = {lo, hi}; const bf16x2_t b = __builtin_convertvector(f, bf16x2_t); return __builtin_bit_cast(unsigned, b); }
DEV float fsigmoid(float x) { return 1.f / (1.f + __expf(-x)); }
DEV float fsilu(float x) { return x / (1.f + __expf(-x)); }
DEV unsigned cvtpk(float lo, float hi) { return pk2(lo, hi); }
DEV float ex2(float x) { return __builtin_amdgcn_exp2f(x); }
DEV float lg2(float x) { return __builtin_amdgcn_logf(x); }
DEV float frcp(float x) { return __builtin_amdgcn_rcpf(x); }
DEV float lo16(unsigned u) { return __uint_as_float(u << 16); }
DEV float hi16(unsigned u) { return __uint_as_float(u & 0xffff0000u); }
DEV int rowoff(int reg, int h) { return (reg & 3) + 8 * (reg >> 2) + 4 * h; }
DEV f32x16 zero16() { f32x16 z;
#pragma unroll
  for (int i = 0; i < 16; ++i) z[i] = 0.f; return z; }

template <int KD>
DEV void mma32(f32x16& acc, const bf16_t* a, int lda, const bf16_t* b, int ldb, int lane) {
  const int r = lane & 31, h = lane >> 5;
  const bf16_t* ap = a + r * lda + 8 * h;
  const bf16_t* bp = b + r * ldb + 8 * h;
#pragma unroll 4
  for (int k = 0; k < KD; k += 16) {
    bf16x8 av = *(const bf16x8*)(ap + k);
    bf16x8 bv = *(const bf16x8*)(bp + k);
    acc = __builtin_amdgcn_mfma_f32_32x32x16_bf16(av, bv, acc, 0, 0, 0);
  }
}

DEV int orig_col(int n) {
  if (n < 4864) return n;
  if (n < 6400) return n + 16;
  if (n < 6912) return n + 48;
  if (n < 6928) return n - 2048;
  if (n < 6960) return n - 512;
  return -1;
}

DEV void convert_weights(const ParamsG& p, int l, int which, unsigned char* smem) {
  float* s = (float*)smem;
  const int tid = launder(threadIdx.x);
  const float* win = (const float*)(p.w_in + (size_t)l * DM * NIN);
  const float* wout = (const float*)(p.w_out + (size_t)l * DI * DM);
  bf16_t* wint = (bf16_t*)(p.ws + OFF_WIN);
  bf16_t* woutt = (bf16_t*)(p.ws + OFF_WOUT);
  const int n_in_tiles = (NPAD / 64) * (DM / 64);
  const int n_out_tiles = (DM / 64) * (DI / 64);
  const int it_lo = (which & 1) ? 0 : n_in_tiles, it_hi = (which & 2) ? (n_in_tiles + n_out_tiles) : n_in_tiles;
  for (int it = it_lo + blockIdx.x; it < it_hi; it += gridDim.x) {
    lds_barrier();
    if (it < n_in_tiles) {
      const int n0 = (it / 16) * 64, k0 = (it % 16) * 64;
#pragma unroll
      for (int e = 0; e < 8; ++e) {
        const int idx = e * NT + tid, kk = idx >> 6, nn = idx & 63;
        const int oc = orig_col(n0 + nn);
        s[kk * 65 + nn] = (oc >= 0) ? win[(size_t)(k0 + kk) * NIN + oc] : 0.f;
      }
      lds_barrier();
      const int n = tid >> 3, kc = (tid & 7) * 8;
      uint4 o;
      o.x = pk2(s[(kc + 0) * 65 + n], s[(kc + 1) * 65 + n]); o.y = pk2(s[(kc + 2) * 65 + n], s[(kc + 3) * 65 + n]);
      o.z = pk2(s[(kc + 4) * 65 + n], s[(kc + 5) * 65 + n]); o.w = pk2(s[(kc + 6) * 65 + n], s[(kc + 7) * 65 + n]);
      *(uint4*)(wint + (size_t)(n0 + n) * DM + k0 + kc) = o;
    } else {
      const int j = it - n_in_tiles;
      const int n0 = (j / 32) * 64, k0 = (j % 32) * 64;
#pragma unroll
      for (int e = 0; e < 8; ++e) {
        const int idx = e * NT + tid, kk = idx >> 6, nn = idx & 63;
        s[kk * 65 + nn] = wout[(size_t)(k0 + kk) * DM + n0 + nn];
      }
      lds_barrier();
      const int n = tid >> 3, kc = (tid & 7) * 8;
      uint4 o;
      o.x = pk2(s[(kc + 0) * 65 + n], s[(kc + 1) * 65 + n]); o.y = pk2(s[(kc + 2) * 65 + n], s[(kc + 3) * 65 + n]);
      o.z = pk2(s[(kc + 4) * 65 + n], s[(kc + 5) * 65 + n]); o.w = pk2(s[(kc + 6) * 65 + n], s[(kc + 7) * 65 + n]);
      *(uint4*)(woutt + (size_t)(n0 + n) * DI + k0 + kc) = o;
    }
  }
  lds_barrier();
}

DEV void fsincos(float x, float& s, float& c) {
  const float k = rintf(x * 0.63661977236758134308f);
  float r = fmaf(-k, 1.5707855225e+00f, x);
  r = fmaf(-k, 1.0804273188e-05f, r);
  r = fmaf(-k, 6.0770999344e-11f, r);
  const float r2 = r * r;
  float ps = fmaf(r2, 2.7557319224e-06f, -1.9841269841e-04f);
  ps = fmaf(ps, r2, 8.3333333333e-03f); ps = fmaf(ps, r2, -1.6666666667e-01f);
  const float sinr = fmaf(ps * r2, r, r);
  float pc = fmaf(r2, -2.7557319224e-07f, 2.4801587302e-05f);
  pc = fmaf(pc, r2, -1.3888888889e-03f); pc = fmaf(pc, r2, 4.1666666667e-02f); pc = fmaf(pc, r2, -0.5f);
  const float cosr = fmaf(pc, r2, 1.0f);
  const int q = ((int)k) & 3;
  if (q == 0) { s = sinr; c = cosr; }
  else if (q == 1) { s = cosr; c = -sinr; }
  else if (q == 2) { s = -sinr; c = -cosr; }
  else { s = -cosr; c = sinr; }
}

DEV void phase_pro(const ParamsG& p, unsigned char* smem) {
  const int tid = launder(threadIdx.x);
  const size_t gtid = (size_t)blockIdx.x * NT + tid, gsz = (size_t)gridDim.x * NT;
  const float4* x4 = (const float4*)p.x;
  uint4* xb4 = (uint4*)(p.ws + OFF_XB);
  for (size_t i = gtid; i < (size_t)T_ALL * DM / 8; i += gsz) {
    const float4 a = x4[2 * i], b = x4[2 * i + 1];
    uint4 o; o.x = pk2(a.x, a.y); o.y = pk2(a.z, a.w); o.z = pk2(b.x, b.y); o.w = pk2(b.z, b.w);
    xb4[i] = o;
  }
  if (blockIdx.x == 0) {
    float2* tab = (float2*)(p.ws + OFF_TAB);
    for (int i = tid; i < 64 * 16; i += NT) {
      const int pos = i >> 4, fi = i & 15;
      const float invf = exp2f(-(float)fi * (13.287712379549449f / 16.0f));
      const float ang = (float)pos * invf;
      float sn, cs; fsincos(ang, sn, cs);
      tab[i] = make_float2(cs, sn);
    }
  }
}

namespace pg8 {
#define PG8_LAS __attribute__((address_space(3)))
typedef unsigned short bf16_t;
typedef short bf16x8 __attribute__((ext_vector_type(8)));
typedef float f32x4 __attribute__((ext_vector_type(4)));
typedef unsigned u32x4 __attribute__((ext_vector_type(4)));
constexpr int BM = 256, BK = 64, HALF = 128, HTB = HALF * BK * 2  , STAGE_BYTES = 8 * HTB, NXCD = 8, WGM = 8;

__host__ __device__ __forceinline__ int lds_byte(int r, int c) { const int st = (r >> 4) * 2 + (c >> 5), rr = r & 15, cc = c & 31, ob = rr * 64 + cc * 2; return st * 1024 + (ob ^ (((ob >> 9) & 1) << 5)); }
__host__ __device__ __forceinline__ void stage_rc(int b, int& R, int& C) { const int st = b / 1024, sb = b % 1024, swz = sb ^ (((sb >> 9) & 1) << 5); R = (st >> 1) * 16 + swz / 64; C = (st & 1) * 32 + (swz % 64) / 2; }
__host__ __device__ __forceinline__ int perm32(int rho) { const int n = rho >> 4, i = rho & 15; return 8 * (i >> 2) + 4 * n + (i & 3); }

struct Unit { int pm, pn; };
struct Gemm { const bf16_t* A; const bf16_t* Bt; int M, N, K; };

__device__ __forceinline__ unsigned cvt_pk_bf16(float lo, float hi) { unsigned r; asm volatile("v_cvt_pk_bf16_f32 %0, %1, %2" : "=v"(r) : "v"(lo), "v"(hi)); return r; }

struct XcdOrder {
    int rpx, nN, x, c, ncu, skew;
    __device__ void init(int M, int N, int skew_ = 0) { rpx = (M / BM) / NXCD; nN = N / BM; x = blockIdx.x & 7; c = blockIdx.x >> 3; ncu = gridDim.x >> 3; skew = skew_; }
    __device__ bool next(int i, Unit& u) const {
        const int total = rpx * nN, full = (total / ncu) * ncu;
        int j = c + i * ncu;
        if (skew > 0 && j >= full) { const int cc = c - skew; j = (cc >= 0 && i == total / ncu) ? full + cc : total; }
        if (j >= total) return false; u.pm = rpx * x + (j % rpx); u.pn = j / rpx; return true; }
    __device__ __forceinline__ void a_ready(const Unit&) const {}
    __device__ __forceinline__ void done(const Unit&) const {}
};
struct EpiIn {
    static constexpr bool PERM = true, AFTER_DRAIN = false;
    bf16_t* O; int ldc; float* small; int small_pn;
    __device__ __forceinline__ void operator()(const f32x4 (&acc)[2][2][4][2], const Unit& u, int wr, int wc, int fr, int fq) const {
        const int row0 = u.pm * BM + wr * 64 + fr, col0 = u.pn * BM + wc * 32 + 8 * fq;
        if (u.pn == small_pn) {
            const int c = wc * 32 + 8 * fq;
            if (c < 48) {
#pragma unroll
                for (int ai = 0; ai < 2; ++ai)
#pragma unroll
                    for (int m = 0; m < 4; ++m) { float* rp = small + (size_t)(row0 + ai * HALF + m * 16) * 48 + c; *(f32x4*)rp = acc[ai][0][m][0]; *(f32x4*)(rp + 4) = acc[ai][0][m][1]; }
            }
            return;
        }
        const int act = (u.pn == 5 || u.pn == 6) ? 1 : ((u.pn == 21) ? 2 : 0);
#pragma unroll
        for (int ai = 0; ai < 2; ++ai)
#pragma unroll
            for (int m = 0; m < 4; ++m) { bf16_t* rowp = O + (size_t)(row0 + ai * HALF + m * 16) * ldc + col0;
#pragma unroll
                for (int bj = 0; bj < 2; ++bj) { f32x4 v0 = acc[ai][bj][m][0], v1 = acc[ai][bj][m][1];
                    if (act == 1) {
#pragma unroll
                        for (int e = 0; e < 4; ++e) {
                            v0[e] = v0[e] * __builtin_amdgcn_rcpf(1.f + __builtin_amdgcn_exp2f(fminf(-v0[e] * 1.4426950408889634f, 80.f))) * 0.08838834764831845f;
                            v1[e] = v1[e] * __builtin_amdgcn_rcpf(1.f + __builtin_amdgcn_exp2f(fminf(-v1[e] * 1.4426950408889634f, 80.f))) * 0.08838834764831845f; }
                    } else if (act == 2) { v0 = v0 * 0.125f; v1 = v1 * 0.125f; }
                    u32x4 w; w.x = cvt_pk_bf16(v0[0], v0[1]); w.y = cvt_pk_bf16(v0[2], v0[3]); w.z = cvt_pk_bf16(v1[0], v1[1]); w.w = cvt_pk_bf16(v1[2], v1[3]);
                    *(u32x4*)(rowp + bj * HALF) = w; } }
    }
};
struct EpiOut {
    static constexpr bool PERM = true, AFTER_DRAIN = false;
    const float* X; float* Y; int ldc; float alpha;
    __device__ __forceinline__ void operator()(const f32x4 (&acc)[2][2][4][2], const Unit& u, int wr, int wc, int fr, int fq) const {
        const int row0 = u.pm * BM + wr * 64 + fr, col0 = u.pn * BM + wc * 32 + 8 * fq;
#pragma unroll
        for (int ai = 0; ai < 2; ++ai)
#pragma unroll
            for (int m = 0; m < 4; ++m) { const size_t off = (size_t)(row0 + ai * HALF + m * 16) * ldc + col0;
#pragma unroll
                for (int bj = 0; bj < 2; ++bj) { const f32x4 x0 = *(const f32x4*)(X + off + bj * HALF), x1 = *(const f32x4*)(X + off + bj * HALF + 4);
                    *(f32x4*)(Y + off + bj * HALF) = x0 * alpha + acc[ai][bj][m][0]; *(f32x4*)(Y + off + bj * HALF + 4) = x1 * alpha + acc[ai][bj][m][1]; } }
    }
};

template <class Epi, class Sched, bool ALIGN_EPI = false, bool SP2 = false>
__device__ __forceinline__ void gemm_phase(PG8_LAS unsigned char* lds, const Gemm g, const Sched& S, const Epi& E) {
    const int tid = launder((int)threadIdx.x), wid = __builtin_amdgcn_readfirstlane(tid >> 6), lane = tid & 63, wr = wid >> 2, wc = wid & 3, fr = lane & 15, fq = lane >> 4;
    const int K = g.K, nt = K / BK;
    unsigned voffA[2], voffB[2];
#pragma unroll
    for (int i = 0; i < 2; ++i) { int R, C; stage_rc(tid * 16 + i * 8192, R, C); const int Rb = Epi::PERM ? ((R & ~31) + perm32(R & 31)) : R;
        voffA[i] = (unsigned)(R * K + C) * 2u; voffB[i] = (unsigned)(Rb * K + C) * 2u; }
    const size_t kstep = (size_t)(BK * 2);
    const size_t hstep = (size_t)HALF * K * 2;
    const size_t tstep = 2 * hstep;
    const unsigned ldsw = (unsigned)wid * 1024u;
    const int aoff = lds_byte(wr * 64 + fr, fq * 8), boff = lds_byte(wc * 32 + fr, fq * 8);
#define PG8_SA(b, h) (((b) * 2 + (h)) * HTB)
#define PG8_SB(b, h) ((4 + (b) * 2 + (h)) * HTB)
#define PG8_STAGE(bufoff, gbase, voff) do { _Pragma("unroll") for (int _i = 0; _i < 2; ++_i) \
        __builtin_amdgcn_global_load_lds((const unsigned*)((const char*)(gbase) + (voff)[_i]), (PG8_LAS unsigned*)(lds + (bufoff) + ldsw + _i * 8192), 16, 0, 0); } while (0)
#define PG8_LDA(dst, b, h) do { _Pragma("unroll") for (int m = 0; m < 4; ++m) _Pragma("unroll") for (int k = 0; k < 2; ++k) dst[m][k] = *(const PG8_LAS bf16x8*)(lds + PG8_SA(b, h) + aoff + m * 2048 + k * 1024); } while (0)
#define PG8_LDB(dst, b, h) do { _Pragma("unroll") for (int n = 0; n < 2; ++n) _Pragma("unroll") for (int k = 0; k < 2; ++k) dst[n][k] = *(const PG8_LAS bf16x8*)(lds + PG8_SB(b, h) + boff + n * 2048 + k * 1024); } while (0)
#define PG8_MMA(ai, bj, At, Bt) do { __builtin_amdgcn_s_setprio(1); _Pragma("unroll") for (int m = 0; m < 4; ++m) _Pragma("unroll") for (int n = 0; n < 2; ++n) _Pragma("unroll") for (int k = 0; k < 2; ++k) \
        acc[ai][bj][m][n] = __builtin_amdgcn_mfma_f32_16x16x32_bf16(Bt[n][k], At[m][k], acc[ai][bj][m][n], 0, 0, 0); __builtin_amdgcn_s_setprio(0); } while (0)
#define PG8_WAIT_V(n) asm volatile("s_waitcnt vmcnt(" #n ")" ::: "memory")
#define PG8_WAIT_L(n) asm volatile("s_waitcnt lgkmcnt(" #n ")" ::: "memory")
#define PG8_BAR __builtin_amdgcn_s_barrier()
#define PG8_SCHED __builtin_amdgcn_sched_barrier(0)
    Unit cur, nxt; int ui = 0;
    if (!S.next(0, cur)) return;
    f32x4 acc[2][2][4][2];
#pragma unroll
    for (int a = 0; a < 2; ++a)
#pragma unroll
        for (int b = 0; b < 2; ++b)
#pragma unroll
            for (int m = 0; m < 4; ++m)
#pragma unroll
                for (int n = 0; n < 2; ++n) acc[a][b][m][n] = (f32x4){0.f, 0.f, 0.f, 0.f};
    bf16x8 At[4][2], B0[2][2], B1[2][2];
    const char* cA = (const char*)g.A + (size_t)cur.pm * tstep; const char* cB = (const char*)g.Bt + (size_t)cur.pn * tstep;
    S.a_ready(cur);
    if constexpr (SP2) {
        PG8_STAGE(PG8_SB(0, 0), cB, voffB); PG8_STAGE(PG8_SB(0, 1), cB + hstep, voffB); PG8_STAGE(PG8_SA(0, 0), cA, voffA); PG8_STAGE(PG8_SA(0, 1), cA + hstep, voffA);
        if (wr == 1) PG8_BAR;
        PG8_WAIT_V(2); PG8_BAR;
        PG8_STAGE(PG8_SB(1, 0), cB + kstep, voffB); PG8_STAGE(PG8_SA(1, 0), cA + kstep, voffA); PG8_STAGE(PG8_SB(1, 1), cB + hstep + kstep, voffB);
        PG8_WAIT_V(6); PG8_BAR;
    } else {
        PG8_STAGE(PG8_SB(0, 0), cB, voffB); PG8_STAGE(PG8_SA(0, 0), cA, voffA); PG8_STAGE(PG8_SB(0, 1), cB + hstep, voffB); PG8_STAGE(PG8_SA(0, 1), cA + hstep, voffA);
        if (wr == 1) PG8_BAR;
        PG8_WAIT_V(4); PG8_BAR;
        PG8_STAGE(PG8_SB(1, 0), cB + kstep, voffB); PG8_STAGE(PG8_SA(1, 0), cA + kstep, voffA); PG8_STAGE(PG8_SB(1, 1), cB + hstep + kstep, voffB);
        PG8_WAIT_V(6); PG8_BAR;
    }
    for (;;) {
        const bool has_next = S.next(ui + 1, nxt);
        const char* nA = has_next ? (const char*)g.A + (size_t)nxt.pm * tstep : cA; const char* nB = has_next ? (const char*)g.Bt + (size_t)nxt.pn * tstep : cB;
        for (int t = 0; t < nt; t += 2) {
            const bool last = (t == nt - 2);
            const char* a1 = cA + (size_t)(t + 1) * kstep;
            const char* a2 = last ? nA : cA + (size_t)(t + 2) * kstep; const char* b2 = last ? nB : cB + (size_t)(t + 2) * kstep;
            const char* a3 = a2 + kstep; const char* b3 = b2 + kstep;
            if (last && has_next) S.a_ready(nxt);
            if constexpr (SP2) {
            PG8_LDB(B0, 0, 0); PG8_LDB(B1, 0, 1); PG8_SCHED; PG8_LDA(At, 0, 0); PG8_STAGE(PG8_SA(1, 1), a1 + hstep, voffA);
            PG8_WAIT_V(8); PG8_WAIT_L(0); PG8_BAR; PG8_MMA(0, 0, At, B0); PG8_MMA(0, 1, At, B1); PG8_BAR; PG8_SCHED;
            PG8_LDA(At, 0, 1); PG8_STAGE(PG8_SB(0, 0), b2, voffB); PG8_STAGE(PG8_SB(0, 1), b2 + hstep, voffB); PG8_STAGE(PG8_SA(0, 0), a2, voffA);
            PG8_WAIT_V(8); PG8_WAIT_L(0); PG8_BAR; PG8_MMA(1, 0, At, B0); PG8_MMA(1, 1, At, B1); PG8_BAR; PG8_SCHED;
            PG8_LDB(B0, 1, 0); PG8_LDB(B1, 1, 1); PG8_SCHED; PG8_LDA(At, 1, 0); PG8_STAGE(PG8_SA(0, 1), a2 + hstep, voffA);
            PG8_WAIT_V(8); PG8_WAIT_L(0); PG8_BAR; PG8_MMA(0, 0, At, B0); PG8_MMA(0, 1, At, B1); PG8_BAR; PG8_SCHED;
            PG8_LDA(At, 1, 1); PG8_STAGE(PG8_SB(1, 0), b3, voffB); PG8_STAGE(PG8_SB(1, 1), b3 + hstep, voffB); PG8_STAGE(PG8_SA(1, 0), a3, voffA);
            PG8_WAIT_V(8); PG8_WAIT_L(0); PG8_BAR; PG8_MMA(1, 0, At, B0); PG8_MMA(1, 1, At, B1); PG8_BAR; PG8_SCHED;
            } else {
            PG8_LDB(B0, 0, 0); PG8_SCHED; PG8_LDA(At, 0, 0); PG8_STAGE(PG8_SA(1, 1), a1 + hstep, voffA);
            PG8_WAIT_L(8); PG8_BAR; PG8_WAIT_L(0); PG8_MMA(0, 0, At, B0); PG8_BAR; PG8_SCHED;
            PG8_LDB(B1, 0, 1); PG8_STAGE(PG8_SB(0, 0), b2, voffB);
            PG8_BAR; PG8_WAIT_L(0); PG8_MMA(0, 1, At, B1); PG8_BAR;
            PG8_LDA(At, 0, 1); PG8_STAGE(PG8_SA(0, 0), a2, voffA);
            PG8_BAR; PG8_WAIT_L(0); PG8_MMA(1, 0, At, B0); PG8_BAR; PG8_SCHED;
            PG8_STAGE(PG8_SB(0, 1), b2 + hstep, voffB);
            PG8_WAIT_V(6); PG8_BAR; PG8_MMA(1, 1, At, B1); PG8_BAR;
            PG8_LDB(B0, 1, 0); PG8_SCHED; PG8_LDA(At, 1, 0); PG8_STAGE(PG8_SA(0, 1), a2 + hstep, voffA);
            PG8_WAIT_L(8); PG8_BAR; PG8_WAIT_L(0); PG8_MMA(0, 0, At, B0); PG8_BAR; PG8_SCHED;
            PG8_LDB(B1, 1, 1); PG8_STAGE(PG8_SB(1, 0), b3, voffB);
            PG8_BAR; PG8_WAIT_L(0); PG8_MMA(0, 1, At, B1); PG8_BAR;
            PG8_LDA(At, 1, 1); PG8_STAGE(PG8_SA(1, 0), a3, voffA);
            PG8_BAR; PG8_WAIT_L(0); PG8_MMA(1, 0, At, B0); PG8_BAR; PG8_SCHED;
            PG8_STAGE(PG8_SB(1, 1), b3 + hstep, voffB);
            PG8_WAIT_V(6); PG8_BAR; PG8_MMA(1, 1, At, B1); PG8_BAR;
            }
        }
        if constexpr (ALIGN_EPI) { if (wr == 0) PG8_BAR; }
        if constexpr (!Epi::AFTER_DRAIN) { E(acc, cur, wr, wc, fr, fq); S.done(cur); }
        if (!has_next) break;
#pragma unroll
        for (int a = 0; a < 2; ++a)
#pragma unroll
            for (int b = 0; b < 2; ++b)
#pragma unroll
                for (int m = 0; m < 4; ++m)
#pragma unroll
                    for (int n = 0; n < 2; ++n) acc[a][b][m][n] = (f32x4){0.f, 0.f, 0.f, 0.f};
        cur = nxt; cA = nA; cB = nB; ++ui;
        if constexpr (ALIGN_EPI) { if (wr == 1) PG8_BAR; }
    }
    PG8_WAIT_V(0);
    if constexpr (!ALIGN_EPI) { if (wr == 0) PG8_BAR; }
    PG8_BAR;
    if constexpr (Epi::AFTER_DRAIN) { E.fused(acc, cur, wr, wc, fr, fq, lds, wid, lane); S.done(cur); }
#undef PG8_SA
#undef PG8_SB
#undef PG8_STAGE
#undef PG8_LDA
#undef PG8_LDB
#undef PG8_MMA
#undef PG8_WAIT_V
#undef PG8_WAIT_L
#undef PG8_BAR
#undef PG8_SCHED
}
}

DEV void phase_inproj(const ParamsG& p, int l, int hf, int skew, unsigned char* smem) {
  pg8::Gemm g{(const bf16_t*)(p.ws + OFF_XB) + (size_t)hf * TH * DM, (const bf16_t*)(p.ws + OFF_WIN), TH, NPAD, DM};
  pg8::XcdOrder S; S.init(TH, NPAD, skew);
  pg8::EpiIn E{(bf16_t*)(p.ws + OFF_H), NPAD, (float*)(p.ws + OFF_SMALL), SM0 / 256};
  pg8::gemm_phase<pg8::EpiIn, pg8::XcdOrder, true, true>((PG8_LAS unsigned char*)smem, g, S, E);
}

DEV void phase_outproj(const ParamsG& p, int l, int hf, unsigned char* smem) {
  pg8::Gemm g{(const bf16_t*)(p.ws + OFF_MIXED), (const bf16_t*)(p.ws + OFF_WOUT), TH, DM, DI};
  pg8::XcdOrder S; S.init(TH, DM);
  const float* xin = (const float*)(((l == 0) ? p.x : (GAS const float*)p.out) + (size_t)hf * TH * DM);
  pg8::EpiOut E{xin, (float*)(p.out + (size_t)hf * TH * DM), DM, DN_ALPHA};
  pg8::gemm_phase<pg8::EpiOut, pg8::XcdOrder, true, true>((PG8_LAS unsigned char*)smem, g, S, E);
}

DEV void phase_ln(const ParamsG& p, int l, int hf) {
  const int tid = launder(threadIdx.x), lane = tid & 63, w = tid >> 6;
  const float* g = (const float*)(p.ln_g + l * DM); const float* b = (const float*)(p.ln_b + l * DM);
  bf16_t* xb = (bf16_t*)(p.ws + OFF_XB);
  for (int r0 = (blockIdx.x * 8 + w) * 4; r0 < TH; r0 += gridDim.x * 32) {
    f32x4 v[4][4];
#pragma unroll
    for (int i = 0; i < 4; ++i)
#pragma unroll
      for (int j = 0; j < 4; ++j) v[i][j] = ((const f32x4*)(p.out + (size_t)(hf * TH + r0 + i) * DM))[j * 64 + lane];
    f32x4 gg[4], bb[4];
#pragma unroll
    for (int j = 0; j < 4; ++j) { gg[j] = ((const f32x4*)g)[j * 64 + lane]; bb[j] = ((const f32x4*)b)[j * 64 + lane]; }
#pragma unroll
    for (int i = 0; i < 4; ++i) {
      const int row = hf * TH + r0 + i;
      float sm = 0.f;
#pragma unroll
      for (int j = 0; j < 4; ++j) sm += (v[i][j][0] + v[i][j][1]) + (v[i][j][2] + v[i][j][3]);
#pragma unroll
      for (int o = 32; o >= 1; o >>= 1) sm += __shfl_xor(sm, o);
      const float mu = sm * (1.f / DM);
      float q = 0.f;
#pragma unroll
      for (int j = 0; j < 4; ++j) { const f32x4 d = v[i][j] - mu; q += (d[0] * d[0] + d[1] * d[1]) + (d[2] * d[2] + d[3] * d[3]); }
#pragma unroll
      for (int o = 32; o >= 1; o >>= 1) q += __shfl_xor(q, o);
      const float rstd = rsqrtf(q * (1.f / DM) + 1e-5f);
#pragma unroll
      for (int j = 0; j < 4; ++j) {
        const f32x4 o = (v[i][j] - mu) * rstd * gg[j] + bb[j];
        ((f32x4*)(p.out + (size_t)row * DM))[j * 64 + lane] = o;
        if (l == 0) *(uint2*)(xb + (size_t)row * DM + (j * 64 + lane) * 4) = make_uint2(pk2(o[0], o[1]), pk2(o[2], o[3]));
      }
    }
  }
}

DEV void attn_item(const ParamsG& p, int l, int item, unsigned char* smem) {
  const int tid = launder(threadIdx.x), lane = tid & 63, w = tid >> 6, r = lane & 31, h = lane >> 5;
  const int qt = item & 15, head = (item >> 4) & 7, bl = item >> 7;
  const int kvh = head >> 2;
  bf16_t* Hh = (bf16_t*)(p.ws + OFF_H);
  const bf16_t* VT = (const bf16_t*)(p.ws + OFF_VT);
  const size_t rowbase = (size_t)bl * SEQ;
  float mq = fabsf(p.q_gain[l * 64 + lane]), mk = fabsf(p.k_gain[l * 64 + lane]);
#pragma unroll
  for (int o = 32; o >= 1; o >>= 1) { mq = fmaxf(mq, __shfl_xor(mq, o)); mk = fmaxf(mk, __shfl_xor(mk, o)); }
  const float M2 = 8.f * mq * mk * LOG2E * 1.01f;
  const int qrow = qt * 256 + w * 32 + r;
  const bf16_t* qp = Hh + (rowbase + qrow) * NPAD + A_Q + head * 64 + 8 * h;
  bf16x8 qf[4];
#pragma unroll
  for (int ks = 0; ks < 4; ++ks) qf[ks] = *(const bf16x8*)(qp + ks * 16);
  f32x16 o0 = zero16(), o1 = zero16();
  f32x2_t lsum2 = {0.f, 0.f};
  const int srow = tid >> 3, sch = (tid & 7) * 8;
  const bf16_t* kp = Hh + (rowbase + srow) * NPAD + A_K + kvh * 64 + sch;
  const bf16_t* vp = VT + ((size_t)((bl * 2 + kvh) * 64 + srow)) * SEQ + sch;
  union PB { bf16x8 v; unsigned u[4]; };
  auto qk = [&](int st, f32x16& s0, f32x16& s1) __attribute__((always_inline)) {
    const bf16_t* sK = (const bf16_t*)(smem + st * 18432);
#pragma unroll
    for (int i = 0; i < 16; ++i) { s0[i] = -M2; s1[i] = -M2; }
#pragma unroll
    for (int ks = 0; ks < 4; ++ks) {
      const bf16x8 a0 = *(const bf16x8*)(sK + r * 72 + ks * 16 + 8 * h);
      const bf16x8 a1 = *(const bf16x8*)(sK + (32 + r) * 72 + ks * 16 + 8 * h);
      s0 = __builtin_amdgcn_mfma_f32_32x32x16_bf16(a0, qf[ks], s0, 0, 0, 0);
      s1 = __builtin_amdgcn_mfma_f32_32x32x16_bf16(a1, qf[ks], s1, 0, 0, 0);
    }
  };
  auto soft = [&](f32x16& s0, f32x16& s1, PB (&pb)[2][2]) __attribute__((always_inline)) {
#pragma unroll
    for (int i = 0; i < 16; ++i) { s0[i] = __builtin_amdgcn_exp2f(s0[i]); s1[i] = __builtin_amdgcn_exp2f(s1[i]); lsum2 += (f32x2_t){s0[i], s1[i]}; }
#pragma unroll
    for (int s = 0; s < 2; ++s)
#pragma unroll
      for (int j = 0; j < 4; ++j) {
        pb[0][s].u[j] = pk2(s0[8 * s + 2 * j], s0[8 * s + 2 * j + 1]);
        pb[1][s].u[j] = pk2(s1[8 * s + 2 * j], s1[8 * s + 2 * j + 1]);
      }
  };
  auto pv = [&](int st, const PB (&pb)[2][2]) __attribute__((always_inline)) {
    const bf16_t* sV = (const bf16_t*)(smem + st * 18432 + 9216);
#pragma unroll
    for (int kt2 = 0; kt2 < 2; ++kt2)
#pragma unroll
      for (int s = 0; s < 2; ++s) {
        const int kb = kt2 * 32 + 16 * s + 4 * h;
        union { bf16x8 v; uint2 u[2]; } a0, a1;
        a0.u[0] = *(const uint2*)(sV + r * 72 + kb); a0.u[1] = *(const uint2*)(sV + r * 72 + kb + 8);
        a1.u[0] = *(const uint2*)(sV + (32 + r) * 72 + kb); a1.u[1] = *(const uint2*)(sV + (32 + r) * 72 + kb + 8);
        o0 = __builtin_amdgcn_mfma_f32_32x32x16_bf16(a0.v, pb[kt2][s].v, o0, 0, 0, 0);
        o1 = __builtin_amdgcn_mfma_f32_32x32x16_bf16(a1.v, pb[kt2][s].v, o1, 0, 0, 0);
      }
  };
  auto compute2 = [&](int sta, int stb) __attribute__((always_inline)) {
    f32x16 sa0, sa1, sb0, sb1; PB pa[2][2], pbb[2][2];
    qk(sta, sa0, sa1); qk(stb, sb0, sb1);
    soft(sa0, sa1, pa); pv(sta, pa);
    soft(sb0, sb1, pbb); pv(stb, pbb);
  };
  constexpr int NKT = SEQ / 64;
  auto sstore = [&](int st, const u32x4& kk, const u32x4& vv) __attribute__((always_inline)) {
    *(u32x4*)(smem + st * 18432 + srow * 144 + sch * 2) = kk;
    *(u32x4*)(smem + st * 18432 + 9216 + srow * 144 + sch * 2) = vv;
  };
  u32x4 k0 = *(const u32x4*)kp, v0 = *(const u32x4*)vp;
  u32x4 k1 = *(const u32x4*)(kp + (size_t)64 * NPAD), v1 = *(const u32x4*)(vp + 64);
  sstore(0, k0, v0); sstore(1, k1, v1);
  k0 = *(const u32x4*)(kp + (size_t)2 * 64 * NPAD); v0 = *(const u32x4*)(vp + 2 * 64);
  k1 = *(const u32x4*)(kp + (size_t)3 * 64 * NPAD); v1 = *(const u32x4*)(vp + 3 * 64);
  lds_barrier();
  for (int kt = 0; kt < NKT; kt += 4) {
    sstore(2, k0, v0); sstore(3, k1, v1);
    if (kt + 4 < NKT) {
      k0 = *(const u32x4*)(kp + (size_t)(kt + 4) * 64 * NPAD); v0 = *(const u32x4*)(vp + (kt + 4) * 64);
      k1 = *(const u32x4*)(kp + (size_t)(kt + 5) * 64 * NPAD); v1 = *(const u32x4*)(vp + (kt + 5) * 64);
    }
    compute2(0, 1);
    lds_barrier();
    if (kt + 4 < NKT) {
      sstore(0, k0, v0); sstore(1, k1, v1);
      if (kt + 6 < NKT) {
        k0 = *(const u32x4*)(kp + (size_t)(kt + 6) * 64 * NPAD); v0 = *(const u32x4*)(vp + (kt + 6) * 64);
        k1 = *(const u32x4*)(kp + (size_t)(kt + 7) * 64 * NPAD); v1 = *(const u32x4*)(vp + (kt + 7) * 64);
      }
    }
    compute2(2, 3);
    lds_barrier();
  }
  float lsum = lsum2[0] + lsum2[1];
  lsum += __shfl_xor(lsum, 32);
  const float inv = 1.f / lsum;
  const bf16_t* zp = Hh + (rowbase + qrow) * NPAD + A_Z + head * 64;
  bf16_t* op = Hh + (rowbase + qrow) * NPAD + A_Q + head * 64;
#pragma unroll
  for (int dt = 0; dt < 2; ++dt)
#pragma unroll
    for (int g = 0; g < 4; ++g) {
      const int d0 = dt * 32 + 8 * g + 4 * h;
      const uint2 zz = *(const uint2*)(zp + d0);
      const float z0 = bf2f((bf16_t)(zz.x & 0xffff)), z1 = bf2f((bf16_t)(zz.x >> 16)), z2 = bf2f((bf16_t)(zz.y & 0xffff)), z3 = bf2f((bf16_t)(zz.y >> 16));
      const f32x16& oo = dt ? o1 : o0;
      uint2 ov;
      ov.x = pk2(oo[4 * g + 0] * inv * fsilu(z0), oo[4 * g + 1] * inv * fsilu(z1));
      ov.y = pk2(oo[4 * g + 2] * inv * fsilu(z2), oo[4 * g + 3] * inv * fsilu(z3));
      *(uint2*)(op + d0) = ov;
    }
  lds_barrier();
}

constexpr int L_QT = 0, L_KT = 17408, L_QC = 34816, L_KHT = 52224, L_VT = 70656, L_ST = 89088,
              L_D = 123904, L_TOT = 124416, L_ACS = 128512, L_DT = 129024;

template <int K, int V> struct ScanGeom {
  static constexpr int KP = K + 8;
  static constexpr int NS = (K / 32) * (V / 32) / 8;
};

template <int K, int V>
DEV void scan_write_state(unsigned char* smem, const f32x16* S, int w, int lane) {
  constexpr int KP = K + 8, NS = ScanGeom<K, V>::NS, NVT = V / 32;
  bf16_t* sST = (bf16_t*)(smem + L_ST);
  const int c = lane & 31, h = lane >> 5;
#pragma unroll
  for (int i = 0; i < NS; ++i) {
    const int tile = w * NS + i, kt = tile / NVT, nt = tile % NVT;
#pragma unroll
    for (int g = 0; g < 4; ++g) {
      uint2 o; o.x = pk2(S[i][4 * g + 0], S[i][4 * g + 1]); o.y = pk2(S[i][4 * g + 2], S[i][4 * g + 3]);
      *(uint2*)(sST + (nt * 32 + c) * KP + kt * 32 + 8 * g + 4 * h) = o;
    }
  }
}

template <int K, int V, bool SSDM>
DEV void scan_core(unsigned char* smem, f32x16* S, bf16_t* orow0, int dir, int w, int lane, bool do_out, const float* sAcs) {
  constexpr int KP = K + 8, NS = ScanGeom<K, V>::NS, NVT = V / 32, NOT = 2 * NVT;
  const bf16_t* sQt = (const bf16_t*)(smem + L_QT); const bf16_t* sKt = (const bf16_t*)(smem + L_KT);
  const bf16_t* sQc = (const bf16_t*)(smem + L_QC); const bf16_t* sKhT = (const bf16_t*)(smem + L_KHT);
  const bf16_t* sVT = (const bf16_t*)(smem + L_VT);
  const bf16_t* sST = (const bf16_t*)(smem + L_ST); const float* sD = (const float*)(smem + L_D);
  const int c = lane & 31, h = lane >> 5;
  if (do_out && w < NOT) {
    const int tt = w / NVT, nt = w % NVT;
    f32x16 acc = zero16();
#pragma unroll
    for (int st = 0; st < 2; ++st) {
      if (st <= tt) {
        f32x16 pt = zero16();
        mma32<K>(pt, sKt + st * 32 * KP, KP, sQt + tt * 32 * KP, KP, lane);
        const int tau = tt * 32 + c;
        const float at = SSDM ? sAcs[tau] : 0.f;
#pragma unroll
        for (int reg = 0; reg < 16; ++reg) {
          const int sig = st * 32 + rowoff(reg, h);
          float v = pt[reg];
          if (SSDM) v *= ex2(at - sAcs[sig]);
          pt[reg] = (sig <= tau) ? v : 0.f;
        }
#pragma unroll
        for (int s2 = 0; s2 < 2; ++s2) {
          union { bf16x8 v; unsigned u[4]; } pa;
#pragma unroll
          for (int j = 0; j < 4; ++j) pa.u[j] = pk2(pt[8 * s2 + 2 * j], pt[8 * s2 + 2 * j + 1]);
          const int kb = st * 32 + 16 * s2 + 4 * h;
          union { bf16x8 v; uint2 u[2]; } vb;
          vb.u[0] = *(const uint2*)(sVT + (nt * 32 + c) * 72 + kb); vb.u[1] = *(const uint2*)(sVT + (nt * 32 + c) * 72 + kb + 8);
          acc = __builtin_amdgcn_mfma_f32_32x32x16_bf16(pa.v, vb.v, acc, 0, 0, 0);
        }
      }
    }
    mma32<K>(acc, sQc + tt * 32 * KP, KP, sST + nt * 32 * KP, KP, lane);
#pragma unroll
    for (int reg = 0; reg < 16; ++reg) {
      const int tau = tt * 32 + rowoff(reg, h);
      const int tok = dir ? (63 - tau) : tau;
      orow0[(size_t)tok * 512 + nt * 32 + c] = f2bf(acc[reg]);
    }
  }
#pragma unroll
  for (int i = 0; i < NS; ++i) {
    const int tile = w * NS + i, kt = tile / NVT, nt = tile % NVT;
#pragma unroll
    for (int reg = 0; reg < 16; ++reg) S[i][reg] *= sD[kt * 32 + rowoff(reg, h)];
    mma32<64>(S[i], sKhT + kt * 32 * 72, 72, sVT + nt * 32 * 72, 72, lane);
  }
}

template <int K, int V>
DEV void state_store(float* buf, const f32x16* S, int w, int lane) {
  constexpr int NS = ScanGeom<K, V>::NS, NVT = V / 32;
  const int c = lane & 31, h = lane >> 5;
#pragma unroll
  for (int i = 0; i < NS; ++i) {
    const int tile = w * NS + i, kt = tile / NVT, nt = tile % NVT;
#pragma unroll
    for (int reg = 0; reg < 16; ++reg) buf[(kt * 32 + rowoff(reg, h)) * V + nt * 32 + c] = S[i][reg];
  }
}
template <int K, int V>
DEV void state_load(const float* buf, f32x16* S, int w, int lane) {
  constexpr int NS = ScanGeom<K, V>::NS, NVT = V / 32;
  const int c = lane & 31, h = lane >> 5;
#pragma unroll
  for (int i = 0; i < NS; ++i) {
    const int tile = w * NS + i, kt = tile / NVT, nt = tile % NVT;
#pragma unroll
    for (int reg = 0; reg < 16; ++reg) S[i][reg] = buf[(kt * 32 + rowoff(reg, h)) * V + nt * 32 + c];
  }
}

template <int K, int V>
DEV void state_combine(const float* ubase, int ustride, const float* dbase, int seg, f32x16* S, int w, int lane) {
  constexpr int NS = ScanGeom<K, V>::NS, NVT = V / 32;
  const int c = lane & 31, h = lane >> 5;
  for (int j = 0; j < seg; ++j) {
    const float* buf = ubase + (size_t)j * ustride;
    const float* dj = dbase + j * 128;
    float u[NS][16]; f32x4 dv[NS][4];
#pragma unroll
    for (int i = 0; i < NS; ++i) {
      const int tile = w * NS + i, kt = tile / NVT, nt = tile % NVT;
#pragma unroll
      for (int g = 0; g < 4; ++g) dv[i][g] = *(const f32x4*)(dj + kt * 32 + 8 * g + 4 * h);
#pragma unroll
      for (int reg = 0; reg < 16; ++reg) u[i][reg] = buf[(kt * 32 + rowoff(reg, h)) * V + nt * 32 + c];
    }
#pragma unroll
    for (int i = 0; i < NS; ++i)
#pragma unroll
      for (int reg = 0; reg < 16; ++reg) S[i][reg] = (j > 0 ? dv[i][reg >> 2][reg & 3] * S[i][reg] : 0.f) + u[i][reg];
  }
}

#define PACK8_LO(v) (u32x4){((v)[0] & 0xffffu) | ((v)[1] << 16), ((v)[2] & 0xffffu) | ((v)[3] << 16), ((v)[4] & 0xffffu) | ((v)[5] << 16), ((v)[6] & 0xffffu) | ((v)[7] << 16)}
#define PACK8_HI(v) (u32x4){((v)[0] >> 16) | ((v)[1] & 0xffff0000u), ((v)[2] >> 16) | ((v)[3] & 0xffff0000u), ((v)[4] >> 16) | ((v)[5] & 0xffff0000u), ((v)[6] >> 16) | ((v)[7] & 0xffff0000u)}
#define CVT8(f) (u32x4){pk2((f)[0], (f)[1]), pk2((f)[2], (f)[3]), pk2((f)[4], (f)[5]), pk2((f)[6], (f)[7])}


DEV void hgrn_item(const ParamsG& p, int l, int it, int seg, int mode, unsigned char* smem) {
  const int bl = it >> 3, head = (it >> 1) & 3, dir = it & 1;
  const bool do_out = (mode == 3);
  constexpr int K = 128, V = 128, KPW = 68;
  const int tid = launder(threadIdx.x), lane = tid & 63, w = tid >> 6;
  const int cp = tid & 63, tg = tid >> 6, ch0 = 2 * cp;
  const bf16_t* Hh = (const bf16_t*)(p.ws + OFF_H);
  bf16_t* OB = (bf16_t*)(p.ws + OFF_OBUF) + (size_t)(0 * 2 + dir) * TH * 512;
  const size_t rowbase = (size_t)bl * SEQ;
  float lb0 = 0.f, lb1 = 0.f;
  if (l > 0) {
    lb0 = fsigmoid(p.lb_logits[512 + head * 128 + ch0] - p.lb_logits[head * 128 + ch0]);
    lb1 = fsigmoid(p.lb_logits[512 + head * 128 + ch0 + 1] - p.lb_logits[head * 128 + ch0 + 1]);
  }
  const float om0 = 1.f - lb0, om1 = 1.f - lb1;
  const int fbase = dir ? H_FB : H_FF;
  unsigned* sQt = (unsigned*)(smem + L_QT); unsigned* sKt = (unsigned*)(smem + L_KT); unsigned* sQc = (unsigned*)(smem + L_QC);
  bf16_t* sKhT = (bf16_t*)(smem + L_KHT); bf16_t* sVT = (bf16_t*)(smem + L_VT);
  float* sD = (float*)(smem + L_D); float* sTot = (float*)(smem + L_TOT);
  f32x16 S[2]; S[0] = zero16(); S[1] = zero16();
  float* sbuf = (float*)(p.ws + OFF_SB0) + ((size_t)it * NSEG + seg) * 16384;
  if (do_out) state_combine<K, V>((const float*)(p.ws + OFF_SB0) + (size_t)it * NSEG * 16384, 16384, (const float*)(p.ws + OFF_DB) + (size_t)it * NSEG * 128, seg, S, w, lane);
  float dlog0 = 0.f, dlog1 = 0.f;
  unsigned pf[8], qq[8], vv[8];
  float g0[8], g1[8], kx0[8], kx1[8];
  auto gloadA = [&](int cidx) __attribute__((always_inline)) {
    const int chunk = dir ? (63 - cidx) : cidx;
#pragma unroll
    for (int i = 0; i < 8; ++i) {
      const int tau = 8 * tg + i;
      const int tok = chunk * 64 + (dir ? (63 - tau) : tau);
      pf[i] = ((const unsigned*)(Hh + (rowbase + tok) * NPAD + head * 128 + fbase))[cp];
    }
  };
  auto gloadB = [&](int cidx) __attribute__((always_inline)) {
    const int chunk = dir ? (63 - cidx) : cidx;
#pragma unroll
    for (int i = 0; i < 8; ++i) {
      const int tau = 8 * tg + i;
      const int tok = chunk * 64 + (dir ? (63 - tau) : tau);
      const unsigned* rp = (const unsigned*)(Hh + (rowbase + tok) * NPAD + head * 128) + cp;
      vv[i] = rp[H_I / 2];
      qq[i] = do_out ? rp[H_Q / 2] : 0u;
    }
  };
  auto stage1 = [&]() __attribute__((always_inline)) {
    float r0 = 0.f, r1 = 0.f;
#pragma unroll
    for (int i = 0; i < 8; ++i) {
      const float e0 = ex2(fminf(-lo16(pf[i]) * LOG2E, 80.f)), e1 = ex2(fminf(-hi16(pf[i]) * LOG2E, 80.f));
      const float s0 = frcp(1.f + e0), s1 = frcp(1.f + e1);
      r0 += lg2(lb0 + om0 * s0); r1 += lg2(lb1 + om1 * s1);
      g0[i] = r0; g1[i] = r1;
      kx0[i] = om0 * e0 * s0; kx1[i] = om1 * e1 * s1;
    }
    *(float2*)(sTot + tg * 128 + ch0) = make_float2(r0, r1);
  };
  gloadA(seg * SLEN); gloadB(seg * SLEN);
  stage1();
  if (SLEN > 1) gloadA(seg * SLEN + 1);
  for (int ci = 0; ci < SLEN; ++ci) {
    const int cidx = seg * SLEN + ci;
    const int chunk = dir ? (63 - cidx) : cidx;
    lds_barrier();
    float off0 = 0.f, off1 = 0.f, ref0 = 0.f, ref1 = 0.f, be0 = 0.f, be1 = 0.f;
#pragma unroll
    for (int j = 0; j < 8; ++j) {
      const float2 t = *(const float2*)(sTot + j * 128 + ch0);
      if (j < tg) { off0 += t.x; off1 += t.y; }
      if (j < 4) { ref0 += t.x; ref1 += t.y; }
      be0 += t.x; be1 += t.y;
    }
    dlog0 += be0; dlog1 += be1;
    const float eref0 = ex2(ref0), eref1 = ex2(ref1), ebr0 = ex2(be0 - ref0), ebr1 = ex2(be1 - ref1);
    const float d0 = off0 - ref0, d1 = off1 - ref1;
    float kh0[8], kh1[8];
#pragma unroll
    for (int i = 0; i < 8; ++i) {
      const int tau = 8 * tg + i;
      const float E0 = ex2(g0[i] + d0), E1 = ex2(g1[i] + d1);
      const float kt0 = kx0[i] * frcp(E0), kt1 = kx1[i] * frcp(E1);
      if (do_out) {
        const float qt0 = lo16(qq[i]) * E0, qt1 = hi16(qq[i]) * E1;
        sQt[tau * KPW + cp] = pk2(qt0, qt1);
        sKt[tau * KPW + cp] = pk2(kt0, kt1);
        sQc[tau * KPW + cp] = pk2(qt0 * eref0, qt1 * eref1);
      }
      kh0[i] = kt0 * ebr0; kh1[i] = kt1 * ebr1;
    }
    *(u32x4*)(sKhT + ch0 * 72 + 8 * tg) = CVT8(kh0);
    *(u32x4*)(sKhT + (ch0 + 1) * 72 + 8 * tg) = CVT8(kh1);
    *(u32x4*)(sVT + ch0 * 72 + 8 * tg) = PACK8_LO(vv);
    *(u32x4*)(sVT + (ch0 + 1) * 72 + 8 * tg) = PACK8_HI(vv);
    if (tg == 0) *(float2*)(sD + ch0) = make_float2(ex2(be0), ex2(be1));
    if (do_out) scan_write_state<K, V>(smem, S, w, lane);
    if (ci + 1 < SLEN) gloadB(cidx + 1);
    lds_barrier();
    scan_core<K, V, false>(smem, S, OB + (rowbase + (size_t)chunk * 64) * 512 + head * 128, dir, w, lane, do_out, nullptr);
    if (ci + 1 < SLEN) { stage1(); if (ci + 2 < SLEN) gloadA(cidx + 2); }
  }
  if (!do_out) {
    state_store<K, V>(sbuf, S, w, lane);
    if (tg == 0) *(float2*)((float*)(p.ws + OFF_DB) + ((size_t)it * NSEG + seg) * 128 + ch0) = make_float2(ex2(dlog0), ex2(dlog1));
  }
  lds_barrier();
}

DEV void gla_item(const ParamsG& p, int l, int it, int seg, int mode, unsigned char* smem) {
  const int j16 = it - 16, bl = j16 >> 3, head = (j16 >> 1) & 3, dir = j16 & 1;
  const bool do_out = (mode == 3);
  constexpr int K = 64, V = 128, KPW = 36;
  const int tid = launder(threadIdx.x), lane = tid & 63, w = tid >> 6;
  const int cp = tid & 31, tg = tid >> 5, ch0 = 2 * cp;
  const int vp2 = tid & 63, vg = tid >> 6;
  const bf16_t* Hh = (const bf16_t*)(p.ws + OFF_H);
  const bf16_t* Gb = (const bf16_t*)(p.ws + OFF_G);
  bf16_t* OB = (bf16_t*)(p.ws + OFF_OBUF) + (size_t)(2 * 2 + dir) * TH * 512;
  const size_t rowbase = (size_t)bl * SEQ;
  unsigned* sQt = (unsigned*)(smem + L_QT); unsigned* sKt = (unsigned*)(smem + L_KT); unsigned* sQc = (unsigned*)(smem + L_QC);
  bf16_t* sKhT = (bf16_t*)(smem + L_KHT); bf16_t* sVT = (bf16_t*)(smem + L_VT);
  float* sD = (float*)(smem + L_D); float* sTot = (float*)(smem + L_TOT);
  f32x16 S[1]; S[0] = zero16();
  float* sbuf = (float*)(p.ws + OFF_SB1) + ((size_t)j16 * NSEG + seg) * 8192;
  if (do_out) state_combine<K, V>((const float*)(p.ws + OFF_SB1) + (size_t)j16 * NSEG * 8192, 8192, (const float*)(p.ws + OFF_DB) + (size_t)it * NSEG * 128, seg, S, w, lane);
  float dlog0 = 0.f, dlog1 = 0.f;
  unsigned pg[4];
  float g0[4], g1[4]; unsigned kk[4], qq[4], vv[8];
  auto gloadA = [&](int cidx) __attribute__((always_inline)) {
    const int chunk = dir ? (63 - cidx) : cidx;
#pragma unroll
    for (int i = 0; i < 4; ++i) {
      const int tau = 4 * tg + i;
      const int tok = chunk * 64 + (dir ? (63 - tau) : tau);
      pg[i] = ((const unsigned*)(Gb + (rowbase + tok) * 512 + dir * 256 + head * 64))[cp];
    }
  };
  auto gloadB = [&](int cidx) __attribute__((always_inline)) {
    const int chunk = dir ? (63 - cidx) : cidx;
#pragma unroll
    for (int i = 0; i < 4; ++i) {
      const int tau = 4 * tg + i;
      const int tok = chunk * 64 + (dir ? (63 - tau) : tau);
      const unsigned* rp = (const unsigned*)(Hh + (rowbase + tok) * NPAD + head * 64) + cp;
      kk[i] = rp[G_K / 2]; qq[i] = do_out ? rp[G_Q / 2] : 0u;
    }
#pragma unroll
    for (int i = 0; i < 8; ++i) {
      const int tau = 8 * vg + i;
      const int tok = chunk * 64 + (dir ? (63 - tau) : tau);
      vv[i] = ((const unsigned*)(Hh + (rowbase + tok) * NPAD + G_V + head * 128))[vp2];
    }
  };
  auto stage1 = [&]() __attribute__((always_inline)) {
    float r0 = 0.f, r1 = 0.f;
#pragma unroll
    for (int i = 0; i < 4; ++i) { r0 += lo16(pg[i]); r1 += hi16(pg[i]); g0[i] = r0; g1[i] = r1; }
    *(float2*)(sTot + tg * 64 + ch0) = make_float2(r0, r1);
  };
  gloadA(seg * SLEN); gloadB(seg * SLEN);
  stage1();
  if (SLEN > 1) gloadA(seg * SLEN + 1);
  for (int ci = 0; ci < SLEN; ++ci) {
    const int cidx = seg * SLEN + ci;
    const int chunk = dir ? (63 - cidx) : cidx;
    lds_barrier();
    float off0 = 0.f, off1 = 0.f, ref0 = 0.f, ref1 = 0.f, be0 = 0.f, be1 = 0.f;
#pragma unroll
    for (int j = 0; j < 16; ++j) {
      const float2 t = *(const float2*)(sTot + j * 64 + ch0);
      if (j < tg) { off0 += t.x; off1 += t.y; }
      if (j < 8) { ref0 += t.x; ref1 += t.y; }
      be0 += t.x; be1 += t.y;
    }
    dlog0 += be0; dlog1 += be1;
    const float eref0 = ex2(ref0), eref1 = ex2(ref1), ebr0 = ex2(be0 - ref0), ebr1 = ex2(be1 - ref1);
    const float d0 = off0 - ref0, d1 = off1 - ref1;
    float kh0[4], kh1[4];
#pragma unroll
    for (int i = 0; i < 4; ++i) {
      const int tau = 4 * tg + i;
      const float E0 = ex2(g0[i] + d0), E1 = ex2(g1[i] + d1);
      const float kt0 = lo16(kk[i]) * frcp(E0), kt1 = hi16(kk[i]) * frcp(E1);
      if (do_out) {
        const float qt0 = lo16(qq[i]) * E0, qt1 = hi16(qq[i]) * E1;
        sQt[tau * KPW + cp] = pk2(qt0, qt1);
        sKt[tau * KPW + cp] = pk2(kt0, kt1);
        sQc[tau * KPW + cp] = pk2(qt0 * eref0, qt1 * eref1);
      }
      kh0[i] = kt0 * ebr0; kh1[i] = kt1 * ebr1;
    }
    *(uint2*)(sKhT + ch0 * 72 + 4 * tg) = make_uint2(pk2(kh0[0], kh0[1]), pk2(kh0[2], kh0[3]));
    *(uint2*)(sKhT + (ch0 + 1) * 72 + 4 * tg) = make_uint2(pk2(kh1[0], kh1[1]), pk2(kh1[2], kh1[3]));
    *(u32x4*)(sVT + (2 * vp2) * 72 + 8 * vg) = PACK8_LO(vv);
    *(u32x4*)(sVT + (2 * vp2 + 1) * 72 + 8 * vg) = PACK8_HI(vv);
    if (tg == 0) *(float2*)(sD + ch0) = make_float2(ex2(be0), ex2(be1));
    if (do_out) scan_write_state<K, V>(smem, S, w, lane);
    if (ci + 1 < SLEN) gloadB(cidx + 1);
    lds_barrier();
    scan_core<K, V, false>(smem, S, OB + (rowbase + (size_t)chunk * 64) * 512 + head * 128, dir, w, lane, do_out, nullptr);
    if (ci + 1 < SLEN) { stage1(); if (ci + 2 < SLEN) gloadA(cidx + 2); }
  }
  if (!do_out) {
    state_store<K, V>(sbuf, S, w, lane);
    if (tg == 0) *(float2*)((float*)(p.ws + OFF_DB) + ((size_t)it * NSEG + seg) * 128 + ch0) = make_float2(ex2(dlog0), ex2(dlog1));
  }
  lds_barrier();
}

DEV void ssd_item(const ParamsG& p, int l, int it, int seg, int mode, unsigned char* smem) {
  const int j32 = it - 32, bl = j32 >> 4, head = (j32 >> 1) & 7, dir = j32 & 1;
  const bool do_out = (mode == 3);
  constexpr int K = 128, V = 64, KPW = 68;
  const int tid = launder(threadIdx.x), lane = tid & 63, w = tid >> 6;
  const int cp = tid & 63, tg = tid >> 6, n0 = 2 * cp;
  const int xp = tid & 31, xg = tid >> 5;
  const int grp = head >> 2;
  const bf16_t* U = (const bf16_t*)(p.ws + OFF_U);
  const float* SMALL = (const float*)(p.ws + OFF_SMALL);
  bf16_t* OB = (bf16_t*)(p.ws + OFF_OBUF) + (size_t)(1 * 2 + dir) * TH * 512;
  const size_t rowbase = (size_t)bl * SEQ;
  unsigned* sQt = (unsigned*)(smem + L_QT); unsigned* sKt = (unsigned*)(smem + L_KT); unsigned* sQc = (unsigned*)(smem + L_QC);
  bf16_t* sKhT = (bf16_t*)(smem + L_KHT); bf16_t* sVT = (bf16_t*)(smem + L_VT);
  float* sD = (float*)(smem + L_D);
  const float dtb = p.dt_bias[(l * 2 + dir) * 8 + head];
  const float Acoef = -__expf(p.a_log[(l * 2 + dir) * 8 + head]) * LOG2E;
  f32x16 S[1]; S[0] = zero16();
  float* sbuf = (float*)(p.ws + OFF_SB2) + ((size_t)j32 * NSEG + seg) * 8192;
  if (do_out) state_combine<K, V>((const float*)(p.ws + OFF_SB2) + (size_t)j32 * NSEG * 8192, 8192, (const float*)(p.ws + OFF_DB) + (size_t)it * NSEG * 128, seg, S, w, lane);
  float dlog = 0.f;
  unsigned bb[8], cc[8], xx[4];
  float rdt = 0.f;
  auto gloadA = [&](int cidx) __attribute__((always_inline)) {
    const int chunk = dir ? (63 - cidx) : cidx;
    if (w == 0) {
      const int tok = chunk * 64 + (dir ? (63 - lane) : lane);
      rdt = SMALL[(rowbase + tok) * 48 + dir * 8 + head];
    }
  };
  auto gloadB = [&](int cidx) __attribute__((always_inline)) {
    const int chunk = dir ? (63 - cidx) : cidx;
#pragma unroll
    for (int i = 0; i < 8; ++i) {
      const int tau = 8 * tg + i;
      const int tok = chunk * 64 + (dir ? (63 - tau) : tau);
      const unsigned* rp = (const unsigned*)(U + (rowbase + tok) * 1024 + grp * 128) + cp;
      bb[i] = rp[512 / 2]; cc[i] = do_out ? rp[768 / 2] : 0u;
    }
#pragma unroll
    for (int i = 0; i < 4; ++i) {
      const int tau = 4 * xg + i;
      const int tok = chunk * 64 + (dir ? (63 - tau) : tau);
      xx[i] = ((const unsigned*)(U + (rowbase + tok) * 1024 + head * 64))[xp];
    }
  };
  auto stage1 = [&](int par) __attribute__((always_inline)) {
    if (w == 0) {
      const float xv = rdt + dtb;
      const float dt = (xv > 20.f) ? xv : log1pf(__expf(xv));
      float a = dt * Acoef;
#pragma unroll
      for (int o = 1; o < 64; o <<= 1) { const float t = __shfl_up(a, o); if (lane >= o) a += t; }
      ((float*)(smem + L_ACS))[par * 64 + lane] = a; ((float*)(smem + L_DT))[par * 64 + lane] = dt;
    }
  };
  gloadA(seg * SLEN); gloadB(seg * SLEN);
  stage1(0);
  if (SLEN > 1) gloadA(seg * SLEN + 1);
  for (int ci = 0; ci < SLEN; ++ci) {
    const int cidx = seg * SLEN + ci;
    const int chunk = dir ? (63 - cidx) : cidx;
    const float* sAcs = (const float*)(smem + L_ACS) + (ci & 1) * 64;
    const float* sDt = (const float*)(smem + L_DT) + (ci & 1) * 64;
    lds_barrier();
    const float aend = sAcs[63];
    dlog += aend;
    {
      float kh0[8], kh1[8];
#pragma unroll
      for (int i = 0; i < 8; ++i) {
        const int tau = 8 * tg + i;
        const float ac = sAcs[tau];
        const float eb = ex2(aend - ac);
        kh0[i] = lo16(bb[i]) * eb; kh1[i] = hi16(bb[i]) * eb;
        if (do_out) {
          const float ea = ex2(ac);
          sKt[tau * KPW + cp] = bb[i];
          sQt[tau * KPW + cp] = cc[i];
          sQc[tau * KPW + cp] = pk2(lo16(cc[i]) * ea, hi16(cc[i]) * ea);
        }
      }
      *(u32x4*)(sKhT + n0 * 72 + 8 * tg) = CVT8(kh0);
      *(u32x4*)(sKhT + (n0 + 1) * 72 + 8 * tg) = CVT8(kh1);
      float x0[4], x1[4];
#pragma unroll
      for (int i = 0; i < 4; ++i) { const float dtv = sDt[4 * xg + i]; x0[i] = lo16(xx[i]) * dtv; x1[i] = hi16(xx[i]) * dtv; }
      *(uint2*)(sVT + (2 * xp) * 72 + 4 * xg) = make_uint2(pk2(x0[0], x0[1]), pk2(x0[2], x0[3]));
      *(uint2*)(sVT + (2 * xp + 1) * 72 + 4 * xg) = make_uint2(pk2(x1[0], x1[1]), pk2(x1[2], x1[3]));
      if (tg == 0) *(float2*)(sD + n0) = make_float2(ex2(aend), ex2(aend));
    }
    if (do_out) scan_write_state<K, V>(smem, S, w, lane);
    if (ci + 1 < SLEN) gloadB(cidx + 1);
    lds_barrier();
    scan_core<K, V, true>(smem, S, OB + (rowbase + (size_t)chunk * 64) * 512 + head * 64, dir, w, lane, do_out, sAcs);
    if (ci + 1 < SLEN) { stage1((ci + 1) & 1); if (ci + 2 < SLEN) gloadA(cidx + 2); }
  }
  if (!do_out) {
    state_store<K, V>(sbuf, S, w, lane);
    if (tg == 0) *(float2*)((float*)(p.ws + OFF_DB) + ((size_t)it * NSEG + seg) * 128 + n0) = make_float2(ex2(dlog), ex2(dlog));
  }
  lds_barrier();
}

DEV void phase_prep(const ParamsG& p, int l, int hf, int rep, unsigned char* smem) {
  const int tid = launder(threadIdx.x), lane = tid & 63;
  bf16_t* Hh = (bf16_t*)(p.ws + OFF_H);
  bf16_t* U = (bf16_t*)(p.ws + OFF_U);
  bf16_t* Gb = (bf16_t*)(p.ws + OFF_G);
  bf16_t* VT = (bf16_t*)(p.ws + OFF_VT);
  const float* SMALLp = (const float*)(p.ws + OFF_SMALL);
  float2* stab = (float2*)smem;
  float* slow = (float*)(smem + 8192);
  bf16_t* sT = (bf16_t*)(smem + 12288);
  {
    const float2* tabg = (const float2*)(p.ws + OFF_TAB);
    for (int i = tid; i < 1024; i += NT) stab[i] = tabg[i];
  }
  const int cg8 = (tid & 127) * 8, rsub = tid >> 7;
  const float* cw = (const float*)(p.conv_w + (size_t)l * 5 * 1024); const float* cb = (const float*)(p.conv_b + (size_t)l * 1024);
  float wv[5][8], bv[8];
#pragma unroll
  for (int j = 0; j < 5; ++j)
#pragma unroll
    for (int e = 0; e < 8; ++e) wv[j][e] = cw[j * 1024 + cg8 + e];
#pragma unroll
  for (int e = 0; e < 8; ++e) bv[e] = cb[cg8 + e];
  const int gd = tid >> 8, gc = tid & 255;
  const int i16 = lane & 15;
  const float* gq = (const float*)(p.q_gain + l * 64 + 4 * i16); const float* gk = (const float*)(p.k_gain + l * 64 + 4 * i16);
  const float gqv[4] = {gq[0], gq[1], gq[2], gq[3]}, gkv[4] = {gk[0], gk[1], gk[2], gk[3]};
  for (int grp = blockIdx.x; grp < TH / 32; grp += gridDim.x) {
    const int r0 = grp * 32;
    lds_barrier();
    const u32x4 vt = *(const u32x4*)(Hh + (size_t)(r0 + (tid >> 4)) * NPAD + A_V + (tid & 15) * 8);
    const float2 lowv = *(const float2*)(SMALLp + (size_t)(r0 + (tid >> 4)) * 48 + 16 + (tid & 15) * 2);
    *(u32x4*)(sT + (tid >> 4) * 136 + (tid & 15) * 8) = vt;
    *(float2*)(slow + (tid >> 4) * 32 + (tid & 15) * 2) = lowv;
#pragma unroll 1
    for (int ps = 0; ps < 2; ++ps) {
      const int ra = r0 + 16 * ps + 4 * rsub, ta = ra & (SEQ - 1);
      u32x4 xc[8];
#pragma unroll
      for (int m = 0; m < 8; ++m) {
        const int sq = ta + m - 2;
        xc[m] = (u32x4){0u, 0u, 0u, 0u};
        if (sq >= 0 && sq < SEQ) xc[m] = *(const u32x4*)(Hh + (size_t)(ra + m - 2) * NPAD + S_X + cg8);
      }
#pragma unroll
      for (int o4 = 0; o4 < 4; ++o4) {
        float u[8];
#pragma unroll
        for (int e = 0; e < 8; ++e) u[e] = bv[e];
#pragma unroll
        for (int j = 0; j < 5; ++j)
#pragma unroll
          for (int e = 0; e < 4; ++e) { u[2 * e] += wv[j][2 * e] * lo16(xc[o4 + j][e]); u[2 * e + 1] += wv[j][2 * e + 1] * hi16(xc[o4 + j][e]); }
        u32x4 o;
#pragma unroll
        for (int e = 0; e < 4; ++e) {
          const float a = u[2 * e] * frcp(1.f + ex2(fminf(-u[2 * e] * LOG2E, 80.f)));
          const float b = u[2 * e + 1] * frcp(1.f + ex2(fminf(-u[2 * e + 1] * LOG2E, 80.f)));
          o[e] = pk2(a, b);
        }
        *(u32x4*)(U + (size_t)(ra + o4) * 1024 + cg8) = o;
      }
    }
    lds_barrier();
    if (rep == 0) {
#pragma unroll 1
      for (int ub = 0; ub < 10; ub += 5) {
        uint2 xq[5];
#pragma unroll
        for (int u = 0; u < 5; ++u) {
          const int pi = (ub + u) * 32 + (tid >> 4), row = r0 + pi / 10, hd = pi % 10;
          xq[u] = *(const uint2*)(Hh + (size_t)row * NPAD + ((hd < 8) ? (A_Q + hd * 64) : (A_K + (hd - 8) * 64)) + 4 * i16);
        }
#pragma unroll
        for (int u = 0; u < 5; ++u) {
          const int pi = (ub + u) * 32 + (tid >> 4), row = r0 + pi / 10, hd = pi % 10;
          const bool isq = hd < 8;
          const float x[4] = {lo16(xq[u].x), hi16(xq[u].x), lo16(xq[u].y), hi16(xq[u].y)};
          float ss = x[0] * x[0] + x[1] * x[1] + x[2] * x[2] + x[3] * x[3];
          ss += __shfl_xor(ss, 1); ss += __shfl_xor(ss, 2); ss += __shfl_xor(ss, 4); ss += __shfl_xor(ss, 8);
          const float rstd = rsqrtf(ss * (1.f / 64.f) + 1e-6f);
          const int t = row & (SEQ - 1);
          const int pos = (i16 < 8) ? (t >> 6) : (t & 63);
          const float osc = isq ? QSCALE : 1.f;
          float o[4];
#pragma unroll
          for (int e = 0; e < 4; ++e) {
            const float v = x[e] * rstd * (isq ? gqv[e] : gkv[e]);
            const float pv = __shfl_xor(v, 4);
            const float2 cs = stab[pos * 16 + 4 * (i16 & 3) + e];
            o[e] = ((i16 & 4) ? (v * cs.x + pv * cs.y) : (v * cs.x - pv * cs.y)) * osc;
          }
          *(uint2*)(Hh + (size_t)row * NPAD + (isq ? (A_Q + hd * 64) : (A_K + (hd - 8) * 64)) + 4 * i16) = make_uint2(pk2(o[0], o[1]), pk2(o[2], o[3]));
        }
      }
    }
    float w2c[16];
#pragma unroll
    for (int r = 0; r < 16; ++r) w2c[r] = p.gk_w2[((size_t)(l * 2 + gd) * 16 + r) * 256 + gc];
    const float gbias = p.gk_b[(l * 2 + gd) * 256 + gc];
#pragma unroll 4
    for (int rr = 0; rr < 32; ++rr) {
      const float4* lp4 = (const float4*)(slow + rr * 32 + gd * 16);
      float gkk = gbias;
#pragma unroll
      for (int r4 = 0; r4 < 4; ++r4) { const float4 lw = lp4[r4]; gkk += lw.x * w2c[4 * r4] + lw.y * w2c[4 * r4 + 1] + lw.z * w2c[4 * r4 + 2] + lw.w * w2c[4 * r4 + 3]; }
      const float l2 = (fminf(gkk, 0.f) * LOG2E - lg2(1.f + ex2(-fabsf(gkk) * LOG2E))) * (1.f / 16.f);
      Gb[(size_t)(r0 + rr) * 512 + tid] = f2bf(l2);
    }
    {
      const int c = tid >> 2, tq = (tid & 3) * 8;
      unsigned v[8];
#pragma unroll
      for (int i = 0; i < 8; ++i) v[i] = sT[(tq + i) * 136 + c];
      const int bl = r0 >> 12, t0 = (r0 & (SEQ - 1)) + tq;
      *(u32x4*)(VT + ((size_t)((bl * 2 + (c >> 6)) * 64 + (c & 63))) * SEQ + t0) = (u32x4){v[0] | (v[1] << 16), v[2] | (v[3] << 16), v[4] | (v[5] << 16), v[6] | (v[7] << 16)};
    }
  }
  lds_barrier();
}

DEV void phase_mix(const ParamsG& p, int l, int hf, int slot, int mode, int att_lo, int att_hi, int vid_lo, int vid_hi, unsigned char* smem) {
  unsigned* ctr = (unsigned*)(p.ws + OFF_CTRL) + CTR_WORD0 + slot * 16;
  volatile int* sItem = (volatile int*)(smem + LDS_BYTES - 16);
  const int n_scan = 64 * NSEG;
  int hi = n_scan + (att_hi - att_lo); if (vid_hi < hi) hi = vid_hi;
  for (;;) {
    lds_barrier();
    if (threadIdx.x == 0) *sItem = vid_lo + (int)atomicAdd(ctr, 1u);
    lds_barrier();
    const int vid = *sItem;
    if (vid >= hi) break;
    if (vid < n_scan) {
      const int seg = vid >> 6, it = vid & 63;
      if (mode == 1 && seg == NSEG - 1) continue;
#if PROBE_REP > 0
      if (slot >= 40 && PROBE_TYPE >= 0 && ((it < 16) ? 0 : (it < 32) ? 1 : 2) != PROBE_TYPE) continue;
#endif
      if (it < 16) { if (PH_MASK & 0x100) hgrn_item(p, l, it, seg, mode, smem); }
      else if (it < 32) { if (PH_MASK & 0x200) gla_item(p, l, it, seg, mode, smem); }
      else { if (PH_MASK & 0x400) ssd_item(p, l, it, seg, mode, smem); }
    } else { if (PH_MASK & 0x800) attn_item(p, l, att_lo + (vid - n_scan), smem); }
  }
}

DEV void phase_scan2(const ParamsG& p) {
  const size_t gtid = (size_t)blockIdx.x * NT + threadIdx.x, gsz = (size_t)gridDim.x * NT;
  const float* DB = (const float*)(p.ws + OFF_DB);
  for (size_t e = gtid; e < 655360; e += gsz) {
    float* buf; const float* dp; int stride;
    if (e < 262144) { const int it = (int)(e >> 14), idx = (int)(e & 16383); buf = (float*)(p.ws + OFF_SB0) + (size_t)it * NSEG * 16384 + idx; stride = 16384; dp = DB + (size_t)it * NSEG * 128 + (idx >> 7); }
    else if (e < 393216) { const int e2 = (int)(e - 262144), j = e2 >> 13, idx = e2 & 8191; buf = (float*)(p.ws + OFF_SB1) + (size_t)j * NSEG * 8192 + idx; stride = 8192; dp = DB + (size_t)(16 + j) * NSEG * 128 + (idx >> 7); }
    else { const int e3 = (int)(e - 393216), j = e3 >> 13, idx = e3 & 8191; buf = (float*)(p.ws + OFF_SB2) + (size_t)j * NSEG * 8192 + idx; stride = 8192; dp = DB + (size_t)(32 + j) * NSEG * 128 + (idx >> 6); }
    float u[NSEG - 1], d[NSEG - 1];
#pragma unroll
    for (int sg = 0; sg < NSEG - 1; ++sg) { u[sg] = buf[(size_t)sg * stride]; d[sg] = dp[sg * 128]; }
    float st = 0.f;
#pragma unroll
    for (int sg = 0; sg < NSEG; ++sg) { buf[(size_t)sg * stride] = st; if (sg < NSEG - 1) st = d[sg] * st + u[sg]; }
  }
}

DEV float bfe(const u32x4& v, int j) { return (j & 1) ? hi16(v[j >> 1]) : lo16(v[j >> 1]); }
DEV void phase_fin(const ParamsG& p, int l, int hf) {
  const int tid = launder(threadIdx.x), lane = tid & 63, w = tid >> 6;
  const bf16_t* Hh = (const bf16_t*)(p.ws + OFF_H);
  const bf16_t* OB = (const bf16_t*)(p.ws + OFF_OBUF);
  bf16_t* MX = (bf16_t*)(p.ws + OFF_MIXED);
  const int c0 = lane * 8;
  const float* cw = (const float*)(p.conv_w + (size_t)l * 5 * 1024); const float* cb = (const float*)(p.conv_b + (size_t)l * 1024);
  for (int r0 = (blockIdx.x * 8 + w) * 4; r0 < TH; r0 += gridDim.x * 32) {
    {
      u32x4 at[4], a[4], b[4], z[4];
#pragma unroll
      for (int i = 0; i < 4; ++i) {
        const bf16_t* hrow = Hh + (size_t)(r0 + i) * NPAD;
        at[i] = *(const u32x4*)(hrow + A_Q + c0);
        a[i] = *(const u32x4*)(OB + ((size_t)0 * TH + r0 + i) * 512 + c0); b[i] = *(const u32x4*)(OB + ((size_t)1 * TH + r0 + i) * 512 + c0);
        z[i] = *(const u32x4*)(hrow + H_Z + c0);
      }
      float gn[8];
#pragma unroll
      for (int j = 0; j < 8; ++j) gn[j] = p.hgrn_norm[l * 512 + c0 + j];
#pragma unroll
      for (int i = 0; i < 4; ++i) {
        *(u32x4*)(MX + (size_t)(r0 + i) * DI + c0) = at[i];
        float o[8]; float ss = 0.f;
#pragma unroll
        for (int j = 0; j < 8; ++j) { o[j] = bfe(a[i], j) + bfe(b[i], j); ss += o[j] * o[j]; }
#pragma unroll
        for (int of = 32; of >= 1; of >>= 1) ss += __shfl_xor(ss, of);
        const float rstd = rsqrtf(ss * (1.f / 512.f) + 1e-6f);
        float y[8];
#pragma unroll
        for (int j = 0; j < 8; ++j) { const float zz = bfe(z[i], j); y[j] = o[j] * rstd * gn[j] * (zz * frcp(1.f + ex2(fminf(-zz * LOG2E, 80.f)))); }
        *(u32x4*)(MX + (size_t)(r0 + i) * DI + 512 + c0) = (u32x4){pk2(y[0], y[1]), pk2(y[2], y[3]), pk2(y[4], y[5]), pk2(y[6], y[7])};
      }
    }
    {
      u32x4 a[4], b[4], z[4];
#pragma unroll
      for (int i = 0; i < 4; ++i) {
        a[i] = *(const u32x4*)(OB + ((size_t)4 * TH + r0 + i) * 512 + c0); b[i] = *(const u32x4*)(OB + ((size_t)5 * TH + r0 + i) * 512 + c0);
        z[i] = *(const u32x4*)(Hh + (size_t)(r0 + i) * NPAD + G_Z + c0);
      }
      float gn[8];
#pragma unroll
      for (int j = 0; j < 8; ++j) gn[j] = p.gla_norm[l * 128 + ((c0 + j) & 127)];
#pragma unroll
      for (int i = 0; i < 4; ++i) {
        float o[8]; float ss = 0.f;
#pragma unroll
        for (int j = 0; j < 8; ++j) { o[j] = bfe(a[i], j) + bfe(b[i], j); ss += o[j] * o[j]; }
#pragma unroll
        for (int of = 8; of >= 1; of >>= 1) ss += __shfl_xor(ss, of);
        const float rstd = rsqrtf(ss * (1.f / 128.f) + 1e-6f);
        float y[8];
#pragma unroll
        for (int j = 0; j < 8; ++j) { const float zz = bfe(z[i], j); y[j] = o[j] * rstd * gn[j] * (zz * frcp(1.f + ex2(fminf(-zz * LOG2E, 80.f)))); }
        *(u32x4*)(MX + (size_t)(r0 + i) * DI + 1536 + c0) = (u32x4){pk2(y[0], y[1]), pk2(y[2], y[3]), pk2(y[4], y[5]), pk2(y[6], y[7])};
      }
    }
    {
      u32x4 a[4], b[4], z[4], xr[8];
      const int t0 = r0 & (SEQ - 1);
#pragma unroll
      for (int i = 0; i < 4; ++i) {
        a[i] = *(const u32x4*)(OB + ((size_t)2 * TH + r0 + i) * 512 + c0); b[i] = *(const u32x4*)(OB + ((size_t)3 * TH + r0 + i) * 512 + c0);
        z[i] = *(const u32x4*)(Hh + (size_t)(r0 + i) * NPAD + S_Z + c0);
      }
#pragma unroll
      for (int m = 0; m < 8; ++m) {
        const int sq = t0 + m - 2;
        xr[m] = (u32x4){0u, 0u, 0u, 0u};
        if (sq >= 0 && sq < SEQ) xr[m] = *(const u32x4*)(Hh + (size_t)(r0 + m - 2) * NPAD + S_X + c0);
      }
      float gn[8], cbv[8];
#pragma unroll
      for (int j = 0; j < 8; ++j) { gn[j] = p.ssd_norm[l * 512 + c0 + j]; cbv[j] = cb[c0 + j]; }
      const float dsk = p.ssd_d[l * 8 + (c0 >> 6)];
#pragma unroll
      for (int i = 0; i < 4; ++i) {
        float u[8];
#pragma unroll
        for (int j = 0; j < 8; ++j) u[j] = cbv[j];
#pragma unroll
        for (int jj = 0; jj < 5; ++jj)
#pragma unroll
          for (int j = 0; j < 8; ++j) u[j] += cw[jj * 1024 + c0 + j] * bfe(xr[i + jj], j);
        float y[8]; float ss = 0.f;
#pragma unroll
        for (int j = 0; j < 8; ++j) {
          const float zz = bfe(z[i], j);
          const float xs = u[j] * frcp(1.f + ex2(fminf(-u[j] * LOG2E, 80.f)));
          y[j] = (bfe(a[i], j) + bfe(b[i], j) + dsk * xs) * (zz * frcp(1.f + ex2(fminf(-zz * LOG2E, 80.f))));
          ss += y[j] * y[j];
        }
#pragma unroll
        for (int of = 32; of >= 1; of >>= 1) ss += __shfl_xor(ss, of);
        const float rstd = rsqrtf(ss * (1.f / 512.f) + 1e-6f);
#pragma unroll
        for (int j = 0; j < 8; ++j) y[j] = y[j] * rstd * gn[j];
        *(u32x4*)(MX + (size_t)(r0 + i) * DI + 1024 + c0) = (u32x4){pk2(y[0], y[1]), pk2(y[2], y[3]), pk2(y[4], y[5]), pk2(y[6], y[7])};
      }
    }
  }
}

#define XB_TMO      128
#define XB_XCNT(j)  (256  + 64 * (j))
#define XB_XSUB(j)  (1280 + 64 * (j))
#define XB_XGEN(j)  (2304 + 64 * (j))
#define XB_TOP      3328
#define XB_TOPGEN   3392
#define XB_SPIN_CAP (1u << 22)
#define LAS __attribute__((address_space(3)))
DEV unsigned xb_ld(unsigned* p) { return __hip_atomic_load(p, __ATOMIC_RELAXED, __HIP_MEMORY_SCOPE_AGENT); }
DEV unsigned xb_add(unsigned* p, unsigned v) { return __hip_atomic_fetch_add(p, v, __ATOMIC_RELAXED, __HIP_MEMORY_SCOPE_AGENT); }
DEV unsigned xb_xcc_id() { return (unsigned)__builtin_amdgcn_s_getreg((3 << 11) | 20) & 0xFu; }
#define XB_SPIN(cond, bar) do { unsigned _sp = 0; while (cond) { __builtin_amdgcn_s_sleep(1); \
    if ((++_sp & 255u) == 0u) { if (xb_ld(&(bar)[XB_TMO])) break; if (_sp > XB_SPIN_CAP) { atomicAdd(&(bar)[XB_TMO], 1u); break; } } } } while (0)
struct XcdBarrier { unsigned* bar; unsigned x; volatile LAS unsigned* st; };
DEV XcdBarrier xcd_barrier_post(unsigned* bar, volatile LAS unsigned* st) {
  XcdBarrier b; b.bar = bar; b.x = xb_xcc_id(); b.st = st;
  if (threadIdx.x == 0) (void)xb_add(&bar[XB_XCNT(b.x)], 1u);
  return b;
}
DEV void xcd_barrier_complete(unsigned* bar, unsigned x, unsigned& nloc, unsigned& nx) {
  const unsigned G = gridDim.x * gridDim.y * gridDim.z;
  unsigned sum, cnt, mine, sp = 0u;
  for (;;) {
    sum = 0u; cnt = 0u; mine = 0u;
#pragma unroll
    for (unsigned j = 0; j < 16; ++j) { const unsigned c = xb_ld(&bar[XB_XCNT(j)]); sum += c; cnt += (c > 0u) ? 1u : 0u; mine = (j == x) ? c : mine; }
    if (sum == G) break;
    __builtin_amdgcn_s_sleep(1);
    if ((++sp & 255u) == 0u) { if (xb_ld(&bar[XB_TMO])) break; if (sp > XB_SPIN_CAP) { atomicAdd(&bar[XB_TMO], 1u); break; } }
  }
  nloc = mine > 0u ? mine : 1u; nx = cnt > 0u ? cnt : 1u;
}
DEV void xcd_barrier(const XcdBarrier& b) {
  asm volatile("s_waitcnt vmcnt(0)" ::: "memory");
  __syncthreads();
  if (threadIdx.x == 0) {
    unsigned* bar = b.bar;
    __builtin_amdgcn_s_waitcnt(0);
    unsigned nloc = b.st[0], nx = b.st[1];
    if (nloc == 0u) { xcd_barrier_complete(bar, b.x, nloc, nx); b.st[0] = nloc; b.st[1] = nx; }
    const unsigned old = xb_add(&bar[XB_XSUB(b.x)], 1u);
    const unsigned gen = old / nloc;
    if (old + 1u == (gen + 1u) * nloc) {
      __builtin_amdgcn_fence(__ATOMIC_RELEASE, "agent");
      asm volatile("s_waitcnt vmcnt(0)" ::: "memory");
      const unsigned og = xb_add(&bar[XB_TOP], 1u);
      const unsigned tg = og / nx;
      if (og + 1u == (tg + 1u) * nx) xb_add(&bar[XB_TOPGEN], 1u);
      else XB_SPIN(xb_ld(&bar[XB_TOPGEN]) == tg, bar);
      __builtin_amdgcn_fence(__ATOMIC_ACQUIRE, "agent");
      xb_add(&bar[XB_XGEN(b.x)], 1u);
      asm volatile("s_waitcnt vmcnt(0)" ::: "memory");
    } else {
      XB_SPIN(xb_ld(&bar[XB_XGEN(b.x)]) == gen, bar);
      __builtin_amdgcn_fence(__ATOMIC_ACQUIRE, "agent");
      asm volatile("s_waitcnt vmcnt(0)" ::: "memory");
    }
  }
  __syncthreads();
}

DEV void run_phase(const ParamsG& p, int ph, int rep, unsigned char* smem) {
  if (ph == 0) { if (PH_MASK & 1) { phase_pro(p, smem); convert_weights(p, 0, 3, smem); } return; }
  if (ph == 21) { if (PH_MASK & 16) phase_outproj(p, 1, 1, smem); return; }
  if (ph == 22) { if (PH_MASK & 32) phase_ln(p, 1, 1); return; }
  const int q = ph - 1, blk = q / 5, st = q % 5, l = blk >> 1, hf = blk & 1;
  if (st == 0) {
    if (blk > 0 && (PH_MASK & 16)) phase_outproj(p, (blk - 1) >> 1, (blk - 1) & 1, smem);
    if (PH_MASK & 2) phase_inproj(p, l, hf, blk > 0 ? 16 : 0, smem);
  } else if (st == 1) {
    if (blk > 0 && rep == 0 && (PH_MASK & 32)) phase_ln(p, (blk - 1) >> 1, (blk - 1) & 1);
    if (PH_MASK & 4) phase_prep(p, l, hf, rep, smem);
    if ((PH_MASK & 1) && rep == 0 && blk == 1) convert_weights(p, 1, 1, smem);
    if ((PH_MASK & 1) && rep == 0 && blk == 2) convert_weights(p, 1, 2, smem);
  }
  else if (st == 2) { if (PH_MASK & 0xF00) phase_mix(p, l, hf, ph + 40 * rep, 1, 0, ATT_SPLIT, rep ? PROBE_LO : 0, rep ? PROBE_HI : 100000, smem); }
  else if (st == 3) { if (PH_MASK & 0xF00) phase_mix(p, l, hf, ph + 40 * rep, 3, ATT_SPLIT, 256, rep ? PROBE_LO : 0, rep ? PROBE_HI : 100000, smem); }
  else { if (PH_MASK & 8) phase_fin(p, l, hf); }
}
__global__ void __launch_bounds__(NT) mega(Params p) {
  extern __shared__ __attribute__((aligned(16))) unsigned char smem[];
#if ONE_LAUNCH
  volatile LAS unsigned* xst = (volatile LAS unsigned*)(smem + LDS_BYTES - 32);
  if (threadIdx.x == 0) { xst[0] = 0u; xst[1] = 0u; }
  __syncthreads();
  XcdBarrier xb = xcd_barrier_post((unsigned*)(p.ws + OFF_CTRL), xst);
#endif
  ParamsG* lp = (ParamsG*)(smem + 147456);
  if (threadIdx.x == 0) {
    lp->x = (GAS const float*)p.x; lp->w_in = (GAS const float*)p.w_in; lp->q_gain = (GAS const float*)p.q_gain; lp->k_gain = (GAS const float*)p.k_gain;
    lp->lb_logits = (GAS const float*)p.lb_logits; lp->hgrn_norm = (GAS const float*)p.hgrn_norm; lp->conv_w = (GAS const float*)p.conv_w; lp->conv_b = (GAS const float*)p.conv_b;
    lp->dt_bias = (GAS const float*)p.dt_bias; lp->a_log = (GAS const float*)p.a_log; lp->ssd_d = (GAS const float*)p.ssd_d; lp->ssd_norm = (GAS const float*)p.ssd_norm;
    lp->gk_w2 = (GAS const float*)p.gk_w2; lp->gk_b = (GAS const float*)p.gk_b; lp->gla_norm = (GAS const float*)p.gla_norm; lp->w_out = (GAS const float*)p.w_out;
    lp->ln_g = (GAS const float*)p.ln_g; lp->ln_b = (GAS const float*)p.ln_b; lp->out = (GAS float*)p.out; lp->ws = (GAS unsigned char*)p.ws;
  }
  __syncthreads();
  const int ph_begin = p.phase_begin, ph_end = p.phase_end;
  for (int ph = ph_begin; ph < ph_end; ++ph) {
    int nrep = 0;
#if PROBE_REP > 0
    {
      const int q = ph - 1, st = q % 5;
      const bool idem = (ph >= 1 && ph <= 20) && (st == PROBE_ST) && (st >= 1 || ph <= PROBE_PHMAX) && (ph >= PROBE_PHMIN);
      if (idem) nrep = PROBE_REP;
    }
#endif
    for (int r = 0; r <= nrep; ++r) {
      run_phase(*lp, ph, r, smem);
#if ONE_LAUNCH
      if (r < nrep || ph + 1 < ph_end) xcd_barrier(xb);
#endif
    }
  }
}

extern "C" void kernel_launch(void* const* d_in, const int* in_sizes, int n_in, void* d_out, int out_size, void* d_ws, size_t ws_size,
                              hipStream_t stream) {
  static int grid_blocks = 0;
  if (!grid_blocks) {
    int dev = 0, cus = 0, per_cu = 0;
    hipGetDevice(&dev);
    hipDeviceGetAttribute(&cus, hipDeviceAttributeMultiprocessorCount, dev);
    hipFuncSetAttribute((const void*)mega, hipFuncAttributeMaxDynamicSharedMemorySize, LDS_BYTES);
    hipOccupancyMaxActiveBlocksPerMultiprocessor(&per_cu, mega, NT, LDS_BYTES);
    if (per_cu < 1) per_cu = 1;
    grid_blocks = cus;
  }
  Params p{};
  p.x = (const float*)d_in[0]; p.w_in = (const float*)d_in[1]; p.q_gain = (const float*)d_in[2]; p.k_gain = (const float*)d_in[3];
  p.lb_logits = (const float*)d_in[4]; p.hgrn_norm = (const float*)d_in[5]; p.conv_w = (const float*)d_in[6]; p.conv_b = (const float*)d_in[7];
  p.dt_bias = (const float*)d_in[8]; p.a_log = (const float*)d_in[9]; p.ssd_d = (const float*)d_in[10]; p.ssd_norm = (const float*)d_in[11];
  p.gk_w2 = (const float*)d_in[12]; p.gk_b = (const float*)d_in[13]; p.gla_norm = (const float*)d_in[14]; p.w_out = (const float*)d_in[15];
  p.ln_g = (const float*)d_in[16]; p.ln_b = (const float*)d_in[17];
  p.out = (float*)d_out; p.ws = (unsigned char*)d_ws;
  hipMemsetAsync(d_ws, 0, CTRL_BYTES, stream);
#if ONE_LAUNCH
  p.phase_begin = 0; p.phase_end = NPHASE;
  void* args[] = {&p};
  (void)args;
  hipLaunchKernelGGL(mega, dim3(grid_blocks), dim3(NT), LDS_BYTES, stream, p);
#else
  for (int ph = 0; ph < NPHASE; ++ph) {
    p.phase_begin = ph; p.phase_end = ph + 1;
    hipLaunchKernelGGL(mega, dim3(grid_blocks), dim3(NT), LDS_BYTES, stream, p);
  }
#endif
}
```

```cpp
#include <hip/hip_runtime.h>
#include <hip/hip_cooperative_groups.h>
#include <stdint.h>
#include <stdio.h>
namespace cg = cooperative_groups;

#ifndef ONE_LAUNCH
#define ONE_LAUNCH 1
#endif

#ifndef PH_MASK
#define PH_MASK 0xFFF
#endif
#ifndef PROBE_ST
#define PROBE_ST -1
#endif
#ifndef PROBE_REP
#define PROBE_REP 0
#endif
#ifndef PROBE_PHMAX
#define PROBE_PHMAX 0
#endif
#ifndef PROBE_PHMIN
#define PROBE_PHMIN 0
#endif
#ifndef PROBE_TYPE
#define PROBE_TYPE -1
#endif
#ifndef PROBE_LO
#define PROBE_LO 0
#endif
#ifndef PROBE_HI
#define PROBE_HI 100000
#endif
#define DEV __device__ __forceinline__
typedef unsigned short bf16_t;
typedef short bf16x8 __attribute__((ext_vector_type(8)));
typedef float f32x16 __attribute__((ext_vector_type(16)));
typedef unsigned u32x4 __attribute__((ext_vector_type(4)));
typedef float f32x4 __attribute__((ext_vector_type(4)));

constexpr int NT = 512;
constexpr int T_ALL = 16384, TH = 8192, SEQ = 4096, DM = 1024, NPAD = 7168, DI = 2048, NIN = 6960;
constexpr int A_Q = 0, A_K = 512, A_V = 640, A_Z = 768, H_Q = 1280, H_FF = 1792, H_FB = 2304, H_I = 2816, H_Z = 3328,
              S_X = 3840, S_Z = 4864, G_Q = 5376, G_K = 5632, G_V = 5888, G_Z = 6400, SM0 = 6912;
constexpr size_t OFF_CTRL = 0, OFF_TAB = 65536, OFF_XB = 131072;
constexpr size_t OFF_WIN = OFF_XB + (size_t)T_ALL * DM * 2;
constexpr size_t OFF_WOUT = OFF_WIN + (size_t)NPAD * DM * 2;
constexpr size_t OFF_H = OFF_WOUT + (size_t)DM * DI * 2;
constexpr size_t OFF_SMALL = OFF_H + (size_t)TH * NPAD * 2;
constexpr size_t OFF_OBUF = OFF_SMALL + (size_t)TH * 48 * 4;
constexpr size_t OFF_VT = OFF_OBUF + (size_t)6 * TH * 512 * 2;
constexpr size_t OFF_DB = OFF_VT + (size_t)2 * 2 * 64 * SEQ * 2;
constexpr int NSEG = 8, SLEN = 64 / NSEG;
constexpr size_t OFF_MIXED = OFF_DB + (size_t)64 * NSEG * 128 * 4;
constexpr size_t OFF_SB0 = OFF_MIXED, OFF_SB1 = OFF_SB0 + (size_t)16 * NSEG * 16384 * 2, OFF_SB2 = OFF_SB1 + (size_t)16 * NSEG * 8192 * 2;
constexpr size_t OFF_U = OFF_SB2 + (size_t)32 * NSEG * 8192 * 2;
constexpr size_t OFF_G = OFF_U + (size_t)TH * 1024 * 2;
constexpr size_t WS_END = (OFF_G + (size_t)TH * 512 * 2 > OFF_MIXED + (size_t)TH * DI * 2) ? (OFF_G + (size_t)TH * 512 * 2) : (OFF_MIXED + (size_t)TH * DI * 2);
static_assert(OFF_MIXED + (size_t)TH * DI * 2 <= WS_END, "MIXED must fit");
static_assert(WS_END <= 268435456, "workspace");
constexpr size_t CTRL_BYTES = 65536;
constexpr int CTR_WORD0 = 4096;
constexpr int LDS_BYTES = 148480;
constexpr float LOG2E = 1.4426950408889634f;
constexpr float QSCALE = 0.125f * LOG2E;
constexpr float DN_ALPHA = 1.4142135623730951f;
constexpr int NPHASE = 23;
constexpr int ATT_SPLIT = 256;

struct Params {
  const float* x; const float* w_in; const float* q_gain; const float* k_gain; const float* lb_logits; const float* hgrn_norm;
  const float* conv_w; const float* conv_b; const float* dt_bias; const float* a_log; const float* ssd_d; const float* ssd_norm;
  const float* gk_w2; const float* gk_b; const float* gla_norm; const float* w_out; const float* ln_g; const float* ln_b;
  float* out; unsigned char* ws;
  int phase_begin, phase_end;
};
#define GAS __attribute__((address_space(1)))
struct ParamsG {
  GAS const float* x; GAS const float* w_in; GAS const float* q_gain; GAS const float* k_gain; GAS const float* lb_logits; GAS const float* hgrn_norm;
  GAS const float* conv_w; GAS const float* conv_b; GAS const float* dt_bias; GAS const float* a_log; GAS const float* ssd_d; GAS const float* ssd_norm;
  GAS const float* gk_w2; GAS const float* gk_b; GAS const float* gla_norm; GAS const float* w_out; GAS const float* ln_g; GAS const float* ln_b;
  GAS float* out; GAS unsigned char* ws;
};

DEV void lds_barrier() { asm volatile("s_waitcnt lgkmcnt(0)" ::: "memory"); __builtin_amdgcn_s_barrier(); asm volatile("" ::: "memory"); }
DEV int launder(int v) { asm volatile("" : "+v"(v)); return v; }
DEV float bf2f(bf16_t v) { return __uint_as_float(((unsigned)v) << 16); }
DEV bf16_t f2bf(float f) { unsigned u = __float_as_uint(f); u += 0x7fffu + ((u >> 16) & 1u); return (bf16_t)(u >> 16); }
typedef __bf16 bf16x2_t __attribute__((ext_vector_type(2)));
typedef float f32x2_t __attribute__((ext_vector_type(2)));
DEV unsigned pk2(float lo, float hi) { const f32x2_t f = {lo, hi}; const bf16x2_t b = __builtin_convertvector(f, bf16x2_t); return __builtin_bit_cast(unsigned, b); }
DEV float fsigmoid(float x) { return 1.f / (1.f + __expf(-x)); }
DEV float fsilu(float x) { return x / (1.f + __expf(-x)); }
DEV unsigned cvtpk(float lo, float hi) { return pk2(lo, hi); }
DEV float ex2(float x) { return __builtin_amdgcn_exp2f(x); }
DEV float lg2(float x) { return __builtin_amdgcn_logf(x); }
DEV float frcp(float x) { return __builtin_amdgcn_rcpf(x); }
DEV float lo16(unsigned u) { return __uint_as_float(u << 16); }
DEV float hi16(unsigned u) { return __uint_as_float(u & 0xffff0000u); }
DEV int rowoff(int reg, int h) { return (reg & 3) + 8 * (reg >> 2) + 4 * h; }
DEV f32x16 zero16() { f32x16 z;
#pragma unroll
  for (int i = 0; i < 16; ++i) z[i] = 0.f; return z; }

template <int KD>
DEV void mma32(f32x16& acc, const bf16_t* a, int lda, const bf16_t* b, int ldb, int lane) {
  const int r = lane & 31, h = lane >> 5;
  const bf16_t* ap = a + r * lda + 8 * h;
  const bf16_t* bp = b + r * ldb + 8 * h;
#pragma unroll 4
  for (int k = 0; k < KD; k += 16) {
    bf16x8 av = *(const bf16x8*)(ap + k);
    bf16x8 bv = *(const bf16x8*)(bp + k);
    acc = __builtin_amdgcn_mfma_f32_32x32x16_bf16(av, bv, acc, 0, 0, 0);
  }
}

DEV int orig_col(int n) {
  if (n < 4864) return n;
  if (n < 6400) return n + 16;
  if (n < 6912) return n + 48;
  if (n < 6928) return n - 2048;
  if (n < 6960) return n - 512;
  return -1;
}

DEV void convert_weights(const ParamsG& p, int l, int which, unsigned char* smem) {
  float* s = (float*)smem;
  const int tid = launder(threadIdx.x);
  const float* win = (const float*)(p.w_in + (size_t)l * DM * NIN);
  const float* wout = (const float*)(p.w_out + (size_t)l * DI * DM);
  bf16_t* wint = (bf16_t*)(p.ws + OFF_WIN);
  bf16_t* woutt = (bf16_t*)(p.ws + OFF_WOUT);
  const int n_in_tiles = (NPAD / 64) * (DM / 64);
  const int n_out_tiles = (DM / 64) * (DI / 64);
  const int it_lo = (which & 1) ? 0 : n_in_tiles, it_hi = (which & 2) ? (n_in_tiles + n_out_tiles) : n_in_tiles;
  for (int it = it_lo + blockIdx.x; it < it_hi; it += gridDim.x) {
    lds_barrier();
    if (it < n_in_tiles) {
      const int n0 = (it / 16) * 64, k0 = (it % 16) * 64;
#pragma unroll
      for (int e = 0; e < 8; ++e) {
        const int idx = e * NT + tid, kk = idx >> 6, nn = idx & 63;
        const int oc = orig_col(n0 + nn);
        s[kk * 65 + nn] = (oc >= 0) ? win[(size_t)(k0 + kk) * NIN + oc] : 0.f;
      }
      lds_barrier();
      const int n = tid >> 3, kc = (tid & 7) * 8;
      uint4 o;
      o.x = pk2(s[(kc + 0) * 65 + n], s[(kc + 1) * 65 + n]); o.y = pk2(s[(kc + 2) * 65 + n], s[(kc + 3) * 65 + n]);
      o.z = pk2(s[(kc + 4) * 65 + n], s[(kc + 5) * 65 + n]); o.w = pk2(s[(kc + 6) * 65 + n], s[(kc + 7) * 65 + n]);
      *(uint4*)(wint + (size_t)(n0 + n) * DM + k0 + kc) = o;
    } else {
      const int j = it - n_in_tiles;
      const int n0 = (j / 32) * 64, k0 = (j % 32) * 64;
#pragma unroll
      for (int e = 0; e < 8; ++e) {
        const int idx = e * NT + tid, kk = idx >> 6, nn = idx & 63;
        s[kk * 65 + nn] = wout[(size_t)(k0 + kk) * DM + n0 + nn];
      }
      lds_barrier();
      const int n = tid >> 3, kc = (tid & 7) * 8;
      uint4 o;
      o.x = pk2(s[(kc + 0) * 65 + n], s[(kc + 1) * 65 + n]); o.y = pk2(s[(kc + 2) * 65 + n], s[(kc + 3) * 65 + n]);
      o.z = pk2(s[(kc + 4) * 65 + n], s[(kc + 5) * 65 + n]); o.w = pk2(s[(kc + 6) * 65 + n], s[(kc + 7) * 65 + n]);
      *(uint4*)(woutt + (size_t)(n0 + n) * DI + k0 + kc) = o;
    }
  }
  lds_barrier();
}

DEV void fsincos(float x, float& s, float& c) {
  const float k = rintf(x * 0.63661977236758134308f);
  float r = fmaf(-k, 1.5707855225e+00f, x);
  r = fmaf(-k, 1.0804273188e-05f, r);
  r = fmaf(-k, 6.0770999344e-11f, r);
  const float r2 = r * r;
  float ps = fmaf(r2, 2.7557319224e-06f, -1.9841269841e-04f);
  ps = fmaf(ps, r2, 8.3333333333e-03f); ps = fmaf(ps, r2, -1.6666666667e-01f);
  const float sinr = fmaf(ps * r2, r, r);
  float pc = fmaf(r2, -2.7557319224e-07f, 2.4801587302e-05f);
  pc = fmaf(pc, r2, -1.3888888889e-03f); pc = fmaf(pc, r2, 4.1666666667e-02f); pc = fmaf(pc, r2, -0.5f);
  const float cosr = fmaf(pc, r2, 1.0f);
  const int q = ((int)k) & 3;
  if (q == 0) { s = sinr; c = cosr; }
  else if (q == 1) { s = cosr; c = -sinr; }
  else if (q == 2) { s = -sinr; c = -cosr; }
  else { s = -cosr; c = sinr; }
}

DEV void phase_pro(const ParamsG& p, unsigned char* smem) {
  const int tid = launder(threadIdx.x);
  const size_t gtid = (size_t)blockIdx.x * NT + tid, gsz = (size_t)gridDim.x * NT;
  const float4* x4 = (const float4*)p.x;
  uint4* xb4 = (uint4*)(p.ws + OFF_XB);
  for (size_t i = gtid; i < (size_t)T_ALL * DM / 8; i += gsz) {
    const float4 a = x4[2 * i], b = x4[2 * i + 1];
    uint4 o; o.x = pk2(a.x, a.y); o.y = pk2(a.z, a.w); o.z = pk2(b.x, b.y); o.w = pk2(b.z, b.w);
    xb4[i] = o;
  }
  if (blockIdx.x == 0) {
    float2* tab = (float2*)(p.ws + OFF_TAB);
    for (int i = tid; i < 64 * 16; i += NT) {
      const int pos = i >> 4, fi = i & 15;
      const float invf = exp2f(-(float)fi * (13.287712379549449f / 16.0f));
      const float ang = (float)pos * invf;
      float sn, cs; fsincos(ang, sn, cs);
      tab[i] = make_float2(cs, sn);
    }
  }
}

namespace pg8 {
#define PG8_LAS __attribute__((address_space(3)))
typedef unsigned short bf16_t;
typedef short bf16x8 __attribute__((ext_vector_type(8)));
typedef float f32x4 __attribute__((ext_vector_type(4)));
typedef unsigned u32x4 __attribute__((ext_vector_type(4)));
constexpr int BM = 256, BK = 64, HALF = 128, HTB = HALF * BK * 2  , STAGE_BYTES = 8 * HTB, NXCD = 8, WGM = 8;

__host__ __device__ __forceinline__ int lds_byte(int r, int c) { const int st = (r >> 4) * 2 + (c >> 5), rr = r & 15, cc = c & 31, ob = rr * 64 + cc * 2; return st * 1024 + (ob ^ (((ob >> 9) & 1) << 5)); }
__host__ __device__ __forceinline__ void stage_rc(int b, int& R, int& C) { const int st = b / 1024, sb = b % 1024, swz = sb ^ (((sb >> 9) & 1) << 5); R = (st >> 1) * 16 + swz / 64; C = (st & 1) * 32 + (swz % 64) / 2; }
__host__ __device__ __forceinline__ int perm32(int rho) { const int n = rho >> 4, i = rho & 15; return 8 * (i >> 2) + 4 * n + (i & 3); }

struct Unit { int pm, pn; };
struct Gemm { const bf16_t* A; const bf16_t* Bt; int M, N, K; };

__device__ __forceinline__ unsigned cvt_pk_bf16(float lo, float hi) { unsigned r; asm volatile("v_cvt_pk_bf16_f32 %0, %1, %2" : "=v"(r) : "v"(lo), "v"(hi)); return r; }

struct XcdOrder {
    int rpx, nN, x, c, ncu, skew;
    __device__ void init(int M, int N, int skew_ = 0) { rpx = (M / BM) / NXCD; nN = N / BM; x = blockIdx.x & 7; c = blockIdx.x >> 3; ncu = gridDim.x >> 3; skew = skew_; }
    __device__ bool next(int i, Unit& u) const {
        const int total = rpx * nN, full = (total / ncu) * ncu;
        int j = c + i * ncu;
        if (skew > 0 && j >= full) { const int cc = c - skew; j = (cc >= 0 && i == total / ncu) ? full + cc : total; }
        if (j >= total) return false; u.pm = rpx * x + (j % rpx); u.pn = j / rpx; return true; }
    __device__ __forceinline__ void a_ready(const Unit&) const {}
    __device__ __forceinline__ void done(const Unit&) const {}
};
struct EpiIn {
    static constexpr bool PERM = true, AFTER_DRAIN = false;
    bf16_t* O; int ldc; float* small; int small_pn;
    __device__ __forceinline__ void operator()(const f32x4 (&acc)[2][2][4][2], const Unit& u, int wr, int wc, int fr, int fq) const {
        const int row0 = u.pm * BM + wr * 64 + fr, col0 = u.pn * BM + wc * 32 + 8 * fq;
        if (u.pn == small_pn) {
            const int c = wc * 32 + 8 * fq;
            if (c < 48) {
#pragma unroll
                for (int ai = 0; ai < 2; ++ai)
#pragma unroll
                    for (int m = 0; m < 4; ++m) { float* rp = small + (size_t)(row0 + ai * HALF + m * 16) * 48 + c; *(f32x4*)rp = acc[ai][0][m][0]; *(f32x4*)(rp + 4) = acc[ai][0][m][1]; }
            }
            return;
        }
        const int act = (u.pn == 5 || u.pn == 6) ? 1 : ((u.pn == 21) ? 2 : 0);
#pragma unroll
        for (int ai = 0; ai < 2; ++ai)
#pragma unroll
            for (int m = 0; m < 4; ++m) { bf16_t* rowp = O + (size_t)(row0 + ai * HALF + m * 16) * ldc + col0;
#pragma unroll
                for (int bj = 0; bj < 2; ++bj) { f32x4 v0 = acc[ai][bj][m][0], v1 = acc[ai][bj][m][1];
                    if (act == 1) {
#pragma unroll
                        for (int e = 0; e < 4; ++e) {
                            v0[e] = v0[e] * __builtin_amdgcn_rcpf(1.f + __builtin_amdgcn_exp2f(fminf(-v0[e] * 1.4426950408889634f, 80.f))) * 0.08838834764831845f;
                            v1[e] = v1[e] * __builtin_amdgcn_rcpf(1.f + __builtin_amdgcn_exp2f(fminf(-v1[e] * 1.4426950408889634f, 80.f))) * 0.08838834764831845f; }
                    } else if (act == 2) { v0 = v0 * 0.125f; v1 = v1 * 0.125f; }
                    u32x4 w; w.x = cvt_pk_bf16(v0[0], v0[1]); w.y = cvt_pk_bf16(v0[2], v0[3]); w.z = cvt_pk_bf16(v1[0], v1[1]); w.w = cvt_pk_bf16(v1[2], v1[3]);
                    *(u32x4*)(rowp + bj * HALF) = w; } }
    }
};
struct EpiOut {
    static constexpr bool PERM = true, AFTER_DRAIN = false;
    const float* X; float* Y; int ldc; float alpha;
    __device__ __forceinline__ void operator()(const f32x4 (&acc)[2][2][4][2], const Unit& u, int wr, int wc, int fr, int fq) const {
        const int row0 = u.pm * BM + wr * 64 + fr, col0 = u.pn * BM + wc * 32 + 8 * fq;
#pragma unroll
        for (int ai = 0; ai < 2; ++ai)
#pragma unroll
            for (int m = 0; m < 4; ++m) { const size_t off = (size_t)(row0 + ai * HALF + m * 16) * ldc + col0;
#pragma unroll
                for (int bj = 0; bj < 2; ++bj) { const f32x4 x0 = *(const f32x4*)(X + off + bj * HALF), x1 = *(const f32x4*)(X + off + bj * HALF + 4);
                    *(f32x4*)(Y + off + bj * HALF) = x0 * alpha + acc[ai][bj][m][0]; *(f32x4*)(Y + off + bj * HALF + 4) = x1 * alpha + acc[ai][bj][m][1]; } }
    }
};

template <class Epi, class Sched, bool ALIGN_EPI = false, bool SP2 = false>
__device__ __forceinline__ void gemm_phase(PG8_LAS unsigned char* lds, const Gemm g, const Sched& S, const Epi& E) {
    const int tid = launder((int)threadIdx.x), wid = __builtin_amdgcn_readfirstlane(tid >> 6), lane = tid & 63, wr = wid >> 2, wc = wid & 3, fr = lane & 15, fq = lane >> 4;
    const int K = g.K, nt = K / BK;
    unsigned voffA[2], voffB[2];
#pragma unroll
    for (int i = 0; i < 2; ++i) { int R, C; stage_rc(tid * 16 + i * 8192, R, C); const int Rb = Epi::PERM ? ((R & ~31) + perm32(R & 31)) : R;
        voffA[i] = (unsigned)(R * K + C) * 2u; voffB[i] = (unsigned)(Rb * K + C) * 2u; }
    const size_t kstep = (size_t)(BK * 2);
    const size_t hstep = (size_t)HALF * K * 2;
    const size_t tstep = 2 * hstep;
    const unsigned ldsw = (unsigned)wid * 1024u;
    const int aoff = lds_byte(wr * 64 + fr, fq * 8), boff = lds_byte(wc * 32 + fr, fq * 8);
#define PG8_SA(b, h) (((b) * 2 + (h)) * HTB)
#define PG8_SB(b, h) ((4 + (b) * 2 + (h)) * HTB)
#define PG8_STAGE(bufoff, gbase, voff) do { _Pragma("unroll") for (int _i = 0; _i < 2; ++_i) \
        __builtin_amdgcn_global_load_lds((const unsigned*)((const char*)(gbase) + (voff)[_i]), (PG8_LAS unsigned*)(lds + (bufoff) + ldsw + _i * 8192), 16, 0, 0); } while (0)
#define PG8_LDA(dst, b, h) do { _Pragma("unroll") for (int m = 0; m < 4; ++m) _Pragma("unroll") for (int k = 0; k < 2; ++k) dst[m][k] = *(const PG8_LAS bf16x8*)(lds + PG8_SA(b, h) + aoff + m * 2048 + k * 1024); } while (0)
#define PG8_LDB(dst, b, h) do { _Pragma("unroll") for (int n = 0; n < 2; ++n) _Pragma("unroll") for (int k = 0; k < 2; ++k) dst[n][k] = *(const PG8_LAS bf16x8*)(lds + PG8_SB(b, h) + boff + n * 2048 + k * 1024); } while (0)
#define PG8_MMA(ai, bj, At, Bt) do { __builtin_amdgcn_s_setprio(1); _Pragma("unroll") for (int m = 0; m < 4; ++m) _Pragma("unroll") for (int n = 0; n < 2; ++n) _Pragma("unroll") for (int k = 0; k < 2; ++k) \
        acc[ai][bj][m][n] = __builtin_amdgcn_mfma_f32_16x16x32_bf16(Bt[n][k], At[m][k], acc[ai][bj][m][n], 0, 0, 0); __builtin_amdgcn_s_setprio(0); } while (0)
#define PG8_WAIT_V(n) asm volatile("s_waitcnt vmcnt(" #n ")" ::: "memory")
#define PG8_WAIT_L(n) asm volatile("s_waitcnt lgkmcnt(" #n ")" ::: "memory")
#define PG8_BAR __builtin_amdgcn_s_barrier()
#define PG8_SCHED __builtin_amdgcn_sched_barrier(0)
    Unit cur, nxt; int ui = 0;
    if (!S.next(0, cur)) return;
    f32x4 acc[2][2][4][2];
#pragma unroll
    for (int a = 0; a < 2; ++a)
#pragma unroll
        for (int b = 0; b < 2; ++b)
#pragma unroll
            for (int m = 0; m < 4; ++m)
#pragma unroll
                for (int n = 0; n < 2; ++n) acc[a][b][m][n] = (f32x4){0.f, 0.f, 0.f, 0.f};
    bf16x8 At[4][2], B0[2][2], B1[2][2];
    const char* cA = (const char*)g.A + (size_t)cur.pm * tstep; const char* cB = (const char*)g.Bt + (size_t)cur.pn * tstep;
    S.a_ready(cur);
    if constexpr (SP2) {
        PG8_STAGE(PG8_SB(0, 0), cB, voffB); PG8_STAGE(PG8_SB(0, 1), cB + hstep, voffB); PG8_STAGE(PG8_SA(0, 0), cA, voffA); PG8_STAGE(PG8_SA(0, 1), cA + hstep, voffA);
        if (wr == 1) PG8_BAR;
        PG8_WAIT_V(2); PG8_BAR;
        PG8_STAGE(PG8_SB(1, 0), cB + kstep, voffB); PG8_STAGE(PG8_SA(1, 0), cA + kstep, voffA); PG8_STAGE(PG8_SB(1, 1), cB + hstep + kstep, voffB);
        PG8_WAIT_V(6); PG8_BAR;
    } else {
        PG8_STAGE(PG8_SB(0, 0), cB, voffB); PG8_STAGE(PG8_SA(0, 0), cA, voffA); PG8_STAGE(PG8_SB(0, 1), cB + hstep, voffB); PG8_STAGE(PG8_SA(0, 1), cA + hstep, voffA);
        if (wr == 1) PG8_BAR;
        PG8_WAIT_V(4); PG8_BAR;
        PG8_STAGE(PG8_SB(1, 0), cB + kstep, voffB); PG8_STAGE(PG8_SA(1, 0), cA + kstep, voffA); PG8_STAGE(PG8_SB(1, 1), cB + hstep + kstep, voffB);
        PG8_WAIT_V(6); PG8_BAR;
    }
    for (;;) {
        const bool has_next = S.next(ui + 1, nxt);
        const char* nA = has_next ? (const char*)g.A + (size_t)nxt.pm * tstep : cA; const char* nB = has_next ? (const char*)g.Bt + (size_t)nxt.pn * tstep : cB;
        for (int t = 0; t < nt; t += 2) {
            const bool last = (t == nt - 2);
            const char* a1 = cA + (size_t)(t + 1) * kstep;
            const char* a2 = last ? nA : cA + (size_t)(t + 2) * kstep; const char* b2 = last ? nB : cB + (size_t)(t + 2) * kstep;
            const char* a3 = a2 + kstep; const char* b3 = b2 + kstep;
            if (last && has_next) S.a_ready(nxt);
            if constexpr (SP2) {
            PG8_LDB(B0, 0, 0); PG8_LDB(B1, 0, 1); PG8_SCHED; PG8_LDA(At, 0, 0); PG8_STAGE(PG8_SA(1, 1), a1 + hstep, voffA);
            PG8_WAIT_V(8); PG8_WAIT_L(0); PG8_BAR; PG8_MMA(0, 0, At, B0); PG8_MMA(0, 1, At, B1); PG8_BAR; PG8_SCHED;
            PG8_LDA(At, 0, 1); PG8_STAGE(PG8_SB(0, 0), b2, voffB); PG8_STAGE(PG8_SB(0, 1), b2 + hstep, voffB); PG8_STAGE(PG8_SA(0, 0), a2, voffA);
            PG8_WAIT_V(8); PG8_WAIT_L(0); PG8_BAR; PG8_MMA(1, 0, At, B0); PG8_MMA(1, 1, At, B1); PG8_BAR; PG8_SCHED;
            PG8_LDB(B0, 1, 0); PG8_LDB(B1, 1, 1); PG8_SCHED; PG8_LDA(At, 1, 0); PG8_STAGE(PG8_SA(0, 1), a2 + hstep, voffA);
            PG8_WAIT_V(8); PG8_WAIT_L(0); PG8_BAR; PG8_MMA(0, 0, At, B0); PG8_MMA(0, 1, At, B1); PG8_BAR; PG8_SCHED;
            PG8_LDA(At, 1, 1); PG8_STAGE(PG8_SB(1, 0), b3, voffB); PG8_STAGE(PG8_SB(1, 1), b3 + hstep, voffB); PG8_STAGE(PG8_SA(1, 0), a3, voffA);
            PG8_WAIT_V(8); PG8_WAIT_L(0); PG8_BAR; PG8_MMA(1, 0, At, B0); PG8_MMA(1, 1, At, B1); PG8_BAR; PG8_SCHED;
            } else {
            PG8_LDB(B0, 0, 0); PG8_SCHED; PG8_LDA(At, 0, 0); PG8_STAGE(PG8_SA(1, 1), a1 + hstep, voffA);
            PG8_WAIT_L(8); PG8_BAR; PG8_WAIT_L(0); PG8_MMA(0, 0, At, B0); PG8_BAR; PG8_SCHED;
            PG8_LDB(B1, 0, 1); PG8_STAGE(PG8_SB(0, 0), b2, voffB);
            PG8_BAR; PG8_WAIT_L(0); PG8_MMA(0, 1, At, B1); PG8_BAR;
            PG8_LDA(At, 0, 1); PG8_STAGE(PG8_SA(0, 0), a2, voffA);
            PG8_BAR; PG8_WAIT_L(0); PG8_MMA(1, 0, At, B0); PG8_BAR; PG8_SCHED;
            PG8_STAGE(PG8_SB(0, 1), b2 + hstep, voffB);
            PG8_WAIT_V(6); PG8_BAR; PG8_MMA(1, 1, At, B1); PG8_BAR;
            PG8_LDB(B0, 1, 0); PG8_SCHED; PG8_LDA(At, 1, 0); PG8_STAGE(PG8_SA(0, 1), a2 + hstep, voffA);
            PG8_WAIT_L(8); PG8_BAR; PG8_WAIT_L(0); PG8_MMA(0, 0, At, B0); PG8_BAR; PG8_SCHED;
            PG8_LDB(B1, 1, 1); PG8_STAGE(PG8_SB(1, 0), b3, voffB);
            PG8_BAR; PG8_WAIT_L(0); PG8_MMA(0, 1, At, B1); PG8_BAR;
            PG8_LDA(At, 1, 1); PG8_STAGE(PG8_SA(1, 0), a3, voffA);
            PG8_BAR; PG8_WAIT_L(0); PG8_MMA(1, 0, At, B0); PG8_BAR; PG8_SCHED;
            PG8_STAGE(PG8_SB(1, 1), b3 + hstep, voffB);
            PG8_WAIT_V(6); PG8_BAR; PG8_MMA(1, 1, At, B1); PG8_BAR;
            }
        }
        if constexpr (ALIGN_EPI) { if (wr == 0) PG8_BAR; }
        if constexpr (!Epi::AFTER_DRAIN) { E(acc, cur, wr, wc, fr, fq); S.done(cur); }
        if (!has_next) break;
#pragma unroll
        for (int a = 0; a < 2; ++a)
#pragma unroll
            for (int b = 0; b < 2; ++b)
#pragma unroll
                for (int m = 0; m < 4; ++m)
#pragma unroll
                    for (int n = 0; n < 2; ++n) acc[a][b][m][n] = (f32x4){0.f, 0.f, 0.f, 0.f};
        cur = nxt; cA = nA; cB = nB; ++ui;
        if constexpr (ALIGN_EPI) { if (wr == 1) PG8_BAR; }
    }
    PG8_WAIT_V(0);
    if constexpr (!ALIGN_EPI) { if (wr == 0) PG8_BAR; }
    PG8_BAR;
    if constexpr (Epi::AFTER_DRAIN) { E.fused(acc, cur, wr, wc, fr, fq, lds, wid, lane); S.done(cur); }
#undef PG8_SA
#undef PG8_SB
#undef PG8_STAGE
#undef PG8_LDA
#undef PG8_LDB
#undef PG8_MMA
#undef PG8_WAIT_V
#undef PG8_WAIT_L
#undef PG8_BAR
#undef PG8_SCHED
}
}

DEV void phase_inproj(const ParamsG& p, int l, int hf, int skew, unsigned char* smem) {
  pg8::Gemm g{(const bf16_t*)(p.ws + OFF_XB) + (size_t)hf * TH * DM, (const bf16_t*)(p.ws + OFF_WIN), TH, NPAD, DM};
  pg8::XcdOrder S; S.init(TH, NPAD, skew);
  pg8::EpiIn E{(bf16_t*)(p.ws + OFF_H), NPAD, (float*)(p.ws + OFF_SMALL), SM0 / 256};
  pg8::gemm_phase<pg8::EpiIn, pg8::XcdOrder, true, true>((PG8_LAS unsigned char*)smem, g, S, E);
}

DEV void phase_outproj(const ParamsG& p, int l, int hf, unsigned char* smem) {
  pg8::Gemm g{(const bf16_t*)(p.ws + OFF_MIXED), (const bf16_t*)(p.ws + OFF_WOUT), TH, DM, DI};
  pg8::XcdOrder S; S.init(TH, DM);
  const float* xin = (const float*)(((l == 0) ? p.x : (GAS const float*)p.out) + (size_t)hf * TH * DM);
  pg8::EpiOut E{xin, (float*)(p.out + (size_t)hf * TH * DM), DM, DN_ALPHA};
  pg8::gemm_phase<pg8::EpiOut, pg8::XcdOrder, true, true>((PG8_LAS unsigned char*)smem, g, S, E);
}

DEV void phase_ln(const ParamsG& p, int l, int hf) {
  const int tid = launder(threadIdx.x), lane = tid & 63, w = tid >> 6;
  const float* g = (const float*)(p.ln_g + l * DM); const float* b = (const float*)(p.ln_b + l * DM);
  bf16_t* xb = (bf16_t*)(p.ws + OFF_XB);
  for (int r0 = (blockIdx.x * 8 + w) * 4; r0 < TH; r0 += gridDim.x * 32) {
    f32x4 v[4][4];
#pragma unroll
    for (int i = 0; i < 4; ++i)
#pragma unroll
      for (int j = 0; j < 4; ++j) v[i][j] = ((const f32x4*)(p.out + (size_t)(hf * TH + r0 + i) * DM))[j * 64 + lane];
    f32x4 gg[4], bb[4];
#pragma unroll
    for (int j = 0; j < 4; ++j) { gg[j] = ((const f32x4*)g)[j * 64 + lane]; bb[j] = ((const f32x4*)b)[j * 64 + lane]; }
#pragma unroll
    for (int i = 0; i < 4; ++i) {
      const int row = hf * TH + r0 + i;
      float sm = 0.f;
#pragma unroll
      for (int j = 0; j < 4; ++j) sm += (v[i][j][0] + v[i][j][1]) + (v[i][j][2] + v[i][j][3]);
#pragma unroll
      for (int o = 32; o >= 1; o >>= 1) sm += __shfl_xor(sm, o);
      const float mu = sm * (1.f / DM);
      float q = 0.f;
#pragma unroll
      for (int j = 0; j < 4; ++j) { const f32x4 d = v[i][j] - mu; q += (d[0] * d[0] + d[1] * d[1]) + (d[2] * d[2] + d[3] * d[3]); }
#pragma unroll
      for (int o = 32; o >= 1; o >>= 1) q += __shfl_xor(q, o);
      const float rstd = rsqrtf(q * (1.f / DM) + 1e-5f);
#pragma unroll
      for (int j = 0; j < 4; ++j) {
        const f32x4 o = (v[i][j] - mu) * rstd * gg[j] + bb[j];
        ((f32x4*)(p.out + (size_t)row * DM))[j * 64 + lane] = o;
        if (l == 0) *(uint2*)(xb + (size_t)row * DM + (j * 64 + lane) * 4) = make_uint2(pk2(o[0], o[1]), pk2(o[2], o[3]));
      }
    }
  }
}

DEV void attn_item(const ParamsG& p, int l, int item, unsigned char* smem) {
  const int tid = launder(threadIdx.x), lane = tid & 63, w = tid >> 6, r = lane & 31, h = lane >> 5;
  const int qt = item & 15, head = (item >> 4) & 7, bl = item >> 7;
  const int kvh = head >> 2;
  bf16_t* Hh = (bf16_t*)(p.ws + OFF_H);
  const bf16_t* VT = (const bf16_t*)(p.ws + OFF_VT);
  const size_t rowbase = (size_t)bl * SEQ;
  float mq = fabsf(p.q_gain[l * 64 + lane]), mk = fabsf(p.k_gain[l * 64 + lane]);
#pragma unroll
  for (int o = 32; o >= 1; o >>= 1) { mq = fmaxf(mq, __shfl_xor(mq, o)); mk = fmaxf(mk, __shfl_xor(mk, o)); }
  const float M2 = 8.f * mq * mk * LOG2E * 1.01f;
  const int qrow = qt * 256 + w * 32 + r;
  const bf16_t* qp = Hh + (rowbase + qrow) * NPAD + A_Q + head * 64 + 8 * h;
  bf16x8 qf[4];
#pragma unroll
  for (int ks = 0; ks < 4; ++ks) qf[ks] = *(const bf16x8*)(qp + ks * 16);
  f32x16 o0 = zero16(), o1 = zero16();
  f32x2_t lsum2 = {0.f, 0.f};
  const int srow = tid >> 3, sch = (tid & 7) * 8;
  const bf16_t* kp = Hh + (rowbase + srow) * NPAD + A_K + kvh * 64 + sch;
  const bf16_t* vp = VT + ((size_t)((bl * 2 + kvh) * 64 + srow)) * SEQ + sch;
  union PB { bf16x8 v; unsigned u[4]; };
  auto qk = [&](int st, f32x16& s0, f32x16& s1) __attribute__((always_inline)) {
    const bf16_t* sK = (const bf16_t*)(smem + st * 18432);
#pragma unroll
    for (int i = 0; i < 16; ++i) { s0[i] = -M2; s1[i] = -M2; }
#pragma unroll
    for (int ks = 0; ks < 4; ++ks) {
      const bf16x8 a0 = *(const bf16x8*)(sK + r * 72 + ks * 16 + 8 * h);
      const bf16x8 a1 = *(const bf16x8*)(sK + (32 + r) * 72 + ks * 16 + 8 * h);
      s0 = __builtin_amdgcn_mfma_f32_32x32x16_bf16(a0, qf[ks], s0, 0, 0, 0);
      s1 = __builtin_amdgcn_mfma_f32_32x32x16_bf16(a1, qf[ks], s1, 0, 0, 0);
    }
  };
  auto soft = [&](f32x16& s0, f32x16& s1, PB (&pb)[2][2]) __attribute__((always_inline)) {
#pragma unroll
    for (int i = 0; i < 16; ++i) { s0[i] = __builtin_amdgcn_exp2f(s0[i]); s1[i] = __builtin_amdgcn_exp2f(s1[i]); lsum2 += (f32x2_t){s0[i], s1[i]}; }
#pragma unroll
    for (int s = 0; s < 2; ++s)
#pragma unroll
      for (int j = 0; j < 4; ++j) {
        pb[0][s].u[j] = pk2(s0[8 * s + 2 * j], s0[8 * s + 2 * j + 1]);
        pb[1][s].u[j] = pk2(s1[8 * s + 2 * j], s1[8 * s + 2 * j + 1]);
      }
  };
  auto pv = [&](int st, const PB (&pb)[2][2]) __attribute__((always_inline)) {
    const bf16_t* sV = (const bf16_t*)(smem + st * 18432 + 9216);
#pragma unroll
    for (int kt2 = 0; kt2 < 2; ++kt2)
#pragma unroll
      for (int s = 0; s < 2; ++s) {
        const int kb = kt2 * 32 + 16 * s + 4 * h;
        union { bf16x8 v; uint2 u[2]; } a0, a1;
        a0.u[0] = *(const uint2*)(sV + r * 72 + kb); a0.u[1] = *(const uint2*)(sV + r * 72 + kb + 8);
        a1.u[0] = *(const uint2*)(sV + (32 + r) * 72 + kb); a1.u[1] = *(const uint2*)(sV + (32 + r) * 72 + kb + 8);
        o0 = __builtin_amdgcn_mfma_f32_32x32x16_bf16(a0.v, pb[kt2][s].v, o0, 0, 0, 0);
        o1 = __builtin_amdgcn_mfma_f32_32x32x16_bf16(a1.v, pb[kt2][s].v, o1, 0, 0, 0);
      }
  };
  auto compute2 = [&](int sta, int stb) __attribute__((always_inline)) {
    f32x16 sa0, sa1, sb0, sb1; PB pa[2][2], pbb[2][2];
    qk(sta, sa0, sa1); qk(stb, sb0, sb1);
    soft(sa0, sa1, pa); pv(sta, pa);
    soft(sb0, sb1, pbb); pv(stb, pbb);
  };
  constexpr int NKT = SEQ / 64;
  auto sstore = [&](int st, const u32x4& kk, const u32x4& vv) __attribute__((always_inline)) {
    *(u32x4*)(smem + st * 18432 + srow * 144 + sch * 2) = kk;
    *(u32x4*)(smem + st * 18432 + 9216 + srow * 144 + sch * 2) = vv;
  };
  u32x4 k0 = *(const u32x4*)kp, v0 = *(const u32x4*)vp;
  u32x4 k1 = *(const u32x4*)(kp + (size_t)64 * NPAD), v1 = *(const u32x4*)(vp + 64);
  sstore(0, k0, v0); sstore(1, k1, v1);
  k0 = *(const u32x4*)(kp + (size_t)2 * 64 * NPAD); v0 = *(const u32x4*)(vp + 2 * 64);
  k1 = *(const u32x4*)(kp + (size_t)3 * 64 * NPAD); v1 = *(const u32x4*)(vp + 3 * 64);
  lds_barrier();
  for (int kt = 0; kt < NKT; kt += 4) {
    sstore(2, k0, v0); sstore(3, k1, v1);
    if (kt + 4 < NKT) {
      k0 = *(const u32x4*)(kp + (size_t)(kt + 4) * 64 * NPAD); v0 = *(const u32x4*)(vp + (kt + 4) * 64);
      k1 = *(const u32x4*)(kp + (size_t)(kt + 5) * 64 * NPAD); v1 = *(const u32x4*)(vp + (kt + 5) * 64);
    }
    compute2(0, 1);
    lds_barrier();
    if (kt + 4 < NKT) {
      sstore(0, k0, v0); sstore(1, k1, v1);
      if (kt + 6 < NKT) {
        k0 = *(const u32x4*)(kp + (size_t)(kt + 6) * 64 * NPAD); v0 = *(const u32x4*)(vp + (kt + 6) * 64);
        k1 = *(const u32x4*)(kp + (size_t)(kt + 7) * 64 * NPAD); v1 = *(const u32x4*)(vp + (kt + 7) * 64);
      }
    }
    compute2(2, 3);
    lds_barrier();
  }
  float lsum = lsum2[0] + lsum2[1];
  lsum += __shfl_xor(lsum, 32);
  const float inv = 1.f / lsum;
  const bf16_t* zp = Hh + (rowbase + qrow) * NPAD + A_Z + head * 64;
  bf16_t* op = Hh + (rowbase + qrow) * NPAD + A_Q + head * 64;
#pragma unroll
  for (int dt = 0; dt < 2; ++dt)
#pragma unroll
    for (int g = 0; g < 4; ++g) {
      const int d0 = dt * 32 + 8 * g + 4 * h;
      const uint2 zz = *(const uint2*)(zp + d0);
      const float z0 = bf2f((bf16_t)(zz.x & 0xffff)), z1 = bf2f((bf16_t)(zz.x >> 16)), z2 = bf2f((bf16_t)(zz.y & 0xffff)), z3 = bf2f((bf16_t)(zz.y >> 16));
      const f32x16& oo = dt ? o1 : o0;
      uint2 ov;
      ov.x = pk2(oo[4 * g + 0] * inv * fsilu(z0), oo[4 * g + 1] * inv * fsilu(z1));
      ov.y = pk2(oo[4 * g + 2] * inv * fsilu(z2), oo[4 * g + 3] * inv * fsilu(z3));
      *(uint2*)(op + d0) = ov;
    }
  lds_barrier();
}

constexpr int L_QT = 0, L_KT = 17408, L_QC = 34816, L_KHT = 52224, L_VT = 70656, L_ST = 89088,
              L_D = 123904, L_TOT = 124416, L_ACS = 128512, L_DT = 129024;

template <int K, int V> struct ScanGeom {
  static constexpr int KP = K + 8;
  static constexpr int NS = (K / 32) * (V / 32) / 8;
};

template <int K, int V>
DEV void scan_write_state(unsigned char* smem, const f32x16* S, int w, int lane) {
  constexpr int KP = K + 8, NS = ScanGeom<K, V>::NS, NVT = V / 32;
  bf16_t* sST = (bf16_t*)(smem + L_ST);
  const int c = lane & 31, h = lane >> 5;
#pragma unroll
  for (int i = 0; i < NS; ++i) {
    const int tile = w * NS + i, kt = tile / NVT, nt = tile % NVT;
#pragma unroll
    for (int g = 0; g < 4; ++g) {
      uint2 o; o.x = pk2(S[i][4 * g + 0], S[i][4 * g + 1]); o.y = pk2(S[i][4 * g + 2], S[i][4 * g + 3]);
      *(uint2*)(sST + (nt * 32 + c) * KP + kt * 32 + 8 * g + 4 * h) = o;
    }
  }
}

template <int K, int V, bool SSDM>
DEV void scan_core(unsigned char* smem, f32x16* S, bf16_t* orow0, int dir, int w, int lane, bool do_out, const float* sAcs) {
  constexpr int KP = K + 8, NS = ScanGeom<K, V>::NS, NVT = V / 32, NOT = 2 * NVT;
  const bf16_t* sQt = (const bf16_t*)(smem + L_QT); const bf16_t* sKt = (const bf16_t*)(smem + L_KT);
  const bf16_t* sQc = (const bf16_t*)(smem + L_QC); const bf16_t* sKhT = (const bf16_t*)(smem + L_KHT);
  const bf16_t* sVT = (const bf16_t*)(smem + L_VT);
  const bf16_t* sST = (const bf16_t*)(smem + L_ST); const float* sD = (const float*)(smem + L_D);
  const int c = lane & 31, h = lane >> 5;
  if (do_out && w < NOT) {
    const int tt = w / NVT, nt = w % NVT;
    f32x16 acc = zero16();
#pragma unroll
    for (int st = 0; st < 2; ++st) {
      if (st <= tt) {
        f32x16 pt = zero16();
        mma32<K>(pt, sKt + st * 32 * KP, KP, sQt + tt * 32 * KP, KP, lane);
        const int tau = tt * 32 + c;
        const float at = SSDM ? sAcs[tau] : 0.f;
#pragma unroll
        for (int reg = 0; reg < 16; ++reg) {
          const int sig = st * 32 + rowoff(reg, h);
          float v = pt[reg];
          if (SSDM) v *= ex2(at - sAcs[sig]);
          pt[reg] = (sig <= tau) ? v : 0.f;
        }
#pragma unroll
        for (int s2 = 0; s2 < 2; ++s2) {
          union { bf16x8 v; unsigned u[4]; } pa;
#pragma unroll
          for (int j = 0; j < 4; ++j) pa.u[j] = pk2(pt[8 * s2 + 2 * j], pt[8 * s2 + 2 * j + 1]);
          const int kb = st * 32 + 16 * s2 + 4 * h;
          union { bf16x8 v; uint2 u[2]; } vb;
          vb.u[0] = *(const uint2*)(sVT + (nt * 32 + c) * 72 + kb); vb.u[1] = *(const uint2*)(sVT + (nt * 32 + c) * 72 + kb + 8);
          acc = __builtin_amdgcn_mfma_f32_32x32x16_bf16(pa.v, vb.v, acc, 0, 0, 0);
        }
      }
    }
    mma32<K>(acc, sQc + tt * 32 * KP, KP, sST + nt * 32 * KP, KP, lane);
#pragma unroll
    for (int reg = 0; reg < 16; ++reg) {
      const int tau = tt * 32 + rowoff(reg, h);
      const int tok = dir ? (63 - tau) : tau;
      orow0[(size_t)tok * 512 + nt * 32 + c] = f2bf(acc[reg]);
    }
  }
#pragma unroll
  for (int i = 0; i < NS; ++i) {
    const int tile = w * NS + i, kt = tile / NVT, nt = tile % NVT;
#pragma unroll
    for (int reg = 0; reg < 16; ++reg) S[i][reg] *= sD[kt * 32 + rowoff(reg, h)];
    mma32<64>(S[i], sKhT + kt * 32 * 72, 72, sVT + nt * 32 * 72, 72, lane);
  }
}

template <int K, int V>
DEV void state_store(bf16_t* buf, const f32x16* S, int w, int lane) {
  constexpr int NS = ScanGeom<K, V>::NS, NVT = V / 32;
  const int c = lane & 31, h = lane >> 5;
#pragma unroll
  for (int i = 0; i < NS; ++i) {
    const int tile = w * NS + i, kt = tile / NVT, nt = tile % NVT;
#pragma unroll
    for (int reg = 0; reg < 16; ++reg) buf[(kt * 32 + rowoff(reg, h)) * V + nt * 32 + c] = f2bf(S[i][reg]);
  }
}
template <int K, int V>
DEV void state_load(const float* buf, f32x16* S, int w, int lane) {
  constexpr int NS = ScanGeom<K, V>::NS, NVT = V / 32;
  const int c = lane & 31, h = lane >> 5;
#pragma unroll
  for (int i = 0; i < NS; ++i) {
    const int tile = w * NS + i, kt = tile / NVT, nt = tile % NVT;
#pragma unroll
    for (int reg = 0; reg < 16; ++reg) S[i][reg] = buf[(kt * 32 + rowoff(reg, h)) * V + nt * 32 + c];
  }
}

template <int K, int V>
DEV void state_combine(const bf16_t* ubase, int ustride, const float* dbase, int seg, f32x16* S, int w, int lane) {
  constexpr int NS = ScanGeom<K, V>::NS, NVT = V / 32;
  const int c = lane & 31, h = lane >> 5;
  for (int j = 0; j < seg; ++j) {
    const bf16_t* buf = ubase + (size_t)j * ustride;
    const float* dj = dbase + j * 128;
    float u[NS][16]; f32x4 dv[NS][4];
#pragma unroll
    for (int i = 0; i < NS; ++i) {
      const int tile = w * NS + i, kt = tile / NVT, nt = tile % NVT;
#pragma unroll
      for (int g = 0; g < 4; ++g) dv[i][g] = *(const f32x4*)(dj + kt * 32 + 8 * g + 4 * h);
#pragma unroll
      for (int reg = 0; reg < 16; ++reg) u[i][reg] = bf2f(buf[(kt * 32 + rowoff(reg, h)) * V + nt * 32 + c]);
    }
#pragma unroll
    for (int i = 0; i < NS; ++i)
#pragma unroll
      for (int reg = 0; reg < 16; ++reg) S[i][reg] = (j > 0 ? dv[i][reg >> 2][reg & 3] * S[i][reg] : 0.f) + u[i][reg];
  }
}

#define PACK8_LO(v) (u32x4){((v)[0] & 0xffffu) | ((v)[1] << 16), ((v)[2] & 0xffffu) | ((v)[3] << 16), ((v)[4] & 0xffffu) | ((v)[5] << 16), ((v)[6] & 0xffffu) | ((v)[7] << 16)}
#define PACK8_HI(v) (u32x4){((v)[0] >> 16) | ((v)[1] & 0xffff0000u), ((v)[2] >> 16) | ((v)[3] & 0xffff0000u), ((v)[4] >> 16) | ((v)[5] & 0xffff0000u), ((v)[6] >> 16) | ((v)[7] & 0xffff0000u)}
#define CVT8(f) (u32x4){pk2((f)[0], (f)[1]), pk2((f)[2], (f)[3]), pk2((f)[4], (f)[5]), pk2((f)[6], (f)[7])}


DEV void hgrn_item(const ParamsG& p, int l, int it, int seg, int mode, unsigned char* smem) {
  const int bl = it >> 3, head = (it >> 1) & 3, dir = it & 1;
  const bool do_out = (mode == 3);
  constexpr int K = 128, V = 128, KPW = 68;
  const int tid = launder(threadIdx.x), lane = tid & 63, w = tid >> 6;
  const int cp = tid & 63, tg = tid >> 6, ch0 = 2 * cp;
  const bf16_t* Hh = (const bf16_t*)(p.ws + OFF_H);
  bf16_t* OB = (bf16_t*)(p.ws + OFF_OBUF) + (size_t)(0 * 2 + dir) * TH * 512;
  const size_t rowbase = (size_t)bl * SEQ;
  float lb0 = 0.f, lb1 = 0.f;
  if (l > 0) {
    lb0 = fsigmoid(p.lb_logits[512 + head * 128 + ch0] - p.lb_logits[head * 128 + ch0]);
    lb1 = fsigmoid(p.lb_logits[512 + head * 128 + ch0 + 1] - p.lb_logits[head * 128 + ch0 + 1]);
  }
  const float om0 = 1.f - lb0, om1 = 1.f - lb1;
  const int fbase = dir ? H_FB : H_FF;
  unsigned* sQt = (unsigned*)(smem + L_QT); unsigned* sKt = (unsigned*)(smem + L_KT); unsigned* sQc = (unsigned*)(smem + L_QC);
  bf16_t* sKhT = (bf16_t*)(smem + L_KHT); bf16_t* sVT = (bf16_t*)(smem + L_VT);
  float* sD = (float*)(smem + L_D); float* sTot = (float*)(smem + L_TOT);
  f32x16 S[2]; S[0] = zero16(); S[1] = zero16();
  bf16_t* sbuf = (bf16_t*)(p.ws + OFF_SB0) + ((size_t)it * NSEG + seg) * 16384;
  if (do_out) state_combine<K, V>((const bf16_t*)(p.ws + OFF_SB0) + (size_t)it * NSEG * 16384, 16384, (const float*)(p.ws + OFF_DB) + (size_t)it * NSEG * 128, seg, S, w, lane);
  float dlog0 = 0.f, dlog1 = 0.f;
  unsigned pf[8], qq[8], vv[8];
  float g0[8], g1[8], kx0[8], kx1[8];
  auto gloadA = [&](int cidx) __attribute__((always_inline)) {
    const int chunk = dir ? (63 - cidx) : cidx;
#pragma unroll
    for (int i = 0; i < 8; ++i) {
      const int tau = 8 * tg + i;
      const int tok = chunk * 64 + (dir ? (63 - tau) : tau);
      pf[i] = ((const unsigned*)(Hh + (rowbase + tok) * NPAD + head * 128 + fbase))[cp];
    }
  };
  auto gloadB = [&](int cidx) __attribute__((always_inline)) {
    const int chunk = dir ? (63 - cidx) : cidx;
#pragma unroll
    for (int i = 0; i < 8; ++i) {
      const int tau = 8 * tg + i;
      const int tok = chunk * 64 + (dir ? (63 - tau) : tau);
      const unsigned* rp = (const unsigned*)(Hh + (rowbase + tok) * NPAD + head * 128) + cp;
      vv[i] = rp[H_I / 2];
      qq[i] = do_out ? rp[H_Q / 2] : 0u;
    }
  };
  auto stage1 = [&]() __attribute__((always_inline)) {
    float r0 = 0.f, r1 = 0.f;
#pragma unroll
    for (int i = 0; i < 8; ++i) {
      const float e0 = ex2(fminf(-lo16(pf[i]) * LOG2E, 80.f)), e1 = ex2(fminf(-hi16(pf[i]) * LOG2E, 80.f));
      const float s0 = frcp(1.f + e0), s1 = frcp(1.f + e1);
      r0 += lg2(lb0 + om0 * s0); r1 += lg2(lb1 + om1 * s1);
      g0[i] = r0; g1[i] = r1;
      kx0[i] = om0 * e0 * s0; kx1[i] = om1 * e1 * s1;
    }
    *(float2*)(sTot + tg * 128 + ch0) = make_float2(r0, r1);
  };
  gloadA(seg * SLEN); gloadB(seg * SLEN);
  stage1();
  if (SLEN > 1) gloadA(seg * SLEN + 1);
  for (int ci = 0; ci < SLEN; ++ci) {
    const int cidx = seg * SLEN + ci;
    const int chunk = dir ? (63 - cidx) : cidx;
    lds_barrier();
    float off0 = 0.f, off1 = 0.f, ref0 = 0.f, ref1 = 0.f, be0 = 0.f, be1 = 0.f;
#pragma unroll
    for (int j = 0; j < 8; ++j) {
      const float2 t = *(const float2*)(sTot + j * 128 + ch0);
      if (j < tg) { off0 += t.x; off1 += t.y; }
      if (j < 4) { ref0 += t.x; ref1 += t.y; }
      be0 += t.x; be1 += t.y;
    }
    dlog0 += be0; dlog1 += be1;
    const float eref0 = ex2(ref0), eref1 = ex2(ref1), ebr0 = ex2(be0 - ref0), ebr1 = ex2(be1 - ref1);
    const float d0 = off0 - ref0, d1 = off1 - ref1;
    float kh0[8], kh1[8];
#pragma unroll
    for (int i = 0; i < 8; ++i) {
      const int tau = 8 * tg + i;
      const float E0 = ex2(g0[i] + d0), E1 = ex2(g1[i] + d1);
      const float kt0 = kx0[i] * frcp(E0), kt1 = kx1[i] * frcp(E1);
      if (do_out) {
        const float qt0 = lo16(qq[i]) * E0, qt1 = hi16(qq[i]) * E1;
        sQt[tau * KPW + cp] = pk2(qt0, qt1);
        sKt[tau * KPW + cp] = pk2(kt0, kt1);
        sQc[tau * KPW + cp] = pk2(qt0 * eref0, qt1 * eref1);
      }
      kh0[i] = kt0 * ebr0; kh1[i] = kt1 * ebr1;
    }
    *(u32x4*)(sKhT + ch0 * 72 + 8 * tg) = CVT8(kh0);
    *(u32x4*)(sKhT + (ch0 + 1) * 72 + 8 * tg) = CVT8(kh1);
    *(u32x4*)(sVT + ch0 * 72 + 8 * tg) = PACK8_LO(vv);
    *(u32x4*)(sVT + (ch0 + 1) * 72 + 8 * tg) = PACK8_HI(vv);
    if (tg == 0) *(float2*)(sD + ch0) = make_float2(ex2(be0), ex2(be1));
    if (do_out) scan_write_state<K, V>(smem, S, w, lane);
    if (ci + 1 < SLEN) gloadB(cidx + 1);
    lds_barrier();
    scan_core<K, V, false>(smem, S, OB + (rowbase + (size_t)chunk * 64) * 512 + head * 128, dir, w, lane, do_out, nullptr);
    if (ci + 1 < SLEN) { stage1(); if (ci + 2 < SLEN) gloadA(cidx + 2); }
  }
  if (!do_out) {
    state_store<K, V>(sbuf, S, w, lane);
    if (tg == 0) *(float2*)((float*)(p.ws + OFF_DB) + ((size_t)it * NSEG + seg) * 128 + ch0) = make_float2(ex2(dlog0), ex2(dlog1));
  }
  lds_barrier();
}

DEV void gla_item(const ParamsG& p, int l, int it, int seg, int mode, unsigned char* smem) {
  const int j16 = it - 16, bl = j16 >> 3, head = (j16 >> 1) & 3, dir = j16 & 1;
  const bool do_out = (mode == 3);
  constexpr int K = 64, V = 128, KPW = 36;
  const int tid = launder(threadIdx.x), lane = tid & 63, w = tid >> 6;
  const int cp = tid & 31, tg = tid >> 5, ch0 = 2 * cp;
  const int vp2 = tid & 63, vg = tid >> 6;
  const bf16_t* Hh = (const bf16_t*)(p.ws + OFF_H);
  const bf16_t* Gb = (const bf16_t*)(p.ws + OFF_G);
  bf16_t* OB = (bf16_t*)(p.ws + OFF_OBUF) + (size_t)(2 * 2 + dir) * TH * 512;
  const size_t rowbase = (size_t)bl * SEQ;
  unsigned* sQt = (unsigned*)(smem + L_QT); unsigned* sKt = (unsigned*)(smem + L_KT); unsigned* sQc = (unsigned*)(smem + L_QC);
  bf16_t* sKhT = (bf16_t*)(smem + L_KHT); bf16_t* sVT = (bf16_t*)(smem + L_VT);
  float* sD = (float*)(smem + L_D); float* sTot = (float*)(smem + L_TOT);
  f32x16 S[1]; S[0] = zero16();
  bf16_t* sbuf = (bf16_t*)(p.ws + OFF_SB1) + ((size_t)j16 * NSEG + seg) * 8192;
  if (do_out) state_combine<K, V>((const bf16_t*)(p.ws + OFF_SB1) + (size_t)j16 * NSEG * 8192, 8192, (const float*)(p.ws + OFF_DB) + (size_t)it * NSEG * 128, seg, S, w, lane);
  float dlog0 = 0.f, dlog1 = 0.f;
  unsigned pg[4];
  float g0[4], g1[4]; unsigned kk[4], qq[4], vv[8];
  auto gloadA = [&](int cidx) __attribute__((always_inline)) {
    const int chunk = dir ? (63 - cidx) : cidx;
#pragma unroll
    for (int i = 0; i < 4; ++i) {
      const int tau = 4 * tg + i;
      const int tok = chunk * 64 + (dir ? (63 - tau) : tau);
      pg[i] = ((const unsigned*)(Gb + (rowbase + tok) * 512 + dir * 256 + head * 64))[cp];
    }
  };
  auto gloadB = [&](int cidx) __attribute__((always_inline)) {
    const int chunk = dir ? (63 - cidx) : cidx;
#pragma unroll
    for (int i = 0; i < 4; ++i) {
      const int tau = 4 * tg + i;
      const int tok = chunk * 64 + (dir ? (63 - tau) : tau);
      const unsigned* rp = (const unsigned*)(Hh + (rowbase + tok) * NPAD + head * 64) + cp;
      kk[i] = rp[G_K / 2]; qq[i] = do_out ? rp[G_Q / 2] : 0u;
    }
#pragma unroll
    for (int i = 0; i < 8; ++i) {
      const int tau = 8 * vg + i;
      const int tok = chunk * 64 + (dir ? (63 - tau) : tau);
      vv[i] = ((const unsigned*)(Hh + (rowbase + tok) * NPAD + G_V + head * 128))[vp2];
    }
  };
  auto stage1 = [&]() __attribute__((always_inline)) {
    float r0 = 0.f, r1 = 0.f;
#pragma unroll
    for (int i = 0; i < 4; ++i) { r0 += lo16(pg[i]); r1 += hi16(pg[i]); g0[i] = r0; g1[i] = r1; }
    *(float2*)(sTot + tg * 64 + ch0) = make_float2(r0, r1);
  };
  gloadA(seg * SLEN); gloadB(seg * SLEN);
  stage1();
  if (SLEN > 1) gloadA(seg * SLEN + 1);
  for (int ci = 0; ci < SLEN; ++ci) {
    const int cidx = seg * SLEN + ci;
    const int chunk = dir ? (63 - cidx) : cidx;
    lds_barrier();
    float off0 = 0.f, off1 = 0.f, ref0 = 0.f, ref1 = 0.f, be0 = 0.f, be1 = 0.f;
#pragma unroll
    for (int j = 0; j < 16; ++j) {
      const float2 t = *(const float2*)(sTot + j * 64 + ch0);
      if (j < tg) { off0 += t.x; off1 += t.y; }
      if (j < 8) { ref0 += t.x; ref1 += t.y; }
      be0 += t.x; be1 += t.y;
    }
    dlog0 += be0; dlog1 += be1;
    const float eref0 = ex2(ref0), eref1 = ex2(ref1), ebr0 = ex2(be0 - ref0), ebr1 = ex2(be1 - ref1);
    const float d0 = off0 - ref0, d1 = off1 - ref1;
    float kh0[4], kh1[4];
#pragma unroll
    for (int i = 0; i < 4; ++i) {
      const int tau = 4 * tg + i;
      const float E0 = ex2(g0[i] + d0), E1 = ex2(g1[i] + d1);
      const float kt0 = lo16(kk[i]) * frcp(E0), kt1 = hi16(kk[i]) * frcp(E1);
      if (do_out) {
        const float qt0 = lo16(qq[i]) * E0, qt1 = hi16(qq[i]) * E1;
        sQt[tau * KPW + cp] = pk2(qt0, qt1);
        sKt[tau * KPW + cp] = pk2(kt0, kt1);
        sQc[tau * KPW + cp] = pk2(qt0 * eref0, qt1 * eref1);
      }
      kh0[i] = kt0 * ebr0; kh1[i] = kt1 * ebr1;
    }
    *(uint2*)(sKhT + ch0 * 72 + 4 * tg) = make_uint2(pk2(kh0[0], kh0[1]), pk2(kh0[2], kh0[3]));
    *(uint2*)(sKhT + (ch0 + 1) * 72 + 4 * tg) = make_uint2(pk2(kh1[0], kh1[1]), pk2(kh1[2], kh1[3]));
    *(u32x4*)(sVT + (2 * vp2) * 72 + 8 * vg) = PACK8_LO(vv);
    *(u32x4*)(sVT + (2 * vp2 + 1) * 72 + 8 * vg) = PACK8_HI(vv);
    if (tg == 0) *(float2*)(sD + ch0) = make_float2(ex2(be0), ex2(be1));
    if (do_out) scan_write_state<K, V>(smem, S, w, lane);
    if (ci + 1 < SLEN) gloadB(cidx + 1);
    lds_barrier();
    scan_core<K, V, false>(smem, S, OB + (rowbase + (size_t)chunk * 64) * 512 + head * 128, dir, w, lane, do_out, nullptr);
    if (ci + 1 < SLEN) { stage1(); if (ci + 2 < SLEN) gloadA(cidx + 2); }
  }
  if (!do_out) {
    state_store<K, V>(sbuf, S, w, lane);
    if (tg == 0) *(float2*)((float*)(p.ws + OFF_DB) + ((size_t)it * NSEG + seg) * 128 + ch0) = make_float2(ex2(dlog0), ex2(dlog1));
  }
  lds_barrier();
}

DEV void ssd_item(const ParamsG& p, int l, int it, int seg, int mode, unsigned char* smem) {
  const int j32 = it - 32, bl = j32 >> 4, head = (j32 >> 1) & 7, dir = j32 & 1;
  const bool do_out = (mode == 3);
  constexpr int K = 128, V = 64, KPW = 68;
  const int tid = launder(threadIdx.x), lane = tid & 63, w = tid >> 6;
  const int cp = tid & 63, tg = tid >> 6, n0 = 2 * cp;
  const int xp = tid & 31, xg = tid >> 5;
  const int grp = head >> 2;
  const bf16_t* U = (const bf16_t*)(p.ws + OFF_U);
  const float* SMALL = (const float*)(p.ws + OFF_SMALL);
  bf16_t* OB = (bf16_t*)(p.ws + OFF_OBUF) + (size_t)(1 * 2 + dir) * TH * 512;
  const size_t rowbase = (size_t)bl * SEQ;
  unsigned* sQt = (unsigned*)(smem + L_QT); unsigned* sKt = (unsigned*)(smem + L_KT); unsigned* sQc = (unsigned*)(smem + L_QC);
  bf16_t* sKhT = (bf16_t*)(smem + L_KHT); bf16_t* sVT = (bf16_t*)(smem + L_VT);
  float* sD = (float*)(smem + L_D);
  const float dtb = p.dt_bias[(l * 2 + dir) * 8 + head];
  const float Acoef = -__expf(p.a_log[(l * 2 + dir) * 8 + head]) * LOG2E;
  f32x16 S[1]; S[0] = zero16();
  bf16_t* sbuf = (bf16_t*)(p.ws + OFF_SB2) + ((size_t)j32 * NSEG + seg) * 8192;
  if (do_out) state_combine<K, V>((const bf16_t*)(p.ws + OFF_SB2) + (size_t)j32 * NSEG * 8192, 8192, (const float*)(p.ws + OFF_DB) + (size_t)it * NSEG * 128, seg, S, w, lane);
  float dlog = 0.f;
  unsigned bb[8], cc[8], xx[4];
  float rdt = 0.f;
  auto gloadA = [&](int cidx) __attribute__((always_inline)) {
    const int chunk = dir ? (63 - cidx) : cidx;
    if (w == 0) {
      const int tok = chunk * 64 + (dir ? (63 - lane) : lane);
      rdt = SMALL[(rowbase + tok) * 48 + dir * 8 + head];
    }
  };
  auto gloadB = [&](int cidx) __attribute__((always_inline)) {
    const int chunk = dir ? (63 - cidx) : cidx;
#pragma unroll
    for (int i = 0; i < 8; ++i) {
      const int tau = 8 * tg + i;
      const int tok = chunk * 64 + (dir ? (63 - tau) : tau);
      const unsigned* rp = (const unsigned*)(U + (rowbase + tok) * 1024 + grp * 128) + cp;
      bb[i] = rp[512 / 2]; cc[i] = do_out ? rp[768 / 2] : 0u;
    }
#pragma unroll
    for (int i = 0; i < 4; ++i) {
      const int tau = 4 * xg + i;
      const int tok = chunk * 64 + (dir ? (63 - tau) : tau);
      xx[i] = ((const unsigned*)(U + (rowbase + tok) * 1024 + head * 64))[xp];
    }
  };
  auto stage1 = [&](int par) __attribute__((always_inline)) {
    if (w == 0) {
      const float xv = rdt + dtb;
      const float dt = (xv > 20.f) ? xv : log1pf(__expf(xv));
      float a = dt * Acoef;
#pragma unroll
      for (int o = 1; o < 64; o <<= 1) { const float t = __shfl_up(a, o); if (lane >= o) a += t; }
      ((float*)(smem + L_ACS))[par * 64 + lane] = a; ((float*)(smem + L_DT))[par * 64 + lane] = dt;
    }
  };
  gloadA(seg * SLEN); gloadB(seg * SLEN);
  stage1(0);
  if (SLEN > 1) gloadA(seg * SLEN + 1);
  for (int ci = 0; ci < SLEN; ++ci) {
    const int cidx = seg * SLEN + ci;
    const int chunk = dir ? (63 - cidx) : cidx;
    const float* sAcs = (const float*)(smem + L_ACS) + (ci & 1) * 64;
    const float* sDt = (const float*)(smem + L_DT) + (ci & 1) * 64;
    lds_barrier();
    const float aend = sAcs[63];
    dlog += aend;
    {
      float kh0[8], kh1[8];
#pragma unroll
      for (int i = 0; i < 8; ++i) {
        const int tau = 8 * tg + i;
        const float ac = sAcs[tau];
        const float eb = ex2(aend - ac);
        kh0[i] = lo16(bb[i]) * eb; kh1[i] = hi16(bb[i]) * eb;
        if (do_out) {
          const float ea = ex2(ac);
          sKt[tau * KPW + cp] = bb[i];
          sQt[tau * KPW + cp] = cc[i];
          sQc[tau * KPW + cp] = pk2(lo16(cc[i]) * ea, hi16(cc[i]) * ea);
        }
      }
      *(u32x4*)(sKhT + n0 * 72 + 8 * tg) = CVT8(kh0);
      *(u32x4*)(sKhT + (n0 + 1) * 72 + 8 * tg) = CVT8(kh1);
      float x0[4], x1[4];
#pragma unroll
      for (int i = 0; i < 4; ++i) { const float dtv = sDt[4 * xg + i]; x0[i] = lo16(xx[i]) * dtv; x1[i] = hi16(xx[i]) * dtv; }
      *(uint2*)(sVT + (2 * xp) * 72 + 4 * xg) = make_uint2(pk2(x0[0], x0[1]), pk2(x0[2], x0[3]));
      *(uint2*)(sVT + (2 * xp + 1) * 72 + 4 * xg) = make_uint2(pk2(x1[0], x1[1]), pk2(x1[2], x1[3]));
      if (tg == 0) *(float2*)(sD + n0) = make_float2(ex2(aend), ex2(aend));
    }
    if (do_out) scan_write_state<K, V>(smem, S, w, lane);
    if (ci + 1 < SLEN) gloadB(cidx + 1);
    lds_barrier();
    scan_core<K, V, true>(smem, S, OB + (rowbase + (size_t)chunk * 64) * 512 + head * 64, dir, w, lane, do_out, sAcs);
    if (ci + 1 < SLEN) { stage1((ci + 1) & 1); if (ci + 2 < SLEN) gloadA(cidx + 2); }
  }
  if (!do_out) {
    state_store<K, V>(sbuf, S, w, lane);
    if (tg == 0) *(float2*)((float*)(p.ws + OFF_DB) + ((size_t)it * NSEG + seg) * 128 + n0) = make_float2(ex2(dlog), ex2(dlog));
  }
  lds_barrier();
}

DEV void phase_prep(const ParamsG& p, int l, int hf, int rep, unsigned char* smem) {
  const int tid = launder(threadIdx.x), lane = tid & 63;
  bf16_t* Hh = (bf16_t*)(p.ws + OFF_H);
  bf16_t* U = (bf16_t*)(p.ws + OFF_U);
  bf16_t* Gb = (bf16_t*)(p.ws + OFF_G);
  bf16_t* VT = (bf16_t*)(p.ws + OFF_VT);
  const float* SMALLp = (const float*)(p.ws + OFF_SMALL);
  float2* stab = (float2*)smem;
  float* slow = (float*)(smem + 8192);
  bf16_t* sT = (bf16_t*)(smem + 12288);
  {
    const float2* tabg = (const float2*)(p.ws + OFF_TAB);
    for (int i = tid; i < 1024; i += NT) stab[i] = tabg[i];
  }
  const int cg8 = (tid & 127) * 8, rsub = tid >> 7;
  const float* cw = (const float*)(p.conv_w + (size_t)l * 5 * 1024); const float* cb = (const float*)(p.conv_b + (size_t)l * 1024);
  float wv[5][8], bv[8];
#pragma unroll
  for (int j = 0; j < 5; ++j)
#pragma unroll
    for (int e = 0; e < 8; ++e) wv[j][e] = cw[j * 1024 + cg8 + e];
#pragma unroll
  for (int e = 0; e < 8; ++e) bv[e] = cb[cg8 + e];
  const int gd = tid >> 8, gc = tid & 255;
  const int i16 = lane & 15;
  const float* gq = (const float*)(p.q_gain + l * 64 + 4 * i16); const float* gk = (const float*)(p.k_gain + l * 64 + 4 * i16);
  const float gqv[4] = {gq[0], gq[1], gq[2], gq[3]}, gkv[4] = {gk[0], gk[1], gk[2], gk[3]};
  for (int grp = blockIdx.x; grp < TH / 32; grp += gridDim.x) {
    const int r0 = grp * 32;
    lds_barrier();
    const u32x4 vt = *(const u32x4*)(Hh + (size_t)(r0 + (tid >> 4)) * NPAD + A_V + (tid & 15) * 8);
    const float2 lowv = *(const float2*)(SMALLp + (size_t)(r0 + (tid >> 4)) * 48 + 16 + (tid & 15) * 2);
    *(u32x4*)(sT + (tid >> 4) * 136 + (tid & 15) * 8) = vt;
    *(float2*)(slow + (tid >> 4) * 32 + (tid & 15) * 2) = lowv;
#pragma unroll 1
    for (int ps = 0; ps < 2; ++ps) {
      const int ra = r0 + 16 * ps + 4 * rsub, ta = ra & (SEQ - 1);
      u32x4 xc[8];
#pragma unroll
      for (int m = 0; m < 8; ++m) {
        const int sq = ta + m - 2;
        xc[m] = (u32x4){0u, 0u, 0u, 0u};
        if (sq >= 0 && sq < SEQ) xc[m] = *(const u32x4*)(Hh + (size_t)(ra + m - 2) * NPAD + S_X + cg8);
      }
#pragma unroll
      for (int o4 = 0; o4 < 4; ++o4) {
        float u[8];
#pragma unroll
        for (int e = 0; e < 8; ++e) u[e] = bv[e];
#pragma unroll
        for (int j = 0; j < 5; ++j)
#pragma unroll
          for (int e = 0; e < 4; ++e) { u[2 * e] += wv[j][2 * e] * lo16(xc[o4 + j][e]); u[2 * e + 1] += wv[j][2 * e + 1] * hi16(xc[o4 + j][e]); }
        u32x4 o;
#pragma unroll
        for (int e = 0; e < 4; ++e) {
          const float a = u[2 * e] * frcp(1.f + ex2(fminf(-u[2 * e] * LOG2E, 80.f)));
          const float b = u[2 * e + 1] * frcp(1.f + ex2(fminf(-u[2 * e + 1] * LOG2E, 80.f)));
          o[e] = pk2(a, b);
        }
        *(u32x4*)(U + (size_t)(ra + o4) * 1024 + cg8) = o;
      }
    }
    lds_barrier();
    if (rep == 0) {
#pragma unroll 1
      for (int ub = 0; ub < 10; ub += 5) {
        uint2 xq[5];
#pragma unroll
        for (int u = 0; u < 5; ++u) {
          const int pi = (ub + u) * 32 + (tid >> 4), row = r0 + pi / 10, hd = pi % 10;
          xq[u] = *(const uint2*)(Hh + (size_t)row * NPAD + ((hd < 8) ? (A_Q + hd * 64) : (A_K + (hd - 8) * 64)) + 4 * i16);
        }
#pragma unroll
        for (int u = 0; u < 5; ++u) {
          const int pi = (ub + u) * 32 + (tid >> 4), row = r0 + pi / 10, hd = pi % 10;
          const bool isq = hd < 8;
          const float x[4] = {lo16(xq[u].x), hi16(xq[u].x), lo16(xq[u].y), hi16(xq[u].y)};
          float ss = x[0] * x[0] + x[1] * x[1] + x[2] * x[2] + x[3] * x[3];
          ss += __shfl_xor(ss, 1); ss += __shfl_xor(ss, 2); ss += __shfl_xor(ss, 4); ss += __shfl_xor(ss, 8);
          const float rstd = rsqrtf(ss * (1.f / 64.f) + 1e-6f);
          const int t = row & (SEQ - 1);
          const int pos = (i16 < 8) ? (t >> 6) : (t & 63);
          const float osc = isq ? QSCALE : 1.f;
          float o[4];
#pragma unroll
          for (int e = 0; e < 4; ++e) {
            const float v = x[e] * rstd * (isq ? gqv[e] : gkv[e]);
            const float pv = __shfl_xor(v, 4);
            const float2 cs = stab[pos * 16 + 4 * (i16 & 3) + e];
            o[e] = ((i16 & 4) ? (v * cs.x + pv * cs.y) : (v * cs.x - pv * cs.y)) * osc;
          }
          *(uint2*)(Hh + (size_t)row * NPAD + (isq ? (A_Q + hd * 64) : (A_K + (hd - 8) * 64)) + 4 * i16) = make_uint2(pk2(o[0], o[1]), pk2(o[2], o[3]));
        }
      }
    }
    float w2c[16];
#pragma unroll
    for (int r = 0; r < 16; ++r) w2c[r] = p.gk_w2[((size_t)(l * 2 + gd) * 16 + r) * 256 + gc];
    const float gbias = p.gk_b[(l * 2 + gd) * 256 + gc];
#pragma unroll 4
    for (int rr = 0; rr < 32; ++rr) {
      const float4* lp4 = (const float4*)(slow + rr * 32 + gd * 16);
      float gkk = gbias;
#pragma unroll
      for (int r4 = 0; r4 < 4; ++r4) { const float4 lw = lp4[r4]; gkk += lw.x * w2c[4 * r4] + lw.y * w2c[4 * r4 + 1] + lw.z * w2c[4 * r4 + 2] + lw.w * w2c[4 * r4 + 3]; }
      const float l2 = (fminf(gkk, 0.f) * LOG2E - lg2(1.f + ex2(-fabsf(gkk) * LOG2E))) * (1.f / 16.f);
      Gb[(size_t)(r0 + rr) * 512 + tid] = f2bf(l2);
    }
    {
      const int c = tid >> 2, tq = (tid & 3) * 8;
      unsigned v[8];
#pragma unroll
      for (int i = 0; i < 8; ++i) v[i] = sT[(tq + i) * 136 + c];
      const int bl = r0 >> 12, t0 = (r0 & (SEQ - 1)) + tq;
      *(u32x4*)(VT + ((size_t)((bl * 2 + (c >> 6)) * 64 + (c & 63))) * SEQ + t0) = (u32x4){v[0] | (v[1] << 16), v[2] | (v[3] << 16), v[4] | (v[5] << 16), v[6] | (v[7] << 16)};
    }
  }
  lds_barrier();
}

DEV void phase_mix(const ParamsG& p, int l, int hf, int slot, int mode, int att_lo, int att_hi, int vid_lo, int vid_hi, unsigned char* smem) {
  unsigned* ctr = (unsigned*)(p.ws + OFF_CTRL) + CTR_WORD0 + slot * 16;
  volatile int* sItem = (volatile int*)(smem + LDS_BYTES - 16);
  const int n_scan = 64 * NSEG;
  int hi = n_scan + (att_hi - att_lo); if (vid_hi < hi) hi = vid_hi;
  for (;;) {
    lds_barrier();
    if (threadIdx.x == 0) *sItem = vid_lo + (int)atomicAdd(ctr, 1u);
    lds_barrier();
    const int vid = *sItem;
    if (vid >= hi) break;
    if (vid < n_scan) {
      int seg = vid >> 6, it = vid & 63;
      {
        if (vid < 16 * NSEG) { it = vid & 15; seg = vid >> 4; }
        else if (vid < 48 * NSEG) { const int v2 = vid - 16 * NSEG; it = 32 + (v2 & 31); seg = v2 >> 5; }
        else { const int v2 = vid - 48 * NSEG; it = 16 + (v2 & 15); seg = v2 >> 4; }
      }
      if (mode == 1 && seg == NSEG - 1) continue;
#if PROBE_REP > 0
      if (slot >= 40 && PROBE_TYPE >= 0 && ((it < 16) ? 0 : (it < 32) ? 1 : 2) != PROBE_TYPE) continue;
#endif
      if (it < 16) { if (PH_MASK & 0x100) hgrn_item(p, l, it, seg, mode, smem); }
      else if (it < 32) { if (PH_MASK & 0x200) gla_item(p, l, it, seg, mode, smem); }
      else { if (PH_MASK & 0x400) ssd_item(p, l, it, seg, mode, smem); }
    } else { if (PH_MASK & 0x800) attn_item(p, l, att_lo + (vid - n_scan), smem); }
  }
}

DEV void phase_scan2(const ParamsG& p) {
  const size_t gtid = (size_t)blockIdx.x * NT + threadIdx.x, gsz = (size_t)gridDim.x * NT;
  const float* DB = (const float*)(p.ws + OFF_DB);
  for (size_t e = gtid; e < 655360; e += gsz) {
    float* buf; const float* dp; int stride;
    if (e < 262144) { const int it = (int)(e >> 14), idx = (int)(e & 16383); buf = (float*)(p.ws + OFF_SB0) + (size_t)it * NSEG * 16384 + idx; stride = 16384; dp = DB + (size_t)it * NSEG * 128 + (idx >> 7); }
    else if (e < 393216) { const int e2 = (int)(e - 262144), j = e2 >> 13, idx = e2 & 8191; buf = (float*)(p.ws + OFF_SB1) + (size_t)j * NSEG * 8192 + idx; stride = 8192; dp = DB + (size_t)(16 + j) * NSEG * 128 + (idx >> 7); }
    else { const int e3 = (int)(e - 393216), j = e3 >> 13, idx = e3 & 8191; buf = (float*)(p.ws + OFF_SB2) + (size_t)j * NSEG * 8192 + idx; stride = 8192; dp = DB + (size_t)(32 + j) * NSEG * 128 + (idx >> 6); }
    float u[NSEG - 1], d[NSEG - 1];
#pragma unroll
    for (int sg = 0; sg < NSEG - 1; ++sg) { u[sg] = buf[(size_t)sg * stride]; d[sg] = dp[sg * 128]; }
    float st = 0.f;
#pragma unroll
    for (int sg = 0; sg < NSEG; ++sg) { buf[(size_t)sg * stride] = st; if (sg < NSEG - 1) st = d[sg] * st + u[sg]; }
  }
}

DEV float bfe(const u32x4& v, int j) { return (j & 1) ? hi16(v[j >> 1]) : lo16(v[j >> 1]); }
DEV void phase_fin(const ParamsG& p, int l, int hf) {
  const int tid = launder(threadIdx.x), lane = tid & 63, w = tid >> 6;
  const bf16_t* Hh = (const bf16_t*)(p.ws + OFF_H);
  const bf16_t* OB = (const bf16_t*)(p.ws + OFF_OBUF);
  bf16_t* MX = (bf16_t*)(p.ws + OFF_MIXED);
  const int c0 = lane * 8;
  const float* cw = (const float*)(p.conv_w + (size_t)l * 5 * 1024); const float* cb = (const float*)(p.conv_b + (size_t)l * 1024);
  for (int r0 = (blockIdx.x * 8 + w) * 4; r0 < TH; r0 += gridDim.x * 32) {
    {
      u32x4 at[4], a[4], b[4], z[4];
#pragma unroll
      for (int i = 0; i < 4; ++i) {
        const bf16_t* hrow = Hh + (size_t)(r0 + i) * NPAD;
        at[i] = *(const u32x4*)(hrow + A_Q + c0);
        a[i] = *(const u32x4*)(OB + ((size_t)0 * TH + r0 + i) * 512 + c0); b[i] = *(const u32x4*)(OB + ((size_t)1 * TH + r0 + i) * 512 + c0);
        z[i] = *(const u32x4*)(hrow + H_Z + c0);
      }
      float gn[8];
#pragma unroll
      for (int j = 0; j < 8; ++j) gn[j] = p.hgrn_norm[l * 512 + c0 + j];
#pragma unroll
      for (int i = 0; i < 4; ++i) {
        *(u32x4*)(MX + (size_t)(r0 + i) * DI + c0) = at[i];
        float o[8]; float ss = 0.f;
#pragma unroll
        for (int j = 0; j < 8; ++j) { o[j] = bfe(a[i], j) + bfe(b[i], j); ss += o[j] * o[j]; }
#pragma unroll
        for (int of = 32; of >= 1; of >>= 1) ss += __shfl_xor(ss, of);
        const float rstd = rsqrtf(ss * (1.f / 512.f) + 1e-6f);
        float y[8];
#pragma unroll
        for (int j = 0; j < 8; ++j) { const float zz = bfe(z[i], j); y[j] = o[j] * rstd * gn[j] * (zz * frcp(1.f + ex2(fminf(-zz * LOG2E, 80.f)))); }
        *(u32x4*)(MX + (size_t)(r0 + i) * DI + 512 + c0) = (u32x4){pk2(y[0], y[1]), pk2(y[2], y[3]), pk2(y[4], y[5]), pk2(y[6], y[7])};
      }
    }
    {
      u32x4 a[4], b[4], z[4];
#pragma unroll
      for (int i = 0; i < 4; ++i) {
        a[i] = *(const u32x4*)(OB + ((size_t)4 * TH + r0 + i) * 512 + c0); b[i] = *(const u32x4*)(OB + ((size_t)5 * TH + r0 + i) * 512 + c0);
        z[i] = *(const u32x4*)(Hh + (size_t)(r0 + i) * NPAD + G_Z + c0);
      }
      float gn[8];
#pragma unroll
      for (int j = 0; j < 8; ++j) gn[j] = p.gla_norm[l * 128 + ((c0 + j) & 127)];
#pragma unroll
      for (int i = 0; i < 4; ++i) {
        float o[8]; float ss = 0.f;
#pragma unroll
        for (int j = 0; j < 8; ++j) { o[j] = bfe(a[i], j) + bfe(b[i], j); ss += o[j] * o[j]; }
#pragma unroll
        for (int of = 8; of >= 1; of >>= 1) ss += __shfl_xor(ss, of);
        const float rstd = rsqrtf(ss * (1.f / 128.f) + 1e-6f);
        float y[8];
#pragma unroll
        for (int j = 0; j < 8; ++j) { const float zz = bfe(z[i], j); y[j] = o[j] * rstd * gn[j] * (zz * frcp(1.f + ex2(fminf(-zz * LOG2E, 80.f)))); }
        *(u32x4*)(MX + (size_t)(r0 + i) * DI + 1536 + c0) = (u32x4){pk2(y[0], y[1]), pk2(y[2], y[3]), pk2(y[4], y[5]), pk2(y[6], y[7])};
      }
    }
    {
      u32x4 a[4], b[4], z[4], xr[8];
      const int t0 = r0 & (SEQ - 1);
#pragma unroll
      for (int i = 0; i < 4; ++i) {
        a[i] = *(const u32x4*)(OB + ((size_t)2 * TH + r0 + i) * 512 + c0); b[i] = *(const u32x4*)(OB + ((size_t)3 * TH + r0 + i) * 512 + c0);
        z[i] = *(const u32x4*)(Hh + (size_t)(r0 + i) * NPAD + S_Z + c0);
      }
#pragma unroll
      for (int m = 0; m < 8; ++m) {
        const int sq = t0 + m - 2;
        xr[m] = (u32x4){0u, 0u, 0u, 0u};
        if (sq >= 0 && sq < SEQ) xr[m] = *(const u32x4*)(Hh + (size_t)(r0 + m - 2) * NPAD + S_X + c0);
      }
      float gn[8], cbv[8];
#pragma unroll
      for (int j = 0; j < 8; ++j) { gn[j] = p.ssd_norm[l * 512 + c0 + j]; cbv[j] = cb[c0 + j]; }
      const float dsk = p.ssd_d[l * 8 + (c0 >> 6)];
#pragma unroll
      for (int i = 0; i < 4; ++i) {
        float u[8];
#pragma unroll
        for (int j = 0; j < 8; ++j) u[j] = cbv[j];
#pragma unroll
        for (int jj = 0; jj < 5; ++jj)
#pragma unroll
          for (int j = 0; j < 8; ++j) u[j] += cw[jj * 1024 + c0 + j] * bfe(xr[i + jj], j);
        float y[8]; float ss = 0.f;
#pragma unroll
        for (int j = 0; j < 8; ++j) {
          const float zz = bfe(z[i], j);
          const float xs = u[j] * frcp(1.f + ex2(fminf(-u[j] * LOG2E, 80.f)));
          y[j] = (bfe(a[i], j) + bfe(b[i], j) + dsk * xs) * (zz * frcp(1.f + ex2(fminf(-zz * LOG2E, 80.f))));
          ss += y[j] * y[j];
        }
#pragma unroll
        for (int of = 32; of >= 1; of >>= 1) ss += __shfl_xor(ss, of);
        const float rstd = rsqrtf(ss * (1.f / 512.f) + 1e-6f);
#pragma unroll
        for (int j = 0; j < 8; ++j) y[j] = y[j] * rstd * gn[j];
        *(u32x4*)(MX + (size_t)(r0 + i) * DI + 1024 + c0) = (u32x4){pk2(y[0], y[1]), pk2(y[2], y[3]), pk2(y[4], y[5]), pk2(y[6], y[7])};
      }
    }
  }
}

#define XB_TMO      128
#define XB_XCNT(j)  (256  + 64 * (j))
#define XB_XSUB(j)  (1280 + 64 * (j))
#define XB_XGEN(j)  (2304 + 64 * (j))
#define XB_TOP      3328
#define XB_TOPGEN   3392
#define XB_SPIN_CAP (1u << 22)
#define LAS __attribute__((address_space(3)))
DEV unsigned xb_ld(unsigned* p) { return __hip_atomic_load(p, __ATOMIC_RELAXED, __HIP_MEMORY_SCOPE_AGENT); }
DEV unsigned xb_add(unsigned* p, unsigned v) { return __hip_atomic_fetch_add(p, v, __ATOMIC_RELAXED, __HIP_MEMORY_SCOPE_AGENT); }
DEV unsigned xb_xcc_id() { return (unsigned)__builtin_amdgcn_s_getreg((3 << 11) | 20) & 0xFu; }
#define XB_SPIN(cond, bar) do { unsigned _sp = 0; while (cond) { __builtin_amdgcn_s_sleep(1); \
    if ((++_sp & 255u) == 0u) { if (xb_ld(&(bar)[XB_TMO])) break; if (_sp > XB_SPIN_CAP) { atomicAdd(&(bar)[XB_TMO], 1u); break; } } } } while (0)
struct XcdBarrier { unsigned* bar; unsigned x; volatile LAS unsigned* st; };
DEV XcdBarrier xcd_barrier_post(unsigned* bar, volatile LAS unsigned* st) {
  XcdBarrier b; b.bar = bar; b.x = xb_xcc_id(); b.st = st;
  if (threadIdx.x == 0) (void)xb_add(&bar[XB_XCNT(b.x)], 1u);
  return b;
}
DEV void xcd_barrier_complete(unsigned* bar, unsigned x, unsigned& nloc, unsigned& nx) {
  const unsigned G = gridDim.x * gridDim.y * gridDim.z;
  unsigned sum, cnt, mine, sp = 0u;
  for (;;) {
    sum = 0u; cnt = 0u; mine = 0u;
#pragma unroll
    for (unsigned j = 0; j < 16; ++j) { const unsigned c = xb_ld(&bar[XB_XCNT(j)]); sum += c; cnt += (c > 0u) ? 1u : 0u; mine = (j == x) ? c : mine; }
    if (sum == G) break;
    __builtin_amdgcn_s_sleep(1);
    if ((++sp & 255u) == 0u) { if (xb_ld(&bar[XB_TMO])) break; if (sp > XB_SPIN_CAP) { atomicAdd(&bar[XB_TMO], 1u); break; } }
  }
  nloc = mine > 0u ? mine : 1u; nx = cnt > 0u ? cnt : 1u;
}
DEV void xcd_barrier(const XcdBarrier& b) {
  asm volatile("s_waitcnt vmcnt(0)" ::: "memory");
  __syncthreads();
  if (threadIdx.x == 0) {
    unsigned* bar = b.bar;
    __builtin_amdgcn_s_waitcnt(0);
    unsigned nloc = b.st[0], nx = b.st[1];
    if (nloc == 0u) { xcd_barrier_complete(bar, b.x, nloc, nx); b.st[0] = nloc; b.st[1] = nx; }
    const unsigned old = xb_add(&bar[XB_XSUB(b.x)], 1u);
    const unsigned gen = old / nloc;
    if (old + 1u == (gen + 1u) * nloc) {
      __builtin_amdgcn_fence(__ATOMIC_RELEASE, "agent");
      asm volatile("s_waitcnt vmcnt(0)" ::: "memory");
      const unsigned og = xb_add(&bar[XB_TOP], 1u);
      const unsigned tg = og / nx;
      if (og + 1u == (tg + 1u) * nx) xb_add(&bar[XB_TOPGEN], 1u);
      else XB_SPIN(xb_ld(&bar[XB_TOPGEN]) == tg, bar);
      __builtin_amdgcn_fence(__ATOMIC_ACQUIRE, "agent");
      xb_add(&bar[XB_XGEN(b.x)], 1u);
      asm volatile("s_waitcnt vmcnt(0)" ::: "memory");
    } else {
      XB_SPIN(xb_ld(&bar[XB_XGEN(b.x)]) == gen, bar);
      __builtin_amdgcn_fence(__ATOMIC_ACQUIRE, "agent");
      asm volatile("s_waitcnt vmcnt(0)" ::: "memory");
    }
  }
  __syncthreads();
}

DEV void run_phase(const ParamsG& p, int ph, int rep, unsigned char* smem) {
  if (ph == 0) { if (PH_MASK & 1) { phase_pro(p, smem); convert_weights(p, 0, 3, smem); } return; }
  if (ph == 21) { if (PH_MASK & 16) phase_outproj(p, 1, 1, smem); return; }
  if (ph == 22) { if (PH_MASK & 32) phase_ln(p, 1, 1); return; }
  const int q = ph - 1, blk = q / 5, st = q % 5, l = blk >> 1, hf = blk & 1;
  if (st == 0) {
    if (blk > 0 && (PH_MASK & 16)) phase_outproj(p, (blk - 1) >> 1, (blk - 1) & 1, smem);
    if (PH_MASK & 2) phase_inproj(p, l, hf, blk > 0 ? 16 : 0, smem);
  } else if (st == 1) {
    if (blk > 0 && rep == 0 && (PH_MASK & 32)) phase_ln(p, (blk - 1) >> 1, (blk - 1) & 1);
    if (PH_MASK & 4) phase_prep(p, l, hf, rep, smem);
    if ((PH_MASK & 1) && rep == 0 && blk == 1) convert_weights(p, 1, 1, smem);
    if ((PH_MASK & 1) && rep == 0 && blk == 2) convert_weights(p, 1, 2, smem);
  }
  else if (st == 2) { if (PH_MASK & 0xF00) phase_mix(p, l, hf, ph + 40 * rep, 1, 0, ATT_SPLIT, rep ? PROBE_LO : 0, rep ? PROBE_HI : 100000, smem); }
  else if (st == 3) { if (PH_MASK & 0xF00) phase_mix(p, l, hf, ph + 40 * rep, 3, ATT_SPLIT, 256, rep ? PROBE_LO : 0, rep ? PROBE_HI : 100000, smem); }
  else { if (PH_MASK & 8) phase_fin(p, l, hf); }
}
__global__ void __launch_bounds__(NT) mega(Params p) {
  extern __shared__ __attribute__((aligned(16))) unsigned char smem[];
#if ONE_LAUNCH
  volatile LAS unsigned* xst = (volatile LAS unsigned*)(smem + LDS_BYTES - 32);
  if (threadIdx.x == 0) { xst[0] = 0u; xst[1] = 0u; }
  __syncthreads();
  XcdBarrier xb = xcd_barrier_post((unsigned*)(p.ws + OFF_CTRL), xst);
#endif
  ParamsG* lp = (ParamsG*)(smem + 147456);
  if (threadIdx.x == 0) {
    lp->x = (GAS const float*)p.x; lp->w_in = (GAS const float*)p.w_in; lp->q_gain = (GAS const float*)p.q_gain; lp->k_gain = (GAS const float*)p.k_gain;
    lp->lb_logits = (GAS const float*)p.lb_logits; lp->hgrn_norm = (GAS const float*)p.hgrn_norm; lp->conv_w = (GAS const float*)p.conv_w; lp->conv_b = (GAS const float*)p.conv_b;
    lp->dt_bias = (GAS const float*)p.dt_bias; lp->a_log = (GAS const float*)p.a_log; lp->ssd_d = (GAS const float*)p.ssd_d; lp->ssd_norm = (GAS const float*)p.ssd_norm;
    lp->gk_w2 = (GAS const float*)p.gk_w2; lp->gk_b = (GAS const float*)p.gk_b; lp->gla_norm = (GAS const float*)p.gla_norm; lp->w_out = (GAS const float*)p.w_out;
    lp->ln_g = (GAS const float*)p.ln_g; lp->ln_b = (GAS const float*)p.ln_b; lp->out = (GAS float*)p.out; lp->ws = (GAS unsigned char*)p.ws;
  }
  __syncthreads();
  const int ph_begin = p.phase_begin, ph_end = p.phase_end;
  for (int ph = ph_begin; ph < ph_end; ++ph) {
    int nrep = 0;
#if PROBE_REP > 0
    {
      const int q = ph - 1, st = q % 5;
      const bool idem = (ph >= 1 && ph <= 20) && (st == PROBE_ST) && (st >= 1 || ph <= PROBE_PHMAX) && (ph >= PROBE_PHMIN);
      if (idem) nrep = PROBE_REP;
    }
#endif
    for (int r = 0; r <= nrep; ++r) {
      run_phase(*lp, ph, r, smem);
#if ONE_LAUNCH
      if (r < nrep || ph + 1 < ph_end) xcd_barrier(xb);
#endif
    }
  }
}

extern "C" void kernel_launch(void* const* d_in, const int* in_sizes, int n_in, void* d_out, int out_size, void* d_ws, size_t ws_size,
                              hipStream_t stream) {
  static int grid_blocks = 0;
  if (!grid_blocks) {
    int dev = 0, cus = 0, per_cu = 0;
    hipGetDevice(&dev);
    hipDeviceGetAttribute(&cus, hipDeviceAttributeMultiprocessorCount, dev);
    hipFuncSetAttribute((const void*)mega, hipFuncAttributeMaxDynamicSharedMemorySize, LDS_BYTES);
    hipOccupancyMaxActiveBlocksPerMultiprocessor(&per_cu, mega, NT, LDS_BYTES);
    if (per_cu < 1) per_cu = 1;
    grid_blocks = cus;
  }
  Params p{};
  p.x = (const float*)d_in[0]; p.w_in = (const float*)d_in[1]; p.q_gain = (const float*)d_in[2]; p.k_gain = (const float*)d_in[3];
  p.lb_logits = (const float*)d_in[4]; p.hgrn_norm = (const float*)d_in[5]; p.conv_w = (const float*)d_in[6]; p.conv_b = (const float*)d_in[7];
  p.dt_bias = (const float*)d_in[8]; p.a_log = (const float*)d_in[9]; p.ssd_d = (const float*)d_in[10]; p.ssd_norm = (const float*)d_in[11];
  p.gk_w2 = (const float*)d_in[12]; p.gk_b = (const float*)d_in[13]; p.gla_norm = (const float*)d_in[14]; p.w_out = (const float*)d_in[15];
  p.ln_g = (const float*)d_in[16]; p.ln_b = (const float*)d_in[17];
  p.out = (float*)d_out; p.ws = (unsigned char*)d_ws;
  hipMemsetAsync(d_ws, 0, CTRL_BYTES, stream);
#if ONE_LAUNCH
  p.phase_begin = 0; p.phase_end = NPHASE;
  void* args[] = {&p};
  (void)args;
  hipLaunchKernelGGL(mega, dim3(grid_blocks), dim3(NT), LDS_BYTES, stream, p);
#else
  for (int ph = 0; ph < NPHASE; ++ph) {
    p.phase_begin = ph; p.phase_end = ph + 1;
    hipLaunchKernelGGL(mega, dim3(grid_blocks), dim3(NT), LDS_BYTES, stream, p);
  }
#endif
}
```

```cpp
#include <hip/hip_runtime.h>
#include <hip/hip_cooperative_groups.h>
#include <stdint.h>
#include <stdio.h>
namespace cg = cooperative_groups;

#ifndef ONE_LAUNCH
#define ONE_LAUNCH 1
#endif

#ifndef PH_MASK
#define PH_MASK 0xFFF
#endif
#ifndef PROBE_ST
#define PROBE_ST -1
#endif
#ifndef PROBE_REP
#define PROBE_REP 0
#endif
#ifndef PROBE_PHMAX
#define PROBE_PHMAX 0
#endif
#ifndef PROBE_PHMIN
#define PROBE_PHMIN 0
#endif
#ifndef PROBE_TYPE
#define PROBE_TYPE -1
#endif
#ifndef PROBE_LO
#define PROBE_LO 0
#endif
#ifndef PROBE_HI
#define PROBE_HI 100000
#endif
#define DEV __device__ __forceinline__
typedef unsigned short bf16_t;
typedef short bf16x8 __attribute__((ext_vector_type(8)));
typedef float f32x16 __attribute__((ext_vector_type(16)));
typedef unsigned u32x4 __attribute__((ext_vector_type(4)));
typedef float f32x4 __attribute__((ext_vector_type(4)));

constexpr int NT = 512;
constexpr int T_ALL = 16384, TH = 8192, SEQ = 4096, DM = 1024, NPAD = 7168, DI = 2048, NIN = 6960;
constexpr int A_Q = 0, A_K = 512, A_V = 640, A_Z = 768, H_Q = 1280, H_FF = 1792, H_FB = 2304, H_I = 2816, H_Z = 3328,
              S_X = 3840, S_Z = 4864, G_Q = 5376, G_K = 5632, G_V = 5888, G_Z = 6400, SM0 = 6912;
constexpr size_t OFF_CTRL = 0, OFF_TAB = 65536, OFF_XB = 131072;
constexpr size_t OFF_WIN = OFF_XB + (size_t)T_ALL * DM * 2;
constexpr size_t OFF_WOUT = OFF_WIN + (size_t)NPAD * DM * 2;
constexpr size_t OFF_H = OFF_WOUT + (size_t)DM * DI * 2;
constexpr size_t OFF_SMALL = OFF_H + (size_t)TH * NPAD * 2;
constexpr size_t OFF_OBUF = OFF_SMALL + (size_t)TH * 48 * 4;
constexpr size_t OFF_VT = OFF_OBUF + (size_t)6 * TH * 512 * 2;
constexpr size_t OFF_DB = OFF_VT + (size_t)2 * 2 * 64 * SEQ * 2;
constexpr int NSEG = 8, SLEN = 64 / NSEG;
constexpr size_t OFF_MIXED = OFF_DB + (size_t)64 * NSEG * 128 * 4;
constexpr size_t OFF_SB0 = OFF_MIXED, OFF_SB1 = OFF_SB0 + (size_t)16 * NSEG * 16384 * 2, OFF_SB2 = OFF_SB1 + (size_t)16 * NSEG * 8192 * 2;
constexpr size_t OFF_U = OFF_SB2 + (size_t)32 * NSEG * 8192 * 2;
constexpr size_t OFF_G = OFF_U + (size_t)TH * 1024 * 2;
constexpr size_t WS_END = (OFF_G + (size_t)TH * 512 * 2 > OFF_MIXED + (size_t)TH * DI * 2) ? (OFF_G + (size_t)TH * 512 * 2) : (OFF_MIXED + (size_t)TH * DI * 2);
static_assert(OFF_MIXED + (size_t)TH * DI * 2 <= WS_END, "MIXED must fit");
static_assert(WS_END <= 268435456, "workspace");
constexpr size_t CTRL_BYTES = 65536;
constexpr int CTR_WORD0 = 4096;
constexpr int LDS_BYTES = 148480;
constexpr float LOG2E = 1.4426950408889634f;
constexpr float QSCALE = 0.125f * LOG2E;
constexpr float DN_ALPHA = 1.4142135623730951f;
constexpr int NPHASE = 23;
constexpr int ATT_SPLIT = 256;

struct Params {
  const float* x; const float* w_in; const float* q_gain; const float* k_gain; const float* lb_logits; const float* hgrn_norm;
  const float* conv_w; const float* conv_b; const float* dt_bias; const float* a_log; const float* ssd_d; const float* ssd_norm;
  const float* gk_w2; const float* gk_b; const float* gla_norm; const float* w_out; const float* ln_g; const float* ln_b;
  float* out; unsigned char* ws;
  int phase_begin, phase_end;
};
#define GAS __attribute__((address_space(1)))
struct ParamsG {
  GAS const float* x; GAS const float* w_in; GAS const float* q_gain; GAS const float* k_gain; GAS const float* lb_logits; GAS const float* hgrn_norm;
  GAS const float* conv_w; GAS const float* conv_b; GAS const float* dt_bias; GAS const float* a_log; GAS const float* ssd_d; GAS const float* ssd_norm;
  GAS const float* gk_w2; GAS const float* gk_b; GAS const float* gla_norm; GAS const float* w_out; GAS const float* ln_g; GAS const float* ln_b;
  GAS float* out; GAS unsigned char* ws;
};

DEV void lds_barrier() { asm volatile("s_waitcnt lgkmcnt(0)" ::: "memory"); __builtin_amdgcn_s_barrier(); asm volatile("" ::: "memory"); }
DEV int launder(int v) { asm volatile("" : "+v"(v)); return v; }
DEV float bf2f(bf16_t v) { return __uint_as_float(((unsigned)v) << 16); }
DEV bf16_t f2bf(float f) { unsigned u = __float_as_uint(f); u += 0x7fffu + ((u >> 16) & 1u); return (bf16_t)(u >> 16); }
typedef __bf16 bf16x2_t __attribute__((ext_vector_type(2)));
typedef float f32x2_t __attribute__((ext_vector_type(2)));
DEV unsigned pk2(float lo, float hi) { const f32x2_t f = {lo, hi}; const bf16x2_t b = __builtin_convertvector(f, bf16x2_t); return __builtin_bit_cast(unsigned, b); }
DEV float fsigmoid(float x) { return 1.f / (1.f + __expf(-x)); }
DEV float fsilu(float x) { return x / (1.f + __expf(-x)); }
DEV unsigned cvtpk(float lo, float hi) { return pk2(lo, hi); }
DEV float ex2(float x) { return __builtin_amdgcn_exp2f(x); }
DEV float lg2(float x) { return __builtin_amdgcn_logf(x); }
DEV float frcp(float x) { return __builtin_amdgcn_rcpf(x); }
DEV float lo16(unsigned u) { return __uint_as_float(u << 16); }
DEV float hi16(unsigned u) { return __uint_as_float(u & 0xffff0000u); }
DEV int rowoff(int reg, int h) { return (reg & 3) + 8 * (reg >> 2) + 4 * h; }
DEV f32x16 zero16() { f32x16 z;
#pragma unroll
  for (int i = 0; i < 16; ++i) z[i] = 0.f; return z; }

template <int KD>
DEV void mma32(f32x16& acc, const bf16_t* a, int lda, const bf16_t* b, int ldb, int lane) {
  const int r = lane & 31, h = lane >> 5;
  const bf16_t* ap = a + r * lda + 8 * h;
  const bf16_t* bp = b + r * ldb + 8 * h;
#pragma unroll 4
  for (int k = 0; k < KD; k += 16) {
    bf16x8 av = *(const bf16x8*)(ap + k);
    bf16x8 bv = *(const bf16x8*)(bp + k);
    acc = __builtin_amdgcn_mfma_f32_32x32x16_bf16(av, bv, acc, 0, 0, 0);
  }
}

DEV int orig_col(int n) {
  if (n < 4864) return n;
  if (n < 6400) return n + 16;
  if (n < 6912) return n + 48;
  if (n < 6928) return n - 2048;
  if (n < 6960) return n - 512;
  return -1;
}

DEV void convert_weights(const ParamsG& p, int l, int which, unsigned char* smem) {
  float* s = (float*)smem;
  const int tid = launder(threadIdx.x);
  const float* win = (const float*)(p.w_in + (size_t)l * DM * NIN);
  const float* wout = (const float*)(p.w_out + (size_t)l * DI * DM);
  bf16_t* wint = (bf16_t*)(p.ws + OFF_WIN);
  bf16_t* woutt = (bf16_t*)(p.ws + OFF_WOUT);
  const int n_in_tiles = (NPAD / 64) * (DM / 64);
  const int n_out_tiles = (DM / 64) * (DI / 64);
  const int it_lo = (which & 1) ? 0 : n_in_tiles, it_hi = (which & 2) ? (n_in_tiles + n_out_tiles) : n_in_tiles;
  for (int it = it_lo + blockIdx.x; it < it_hi; it += gridDim.x) {
    lds_barrier();
    if (it < n_in_tiles) {
      const int n0 = (it / 16) * 64, k0 = (it % 16) * 64;
#pragma unroll
      for (int e = 0; e < 8; ++e) {
        const int idx = e * NT + tid, kk = idx >> 6, nn = idx & 63;
        const int oc = orig_col(n0 + nn);
        s[kk * 65 + nn] = (oc >= 0) ? win[(size_t)(k0 + kk) * NIN + oc] : 0.f;
      }
      lds_barrier();
      const int n = tid >> 3, kc = (tid & 7) * 8;
      uint4 o;
      o.x = pk2(s[(kc + 0) * 65 + n], s[(kc + 1) * 65 + n]); o.y = pk2(s[(kc + 2) * 65 + n], s[(kc + 3) * 65 + n]);
      o.z = pk2(s[(kc + 4) * 65 + n], s[(kc + 5) * 65 + n]); o.w = pk2(s[(kc + 6) * 65 + n], s[(kc + 7) * 65 + n]);
      *(uint4*)(wint + (size_t)(n0 + n) * DM + k0 + kc) = o;
    } else {
      const int j = it - n_in_tiles;
      const int n0 = (j / 32) * 64, k0 = (j % 32) * 64;
#pragma unroll
      for (int e = 0; e < 8; ++e) {
        const int idx = e * NT + tid, kk = idx >> 6, nn = idx & 63;
        s[kk * 65 + nn] = wout[(size_t)(k0 + kk) * DM + n0 + nn];
      }
      lds_barrier();
      const int n = tid >> 3, kc = (tid & 7) * 8;
      uint4 o;
      o.x = pk2(s[(kc + 0) * 65 + n], s[(kc + 1) * 65 + n]); o.y = pk2(s[(kc + 2) * 65 + n], s[(kc + 3) * 65 + n]);
      o.z = pk2(s[(kc + 4) * 65 + n], s[(kc + 5) * 65 + n]); o.w = pk2(s[(kc + 6) * 65 + n], s[(kc + 7) * 65 + n]);
      *(uint4*)(woutt + (size_t)(n0 + n) * DI + k0 + kc) = o;
    }
  }
  lds_barrier();
}

DEV void fsincos(float x, float& s, float& c) {
  const float k = rintf(x * 0.63661977236758134308f);
  float r = fmaf(-k, 1.5707855225e+00f, x);
  r = fmaf(-k, 1.0804273188e-05f, r);
  r = fmaf(-k, 6.0770999344e-11f, r);
  const float r2 = r * r;
  float ps = fmaf(r2, 2.7557319224e-06f, -1.9841269841e-04f);
  ps = fmaf(ps, r2, 8.3333333333e-03f); ps = fmaf(ps, r2, -1.6666666667e-01f);
  const float sinr = fmaf(ps * r2, r, r);
  float pc = fmaf(r2, -2.7557319224e-07f, 2.4801587302e-05f);
  pc = fmaf(pc, r2, -1.3888888889e-03f); pc = fmaf(pc, r2, 4.1666666667e-02f); pc = fmaf(pc, r2, -0.5f);
  const float cosr = fmaf(pc, r2, 1.0f);
  const int q = ((int)k) & 3;
  if (q == 0) { s = sinr; c = cosr; }
  else if (q == 1) { s = cosr; c = -sinr; }
  else if (q == 2) { s = -sinr; c = -cosr; }
  else { s = -cosr; c = sinr; }
}

DEV void phase_pro(const ParamsG& p, unsigned char* smem) {
  const int tid = launder(threadIdx.x);
  const size_t gtid = (size_t)blockIdx.x * NT + tid, gsz = (size_t)gridDim.x * NT;
  const float4* x4 = (const float4*)p.x;
  uint4* xb4 = (uint4*)(p.ws + OFF_XB);
  for (size_t i = gtid; i < (size_t)T_ALL * DM / 8; i += gsz) {
    const float4 a = x4[2 * i], b = x4[2 * i + 1];
    uint4 o; o.x = pk2(a.x, a.y); o.y = pk2(a.z, a.w); o.z = pk2(b.x, b.y); o.w = pk2(b.z, b.w);
    xb4[i] = o;
  }
  if (blockIdx.x == 0) {
    float2* tab = (float2*)(p.ws + OFF_TAB);
    for (int i = tid; i < 64 * 16; i += NT) {
      const int pos = i >> 4, fi = i & 15;
      const float invf = exp2f(-(float)fi * (13.287712379549449f / 16.0f));
      const float ang = (float)pos * invf;
      float sn, cs; fsincos(ang, sn, cs);
      tab[i] = make_float2(cs, sn);
    }
  }
}

namespace pg8 {
#define PG8_LAS __attribute__((address_space(3)))
typedef unsigned short bf16_t;
typedef short bf16x8 __attribute__((ext_vector_type(8)));
typedef float f32x4 __attribute__((ext_vector_type(4)));
typedef unsigned u32x4 __attribute__((ext_vector_type(4)));
constexpr int BM = 256, BK = 64, HALF = 128, HTB = HALF * BK * 2  , STAGE_BYTES = 8 * HTB, NXCD = 8, WGM = 8;

__host__ __device__ __forceinline__ int lds_byte(int r, int c) { const int st = (r >> 4) * 2 + (c >> 5), rr = r & 15, cc = c & 31, ob = rr * 64 + cc * 2; return st * 1024 + (ob ^ (((ob >> 9) & 1) << 5)); }
__host__ __device__ __forceinline__ void stage_rc(int b, int& R, int& C) { const int st = b / 1024, sb = b % 1024, swz = sb ^ (((sb >> 9) & 1) << 5); R = (st >> 1) * 16 + swz / 64; C = (st & 1) * 32 + (swz % 64) / 2; }
__host__ __device__ __forceinline__ int perm32(int rho) { const int n = rho >> 4, i = rho & 15; return 8 * (i >> 2) + 4 * n + (i & 3); }

struct Unit { int pm, pn; };
struct Gemm { const bf16_t* A; const bf16_t* Bt; int M, N, K; };

__device__ __forceinline__ unsigned cvt_pk_bf16(float lo, float hi) { unsigned r; asm volatile("v_cvt_pk_bf16_f32 %0, %1, %2" : "=v"(r) : "v"(lo), "v"(hi)); return r; }

struct XcdOrder {
    int rpx, nN, x, c, ncu, skew;
    __device__ void init(int M, int N, int skew_ = 0) { rpx = (M / BM) / NXCD; nN = N / BM; x = blockIdx.x & 7; c = blockIdx.x >> 3; ncu = gridDim.x >> 3; skew = skew_; }
    __device__ bool next(int i, Unit& u) const {
        const int total = rpx * nN, full = (total / ncu) * ncu;
        int j = c + i * ncu;
        if (skew > 0 && j >= full) { const int cc = c - skew; j = (cc >= 0 && i == total / ncu) ? full + cc : total; }
        if (j >= total) return false; u.pm = rpx * x + (j % rpx); u.pn = j / rpx; return true; }
    __device__ __forceinline__ void a_ready(const Unit&) const {}
    __device__ __forceinline__ void done(const Unit&) const {}
};
struct EpiIn {
    static constexpr bool PERM = true, AFTER_DRAIN = false;
    bf16_t* O; int ldc; float* small; int small_pn;
    __device__ __forceinline__ void operator()(const f32x4 (&acc)[2][2][4][2], const Unit& u, int wr, int wc, int fr, int fq) const {
        const int row0 = u.pm * BM + wr * 64 + fr, col0 = u.pn * BM + wc * 32 + 8 * fq;
        if (u.pn == small_pn) {
            const int c = wc * 32 + 8 * fq;
            if (c < 48) {
#pragma unroll
                for (int ai = 0; ai < 2; ++ai)
#pragma unroll
                    for (int m = 0; m < 4; ++m) { float* rp = small + (size_t)(row0 + ai * HALF + m * 16) * 48 + c; *(f32x4*)rp = acc[ai][0][m][0]; *(f32x4*)(rp + 4) = acc[ai][0][m][1]; }
            }
            return;
        }
        const int act = (u.pn == 5 || u.pn == 6) ? 1 : ((u.pn == 21) ? 2 : 0);
#pragma unroll
        for (int ai = 0; ai < 2; ++ai)
#pragma unroll
            for (int m = 0; m < 4; ++m) { bf16_t* rowp = O + (size_t)(row0 + ai * HALF + m * 16) * ldc + col0;
#pragma unroll
                for (int bj = 0; bj < 2; ++bj) { f32x4 v0 = acc[ai][bj][m][0], v1 = acc[ai][bj][m][1];
                    if (act == 1) {
#pragma unroll
                        for (int e = 0; e < 4; ++e) {
                            v0[e] = v0[e] * __builtin_amdgcn_rcpf(1.f + __builtin_amdgcn_exp2f(fminf(-v0[e] * 1.4426950408889634f, 80.f))) * 0.08838834764831845f;
                            v1[e] = v1[e] * __builtin_amdgcn_rcpf(1.f + __builtin_amdgcn_exp2f(fminf(-v1[e] * 1.4426950408889634f, 80.f))) * 0.08838834764831845f; }
                    } else if (act == 2) { v0 = v0 * 0.125f; v1 = v1 * 0.125f; }
                    u32x4 w; w.x = cvt_pk_bf16(v0[0], v0[1]); w.y = cvt_pk_bf16(v0[2], v0[3]); w.z = cvt_pk_bf16(v1[0], v1[1]); w.w = cvt_pk_bf16(v1[2], v1[3]);
                    *(u32x4*)(rowp + bj * HALF) = w; } }
    }
};
struct EpiOut {
    static constexpr bool PERM = true, AFTER_DRAIN = false;
    const float* X; float* Y; int ldc; float alpha;
    __device__ __forceinline__ void operator()(const f32x4 (&acc)[2][2][4][2], const Unit& u, int wr, int wc, int fr, int fq) const {
        const int row0 = u.pm * BM + wr * 64 + fr, col0 = u.pn * BM + wc * 32 + 8 * fq;
#pragma unroll
        for (int ai = 0; ai < 2; ++ai)
#pragma unroll
            for (int m = 0; m < 4; ++m) { const size_t off = (size_t)(row0 + ai * HALF + m * 16) * ldc + col0;
#pragma unroll
                for (int bj = 0; bj < 2; ++bj) { const f32x4 x0 = *(const f32x4*)(X + off + bj * HALF), x1 = *(const f32x4*)(X + off + bj * HALF + 4);
                    *(f32x4*)(Y + off + bj * HALF) = x0 * alpha + acc[ai][bj][m][0]; *(f32x4*)(Y + off + bj * HALF + 4) = x1 * alpha + acc[ai][bj][m][1]; } }
    }
};

template <class Epi, class Sched, bool ALIGN_EPI = false, bool SP2 = false>
__device__ __forceinline__ void gemm_phase(PG8_LAS unsigned char* lds, const Gemm g, const Sched& S, const Epi& E) {
    const int tid = launder((int)threadIdx.x), wid = __builtin_amdgcn_readfirstlane(tid >> 6), lane = tid & 63, wr = wid >> 2, wc = wid & 3, fr = lane & 15, fq = lane >> 4;
    const int K = g.K, nt = K / BK;
    unsigned voffA[2], voffB[2];
#pragma unroll
    for (int i = 0; i < 2; ++i) { int R, C; stage_rc(tid * 16 + i * 8192, R, C); const int Rb = Epi::PERM ? ((R & ~31) + perm32(R & 31)) : R;
        voffA[i] = (unsigned)(R * K + C) * 2u; voffB[i] = (unsigned)(Rb * K + C) * 2u; }
    const size_t kstep = (size_t)(BK * 2);
    const size_t hstep = (size_t)HALF * K * 2;
    const size_t tstep = 2 * hstep;
    const unsigned ldsw = (unsigned)wid * 1024u;
    const int aoff = lds_byte(wr * 64 + fr, fq * 8), boff = lds_byte(wc * 32 + fr, fq * 8);
#define PG8_SA(b, h) (((b) * 2 + (h)) * HTB)
#define PG8_SB(b, h) ((4 + (b) * 2 + (h)) * HTB)
#define PG8_STAGE(bufoff, gbase, voff) do { _Pragma("unroll") for (int _i = 0; _i < 2; ++_i) \
        __builtin_amdgcn_global_load_lds((const unsigned*)((const char*)(gbase) + (voff)[_i]), (PG8_LAS unsigned*)(lds + (bufoff) + ldsw + _i * 8192), 16, 0, 0); } while (0)
#define PG8_LDA(dst, b, h) do { _Pragma("unroll") for (int m = 0; m < 4; ++m) _Pragma("unroll") for (int k = 0; k < 2; ++k) dst[m][k] = *(const PG8_LAS bf16x8*)(lds + PG8_SA(b, h) + aoff + m * 2048 + k * 1024); } while (0)
#define PG8_LDB(dst, b, h) do { _Pragma("unroll") for (int n = 0; n < 2; ++n) _Pragma("unroll") for (int k = 0; k < 2; ++k) dst[n][k] = *(const PG8_LAS bf16x8*)(lds + PG8_SB(b, h) + boff + n * 2048 + k * 1024); } while (0)
#define PG8_MMA(ai, bj, At, Bt) do { __builtin_amdgcn_s_setprio(1); _Pragma("unroll") for (int m = 0; m < 4; ++m) _Pragma("unroll") for (int n = 0; n < 2; ++n) _Pragma("unroll") for (int k = 0; k < 2; ++k) \
        acc[ai][bj][m][n] = __builtin_amdgcn_mfma_f32_16x16x32_bf16(Bt[n][k], At[m][k], acc[ai][bj][m][n], 0, 0, 0); __builtin_amdgcn_s_setprio(0); } while (0)
#define PG8_WAIT_V(n) asm volatile("s_waitcnt vmcnt(" #n ")" ::: "memory")
#define PG8_WAIT_L(n) asm volatile("s_waitcnt lgkmcnt(" #n ")" ::: "memory")
#define PG8_BAR __builtin_amdgcn_s_barrier()
#define PG8_SCHED __builtin_amdgcn_sched_barrier(0)
    Unit cur, nxt; int ui = 0;
    if (!S.next(0, cur)) return;
    f32x4 acc[2][2][4][2];
#pragma unroll
    for (int a = 0; a < 2; ++a)
#pragma unroll
        for (int b = 0; b < 2; ++b)
#pragma unroll
            for (int m = 0; m < 4; ++m)
#pragma unroll
                for (int n = 0; n < 2; ++n) acc[a][b][m][n] = (f32x4){0.f, 0.f, 0.f, 0.f};
    bf16x8 At[4][2], B0[2][2], B1[2][2];
    const char* cA = (const char*)g.A + (size_t)cur.pm * tstep; const char* cB = (const char*)g.Bt + (size_t)cur.pn * tstep;
    S.a_ready(cur);
    if constexpr (SP2) {
        PG8_STAGE(PG8_SB(0, 0), cB, voffB); PG8_STAGE(PG8_SB(0, 1), cB + hstep, voffB); PG8_STAGE(PG8_SA(0, 0), cA, voffA); PG8_STAGE(PG8_SA(0, 1), cA + hstep, voffA);
        if (wr == 1) PG8_BAR;
        PG8_WAIT_V(2); PG8_BAR;
        PG8_STAGE(PG8_SB(1, 0), cB + kstep, voffB); PG8_STAGE(PG8_SA(1, 0), cA + kstep, voffA); PG8_STAGE(PG8_SB(1, 1), cB + hstep + kstep, voffB);
        PG8_WAIT_V(6); PG8_BAR;
    } else {
        PG8_STAGE(PG8_SB(0, 0), cB, voffB); PG8_STAGE(PG8_SA(0, 0), cA, voffA); PG8_STAGE(PG8_SB(0, 1), cB + hstep, voffB); PG8_STAGE(PG8_SA(0, 1), cA + hstep, voffA);
        if (wr == 1) PG8_BAR;
        PG8_WAIT_V(4); PG8_BAR;
        PG8_STAGE(PG8_SB(1, 0), cB + kstep, voffB); PG8_STAGE(PG8_SA(1, 0), cA + kstep, voffA); PG8_STAGE(PG8_SB(1, 1), cB + hstep + kstep, voffB);
        PG8_WAIT_V(6); PG8_BAR;
    }
    for (;;) {
        const bool has_next = S.next(ui + 1, nxt);
        const char* nA = has_next ? (const char*)g.A + (size_t)nxt.pm * tstep : cA; const char* nB = has_next ? (const char*)g.Bt + (size_t)nxt.pn * tstep : cB;
        for (int t = 0; t < nt; t += 2) {
            const bool last = (t == nt - 2);
            const char* a1 = cA + (size_t)(t + 1) * kstep;
            const char* a2 = last ? nA : cA + (size_t)(t + 2) * kstep; const char* b2 = last ? nB : cB + (size_t)(t + 2) * kstep;
            const char* a3 = a2 + kstep; const char* b3 = b2 + kstep;
            if (last && has_next) S.a_ready(nxt);
            if constexpr (SP2) {
            PG8_LDB(B0, 0, 0); PG8_LDB(B1, 0, 1); PG8_SCHED; PG8_LDA(At, 0, 0); PG8_STAGE(PG8_SA(1, 1), a1 + hstep, voffA);
            PG8_WAIT_V(8); PG8_WAIT_L(0); PG8_BAR; PG8_MMA(0, 0, At, B0); PG8_MMA(0, 1, At, B1); PG8_BAR; PG8_SCHED;
            PG8_LDA(At, 0, 1); PG8_STAGE(PG8_SB(0, 0), b2, voffB); PG8_STAGE(PG8_SB(0, 1), b2 + hstep, voffB); PG8_STAGE(PG8_SA(0, 0), a2, voffA);
            PG8_WAIT_V(8); PG8_WAIT_L(0); PG8_BAR; PG8_MMA(1, 0, At, B0); PG8_MMA(1, 1, At, B1); PG8_BAR; PG8_SCHED;
            PG8_LDB(B0, 1, 0); PG8_LDB(B1, 1, 1); PG8_SCHED; PG8_LDA(At, 1, 0); PG8_STAGE(PG8_SA(0, 1), a2 + hstep, voffA);
            PG8_WAIT_V(8); PG8_WAIT_L(0); PG8_BAR; PG8_MMA(0, 0, At, B0); PG8_MMA(0, 1, At, B1); PG8_BAR; PG8_SCHED;
            PG8_LDA(At, 1, 1); PG8_STAGE(PG8_SB(1, 0), b3, voffB); PG8_STAGE(PG8_SB(1, 1), b3 + hstep, voffB); PG8_STAGE(PG8_SA(1, 0), a3, voffA);
            PG8_WAIT_V(8); PG8_WAIT_L(0); PG8_BAR; PG8_MMA(1, 0, At, B0); PG8_MMA(1, 1, At, B1); PG8_BAR; PG8_SCHED;
            } else {
            PG8_LDB(B0, 0, 0); PG8_SCHED; PG8_LDA(At, 0, 0); PG8_STAGE(PG8_SA(1, 1), a1 + hstep, voffA);
            PG8_WAIT_L(8); PG8_BAR; PG8_WAIT_L(0); PG8_MMA(0, 0, At, B0); PG8_BAR; PG8_SCHED;
            PG8_LDB(B1, 0, 1); PG8_STAGE(PG8_SB(0, 0), b2, voffB);
            PG8_BAR; PG8_WAIT_L(0); PG8_MMA(0, 1, At, B1); PG8_BAR;
            PG8_LDA(At, 0, 1); PG8_STAGE(PG8_SA(0, 0), a2, voffA);
            PG8_BAR; PG8_WAIT_L(0); PG8_MMA(1, 0, At, B0); PG8_BAR; PG8_SCHED;
            PG8_STAGE(PG8_SB(0, 1), b2 + hstep, voffB);
            PG8_WAIT_V(6); PG8_BAR; PG8_MMA(1, 1, At, B1); PG8_BAR;
            PG8_LDB(B0, 1, 0); PG8_SCHED; PG8_LDA(At, 1, 0); PG8_STAGE(PG8_SA(0, 1), a2 + hstep, voffA);
            PG8_WAIT_L(8); PG8_BAR; PG8_WAIT_L(0); PG8_MMA(0, 0, At, B0); PG8_BAR; PG8_SCHED;
            PG8_LDB(B1, 1, 1); PG8_STAGE(PG8_SB(1, 0), b3, voffB);
            PG8_BAR; PG8_WAIT_L(0); PG8_MMA(0, 1, At, B1); PG8_BAR;
            PG8_LDA(At, 1, 1); PG8_STAGE(PG8_SA(1, 0), a3, voffA);
            PG8_BAR; PG8_WAIT_L(0); PG8_MMA(1, 0, At, B0); PG8_BAR; PG8_SCHED;
            PG8_STAGE(PG8_SB(1, 1), b3 + hstep, voffB);
            PG8_WAIT_V(6); PG8_BAR; PG8_MMA(1, 1, At, B1); PG8_BAR;
            }
        }
        if constexpr (ALIGN_EPI) { if (wr == 0) PG8_BAR; }
        if constexpr (!Epi::AFTER_DRAIN) { E(acc, cur, wr, wc, fr, fq); S.done(cur); }
        if (!has_next) break;
#pragma unroll
        for (int a = 0; a < 2; ++a)
#pragma unroll
            for (int b = 0; b < 2; ++b)
#pragma unroll
                for (int m = 0; m < 4; ++m)
#pragma unroll
                    for (int n = 0; n < 2; ++n) acc[a][b][m][n] = (f32x4){0.f, 0.f, 0.f, 0.f};
        cur = nxt; cA = nA; cB = nB; ++ui;
        if constexpr (ALIGN_EPI) { if (wr == 1) PG8_BAR; }
    }
    PG8_WAIT_V(0);
    if constexpr (!ALIGN_EPI) { if (wr == 0) PG8_BAR; }
    PG8_BAR;
    if constexpr (Epi::AFTER_DRAIN) { E.fused(acc, cur, wr, wc, fr, fq, lds, wid, lane); S.done(cur); }
#undef PG8_SA
#undef PG8_SB
#undef PG8_STAGE
#undef PG8_LDA
#undef PG8_LDB
#undef PG8_MMA
#undef PG8_WAIT_V
#undef PG8_WAIT_L
#undef PG8_BAR
#undef PG8_SCHED
}
}

DEV void phase_inproj(const ParamsG& p, int l, int hf, int skew, unsigned char* smem) {
  pg8::Gemm g{(const bf16_t*)(p.ws + OFF_XB) + (size_t)hf * TH * DM, (const bf16_t*)(p.ws + OFF_WIN), TH, NPAD, DM};
  pg8::XcdOrder S; S.init(TH, NPAD, skew);
  pg8::EpiIn E{(bf16_t*)(p.ws + OFF_H), NPAD, (float*)(p.ws + OFF_SMALL), SM0 / 256};
  pg8::gemm_phase<pg8::EpiIn, pg8::XcdOrder, true, true>((PG8_LAS unsigned char*)smem, g, S, E);
}

DEV void phase_outproj(const ParamsG& p, int l, int hf, unsigned char* smem) {
  pg8::Gemm g{(const bf16_t*)(p.ws + OFF_MIXED), (const bf16_t*)(p.ws + OFF_WOUT), TH, DM, DI};
  pg8::XcdOrder S; S.init(TH, DM);
  const float* xin = (const float*)(((l == 0) ? p.x : (GAS const float*)p.out) + (size_t)hf * TH * DM);
  pg8::EpiOut E{xin, (float*)(p.out + (size_t)hf * TH * DM), DM, DN_ALPHA};
  pg8::gemm_phase<pg8::EpiOut, pg8::XcdOrder, true, true>((PG8_LAS unsigned char*)smem, g, S, E);
}

DEV void phase_ln(const ParamsG& p, int l, int hf) {
  const int tid = launder(threadIdx.x), lane = tid & 63, w = tid >> 6;
  const float* g = (const float*)(p.ln_g + l * DM); const float* b = (const float*)(p.ln_b + l * DM);
  bf16_t* xb = (bf16_t*)(p.ws + OFF_XB);
  for (int r0 = (blockIdx.x * 8 + w) * 4; r0 < TH; r0 += gridDim.x * 32) {
    f32x4 v[4][4];
#pragma unroll
    for (int i = 0; i < 4; ++i)
#pragma unroll
      for (int j = 0; j < 4; ++j) v[i][j] = ((const f32x4*)(p.out + (size_t)(hf * TH + r0 + i) * DM))[j * 64 + lane];
    f32x4 gg[4], bb[4];
#pragma unroll
    for (int j = 0; j < 4; ++j) { gg[j] = ((const f32x4*)g)[j * 64 + lane]; bb[j] = ((const f32x4*)b)[j * 64 + lane]; }
#pragma unroll
    for (int i = 0; i < 4; ++i) {
      const int row = hf * TH + r0 + i;
      float sm = 0.f;
#pragma unroll
      for (int j = 0; j < 4; ++j) sm += (v[i][j][0] + v[i][j][1]) + (v[i][j][2] + v[i][j][3]);
#pragma unroll
      for (int o = 32; o >= 1; o >>= 1) sm += __shfl_xor(sm, o);
      const float mu = sm * (1.f / DM);
      float q = 0.f;
#pragma unroll
      for (int j = 0; j < 4; ++j) { const f32x4 d = v[i][j] - mu; q += (d[0] * d[0] + d[1] * d[1]) + (d[2] * d[2] + d[3] * d[3]); }
#pragma unroll
      for (int o = 32; o >= 1; o >>= 1) q += __shfl_xor(q, o);
      const float rstd = rsqrtf(q * (1.f / DM) + 1e-5f);
#pragma unroll
      for (int j = 0; j < 4; ++j) {
        const f32x4 o = (v[i][j] - mu) * rstd * gg[j] + bb[j];
        ((f32x4*)(p.out + (size_t)row * DM))[j * 64 + lane] = o;
        if (l == 0) *(uint2*)(xb + (size_t)row * DM + (j * 64 + lane) * 4) = make_uint2(pk2(o[0], o[1]), pk2(o[2], o[3]));
      }
    }
  }
}

DEV void attn_item(const ParamsG& p, int l, int item, unsigned char* smem) {
  const int tid = launder(threadIdx.x), lane = tid & 63, w = tid >> 6, r = lane & 31, h = lane >> 5;
  const int qt = item & 15, head = (item >> 4) & 7, bl = item >> 7;
  const int kvh = head >> 2;
  bf16_t* Hh = (bf16_t*)(p.ws + OFF_H);
  const bf16_t* VT = (const bf16_t*)(p.ws + OFF_VT);
  const size_t rowbase = (size_t)bl * SEQ;
  float mq = fabsf(p.q_gain[l * 64 + lane]), mk = fabsf(p.k_gain[l * 64 + lane]);
#pragma unroll
  for (int o = 32; o >= 1; o >>= 1) { mq = fmaxf(mq, __shfl_xor(mq, o)); mk = fmaxf(mk, __shfl_xor(mk, o)); }
  const float M2 = 8.f * mq * mk * LOG2E * 1.01f;
  const int qrow = qt * 256 + w * 32 + r;
  const bf16_t* qp = Hh + (rowbase + qrow) * NPAD + A_Q + head * 64 + 8 * h;
  bf16x8 qf[4];
#pragma unroll
  for (int ks = 0; ks < 4; ++ks) qf[ks] = *(const bf16x8*)(qp + ks * 16);
  f32x16 o0 = zero16(), o1 = zero16();
  f32x2_t lsum2 = {0.f, 0.f};
  const int srow = tid >> 3, sch = (tid & 7) * 8;
  const bf16_t* kp = Hh + (rowbase + srow) * NPAD + A_K + kvh * 64 + sch;
  const bf16_t* vp = VT + ((size_t)((bl * 2 + kvh) * 64 + srow)) * SEQ + sch;
  union PB { bf16x8 v; unsigned u[4]; };
  auto qk = [&](int st, f32x16& s0, f32x16& s1) __attribute__((always_inline)) {
    const bf16_t* sK = (const bf16_t*)(smem + st * 18432);
#pragma unroll
    for (int i = 0; i < 16; ++i) { s0[i] = -M2; s1[i] = -M2; }
#pragma unroll
    for (int ks = 0; ks < 4; ++ks) {
      const bf16x8 a0 = *(const bf16x8*)(sK + r * 72 + ks * 16 + 8 * h);
      const bf16x8 a1 = *(const bf16x8*)(sK + (32 + r) * 72 + ks * 16 + 8 * h);
      s0 = __builtin_amdgcn_mfma_f32_32x32x16_bf16(a0, qf[ks], s0, 0, 0, 0);
      s1 = __builtin_amdgcn_mfma_f32_32x32x16_bf16(a1, qf[ks], s1, 0, 0, 0);
    }
  };
  auto soft = [&](f32x16& s0, f32x16& s1, PB (&pb)[2][2]) __attribute__((always_inline)) {
#pragma unroll
    for (int i = 0; i < 16; ++i) { s0[i] = __builtin_amdgcn_exp2f(s0[i]); s1[i] = __builtin_amdgcn_exp2f(s1[i]); lsum2 += (f32x2_t){s0[i], s1[i]}; }
#pragma unroll
    for (int s = 0; s < 2; ++s)
#pragma unroll
      for (int j = 0; j < 4; ++j) {
        pb[0][s].u[j] = pk2(s0[8 * s + 2 * j], s0[8 * s + 2 * j + 1]);
        pb[1][s].u[j] = pk2(s1[8 * s + 2 * j], s1[8 * s + 2 * j + 1]);
      }
  };
  auto pv = [&](int st, const PB (&pb)[2][2]) __attribute__((always_inline)) {
    const bf16_t* sV = (const bf16_t*)(smem + st * 18432 + 9216);
#pragma unroll
    for (int kt2 = 0; kt2 < 2; ++kt2)
#pragma unroll
      for (int s = 0; s < 2; ++s) {
        const int kb = kt2 * 32 + 16 * s + 4 * h;
        union { bf16x8 v; uint2 u[2]; } a0, a1;
        a0.u[0] = *(const uint2*)(sV + r * 72 + kb); a0.u[1] = *(const uint2*)(sV + r * 72 + kb + 8);
        a1.u[0] = *(const uint2*)(sV + (32 + r) * 72 + kb); a1.u[1] = *(const uint2*)(sV + (32 + r) * 72 + kb + 8);
        o0 = __builtin_amdgcn_mfma_f32_32x32x16_bf16(a0.v, pb[kt2][s].v, o0, 0, 0, 0);
        o1 = __builtin_amdgcn_mfma_f32_32x32x16_bf16(a1.v, pb[kt2][s].v, o1, 0, 0, 0);
      }
  };
  auto compute2 = [&](int sta, int stb) __attribute__((always_inline)) {
    f32x16 sa0, sa1, sb0, sb1; PB pa[2][2], pbb[2][2];
    qk(sta, sa0, sa1); qk(stb, sb0, sb1);
    soft(sa0, sa1, pa); pv(sta, pa);
    soft(sb0, sb1, pbb); pv(stb, pbb);
  };
  constexpr int NKT = SEQ / 64;
  auto sstore = [&](int st, const u32x4& kk, const u32x4& vv) __attribute__((always_inline)) {
    *(u32x4*)(smem + st * 18432 + srow * 144 + sch * 2) = kk;
    *(u32x4*)(smem + st * 18432 + 9216 + srow * 144 + sch * 2) = vv;
  };
  u32x4 k0 = *(const u32x4*)kp, v0 = *(const u32x4*)vp;
  u32x4 k1 = *(const u32x4*)(kp + (size_t)64 * NPAD), v1 = *(const u32x4*)(vp + 64);
  sstore(0, k0, v0); sstore(1, k1, v1);
  k0 = *(const u32x4*)(kp + (size_t)2 * 64 * NPAD); v0 = *(const u32x4*)(vp + 2 * 64);
  k1 = *(const u32x4*)(kp + (size_t)3 * 64 * NPAD); v1 = *(const u32x4*)(vp + 3 * 64);
  lds_barrier();
  for (int kt = 0; kt < NKT; kt += 4) {
    sstore(2, k0, v0); sstore(3, k1, v1);
    if (kt + 4 < NKT) {
      k0 = *(const u32x4*)(kp + (size_t)(kt + 4) * 64 * NPAD); v0 = *(const u32x4*)(vp + (kt + 4) * 64);
      k1 = *(const u32x4*)(kp + (size_t)(kt + 5) * 64 * NPAD); v1 = *(const u32x4*)(vp + (kt + 5) * 64);
    }
    compute2(0, 1);
    lds_barrier();
    if (kt + 4 < NKT) {
      sstore(0, k0, v0); sstore(1, k1, v1);
      if (kt + 6 < NKT) {
        k0 = *(const u32x4*)(kp + (size_t)(kt + 6) * 64 * NPAD); v0 = *(const u32x4*)(vp + (kt + 6) * 64);
        k1 = *(const u32x4*)(kp + (size_t)(kt + 7) * 64 * NPAD); v1 = *(const u32x4*)(vp + (kt + 7) * 64);
      }
    }
    compute2(2, 3);
    lds_barrier();
  }
  float lsum = lsum2[0] + lsum2[1];
  lsum += __shfl_xor(lsum, 32);
  const float inv = 1.f / lsum;
  const bf16_t* zp = Hh + (rowbase + qrow) * NPAD + A_Z + head * 64;
  bf16_t* op = Hh + (rowbase + qrow) * NPAD + A_Q + head * 64;
#pragma unroll
  for (int dt = 0; dt < 2; ++dt)
#pragma unroll
    for (int g = 0; g < 4; ++g) {
      const int d0 = dt * 32 + 8 * g + 4 * h;
      const uint2 zz = *(const uint2*)(zp + d0);
      const float z0 = bf2f((bf16_t)(zz.x & 0xffff)), z1 = bf2f((bf16_t)(zz.x >> 16)), z2 = bf2f((bf16_t)(zz.y & 0xffff)), z3 = bf2f((bf16_t)(zz.y >> 16));
      const f32x16& oo = dt ? o1 : o0;
      uint2 ov;
      ov.x = pk2(oo[4 * g + 0] * inv * fsilu(z0), oo[4 * g + 1] * inv * fsilu(z1));
      ov.y = pk2(oo[4 * g + 2] * inv * fsilu(z2), oo[4 * g + 3] * inv * fsilu(z3));
      *(uint2*)(op + d0) = ov;
    }
  lds_barrier();
}

constexpr int L_QT = 0, L_KT = 17408, L_QC = 34816, L_KHT = 52224, L_VT = 70656, L_ST = 89088,
              L_D = 123904, L_TOT = 124416, L_ACS = 128512, L_DT = 129024;

template <int K, int V> struct ScanGeom {
  static constexpr int KP = K + 8;
  static constexpr int NS = (K / 32) * (V / 32) / 8;
};

template <int K, int V>
DEV void scan_write_state(unsigned char* smem, const f32x16* S, int w, int lane) {
  constexpr int KP = K + 8, NS = ScanGeom<K, V>::NS, NVT = V / 32;
  bf16_t* sST = (bf16_t*)(smem + L_ST);
  const int c = lane & 31, h = lane >> 5;
#pragma unroll
  for (int i = 0; i < NS; ++i) {
    const int tile = w * NS + i, kt = tile / NVT, nt = tile % NVT;
#pragma unroll
    for (int g = 0; g < 4; ++g) {
      uint2 o; o.x = pk2(S[i][4 * g + 0], S[i][4 * g + 1]); o.y = pk2(S[i][4 * g + 2], S[i][4 * g + 3]);
      *(uint2*)(sST + (nt * 32 + c) * KP + kt * 32 + 8 * g + 4 * h) = o;
    }
  }
}

template <int K, int V, bool SSDM>
DEV void scan_core(unsigned char* smem, f32x16* S, bf16_t* orow0, int dir, int w, int lane, bool do_out, const float* sAcs) {
  constexpr int KP = K + 8, NS = ScanGeom<K, V>::NS, NVT = V / 32, NOT = 2 * NVT;
  const bf16_t* sQt = (const bf16_t*)(smem + L_QT); const bf16_t* sKt = (const bf16_t*)(smem + L_KT);
  const bf16_t* sQc = (const bf16_t*)(smem + L_QC); const bf16_t* sKhT = (const bf16_t*)(smem + L_KHT);
  const bf16_t* sVT = (const bf16_t*)(smem + L_VT);
  const bf16_t* sST = (const bf16_t*)(smem + L_ST); const float* sD = (const float*)(smem + L_D);
  const int c = lane & 31, h = lane >> 5;
  if (do_out && w < NOT) {
    const int tt = w / NVT, nt = w % NVT;
    f32x16 acc = zero16();
#pragma unroll
    for (int st = 0; st < 2; ++st) {
      if (st <= tt) {
        f32x16 pt = zero16();
        mma32<K>(pt, sKt + st * 32 * KP, KP, sQt + tt * 32 * KP, KP, lane);
        const int tau = tt * 32 + c;
        const float at = SSDM ? sAcs[tau] : 0.f;
#pragma unroll
        for (int reg = 0; reg < 16; ++reg) {
          const int sig = st * 32 + rowoff(reg, h);
          float v = pt[reg];
          if (SSDM) v *= ex2(at - sAcs[sig]);
          pt[reg] = (sig <= tau) ? v : 0.f;
        }
#pragma unroll
        for (int s2 = 0; s2 < 2; ++s2) {
          union { bf16x8 v; unsigned u[4]; } pa;
#pragma unroll
          for (int j = 0; j < 4; ++j) pa.u[j] = pk2(pt[8 * s2 + 2 * j], pt[8 * s2 + 2 * j + 1]);
          const int kb = st * 32 + 16 * s2 + 4 * h;
          union { bf16x8 v; uint2 u[2]; } vb;
          vb.u[0] = *(const uint2*)(sVT + (nt * 32 + c) * 72 + kb); vb.u[1] = *(const uint2*)(sVT + (nt * 32 + c) * 72 + kb + 8);
          acc = __builtin_amdgcn_mfma_f32_32x32x16_bf16(pa.v, vb.v, acc, 0, 0, 0);
        }
      }
    }
    mma32<K>(acc, sQc + tt * 32 * KP, KP, sST + nt * 32 * KP, KP, lane);
    {
      const int l1 = lane & 1, l2 = (lane >> 1) & 1;
#pragma unroll
      for (int g = 0; g < 4; ++g) {
        const float a0 = acc[4 * g], a1 = acc[4 * g + 1], a2 = acc[4 * g + 2], a3 = acc[4 * g + 3];
        const float n0 = __builtin_bit_cast(float, __builtin_amdgcn_update_dpp(0, __builtin_bit_cast(int, a0), 0xB1, 0xF, 0xF, false));
        const float n1 = __builtin_bit_cast(float, __builtin_amdgcn_update_dpp(0, __builtin_bit_cast(int, a1), 0xB1, 0xF, 0xF, false));
        const float n2 = __builtin_bit_cast(float, __builtin_amdgcn_update_dpp(0, __builtin_bit_cast(int, a2), 0xB1, 0xF, 0xF, false));
        const float n3 = __builtin_bit_cast(float, __builtin_amdgcn_update_dpp(0, __builtin_bit_cast(int, a3), 0xB1, 0xF, 0xF, false));
        const unsigned A = l1 ? pk2(n1, a1) : pk2(a0, n0);
        const unsigned B = l1 ? pk2(n3, a3) : pk2(a2, n2);
        const unsigned send = l2 ? A : B, keep = l2 ? B : A;
        const unsigned recv = (unsigned)__builtin_amdgcn_update_dpp(0, (int)send, 0x4E, 0xF, 0xF, false);
        const int tau = tt * 32 + 8 * g + 4 * h + 2 * l2 + l1;
        const int tok = dir ? (63 - tau) : tau;
        *(uint2*)(orow0 + (size_t)tok * 512 + nt * 32 + 4 * (c >> 2)) = l2 ? make_uint2(recv, keep) : make_uint2(keep, recv);
      }
    }
  }
#pragma unroll
  for (int i = 0; i < NS; ++i) {
    const int tile = w * NS + i, kt = tile / NVT, nt = tile % NVT;
#pragma unroll
    for (int reg = 0; reg < 16; ++reg) S[i][reg] *= sD[kt * 32 + rowoff(reg, h)];
    mma32<64>(S[i], sKhT + kt * 32 * 72, 72, sVT + nt * 32 * 72, 72, lane);
  }
}

template <int K, int V>
DEV void state_store(bf16_t* buf, const f32x16* S, int w, int lane) {
  constexpr int NS = ScanGeom<K, V>::NS, NVT = V / 32;
  const int c = lane & 31, h = lane >> 5;
#pragma unroll
  for (int i = 0; i < NS; ++i) {
    const int tile = w * NS + i, kt = tile / NVT, nt = tile % NVT;
#pragma unroll
    for (int reg = 0; reg < 16; ++reg) buf[(kt * 32 + rowoff(reg, h)) * V + nt * 32 + c] = f2bf(S[i][reg]);
  }
}
template <int K, int V>
DEV void state_load(const float* buf, f32x16* S, int w, int lane) {
  constexpr int NS = ScanGeom<K, V>::NS, NVT = V / 32;
  const int c = lane & 31, h = lane >> 5;
#pragma unroll
  for (int i = 0; i < NS; ++i) {
    const int tile = w * NS + i, kt = tile / NVT, nt = tile % NVT;
#pragma unroll
    for (int reg = 0; reg < 16; ++reg) S[i][reg] = buf[(kt * 32 + rowoff(reg, h)) * V + nt * 32 + c];
  }
}

template <int K, int V>
DEV void state_combine(const bf16_t* ubase, int ustride, const float* dbase, int seg, f32x16* S, int w, int lane) {
  constexpr int NS = ScanGeom<K, V>::NS, NVT = V / 32;
  const int c = lane & 31, h = lane >> 5;
  for (int j = 0; j < seg; ++j) {
    const bf16_t* buf = ubase + (size_t)j * ustride;
    const float* dj = dbase + j * 128;
    float u[NS][16]; f32x4 dv[NS][4];
#pragma unroll
    for (int i = 0; i < NS; ++i) {
      const int tile = w * NS + i, kt = tile / NVT, nt = tile % NVT;
#pragma unroll
      for (int g = 0; g < 4; ++g) dv[i][g] = *(const f32x4*)(dj + kt * 32 + 8 * g + 4 * h);
#pragma unroll
      for (int reg = 0; reg < 16; ++reg) u[i][reg] = bf2f(buf[(kt * 32 + rowoff(reg, h)) * V + nt * 32 + c]);
    }
#pragma unroll
    for (int i = 0; i < NS; ++i)
#pragma unroll
      for (int reg = 0; reg < 16; ++reg) S[i][reg] = (j > 0 ? dv[i][reg >> 2][reg & 3] * S[i][reg] : 0.f) + u[i][reg];
  }
}

#define PACK8_LO(v) (u32x4){((v)[0] & 0xffffu) | ((v)[1] << 16), ((v)[2] & 0xffffu) | ((v)[3] << 16), ((v)[4] & 0xffffu) | ((v)[5] << 16), ((v)[6] & 0xffffu) | ((v)[7] << 16)}
#define PACK8_HI(v) (u32x4){((v)[0] >> 16) | ((v)[1] & 0xffff0000u), ((v)[2] >> 16) | ((v)[3] & 0xffff0000u), ((v)[4] >> 16) | ((v)[5] & 0xffff0000u), ((v)[6] >> 16) | ((v)[7] & 0xffff0000u)}
#define CVT8(f) (u32x4){pk2((f)[0], (f)[1]), pk2((f)[2], (f)[3]), pk2((f)[4], (f)[5]), pk2((f)[6], (f)[7])}


DEV void hgrn_item(const ParamsG& p, int l, int it, int seg, int mode, unsigned char* smem) {
  const int bl = it >> 3, head = (it >> 1) & 3, dir = it & 1;
  const bool do_out = (mode == 3);
  constexpr int K = 128, V = 128, KPW = 68;
  const int tid = launder(threadIdx.x), lane = tid & 63, w = tid >> 6;
  const int cp = tid & 63, tg = tid >> 6, ch0 = 2 * cp;
  const bf16_t* Hh = (const bf16_t*)(p.ws + OFF_H);
  bf16_t* OB = (bf16_t*)(p.ws + OFF_OBUF) + (size_t)(0 * 2 + dir) * TH * 512;
  const size_t rowbase = (size_t)bl * SEQ;
  float lb0 = 0.f, lb1 = 0.f;
  if (l > 0) {
    lb0 = fsigmoid(p.lb_logits[512 + head * 128 + ch0] - p.lb_logits[head * 128 + ch0]);
    lb1 = fsigmoid(p.lb_logits[512 + head * 128 + ch0 + 1] - p.lb_logits[head * 128 + ch0 + 1]);
  }
  const float om0 = 1.f - lb0, om1 = 1.f - lb1;
  const int fbase = dir ? H_FB : H_FF;
  unsigned* sQt = (unsigned*)(smem + L_QT); unsigned* sKt = (unsigned*)(smem + L_KT); unsigned* sQc = (unsigned*)(smem + L_QC);
  bf16_t* sKhT = (bf16_t*)(smem + L_KHT); bf16_t* sVT = (bf16_t*)(smem + L_VT);
  float* sD = (float*)(smem + L_D); float* sTot = (float*)(smem + L_TOT);
  f32x16 S[2]; S[0] = zero16(); S[1] = zero16();
  bf16_t* sbuf = (bf16_t*)(p.ws + OFF_SB0) + ((size_t)it * NSEG + seg) * 16384;
  if (do_out) state_combine<K, V>((const bf16_t*)(p.ws + OFF_SB0) + (size_t)it * NSEG * 16384, 16384, (const float*)(p.ws + OFF_DB) + (size_t)it * NSEG * 128, seg, S, w, lane);
  float dlog0 = 0.f, dlog1 = 0.f;
  unsigned pf[8], qq[8], vv[8];
  float g0[8], g1[8], kx0[8], kx1[8];
  auto gloadA = [&](int cidx) __attribute__((always_inline)) {
    const int chunk = dir ? (63 - cidx) : cidx;
#pragma unroll
    for (int i = 0; i < 8; ++i) {
      const int tau = 8 * tg + i;
      const int tok = chunk * 64 + (dir ? (63 - tau) : tau);
      pf[i] = ((const unsigned*)(Hh + (rowbase + tok) * NPAD + head * 128 + fbase))[cp];
    }
  };
  auto gloadB = [&](int cidx) __attribute__((always_inline)) {
    const int chunk = dir ? (63 - cidx) : cidx;
#pragma unroll
    for (int i = 0; i < 8; ++i) {
      const int tau = 8 * tg + i;
      const int tok = chunk * 64 + (dir ? (63 - tau) : tau);
      const unsigned* rp = (const unsigned*)(Hh + (rowbase + tok) * NPAD + head * 128) + cp;
      vv[i] = rp[H_I / 2];
      qq[i] = do_out ? rp[H_Q / 2] : 0u;
    }
  };
  auto stage1 = [&]() __attribute__((always_inline)) {
    float r0 = 0.f, r1 = 0.f;
#pragma unroll
    for (int i = 0; i < 8; ++i) {
      const float e0 = ex2(fminf(-lo16(pf[i]) * LOG2E, 80.f)), e1 = ex2(fminf(-hi16(pf[i]) * LOG2E, 80.f));
      const float s0 = frcp(1.f + e0), s1 = frcp(1.f + e1);
      r0 += lg2(lb0 + om0 * s0); r1 += lg2(lb1 + om1 * s1);
      g0[i] = r0; g1[i] = r1;
      kx0[i] = om0 * e0 * s0; kx1[i] = om1 * e1 * s1;
    }
    *(float2*)(sTot + tg * 128 + ch0) = make_float2(r0, r1);
  };
  gloadA(seg * SLEN); gloadB(seg * SLEN);
  stage1();
  if (SLEN > 1) gloadA(seg * SLEN + 1);
  for (int ci = 0; ci < SLEN; ++ci) {
    const int cidx = seg * SLEN + ci;
    const int chunk = dir ? (63 - cidx) : cidx;
    lds_barrier();
    float off0 = 0.f, off1 = 0.f, ref0 = 0.f, ref1 = 0.f, be0 = 0.f, be1 = 0.f;
#pragma unroll
    for (int j = 0; j < 8; ++j) {
      const float2 t = *(const float2*)(sTot + j * 128 + ch0);
      if (j < tg) { off0 += t.x; off1 += t.y; }
      if (j < 4) { ref0 += t.x; ref1 += t.y; }
      be0 += t.x; be1 += t.y;
    }
    dlog0 += be0; dlog1 += be1;
    const float eref0 = ex2(ref0), eref1 = ex2(ref1), ebr0 = ex2(be0 - ref0), ebr1 = ex2(be1 - ref1);
    const float d0 = off0 - ref0, d1 = off1 - ref1;
    float kh0[8], kh1[8];
#pragma unroll
    for (int i = 0; i < 8; ++i) {
      const int tau = 8 * tg + i;
      const float E0 = ex2(g0[i] + d0), E1 = ex2(g1[i] + d1);
      const float kt0 = kx0[i] * frcp(E0), kt1 = kx1[i] * frcp(E1);
      if (do_out) {
        const float qt0 = lo16(qq[i]) * E0, qt1 = hi16(qq[i]) * E1;
        sQt[tau * KPW + cp] = pk2(qt0, qt1);
        sKt[tau * KPW + cp] = pk2(kt0, kt1);
        sQc[tau * KPW + cp] = pk2(qt0 * eref0, qt1 * eref1);
      }
      kh0[i] = kt0 * ebr0; kh1[i] = kt1 * ebr1;
    }
    *(u32x4*)(sKhT + ch0 * 72 + 8 * tg) = CVT8(kh0);
    *(u32x4*)(sKhT + (ch0 + 1) * 72 + 8 * tg) = CVT8(kh1);
    *(u32x4*)(sVT + ch0 * 72 + 8 * tg) = PACK8_LO(vv);
    *(u32x4*)(sVT + (ch0 + 1) * 72 + 8 * tg) = PACK8_HI(vv);
    if (tg == 0) *(float2*)(sD + ch0) = make_float2(ex2(be0), ex2(be1));
    if (do_out) scan_write_state<K, V>(smem, S, w, lane);
    if (ci + 1 < SLEN) gloadB(cidx + 1);
    lds_barrier();
    scan_core<K, V, false>(smem, S, OB + (rowbase + (size_t)chunk * 64) * 512 + head * 128, dir, w, lane, do_out, nullptr);
    if (ci + 1 < SLEN) { stage1(); if (ci + 2 < SLEN) gloadA(cidx + 2); }
  }
  if (!do_out) {
    state_store<K, V>(sbuf, S, w, lane);
    if (tg == 0) *(float2*)((float*)(p.ws + OFF_DB) + ((size_t)it * NSEG + seg) * 128 + ch0) = make_float2(ex2(dlog0), ex2(dlog1));
  }
  lds_barrier();
}

DEV void gla_item(const ParamsG& p, int l, int it, int seg, int mode, unsigned char* smem) {
  const int j16 = it - 16, bl = j16 >> 3, head = (j16 >> 1) & 3, dir = j16 & 1;
  const bool do_out = (mode == 3);
  constexpr int K = 64, V = 128, KPW = 36;
  const int tid = launder(threadIdx.x), lane = tid & 63, w = tid >> 6;
  const int cp = tid & 31, tg = tid >> 5, ch0 = 2 * cp;
  const int vp2 = tid & 63, vg = tid >> 6;
  const bf16_t* Hh = (const bf16_t*)(p.ws + OFF_H);
  const bf16_t* Gb = (const bf16_t*)(p.ws + OFF_G);
  bf16_t* OB = (bf16_t*)(p.ws + OFF_OBUF) + (size_t)(2 * 2 + dir) * TH * 512;
  const size_t rowbase = (size_t)bl * SEQ;
  unsigned* sQt = (unsigned*)(smem + L_QT); unsigned* sKt = (unsigned*)(smem + L_KT); unsigned* sQc = (unsigned*)(smem + L_QC);
  bf16_t* sKhT = (bf16_t*)(smem + L_KHT); bf16_t* sVT = (bf16_t*)(smem + L_VT);
  float* sD = (float*)(smem + L_D); float* sTot = (float*)(smem + L_TOT);
  f32x16 S[1]; S[0] = zero16();
  bf16_t* sbuf = (bf16_t*)(p.ws + OFF_SB1) + ((size_t)j16 * NSEG + seg) * 8192;
  if (do_out) state_combine<K, V>((const bf16_t*)(p.ws + OFF_SB1) + (size_t)j16 * NSEG * 8192, 8192, (const float*)(p.ws + OFF_DB) + (size_t)it * NSEG * 128, seg, S, w, lane);
  float dlog0 = 0.f, dlog1 = 0.f;
  unsigned pg[4];
  float g0[4], g1[4]; unsigned kk[4], qq[4], vv[8];
  auto gloadA = [&](int cidx) __attribute__((always_inline)) {
    const int chunk = dir ? (63 - cidx) : cidx;
#pragma unroll
    for (int i = 0; i < 4; ++i) {
      const int tau = 4 * tg + i;
      const int tok = chunk * 64 + (dir ? (63 - tau) : tau);
      pg[i] = ((const unsigned*)(Gb + (rowbase + tok) * 512 + dir * 256 + head * 64))[cp];
    }
  };
  auto gloadB = [&](int cidx) __attribute__((always_inline)) {
    const int chunk = dir ? (63 - cidx) : cidx;
#pragma unroll
    for (int i = 0; i < 4; ++i) {
      const int tau = 4 * tg + i;
      const int tok = chunk * 64 + (dir ? (63 - tau) : tau);
      const unsigned* rp = (const unsigned*)(Hh + (rowbase + tok) * NPAD + head * 64) + cp;
      kk[i] = rp[G_K / 2]; qq[i] = do_out ? rp[G_Q / 2] : 0u;
    }
#pragma unroll
    for (int i = 0; i < 8; ++i) {
      const int tau = 8 * vg + i;
      const int tok = chunk * 64 + (dir ? (63 - tau) : tau);
      vv[i] = ((const unsigned*)(Hh + (rowbase + tok) * NPAD + G_V + head * 128))[vp2];
    }
  };
  auto stage1 = [&]() __attribute__((always_inline)) {
    float r0 = 0.f, r1 = 0.f;
#pragma unroll
    for (int i = 0; i < 4; ++i) { r0 += lo16(pg[i]); r1 += hi16(pg[i]); g0[i] = r0; g1[i] = r1; }
    *(float2*)(sTot + tg * 64 + ch0) = make_float2(r0, r1);
  };
  gloadA(seg * SLEN); gloadB(seg * SLEN);
  stage1();
  if (SLEN > 1) gloadA(seg * SLEN + 1);
  for (int ci = 0; ci < SLEN; ++ci) {
    const int cidx = seg * SLEN + ci;
    const int chunk = dir ? (63 - cidx) : cidx;
    lds_barrier();
    float off0 = 0.f, off1 = 0.f, ref0 = 0.f, ref1 = 0.f, be0 = 0.f, be1 = 0.f;
#pragma unroll
    for (int j = 0; j < 16; ++j) {
      const float2 t = *(const float2*)(sTot + j * 64 + ch0);
      if (j < tg) { off0 += t.x; off1 += t.y; }
      if (j < 8) { ref0 += t.x; ref1 += t.y; }
      be0 += t.x; be1 += t.y;
    }
    dlog0 += be0; dlog1 += be1;
    const float eref0 = ex2(ref0), eref1 = ex2(ref1), ebr0 = ex2(be0 - ref0), ebr1 = ex2(be1 - ref1);
    const float d0 = off0 - ref0, d1 = off1 - ref1;
    float kh0[4], kh1[4];
#pragma unroll
    for (int i = 0; i < 4; ++i) {
      const int tau = 4 * tg + i;
      const float E0 = ex2(g0[i] + d0), E1 = ex2(g1[i] + d1);
      const float kt0 = lo16(kk[i]) * frcp(E0), kt1 = hi16(kk[i]) * frcp(E1);
      if (do_out) {
        const float qt0 = lo16(qq[i]) * E0, qt1 = hi16(qq[i]) * E1;
        sQt[tau * KPW + cp] = pk2(qt0, qt1);
        sKt[tau * KPW + cp] = pk2(kt0, kt1);
        sQc[tau * KPW + cp] = pk2(qt0 * eref0, qt1 * eref1);
      }
      kh0[i] = kt0 * ebr0; kh1[i] = kt1 * ebr1;
    }
    *(uint2*)(sKhT + ch0 * 72 + 4 * tg) = make_uint2(pk2(kh0[0], kh0[1]), pk2(kh0[2], kh0[3]));
    *(uint2*)(sKhT + (ch0 + 1) * 72 + 4 * tg) = make_uint2(pk2(kh1[0], kh1[1]), pk2(kh1[2], kh1[3]));
    *(u32x4*)(sVT + (2 * vp2) * 72 + 8 * vg) = PACK8_LO(vv);
    *(u32x4*)(sVT + (2 * vp2 + 1) * 72 + 8 * vg) = PACK8_HI(vv);
    if (tg == 0) *(float2*)(sD + ch0) = make_float2(ex2(be0), ex2(be1));
    if (do_out) scan_write_state<K, V>(smem, S, w, lane);
    if (ci + 1 < SLEN) gloadB(cidx + 1);
    lds_barrier();
    scan_core<K, V, false>(smem, S, OB + (rowbase + (size_t)chunk * 64) * 512 + head * 128, dir, w, lane, do_out, nullptr);
    if (ci + 1 < SLEN) { stage1(); if (ci + 2 < SLEN) gloadA(cidx + 2); }
  }
  if (!do_out) {
    state_store<K, V>(sbuf, S, w, lane);
    if (tg == 0) *(float2*)((float*)(p.ws + OFF_DB) + ((size_t)it * NSEG + seg) * 128 + ch0) = make_float2(ex2(dlog0), ex2(dlog1));
  }
  lds_barrier();
}

DEV void ssd_item(const ParamsG& p, int l, int it, int seg, int mode, unsigned char* smem) {
  const int j32 = it - 32, bl = j32 >> 4, head = (j32 >> 1) & 7, dir = j32 & 1;
  const bool do_out = (mode == 3);
  constexpr int K = 128, V = 64, KPW = 68;
  const int tid = launder(threadIdx.x), lane = tid & 63, w = tid >> 6;
  const int cp = tid & 63, tg = tid >> 6, n0 = 2 * cp;
  const int xp = tid & 31, xg = tid >> 5;
  const int grp = head >> 2;
  const bf16_t* U = (const bf16_t*)(p.ws + OFF_U);
  const float* SMALL = (const float*)(p.ws + OFF_SMALL);
  bf16_t* OB = (bf16_t*)(p.ws + OFF_OBUF) + (size_t)(1 * 2 + dir) * TH * 512;
  const size_t rowbase = (size_t)bl * SEQ;
  unsigned* sQt = (unsigned*)(smem + L_QT); unsigned* sKt = (unsigned*)(smem + L_KT); unsigned* sQc = (unsigned*)(smem + L_QC);
  bf16_t* sKhT = (bf16_t*)(smem + L_KHT); bf16_t* sVT = (bf16_t*)(smem + L_VT);
  float* sD = (float*)(smem + L_D);
  const float dtb = p.dt_bias[(l * 2 + dir) * 8 + head];
  const float Acoef = -__expf(p.a_log[(l * 2 + dir) * 8 + head]) * LOG2E;
  f32x16 S[1]; S[0] = zero16();
  bf16_t* sbuf = (bf16_t*)(p.ws + OFF_SB2) + ((size_t)j32 * NSEG + seg) * 8192;
  if (do_out) state_combine<K, V>((const bf16_t*)(p.ws + OFF_SB2) + (size_t)j32 * NSEG * 8192, 8192, (const float*)(p.ws + OFF_DB) + (size_t)it * NSEG * 128, seg, S, w, lane);
  float dlog = 0.f;
  unsigned bb[8], cc[8], xx[4];
  float rdt = 0.f;
  auto gloadA = [&](int cidx) __attribute__((always_inline)) {
    const int chunk = dir ? (63 - cidx) : cidx;
    if (w == 0) {
      const int tok = chunk * 64 + (dir ? (63 - lane) : lane);
      rdt = SMALL[(rowbase + tok) * 48 + dir * 8 + head];
    }
  };
  auto gloadB = [&](int cidx) __attribute__((always_inline)) {
    const int chunk = dir ? (63 - cidx) : cidx;
#pragma unroll
    for (int i = 0; i < 8; ++i) {
      const int tau = 8 * tg + i;
      const int tok = chunk * 64 + (dir ? (63 - tau) : tau);
      const unsigned* rp = (const unsigned*)(U + (rowbase + tok) * 1024 + grp * 128) + cp;
      bb[i] = rp[512 / 2]; cc[i] = do_out ? rp[768 / 2] : 0u;
    }
#pragma unroll
    for (int i = 0; i < 4; ++i) {
      const int tau = 4 * xg + i;
      const int tok = chunk * 64 + (dir ? (63 - tau) : tau);
      xx[i] = ((const unsigned*)(U + (rowbase + tok) * 1024 + head * 64))[xp];
    }
  };
  auto stage1 = [&](int par) __attribute__((always_inline)) {
    if (w == 0) {
      const float xv = rdt + dtb;
      const float dt = (xv > 20.f) ? xv : log1pf(__expf(xv));
      float a = dt * Acoef;
#pragma unroll
      for (int o = 1; o < 64; o <<= 1) { const float t = __shfl_up(a, o); if (lane >= o) a += t; }
      ((float*)(smem + L_ACS))[par * 64 + lane] = a; ((float*)(smem + L_DT))[par * 64 + lane] = dt;
    }
  };
  gloadA(seg * SLEN); gloadB(seg * SLEN);
  stage1(0);
  if (SLEN > 1) gloadA(seg * SLEN + 1);
  for (int ci = 0; ci < SLEN; ++ci) {
    const int cidx = seg * SLEN + ci;
    const int chunk = dir ? (63 - cidx) : cidx;
    const float* sAcs = (const float*)(smem + L_ACS) + (ci & 1) * 64;
    const float* sDt = (const float*)(smem + L_DT) + (ci & 1) * 64;
    lds_barrier();
    const float aend = sAcs[63];
    dlog += aend;
    {
      float kh0[8], kh1[8];
#pragma unroll
      for (int i = 0; i < 8; ++i) {
        const int tau = 8 * tg + i;
        const float ac = sAcs[tau];
        const float eb = ex2(aend - ac);
        kh0[i] = lo16(bb[i]) * eb; kh1[i] = hi16(bb[i]) * eb;
        if (do_out) {
          const float ea = ex2(ac);
          sKt[tau * KPW + cp] = bb[i];
          sQt[tau * KPW + cp] = cc[i];
          sQc[tau * KPW + cp] = pk2(lo16(cc[i]) * ea, hi16(cc[i]) * ea);
        }
      }
      *(u32x4*)(sKhT + n0 * 72 + 8 * tg) = CVT8(kh0);
      *(u32x4*)(sKhT + (n0 + 1) * 72 + 8 * tg) = CVT8(kh1);
      float x0[4], x1[4];
#pragma unroll
      for (int i = 0; i < 4; ++i) { const float dtv = sDt[4 * xg + i]; x0[i] = lo16(xx[i]) * dtv; x1[i] = hi16(xx[i]) * dtv; }
      *(uint2*)(sVT + (2 * xp) * 72 + 4 * xg) = make_uint2(pk2(x0[0], x0[1]), pk2(x0[2], x0[3]));
      *(uint2*)(sVT + (2 * xp + 1) * 72 + 4 * xg) = make_uint2(pk2(x1[0], x1[1]), pk2(x1[2], x1[3]));
      if (tg == 0) *(float2*)(sD + n0) = make_float2(ex2(aend), ex2(aend));
    }
    if (do_out) scan_write_state<K, V>(smem, S, w, lane);
    if (ci + 1 < SLEN) gloadB(cidx + 1);
    lds_barrier();
    scan_core<K, V, true>(smem, S, OB + (rowbase + (size_t)chunk * 64) * 512 + head * 64, dir, w, lane, do_out, sAcs);
    if (ci + 1 < SLEN) { stage1((ci + 1) & 1); if (ci + 2 < SLEN) gloadA(cidx + 2); }
  }
  if (!do_out) {
    state_store<K, V>(sbuf, S, w, lane);
    if (tg == 0) *(float2*)((float*)(p.ws + OFF_DB) + ((size_t)it * NSEG + seg) * 128 + n0) = make_float2(ex2(dlog), ex2(dlog));
  }
  lds_barrier();
}

DEV void phase_prep(const ParamsG& p, int l, int hf, int rep, unsigned char* smem) {
  const int tid = launder(threadIdx.x), lane = tid & 63;
  bf16_t* Hh = (bf16_t*)(p.ws + OFF_H);
  bf16_t* U = (bf16_t*)(p.ws + OFF_U);
  bf16_t* Gb = (bf16_t*)(p.ws + OFF_G);
  bf16_t* VT = (bf16_t*)(p.ws + OFF_VT);
  const float* SMALLp = (const float*)(p.ws + OFF_SMALL);
  float2* stab = (float2*)smem;
  float* slow = (float*)(smem + 8192);
  bf16_t* sT = (bf16_t*)(smem + 12288);
  {
    const float2* tabg = (const float2*)(p.ws + OFF_TAB);
    for (int i = tid; i < 1024; i += NT) stab[i] = tabg[i];
  }
  const int cg8 = (tid & 127) * 8, rsub = tid >> 7;
  const float* cw = (const float*)(p.conv_w + (size_t)l * 5 * 1024); const float* cb = (const float*)(p.conv_b + (size_t)l * 1024);
  float wv[5][8], bv[8];
#pragma unroll
  for (int j = 0; j < 5; ++j)
#pragma unroll
    for (int e = 0; e < 8; ++e) wv[j][e] = cw[j * 1024 + cg8 + e];
#pragma unroll
  for (int e = 0; e < 8; ++e) bv[e] = cb[cg8 + e];
  const int gd = tid >> 8, gc = tid & 255;
  const int i16 = lane & 15;
  const float* gq = (const float*)(p.q_gain + l * 64 + 4 * i16); const float* gk = (const float*)(p.k_gain + l * 64 + 4 * i16);
  const float gqv[4] = {gq[0], gq[1], gq[2], gq[3]}, gkv[4] = {gk[0], gk[1], gk[2], gk[3]};
  for (int grp = blockIdx.x; grp < TH / 32; grp += gridDim.x) {
    const int r0 = grp * 32;
    lds_barrier();
    const u32x4 vt = *(const u32x4*)(Hh + (size_t)(r0 + (tid >> 4)) * NPAD + A_V + (tid & 15) * 8);
    const float2 lowv = *(const float2*)(SMALLp + (size_t)(r0 + (tid >> 4)) * 48 + 16 + (tid & 15) * 2);
    *(u32x4*)(sT + (tid >> 4) * 136 + (tid & 15) * 8) = vt;
    *(float2*)(slow + (tid >> 4) * 32 + (tid & 15) * 2) = lowv;
#pragma unroll 1
    for (int ps = 0; ps < 2; ++ps) {
      const int ra = r0 + 16 * ps + 4 * rsub, ta = ra & (SEQ - 1);
      u32x4 xc[8];
#pragma unroll
      for (int m = 0; m < 8; ++m) {
        const int sq = ta + m - 2;
        xc[m] = (u32x4){0u, 0u, 0u, 0u};
        if (sq >= 0 && sq < SEQ) xc[m] = *(const u32x4*)(Hh + (size_t)(ra + m - 2) * NPAD + S_X + cg8);
      }
#pragma unroll
      for (int o4 = 0; o4 < 4; ++o4) {
        float u[8];
#pragma unroll
        for (int e = 0; e < 8; ++e) u[e] = bv[e];
#pragma unroll
        for (int j = 0; j < 5; ++j)
#pragma unroll
          for (int e = 0; e < 4; ++e) { u[2 * e] += wv[j][2 * e] * lo16(xc[o4 + j][e]); u[2 * e + 1] += wv[j][2 * e + 1] * hi16(xc[o4 + j][e]); }
        u32x4 o;
#pragma unroll
        for (int e = 0; e < 4; ++e) {
          const float a = u[2 * e] * frcp(1.f + ex2(fminf(-u[2 * e] * LOG2E, 80.f)));
          const float b = u[2 * e + 1] * frcp(1.f + ex2(fminf(-u[2 * e + 1] * LOG2E, 80.f)));
          o[e] = pk2(a, b);
        }
        *(u32x4*)(U + (size_t)(ra + o4) * 1024 + cg8) = o;
      }
    }
    lds_barrier();
    if (rep == 0) {
#pragma unroll 1
      for (int ub = 0; ub < 10; ub += 5) {
        uint2 xq[5];
#pragma unroll
        for (int u = 0; u < 5; ++u) {
          const int pi = (ub + u) * 32 + (tid >> 4), row = r0 + pi / 10, hd = pi % 10;
          xq[u] = *(const uint2*)(Hh + (size_t)row * NPAD + ((hd < 8) ? (A_Q + hd * 64) : (A_K + (hd - 8) * 64)) + 4 * i16);
        }
#pragma unroll
        for (int u = 0; u < 5; ++u) {
          const int pi = (ub + u) * 32 + (tid >> 4), row = r0 + pi / 10, hd = pi % 10;
          const bool isq = hd < 8;
          const float x[4] = {lo16(xq[u].x), hi16(xq[u].x), lo16(xq[u].y), hi16(xq[u].y)};
          float ss = x[0] * x[0] + x[1] * x[1] + x[2] * x[2] + x[3] * x[3];
          ss += __shfl_xor(ss, 1); ss += __shfl_xor(ss, 2); ss += __shfl_xor(ss, 4); ss += __shfl_xor(ss, 8);
          const float rstd = rsqrtf(ss * (1.f / 64.f) + 1e-6f);
          const int t = row & (SEQ - 1);
          const int pos = (i16 < 8) ? (t >> 6) : (t & 63);
          const float osc = isq ? QSCALE : 1.f;
          float o[4];
#pragma unroll
          for (int e = 0; e < 4; ++e) {
            const float v = x[e] * rstd * (isq ? gqv[e] : gkv[e]);
            const float pv = __shfl_xor(v, 4);
            const float2 cs = stab[pos * 16 + 4 * (i16 & 3) + e];
            o[e] = ((i16 & 4) ? (v * cs.x + pv * cs.y) : (v * cs.x - pv * cs.y)) * osc;
          }
          *(uint2*)(Hh + (size_t)row * NPAD + (isq ? (A_Q + hd * 64) : (A_K + (hd - 8) * 64)) + 4 * i16) = make_uint2(pk2(o[0], o[1]), pk2(o[2], o[3]));
        }
      }
    }
    float w2c[16];
#pragma unroll
    for (int r = 0; r < 16; ++r) w2c[r] = p.gk_w2[((size_t)(l * 2 + gd) * 16 + r) * 256 + gc];
    const float gbias = p.gk_b[(l * 2 + gd) * 256 + gc];
#pragma unroll 4
    for (int rr = 0; rr < 32; ++rr) {
      const float4* lp4 = (const float4*)(slow + rr * 32 + gd * 16);
      float gkk = gbias;
#pragma unroll
      for (int r4 = 0; r4 < 4; ++r4) { const float4 lw = lp4[r4]; gkk += lw.x * w2c[4 * r4] + lw.y * w2c[4 * r4 + 1] + lw.z * w2c[4 * r4 + 2] + lw.w * w2c[4 * r4 + 3]; }
      const float l2 = (fminf(gkk, 0.f) * LOG2E - lg2(1.f + ex2(-fabsf(gkk) * LOG2E))) * (1.f / 16.f);
      Gb[(size_t)(r0 + rr) * 512 + tid] = f2bf(l2);
    }
    {
      const int c = tid >> 2, tq = (tid & 3) * 8;
      unsigned v[8];
#pragma unroll
      for (int i = 0; i < 8; ++i) v[i] = sT[(tq + i) * 136 + c];
      const int bl = r0 >> 12, t0 = (r0 & (SEQ - 1)) + tq;
      *(u32x4*)(VT + ((size_t)((bl * 2 + (c >> 6)) * 64 + (c & 63))) * SEQ + t0) = (u32x4){v[0] | (v[1] << 16), v[2] | (v[3] << 16), v[4] | (v[5] << 16), v[6] | (v[7] << 16)};
    }
  }
  lds_barrier();
}

DEV void phase_mix(const ParamsG& p, int l, int hf, int slot, int mode, int att_lo, int att_hi, int vid_lo, int vid_hi, unsigned char* smem) {
  unsigned* ctr = (unsigned*)(p.ws + OFF_CTRL) + CTR_WORD0 + slot * 16;
  volatile int* sItem = (volatile int*)(smem + LDS_BYTES - 16);
  const int n_scan = 64 * NSEG;
  int hi = n_scan + (att_hi - att_lo); if (vid_hi < hi) hi = vid_hi;
  for (;;) {
    lds_barrier();
    if (threadIdx.x == 0) *sItem = vid_lo + (int)atomicAdd(ctr, 1u);
    lds_barrier();
    const int vid = *sItem;
    if (vid >= hi) break;
    if (vid < n_scan) {
      int seg = vid >> 6, it = vid & 63;
      {
        if (vid < 16 * NSEG) { it = vid & 15; seg = vid >> 4; }
        else if (vid < 48 * NSEG) { const int v2 = vid - 16 * NSEG; it = 32 + (v2 & 31); seg = v2 >> 5; }
        else { const int v2 = vid - 48 * NSEG; it = 16 + (v2 & 15); seg = v2 >> 4; }
      }
      if (mode == 1 && seg == NSEG - 1) continue;
#if PROBE_REP > 0
      if (slot >= 40 && PROBE_TYPE >= 0 && ((it < 16) ? 0 : (it < 32) ? 1 : 2) != PROBE_TYPE) continue;
#endif
      if (it < 16) { if (PH_MASK & 0x100) hgrn_item(p, l, it, seg, mode, smem); }
      else if (it < 32) { if (PH_MASK & 0x200) gla_item(p, l, it, seg, mode, smem); }
      else { if (PH_MASK & 0x400) ssd_item(p, l, it, seg, mode, smem); }
    } else { if (PH_MASK & 0x800) attn_item(p, l, att_lo + (vid - n_scan), smem); }
  }
}

DEV void phase_scan2(const ParamsG& p) {
  const size_t gtid = (size_t)blockIdx.x * NT + threadIdx.x, gsz = (size_t)gridDim.x * NT;
  const float* DB = (const float*)(p.ws + OFF_DB);
  for (size_t e = gtid; e < 655360; e += gsz) {
    float* buf; const float* dp; int stride;
    if (e < 262144) { const int it = (int)(e >> 14), idx = (int)(e & 16383); buf = (float*)(p.ws + OFF_SB0) + (size_t)it * NSEG * 16384 + idx; stride = 16384; dp = DB + (size_t)it * NSEG * 128 + (idx >> 7); }
    else if (e < 393216) { const int e2 = (int)(e - 262144), j = e2 >> 13, idx = e2 & 8191; buf = (float*)(p.ws + OFF_SB1) + (size_t)j * NSEG * 8192 + idx; stride = 8192; dp = DB + (size_t)(16 + j) * NSEG * 128 + (idx >> 7); }
    else { const int e3 = (int)(e - 393216), j = e3 >> 13, idx = e3 & 8191; buf = (float*)(p.ws + OFF_SB2) + (size_t)j * NSEG * 8192 + idx; stride = 8192; dp = DB + (size_t)(32 + j) * NSEG * 128 + (idx >> 6); }
    float u[NSEG - 1], d[NSEG - 1];
#pragma unroll
    for (int sg = 0; sg < NSEG - 1; ++sg) { u[sg] = buf[(size_t)sg * stride]; d[sg] = dp[sg * 128]; }
    float st = 0.f;
#pragma unroll
    for (int sg = 0; sg < NSEG; ++sg) { buf[(size_t)sg * stride] = st; if (sg < NSEG - 1) st = d[sg] * st + u[sg]; }
  }
}

DEV float bfe(const u32x4& v, int j) { return (j & 1) ? hi16(v[j >> 1]) : lo16(v[j >> 1]); }
DEV void phase_fin(const ParamsG& p, int l, int hf) {
  const int tid = launder(threadIdx.x), lane = tid & 63, w = tid >> 6;
  const bf16_t* Hh = (const bf16_t*)(p.ws + OFF_H);
  const bf16_t* OB = (const bf16_t*)(p.ws + OFF_OBUF);
  bf16_t* MX = (bf16_t*)(p.ws + OFF_MIXED);
  const int c0 = lane * 8;
  const float* cw = (const float*)(p.conv_w + (size_t)l * 5 * 1024); const float* cb = (const float*)(p.conv_b + (size_t)l * 1024);
  for (int r0 = (blockIdx.x * 8 + w) * 4; r0 < TH; r0 += gridDim.x * 32) {
    {
      u32x4 at[4], a[4], b[4], z[4];
#pragma unroll
      for (int i = 0; i < 4; ++i) {
        const bf16_t* hrow = Hh + (size_t)(r0 + i) * NPAD;
        at[i] = *(const u32x4*)(hrow + A_Q + c0);
        a[i] = *(const u32x4*)(OB + ((size_t)0 * TH + r0 + i) * 512 + c0); b[i] = *(const u32x4*)(OB + ((size_t)1 * TH + r0 + i) * 512 + c0);
        z[i] = *(const u32x4*)(hrow + H_Z + c0);
      }
      float gn[8];
#pragma unroll
      for (int j = 0; j < 8; ++j) gn[j] = p.hgrn_norm[l * 512 + c0 + j];
#pragma unroll
      for (int i = 0; i < 4; ++i) {
        *(u32x4*)(MX + (size_t)(r0 + i) * DI + c0) = at[i];
        float o[8]; float ss = 0.f;
#pragma unroll
        for (int j = 0; j < 8; ++j) { o[j] = bfe(a[i], j) + bfe(b[i], j); ss += o[j] * o[j]; }
#pragma unroll
        for (int of = 32; of >= 1; of >>= 1) ss += __shfl_xor(ss, of);
        const float rstd = rsqrtf(ss * (1.f / 512.f) + 1e-6f);
        float y[8];
#pragma unroll
        for (int j = 0; j < 8; ++j) { const float zz = bfe(z[i], j); y[j] = o[j] * rstd * gn[j] * (zz * frcp(1.f + ex2(fminf(-zz * LOG2E, 80.f)))); }
        *(u32x4*)(MX + (size_t)(r0 + i) * DI + 512 + c0) = (u32x4){pk2(y[0], y[1]), pk2(y[2], y[3]), pk2(y[4], y[5]), pk2(y[6], y[7])};
      }
    }
    {
      u32x4 a[4], b[4], z[4];
#pragma unroll
      for (int i = 0; i < 4; ++i) {
        a[i] = *(const u32x4*)(OB + ((size_t)4 * TH + r0 + i) * 512 + c0); b[i] = *(const u32x4*)(OB + ((size_t)5 * TH + r0 + i) * 512 + c0);
        z[i] = *(const u32x4*)(Hh + (size_t)(r0 + i) * NPAD + G_Z + c0);
      }
      float gn[8];
#pragma unroll
      for (int j = 0; j < 8; ++j) gn[j] = p.gla_norm[l * 128 + ((c0 + j) & 127)];
#pragma unroll
      for (int i = 0; i < 4; ++i) {
        float o[8]; float ss = 0.f;
#pragma unroll
        for (int j = 0; j < 8; ++j) { o[j] = bfe(a[i], j) + bfe(b[i], j); ss += o[j] * o[j]; }
#pragma unroll
        for (int of = 8; of >= 1; of >>= 1) ss += __shfl_xor(ss, of);
        const float rstd = rsqrtf(ss * (1.f / 128.f) + 1e-6f);
        float y[8];
#pragma unroll
        for (int j = 0; j < 8; ++j) { const float zz = bfe(z[i], j); y[j] = o[j] * rstd * gn[j] * (zz * frcp(1.f + ex2(fminf(-zz * LOG2E, 80.f)))); }
        *(u32x4*)(MX + (size_t)(r0 + i) * DI + 1536 + c0) = (u32x4){pk2(y[0], y[1]), pk2(y[2], y[3]), pk2(y[4], y[5]), pk2(y[6], y[7])};
      }
    }
    {
      u32x4 a[4], b[4], z[4], xr[8];
      const int t0 = r0 & (SEQ - 1);
#pragma unroll
      for (int i = 0; i < 4; ++i) {
        a[i] = *(const u32x4*)(OB + ((size_t)2 * TH + r0 + i) * 512 + c0); b[i] = *(const u32x4*)(OB + ((size_t)3 * TH + r0 + i) * 512 + c0);
        z[i] = *(const u32x4*)(Hh + (size_t)(r0 + i) * NPAD + S_Z + c0);
      }
#pragma unroll
      for (int m = 0; m < 8; ++m) {
        const int sq = t0 + m - 2;
        xr[m] = (u32x4){0u, 0u, 0u, 0u};
        if (sq >= 0 && sq < SEQ) xr[m] = *(const u32x4*)(Hh + (size_t)(r0 + m - 2) * NPAD + S_X + c0);
      }
      float gn[8], cbv[8];
#pragma unroll
      for (int j = 0; j < 8; ++j) { gn[j] = p.ssd_norm[l * 512 + c0 + j]; cbv[j] = cb[c0 + j]; }
      const float dsk = p.ssd_d[l * 8 + (c0 >> 6)];
#pragma unroll
      for (int i = 0; i < 4; ++i) {
        float u[8];
#pragma unroll
        for (int j = 0; j < 8; ++j) u[j] = cbv[j];
#pragma unroll
        for (int jj = 0; jj < 5; ++jj)
#pragma unroll
          for (int j = 0; j < 8; ++j) u[j] += cw[jj * 1024 + c0 + j] * bfe(xr[i + jj], j);
        float y[8]; float ss = 0.f;
#pragma unroll
        for (int j = 0; j < 8; ++j) {
          const float zz = bfe(z[i], j);
          const float xs = u[j] * frcp(1.f + ex2(fminf(-u[j] * LOG2E, 80.f)));
          y[j] = (bfe(a[i], j) + bfe(b[i], j) + dsk * xs) * (zz * frcp(1.f + ex2(fminf(-zz * LOG2E, 80.f))));
          ss += y[j] * y[j];
        }
#pragma unroll
        for (int of = 32; of >= 1; of >>= 1) ss += __shfl_xor(ss, of);
        const float rstd = rsqrtf(ss * (1.f / 512.f) + 1e-6f);
#pragma unroll
        for (int j = 0; j < 8; ++j) y[j] = y[j] * rstd * gn[j];
        *(u32x4*)(MX + (size_t)(r0 + i) * DI + 1024 + c0) = (u32x4){pk2(y[0], y[1]), pk2(y[2], y[3]), pk2(y[4], y[5]), pk2(y[6], y[7])};
      }
    }
  }
}

#define XB_TMO      128
#define XB_XCNT(j)  (256  + 64 * (j))
#define XB_XSUB(j)  (1280 + 64 * (j))
#define XB_XGEN(j)  (2304 + 64 * (j))
#define XB_TOP      3328
#define XB_TOPGEN   3392
#define XB_SPIN_CAP (1u << 22)
#define LAS __attribute__((address_space(3)))
DEV unsigned xb_ld(unsigned* p) { return __hip_atomic_load(p, __ATOMIC_RELAXED, __HIP_MEMORY_SCOPE_AGENT); }
DEV unsigned xb_add(unsigned* p, unsigned v) { return __hip_atomic_fetch_add(p, v, __ATOMIC_RELAXED, __HIP_MEMORY_SCOPE_AGENT); }
DEV unsigned xb_xcc_id() { return (unsigned)__builtin_amdgcn_s_getreg((3 << 11) | 20) & 0xFu; }
#define XB_SPIN(cond, bar) do { unsigned _sp = 0; while (cond) { __builtin_amdgcn_s_sleep(1); \
    if ((++_sp & 255u) == 0u) { if (xb_ld(&(bar)[XB_TMO])) break; if (_sp > XB_SPIN_CAP) { atomicAdd(&(bar)[XB_TMO], 1u); break; } } } } while (0)
struct XcdBarrier { unsigned* bar; unsigned x; volatile LAS unsigned* st; };
DEV XcdBarrier xcd_barrier_post(unsigned* bar, volatile LAS unsigned* st) {
  XcdBarrier b; b.bar = bar; b.x = xb_xcc_id(); b.st = st;
  if (threadIdx.x == 0) (void)xb_add(&bar[XB_XCNT(b.x)], 1u);
  return b;
}
DEV void xcd_barrier_complete(unsigned* bar, unsigned x, unsigned& nloc, unsigned& nx) {
  const unsigned G = gridDim.x * gridDim.y * gridDim.z;
  unsigned sum, cnt, mine, sp = 0u;
  for (;;) {
    sum = 0u; cnt = 0u; mine = 0u;
#pragma unroll
    for (unsigned j = 0; j < 16; ++j) { const unsigned c = xb_ld(&bar[XB_XCNT(j)]); sum += c; cnt += (c > 0u) ? 1u : 0u; mine = (j == x) ? c : mine; }
    if (sum == G) break;
    __builtin_amdgcn_s_sleep(1);
    if ((++sp & 255u) == 0u) { if (xb_ld(&bar[XB_TMO])) break; if (sp > XB_SPIN_CAP) { atomicAdd(&bar[XB_TMO], 1u); break; } }
  }
  nloc = mine > 0u ? mine : 1u; nx = cnt > 0u ? cnt : 1u;
}
DEV void xcd_barrier(const XcdBarrier& b) {
  asm volatile("s_waitcnt vmcnt(0)" ::: "memory");
  __syncthreads();
  if (threadIdx.x == 0) {
    unsigned* bar = b.bar;
    __builtin_amdgcn_s_waitcnt(0);
    unsigned nloc = b.st[0], nx = b.st[1];
    if (nloc == 0u) { xcd_barrier_complete(bar, b.x, nloc, nx); b.st[0] = nloc; b.st[1] = nx; }
    const unsigned old = xb_add(&bar[XB_XSUB(b.x)], 1u);
    const unsigned gen = old / nloc;
    if (old + 1u == (gen + 1u) * nloc) {
      __builtin_amdgcn_fence(__ATOMIC_RELEASE, "agent");
      asm volatile("s_waitcnt vmcnt(0)" ::: "memory");
      const unsigned og = xb_add(&bar[XB_TOP], 1u);
      const unsigned tg = og / nx;
      if (og + 1u == (tg + 1u) * nx) xb_add(&bar[XB_TOPGEN], 1u);
      else XB_SPIN(xb_ld(&bar[XB_TOPGEN]) == tg, bar);
      __builtin_amdgcn_fence(__ATOMIC_ACQUIRE, "agent");
      xb_add(&bar[XB_XGEN(b.x)], 1u);
      asm volatile("s_waitcnt vmcnt(0)" ::: "memory");
    } else {
      XB_SPIN(xb_ld(&bar[XB_XGEN(b.x)]) == gen, bar);
      __builtin_amdgcn_fence(__ATOMIC_ACQUIRE, "agent");
      asm volatile("s_waitcnt vmcnt(0)" ::: "memory");
    }
  }
  __syncthreads();
}

DEV void run_phase(const ParamsG& p, int ph, int rep, unsigned char* smem) {
  if (ph == 0) { if (PH_MASK & 1) { phase_pro(p, smem); convert_weights(p, 0, 3, smem); } return; }
  if (ph == 21) { if (PH_MASK & 16) phase_outproj(p, 1, 1, smem); return; }
  if (ph == 22) { if (PH_MASK & 32) phase_ln(p, 1, 1); return; }
  const int q = ph - 1, blk = q / 5, st = q % 5, l = blk >> 1, hf = blk & 1;
  if (st == 0) {
    if (blk > 0 && (PH_MASK & 16)) phase_outproj(p, (blk - 1) >> 1, (blk - 1) & 1, smem);
    if (PH_MASK & 2) phase_inproj(p, l, hf, blk > 0 ? 16 : 0, smem);
  } else if (st == 1) {
    if (blk > 0 && rep == 0 && (PH_MASK & 32)) phase_ln(p, (blk - 1) >> 1, (blk - 1) & 1);
    if (PH_MASK & 4) phase_prep(p, l, hf, rep, smem);
    if ((PH_MASK & 1) && rep == 0 && blk == 1) convert_weights(p, 1, 1, smem);
    if ((PH_MASK & 1) && rep == 0 && blk == 2) convert_weights(p, 1, 2, smem);
  }
  else if (st == 2) { if (PH_MASK & 0xF00) phase_mix(p, l, hf, ph + 40 * rep, 1, 0, ATT_SPLIT, rep ? PROBE_LO : 0, rep ? PROBE_HI : 100000, smem); }
  else if (st == 3) { if (PH_MASK & 0xF00) phase_mix(p, l, hf, ph + 40 * rep, 3, ATT_SPLIT, 256, rep ? PROBE_LO : 0, rep ? PROBE_HI : 100000, smem); }
  else { if (PH_MASK & 8) phase_fin(p, l, hf); }
}
__global__ void __launch_bounds__(NT) mega(Params p) {
  extern __shared__ __attribute__((aligned(16))) unsigned char smem[];
#if ONE_LAUNCH
  volatile LAS unsigned* xst = (volatile LAS unsigned*)(smem + LDS_BYTES - 32);
  if (threadIdx.x == 0) { xst[0] = 0u; xst[1] = 0u; }
  __syncthreads();
  XcdBarrier xb = xcd_barrier_post((unsigned*)(p.ws + OFF_CTRL), xst);
#endif
  ParamsG* lp = (ParamsG*)(smem + 147456);
  if (threadIdx.x == 0) {
    lp->x = (GAS const float*)p.x; lp->w_in = (GAS const float*)p.w_in; lp->q_gain = (GAS const float*)p.q_gain; lp->k_gain = (GAS const float*)p.k_gain;
    lp->lb_logits = (GAS const float*)p.lb_logits; lp->hgrn_norm = (GAS const float*)p.hgrn_norm; lp->conv_w = (GAS const float*)p.conv_w; lp->conv_b = (GAS const float*)p.conv_b;
    lp->dt_bias = (GAS const float*)p.dt_bias; lp->a_log = (GAS const float*)p.a_log; lp->ssd_d = (GAS const float*)p.ssd_d; lp->ssd_norm = (GAS const float*)p.ssd_norm;
    lp->gk_w2 = (GAS const float*)p.gk_w2; lp->gk_b = (GAS const float*)p.gk_b; lp->gla_norm = (GAS const float*)p.gla_norm; lp->w_out = (GAS const float*)p.w_out;
    lp->ln_g = (GAS const float*)p.ln_g; lp->ln_b = (GAS const float*)p.ln_b; lp->out = (GAS float*)p.out; lp->ws = (GAS unsigned char*)p.ws;
  }
  __syncthreads();
  const int ph_begin = p.phase_begin, ph_end = p.phase_end;
  for (int ph = ph_begin; ph < ph_end; ++ph) {
    int nrep = 0;
#if PROBE_REP > 0
    {
      const int q = ph - 1, st = q % 5;
      const bool idem = (ph >= 1 && ph <= 20) && (st == PROBE_ST) && (st >= 1 || ph <= PROBE_PHMAX) && (ph >= PROBE_PHMIN);
      if (idem) nrep = PROBE_REP;
    }
#endif
    for (int r = 0; r <= nrep; ++r) {
      run_phase(*lp, ph, r, smem);
#if ONE_LAUNCH
      if (r < nrep || ph + 1 < ph_end) xcd_barrier(xb);
#endif
    }
  }
}

extern "C" void kernel_launch(void* const* d_in, const int* in_sizes, int n_in, void* d_out, int out_size, void* d_ws, size_t ws_size,
                              hipStream_t stream) {
  static int grid_blocks = 0;
  if (!grid_blocks) {
    int dev = 0, cus = 0, per_cu = 0;
    hipGetDevice(&dev);
    hipDeviceGetAttribute(&cus, hipDeviceAttributeMultiprocessorCount, dev);
    hipFuncSetAttribute((const void*)mega, hipFuncAttributeMaxDynamicSharedMemorySize, LDS_BYTES);
    hipOccupancyMaxActiveBlocksPerMultiprocessor(&per_cu, mega, NT, LDS_BYTES);
    if (per_cu < 1) per_cu = 1;
    grid_blocks = cus;
  }
  Params p{};
  p.x = (const float*)d_in[0]; p.w_in = (const float*)d_in[1]; p.q_gain = (const float*)d_in[2]; p.k_gain = (const float*)d_in[3];
  p.lb_logits = (const float*)d_in[4]; p.hgrn_norm = (const float*)d_in[5]; p.conv_w = (const float*)d_in[6]; p.conv_b = (const float*)d_in[7];
  p.dt_bias = (const float*)d_in[8]; p.a_log = (const float*)d_in[9]; p.ssd_d = (const float*)d_in[10]; p.ssd_norm = (const float*)d_in[11];
  p.gk_w2 = (const float*)d_in[12]; p.gk_b = (const float*)d_in[13]; p.gla_norm = (const float*)d_in[14]; p.w_out = (const float*)d_in[15];
  p.ln_g = (const float*)d_in[16]; p.ln_b = (const float*)d_in[17];
  p.out = (float*)d_out; p.ws = (unsigned char*)d_ws;
  hipMemsetAsync(d_ws, 0, CTRL_BYTES, stream);
#if ONE_LAUNCH
  p.phase_begin = 0; p.phase_end = NPHASE;
  void* args[] = {&p};
  (void)args;
  hipLaunchKernelGGL(mega, dim3(grid_blocks), dim3(NT), LDS_BYTES, stream, p);
#else
  for (int ph = 0; ph < NPHASE; ++ph) {
    p.phase_begin = ph; p.phase_end = ph + 1;
    hipLaunchKernelGGL(mega, dim3(grid_blocks), dim3(NT), LDS_BYTES, stream, p);
  }
#endif
}
```

```cpp
#include <hip/hip_runtime.h>
#include <hip/hip_cooperative_groups.h>
#include <stdint.h>
#include <stdio.h>
namespace cg = cooperative_groups;

#ifndef ONE_LAUNCH
#define ONE_LAUNCH 1
#endif

#ifndef PH_MASK
#define PH_MASK 0xFFF
#endif
#ifndef PROBE_ST
#define PROBE_ST -1
#endif
#ifndef PROBE_REP
#define PROBE_REP 0
#endif
#ifndef PROBE_PHMAX
#define PROBE_PHMAX 0
#endif
#ifndef PROBE_PHMIN
#define PROBE_PHMIN 0
#endif
#ifndef PROBE_TYPE
#define PROBE_TYPE -1
#endif
#ifndef PROBE_LO
#define PROBE_LO 0
#endif
#ifndef PROBE_HI
#define PROBE_HI 100000
#endif
#define DEV __device__ __forceinline__
typedef unsigned short bf16_t;
typedef short bf16x8 __attribute__((ext_vector_type(8)));
typedef float f32x16 __attribute__((ext_vector_type(16)));
typedef unsigned u32x4 __attribute__((ext_vector_type(4)));
typedef float f32x4 __attribute__((ext_vector_type(4)));

constexpr int NT = 512;
constexpr int T_ALL = 16384, TH = 8192, SEQ = 4096, DM = 1024, NPAD = 7168, DI = 2048, NIN = 6960;
constexpr int A_Q = 0, A_K = 512, A_V = 640, A_Z = 768, H_Q = 1280, H_FF = 1792, H_FB = 2304, H_I = 2816, H_Z = 3328,
              S_X = 3840, S_Z = 4864, G_Q = 5376, G_K = 5632, G_V = 5888, G_Z = 6400, SM0 = 6912;
constexpr size_t OFF_CTRL = 0, OFF_TAB = 65536, OFF_XB = 131072;
constexpr size_t OFF_WIN = OFF_XB + (size_t)T_ALL * DM * 2;
constexpr size_t OFF_WOUT = OFF_WIN + (size_t)NPAD * DM * 2;
constexpr size_t OFF_H = OFF_WOUT + (size_t)DM * DI * 2;
constexpr size_t OFF_SMALL = OFF_H + (size_t)TH * NPAD * 2;
constexpr size_t OFF_OBUF = OFF_SMALL + (size_t)TH * 48 * 4;
constexpr size_t OFF_VT = OFF_OBUF + (size_t)6 * TH * 512 * 2;
constexpr size_t OFF_DB = OFF_VT + (size_t)2 * 2 * 64 * SEQ * 2;
constexpr int NSEG = 8, SLEN = 64 / NSEG;
constexpr size_t OFF_MIXED = OFF_DB + (size_t)64 * NSEG * 128 * 4;
constexpr size_t OFF_SB0 = OFF_MIXED, OFF_SB1 = OFF_SB0 + (size_t)16 * NSEG * 16384 * 2, OFF_SB2 = OFF_SB1 + (size_t)16 * NSEG * 8192 * 2;
constexpr size_t OFF_U = OFF_SB2 + (size_t)32 * NSEG * 8192 * 2;
constexpr size_t OFF_G = OFF_U + (size_t)TH * 1024 * 2;
constexpr size_t WS_END = (OFF_G + (size_t)TH * 512 * 2 > OFF_MIXED + (size_t)TH * DI * 2) ? (OFF_G + (size_t)TH * 512 * 2) : (OFF_MIXED + (size_t)TH * DI * 2);
static_assert(OFF_MIXED + (size_t)TH * DI * 2 <= WS_END, "MIXED must fit");
static_assert(WS_END <= 268435456, "workspace");
constexpr size_t CTRL_BYTES = 65536;
constexpr int CTR_WORD0 = 4096;
constexpr int LDS_BYTES = 148480;
constexpr float LOG2E = 1.4426950408889634f;
constexpr float QSCALE = 0.125f * LOG2E;
constexpr float DN_ALPHA = 1.4142135623730951f;
constexpr int NPHASE = 23;
constexpr int ATT_SPLIT = 256;

struct Params {
  const float* x; const float* w_in; const float* q_gain; const float* k_gain; const float* lb_logits; const float* hgrn_norm;
  const float* conv_w; const float* conv_b; const float* dt_bias; const float* a_log; const float* ssd_d; const float* ssd_norm;
  const float* gk_w2; const float* gk_b; const float* gla_norm; const float* w_out; const float* ln_g; const float* ln_b;
  float* out; unsigned char* ws;
  int phase_begin, phase_end;
};
#define GAS __attribute__((address_space(1)))
struct ParamsG {
  GAS const float* x; GAS const float* w_in; GAS const float* q_gain; GAS const float* k_gain; GAS const float* lb_logits; GAS const float* hgrn_norm;
  GAS const float* conv_w; GAS const float* conv_b; GAS const float* dt_bias; GAS const float* a_log; GAS const float* ssd_d; GAS const float* ssd_norm;
  GAS const float* gk_w2; GAS const float* gk_b; GAS const float* gla_norm; GAS const float* w_out; GAS const float* ln_g; GAS const float* ln_b;
  GAS float* out; GAS unsigned char* ws;
};

DEV void lds_barrier() { asm volatile("s_waitcnt lgkmcnt(0)" ::: "memory"); __builtin_amdgcn_s_barrier(); asm volatile("" ::: "memory"); }
DEV int launder(int v) { asm volatile("" : "+v"(v)); return v; }
DEV float bf2f(bf16_t v) { return __uint_as_float(((unsigned)v) << 16); }
DEV bf16_t f2bf(float f) { unsigned u = __float_as_uint(f); u += 0x7fffu + ((u >> 16) & 1u); return (bf16_t)(u >> 16); }
typedef __bf16 bf16x2_t __attribute__((ext_vector_type(2)));
typedef float f32x2_t __attribute__((ext_vector_type(2)));
DEV unsigned pk2(float lo, float hi) { const f32x2_t f = {lo, hi}; const bf16x2_t b = __builtin_convertvector(f, bf16x2_t); return __builtin_bit_cast(unsigned, b); }
DEV float fsigmoid(float x) { return 1.f / (1.f + __expf(-x)); }
DEV float fsilu(float x) { return x / (1.f + __expf(-x)); }
DEV unsigned cvtpk(float lo, float hi) { return pk2(lo, hi); }
DEV float ex2(float x) { return __builtin_amdgcn_exp2f(x); }
DEV float lg2(float x) { return __builtin_amdgcn_logf(x); }
DEV float frcp(float x) { return __builtin_amdgcn_rcpf(x); }
DEV float lo16(unsigned u) { return __uint_as_float(u << 16); }
DEV float hi16(unsigned u) { return __uint_as_float(u & 0xffff0000u); }
DEV int rowoff(int reg, int h) { return (reg & 3) + 8 * (reg >> 2) + 4 * h; }
DEV f32x16 zero16() { f32x16 z;
#pragma unroll
  for (int i = 0; i < 16; ++i) z[i] = 0.f; return z; }

template <int KD>
DEV void mma32(f32x16& acc, const bf16_t* a, int lda, const bf16_t* b, int ldb, int lane) {
  const int r = lane & 31, h = lane >> 5;
  const bf16_t* ap = a + r * lda + 8 * h;
  const bf16_t* bp = b + r * ldb + 8 * h;
#pragma unroll 1
  for (int k0 = 0; k0 < KD; k0 += 64) {
    bf16x8 av[4], bv[4];
#pragma unroll
    for (int j = 0; j < 4; ++j) { av[j] = *(const bf16x8*)(ap + k0 + 16 * j); bv[j] = *(const bf16x8*)(bp + k0 + 16 * j); }
    __builtin_amdgcn_sched_barrier(0);
#pragma unroll
    for (int j = 0; j < 4; ++j) acc = __builtin_amdgcn_mfma_f32_32x32x16_bf16(av[j], bv[j], acc, 0, 0, 0);
  }
}

DEV int orig_col(int n) {
  if (n < 4864) return n;
  if (n < 6400) return n + 16;
  if (n < 6912) return n + 48;
  if (n < 6928) return n - 2048;
  if (n < 6960) return n - 512;
  return -1;
}

DEV void convert_weights(const ParamsG& p, int l, int which, unsigned char* smem) {
  float* s = (float*)smem;
  const int tid = launder(threadIdx.x);
  const float* win = (const float*)(p.w_in + (size_t)l * DM * NIN);
  const float* wout = (const float*)(p.w_out + (size_t)l * DI * DM);
  bf16_t* wint = (bf16_t*)(p.ws + OFF_WIN);
  bf16_t* woutt = (bf16_t*)(p.ws + OFF_WOUT);
  const int n_in_tiles = (NPAD / 64) * (DM / 64);
  const int n_out_tiles = (DM / 64) * (DI / 64);
  const int it_lo = (which & 1) ? 0 : n_in_tiles, it_hi = (which & 2) ? (n_in_tiles + n_out_tiles) : n_in_tiles;
  for (int it = it_lo + blockIdx.x; it < it_hi; it += gridDim.x) {
    lds_barrier();
    if (it < n_in_tiles) {
      const int n0 = (it / 16) * 64, k0 = (it % 16) * 64;
#pragma unroll
      for (int e = 0; e < 8; ++e) {
        const int idx = e * NT + tid, kk = idx >> 6, nn = idx & 63;
        const int oc = orig_col(n0 + nn);
        s[kk * 65 + nn] = (oc >= 0) ? win[(size_t)(k0 + kk) * NIN + oc] : 0.f;
      }
      lds_barrier();
      const int n = tid >> 3, kc = (tid & 7) * 8;
      uint4 o;
      o.x = pk2(s[(kc + 0) * 65 + n], s[(kc + 1) * 65 + n]); o.y = pk2(s[(kc + 2) * 65 + n], s[(kc + 3) * 65 + n]);
      o.z = pk2(s[(kc + 4) * 65 + n], s[(kc + 5) * 65 + n]); o.w = pk2(s[(kc + 6) * 65 + n], s[(kc + 7) * 65 + n]);
      *(uint4*)(wint + (size_t)(n0 + n) * DM + k0 + kc) = o;
    } else {
      const int j = it - n_in_tiles;
      const int n0 = (j / 32) * 64, k0 = (j % 32) * 64;
#pragma unroll
      for (int e = 0; e < 8; ++e) {
        const int idx = e * NT + tid, kk = idx >> 6, nn = idx & 63;
        s[kk * 65 + nn] = wout[(size_t)(k0 + kk) * DM + n0 + nn];
      }
      lds_barrier();
      const int n = tid >> 3, kc = (tid & 7) * 8;
      uint4 o;
      o.x = pk2(s[(kc + 0) * 65 + n], s[(kc + 1) * 65 + n]); o.y = pk2(s[(kc + 2) * 65 + n], s[(kc + 3) * 65 + n]);
      o.z = pk2(s[(kc + 4) * 65 + n], s[(kc + 5) * 65 + n]); o.w = pk2(s[(kc + 6) * 65 + n], s[(kc + 7) * 65 + n]);
      *(uint4*)(woutt + (size_t)(n0 + n) * DI + k0 + kc) = o;
    }
  }
  lds_barrier();
}

DEV void fsincos(float x, float& s, float& c) {
  const float k = rintf(x * 0.63661977236758134308f);
  float r = fmaf(-k, 1.5707855225e+00f, x);
  r = fmaf(-k, 1.0804273188e-05f, r);
  r = fmaf(-k, 6.0770999344e-11f, r);
  const float r2 = r * r;
  float ps = fmaf(r2, 2.7557319224e-06f, -1.9841269841e-04f);
  ps = fmaf(ps, r2, 8.3333333333e-03f); ps = fmaf(ps, r2, -1.6666666667e-01f);
  const float sinr = fmaf(ps * r2, r, r);
  float pc = fmaf(r2, -2.7557319224e-07f, 2.4801587302e-05f);
  pc = fmaf(pc, r2, -1.3888888889e-03f); pc = fmaf(pc, r2, 4.1666666667e-02f); pc = fmaf(pc, r2, -0.5f);
  const float cosr = fmaf(pc, r2, 1.0f);
  const int q = ((int)k) & 3;
  if (q == 0) { s = sinr; c = cosr; }
  else if (q == 1) { s = cosr; c = -sinr; }
  else if (q == 2) { s = -sinr; c = -cosr; }
  else { s = -cosr; c = sinr; }
}

DEV void phase_pro(const ParamsG& p, unsigned char* smem) {
  const int tid = launder(threadIdx.x);
  const size_t gtid = (size_t)blockIdx.x * NT + tid, gsz = (size_t)gridDim.x * NT;
  const float4* x4 = (const float4*)p.x;
  uint4* xb4 = (uint4*)(p.ws + OFF_XB);
  for (size_t i = gtid; i < (size_t)T_ALL * DM / 8; i += gsz) {
    const float4 a = x4[2 * i], b = x4[2 * i + 1];
    uint4 o; o.x = pk2(a.x, a.y); o.y = pk2(a.z, a.w); o.z = pk2(b.x, b.y); o.w = pk2(b.z, b.w);
    xb4[i] = o;
  }
  if (blockIdx.x == 0) {
    float2* tab = (float2*)(p.ws + OFF_TAB);
    for (int i = tid; i < 64 * 16; i += NT) {
      const int pos = i >> 4, fi = i & 15;
      const float invf = exp2f(-(float)fi * (13.287712379549449f / 16.0f));
      const float ang = (float)pos * invf;
      float sn, cs; fsincos(ang, sn, cs);
      tab[i] = make_float2(cs, sn);
    }
  }
}

namespace pg8 {
#define PG8_LAS __attribute__((address_space(3)))
typedef unsigned short bf16_t;
typedef short bf16x8 __attribute__((ext_vector_type(8)));
typedef float f32x4 __attribute__((ext_vector_type(4)));
typedef unsigned u32x4 __attribute__((ext_vector_type(4)));
constexpr int BM = 256, BK = 64, HALF = 128, HTB = HALF * BK * 2  , STAGE_BYTES = 8 * HTB, NXCD = 8, WGM = 8;

__host__ __device__ __forceinline__ int lds_byte(int r, int c) { const int st = (r >> 4) * 2 + (c >> 5), rr = r & 15, cc = c & 31, ob = rr * 64 + cc * 2; return st * 1024 + (ob ^ (((ob >> 9) & 1) << 5)); }
__host__ __device__ __forceinline__ void stage_rc(int b, int& R, int& C) { const int st = b / 1024, sb = b % 1024, swz = sb ^ (((sb >> 9) & 1) << 5); R = (st >> 1) * 16 + swz / 64; C = (st & 1) * 32 + (swz % 64) / 2; }
__host__ __device__ __forceinline__ int perm32(int rho) { const int n = rho >> 4, i = rho & 15; return 8 * (i >> 2) + 4 * n + (i & 3); }

struct Unit { int pm, pn; };
struct Gemm { const bf16_t* A; const bf16_t* Bt; int M, N, K; };

__device__ __forceinline__ unsigned cvt_pk_bf16(float lo, float hi) { unsigned r; asm volatile("v_cvt_pk_bf16_f32 %0, %1, %2" : "=v"(r) : "v"(lo), "v"(hi)); return r; }

struct XcdOrder {
    int rpx, nN, x, c, ncu, skew;
    __device__ void init(int M, int N, int skew_ = 0) { rpx = (M / BM) / NXCD; nN = N / BM; x = blockIdx.x & 7; c = blockIdx.x >> 3; ncu = gridDim.x >> 3; skew = skew_; }
    __device__ bool next(int i, Unit& u) const {
        const int total = rpx * nN, full = (total / ncu) * ncu;
        int j = c + i * ncu;
        if (skew < 0 && j >= full) return false;
        if (skew > 0 && j >= full) { const int cc = c - skew; j = (cc >= 0 && i == total / ncu) ? full + cc : total; }
        if (j >= total) return false; u.pm = rpx * x + (j % rpx); u.pn = j / rpx; return true; }
    __device__ bool tail(int q, Unit& u, int& hh) const {
        const int total = rpx * nN, full = (total / ncu) * ncu, left = total - full;
        if (q >= 2 * left) return false;
        const int j = full + (q % left); hh = q / left; u.pm = rpx * x + (j % rpx); u.pn = j / rpx; return true; }
    __device__ __forceinline__ void a_ready(const Unit&) const {}
    __device__ __forceinline__ void done(const Unit&) const {}
};
struct EpiIn {
    static constexpr bool PERM = true, AFTER_DRAIN = false;
    bf16_t* O; int ldc; float* small; int small_pn;
    __device__ __forceinline__ void one(const f32x4 (&a)[2][4][2], int pn, int row0, int wc, int fq) const {
        const int col0 = pn * BM + wc * 32 + 8 * fq;
        if (pn == small_pn) {
            const int c = wc * 32 + 8 * fq;
            if (c < 48) {
#pragma unroll
                for (int m = 0; m < 4; ++m) { float* rp = small + (size_t)(row0 + m * 16) * 48 + c; *(f32x4*)rp = a[0][m][0]; *(f32x4*)(rp + 4) = a[0][m][1]; }
            }
            return;
        }
        const int act = (pn == 5 || pn == 6) ? 1 : ((pn == 21) ? 2 : 0);
#pragma unroll
        for (int m = 0; m < 4; ++m) { bf16_t* rowp = O + (size_t)(row0 + m * 16) * ldc + col0;
#pragma unroll
            for (int bj = 0; bj < 2; ++bj) { f32x4 v0 = a[bj][m][0], v1 = a[bj][m][1];
                if (act == 1) {
#pragma unroll
                    for (int e = 0; e < 4; ++e) {
                        v0[e] = v0[e] * __builtin_amdgcn_rcpf(1.f + __builtin_amdgcn_exp2f(fminf(-v0[e] * 1.4426950408889634f, 80.f))) * 0.08838834764831845f;
                        v1[e] = v1[e] * __builtin_amdgcn_rcpf(1.f + __builtin_amdgcn_exp2f(fminf(-v1[e] * 1.4426950408889634f, 80.f))) * 0.08838834764831845f; }
                } else if (act == 2) { v0 = v0 * 0.125f; v1 = v1 * 0.125f; }
                u32x4 w; w.x = cvt_pk_bf16(v0[0], v0[1]); w.y = cvt_pk_bf16(v0[2], v0[3]); w.z = cvt_pk_bf16(v1[0], v1[1]); w.w = cvt_pk_bf16(v1[2], v1[3]);
                *(u32x4*)(rowp + bj * HALF) = w; } }
    }
    __device__ __forceinline__ void operator()(const f32x4 (&acc)[2][2][4][2], const Unit& u, int wr, int wc, int fr, int fq) const {
        const int row0 = u.pm * BM + wr * 64 + fr;
#pragma unroll
        for (int ai = 0; ai < 2; ++ai) one(acc[ai], u.pn, row0 + ai * HALF, wc, fq);
    }
};
struct EpiOut {
    static constexpr bool PERM = true, AFTER_DRAIN = false;
    const float* X; float* Y; int ldc; float alpha;
    __device__ __forceinline__ void one(const f32x4 (&a)[2][4][2], int pn, int row0, int wc, int fq) const {
        const int col0 = pn * BM + wc * 32 + 8 * fq;
#pragma unroll
        for (int m = 0; m < 4; ++m) { const size_t off = (size_t)(row0 + m * 16) * ldc + col0;
#pragma unroll
            for (int bj = 0; bj < 2; ++bj) { const f32x4 x0 = *(const f32x4*)(X + off + bj * HALF), x1 = *(const f32x4*)(X + off + bj * HALF + 4);
                *(f32x4*)(Y + off + bj * HALF) = x0 * alpha + a[bj][m][0]; *(f32x4*)(Y + off + bj * HALF + 4) = x1 * alpha + a[bj][m][1]; } }
    }
    __device__ __forceinline__ void operator()(const f32x4 (&acc)[2][2][4][2], const Unit& u, int wr, int wc, int fr, int fq) const {
        const int row0 = u.pm * BM + wr * 64 + fr;
#pragma unroll
        for (int ai = 0; ai < 2; ++ai) one(acc[ai], u.pn, row0 + ai * HALF, wc, fq);
    }
};

template <class Epi, class Sched, bool ALIGN_EPI = false, bool SP2 = false>
__device__ __forceinline__ void gemm_phase(PG8_LAS unsigned char* lds, const Gemm g, const Sched& S, const Epi& E) {
    const int tid = launder((int)threadIdx.x), wid = __builtin_amdgcn_readfirstlane(tid >> 6), lane = tid & 63, wr = wid >> 2, wc = wid & 3, fr = lane & 15, fq = lane >> 4;
    const int K = g.K, nt = K / BK;
    unsigned voffA[2], voffB[2];
#pragma unroll
    for (int i = 0; i < 2; ++i) { int R, C; stage_rc(tid * 16 + i * 8192, R, C); const int Rb = Epi::PERM ? ((R & ~31) + perm32(R & 31)) : R;
        voffA[i] = (unsigned)(R * K + C) * 2u; voffB[i] = (unsigned)(Rb * K + C) * 2u; }
    const size_t kstep = (size_t)(BK * 2);
    const size_t hstep = (size_t)HALF * K * 2;
    const size_t tstep = 2 * hstep;
    const unsigned ldsw = (unsigned)wid * 1024u;
    const int aoff = lds_byte(wr * 64 + fr, fq * 8), boff = lds_byte(wc * 32 + fr, fq * 8);
#define PG8_SA(b, h) (((b) * 2 + (h)) * HTB)
#define PG8_SB(b, h) ((4 + (b) * 2 + (h)) * HTB)
#define PG8_STAGE(bufoff, gbase, voff) do { _Pragma("unroll") for (int _i = 0; _i < 2; ++_i) \
        __builtin_amdgcn_global_load_lds((const unsigned*)((const char*)(gbase) + (voff)[_i]), (PG8_LAS unsigned*)(lds + (bufoff) + ldsw + _i * 8192), 16, 0, 0); } while (0)
#define PG8_LDA(dst, b, h) do { _Pragma("unroll") for (int m = 0; m < 4; ++m) _Pragma("unroll") for (int k = 0; k < 2; ++k) dst[m][k] = *(const PG8_LAS bf16x8*)(lds + PG8_SA(b, h) + aoff + m * 2048 + k * 1024); } while (0)
#define PG8_LDB(dst, b, h) do { _Pragma("unroll") for (int n = 0; n < 2; ++n) _Pragma("unroll") for (int k = 0; k < 2; ++k) dst[n][k] = *(const PG8_LAS bf16x8*)(lds + PG8_SB(b, h) + boff + n * 2048 + k * 1024); } while (0)
#define PG8_MMA(ai, bj, At, Bt) do { __builtin_amdgcn_s_setprio(1); _Pragma("unroll") for (int m = 0; m < 4; ++m) _Pragma("unroll") for (int n = 0; n < 2; ++n) _Pragma("unroll") for (int k = 0; k < 2; ++k) \
        acc[ai][bj][m][n] = __builtin_amdgcn_mfma_f32_16x16x32_bf16(Bt[n][k], At[m][k], acc[ai][bj][m][n], 0, 0, 0); __builtin_amdgcn_s_setprio(0); } while (0)
#define PG8_WAIT_V(n) asm volatile("s_waitcnt vmcnt(" #n ")" ::: "memory")
#define PG8_WAIT_L(n) asm volatile("s_waitcnt lgkmcnt(" #n ")" ::: "memory")
#define PG8_BAR __builtin_amdgcn_s_barrier()
#define PG8_SCHED __builtin_amdgcn_sched_barrier(0)
    Unit cur, nxt; int ui = 0;
    if (!S.next(0, cur)) return;
    f32x4 acc[2][2][4][2];
#pragma unroll
    for (int a = 0; a < 2; ++a)
#pragma unroll
        for (int b = 0; b < 2; ++b)
#pragma unroll
            for (int m = 0; m < 4; ++m)
#pragma unroll
                for (int n = 0; n < 2; ++n) acc[a][b][m][n] = (f32x4){0.f, 0.f, 0.f, 0.f};
    bf16x8 At[4][2], B0[2][2], B1[2][2];
    const char* cA = (const char*)g.A + (size_t)cur.pm * tstep; const char* cB = (const char*)g.Bt + (size_t)cur.pn * tstep;
    S.a_ready(cur);
    if constexpr (SP2) {
        PG8_STAGE(PG8_SB(0, 0), cB, voffB); PG8_STAGE(PG8_SB(0, 1), cB + hstep, voffB); PG8_STAGE(PG8_SA(0, 0), cA, voffA); PG8_STAGE(PG8_SA(0, 1), cA + hstep, voffA);
        if (wr == 1) PG8_BAR;
        PG8_WAIT_V(2); PG8_BAR;
        PG8_STAGE(PG8_SB(1, 0), cB + kstep, voffB); PG8_STAGE(PG8_SA(1, 0), cA + kstep, voffA); PG8_STAGE(PG8_SB(1, 1), cB + hstep + kstep, voffB);
        PG8_WAIT_V(6); PG8_BAR;
    } else {
        PG8_STAGE(PG8_SB(0, 0), cB, voffB); PG8_STAGE(PG8_SA(0, 0), cA, voffA); PG8_STAGE(PG8_SB(0, 1), cB + hstep, voffB); PG8_STAGE(PG8_SA(0, 1), cA + hstep, voffA);
        if (wr == 1) PG8_BAR;
        PG8_WAIT_V(4); PG8_BAR;
        PG8_STAGE(PG8_SB(1, 0), cB + kstep, voffB); PG8_STAGE(PG8_SA(1, 0), cA + kstep, voffA); PG8_STAGE(PG8_SB(1, 1), cB + hstep + kstep, voffB);
        PG8_WAIT_V(6); PG8_BAR;
    }
    for (;;) {
        const bool has_next = S.next(ui + 1, nxt);
        const char* nA = has_next ? (const char*)g.A + (size_t)nxt.pm * tstep : cA; const char* nB = has_next ? (const char*)g.Bt + (size_t)nxt.pn * tstep : cB;
        for (int t = 0; t < nt; t += 2) {
            const bool last = (t == nt - 2);
            const char* a1 = cA + (size_t)(t + 1) * kstep;
            const char* a2 = last ? nA : cA + (size_t)(t + 2) * kstep; const char* b2 = last ? nB : cB + (size_t)(t + 2) * kstep;
            const char* a3 = a2 + kstep; const char* b3 = b2 + kstep;
            if (last && has_next) S.a_ready(nxt);
            if constexpr (SP2) {
            PG8_LDB(B0, 0, 0); PG8_LDB(B1, 0, 1); PG8_SCHED; PG8_LDA(At, 0, 0); PG8_STAGE(PG8_SA(1, 1), a1 + hstep, voffA);
            PG8_WAIT_V(8); PG8_WAIT_L(0); PG8_BAR; PG8_MMA(0, 0, At, B0); PG8_MMA(0, 1, At, B1); PG8_BAR; PG8_SCHED;
            PG8_LDA(At, 0, 1); PG8_STAGE(PG8_SB(0, 0), b2, voffB); PG8_STAGE(PG8_SB(0, 1), b2 + hstep, voffB); PG8_STAGE(PG8_SA(0, 0), a2, voffA);
            PG8_WAIT_V(8); PG8_WAIT_L(0); PG8_BAR; PG8_MMA(1, 0, At, B0); PG8_MMA(1, 1, At, B1); PG8_BAR; PG8_SCHED;
            PG8_LDB(B0, 1, 0); PG8_LDB(B1, 1, 1); PG8_SCHED; PG8_LDA(At, 1, 0); PG8_STAGE(PG8_SA(0, 1), a2 + hstep, voffA);
            PG8_WAIT_V(8); PG8_WAIT_L(0); PG8_BAR; PG8_MMA(0, 0, At, B0); PG8_MMA(0, 1, At, B1); PG8_BAR; PG8_SCHED;
            PG8_LDA(At, 1, 1); PG8_STAGE(PG8_SB(1, 0), b3, voffB); PG8_STAGE(PG8_SB(1, 1), b3 + hstep, voffB); PG8_STAGE(PG8_SA(1, 0), a3, voffA);
            PG8_WAIT_V(8); PG8_WAIT_L(0); PG8_BAR; PG8_MMA(1, 0, At, B0); PG8_MMA(1, 1, At, B1); PG8_BAR; PG8_SCHED;
            } else {
            PG8_LDB(B0, 0, 0); PG8_SCHED; PG8_LDA(At, 0, 0); PG8_STAGE(PG8_SA(1, 1), a1 + hstep, voffA);
            PG8_WAIT_L(8); PG8_BAR; PG8_WAIT_L(0); PG8_MMA(0, 0, At, B0); PG8_BAR; PG8_SCHED;
            PG8_LDB(B1, 0, 1); PG8_STAGE(PG8_SB(0, 0), b2, voffB);
            PG8_BAR; PG8_WAIT_L(0); PG8_MMA(0, 1, At, B1); PG8_BAR;
            PG8_LDA(At, 0, 1); PG8_STAGE(PG8_SA(0, 0), a2, voffA);
            PG8_BAR; PG8_WAIT_L(0); PG8_MMA(1, 0, At, B0); PG8_BAR; PG8_SCHED;
            PG8_STAGE(PG8_SB(0, 1), b2 + hstep, voffB);
            PG8_WAIT_V(6); PG8_BAR; PG8_MMA(1, 1, At, B1); PG8_BAR;
            PG8_LDB(B0, 1, 0); PG8_SCHED; PG8_LDA(At, 1, 0); PG8_STAGE(PG8_SA(0, 1), a2 + hstep, voffA);
            PG8_WAIT_L(8); PG8_BAR; PG8_WAIT_L(0); PG8_MMA(0, 0, At, B0); PG8_BAR; PG8_SCHED;
            PG8_LDB(B1, 1, 1); PG8_STAGE(PG8_SB(1, 0), b3, voffB);
            PG8_BAR; PG8_WAIT_L(0); PG8_MMA(0, 1, At, B1); PG8_BAR;
            PG8_LDA(At, 1, 1); PG8_STAGE(PG8_SA(1, 0), a3, voffA);
            PG8_BAR; PG8_WAIT_L(0); PG8_MMA(1, 0, At, B0); PG8_BAR; PG8_SCHED;
            PG8_STAGE(PG8_SB(1, 1), b3 + hstep, voffB);
            PG8_WAIT_V(6); PG8_BAR; PG8_MMA(1, 1, At, B1); PG8_BAR;
            }
        }
        if constexpr (ALIGN_EPI) { if (wr == 0) PG8_BAR; }
        if constexpr (!Epi::AFTER_DRAIN) { E(acc, cur, wr, wc, fr, fq); S.done(cur); }
        if (!has_next) break;
#pragma unroll
        for (int a = 0; a < 2; ++a)
#pragma unroll
            for (int b = 0; b < 2; ++b)
#pragma unroll
                for (int m = 0; m < 4; ++m)
#pragma unroll
                    for (int n = 0; n < 2; ++n) acc[a][b][m][n] = (f32x4){0.f, 0.f, 0.f, 0.f};
        cur = nxt; cA = nA; cB = nB; ++ui;
        if constexpr (ALIGN_EPI) { if (wr == 1) PG8_BAR; }
    }
    PG8_WAIT_V(0);
    if constexpr (!ALIGN_EPI) { if (wr == 0) PG8_BAR; }
    PG8_BAR;
    if constexpr (Epi::AFTER_DRAIN) { E.fused(acc, cur, wr, wc, fr, fq, lds, wid, lane); S.done(cur); }
#undef PG8_SA
#undef PG8_SB
#undef PG8_STAGE
#undef PG8_LDA
#undef PG8_LDB
#undef PG8_MMA
#undef PG8_WAIT_V
#undef PG8_WAIT_L
#undef PG8_BAR
#undef PG8_SCHED
}

template <class Epi>
__device__ __forceinline__ void gemm_half(PG8_LAS unsigned char* lds, const Gemm g, int pm, int pn, int hh, const Epi& E) {
    const int tid = launder((int)threadIdx.x), wid = __builtin_amdgcn_readfirstlane(tid >> 6), lane = tid & 63, wr = wid >> 2, wc = wid & 3, fr = lane & 15, fq = lane >> 4;
    const int K = g.K, nt = K / BK;
    unsigned voffA[2], voffB[2];
#pragma unroll
    for (int i = 0; i < 2; ++i) { int R, C; stage_rc(tid * 16 + i * 8192, R, C); const int Rb = Epi::PERM ? ((R & ~31) + perm32(R & 31)) : R;
        voffA[i] = (unsigned)(R * K + C) * 2u; voffB[i] = (unsigned)(Rb * K + C) * 2u; }
    const size_t kstep = (size_t)(BK * 2);
    const size_t hstep = (size_t)HALF * K * 2;
    const unsigned ldsw = (unsigned)wid * 1024u;
    const int aoff = lds_byte(wr * 64 + fr, fq * 8), boff = lds_byte(wc * 32 + fr, fq * 8);
    constexpr int SETB = 3 * HTB;
#define HU_STAGE(bufoff, gbase, voff) do { _Pragma("unroll") for (int _i = 0; _i < 2; ++_i) \
        __builtin_amdgcn_global_load_lds((const unsigned*)((const char*)(gbase) + (voff)[_i]), (PG8_LAS unsigned*)(lds + (bufoff) + ldsw + _i * 8192), 16, 0, 0); } while (0)
#define HU_STAGE3(so, kt) do { HU_STAGE((so), cB + (size_t)(kt) * kstep, voffB); HU_STAGE((so) + HTB, cB + hstep + (size_t)(kt) * kstep, voffB); HU_STAGE((so) + 2 * HTB, cA + (size_t)(kt) * kstep, voffA); } while (0)
#define HU_LDA(dst, so) do { _Pragma("unroll") for (int m = 0; m < 4; ++m) _Pragma("unroll") for (int k = 0; k < 2; ++k) dst[m][k] = *(const PG8_LAS bf16x8*)(lds + (so) + 2 * HTB + aoff + m * 2048 + k * 1024); } while (0)
#define HU_LDB(dst, so, h) do { _Pragma("unroll") for (int n = 0; n < 2; ++n) _Pragma("unroll") for (int k = 0; k < 2; ++k) dst[n][k] = *(const PG8_LAS bf16x8*)(lds + (so) + (h) * HTB + boff + n * 2048 + k * 1024); } while (0)
#define HU_MMA(bj, At, Bt) do { __builtin_amdgcn_s_setprio(1); _Pragma("unroll") for (int m = 0; m < 4; ++m) _Pragma("unroll") for (int n = 0; n < 2; ++n) _Pragma("unroll") for (int k = 0; k < 2; ++k) \
        acc[bj][m][n] = __builtin_amdgcn_mfma_f32_16x16x32_bf16(Bt[n][k], At[m][k], acc[bj][m][n], 0, 0, 0); __builtin_amdgcn_s_setprio(0); } while (0)
#define HU_WAIT_V(n) asm volatile("s_waitcnt vmcnt(" #n ")" ::: "memory")
#define HU_WAIT_L(n) asm volatile("s_waitcnt lgkmcnt(" #n ")" ::: "memory")
#define HU_BAR __builtin_amdgcn_s_barrier()
#define HU_SCHED __builtin_amdgcn_sched_barrier(0)
    f32x4 acc[2][4][2];
#pragma unroll
    for (int b = 0; b < 2; ++b)
#pragma unroll
        for (int m = 0; m < 4; ++m)
#pragma unroll
            for (int n = 0; n < 2; ++n) acc[b][m][n] = (f32x4){0.f, 0.f, 0.f, 0.f};
    bf16x8 At[4][2], B0[2][2], B1[2][2];
    const char* cA = (const char*)g.A + ((size_t)pm * 2 + hh) * hstep; const char* cB = (const char*)g.Bt + (size_t)pn * 2 * hstep;
    HU_STAGE3(0, 0);
    if (wr == 1) HU_BAR;
    HU_WAIT_V(0); HU_BAR;
    HU_STAGE3(SETB, 1);
    HU_BAR;
    int so = 0, so2 = 2 * SETB;
    for (int t = 0; t < nt; ++t) {
        HU_LDB(B0, so, 0); HU_LDB(B1, so, 1); HU_SCHED; HU_LDA(At, so);
        if (t + 2 < nt) { HU_STAGE3(so2, t + 2); HU_WAIT_V(6); } else { HU_WAIT_V(0); }
        HU_WAIT_L(0); HU_BAR; HU_MMA(0, At, B0); HU_MMA(1, At, B1); HU_BAR; HU_SCHED;
        so = (so == 2 * SETB) ? 0 : so + SETB; so2 = (so2 == 2 * SETB) ? 0 : so2 + SETB;
    }
    if (wr == 0) HU_BAR;
    E.one(acc, pn, pm * BM + hh * HALF + wr * 64 + fr, wc, fq);
    HU_BAR;
#undef HU_STAGE
#undef HU_STAGE3
#undef HU_LDA
#undef HU_LDB
#undef HU_MMA
#undef HU_WAIT_V
#undef HU_WAIT_L
#undef HU_BAR
#undef HU_SCHED
}
}

DEV void phase_inproj(const ParamsG& p, int l, int hf, int skew, unsigned char* smem) {
  pg8::Gemm g{(const bf16_t*)(p.ws + OFF_XB) + (size_t)hf * TH * DM, (const bf16_t*)(p.ws + OFF_WIN), TH, NPAD, DM};
  pg8::XcdOrder S; S.init(TH, NPAD, -1);
  pg8::EpiIn E{(bf16_t*)(p.ws + OFF_H), NPAD, (float*)(p.ws + OFF_SMALL), SM0 / 256};
  pg8::gemm_phase<pg8::EpiIn, pg8::XcdOrder, true, true>((PG8_LAS unsigned char*)smem, g, S, E);
  for (int q = S.c; ; q += S.ncu) { pg8::Unit u; int hh; if (!S.tail(q, u, hh)) break; pg8::gemm_half<pg8::EpiIn>((PG8_LAS unsigned char*)smem, g, u.pm, u.pn, hh, E); }
}

DEV void phase_outproj(const ParamsG& p, int l, int hf, unsigned char* smem) {
  pg8::Gemm g{(const bf16_t*)(p.ws + OFF_MIXED), (const bf16_t*)(p.ws + OFF_WOUT), TH, DM, DI};
  pg8::XcdOrder S; S.init(TH, DM, -1);
  const float* xin = (const float*)(((l == 0) ? p.x : (GAS const float*)p.out) + (size_t)hf * TH * DM);
  pg8::EpiOut E{xin, (float*)(p.out + (size_t)hf * TH * DM), DM, DN_ALPHA};
  const int total = S.rpx * S.nN;
  for (int q = S.c; q < 2 * total; q += S.ncu) {
    const int j = q % total, hh = q / total;
    pg8::gemm_half<pg8::EpiOut>((PG8_LAS unsigned char*)smem, g, S.rpx * S.x + (j % S.rpx), j / S.rpx, hh, E);
  }
}

DEV void phase_ln(const ParamsG& p, int l, int hf) {
  const int tid = launder(threadIdx.x), lane = tid & 63, w = tid >> 6;
  const float* g = (const float*)(p.ln_g + l * DM); const float* b = (const float*)(p.ln_b + l * DM);
  bf16_t* xb = (bf16_t*)(p.ws + OFF_XB);
  for (int r0 = (blockIdx.x * 8 + w) * 4; r0 < TH; r0 += gridDim.x * 32) {
    f32x4 v[4][4];
#pragma unroll
    for (int i = 0; i < 4; ++i)
#pragma unroll
      for (int j = 0; j < 4; ++j) v[i][j] = __builtin_nontemporal_load((const f32x4*)(p.out + (size_t)(hf * TH + r0 + i) * DM) + j * 64 + lane);
    f32x4 gg[4], bb[4];
#pragma unroll
    for (int j = 0; j < 4; ++j) { gg[j] = ((const f32x4*)g)[j * 64 + lane]; bb[j] = ((const f32x4*)b)[j * 64 + lane]; }
#pragma unroll
    for (int i = 0; i < 4; ++i) {
      const int row = hf * TH + r0 + i;
      float sm = 0.f;
#pragma unroll
      for (int j = 0; j < 4; ++j) sm += (v[i][j][0] + v[i][j][1]) + (v[i][j][2] + v[i][j][3]);
#pragma unroll
      for (int o = 32; o >= 1; o >>= 1) sm += __shfl_xor(sm, o);
      const float mu = sm * (1.f / DM);
      float q = 0.f;
#pragma unroll
      for (int j = 0; j < 4; ++j) { const f32x4 d = v[i][j] - mu; q += (d[0] * d[0] + d[1] * d[1]) + (d[2] * d[2] + d[3] * d[3]); }
#pragma unroll
      for (int o = 32; o >= 1; o >>= 1) q += __shfl_xor(q, o);
      const float rstd = rsqrtf(q * (1.f / DM) + 1e-5f);
#pragma unroll
      for (int j = 0; j < 4; ++j) {
        const f32x4 o = (v[i][j] - mu) * rstd * gg[j] + bb[j];
        ((f32x4*)(p.out + (size_t)row * DM))[j * 64 + lane] = o;
        if (l == 0) *(uint2*)(xb + (size_t)row * DM + (j * 64 + lane) * 4) = make_uint2(pk2(o[0], o[1]), pk2(o[2], o[3]));
      }
    }
  }
}

DEV void attn_item(const ParamsG& p, int l, int item, unsigned char* smem) {
  const int tid = launder(threadIdx.x), lane = tid & 63, w = tid >> 6, r = lane & 31, h = lane >> 5;
  const int qt = item & 15, head = (item >> 4) & 7, bl = item >> 7;
  const int kvh = head >> 2;
  bf16_t* Hh = (bf16_t*)(p.ws + OFF_H);
  const bf16_t* VT = (const bf16_t*)(p.ws + OFF_VT);
  const size_t rowbase = (size_t)bl * SEQ;
  float mq = fabsf(p.q_gain[l * 64 + lane]), mk = fabsf(p.k_gain[l * 64 + lane]);
#pragma unroll
  for (int o = 32; o >= 1; o >>= 1) { mq = fmaxf(mq, __shfl_xor(mq, o)); mk = fmaxf(mk, __shfl_xor(mk, o)); }
  const float M2 = 8.f * mq * mk * LOG2E * 1.01f;
  const int qrow = qt * 256 + w * 32 + r;
  const bf16_t* qp = Hh + (rowbase + qrow) * NPAD + A_Q + head * 64 + 8 * h;
  bf16x8 qf[4];
#pragma unroll
  for (int ks = 0; ks < 4; ++ks) qf[ks] = *(const bf16x8*)(qp + ks * 16);
  f32x16 o0 = zero16(), o1 = zero16();
  f32x2_t lsum2 = {0.f, 0.f};
  const int srow = tid >> 3, sch = (tid & 7) * 8;
  const bf16_t* kp = Hh + (rowbase + srow) * NPAD + A_K + kvh * 64 + sch;
  const bf16_t* vp = VT + ((size_t)((bl * 2 + kvh) * 64 + srow)) * SEQ + sch;
  union PB { bf16x8 v; unsigned u[4]; };
  auto qk = [&](int st, f32x16& s0, f32x16& s1) __attribute__((always_inline)) {
    const bf16_t* sK = (const bf16_t*)(smem + st * 18432);
#pragma unroll
    for (int i = 0; i < 16; ++i) { s0[i] = -M2; s1[i] = -M2; }
    bf16x8 a0[4], a1[4];
#pragma unroll
    for (int ks = 0; ks < 4; ++ks) { a0[ks] = *(const bf16x8*)(sK + r * 72 + ks * 16 + 8 * h); a1[ks] = *(const bf16x8*)(sK + (32 + r) * 72 + ks * 16 + 8 * h); }
    __builtin_amdgcn_sched_barrier(0);
#pragma unroll
    for (int ks = 0; ks < 4; ++ks) {
      s0 = __builtin_amdgcn_mfma_f32_32x32x16_bf16(a0[ks], qf[ks], s0, 0, 0, 0);
      s1 = __builtin_amdgcn_mfma_f32_32x32x16_bf16(a1[ks], qf[ks], s1, 0, 0, 0);
    }
  };
  auto soft = [&](f32x16& s0, f32x16& s1, PB (&pb)[2][2]) __attribute__((always_inline)) {
#pragma unroll
    for (int i = 0; i < 16; ++i) { s0[i] = __builtin_amdgcn_exp2f(s0[i]); s1[i] = __builtin_amdgcn_exp2f(s1[i]); lsum2 += (f32x2_t){s0[i], s1[i]}; }
#pragma unroll
    for (int s = 0; s < 2; ++s)
#pragma unroll
      for (int j = 0; j < 4; ++j) {
        pb[0][s].u[j] = pk2(s0[8 * s + 2 * j], s0[8 * s + 2 * j + 1]);
        pb[1][s].u[j] = pk2(s1[8 * s + 2 * j], s1[8 * s + 2 * j + 1]);
      }
  };
  auto pv = [&](int st, const PB (&pb)[2][2]) __attribute__((always_inline)) {
    const bf16_t* sV = (const bf16_t*)(smem + st * 18432 + 9216);
    union VF { bf16x8 v; uint2 u[2]; };
    VF a0[2][2], a1[2][2];
#pragma unroll
    for (int kt2 = 0; kt2 < 2; ++kt2)
#pragma unroll
      for (int s = 0; s < 2; ++s) {
        const int kb = kt2 * 32 + 16 * s + 4 * h;
        a0[kt2][s].u[0] = *(const uint2*)(sV + r * 72 + kb); a0[kt2][s].u[1] = *(const uint2*)(sV + r * 72 + kb + 8);
        a1[kt2][s].u[0] = *(const uint2*)(sV + (32 + r) * 72 + kb); a1[kt2][s].u[1] = *(const uint2*)(sV + (32 + r) * 72 + kb + 8);
      }
    __builtin_amdgcn_sched_barrier(0);
#pragma unroll
    for (int kt2 = 0; kt2 < 2; ++kt2)
#pragma unroll
      for (int s = 0; s < 2; ++s) {
        o0 = __builtin_amdgcn_mfma_f32_32x32x16_bf16(a0[kt2][s].v, pb[kt2][s].v, o0, 0, 0, 0);
        o1 = __builtin_amdgcn_mfma_f32_32x32x16_bf16(a1[kt2][s].v, pb[kt2][s].v, o1, 0, 0, 0);
      }
  };
  auto compute2 = [&](int sta, int stb) __attribute__((always_inline)) {
    f32x16 sa0, sa1, sb0, sb1; PB pa[2][2], pbb[2][2];
    qk(sta, sa0, sa1); qk(stb, sb0, sb1);
    soft(sa0, sa1, pa); pv(sta, pa);
    soft(sb0, sb1, pbb); pv(stb, pbb);
  };
  constexpr int NKT = SEQ / 64;
  auto sstore = [&](int st, const u32x4& kk, const u32x4& vv) __attribute__((always_inline)) {
    *(u32x4*)(smem + st * 18432 + srow * 144 + sch * 2) = kk;
    *(u32x4*)(smem + st * 18432 + 9216 + srow * 144 + sch * 2) = vv;
  };
  u32x4 k0 = *(const u32x4*)kp, v0 = *(const u32x4*)vp;
  u32x4 k1 = *(const u32x4*)(kp + (size_t)64 * NPAD), v1 = *(const u32x4*)(vp + 64);
  sstore(0, k0, v0); sstore(1, k1, v1);
  k0 = *(const u32x4*)(kp + (size_t)2 * 64 * NPAD); v0 = *(const u32x4*)(vp + 2 * 64);
  k1 = *(const u32x4*)(kp + (size_t)3 * 64 * NPAD); v1 = *(const u32x4*)(vp + 3 * 64);
  lds_barrier();
  for (int kt = 0; kt < NKT; kt += 4) {
    sstore(2, k0, v0); sstore(3, k1, v1);
    if (kt + 4 < NKT) {
      k0 = *(const u32x4*)(kp + (size_t)(kt + 4) * 64 * NPAD); v0 = *(const u32x4*)(vp + (kt + 4) * 64);
      k1 = *(const u32x4*)(kp + (size_t)(kt + 5) * 64 * NPAD); v1 = *(const u32x4*)(vp + (kt + 5) * 64);
    }
    compute2(0, 1);
    lds_barrier();
    if (kt + 4 < NKT) {
      sstore(0, k0, v0); sstore(1, k1, v1);
      if (kt + 6 < NKT) {
        k0 = *(const u32x4*)(kp + (size_t)(kt + 6) * 64 * NPAD); v0 = *(const u32x4*)(vp + (kt + 6) * 64);
        k1 = *(const u32x4*)(kp + (size_t)(kt + 7) * 64 * NPAD); v1 = *(const u32x4*)(vp + (kt + 7) * 64);
      }
    }
    compute2(2, 3);
    lds_barrier();
  }
  float lsum = lsum2[0] + lsum2[1];
  lsum += __shfl_xor(lsum, 32);
  const float inv = 1.f / lsum;
  const bf16_t* zp = Hh + (rowbase + qrow) * NPAD + A_Z + head * 64;
  bf16_t* op = Hh + (rowbase + qrow) * NPAD + A_Q + head * 64;
#pragma unroll
  for (int dt = 0; dt < 2; ++dt)
#pragma unroll
    for (int g = 0; g < 4; ++g) {
      const int d0 = dt * 32 + 8 * g + 4 * h;
      const uint2 zz = *(const uint2*)(zp + d0);
      const float z0 = bf2f((bf16_t)(zz.x & 0xffff)), z1 = bf2f((bf16_t)(zz.x >> 16)), z2 = bf2f((bf16_t)(zz.y & 0xffff)), z3 = bf2f((bf16_t)(zz.y >> 16));
      const f32x16& oo = dt ? o1 : o0;
      uint2 ov;
      ov.x = pk2(oo[4 * g + 0] * inv * fsilu(z0), oo[4 * g + 1] * inv * fsilu(z1));
      ov.y = pk2(oo[4 * g + 2] * inv * fsilu(z2), oo[4 * g + 3] * inv * fsilu(z3));
      *(uint2*)(op + d0) = ov;
    }
  lds_barrier();
}

constexpr int L_QT = 0, L_KT = 17408, L_QC = 34816, L_KHT = 52224, L_VT = 70656, L_ST = 89088,
              L_D = 123904, L_TOT = 124416, L_ACS = 128512, L_DT = 129024;

template <int K, int V> struct ScanGeom {
  static constexpr int KP = K + 8;
  static constexpr int NS = (K / 32) * (V / 32) / 8;
};

template <int K, int V>
DEV void scan_write_state(unsigned char* smem, const f32x16* S, int w, int lane) {
  constexpr int KP = K + 8, NS = ScanGeom<K, V>::NS, NVT = V / 32;
  bf16_t* sST = (bf16_t*)(smem + L_ST);
  const int c = lane & 31, h = lane >> 5;
#pragma unroll
  for (int i = 0; i < NS; ++i) {
    const int tile = w * NS + i, kt = tile / NVT, nt = tile % NVT;
#pragma unroll
    for (int g = 0; g < 4; ++g) {
      uint2 o; o.x = pk2(S[i][4 * g + 0], S[i][4 * g + 1]); o.y = pk2(S[i][4 * g + 2], S[i][4 * g + 3]);
      *(uint2*)(sST + (nt * 32 + c) * KP + kt * 32 + 8 * g + 4 * h) = o;
    }
  }
}

template <int K, int V, bool SSDM>
DEV void scan_core(unsigned char* smem, f32x16* S, bf16_t* orow0, int dir, int w, int lane, bool do_out, const float* sAcs) {
  constexpr int KP = K + 8, NS = ScanGeom<K, V>::NS, NVT = V / 32, NOT = 2 * NVT;
  const bf16_t* sQt = (const bf16_t*)(smem + L_QT); const bf16_t* sKt = (const bf16_t*)(smem + L_KT);
  const bf16_t* sQc = (const bf16_t*)(smem + L_QC); const bf16_t* sKhT = (const bf16_t*)(smem + L_KHT);
  const bf16_t* sVT = (const bf16_t*)(smem + L_VT);
  const bf16_t* sST = (const bf16_t*)(smem + L_ST); const float* sD = (const float*)(smem + L_D);
  const int c = lane & 31, h = lane >> 5;
  if (do_out && w < NOT) {
    const int tt = w / NVT, nt = w % NVT;
    f32x16 acc = zero16();
    union VB { bf16x8 v; uint2 u[2]; };
    VB vbf[2][2];
#pragma unroll
    for (int st = 0; st < 2; ++st)
#pragma unroll
      for (int s2 = 0; s2 < 2; ++s2) {
        const int kb = st * 32 + 16 * s2 + 4 * h;
        vbf[st][s2].u[0] = *(const uint2*)(sVT + (nt * 32 + c) * 72 + kb); vbf[st][s2].u[1] = *(const uint2*)(sVT + (nt * 32 + c) * 72 + kb + 8);
      }
#pragma unroll
    for (int st = 0; st < 2; ++st) {
      if (st <= tt) {
        f32x16 pt = zero16();
        mma32<K>(pt, sKt + st * 32 * KP, KP, sQt + tt * 32 * KP, KP, lane);
        const int tau = tt * 32 + c;
        const float at = SSDM ? sAcs[tau] : 0.f;
#pragma unroll
        for (int reg = 0; reg < 16; ++reg) {
          const int sig = st * 32 + rowoff(reg, h);
          float v = pt[reg];
          if (SSDM) v *= ex2(at - sAcs[sig]);
          pt[reg] = (sig <= tau) ? v : 0.f;
        }
#pragma unroll
        for (int s2 = 0; s2 < 2; ++s2) {
          union { bf16x8 v; unsigned u[4]; } pa;
#pragma unroll
          for (int j = 0; j < 4; ++j) pa.u[j] = pk2(pt[8 * s2 + 2 * j], pt[8 * s2 + 2 * j + 1]);
          acc = __builtin_amdgcn_mfma_f32_32x32x16_bf16(pa.v, vbf[st][s2].v, acc, 0, 0, 0);
        }
      }
    }
    mma32<K>(acc, sQc + tt * 32 * KP, KP, sST + nt * 32 * KP, KP, lane);
    {
      const int l1 = lane & 1, l2 = (lane >> 1) & 1;
#pragma unroll
      for (int g = 0; g < 4; ++g) {
        const float a0 = acc[4 * g], a1 = acc[4 * g + 1], a2 = acc[4 * g + 2], a3 = acc[4 * g + 3];
        const float n0 = __builtin_bit_cast(float, __builtin_amdgcn_update_dpp(0, __builtin_bit_cast(int, a0), 0xB1, 0xF, 0xF, false));
        const float n1 = __builtin_bit_cast(float, __builtin_amdgcn_update_dpp(0, __builtin_bit_cast(int, a1), 0xB1, 0xF, 0xF, false));
        const float n2 = __builtin_bit_cast(float, __builtin_amdgcn_update_dpp(0, __builtin_bit_cast(int, a2), 0xB1, 0xF, 0xF, false));
        const float n3 = __builtin_bit_cast(float, __builtin_amdgcn_update_dpp(0, __builtin_bit_cast(int, a3), 0xB1, 0xF, 0xF, false));
        const unsigned A = l1 ? pk2(n1, a1) : pk2(a0, n0);
        const unsigned B = l1 ? pk2(n3, a3) : pk2(a2, n2);
        const unsigned send = l2 ? A : B, keep = l2 ? B : A;
        const unsigned recv = (unsigned)__builtin_amdgcn_update_dpp(0, (int)send, 0x4E, 0xF, 0xF, false);
        const int tau = tt * 32 + 8 * g + 4 * h + 2 * l2 + l1;
        const int tok = dir ? (63 - tau) : tau;
        *(uint2*)(orow0 + (size_t)tok * 512 + nt * 32 + 4 * (c >> 2)) = l2 ? make_uint2(recv, keep) : make_uint2(keep, recv);
      }
    }
  }
  {
    const int kt = (w * NS) / NVT;
    f32x4 dv[4];
#pragma unroll
    for (int g = 0; g < 4; ++g) dv[g] = *(const f32x4*)(sD + kt * 32 + 8 * g + 4 * h);
#pragma unroll
    for (int i = 0; i < NS; ++i) {
      const int nt = (w * NS + i) % NVT;
      const bf16_t* ap = sKhT + kt * 32 * 72 + c * 72 + 8 * h;
      const bf16_t* bp = sVT + nt * 32 * 72 + c * 72 + 8 * h;
      bf16x8 av[4], bv[4];
#pragma unroll
      for (int j = 0; j < 4; ++j) { av[j] = *(const bf16x8*)(ap + 16 * j); bv[j] = *(const bf16x8*)(bp + 16 * j); }
      __builtin_amdgcn_sched_barrier(0);
#pragma unroll
      for (int reg = 0; reg < 16; ++reg) S[i][reg] *= dv[reg >> 2][reg & 3];
#pragma unroll
      for (int j = 0; j < 4; ++j) S[i] = __builtin_amdgcn_mfma_f32_32x32x16_bf16(av[j], bv[j], S[i], 0, 0, 0);
    }
  }
}

template <int K, int V>
DEV void state_store(bf16_t* buf, const f32x16* S, int w, int lane) {
  constexpr int NS = ScanGeom<K, V>::NS, NVT = V / 32;
  const int c = lane & 31, h = lane >> 5;
#pragma unroll
  for (int i = 0; i < NS; ++i) {
    const int tile = w * NS + i, kt = tile / NVT, nt = tile % NVT;
#pragma unroll
    for (int reg = 0; reg < 16; ++reg) buf[(kt * 32 + rowoff(reg, h)) * V + nt * 32 + c] = f2bf(S[i][reg]);
  }
}
template <int K, int V>
DEV void state_load(const float* buf, f32x16* S, int w, int lane) {
  constexpr int NS = ScanGeom<K, V>::NS, NVT = V / 32;
  const int c = lane & 31, h = lane >> 5;
#pragma unroll
  for (int i = 0; i < NS; ++i) {
    const int tile = w * NS + i, kt = tile / NVT, nt = tile % NVT;
#pragma unroll
    for (int reg = 0; reg < 16; ++reg) S[i][reg] = buf[(kt * 32 + rowoff(reg, h)) * V + nt * 32 + c];
  }
}

template <int K, int V>
DEV void state_combine(const bf16_t* ubase, int ustride, const float* dbase, int seg, f32x16* S, int w, int lane) {
  constexpr int NS = ScanGeom<K, V>::NS, NVT = V / 32;
  const int c = lane & 31, h = lane >> 5;
  for (int j = 0; j < seg; ++j) {
    const bf16_t* buf = ubase + (size_t)j * ustride;
    const float* dj = dbase + j * 128;
    float u[NS][16]; f32x4 dv[NS][4];
#pragma unroll
    for (int i = 0; i < NS; ++i) {
      const int tile = w * NS + i, kt = tile / NVT, nt = tile % NVT;
#pragma unroll
      for (int g = 0; g < 4; ++g) dv[i][g] = *(const f32x4*)(dj + kt * 32 + 8 * g + 4 * h);
#pragma unroll
      for (int reg = 0; reg < 16; ++reg) u[i][reg] = bf2f(buf[(kt * 32 + rowoff(reg, h)) * V + nt * 32 + c]);
    }
#pragma unroll
    for (int i = 0; i < NS; ++i)
#pragma unroll
      for (int reg = 0; reg < 16; ++reg) S[i][reg] = (j > 0 ? dv[i][reg >> 2][reg & 3] * S[i][reg] : 0.f) + u[i][reg];
  }
}

#define PACK8_LO(v) (u32x4){((v)[0] & 0xffffu) | ((v)[1] << 16), ((v)[2] & 0xffffu) | ((v)[3] << 16), ((v)[4] & 0xffffu) | ((v)[5] << 16), ((v)[6] & 0xffffu) | ((v)[7] << 16)}
#define PACK8_HI(v) (u32x4){((v)[0] >> 16) | ((v)[1] & 0xffff0000u), ((v)[2] >> 16) | ((v)[3] & 0xffff0000u), ((v)[4] >> 16) | ((v)[5] & 0xffff0000u), ((v)[6] >> 16) | ((v)[7] & 0xffff0000u)}
#define CVT8(f) (u32x4){pk2((f)[0], (f)[1]), pk2((f)[2], (f)[3]), pk2((f)[4], (f)[5]), pk2((f)[6], (f)[7])}


DEV void hgrn_item(const ParamsG& p, int l, int it, int seg, int mode, unsigned char* smem) {
  const int bl = it >> 3, head = (it >> 1) & 3, dir = it & 1;
  const bool do_out = (mode == 3);
  constexpr int K = 128, V = 128, KPW = 68;
  const int tid = launder(threadIdx.x), lane = tid & 63, w = tid >> 6;
  const int cp = tid & 63, tg = tid >> 6, ch0 = 2 * cp;
  const bf16_t* Hh = (const bf16_t*)(p.ws + OFF_H);
  bf16_t* OB = (bf16_t*)(p.ws + OFF_OBUF) + (size_t)(0 * 2 + dir) * TH * 512;
  const size_t rowbase = (size_t)bl * SEQ;
  float lb0 = 0.f, lb1 = 0.f;
  if (l > 0) {
    lb0 = fsigmoid(p.lb_logits[512 + head * 128 + ch0] - p.lb_logits[head * 128 + ch0]);
    lb1 = fsigmoid(p.lb_logits[512 + head * 128 + ch0 + 1] - p.lb_logits[head * 128 + ch0 + 1]);
  }
  const float om0 = 1.f - lb0, om1 = 1.f - lb1;
  const int fbase = dir ? H_FB : H_FF;
  unsigned* sQt = (unsigned*)(smem + L_QT); unsigned* sKt = (unsigned*)(smem + L_KT); unsigned* sQc = (unsigned*)(smem + L_QC);
  bf16_t* sKhT = (bf16_t*)(smem + L_KHT); bf16_t* sVT = (bf16_t*)(smem + L_VT);
  float* sD = (float*)(smem + L_D); float* sTot = (float*)(smem + L_TOT);
  f32x16 S[2]; S[0] = zero16(); S[1] = zero16();
  bf16_t* sbuf = (bf16_t*)(p.ws + OFF_SB0) + ((size_t)it * NSEG + seg) * 16384;
  if (do_out) state_combine<K, V>((const bf16_t*)(p.ws + OFF_SB0) + (size_t)it * NSEG * 16384, 16384, (const float*)(p.ws + OFF_DB) + (size_t)it * NSEG * 128, seg, S, w, lane);
  float dlog0 = 0.f, dlog1 = 0.f;
  unsigned pf[8], qq[8], vv[8];
  float g0[8], g1[8], kx0[8], kx1[8];
  auto gloadA = [&](int cidx) __attribute__((always_inline)) {
    const int chunk = dir ? (63 - cidx) : cidx;
#pragma unroll
    for (int i = 0; i < 8; ++i) {
      const int tau = 8 * tg + i;
      const int tok = chunk * 64 + (dir ? (63 - tau) : tau);
      pf[i] = ((const unsigned*)(Hh + (rowbase + tok) * NPAD + head * 128 + fbase))[cp];
    }
  };
  auto gloadB = [&](int cidx) __attribute__((always_inline)) {
    const int chunk = dir ? (63 - cidx) : cidx;
#pragma unroll
    for (int i = 0; i < 8; ++i) {
      const int tau = 8 * tg + i;
      const int tok = chunk * 64 + (dir ? (63 - tau) : tau);
      const unsigned* rp = (const unsigned*)(Hh + (rowbase + tok) * NPAD + head * 128) + cp;
      vv[i] = rp[H_I / 2];
      qq[i] = do_out ? rp[H_Q / 2] : 0u;
    }
  };
  auto stage1 = [&]() __attribute__((always_inline)) {
    float r0 = 0.f, r1 = 0.f;
#pragma unroll
    for (int i = 0; i < 8; ++i) {
      const float e0 = ex2(fminf(-lo16(pf[i]) * LOG2E, 80.f)), e1 = ex2(fminf(-hi16(pf[i]) * LOG2E, 80.f));
      const float s0 = frcp(1.f + e0), s1 = frcp(1.f + e1);
      r0 += lg2(lb0 + om0 * s0); r1 += lg2(lb1 + om1 * s1);
      g0[i] = r0; g1[i] = r1;
      kx0[i] = om0 * e0 * s0; kx1[i] = om1 * e1 * s1;
    }
    *(float2*)(sTot + tg * 128 + ch0) = make_float2(r0, r1);
  };
  gloadA(seg * SLEN); gloadB(seg * SLEN);
  stage1();
  if (SLEN > 1) gloadA(seg * SLEN + 1);
  for (int ci = 0; ci < SLEN; ++ci) {
    const int cidx = seg * SLEN + ci;
    const int chunk = dir ? (63 - cidx) : cidx;
    lds_barrier();
    float off0 = 0.f, off1 = 0.f, ref0 = 0.f, ref1 = 0.f, be0 = 0.f, be1 = 0.f;
#pragma unroll
    for (int j = 0; j < 8; ++j) {
      const float2 t = *(const float2*)(sTot + j * 128 + ch0);
      if (j < tg) { off0 += t.x; off1 += t.y; }
      if (j < 4) { ref0 += t.x; ref1 += t.y; }
      be0 += t.x; be1 += t.y;
    }
    dlog0 += be0; dlog1 += be1;
    const float eref0 = ex2(ref0), eref1 = ex2(ref1), ebr0 = ex2(be0 - ref0), ebr1 = ex2(be1 - ref1);
    const float d0 = off0 - ref0, d1 = off1 - ref1;
    float kh0[8], kh1[8];
#pragma unroll
    for (int i = 0; i < 8; ++i) {
      const int tau = 8 * tg + i;
      const float E0 = ex2(g0[i] + d0), E1 = ex2(g1[i] + d1);
      const float kt0 = kx0[i] * frcp(E0), kt1 = kx1[i] * frcp(E1);
      if (do_out) {
        const float qt0 = lo16(qq[i]) * E0, qt1 = hi16(qq[i]) * E1;
        sQt[tau * KPW + cp] = pk2(qt0, qt1);
        sKt[tau * KPW + cp] = pk2(kt0, kt1);
        sQc[tau * KPW + cp] = pk2(qt0 * eref0, qt1 * eref1);
      }
      kh0[i] = kt0 * ebr0; kh1[i] = kt1 * ebr1;
    }
    *(u32x4*)(sKhT + ch0 * 72 + 8 * tg) = CVT8(kh0);
    *(u32x4*)(sKhT + (ch0 + 1) * 72 + 8 * tg) = CVT8(kh1);
    *(u32x4*)(sVT + ch0 * 72 + 8 * tg) = PACK8_LO(vv);
    *(u32x4*)(sVT + (ch0 + 1) * 72 + 8 * tg) = PACK8_HI(vv);
    if (tg == 0) *(float2*)(sD + ch0) = make_float2(ex2(be0), ex2(be1));
    if (do_out) scan_write_state<K, V>(smem, S, w, lane);
    if (ci + 1 < SLEN) gloadB(cidx + 1);
    lds_barrier();
    scan_core<K, V, false>(smem, S, OB + (rowbase + (size_t)chunk * 64) * 512 + head * 128, dir, w, lane, do_out, nullptr);
    if (ci + 1 < SLEN) { stage1(); if (ci + 2 < SLEN) gloadA(cidx + 2); }
  }
  if (!do_out) {
    state_store<K, V>(sbuf, S, w, lane);
    if (tg == 0) *(float2*)((float*)(p.ws + OFF_DB) + ((size_t)it * NSEG + seg) * 128 + ch0) = make_float2(ex2(dlog0), ex2(dlog1));
  }
  lds_barrier();
}

DEV void gla_item(const ParamsG& p, int l, int it, int seg, int mode, unsigned char* smem) {
  const int j16 = it - 16, bl = j16 >> 3, head = (j16 >> 1) & 3, dir = j16 & 1;
  const bool do_out = (mode == 3);
  constexpr int K = 64, V = 128, KPW = 36;
  const int tid = launder(threadIdx.x), lane = tid & 63, w = tid >> 6;
  const int cp = tid & 31, tg = tid >> 5, ch0 = 2 * cp;
  const int vp2 = tid & 63, vg = tid >> 6;
  const bf16_t* Hh = (const bf16_t*)(p.ws + OFF_H);
  const bf16_t* Gb = (const bf16_t*)(p.ws + OFF_G);
  bf16_t* OB = (bf16_t*)(p.ws + OFF_OBUF) + (size_t)(2 * 2 + dir) * TH * 512;
  const size_t rowbase = (size_t)bl * SEQ;
  unsigned* sQt = (unsigned*)(smem + L_QT); unsigned* sKt = (unsigned*)(smem + L_KT); unsigned* sQc = (unsigned*)(smem + L_QC);
  bf16_t* sKhT = (bf16_t*)(smem + L_KHT); bf16_t* sVT = (bf16_t*)(smem + L_VT);
  float* sD = (float*)(smem + L_D); float* sTot = (float*)(smem + L_TOT);
  f32x16 S[1]; S[0] = zero16();
  bf16_t* sbuf = (bf16_t*)(p.ws + OFF_SB1) + ((size_t)j16 * NSEG + seg) * 8192;
  if (do_out) state_combine<K, V>((const bf16_t*)(p.ws + OFF_SB1) + (size_t)j16 * NSEG * 8192, 8192, (const float*)(p.ws + OFF_DB) + (size_t)it * NSEG * 128, seg, S, w, lane);
  float dlog0 = 0.f, dlog1 = 0.f;
  unsigned pg[4];
  float g0[4], g1[4]; unsigned kk[4], qq[4], vv[8];
  auto gloadA = [&](int cidx) __attribute__((always_inline)) {
    const int chunk = dir ? (63 - cidx) : cidx;
#pragma unroll
    for (int i = 0; i < 4; ++i) {
      const int tau = 4 * tg + i;
      const int tok = chunk * 64 + (dir ? (63 - tau) : tau);
      pg[i] = ((const unsigned*)(Gb + (rowbase + tok) * 512 + dir * 256 + head * 64))[cp];
    }
  };
  auto gloadB = [&](int cidx) __attribute__((always_inline)) {
    const int chunk = dir ? (63 - cidx) : cidx;
#pragma unroll
    for (int i = 0; i < 4; ++i) {
      const int tau = 4 * tg + i;
      const int tok = chunk * 64 + (dir ? (63 - tau) : tau);
      const unsigned* rp = (const unsigned*)(Hh + (rowbase + tok) * NPAD + head * 64) + cp;
      kk[i] = rp[G_K / 2]; qq[i] = do_out ? rp[G_Q / 2] : 0u;
    }
#pragma unroll
    for (int i = 0; i < 8; ++i) {
      const int tau = 8 * vg + i;
      const int tok = chunk * 64 + (dir ? (63 - tau) : tau);
      vv[i] = ((const unsigned*)(Hh + (rowbase + tok) * NPAD + G_V + head * 128))[vp2];
    }
  };
  auto stage1 = [&]() __attribute__((always_inline)) {
    float r0 = 0.f, r1 = 0.f;
#pragma unroll
    for (int i = 0; i < 4; ++i) { r0 += lo16(pg[i]); r1 += hi16(pg[i]); g0[i] = r0; g1[i] = r1; }
    *(float2*)(sTot + tg * 64 + ch0) = make_float2(r0, r1);
  };
  gloadA(seg * SLEN); gloadB(seg * SLEN);
  stage1();
  if (SLEN > 1) gloadA(seg * SLEN + 1);
  for (int ci = 0; ci < SLEN; ++ci) {
    const int cidx = seg * SLEN + ci;
    const int chunk = dir ? (63 - cidx) : cidx;
    lds_barrier();
    float off0 = 0.f, off1 = 0.f, ref0 = 0.f, ref1 = 0.f, be0 = 0.f, be1 = 0.f;
#pragma unroll
    for (int j = 0; j < 16; ++j) {
      const float2 t = *(const float2*)(sTot + j * 64 + ch0);
      if (j < tg) { off0 += t.x; off1 += t.y; }
      if (j < 8) { ref0 += t.x; ref1 += t.y; }
      be0 += t.x; be1 += t.y;
    }
    dlog0 += be0; dlog1 += be1;
    const float eref0 = ex2(ref0), eref1 = ex2(ref1), ebr0 = ex2(be0 - ref0), ebr1 = ex2(be1 - ref1);
    const float d0 = off0 - ref0, d1 = off1 - ref1;
    float kh0[4], kh1[4];
#pragma unroll
    for (int i = 0; i < 4; ++i) {
      const int tau = 4 * tg + i;
      const float E0 = ex2(g0[i] + d0), E1 = ex2(g1[i] + d1);
      const float kt0 = lo16(kk[i]) * frcp(E0), kt1 = hi16(kk[i]) * frcp(E1);
      if (do_out) {
        const float qt0 = lo16(qq[i]) * E0, qt1 = hi16(qq[i]) * E1;
        sQt[tau * KPW + cp] = pk2(qt0, qt1);
        sKt[tau * KPW + cp] = pk2(kt0, kt1);
        sQc[tau * KPW + cp] = pk2(qt0 * eref0, qt1 * eref1);
      }
      kh0[i] = kt0 * ebr0; kh1[i] = kt1 * ebr1;
    }
    *(uint2*)(sKhT + ch0 * 72 + 4 * tg) = make_uint2(pk2(kh0[0], kh0[1]), pk2(kh0[2], kh0[3]));
    *(uint2*)(sKhT + (ch0 + 1) * 72 + 4 * tg) = make_uint2(pk2(kh1[0], kh1[1]), pk2(kh1[2], kh1[3]));
    *(u32x4*)(sVT + (2 * vp2) * 72 + 8 * vg) = PACK8_LO(vv);
    *(u32x4*)(sVT + (2 * vp2 + 1) * 72 + 8 * vg) = PACK8_HI(vv);
    if (tg == 0) *(float2*)(sD + ch0) = make_float2(ex2(be0), ex2(be1));
    if (do_out) scan_write_state<K, V>(smem, S, w, lane);
    if (ci + 1 < SLEN) gloadB(cidx + 1);
    lds_barrier();
    scan_core<K, V, false>(smem, S, OB + (rowbase + (size_t)chunk * 64) * 512 + head * 128, dir, w, lane, do_out, nullptr);
    if (ci + 1 < SLEN) { stage1(); if (ci + 2 < SLEN) gloadA(cidx + 2); }
  }
  if (!do_out) {
    state_store<K, V>(sbuf, S, w, lane);
    if (tg == 0) *(float2*)((float*)(p.ws + OFF_DB) + ((size_t)it * NSEG + seg) * 128 + ch0) = make_float2(ex2(dlog0), ex2(dlog1));
  }
  lds_barrier();
}

DEV void ssd_item(const ParamsG& p, int l, int it, int seg, int mode, unsigned char* smem) {
  const int j32 = it - 32, bl = j32 >> 4, head = (j32 >> 1) & 7, dir = j32 & 1;
  const bool do_out = (mode == 3);
  constexpr int K = 128, V = 64, KPW = 68;
  const int tid = launder(threadIdx.x), lane = tid & 63, w = tid >> 6;
  const int cp = tid & 63, tg = tid >> 6, n0 = 2 * cp;
  const int xp = tid & 31, xg = tid >> 5;
  const int grp = head >> 2;
  const bf16_t* U = (const bf16_t*)(p.ws + OFF_U);
  const float* SMALL = (const float*)(p.ws + OFF_SMALL);
  bf16_t* OB = (bf16_t*)(p.ws + OFF_OBUF) + (size_t)(1 * 2 + dir) * TH * 512;
  const size_t rowbase = (size_t)bl * SEQ;
  unsigned* sQt = (unsigned*)(smem + L_QT); unsigned* sKt = (unsigned*)(smem + L_KT); unsigned* sQc = (unsigned*)(smem + L_QC);
  bf16_t* sKhT = (bf16_t*)(smem + L_KHT); bf16_t* sVT = (bf16_t*)(smem + L_VT);
  float* sD = (float*)(smem + L_D);
  const float dtb = p.dt_bias[(l * 2 + dir) * 8 + head];
  const float Acoef = -__expf(p.a_log[(l * 2 + dir) * 8 + head]) * LOG2E;
  f32x16 S[1]; S[0] = zero16();
  bf16_t* sbuf = (bf16_t*)(p.ws + OFF_SB2) + ((size_t)j32 * NSEG + seg) * 8192;
  if (do_out) state_combine<K, V>((const bf16_t*)(p.ws + OFF_SB2) + (size_t)j32 * NSEG * 8192, 8192, (const float*)(p.ws + OFF_DB) + (size_t)it * NSEG * 128, seg, S, w, lane);
  float dlog = 0.f;
  unsigned bb[8], cc[8], xx[4];
  float rdt = 0.f;
  auto gloadA = [&](int cidx) __attribute__((always_inline)) {
    const int chunk = dir ? (63 - cidx) : cidx;
    if (w == 0) {
      const int tok = chunk * 64 + (dir ? (63 - lane) : lane);
      rdt = SMALL[(rowbase + tok) * 48 + dir * 8 + head];
    }
  };
  auto gloadB = [&](int cidx) __attribute__((always_inline)) {
    const int chunk = dir ? (63 - cidx) : cidx;
#pragma unroll
    for (int i = 0; i < 8; ++i) {
      const int tau = 8 * tg + i;
      const int tok = chunk * 64 + (dir ? (63 - tau) : tau);
      const unsigned* rp = (const unsigned*)(U + (rowbase + tok) * 1024 + grp * 128) + cp;
      bb[i] = rp[512 / 2]; cc[i] = do_out ? rp[768 / 2] : 0u;
    }
#pragma unroll
    for (int i = 0; i < 4; ++i) {
      const int tau = 4 * xg + i;
      const int tok = chunk * 64 + (dir ? (63 - tau) : tau);
      xx[i] = ((const unsigned*)(U + (rowbase + tok) * 1024 + head * 64))[xp];
    }
  };
  auto stage1 = [&](int par) __attribute__((always_inline)) {
    if (w == 0) {
      const float xv = rdt + dtb;
      const float dt = (xv > 20.f) ? xv : log1pf(__expf(xv));
      float a = dt * Acoef;
#pragma unroll
      for (int o = 1; o < 64; o <<= 1) { const float t = __shfl_up(a, o); if (lane >= o) a += t; }
      ((float*)(smem + L_ACS))[par * 64 + lane] = a; ((float*)(smem + L_DT))[par * 64 + lane] = dt;
    }
  };
  gloadA(seg * SLEN); gloadB(seg * SLEN);
  stage1(0);
  if (SLEN > 1) gloadA(seg * SLEN + 1);
  for (int ci = 0; ci < SLEN; ++ci) {
    const int cidx = seg * SLEN + ci;
    const int chunk = dir ? (63 - cidx) : cidx;
    const float* sAcs = (const float*)(smem + L_ACS) + (ci & 1) * 64;
    const float* sDt = (const float*)(smem + L_DT) + (ci & 1) * 64;
    lds_barrier();
    const float aend = sAcs[63];
    dlog += aend;
    {
      float kh0[8], kh1[8];
#pragma unroll
      for (int i = 0; i < 8; ++i) {
        const int tau = 8 * tg + i;
        const float ac = sAcs[tau];
        const float eb = ex2(aend - ac);
        kh0[i] = lo16(bb[i]) * eb; kh1[i] = hi16(bb[i]) * eb;
        if (do_out) {
          const float ea = ex2(ac);
          sKt[tau * KPW + cp] = bb[i];
          sQt[tau * KPW + cp] = cc[i];
          sQc[tau * KPW + cp] = pk2(lo16(cc[i]) * ea, hi16(cc[i]) * ea);
        }
      }
      *(u32x4*)(sKhT + n0 * 72 + 8 * tg) = CVT8(kh0);
      *(u32x4*)(sKhT + (n0 + 1) * 72 + 8 * tg) = CVT8(kh1);
      float x0[4], x1[4];
#pragma unroll
      for (int i = 0; i < 4; ++i) { const float dtv = sDt[4 * xg + i]; x0[i] = lo16(xx[i]) * dtv; x1[i] = hi16(xx[i]) * dtv; }
      *(uint2*)(sVT + (2 * xp) * 72 + 4 * xg) = make_uint2(pk2(x0[0], x0[1]), pk2(x0[2], x0[3]));
      *(uint2*)(sVT + (2 * xp + 1) * 72 + 4 * xg) = make_uint2(pk2(x1[0], x1[1]), pk2(x1[2], x1[3]));
      if (tg == 0) *(float2*)(sD + n0) = make_float2(ex2(aend), ex2(aend));
    }
    if (do_out) scan_write_state<K, V>(smem, S, w, lane);
    if (ci + 1 < SLEN) gloadB(cidx + 1);
    lds_barrier();
    scan_core<K, V, true>(smem, S, OB + (rowbase + (size_t)chunk * 64) * 512 + head * 64, dir, w, lane, do_out, sAcs);
    if (ci + 1 < SLEN) { stage1((ci + 1) & 1); if (ci + 2 < SLEN) gloadA(cidx + 2); }
  }
  if (!do_out) {
    state_store<K, V>(sbuf, S, w, lane);
    if (tg == 0) *(float2*)((float*)(p.ws + OFF_DB) + ((size_t)it * NSEG + seg) * 128 + n0) = make_float2(ex2(dlog), ex2(dlog));
  }
  lds_barrier();
}

DEV void ssd_pass1_item(const ParamsG& p, int l, int it, int seg, unsigned char* smem) {
  const int j32 = it - 32, bl = j32 >> 4, head = (j32 >> 1) & 7, dir = j32 & 1;
  constexpr int K = 128, V = 64;
  const int tid = launder(threadIdx.x), lane = tid & 63, w = tid >> 6;
  const int cp = tid & 63, tg = tid >> 6, n0 = 2 * cp;
  const int xp = tid & 31, xg = tid >> 5;
  const int grp = head >> 2;
  const bf16_t* U = (const bf16_t*)(p.ws + OFF_U);
  const float* SMALL = (const float*)(p.ws + OFF_SMALL);
  const size_t rowbase = (size_t)bl * SEQ;
  float* sW = (float*)(smem + L_TOT); float* sWT = (float*)(smem + L_D);
  unsigned bb[SLEN][8], xx[SLEN][4];
#pragma unroll
  for (int ci = 0; ci < SLEN; ++ci) {
    const int cidx = seg * SLEN + ci, chunk = dir ? (63 - cidx) : cidx;
#pragma unroll
    for (int i = 0; i < 8; ++i) {
      const int tau = 8 * tg + i, tok = chunk * 64 + (dir ? (63 - tau) : tau);
      bb[ci][i] = ((const unsigned*)(U + (rowbase + tok) * 1024 + grp * 128 + 512))[cp];
    }
#pragma unroll
    for (int i = 0; i < 4; ++i) {
      const int tau = 4 * xg + i, tok = chunk * 64 + (dir ? (63 - tau) : tau);
      xx[ci][i] = ((const unsigned*)(U + (rowbase + tok) * 1024 + head * 64))[xp];
    }
  }
  float dlog;
  {
    const float dtb = p.dt_bias[(l * 2 + dir) * 8 + head];
    const float Acoef = -__expf(p.a_log[(l * 2 + dir) * 8 + head]) * LOG2E;
    const int n = seg * (SLEN * 64) + tid, pos = dir ? (SEQ - 1 - n) : n;
    const float xv = SMALL[(rowbase + pos) * 48 + dir * 8 + head] + dtb;
    const float dt = (xv > 20.f) ? xv : log1pf(__expf(xv));
    float a = dt * Acoef;
#pragma unroll
    for (int o = 1; o < 64; o <<= 1) { const float t = __shfl_up(a, o); if (lane >= o) a += t; }
    if (lane == 63) sWT[w] = a;
    lds_barrier();
    float off = 0.f, tot = 0.f;
#pragma unroll
    for (int j = 0; j < 8; ++j) { const float t = sWT[j]; if (j < w) off += t; tot += t; }
    sW[tid] = dt * ex2(tot - (a + off));
    dlog = tot;
    lds_barrier();
  }
  f32x16 S[1]; S[0] = zero16();
#pragma unroll
  for (int ci = 0; ci < SLEN; ++ci) {
    bf16_t* sBT = (bf16_t*)(smem + (ci & 1) * 27648); bf16_t* sXT = sBT + 128 * 72;
    *(u32x4*)(sBT + n0 * 72 + 8 * tg) = PACK8_LO(bb[ci]);
    *(u32x4*)(sBT + (n0 + 1) * 72 + 8 * tg) = PACK8_HI(bb[ci]);
    float x0[4], x1[4];
#pragma unroll
    for (int i = 0; i < 4; ++i) { const float wv = sW[ci * 64 + 4 * xg + i]; x0[i] = lo16(xx[ci][i]) * wv; x1[i] = hi16(xx[ci][i]) * wv; }
    *(uint2*)(sXT + (2 * xp) * 72 + 4 * xg) = make_uint2(pk2(x0[0], x0[1]), pk2(x0[2], x0[3]));
    *(uint2*)(sXT + (2 * xp + 1) * 72 + 4 * xg) = make_uint2(pk2(x1[0], x1[1]), pk2(x1[2], x1[3]));
    lds_barrier();
    mma32<64>(S[0], sBT + (w >> 1) * 32 * 72, 72, sXT + (w & 1) * 32 * 72, 72, lane);
  }
  state_store<K, V>((bf16_t*)(p.ws + OFF_SB2) + ((size_t)j32 * NSEG + seg) * 8192, S, w, lane);
  if (tg == 0) *(float2*)((float*)(p.ws + OFF_DB) + ((size_t)it * NSEG + seg) * 128 + n0) = make_float2(ex2(dlog), ex2(dlog));
  lds_barrier();
}

DEV void phase_prep(const ParamsG& p, int l, int hf, int rep, unsigned char* smem) {
  const int tid = launder(threadIdx.x), lane = tid & 63;
  bf16_t* Hh = (bf16_t*)(p.ws + OFF_H);
  bf16_t* U = (bf16_t*)(p.ws + OFF_U);
  bf16_t* Gb = (bf16_t*)(p.ws + OFF_G);
  bf16_t* VT = (bf16_t*)(p.ws + OFF_VT);
  const float* SMALLp = (const float*)(p.ws + OFF_SMALL);
  float2* stab = (float2*)smem;
  float* slow = (float*)(smem + 8192);
  bf16_t* sT = (bf16_t*)(smem + 12288);
  {
    const float2* tabg = (const float2*)(p.ws + OFF_TAB);
    for (int i = tid; i < 1024; i += NT) stab[i] = tabg[i];
  }
  const int cg8 = (tid & 127) * 8, rsub = tid >> 7;
  const float* cw = (const float*)(p.conv_w + (size_t)l * 5 * 1024); const float* cb = (const float*)(p.conv_b + (size_t)l * 1024);
  float wv[5][8], bv[8];
#pragma unroll
  for (int j = 0; j < 5; ++j)
#pragma unroll
    for (int e = 0; e < 8; ++e) wv[j][e] = cw[j * 1024 + cg8 + e];
#pragma unroll
  for (int e = 0; e < 8; ++e) bv[e] = cb[cg8 + e];
  const int gd = tid >> 8, gc = tid & 255;
  const int i16 = lane & 15;
  const float* gq = (const float*)(p.q_gain + l * 64 + 4 * i16); const float* gk = (const float*)(p.k_gain + l * 64 + 4 * i16);
  const float gqv[4] = {gq[0], gq[1], gq[2], gq[3]}, gkv[4] = {gk[0], gk[1], gk[2], gk[3]};
  for (int grp = blockIdx.x; grp < TH / 32; grp += gridDim.x) {
    const int r0 = grp * 32;
    lds_barrier();
    const u32x4 vt = *(const u32x4*)(Hh + (size_t)(r0 + (tid >> 4)) * NPAD + A_V + (tid & 15) * 8);
    const float2 lowv = *(const float2*)(SMALLp + (size_t)(r0 + (tid >> 4)) * 48 + 16 + (tid & 15) * 2);
    *(u32x4*)(sT + (tid >> 4) * 136 + (tid & 15) * 8) = vt;
    *(float2*)(slow + (tid >> 4) * 32 + (tid & 15) * 2) = lowv;
#pragma unroll 1
    for (int ps = 0; ps < 2; ++ps) {
      const int ra = r0 + 16 * ps + 4 * rsub, ta = ra & (SEQ - 1);
      u32x4 xc[8];
#pragma unroll
      for (int m = 0; m < 8; ++m) {
        const int sq = ta + m - 2;
        xc[m] = (u32x4){0u, 0u, 0u, 0u};
        if (sq >= 0 && sq < SEQ) xc[m] = *(const u32x4*)(Hh + (size_t)(ra + m - 2) * NPAD + S_X + cg8);
      }
#pragma unroll
      for (int o4 = 0; o4 < 4; ++o4) {
        float u[8];
#pragma unroll
        for (int e = 0; e < 8; ++e) u[e] = bv[e];
#pragma unroll
        for (int j = 0; j < 5; ++j)
#pragma unroll
          for (int e = 0; e < 4; ++e) { u[2 * e] += wv[j][2 * e] * lo16(xc[o4 + j][e]); u[2 * e + 1] += wv[j][2 * e + 1] * hi16(xc[o4 + j][e]); }
        u32x4 o;
#pragma unroll
        for (int e = 0; e < 4; ++e) {
          const float a = u[2 * e] * frcp(1.f + ex2(fminf(-u[2 * e] * LOG2E, 80.f)));
          const float b = u[2 * e + 1] * frcp(1.f + ex2(fminf(-u[2 * e + 1] * LOG2E, 80.f)));
          o[e] = pk2(a, b);
        }
        *(u32x4*)(U + (size_t)(ra + o4) * 1024 + cg8) = o;
      }
    }
    lds_barrier();
    if (rep == 0) {
#pragma unroll 1
      for (int ub = 0; ub < 10; ub += 5) {
        uint2 xq[5];
#pragma unroll
        for (int u = 0; u < 5; ++u) {
          const int pi = (ub + u) * 32 + (tid >> 4), row = r0 + pi / 10, hd = pi % 10;
          xq[u] = *(const uint2*)(Hh + (size_t)row * NPAD + ((hd < 8) ? (A_Q + hd * 64) : (A_K + (hd - 8) * 64)) + 4 * i16);
        }
#pragma unroll
        for (int u = 0; u < 5; ++u) {
          const int pi = (ub + u) * 32 + (tid >> 4), row = r0 + pi / 10, hd = pi % 10;
          const bool isq = hd < 8;
          const float x[4] = {lo16(xq[u].x), hi16(xq[u].x), lo16(xq[u].y), hi16(xq[u].y)};
          float ss = x[0] * x[0] + x[1] * x[1] + x[2] * x[2] + x[3] * x[3];
          ss += __shfl_xor(ss, 1); ss += __shfl_xor(ss, 2); ss += __shfl_xor(ss, 4); ss += __shfl_xor(ss, 8);
          const float rstd = rsqrtf(ss * (1.f / 64.f) + 1e-6f);
          const int t = row & (SEQ - 1);
          const int pos = (i16 < 8) ? (t >> 6) : (t & 63);
          const float osc = isq ? QSCALE : 1.f;
          float o[4];
#pragma unroll
          for (int e = 0; e < 4; ++e) {
            const float v = x[e] * rstd * (isq ? gqv[e] : gkv[e]);
            const float pv = __shfl_xor(v, 4);
            const float2 cs = stab[pos * 16 + 4 * (i16 & 3) + e];
            o[e] = ((i16 & 4) ? (v * cs.x + pv * cs.y) : (v * cs.x - pv * cs.y)) * osc;
          }
          *(uint2*)(Hh + (size_t)row * NPAD + (isq ? (A_Q + hd * 64) : (A_K + (hd - 8) * 64)) + 4 * i16) = make_uint2(pk2(o[0], o[1]), pk2(o[2], o[3]));
        }
      }
    }
    float w2c[16];
#pragma unroll
    for (int r = 0; r < 16; ++r) w2c[r] = p.gk_w2[((size_t)(l * 2 + gd) * 16 + r) * 256 + gc];
    const float gbias = p.gk_b[(l * 2 + gd) * 256 + gc];
#pragma unroll 4
    for (int rr = 0; rr < 32; ++rr) {
      const float4* lp4 = (const float4*)(slow + rr * 32 + gd * 16);
      float gkk = gbias;
#pragma unroll
      for (int r4 = 0; r4 < 4; ++r4) { const float4 lw = lp4[r4]; gkk += lw.x * w2c[4 * r4] + lw.y * w2c[4 * r4 + 1] + lw.z * w2c[4 * r4 + 2] + lw.w * w2c[4 * r4 + 3]; }
      const float l2 = (fminf(gkk, 0.f) * LOG2E - lg2(1.f + ex2(-fabsf(gkk) * LOG2E))) * (1.f / 16.f);
      Gb[(size_t)(r0 + rr) * 512 + tid] = f2bf(l2);
    }
    {
      const int c = tid >> 2, tq = (tid & 3) * 8;
      unsigned v[8];
#pragma unroll
      for (int i = 0; i < 8; ++i) v[i] = sT[(tq + i) * 136 + c];
      const int bl = r0 >> 12, t0 = (r0 & (SEQ - 1)) + tq;
      *(u32x4*)(VT + ((size_t)((bl * 2 + (c >> 6)) * 64 + (c & 63))) * SEQ + t0) = (u32x4){v[0] | (v[1] << 16), v[2] | (v[3] << 16), v[4] | (v[5] << 16), v[6] | (v[7] << 16)};
    }
  }
  lds_barrier();
}

DEV void phase_mix(const ParamsG& p, int l, int hf, int slot, int mode, int att_lo, int att_hi, int vid_lo, int vid_hi, unsigned char* smem) {
  unsigned* ctr = (unsigned*)(p.ws + OFF_CTRL) + CTR_WORD0 + slot * 16;
  volatile int* sItem = (volatile int*)(smem + LDS_BYTES - 16);
  const int n_scan = 64 * NSEG;
  int hi = n_scan + (att_hi - att_lo); if (vid_hi < hi) hi = vid_hi;
  bool first = true;
  for (;;) {
    lds_barrier();
    if (threadIdx.x == 0) *sItem = vid_lo + (first ? (int)blockIdx.x : (int)(gridDim.x + atomicAdd(ctr, 1u)));
    first = false;
    lds_barrier();
    const int vid = *sItem;
    if (vid >= hi) break;
    if (vid < n_scan) {
      int seg = vid >> 6, it = vid & 63;
      {
        if (vid < 16 * NSEG) { it = vid & 15; seg = vid >> 4; }
        else if (mode == 1) {
          if (vid < 32 * NSEG) { const int v2 = vid - 16 * NSEG; it = 16 + (v2 & 15); seg = v2 >> 4; }
          else { const int v2 = vid - 32 * NSEG; it = 32 + (v2 & 31); seg = v2 >> 5; }
        }
        else if (vid < 48 * NSEG) { const int v2 = vid - 16 * NSEG; it = 32 + (v2 & 31); seg = v2 >> 5; }
        else { const int v2 = vid - 48 * NSEG; it = 16 + (v2 & 15); seg = v2 >> 4; }
      }
      if (mode == 1 && seg == NSEG - 1) continue;
#if PROBE_REP > 0
      if (slot >= 40 && PROBE_TYPE >= 0 && ((it < 16) ? 0 : (it < 32) ? 1 : 2) != PROBE_TYPE) continue;
#endif
      if (it < 16) { if (PH_MASK & 0x100) hgrn_item(p, l, it, seg, mode, smem); }
      else if (it < 32) { if (PH_MASK & 0x200) gla_item(p, l, it, seg, mode, smem); }
      else { if (PH_MASK & 0x400) { if (mode == 1) ssd_pass1_item(p, l, it, seg, smem); else ssd_item(p, l, it, seg, mode, smem); } }
    } else { if (PH_MASK & 0x800) attn_item(p, l, att_lo + (vid - n_scan), smem); }
  }
}

DEV void phase_scan2(const ParamsG& p) {
  const size_t gtid = (size_t)blockIdx.x * NT + threadIdx.x, gsz = (size_t)gridDim.x * NT;
  const float* DB = (const float*)(p.ws + OFF_DB);
  for (size_t e = gtid; e < 655360; e += gsz) {
    float* buf; const float* dp; int stride;
    if (e < 262144) { const int it = (int)(e >> 14), idx = (int)(e & 16383); buf = (float*)(p.ws + OFF_SB0) + (size_t)it * NSEG * 16384 + idx; stride = 16384; dp = DB + (size_t)it * NSEG * 128 + (idx >> 7); }
    else if (e < 393216) { const int e2 = (int)(e - 262144), j = e2 >> 13, idx = e2 & 8191; buf = (float*)(p.ws + OFF_SB1) + (size_t)j * NSEG * 8192 + idx; stride = 8192; dp = DB + (size_t)(16 + j) * NSEG * 128 + (idx >> 7); }
    else { const int e3 = (int)(e - 393216), j = e3 >> 13, idx = e3 & 8191; buf = (float*)(p.ws + OFF_SB2) + (size_t)j * NSEG * 8192 + idx; stride = 8192; dp = DB + (size_t)(32 + j) * NSEG * 128 + (idx >> 6); }
    float u[NSEG - 1], d[NSEG - 1];
#pragma unroll
    for (int sg = 0; sg < NSEG - 1; ++sg) { u[sg] = buf[(size_t)sg * stride]; d[sg] = dp[sg * 128]; }
    float st = 0.f;
#pragma unroll
    for (int sg = 0; sg < NSEG; ++sg) { buf[(size_t)sg * stride] = st; if (sg < NSEG - 1) st = d[sg] * st + u[sg]; }
  }
}

DEV float bfe(const u32x4& v, int j) { return (j & 1) ? hi16(v[j >> 1]) : lo16(v[j >> 1]); }
DEV void phase_fin(const ParamsG& p, int l, int hf) {
  const int tid = launder(threadIdx.x), lane = tid & 63, w = tid >> 6;
  const bf16_t* Hh = (const bf16_t*)(p.ws + OFF_H);
  const bf16_t* OB = (const bf16_t*)(p.ws + OFF_OBUF);
  bf16_t* MX = (bf16_t*)(p.ws + OFF_MIXED);
  const int c0 = lane * 8;
  const float* cw = (const float*)(p.conv_w + (size_t)l * 5 * 1024); const float* cb = (const float*)(p.conv_b + (size_t)l * 1024);
  for (int r0 = (blockIdx.x * 8 + w) * 4; r0 < TH; r0 += gridDim.x * 32) {
    {
      u32x4 at[4], a[4], b[4], z[4];
#pragma unroll
      for (int i = 0; i < 4; ++i) {
        const bf16_t* hrow = Hh + (size_t)(r0 + i) * NPAD;
        at[i] = __builtin_nontemporal_load((const u32x4*)(hrow + A_Q + c0));
        a[i] = __builtin_nontemporal_load((const u32x4*)(OB + ((size_t)0 * TH + r0 + i) * 512 + c0)); b[i] = __builtin_nontemporal_load((const u32x4*)(OB + ((size_t)1 * TH + r0 + i) * 512 + c0));
        z[i] = __builtin_nontemporal_load((const u32x4*)(hrow + H_Z + c0));
      }
      float gn[8];
#pragma unroll
      for (int j = 0; j < 8; ++j) gn[j] = p.hgrn_norm[l * 512 + c0 + j];
#pragma unroll
      for (int i = 0; i < 4; ++i) {
        *(u32x4*)(MX + (size_t)(r0 + i) * DI + c0) = at[i];
        float o[8]; float ss = 0.f;
#pragma unroll
        for (int j = 0; j < 8; ++j) { o[j] = bfe(a[i], j) + bfe(b[i], j); ss += o[j] * o[j]; }
#pragma unroll
        for (int of = 32; of >= 1; of >>= 1) ss += __shfl_xor(ss, of);
        const float rstd = rsqrtf(ss * (1.f / 512.f) + 1e-6f);
        float y[8];
#pragma unroll
        for (int j = 0; j < 8; ++j) { const float zz = bfe(z[i], j); y[j] = o[j] * rstd * gn[j] * (zz * frcp(1.f + ex2(fminf(-zz * LOG2E, 80.f)))); }
        *(u32x4*)(MX + (size_t)(r0 + i) * DI + 512 + c0) = (u32x4){pk2(y[0], y[1]), pk2(y[2], y[3]), pk2(y[4], y[5]), pk2(y[6], y[7])};
      }
    }
    {
      u32x4 a[4], b[4], z[4];
#pragma unroll
      for (int i = 0; i < 4; ++i) {
        a[i] = __builtin_nontemporal_load((const u32x4*)(OB + ((size_t)4 * TH + r0 + i) * 512 + c0)); b[i] = __builtin_nontemporal_load((const u32x4*)(OB + ((size_t)5 * TH + r0 + i) * 512 + c0));
        z[i] = __builtin_nontemporal_load((const u32x4*)(Hh + (size_t)(r0 + i) * NPAD + G_Z + c0));
      }
      float gn[8];
#pragma unroll
      for (int j = 0; j < 8; ++j) gn[j] = p.gla_norm[l * 128 + ((c0 + j) & 127)];
#pragma unroll
      for (int i = 0; i < 4; ++i) {
        float o[8]; float ss = 0.f;
#pragma unroll
        for (int j = 0; j < 8; ++j) { o[j] = bfe(a[i], j) + bfe(b[i], j); ss += o[j] * o[j]; }
#pragma unroll
        for (int of = 8; of >= 1; of >>= 1) ss += __shfl_xor(ss, of);
        const float rstd = rsqrtf(ss * (1.f / 128.f) + 1e-6f);
        float y[8];
#pragma unroll
        for (int j = 0; j < 8; ++j) { const float zz = bfe(z[i], j); y[j] = o[j] * rstd * gn[j] * (zz * frcp(1.f + ex2(fminf(-zz * LOG2E, 80.f)))); }
        *(u32x4*)(MX + (size_t)(r0 + i) * DI + 1536 + c0) = (u32x4){pk2(y[0], y[1]), pk2(y[2], y[3]), pk2(y[4], y[5]), pk2(y[6], y[7])};
      }
    }
    {
      u32x4 a[4], b[4], z[4], xr[8];
      const int t0 = r0 & (SEQ - 1);
#pragma unroll
      for (int i = 0; i < 4; ++i) {
        a[i] = __builtin_nontemporal_load((const u32x4*)(OB + ((size_t)2 * TH + r0 + i) * 512 + c0)); b[i] = __builtin_nontemporal_load((const u32x4*)(OB + ((size_t)3 * TH + r0 + i) * 512 + c0));
        z[i] = __builtin_nontemporal_load((const u32x4*)(Hh + (size_t)(r0 + i) * NPAD + S_Z + c0));
      }
#pragma unroll
      for (int m = 0; m < 8; ++m) {
        const int sq = t0 + m - 2;
        xr[m] = (u32x4){0u, 0u, 0u, 0u};
        if (sq >= 0 && sq < SEQ) xr[m] = __builtin_nontemporal_load((const u32x4*)(Hh + (size_t)(r0 + m - 2) * NPAD + S_X + c0));
      }
      float gn[8], cbv[8];
#pragma unroll
      for (int j = 0; j < 8; ++j) { gn[j] = p.ssd_norm[l * 512 + c0 + j]; cbv[j] = cb[c0 + j]; }
      const float dsk = p.ssd_d[l * 8 + (c0 >> 6)];
#pragma unroll
      for (int i = 0; i < 4; ++i) {
        float u[8];
#pragma unroll
        for (int j = 0; j < 8; ++j) u[j] = cbv[j];
#pragma unroll
        for (int jj = 0; jj < 5; ++jj)
#pragma unroll
          for (int j = 0; j < 8; ++j) u[j] += cw[jj * 1024 + c0 + j] * bfe(xr[i + jj], j);
        float y[8]; float ss = 0.f;
#pragma unroll
        for (int j = 0; j < 8; ++j) {
          const float zz = bfe(z[i], j);
          const float xs = u[j] * frcp(1.f + ex2(fminf(-u[j] * LOG2E, 80.f)));
          y[j] = (bfe(a[i], j) + bfe(b[i], j) + dsk * xs) * (zz * frcp(1.f + ex2(fminf(-zz * LOG2E, 80.f))));
          ss += y[j] * y[j];
        }
#pragma unroll
        for (int of = 32; of >= 1; of >>= 1) ss += __shfl_xor(ss, of);
        const float rstd = rsqrtf(ss * (1.f / 512.f) + 1e-6f);
#pragma unroll
        for (int j = 0; j < 8; ++j) y[j] = y[j] * rstd * gn[j];
        *(u32x4*)(MX + (size_t)(r0 + i) * DI + 1024 + c0) = (u32x4){pk2(y[0], y[1]), pk2(y[2], y[3]), pk2(y[4], y[5]), pk2(y[6], y[7])};
      }
    }
  }
}

#define XB_TMO      128
#define XB_XCNT(j)  (256  + 64 * (j))
#define XB_XSUB(j)  (1280 + 64 * (j))
#define XB_XGEN(j)  (2304 + 64 * (j))
#define XB_TOP      3328
#define XB_TOPGEN   3392
#define XB_SPIN_CAP (1u << 22)
#define LAS __attribute__((address_space(3)))
DEV unsigned xb_ld(unsigned* p) { return __hip_atomic_load(p, __ATOMIC_RELAXED, __HIP_MEMORY_SCOPE_AGENT); }
DEV unsigned xb_add(unsigned* p, unsigned v) { return __hip_atomic_fetch_add(p, v, __ATOMIC_RELAXED, __HIP_MEMORY_SCOPE_AGENT); }
DEV unsigned xb_xcc_id() { return (unsigned)__builtin_amdgcn_s_getreg((3 << 11) | 20) & 0xFu; }
#define XB_SPIN(cond, bar) do { unsigned _sp = 0; while (cond) { __builtin_amdgcn_s_sleep(1); \
    if ((++_sp & 255u) == 0u) { if (xb_ld(&(bar)[XB_TMO])) break; if (_sp > XB_SPIN_CAP) { atomicAdd(&(bar)[XB_TMO], 1u); break; } } } } while (0)
struct XcdBarrier { unsigned* bar; unsigned x; volatile LAS unsigned* st; };
DEV XcdBarrier xcd_barrier_post(unsigned* bar, volatile LAS unsigned* st) {
  XcdBarrier b; b.bar = bar; b.x = xb_xcc_id(); b.st = st;
  if (threadIdx.x == 0) (void)xb_add(&bar[XB_XCNT(b.x)], 1u);
  return b;
}
DEV void xcd_barrier_complete(unsigned* bar, unsigned x, unsigned& nloc, unsigned& nx) {
  const unsigned G = gridDim.x * gridDim.y * gridDim.z;
  unsigned sum, cnt, mine, sp = 0u;
  for (;;) {
    sum = 0u; cnt = 0u; mine = 0u;
#pragma unroll
    for (unsigned j = 0; j < 16; ++j) { const unsigned c = xb_ld(&bar[XB_XCNT(j)]); sum += c; cnt += (c > 0u) ? 1u : 0u; mine = (j == x) ? c : mine; }
    if (sum == G) break;
    __builtin_amdgcn_s_sleep(1);
    if ((++sp & 255u) == 0u) { if (xb_ld(&bar[XB_TMO])) break; if (sp > XB_SPIN_CAP) { atomicAdd(&bar[XB_TMO], 1u); break; } }
  }
  nloc = mine > 0u ? mine : 1u; nx = cnt > 0u ? cnt : 1u;
}
DEV void xcd_barrier(const XcdBarrier& b) {
  asm volatile("s_waitcnt vmcnt(0)" ::: "memory");
  __syncthreads();
  if (threadIdx.x == 0) {
    unsigned* bar = b.bar;
    __builtin_amdgcn_s_waitcnt(0);
    unsigned nloc = b.st[0], nx = b.st[1];
    if (nloc == 0u) { xcd_barrier_complete(bar, b.x, nloc, nx); b.st[0] = nloc; b.st[1] = nx; }
    const unsigned old = xb_add(&bar[XB_XSUB(b.x)], 1u);
    const unsigned gen = old / nloc;
    if (old + 1u == (gen + 1u) * nloc) {
      __builtin_amdgcn_fence(__ATOMIC_RELEASE, "agent");
      asm volatile("s_waitcnt vmcnt(0)" ::: "memory");
      const unsigned og = xb_add(&bar[XB_TOP], 1u);
      const unsigned tg = og / nx;
      if (og + 1u == (tg + 1u) * nx) xb_add(&bar[XB_TOPGEN], 1u);
      else XB_SPIN(xb_ld(&bar[XB_TOPGEN]) == tg, bar);
      __builtin_amdgcn_fence(__ATOMIC_ACQUIRE, "agent");
      xb_add(&bar[XB_XGEN(b.x)], 1u);
      asm volatile("s_waitcnt vmcnt(0)" ::: "memory");
    } else {
      XB_SPIN(xb_ld(&bar[XB_XGEN(b.x)]) == gen, bar);
      __builtin_amdgcn_fence(__ATOMIC_ACQUIRE, "agent");
      asm volatile("s_waitcnt vmcnt(0)" ::: "memory");
    }
  }
  __syncthreads();
}

DEV void run_phase(const ParamsG& p, int ph, int rep, unsigned char* smem) {
  if (ph == 0) { if (PH_MASK & 1) { phase_pro(p, smem); convert_weights(p, 0, 3, smem); } return; }
  if (ph == 21) { if (PH_MASK & 16) phase_outproj(p, 1, 1, smem); return; }
  if (ph == 22) { if (PH_MASK & 32) phase_ln(p, 1, 1); return; }
  const int q = ph - 1, blk = q / 5, st = q % 5, l = blk >> 1, hf = blk & 1;
  if (st == 0) {
    if (blk > 0 && (PH_MASK & 16)) phase_outproj(p, (blk - 1) >> 1, (blk - 1) & 1, smem);
    if (PH_MASK & 2) phase_inproj(p, l, hf, blk > 0 ? 16 : 0, smem);
  } else if (st == 1) {
    if (blk > 0 && rep == 0 && (PH_MASK & 32)) phase_ln(p, (blk - 1) >> 1, (blk - 1) & 1);
    if (PH_MASK & 4) phase_prep(p, l, hf, rep, smem);
    if ((PH_MASK & 1) && rep == 0 && blk == 1) convert_weights(p, 1, 1, smem);
    if ((PH_MASK & 1) && rep == 0 && blk == 2) convert_weights(p, 1, 2, smem);
  }
  else if (st == 2) { if (PH_MASK & 0xF00) phase_mix(p, l, hf, ph + 40 * rep, 1, 0, ATT_SPLIT, rep ? PROBE_LO : 0, rep ? PROBE_HI : 100000, smem); }
  else if (st == 3) { if (PH_MASK & 0xF00) phase_mix(p, l, hf, ph + 40 * rep, 3, ATT_SPLIT, 256, rep ? PROBE_LO : 0, rep ? PROBE_HI : 100000, smem); }
  else { if (PH_MASK & 8) phase_fin(p, l, hf); }
}
__global__ void __launch_bounds__(NT) mega(Params p) {
  extern __shared__ __attribute__((aligned(16))) unsigned char smem[];
#if ONE_LAUNCH
  volatile LAS unsigned* xst = (volatile LAS unsigned*)(smem + LDS_BYTES - 32);
  if (threadIdx.x == 0) { xst[0] = 0u; xst[1] = 0u; }
  __syncthreads();
  XcdBarrier xb = xcd_barrier_post((unsigned*)(p.ws + OFF_CTRL), xst);
#endif
  ParamsG* lp = (ParamsG*)(smem + 147456);
  if (threadIdx.x == 0) {
    lp->x = (GAS const float*)p.x; lp->w_in = (GAS const float*)p.w_in; lp->q_gain = (GAS const float*)p.q_gain; lp->k_gain = (GAS const float*)p.k_gain;
    lp->lb_logits = (GAS const float*)p.lb_logits; lp->hgrn_norm = (GAS const float*)p.hgrn_norm; lp->conv_w = (GAS const float*)p.conv_w; lp->conv_b = (GAS const float*)p.conv_b;
    lp->dt_bias = (GAS const float*)p.dt_bias; lp->a_log = (GAS const float*)p.a_log; lp->ssd_d = (GAS const float*)p.ssd_d; lp->ssd_norm = (GAS const float*)p.ssd_norm;
    lp->gk_w2 = (GAS const float*)p.gk_w2; lp->gk_b = (GAS const float*)p.gk_b; lp->gla_norm = (GAS const float*)p.gla_norm; lp->w_out = (GAS const float*)p.w_out;
    lp->ln_g = (GAS const float*)p.ln_g; lp->ln_b = (GAS const float*)p.ln_b; lp->out = (GAS float*)p.out; lp->ws = (GAS unsigned char*)p.ws;
  }
  __syncthreads();
  const int ph_begin = p.phase_begin, ph_end = p.phase_end;
  for (int ph = ph_begin; ph < ph_end; ++ph) {
    int nrep = 0;
#if PROBE_REP > 0
    {
      const int q = ph - 1, st = q % 5;
      const bool idem = (ph >= 1 && ph <= 20) && (st == PROBE_ST) && (st >= 1 || ph <= PROBE_PHMAX) && (ph >= PROBE_PHMIN);
      if (idem) nrep = PROBE_REP;
    }
#endif
    for (int r = 0; r <= nrep; ++r) {
      run_phase(*lp, ph, r, smem);
#if ONE_LAUNCH
      if (r < nrep || ph + 1 < ph_end) xcd_barrier(xb);
#endif
    }
  }
}

extern "C" void kernel_launch(void* const* d_in, const int* in_sizes, int n_in, void* d_out, int out_size, void* d_ws, size_t ws_size,
                              hipStream_t stream) {
  static int grid_blocks = 0;
  if (!grid_blocks) {
    int dev = 0, cus = 0, per_cu = 0;
    hipGetDevice(&dev);
    hipDeviceGetAttribute(&cus, hipDeviceAttributeMultiprocessorCount, dev);
    hipFuncSetAttribute((const void*)mega, hipFuncAttributeMaxDynamicSharedMemorySize, LDS_BYTES);
    hipOccupancyMaxActiveBlocksPerMultiprocessor(&per_cu, mega, NT, LDS_BYTES);
    if (per_cu < 1) per_cu = 1;
    grid_blocks = cus;
  }
  Params p{};
  p.x = (const float*)d_in[0]; p.w_in = (const float*)d_in[1]; p.q_gain = (const float*)d_in[2]; p.k_gain = (const float*)d_in[3];
  p.lb_logits = (const float*)d_in[4]; p.hgrn_norm = (const float*)d_in[5]; p.conv_w = (const float*)d_in[6]; p.conv_b = (const float*)d_in[7];
  p.dt_bias = (const float*)d_in[8]; p.a_log = (const float*)d_in[9]; p.ssd_d = (const float*)d_in[10]; p.ssd_norm = (const float*)d_in[11];
  p.gk_w2 = (const float*)d_in[12]; p.gk_b = (const float*)d_in[13]; p.gla_norm = (const float*)d_in[14]; p.w_out = (const float*)d_in[15];
  p.ln_g = (const float*)d_in[16]; p.ln_b = (const float*)d_in[17];
  p.out = (float*)d_out; p.ws = (unsigned char*)d_ws;
  hipMemsetAsync(d_ws, 0, CTRL_BYTES, stream);
#if ONE_LAUNCH
  p.phase_begin = 0; p.phase_end = NPHASE;
  void* args[] = {&p};
  (void)args;
  hipLaunchKernelGGL(mega, dim3(grid_blocks), dim3(NT), LDS_BYTES, stream, p);
#else
  for (int ph = 0; ph < NPHASE; ++ph) {
    p.phase_begin = ph; p.phase_end = ph + 1;
    hipLaunchKernelGGL(mega, dim3(grid_blocks), dim3(NT), LDS_BYTES, stream, p);
  }
#endif
}
```

```cpp
#include <hip/hip_runtime.h>
#include <hip/hip_cooperative_groups.h>
#include <stdint.h>
#include <stdio.h>
namespace cg = cooperative_groups;

#ifndef ONE_LAUNCH
#define ONE_LAUNCH 1
#endif

#ifndef PH_MASK
#define PH_MASK 0xFFF
#endif
#ifndef PROBE_ST
#define PROBE_ST -1
#endif
#ifndef PROBE_REP
#define PROBE_REP 0
#endif
#ifndef PROBE_PHMAX
#define PROBE_PHMAX 0
#endif
#ifndef PROBE_PHMIN
#define PROBE_PHMIN 0
#endif
#ifndef PROBE_TYPE
#define PROBE_TYPE -1
#endif
#ifndef PROBE_LO
#define PROBE_LO 0
#endif
#ifndef PROBE_HI
#define PROBE_HI 100000
#endif
#define DEV __device__ __forceinline__
typedef unsigned short bf16_t;
typedef short bf16x8 __attribute__((ext_vector_type(8)));
typedef float f32x16 __attribute__((ext_vector_type(16)));
typedef unsigned u32x4 __attribute__((ext_vector_type(4)));
typedef float f32x4 __attribute__((ext_vector_type(4)));

constexpr int NT = 512;
constexpr int T_ALL = 16384, TH = 8192, SEQ = 4096, DM = 1024, NPAD = 7168, DI = 2048, NIN = 6960;
constexpr int A_Q = 0, A_K = 512, A_V = 640, A_Z = 768, H_Q = 1280, H_FF = 1792, H_FB = 2304, H_I = 2816, H_Z = 3328,
              S_X = 3840, S_Z = 4864, G_Q = 5376, G_K = 5632, G_V = 5888, G_Z = 6400, SM0 = 6912;
constexpr size_t OFF_CTRL = 0, OFF_TAB = 65536, OFF_XB = 131072;
constexpr size_t OFF_WIN = OFF_XB + (size_t)T_ALL * DM * 2;
constexpr size_t OFF_WOUT = OFF_WIN + (size_t)NPAD * DM * 2;
constexpr size_t OFF_H = OFF_WOUT + (size_t)DM * DI * 2;
constexpr size_t OFF_SMALL = OFF_H + (size_t)TH * NPAD * 2;
constexpr size_t OFF_OBUF = OFF_SMALL + (size_t)TH * 48 * 4;
constexpr size_t OFF_VT = OFF_OBUF + (size_t)6 * TH * 512 * 2;
constexpr size_t OFF_DB = OFF_VT + (size_t)2 * 2 * 64 * SEQ * 2;
constexpr int NSEG = 8, SLEN = 64 / NSEG;
constexpr size_t OFF_MIXED = OFF_DB + (size_t)64 * NSEG * 128 * 4;
constexpr size_t OFF_SB0 = OFF_MIXED, OFF_SB1 = OFF_SB0 + (size_t)16 * NSEG * 16384 * 2, OFF_SB2 = OFF_SB1 + (size_t)16 * NSEG * 8192 * 2;
constexpr size_t OFF_U = OFF_SB2 + (size_t)32 * NSEG * 8192 * 2;
constexpr size_t OFF_G = OFF_U + (size_t)TH * 1024 * 2;
constexpr size_t WS_END = (OFF_G + (size_t)TH * 512 * 2 > OFF_MIXED + (size_t)TH * DI * 2) ? (OFF_G + (size_t)TH * 512 * 2) : (OFF_MIXED + (size_t)TH * DI * 2);
static_assert(OFF_MIXED + (size_t)TH * DI * 2 <= WS_END, "MIXED must fit");
static_assert(WS_END <= 268435456, "workspace");
constexpr size_t CTRL_BYTES = 65536;
constexpr int CTR_WORD0 = 4096;
constexpr int LDS_BYTES = 148480;
constexpr float LOG2E = 1.4426950408889634f;
constexpr float QSCALE = 0.125f * LOG2E;
constexpr float DN_ALPHA = 1.4142135623730951f;
constexpr int NPHASE = 23;
constexpr int ATT_SPLIT = 256;

struct Params {
  const float* x; const float* w_in; const float* q_gain; const float* k_gain; const float* lb_logits; const float* hgrn_norm;
  const float* conv_w; const float* conv_b; const float* dt_bias; const float* a_log; const float* ssd_d; const float* ssd_norm;
  const float* gk_w2; const float* gk_b; const float* gla_norm; const float* w_out; const float* ln_g; const float* ln_b;
  float* out; unsigned char* ws;
  int phase_begin, phase_end;
};
#define GAS __attribute__((address_space(1)))
struct ParamsG {
  GAS const float* x; GAS const float* w_in; GAS const float* q_gain; GAS const float* k_gain; GAS const float* lb_logits; GAS const float* hgrn_norm;
  GAS const float* conv_w; GAS const float* conv_b; GAS const float* dt_bias; GAS const float* a_log; GAS const float* ssd_d; GAS const float* ssd_norm;
  GAS const float* gk_w2; GAS const float* gk_b; GAS const float* gla_norm; GAS const float* w_out; GAS const float* ln_g; GAS const float* ln_b;
  GAS float* out; GAS unsigned char* ws;
};

DEV void lds_barrier() { asm volatile("s_waitcnt lgkmcnt(0)" ::: "memory"); __builtin_amdgcn_s_barrier(); asm volatile("" ::: "memory"); }
DEV int launder(int v) { asm volatile("" : "+v"(v)); return v; }
DEV float bf2f(bf16_t v) { return __uint_as_float(((unsigned)v) << 16); }
DEV bf16_t f2bf(float f) { unsigned u = __float_as_uint(f); u += 0x7fffu + ((u >> 16) & 1u); return (bf16_t)(u >> 16); }
typedef __bf16 bf16x2_t __attribute__((ext_vector_type(2)));
typedef float f32x2_t __attribute__((ext_vector_type(2)));
DEV unsigned pk2(float lo, float hi) { const f32x2_t f = {lo, hi}; const bf16x2_t b = __builtin_convertvector(f, bf16x2_t); return __builtin_bit_cast(unsigned, b); }
DEV float fsigmoid(float x) { return 1.f / (1.f + __expf(-x)); }
DEV float fsilu(float x) { return x / (1.f + __expf(-x)); }
DEV unsigned cvtpk(float lo, float hi) { return pk2(lo, hi); }
DEV float ex2(float x) { return __builtin_amdgcn_exp2f(x); }
DEV float lg2(float x) { return __builtin_amdgcn_logf(x); }
DEV float frcp(float x) { return __builtin_amdgcn_rcpf(x); }
DEV float lo16(unsigned u) { return __uint_as_float(u << 16); }
DEV float hi16(unsigned u) { return __uint_as_float(u & 0xffff0000u); }
DEV int rowoff(int reg, int h) { return (reg & 3) + 8 * (reg >> 2) + 4 * h; }
DEV f32x16 zero16() { f32x16 z;
#pragma unroll
  for (int i = 0; i < 16; ++i) z[i] = 0.f; return z; }

template <int KD>
DEV void mma32(f32x16& acc, const bf16_t* a, int lda, const bf16_t* b, int ldb, int lane) {
  const int r = lane & 31, h = lane >> 5;
  const bf16_t* ap = a + r * lda + 8 * h;
  const bf16_t* bp = b + r * ldb + 8 * h;
#pragma unroll 1
  for (int k0 = 0; k0 < KD; k0 += 64) {
    bf16x8 av[4], bv[4];
#pragma unroll
    for (int j = 0; j < 4; ++j) { av[j] = *(const bf16x8*)(ap + k0 + 16 * j); bv[j] = *(const bf16x8*)(bp + k0 + 16 * j); }
    __builtin_amdgcn_sched_barrier(0);
#pragma unroll
    for (int j = 0; j < 4; ++j) acc = __builtin_amdgcn_mfma_f32_32x32x16_bf16(av[j], bv[j], acc, 0, 0, 0);
  }
}

DEV int orig_col(int n) {
  if (n < 4864) return n;
  if (n < 6400) return n + 16;
  if (n < 6912) return n + 48;
  if (n < 6928) return n - 2048;
  if (n < 6960) return n - 512;
  return -1;
}

DEV void convert_weights(const ParamsG& p, int l, int which, unsigned char* smem) {
  float* s = (float*)smem;
  const int tid = launder(threadIdx.x);
  const float* win = (const float*)(p.w_in + (size_t)l * DM * NIN);
  const float* wout = (const float*)(p.w_out + (size_t)l * DI * DM);
  bf16_t* wint = (bf16_t*)(p.ws + OFF_WIN);
  bf16_t* woutt = (bf16_t*)(p.ws + OFF_WOUT);
  const int n_in_tiles = (NPAD / 64) * (DM / 64);
  const int n_out_tiles = (DM / 64) * (DI / 64);
  const int it_lo = (which & 1) ? 0 : n_in_tiles, it_hi = (which & 2) ? (n_in_tiles + n_out_tiles) : n_in_tiles;
  for (int it = it_lo + blockIdx.x; it < it_hi; it += gridDim.x) {
    lds_barrier();
    if (it < n_in_tiles) {
      const int n0 = (it / 16) * 64, k0 = (it % 16) * 64;
#pragma unroll
      for (int e = 0; e < 8; ++e) {
        const int idx = e * NT + tid, kk = idx >> 6, nn = idx & 63;
        const int oc = orig_col(n0 + nn);
        s[kk * 65 + nn] = (oc >= 0) ? win[(size_t)(k0 + kk) * NIN + oc] : 0.f;
      }
      lds_barrier();
      const int n = tid >> 3, kc = (tid & 7) * 8;
      uint4 o;
      o.x = pk2(s[(kc + 0) * 65 + n], s[(kc + 1) * 65 + n]); o.y = pk2(s[(kc + 2) * 65 + n], s[(kc + 3) * 65 + n]);
      o.z = pk2(s[(kc + 4) * 65 + n], s[(kc + 5) * 65 + n]); o.w = pk2(s[(kc + 6) * 65 + n], s[(kc + 7) * 65 + n]);
      *(uint4*)(wint + (size_t)(n0 + n) * DM + k0 + kc) = o;
    } else {
      const int j = it - n_in_tiles;
      const int n0 = (j / 32) * 64, k0 = (j % 32) * 64;
#pragma unroll
      for (int e = 0; e < 8; ++e) {
        const int idx = e * NT + tid, kk = idx >> 6, nn = idx & 63;
        s[kk * 65 + nn] = wout[(size_t)(k0 + kk) * DM + n0 + nn];
      }
      lds_barrier();
      const int n = tid >> 3, kc = (tid & 7) * 8;
      uint4 o;
      o.x = pk2(s[(kc + 0) * 65 + n], s[(kc + 1) * 65 + n]); o.y = pk2(s[(kc + 2) * 65 + n], s[(kc + 3) * 65 + n]);
      o.z = pk2(s[(kc + 4) * 65 + n], s[(kc + 5) * 65 + n]); o.w = pk2(s[(kc + 6) * 65 + n], s[(kc + 7) * 65 + n]);
      *(uint4*)(woutt + (size_t)(n0 + n) * DI + k0 + kc) = o;
    }
  }
  lds_barrier();
}

DEV void fsincos(float x, float& s, float& c) {
  const float k = rintf(x * 0.63661977236758134308f);
  float r = fmaf(-k, 1.5707855225e+00f, x);
  r = fmaf(-k, 1.0804273188e-05f, r);
  r = fmaf(-k, 6.0770999344e-11f, r);
  const float r2 = r * r;
  float ps = fmaf(r2, 2.7557319224e-06f, -1.9841269841e-04f);
  ps = fmaf(ps, r2, 8.3333333333e-03f); ps = fmaf(ps, r2, -1.6666666667e-01f);
  const float sinr = fmaf(ps * r2, r, r);
  float pc = fmaf(r2, -2.7557319224e-07f, 2.4801587302e-05f);
  pc = fmaf(pc, r2, -1.3888888889e-03f); pc = fmaf(pc, r2, 4.1666666667e-02f); pc = fmaf(pc, r2, -0.5f);
  const float cosr = fmaf(pc, r2, 1.0f);
  const int q = ((int)k) & 3;
  if (q == 0) { s = sinr; c = cosr; }
  else if (q == 1) { s = cosr; c = -sinr; }
  else if (q == 2) { s = -sinr; c = -cosr; }
  else { s = -cosr; c = sinr; }
}

DEV void phase_pro(const ParamsG& p, unsigned char* smem) {
  const int tid = launder(threadIdx.x);
  const size_t gtid = (size_t)blockIdx.x * NT + tid, gsz = (size_t)gridDim.x * NT;
  const float4* x4 = (const float4*)p.x;
  uint4* xb4 = (uint4*)(p.ws + OFF_XB);
  for (size_t i = gtid; i < (size_t)T_ALL * DM / 8; i += gsz) {
    const float4 a = x4[2 * i], b = x4[2 * i + 1];
    uint4 o; o.x = pk2(a.x, a.y); o.y = pk2(a.z, a.w); o.z = pk2(b.x, b.y); o.w = pk2(b.z, b.w);
    xb4[i] = o;
  }
  if (blockIdx.x == 0) {
    float2* tab = (float2*)(p.ws + OFF_TAB);
    for (int i = tid; i < 64 * 16; i += NT) {
      const int pos = i >> 4, fi = i & 15;
      const float invf = exp2f(-(float)fi * (13.287712379549449f / 16.0f));
      const float ang = (float)pos * invf;
      float sn, cs; fsincos(ang, sn, cs);
      tab[i] = make_float2(cs, sn);
    }
  }
}

namespace pg8 {
#define PG8_LAS __attribute__((address_space(3)))
typedef unsigned short bf16_t;
typedef short bf16x8 __attribute__((ext_vector_type(8)));
typedef float f32x4 __attribute__((ext_vector_type(4)));
typedef unsigned u32x4 __attribute__((ext_vector_type(4)));
constexpr int BM = 256, BK = 64, HALF = 128, HTB = HALF * BK * 2  , STAGE_BYTES = 8 * HTB, NXCD = 8, WGM = 8;

__host__ __device__ __forceinline__ int lds_byte(int r, int c) { const int st = (r >> 4) * 2 + (c >> 5), rr = r & 15, cc = c & 31, ob = rr * 64 + cc * 2; return st * 1024 + (ob ^ (((ob >> 9) & 1) << 5)); }
__host__ __device__ __forceinline__ void stage_rc(int b, int& R, int& C) { const int st = b / 1024, sb = b % 1024, swz = sb ^ (((sb >> 9) & 1) << 5); R = (st >> 1) * 16 + swz / 64; C = (st & 1) * 32 + (swz % 64) / 2; }
__host__ __device__ __forceinline__ int perm32(int rho) { const int n = rho >> 4, i = rho & 15; return 8 * (i >> 2) + 4 * n + (i & 3); }

struct Unit { int pm, pn; };
struct Gemm { const bf16_t* A; const bf16_t* Bt; int M, N, K; };

__device__ __forceinline__ unsigned cvt_pk_bf16(float lo, float hi) { unsigned r; asm volatile("v_cvt_pk_bf16_f32 %0, %1, %2" : "=v"(r) : "v"(lo), "v"(hi)); return r; }

struct XcdOrder {
    int rpx, nN, x, c, ncu, skew;
    __device__ void init(int M, int N, int skew_ = 0) { rpx = (M / BM) / NXCD; nN = N / BM; x = blockIdx.x & 7; c = blockIdx.x >> 3; ncu = gridDim.x >> 3; skew = skew_; }
    __device__ bool next(int i, Unit& u) const {
        const int total = rpx * nN, full = (total / ncu) * ncu;
        int j = c + i * ncu;
        if (skew < 0 && j >= full) return false;
        if (skew > 0 && j >= full) { const int cc = c - skew; j = (cc >= 0 && i == total / ncu) ? full + cc : total; }
        if (j >= total) return false; u.pm = rpx * x + (j % rpx); u.pn = j / rpx; return true; }
    __device__ bool tail(int q, Unit& u, int& hh) const {
        const int total = rpx * nN, full = (total / ncu) * ncu, left = total - full;
        if (q >= 2 * left) return false;
        const int j = full + (q % left); hh = q / left; u.pm = rpx * x + (j % rpx); u.pn = j / rpx; return true; }
    __device__ __forceinline__ void a_ready(const Unit&) const {}
    __device__ __forceinline__ void done(const Unit&) const {}
};
struct EpiIn {
    static constexpr bool PERM = true, AFTER_DRAIN = false;
    bf16_t* O; int ldc; float* small; int small_pn;
    __device__ __forceinline__ void one(const f32x4 (&a)[2][4][2], int pn, int row0, int wc, int fq) const {
        const int col0 = pn * BM + wc * 32 + 8 * fq;
        if (pn == small_pn) {
            const int c = wc * 32 + 8 * fq;
            if (c < 48) {
#pragma unroll
                for (int m = 0; m < 4; ++m) { float* rp = small + (size_t)(row0 + m * 16) * 48 + c; *(f32x4*)rp = a[0][m][0]; *(f32x4*)(rp + 4) = a[0][m][1]; }
            }
            return;
        }
        const int act = (pn == 5 || pn == 6) ? 1 : ((pn == 21) ? 2 : 0);
#pragma unroll
        for (int m = 0; m < 4; ++m) { bf16_t* rowp = O + (size_t)(row0 + m * 16) * ldc + col0;
#pragma unroll
            for (int bj = 0; bj < 2; ++bj) { f32x4 v0 = a[bj][m][0], v1 = a[bj][m][1];
                if (act == 1) {
#pragma unroll
                    for (int e = 0; e < 4; ++e) {
                        v0[e] = v0[e] * __builtin_amdgcn_rcpf(1.f + __builtin_amdgcn_exp2f(fminf(-v0[e] * 1.4426950408889634f, 80.f))) * 0.08838834764831845f;
                        v1[e] = v1[e] * __builtin_amdgcn_rcpf(1.f + __builtin_amdgcn_exp2f(fminf(-v1[e] * 1.4426950408889634f, 80.f))) * 0.08838834764831845f; }
                } else if (act == 2) { v0 = v0 * 0.125f; v1 = v1 * 0.125f; }
                u32x4 w; w.x = cvt_pk_bf16(v0[0], v0[1]); w.y = cvt_pk_bf16(v0[2], v0[3]); w.z = cvt_pk_bf16(v1[0], v1[1]); w.w = cvt_pk_bf16(v1[2], v1[3]);
                *(u32x4*)(rowp + bj * HALF) = w; } }
    }
    __device__ __forceinline__ void operator()(const f32x4 (&acc)[2][2][4][2], const Unit& u, int wr, int wc, int fr, int fq) const {
        const int row0 = u.pm * BM + wr * 64 + fr;
#pragma unroll
        for (int ai = 0; ai < 2; ++ai) one(acc[ai], u.pn, row0 + ai * HALF, wc, fq);
    }
};
struct EpiOut {
    static constexpr bool PERM = true, AFTER_DRAIN = false;
    const float* X; float* Y; int ldc; float alpha;
    __device__ __forceinline__ void one(const f32x4 (&a)[2][4][2], int pn, int row0, int wc, int fq) const {
        const int col0 = pn * BM + wc * 32 + 8 * fq;
#pragma unroll
        for (int m = 0; m < 4; ++m) { const size_t off = (size_t)(row0 + m * 16) * ldc + col0;
#pragma unroll
            for (int bj = 0; bj < 2; ++bj) { const f32x4 x0 = *(const f32x4*)(X + off + bj * HALF), x1 = *(const f32x4*)(X + off + bj * HALF + 4);
                *(f32x4*)(Y + off + bj * HALF) = x0 * alpha + a[bj][m][0]; *(f32x4*)(Y + off + bj * HALF + 4) = x1 * alpha + a[bj][m][1]; } }
    }
    __device__ __forceinline__ void operator()(const f32x4 (&acc)[2][2][4][2], const Unit& u, int wr, int wc, int fr, int fq) const {
        const int row0 = u.pm * BM + wr * 64 + fr;
#pragma unroll
        for (int ai = 0; ai < 2; ++ai) one(acc[ai], u.pn, row0 + ai * HALF, wc, fq);
    }
};

template <class Epi, class Sched, bool ALIGN_EPI = false, bool SP2 = false>
__device__ __forceinline__ void gemm_phase(PG8_LAS unsigned char* lds, const Gemm g, const Sched& S, const Epi& E) {
    const int tid = launder((int)threadIdx.x), wid = __builtin_amdgcn_readfirstlane(tid >> 6), lane = tid & 63, wr = wid >> 2, wc = wid & 3, fr = lane & 15, fq = lane >> 4;
    const int K = g.K, nt = K / BK;
    unsigned voffA[2], voffB[2];
#pragma unroll
    for (int i = 0; i < 2; ++i) { int R, C; stage_rc(tid * 16 + i * 8192, R, C); const int Rb = Epi::PERM ? ((R & ~31) + perm32(R & 31)) : R;
        voffA[i] = (unsigned)(R * K + C) * 2u; voffB[i] = (unsigned)(Rb * K + C) * 2u; }
    const size_t kstep = (size_t)(BK * 2);
    const size_t hstep = (size_t)HALF * K * 2;
    const size_t tstep = 2 * hstep;
    const unsigned ldsw = (unsigned)wid * 1024u;
    const int aoff = lds_byte(wr * 64 + fr, fq * 8), boff = lds_byte(wc * 32 + fr, fq * 8);
#define PG8_SA(b, h) (((b) * 2 + (h)) * HTB)
#define PG8_SB(b, h) ((4 + (b) * 2 + (h)) * HTB)
#define PG8_STAGE(bufoff, gbase, voff) do { _Pragma("unroll") for (int _i = 0; _i < 2; ++_i) \
        __builtin_amdgcn_global_load_lds((const unsigned*)((const char*)(gbase) + (voff)[_i]), (PG8_LAS unsigned*)(lds + (bufoff) + ldsw + _i * 8192), 16, 0, 0); } while (0)
#define PG8_LDA(dst, b, h) do { _Pragma("unroll") for (int m = 0; m < 4; ++m) _Pragma("unroll") for (int k = 0; k < 2; ++k) dst[m][k] = *(const PG8_LAS bf16x8*)(lds + PG8_SA(b, h) + aoff + m * 2048 + k * 1024); } while (0)
#define PG8_LDB(dst, b, h) do { _Pragma("unroll") for (int n = 0; n < 2; ++n) _Pragma("unroll") for (int k = 0; k < 2; ++k) dst[n][k] = *(const PG8_LAS bf16x8*)(lds + PG8_SB(b, h) + boff + n * 2048 + k * 1024); } while (0)
#define PG8_MMA(ai, bj, At, Bt) do { __builtin_amdgcn_s_setprio(1); _Pragma("unroll") for (int m = 0; m < 4; ++m) _Pragma("unroll") for (int n = 0; n < 2; ++n) _Pragma("unroll") for (int k = 0; k < 2; ++k) \
        acc[ai][bj][m][n] = __builtin_amdgcn_mfma_f32_16x16x32_bf16(Bt[n][k], At[m][k], acc[ai][bj][m][n], 0, 0, 0); __builtin_amdgcn_s_setprio(0); } while (0)
#define PG8_WAIT_V(n) asm volatile("s_waitcnt vmcnt(" #n ")" ::: "memory")
#define PG8_WAIT_L(n) asm volatile("s_waitcnt lgkmcnt(" #n ")" ::: "memory")
#define PG8_BAR __builtin_amdgcn_s_barrier()
#define PG8_SCHED __builtin_amdgcn_sched_barrier(0)
    Unit cur, nxt; int ui = 0;
    if (!S.next(0, cur)) return;
    f32x4 acc[2][2][4][2];
#pragma unroll
    for (int a = 0; a < 2; ++a)
#pragma unroll
        for (int b = 0; b < 2; ++b)
#pragma unroll
            for (int m = 0; m < 4; ++m)
#pragma unroll
                for (int n = 0; n < 2; ++n) acc[a][b][m][n] = (f32x4){0.f, 0.f, 0.f, 0.f};
    bf16x8 At[4][2], B0[2][2], B1[2][2];
    const char* cA = (const char*)g.A + (size_t)cur.pm * tstep; const char* cB = (const char*)g.Bt + (size_t)cur.pn * tstep;
    S.a_ready(cur);
    if constexpr (SP2) {
        PG8_STAGE(PG8_SB(0, 0), cB, voffB); PG8_STAGE(PG8_SB(0, 1), cB + hstep, voffB); PG8_STAGE(PG8_SA(0, 0), cA, voffA); PG8_STAGE(PG8_SA(0, 1), cA + hstep, voffA);
        if (wr == 1) PG8_BAR;
        PG8_WAIT_V(2); PG8_BAR;
        PG8_STAGE(PG8_SB(1, 0), cB + kstep, voffB); PG8_STAGE(PG8_SA(1, 0), cA + kstep, voffA); PG8_STAGE(PG8_SB(1, 1), cB + hstep + kstep, voffB);
        PG8_WAIT_V(6); PG8_BAR;
    } else {
        PG8_STAGE(PG8_SB(0, 0), cB, voffB); PG8_STAGE(PG8_SA(0, 0), cA, voffA); PG8_STAGE(PG8_SB(0, 1), cB + hstep, voffB); PG8_STAGE(PG8_SA(0, 1), cA + hstep, voffA);
        if (wr == 1) PG8_BAR;
        PG8_WAIT_V(4); PG8_BAR;
        PG8_STAGE(PG8_SB(1, 0), cB + kstep, voffB); PG8_STAGE(PG8_SA(1, 0), cA + kstep, voffA); PG8_STAGE(PG8_SB(1, 1), cB + hstep + kstep, voffB);
        PG8_WAIT_V(6); PG8_BAR;
    }
    for (;;) {
        const bool has_next = S.next(ui + 1, nxt);
        const char* nA = has_next ? (const char*)g.A + (size_t)nxt.pm * tstep : cA; const char* nB = has_next ? (const char*)g.Bt + (size_t)nxt.pn * tstep : cB;
        for (int t = 0; t < nt; t += 2) {
            const bool last = (t == nt - 2);
            const char* a1 = cA + (size_t)(t + 1) * kstep;
            const char* a2 = last ? nA : cA + (size_t)(t + 2) * kstep; const char* b2 = last ? nB : cB + (size_t)(t + 2) * kstep;
            const char* a3 = a2 + kstep; const char* b3 = b2 + kstep;
            if (last && has_next) S.a_ready(nxt);
            if constexpr (SP2) {
            PG8_LDB(B0, 0, 0); PG8_LDB(B1, 0, 1); PG8_SCHED; PG8_LDA(At, 0, 0); PG8_STAGE(PG8_SA(1, 1), a1 + hstep, voffA);
            PG8_WAIT_V(8); PG8_WAIT_L(0); PG8_BAR; PG8_MMA(0, 0, At, B0); PG8_MMA(0, 1, At, B1); PG8_BAR; PG8_SCHED;
            PG8_LDA(At, 0, 1); PG8_STAGE(PG8_SB(0, 0), b2, voffB); PG8_STAGE(PG8_SB(0, 1), b2 + hstep, voffB); PG8_STAGE(PG8_SA(0, 0), a2, voffA);
            PG8_WAIT_V(8); PG8_WAIT_L(0); PG8_BAR; PG8_MMA(1, 0, At, B0); PG8_MMA(1, 1, At, B1); PG8_BAR; PG8_SCHED;
            PG8_LDB(B0, 1, 0); PG8_LDB(B1, 1, 1); PG8_SCHED; PG8_LDA(At, 1, 0); PG8_STAGE(PG8_SA(0, 1), a2 + hstep, voffA);
            PG8_WAIT_V(8); PG8_WAIT_L(0); PG8_BAR; PG8_MMA(0, 0, At, B0); PG8_MMA(0, 1, At, B1); PG8_BAR; PG8_SCHED;
            PG8_LDA(At, 1, 1); PG8_STAGE(PG8_SB(1, 0), b3, voffB); PG8_STAGE(PG8_SB(1, 1), b3 + hstep, voffB); PG8_STAGE(PG8_SA(1, 0), a3, voffA);
            PG8_WAIT_V(8); PG8_WAIT_L(0); PG8_BAR; PG8_MMA(1, 0, At, B0); PG8_MMA(1, 1, At, B1); PG8_BAR; PG8_SCHED;
            } else {
            PG8_LDB(B0, 0, 0); PG8_SCHED; PG8_LDA(At, 0, 0); PG8_STAGE(PG8_SA(1, 1), a1 + hstep, voffA);
            PG8_WAIT_L(8); PG8_BAR; PG8_WAIT_L(0); PG8_MMA(0, 0, At, B0); PG8_BAR; PG8_SCHED;
            PG8_LDB(B1, 0, 1); PG8_STAGE(PG8_SB(0, 0), b2, voffB);
            PG8_BAR; PG8_WAIT_L(0); PG8_MMA(0, 1, At, B1); PG8_BAR;
            PG8_LDA(At, 0, 1); PG8_STAGE(PG8_SA(0, 0), a2, voffA);
            PG8_BAR; PG8_WAIT_L(0); PG8_MMA(1, 0, At, B0); PG8_BAR; PG8_SCHED;
            PG8_STAGE(PG8_SB(0, 1), b2 + hstep, voffB);
            PG8_WAIT_V(6); PG8_BAR; PG8_MMA(1, 1, At, B1); PG8_BAR;
            PG8_LDB(B0, 1, 0); PG8_SCHED; PG8_LDA(At, 1, 0); PG8_STAGE(PG8_SA(0, 1), a2 + hstep, voffA);
            PG8_WAIT_L(8); PG8_BAR; PG8_WAIT_L(0); PG8_MMA(0, 0, At, B0); PG8_BAR; PG8_SCHED;
            PG8_LDB(B1, 1, 1); PG8_STAGE(PG8_SB(1, 0), b3, voffB);
            PG8_BAR; PG8_WAIT_L(0); PG8_MMA(0, 1, At, B1); PG8_BAR;
            PG8_LDA(At, 1, 1); PG8_STAGE(PG8_SA(1, 0), a3, voffA);
            PG8_BAR; PG8_WAIT_L(0); PG8_MMA(1, 0, At, B0); PG8_BAR; PG8_SCHED;
            PG8_STAGE(PG8_SB(1, 1), b3 + hstep, voffB);
            PG8_WAIT_V(6); PG8_BAR; PG8_MMA(1, 1, At, B1); PG8_BAR;
            }
        }
        if constexpr (ALIGN_EPI) { if (wr == 0) PG8_BAR; }
        if constexpr (!Epi::AFTER_DRAIN) { E(acc, cur, wr, wc, fr, fq); S.done(cur); }
        if (!has_next) break;
#pragma unroll
        for (int a = 0; a < 2; ++a)
#pragma unroll
            for (int b = 0; b < 2; ++b)
#pragma unroll
                for (int m = 0; m < 4; ++m)
#pragma unroll
                    for (int n = 0; n < 2; ++n) acc[a][b][m][n] = (f32x4){0.f, 0.f, 0.f, 0.f};
        cur = nxt; cA = nA; cB = nB; ++ui;
        if constexpr (ALIGN_EPI) { if (wr == 1) PG8_BAR; }
    }
    PG8_WAIT_V(0);
    if constexpr (!ALIGN_EPI) { if (wr == 0) PG8_BAR; }
    PG8_BAR;
    if constexpr (Epi::AFTER_DRAIN) { E.fused(acc, cur, wr, wc, fr, fq, lds, wid, lane); S.done(cur); }
#undef PG8_SA
#undef PG8_SB
#undef PG8_STAGE
#undef PG8_LDA
#undef PG8_LDB
#undef PG8_MMA
#undef PG8_WAIT_V
#undef PG8_WAIT_L
#undef PG8_BAR
#undef PG8_SCHED
}

template <class Epi>
__device__ __forceinline__ void gemm_half(PG8_LAS unsigned char* lds, const Gemm g, int pm, int pn, int hh, const Epi& E) {
    const int tid = launder((int)threadIdx.x), wid = __builtin_amdgcn_readfirstlane(tid >> 6), lane = tid & 63, wr = wid >> 2, wc = wid & 3, fr = lane & 15, fq = lane >> 4;
    const int K = g.K, nt = K / BK;
    unsigned voffA[2], voffB[2];
#pragma unroll
    for (int i = 0; i < 2; ++i) { int R, C; stage_rc(tid * 16 + i * 8192, R, C); const int Rb = Epi::PERM ? ((R & ~31) + perm32(R & 31)) : R;
        voffA[i] = (unsigned)(R * K + C) * 2u; voffB[i] = (unsigned)(Rb * K + C) * 2u; }
    const size_t kstep = (size_t)(BK * 2);
    const size_t hstep = (size_t)HALF * K * 2;
    const unsigned ldsw = (unsigned)wid * 1024u;
    const int aoff = lds_byte(wr * 64 + fr, fq * 8), boff = lds_byte(wc * 32 + fr, fq * 8);
    constexpr int SETB = 3 * HTB;
#define HU_STAGE(bufoff, gbase, voff) do { _Pragma("unroll") for (int _i = 0; _i < 2; ++_i) \
        __builtin_amdgcn_global_load_lds((const unsigned*)((const char*)(gbase) + (voff)[_i]), (PG8_LAS unsigned*)(lds + (bufoff) + ldsw + _i * 8192), 16, 0, 0); } while (0)
#define HU_STAGE3(so, kt) do { HU_STAGE((so), cB + (size_t)(kt) * kstep, voffB); HU_STAGE((so) + HTB, cB + hstep + (size_t)(kt) * kstep, voffB); HU_STAGE((so) + 2 * HTB, cA + (size_t)(kt) * kstep, voffA); } while (0)
#define HU_LDA(dst, so) do { _Pragma("unroll") for (int m = 0; m < 4; ++m) _Pragma("unroll") for (int k = 0; k < 2; ++k) dst[m][k] = *(const PG8_LAS bf16x8*)(lds + (so) + 2 * HTB + aoff + m * 2048 + k * 1024); } while (0)
#define HU_LDB(dst, so, h) do { _Pragma("unroll") for (int n = 0; n < 2; ++n) _Pragma("unroll") for (int k = 0; k < 2; ++k) dst[n][k] = *(const PG8_LAS bf16x8*)(lds + (so) + (h) * HTB + boff + n * 2048 + k * 1024); } while (0)
#define HU_MMA(bj, At, Bt) do { __builtin_amdgcn_s_setprio(1); _Pragma("unroll") for (int m = 0; m < 4; ++m) _Pragma("unroll") for (int n = 0; n < 2; ++n) _Pragma("unroll") for (int k = 0; k < 2; ++k) \
        acc[bj][m][n] = __builtin_amdgcn_mfma_f32_16x16x32_bf16(Bt[n][k], At[m][k], acc[bj][m][n], 0, 0, 0); __builtin_amdgcn_s_setprio(0); } while (0)
#define HU_WAIT_V(n) asm volatile("s_waitcnt vmcnt(" #n ")" ::: "memory")
#define HU_WAIT_L(n) asm volatile("s_waitcnt lgkmcnt(" #n ")" ::: "memory")
#define HU_BAR __builtin_amdgcn_s_barrier()
#define HU_SCHED __builtin_amdgcn_sched_barrier(0)
    f32x4 acc[2][4][2];
#pragma unroll
    for (int b = 0; b < 2; ++b)
#pragma unroll
        for (int m = 0; m < 4; ++m)
#pragma unroll
            for (int n = 0; n < 2; ++n) acc[b][m][n] = (f32x4){0.f, 0.f, 0.f, 0.f};
    bf16x8 At[4][2], B0[2][2], B1[2][2];
    const char* cA = (const char*)g.A + ((size_t)pm * 2 + hh) * hstep; const char* cB = (const char*)g.Bt + (size_t)pn * 2 * hstep;
    HU_STAGE3(0, 0);
    if (wr == 1) HU_BAR;
    HU_WAIT_V(0); HU_BAR;
    HU_STAGE3(SETB, 1);
    HU_BAR;
    int so = 0, so2 = 2 * SETB;
    for (int t = 0; t < nt; ++t) {
        HU_LDB(B0, so, 0); HU_LDB(B1, so, 1); HU_SCHED; HU_LDA(At, so);
        if (t + 2 < nt) { HU_STAGE3(so2, t + 2); HU_WAIT_V(6); } else { HU_WAIT_V(0); }
        HU_WAIT_L(0); HU_BAR; HU_MMA(0, At, B0); HU_MMA(1, At, B1); HU_BAR; HU_SCHED;
        so = (so == 2 * SETB) ? 0 : so + SETB; so2 = (so2 == 2 * SETB) ? 0 : so2 + SETB;
    }
    if (wr == 0) HU_BAR;
    E.one(acc, pn, pm * BM + hh * HALF + wr * 64 + fr, wc, fq);
    HU_BAR;
#undef HU_STAGE
#undef HU_STAGE3
#undef HU_LDA
#undef HU_LDB
#undef HU_MMA
#undef HU_WAIT_V
#undef HU_WAIT_L
#undef HU_BAR
#undef HU_SCHED
}
}

DEV void phase_inproj(const ParamsG& p, int l, int hf, int skew, unsigned char* smem) {
  pg8::Gemm g{(const bf16_t*)(p.ws + OFF_XB) + (size_t)hf * TH * DM, (const bf16_t*)(p.ws + OFF_WIN), TH, NPAD, DM};
  pg8::XcdOrder S; S.init(TH, NPAD, -1);
  pg8::EpiIn E{(bf16_t*)(p.ws + OFF_H), NPAD, (float*)(p.ws + OFF_SMALL), SM0 / 256};
  pg8::gemm_phase<pg8::EpiIn, pg8::XcdOrder, true, true>((PG8_LAS unsigned char*)smem, g, S, E);
  for (int q = S.c; ; q += S.ncu) { pg8::Unit u; int hh; if (!S.tail(q, u, hh)) break; pg8::gemm_half<pg8::EpiIn>((PG8_LAS unsigned char*)smem, g, u.pm, u.pn, hh, E); }
}

DEV void phase_outproj(const ParamsG& p, int l, int hf, unsigned char* smem) {
  pg8::Gemm g{(const bf16_t*)(p.ws + OFF_MIXED), (const bf16_t*)(p.ws + OFF_WOUT), TH, DM, DI};
  pg8::XcdOrder S; S.init(TH, DM, -1);
  const float* xin = (const float*)(((l == 0) ? p.x : (GAS const float*)p.out) + (size_t)hf * TH * DM);
  pg8::EpiOut E{xin, (float*)(p.out + (size_t)hf * TH * DM), DM, DN_ALPHA};
  const int total = S.rpx * S.nN;
  for (int q = S.c; q < 2 * total; q += S.ncu) {
    const int j = q % total, hh = q / total;
    pg8::gemm_half<pg8::EpiOut>((PG8_LAS unsigned char*)smem, g, S.rpx * S.x + (j % S.rpx), j / S.rpx, hh, E);
  }
}

DEV void phase_ln(const ParamsG& p, int l, int hf) {
  const int tid = launder(threadIdx.x), lane = tid & 63, w = tid >> 6;
  const float* g = (const float*)(p.ln_g + l * DM); const float* b = (const float*)(p.ln_b + l * DM);
  bf16_t* xb = (bf16_t*)(p.ws + OFF_XB);
  for (int r0 = (blockIdx.x * 8 + w) * 4; r0 < TH; r0 += gridDim.x * 32) {
    f32x4 v[4][4];
#pragma unroll
    for (int i = 0; i < 4; ++i)
#pragma unroll
      for (int j = 0; j < 4; ++j) v[i][j] = __builtin_nontemporal_load((const f32x4*)(p.out + (size_t)(hf * TH + r0 + i) * DM) + j * 64 + lane);
    f32x4 gg[4], bb[4];
#pragma unroll
    for (int j = 0; j < 4; ++j) { gg[j] = ((const f32x4*)g)[j * 64 + lane]; bb[j] = ((const f32x4*)b)[j * 64 + lane]; }
#pragma unroll
    for (int i = 0; i < 4; ++i) {
      const int row = hf * TH + r0 + i;
      float sm = 0.f;
#pragma unroll
      for (int j = 0; j < 4; ++j) sm += (v[i][j][0] + v[i][j][1]) + (v[i][j][2] + v[i][j][3]);
#pragma unroll
      for (int o = 32; o >= 1; o >>= 1) sm += __shfl_xor(sm, o);
      const float mu = sm * (1.f / DM);
      float q = 0.f;
#pragma unroll
      for (int j = 0; j < 4; ++j) { const f32x4 d = v[i][j] - mu; q += (d[0] * d[0] + d[1] * d[1]) + (d[2] * d[2] + d[3] * d[3]); }
#pragma unroll
      for (int o = 32; o >= 1; o >>= 1) q += __shfl_xor(q, o);
      const float rstd = rsqrtf(q * (1.f / DM) + 1e-5f);
#pragma unroll
      for (int j = 0; j < 4; ++j) {
        const f32x4 o = (v[i][j] - mu) * rstd * gg[j] + bb[j];
        ((f32x4*)(p.out + (size_t)row * DM))[j * 64 + lane] = o;
        if (l == 0) *(uint2*)(xb + (size_t)row * DM + (j * 64 + lane) * 4) = make_uint2(pk2(o[0], o[1]), pk2(o[2], o[3]));
      }
    }
  }
}

DEV void attn_item(const ParamsG& p, int l, int item, unsigned char* smem) {
  const int tid = launder(threadIdx.x), lane = tid & 63, w = tid >> 6, r = lane & 31, h = lane >> 5;
  const int qt = item & 15, head = (item >> 4) & 7, bl = item >> 7;
  const int kvh = head >> 2;
  bf16_t* Hh = (bf16_t*)(p.ws + OFF_H);
  const bf16_t* VT = (const bf16_t*)(p.ws + OFF_VT);
  const size_t rowbase = (size_t)bl * SEQ;
  float mq = fabsf(p.q_gain[l * 64 + lane]), mk = fabsf(p.k_gain[l * 64 + lane]);
#pragma unroll
  for (int o = 32; o >= 1; o >>= 1) { mq = fmaxf(mq, __shfl_xor(mq, o)); mk = fmaxf(mk, __shfl_xor(mk, o)); }
  const float M2 = 8.f * mq * mk * LOG2E * 1.01f;
  const int qrow = qt * 256 + w * 32 + r;
  const bf16_t* qp = Hh + (rowbase + qrow) * NPAD + A_Q + head * 64 + 8 * h;
  bf16x8 qf[4];
#pragma unroll
  for (int ks = 0; ks < 4; ++ks) qf[ks] = *(const bf16x8*)(qp + ks * 16);
  f32x16 o0 = zero16(), o1 = zero16();
  f32x2_t lsum2 = {0.f, 0.f};
  const int srow = tid >> 3, sch = (tid & 7) * 8;
  const bf16_t* kp = Hh + (rowbase + srow) * NPAD + A_K + kvh * 64 + sch;
  const bf16_t* vp = VT + ((size_t)((bl * 2 + kvh) * 64 + srow)) * SEQ + sch;
  union PB { bf16x8 v; unsigned u[4]; };
  auto qk = [&](int st, f32x16& s0, f32x16& s1) __attribute__((always_inline)) {
    const bf16_t* sK = (const bf16_t*)(smem + st * 18432);
#pragma unroll
    for (int i = 0; i < 16; ++i) { s0[i] = -M2; s1[i] = -M2; }
    bf16x8 a0[4], a1[4];
#pragma unroll
    for (int ks = 0; ks < 4; ++ks) { a0[ks] = *(const bf16x8*)(sK + r * 72 + ks * 16 + 8 * h); a1[ks] = *(const bf16x8*)(sK + (32 + r) * 72 + ks * 16 + 8 * h); }
    __builtin_amdgcn_sched_barrier(0);
#pragma unroll
    for (int ks = 0; ks < 4; ++ks) {
      s0 = __builtin_amdgcn_mfma_f32_32x32x16_bf16(a0[ks], qf[ks], s0, 0, 0, 0);
      s1 = __builtin_amdgcn_mfma_f32_32x32x16_bf16(a1[ks], qf[ks], s1, 0, 0, 0);
    }
  };
  auto soft = [&](f32x16& s0, f32x16& s1, PB (&pb)[2][2]) __attribute__((always_inline)) {
#pragma unroll
    for (int i = 0; i < 16; ++i) { s0[i] = __builtin_amdgcn_exp2f(s0[i]); s1[i] = __builtin_amdgcn_exp2f(s1[i]); lsum2 += (f32x2_t){s0[i], s1[i]}; }
#pragma unroll
    for (int s = 0; s < 2; ++s)
#pragma unroll
      for (int j = 0; j < 4; ++j) {
        pb[0][s].u[j] = pk2(s0[8 * s + 2 * j], s0[8 * s + 2 * j + 1]);
        pb[1][s].u[j] = pk2(s1[8 * s + 2 * j], s1[8 * s + 2 * j + 1]);
      }
  };
  auto pv = [&](int st, const PB (&pb)[2][2]) __attribute__((always_inline)) {
    const bf16_t* sV = (const bf16_t*)(smem + st * 18432 + 9216);
    union VF { bf16x8 v; uint2 u[2]; };
    VF a0[2][2], a1[2][2];
#pragma unroll
    for (int kt2 = 0; kt2 < 2; ++kt2)
#pragma unroll
      for (int s = 0; s < 2; ++s) {
        const int kb = kt2 * 32 + 16 * s + 4 * h;
        a0[kt2][s].u[0] = *(const uint2*)(sV + r * 72 + kb); a0[kt2][s].u[1] = *(const uint2*)(sV + r * 72 + kb + 8);
        a1[kt2][s].u[0] = *(const uint2*)(sV + (32 + r) * 72 + kb); a1[kt2][s].u[1] = *(const uint2*)(sV + (32 + r) * 72 + kb + 8);
      }
    __builtin_amdgcn_sched_barrier(0);
#pragma unroll
    for (int kt2 = 0; kt2 < 2; ++kt2)
#pragma unroll
      for (int s = 0; s < 2; ++s) {
        o0 = __builtin_amdgcn_mfma_f32_32x32x16_bf16(a0[kt2][s].v, pb[kt2][s].v, o0, 0, 0, 0);
        o1 = __builtin_amdgcn_mfma_f32_32x32x16_bf16(a1[kt2][s].v, pb[kt2][s].v, o1, 0, 0, 0);
      }
  };
  auto compute2 = [&](int sta, int stb) __attribute__((always_inline)) {
    f32x16 sa0, sa1, sb0, sb1; PB pa[2][2], pbb[2][2];
    qk(sta, sa0, sa1); qk(stb, sb0, sb1);
    soft(sa0, sa1, pa); pv(sta, pa);
    soft(sb0, sb1, pbb); pv(stb, pbb);
  };
  constexpr int NKT = SEQ / 64;
  auto sstore = [&](int st, const u32x4& kk, const u32x4& vv) __attribute__((always_inline)) {
    *(u32x4*)(smem + st * 18432 + srow * 144 + sch * 2) = kk;
    *(u32x4*)(smem + st * 18432 + 9216 + srow * 144 + sch * 2) = vv;
  };
  u32x4 k0 = *(const u32x4*)kp, v0 = *(const u32x4*)vp;
  u32x4 k1 = *(const u32x4*)(kp + (size_t)64 * NPAD), v1 = *(const u32x4*)(vp + 64);
  sstore(0, k0, v0); sstore(1, k1, v1);
  k0 = *(const u32x4*)(kp + (size_t)2 * 64 * NPAD); v0 = *(const u32x4*)(vp + 2 * 64);
  k1 = *(const u32x4*)(kp + (size_t)3 * 64 * NPAD); v1 = *(const u32x4*)(vp + 3 * 64);
  lds_barrier();
  for (int kt = 0; kt < NKT; kt += 4) {
    sstore(2, k0, v0); sstore(3, k1, v1);
    if (kt + 4 < NKT) {
      k0 = *(const u32x4*)(kp + (size_t)(kt + 4) * 64 * NPAD); v0 = *(const u32x4*)(vp + (kt + 4) * 64);
      k1 = *(const u32x4*)(kp + (size_t)(kt + 5) * 64 * NPAD); v1 = *(const u32x4*)(vp + (kt + 5) * 64);
    }
    compute2(0, 1);
    lds_barrier();
    if (kt + 4 < NKT) {
      sstore(0, k0, v0); sstore(1, k1, v1);
      if (kt + 6 < NKT) {
        k0 = *(const u32x4*)(kp + (size_t)(kt + 6) * 64 * NPAD); v0 = *(const u32x4*)(vp + (kt + 6) * 64);
        k1 = *(const u32x4*)(kp + (size_t)(kt + 7) * 64 * NPAD); v1 = *(const u32x4*)(vp + (kt + 7) * 64);
      }
    }
    compute2(2, 3);
    lds_barrier();
  }
  float lsum = lsum2[0] + lsum2[1];
  lsum += __shfl_xor(lsum, 32);
  const float inv = 1.f / lsum;
  const bf16_t* zp = Hh + (rowbase + qrow) * NPAD + A_Z + head * 64;
  bf16_t* op = Hh + (rowbase + qrow) * NPAD + A_Q + head * 64;
#pragma unroll
  for (int dt = 0; dt < 2; ++dt)
#pragma unroll
    for (int g = 0; g < 4; ++g) {
      const int d0 = dt * 32 + 8 * g + 4 * h;
      const uint2 zz = *(const uint2*)(zp + d0);
      const float z0 = bf2f((bf16_t)(zz.x & 0xffff)), z1 = bf2f((bf16_t)(zz.x >> 16)), z2 = bf2f((bf16_t)(zz.y & 0xffff)), z3 = bf2f((bf16_t)(zz.y >> 16));
      const f32x16& oo = dt ? o1 : o0;
      uint2 ov;
      ov.x = pk2(oo[4 * g + 0] * inv * fsilu(z0), oo[4 * g + 1] * inv * fsilu(z1));
      ov.y = pk2(oo[4 * g + 2] * inv * fsilu(z2), oo[4 * g + 3] * inv * fsilu(z3));
      *(uint2*)(op + d0) = ov;
    }
  lds_barrier();
}

constexpr int L_QT = 0, L_KT = 17408, L_QC = 34816, L_KHT = 52224, L_VT = 70656, L_ST = 89088,
              L_D = 123904, L_TOT = 124416, L_ACS = 128512, L_DT = 129024;

template <int K, int V> struct ScanGeom {
  static constexpr int KP = K + 8;
  static constexpr int NS = (K / 32) * (V / 32) / 8;
};

template <int K, int V>
DEV void scan_write_state(unsigned char* smem, const f32x16* S, int w, int lane) {
  constexpr int KP = K + 8, NS = ScanGeom<K, V>::NS, NVT = V / 32;
  bf16_t* sST = (bf16_t*)(smem + L_ST);
  const int c = lane & 31, h = lane >> 5;
#pragma unroll
  for (int i = 0; i < NS; ++i) {
    const int tile = w * NS + i, kt = tile / NVT, nt = tile % NVT;
#pragma unroll
    for (int g = 0; g < 4; ++g) {
      uint2 o; o.x = pk2(S[i][4 * g + 0], S[i][4 * g + 1]); o.y = pk2(S[i][4 * g + 2], S[i][4 * g + 3]);
      *(uint2*)(sST + (nt * 32 + c) * KP + kt * 32 + 8 * g + 4 * h) = o;
    }
  }
}

template <int K, int V, bool SSDM>
DEV void scan_core(unsigned char* smem, f32x16* S, bf16_t* orow0, int dir, int w, int lane, bool do_out, const float* sAcs) {
  constexpr int KP = K + 8, NS = ScanGeom<K, V>::NS, NVT = V / 32, NOT = 2 * NVT;
  const bf16_t* sQt = (const bf16_t*)(smem + L_QT); const bf16_t* sKt = (const bf16_t*)(smem + L_KT);
  const bf16_t* sQc = (const bf16_t*)(smem + L_QC); const bf16_t* sKhT = (const bf16_t*)(smem + L_KHT);
  const bf16_t* sVT = (const bf16_t*)(smem + L_VT);
  const bf16_t* sST = (const bf16_t*)(smem + L_ST); const float* sD = (const float*)(smem + L_D);
  const int c = lane & 31, h = lane >> 5;
  if (do_out && w < NOT) {
    const int tt = w / NVT, nt = w % NVT;
    f32x16 acc = zero16();
    union VB { bf16x8 v; uint2 u[2]; };
    VB vbf[2][2];
#pragma unroll
    for (int st = 0; st < 2; ++st)
#pragma unroll
      for (int s2 = 0; s2 < 2; ++s2) {
        const int kb = st * 32 + 16 * s2 + 4 * h;
        vbf[st][s2].u[0] = *(const uint2*)(sVT + (nt * 32 + c) * 72 + kb); vbf[st][s2].u[1] = *(const uint2*)(sVT + (nt * 32 + c) * 72 + kb + 8);
      }
#pragma unroll
    for (int st = 0; st < 2; ++st) {
      if (st <= tt) {
        f32x16 pt = zero16();
        mma32<K>(pt, sKt + st * 32 * KP, KP, sQt + tt * 32 * KP, KP, lane);
        const int tau = tt * 32 + c;
        const float at = SSDM ? sAcs[tau] : 0.f;
        f32x4 asg[4];
#pragma unroll
        for (int g = 0; g < 4; ++g) asg[g] = SSDM ? *(const f32x4*)(sAcs + st * 32 + 8 * g + 4 * h) : (f32x4){0.f, 0.f, 0.f, 0.f};
#pragma unroll
        for (int reg = 0; reg < 16; ++reg) {
          const int sig = st * 32 + rowoff(reg, h);
          float v = pt[reg];
          if (SSDM) v *= ex2(at - asg[reg >> 2][reg & 3]);
          pt[reg] = (sig <= tau) ? v : 0.f;
        }
#pragma unroll
        for (int s2 = 0; s2 < 2; ++s2) {
          union { bf16x8 v; unsigned u[4]; } pa;
#pragma unroll
          for (int j = 0; j < 4; ++j) pa.u[j] = pk2(pt[8 * s2 + 2 * j], pt[8 * s2 + 2 * j + 1]);
          acc = __builtin_amdgcn_mfma_f32_32x32x16_bf16(pa.v, vbf[st][s2].v, acc, 0, 0, 0);
        }
      }
    }
    mma32<K>(acc, sQc + tt * 32 * KP, KP, sST + nt * 32 * KP, KP, lane);
    {
      const int l1 = lane & 1, l2 = (lane >> 1) & 1;
#pragma unroll
      for (int g = 0; g < 4; ++g) {
        const float a0 = acc[4 * g], a1 = acc[4 * g + 1], a2 = acc[4 * g + 2], a3 = acc[4 * g + 3];
        const float n0 = __builtin_bit_cast(float, __builtin_amdgcn_update_dpp(0, __builtin_bit_cast(int, a0), 0xB1, 0xF, 0xF, false));
        const float n1 = __builtin_bit_cast(float, __builtin_amdgcn_update_dpp(0, __builtin_bit_cast(int, a1), 0xB1, 0xF, 0xF, false));
        const float n2 = __builtin_bit_cast(float, __builtin_amdgcn_update_dpp(0, __builtin_bit_cast(int, a2), 0xB1, 0xF, 0xF, false));
        const float n3 = __builtin_bit_cast(float, __builtin_amdgcn_update_dpp(0, __builtin_bit_cast(int, a3), 0xB1, 0xF, 0xF, false));
        const unsigned A = l1 ? pk2(n1, a1) : pk2(a0, n0);
        const unsigned B = l1 ? pk2(n3, a3) : pk2(a2, n2);
        const unsigned send = l2 ? A : B, keep = l2 ? B : A;
        const unsigned recv = (unsigned)__builtin_amdgcn_update_dpp(0, (int)send, 0x4E, 0xF, 0xF, false);
        const int tau = tt * 32 + 8 * g + 4 * h + 2 * l2 + l1;
        const int tok = dir ? (63 - tau) : tau;
        *(uint2*)(orow0 + (size_t)tok * 512 + nt * 32 + 4 * (c >> 2)) = l2 ? make_uint2(recv, keep) : make_uint2(keep, recv);
      }
    }
  }
  {
    const int kt = (w * NS) / NVT;
    f32x4 dv[4];
#pragma unroll
    for (int g = 0; g < 4; ++g) dv[g] = *(const f32x4*)(sD + kt * 32 + 8 * g + 4 * h);
#pragma unroll
    for (int i = 0; i < NS; ++i) {
      const int nt = (w * NS + i) % NVT;
      const bf16_t* ap = sKhT + kt * 32 * 72 + c * 72 + 8 * h;
      const bf16_t* bp = sVT + nt * 32 * 72 + c * 72 + 8 * h;
      bf16x8 av[4], bv[4];
#pragma unroll
      for (int j = 0; j < 4; ++j) { av[j] = *(const bf16x8*)(ap + 16 * j); bv[j] = *(const bf16x8*)(bp + 16 * j); }
      __builtin_amdgcn_sched_barrier(0);
#pragma unroll
      for (int reg = 0; reg < 16; ++reg) S[i][reg] *= dv[reg >> 2][reg & 3];
#pragma unroll
      for (int j = 0; j < 4; ++j) S[i] = __builtin_amdgcn_mfma_f32_32x32x16_bf16(av[j], bv[j], S[i], 0, 0, 0);
    }
  }
}

template <int K, int V>
DEV void state_store(bf16_t* buf, const f32x16* S, int w, int lane) {
  constexpr int NS = ScanGeom<K, V>::NS, NVT = V / 32;
  const int c = lane & 31, h = lane >> 5;
#pragma unroll
  for (int i = 0; i < NS; ++i) {
    const int tile = w * NS + i, kt = tile / NVT, nt = tile % NVT;
#pragma unroll
    for (int reg = 0; reg < 16; ++reg) buf[(kt * 32 + rowoff(reg, h)) * V + nt * 32 + c] = f2bf(S[i][reg]);
  }
}
template <int K, int V>
DEV void state_load(const float* buf, f32x16* S, int w, int lane) {
  constexpr int NS = ScanGeom<K, V>::NS, NVT = V / 32;
  const int c = lane & 31, h = lane >> 5;
#pragma unroll
  for (int i = 0; i < NS; ++i) {
    const int tile = w * NS + i, kt = tile / NVT, nt = tile % NVT;
#pragma unroll
    for (int reg = 0; reg < 16; ++reg) S[i][reg] = buf[(kt * 32 + rowoff(reg, h)) * V + nt * 32 + c];
  }
}

template <int K, int V>
DEV void state_combine(const bf16_t* ubase, int ustride, const float* dbase, int seg, f32x16* S, int w, int lane) {
  constexpr int NS = ScanGeom<K, V>::NS, NVT = V / 32;
  const int c = lane & 31, h = lane >> 5;
  for (int j = 0; j < seg; ++j) {
    const bf16_t* buf = ubase + (size_t)j * ustride;
    const float* dj = dbase + j * 128;
    float u[NS][16]; f32x4 dv[NS][4];
#pragma unroll
    for (int i = 0; i < NS; ++i) {
      const int tile = w * NS + i, kt = tile / NVT, nt = tile % NVT;
#pragma unroll
      for (int g = 0; g < 4; ++g) dv[i][g] = *(const f32x4*)(dj + kt * 32 + 8 * g + 4 * h);
#pragma unroll
      for (int reg = 0; reg < 16; ++reg) u[i][reg] = bf2f(buf[(kt * 32 + rowoff(reg, h)) * V + nt * 32 + c]);
    }
#pragma unroll
    for (int i = 0; i < NS; ++i)
#pragma unroll
      for (int reg = 0; reg < 16; ++reg) S[i][reg] = (j > 0 ? dv[i][reg >> 2][reg & 3] * S[i][reg] : 0.f) + u[i][reg];
  }
}

#define PACK8_LO(v) (u32x4){((v)[0] & 0xffffu) | ((v)[1] << 16), ((v)[2] & 0xffffu) | ((v)[3] << 16), ((v)[4] & 0xffffu) | ((v)[5] << 16), ((v)[6] & 0xffffu) | ((v)[7] << 16)}
#define PACK8_HI(v) (u32x4){((v)[0] >> 16) | ((v)[1] & 0xffff0000u), ((v)[2] >> 16) | ((v)[3] & 0xffff0000u), ((v)[4] >> 16) | ((v)[5] & 0xffff0000u), ((v)[6] >> 16) | ((v)[7] & 0xffff0000u)}
#define CVT8(f) (u32x4){pk2((f)[0], (f)[1]), pk2((f)[2], (f)[3]), pk2((f)[4], (f)[5]), pk2((f)[6], (f)[7])}


DEV void hgrn_item(const ParamsG& p, int l, int it, int seg, int mode, unsigned char* smem) {
  const int bl = it >> 3, head = (it >> 1) & 3, dir = it & 1;
  const bool do_out = (mode == 3);
  constexpr int K = 128, V = 128, KPW = 68;
  const int tid = launder(threadIdx.x), lane = tid & 63, w = tid >> 6;
  const int cp = tid & 63, tg = tid >> 6, ch0 = 2 * cp;
  const bf16_t* Hh = (const bf16_t*)(p.ws + OFF_H);
  bf16_t* OB = (bf16_t*)(p.ws + OFF_OBUF) + (size_t)(0 * 2 + dir) * TH * 512;
  const size_t rowbase = (size_t)bl * SEQ;
  float lb0 = 0.f, lb1 = 0.f;
  if (l > 0) {
    lb0 = fsigmoid(p.lb_logits[512 + head * 128 + ch0] - p.lb_logits[head * 128 + ch0]);
    lb1 = fsigmoid(p.lb_logits[512 + head * 128 + ch0 + 1] - p.lb_logits[head * 128 + ch0 + 1]);
  }
  const float om0 = 1.f - lb0, om1 = 1.f - lb1;
  const int fbase = dir ? H_FB : H_FF;
  unsigned* sQt = (unsigned*)(smem + L_QT); unsigned* sKt = (unsigned*)(smem + L_KT); unsigned* sQc = (unsigned*)(smem + L_QC);
  bf16_t* sKhT = (bf16_t*)(smem + L_KHT); bf16_t* sVT = (bf16_t*)(smem + L_VT);
  float* sD = (float*)(smem + L_D); float* sTot = (float*)(smem + L_TOT);
  f32x16 S[2]; S[0] = zero16(); S[1] = zero16();
  bf16_t* sbuf = (bf16_t*)(p.ws + OFF_SB0) + ((size_t)it * NSEG + seg) * 16384;
  if (do_out) state_combine<K, V>((const bf16_t*)(p.ws + OFF_SB0) + (size_t)it * NSEG * 16384, 16384, (const float*)(p.ws + OFF_DB) + (size_t)it * NSEG * 128, seg, S, w, lane);
  float dlog0 = 0.f, dlog1 = 0.f;
  unsigned pf[8], qq[8], vv[8];
  float g0[8], g1[8], kx0[8], kx1[8];
  auto gloadA = [&](int cidx) __attribute__((always_inline)) {
    const int chunk = dir ? (63 - cidx) : cidx;
#pragma unroll
    for (int i = 0; i < 8; ++i) {
      const int tau = 8 * tg + i;
      const int tok = chunk * 64 + (dir ? (63 - tau) : tau);
      pf[i] = ((const unsigned*)(Hh + (rowbase + tok) * NPAD + head * 128 + fbase))[cp];
    }
  };
  auto gloadB = [&](int cidx) __attribute__((always_inline)) {
    const int chunk = dir ? (63 - cidx) : cidx;
#pragma unroll
    for (int i = 0; i < 8; ++i) {
      const int tau = 8 * tg + i;
      const int tok = chunk * 64 + (dir ? (63 - tau) : tau);
      const unsigned* rp = (const unsigned*)(Hh + (rowbase + tok) * NPAD + head * 128) + cp;
      vv[i] = rp[H_I / 2];
      qq[i] = do_out ? rp[H_Q / 2] : 0u;
    }
  };
  auto stage1 = [&]() __attribute__((always_inline)) {
    float r0 = 0.f, r1 = 0.f;
#pragma unroll
    for (int i = 0; i < 8; ++i) {
      const float e0 = ex2(fminf(-lo16(pf[i]) * LOG2E, 80.f)), e1 = ex2(fminf(-hi16(pf[i]) * LOG2E, 80.f));
      const float s0 = frcp(1.f + e0), s1 = frcp(1.f + e1);
      r0 += lg2(lb0 + om0 * s0); r1 += lg2(lb1 + om1 * s1);
      g0[i] = r0; g1[i] = r1;
      kx0[i] = om0 * e0 * s0; kx1[i] = om1 * e1 * s1;
    }
    *(float2*)(sTot + tg * 128 + ch0) = make_float2(r0, r1);
  };
  gloadA(seg * SLEN); gloadB(seg * SLEN);
  stage1();
  if (SLEN > 1) gloadA(seg * SLEN + 1);
  for (int ci = 0; ci < SLEN; ++ci) {
    const int cidx = seg * SLEN + ci;
    const int chunk = dir ? (63 - cidx) : cidx;
    lds_barrier();
    float off0 = 0.f, off1 = 0.f, ref0 = 0.f, ref1 = 0.f, be0 = 0.f, be1 = 0.f;
    float2 tl[8];
#pragma unroll
    for (int j = 0; j < 8; ++j) tl[j] = *(const float2*)(sTot + j * 128 + ch0);
    __builtin_amdgcn_sched_barrier(0);
#pragma unroll
    for (int j = 0; j < 8; ++j) {
      const float2 t = tl[j];
      if (j < tg) { off0 += t.x; off1 += t.y; }
      if (j < 4) { ref0 += t.x; ref1 += t.y; }
      be0 += t.x; be1 += t.y;
    }
    dlog0 += be0; dlog1 += be1;
    const float eref0 = ex2(ref0), eref1 = ex2(ref1), ebr0 = ex2(be0 - ref0), ebr1 = ex2(be1 - ref1);
    const float d0 = off0 - ref0, d1 = off1 - ref1;
    float kh0[8], kh1[8];
#pragma unroll
    for (int i = 0; i < 8; ++i) {
      const int tau = 8 * tg + i;
      const float E0 = ex2(g0[i] + d0), E1 = ex2(g1[i] + d1);
      const float kt0 = kx0[i] * frcp(E0), kt1 = kx1[i] * frcp(E1);
      if (do_out) {
        const float qt0 = lo16(qq[i]) * E0, qt1 = hi16(qq[i]) * E1;
        sQt[tau * KPW + cp] = pk2(qt0, qt1);
        sKt[tau * KPW + cp] = pk2(kt0, kt1);
        sQc[tau * KPW + cp] = pk2(qt0 * eref0, qt1 * eref1);
      }
      kh0[i] = kt0 * ebr0; kh1[i] = kt1 * ebr1;
    }
    *(u32x4*)(sKhT + ch0 * 72 + 8 * tg) = CVT8(kh0);
    *(u32x4*)(sKhT + (ch0 + 1) * 72 + 8 * tg) = CVT8(kh1);
    *(u32x4*)(sVT + ch0 * 72 + 8 * tg) = PACK8_LO(vv);
    *(u32x4*)(sVT + (ch0 + 1) * 72 + 8 * tg) = PACK8_HI(vv);
    if (tg == 0) *(float2*)(sD + ch0) = make_float2(ex2(be0), ex2(be1));
    if (do_out) scan_write_state<K, V>(smem, S, w, lane);
    if (ci + 1 < SLEN) gloadB(cidx + 1);
    lds_barrier();
    scan_core<K, V, false>(smem, S, OB + (rowbase + (size_t)chunk * 64) * 512 + head * 128, dir, w, lane, do_out, nullptr);
    if (ci + 1 < SLEN) { stage1(); if (ci + 2 < SLEN) gloadA(cidx + 2); }
  }
  if (!do_out) {
    state_store<K, V>(sbuf, S, w, lane);
    if (tg == 0) *(float2*)((float*)(p.ws + OFF_DB) + ((size_t)it * NSEG + seg) * 128 + ch0) = make_float2(ex2(dlog0), ex2(dlog1));
  }
  lds_barrier();
}

DEV void gla_item(const ParamsG& p, int l, int it, int seg, int mode, unsigned char* smem) {
  const int j16 = it - 16, bl = j16 >> 3, head = (j16 >> 1) & 3, dir = j16 & 1;
  const bool do_out = (mode == 3);
  constexpr int K = 64, V = 128, KPW = 36;
  const int tid = launder(threadIdx.x), lane = tid & 63, w = tid >> 6;
  const int cp = tid & 31, tg = tid >> 5, ch0 = 2 * cp;
  const int vp2 = tid & 63, vg = tid >> 6;
  const bf16_t* Hh = (const bf16_t*)(p.ws + OFF_H);
  const bf16_t* Gb = (const bf16_t*)(p.ws + OFF_G);
  bf16_t* OB = (bf16_t*)(p.ws + OFF_OBUF) + (size_t)(2 * 2 + dir) * TH * 512;
  const size_t rowbase = (size_t)bl * SEQ;
  unsigned* sQt = (unsigned*)(smem + L_QT); unsigned* sKt = (unsigned*)(smem + L_KT); unsigned* sQc = (unsigned*)(smem + L_QC);
  bf16_t* sKhT = (bf16_t*)(smem + L_KHT); bf16_t* sVT = (bf16_t*)(smem + L_VT);
  float* sD = (float*)(smem + L_D); float* sTot = (float*)(smem + L_TOT);
  f32x16 S[1]; S[0] = zero16();
  bf16_t* sbuf = (bf16_t*)(p.ws + OFF_SB1) + ((size_t)j16 * NSEG + seg) * 8192;
  if (do_out) state_combine<K, V>((const bf16_t*)(p.ws + OFF_SB1) + (size_t)j16 * NSEG * 8192, 8192, (const float*)(p.ws + OFF_DB) + (size_t)it * NSEG * 128, seg, S, w, lane);
  float dlog0 = 0.f, dlog1 = 0.f;
  unsigned pg[4];
  float g0[4], g1[4]; unsigned kk[4], qq[4], vv[8];
  auto gloadA = [&](int cidx) __attribute__((always_inline)) {
    const int chunk = dir ? (63 - cidx) : cidx;
#pragma unroll
    for (int i = 0; i < 4; ++i) {
      const int tau = 4 * tg + i;
      const int tok = chunk * 64 + (dir ? (63 - tau) : tau);
      pg[i] = ((const unsigned*)(Gb + (rowbase + tok) * 512 + dir * 256 + head * 64))[cp];
    }
  };
  auto gloadB = [&](int cidx) __attribute__((always_inline)) {
    const int chunk = dir ? (63 - cidx) : cidx;
#pragma unroll
    for (int i = 0; i < 4; ++i) {
      const int tau = 4 * tg + i;
      const int tok = chunk * 64 + (dir ? (63 - tau) : tau);
      const unsigned* rp = (const unsigned*)(Hh + (rowbase + tok) * NPAD + head * 64) + cp;
      kk[i] = rp[G_K / 2]; qq[i] = do_out ? rp[G_Q / 2] : 0u;
    }
#pragma unroll
    for (int i = 0; i < 8; ++i) {
      const int tau = 8 * vg + i;
      const int tok = chunk * 64 + (dir ? (63 - tau) : tau);
      vv[i] = ((const unsigned*)(Hh + (rowbase + tok) * NPAD + G_V + head * 128))[vp2];
    }
  };
  auto stage1 = [&]() __attribute__((always_inline)) {
    float r0 = 0.f, r1 = 0.f;
#pragma unroll
    for (int i = 0; i < 4; ++i) { r0 += lo16(pg[i]); r1 += hi16(pg[i]); g0[i] = r0; g1[i] = r1; }
    *(float2*)(sTot + tg * 64 + ch0) = make_float2(r0, r1);
  };
  gloadA(seg * SLEN); gloadB(seg * SLEN);
  stage1();
  if (SLEN > 1) gloadA(seg * SLEN + 1);
  for (int ci = 0; ci < SLEN; ++ci) {
    const int cidx = seg * SLEN + ci;
    const int chunk = dir ? (63 - cidx) : cidx;
    lds_barrier();
    float off0 = 0.f, off1 = 0.f, ref0 = 0.f, ref1 = 0.f, be0 = 0.f, be1 = 0.f;
    float2 tl[16];
#pragma unroll
    for (int j = 0; j < 16; ++j) tl[j] = *(const float2*)(sTot + j * 64 + ch0);
    __builtin_amdgcn_sched_barrier(0);
#pragma unroll
    for (int j = 0; j < 16; ++j) {
      const float2 t = tl[j];
      if (j < tg) { off0 += t.x; off1 += t.y; }
      if (j < 8) { ref0 += t.x; ref1 += t.y; }
      be0 += t.x; be1 += t.y;
    }
    dlog0 += be0; dlog1 += be1;
    const float eref0 = ex2(ref0), eref1 = ex2(ref1), ebr0 = ex2(be0 - ref0), ebr1 = ex2(be1 - ref1);
    const float d0 = off0 - ref0, d1 = off1 - ref1;
    float kh0[4], kh1[4];
#pragma unroll
    for (int i = 0; i < 4; ++i) {
      const int tau = 4 * tg + i;
      const float E0 = ex2(g0[i] + d0), E1 = ex2(g1[i] + d1);
      const float kt0 = lo16(kk[i]) * frcp(E0), kt1 = hi16(kk[i]) * frcp(E1);
      if (do_out) {
        const float qt0 = lo16(qq[i]) * E0, qt1 = hi16(qq[i]) * E1;
        sQt[tau * KPW + cp] = pk2(qt0, qt1);
        sKt[tau * KPW + cp] = pk2(kt0, kt1);
        sQc[tau * KPW + cp] = pk2(qt0 * eref0, qt1 * eref1);
      }
      kh0[i] = kt0 * ebr0; kh1[i] = kt1 * ebr1;
    }
    *(uint2*)(sKhT + ch0 * 72 + 4 * tg) = make_uint2(pk2(kh0[0], kh0[1]), pk2(kh0[2], kh0[3]));
    *(uint2*)(sKhT + (ch0 + 1) * 72 + 4 * tg) = make_uint2(pk2(kh1[0], kh1[1]), pk2(kh1[2], kh1[3]));
    *(u32x4*)(sVT + (2 * vp2) * 72 + 8 * vg) = PACK8_LO(vv);
    *(u32x4*)(sVT + (2 * vp2 + 1) * 72 + 8 * vg) = PACK8_HI(vv);
    if (tg == 0) *(float2*)(sD + ch0) = make_float2(ex2(be0), ex2(be1));
    if (do_out) scan_write_state<K, V>(smem, S, w, lane);
    if (ci + 1 < SLEN) gloadB(cidx + 1);
    lds_barrier();
    scan_core<K, V, false>(smem, S, OB + (rowbase + (size_t)chunk * 64) * 512 + head * 128, dir, w, lane, do_out, nullptr);
    if (ci + 1 < SLEN) { stage1(); if (ci + 2 < SLEN) gloadA(cidx + 2); }
  }
  if (!do_out) {
    state_store<K, V>(sbuf, S, w, lane);
    if (tg == 0) *(float2*)((float*)(p.ws + OFF_DB) + ((size_t)it * NSEG + seg) * 128 + ch0) = make_float2(ex2(dlog0), ex2(dlog1));
  }
  lds_barrier();
}

DEV void ssd_item(const ParamsG& p, int l, int it, int seg, int mode, unsigned char* smem) {
  const int j32 = it - 32, bl = j32 >> 4, head = (j32 >> 1) & 7, dir = j32 & 1;
  const bool do_out = (mode == 3);
  constexpr int K = 128, V = 64, KPW = 68;
  const int tid = launder(threadIdx.x), lane = tid & 63, w = tid >> 6;
  const int cp = tid & 63, tg = tid >> 6, n0 = 2 * cp;
  const int xp = tid & 31, xg = tid >> 5;
  const int grp = head >> 2;
  const bf16_t* U = (const bf16_t*)(p.ws + OFF_U);
  const float* SMALL = (const float*)(p.ws + OFF_SMALL);
  bf16_t* OB = (bf16_t*)(p.ws + OFF_OBUF) + (size_t)(1 * 2 + dir) * TH * 512;
  const size_t rowbase = (size_t)bl * SEQ;
  unsigned* sQt = (unsigned*)(smem + L_QT); unsigned* sKt = (unsigned*)(smem + L_KT); unsigned* sQc = (unsigned*)(smem + L_QC);
  bf16_t* sKhT = (bf16_t*)(smem + L_KHT); bf16_t* sVT = (bf16_t*)(smem + L_VT);
  float* sD = (float*)(smem + L_D);
  const float dtb = p.dt_bias[(l * 2 + dir) * 8 + head];
  const float Acoef = -__expf(p.a_log[(l * 2 + dir) * 8 + head]) * LOG2E;
  f32x16 S[1]; S[0] = zero16();
  bf16_t* sbuf = (bf16_t*)(p.ws + OFF_SB2) + ((size_t)j32 * NSEG + seg) * 8192;
  if (do_out) state_combine<K, V>((const bf16_t*)(p.ws + OFF_SB2) + (size_t)j32 * NSEG * 8192, 8192, (const float*)(p.ws + OFF_DB) + (size_t)it * NSEG * 128, seg, S, w, lane);
  float dlog = 0.f;
  unsigned bb[8], cc[8], xx[4];
  float rdt = 0.f;
  auto gloadA = [&](int cidx) __attribute__((always_inline)) {
    const int chunk = dir ? (63 - cidx) : cidx;
    if (w == 0) {
      const int tok = chunk * 64 + (dir ? (63 - lane) : lane);
      rdt = SMALL[(rowbase + tok) * 48 + dir * 8 + head];
    }
  };
  auto gloadB = [&](int cidx) __attribute__((always_inline)) {
    const int chunk = dir ? (63 - cidx) : cidx;
#pragma unroll
    for (int i = 0; i < 8; ++i) {
      const int tau = 8 * tg + i;
      const int tok = chunk * 64 + (dir ? (63 - tau) : tau);
      const unsigned* rp = (const unsigned*)(U + (rowbase + tok) * 1024 + grp * 128) + cp;
      bb[i] = rp[512 / 2]; cc[i] = do_out ? rp[768 / 2] : 0u;
    }
#pragma unroll
    for (int i = 0; i < 4; ++i) {
      const int tau = 4 * xg + i;
      const int tok = chunk * 64 + (dir ? (63 - tau) : tau);
      xx[i] = ((const unsigned*)(U + (rowbase + tok) * 1024 + head * 64))[xp];
    }
  };
  auto stage1 = [&](int par) __attribute__((always_inline)) {
    if (w == 0) {
      const float xv = rdt + dtb;
      const float dt = (xv > 20.f) ? xv : log1pf(__expf(xv));
      float a = dt * Acoef;
#pragma unroll
      for (int o = 1; o < 64; o <<= 1) { const float t = __shfl_up(a, o); if (lane >= o) a += t; }
      ((float*)(smem + L_ACS))[par * 64 + lane] = a; ((float*)(smem + L_DT))[par * 64 + lane] = dt;
    }
  };
  gloadA(seg * SLEN); gloadB(seg * SLEN);
  stage1(0);
  if (SLEN > 1) gloadA(seg * SLEN + 1);
  for (int ci = 0; ci < SLEN; ++ci) {
    const int cidx = seg * SLEN + ci;
    const int chunk = dir ? (63 - cidx) : cidx;
    const float* sAcs = (const float*)(smem + L_ACS) + (ci & 1) * 64;
    const float* sDt = (const float*)(smem + L_DT) + (ci & 1) * 64;
    lds_barrier();
    const float aend = sAcs[63];
    dlog += aend;
    {
      float kh0[8], kh1[8];
      const f32x4 acv0 = *(const f32x4*)(sAcs + 8 * tg), acv1 = *(const f32x4*)(sAcs + 8 * tg + 4);
      const f32x4 dtv4 = *(const f32x4*)(sDt + 4 * xg);
#pragma unroll
      for (int i = 0; i < 8; ++i) {
        const int tau = 8 * tg + i;
        const float ac = (i < 4) ? acv0[i & 3] : acv1[i & 3];
        const float eb = ex2(aend - ac);
        kh0[i] = lo16(bb[i]) * eb; kh1[i] = hi16(bb[i]) * eb;
        if (do_out) {
          const float ea = ex2(ac);
          sKt[tau * KPW + cp] = bb[i];
          sQt[tau * KPW + cp] = cc[i];
          sQc[tau * KPW + cp] = pk2(lo16(cc[i]) * ea, hi16(cc[i]) * ea);
        }
      }
      *(u32x4*)(sKhT + n0 * 72 + 8 * tg) = CVT8(kh0);
      *(u32x4*)(sKhT + (n0 + 1) * 72 + 8 * tg) = CVT8(kh1);
      float x0[4], x1[4];
#pragma unroll
      for (int i = 0; i < 4; ++i) { const float dtv = dtv4[i]; x0[i] = lo16(xx[i]) * dtv; x1[i] = hi16(xx[i]) * dtv; }
      *(uint2*)(sVT + (2 * xp) * 72 + 4 * xg) = make_uint2(pk2(x0[0], x0[1]), pk2(x0[2], x0[3]));
      *(uint2*)(sVT + (2 * xp + 1) * 72 + 4 * xg) = make_uint2(pk2(x1[0], x1[1]), pk2(x1[2], x1[3]));
      if (tg == 0) *(float2*)(sD + n0) = make_float2(ex2(aend), ex2(aend));
    }
    if (do_out) scan_write_state<K, V>(smem, S, w, lane);
    if (ci + 1 < SLEN) gloadB(cidx + 1);
    lds_barrier();
    scan_core<K, V, true>(smem, S, OB + (rowbase + (size_t)chunk * 64) * 512 + head * 64, dir, w, lane, do_out, sAcs);
    if (ci + 1 < SLEN) { stage1((ci + 1) & 1); if (ci + 2 < SLEN) gloadA(cidx + 2); }
  }
  if (!do_out) {
    state_store<K, V>(sbuf, S, w, lane);
    if (tg == 0) *(float2*)((float*)(p.ws + OFF_DB) + ((size_t)it * NSEG + seg) * 128 + n0) = make_float2(ex2(dlog), ex2(dlog));
  }
  lds_barrier();
}

DEV void ssd_pass1_item(const ParamsG& p, int l, int it, int seg, unsigned char* smem) {
  const int j32 = it - 32, bl = j32 >> 4, head = (j32 >> 1) & 7, dir = j32 & 1;
  constexpr int K = 128, V = 64;
  const int tid = launder(threadIdx.x), lane = tid & 63, w = tid >> 6;
  const int cp = tid & 63, tg = tid >> 6, n0 = 2 * cp;
  const int xp = tid & 31, xg = tid >> 5;
  const int grp = head >> 2;
  const bf16_t* U = (const bf16_t*)(p.ws + OFF_U);
  const float* SMALL = (const float*)(p.ws + OFF_SMALL);
  const size_t rowbase = (size_t)bl * SEQ;
  float* sW = (float*)(smem + L_TOT); float* sWT = (float*)(smem + L_D);
  unsigned bb[SLEN][8], xx[SLEN][4];
#pragma unroll
  for (int ci = 0; ci < SLEN; ++ci) {
    const int cidx = seg * SLEN + ci, chunk = dir ? (63 - cidx) : cidx;
#pragma unroll
    for (int i = 0; i < 8; ++i) {
      const int tau = 8 * tg + i, tok = chunk * 64 + (dir ? (63 - tau) : tau);
      bb[ci][i] = ((const unsigned*)(U + (rowbase + tok) * 1024 + grp * 128 + 512))[cp];
    }
#pragma unroll
    for (int i = 0; i < 4; ++i) {
      const int tau = 4 * xg + i, tok = chunk * 64 + (dir ? (63 - tau) : tau);
      xx[ci][i] = ((const unsigned*)(U + (rowbase + tok) * 1024 + head * 64))[xp];
    }
  }
  float dlog;
  {
    const float dtb = p.dt_bias[(l * 2 + dir) * 8 + head];
    const float Acoef = -__expf(p.a_log[(l * 2 + dir) * 8 + head]) * LOG2E;
    const int n = seg * (SLEN * 64) + tid, pos = dir ? (SEQ - 1 - n) : n;
    const float xv = SMALL[(rowbase + pos) * 48 + dir * 8 + head] + dtb;
    const float dt = (xv > 20.f) ? xv : log1pf(__expf(xv));
    float a = dt * Acoef;
#pragma unroll
    for (int o = 1; o < 64; o <<= 1) { const float t = __shfl_up(a, o); if (lane >= o) a += t; }
    if (lane == 63) sWT[w] = a;
    lds_barrier();
    float off = 0.f, tot = 0.f;
#pragma unroll
    for (int j = 0; j < 8; ++j) { const float t = sWT[j]; if (j < w) off += t; tot += t; }
    sW[tid] = dt * ex2(tot - (a + off));
    dlog = tot;
    lds_barrier();
  }
  f32x16 S[1]; S[0] = zero16();
#pragma unroll
  for (int ci = 0; ci < SLEN; ++ci) {
    bf16_t* sBT = (bf16_t*)(smem + (ci & 1) * 27648); bf16_t* sXT = sBT + 128 * 72;
    *(u32x4*)(sBT + n0 * 72 + 8 * tg) = PACK8_LO(bb[ci]);
    *(u32x4*)(sBT + (n0 + 1) * 72 + 8 * tg) = PACK8_HI(bb[ci]);
    float x0[4], x1[4];
#pragma unroll
    for (int i = 0; i < 4; ++i) { const float wv = sW[ci * 64 + 4 * xg + i]; x0[i] = lo16(xx[ci][i]) * wv; x1[i] = hi16(xx[ci][i]) * wv; }
    *(uint2*)(sXT + (2 * xp) * 72 + 4 * xg) = make_uint2(pk2(x0[0], x0[1]), pk2(x0[2], x0[3]));
    *(uint2*)(sXT + (2 * xp + 1) * 72 + 4 * xg) = make_uint2(pk2(x1[0], x1[1]), pk2(x1[2], x1[3]));
    lds_barrier();
    mma32<64>(S[0], sBT + (w >> 1) * 32 * 72, 72, sXT + (w & 1) * 32 * 72, 72, lane);
  }
  state_store<K, V>((bf16_t*)(p.ws + OFF_SB2) + ((size_t)j32 * NSEG + seg) * 8192, S, w, lane);
  if (tg == 0) *(float2*)((float*)(p.ws + OFF_DB) + ((size_t)it * NSEG + seg) * 128 + n0) = make_float2(ex2(dlog), ex2(dlog));
  lds_barrier();
}

DEV void phase_prep(const ParamsG& p, int l, int hf, int rep, unsigned char* smem) {
  const int tid = launder(threadIdx.x), lane = tid & 63;
  bf16_t* Hh = (bf16_t*)(p.ws + OFF_H);
  bf16_t* U = (bf16_t*)(p.ws + OFF_U);
  bf16_t* Gb = (bf16_t*)(p.ws + OFF_G);
  bf16_t* VT = (bf16_t*)(p.ws + OFF_VT);
  const float* SMALLp = (const float*)(p.ws + OFF_SMALL);
  float2* stab = (float2*)smem;
  float* slow = (float*)(smem + 8192);
  bf16_t* sT = (bf16_t*)(smem + 12288);
  {
    const float2* tabg = (const float2*)(p.ws + OFF_TAB);
    for (int i = tid; i < 1024; i += NT) stab[i] = tabg[i];
  }
  const int cg8 = (tid & 127) * 8, rsub = tid >> 7;
  const float* cw = (const float*)(p.conv_w + (size_t)l * 5 * 1024); const float* cb = (const float*)(p.conv_b + (size_t)l * 1024);
  float wv[5][8], bv[8];
#pragma unroll
  for (int j = 0; j < 5; ++j)
#pragma unroll
    for (int e = 0; e < 8; ++e) wv[j][e] = cw[j * 1024 + cg8 + e];
#pragma unroll
  for (int e = 0; e < 8; ++e) bv[e] = cb[cg8 + e];
  const int gd = tid >> 8, gc = tid & 255;
  const int i16 = lane & 15;
  const float* gq = (const float*)(p.q_gain + l * 64 + 4 * i16); const float* gk = (const float*)(p.k_gain + l * 64 + 4 * i16);
  const float gqv[4] = {gq[0], gq[1], gq[2], gq[3]}, gkv[4] = {gk[0], gk[1], gk[2], gk[3]};
  for (int grp = blockIdx.x; grp < TH / 32; grp += gridDim.x) {
    const int r0 = grp * 32;
    lds_barrier();
    const u32x4 vt = *(const u32x4*)(Hh + (size_t)(r0 + (tid >> 4)) * NPAD + A_V + (tid & 15) * 8);
    const float2 lowv = *(const float2*)(SMALLp + (size_t)(r0 + (tid >> 4)) * 48 + 16 + (tid & 15) * 2);
    *(u32x4*)(sT + (tid >> 4) * 136 + (tid & 15) * 8) = vt;
    *(float2*)(slow + (tid >> 4) * 32 + (tid & 15) * 2) = lowv;
#pragma unroll 1
    for (int ps = 0; ps < 2; ++ps) {
      const int ra = r0 + 16 * ps + 4 * rsub, ta = ra & (SEQ - 1);
      u32x4 xc[8];
#pragma unroll
      for (int m = 0; m < 8; ++m) {
        const int sq = ta + m - 2;
        xc[m] = (u32x4){0u, 0u, 0u, 0u};
        if (sq >= 0 && sq < SEQ) xc[m] = *(const u32x4*)(Hh + (size_t)(ra + m - 2) * NPAD + S_X + cg8);
      }
#pragma unroll
      for (int o4 = 0; o4 < 4; ++o4) {
        float u[8];
#pragma unroll
        for (int e = 0; e < 8; ++e) u[e] = bv[e];
#pragma unroll
        for (int j = 0; j < 5; ++j)
#pragma unroll
          for (int e = 0; e < 4; ++e) { u[2 * e] += wv[j][2 * e] * lo16(xc[o4 + j][e]); u[2 * e + 1] += wv[j][2 * e + 1] * hi16(xc[o4 + j][e]); }
        u32x4 o;
#pragma unroll
        for (int e = 0; e < 4; ++e) {
          const float a = u[2 * e] * frcp(1.f + ex2(fminf(-u[2 * e] * LOG2E, 80.f)));
          const float b = u[2 * e + 1] * frcp(1.f + ex2(fminf(-u[2 * e + 1] * LOG2E, 80.f)));
          o[e] = pk2(a, b);
        }
        *(u32x4*)(U + (size_t)(ra + o4) * 1024 + cg8) = o;
      }
    }
    lds_barrier();
    if (rep == 0) {
#pragma unroll 1
      for (int ub = 0; ub < 10; ub += 5) {
        uint2 xq[5];
#pragma unroll
        for (int u = 0; u < 5; ++u) {
          const int pi = (ub + u) * 32 + (tid >> 4), row = r0 + pi / 10, hd = pi % 10;
          xq[u] = *(const uint2*)(Hh + (size_t)row * NPAD + ((hd < 8) ? (A_Q + hd * 64) : (A_K + (hd - 8) * 64)) + 4 * i16);
        }
#pragma unroll
        for (int u = 0; u < 5; ++u) {
          const int pi = (ub + u) * 32 + (tid >> 4), row = r0 + pi / 10, hd = pi % 10;
          const bool isq = hd < 8;
          const float x[4] = {lo16(xq[u].x), hi16(xq[u].x), lo16(xq[u].y), hi16(xq[u].y)};
          float ss = x[0] * x[0] + x[1] * x[1] + x[2] * x[2] + x[3] * x[3];
          ss += __shfl_xor(ss, 1); ss += __shfl_xor(ss, 2); ss += __shfl_xor(ss, 4); ss += __shfl_xor(ss, 8);
          const float rstd = rsqrtf(ss * (1.f / 64.f) + 1e-6f);
          const int t = row & (SEQ - 1);
          const int pos = (i16 < 8) ? (t >> 6) : (t & 63);
          const float osc = isq ? QSCALE : 1.f;
          float o[4];
#pragma unroll
          for (int e = 0; e < 4; ++e) {
            const float v = x[e] * rstd * (isq ? gqv[e] : gkv[e]);
            const float pv = __shfl_xor(v, 4);
            const float2 cs = stab[pos * 16 + 4 * (i16 & 3) + e];
            o[e] = ((i16 & 4) ? (v * cs.x + pv * cs.y) : (v * cs.x - pv * cs.y)) * osc;
          }
          *(uint2*)(Hh + (size_t)row * NPAD + (isq ? (A_Q + hd * 64) : (A_K + (hd - 8) * 64)) + 4 * i16) = make_uint2(pk2(o[0], o[1]), pk2(o[2], o[3]));
        }
      }
    }
    float w2c[16];
#pragma unroll
    for (int r = 0; r < 16; ++r) w2c[r] = p.gk_w2[((size_t)(l * 2 + gd) * 16 + r) * 256 + gc];
    const float gbias = p.gk_b[(l * 2 + gd) * 256 + gc];
#pragma unroll 4
    for (int rr = 0; rr < 32; ++rr) {
      const float4* lp4 = (const float4*)(slow + rr * 32 + gd * 16);
      float gkk = gbias;
#pragma unroll
      for (int r4 = 0; r4 < 4; ++r4) { const float4 lw = lp4[r4]; gkk += lw.x * w2c[4 * r4] + lw.y * w2c[4 * r4 + 1] + lw.z * w2c[4 * r4 + 2] + lw.w * w2c[4 * r4 + 3]; }
      const float l2 = (fminf(gkk, 0.f) * LOG2E - lg2(1.f + ex2(-fabsf(gkk) * LOG2E))) * (1.f / 16.f);
      Gb[(size_t)(r0 + rr) * 512 + tid] = f2bf(l2);
    }
    {
      const int c = tid >> 2, tq = (tid & 3) * 8;
      unsigned v[8];
#pragma unroll
      for (int i = 0; i < 8; ++i) v[i] = sT[(tq + i) * 136 + c];
      const int bl = r0 >> 12, t0 = (r0 & (SEQ - 1)) + tq;
      *(u32x4*)(VT + ((size_t)((bl * 2 + (c >> 6)) * 64 + (c & 63))) * SEQ + t0) = (u32x4){v[0] | (v[1] << 16), v[2] | (v[3] << 16), v[4] | (v[5] << 16), v[6] | (v[7] << 16)};
    }
  }
  lds_barrier();
}

DEV void phase_mix(const ParamsG& p, int l, int hf, int slot, int mode, int att_lo, int att_hi, int vid_lo, int vid_hi, unsigned char* smem) {
  unsigned* ctr = (unsigned*)(p.ws + OFF_CTRL) + CTR_WORD0 + slot * 16;
  volatile int* sItem = (volatile int*)(smem + LDS_BYTES - 16);
  const int n_scan = 64 * NSEG;
  int hi = n_scan + (att_hi - att_lo); if (vid_hi < hi) hi = vid_hi;
  bool first = true;
  for (;;) {
    lds_barrier();
    if (threadIdx.x == 0) *sItem = vid_lo + (first ? (int)blockIdx.x : (int)(gridDim.x + atomicAdd(ctr, 1u)));
    first = false;
    lds_barrier();
    const int vid = *sItem;
    if (vid >= hi) break;
    if (vid < n_scan) {
      int seg = vid >> 6, it = vid & 63;
      {
        if (vid < 16 * NSEG) { it = vid & 15; seg = vid >> 4; }
        else if (mode == 1) {
          if (vid < 32 * NSEG) { const int v2 = vid - 16 * NSEG; it = 16 + (v2 & 15); seg = v2 >> 4; }
          else { const int v2 = vid - 32 * NSEG; it = 32 + (v2 & 31); seg = v2 >> 5; }
        }
        else if (vid < 48 * NSEG) { const int v2 = vid - 16 * NSEG; it = 32 + (v2 & 31); seg = v2 >> 5; }
        else { const int v2 = vid - 48 * NSEG; it = 16 + (v2 & 15); seg = v2 >> 4; }
      }
      if (mode == 1 && seg == NSEG - 1) continue;
#if PROBE_REP > 0
      if (slot >= 40 && PROBE_TYPE >= 0 && ((it < 16) ? 0 : (it < 32) ? 1 : 2) != PROBE_TYPE) continue;
#endif
      if (it < 16) { if (PH_MASK & 0x100) hgrn_item(p, l, it, seg, mode, smem); }
      else if (it < 32) { if (PH_MASK & 0x200) gla_item(p, l, it, seg, mode, smem); }
      else { if (PH_MASK & 0x400) { if (mode == 1) ssd_pass1_item(p, l, it, seg, smem); else ssd_item(p, l, it, seg, mode, smem); } }
    } else { if (PH_MASK & 0x800) attn_item(p, l, att_lo + (vid - n_scan), smem); }
  }
}

DEV void phase_scan2(const ParamsG& p) {
  const size_t gtid = (size_t)blockIdx.x * NT + threadIdx.x, gsz = (size_t)gridDim.x * NT;
  const float* DB = (const float*)(p.ws + OFF_DB);
  for (size_t e = gtid; e < 655360; e += gsz) {
    float* buf; const float* dp; int stride;
    if (e < 262144) { const int it = (int)(e >> 14), idx = (int)(e & 16383); buf = (float*)(p.ws + OFF_SB0) + (size_t)it * NSEG * 16384 + idx; stride = 16384; dp = DB + (size_t)it * NSEG * 128 + (idx >> 7); }
    else if (e < 393216) { const int e2 = (int)(e - 262144), j = e2 >> 13, idx = e2 & 8191; buf = (float*)(p.ws + OFF_SB1) + (size_t)j * NSEG * 8192 + idx; stride = 8192; dp = DB + (size_t)(16 + j) * NSEG * 128 + (idx >> 7); }
    else { const int e3 = (int)(e - 393216), j = e3 >> 13, idx = e3 & 8191; buf = (float*)(p.ws + OFF_SB2) + (size_t)j * NSEG * 8192 + idx; stride = 8192; dp = DB + (size_t)(32 + j) * NSEG * 128 + (idx >> 6); }
    float u[NSEG - 1], d[NSEG - 1];
#pragma unroll
    for (int sg = 0; sg < NSEG - 1; ++sg) { u[sg] = buf[(size_t)sg * stride]; d[sg] = dp[sg * 128]; }
    float st = 0.f;
#pragma unroll
    for (int sg = 0; sg < NSEG; ++sg) { buf[(size_t)sg * stride] = st; if (sg < NSEG - 1) st = d[sg] * st + u[sg]; }
  }
}

DEV float bfe(const u32x4& v, int j) { return (j & 1) ? hi16(v[j >> 1]) : lo16(v[j >> 1]); }
DEV void phase_fin(const ParamsG& p, int l, int hf) {
  const int tid = launder(threadIdx.x), lane = tid & 63, w = tid >> 6;
  const bf16_t* Hh = (const bf16_t*)(p.ws + OFF_H);
  const bf16_t* OB = (const bf16_t*)(p.ws + OFF_OBUF);
  bf16_t* MX = (bf16_t*)(p.ws + OFF_MIXED);
  const int c0 = lane * 8;
  const float* cw = (const float*)(p.conv_w + (size_t)l * 5 * 1024); const float* cb = (const float*)(p.conv_b + (size_t)l * 1024);
  for (int r0 = (blockIdx.x * 8 + w) * 4; r0 < TH; r0 += gridDim.x * 32) {
    {
      u32x4 at[4], a[4], b[4], z[4];
#pragma unroll
      for (int i = 0; i < 4; ++i) {
        const bf16_t* hrow = Hh + (size_t)(r0 + i) * NPAD;
        at[i] = __builtin_nontemporal_load((const u32x4*)(hrow + A_Q + c0));
        a[i] = __builtin_nontemporal_load((const u32x4*)(OB + ((size_t)0 * TH + r0 + i) * 512 + c0)); b[i] = __builtin_nontemporal_load((const u32x4*)(OB + ((size_t)1 * TH + r0 + i) * 512 + c0));
        z[i] = __builtin_nontemporal_load((const u32x4*)(hrow + H_Z + c0));
      }
      float gn[8];
#pragma unroll
      for (int j = 0; j < 8; ++j) gn[j] = p.hgrn_norm[l * 512 + c0 + j];
#pragma unroll
      for (int i = 0; i < 4; ++i) {
        *(u32x4*)(MX + (size_t)(r0 + i) * DI + c0) = at[i];
        float o[8]; float ss = 0.f;
#pragma unroll
        for (int j = 0; j < 8; ++j) { o[j] = bfe(a[i], j) + bfe(b[i], j); ss += o[j] * o[j]; }
#pragma unroll
        for (int of = 32; of >= 1; of >>= 1) ss += __shfl_xor(ss, of);
        const float rstd = rsqrtf(ss * (1.f / 512.f) + 1e-6f);
        float y[8];
#pragma unroll
        for (int j = 0; j < 8; ++j) { const float zz = bfe(z[i], j); y[j] = o[j] * rstd * gn[j] * (zz * frcp(1.f + ex2(fminf(-zz * LOG2E, 80.f)))); }
        *(u32x4*)(MX + (size_t)(r0 + i) * DI + 512 + c0) = (u32x4){pk2(y[0], y[1]), pk2(y[2], y[3]), pk2(y[4], y[5]), pk2(y[6], y[7])};
      }
    }
    {
      u32x4 a[4], b[4], z[4];
#pragma unroll
      for (int i = 0; i < 4; ++i) {
        a[i] = __builtin_nontemporal_load((const u32x4*)(OB + ((size_t)4 * TH + r0 + i) * 512 + c0)); b[i] = __builtin_nontemporal_load((const u32x4*)(OB + ((size_t)5 * TH + r0 + i) * 512 + c0));
        z[i] = __builtin_nontemporal_load((const u32x4*)(Hh + (size_t)(r0 + i) * NPAD + G_Z + c0));
      }
      float gn[8];
#pragma unroll
      for (int j = 0; j < 8; ++j) gn[j] = p.gla_norm[l * 128 + ((c0 + j) & 127)];
#pragma unroll
      for (int i = 0; i < 4; ++i) {
        float o[8]; float ss = 0.f;
#pragma unroll
        for (int j = 0; j < 8; ++j) { o[j] = bfe(a[i], j) + bfe(b[i], j); ss += o[j] * o[j]; }
#pragma unroll
        for (int of = 8; of >= 1; of >>= 1) ss += __shfl_xor(ss, of);
        const float rstd = rsqrtf(ss * (1.f / 128.f) + 1e-6f);
        float y[8];
#pragma unroll
        for (int j = 0; j < 8; ++j) { const float zz = bfe(z[i], j); y[j] = o[j] * rstd * gn[j] * (zz * frcp(1.f + ex2(fminf(-zz * LOG2E, 80.f)))); }
        *(u32x4*)(MX + (size_t)(r0 + i) * DI + 1536 + c0) = (u32x4){pk2(y[0], y[1]), pk2(y[2], y[3]), pk2(y[4], y[5]), pk2(y[6], y[7])};
      }
    }
    {
      u32x4 a[4], b[4], z[4], xr[8];
      const int t0 = r0 & (SEQ - 1);
#pragma unroll
      for (int i = 0; i < 4; ++i) {
        a[i] = __builtin_nontemporal_load((const u32x4*)(OB + ((size_t)2 * TH + r0 + i) * 512 + c0)); b[i] = __builtin_nontemporal_load((const u32x4*)(OB + ((size_t)3 * TH + r0 + i) * 512 + c0));
        z[i] = __builtin_nontemporal_load((const u32x4*)(Hh + (size_t)(r0 + i) * NPAD + S_Z + c0));
      }
#pragma unroll
      for (int m = 0; m < 8; ++m) {
        const int sq = t0 + m - 2;
        xr[m] = (u32x4){0u, 0u, 0u, 0u};
        if (sq >= 0 && sq < SEQ) xr[m] = __builtin_nontemporal_load((const u32x4*)(Hh + (size_t)(r0 + m - 2) * NPAD + S_X + c0));
      }
      float gn[8], cbv[8];
#pragma unroll
      for (int j = 0; j < 8; ++j) { gn[j] = p.ssd_norm[l * 512 + c0 + j]; cbv[j] = cb[c0 + j]; }
      const float dsk = p.ssd_d[l * 8 + (c0 >> 6)];
#pragma unroll
      for (int i = 0; i < 4; ++i) {
        float u[8];
#pragma unroll
        for (int j = 0; j < 8; ++j) u[j] = cbv[j];
#pragma unroll
        for (int jj = 0; jj < 5; ++jj)
#pragma unroll
          for (int j = 0; j < 8; ++j) u[j] += cw[jj * 1024 + c0 + j] * bfe(xr[i + jj], j);
        float y[8]; float ss = 0.f;
#pragma unroll
        for (int j = 0; j < 8; ++j) {
          const float zz = bfe(z[i], j);
          const float xs = u[j] * frcp(1.f + ex2(fminf(-u[j] * LOG2E, 80.f)));
          y[j] = (bfe(a[i], j) + bfe(b[i], j) + dsk * xs) * (zz * frcp(1.f + ex2(fminf(-zz * LOG2E, 80.f))));
          ss += y[j] * y[j];
        }
#pragma unroll
        for (int of = 32; of >= 1; of >>= 1) ss += __shfl_xor(ss, of);
        const float rstd = rsqrtf(ss * (1.f / 512.f) + 1e-6f);
#pragma unroll
        for (int j = 0; j < 8; ++j) y[j] = y[j] * rstd * gn[j];
        *(u32x4*)(MX + (size_t)(r0 + i) * DI + 1024 + c0) = (u32x4){pk2(y[0], y[1]), pk2(y[2], y[3]), pk2(y[4], y[5]), pk2(y[6], y[7])};
      }
    }
  }
}

#define XB_TMO      128
#define XB_XCNT(j)  (256  + 64 * (j))
#define XB_XSUB(j)  (1280 + 64 * (j))
#define XB_XGEN(j)  (2304 + 64 * (j))
#define XB_TOP      3328
#define XB_TOPGEN   3392
#define XB_SPIN_CAP (1u << 22)
#define LAS __attribute__((address_space(3)))
DEV unsigned xb_ld(unsigned* p) { return __hip_atomic_load(p, __ATOMIC_RELAXED, __HIP_MEMORY_SCOPE_AGENT); }
DEV unsigned xb_add(unsigned* p, unsigned v) { return __hip_atomic_fetch_add(p, v, __ATOMIC_RELAXED, __HIP_MEMORY_SCOPE_AGENT); }
DEV unsigned xb_xcc_id() { return (unsigned)__builtin_amdgcn_s_getreg((3 << 11) | 20) & 0xFu; }
#define XB_SPIN(cond, bar) do { unsigned _sp = 0; while (cond) { __builtin_amdgcn_s_sleep(1); \
    if ((++_sp & 255u) == 0u) { if (xb_ld(&(bar)[XB_TMO])) break; if (_sp > XB_SPIN_CAP) { atomicAdd(&(bar)[XB_TMO], 1u); break; } } } } while (0)
struct XcdBarrier { unsigned* bar; unsigned x; volatile LAS unsigned* st; };
DEV XcdBarrier xcd_barrier_post(unsigned* bar, volatile LAS unsigned* st) {
  XcdBarrier b; b.bar = bar; b.x = xb_xcc_id(); b.st = st;
  if (threadIdx.x == 0) (void)xb_add(&bar[XB_XCNT(b.x)], 1u);
  return b;
}
DEV void xcd_barrier_complete(unsigned* bar, unsigned x, unsigned& nloc, unsigned& nx) {
  const unsigned G = gridDim.x * gridDim.y * gridDim.z;
  unsigned sum, cnt, mine, sp = 0u;
  for (;;) {
    sum = 0u; cnt = 0u; mine = 0u;
#pragma unroll
    for (unsigned j = 0; j < 16; ++j) { const unsigned c = xb_ld(&bar[XB_XCNT(j)]); sum += c; cnt += (c > 0u) ? 1u : 0u; mine = (j == x) ? c : mine; }
    if (sum == G) break;
    __builtin_amdgcn_s_sleep(1);
    if ((++sp & 255u) == 0u) { if (xb_ld(&bar[XB_TMO])) break; if (sp > XB_SPIN_CAP) { atomicAdd(&bar[XB_TMO], 1u); break; } }
  }
  nloc = mine > 0u ? mine : 1u; nx = cnt > 0u ? cnt : 1u;
}
DEV void xcd_barrier(const XcdBarrier& b) {
  asm volatile("s_waitcnt vmcnt(0)" ::: "memory");
  __syncthreads();
  if (threadIdx.x == 0) {
    unsigned* bar = b.bar;
    __builtin_amdgcn_s_waitcnt(0);
    unsigned nloc = b.st[0], nx = b.st[1];
    if (nloc == 0u) { xcd_barrier_complete(bar, b.x, nloc, nx); b.st[0] = nloc; b.st[1] = nx; }
    const unsigned old = xb_add(&bar[XB_XSUB(b.x)], 1u);
    const unsigned gen = old / nloc;
    if (old + 1u == (gen + 1u) * nloc) {
      __builtin_amdgcn_fence(__ATOMIC_RELEASE, "agent");
      asm volatile("s_waitcnt vmcnt(0)" ::: "memory");
      const unsigned og = xb_add(&bar[XB_TOP], 1u);
      const unsigned tg = og / nx;
      if (og + 1u == (tg + 1u) * nx) xb_add(&bar[XB_TOPGEN], 1u);
      else XB_SPIN(xb_ld(&bar[XB_TOPGEN]) == tg, bar);
      __builtin_amdgcn_fence(__ATOMIC_ACQUIRE, "agent");
      xb_add(&bar[XB_XGEN(b.x)], 1u);
      asm volatile("s_waitcnt vmcnt(0)" ::: "memory");
    } else {
      XB_SPIN(xb_ld(&bar[XB_XGEN(b.x)]) == gen, bar);
      __builtin_amdgcn_fence(__ATOMIC_ACQUIRE, "agent");
      asm volatile("s_waitcnt vmcnt(0)" ::: "memory");
    }
  }
  __syncthreads();
}

DEV void run_phase(const ParamsG& p, int ph, int rep, unsigned char* smem) {
  if (ph == 0) { if (PH_MASK & 1) { phase_pro(p, smem); convert_weights(p, 0, 3, smem); } return; }
  if (ph == 21) { if (PH_MASK & 16) phase_outproj(p, 1, 1, smem); return; }
  if (ph == 22) { if (PH_MASK & 32) phase_ln(p, 1, 1); return; }
  const int q = ph - 1, blk = q / 5, st = q % 5, l = blk >> 1, hf = blk & 1;
  if (st == 0) {
    if (blk > 0 && (PH_MASK & 16)) phase_outproj(p, (blk - 1) >> 1, (blk - 1) & 1, smem);
    if (PH_MASK & 2) phase_inproj(p, l, hf, blk > 0 ? 16 : 0, smem);
  } else if (st == 1) {
    if (blk > 0 && rep == 0 && (PH_MASK & 32)) phase_ln(p, (blk - 1) >> 1, (blk - 1) & 1);
    if (PH_MASK & 4) phase_prep(p, l, hf, rep, smem);
    if ((PH_MASK & 1) && rep == 0 && blk == 1) convert_weights(p, 1, 1, smem);
    if ((PH_MASK & 1) && rep == 0 && blk == 2) convert_weights(p, 1, 2, smem);
  }
  else if (st == 2) { if (PH_MASK & 0xF00) phase_mix(p, l, hf, ph + 40 * rep, 1, 0, ATT_SPLIT, rep ? PROBE_LO : 0, rep ? PROBE_HI : 100000, smem); }
  else if (st == 3) { if (PH_MASK & 0xF00) phase_mix(p, l, hf, ph + 40 * rep, 3, ATT_SPLIT, 256, rep ? PROBE_LO : 0, rep ? PROBE_HI : 100000, smem); }
  else { if (PH_MASK & 8) phase_fin(p, l, hf); }
}
__global__ void __launch_bounds__(NT) mega(Params p) {
  extern __shared__ __attribute__((aligned(16))) unsigned char smem[];
#if ONE_LAUNCH
  volatile LAS unsigned* xst = (volatile LAS unsigned*)(smem + LDS_BYTES - 32);
  if (threadIdx.x == 0) { xst[0] = 0u; xst[1] = 0u; }
  __syncthreads();
  XcdBarrier xb = xcd_barrier_post((unsigned*)(p.ws + OFF_CTRL), xst);
#endif
  ParamsG* lp = (ParamsG*)(smem + 147456);
  if (threadIdx.x == 0) {
    lp->x = (GAS const float*)p.x; lp->w_in = (GAS const float*)p.w_in; lp->q_gain = (GAS const float*)p.q_gain; lp->k_gain = (GAS const float*)p.k_gain;
    lp->lb_logits = (GAS const float*)p.lb_logits; lp->hgrn_norm = (GAS const float*)p.hgrn_norm; lp->conv_w = (GAS const float*)p.conv_w; lp->conv_b = (GAS const float*)p.conv_b;
    lp->dt_bias = (GAS const float*)p.dt_bias; lp->a_log = (GAS const float*)p.a_log; lp->ssd_d = (GAS const float*)p.ssd_d; lp->ssd_norm = (GAS const float*)p.ssd_norm;
    lp->gk_w2 = (GAS const float*)p.gk_w2; lp->gk_b = (GAS const float*)p.gk_b; lp->gla_norm = (GAS const float*)p.gla_norm; lp->w_out = (GAS const float*)p.w_out;
    lp->ln_g = (GAS const float*)p.ln_g; lp->ln_b = (GAS const float*)p.ln_b; lp->out = (GAS float*)p.out; lp->ws = (GAS unsigned char*)p.ws;
  }
  __syncthreads();
  const int ph_begin = p.phase_begin, ph_end = p.phase_end;
  for (int ph = ph_begin; ph < ph_end; ++ph) {
    int nrep = 0;
#if PROBE_REP > 0
    {
      const int q = ph - 1, st = q % 5;
      const bool idem = (ph >= 1 && ph <= 20) && (st == PROBE_ST) && (st >= 1 || ph <= PROBE_PHMAX) && (ph >= PROBE_PHMIN);
      if (idem) nrep = PROBE_REP;
    }
#endif
    for (int r = 0; r <= nrep; ++r) {
      run_phase(*lp, ph, r, smem);
#if ONE_LAUNCH
      if (r < nrep || ph + 1 < ph_end) xcd_barrier(xb);
#endif
    }
  }
}

extern "C" void kernel_launch(void* const* d_in, const int* in_sizes, int n_in, void* d_out, int out_size, void* d_ws, size_t ws_size,
                              hipStream_t stream) {
  static int grid_blocks = 0;
  if (!grid_blocks) {
    int dev = 0, cus = 0, per_cu = 0;
    hipGetDevice(&dev);
    hipDeviceGetAttribute(&cus, hipDeviceAttributeMultiprocessorCount, dev);
    hipFuncSetAttribute((const void*)mega, hipFuncAttributeMaxDynamicSharedMemorySize, LDS_BYTES);
    hipOccupancyMaxActiveBlocksPerMultiprocessor(&per_cu, mega, NT, LDS_BYTES);
    if (per_cu < 1) per_cu = 1;
    grid_blocks = cus;
  }
  Params p{};
  p.x = (const float*)d_in[0]; p.w_in = (const float*)d_in[1]; p.q_gain = (const float*)d_in[2]; p.k_gain = (const float*)d_in[3];
  p.lb_logits = (const float*)d_in[4]; p.hgrn_norm = (const float*)d_in[5]; p.conv_w = (const float*)d_in[6]; p.conv_b = (const float*)d_in[7];
  p.dt_bias = (const float*)d_in[8]; p.a_log = (const float*)d_in[9]; p.ssd_d = (const float*)d_in[10]; p.ssd_norm = (const float*)d_in[11];
  p.gk_w2 = (const float*)d_in[12]; p.gk_b = (const float*)d_in[13]; p.gla_norm = (const float*)d_in[14]; p.w_out = (const float*)d_in[15];
  p.ln_g = (const float*)d_in[16]; p.ln_b = (const float*)d_in[17];
  p.out = (float*)d_out; p.ws = (unsigned char*)d_ws;
  hipMemsetAsync(d_ws, 0, CTRL_BYTES, stream);
#if ONE_LAUNCH
  p.phase_begin = 0; p.phase_end = NPHASE;
  void* args[] = {&p};
  (void)args;
  hipLaunchKernelGGL(mega, dim3(grid_blocks), dim3(NT), LDS_BYTES, stream, p);
#else
  for (int ph = 0; ph < NPHASE; ++ph) {
    p.phase_begin = ph; p.phase_end = ph + 1;
    hipLaunchKernelGGL(mega, dim3(grid_blocks), dim3(NT), LDS_BYTES, stream, p);
  }
#endif
}
```

```cpp
#include <hip/hip_runtime.h>
#include <hip/hip_cooperative_groups.h>
#include <stdint.h>
#include <stdio.h>
namespace cg = cooperative_groups;

#ifndef ONE_LAUNCH
#define ONE_LAUNCH 1
#endif

#ifndef PH_MASK
#define PH_MASK 0xFFF
#endif
#ifndef PROBE_ST
#define PROBE_ST -1
#endif
#ifndef PROBE_REP
#define PROBE_REP 0
#endif
#ifndef PROBE_PHMAX
#define PROBE_PHMAX 0
#endif
#ifndef PROBE_PHMIN
#define PROBE_PHMIN 0
#endif
#ifndef PROBE_TYPE
#define PROBE_TYPE -1
#endif
#ifndef PROBE_LO
#define PROBE_LO 0
#endif
#ifndef PROBE_HI
#define PROBE_HI 100000
#endif
#define DEV __device__ __forceinline__
typedef unsigned short bf16_t;
typedef short bf16x8 __attribute__((ext_vector_type(8)));
typedef float f32x16 __attribute__((ext_vector_type(16)));
typedef unsigned u32x2 __attribute__((ext_vector_type(2)));
typedef unsigned u32x4 __attribute__((ext_vector_type(4)));
typedef float f32x4 __attribute__((ext_vector_type(4)));

constexpr int NT = 512;
constexpr int T_ALL = 16384, TH = 8192, SEQ = 4096, DM = 1024, NPAD = 7168, DI = 2048, NIN = 6960;
constexpr int A_Q = 0, A_K = 512, A_V = 640, A_Z = 768, H_Q = 1280, H_FF = 1792, H_FB = 2304, H_I = 2816, H_Z = 3328,
              S_X = 3840, S_Z = 4864, G_Q = 5376, G_K = 5632, G_V = 5888, G_Z = 6400, SM0 = 6912;
constexpr size_t OFF_CTRL = 0, OFF_TAB = 65536, OFF_XB = 131072;
constexpr size_t OFF_WIN = OFF_XB + (size_t)T_ALL * DM * 2;
constexpr size_t OFF_WOUT = OFF_WIN + (size_t)NPAD * DM * 2;
constexpr size_t OFF_H = OFF_WOUT + (size_t)DM * DI * 2;
constexpr size_t OFF_SMALL = OFF_H + (size_t)TH * NPAD * 2;
constexpr size_t OFF_OBUF = OFF_SMALL + (size_t)TH * 48 * 4;
constexpr size_t OFF_VT = OFF_OBUF + (size_t)6 * TH * 512 * 2;
constexpr size_t OFF_DB = OFF_VT + (size_t)2 * 2 * 64 * SEQ * 2;
constexpr int NSEG = 8, SLEN = 64 / NSEG;
constexpr size_t OFF_MIXED = OFF_DB + (size_t)64 * NSEG * 128 * 4;
constexpr size_t OFF_SB0 = OFF_MIXED, OFF_SB1 = OFF_SB0 + (size_t)16 * NSEG * 16384 * 2, OFF_SB2 = OFF_SB1 + (size_t)16 * NSEG * 8192 * 2;
constexpr size_t OFF_U = OFF_SB2 + (size_t)32 * NSEG * 8192 * 2;
constexpr size_t OFF_G = OFF_U + (size_t)TH * 1024 * 2;
constexpr size_t WS_END = (OFF_G + (size_t)TH * 512 * 2 > OFF_MIXED + (size_t)TH * DI * 2) ? (OFF_G + (size_t)TH * 512 * 2) : (OFF_MIXED + (size_t)TH * DI * 2);
static_assert(OFF_MIXED + (size_t)TH * DI * 2 <= WS_END, "MIXED must fit");
static_assert(WS_END <= 268435456, "workspace");
constexpr size_t OFF_AO = WS_END;
static_assert(OFF_AO + (size_t)TH * 512 * 2 <= 268435456, "workspace");
constexpr size_t CTRL_BYTES = 65536;
constexpr int CTR_WORD0 = 4096;
constexpr int LDS_BYTES = 148480;
constexpr float LOG2E = 1.4426950408889634f;
constexpr float QSCALE = 0.125f * LOG2E;
constexpr float DN_ALPHA = 1.4142135623730951f;
constexpr int NPHASE = 23;
constexpr int ATT_SPLIT = 256;

struct Params {
  const float* x; const float* w_in; const float* q_gain; const float* k_gain; const float* lb_logits; const float* hgrn_norm;
  const float* conv_w; const float* conv_b; const float* dt_bias; const float* a_log; const float* ssd_d; const float* ssd_norm;
  const float* gk_w2; const float* gk_b; const float* gla_norm; const float* w_out; const float* ln_g; const float* ln_b;
  float* out; unsigned char* ws;
  int phase_begin, phase_end;
};
#define GAS __attribute__((address_space(1)))
struct ParamsG {
  GAS const float* x; GAS const float* w_in; GAS const float* q_gain; GAS const float* k_gain; GAS const float* lb_logits; GAS const float* hgrn_norm;
  GAS const float* conv_w; GAS const float* conv_b; GAS const float* dt_bias; GAS const float* a_log; GAS const float* ssd_d; GAS const float* ssd_norm;
  GAS const float* gk_w2; GAS const float* gk_b; GAS const float* gla_norm; GAS const float* w_out; GAS const float* ln_g; GAS const float* ln_b;
  GAS float* out; GAS unsigned char* ws;
};

DEV void lds_barrier() { asm volatile("s_waitcnt lgkmcnt(0)" ::: "memory"); __builtin_amdgcn_s_barrier(); asm volatile("" ::: "memory"); }
DEV int launder(int v) { asm volatile("" : "+v"(v)); return v; }
DEV float bf2f(bf16_t v) { return __uint_as_float(((unsigned)v) << 16); }
DEV bf16_t f2bf(float f) { unsigned u = __float_as_uint(f); u += 0x7fffu + ((u >> 16) & 1u); return (bf16_t)(u >> 16); }
typedef __bf16 bf16x2_t __attribute__((ext_vector_type(2)));
typedef float f32x2_t __attribute__((ext_vector_type(2)));
DEV unsigned pk2(float lo, float hi) { const f32x2_t f = {lo, hi}; const bf16x2_t b = __builtin_convertvector(f, bf16x2_t); return __builtin_bit_cast(unsigned, b); }
DEV float fsigmoid(float x) { return 1.f / (1.f + __expf(-x)); }
DEV float fsilu(float x) { return x / (1.f + __expf(-x)); }
DEV unsigned cvtpk(float lo, float hi) { return pk2(lo, hi); }
DEV float ex2(float x) { return __builtin_amdgcn_exp2f(x); }
DEV float lg2(float x) { return __builtin_amdgcn_logf(x); }
DEV float frcp(float x) { return __builtin_amdgcn_rcpf(x); }
DEV float lo16(unsigned u) { return __uint_as_float(u << 16); }
DEV float hi16(unsigned u) { return __uint_as_float(u & 0xffff0000u); }
DEV int rowoff(int reg, int h) { return (reg & 3) + 8 * (reg >> 2) + 4 * h; }
DEV f32x16 zero16() { f32x16 z;
#pragma unroll
  for (int i = 0; i < 16; ++i) z[i] = 0.f; return z; }

template <int KD>
DEV void mma32(f32x16& acc, const bf16_t* a, int lda, const bf16_t* b, int ldb, int lane) {
  const int r = lane & 31, h = lane >> 5;
  const bf16_t* ap = a + r * lda + 8 * h;
  const bf16_t* bp = b + r * ldb + 8 * h;
#pragma unroll 1
  for (int k0 = 0; k0 < KD; k0 += 64) {
    bf16x8 av[4], bv[4];
#pragma unroll
    for (int j = 0; j < 4; ++j) { av[j] = *(const bf16x8*)(ap + k0 + 16 * j); bv[j] = *(const bf16x8*)(bp + k0 + 16 * j); }
    __builtin_amdgcn_sched_barrier(0);
#pragma unroll
    for (int j = 0; j < 4; ++j) acc = __builtin_amdgcn_mfma_f32_32x32x16_bf16(av[j], bv[j], acc, 0, 0, 0);
  }
}

template <int KD>
DEV f32x16 mma32z(const bf16_t* a, int lda, const bf16_t* b, int ldb, int lane) {
  const int r = lane & 31, h = lane >> 5;
  const bf16_t* ap = a + r * lda + 8 * h;
  const bf16_t* bp = b + r * ldb + 8 * h;
  f32x16 acc;
  {
    bf16x8 av[4], bv[4];
#pragma unroll
    for (int j = 0; j < 4; ++j) { av[j] = *(const bf16x8*)(ap + 16 * j); bv[j] = *(const bf16x8*)(bp + 16 * j); }
    __builtin_amdgcn_sched_barrier(0);
    acc = __builtin_amdgcn_mfma_f32_32x32x16_bf16(av[0], bv[0], zero16(), 0, 0, 0);
#pragma unroll
    for (int j = 1; j < 4; ++j) acc = __builtin_amdgcn_mfma_f32_32x32x16_bf16(av[j], bv[j], acc, 0, 0, 0);
  }
#pragma unroll 1
  for (int k0 = 64; k0 < KD; k0 += 64) {
    bf16x8 av[4], bv[4];
#pragma unroll
    for (int j = 0; j < 4; ++j) { av[j] = *(const bf16x8*)(ap + k0 + 16 * j); bv[j] = *(const bf16x8*)(bp + k0 + 16 * j); }
    __builtin_amdgcn_sched_barrier(0);
#pragma unroll
    for (int j = 0; j < 4; ++j) acc = __builtin_amdgcn_mfma_f32_32x32x16_bf16(av[j], bv[j], acc, 0, 0, 0);
  }
  return acc;
}

DEV int orig_col(int n) {
  if (n < 4864) return n;
  if (n < 6400) return n + 16;
  if (n < 6912) return n + 48;
  if (n < 6928) return n - 2048;
  if (n < 6960) return n - 512;
  return -1;
}

DEV void convert_weights(const ParamsG& p, int l, int which, unsigned char* smem) {
  float* s = (float*)smem;
  const int tid = launder(threadIdx.x);
  const float* win = (const float*)(p.w_in + (size_t)l * DM * NIN);
  const float* wout = (const float*)(p.w_out + (size_t)l * DI * DM);
  bf16_t* wint = (bf16_t*)(p.ws + OFF_WIN);
  bf16_t* woutt = (bf16_t*)(p.ws + OFF_WOUT);
  const int n_in_tiles = (NPAD / 64) * (DM / 64);
  const int n_out_tiles = (DM / 64) * (DI / 64);
  const int it_lo = (which & 1) ? 0 : n_in_tiles, it_hi = (which & 2) ? (n_in_tiles + n_out_tiles) : n_in_tiles;
  for (int it = it_lo + blockIdx.x; it < it_hi; it += gridDim.x) {
    lds_barrier();
    if (it < n_in_tiles) {
      const int n0 = (it / 16) * 64, k0 = (it % 16) * 64;
#pragma unroll
      for (int e = 0; e < 8; ++e) {
        const int idx = e * NT + tid, kk = idx >> 6, nn = idx & 63;
        const int oc = orig_col(n0 + nn);
        s[kk * 65 + nn] = (oc >= 0) ? win[(size_t)(k0 + kk) * NIN + oc] : 0.f;
      }
      lds_barrier();
      const int n = tid >> 3, kc = (tid & 7) * 8;
      uint4 o;
      o.x = pk2(s[(kc + 0) * 65 + n], s[(kc + 1) * 65 + n]); o.y = pk2(s[(kc + 2) * 65 + n], s[(kc + 3) * 65 + n]);
      o.z = pk2(s[(kc + 4) * 65 + n], s[(kc + 5) * 65 + n]); o.w = pk2(s[(kc + 6) * 65 + n], s[(kc + 7) * 65 + n]);
      *(uint4*)(wint + (size_t)(n0 + n) * DM + k0 + kc) = o;
    } else {
      const int j = it - n_in_tiles;
      const int n0 = (j / 32) * 64, k0 = (j % 32) * 64;
#pragma unroll
      for (int e = 0; e < 8; ++e) {
        const int idx = e * NT + tid, kk = idx >> 6, nn = idx & 63;
        s[kk * 65 + nn] = wout[(size_t)(k0 + kk) * DM + n0 + nn];
      }
      lds_barrier();
      const int n = tid >> 3, kc = (tid & 7) * 8;
      uint4 o;
      o.x = pk2(s[(kc + 0) * 65 + n], s[(kc + 1) * 65 + n]); o.y = pk2(s[(kc + 2) * 65 + n], s[(kc + 3) * 65 + n]);
      o.z = pk2(s[(kc + 4) * 65 + n], s[(kc + 5) * 65 + n]); o.w = pk2(s[(kc + 6) * 65 + n], s[(kc + 7) * 65 + n]);
      *(uint4*)(woutt + (size_t)(n0 + n) * DI + k0 + kc) = o;
    }
  }
  lds_barrier();
}

DEV void fsincos(float x, float& s, float& c) {
  const float k = rintf(x * 0.63661977236758134308f);
  float r = fmaf(-k, 1.5707855225e+00f, x);
  r = fmaf(-k, 1.0804273188e-05f, r);
  r = fmaf(-k, 6.0770999344e-11f, r);
  const float r2 = r * r;
  float ps = fmaf(r2, 2.7557319224e-06f, -1.9841269841e-04f);
  ps = fmaf(ps, r2, 8.3333333333e-03f); ps = fmaf(ps, r2, -1.6666666667e-01f);
  const float sinr = fmaf(ps * r2, r, r);
  float pc = fmaf(r2, -2.7557319224e-07f, 2.4801587302e-05f);
  pc = fmaf(pc, r2, -1.3888888889e-03f); pc = fmaf(pc, r2, 4.1666666667e-02f); pc = fmaf(pc, r2, -0.5f);
  const float cosr = fmaf(pc, r2, 1.0f);
  const int q = ((int)k) & 3;
  if (q == 0) { s = sinr; c = cosr; }
  else if (q == 1) { s = cosr; c = -sinr; }
  else if (q == 2) { s = -sinr; c = -cosr; }
  else { s = -cosr; c = sinr; }
}

DEV void phase_pro(const ParamsG& p, unsigned char* smem) {
  const int tid = launder(threadIdx.x);
  const size_t gtid = (size_t)blockIdx.x * NT + tid, gsz = (size_t)gridDim.x * NT;
  const float4* x4 = (const float4*)p.x;
  uint4* xb4 = (uint4*)(p.ws + OFF_XB);
  for (size_t i = gtid; i < (size_t)TH * DM / 8; i += gsz) {
    const float4 a = x4[2 * i], b = x4[2 * i + 1];
    uint4 o; o.x = pk2(a.x, a.y); o.y = pk2(a.z, a.w); o.z = pk2(b.x, b.y); o.w = pk2(b.z, b.w);
    xb4[i] = o;
  }
  if (blockIdx.x == 0) {
    float2* tab = (float2*)(p.ws + OFF_TAB);
    for (int i = tid; i < 64 * 16; i += NT) {
      const int pos = i >> 4, fi = i & 15;
      const float invf = exp2f(-(float)fi * (13.287712379549449f / 16.0f));
      const float ang = (float)pos * invf;
      float sn, cs; fsincos(ang, sn, cs);
      tab[i] = make_float2(cs, sn);
    }
  }
}
DEV void xconv_item(const ParamsG& p, int f) {
  const int tid = launder(threadIdx.x);
  const float4* x4 = (const float4*)p.x;
  uint4* xb4 = (uint4*)(p.ws + OFF_XB);
  const size_t base = ((size_t)TH + (size_t)f * 32) * DM / 8;
  float4 a[8], b[8];
#pragma unroll
  for (int e = 0; e < 8; ++e) { const size_t i = base + e * NT + tid; a[e] = x4[2 * i]; b[e] = x4[2 * i + 1]; }
#pragma unroll
  for (int e = 0; e < 8; ++e) {
    uint4 o; o.x = pk2(a[e].x, a[e].y); o.y = pk2(a[e].z, a[e].w); o.z = pk2(b[e].x, b[e].y); o.w = pk2(b[e].z, b[e].w);
    xb4[base + e * NT + tid] = o;
  }
}

namespace pg8 {
#define PG8_LAS __attribute__((address_space(3)))
typedef unsigned short bf16_t;
typedef short bf16x8 __attribute__((ext_vector_type(8)));
typedef float f32x4 __attribute__((ext_vector_type(4)));
typedef unsigned u32x4 __attribute__((ext_vector_type(4)));
constexpr int BM = 256, BK = 64, HALF = 128, HTB = HALF * BK * 2  , STAGE_BYTES = 8 * HTB, NXCD = 8, WGM = 8;

__host__ __device__ __forceinline__ int lds_byte(int r, int c) { const int st = (r >> 4) * 2 + (c >> 5), rr = r & 15, cc = c & 31, ob = rr * 64 + cc * 2; return st * 1024 + (ob ^ (((ob >> 9) & 1) << 5)); }
__host__ __device__ __forceinline__ void stage_rc(int b, int& R, int& C) { const int st = b / 1024, sb = b % 1024, swz = sb ^ (((sb >> 9) & 1) << 5); R = (st >> 1) * 16 + swz / 64; C = (st & 1) * 32 + (swz % 64) / 2; }
__host__ __device__ __forceinline__ int perm32(int rho) { const int n = rho >> 4, i = rho & 15; return 8 * (i >> 2) + 4 * n + (i & 3); }

struct Unit { int pm, pn; };
struct Gemm { const bf16_t* A; const bf16_t* Bt; int M, N, K; const bf16_t* A2 = nullptr; int lda2 = 0, nk2 = 0; };

__device__ __forceinline__ unsigned cvt_pk_bf16(float lo, float hi) { unsigned r; asm volatile("v_cvt_pk_bf16_f32 %0, %1, %2" : "=v"(r) : "v"(lo), "v"(hi)); return r; }

struct XcdOrder {
    int rpx, nN, x, c, ncu, skew;
    __device__ void init(int M, int N, int skew_ = 0) { rpx = (M / BM) / NXCD; nN = N / BM; x = blockIdx.x & 7; c = blockIdx.x >> 3; ncu = gridDim.x >> 3; skew = skew_; }
    __device__ bool next(int i, Unit& u) const {
        const int total = rpx * nN, full = (total / ncu) * ncu;
        int j = c + i * ncu;
        if (skew < 0 && j >= full) return false;
        if (skew > 0 && j >= full) { const int cc = c - skew; j = (cc >= 0 && i == total / ncu) ? full + cc : total; }
        if (j >= total) return false; u.pm = rpx * x + (j % rpx); u.pn = j / rpx; return true; }
    __device__ bool tail(int q, Unit& u, int& hh) const {
        const int total = rpx * nN, full = (total / ncu) * ncu, left = total - full;
        if (q >= 2 * left) return false;
        const int j = full + (q % left); hh = q / left; u.pm = rpx * x + (j % rpx); u.pn = j / rpx; return true; }
    __device__ __forceinline__ void a_ready(const Unit&) const {}
    __device__ __forceinline__ void done(const Unit&) const {}
};
struct EpiIn {
    static constexpr bool PERM = true, AFTER_DRAIN = false;
    bf16_t* O; int ldc; float* small; int small_pn;
    __device__ __forceinline__ void one(const f32x4 (&a)[2][4][2], int pn, int row0, int wc, int fq) const {
        const int col0 = pn * BM + wc * 32 + 8 * fq;
        if (pn == small_pn) {
            const int c = wc * 32 + 8 * fq;
            if (c < 48) {
#pragma unroll
                for (int m = 0; m < 4; ++m) { float* rp = small + (size_t)(row0 + m * 16) * 48 + c; *(f32x4*)rp = a[0][m][0]; *(f32x4*)(rp + 4) = a[0][m][1]; }
            }
            return;
        }
        const int act = (pn == 5 || pn == 6) ? 1 : ((pn == 21) ? 2 : 0);
#pragma unroll
        for (int m = 0; m < 4; ++m) { bf16_t* rowp = O + (size_t)(row0 + m * 16) * ldc + col0;
#pragma unroll
            for (int bj = 0; bj < 2; ++bj) { f32x4 v0 = a[bj][m][0], v1 = a[bj][m][1];
                if (act == 1) {
#pragma unroll
                    for (int e = 0; e < 4; ++e) {
                        v0[e] = v0[e] * __builtin_amdgcn_rcpf(1.f + __builtin_amdgcn_exp2f(fminf(-v0[e] * 1.4426950408889634f, 80.f))) * 0.08838834764831845f;
                        v1[e] = v1[e] * __builtin_amdgcn_rcpf(1.f + __builtin_amdgcn_exp2f(fminf(-v1[e] * 1.4426950408889634f, 80.f))) * 0.08838834764831845f; }
                } else if (act == 2) { v0 = v0 * 0.125f; v1 = v1 * 0.125f; }
                u32x4 w; w.x = cvt_pk_bf16(v0[0], v0[1]); w.y = cvt_pk_bf16(v0[2], v0[3]); w.z = cvt_pk_bf16(v1[0], v1[1]); w.w = cvt_pk_bf16(v1[2], v1[3]);
                *(u32x4*)(rowp + bj * HALF) = w; } }
    }
    __device__ __forceinline__ void operator()(const f32x4 (&acc)[2][2][4][2], const Unit& u, int wr, int wc, int fr, int fq) const {
        const int row0 = u.pm * BM + wr * 64 + fr;
#pragma unroll
        for (int ai = 0; ai < 2; ++ai) one(acc[ai], u.pn, row0 + ai * HALF, wc, fq);
    }
};
struct EpiOut {
    static constexpr bool PERM = true, AFTER_DRAIN = false;
    const float* X; const bf16_t* Xb; bf16_t* Y; int ldc; float alpha;
    __device__ __forceinline__ void one(const f32x4 (&a)[2][4][2], int pn, int row0, int wc, int fq) const {
        const int col0 = pn * BM + wc * 32 + 8 * fq;
#pragma unroll
        for (int m = 0; m < 4; ++m) { const size_t off = (size_t)(row0 + m * 16) * ldc + col0;
#pragma unroll
            for (int bj = 0; bj < 2; ++bj) {
                f32x4 x0, x1;
                if (Xb) { const u32x4 r = *(const u32x4*)(Xb + off + bj * HALF);
                    x0 = (f32x4){__uint_as_float(r.x << 16), __uint_as_float(r.x & 0xffff0000u), __uint_as_float(r.y << 16), __uint_as_float(r.y & 0xffff0000u)};
                    x1 = (f32x4){__uint_as_float(r.z << 16), __uint_as_float(r.z & 0xffff0000u), __uint_as_float(r.w << 16), __uint_as_float(r.w & 0xffff0000u)}; }
                else { x0 = *(const f32x4*)(X + off + bj * HALF); x1 = *(const f32x4*)(X + off + bj * HALF + 4); }
                const f32x4 y0 = x0 * alpha + a[bj][m][0], y1 = x1 * alpha + a[bj][m][1];
                u32x4 w; w.x = cvt_pk_bf16(y0[0], y0[1]); w.y = cvt_pk_bf16(y0[2], y0[3]); w.z = cvt_pk_bf16(y1[0], y1[1]); w.w = cvt_pk_bf16(y1[2], y1[3]);
                *(u32x4*)(Y + off + bj * HALF) = w; } }
    }
    __device__ __forceinline__ void operator()(const f32x4 (&acc)[2][2][4][2], const Unit& u, int wr, int wc, int fr, int fq) const {
        const int row0 = u.pm * BM + wr * 64 + fr;
#pragma unroll
        for (int ai = 0; ai < 2; ++ai) one(acc[ai], u.pn, row0 + ai * HALF, wc, fq);
    }
};

template <class Epi, class Sched, bool ALIGN_EPI = false, bool SP2 = false>
__device__ __forceinline__ void gemm_phase(PG8_LAS unsigned char* lds, const Gemm g, const Sched& S, const Epi& E) {
    const int tid = launder((int)threadIdx.x), wid = __builtin_amdgcn_readfirstlane(tid >> 6), lane = tid & 63, wr = wid >> 2, wc = wid & 3, fr = lane & 15, fq = lane >> 4;
    const int K = g.K, nt = K / BK;
    unsigned voffA[2], voffB[2];
#pragma unroll
    for (int i = 0; i < 2; ++i) { int R, C; stage_rc(tid * 16 + i * 8192, R, C); const int Rb = Epi::PERM ? ((R & ~31) + perm32(R & 31)) : R;
        voffA[i] = (unsigned)(R * K + C) * 2u; voffB[i] = (unsigned)(Rb * K + C) * 2u; }
    const size_t kstep = (size_t)(BK * 2);
    const size_t hstep = (size_t)HALF * K * 2;
    const size_t tstep = 2 * hstep;
    const unsigned ldsw = (unsigned)wid * 1024u;
    const int aoff = lds_byte(wr * 64 + fr, fq * 8), boff = lds_byte(wc * 32 + fr, fq * 8);
#define PG8_SA(b, h) (((b) * 2 + (h)) * HTB)
#define PG8_SB(b, h) ((4 + (b) * 2 + (h)) * HTB)
#define PG8_STAGE(bufoff, gbase, voff) do { _Pragma("unroll") for (int _i = 0; _i < 2; ++_i) \
        __builtin_amdgcn_global_load_lds((const unsigned*)((const char*)(gbase) + (voff)[_i]), (PG8_LAS unsigned*)(lds + (bufoff) + ldsw + _i * 8192), 16, 0, 0); } while (0)
#define PG8_LDA(dst, b, h) do { _Pragma("unroll") for (int m = 0; m < 4; ++m) _Pragma("unroll") for (int k = 0; k < 2; ++k) dst[m][k] = *(const PG8_LAS bf16x8*)(lds + PG8_SA(b, h) + aoff + m * 2048 + k * 1024); } while (0)
#define PG8_LDB(dst, b, h) do { _Pragma("unroll") for (int n = 0; n < 2; ++n) _Pragma("unroll") for (int k = 0; k < 2; ++k) dst[n][k] = *(const PG8_LAS bf16x8*)(lds + PG8_SB(b, h) + boff + n * 2048 + k * 1024); } while (0)
#define PG8_MMA(ai, bj, At, Bt) do { __builtin_amdgcn_s_setprio(1); _Pragma("unroll") for (int m = 0; m < 4; ++m) _Pragma("unroll") for (int n = 0; n < 2; ++n) _Pragma("unroll") for (int k = 0; k < 2; ++k) \
        acc[ai][bj][m][n] = __builtin_amdgcn_mfma_f32_16x16x32_bf16(Bt[n][k], At[m][k], acc[ai][bj][m][n], 0, 0, 0); __builtin_amdgcn_s_setprio(0); } while (0)
#define PG8_WAIT_V(n) asm volatile("s_waitcnt vmcnt(" #n ")" ::: "memory")
#define PG8_WAIT_L(n) asm volatile("s_waitcnt lgkmcnt(" #n ")" ::: "memory")
#define PG8_BAR __builtin_amdgcn_s_barrier()
#define PG8_SCHED __builtin_amdgcn_sched_barrier(0)
    Unit cur, nxt; int ui = 0;
    if (!S.next(0, cur)) return;
    f32x4 acc[2][2][4][2];
#pragma unroll
    for (int a = 0; a < 2; ++a)
#pragma unroll
        for (int b = 0; b < 2; ++b)
#pragma unroll
            for (int m = 0; m < 4; ++m)
#pragma unroll
                for (int n = 0; n < 2; ++n) acc[a][b][m][n] = (f32x4){0.f, 0.f, 0.f, 0.f};
    bf16x8 At[4][2], B0[2][2], B1[2][2];
    const char* cA = (const char*)g.A + (size_t)cur.pm * tstep; const char* cB = (const char*)g.Bt + (size_t)cur.pn * tstep;
    S.a_ready(cur);
    if constexpr (SP2) {
        PG8_STAGE(PG8_SB(0, 0), cB, voffB); PG8_STAGE(PG8_SB(0, 1), cB + hstep, voffB); PG8_STAGE(PG8_SA(0, 0), cA, voffA); PG8_STAGE(PG8_SA(0, 1), cA + hstep, voffA);
        if (wr == 1) PG8_BAR;
        PG8_WAIT_V(2); PG8_BAR;
        PG8_STAGE(PG8_SB(1, 0), cB + kstep, voffB); PG8_STAGE(PG8_SA(1, 0), cA + kstep, voffA); PG8_STAGE(PG8_SB(1, 1), cB + hstep + kstep, voffB);
        PG8_WAIT_V(6); PG8_BAR;
    } else {
        PG8_STAGE(PG8_SB(0, 0), cB, voffB); PG8_STAGE(PG8_SA(0, 0), cA, voffA); PG8_STAGE(PG8_SB(0, 1), cB + hstep, voffB); PG8_STAGE(PG8_SA(0, 1), cA + hstep, voffA);
        if (wr == 1) PG8_BAR;
        PG8_WAIT_V(4); PG8_BAR;
        PG8_STAGE(PG8_SB(1, 0), cB + kstep, voffB); PG8_STAGE(PG8_SA(1, 0), cA + kstep, voffA); PG8_STAGE(PG8_SB(1, 1), cB + hstep + kstep, voffB);
        PG8_WAIT_V(6); PG8_BAR;
    }
    for (;;) {
        const bool has_next = S.next(ui + 1, nxt);
        const char* nA = has_next ? (const char*)g.A + (size_t)nxt.pm * tstep : cA; const char* nB = has_next ? (const char*)g.Bt + (size_t)nxt.pn * tstep : cB;
        for (int t = 0; t < nt; t += 2) {
            const bool last = (t == nt - 2);
            const char* a1 = cA + (size_t)(t + 1) * kstep;
            const char* a2 = last ? nA : cA + (size_t)(t + 2) * kstep; const char* b2 = last ? nB : cB + (size_t)(t + 2) * kstep;
            const char* a3 = a2 + kstep; const char* b3 = b2 + kstep;
            if (last && has_next) S.a_ready(nxt);
            if constexpr (SP2) {
            PG8_LDB(B0, 0, 0); PG8_LDB(B1, 0, 1); PG8_SCHED; PG8_LDA(At, 0, 0); PG8_STAGE(PG8_SA(1, 1), a1 + hstep, voffA);
            PG8_WAIT_V(8); PG8_WAIT_L(0); PG8_BAR; PG8_MMA(0, 0, At, B0); PG8_MMA(0, 1, At, B1); PG8_BAR; PG8_SCHED;
            PG8_LDA(At, 0, 1); PG8_STAGE(PG8_SB(0, 0), b2, voffB); PG8_STAGE(PG8_SB(0, 1), b2 + hstep, voffB); PG8_STAGE(PG8_SA(0, 0), a2, voffA);
            PG8_WAIT_V(8); PG8_WAIT_L(0); PG8_BAR; PG8_MMA(1, 0, At, B0); PG8_MMA(1, 1, At, B1); PG8_BAR; PG8_SCHED;
            PG8_LDB(B0, 1, 0); PG8_LDB(B1, 1, 1); PG8_SCHED; PG8_LDA(At, 1, 0); PG8_STAGE(PG8_SA(0, 1), a2 + hstep, voffA);
            PG8_WAIT_V(8); PG8_WAIT_L(0); PG8_BAR; PG8_MMA(0, 0, At, B0); PG8_MMA(0, 1, At, B1); PG8_BAR; PG8_SCHED;
            PG8_LDA(At, 1, 1); PG8_STAGE(PG8_SB(1, 0), b3, voffB); PG8_STAGE(PG8_SB(1, 1), b3 + hstep, voffB); PG8_STAGE(PG8_SA(1, 0), a3, voffA);
            PG8_WAIT_V(8); PG8_WAIT_L(0); PG8_BAR; PG8_MMA(1, 0, At, B0); PG8_MMA(1, 1, At, B1); PG8_BAR; PG8_SCHED;
            } else {
            PG8_LDB(B0, 0, 0); PG8_SCHED; PG8_LDA(At, 0, 0); PG8_STAGE(PG8_SA(1, 1), a1 + hstep, voffA);
            PG8_WAIT_L(8); PG8_BAR; PG8_WAIT_L(0); PG8_MMA(0, 0, At, B0); PG8_BAR; PG8_SCHED;
            PG8_LDB(B1, 0, 1); PG8_STAGE(PG8_SB(0, 0), b2, voffB);
            PG8_BAR; PG8_WAIT_L(0); PG8_MMA(0, 1, At, B1); PG8_BAR;
            PG8_LDA(At, 0, 1); PG8_STAGE(PG8_SA(0, 0), a2, voffA);
            PG8_BAR; PG8_WAIT_L(0); PG8_MMA(1, 0, At, B0); PG8_BAR; PG8_SCHED;
            PG8_STAGE(PG8_SB(0, 1), b2 + hstep, voffB);
            PG8_WAIT_V(6); PG8_BAR; PG8_MMA(1, 1, At, B1); PG8_BAR;
            PG8_LDB(B0, 1, 0); PG8_SCHED; PG8_LDA(At, 1, 0); PG8_STAGE(PG8_SA(0, 1), a2 + hstep, voffA);
            PG8_WAIT_L(8); PG8_BAR; PG8_WAIT_L(0); PG8_MMA(0, 0, At, B0); PG8_BAR; PG8_SCHED;
            PG8_LDB(B1, 1, 1); PG8_STAGE(PG8_SB(1, 0), b3, voffB);
            PG8_BAR; PG8_WAIT_L(0); PG8_MMA(0, 1, At, B1); PG8_BAR;
            PG8_LDA(At, 1, 1); PG8_STAGE(PG8_SA(1, 0), a3, voffA);
            PG8_BAR; PG8_WAIT_L(0); PG8_MMA(1, 0, At, B0); PG8_BAR; PG8_SCHED;
            PG8_STAGE(PG8_SB(1, 1), b3 + hstep, voffB);
            PG8_WAIT_V(6); PG8_BAR; PG8_MMA(1, 1, At, B1); PG8_BAR;
            }
        }
        if constexpr (ALIGN_EPI) { if (wr == 0) PG8_BAR; }
        if constexpr (!Epi::AFTER_DRAIN) { E(acc, cur, wr, wc, fr, fq); S.done(cur); }
        if (!has_next) break;
#pragma unroll
        for (int a = 0; a < 2; ++a)
#pragma unroll
            for (int b = 0; b < 2; ++b)
#pragma unroll
                for (int m = 0; m < 4; ++m)
#pragma unroll
                    for (int n = 0; n < 2; ++n) acc[a][b][m][n] = (f32x4){0.f, 0.f, 0.f, 0.f};
        cur = nxt; cA = nA; cB = nB; ++ui;
        if constexpr (ALIGN_EPI) { if (wr == 1) PG8_BAR; }
    }
    PG8_WAIT_V(0);
    if constexpr (!ALIGN_EPI) { if (wr == 0) PG8_BAR; }
    PG8_BAR;
    if constexpr (Epi::AFTER_DRAIN) { E.fused(acc, cur, wr, wc, fr, fq, lds, wid, lane); S.done(cur); }
#undef PG8_SA
#undef PG8_SB
#undef PG8_STAGE
#undef PG8_LDA
#undef PG8_LDB
#undef PG8_MMA
#undef PG8_WAIT_V
#undef PG8_WAIT_L
#undef PG8_BAR
#undef PG8_SCHED
}

template <class Epi>
__device__ __forceinline__ void gemm_half(PG8_LAS unsigned char* lds, const Gemm g, int pm, int pn, int hh, const Epi& E) {
    const int tid = launder((int)threadIdx.x), wid = __builtin_amdgcn_readfirstlane(tid >> 6), lane = tid & 63, wr = wid >> 2, wc = wid & 3, fr = lane & 15, fq = lane >> 4;
    const int K = g.K, nt = K / BK;
    unsigned voffA[2], voffB[2], voffA2[2];
#pragma unroll
    for (int i = 0; i < 2; ++i) { int R, C; stage_rc(tid * 16 + i * 8192, R, C); const int Rb = Epi::PERM ? ((R & ~31) + perm32(R & 31)) : R;
        voffA[i] = (unsigned)(R * K + C) * 2u; voffB[i] = (unsigned)(Rb * K + C) * 2u; voffA2[i] = (unsigned)(R * g.lda2 + C) * 2u; }
    const size_t kstep = (size_t)(BK * 2);
    const size_t hstep = (size_t)HALF * K * 2;
    const unsigned ldsw = (unsigned)wid * 1024u;
    const int aoff = lds_byte(wr * 64 + fr, fq * 8), boff = lds_byte(wc * 32 + fr, fq * 8);
    constexpr int SETB = 3 * HTB;
#define HU_STAGE(bufoff, gbase, voff) do { _Pragma("unroll") for (int _i = 0; _i < 2; ++_i) \
        __builtin_amdgcn_global_load_lds((const unsigned*)((const char*)(gbase) + (voff)[_i]), (PG8_LAS unsigned*)(lds + (bufoff) + ldsw + _i * 8192), 16, 0, 0); } while (0)
#define HU_STAGE3(so, kt) do { HU_STAGE((so), cB + (size_t)(kt) * kstep, voffB); HU_STAGE((so) + HTB, cB + hstep + (size_t)(kt) * kstep, voffB); \
        if ((kt) < g.nk2) HU_STAGE((so) + 2 * HTB, cA2 + (size_t)(kt) * kstep, voffA2); else HU_STAGE((so) + 2 * HTB, cA + (size_t)(kt) * kstep, voffA); } while (0)
#define HU_LDA(dst, so) do { _Pragma("unroll") for (int m = 0; m < 4; ++m) _Pragma("unroll") for (int k = 0; k < 2; ++k) dst[m][k] = *(const PG8_LAS bf16x8*)(lds + (so) + 2 * HTB + aoff + m * 2048 + k * 1024); } while (0)
#define HU_LDB(dst, so, h) do { _Pragma("unroll") for (int n = 0; n < 2; ++n) _Pragma("unroll") for (int k = 0; k < 2; ++k) dst[n][k] = *(const PG8_LAS bf16x8*)(lds + (so) + (h) * HTB + boff + n * 2048 + k * 1024); } while (0)
#define HU_MMA(bj, At, Bt) do { __builtin_amdgcn_s_setprio(1); _Pragma("unroll") for (int m = 0; m < 4; ++m) _Pragma("unroll") for (int n = 0; n < 2; ++n) _Pragma("unroll") for (int k = 0; k < 2; ++k) \
        acc[bj][m][n] = __builtin_amdgcn_mfma_f32_16x16x32_bf16(Bt[n][k], At[m][k], acc[bj][m][n], 0, 0, 0); __builtin_amdgcn_s_setprio(0); } while (0)
#define HU_WAIT_V(n) asm volatile("s_waitcnt vmcnt(" #n ")" ::: "memory")
#define HU_WAIT_L(n) asm volatile("s_waitcnt lgkmcnt(" #n ")" ::: "memory")
#define HU_BAR __builtin_amdgcn_s_barrier()
#define HU_SCHED __builtin_amdgcn_sched_barrier(0)
    f32x4 acc[2][4][2];
#pragma unroll
    for (int b = 0; b < 2; ++b)
#pragma unroll
        for (int m = 0; m < 4; ++m)
#pragma unroll
            for (int n = 0; n < 2; ++n) acc[b][m][n] = (f32x4){0.f, 0.f, 0.f, 0.f};
    bf16x8 At[4][2], B0[2][2], B1[2][2];
    const char* cA = (const char*)g.A + ((size_t)pm * 2 + hh) * hstep; const char* cB = (const char*)g.Bt + (size_t)pn * 2 * hstep;
    const char* cA2 = (const char*)g.A2 + ((size_t)pm * 2 + hh) * (size_t)HALF * g.lda2 * 2;
    HU_STAGE3(0, 0);
    if (wr == 1) HU_BAR;
    HU_WAIT_V(0); HU_BAR;
    HU_STAGE3(SETB, 1);
    HU_BAR;
    int so = 0, so2 = 2 * SETB;
    for (int t = 0; t < nt; ++t) {
        HU_LDB(B0, so, 0); HU_LDB(B1, so, 1); HU_SCHED; HU_LDA(At, so);
        if (t + 2 < nt) { HU_STAGE3(so2, t + 2); HU_WAIT_V(6); } else { HU_WAIT_V(0); }
        HU_WAIT_L(0); HU_BAR; HU_MMA(0, At, B0); HU_MMA(1, At, B1); HU_BAR; HU_SCHED;
        so = (so == 2 * SETB) ? 0 : so + SETB; so2 = (so2 == 2 * SETB) ? 0 : so2 + SETB;
    }
    if (wr == 0) HU_BAR;
    E.one(acc, pn, pm * BM + hh * HALF + wr * 64 + fr, wc, fq);
    HU_BAR;
#undef HU_STAGE
#undef HU_STAGE3
#undef HU_LDA
#undef HU_LDB
#undef HU_MMA
#undef HU_WAIT_V
#undef HU_WAIT_L
#undef HU_BAR
#undef HU_SCHED
}
}

DEV void phase_inproj(const ParamsG& p, int l, int hf, int skew, unsigned char* smem) {
  pg8::Gemm g{(const bf16_t*)(p.ws + OFF_XB) + (size_t)hf * TH * DM, (const bf16_t*)(p.ws + OFF_WIN), TH, NPAD, DM};
  pg8::XcdOrder S; S.init(TH, NPAD, -1);
  pg8::EpiIn E{(bf16_t*)(p.ws + OFF_H), NPAD, (float*)(p.ws + OFF_SMALL), SM0 / 256};
  pg8::gemm_phase<pg8::EpiIn, pg8::XcdOrder, true, true>((PG8_LAS unsigned char*)smem, g, S, E);
  for (int q = S.c; ; q += S.ncu) { pg8::Unit u; int hh; if (!S.tail(q, u, hh)) break; pg8::gemm_half<pg8::EpiIn>((PG8_LAS unsigned char*)smem, g, u.pm, u.pn, hh, E); }
}

DEV void phase_outproj(const ParamsG& p, int l, int hf, unsigned char* smem) {
  pg8::Gemm g{(const bf16_t*)(p.ws + OFF_MIXED), (const bf16_t*)(p.ws + OFF_WOUT), TH, DM, DI, (const bf16_t*)(p.ws + OFF_AO), 512, 8};
  pg8::XcdOrder S; S.init(TH, DM, -1);
  const float* xin = (const float*)(p.x + (size_t)hf * TH * DM);
  const bf16_t* xbin = (l == 0) ? (const bf16_t*)nullptr : (const bf16_t*)(p.ws + OFF_XB) + (size_t)hf * TH * DM;
  pg8::EpiOut E{xin, xbin, (bf16_t*)(p.ws + OFF_OBUF), DM, DN_ALPHA};
  const int total = S.rpx * S.nN;
  for (int q = S.c; q < 2 * total; q += S.ncu) {
    const int j = q % total, hh = q / total;
    pg8::gemm_half<pg8::EpiOut>((PG8_LAS unsigned char*)smem, g, S.rpx * S.x + (j % S.rpx), j / S.rpx, hh, E);
  }
}

DEV void ln_block(const ParamsG& p, int l, int hf, int rbase) {
  const int tid = launder(threadIdx.x), lane = tid & 63, w = tid >> 6;
  const float* g = (const float*)(p.ln_g + l * DM); const float* b = (const float*)(p.ln_b + l * DM);
  bf16_t* xb = (bf16_t*)(p.ws + OFF_XB);
  {
    const int r0 = rbase + w * 4;
    f32x4 v[4][4];
#pragma unroll
    for (int i = 0; i < 4; ++i)
#pragma unroll
      for (int j = 0; j < 4; ++j) {
        const u32x2 r = __builtin_nontemporal_load((const u32x2*)((const bf16_t*)(p.ws + OFF_OBUF) + (size_t)(r0 + i) * DM) + j * 64 + lane);
        v[i][j] = (f32x4){__uint_as_float(r.x << 16), __uint_as_float(r.x & 0xffff0000u), __uint_as_float(r.y << 16), __uint_as_float(r.y & 0xffff0000u)};
      }
    f32x4 gg[4], bb[4];
#pragma unroll
    for (int j = 0; j < 4; ++j) { gg[j] = ((const f32x4*)g)[j * 64 + lane]; bb[j] = ((const f32x4*)b)[j * 64 + lane]; }
#pragma unroll
    for (int i = 0; i < 4; ++i) {
      const int row = hf * TH + r0 + i;
      float sm = 0.f;
#pragma unroll
      for (int j = 0; j < 4; ++j) sm += (v[i][j][0] + v[i][j][1]) + (v[i][j][2] + v[i][j][3]);
#pragma unroll
      for (int o = 32; o >= 1; o >>= 1) sm += __shfl_xor(sm, o);
      const float mu = sm * (1.f / DM);
      float q = 0.f;
#pragma unroll
      for (int j = 0; j < 4; ++j) { const f32x4 d = v[i][j] - mu; q += (d[0] * d[0] + d[1] * d[1]) + (d[2] * d[2] + d[3] * d[3]); }
#pragma unroll
      for (int o = 32; o >= 1; o >>= 1) q += __shfl_xor(q, o);
      const float rstd = rsqrtf(q * (1.f / DM) + 1e-5f);
#pragma unroll
      for (int j = 0; j < 4; ++j) {
        const f32x4 o = (v[i][j] - mu) * rstd * gg[j] + bb[j];
        if (l == 0) *(uint2*)(xb + (size_t)row * DM + (j * 64 + lane) * 4) = make_uint2(pk2(o[0], o[1]), pk2(o[2], o[3]));
        else __builtin_nontemporal_store(o, (f32x4*)(p.out + (size_t)row * DM) + j * 64 + lane);
      }
    }
  }
}
DEV void ln_block64(const ParamsG& p, int l, int hf, int rbase) {
  const int tid = launder(threadIdx.x), lane = tid & 63, w = tid >> 6;
  const float* g = (const float*)(p.ln_g + l * DM); const float* b = (const float*)(p.ln_b + l * DM);
  bf16_t* xb = (bf16_t*)(p.ws + OFF_XB);
  const int r0 = rbase + w * 8;
  u32x2 raw[8][4];
#pragma unroll
  for (int i = 0; i < 8; ++i)
#pragma unroll
    for (int j = 0; j < 4; ++j) raw[i][j] = __builtin_nontemporal_load((const u32x2*)((const bf16_t*)(p.ws + OFF_OBUF) + (size_t)(r0 + i) * DM) + j * 64 + lane);
  f32x4 gg[4], bb[4];
#pragma unroll
  for (int j = 0; j < 4; ++j) { gg[j] = ((const f32x4*)g)[j * 64 + lane]; bb[j] = ((const f32x4*)b)[j * 64 + lane]; }
#pragma unroll
  for (int i = 0; i < 8; ++i) {
    const int row = hf * TH + r0 + i;
    f32x4 v[4];
#pragma unroll
    for (int j = 0; j < 4; ++j) { const u32x2 r = raw[i][j]; v[j] = (f32x4){__uint_as_float(r.x << 16), __uint_as_float(r.x & 0xffff0000u), __uint_as_float(r.y << 16), __uint_as_float(r.y & 0xffff0000u)}; }
    float sm = 0.f;
#pragma unroll
    for (int j = 0; j < 4; ++j) sm += (v[j][0] + v[j][1]) + (v[j][2] + v[j][3]);
#pragma unroll
    for (int o = 32; o >= 1; o >>= 1) sm += __shfl_xor(sm, o);
    const float mu = sm * (1.f / DM);
    float q = 0.f;
#pragma unroll
    for (int j = 0; j < 4; ++j) { const f32x4 d = v[j] - mu; q += (d[0] * d[0] + d[1] * d[1]) + (d[2] * d[2] + d[3] * d[3]); }
#pragma unroll
    for (int o = 32; o >= 1; o >>= 1) q += __shfl_xor(q, o);
    const float rstd = rsqrtf(q * (1.f / DM) + 1e-5f);
#pragma unroll
    for (int j = 0; j < 4; ++j) {
      const f32x4 o = (v[j] - mu) * rstd * gg[j] + bb[j];
      if (l == 0) *(uint2*)(xb + (size_t)row * DM + (j * 64 + lane) * 4) = make_uint2(pk2(o[0], o[1]), pk2(o[2], o[3]));
      else __builtin_nontemporal_store(o, (f32x4*)(p.out + (size_t)row * DM) + j * 64 + lane);
    }
  }
}
DEV void phase_ln(const ParamsG& p, int l, int hf) {
  for (int rb = blockIdx.x * 32; rb < TH; rb += gridDim.x * 32) ln_block(p, l, hf, rb);
}

DEV void attn_item(const ParamsG& p, int l, int item, unsigned* ctr, unsigned char* smem) {
  const int tid = launder(threadIdx.x), lane = tid & 63, w = tid >> 6, r = lane & 31, h = lane >> 5;
  const int qt = item & 15, head = (item >> 4) & 7, bl = item >> 7;
  const int kvh = head >> 2;
  bf16_t* Hh = (bf16_t*)(p.ws + OFF_H);
  const bf16_t* VT = (const bf16_t*)(p.ws + OFF_VT);
  const size_t rowbase = (size_t)bl * SEQ;
  float mq = fabsf(p.q_gain[l * 64 + lane]), mk = fabsf(p.k_gain[l * 64 + lane]);
#pragma unroll
  for (int o = 32; o >= 1; o >>= 1) { mq = fmaxf(mq, __shfl_xor(mq, o)); mk = fmaxf(mk, __shfl_xor(mk, o)); }
  const float M2 = 8.f * mq * mk * LOG2E * 1.01f;
  const int qrow = qt * 256 + w * 32 + r;
  const bf16_t* qp = Hh + (rowbase + qrow) * NPAD + A_Q + head * 64 + 8 * h;
  bf16x8 qf[4];
  {
    bf16x8 qr[4];
#pragma unroll
    for (int ks = 0; ks < 4; ++ks) qr[ks] = *(const bf16x8*)(qp + ks * 16);
    const float2* tab = (const float2*)(p.ws + OFF_TAB);
    const int t = qrow;
    f32x4 c1[4], c2[4];
#pragma unroll
    for (int j = 0; j < 4; ++j) { c1[j] = *(const f32x4*)(tab + (t >> 6) * 16 + 8 * h + 2 * j); c2[j] = *(const f32x4*)(tab + (t & 63) * 16 + 8 * h + 2 * j); }
    float gq8[4][8];
#pragma unroll
    for (int ks = 0; ks < 4; ++ks) {
      const f32x4 ga = *(const f32x4*)(p.q_gain + l * 64 + ks * 16 + 8 * h), gb = *(const f32x4*)(p.q_gain + l * 64 + ks * 16 + 8 * h + 4);
#pragma unroll
      for (int j = 0; j < 4; ++j) { gq8[ks][j] = ga[j]; gq8[ks][4 + j] = gb[j]; }
    }
    float xv[4][8]; float ss = 0.f;
#pragma unroll
    for (int ks = 0; ks < 4; ++ks)
#pragma unroll
      for (int j = 0; j < 8; ++j) { xv[ks][j] = bf2f((bf16_t)qr[ks][j]); ss += xv[ks][j] * xv[ks][j]; }
    ss += __shfl_xor(ss, 32);
    const float rs = rsqrtf(ss * (1.f / 64.f) + 1e-6f);
#pragma unroll
    for (int ks = 0; ks < 4; ++ks)
#pragma unroll
      for (int j = 0; j < 8; ++j) xv[ks][j] *= rs * gq8[ks][j];
#pragma unroll
    for (int pr = 0; pr < 2; ++pr) {
      float lo[8], hi[8];
#pragma unroll
      for (int j = 0; j < 8; ++j) {
        const f32x4 cc = pr ? c2[j >> 1] : c1[j >> 1];
        const float cs = (j & 1) ? cc[2] : cc[0], sn = (j & 1) ? cc[3] : cc[1];
        const float a = xv[2 * pr][j], b = xv[2 * pr + 1][j];
        lo[j] = (a * cs - b * sn) * QSCALE; hi[j] = (b * cs + a * sn) * QSCALE;
      }
      const u32x4 plo = (u32x4){pk2(lo[0], lo[1]), pk2(lo[2], lo[3]), pk2(lo[4], lo[5]), pk2(lo[6], lo[7])}, phi = (u32x4){pk2(hi[0], hi[1]), pk2(hi[2], hi[3]), pk2(hi[4], hi[5]), pk2(hi[6], hi[7])};
      qf[2 * pr] = __builtin_bit_cast(bf16x8, plo); qf[2 * pr + 1] = __builtin_bit_cast(bf16x8, phi);
    }
  }
  f32x16 o0 = zero16(), o1 = zero16();
  f32x2_t lsum2 = {0.f, 0.f};
  const int srow = tid >> 3, sch = (tid & 7) * 8, vpos = 16 * ((tid & 7) >> 1) + 4 * (tid & 1);
  const bf16_t* kp = Hh + (rowbase + srow) * NPAD + A_K + kvh * 64 + sch;
  const bf16_t* vp = VT + ((size_t)((bl * 2 + kvh) * 64 + srow)) * SEQ + sch;
  union PB { bf16x8 v; unsigned u[4]; };
  auto qk = [&](int st, f32x16& s0, f32x16& s1) __attribute__((always_inline)) {
    const bf16_t* sK = (const bf16_t*)(smem + st * 18432);
#pragma unroll
    for (int i = 0; i < 16; ++i) { s0[i] = -M2; s1[i] = -M2; }
    bf16x8 a0[4], a1[4];
#pragma unroll
    for (int ks = 0; ks < 4; ++ks) { a0[ks] = *(const bf16x8*)(sK + r * 72 + ks * 16 + 8 * h); a1[ks] = *(const bf16x8*)(sK + (32 + r) * 72 + ks * 16 + 8 * h); }
    __builtin_amdgcn_sched_barrier(0);
#pragma unroll
    for (int ks = 0; ks < 4; ++ks) {
      s0 = __builtin_amdgcn_mfma_f32_32x32x16_bf16(a0[ks], qf[ks], s0, 0, 0, 0);
      s1 = __builtin_amdgcn_mfma_f32_32x32x16_bf16(a1[ks], qf[ks], s1, 0, 0, 0);
    }
  };
  auto soft = [&](f32x16& s0, f32x16& s1, PB (&pb)[2][2]) __attribute__((always_inline)) {
#pragma unroll
    for (int i = 0; i < 16; ++i) { s0[i] = __builtin_amdgcn_exp2f(s0[i]); s1[i] = __builtin_amdgcn_exp2f(s1[i]); lsum2 += (f32x2_t){s0[i], s1[i]}; }
#pragma unroll
    for (int s = 0; s < 2; ++s)
#pragma unroll
      for (int j = 0; j < 4; ++j) {
        pb[0][s].u[j] = pk2(s0[8 * s + 2 * j], s0[8 * s + 2 * j + 1]);
        pb[1][s].u[j] = pk2(s1[8 * s + 2 * j], s1[8 * s + 2 * j + 1]);
      }
  };
  auto pv = [&](int st, const PB (&pb)[2][2]) __attribute__((always_inline)) {
    const bf16_t* sV = (const bf16_t*)(smem + st * 18432 + 9216);
    union VF { bf16x8 v; uint2 u[2]; };
    VF a0[2][2], a1[2][2];
#pragma unroll
    for (int kt2 = 0; kt2 < 2; ++kt2)
#pragma unroll
      for (int s = 0; s < 2; ++s) {
        const int kb = kt2 * 32 + 16 * s + 8 * h;
        a0[kt2][s].v = *(const bf16x8*)(sV + r * 72 + kb);
        a1[kt2][s].v = *(const bf16x8*)(sV + (32 + r) * 72 + kb);
      }
    __builtin_amdgcn_sched_barrier(0);
#pragma unroll
    for (int kt2 = 0; kt2 < 2; ++kt2)
#pragma unroll
      for (int s = 0; s < 2; ++s) {
        o0 = __builtin_amdgcn_mfma_f32_32x32x16_bf16(a0[kt2][s].v, pb[kt2][s].v, o0, 0, 0, 0);
        o1 = __builtin_amdgcn_mfma_f32_32x32x16_bf16(a1[kt2][s].v, pb[kt2][s].v, o1, 0, 0, 0);
      }
  };
  auto compute2 = [&](int sta, int stb) __attribute__((always_inline)) {
    f32x16 sa0, sa1, sb0, sb1; PB pa[2][2], pbb[2][2];
    qk(sta, sa0, sa1); qk(stb, sb0, sb1);
    soft(sa0, sa1, pa); pv(sta, pa);
    soft(sb0, sb1, pbb); pv(stb, pbb);
  };
  constexpr int NKT = SEQ / 64;
  auto sstore = [&](int st, const u32x4& kk, const u32x4& vv) __attribute__((always_inline)) {
    *(u32x4*)(smem + st * 18432 + srow * 144 + sch * 2) = kk;
    *(uint2*)(smem + st * 18432 + 9216 + srow * 144 + vpos * 2) = make_uint2(vv.x, vv.y);
    *(uint2*)(smem + st * 18432 + 9216 + srow * 144 + vpos * 2 + 16) = make_uint2(vv.z, vv.w);
  };
  int nxt = 0;
  u32x4 k0 = *(const u32x4*)kp, v0 = *(const u32x4*)vp;
  u32x4 k1 = *(const u32x4*)(kp + (size_t)64 * NPAD), v1 = *(const u32x4*)(vp + 64);
  sstore(0, k0, v0); sstore(1, k1, v1);
  k0 = *(const u32x4*)(kp + (size_t)2 * 64 * NPAD); v0 = *(const u32x4*)(vp + 2 * 64);
  k1 = *(const u32x4*)(kp + (size_t)3 * 64 * NPAD); v1 = *(const u32x4*)(vp + 3 * 64);
  lds_barrier();
  for (int kt = 0; kt < NKT; kt += 4) {
    sstore(2, k0, v0); sstore(3, k1, v1);
    if (kt + 4 >= NKT && tid == 0) nxt = (int)atomicAdd(ctr, 1u);
    if (kt + 4 < NKT) {
      k0 = *(const u32x4*)(kp + (size_t)(kt + 4) * 64 * NPAD); v0 = *(const u32x4*)(vp + (kt + 4) * 64);
      k1 = *(const u32x4*)(kp + (size_t)(kt + 5) * 64 * NPAD); v1 = *(const u32x4*)(vp + (kt + 5) * 64);
    }
    compute2(0, 1);
    lds_barrier();
    if (kt + 4 < NKT) {
      sstore(0, k0, v0); sstore(1, k1, v1);
      if (kt + 6 < NKT) {
        k0 = *(const u32x4*)(kp + (size_t)(kt + 6) * 64 * NPAD); v0 = *(const u32x4*)(vp + (kt + 6) * 64);
        k1 = *(const u32x4*)(kp + (size_t)(kt + 7) * 64 * NPAD); v1 = *(const u32x4*)(vp + (kt + 7) * 64);
      }
    }
    compute2(2, 3);
    lds_barrier();
  }
  float lsum = lsum2[0] + lsum2[1];
  lsum += __shfl_xor(lsum, 32);
  const float inv = 1.f / lsum;
  const bf16_t* zp = Hh + (rowbase + qrow) * NPAD + A_Z + head * 64;
  bf16_t* op = (bf16_t*)(p.ws + OFF_AO) + (rowbase + qrow) * 512 + head * 64;
#pragma unroll
  for (int dt = 0; dt < 2; ++dt)
#pragma unroll
    for (int g = 0; g < 4; ++g) {
      const int d0 = dt * 32 + 8 * g + 4 * h;
      const uint2 zz = *(const uint2*)(zp + d0);
      const float z0 = bf2f((bf16_t)(zz.x & 0xffff)), z1 = bf2f((bf16_t)(zz.x >> 16)), z2 = bf2f((bf16_t)(zz.y & 0xffff)), z3 = bf2f((bf16_t)(zz.y >> 16));
      const f32x16& oo = dt ? o1 : o0;
      uint2 ov;
      ov.x = pk2(oo[4 * g + 0] * inv * fsilu(z0), oo[4 * g + 1] * inv * fsilu(z1));
      ov.y = pk2(oo[4 * g + 2] * inv * fsilu(z2), oo[4 * g + 3] * inv * fsilu(z3));
      *(uint2*)(op + d0) = ov;
    }
  if (tid == 0) ((volatile int*)(smem + LDS_BYTES - 16))[1] = nxt;
  lds_barrier();
}

constexpr int L_QT = 0, L_KT = 17408, L_QC = 34816, L_KHT = 52224, L_VT = 70656, L_ST = 89088,
              L_D = 123904, L_TOT = 124416, L_ACS = 128512, L_DT = 129024, L_ACS8 = 129536, L_DT8 = 131584;

template <int K, int V> struct ScanGeom {
  static constexpr int KP = K + 8;
  static constexpr int NS = (K / 32) * (V / 32) / 8;
};

template <int K, int V>
DEV void scan_write_state(unsigned char* smem, const f32x16* S, int w, int lane) {
  constexpr int KP = K + 8, NS = ScanGeom<K, V>::NS, NVT = V / 32;
  bf16_t* sST = (bf16_t*)(smem + L_ST);
  const int c = lane & 31, h = lane >> 5;
#pragma unroll
  for (int i = 0; i < NS; ++i) {
    const int tile = w * NS + i, kt = tile / NVT, nt = tile % NVT;
#pragma unroll
    for (int g = 0; g < 4; ++g) {
      uint2 o; o.x = pk2(S[i][4 * g + 0], S[i][4 * g + 1]); o.y = pk2(S[i][4 * g + 2], S[i][4 * g + 3]);
      *(uint2*)(sST + (nt * 32 + c) * KP + kt * 32 + 8 * g + 4 * h) = o;
    }
  }
}

template <int K, int V, bool SSDM>
DEV void scan_core(unsigned char* smem, f32x16* S, bf16_t* orow0, int dir, int w, int lane, bool do_out, const float* sAcs) {
  constexpr int KP = K + 8, NS = ScanGeom<K, V>::NS, NVT = V / 32, NOT = 2 * NVT;
  const bf16_t* sQt = (const bf16_t*)(smem + L_QT); const bf16_t* sKt = (const bf16_t*)(smem + L_KT);
  const bf16_t* sQc = (const bf16_t*)(smem + L_QC); const bf16_t* sKhT = (const bf16_t*)(smem + L_KHT);
  const bf16_t* sVT = (const bf16_t*)(smem + L_VT);
  const bf16_t* sST = (const bf16_t*)(smem + L_ST); const float* sD = (const float*)(smem + L_D);
  const int c = lane & 31, h = lane >> 5;
  if (do_out && w < NOT) {
    const int tt = w / NVT, nt = w % NVT;
    f32x16 acc = zero16();
    union VB { bf16x8 v; uint2 u[2]; };
    VB vbf[2][2];
#pragma unroll
    for (int st = 0; st < 2; ++st)
#pragma unroll
      for (int s2 = 0; s2 < 2; ++s2) {
        const int kb = st * 32 + 16 * s2 + 4 * h;
        vbf[st][s2].u[0] = *(const uint2*)(sVT + (nt * 32 + c) * 72 + kb); vbf[st][s2].u[1] = *(const uint2*)(sVT + (nt * 32 + c) * 72 + kb + 8);
      }
#pragma unroll
    for (int st = 0; st < 2; ++st) {
      if (st <= tt) {
        f32x16 pt = mma32z<K>(sKt + st * 32 * KP, KP, sQt + tt * 32 * KP, KP, lane);
        const int tau = tt * 32 + c;
        const float at = SSDM ? sAcs[tau] : 0.f;
        f32x4 asg[4];
#pragma unroll
        for (int g = 0; g < 4; ++g) asg[g] = SSDM ? *(const f32x4*)(sAcs + st * 32 + 8 * g + 4 * h) : (f32x4){0.f, 0.f, 0.f, 0.f};
#pragma unroll
        for (int reg = 0; reg < 16; ++reg) {
          const int sig = st * 32 + rowoff(reg, h);
          float v = pt[reg];
          if (SSDM) v *= ex2(at - asg[reg >> 2][reg & 3]);
          pt[reg] = (sig <= tau) ? v : 0.f;
        }
#pragma unroll
        for (int s2 = 0; s2 < 2; ++s2) {
          union { bf16x8 v; unsigned u[4]; } pa;
#pragma unroll
          for (int j = 0; j < 4; ++j) pa.u[j] = pk2(pt[8 * s2 + 2 * j], pt[8 * s2 + 2 * j + 1]);
          acc = __builtin_amdgcn_mfma_f32_32x32x16_bf16(pa.v, vbf[st][s2].v, acc, 0, 0, 0);
        }
      }
    }
    mma32<K>(acc, sQc + tt * 32 * KP, KP, sST + nt * 32 * KP, KP, lane);
    {
      const int l1 = lane & 1, l2 = (lane >> 1) & 1;
#pragma unroll
      for (int g = 0; g < 4; ++g) {
        const float a0 = acc[4 * g], a1 = acc[4 * g + 1], a2 = acc[4 * g + 2], a3 = acc[4 * g + 3];
        const float n0 = __builtin_bit_cast(float, __builtin_amdgcn_update_dpp(0, __builtin_bit_cast(int, a0), 0xB1, 0xF, 0xF, false));
        const float n1 = __builtin_bit_cast(float, __builtin_amdgcn_update_dpp(0, __builtin_bit_cast(int, a1), 0xB1, 0xF, 0xF, false));
        const float n2 = __builtin_bit_cast(float, __builtin_amdgcn_update_dpp(0, __builtin_bit_cast(int, a2), 0xB1, 0xF, 0xF, false));
        const float n3 = __builtin_bit_cast(float, __builtin_amdgcn_update_dpp(0, __builtin_bit_cast(int, a3), 0xB1, 0xF, 0xF, false));
        const unsigned A = l1 ? pk2(n1, a1) : pk2(a0, n0);
        const unsigned B = l1 ? pk2(n3, a3) : pk2(a2, n2);
        const unsigned send = l2 ? A : B, keep = l2 ? B : A;
        const unsigned recv = (unsigned)__builtin_amdgcn_update_dpp(0, (int)send, 0x4E, 0xF, 0xF, false);
        const int tau = tt * 32 + 8 * g + 4 * h + 2 * l2 + l1;
        const int tok = dir ? (63 - tau) : tau;
        *(uint2*)(orow0 + (size_t)tok * 512 + nt * 32 + 4 * (c >> 2)) = l2 ? make_uint2(recv, keep) : make_uint2(keep, recv);
      }
    }
  }
  {
    const int kt = (w * NS) / NVT;
    f32x4 dv[4];
#pragma unroll
    for (int g = 0; g < 4; ++g) dv[g] = *(const f32x4*)(sD + kt * 32 + 8 * g + 4 * h);
#pragma unroll
    for (int i = 0; i < NS; ++i) {
      const int nt = (w * NS + i) % NVT;
      const bf16_t* ap = sKhT + kt * 32 * 72 + c * 72 + 8 * h;
      const bf16_t* bp = sVT + nt * 32 * 72 + c * 72 + 8 * h;
      bf16x8 av[4], bv[4];
#pragma unroll
      for (int j = 0; j < 4; ++j) { av[j] = *(const bf16x8*)(ap + 16 * j); bv[j] = *(const bf16x8*)(bp + 16 * j); }
      __builtin_amdgcn_sched_barrier(0);
#pragma unroll
      for (int reg = 0; reg < 16; ++reg) S[i][reg] *= dv[reg >> 2][reg & 3];
#pragma unroll
      for (int j = 0; j < 4; ++j) S[i] = __builtin_amdgcn_mfma_f32_32x32x16_bf16(av[j], bv[j], S[i], 0, 0, 0);
    }
  }
}

DEV void store_tile(const f32x16& acc, bf16_t* orow0, int tt, int nt, int dir, int lane) {
  const int c = lane & 31, h = lane >> 5, l1 = lane & 1, l2 = (lane >> 1) & 1;
#pragma unroll
  for (int g = 0; g < 4; ++g) {
    const float a0 = acc[4 * g], a1 = acc[4 * g + 1], a2 = acc[4 * g + 2], a3 = acc[4 * g + 3];
    const float n0 = __builtin_bit_cast(float, __builtin_amdgcn_update_dpp(0, __builtin_bit_cast(int, a0), 0xB1, 0xF, 0xF, false));
    const float n1 = __builtin_bit_cast(float, __builtin_amdgcn_update_dpp(0, __builtin_bit_cast(int, a1), 0xB1, 0xF, 0xF, false));
    const float n2 = __builtin_bit_cast(float, __builtin_amdgcn_update_dpp(0, __builtin_bit_cast(int, a2), 0xB1, 0xF, 0xF, false));
    const float n3 = __builtin_bit_cast(float, __builtin_amdgcn_update_dpp(0, __builtin_bit_cast(int, a3), 0xB1, 0xF, 0xF, false));
    const unsigned A = l1 ? pk2(n1, a1) : pk2(a0, n0);
    const unsigned B = l1 ? pk2(n3, a3) : pk2(a2, n2);
    const unsigned send = l2 ? A : B, keep = l2 ? B : A;
    const unsigned recv = (unsigned)__builtin_amdgcn_update_dpp(0, (int)send, 0x4E, 0xF, 0xF, false);
    const int tau = tt * 32 + 8 * g + 4 * h + 2 * l2 + l1;
    const int tok = dir ? (63 - tau) : tau;
    *(uint2*)(orow0 + (size_t)tok * 512 + nt * 32 + 4 * (c >> 2)) = l2 ? make_uint2(recv, keep) : make_uint2(keep, recv);
  }
}
constexpr int L_PART = L_ST + 17408;
DEV void scan_core_split(unsigned char* smem, f32x16* S, f32x16& accA, int w, int lane, const float* sAcs, const float* sDt, float dsk) {
  constexpr int K = 128, V = 64, KP = K + 8, NVT = 2;
  const bf16_t* sQt = (const bf16_t*)(smem + L_QT); const bf16_t* sKt = (const bf16_t*)(smem + L_KT);
  const bf16_t* sQc = (const bf16_t*)(smem + L_QC); const bf16_t* sKhT = (const bf16_t*)(smem + L_KHT);
  const bf16_t* sVT = (const bf16_t*)(smem + L_VT);
  const bf16_t* sST = (const bf16_t*)(smem + L_ST); const float* sD = (const float*)(smem + L_D);
  const int c = lane & 31, h = lane >> 5;
  {
    const int part = w >> 2, tile = w & 3, tt = tile / NVT, nt = tile % NVT, st = part;
    f32x16 acc = zero16();
    if (st <= tt) {
      union VB { bf16x8 v; uint2 u[2]; };
      VB vbf[2];
#pragma unroll
      for (int s2 = 0; s2 < 2; ++s2) {
        const int kb = st * 32 + 16 * s2 + 4 * h;
        vbf[s2].u[0] = *(const uint2*)(sVT + (nt * 32 + c) * 72 + kb); vbf[s2].u[1] = *(const uint2*)(sVT + (nt * 32 + c) * 72 + kb + 8);
      }
      f32x16 pt = mma32z<K>(sKt + st * 32 * KP, KP, sQt + tt * 32 * KP, KP, lane);
      const int tau = tt * 32 + c;
      const float at = sAcs[tau];
      f32x4 asg[4];
#pragma unroll
      for (int g = 0; g < 4; ++g) asg[g] = *(const f32x4*)(sAcs + st * 32 + 8 * g + 4 * h);
      const float ddiag = (st == tt) ? dsk * frcp(sDt[tau]) : 0.f;
#pragma unroll
      for (int reg = 0; reg < 16; ++reg) {
        const int sig = st * 32 + rowoff(reg, h);
        const float v = pt[reg] * ex2(at - asg[reg >> 2][reg & 3]);
        pt[reg] = (sig < tau) ? v : ((sig == tau) ? v + ddiag : 0.f);
      }
#pragma unroll
      for (int s2 = 0; s2 < 2; ++s2) {
        union { bf16x8 v; unsigned u[4]; } pa;
#pragma unroll
        for (int j = 0; j < 4; ++j) pa.u[j] = pk2(pt[8 * s2 + 2 * j], pt[8 * s2 + 2 * j + 1]);
        acc = __builtin_amdgcn_mfma_f32_32x32x16_bf16(pa.v, vbf[s2].v, acc, 0, 0, 0);
      }
    }
    mma32<64>(acc, sQc + tt * 32 * KP + 64 * part, KP, sST + nt * 32 * KP + 64 * part, KP, lane);
    if (part) {
      float* sp = (float*)(smem + L_PART) + tile * 1024 + lane;
#pragma unroll
      for (int reg = 0; reg < 16; ++reg) sp[reg * 64] = acc[reg];
    } else accA = acc;
  }
  {
    const int kt = w / NVT, nt = w % NVT;
    f32x4 dv[4];
#pragma unroll
    for (int g = 0; g < 4; ++g) dv[g] = *(const f32x4*)(sD + kt * 32 + 8 * g + 4 * h);
    const bf16_t* ap = sKhT + kt * 32 * 72 + c * 72 + 8 * h;
    const bf16_t* bp = sVT + nt * 32 * 72 + c * 72 + 8 * h;
    bf16x8 av[4], bv[4];
#pragma unroll
    for (int j = 0; j < 4; ++j) { av[j] = *(const bf16x8*)(ap + 16 * j); bv[j] = *(const bf16x8*)(bp + 16 * j); }
    __builtin_amdgcn_sched_barrier(0);
#pragma unroll
    for (int reg = 0; reg < 16; ++reg) S[0][reg] *= dv[reg >> 2][reg & 3];
#pragma unroll
    for (int j = 0; j < 4; ++j) S[0] = __builtin_amdgcn_mfma_f32_32x32x16_bf16(av[j], bv[j], S[0], 0, 0, 0);
  }
}
DEV void scan_finish_split(unsigned char* smem, const f32x16& accA, bf16_t* orow0, int dir, int w, int lane) {
  if (w < 4) {
    const float* sp = (const float*)(smem + L_PART) + w * 1024 + lane;
    f32x16 acc;
#pragma unroll
    for (int reg = 0; reg < 16; ++reg) acc[reg] = sp[reg * 64];
    __builtin_amdgcn_sched_barrier(0);
#pragma unroll
    for (int reg = 0; reg < 16; ++reg) acc[reg] += accA[reg];
    store_tile(acc, orow0, w >> 1, w & 1, dir, lane);
  }
}

template <int K, int V>
DEV void state_store(bf16_t* buf, const f32x16* S, int w, int lane) {
  constexpr int NS = ScanGeom<K, V>::NS, NVT = V / 32;
  const int c = lane & 31, h = lane >> 5;
#pragma unroll
  for (int i = 0; i < NS; ++i) {
    const int tile = w * NS + i, kt = tile / NVT, nt = tile % NVT;
    (void)kt; (void)nt; (void)c; (void)h;
    bf16_t* q = buf + ((size_t)tile * 64 + lane) * 16;
    *(u32x4*)q = (u32x4){pk2(S[i][0], S[i][1]), pk2(S[i][2], S[i][3]), pk2(S[i][4], S[i][5]), pk2(S[i][6], S[i][7])};
    *(u32x4*)(q + 8) = (u32x4){pk2(S[i][8], S[i][9]), pk2(S[i][10], S[i][11]), pk2(S[i][12], S[i][13]), pk2(S[i][14], S[i][15])};
  }
}
template <int K, int V>
DEV void state_load(const float* buf, f32x16* S, int w, int lane) {
  constexpr int NS = ScanGeom<K, V>::NS, NVT = V / 32;
  const int c = lane & 31, h = lane >> 5;
#pragma unroll
  for (int i = 0; i < NS; ++i) {
    const int tile = w * NS + i, kt = tile / NVT, nt = tile % NVT;
#pragma unroll
    for (int reg = 0; reg < 16; ++reg) S[i][reg] = buf[(kt * 32 + rowoff(reg, h)) * V + nt * 32 + c];
  }
}

template <int K, int V>
DEV void state_combine(const bf16_t* ubase, int ustride, const float* dbase, int seg, f32x16* S, int w, int lane) {
  constexpr int NS = ScanGeom<K, V>::NS, NVT = V / 32;
  const int c = lane & 31, h = lane >> 5;
  for (int j = 0; j < seg; ++j) {
    const bf16_t* buf = ubase + (size_t)j * ustride;
    const float* dj = dbase + j * 128;
    float u[NS][16]; f32x4 dv[NS][4];
#pragma unroll
    for (int i = 0; i < NS; ++i) {
      const int tile = w * NS + i, kt = tile / NVT;
#pragma unroll
      for (int g = 0; g < 4; ++g) dv[i][g] = *(const f32x4*)(dj + kt * 32 + 8 * g + 4 * h);
      const bf16_t* q = buf + ((size_t)tile * 64 + lane) * 16;
      const u32x4 q0 = *(const u32x4*)q, q1 = *(const u32x4*)(q + 8);
#pragma unroll
      for (int k2 = 0; k2 < 4; ++k2) { u[i][2 * k2] = lo16(q0[k2]); u[i][2 * k2 + 1] = hi16(q0[k2]); u[i][8 + 2 * k2] = lo16(q1[k2]); u[i][8 + 2 * k2 + 1] = hi16(q1[k2]); }
    }
#pragma unroll
    for (int i = 0; i < NS; ++i)
#pragma unroll
      for (int reg = 0; reg < 16; ++reg) S[i][reg] = (j > 0 ? dv[i][reg >> 2][reg & 3] * S[i][reg] : 0.f) + u[i][reg];
  }
}

#define PACK8_LO(v) (u32x4){((v)[0] & 0xffffu) | ((v)[1] << 16), ((v)[2] & 0xffffu) | ((v)[3] << 16), ((v)[4] & 0xffffu) | ((v)[5] << 16), ((v)[6] & 0xffffu) | ((v)[7] << 16)}
#define PACK8_HI(v) (u32x4){((v)[0] >> 16) | ((v)[1] & 0xffff0000u), ((v)[2] >> 16) | ((v)[3] & 0xffff0000u), ((v)[4] >> 16) | ((v)[5] & 0xffff0000u), ((v)[6] >> 16) | ((v)[7] & 0xffff0000u)}
#define CVT8(f) (u32x4){pk2((f)[0], (f)[1]), pk2((f)[2], (f)[3]), pk2((f)[4], (f)[5]), pk2((f)[6], (f)[7])}


template <bool DO_OUT>
DEV void hgrn_item(const ParamsG& p, int l, int it, int seg, unsigned* ctr, unsigned char* smem) {
  const int bl = it >> 3, head = (it >> 1) & 3, dir = it & 1;
  constexpr bool do_out = DO_OUT;
  int nxt = 0;
  constexpr int K = 128, V = 128, KPW = 68;
  const int tid = launder(threadIdx.x), lane = tid & 63, w = tid >> 6;
  const int cp = tid & 63, tg = tid >> 6, ch0 = 2 * cp;
  const bf16_t* Hh = (const bf16_t*)(p.ws + OFF_H);
  bf16_t* OB = (bf16_t*)(p.ws + OFF_OBUF) + (size_t)(0 * 2 + dir) * TH * 512;
  const size_t rowbase = (size_t)bl * SEQ;
  float lb0 = 0.f, lb1 = 0.f;
  if (l > 0) {
    lb0 = fsigmoid(p.lb_logits[512 + head * 128 + ch0] - p.lb_logits[head * 128 + ch0]);
    lb1 = fsigmoid(p.lb_logits[512 + head * 128 + ch0 + 1] - p.lb_logits[head * 128 + ch0 + 1]);
  }
  const float om0 = 1.f - lb0, om1 = 1.f - lb1;
  const int fbase = dir ? H_FB : H_FF;
  unsigned* sQt = (unsigned*)(smem + L_QT); unsigned* sKt = (unsigned*)(smem + L_KT); unsigned* sQc = (unsigned*)(smem + L_QC);
  bf16_t* sKhT = (bf16_t*)(smem + L_KHT); bf16_t* sVT = (bf16_t*)(smem + L_VT);
  float* sD = (float*)(smem + L_D); float* sTot = (float*)(smem + L_TOT);
  f32x16 S[2]; S[0] = zero16(); S[1] = zero16();
  bf16_t* sbuf = (bf16_t*)(p.ws + OFF_SB0) + ((size_t)it * NSEG + seg) * 16384;
  if (do_out) state_combine<K, V>((const bf16_t*)(p.ws + OFF_SB0) + (size_t)it * NSEG * 16384, 16384, (const float*)(p.ws + OFF_DB) + (size_t)it * NSEG * 128, seg, S, w, lane);
  float dlog0 = 1.f, dlog1 = 1.f;
  unsigned pf[8], qq[8], vv[8];
  float g0[8], g1[8], kx0[8], kx1[8];
  auto gloadA = [&](int cidx) __attribute__((always_inline)) {
    const int chunk = dir ? (63 - cidx) : cidx;
#pragma unroll
    for (int i = 0; i < 8; ++i) {
      const int tau = 8 * tg + i;
      const int tok = chunk * 64 + (dir ? (63 - tau) : tau);
      pf[i] = ((const unsigned*)(Hh + (rowbase + tok) * NPAD + head * 128 + fbase))[cp];
    }
  };
  auto gloadB = [&](int cidx) __attribute__((always_inline)) {
    const int chunk = dir ? (63 - cidx) : cidx;
#pragma unroll
    for (int i = 0; i < 8; ++i) {
      const int tau = 8 * tg + i;
      const int tok = chunk * 64 + (dir ? (63 - tau) : tau);
      const unsigned* rp = (const unsigned*)(Hh + (rowbase + tok) * NPAD + head * 128) + cp;
      vv[i] = rp[H_I / 2];
      qq[i] = do_out ? rp[H_Q / 2] : 0u;
    }
  };
  auto stage1 = [&]() __attribute__((always_inline)) {
#pragma unroll
    for (int i = 0; i < 8; ++i) {
      const float e0 = ex2(fminf(-lo16(pf[i]) * LOG2E, 80.f)), e1 = ex2(fminf(-hi16(pf[i]) * LOG2E, 80.f));
      const float s0 = frcp(1.f + e0), s1 = frcp(1.f + e1);
      g0[i] = lb0 + om0 * s0; g1[i] = lb1 + om1 * s1;
      kx0[i] = om0 * e0 * s0; kx1[i] = om1 * e1 * s1;
    }
    float r0 = 1.f, r1 = 1.f;
    if (do_out) {
#pragma unroll
      for (int i = 0; i < 8; ++i) { r0 *= g0[i]; r1 *= g1[i]; g0[i] = r0; g1[i] = r1; }
    } else {
#pragma unroll
      for (int i = 7; i >= 0; --i) { const float t0 = g0[i], t1 = g1[i]; g0[i] = r0; g1[i] = r1; r0 *= t0; r1 *= t1; }
    }
    *(float2*)(sTot + tg * 128 + ch0) = make_float2(r0, r1);
  };
  gloadA(seg * SLEN); gloadB(seg * SLEN);
  stage1();
  if (SLEN > 1) gloadA(seg * SLEN + 1);
  for (int ci = 0; ci < SLEN; ++ci) {
    const int cidx = seg * SLEN + ci;
    const int chunk = dir ? (63 - cidx) : cidx;
    lds_barrier();
    if (ci == SLEN - 1 && tid == 0) nxt = (int)atomicAdd(ctr, 1u);
    float eref0 = 1.f, eref1 = 1.f, ebr0 = 1.f, ebr1 = 1.f, d0 = 1.f, d1 = 1.f;
    {
      float lo0 = 1.f, lo1 = 1.f;
      float2 tl[4];
#pragma unroll
      for (int j = 0; j < 4; ++j) tl[j] = *(const float2*)(sTot + j * 128 + ch0);
      __builtin_amdgcn_sched_barrier(0);
#pragma unroll
      for (int j = 0; j < 4; ++j) {
        eref0 *= tl[j].x; eref1 *= tl[j].y;
        if (do_out) { if (j >= tg) { lo0 *= tl[j].x; lo1 *= tl[j].y; } } else { if (j > tg) { d0 *= tl[j].x; d1 *= tl[j].y; } }
      }
#pragma unroll
      for (int j = 0; j < 4; ++j) tl[j] = *(const float2*)(sTot + (4 + j) * 128 + ch0);
      __builtin_amdgcn_sched_barrier(0);
#pragma unroll
      for (int j = 0; j < 4; ++j) {
        ebr0 *= tl[j].x; ebr1 *= tl[j].y;
        if (do_out) { if (4 + j < tg) { d0 *= tl[j].x; d1 *= tl[j].y; } } else { if (4 + j > tg) { d0 *= tl[j].x; d1 *= tl[j].y; } }
      }
      if (do_out) { d0 *= frcp(lo0); d1 *= frcp(lo1); }
    }
    const float be0 = eref0 * ebr0, be1 = eref1 * ebr1;
    dlog0 *= be0; dlog1 *= be1;
    float kh0[8], kh1[8];
    if (do_out) {
#pragma unroll
      for (int i = 0; i < 8; ++i) {
        const int tau = 8 * tg + i;
        const float E0 = g0[i] * d0, E1 = g1[i] * d1;
        const float kt0 = kx0[i] * frcp(E0), kt1 = kx1[i] * frcp(E1);
        const float qt0 = lo16(qq[i]) * E0, qt1 = hi16(qq[i]) * E1;
        sQt[tau * KPW + cp] = pk2(qt0, qt1);
        sKt[tau * KPW + cp] = pk2(kt0, kt1);
        sQc[tau * KPW + cp] = pk2(qt0 * eref0, qt1 * eref1);
        kh0[i] = kt0 * ebr0; kh1[i] = kt1 * ebr1;
      }
    } else {
#pragma unroll
      for (int i = 0; i < 8; ++i) { kh0[i] = kx0[i] * (g0[i] * d0); kh1[i] = kx1[i] * (g1[i] * d1); }
    }
    *(u32x4*)(sKhT + ch0 * 72 + 8 * tg) = CVT8(kh0);
    *(u32x4*)(sKhT + (ch0 + 1) * 72 + 8 * tg) = CVT8(kh1);
    *(u32x4*)(sVT + ch0 * 72 + 8 * tg) = PACK8_LO(vv);
    *(u32x4*)(sVT + (ch0 + 1) * 72 + 8 * tg) = PACK8_HI(vv);
    if (tg == 0) *(float2*)(sD + ch0) = make_float2(be0, be1);
    if (do_out) scan_write_state<K, V>(smem, S, w, lane);
    if (ci + 1 < SLEN) gloadB(cidx + 1);
    lds_barrier();
    scan_core<K, V, false>(smem, S, OB + (rowbase + (size_t)chunk * 64) * 512 + head * 128, dir, w, lane, do_out, nullptr);
    if (ci + 1 < SLEN) { stage1(); if (ci + 2 < SLEN) gloadA(cidx + 2); }
  }
  if (!do_out) {
    state_store<K, V>(sbuf, S, w, lane);
    if (tg == 0) *(float2*)((float*)(p.ws + OFF_DB) + ((size_t)it * NSEG + seg) * 128 + ch0) = make_float2(dlog0, dlog1);
  }
  if (tid == 0) ((volatile int*)(smem + LDS_BYTES - 16))[1] = nxt;
  lds_barrier();
}

DEV void gla_item(const ParamsG& p, int l, int it, int seg, int mode, unsigned* ctr, unsigned char* smem) {
  const int j16 = it - 16, bl = j16 >> 3, head = (j16 >> 1) & 3, dir = j16 & 1;
  const bool do_out = (mode == 3);
  int nxt = 0;
  constexpr int K = 64, V = 128, KPW = 36;
  const int tid = launder(threadIdx.x), lane = tid & 63, w = tid >> 6;
  const int cp = tid & 31, tg = tid >> 5, ch0 = 2 * cp;
  const int vp2 = tid & 63, vg = tid >> 6;
  const bf16_t* Hh = (const bf16_t*)(p.ws + OFF_H);
  const bf16_t* Gb = (const bf16_t*)(p.ws + OFF_G);
  bf16_t* OB = (bf16_t*)(p.ws + OFF_OBUF) + (size_t)(2 * 2 + dir) * TH * 512;
  const size_t rowbase = (size_t)bl * SEQ;
  unsigned* sQt = (unsigned*)(smem + L_QT); unsigned* sKt = (unsigned*)(smem + L_KT); unsigned* sQc = (unsigned*)(smem + L_QC);
  bf16_t* sKhT = (bf16_t*)(smem + L_KHT); bf16_t* sVT = (bf16_t*)(smem + L_VT);
  float* sD = (float*)(smem + L_D); float* sTot = (float*)(smem + L_TOT);
  f32x16 S[1]; S[0] = zero16();
  bf16_t* sbuf = (bf16_t*)(p.ws + OFF_SB1) + ((size_t)j16 * NSEG + seg) * 8192;
  if (do_out) state_combine<K, V>((const bf16_t*)(p.ws + OFF_SB1) + (size_t)j16 * NSEG * 8192, 8192, (const float*)(p.ws + OFF_DB) + (size_t)it * NSEG * 128, seg, S, w, lane);
  float dlog0 = 0.f, dlog1 = 0.f;
  unsigned pg[4];
  float g0[4], g1[4]; unsigned kk[4], qq[4], vv[8];
  auto gloadA = [&](int cidx) __attribute__((always_inline)) {
    const int chunk = dir ? (63 - cidx) : cidx;
#pragma unroll
    for (int i = 0; i < 4; ++i) {
      const int tau = 4 * tg + i;
      const int tok = chunk * 64 + (dir ? (63 - tau) : tau);
      pg[i] = ((const unsigned*)(Gb + (rowbase + tok) * 512 + dir * 256 + head * 64))[cp];
    }
  };
  auto gloadB = [&](int cidx) __attribute__((always_inline)) {
    const int chunk = dir ? (63 - cidx) : cidx;
#pragma unroll
    for (int i = 0; i < 4; ++i) {
      const int tau = 4 * tg + i;
      const int tok = chunk * 64 + (dir ? (63 - tau) : tau);
      const unsigned* rp = (const unsigned*)(Hh + (rowbase + tok) * NPAD + head * 64) + cp;
      kk[i] = rp[G_K / 2]; qq[i] = do_out ? rp[G_Q / 2] : 0u;
    }
#pragma unroll
    for (int i = 0; i < 8; ++i) {
      const int tau = 8 * vg + i;
      const int tok = chunk * 64 + (dir ? (63 - tau) : tau);
      vv[i] = ((const unsigned*)(Hh + (rowbase + tok) * NPAD + G_V + head * 128))[vp2];
    }
  };
  auto stage1 = [&]() __attribute__((always_inline)) {
    float r0 = 0.f, r1 = 0.f;
#pragma unroll
    for (int i = 0; i < 4; ++i) { r0 += lo16(pg[i]); r1 += hi16(pg[i]); g0[i] = r0; g1[i] = r1; }
    *(float2*)(sTot + tg * 64 + ch0) = make_float2(r0, r1);
  };
  gloadA(seg * SLEN); gloadB(seg * SLEN);
  stage1();
  if (SLEN > 1) gloadA(seg * SLEN + 1);
  for (int ci = 0; ci < SLEN; ++ci) {
    const int cidx = seg * SLEN + ci;
    const int chunk = dir ? (63 - cidx) : cidx;
    lds_barrier();
    if (ci == SLEN - 1 && tid == 0) nxt = (int)atomicAdd(ctr, 1u);
    float off0 = 0.f, off1 = 0.f, ref0 = 0.f, ref1 = 0.f, be0 = 0.f, be1 = 0.f;
    float2 tl[16];
#pragma unroll
    for (int j = 0; j < 16; ++j) tl[j] = *(const float2*)(sTot + j * 64 + ch0);
    __builtin_amdgcn_sched_barrier(0);
#pragma unroll
    for (int j = 0; j < 16; ++j) {
      const float2 t = tl[j];
      if (j < tg) { off0 += t.x; off1 += t.y; }
      if (j < 8) { ref0 += t.x; ref1 += t.y; }
      be0 += t.x; be1 += t.y;
    }
    dlog0 += be0; dlog1 += be1;
    const float eref0 = ex2(ref0), eref1 = ex2(ref1), ebr0 = ex2(be0 - ref0), ebr1 = ex2(be1 - ref1);
    const float d0 = off0 - ref0, d1 = off1 - ref1;
    float kh0[4], kh1[4];
#pragma unroll
    for (int i = 0; i < 4; ++i) {
      const int tau = 4 * tg + i;
      const float E0 = ex2(g0[i] + d0), E1 = ex2(g1[i] + d1);
      const float kt0 = lo16(kk[i]) * frcp(E0), kt1 = hi16(kk[i]) * frcp(E1);
      if (do_out) {
        const float qt0 = lo16(qq[i]) * E0, qt1 = hi16(qq[i]) * E1;
        sQt[tau * KPW + cp] = pk2(qt0, qt1);
        sKt[tau * KPW + cp] = pk2(kt0, kt1);
        sQc[tau * KPW + cp] = pk2(qt0 * eref0, qt1 * eref1);
      }
      kh0[i] = kt0 * ebr0; kh1[i] = kt1 * ebr1;
    }
    *(uint2*)(sKhT + ch0 * 72 + 4 * tg) = make_uint2(pk2(kh0[0], kh0[1]), pk2(kh0[2], kh0[3]));
    *(uint2*)(sKhT + (ch0 + 1) * 72 + 4 * tg) = make_uint2(pk2(kh1[0], kh1[1]), pk2(kh1[2], kh1[3]));
    *(u32x4*)(sVT + (2 * vp2) * 72 + 8 * vg) = PACK8_LO(vv);
    *(u32x4*)(sVT + (2 * vp2 + 1) * 72 + 8 * vg) = PACK8_HI(vv);
    if (tg == 0) *(float2*)(sD + ch0) = make_float2(ex2(be0), ex2(be1));
    if (do_out) scan_write_state<K, V>(smem, S, w, lane);
    if (ci + 1 < SLEN) gloadB(cidx + 1);
    lds_barrier();
    scan_core<K, V, false>(smem, S, OB + (rowbase + (size_t)chunk * 64) * 512 + head * 128, dir, w, lane, do_out, nullptr);
    if (ci + 1 < SLEN) { stage1(); if (ci + 2 < SLEN) gloadA(cidx + 2); }
  }
  if (!do_out) {
    state_store<K, V>(sbuf, S, w, lane);
    if (tg == 0) *(float2*)((float*)(p.ws + OFF_DB) + ((size_t)it * NSEG + seg) * 128 + ch0) = make_float2(ex2(dlog0), ex2(dlog1));
  }
  if (tid == 0) ((volatile int*)(smem + LDS_BYTES - 16))[1] = nxt;
  lds_barrier();
}

DEV void ssd_item(const ParamsG& p, int l, int it, int seg, int mode, unsigned* ctr, unsigned char* smem) {
  const int j32 = it - 32, bl = j32 >> 4, head = (j32 >> 1) & 7, dir = j32 & 1;
  const bool do_out = (mode == 3);
  int nxt = 0;
  constexpr int K = 128, V = 64, KPW = 68;
  const int tid = launder(threadIdx.x), lane = tid & 63, w = tid >> 6;
  const int cp = tid & 63, tg = tid >> 6, n0 = 2 * cp;
  const int xp = tid & 31, xg = tid >> 5;
  const int grp = head >> 2;
  const bf16_t* U = (const bf16_t*)(p.ws + OFF_U);
  const float* SMALL = (const float*)(p.ws + OFF_SMALL);
  bf16_t* OB = (bf16_t*)(p.ws + OFF_OBUF) + (size_t)(1 * 2 + dir) * TH * 512;
  const size_t rowbase = (size_t)bl * SEQ;
  unsigned* sQt = (unsigned*)(smem + L_QT); unsigned* sKt = (unsigned*)(smem + L_KT); unsigned* sQc = (unsigned*)(smem + L_QC);
  bf16_t* sKhT = (bf16_t*)(smem + L_KHT); bf16_t* sVT = (bf16_t*)(smem + L_VT);
  float* sD = (float*)(smem + L_D);
  const float dtb = p.dt_bias[(l * 2 + dir) * 8 + head];
  const float Acoef = -__expf(p.a_log[(l * 2 + dir) * 8 + head]) * LOG2E;
  const float dsk = (dir == 0) ? p.ssd_d[l * 8 + head] : 0.f;
  f32x16 S[1]; S[0] = zero16();
  f32x16 accA = zero16();
  bf16_t* sbuf = (bf16_t*)(p.ws + OFF_SB2) + ((size_t)j32 * NSEG + seg) * 8192;
  if (do_out) state_combine<K, V>((const bf16_t*)(p.ws + OFF_SB2) + (size_t)j32 * NSEG * 8192, 8192, (const float*)(p.ws + OFF_DB) + (size_t)it * NSEG * 128, seg, S, w, lane);
  float dlog = 0.f;
  unsigned bb[8], cc[8], xx[4];
  auto gloadB = [&](int cidx) __attribute__((always_inline)) {
    const int chunk = dir ? (63 - cidx) : cidx;
#pragma unroll
    for (int i = 0; i < 8; ++i) {
      const int tau = 8 * tg + i;
      const int tok = chunk * 64 + (dir ? (63 - tau) : tau);
      const unsigned* rp = (const unsigned*)(U + (rowbase + tok) * 1024 + grp * 128) + cp;
      bb[i] = rp[512 / 2]; cc[i] = do_out ? rp[768 / 2] : 0u;
    }
#pragma unroll
    for (int i = 0; i < 4; ++i) {
      const int tau = 4 * xg + i;
      const int tok = chunk * 64 + (dir ? (63 - tau) : tau);
      xx[i] = ((const unsigned*)(U + (rowbase + tok) * 1024 + head * 64))[xp];
    }
  };
  gloadB(seg * SLEN);
  static_assert(SLEN == 8, "one wave per chunk");
  {
    const int cidx = seg * SLEN + w, chunk = dir ? (63 - cidx) : cidx;
    const int tok = chunk * 64 + (dir ? (63 - lane) : lane);
    const float xv = SMALL[(rowbase + tok) * 48 + dir * 8 + head] + dtb;
    const float dt = (xv > 20.f) ? xv : lg2(1.f + ex2(xv * LOG2E)) * 0.6931471805599453f;
    float a = dt * Acoef;
#pragma unroll
    for (int o = 1; o < 64; o <<= 1) { const float t = __shfl_up(a, o); if (lane >= o) a += t; }
    ((float*)(smem + L_ACS8))[w * 64 + lane] = a; ((float*)(smem + L_DT8))[w * 64 + lane] = dt;
  }
  for (int ci = 0; ci < SLEN; ++ci) {
    const int cidx = seg * SLEN + ci;
    const int chunk = dir ? (63 - cidx) : cidx;
    const float* sAcs = (const float*)(smem + L_ACS8) + ci * 64;
    const float* sDt = (const float*)(smem + L_DT8) + ci * 64;
    lds_barrier();
    if (ci == SLEN - 1 && tid == 0) nxt = (int)atomicAdd(ctr, 1u);
    if (do_out && ci > 0) { const int pc = dir ? (63 - (cidx - 1)) : (cidx - 1); scan_finish_split(smem, accA, OB + (rowbase + (size_t)pc * 64) * 512 + head * 64, dir, w, lane); }
    const float aend = sAcs[63];
    dlog += aend;
    {
      float kh0[8], kh1[8];
      const f32x4 acv0 = *(const f32x4*)(sAcs + 8 * tg), acv1 = *(const f32x4*)(sAcs + 8 * tg + 4);
      const f32x4 dtv4 = *(const f32x4*)(sDt + 4 * xg);
#pragma unroll
      for (int i = 0; i < 8; ++i) {
        const int tau = 8 * tg + i;
        const float ac = (i < 4) ? acv0[i & 3] : acv1[i & 3];
        const float eb = ex2(aend - ac);
        kh0[i] = lo16(bb[i]) * eb; kh1[i] = hi16(bb[i]) * eb;
        if (do_out) {
          const float ea = ex2(ac);
          sKt[tau * KPW + cp] = bb[i];
          sQt[tau * KPW + cp] = cc[i];
          sQc[tau * KPW + cp] = pk2(lo16(cc[i]) * ea, hi16(cc[i]) * ea);
        }
      }
      *(u32x4*)(sKhT + n0 * 72 + 8 * tg) = CVT8(kh0);
      *(u32x4*)(sKhT + (n0 + 1) * 72 + 8 * tg) = CVT8(kh1);
      float x0[4], x1[4];
#pragma unroll
      for (int i = 0; i < 4; ++i) { const float dtv = dtv4[i]; x0[i] = lo16(xx[i]) * dtv; x1[i] = hi16(xx[i]) * dtv; }
      *(uint2*)(sVT + (2 * xp) * 72 + 4 * xg) = make_uint2(pk2(x0[0], x0[1]), pk2(x0[2], x0[3]));
      *(uint2*)(sVT + (2 * xp + 1) * 72 + 4 * xg) = make_uint2(pk2(x1[0], x1[1]), pk2(x1[2], x1[3]));
      if (tg == 0) *(float2*)(sD + n0) = make_float2(ex2(aend), ex2(aend));
    }
    if (do_out) scan_write_state<K, V>(smem, S, w, lane);
    if (ci + 1 < SLEN) gloadB(cidx + 1);
    lds_barrier();
    if (do_out) scan_core_split(smem, S, accA, w, lane, sAcs, sDt, dsk);
    else scan_core<K, V, true>(smem, S, OB + (rowbase + (size_t)chunk * 64) * 512 + head * 64, dir, w, lane, do_out, sAcs);
  }
  if (!do_out) {
    state_store<K, V>(sbuf, S, w, lane);
    if (tg == 0) *(float2*)((float*)(p.ws + OFF_DB) + ((size_t)it * NSEG + seg) * 128 + n0) = make_float2(ex2(dlog), ex2(dlog));
  }
  if (do_out) {
    lds_barrier();
    const int lc = seg * SLEN + SLEN - 1, pc = dir ? (63 - lc) : lc;
    scan_finish_split(smem, accA, OB + (rowbase + (size_t)pc * 64) * 512 + head * 64, dir, w, lane);
  }
  if (tid == 0) ((volatile int*)(smem + LDS_BYTES - 16))[1] = nxt;
  lds_barrier();
}

DEV void gla_pass1_item(const ParamsG& p, int l, int it, int seg, unsigned* ctr, unsigned char* smem) {
  const int j16 = it - 16, bl = j16 >> 3, head = (j16 >> 1) & 3, dir = j16 & 1;
  constexpr int K = 64, V = 128, TS = SLEN * 64, KHP = TS + 8;
  const int tid = launder(threadIdx.x), lane = tid & 63, w = tid >> 6;
  const int cp = tid & 31, tg = tid >> 5, ch0 = 2 * cp;
  const int vp2 = tid & 63, vg = tid >> 6;
  const bf16_t* Hh = (const bf16_t*)(p.ws + OFF_H);
  const bf16_t* Gb = (const bf16_t*)(p.ws + OFF_G);
  const size_t rowbase = (size_t)bl * SEQ;
  bf16_t* sKhT = (bf16_t*)smem;
  float* sTot = (float*)(smem + 66560);
  auto tokpos = [&](int n) __attribute__((always_inline)) { const int g = seg * TS + n; return dir ? (SEQ - 1 - g) : g; };
  unsigned pg[32], kk[32];
#pragma unroll
  for (int i = 0; i < 32; ++i) {
    const size_t row = rowbase + tokpos(tg * 32 + i);
    pg[i] = ((const unsigned*)(Gb + row * 512 + dir * 256 + head * 64))[cp];
    kk[i] = ((const unsigned*)(Hh + row * NPAD + G_K + head * 64))[cp];
  }
  float g0[32], g1[32];
  float r0 = 0.f, r1 = 0.f;
#pragma unroll
  for (int i = 0; i < 32; ++i) { r0 += lo16(pg[i]); r1 += hi16(pg[i]); g0[i] = r0; g1[i] = r1; }
  *(float2*)(sTot + tg * 64 + ch0) = make_float2(r0, r1);
  unsigned vv[SLEN][8];
#pragma unroll
  for (int ci = 0; ci < SLEN; ++ci)
#pragma unroll
    for (int i = 0; i < 8; ++i) vv[ci][i] = ((const unsigned*)(Hh + (rowbase + tokpos(ci * 64 + 8 * vg + i)) * NPAD + G_V + head * 128))[vp2];
  lds_barrier();
  float off0 = 0.f, off1 = 0.f, tot0 = 0.f, tot1 = 0.f;
  {
    float2 tl[16];
#pragma unroll
    for (int j = 0; j < 16; ++j) tl[j] = *(const float2*)(sTot + j * 64 + ch0);
#pragma unroll
    for (int j = 0; j < 16; ++j) { if (j < tg) { off0 += tl[j].x; off1 += tl[j].y; } tot0 += tl[j].x; tot1 += tl[j].y; }
  }
  const float d0 = tot0 - off0, d1 = tot1 - off1;
#pragma unroll
  for (int j = 0; j < 4; ++j) {
    float kh0[8], kh1[8];
#pragma unroll
    for (int e = 0; e < 8; ++e) { const int i = 8 * j + e; kh0[e] = lo16(kk[i]) * ex2(d0 - g0[i]); kh1[e] = hi16(kk[i]) * ex2(d1 - g1[i]); }
    *(u32x4*)(sKhT + ch0 * KHP + tg * 32 + 8 * j) = CVT8(kh0);
    *(u32x4*)(sKhT + (ch0 + 1) * KHP + tg * 32 + 8 * j) = CVT8(kh1);
  }
  int nxt = 0;
  f32x16 S[1]; S[0] = zero16();
#pragma unroll
  for (int ci = 0; ci < SLEN; ++ci) {
    bf16_t* sVT = (bf16_t*)(smem + 70656 + (ci & 1) * 18432);
    *(u32x4*)(sVT + (2 * vp2) * 72 + 8 * vg) = PACK8_LO(vv[ci]);
    *(u32x4*)(sVT + (2 * vp2 + 1) * 72 + 8 * vg) = PACK8_HI(vv[ci]);
    if (ci == SLEN - 3 && tid == 0) nxt = (int)atomicAdd(ctr, 1u);
    lds_barrier();
    mma32<64>(S[0], sKhT + (w >> 2) * 32 * KHP + ci * 64, KHP, sVT + (w & 3) * 32 * 72, 72, lane);
  }
  state_store<K, V>((bf16_t*)(p.ws + OFF_SB1) + ((size_t)j16 * NSEG + seg) * 8192, S, w, lane);
  if (tg == 0) *(float2*)((float*)(p.ws + OFF_DB) + ((size_t)it * NSEG + seg) * 128 + ch0) = make_float2(ex2(tot0), ex2(tot1));
  if (tid == 0) ((volatile int*)(smem + LDS_BYTES - 16))[1] = nxt;
  lds_barrier();
}

DEV void ssd_pass1_item(const ParamsG& p, int l, int it, int seg, unsigned* ctr, unsigned char* smem) {
  const int j32 = it - 32, bl = j32 >> 4, head = (j32 >> 1) & 7, dir = j32 & 1;
  constexpr int K = 128, V = 64;
  const int tid = launder(threadIdx.x), lane = tid & 63, w = tid >> 6;
  const int cp = tid & 63, tg = tid >> 6, n0 = 2 * cp;
  const int xp = tid & 31, xg = tid >> 5;
  const int grp = head >> 2;
  const bf16_t* U = (const bf16_t*)(p.ws + OFF_U);
  const float* SMALL = (const float*)(p.ws + OFF_SMALL);
  const size_t rowbase = (size_t)bl * SEQ;
  float* sW = (float*)(smem + L_TOT); float* sWT = (float*)(smem + L_D);
  unsigned bb[SLEN][8], xx[SLEN][4];
#pragma unroll
  for (int ci = 0; ci < SLEN; ++ci) {
    const int cidx = seg * SLEN + ci, chunk = dir ? (63 - cidx) : cidx;
#pragma unroll
    for (int i = 0; i < 8; ++i) {
      const int tau = 8 * tg + i, tok = chunk * 64 + (dir ? (63 - tau) : tau);
      bb[ci][i] = ((const unsigned*)(U + (rowbase + tok) * 1024 + grp * 128 + 512))[cp];
    }
#pragma unroll
    for (int i = 0; i < 4; ++i) {
      const int tau = 4 * xg + i, tok = chunk * 64 + (dir ? (63 - tau) : tau);
      xx[ci][i] = ((const unsigned*)(U + (rowbase + tok) * 1024 + head * 64))[xp];
    }
  }
  float dlog; int nxt = 0;
  {
    const float dtb = p.dt_bias[(l * 2 + dir) * 8 + head];
    const float Acoef = -__expf(p.a_log[(l * 2 + dir) * 8 + head]) * LOG2E;
    const int n = seg * (SLEN * 64) + tid, pos = dir ? (SEQ - 1 - n) : n;
    const float xv = SMALL[(rowbase + pos) * 48 + dir * 8 + head] + dtb;
    const float dt = (xv > 20.f) ? xv : lg2(1.f + ex2(xv * LOG2E)) * 0.6931471805599453f;
    float a = dt * Acoef;
#pragma unroll
    for (int o = 1; o < 64; o <<= 1) { const float t = __shfl_up(a, o); if (lane >= o) a += t; }
    if (lane == 63) sWT[w] = a;
    lds_barrier();
    float off = 0.f, tot = 0.f;
#pragma unroll
    for (int j = 0; j < 8; ++j) { const float t = sWT[j]; if (j < w) off += t; tot += t; }
    sW[tid] = dt * ex2(tot - (a + off));
    dlog = tot;
    lds_barrier();
  }
  f32x16 S[1]; S[0] = zero16();
#pragma unroll
  for (int ci = 0; ci < SLEN; ++ci) {
    bf16_t* sBT = (bf16_t*)(smem + (ci & 1) * 27648); bf16_t* sXT = sBT + 128 * 72;
    *(u32x4*)(sBT + n0 * 72 + 8 * tg) = PACK8_LO(bb[ci]);
    *(u32x4*)(sBT + (n0 + 1) * 72 + 8 * tg) = PACK8_HI(bb[ci]);
    float x0[4], x1[4];
#pragma unroll
    for (int i = 0; i < 4; ++i) { const float wv = sW[ci * 64 + 4 * xg + i]; x0[i] = lo16(xx[ci][i]) * wv; x1[i] = hi16(xx[ci][i]) * wv; }
    *(uint2*)(sXT + (2 * xp) * 72 + 4 * xg) = make_uint2(pk2(x0[0], x0[1]), pk2(x0[2], x0[3]));
    *(uint2*)(sXT + (2 * xp + 1) * 72 + 4 * xg) = make_uint2(pk2(x1[0], x1[1]), pk2(x1[2], x1[3]));
    if (ci == SLEN - 3 && tid == 0) nxt = (int)atomicAdd(ctr, 1u);
    lds_barrier();
    mma32<64>(S[0], sBT + (w >> 1) * 32 * 72, 72, sXT + (w & 1) * 32 * 72, 72, lane);
  }
  state_store<K, V>((bf16_t*)(p.ws + OFF_SB2) + ((size_t)j32 * NSEG + seg) * 8192, S, w, lane);
  if (tg == 0) *(float2*)((float*)(p.ws + OFF_DB) + ((size_t)it * NSEG + seg) * 128 + n0) = make_float2(ex2(dlog), ex2(dlog));
  if (tid == 0) ((volatile int*)(smem + LDS_BYTES - 16))[1] = nxt;
  lds_barrier();
}

DEV void phase_prep(const ParamsG& p, int l, int hf, int rep, unsigned char* smem) {
  const int tid = launder(threadIdx.x), lane = tid & 63;
  bf16_t* Hh = (bf16_t*)(p.ws + OFF_H);
  bf16_t* U = (bf16_t*)(p.ws + OFF_U);
  bf16_t* Gb = (bf16_t*)(p.ws + OFF_G);
  bf16_t* VT = (bf16_t*)(p.ws + OFF_VT);
  const float* SMALLp = (const float*)(p.ws + OFF_SMALL);
  float2* stab = (float2*)smem;
  float* slow = (float*)(smem + 8192);
  bf16_t* sT = (bf16_t*)(smem + 12288);
  {
    const float2* tabg = (const float2*)(p.ws + OFF_TAB);
    for (int i = tid; i < 1024; i += NT) stab[i] = tabg[i];
  }
  const int cg8 = (tid & 127) * 8, rsub = tid >> 7;
  const float* cw = (const float*)(p.conv_w + (size_t)l * 5 * 1024); const float* cb = (const float*)(p.conv_b + (size_t)l * 1024);
  float wv[5][8], bv[8];
#pragma unroll
  for (int j = 0; j < 5; ++j)
#pragma unroll
    for (int e = 0; e < 8; ++e) wv[j][e] = cw[j * 1024 + cg8 + e];
#pragma unroll
  for (int e = 0; e < 8; ++e) bv[e] = cb[cg8 + e];
  const int gd = tid >> 8, gc = tid & 255;
  const int i16 = lane & 15;
  const float* gq = (const float*)(p.q_gain + l * 64 + 4 * i16); const float* gk = (const float*)(p.k_gain + l * 64 + 4 * i16);
  const float gqv[4] = {gq[0], gq[1], gq[2], gq[3]}, gkv[4] = {gk[0], gk[1], gk[2], gk[3]};
  for (int grp = blockIdx.x; grp < TH / 32; grp += gridDim.x) {
    const int r0 = grp * 32;
    lds_barrier();
    const u32x4 vt = *(const u32x4*)(Hh + (size_t)(r0 + (tid >> 4)) * NPAD + A_V + (tid & 15) * 8);
    const float2 lowv = *(const float2*)(SMALLp + (size_t)(r0 + (tid >> 4)) * 48 + 16 + (tid & 15) * 2);
    *(u32x4*)(sT + (tid >> 4) * 136 + (tid & 15) * 8) = vt;
    *(float2*)(slow + (tid >> 4) * 32 + (tid & 15) * 2) = lowv;
#pragma unroll 1
    for (int ps = 0; ps < 2; ++ps) {
      const int ra = r0 + 16 * ps + 4 * rsub, ta = ra & (SEQ - 1);
      u32x4 xc[8];
#pragma unroll
      for (int m = 0; m < 8; ++m) {
        const int sq = ta + m - 2;
        xc[m] = (u32x4){0u, 0u, 0u, 0u};
        if (sq >= 0 && sq < SEQ) xc[m] = *(const u32x4*)(Hh + (size_t)(ra + m - 2) * NPAD + S_X + cg8);
      }
#pragma unroll
      for (int o4 = 0; o4 < 4; ++o4) {
        float u[8];
#pragma unroll
        for (int e = 0; e < 8; ++e) u[e] = bv[e];
#pragma unroll
        for (int j = 0; j < 5; ++j)
#pragma unroll
          for (int e = 0; e < 4; ++e) { u[2 * e] += wv[j][2 * e] * lo16(xc[o4 + j][e]); u[2 * e + 1] += wv[j][2 * e + 1] * hi16(xc[o4 + j][e]); }
        u32x4 o;
#pragma unroll
        for (int e = 0; e < 4; ++e) {
          const float a = u[2 * e] * frcp(1.f + ex2(fminf(-u[2 * e] * LOG2E, 80.f)));
          const float b = u[2 * e + 1] * frcp(1.f + ex2(fminf(-u[2 * e + 1] * LOG2E, 80.f)));
          o[e] = pk2(a, b);
        }
        *(u32x4*)(U + (size_t)(ra + o4) * 1024 + cg8) = o;
      }
    }
    lds_barrier();
    if (rep == 0) {
      uint2 xq[2];
#pragma unroll
      for (int u = 0; u < 2; ++u) {
        const int pi = u * 32 + (tid >> 4), row = r0 + (pi >> 1), hd = pi & 1;
        xq[u] = *(const uint2*)(Hh + (size_t)row * NPAD + A_K + hd * 64 + 4 * i16);
      }
#pragma unroll
      for (int u = 0; u < 2; ++u) {
        const int pi = u * 32 + (tid >> 4), row = r0 + (pi >> 1), hd = pi & 1;
        const float x[4] = {lo16(xq[u].x), hi16(xq[u].x), lo16(xq[u].y), hi16(xq[u].y)};
        float ss = x[0] * x[0] + x[1] * x[1] + x[2] * x[2] + x[3] * x[3];
        ss += __shfl_xor(ss, 1); ss += __shfl_xor(ss, 2); ss += __shfl_xor(ss, 4); ss += __shfl_xor(ss, 8);
        const float rstd = rsqrtf(ss * (1.f / 64.f) + 1e-6f);
        const int t = row & (SEQ - 1);
        const int pos = (i16 < 8) ? (t >> 6) : (t & 63);
        float o[4];
#pragma unroll
        for (int e = 0; e < 4; ++e) {
          const float v = x[e] * rstd * gkv[e];
          const float pv = __shfl_xor(v, 4);
          const float2 cs = stab[pos * 16 + 4 * (i16 & 3) + e];
          o[e] = (i16 & 4) ? (v * cs.x + pv * cs.y) : (v * cs.x - pv * cs.y);
        }
        *(uint2*)(Hh + (size_t)row * NPAD + A_K + hd * 64 + 4 * i16) = make_uint2(pk2(o[0], o[1]), pk2(o[2], o[3]));
      }
    }
    {
      const int gw = tid >> 6, gcl = lane & 31, gh = lane >> 5;
#pragma unroll
      for (int t2 = 0; t2 < 2; ++t2) {
        const int tile = 2 * gw + t2, gdir = tile >> 3, ch = (tile * 32 + gcl) & 255;
        union { bf16x8 v; unsigned u[4]; } aw, bw;
        const float* wp = (const float*)(p.gk_w2 + ((size_t)(l * 2 + gdir) * 16 + 8 * gh) * 256 + ch);
#pragma unroll
        for (int j = 0; j < 4; ++j) bw.u[j] = pk2(wp[(2 * j) * 256], wp[(2 * j + 1) * 256]);
        const f32x4 la = *(const f32x4*)(slow + gcl * 32 + gdir * 16 + 8 * gh), lb = *(const f32x4*)(slow + gcl * 32 + gdir * 16 + 8 * gh + 4);
        aw.u[0] = pk2(la[0], la[1]); aw.u[1] = pk2(la[2], la[3]); aw.u[2] = pk2(lb[0], lb[1]); aw.u[3] = pk2(lb[2], lb[3]);
        f32x16 acc = __builtin_amdgcn_mfma_f32_32x32x16_bf16(aw.v, bw.v, zero16(), 0, 0, 0);
        const float gbias = p.gk_b[(l * 2 + gdir) * 256 + ch];
#pragma unroll
        for (int reg = 0; reg < 16; ++reg) {
          const float gkk = acc[reg] + gbias;
          acc[reg] = (fminf(gkk, 0.f) * LOG2E - lg2(1.f + ex2(-fabsf(gkk) * LOG2E))) * (1.f / 16.f);
        }
        store_tile(acc, Gb + (size_t)r0 * 512, 0, tile, 0, lane);
      }
    }
    {
      const int c = tid >> 2, tq = (tid & 3) * 8;
      unsigned v[8];
#pragma unroll
      for (int i = 0; i < 8; ++i) v[i] = sT[(tq + i) * 136 + c];
      const int bl = r0 >> 12, t0 = (r0 & (SEQ - 1)) + tq;
      *(u32x4*)(VT + ((size_t)((bl * 2 + (c >> 6)) * 64 + (c & 63))) * SEQ + t0) = (u32x4){v[0] | (v[1] << 16), v[2] | (v[3] << 16), v[4] | (v[5] << 16), v[6] | (v[7] << 16)};
    }
  }
  lds_barrier();
}

DEV void filler_item(const ParamsG& p, int fblk, int f, unsigned* ctr, unsigned char* smem) {
  const int tid = launder(threadIdx.x);
  int nxt = 0;
  if (tid == 0) nxt = (int)atomicAdd(ctr, 1u);
  if (fblk == 0) xconv_item(p, f); else ln_block64(p, (fblk - 1) >> 1, (fblk - 1) & 1, f * 64);
  if (tid == 0) ((volatile int*)(smem + LDS_BYTES - 16))[1] = nxt;
  lds_barrier();
}
DEV void phase_mix(const ParamsG& p, int l, int hf, int slot, int mode, int att_lo, int att_hi, int vid_lo, int vid_hi, int fblk, unsigned char* smem) {
  unsigned* ctr = (unsigned*)(p.ws + OFF_CTRL) + CTR_WORD0 + slot * 16;
  volatile int* sItem = (volatile int*)(smem + LDS_BYTES - 16);
  const int nsg = (mode == 1) ? NSEG - 1 : NSEG;
  const int n_scan = 64 * nsg;
  const int n_main = n_scan + (att_hi - att_lo);
  int hi = n_main + ((fblk > 0) ? TH / 64 : (fblk == 0) ? TH / 32 : 0); if (vid_hi < hi) hi = vid_hi;
  bool first = true, have = false;
  for (;;) {
    int vid;
    if (have) vid = vid_lo + (int)gridDim.x + sItem[1];
    else {
      lds_barrier();
      if (threadIdx.x == 0) sItem[0] = vid_lo + (first ? sItem[2]   : (int)(gridDim.x + atomicAdd(ctr, 1u)));
      lds_barrier();
      vid = sItem[0];
    }
    first = false; have = false;
    if (vid >= hi) break;
    if (vid < n_scan) {
      int seg = vid >> 6, it = vid & 63;
      {
        if (vid < 16 * nsg) { it = vid & 15; seg = vid >> 4; }
        else if (vid < 48 * nsg) { const int v2 = vid - 16 * nsg; it = 32 + (v2 & 31); seg = v2 >> 5; }
        else { const int v2 = vid - 48 * nsg; it = 16 + (v2 & 15); seg = v2 >> 4; }
        if (mode == 3) { if (it >= 32) { if (seg >= NSEG / 2) seg = NSEG + NSEG / 2 - 1 - seg; } else if (it >= 16) seg = NSEG - 1 - seg; }
      }
#if PROBE_REP > 0
      if (slot >= 40 && PROBE_TYPE >= 0 && ((it < 16) ? 0 : (it < 32) ? 1 : 2) != PROBE_TYPE) continue;
#endif
      if (it < 16) { if (PH_MASK & 0x100) { if (mode == 3) hgrn_item<true>(p, l, it, seg, ctr, smem); else hgrn_item<false>(p, l, it, seg, ctr, smem); have = true; } }
      else if (it < 32) { if (PH_MASK & 0x200) { if (mode == 1) gla_pass1_item(p, l, it, seg, ctr, smem); else gla_item(p, l, it, seg, mode, ctr, smem); have = true; } }
      else { if (PH_MASK & 0x400) { if (mode == 1) ssd_pass1_item(p, l, it, seg, ctr, smem); else ssd_item(p, l, it, seg, mode, ctr, smem); have = true; } }
    } else if (vid < n_main) { if (PH_MASK & 0x800) { attn_item(p, l, att_lo + (vid - n_scan), ctr, smem); have = true; } }
    else { filler_item(p, fblk, vid - n_main, ctr, smem); have = true; }
  }
}

DEV void phase_scan2(const ParamsG& p) {
  const size_t gtid = (size_t)blockIdx.x * NT + threadIdx.x, gsz = (size_t)gridDim.x * NT;
  const float* DB = (const float*)(p.ws + OFF_DB);
  for (size_t e = gtid; e < 655360; e += gsz) {
    float* buf; const float* dp; int stride;
    if (e < 262144) { const int it = (int)(e >> 14), idx = (int)(e & 16383); buf = (float*)(p.ws + OFF_SB0) + (size_t)it * NSEG * 16384 + idx; stride = 16384; dp = DB + (size_t)it * NSEG * 128 + (idx >> 7); }
    else if (e < 393216) { const int e2 = (int)(e - 262144), j = e2 >> 13, idx = e2 & 8191; buf = (float*)(p.ws + OFF_SB1) + (size_t)j * NSEG * 8192 + idx; stride = 8192; dp = DB + (size_t)(16 + j) * NSEG * 128 + (idx >> 7); }
    else { const int e3 = (int)(e - 393216), j = e3 >> 13, idx = e3 & 8191; buf = (float*)(p.ws + OFF_SB2) + (size_t)j * NSEG * 8192 + idx; stride = 8192; dp = DB + (size_t)(32 + j) * NSEG * 128 + (idx >> 6); }
    float u[NSEG - 1], d[NSEG - 1];
#pragma unroll
    for (int sg = 0; sg < NSEG - 1; ++sg) { u[sg] = buf[(size_t)sg * stride]; d[sg] = dp[sg * 128]; }
    float st = 0.f;
#pragma unroll
    for (int sg = 0; sg < NSEG; ++sg) { buf[(size_t)sg * stride] = st; if (sg < NSEG - 1) st = d[sg] * st + u[sg]; }
  }
}

DEV float bfe(const u32x4& v, int j) { return (j & 1) ? hi16(v[j >> 1]) : lo16(v[j >> 1]); }
DEV void phase_fin(const ParamsG& p, int l, int hf) {
  const int tid = launder(threadIdx.x), lane = tid & 63, w = tid >> 6;
  const bf16_t* Hh = (const bf16_t*)(p.ws + OFF_H);
  const bf16_t* OB = (const bf16_t*)(p.ws + OFF_OBUF);
  bf16_t* MX = (bf16_t*)(p.ws + OFF_MIXED);
  const int c0 = lane * 8;
  const float* cw = (const float*)(p.conv_w + (size_t)l * 5 * 1024); const float* cb = (const float*)(p.conv_b + (size_t)l * 1024);
  for (int r0 = (blockIdx.x * 8 + w) * 4; r0 < TH; r0 += gridDim.x * 32) {
    {
      u32x4 a[4], b[4], z[4];
#pragma unroll
      for (int i = 0; i < 4; ++i) {
        const bf16_t* hrow = Hh + (size_t)(r0 + i) * NPAD;
        a[i] = __builtin_nontemporal_load((const u32x4*)(OB + ((size_t)0 * TH + r0 + i) * 512 + c0)); b[i] = __builtin_nontemporal_load((const u32x4*)(OB + ((size_t)1 * TH + r0 + i) * 512 + c0));
        z[i] = __builtin_nontemporal_load((const u32x4*)(hrow + H_Z + c0));
      }
      float gn[8];
#pragma unroll
      for (int j = 0; j < 8; ++j) gn[j] = p.hgrn_norm[l * 512 + c0 + j];
#pragma unroll
      for (int i = 0; i < 4; ++i) {
        float o[8]; float ss = 0.f;
#pragma unroll
        for (int j = 0; j < 8; ++j) { o[j] = bfe(a[i], j) + bfe(b[i], j); ss += o[j] * o[j]; }
#pragma unroll
        for (int of = 32; of >= 1; of >>= 1) ss += __shfl_xor(ss, of);
        const float rstd = rsqrtf(ss * (1.f / 512.f) + 1e-6f);
        float y[8];
#pragma unroll
        for (int j = 0; j < 8; ++j) { const float zz = bfe(z[i], j); y[j] = o[j] * rstd * gn[j] * (zz * frcp(1.f + ex2(fminf(-zz * LOG2E, 80.f)))); }
        *(u32x4*)(MX + (size_t)(r0 + i) * DI + 512 + c0) = (u32x4){pk2(y[0], y[1]), pk2(y[2], y[3]), pk2(y[4], y[5]), pk2(y[6], y[7])};
      }
    }
    {
      u32x4 a[4], b[4], z[4];
#pragma unroll
      for (int i = 0; i < 4; ++i) {
        a[i] = __builtin_nontemporal_load((const u32x4*)(OB + ((size_t)4 * TH + r0 + i) * 512 + c0)); b[i] = __builtin_nontemporal_load((const u32x4*)(OB + ((size_t)5 * TH + r0 + i) * 512 + c0));
        z[i] = __builtin_nontemporal_load((const u32x4*)(Hh + (size_t)(r0 + i) * NPAD + G_Z + c0));
      }
      float gn[8];
#pragma unroll
      for (int j = 0; j < 8; ++j) gn[j] = p.gla_norm[l * 128 + ((c0 + j) & 127)];
#pragma unroll
      for (int i = 0; i < 4; ++i) {
        float o[8]; float ss = 0.f;
#pragma unroll
        for (int j = 0; j < 8; ++j) { o[j] = bfe(a[i], j) + bfe(b[i], j); ss += o[j] * o[j]; }
#pragma unroll
        for (int of = 8; of >= 1; of >>= 1) ss += __shfl_xor(ss, of);
        const float rstd = rsqrtf(ss * (1.f / 128.f) + 1e-6f);
        float y[8];
#pragma unroll
        for (int j = 0; j < 8; ++j) { const float zz = bfe(z[i], j); y[j] = o[j] * rstd * gn[j] * (zz * frcp(1.f + ex2(fminf(-zz * LOG2E, 80.f)))); }
        *(u32x4*)(MX + (size_t)(r0 + i) * DI + 1536 + c0) = (u32x4){pk2(y[0], y[1]), pk2(y[2], y[3]), pk2(y[4], y[5]), pk2(y[6], y[7])};
      }
    }
    {
      u32x4 a[4], b[4], z[4];
#pragma unroll
      for (int i = 0; i < 4; ++i) {
        a[i] = __builtin_nontemporal_load((const u32x4*)(OB + ((size_t)2 * TH + r0 + i) * 512 + c0)); b[i] = __builtin_nontemporal_load((const u32x4*)(OB + ((size_t)3 * TH + r0 + i) * 512 + c0));
        z[i] = __builtin_nontemporal_load((const u32x4*)(Hh + (size_t)(r0 + i) * NPAD + S_Z + c0));
      }
      float gn[8];
#pragma unroll
      for (int j = 0; j < 8; ++j) gn[j] = p.ssd_norm[l * 512 + c0 + j];
#pragma unroll
      for (int i = 0; i < 4; ++i) {
        float y[8]; float ss = 0.f;
#pragma unroll
        for (int j = 0; j < 8; ++j) {
          const float zz = bfe(z[i], j);
          y[j] = (bfe(a[i], j) + bfe(b[i], j)) * (zz * frcp(1.f + ex2(fminf(-zz * LOG2E, 80.f))));
          ss += y[j] * y[j];
        }
#pragma unroll
        for (int of = 32; of >= 1; of >>= 1) ss += __shfl_xor(ss, of);
        const float rstd = rsqrtf(ss * (1.f / 512.f) + 1e-6f);
#pragma unroll
        for (int j = 0; j < 8; ++j) y[j] = y[j] * rstd * gn[j];
        *(u32x4*)(MX + (size_t)(r0 + i) * DI + 1024 + c0) = (u32x4){pk2(y[0], y[1]), pk2(y[2], y[3]), pk2(y[4], y[5]), pk2(y[6], y[7])};
      }
    }
  }
}

#define XB_TMO      128
#define XB_XCNT(j)  (256  + 64 * (j))
#define XB_XSUB(j)  (1280 + 64 * (j))
#define XB_XGEN(j)  (2304 + 64 * (j))
#define XB_TOP      3328
#define XB_TOPGEN   3392
#define XB_SPIN_CAP (1u << 22)
#define LAS __attribute__((address_space(3)))
DEV unsigned xb_ld(unsigned* p) { return __hip_atomic_load(p, __ATOMIC_RELAXED, __HIP_MEMORY_SCOPE_AGENT); }
DEV unsigned xb_add(unsigned* p, unsigned v) { return __hip_atomic_fetch_add(p, v, __ATOMIC_RELAXED, __HIP_MEMORY_SCOPE_AGENT); }
DEV unsigned xb_xcc_id() { return (unsigned)__builtin_amdgcn_s_getreg((3 << 11) | 20) & 0xFu; }
#define XB_SPIN(cond, bar) do { unsigned _sp = 0; while (cond) { __builtin_amdgcn_s_sleep(1); \
    if ((++_sp & 255u) == 0u) { if (xb_ld(&(bar)[XB_TMO])) break; if (_sp > XB_SPIN_CAP) { atomicAdd(&(bar)[XB_TMO], 1u); break; } } } } while (0)
struct XcdBarrier { unsigned* bar; unsigned x; volatile LAS unsigned* st; };
DEV XcdBarrier xcd_barrier_post(unsigned* bar, volatile LAS unsigned* st) {
  XcdBarrier b; b.bar = bar; b.x = xb_xcc_id(); b.st = st;
  if (threadIdx.x == 0) (void)xb_add(&bar[XB_XCNT(b.x)], 1u);
  return b;
}
DEV void xcd_barrier_complete(unsigned* bar, unsigned x, unsigned& nloc, unsigned& nx) {
  const unsigned G = gridDim.x * gridDim.y * gridDim.z;
  unsigned sum, cnt, mine, sp = 0u;
  for (;;) {
    sum = 0u; cnt = 0u; mine = 0u;
#pragma unroll
    for (unsigned j = 0; j < 16; ++j) { const unsigned c = xb_ld(&bar[XB_XCNT(j)]); sum += c; cnt += (c > 0u) ? 1u : 0u; mine = (j == x) ? c : mine; }
    if (sum == G) break;
    __builtin_amdgcn_s_sleep(1);
    if ((++sp & 255u) == 0u) { if (xb_ld(&bar[XB_TMO])) break; if (sp > XB_SPIN_CAP) { atomicAdd(&bar[XB_TMO], 1u); break; } }
  }
  nloc = mine > 0u ? mine : 1u; nx = cnt > 0u ? cnt : 1u;
}
DEV void xcd_barrier(const XcdBarrier& b) {
  asm volatile("s_waitcnt vmcnt(0)" ::: "memory");
  __syncthreads();
  if (threadIdx.x == 0) {
    unsigned* bar = b.bar;
    __builtin_amdgcn_s_waitcnt(0);
    __builtin_amdgcn_fence(__ATOMIC_ACQUIRE, "agent");
    unsigned nloc = b.st[0], nx = b.st[1];
    if (nloc == 0u) { xcd_barrier_complete(bar, b.x, nloc, nx); b.st[0] = nloc; b.st[1] = nx; }
    const unsigned old = xb_add(&bar[XB_XSUB(b.x)], 1u);
    const unsigned gen = old / nloc;
    if (old + 1u == (gen + 1u) * nloc) {
      __builtin_amdgcn_fence(__ATOMIC_RELEASE, "agent");
      asm volatile("s_waitcnt vmcnt(0)" ::: "memory");
      const unsigned og = xb_add(&bar[XB_TOP], 1u);
      const unsigned tg = og / nx;
      if (og + 1u == (tg + 1u) * nx) xb_add(&bar[XB_TOPGEN], 1u);
      else XB_SPIN(xb_ld(&bar[XB_TOPGEN]) == tg, bar);
      xb_add(&bar[XB_XGEN(b.x)], 1u);
      asm volatile("s_waitcnt vmcnt(0)" ::: "memory");
    } else {
      XB_SPIN(xb_ld(&bar[XB_XGEN(b.x)]) == gen, bar);
      asm volatile("s_waitcnt vmcnt(0)" ::: "memory");
    }
  }
  __syncthreads();
}

DEV void run_phase(const ParamsG& p, int ph, int rep, unsigned char* smem) {
  if (ph == 0) { if (PH_MASK & 1) { phase_pro(p, smem); convert_weights(p, 0, 3, smem); } return; }
  if (ph == 21) { if (PH_MASK & 16) phase_outproj(p, 1, 1, smem); return; }
  if (ph == 22) { if (PH_MASK & 32) phase_ln(p, 1, 1); return; }
  const int q = ph - 1, blk = q / 5, st = q % 5, l = blk >> 1, hf = blk & 1;
  if (st == 0) {
    if (blk > 0 && (PH_MASK & 16)) phase_outproj(p, (blk - 1) >> 1, (blk - 1) & 1, smem);
    if (PH_MASK & 2) phase_inproj(p, l, hf, blk > 0 ? 16 : 0, smem);
  } else if (st == 1) {
    if (PH_MASK & 4) phase_prep(p, l, hf, rep, smem);
    if ((PH_MASK & 1) && rep == 0 && blk == 1) convert_weights(p, 1, 1, smem);
    if ((PH_MASK & 1) && rep == 0 && blk == 2) convert_weights(p, 1, 2, smem);
  }
  else if (st == 2) { if (PH_MASK & 0xF00) phase_mix(p, l, hf, ph + 40 * rep, 1, 0, ATT_SPLIT, rep ? PROBE_LO : 0, rep ? PROBE_HI : 100000, rep ? -1 : blk, smem); }
  else if (st == 3) { if (PH_MASK & 0xF00) phase_mix(p, l, hf, ph + 40 * rep, 3, ATT_SPLIT, 256, rep ? PROBE_LO : 0, rep ? PROBE_HI : 100000, -1, smem); }
  else { if (PH_MASK & 8) phase_fin(p, l, hf); }
}
__global__ void __launch_bounds__(NT) mega(Params p) {
  extern __shared__ __attribute__((aligned(16))) unsigned char smem[];
#if ONE_LAUNCH
  volatile LAS unsigned* xst = (volatile LAS unsigned*)(smem + LDS_BYTES - 32);
  if (threadIdx.x == 0) { xst[0] = 0u; xst[1] = 0u; ((volatile int*)(smem + LDS_BYTES - 16))[2] = (int)blockIdx.x; }
  __syncthreads();
  XcdBarrier xb = xcd_barrier_post((unsigned*)(p.ws + OFF_CTRL), xst);
#endif
  ParamsG* lp = (ParamsG*)(smem + 147456);
  if (threadIdx.x == 0) {
    lp->x = (GAS const float*)p.x; lp->w_in = (GAS const float*)p.w_in; lp->q_gain = (GAS const float*)p.q_gain; lp->k_gain = (GAS const float*)p.k_gain;
    lp->lb_logits = (GAS const float*)p.lb_logits; lp->hgrn_norm = (GAS const float*)p.hgrn_norm; lp->conv_w = (GAS const float*)p.conv_w; lp->conv_b = (GAS const float*)p.conv_b;
    lp->dt_bias = (GAS const float*)p.dt_bias; lp->a_log = (GAS const float*)p.a_log; lp->ssd_d = (GAS const float*)p.ssd_d; lp->ssd_norm = (GAS const float*)p.ssd_norm;
    lp->gk_w2 = (GAS const float*)p.gk_w2; lp->gk_b = (GAS const float*)p.gk_b; lp->gla_norm = (GAS const float*)p.gla_norm; lp->w_out = (GAS const float*)p.w_out;
    lp->ln_g = (GAS const float*)p.ln_g; lp->ln_b = (GAS const float*)p.ln_b; lp->out = (GAS float*)p.out; lp->ws = (GAS unsigned char*)p.ws;
  }
  __syncthreads();
  const int ph_begin = p.phase_begin, ph_end = p.phase_end;
  for (int ph = ph_begin; ph < ph_end; ++ph) {
    int nrep = 0;
#if PROBE_REP > 0
    {
      const int q = ph - 1, st = q % 5;
      const bool idem = (ph >= 1 && ph <= 20) && (st == PROBE_ST) && (st >= 1 || ph <= PROBE_PHMAX) && (ph >= PROBE_PHMIN);
      if (idem) nrep = PROBE_REP;
    }
#endif
    for (int r = 0; r <= nrep; ++r) {
      run_phase(*lp, ph, r, smem);
#if ONE_LAUNCH
      if (r < nrep || ph + 1 < ph_end) xcd_barrier(xb);
#endif
    }
  }
}

extern "C" void kernel_launch(void* const* d_in, const int* in_sizes, int n_in, void* d_out, int out_size, void* d_ws, size_t ws_size,
                              hipStream_t stream) {
  static int grid_blocks = 0;
  if (!grid_blocks) {
    int dev = 0, cus = 0, per_cu = 0;
    hipGetDevice(&dev);
    hipDeviceGetAttribute(&cus, hipDeviceAttributeMultiprocessorCount, dev);
    hipFuncSetAttribute((const void*)mega, hipFuncAttributeMaxDynamicSharedMemorySize, LDS_BYTES);
    hipOccupancyMaxActiveBlocksPerMultiprocessor(&per_cu, mega, NT, LDS_BYTES);
    if (per_cu < 1) per_cu = 1;
    grid_blocks = cus;
  }
  Params p{};
  p.x = (const float*)d_in[0]; p.w_in = (const float*)d_in[1]; p.q_gain = (const float*)d_in[2]; p.k_gain = (const float*)d_in[3];
  p.lb_logits = (const float*)d_in[4]; p.hgrn_norm = (const float*)d_in[5]; p.conv_w = (const float*)d_in[6]; p.conv_b = (const float*)d_in[7];
  p.dt_bias = (const float*)d_in[8]; p.a_log = (const float*)d_in[9]; p.ssd_d = (const float*)d_in[10]; p.ssd_norm = (const float*)d_in[11];
  p.gk_w2 = (const float*)d_in[12]; p.gk_b = (const float*)d_in[13]; p.gla_norm = (const float*)d_in[14]; p.w_out = (const float*)d_in[15];
  p.ln_g = (const float*)d_in[16]; p.ln_b = (const float*)d_in[17];
  p.out = (float*)d_out; p.ws = (unsigned char*)d_ws;
  hipMemsetAsync(d_ws, 0, CTRL_BYTES, stream);
#if ONE_LAUNCH
  p.phase_begin = 0; p.phase_end = NPHASE;
  void* args[] = {&p};
  (void)args;
  hipLaunchKernelGGL(mega, dim3(grid_blocks), dim3(NT), LDS_BYTES, stream, p);
#else
  for (int ph = 0; ph < NPHASE; ++ph) {
    p.phase_begin = ph; p.phase_end = ph + 1;
    hipLaunchKernelGGL(mega, dim3(grid_blocks), dim3(NT), LDS_BYTES, stream, p);
  }
#endif
}
```
